# Optimizing an MI355X kernel written in HIP

```python
import math
import jax, jax.numpy as jnp
from jax import lax
import numpy as np


D_MODEL = 1024
BATCH = 2
SEQ = 8192
DEPTH = 2

D_FF = 2816
DSA_HEADS = 4
DSA_HEAD_DIM = 128
IDX_HEADS = 8
IDX_DIM = 64
TOPK_MAX = 256
RWKV_HEADS = 8
RWKV_HEAD_DIM = 64
RWKV_WIDTH = RWKV_HEADS * RWKV_HEAD_DIM
DECAY_LORA = 64
AAA_LORA = 64
GATE_LORA = 128
RWKV_GN_EPS = 64e-5
DIFF_HEADS = 4
DIFF_QK_DIM = 64
DIFF_V_DIM = 2 * DIFF_QK_DIM
N_BRANCH = 3
BRANCH_WIDTH = 512
Q_BLOCK = 128
NORM_EPS = 1e-6

A_QKV = DSA_HEADS * DSA_HEAD_DIM
A_IQ = IDX_HEADS * IDX_DIM
DSA_SEGMENTS = (A_QKV, A_QKV, A_QKV, A_IQ, IDX_DIM, IDX_HEADS)
RWKV_SEGMENTS = (RWKV_WIDTH, RWKV_WIDTH, RWKV_WIDTH, DECAY_LORA, AAA_LORA, GATE_LORA)
DIFF_SEGMENTS = (DIFF_HEADS * 2 * DIFF_QK_DIM, DIFF_HEADS * 2 * DIFF_QK_DIM, DIFF_HEADS * DIFF_V_DIM)
GATE_COLS = N_BRANCH * D_MODEL
GROUP_SEGMENTS = (sum(DSA_SEGMENTS), sum(RWKV_SEGMENTS), sum(DIFF_SEGMENTS), GATE_COLS)
D_IN = sum(GROUP_SEGMENTS)
RWKV_STREAM = sum(RWKV_SEGMENTS)
GROUP_CUTS = tuple(sum(GROUP_SEGMENTS[:i]) for i in range(1, len(GROUP_SEGMENTS)))
DSA_CUTS = tuple(sum(DSA_SEGMENTS[:i]) for i in range(1, len(DSA_SEGMENTS)))
RWKV_CUTS = tuple(sum(RWKV_SEGMENTS[:i]) for i in range(1, len(RWKV_SEGMENTS)))
DIFF_CUTS = tuple(sum(DIFF_SEGMENTS[:i]) for i in range(1, len(DIFF_SEGMENTS)))

kernel_name = 'hybrid_dsa_rwkv7_diffattn_block'


def _rms_norm(x, g):
    xf = x.astype(jnp.float32)
    y = xf * lax.rsqrt(jnp.mean(xf * xf, axis=-1, keepdims=True) + NORM_EPS)
    return (y * g.astype(jnp.float32)).astype(x.dtype)


def _swiglu(h, w_gate, w_up, w_down):
    return (jax.nn.silu(h @ w_gate) * (h @ w_up)) @ w_down


def _dsa_branch(z):
    B, L, _ = z.shape
    topk = min(TOPK_MAX, L // 4)
    q, k, v, qi, ki, wi = jnp.split(z, DSA_CUTS, axis=-1)
    q = q.reshape(B, L, DSA_HEADS, DSA_HEAD_DIM)
    k = k.reshape(B, L, DSA_HEADS, DSA_HEAD_DIM)
    v = v.reshape(B, L, DSA_HEADS, DSA_HEAD_DIM)
    qi = qi.reshape(B, L, IDX_HEADS, IDX_DIM)
    ki32 = ki.astype(jnp.float32)
    wi32 = wi.astype(jnp.float32) * (IDX_HEADS ** -0.5)
    key_pos = jnp.arange(L)
    gather = jax.vmap(lambda a, ix: a[ix])

    def block(i):
        t0 = i * Q_BLOCK
        qb = lax.dynamic_slice_in_dim(q, t0, Q_BLOCK, axis=1)
        qib = lax.dynamic_slice_in_dim(qi, t0, Q_BLOCK, axis=1).astype(jnp.float32)
        wib = lax.dynamic_slice_in_dim(wi32, t0, Q_BLOCK, axis=1)
        qpos = t0 + jnp.arange(Q_BLOCK)
        causal = key_pos[None, :] <= qpos[:, None]
        dots = jnp.einsum('bqhd,bsd->bqhs', qib, ki32) * (IDX_DIM ** -0.5)
        score = jnp.einsum('bqhs,bqh->bqs', jax.nn.relu(dots), wib)
        score = jnp.where(causal[None], score, -jnp.inf)
        _, sel = lax.top_k(score, topk)
        valid = sel <= qpos[None, :, None]
        ks = gather(k, sel)
        vs = gather(v, sel)
        logits = jnp.einsum('bqhd,bqkhd->bhqk', qb, ks).astype(jnp.float32) * (DSA_HEAD_DIM ** -0.5)
        logits = jnp.where(valid[:, None], logits, -jnp.inf)
        p = jax.nn.softmax(logits, axis=-1).astype(v.dtype)
        return jnp.einsum('bhqk,bqkhd->bqhd', p, vs)

    out = lax.map(block, jnp.arange(L // Q_BLOCK))
    return jnp.moveaxis(out, 0, 1).reshape(B, L, A_QKV)


def _rwkv7_branch(z, mu, w0, w_up, a0, a_up, g_up, k_k, k_a, r_k, ln_w, ln_b):
    B, L, _ = z.shape
    f32 = jnp.float32
    z_prev = jnp.pad(z, ((0, 0), (1, 0), (0, 0)))[:, :L]
    z = z + (z_prev - z) * mu
    r, k, v, wc, ac, gc = jnp.split(z, RWKV_CUTS, axis=-1)
    w_log = -jax.nn.softplus(-(w0 + jnp.tanh(wc) @ w_up)) - 0.5
    decay = jnp.exp(-jnp.exp(w_log.astype(f32)))
    a = jax.nn.sigmoid(a0 + ac @ a_up)
    g = jax.nn.sigmoid(gc) @ g_up
    heads = lambda t: t.reshape(B, L, RWKV_HEADS, RWKV_HEAD_DIM).astype(f32)
    kk = heads(k * k_k)
    kk = kk / jnp.maximum(jnp.linalg.norm(kk, axis=-1, keepdims=True), 1e-12)
    k = k * (1 + (a - 1) * k_a)
    rh, kh, vh, ah, wh = heads(r), heads(k), heads(v), heads(a), heads(decay)

    def step(S, inp):
        r_t, w_t, k_t, v_t, kk_t, b_t = inp
        S = (S * w_t[:, :, None, :]
             + jnp.einsum('bhvk,bhk->bhv', S, -kk_t)[..., None] * b_t[:, :, None, :]
             + v_t[..., None] * k_t[:, :, None, :])
        return S, jnp.einsum('bhvk,bhk->bhv', S, r_t)

    xs = tuple(jnp.moveaxis(t, 1, 0) for t in (rh, wh, kh, vh, kk, kk * ah))
    S0 = jnp.zeros((B, RWKV_HEADS, RWKV_HEAD_DIM, RWKV_HEAD_DIM), f32)
    _, y = lax.scan(step, S0, xs)
    y = jnp.moveaxis(y, 0, 1)
    mean = jnp.mean(y, axis=-1, keepdims=True)
    var = jnp.mean(jnp.square(y - mean), axis=-1, keepdims=True)
    y = ((y - mean) * lax.rsqrt(var + RWKV_GN_EPS)).reshape(B, L, RWKV_WIDTH)
    y = y * ln_w.astype(f32) + ln_b.astype(f32)
    bonus = jnp.sum(rh * kh * r_k.reshape(RWKV_HEADS, RWKV_HEAD_DIM).astype(f32), axis=-1, keepdims=True) * vh
    out = (y + bonus.reshape(B, L, RWKV_WIDTH)) * g.astype(f32)
    return out.astype(z.dtype)


def _diff_branch(z, lq1, lk1, lq2, lk2, subln, lambda_init):
    B, L, _ = z.shape
    q, k, v = jnp.split(z, DIFF_CUTS, axis=-1)
    q = q.reshape(B, L, DIFF_HEADS, 2, DIFF_QK_DIM)
    k = k.reshape(B, L, DIFF_HEADS, 2, DIFF_QK_DIM)
    v = v.reshape(B, L, DIFF_HEADS, DIFF_V_DIM)
    lam = (jnp.exp(jnp.sum(lq1.astype(jnp.float32) * lk1.astype(jnp.float32)))
           - jnp.exp(jnp.sum(lq2.astype(jnp.float32) * lk2.astype(jnp.float32))) + lambda_init)
    key_pos = jnp.arange(L)

    def block(i):
        t0 = i * Q_BLOCK
        qb = lax.dynamic_slice_in_dim(q, t0, Q_BLOCK, axis=1)
        qpos = t0 + jnp.arange(Q_BLOCK)
        causal = key_pos[None, :] <= qpos[:, None]
        s = jnp.einsum('bqhmd,bshmd->bhmqs', qb, k).astype(jnp.float32) * (DIFF_QK_DIM ** -0.5)
        s = jnp.where(causal[None, None, None], s, -jnp.inf)
        p = jax.nn.softmax(s, axis=-1)
        attn = (p[:, :, 0] - lam * p[:, :, 1]).astype(v.dtype)
        return jnp.einsum('bhqs,bshd->bqhd', attn, v)

    out = jnp.moveaxis(lax.map(block, jnp.arange(L // Q_BLOCK)), 0, 1).reshape(B, L, DIFF_HEADS, DIFF_V_DIM)
    out = _rms_norm(out, subln) * (1.0 - lambda_init)
    return out.reshape(B, L, DIFF_HEADS * DIFF_V_DIM)


def _mixer(h, w_in, rwkv_params, diff_params, w_branch, w_out, lambda_init):
    B, L, _ = h.shape
    z = h @ w_in
    z_dsa, z_rwkv, z_diff, z_gate = jnp.split(z, GROUP_CUTS, axis=-1)
    y_a = _dsa_branch(z_dsa)
    y_b = _rwkv7_branch(z_rwkv, *rwkv_params)
    y_c = _diff_branch(z_diff, *diff_params, lambda_init)
    branches = jnp.stack([y_a, y_b, y_c], axis=2)
    proj = jnp.einsum('blnc,ncd->blnd', branches, w_branch)
    gates = jax.nn.sigmoid(z_gate.reshape(B, L, N_BRANCH, D_MODEL))
    merged = jnp.sum(gates * proj, axis=2)
    return merged @ w_out


def setup_inputs(seed: int = 0) -> dict:
    key = jax.random.key(seed)
    ks = jax.random.split(key, 32)
    f32 = jnp.float32
    nrm = lambda k, shape, s: jax.random.normal(k, shape, f32) * s
    gain = lambda k, shape: 1.0 + 0.05 * jax.random.normal(k, shape, f32)
    Ld = DEPTH
    return {
        'x': jax.random.normal(ks[0], (BATCH, SEQ, D_MODEL), f32),
        'ffn1_norm_pre': gain(ks[1], (Ld, D_MODEL)),
        'ffn1_norm_post': gain(ks[2], (Ld, D_MODEL)),
        'ffn1_w_gate': nrm(ks[3], (Ld, D_MODEL, D_FF), D_MODEL ** -0.5),
        'ffn1_w_up': nrm(ks[4], (Ld, D_MODEL, D_FF), D_MODEL ** -0.5),
        'ffn1_w_down': nrm(ks[5], (Ld, D_FF, D_MODEL), D_FF ** -0.5),
        'mix_norm_pre': gain(ks[6], (Ld, D_MODEL)),
        'mix_norm_post': gain(ks[7], (Ld, D_MODEL)),
        'w_in': nrm(ks[8], (Ld, D_MODEL, D_IN), D_MODEL ** -0.5),
        'rwkv_mu': jax.random.uniform(ks[9], (Ld, RWKV_STREAM), f32),
        'rwkv_w0': jax.random.uniform(ks[10], (Ld, RWKV_WIDTH), f32, -6.0, -1.0),
        'rwkv_w_up': nrm(ks[11], (Ld, DECAY_LORA, RWKV_WIDTH), 0.1),
        'rwkv_a0': nrm(ks[12], (Ld, RWKV_WIDTH), 0.1),
        'rwkv_a_up': nrm(ks[13], (Ld, AAA_LORA, RWKV_WIDTH), 0.5 * AAA_LORA ** -0.5),
        'rwkv_g_up': nrm(ks[14], (Ld, GATE_LORA, RWKV_WIDTH), GATE_LORA ** -0.5),
        'rwkv_k_k': 0.85 + 0.05 * jax.random.normal(ks[15], (Ld, RWKV_WIDTH), f32),
        'rwkv_k_a': gain(ks[16], (Ld, RWKV_WIDTH)),
        'rwkv_r_k': nrm(ks[17], (Ld, RWKV_WIDTH), 0.1),
        'rwkv_ln_w': gain(ks[18], (Ld, RWKV_WIDTH)),
        'rwkv_ln_b': nrm(ks[19], (Ld, RWKV_WIDTH), 0.01),
        'diff_lambda_q1': nrm(ks[20], (Ld, DIFF_QK_DIM), 0.1),
        'diff_lambda_k1': nrm(ks[21], (Ld, DIFF_QK_DIM), 0.1),
        'diff_lambda_q2': nrm(ks[22], (Ld, DIFF_QK_DIM), 0.1),
        'diff_lambda_k2': nrm(ks[23], (Ld, DIFF_QK_DIM), 0.1),
        'diff_subln': gain(ks[24], (Ld, DIFF_V_DIM)),
        'w_branch': nrm(ks[25], (Ld, N_BRANCH, BRANCH_WIDTH, D_MODEL), BRANCH_WIDTH ** -0.5),
        'w_out': nrm(ks[26], (Ld, D_MODEL, D_MODEL), D_MODEL ** -0.5),
        'ffn2_norm_pre': gain(ks[27], (Ld, D_MODEL)),
        'ffn2_norm_post': gain(ks[28], (Ld, D_MODEL)),
        'ffn2_w_gate': nrm(ks[29], (Ld, D_MODEL, D_FF), D_MODEL ** -0.5),
        'ffn2_w_up': nrm(ks[30], (Ld, D_MODEL, D_FF), D_MODEL ** -0.5),
        'ffn2_w_down': nrm(ks[31], (Ld, D_FF, D_MODEL), D_FF ** -0.5),
    }


def reference(x, ffn1_norm_pre, ffn1_norm_post, ffn1_w_gate, ffn1_w_up, ffn1_w_down,
              mix_norm_pre, mix_norm_post, w_in, rwkv_mu, rwkv_w0, rwkv_w_up, rwkv_a0, rwkv_a_up,
              rwkv_g_up, rwkv_k_k, rwkv_k_a, rwkv_r_k, rwkv_ln_w, rwkv_ln_b,
              diff_lambda_q1, diff_lambda_k1, diff_lambda_q2, diff_lambda_k2, diff_subln,
              w_branch, w_out, ffn2_norm_pre, ffn2_norm_post, ffn2_w_gate, ffn2_w_up, ffn2_w_down):
    for l in range(DEPTH):
        h = _rms_norm(x, ffn1_norm_pre[l])
        x = x + 0.5 * _rms_norm(_swiglu(h, ffn1_w_gate[l], ffn1_w_up[l], ffn1_w_down[l]), ffn1_norm_post[l])
        h = _rms_norm(x, mix_norm_pre[l])
        rwkv_params = (rwkv_mu[l], rwkv_w0[l], rwkv_w_up[l], rwkv_a0[l], rwkv_a_up[l], rwkv_g_up[l],
                       rwkv_k_k[l], rwkv_k_a[l], rwkv_r_k[l], rwkv_ln_w[l], rwkv_ln_b[l])
        diff_params = (diff_lambda_q1[l], diff_lambda_k1[l], diff_lambda_q2[l], diff_lambda_k2[l], diff_subln[l])
        lambda_init = 0.8 - 0.6 * math.exp(-0.3 * l)
        m = _mixer(h, w_in[l], rwkv_params, diff_params, w_branch[l], w_out[l], lambda_init)
        x = x + _rms_norm(m, mix_norm_post[l])
        h = _rms_norm(x, ffn2_norm_pre[l])
        x = x + 0.5 * _rms_norm(_swiglu(h, ffn2_w_gate[l], ffn2_w_up[l], ffn2_w_down[l]), ffn2_norm_post[l])
    return x
```

```cpp
#include <hip/hip_runtime.h>
#include <hip/hip_bf16.h>
#include <cstdio>
#include <cstdint>
#define MK_ONE_LAUNCH 1
#define GATE_RAW 1

__device__ __forceinline__ int otid_() { int t = (int)threadIdx.x; asm volatile("" : "+v"(t)); return t; }
namespace pg8 {
#define PG8_LAS __attribute__((address_space(3)))
typedef unsigned short bf16_t;
typedef short bf16x8 __attribute__((ext_vector_type(8)));
typedef float f32x4 __attribute__((ext_vector_type(4)));
typedef unsigned u32x4 __attribute__((ext_vector_type(4)));
constexpr int BM = 256, BK = 64, HALF = 128, HTB = HALF * BK * 2  , STAGE_BYTES = 8 * HTB, NXCD = 8, WGM = 8;

__host__ __device__ __forceinline__ int lds_byte(int r, int c) { const int st = (r >> 4) * 2 + (c >> 5), rr = r & 15, cc = c & 31, ob = rr * 64 + cc * 2; return st * 1024 + (ob ^ (((ob >> 9) & 1) << 5)); }
__host__ __device__ __forceinline__ void stage_rc(int b, int& R, int& C) { const int st = b / 1024, sb = b % 1024, swz = sb ^ (((sb >> 9) & 1) << 5); R = (st >> 1) * 16 + swz / 64; C = (st & 1) * 32 + (swz % 64) / 2; }
__host__ __device__ __forceinline__ int perm32(int rho) { const int n = rho >> 4, i = rho & 15; return 8 * (i >> 2) + 4 * n + (i & 3); }

struct Unit { int pm, pn; };
struct Gemm { const bf16_t* A; const bf16_t* Bt; int M, N, K, lda; };

struct StaticOrder {
    int nM, nN, nwg, G, c;
    __host__ __device__ void init(int M, int N, int G_, int c_) { nM = M / BM; nN = N / BM; nwg = nM * nN; G = G_; c = c_; }
    __host__ __device__ bool next(int i, Unit& u) const {
        const long L = (long)i * G + c; if (L >= nwg) return false;
        int wgid = (int)L; { const int q = nwg / NXCD, r = nwg % NXCD, xcd = wgid % NXCD, off = wgid / NXCD; wgid = (xcd < r ? xcd * (q + 1) : r * (q + 1) + (xcd - r) * q) + off; }
        const int nig = WGM * nN, gid = wgid / nig, fm = gid * WGM, gsz = (nM - fm) < WGM ? (nM - fm) : WGM;
        u.pm = fm + ((wgid % nig) % gsz); u.pn = (wgid % nig) / gsz; return true;
    }
    __device__ __forceinline__ void a_ready(const Unit&) const {}
    __device__ __forceinline__ void done(const Unit&) const {}
};

__device__ __forceinline__ unsigned cvt_pk_bf16(float lo, float hi) { unsigned r; asm volatile("v_cvt_pk_bf16_f32 %0, %1, %2" : "=v"(r) : "v"(lo), "v"(hi)); return r; }

template <class Epi, class Sched, bool ALIGN_EPI = false, bool SP2 = false>
__device__ __forceinline__ void gemm_phase(PG8_LAS unsigned char* lds, const Gemm g, const Sched& S, const Epi& E) {
    const int tid = otid_(), wid = __builtin_amdgcn_readfirstlane(tid >> 6), lane = tid & 63, wr = wid >> 2, wc = wid & 3, fr = lane & 15, fq = lane >> 4;
    const int K = g.K, nt = K / BK;
    unsigned voffA[2], voffB[2];
#pragma unroll
    for (int i = 0; i < 2; ++i) { int R, C; stage_rc(tid * 16 + i * 8192, R, C); const int Rb = Epi::PERM ? ((R & ~31) + perm32(R & 31)) : R;
        voffA[i] = (unsigned)(R * g.lda + C) * 2u; voffB[i] = (unsigned)(Rb * K + C) * 2u; }
    const size_t kstep = (size_t)(BK * 2);
    const size_t hstepB = (size_t)HALF * K * 2, hstepA = (size_t)HALF * g.lda * 2;
    const size_t tstepB = 2 * hstepB, tstepA = 2 * hstepA;
    const unsigned ldsw = (unsigned)wid * 1024u;
    const int aoff = lds_byte(wr * 64 + fr, fq * 8), boff = lds_byte(wc * 32 + fr, fq * 8);
#define PG8_SA(b, h) (((b) * 2 + (h)) * HTB)
#define PG8_SB(b, h) ((4 + (b) * 2 + (h)) * HTB)
#define PG8_STAGE(bufoff, gbase, voff) do { _Pragma("unroll") for (int _i = 0; _i < 2; ++_i) \
        __builtin_amdgcn_global_load_lds((const unsigned*)((const char*)(gbase) + (voff)[_i]), (PG8_LAS unsigned*)(lds + (bufoff) + ldsw + _i * 8192), 16, 0, 0); } while (0)
#define PG8_LDA(dst, b, h) do { _Pragma("unroll") for (int m = 0; m < 4; ++m) _Pragma("unroll") for (int k = 0; k < 2; ++k) dst[m][k] = *(const PG8_LAS bf16x8*)(lds + PG8_SA(b, h) + aoff + m * 2048 + k * 1024); } while (0)
#define PG8_LDB(dst, b, h) do { _Pragma("unroll") for (int n = 0; n < 2; ++n) _Pragma("unroll") for (int k = 0; k < 2; ++k) dst[n][k] = *(const PG8_LAS bf16x8*)(lds + PG8_SB(b, h) + boff + n * 2048 + k * 1024); } while (0)
#define PG8_MMA(ai, bj, At, Bt) do { __builtin_amdgcn_s_setprio(1); _Pragma("unroll") for (int m = 0; m < 4; ++m) _Pragma("unroll") for (int n = 0; n < 2; ++n) _Pragma("unroll") for (int k = 0; k < 2; ++k) \
        acc[ai][bj][m][n] = __builtin_amdgcn_mfma_f32_16x16x32_bf16(Bt[n][k], At[m][k], acc[ai][bj][m][n], 0, 0, 0); __builtin_amdgcn_s_setprio(0); } while (0)
#define PG8_WAIT_V(n) asm volatile("s_waitcnt vmcnt(" #n ")" ::: "memory")
#define PG8_WAIT_L(n) asm volatile("s_waitcnt lgkmcnt(" #n ")" ::: "memory")
#define PG8_BAR __builtin_amdgcn_s_barrier()
#define PG8_SCHED __builtin_amdgcn_sched_barrier(0)
    Unit cur, nxt; int ui = 0;
    if (!S.next(0, cur)) return;
    f32x4 acc[2][2][4][2];
#pragma unroll
    for (int a = 0; a < 2; ++a)
#pragma unroll
        for (int b = 0; b < 2; ++b)
#pragma unroll
            for (int m = 0; m < 4; ++m)
#pragma unroll
                for (int n = 0; n < 2; ++n) acc[a][b][m][n] = (f32x4){0.f, 0.f, 0.f, 0.f};
    bf16x8 At[4][2], B0[2][2], B1[2][2];
    const char* cA = (const char*)g.A + (size_t)cur.pm * tstepA; const char* cB = (const char*)g.Bt + (size_t)cur.pn * tstepB;
    S.a_ready(cur);
    if constexpr (SP2) {
        PG8_STAGE(PG8_SB(0, 0), cB, voffB); PG8_STAGE(PG8_SB(0, 1), cB + hstepB, voffB); PG8_STAGE(PG8_SA(0, 0), cA, voffA); PG8_STAGE(PG8_SA(0, 1), cA + hstepA, voffA);
        if (wr == 1) PG8_BAR;
        PG8_WAIT_V(2); PG8_BAR;
        PG8_STAGE(PG8_SB(1, 0), cB + kstep, voffB); PG8_STAGE(PG8_SA(1, 0), cA + kstep, voffA); PG8_STAGE(PG8_SB(1, 1), cB + hstepB + kstep, voffB);
        PG8_WAIT_V(6); PG8_BAR;
    } else {
        PG8_STAGE(PG8_SB(0, 0), cB, voffB); PG8_STAGE(PG8_SA(0, 0), cA, voffA); PG8_STAGE(PG8_SB(0, 1), cB + hstepB, voffB); PG8_STAGE(PG8_SA(0, 1), cA + hstepA, voffA);
        if (wr == 1) PG8_BAR;
        PG8_WAIT_V(4); PG8_BAR;
        PG8_STAGE(PG8_SB(1, 0), cB + kstep, voffB); PG8_STAGE(PG8_SA(1, 0), cA + kstep, voffA); PG8_STAGE(PG8_SB(1, 1), cB + hstepB + kstep, voffB);
        PG8_WAIT_V(6); PG8_BAR;
    }
    for (;;) {
        const bool has_next = S.next(ui + 1, nxt);
        const char* nA = has_next ? (const char*)g.A + (size_t)nxt.pm * tstepA : cA; const char* nB = has_next ? (const char*)g.Bt + (size_t)nxt.pn * tstepB : cB;
        for (int t = 0; t < nt; t += 2) {
            const bool last = (t == nt - 2);
            const char* a1 = cA + (size_t)(t + 1) * kstep;
            const char* a2 = last ? nA : cA + (size_t)(t + 2) * kstep; const char* b2 = last ? nB : cB + (size_t)(t + 2) * kstep;
            const char* a3 = a2 + kstep; const char* b3 = b2 + kstep;
            if (last && has_next) S.a_ready(nxt);
            if constexpr (SP2) {
            PG8_LDB(B0, 0, 0); PG8_LDB(B1, 0, 1); PG8_SCHED; PG8_LDA(At, 0, 0); PG8_STAGE(PG8_SA(1, 1), a1 + hstepA, voffA);
            PG8_WAIT_V(8); PG8_WAIT_L(0); PG8_BAR; PG8_MMA(0, 0, At, B0); PG8_MMA(0, 1, At, B1); PG8_BAR; PG8_SCHED;
            PG8_LDA(At, 0, 1); PG8_STAGE(PG8_SB(0, 0), b2, voffB); PG8_STAGE(PG8_SB(0, 1), b2 + hstepB, voffB); PG8_STAGE(PG8_SA(0, 0), a2, voffA);
            PG8_WAIT_V(8); PG8_WAIT_L(0); PG8_BAR; PG8_MMA(1, 0, At, B0); PG8_MMA(1, 1, At, B1); PG8_BAR; PG8_SCHED;
            PG8_LDB(B0, 1, 0); PG8_LDB(B1, 1, 1); PG8_SCHED; PG8_LDA(At, 1, 0); PG8_STAGE(PG8_SA(0, 1), a2 + hstepA, voffA);
            PG8_WAIT_V(8); PG8_WAIT_L(0); PG8_BAR; PG8_MMA(0, 0, At, B0); PG8_MMA(0, 1, At, B1); PG8_BAR; PG8_SCHED;
            PG8_LDA(At, 1, 1); PG8_STAGE(PG8_SB(1, 0), b3, voffB); PG8_STAGE(PG8_SB(1, 1), b3 + hstepB, voffB); PG8_STAGE(PG8_SA(1, 0), a3, voffA);
            PG8_WAIT_V(8); PG8_WAIT_L(0); PG8_BAR; PG8_MMA(1, 0, At, B0); PG8_MMA(1, 1, At, B1); PG8_BAR; PG8_SCHED;
            } else {
            PG8_LDB(B0, 0, 0); PG8_SCHED; PG8_LDA(At, 0, 0); PG8_STAGE(PG8_SA(1, 1), a1 + hstepA, voffA);
            PG8_WAIT_L(8); PG8_BAR; PG8_WAIT_L(0); PG8_MMA(0, 0, At, B0); PG8_BAR; PG8_SCHED;
            PG8_LDB(B1, 0, 1); PG8_STAGE(PG8_SB(0, 0), b2, voffB);
            PG8_BAR; PG8_WAIT_L(0); PG8_MMA(0, 1, At, B1); PG8_BAR;
            PG8_LDA(At, 0, 1); PG8_STAGE(PG8_SA(0, 0), a2, voffA);
            PG8_BAR; PG8_WAIT_L(0); PG8_MMA(1, 0, At, B0); PG8_BAR; PG8_SCHED;
            PG8_STAGE(PG8_SB(0, 1), b2 + hstepB, voffB);
            PG8_WAIT_V(6); PG8_BAR; PG8_MMA(1, 1, At, B1); PG8_BAR;
            PG8_LDB(B0, 1, 0); PG8_SCHED; PG8_LDA(At, 1, 0); PG8_STAGE(PG8_SA(0, 1), a2 + hstepA, voffA);
            PG8_WAIT_L(8); PG8_BAR; PG8_WAIT_L(0); PG8_MMA(0, 0, At, B0); PG8_BAR; PG8_SCHED;
            PG8_LDB(B1, 1, 1); PG8_STAGE(PG8_SB(1, 0), b3, voffB);
            PG8_BAR; PG8_WAIT_L(0); PG8_MMA(0, 1, At, B1); PG8_BAR;
            PG8_LDA(At, 1, 1); PG8_STAGE(PG8_SA(1, 0), a3, voffA);
            PG8_BAR; PG8_WAIT_L(0); PG8_MMA(1, 0, At, B0); PG8_BAR; PG8_SCHED;
            PG8_STAGE(PG8_SB(1, 1), b3 + hstepB, voffB);
            PG8_WAIT_V(6); PG8_BAR; PG8_MMA(1, 1, At, B1); PG8_BAR;
            }
        }
        if constexpr (ALIGN_EPI) { if (wr == 0) PG8_BAR; }
        if constexpr (!Epi::AFTER_DRAIN) { E(acc, cur, wr, wc, fr, fq); S.done(cur); }
        if (!has_next) break;
#pragma unroll
        for (int a = 0; a < 2; ++a)
#pragma unroll
            for (int b = 0; b < 2; ++b)
#pragma unroll
                for (int m = 0; m < 4; ++m)
#pragma unroll
                    for (int n = 0; n < 2; ++n) acc[a][b][m][n] = (f32x4){0.f, 0.f, 0.f, 0.f};
        cur = nxt; cA = nA; cB = nB; ++ui;
        if constexpr (ALIGN_EPI) { if (wr == 1) PG8_BAR; }
    }
    PG8_WAIT_V(0);
    if constexpr (!ALIGN_EPI) { if (wr == 0) PG8_BAR; }
    PG8_BAR;
    if constexpr (Epi::AFTER_DRAIN) { E.fused(acc, cur, wr, wc, fr, fq, lds, wid, lane); S.done(cur); }
#undef PG8_SA
#undef PG8_SB
#undef PG8_STAGE
#undef PG8_LDA
#undef PG8_LDB
#undef PG8_MMA
#undef PG8_WAIT_V
#undef PG8_WAIT_L
#undef PG8_BAR
#undef PG8_SCHED
}
}
namespace pg8 {
typedef unsigned u32x2 __attribute__((ext_vector_type(2)));
__device__ __forceinline__ float bf_lo(unsigned w) { return __uint_as_float(w << 16); }
__device__ __forceinline__ float bf_hi(unsigned w) { return __uint_as_float(w & 0xffff0000u); }
__device__ __forceinline__ float sigmoidf_(float x) { return __builtin_amdgcn_rcpf(1.0f + __expf(-x)); }

struct EpiSwiGLU {
    static constexpr bool PERM = false, AFTER_DRAIN = false;
    bf16_t* H; int ldh;
    __device__ __forceinline__ void operator()(const f32x4 (&acc)[2][2][4][2], const Unit& u, int wr, int wc, int fr, int fq) const {
        const int row0 = u.pm * BM + wr * 64 + fr, hc0 = u.pn * 128 + wc * 16 + 4 * fq;
#pragma unroll
        for (int ai = 0; ai < 2; ++ai)
#pragma unroll
            for (int m = 0; m < 4; ++m) { bf16_t* rowp = H + (size_t)(row0 + ai * HALF + m * 16) * ldh + hc0;
#pragma unroll
                for (int bj = 0; bj < 2; ++bj) { const f32x4 g = acc[ai][bj][m][0], up = acc[ai][bj][m][1]; float h[4];
#pragma unroll
                    for (int e = 0; e < 4; ++e) h[e] = g[e] * sigmoidf_(g[e]) * up[e];
                    u32x2 w; w.x = cvt_pk_bf16(h[0], h[1]); w.y = cvt_pk_bf16(h[2], h[3]);
                    *(u32x2*)(rowp + bj * 64) = w; } }
    }
};
template <int ACT> struct EpiStore {
    static constexpr bool PERM = true, AFTER_DRAIN = false;
    bf16_t* O0; int ld0; bf16_t* O1; int ld1; int split_tiles;
    __device__ __forceinline__ void operator()(const f32x4 (&acc)[2][2][4][2], const Unit& u, int wr, int wc, int fr, int fq) const {
        const int row0 = u.pm * BM + wr * 64 + fr;
        bf16_t* base; int ld, colt;
        if (u.pn < split_tiles) { base = O0; ld = ld0; colt = u.pn * BM; } else { base = O1; ld = ld1; colt = (u.pn - split_tiles) * BM; }
        const int col0 = colt + wc * 32 + 8 * fq;
#pragma unroll
        for (int ai = 0; ai < 2; ++ai)
#pragma unroll
            for (int m = 0; m < 4; ++m) { bf16_t* rowp = base + (size_t)(row0 + ai * HALF + m * 16) * ld + col0;
#pragma unroll
                for (int bj = 0; bj < 2; ++bj) { f32x4 v0 = acc[ai][bj][m][0], v1 = acc[ai][bj][m][1];
                    if (ACT == 1) {
#pragma unroll
                        for (int e = 0; e < 4; ++e) { v0[e] = sigmoidf_(v0[e]); v1[e] = sigmoidf_(v1[e]); } }
                    u32x4 w; w.x = cvt_pk_bf16(v0[0], v0[1]); w.y = cvt_pk_bf16(v0[2], v0[3]); w.z = cvt_pk_bf16(v1[0], v1[1]); w.w = cvt_pk_bf16(v1[2], v1[3]);
                    *(u32x4*)(rowp + bj * HALF) = w; } }
    }
};
#ifdef GATE_RAW
#define GSIG(x) sigmoidf_(x)
#else
#define GSIG(x) (x)
#endif
struct EpiGateMul {
    static constexpr bool PERM = true, AFTER_DRAIN = false;
    bf16_t* MG; int ldm; const bf16_t* G; int ldg; int first;
    __device__ __forceinline__ void operator()(const f32x4 (&acc)[2][2][4][2], const Unit& u, int wr, int wc, int fr, int fq) const {
        const int row0 = u.pm * BM + wr * 64 + fr, col0 = u.pn * BM + wc * 32 + 8 * fq;
#pragma unroll
        for (int ai = 0; ai < 2; ++ai)
#pragma unroll
            for (int m = 0; m < 4; ++m) { const size_t r = (size_t)(row0 + ai * HALF + m * 16);
#pragma unroll
                for (int bj = 0; bj < 2; ++bj) { const f32x4 v0 = acc[ai][bj][m][0], v1 = acc[ai][bj][m][1];
                    const u32x4 g = *(const u32x4*)(G + r * ldg + col0 + bj * HALF);
                    float o[8] = { v0[0] * GSIG(bf_lo(g.x)), v0[1] * GSIG(bf_hi(g.x)), v0[2] * GSIG(bf_lo(g.y)), v0[3] * GSIG(bf_hi(g.y)), v1[0] * GSIG(bf_lo(g.z)), v1[1] * GSIG(bf_hi(g.z)), v1[2] * GSIG(bf_lo(g.w)), v1[3] * GSIG(bf_hi(g.w)) };
                    bf16_t* mp = MG + r * ldm + col0 + bj * HALF;
                    if (!first) { const u32x4 p = *(const u32x4*)mp;
                        o[0] += bf_lo(p.x); o[1] += bf_hi(p.x); o[2] += bf_lo(p.y); o[3] += bf_hi(p.y); o[4] += bf_lo(p.z); o[5] += bf_hi(p.z); o[6] += bf_lo(p.w); o[7] += bf_hi(p.w); }
                    u32x4 w; w.x = cvt_pk_bf16(o[0], o[1]); w.y = cvt_pk_bf16(o[2], o[3]); w.z = cvt_pk_bf16(o[4], o[5]); w.w = cvt_pk_bf16(o[6], o[7]);
                    *(u32x4*)mp = w; } }
    }
};
}
namespace att {
constexpr int D = 128;
constexpr bool WSKIP = false;
constexpr float THR = 8.f;
constexpr int NW = 8, QBLK = 32, KVBLK = 64, QB = NW * QBLK;
constexpr int SHM_V = KVBLK * D * 2, SHM_K = KVBLK * D * 2;
constexpr int LDS_BYTES = 2 * SHM_V + 2 * SHM_K + NW * 64 * 4;
using bf16 = __hip_bfloat16;
typedef short bf16x8 __attribute__((ext_vector_type(8)));
typedef short s16x4 __attribute__((ext_vector_type(4)));
typedef float f32x16 __attribute__((ext_vector_type(16)));
typedef float f32x4 __attribute__((ext_vector_type(4)));
typedef unsigned u32x4 __attribute__((ext_vector_type(4)));
template <class A, class Bt> struct same_t { static constexpr bool v = false; };
template <class A> struct same_t<A, A> { static constexpr bool v = true; };

#define KSWZ(row, colB) ((row) * 256 + ((colB) ^ (((row) & 7) << 4)))
#define SBAR() __builtin_amdgcn_sched_barrier(0)
__device__ __forceinline__ int v_st(int k, int c) { const int kk = (k & ~0xC) | ((k & 4) << 1) | ((k & 8) >> 1); return ((kk >> 3) * 4 + (c >> 5)) * 512 + ((kk & 7) * 32 + (c & 31)) * 2; }
__device__ __forceinline__ int v_rd_base(int lane) { return ((lane & 3) << 3) | (((lane >> 2) & 3) << 6) | (((lane >> 4) & 1) << 5) | (((lane >> 5) & 1) << 8); }
constexpr int v_rd_off(int d0, int ks, int half) { return d0 * 512 + ks * 4096 + half * 2048; }
__device__ __forceinline__ int crow(int r, int hi) { return (r & 3) + 8 * (r >> 2) + 4 * hi; }
__device__ __forceinline__ unsigned cvtpk(float lo, float hi) {
    unsigned r; asm volatile("v_cvt_pk_bf16_f32 %0, %1, %2" : "=v"(r) : "v"(lo), "v"(hi)); return r;
}
__device__ __forceinline__ bf16x8 pack8(f32x4 a, f32x4 b) {
    u32x4 w = {cvtpk(a[0], a[1]), cvtpk(a[2], a[3]), cvtpk(b[0], b[1]), cvtpk(b[2], b[3])};
    return *reinterpret_cast<bf16x8*>(&w);
}
template <class T> __device__ __forceinline__ bf16x8 load8(const T* p) {
    if constexpr (same_t<T, float>::v) { return pack8(*(const f32x4*)p, *(const f32x4*)(p + 4)); }
    else { return *reinterpret_cast<const bf16x8*>(p); }
}
__device__ __forceinline__ void mask_tile(f32x16& p0, f32x16& p1, int dq, unsigned W) {
    const float NEG = -__builtin_inff();
#pragma unroll
    for (int r = 0; r < 16; ++r) {
        const int c = (r & 3) + 8 * (r >> 2);
        if ((unsigned)(dq - c) >= W) p0[r] = NEG;
        if ((unsigned)(dq - c - 32) >= W) p1[r] = NEG;
    }
}
typedef unsigned u32x2 __attribute__((ext_vector_type(2)));
__device__ __forceinline__ void bitmask_tile(f32x16& p0, f32x16& p1, u32x2 w, int hi) {
    const float NEG = -__builtin_inff();
    const unsigned a = w[0] >> (4 * hi), b = w[1] >> (4 * hi);
#pragma unroll
    for (int r = 0; r < 16; ++r) {
        const int c = (r & 3) + 8 * (r >> 2);
        if (!((a >> c) & 1u)) p0[r] = NEG;
        if (!((b >> c) & 1u)) p1[r] = NEG;
    }
}
template <bool HALFQK> __device__ __forceinline__ void partialSM(f32x16& p0, f32x16& p1, float& m_reg, float& mn, float& alpha) {
    constexpr float SCALE = HALFQK ? 0.125f : 0.08838834764831845f;
    float pmax = p0[0]; for (int r = 1; r < 16; ++r) pmax = fmaxf(pmax, p0[r]); for (int r = 0; r < 16; ++r) pmax = fmaxf(pmax, p1[r]);
    { auto rr = __builtin_amdgcn_permlane32_swap(__float_as_uint(pmax), __float_as_uint(pmax), false, false);
      pmax = fmaxf(__uint_as_float(rr[0]), __uint_as_float(rr[1])); }
    constexpr float C2 = 1.4426950408889634f * SCALE;
    if (__builtin_expect(__all((pmax - m_reg) * SCALE <= THR), 1)) { mn = m_reg; alpha = 1.f; }
    else { mn = fmaxf(m_reg, pmax); alpha = __builtin_amdgcn_exp2f((m_reg - mn) * C2); m_reg = mn; }
    const float mnL = -mn * C2;
    for (int r = 0; r < 16; ++r) p0[r] = fmaf(p0[r], C2, mnL); for (int r = 0; r < 16; ++r) p1[r] = fmaf(p1[r], C2, mnL);
    for (int r = 0; r < 16; ++r) p0[r] = __builtin_amdgcn_exp2f(p0[r]);
}
__device__ __forceinline__ void finishSM(f32x16& p0, f32x16& p1, float alpha, float& l_reg, bf16x8& pa0, bf16x8& pa1, bf16x8& pa2, bf16x8& pa3) {
    for (int r = 0; r < 16; ++r) p1[r] = __builtin_amdgcn_exp2f(p1[r]);
    float ps = 0; for (int r = 0; r < 16; ++r) ps += p0[r]; for (int r = 0; r < 16; ++r) ps += p1[r];
    { auto rr = __builtin_amdgcn_permlane32_swap(__float_as_uint(ps), __float_as_uint(ps), false, false);
      ps = __uint_as_float(rr[0]) + __uint_as_float(rr[1]); }
    l_reg = l_reg * alpha + ps;
#define PK4(P, B_, OUT) do { unsigned a0 = cvtpk(P[B_+0], P[B_+1]), a1 = cvtpk(P[B_+2], P[B_+3]);                          \
        unsigned b0 = cvtpk(P[B_+4], P[B_+5]), b1 = cvtpk(P[B_+6], P[B_+7]);                                             \
        auto r0 = __builtin_amdgcn_permlane32_swap(a0, b0, false, false); auto r1 = __builtin_amdgcn_permlane32_swap(a1, b1, false, false); \
        u32x4 w = {r0[0], r1[0], r0[1], r1[1]}; OUT = *reinterpret_cast<bf16x8*>(&w); } while (0)
    PK4(p0, 0, pa0); PK4(p0, 8, pa1); PK4(p1, 0, pa2); PK4(p1, 8, pa3);
#undef PK4
}
template <int KB, bool SK, bool HALFQK>
__device__ __forceinline__ void qkt(f32x16& p0, f32x16& p1, const char* K_lds, int r32, int hi, const bf16x8* qr, bool act, int koff) {
    if (SK && !act) { const float NEG = -__builtin_inff();
#pragma unroll
        for (int r = 0; r < 16; ++r) { p0[r] = NEG; p1[r] = NEG; } return; }
    p0 = f32x16{}; p1 = f32x16{};
    const char* kb[4];
#pragma unroll
    for (int dd = 0; dd < 4; ++dd) kb[dd] = K_lds + KB * SHM_K + KSWZ(r32, (dd * 16 + hi * 8) * 2) + koff;
#pragma unroll
    for (int d0 = 0; d0 < (HALFQK ? 4 : 8); ++d0) { const char* a = kb[d0 & 3] + (d0 >> 2) * 128;
        bf16x8 b0 = *reinterpret_cast<const bf16x8*>(a);
        bf16x8 b1 = *reinterpret_cast<const bf16x8*>(a + 32 * 256);
        p0 = __builtin_amdgcn_mfma_f32_32x32x16_bf16(b0, qr[d0], p0, 0, 0, 0);
        p1 = __builtin_amdgcn_mfma_f32_32x32x16_bf16(b1, qr[d0], p1, 0, 0, 0); }
}
template <int VB, bool SK>
__device__ __forceinline__ void pv_tile(f32x16* o, int vb0, bf16x8 pa0, bf16x8 pa1, bf16x8 pa2, bf16x8 pa3, bool act) {
    if (SK && !act) return;
#define TRRD(dst, off) asm volatile("ds_read_b64_tr_b16 %0, %1 offset:%2" : "=&v"(dst) : "v"(vb0), "i"(off) : "memory")
#define PV_D0(d0) do { s16x4 l0, l1, l2, l3, h0, h1, h2, h3; constexpr int b_ = VB * SHM_V + v_rd_off(d0, 0, 0);     \
        TRRD(l0, b_); TRRD(h0, b_ + 2048); TRRD(l1, b_ + 4096); TRRD(h1, b_ + 6144); TRRD(l2, b_ + 8192); TRRD(h2, b_ + 10240); TRRD(l3, b_ + 12288); TRRD(h3, b_ + 14336); \
        asm volatile("s_waitcnt lgkmcnt(0)" ::: "memory"); SBAR();                 \
        o[d0] = __builtin_amdgcn_mfma_f32_32x32x16_bf16(pa0, (bf16x8){l0[0], l0[1], l0[2], l0[3], h0[0], h0[1], h0[2], h0[3]}, o[d0], 0, 0, 0);   \
        o[d0] = __builtin_amdgcn_mfma_f32_32x32x16_bf16(pa1, (bf16x8){l1[0], l1[1], l1[2], l1[3], h1[0], h1[1], h1[2], h1[3]}, o[d0], 0, 0, 0);   \
        o[d0] = __builtin_amdgcn_mfma_f32_32x32x16_bf16(pa2, (bf16x8){l2[0], l2[1], l2[2], l2[3], h2[0], h2[1], h2[2], h2[3]}, o[d0], 0, 0, 0);   \
        o[d0] = __builtin_amdgcn_mfma_f32_32x32x16_bf16(pa3, (bf16x8){l3[0], l3[1], l3[2], l3[3], h3[0], h3[1], h3[2], h3[3]}, o[d0], 0, 0, 0); } while (0)
    PV_D0(0); PV_D0(1); PV_D0(2); PV_D0(3);
#undef PV_D0
#undef TRRD
}

constexpr int QS = 1536, KVS = 4096;
template <class TIn, class TOut> struct BlockRef { const TIn* Q; const TIn* K; const TIn* V; TOut* O; int P0; int koff; const unsigned* mask; };
template <class TIn> struct Seam {
    bf16x8 qr[8];
    bf16x8 st_v0, st_v1, st_k0, st_k1; f32x4 sf0, sf1, sf2, sf3;
    f32x4 tq[16];
};
__device__ __forceinline__ int swa_jlo(int P0, int W) { const int lowk = P0 - W + 1; return lowk > 0 ? lowk / KVBLK : 0; }
#define ROW(p, k0, rr) ((p) + (size_t)((k0) + (rr)) * KVS + sc)
#define VMW() asm volatile("s_waitcnt vmcnt(0)" ::: "memory")
#define VMWN(n) asm volatile("s_waitcnt vmcnt(%0)" :: "i"(n) : "memory")
#define SLOAD_H(Kp, Vp, k0) do { S.st_v0 = load8<TIn>(ROW(Vp, k0, sr)); S.st_v1 = load8<TIn>(ROW(Vp, k0, 32 + sr));              \
                         S.st_k0 = load8<TIn>(ROW(Kp, k0, sr)); S.st_k1 = load8<TIn>(ROW(Kp, k0, 32 + sr)); } while (0)
#define SWRITE_HK(bf) do { *(bf16x8*)(K_lds + (bf) * SHM_K + kws) = S.st_k0; *(bf16x8*)(K_lds + (bf) * SHM_K + kws + 32 * 256) = S.st_k1; } while (0)
#define SWRITE_HV(bf) do { *(bf16x8*)(V_lds + (bf) * SHM_V + vst0) = S.st_v0; *(bf16x8*)(V_lds + (bf) * SHM_V + vst1) = S.st_v1; } while (0)
#define SWRITE_H(bf) do { SWRITE_HV(bf); SWRITE_HK(bf); } while (0)
#define SLOAD_F(p, k0) do { S.sf0 = *(const f32x4*)ROW(p, k0, sr); S.sf1 = *(const f32x4*)(ROW(p, k0, sr) + 4);                \
                            S.sf2 = *(const f32x4*)ROW(p, k0, 32 + sr); S.sf3 = *(const f32x4*)(ROW(p, k0, 32 + sr) + 4); } while (0)
#define SWRITE_KF(bf) do { *(bf16x8*)(K_lds + (bf) * SHM_K + kws) = pack8(S.sf0, S.sf1); *(bf16x8*)(K_lds + (bf) * SHM_K + kws + 32 * 256) = pack8(S.sf2, S.sf3); } while (0)
#define SWRITE_VF(bf) do { *(bf16x8*)(V_lds + (bf) * SHM_V + vst0) = pack8(S.sf0, S.sf1); *(bf16x8*)(V_lds + (bf) * SHM_V + vst1) = pack8(S.sf2, S.sf3); } while (0)
template <class TIn, class TOut, bool HALFQK>
__device__ __forceinline__ void causal_swa_prime(const BlockRef<TIn, TOut>& cur, int W, char* lds, Seam<TIn>& S) {
    constexpr bool F32 = same_t<TIn, float>::v;
    const int tid = otid_(), wid = __builtin_amdgcn_readfirstlane(tid >> 6), lane = tid & 63, r32 = lane & 31, hi = lane >> 5;
    const int sr = tid >> 4, sc = (tid & 15) * 8, kws = KSWZ(sr, sc * 2); char* K_lds = lds + 2 * SHM_V;
    const int kb0 = swa_jlo(cur.P0, W) * KVBLK;
    for (int d0 = 0; d0 < (HALFQK ? 4 : 8); ++d0) S.qr[d0] = load8<TIn>(cur.Q + (size_t)(wid * QBLK + r32) * QS + d0 * 16 + hi * 8);
    if constexpr (F32) { SLOAD_F((const float*)cur.K, kb0); VMW(); SWRITE_KF(0); SBAR(); SLOAD_F((const float*)cur.V, kb0); }
    else { SLOAD_H(cur.K, cur.V, kb0); VMW(); SWRITE_HK(0); }
    __syncthreads();
}
template <class TIn, class TOut, bool HALFQK, bool MASKED, int OS>
__device__ __forceinline__ void causal_swa_block(const BlockRef<TIn, TOut>& cur, const BlockRef<TIn, TOut>& nxt, int skv, int W, char* lds, Seam<TIn>& S) {
    constexpr bool F32 = same_t<TIn, float>::v;
    const int tid = otid_(), wid = __builtin_amdgcn_readfirstlane(tid >> 6), lane = tid & 63, r32 = lane & 31, hi = lane >> 5;
    const int j_lo = swa_jlo(cur.P0, W);
    int j_hi = (cur.P0 + QB - 1) / KVBLK + 1; if (j_hi > skv / KVBLK) j_hi = skv / KVBLK;
    const int NT = j_hi - j_lo;
    const int kbn = swa_jlo(nxt.P0, W) * KVBLK;
    const int qlo = cur.P0 + wid * QBLK, qm = qlo + r32 - 4 * hi;
    char* V_lds = lds; char* K_lds = lds + 2 * SHM_V;
    float* ws = (float*)(lds + 2 * SHM_V + 2 * SHM_K) + wid * 64; float* li_l = ws, * al_l = ws + 32;
    float m_reg = -1e30f, l_reg = 0; f32x16 o[4] = {};
    const int sr = tid >> 4, sc = (tid & 15) * 8, vst0 = v_st(sr, sc), vst1 = v_st(32 + sr, sc), kws = KSWZ(sr, sc * 2);
    const int vb0 = (int)(uintptr_t)V_lds + v_rd_base(lane);
    const TIn* Kh = cur.K; const TIn* Vh = cur.V;
#define RESC(a) do { if (__any((a) < 1.f)) { if (hi == 0) al_l[r32] = (a); asm volatile("s_waitcnt lgkmcnt(0)" ::: "memory");              \
                     for (int d_ = 0; d_ < 4; ++d_) for (int r = 0; r < 16; ++r) o[d_][r] *= al_l[crow(r, hi)]; } } while (0)
#define KBASE(t) ((j_lo + (t)) * KVBLK)
#define ACT(t) (KBASE(t) <= qlo + QBLK - 1 && KBASE(t) + KVBLK - 1 >= qlo - W + 1)
#define MASKT(P0_, P1_, t) do { if constexpr (MASKED) bitmask_tile(P0_, P1_, mw, hi);   \
        else { const int kb_ = KBASE(t); if ((!SK || ACT(t)) && (kb_ + KVBLK - 1 > qlo || kb_ <= qlo + QBLK - 1 - W)) mask_tile(P0_, P1_, qm - kb_, (unsigned)W); } } while (0)
    const unsigned moff = (unsigned)((wid * QBLK + r32) * 1024 + 8 * j_lo); u32x2 mw = {0u, 0u};
#define MLOAD(t) do { if constexpr (MASKED) mw = *(const u32x2*)((const char*)cur.mask + (moff + 8u * (unsigned)(t))); } while (0)
    constexpr int NQL = F32 ? 16 : (HALFQK ? 4 : 8);
    constexpr bool SK = WSKIP && !F32;
#define SEAM_K0() do { VMWN(NQL); if constexpr (F32) { SWRITE_KF(0); SBAR(); SLOAD_F((const float*)nxt.V, kbn); } else { SWRITE_HK(0); } SBAR(); } while (0)
    f32x16 pA0, pA1, pB0, pB1; float mnA, mnB, alA, alB; bf16x8 pa0, pa1, pa2, pa3;
    if constexpr (F32) { VMW(); SWRITE_VF(0); SBAR(); } else { SWRITE_HV(0); SBAR(); }
    if (NT > 1) { if constexpr (F32) SLOAD_F((const float*)Kh, KBASE(1)); else SLOAD_H(Kh, Vh, KBASE(1)); }
    SBAR(); qkt<0, SK, HALFQK>(pA0, pA1, K_lds, r32, hi, S.qr, ACT(0), cur.koff); MLOAD(0);
    if constexpr (F32) { if (NT > 1) { VMW(); SWRITE_KF(1); SBAR(); SLOAD_F((const float*)Vh, KBASE(1)); } }
    MASKT(pA0, pA1, 0); partialSM<HALFQK>(pA0, pA1, m_reg, mnA, alA);
    if (NT > 1) { VMW(); if constexpr (F32) { SWRITE_VF(1); SBAR(); if (NT > 2) SLOAD_F((const float*)Kh, KBASE(2)); } else SWRITE_H(1); }
    __syncthreads();
#define HALF_STEP(PX0, PX1, mnX, alX, PY0, PY1, alY, t, KB, VB, SB) do {                                                      \
        SBAR(); qkt<KB, SK, HALFQK>(PX0, PX1, K_lds, r32, hi, S.qr, ACT(t), cur.koff); MLOAD(t);                                             \
        finishSM(PY0, PY1, alY, l_reg, pa0, pa1, pa2, pa3); SBAR();                                                           \
        if ((t) + 1 < NT) { if constexpr (F32) { VMW(); SWRITE_KF(SB); SBAR(); SLOAD_F((const float*)Vh, KBASE((t) + 1)); }  \
                            else { SLOAD_H(Kh, Vh, KBASE((t) + 1)); } SBAR(); }                                               \
        pv_tile<VB, SK>(o, vb0, pa0, pa1, pa2, pa3, ACT((t) - 1)); MASKT(PX0, PX1, (t)); partialSM<HALFQK>(PX0, PX1, m_reg, mnX, alX);                                        \
        __syncthreads();                                                                                                      \
        if ((t) + 1 < NT) { VMW(); if constexpr (F32) { SWRITE_VF(SB); SBAR(); if ((t) + 2 < NT) SLOAD_F((const float*)Kh, KBASE((t) + 2)); } \
                            else { SWRITE_H(SB); } }                                                                          \
        RESC(alX); __syncthreads(); } while (0)
    for (int t = 1; t + 1 < NT; t += 2) {
        HALF_STEP(pB0, pB1, mnB, alB, pA0, pA1, alA, t, 1, 0, 0);
        HALF_STEP(pA0, pA1, mnA, alA, pB0, pB1, alB, t + 1, 0, 1, 1);
    }
    const bool even = (NT & 1) == 0;
    if (even) { SBAR(); qkt<1, SK, HALFQK>(pB0, pB1, K_lds, r32, hi, S.qr, ACT(NT - 1), cur.koff); MLOAD(NT - 1); SBAR(); }
#define QROW(e) (nxt.Q + (size_t)(wid * QBLK + r32) * QS + ((e) >> 1) * 16 + hi * 8 + ((e) & 1) * 4)
    if constexpr (F32) { SLOAD_F((const float*)nxt.K, kbn); SBAR();
#pragma unroll
        for (int e = 0; e < 8; ++e) S.tq[e] = *(const f32x4*)QROW(e); }
    else { SLOAD_H(nxt.K, nxt.V, kbn); SBAR();
#pragma unroll
        for (int d0 = 0; d0 < (HALFQK ? 4 : 8); ++d0) S.qr[d0] = load8<TIn>(nxt.Q + (size_t)(wid * QBLK + r32) * QS + d0 * 16 + hi * 8); }
    SBAR();
    finishSM(pA0, pA1, alA, l_reg, pa0, pa1, pa2, pa3); SBAR();
    if constexpr (F32) {
#pragma unroll
        for (int e = 8; e < 16; ++e) S.tq[e] = *(const f32x4*)QROW(e); SBAR(); }
#undef QROW
    pv_tile<0, SK>(o, vb0, pa0, pa1, pa2, pa3, ACT(even ? NT - 2 : NT - 1));
    if (even) { MASKT(pB0, pB1, NT - 1); partialSM<HALFQK>(pB0, pB1, m_reg, mnB, alB); __syncthreads(); RESC(alB);
        finishSM(pB0, pB1, alB, l_reg, pa0, pa1, pa2, pa3); SBAR(); pv_tile<1, SK>(o, vb0, pa0, pa1, pa2, pa3, ACT(NT - 1)); }
    SBAR(); SEAM_K0();
    if (hi == 0) li_l[r32] = l_reg; asm volatile("s_waitcnt lgkmcnt(0)" ::: "memory");
    float rli[16];
#pragma unroll
    for (int r = 0; r < 16; ++r) rli[r] = __builtin_amdgcn_rcpf(li_l[crow(r, hi)]);
    TOut* Ow = cur.O + (size_t)(wid * QBLK) * OS;
#pragma unroll
    for (int r = 0; r < 16; ++r) { const int orow = crow(r, hi);
#pragma unroll
        for (int d0 = 0; d0 < 4; ++d0) { const float v = o[d0][r] * rli[r];
            if constexpr (same_t<TOut, float>::v) { Ow[(size_t)orow * OS + d0 * 32 + r32] = v; }
            else { const float vn = __shfl_xor(v, 1);
                   if ((r32 & 1) == 0) *(unsigned*)(Ow + (size_t)orow * OS + d0 * 32 + r32) = cvtpk(v, vn); } } }
    if constexpr (F32) {
#pragma unroll
        for (int d0 = 0; d0 < 8; ++d0) S.qr[d0] = pack8(S.tq[2 * d0], S.tq[2 * d0 + 1]); }
    __syncthreads();
#undef RESC
#undef KBASE
#undef ACT
#undef MASKT
#undef MLOAD
#undef SEAM_K0
#undef HALF_STEP
}
#undef ROW
#undef VMW
#undef VMWN
#undef SLOAD_H
#undef SWRITE_HK
#undef SWRITE_HV
#undef SWRITE_H
#undef SLOAD_F
#undef SWRITE_KF
#undef SWRITE_VF
}
#ifndef PROBE
#define PROBE 0
#endif
constexpr int NWAVES = 8;
constexpr int NB = 2, T = 8192, M = NB * T, DM = 1024, FF = 2816, NIN = 8520, NLAYER = 2;
constexpr float NORM_EPS = 1e-6f;
constexpr size_t MiB = 1u << 20;
constexpr size_t WS_CTL = 0, CTL_ZERO_BYTES = 1 * MiB;
constexpr size_t WS_WF = 1 * MiB;
constexpr size_t WS_WF_DOWN = WS_WF + 11 * MiB;
constexpr size_t WS_WM = 18 * MiB;
constexpr size_t WS_WM_BR = WS_WM + 17 * MiB, WS_WM_OUT = WS_WM + 20 * MiB;
constexpr size_t WS_XN = 40 * MiB;
constexpr size_t WS_Q3 = 72 * MiB;
constexpr size_t WS_ZR = 120 * MiB;
constexpr size_t WS_R2 = 248 * MiB;
constexpr size_t WS_END = 280 * MiB;
constexpr size_t WS_MG = WS_ZR + 96 * MiB;
constexpr size_t WS_YRAW = WS_WF;
constexpr size_t WS_X1 = WS_XN + 16 * MiB;
constexpr size_t WS_A8 = WS_WM;
constexpr size_t WS_KID = WS_WM + 8 * MiB;
constexpr size_t WS_BITM = WS_XN;
constexpr size_t WS_RDOTK = WS_WF + 16 * MiB;
constexpr int QP = 1536, ZP = 4096;
constexpr int ZC_DK = 0, ZC_DV = 512, ZC_QI = 1024, ZC_KI = 1536, ZC_WI = 1600, ZC_RK = 1792, ZC_RV = 2304, ZC_WC = 2816, ZC_AC = 2880, ZC_GC = 2944, ZC_FK = 3072, ZC_FV = 3584;
constexpr int CW_TMO = 0;
constexpr int CW_BAR = 4096;
constexpr int CW_Q = 8192;
constexpr int CW_PROBE = 2048;
constexpr int CW_DONE = 12288;
constexpr int LDS_MISC = 160 * 1024 - 256;
constexpr int LDS_BYTES = 160 * 1024;

#define GAS __attribute__((address_space(1)))
#define LAS __attribute__((address_space(3)))
typedef unsigned short bf16;
typedef unsigned v4u __attribute__((ext_vector_type(4)));
typedef unsigned v2u __attribute__((ext_vector_type(2)));
typedef float f32x4 __attribute__((ext_vector_type(4)));
typedef float f32x2 __attribute__((ext_vector_type(2)));
typedef float f32x16 __attribute__((ext_vector_type(16)));
typedef short bf16x8 __attribute__((ext_vector_type(8)));
typedef GAS unsigned gu32;
#define RLX_AGENT __ATOMIC_RELAXED, __HIP_MEMORY_SCOPE_AGENT
#define LDS_WAIT() asm volatile("s_waitcnt lgkmcnt(0)" ::: "memory")
#define VM_WAIT() asm volatile("s_waitcnt vmcnt(0)" ::: "memory")
__device__ __forceinline__ unsigned f2bf(float f) { unsigned u = __builtin_bit_cast(unsigned, f); return (u + 0x7fffu + ((u >> 16) & 1u)) >> 16; }
__device__ __forceinline__ unsigned pk2(float lo, float hi) { return f2bf(lo) | (f2bf(hi) << 16); }
__device__ __forceinline__ float bflo(unsigned w) { return __uint_as_float(w << 16); }
__device__ __forceinline__ float bfhi(unsigned w) { return __uint_as_float(w & 0xffff0000u); }
__device__ __forceinline__ float bf1(bf16 h) { return __uint_as_float((unsigned)h << 16); }
__device__ __forceinline__ float wave_sum(float v) {
#pragma unroll
    for (int o = 1; o < 64; o <<= 1) v += __shfl_xor(v, o);
    return v;
}
__device__ __forceinline__ float sigm(float x) { return __builtin_amdgcn_rcpf(1.0f + __expf(-x)); }

#define XB_TMO      128
#define XB_XCNT(j)  (256  + 64 * (j))
#define XB_XSUB(j)  (1280 + 64 * (j))
#define XB_XGEN(j)  (2304 + 64 * (j))
#define XB_TOP      3328
#define XB_TOPGEN   3392
#define XCD_BAR_WORDS 3456
#define XB_SPIN_CAP (1u << 22)
__device__ __forceinline__ unsigned xb_ld(unsigned* p)              { return __hip_atomic_load(p, __ATOMIC_RELAXED, __HIP_MEMORY_SCOPE_AGENT); }
__device__ __forceinline__ unsigned xb_add(unsigned* p, unsigned v) { return __hip_atomic_fetch_add(p, v, __ATOMIC_RELAXED, __HIP_MEMORY_SCOPE_AGENT); }
__device__ __forceinline__ unsigned xb_xcc_id() { return (unsigned)__builtin_amdgcn_s_getreg((3 << 11) | 20) & 0xFu; }
#define XB_SPIN(cond, bar) do { unsigned _sp = 0; while (cond) { __builtin_amdgcn_s_sleep(1); \
    if ((++_sp & 255u) == 0u) { if (xb_ld(&(bar)[XB_TMO])) break; if (_sp > XB_SPIN_CAP) { atomicAdd(&(bar)[XB_TMO], 1u); break; } } } } while (0)
struct XcdBarrier { unsigned* bar; unsigned x; volatile LAS unsigned* st; };
__device__ __forceinline__ XcdBarrier xcd_barrier_post(unsigned* bar, volatile LAS unsigned* st) {
    XcdBarrier b; b.bar = bar; b.x = xb_xcc_id(); b.st = st;
    if (threadIdx.x == 0) (void)xb_add(&bar[XB_XCNT(b.x)], 1u);
    return b;
}
__device__ __forceinline__ void xcd_barrier_complete(unsigned* bar, unsigned x, unsigned& nloc, unsigned& nx) {
    const unsigned G = gridDim.x * gridDim.y * gridDim.z;
    unsigned sum, cnt, mine, sp = 0u;
    for (;;) {
        sum = 0u; cnt = 0u; mine = 0u;
#pragma unroll
        for (unsigned j = 0; j < 16; ++j) { const unsigned c = xb_ld(&bar[XB_XCNT(j)]); sum += c; cnt += (c > 0u) ? 1u : 0u; mine = (j == x) ? c : mine; }
        if (sum == G) break;
        __builtin_amdgcn_s_sleep(1);
        if ((++sp & 255u) == 0u) { if (xb_ld(&bar[XB_TMO])) break; if (sp > XB_SPIN_CAP) { atomicAdd(&bar[XB_TMO], 1u); break; } }
    }
    nloc = mine > 0u ? mine : 1u; nx = cnt > 0u ? cnt : 1u;
}
__device__ __forceinline__ void xcd_barrier(const XcdBarrier& b) {
    asm volatile("s_waitcnt vmcnt(0)" ::: "memory");
    __syncthreads();
    if (threadIdx.x == 0) {
        unsigned* bar = b.bar;
        __builtin_amdgcn_s_waitcnt(0);
        unsigned nloc = b.st[0], nx = b.st[1];
        if (nloc == 0u) { xcd_barrier_complete(bar, b.x, nloc, nx); b.st[0] = nloc; b.st[1] = nx; }
        const unsigned old = xb_add(&bar[XB_XSUB(b.x)], 1u);
        const unsigned gen = old / nloc;
        if (old + 1u == (gen + 1u) * nloc) {
            __builtin_amdgcn_fence(__ATOMIC_RELEASE, "agent");
            asm volatile("s_waitcnt vmcnt(0)" ::: "memory");
            const unsigned og = xb_add(&bar[XB_TOP], 1u);
            const unsigned tg = og / nx;
            if (og + 1u == (tg + 1u) * nx) xb_add(&bar[XB_TOPGEN], 1u);
            else XB_SPIN(xb_ld(&bar[XB_TOPGEN]) == tg, bar);
            __builtin_amdgcn_fence(__ATOMIC_ACQUIRE, "agent");
            xb_add(&bar[XB_XGEN(b.x)], 1u);
            asm volatile("s_waitcnt vmcnt(0)" ::: "memory");
        } else {
            XB_SPIN(xb_ld(&bar[XB_XGEN(b.x)]) == gen, bar);
            __builtin_amdgcn_fence(__ATOMIC_ACQUIRE, "agent");
            asm volatile("s_waitcnt vmcnt(0)" ::: "memory");
        }
    }
    __syncthreads();
}

struct MapIdent { const float* W; int ld; __device__ __forceinline__ const float* col(int n) const { return W + n; } };
struct MapUp {
    const float* G; const float* U; int ld;
    __device__ __forceinline__ const float* col(int n) const { const int g = n >> 5, j = n & 31; return j < 16 ? G + 16 * g + j : U + 16 * g + (j - 16); }
};
struct MapWin {
    const float* W; int ld;
    __device__ __forceinline__ const float* col(int n) const {
        int src;
        if (n < 512) src = n; else if (n < 1024) src = 2120 + (n - 512); else if (n < 1536) src = 3912 + (n - 1024);
        else if (n < 5632) { const int z = n - 1536; if (z < 1608) src = 512 + z; else if (z < 1792) src = -1; else if (z < 3072) src = 840 + z; else src = 1352 + z; }
        else src = 5448 + (n - 5632);
        return src < 0 ? nullptr : W + src;
    }
};
template <class Map>
__device__ __forceinline__ void conv_item(const Map& mp, int K, bf16* WT, LAS float* scr, int item, int nblk, int lane) {
    const int kb = item / nblk, nb = item % nblk, k0 = 64 * kb, n0 = 32 * nb;
    const float* cp = mp.col(n0 + (lane & 31)); const size_t ld = (size_t)mp.ld;
#pragma unroll 8
    for (int i = 0; i < 32; ++i) { const int kk = 2 * i + (lane >> 5); scr[kk * 33 + (lane & 31)] = cp ? cp[(size_t)(k0 + kk) * ld] : 0.f; }
    LDS_WAIT(); asm volatile("" ::: "memory");
    const int c = lane & 7;
#pragma unroll
    for (int j = 0; j < 4; ++j) { const int n = (lane >> 3) + 8 * j; const LAS float* s = scr + (8 * c) * 33 + n;
        v4u o; o.x = pk2(s[0 * 33], s[1 * 33]); o.y = pk2(s[2 * 33], s[3 * 33]); o.z = pk2(s[4 * 33], s[5 * 33]); o.w = pk2(s[6 * 33], s[7 * 33]);
        *(GAS v4u*)(WT + (size_t)(n0 + n) * K + k0 + 8 * c) = o; }
    LDS_WAIT(); asm volatile("" ::: "memory");
}
template <class Map>
__device__ __forceinline__ void conv_matrix(const Map& mp, int K, int N, bf16* WT, LAS float* scr, int gw, int NGW, int lane) {
    const int nblk = N / 32, nitems = (K / 64) * nblk;
    for (int it = gw; it < nitems; it += NGW) conv_item(mp, K, WT, scr, it, nblk, lane);
}

__device__ __forceinline__ void rownorm_rows(const float* base, const bf16* Y, float s, const float* gpost, float* out, const float* gnext, bf16* XN, int gw, int NGW, int lane, float oscale = 1.f) {
    for (int m = gw; m < M; m += NGW) {
        f32x4 v[4];
#pragma unroll
        for (int j = 0; j < 4; ++j) v[j] = ((const GAS f32x4*)(base + (size_t)m * DM))[lane + 64 * j];
        if (Y) {
            f32x4 y[4]; float ss = 0.f;
#pragma unroll
            for (int j = 0; j < 4; ++j) { const v2u w = ((const GAS v2u*)(Y + (size_t)m * DM))[lane + 64 * j]; y[j] = (f32x4){bflo(w.x), bfhi(w.x), bflo(w.y), bfhi(w.y)};
                ss += (y[j].x * y[j].x + y[j].y * y[j].y) + (y[j].z * y[j].z + y[j].w * y[j].w); }
            const float r = s * __builtin_amdgcn_rsqf(wave_sum(ss) * (1.f / DM) + NORM_EPS);
#pragma unroll
            for (int j = 0; j < 4; ++j) { const f32x4 g = ((const GAS f32x4*)gpost)[lane + 64 * j]; v[j] = v[j] + y[j] * g * r; ((GAS f32x4*)(out + (size_t)m * DM))[lane + 64 * j] = v[j] * oscale; }
        }
        if (XN) {
            float ss = 0.f;
#pragma unroll
            for (int j = 0; j < 4; ++j) ss += (v[j].x * v[j].x + v[j].y * v[j].y) + (v[j].z * v[j].z + v[j].w * v[j].w);
            const float r = __builtin_amdgcn_rsqf(wave_sum(ss) * (1.f / DM) + NORM_EPS);
#pragma unroll
            for (int j = 0; j < 4; ++j) { const f32x4 g = ((const GAS f32x4*)gnext)[lane + 64 * j]; const f32x4 o = v[j] * g * r;
                v2u w; w.x = pk2(o.x, o.y); w.y = pk2(o.z, o.w); ((GAS v2u*)(XN + (size_t)m * DM))[lane + 64 * j] = w; }
        }
    }
}

namespace scan {
template <int CTRL> __device__ __forceinline__ float dpp_add(float x) {
    const int y = __builtin_amdgcn_update_dpp(0, __builtin_bit_cast(int, x), CTRL, 0xF, 0xF, false);
    return x + __builtin_bit_cast(float, y);
}
__device__ __forceinline__ float red8(float x) { x = dpp_add<0xB1>(x); x = dpp_add<0x4E>(x); x = dpp_add<0x141>(x); return x; }
__device__ __forceinline__ float red16(float x) { x = dpp_add<0xB1>(x); x = dpp_add<0x4E>(x); x = dpp_add<0x141>(x); x = dpp_add<0x140>(x); return x; }
__device__ __forceinline__ void ld8(const bf16* p, float (&o)[8]) { const v4u w = *(const GAS v4u*)p; o[0] = bflo(w.x); o[1] = bfhi(w.x); o[2] = bflo(w.y); o[3] = bfhi(w.y); o[4] = bflo(w.z); o[5] = bfhi(w.z); o[6] = bflo(w.w); o[7] = bfhi(w.w); }
}
struct PrepP { const bf16* ZR; bf16* X1; unsigned char* A8; bf16* KI; const float *mu, *w0, *wup, *a0, *aup; };
__device__ __forceinline__ void rwkv_prep(const PrepP& P, LAS unsigned char* lds) {
    const int tid = otid_(), lane = tid & 63, h = __builtin_amdgcn_readfirstlane(tid >> 6), c16 = lane & 15, quad = lane >> 4;
    constexpr int SP = 144;
    LAS unsigned char* TA = lds; LAS unsigned char* AA = lds + 64 * SP;
    bf16x8 bw[4][2], ba[4][2];
#pragma unroll
    for (int ct = 0; ct < 4; ++ct)
#pragma unroll
        for (int s = 0; s < 2; ++s) { const size_t o = (size_t)(32 * s + 8 * quad) * 512 + 64 * h + 16 * ct + c16; const float* gw_ = P.wup + o; const float* ga_ = P.aup + o;
            v4u w; w.x = pk2(gw_[0], gw_[512]); w.y = pk2(gw_[1024], gw_[1536]); w.z = pk2(gw_[2048], gw_[2560]); w.w = pk2(gw_[3072], gw_[3584]); bw[ct][s] = __builtin_bit_cast(bf16x8, w);
            v4u a; a.x = pk2(ga_[0], ga_[512]); a.y = pk2(ga_[1024], ga_[1536]); a.z = pk2(ga_[2048], ga_[2560]); a.w = pk2(ga_[3072], ga_[3584]); ba[ct][s] = __builtin_bit_cast(bf16x8, a); }
    float w0v[4], a0v[4];
#pragma unroll
    for (int ct = 0; ct < 4; ++ct) { w0v[ct] = P.w0[64 * h + 16 * ct + c16]; a0v[ct] = P.a0[64 * h + 16 * ct + c16]; }
    const int stok = tid >> 3, sseg = tid & 7;
#pragma unroll 1
    for (int m0 = blockIdx.x * 64; m0 < M; m0 += gridDim.x * 64) {
        {   const size_t m = (size_t)m0 + stok; const int t = (int)(m & (T - 1));
            *(GAS v4u*)(P.KI + m * 64 + 8 * sseg) = *(const GAS v4u*)(P.ZR + m * ZP + ZC_KI + 8 * sseg);
            float wc[8], ac[8], p8[8];
            scan::ld8(P.ZR + m * ZP + ZC_WC + 8 * sseg, wc); scan::ld8(P.ZR + m * ZP + ZC_AC + 8 * sseg, ac);
            if (t > 0) { scan::ld8(P.ZR + (m - 1) * ZP + ZC_WC + 8 * sseg, p8);
#pragma unroll
                for (int e = 0; e < 8; ++e) wc[e] += (p8[e] - wc[e]) * P.mu[1536 + 8 * sseg + e];
                scan::ld8(P.ZR + (m - 1) * ZP + ZC_AC + 8 * sseg, p8);
#pragma unroll
                for (int e = 0; e < 8; ++e) ac[e] += (p8[e] - ac[e]) * P.mu[1600 + 8 * sseg + e]; }
            else {
#pragma unroll
                for (int e = 0; e < 8; ++e) { wc[e] -= wc[e] * P.mu[1536 + 8 * sseg + e]; ac[e] -= ac[e] * P.mu[1600 + 8 * sseg + e]; } }
            float th[8];
#pragma unroll
            for (int e = 0; e < 8; ++e) th[e] = 1.f - 2.f * __builtin_amdgcn_rcpf(__expf(2.f * wc[e]) + 1.f);
            v4u o; o.x = pk2(th[0], th[1]); o.y = pk2(th[2], th[3]); o.z = pk2(th[4], th[5]); o.w = pk2(th[6], th[7]); *(LAS v4u*)(TA + stok * SP + 16 * sseg) = o;
            v4u q; q.x = pk2(ac[0], ac[1]); q.y = pk2(ac[2], ac[3]); q.z = pk2(ac[4], ac[5]); q.w = pk2(ac[6], ac[7]); *(LAS v4u*)(AA + stok * SP + 16 * sseg) = q;
        }
        __syncthreads();
#pragma unroll 1
        for (int rt = 0; rt < 4; ++rt) {
            f32x4 accw[4], acca[4];
#pragma unroll
            for (int ct = 0; ct < 4; ++ct) { accw[ct] = (f32x4){0.f, 0.f, 0.f, 0.f}; acca[ct] = (f32x4){0.f, 0.f, 0.f, 0.f}; }
#pragma unroll
            for (int s = 0; s < 2; ++s) { const bf16x8 fw = *(const LAS bf16x8*)(TA + (16 * rt + c16) * SP + (32 * s + 8 * quad) * 2), fa = *(const LAS bf16x8*)(AA + (16 * rt + c16) * SP + (32 * s + 8 * quad) * 2);
#pragma unroll
                for (int ct = 0; ct < 4; ++ct) { accw[ct] = __builtin_amdgcn_mfma_f32_16x16x32_bf16(fw, bw[ct][s], accw[ct], 0, 0, 0); acca[ct] = __builtin_amdgcn_mfma_f32_16x16x32_bf16(fa, ba[ct][s], acca[ct], 0, 0, 0); } }
#pragma unroll
            for (int j = 0; j < 4; ++j) { const size_t m = (size_t)m0 + 16 * rt + 4 * quad + j;
#pragma unroll
                for (int ct = 0; ct < 4; ++ct) { const int ch = 64 * h + 16 * ct + c16;
                    const float sg = sigm(w0v[ct] + accw[ct][j]);
                    const float x1 = 1.f - __expf(-0.6065306597126334f * sg);
                    const float a = sigm(a0v[ct] + acca[ct][j]);
                    P.X1[m * 512 + ch] = (bf16)f2bf(x1);
                    P.A8[m * 512 + ch] = (unsigned char)(int)(a * 255.f + 0.5f); } }
        }
        __syncthreads();
    }
}

struct ScanP { const bf16* Q3; const bf16* ZR; const bf16* X1; const unsigned char* A8; bf16* yraw; float* rdotk; const float *mu, *k_k, *k_a, *r_k; };
namespace scan {
constexpr int TB = 32, NBLK = T / TB;
constexpr int CB_W = 0, CB_B = 8192, CB_K = 16384, CB_KW = 24576, CB_V = 40960, CB_BR = 43008, CB_KR = 43136, CB_SA = 43264, CB_YP = 45312, CBSZ = 78080;
constexpr int L_END = 2 * CBSZ;
static_assert(L_END <= LDS_MISC, "scan LDS");
}
__device__ __forceinline__ void rwkv_scan_unit(const ScanP& P, int unit, LAS unsigned char* lds) {
    using namespace scan;
    const int tid = otid_(), wid = __builtin_amdgcn_readfirstlane(tid >> 6), lane = tid & 63;
    const int b = unit >> 5, h = (unit >> 2) & 7, vq = unit & 3;
    const size_t mrow0 = (size_t)b * T;
    if (wid >= 4) {
        const int pw = wid - 4, tokl = lane >> 3, seg = lane & 7, c0 = 8 * seg, hc0 = 64 * h + c0;
        float mu_r[8], mu_k[8], kkv[8], kav[8], rkv[8];
#pragma unroll
        for (int e = 0; e < 8; ++e) { mu_r[e] = P.mu[hc0 + e]; mu_k[e] = P.mu[512 + hc0 + e]; kkv[e] = P.k_k[hc0 + e]; kav[e] = P.k_a[hc0 + e]; rkv[e] = P.r_k[hc0 + e]; }
        const int vc0 = 64 * h + 16 * vq + 2 * seg;
        const float mu_v0 = P.mu[1024 + vc0], mu_v1 = P.mu[1024 + vc0 + 1];
        const int ptid = pw * 64 + lane;
        for (int blk = -1; blk < NBLK; ++blk) {
            const int nb = blk + 1;
            LAS unsigned char* cb = lds + (nb & 1) * CBSZ;
            if (blk >= 1) {
                const int tok = ptid >> 3, v2 = (ptid & 7) * 2;
                const LAS float* YPp = (const LAS float*)(cb + CB_YP) + (tok * 16 + v2) * 16;
                float y0 = 0.f, y1 = 0.f;
#pragma unroll
                for (int q4 = 0; q4 < 4; ++q4) { const f32x4 a = *(const LAS f32x4*)(YPp + 4 * q4), c = *(const LAS f32x4*)(YPp + 16 + 4 * q4); y0 += (a.x + a.y) + (a.z + a.w); y1 += (c.x + c.y) + (c.z + c.w); }
                const float br = *(const LAS float*)(cb + CB_BR + tok * 4), kr = *(const LAS float*)(cb + CB_KR + tok * 4);
                const f32x2 sa = *(const LAS f32x2*)(cb + CB_SA + (tok * 16 + v2) * 4), vv = *(const LAS f32x2*)(cb + CB_V + (tok * 16 + v2) * 4);
                y0 += sa.x * br + vv.x * kr; y1 += sa.y * br + vv.y * kr;
                const size_t m = mrow0 + (size_t)(blk - 1) * TB + tok;
                *(GAS unsigned*)(P.yraw + m * 512 + 64 * h + 16 * vq + v2) = pk2(y0, y1);
                LDS_WAIT(); asm volatile("" ::: "memory");
            }
            if (nb < NBLK) {
                const int t = nb * TB + 8 * pw + tokl; const size_t m = mrow0 + t;
                float r8[8], k8[8], p8[8], x8[8], a8[8];
                ld8(P.Q3 + m * QP + 512 + hc0, r8); ld8(P.ZR + m * ZP + ZC_RK + hc0, k8); ld8(P.X1 + m * 512 + hc0, x8);
                { const v2u aw = *(const GAS v2u*)(P.A8 + m * 512 + hc0); const float sc = 1.f / 255.f;
                  a8[0] = (float)(aw.x & 255u) * sc; a8[1] = (float)((aw.x >> 8) & 255u) * sc; a8[2] = (float)((aw.x >> 16) & 255u) * sc; a8[3] = (float)(aw.x >> 24) * sc;
                  a8[4] = (float)(aw.y & 255u) * sc; a8[5] = (float)((aw.y >> 8) & 255u) * sc; a8[6] = (float)((aw.y >> 16) & 255u) * sc; a8[7] = (float)(aw.y >> 24) * sc; }
                const unsigned vw = *(const GAS unsigned*)(P.ZR + m * ZP + ZC_RV + vc0); float v0 = bflo(vw), v1 = bfhi(vw);
                if (t > 0) {
                    ld8(P.Q3 + (m - 1) * QP + 512 + hc0, p8);
#pragma unroll
                    for (int e = 0; e < 8; ++e) r8[e] += (p8[e] - r8[e]) * mu_r[e];
                    ld8(P.ZR + (m - 1) * ZP + ZC_RK + hc0, p8);
#pragma unroll
                    for (int e = 0; e < 8; ++e) k8[e] += (p8[e] - k8[e]) * mu_k[e];
                    const unsigned pv = *(const GAS unsigned*)(P.ZR + (m - 1) * ZP + ZC_RV + vc0);
                    v0 += (bflo(pv) - v0) * mu_v0; v1 += (bfhi(pv) - v1) * mu_v1;
                } else {
#pragma unroll
                    for (int e = 0; e < 8; ++e) { r8[e] -= r8[e] * mu_r[e]; k8[e] -= k8[e] * mu_k[e]; }
                    v0 -= v0 * mu_v0; v1 -= v1 * mu_v1;
                }
                float kk8[8]; { float ss = 0.f;
#pragma unroll
                  for (int e = 0; e < 8; ++e) { kk8[e] = k8[e] * kkv[e]; ss += kk8[e] * kk8[e]; }
                  ss = red8(ss); const float inv = 1.f / fmaxf(sqrtf(ss), 1e-12f);
#pragma unroll
                  for (int e = 0; e < 8; ++e) kk8[e] *= inv; }
                float w8[8], bb[8], km[8], wr[8]; float brp = 0.f, krp = 0.f, rkp = 0.f;
#pragma unroll
                for (int e = 0; e < 8; ++e) {
                    w8[e] = 1.f - x8[e];
                    bb[e] = kk8[e] * a8[e]; km[e] = k8[e] * (1.f + (a8[e] - 1.f) * kav[e]); wr[e] = w8[e] * r8[e];
                    brp += bb[e] * r8[e]; krp += km[e] * r8[e]; rkp += r8[e] * km[e] * rkv[e];
                }
                brp = red8(brp); krp = red8(krp); rkp = red8(rkp);
                const int ti = 8 * pw + tokl;
                *(LAS f32x4*)(cb + CB_W + (ti * 64 + c0) * 4) = (f32x4){w8[0], w8[1], w8[2], w8[3]}; *(LAS f32x4*)(cb + CB_W + (ti * 64 + c0 + 4) * 4) = (f32x4){w8[4], w8[5], w8[6], w8[7]};
                *(LAS f32x4*)(cb + CB_B + (ti * 64 + c0) * 4) = (f32x4){bb[0], bb[1], bb[2], bb[3]}; *(LAS f32x4*)(cb + CB_B + (ti * 64 + c0 + 4) * 4) = (f32x4){bb[4], bb[5], bb[6], bb[7]};
                *(LAS f32x4*)(cb + CB_K + (ti * 64 + c0) * 4) = (f32x4){km[0], km[1], km[2], km[3]}; *(LAS f32x4*)(cb + CB_K + (ti * 64 + c0 + 4) * 4) = (f32x4){km[4], km[5], km[6], km[7]};
#pragma unroll
                for (int e = 0; e < 8; e += 2) *(LAS f32x4*)(cb + CB_KW + (ti * 64 + c0 + e) * 8) = (f32x4){kk8[e], wr[e], kk8[e + 1], wr[e + 1]};
                *(LAS f32x2*)(cb + CB_V + (ti * 16 + 2 * seg) * 4) = (f32x2){v0, v1};
                if (seg == 0) { *(LAS float*)(cb + CB_BR + ti * 4) = brp; *(LAS float*)(cb + CB_KR + ti * 4) = krp; if (vq == 0) P.rdotk[m * 8 + h] = rkp; }
            }
            __syncthreads();
        }
        { const LAS unsigned char* cb = lds + ((NBLK - 1) & 1) * CBSZ;
          const int tok = ptid >> 3, v2 = (ptid & 7) * 2;
          const LAS float* YPp = (const LAS float*)(cb + CB_YP) + (tok * 16 + v2) * 16;
          float y0 = 0.f, y1 = 0.f;
#pragma unroll
          for (int q4 = 0; q4 < 4; ++q4) { const f32x4 a = *(const LAS f32x4*)(YPp + 4 * q4), c = *(const LAS f32x4*)(YPp + 16 + 4 * q4); y0 += (a.x + a.y) + (a.z + a.w); y1 += (c.x + c.y) + (c.z + c.w); }
          const float br = *(const LAS float*)(cb + CB_BR + tok * 4), kr = *(const LAS float*)(cb + CB_KR + tok * 4);
          const f32x2 sa = *(const LAS f32x2*)(cb + CB_SA + (tok * 16 + v2) * 4), vv = *(const LAS f32x2*)(cb + CB_V + (tok * 16 + v2) * 4);
          y0 += sa.x * br + vv.x * kr; y1 += sa.y * br + vv.y * kr;
          const size_t m = mrow0 + (size_t)(NBLK - 1) * TB + tok;
          *(GAS unsigned*)(P.yraw + m * 512 + 64 * h + 16 * vq + v2) = pk2(y0, y1); }
    } else {
        const int vi = 4 * wid + (lane >> 4), cg = lane & 15;
        f32x2 s01 = {0.f, 0.f}, s23 = {0.f, 0.f};
        __syncthreads();
        __builtin_amdgcn_s_setprio(3);
        const unsigned lo4 = (unsigned)(4 * cg) * 4u, lo8 = (unsigned)(4 * cg) * 8u;
        for (int blk = 0; blk < NBLK; ++blk) {
            const LAS unsigned char* cb = lds + (blk & 1) * CBSZ;
            f32x4 kwa = *(const LAS f32x4*)(cb + CB_KW + lo8), kwb = *(const LAS f32x4*)(cb + CB_KW + lo8 + 16);
            f32x4 w4 = *(const LAS f32x4*)(cb + CB_W + lo4), b4 = *(const LAS f32x4*)(cb + CB_B + lo4), k4 = *(const LAS f32x4*)(cb + CB_K + lo4);
            float vv = *(const LAS float*)(cb + CB_V + vi * 4);
#pragma unroll 4
            for (int tok = 0; tok < TB; ++tok) {
                const int tn = tok + 1 < TB ? tok + 1 : tok;
                const f32x4 nkwa = *(const LAS f32x4*)(cb + CB_KW + tn * 512 + lo8), nkwb = *(const LAS f32x4*)(cb + CB_KW + tn * 512 + lo8 + 16);
                const f32x4 nw4 = *(const LAS f32x4*)(cb + CB_W + tn * 256 + lo4), nb4 = *(const LAS f32x4*)(cb + CB_B + tn * 256 + lo4), nk4 = *(const LAS f32x4*)(cb + CB_K + tn * 256 + lo4);
                const float nvv = *(const LAS float*)(cb + CB_V + (tn * 16 + vi) * 4);
                f32x2 p = (f32x2){s01.x, s01.x} * (f32x2){kwa.x, kwa.y};
                p += (f32x2){s01.y, s01.y} * (f32x2){kwa.z, kwa.w};
                p += (f32x2){s23.x, s23.x} * (f32x2){kwb.x, kwb.y};
                p += (f32x2){s23.y, s23.y} * (f32x2){kwb.z, kwb.w};
                *(LAS float*)(cb + CB_YP + ((tok * 16 + vi) * 16 + cg) * 4) = p.y;
                const f32x2 t01 = s01 * (f32x2){w4.x, w4.y} + (f32x2){k4.x, k4.y} * vv, t23 = s23 * (f32x2){w4.z, w4.w} + (f32x2){k4.z, k4.w} * vv;
                const float d1 = red16(p.x);
                s01 = t01 - (f32x2){b4.x, b4.y} * d1; s23 = t23 - (f32x2){b4.z, b4.w} * d1;
                *(LAS float*)(cb + CB_SA + (tok * 16 + vi) * 4) = -d1;
                kwa = nkwa; kwb = nkwb; w4 = nw4; b4 = nb4; k4 = nk4; vv = nvv;
            }
            __syncthreads();
        }
        __builtin_amdgcn_s_setprio(0);
    }
    __syncthreads();
}

struct Dsa1P { const bf16* ZR; const bf16* KI; unsigned* bitm; gu32* done; };
namespace dsa1 {
constexpr int CAP = 769  , PRUNE_AT = 512, KEEP = 256;
constexpr int L_BUF = 0, L_CNT = 32 * CAP * 4, L_THR = L_CNT + 128, L_THRK = L_THR + 128, L_HIST = ((L_THRK + 128 + 15) / 16) * 16, L_MROW = L_HIST + 8 * 1024, L_QF = L_MROW + 8 * 1024, QFP = 1040, L_END = L_QF + 32 * QFP;
static_assert(L_END <= LDS_MISC, "dsa1 LDS");
__device__ __forceinline__ unsigned packkey(float s, int keyidx) { const unsigned bits = __float_as_uint(s); const unsigned u = bits ^ ((unsigned)((int)bits >> 31) | 0x80000000u); return (u & 0xFFFFE000u) | (unsigned)(8191 - keyidx); }
__device__ __forceinline__ float thr_of(unsigned key) { const unsigned u = key & 0xFFFFE000u; const unsigned bits = (u & 0x80000000u) ? (u ^ 0x80000000u) : ~u; return __uint_as_float(bits); }
__device__ __forceinline__ void prune(LAS unsigned char* lds, int qq, int wid, int lane, bool exact) {
    asm volatile("" : "+v"(lane));
    LAS unsigned* buf = (LAS unsigned*)(lds + L_BUF) + qq * CAP; LAS unsigned* cnt = (LAS unsigned*)(lds + L_CNT); LAS float* thr = (LAS float*)(lds + L_THR); LAS unsigned* thrk = (LAS unsigned*)(lds + L_THRK);
    LAS unsigned* hist = (LAS unsigned*)(lds + L_HIST) + wid * 256;
    const int n = (int)cnt[qq];
    unsigned e[12];
#pragma unroll
    for (int k = 0; k < 12; ++k) e[k] = (lane + 64 * k < n) ? buf[lane + 64 * k] : 0u;
    const unsigned tk = thrk[qq];
    unsigned cut = 0u; bool have = false;
    if (!exact && tk != 0u) {
        const unsigned base16 = tk >> 16;
        *(LAS v4u*)(hist + 4 * lane) = (v4u){0u, 0u, 0u, 0u};
        LDS_WAIT(); asm volatile("" ::: "memory");
#pragma unroll
        for (int k = 0; k < 12; ++k) if (lane + 64 * k < n) { unsigned bn = (e[k] >> 16) - base16; bn = bn > 255u ? 255u : bn; (void)__hip_atomic_fetch_add(hist + bn, 1u, __ATOMIC_RELAXED, __HIP_MEMORY_SCOPE_WORKGROUP); }
        LDS_WAIT(); asm volatile("" ::: "memory");
        const v4u hv = *(const LAS v4u*)(hist + 4 * lane);
        const int tot = (int)(hv.x + hv.y + hv.z + hv.w);
        int suf = tot;
#pragma unroll
        for (int off = 1; off < 64; off <<= 1) { const int t = __shfl_down(suf, off); if (lane + off < 64) suf += t; }
        int above = suf - tot; int dsel = -1, csel = 0;
        { const int h3 = (int)hv.w, h2 = (int)hv.z, h1 = (int)hv.y, h0 = (int)hv.x;
          if (above < KEEP && KEEP <= above + h3) { dsel = 4 * lane + 3; csel = above + h3; } above += h3;
          if (above < KEEP && KEEP <= above + h2) { dsel = 4 * lane + 2; csel = above + h2; } above += h2;
          if (above < KEEP && KEEP <= above + h1) { dsel = 4 * lane + 1; csel = above + h1; } above += h1;
          if (above < KEEP && KEEP <= above + h0) { dsel = 4 * lane + 0; csel = above + h0; } }
        const unsigned long long bm = __ballot(dsel >= 0);
        const int src = bm ? (int)__builtin_ctzll(bm) : 0;
        const int d = __shfl(dsel, src), cd = __shfl(csel, src);
        LDS_WAIT(); asm volatile("" ::: "memory");
        if (bm != 0ull && cd <= KEEP + 128) { cut = (base16 + (unsigned)d) << 16; have = true; }
    }
    if (!have) {
        unsigned prefix = 0u; int want = KEEP;
#pragma unroll 1
        for (int p = 0; p < 4; ++p) {
            const int shift = 24 - 8 * p;
            *(LAS v4u*)(hist + 4 * lane) = (v4u){0u, 0u, 0u, 0u};
            LDS_WAIT(); asm volatile("" ::: "memory");
#pragma unroll
            for (int k = 0; k < 12; ++k) { const bool in = (lane + 64 * k < n) && (p == 0 || (e[k] >> (shift + 8)) == (prefix >> (shift + 8)));
                if (in) (void)__hip_atomic_fetch_add(hist + ((e[k] >> shift) & 255u), 1u, __ATOMIC_RELAXED, __HIP_MEMORY_SCOPE_WORKGROUP); }
            LDS_WAIT(); asm volatile("" ::: "memory");
            const v4u hv = *(const LAS v4u*)(hist + 4 * lane);
            const int tot = (int)(hv.x + hv.y + hv.z + hv.w);
            int suf = tot;
#pragma unroll
            for (int off = 1; off < 64; off <<= 1) { const int t = __shfl_down(suf, off); if (lane + off < 64) suf += t; }
            int above = suf - tot;
            int dsel = -1, asel = 0;
            { const int h3 = (int)hv.w, h2 = (int)hv.z, h1 = (int)hv.y, h0 = (int)hv.x;
              if (above < want && want <= above + h3) { dsel = 4 * lane + 3; asel = above; } above += h3;
              if (above < want && want <= above + h2) { dsel = 4 * lane + 2; asel = above; } above += h2;
              if (above < want && want <= above + h1) { dsel = 4 * lane + 1; asel = above; } above += h1;
              if (above < want && want <= above + h0) { dsel = 4 * lane + 0; asel = above; } }
            const unsigned long long bm = __ballot(dsel >= 0);
            const int src = bm ? (int)__builtin_ctzll(bm) : 0;
            const int d = __shfl(dsel, src), ab = __shfl(asel, src);
            prefix |= ((unsigned)(d < 0 ? 0 : d)) << shift; want -= ab;
            LDS_WAIT(); asm volatile("" ::: "memory");
        }
        cut = prefix;
    }
    int base = 0;
#pragma unroll
    for (int k = 0; k < 12; ++k) { const bool keep = (lane + 64 * k < n) && e[k] >= cut; const unsigned long long mk = __ballot(keep);
        const int pos = base + (int)__builtin_amdgcn_mbcnt_hi((unsigned)(mk >> 32), __builtin_amdgcn_mbcnt_lo((unsigned)mk, 0u));
        if (keep) buf[pos] = e[k]; base += (int)__builtin_popcountll(mk); }
    if (lane == 0) { cnt[qq] = (unsigned)base; thr[qq] = thr_of(cut); thrk[qq] = cut; }
    LDS_WAIT(); asm volatile("" ::: "memory");
}
}
__device__ __forceinline__ void dsa1_unit(const Dsa1P& P, int u, LAS unsigned char* lds) {
    using namespace dsa1;
    const int tid = otid_(), wid = __builtin_amdgcn_readfirstlane(tid >> 6), lane = tid & 63, q = lane & 31, hi = lane >> 5;
    const int b = u & 1, qb32 = 255 - (u >> 1), t0 = 32 * qb32;
    const size_t brow = (size_t)b * T;
    LAS unsigned* buf = (LAS unsigned*)(lds + L_BUF); LAS unsigned* cnt = (LAS unsigned*)(lds + L_CNT); LAS float* thr = (LAS float*)(lds + L_THR);
    if (tid < 32) { cnt[tid] = 0u; thr[tid] = -__builtin_inff(); ((LAS unsigned*)(lds + L_THRK))[tid] = 0u; }
    const bf16* qrow = P.ZR + (brow + t0 + q) * ZP;
    { const int r = tid >> 4, sg = tid & 15; const bf16* src = P.ZR + (brow + t0 + r) * ZP + ZC_QI + 32 * sg;
#pragma unroll
      for (int j = 0; j < 4; ++j) *(LAS v4u*)(lds + L_QF + r * QFP + 64 * sg + 16 * j) = *(const GAS v4u*)(src + 8 * j); }
    float wq[8];
    { const v4u w = *(const GAS v4u*)(qrow + ZC_WI); const float c = 0.35355339059327373f * 0.125f;
      wq[0] = bflo(w.x) * c; wq[1] = bfhi(w.x) * c; wq[2] = bflo(w.y) * c; wq[3] = bfhi(w.y) * c; wq[4] = bflo(w.z) * c; wq[5] = bfhi(w.z) * c; wq[6] = bflo(w.w) * c; wq[7] = bfhi(w.w) * c; }
    const int tq = t0 + q;
    const int nsteps = (t0 + 32 + 255) >> 8;
    __syncthreads();
    float th = -__builtin_inff();
    bf16x8 afn[4];
    { const int k0 = 32 * wid; const bf16* krow = P.KI + (brow + (k0 <= t0 + 31 ? k0 : 0) + q) * 64 + 8 * hi;
#pragma unroll
      for (int s = 0; s < 4; ++s) afn[s] = *(const GAS bf16x8*)(krow + 16 * s); }
    for (int st = 0; st < nsteps; ++st) {
        const int key0 = 256 * st + 32 * wid;
        bf16x8 af[4];
#pragma unroll
        for (int s = 0; s < 4; ++s) af[s] = afn[s];
        { const int k1 = key0 + 256; const bf16* krow = P.KI + (brow + (k1 <= t0 + 31 ? k1 : 0) + q) * 64 + 8 * hi;
#pragma unroll
          for (int s = 0; s < 4; ++s) afn[s] = *(const GAS bf16x8*)(krow + 16 * s); }
        if (key0 <= t0 + 31) {
            f32x16 sc;
#pragma unroll
            for (int i = 0; i < 16; ++i) sc[i] = 0.f;
            unsigned qfo = (unsigned)(L_QF + q * QFP + 16 * hi); asm volatile("" : "+v"(qfo));
#pragma unroll
            for (int hd = 0; hd < 8; ++hd) {
                f32x16 acc;
#pragma unroll
                for (int i = 0; i < 16; ++i) acc[i] = 0.f;
#pragma unroll
                for (int s = 0; s < 4; ++s) { const bf16x8 qb = *(const LAS bf16x8*)(lds + qfo + hd * 128 + 32 * s);
                    acc = __builtin_amdgcn_mfma_f32_32x32x16_bf16(af[s], qb, acc, 0, 0, 0); }
#pragma unroll
                for (int i = 0; i < 16; ++i) sc[i] = fmaf(fmaxf(acc[i], 0.f), wq[hd], sc[i]);
                __builtin_amdgcn_sched_barrier(0);
            }
            const bool diag = key0 + 31 > t0;
            unsigned pm = 0u;
#pragma unroll
            for (int i = 0; i < 16; ++i) { const int kidx = key0 + (i & 3) + 8 * (i >> 2) + 4 * hi; const bool ok = (sc[i] >= th) && (!diag || kidx <= tq); pm |= ok ? (1u << i) : 0u; }
            const int np = __builtin_popcount(pm);
            if (np > 0) {
                int pos = (int)__hip_atomic_fetch_add(cnt + q, (unsigned)np, __ATOMIC_RELAXED, __HIP_MEMORY_SCOPE_WORKGROUP);
                LAS unsigned* bq = buf + q * CAP;
#pragma unroll
                for (int i = 0; i < 16; ++i) if (pm & (1u << i)) { const int kidx = key0 + (i & 3) + 8 * (i >> 2) + 4 * hi; bq[pos] = packkey(sc[i], kidx); ++pos; }
            }
        }
        __syncthreads();
        { unsigned nm = (unsigned)__ballot(cnt[q] > (unsigned)PRUNE_AT); int i = 0;
          while (nm) { const int qq = __builtin_ctz(nm); nm &= nm - 1u; if ((i & 7) == wid) prune(lds, qq, wid, lane, false); ++i; } }
        __syncthreads();
        th = thr[q];
    }
    LAS unsigned* mrow = (LAS unsigned*)(lds + L_MROW) + wid * 256;
#pragma unroll 1
    for (int k = 0; k < 4; ++k) {
        const int qq = wid + 8 * k;
        if (cnt[qq] > (unsigned)KEEP) prune(lds, qq, wid, lane, true);
        const int nf = (int)cnt[qq];
        *(LAS v4u*)(mrow + 4 * lane) = (v4u){0u, 0u, 0u, 0u};
        LDS_WAIT(); asm volatile("" ::: "memory");
#pragma unroll
        for (int j = 0; j < 4; ++j) { const int idx = lane + 64 * j; if (idx < nf) { const unsigned e = buf[qq * CAP + idx]; const unsigned key = 8191u - (e & 0x1FFFu); (void)__hip_atomic_fetch_or(mrow + (key >> 5), 1u << (key & 31u), __ATOMIC_RELAXED, __HIP_MEMORY_SCOPE_WORKGROUP); } }
        LDS_WAIT(); asm volatile("" ::: "memory");
        unsigned long long* grow = (unsigned long long*)(P.bitm + (brow + t0 + qq) * 256);
#pragma unroll
        for (int j = 0; j < 2; ++j) { const int w2 = lane + 64 * j; const unsigned long long v = (unsigned long long)mrow[2 * w2] | ((unsigned long long)mrow[2 * w2 + 1] << 32);
            __hip_atomic_store(grow + w2, v, RLX_AGENT); }
        LDS_WAIT(); asm volatile("" ::: "memory");
    }
    VM_WAIT();
    __syncthreads();
    if (tid == 0) __hip_atomic_fetch_add(P.done + 64 * (b * 32 + (t0 >> 8)), 1u, RLX_AGENT);
}

struct RPostP { const bf16* ZR; bf16* Q3; const bf16* yraw; const float* rdotk; const float *mu, *gup, *lnw, *lnb; };
__device__ __forceinline__ void rwkv_post(const RPostP& P, LAS unsigned char* lds) {
    const int tid = otid_(), lane = tid & 63, h = __builtin_amdgcn_readfirstlane(tid >> 6), c16 = lane & 15, quad = lane >> 4;
    constexpr int SP = 272;
    bf16x8 bfr[4][4];
#pragma unroll
    for (int ct = 0; ct < 4; ++ct)
#pragma unroll
        for (int s = 0; s < 4; ++s) { const float* gp = P.gup + (size_t)(32 * s + 8 * quad) * 512 + 64 * h + 16 * ct + c16;
            v4u w; w.x = pk2(gp[0], gp[512]); w.y = pk2(gp[1024], gp[1536]); w.z = pk2(gp[2048], gp[2560]); w.w = pk2(gp[3072], gp[3584]); bfr[ct][s] = __builtin_bit_cast(bf16x8, w); }
    float muv[4], lnw[4], lnb[4];
#pragma unroll
    for (int ct = 0; ct < 4; ++ct) { const int ch = 64 * h + 16 * ct + c16; muv[ct] = P.mu[1024 + ch]; lnw[ct] = P.lnw[ch]; lnb[ct] = P.lnb[ch]; }
    const int stok = tid >> 3, sseg = tid & 7;
#pragma unroll 1
    for (int m0 = blockIdx.x * 64; m0 < M; m0 += gridDim.x * 64) {
        {   const size_t m = (size_t)m0 + stok; const int t = (int)(m & (T - 1));
            float gv[16], pv[16];
            { const v4u a = *(const GAS v4u*)(P.ZR + m * ZP + ZC_GC + 16 * sseg), c = *(const GAS v4u*)(P.ZR + m * ZP + ZC_GC + 16 * sseg + 8);
              gv[0] = bflo(a.x); gv[1] = bfhi(a.x); gv[2] = bflo(a.y); gv[3] = bfhi(a.y); gv[4] = bflo(a.z); gv[5] = bfhi(a.z); gv[6] = bflo(a.w); gv[7] = bfhi(a.w);
              gv[8] = bflo(c.x); gv[9] = bfhi(c.x); gv[10] = bflo(c.y); gv[11] = bfhi(c.y); gv[12] = bflo(c.z); gv[13] = bfhi(c.z); gv[14] = bflo(c.w); gv[15] = bfhi(c.w); }
            if (t > 0) { const v4u a = *(const GAS v4u*)(P.ZR + (m - 1) * ZP + ZC_GC + 16 * sseg), c = *(const GAS v4u*)(P.ZR + (m - 1) * ZP + ZC_GC + 16 * sseg + 8);
              pv[0] = bflo(a.x); pv[1] = bfhi(a.x); pv[2] = bflo(a.y); pv[3] = bfhi(a.y); pv[4] = bflo(a.z); pv[5] = bfhi(a.z); pv[6] = bflo(a.w); pv[7] = bfhi(a.w);
              pv[8] = bflo(c.x); pv[9] = bfhi(c.x); pv[10] = bflo(c.y); pv[11] = bfhi(c.y); pv[12] = bflo(c.z); pv[13] = bfhi(c.z); pv[14] = bflo(c.w); pv[15] = bfhi(c.w); }
            else {
#pragma unroll
              for (int e = 0; e < 16; ++e) pv[e] = 0.f; }
            float sg[16];
#pragma unroll
            for (int e = 0; e < 16; ++e) { const float mu = P.mu[1664 + 16 * sseg + e]; sg[e] = sigm(gv[e] + (pv[e] - gv[e]) * mu); }
            v4u o0, o1; o0.x = pk2(sg[0], sg[1]); o0.y = pk2(sg[2], sg[3]); o0.z = pk2(sg[4], sg[5]); o0.w = pk2(sg[6], sg[7]); o1.x = pk2(sg[8], sg[9]); o1.y = pk2(sg[10], sg[11]); o1.z = pk2(sg[12], sg[13]); o1.w = pk2(sg[14], sg[15]);
            *(LAS v4u*)(lds + stok * SP + 32 * sseg) = o0; *(LAS v4u*)(lds + stok * SP + 32 * sseg + 16) = o1;
        }
        __syncthreads();
#pragma unroll 1
        for (int rt = 0; rt < 4; ++rt) {
            f32x4 acc[4];
#pragma unroll
            for (int ct = 0; ct < 4; ++ct) acc[ct] = (f32x4){0.f, 0.f, 0.f, 0.f};
#pragma unroll
            for (int s = 0; s < 4; ++s) { const bf16x8 af = *(const LAS bf16x8*)(lds + (16 * rt + c16) * SP + (32 * s + 8 * quad) * 2);
#pragma unroll
                for (int ct = 0; ct < 4; ++ct) acc[ct] = __builtin_amdgcn_mfma_f32_16x16x32_bf16(af, bfr[ct][s], acc[ct], 0, 0, 0); }
#pragma unroll
            for (int j = 0; j < 4; ++j) {
                const size_t m = (size_t)m0 + 16 * rt + 4 * quad + j; const int t = (int)(m & (T - 1));
                float yv[4]; float sm = 0.f;
#pragma unroll
                for (int ct = 0; ct < 4; ++ct) { yv[ct] = bf1(P.yraw[m * 512 + 64 * h + 16 * ct + c16]); sm += yv[ct]; }
                const float mean = scan::red16(sm) * (1.f / 64.f); float vs = 0.f;
#pragma unroll
                for (int ct = 0; ct < 4; ++ct) { yv[ct] -= mean; vs += yv[ct] * yv[ct]; }
                const float rstd = __builtin_amdgcn_rsqf(scan::red16(vs) * (1.f / 64.f) + 64e-5f);
                const float rk = P.rdotk[m * 8 + h];
#pragma unroll
                for (int ct = 0; ct < 4; ++ct) { const int ch = 64 * h + 16 * ct + c16;
                    float v = bf1(P.ZR[m * ZP + ZC_RV + ch]);
                    const float vp = t > 0 ? bf1(P.ZR[(m - 1) * ZP + ZC_RV + ch]) : 0.f;
                    v += (vp - v) * muv[ct];
                    const float o = (yv[ct] * rstd * lnw[ct] + lnb[ct] + rk * v) * acc[ct][j];
                    P.Q3[m * QP + 512 + ch] = (bf16)f2bf(o); }
            }
        }
        __syncthreads();
    }
}
struct DPostP { const bf16* O1; const bf16* O2; bf16* Q3; const float *lq1, *lk1, *lq2, *lk2, *subln; float lambda_init; };
__device__ __forceinline__ void diff_post(const DPostP& P, int gw, int NGW, int lane) {
    const float lam = __expf(wave_sum(P.lq1[lane] * P.lk1[lane])) - __expf(wave_sum(P.lq2[lane] * P.lk2[lane])) + P.lambda_init;
    const float s0 = P.subln[2 * lane] * (1.f - P.lambda_init), s1 = P.subln[2 * lane + 1] * (1.f - P.lambda_init);
    for (int it = gw; it < M * 4; it += NGW) {
        const size_t m = (size_t)(it >> 2); const int hh = it & 3;
        const unsigned a = *(const GAS unsigned*)(P.O1 + m * 512 + 128 * hh + 2 * lane), c = *(const GAS unsigned*)(P.O2 + m * 512 + 128 * hh + 2 * lane);
        const float x0 = bflo(a) - lam * bflo(c), x1 = bfhi(a) - lam * bfhi(c);
        const float r = __builtin_amdgcn_rsqf(wave_sum(x0 * x0 + x1 * x1) * (1.f / 128.f) + NORM_EPS);
        *(GAS unsigned*)(P.Q3 + m * QP + 1024 + 128 * hh + 2 * lane) = pk2(x0 * r * s0, x1 * r * s1);
    }
}

__device__ __forceinline__ int q_fetch(gu32* head, volatile LAS int* slot) {
    if (threadIdx.x == 0) *slot = (int)__hip_atomic_fetch_add(head, 1u, RLX_AGENT);
    __syncthreads();
    const int v = __builtin_amdgcn_readfirstlane(*slot);
    __syncthreads();
    return v;
}

struct Args { const float* in[32]; float* out; unsigned char* ws; int ph_lo, ph_hi; };
__device__ __forceinline__ const float* kin_(int i) { const char* ka = (const char*)__builtin_amdgcn_kernarg_segment_ptr(); unsigned off = (unsigned)i * 8u; asm volatile("" : "+s"(off)); return *(const float* const*)(ka + off); }
#define KIN(i) kin_(i)
#define XOUT ((float*)kin_(32))
__device__ __forceinline__ unsigned char* kws_() { return (unsigned char*)kin_(33); }
__device__ __forceinline__ int kint_(int byteoff) { const char* ka = (const char*)__builtin_amdgcn_kernarg_segment_ptr(); unsigned off = (unsigned)byteoff; asm volatile("" : "+s"(off)); return *(const int*)(ka + off); }
constexpr int PH_L = 14;
constexpr int N_PHASES = 1 + NLAYER * PH_L;

#define G ((int)gridDim.x)
#define bid ((int)blockIdx.x)
#define gw (bid * NWAVES + wave)
#define NGW (G * NWAVES)
#define MISC ((volatile LAS unsigned*)(lds + LDS_MISC))
#define IN(k) (kint_(272) <= (k) && (k) < kint_(276))
#define SEAM(k) do { if ((k) + 1 < kint_(276)) { XcdBarrier bar_; bar_.bar = (unsigned*)(kws_() + WS_CTL) + CW_BAR; bar_.x = xb_xcc_id(); bar_.st = MISC + 8; xcd_barrier(bar_); } } while (0)
#define WSL() unsigned char* wsl = kws_(); const int tid = otid_(), lane = tid & 63, wave = __builtin_amdgcn_readfirstlane(tid >> 6); (void)lane; (void)wave
#define WFu ((bf16*)(wsl + WS_WF))
#define WFd ((bf16*)(wsl + WS_WF_DOWN))
#define WMi ((bf16*)(wsl + WS_WM))
#define WMb ((bf16*)(wsl + WS_WM_BR))
#define WMo ((bf16*)(wsl + WS_WM_OUT))
#define XN ((bf16*)(wsl + WS_XN))
#define Q3 ((bf16*)(wsl + WS_Q3))
#define ZR ((bf16*)(wsl + WS_ZR))
#define YP ((bf16*)(wsl + WS_R2))
#define HB ZR
#define G3 ZR
#define MG ((bf16*)(wsl + WS_MG))
#define O1 ((bf16*)(wsl + WS_R2))
#define O2 ((bf16*)(wsl + WS_R2) + (size_t)M * 512)
#define YRAW ((bf16*)(wsl + WS_YRAW))
#define BITM ((unsigned*)(wsl + WS_BITM))
#define RDOTK ((float*)(wsl + WS_RDOTK))
#define X1B ((bf16*)(wsl + WS_X1))
#define KID ((bf16*)(wsl + WS_KID))
#define A8B ((unsigned char*)(wsl + WS_A8))
#define CTL ((gu32*)(wsl + WS_CTL))
#define cscr ((LAS float*)(lds + wave * 16384))

#define CONV_FFN(l_, f_) do { const int gi_ = (f_) ? 29 : 3; \
        MapUp mu_{KIN(gi_) + (size_t)(l_) * DM * FF, KIN(gi_ + 1) + (size_t)(l_) * DM * FF, FF}; conv_matrix(mu_, DM, 2 * FF, WFu, cscr, gw, NGW, lane); \
        MapIdent md_{KIN(gi_ + 2) + (size_t)(l_) * FF * DM, DM}; conv_matrix(md_, FF, DM, WFd, cscr, gw, NGW, lane); } while (0)
#define CONV_MIX(l_) do { MapWin mw_{KIN(8) + (size_t)(l_) * DM * NIN, NIN}; conv_matrix(mw_, DM, 8704, WMi, cscr, gw, NGW, lane); \
        for (int n_ = 0; n_ < 3; ++n_) { MapIdent mb_{KIN(25) + ((size_t)(l_) * 3 + n_) * 512 * DM, DM}; conv_matrix(mb_, 512, DM, WMb + (size_t)n_ * DM * 512, cscr, gw, NGW, lane); } \
        MapIdent mo_{KIN(26) + (size_t)(l_) * DM * DM, DM}; conv_matrix(mo_, DM, DM, WMo, cscr, gw, NGW, lane); } while (0)

template <int L, int F> __device__ __forceinline__ void ffn_part(LAS unsigned char* lds) {
    constexpr int l = L, f = F, pb = 1 + PH_L * L, pf = pb + (F ? 11 : 0);
            if (IN(pf + 0)) { WSL();
                pg8::Gemm g{XN, WFu, M, 2 * FF, DM, DM}; pg8::StaticOrder S; S.init(M, 2 * FF, G, bid);
                pg8::EpiSwiGLU E{HB, FF};
                pg8::gemm_phase<pg8::EpiSwiGLU, pg8::StaticOrder, true, true>(lds, g, S, E);
                SEAM(pf + 0);
            }
            if (IN(pf + 1)) { WSL();
                pg8::Gemm g{HB, WFd, M, DM, FF, FF}; pg8::StaticOrder S; S.init(M, DM, G, bid);
                pg8::EpiStore<0> E{YP, DM, YP, DM, 1 << 30};
                pg8::gemm_phase<pg8::EpiStore<0>, pg8::StaticOrder, true, true>(lds, g, S, E);
                SEAM(pf + 1);
            }
            if (IN(pf + 2)) { WSL();
                const float* base = (l == 0 && f == 0) ? KIN(0) : XOUT;
                const float* gpost = KIN(f ? 28 : 2) + l * DM;
                const float* gnext = f == 0 ? KIN(6) + l * DM : (l + 1 < NLAYER ? KIN(1) + (l + 1) * DM : nullptr);
#if PROBE
                float osc = 1.f;
                if (l == NLAYER - 1 && f == 1) { const float num = *(const float*)(wsl + WS_CTL + 4 * CW_PROBE), den = *(const float*)(wsl + WS_CTL + 4 * (CW_PROBE + 1)); osc = 1.f + 4.f * sqrtf(num / fmaxf(den, 1e-30f)); }
                rownorm_rows(base, YP, 0.5f, gpost, XOUT, gnext, gnext ? XN : nullptr, gw, NGW, lane, osc);
#else
                rownorm_rows(base, YP, 0.5f, gpost, XOUT, gnext, gnext ? XN : nullptr, gw, NGW, lane);
#endif
                if (f == 1 && l + 1 < NLAYER) { CONV_FFN(l + 1, 0); CONV_MIX(l + 1); }
                SEAM(pf + 2);
            }
}
template <int L> __device__ __forceinline__ void mixer_part(LAS unsigned char* lds, unsigned char* lds_) {
    constexpr int l = L, pb = 1 + PH_L * L;
            const int pm = pb + 3;
            if (IN(pm + 0)) { WSL();
                pg8::Gemm g{XN, WMi, M, 5632, DM, DM}; pg8::StaticOrder S; S.init(M, 5632, G, bid);
                pg8::EpiStore<0> E{Q3, QP, ZR, ZP, 6};
                pg8::gemm_phase<pg8::EpiStore<0>, pg8::StaticOrder, true, true>(lds, g, S, E);
                SEAM(pm + 0);
            }
            if (IN(pm + 1)) { WSL();
                PrepP pp{ZR, X1B, A8B, KID, KIN(9) + l * 1792, KIN(10) + l * 512, KIN(11) + l * 64 * 512, KIN(12) + l * 512, KIN(13) + l * 64 * 512};
                rwkv_prep(pp, lds);
                SEAM(pm + 1);
            }
            if (IN(pm + 2)) { WSL();
                volatile LAS int* slot = (volatile LAS int*)(MISC + 16);
                if (bid < 64) {
                    ScanP sp{Q3, ZR, X1B, A8B, YRAW, RDOTK, KIN(9) + l * 1792, KIN(15) + l * 512, KIN(16) + l * 512, KIN(17) + l * 512};
#ifndef NO_SCAN
                    rwkv_scan_unit(sp, bid, lds);
#ifdef SCAN_TWICE
                    rwkv_scan_unit(sp, bid, lds);
#endif
#endif
                }
                {
                    Dsa1P dp{ZR, KID, BITM, CTL + CW_DONE + 64 * 64 * l};
                    gu32* head = CTL + CW_Q + 64 * (3 * l + 0);
                    #ifndef NO_DSA1
                    for (int u = q_fetch(head, slot); u < 512; u = q_fetch(head, slot)) dsa1_unit(dp, u, lds);
#ifdef DUP_DSA1
                    { gu32* head2 = CTL + 10240 + 64 * (2 * l + 0); for (int u = q_fetch(head2, slot); u < 512; u = q_fetch(head2, slot)) dsa1_unit(dp, u, lds); }
#endif
#endif
                }
                {
                    gu32* head = CTL + CW_Q + 64 * (3 * l + 1);
                    typedef att::BlockRef<att::bf16, att::bf16> Ref;
#define DSA2_REF(i_, r_) do { const int qb_ = 31 - ((i_) >> 3), b_ = ((i_) >> 2) & 1, h_ = (i_) & 3; const size_t row_ = (size_t)b_ * T + 256 * qb_; \
        r_.Q = (const att::bf16*)(Q3 + row_ * QP + 128 * h_); r_.O = (att::bf16*)(Q3 + row_ * QP + 128 * h_); r_.K = (const att::bf16*)(ZR + (size_t)b_ * T * ZP + ZC_DK + 128 * h_); \
        r_.V = (const att::bf16*)(ZR + (size_t)b_ * T * ZP + ZC_DV + 128 * h_); r_.P0 = 256 * qb_; r_.koff = 0; r_.mask = BITM + row_ * 256; } while (0)
                    int ic = q_fetch(head, slot);
                    if (ic < 256) {
                        int in_ = q_fetch(head, slot);
                        Ref cur; DSA2_REF(ic, cur);
                        att::Seam<att::bf16> S;
                        att::causal_swa_prime<att::bf16, att::bf16, false>(cur, T, (char*)lds_, S);
                        for (;;) {
                            const bool last = in_ >= 256;
                            Ref nxt = cur; if (!last) DSA2_REF(in_, nxt);
                            {
                                if (tid == 0) { gu32* dw = CTL + CW_DONE + 64 * (64 * l + (((ic >> 2) & 1) * 32 + (31 - (ic >> 3)))); unsigned sp = 0;
                                    while (__hip_atomic_load(dw, RLX_AGENT) < 8u) { __builtin_amdgcn_s_sleep(2); if (++sp > (1u << 24)) { __hip_atomic_store(CTL + CW_TMO, 1u, RLX_AGENT); break; } }
                                    __builtin_amdgcn_fence(__ATOMIC_ACQUIRE, "agent"); asm volatile("s_waitcnt vmcnt(0)" ::: "memory"); }
                                __syncthreads();
                            }
#ifndef NO_DSA2
                            att::causal_swa_block<att::bf16, att::bf16, false, true, QP>(cur, nxt, T, T, (char*)lds_, S);
#endif
                            if (last) break;
                            cur = nxt; ic = in_; in_ = q_fetch(head, slot);
                        }
                    }
                }
                {
#ifdef DUP_DIFF
                  for (int rep_ = 0; rep_ < 2; ++rep_) {
                    gu32* head = rep_ ? CTL + 10240 + 64 * (2 * l + 1) : CTL + CW_Q + 64 * (3 * l + 2);
#else
                  {
                    gu32* head = CTL + CW_Q + 64 * (3 * l + 2);
#endif
                    typedef att::BlockRef<att::bf16, att::bf16> Ref;
#define DIFF_REF(i_, r_) do { const int qb_ = 31 - ((i_) >> 4), b_ = ((i_) >> 3) & 1, h_ = ((i_) >> 1) & 3, mp_ = (i_) & 1; const size_t row_ = (size_t)b_ * T + 256 * qb_; \
        r_.Q = (const att::bf16*)(Q3 + row_ * QP + 1024 + 128 * h_ + 64 * mp_); r_.O = (att::bf16*)((mp_ ? O2 : O1) + row_ * 512 + 128 * h_); \
        r_.K = (const att::bf16*)(ZR + (size_t)b_ * T * ZP + ZC_FK + 128 * h_); r_.V = (const att::bf16*)(ZR + (size_t)b_ * T * ZP + ZC_FV + 128 * h_); r_.P0 = 256 * qb_; r_.koff = 128 * mp_; r_.mask = nullptr; } while (0)
                    int ic = q_fetch(head, slot);
                    if (ic < 512) {
                        int in_ = q_fetch(head, slot);
                        Ref cur; DIFF_REF(ic, cur);
                        att::Seam<att::bf16> S;
                        att::causal_swa_prime<att::bf16, att::bf16, true>(cur, T, (char*)lds_, S);
                        for (;;) {
                            const bool last = in_ >= 512;
                            Ref nxt = cur; if (!last) DIFF_REF(in_, nxt);
#ifndef NO_DIFF
                            att::causal_swa_block<att::bf16, att::bf16, true, false, 512>(cur, nxt, T, T, (char*)lds_, S);
#endif
                            if (last) break;
                            cur = nxt; ic = in_; in_ = q_fetch(head, slot);
                        }
                    }
                  }
                }
                SEAM(pm + 2);
            }
            if (IN(pm + 3)) { WSL();
                RPostP rp{ZR, Q3, YRAW, RDOTK, KIN(9) + l * 1792, KIN(14) + l * 128 * 512, KIN(18) + l * 512, KIN(19) + l * 512};
#ifndef NO_RPOST
                rwkv_post(rp, lds);
#endif
                constexpr float lambda_init = L == 0 ? 0.2f : 0.35550906759096927f;
                DPostP dq{O1, O2, Q3, KIN(20) + l * 64, KIN(21) + l * 64, KIN(22) + l * 64, KIN(23) + l * 64, KIN(24) + l * 128, lambda_init};
                diff_post(dq, gw, NGW, lane);
                rownorm_rows(XOUT, nullptr, 0.f, nullptr, nullptr, KIN(6) + l * DM, XN, gw, NGW, lane);
                SEAM(pm + 3);
            }
            if (IN(pm + 4)) { WSL();
                pg8::Gemm g{XN, WMi + (size_t)5632 * DM, M, 3072, DM, DM}; pg8::StaticOrder S; S.init(M, 3072, G, bid);
#ifdef GATE_RAW
                pg8::EpiStore<0> E{G3, 3072, G3, 3072, 1 << 30};
                pg8::gemm_phase<pg8::EpiStore<0>, pg8::StaticOrder, true, true>(lds, g, S, E);
#else
                pg8::EpiStore<1> E{G3, 3072, G3, 3072, 1 << 30};
                pg8::gemm_phase<pg8::EpiStore<1>, pg8::StaticOrder, true, true>(lds, g, S, E);
#endif
                SEAM(pm + 4);
            }
            if (IN(pm + 5)) { WSL();
#pragma unroll 1
                for (int n = 0; n < 3; ++n) {
                    pg8::Gemm g{Q3 + 512 * n, WMb + (size_t)n * DM * 512, M, DM, 512, QP}; pg8::StaticOrder S; S.init(M, DM, G, bid);
                    pg8::EpiGateMul E{MG, DM, G3 + 1024 * n, 3072, n == 0 ? 1 : 0};
                    pg8::gemm_phase<pg8::EpiGateMul, pg8::StaticOrder, false, true>(lds, g, S, E);
                    VM_WAIT(); __syncthreads();
                }
                SEAM(pm + 5);
            }
            if (IN(pm + 6)) { WSL();
                pg8::Gemm g{MG, WMo, M, DM, DM, DM}; pg8::StaticOrder S; S.init(M, DM, G, bid);
                pg8::EpiStore<0> E{YP, DM, YP, DM, 1 << 30};
                pg8::gemm_phase<pg8::EpiStore<0>, pg8::StaticOrder, false, true>(lds, g, S, E);
                SEAM(pm + 6);
            }
            if (IN(pm + 7)) { WSL();
                rownorm_rows(XOUT, YP, 1.0f, KIN(7) + l * DM, XOUT, KIN(27) + l * DM, XN, gw, NGW, lane);
                CONV_FFN(l, 1);
                SEAM(pm + 7);
            }
}

__global__ void __launch_bounds__(NWAVES * 64, 2) mk_fwd(Args args) {
    extern __shared__ __attribute__((aligned(16))) unsigned char lds_[];
    LAS unsigned char* lds = (LAS unsigned char*)lds_;
    { const int tid = otid_(); if (tid < 64) MISC[tid] = 0u; }
    __syncthreads();
    (void)xcd_barrier_post((unsigned*)(kws_() + WS_CTL) + CW_BAR, MISC + 8);
    if (IN(0)) { WSL();
        CONV_FFN(0, 0); CONV_MIX(0);
        rownorm_rows(KIN(0), nullptr, 0.f, nullptr, nullptr, KIN(1), XN, gw, NGW, lane);
        SEAM(0);
    }
    ffn_part<0, 0>(lds); mixer_part<0>(lds, lds_); ffn_part<0, 1>(lds);
    ffn_part<1, 0>(lds); mixer_part<1>(lds, lds_); ffn_part<1, 1>(lds);
}

#if PROBE
__device__ __forceinline__ void probe_acc(float num, float den, float* ctlf) {
    __shared__ float rn[256], rd[256];
    rn[threadIdx.x] = num; rd[threadIdx.x] = den; __syncthreads();
    for (int o = 128; o > 0; o >>= 1) { if ((int)threadIdx.x < o) { rn[threadIdx.x] += rn[threadIdx.x + o]; rd[threadIdx.x] += rd[threadIdx.x + o]; } __syncthreads(); }
    if (threadIdx.x == 0) { atomicAdd(ctlf + CW_PROBE, rn[0]); atomicAdd(ctlf + CW_PROBE + 1, rd[0]); }
}
__global__ void __launch_bounds__(256) probe_ffn(const unsigned char* ws, const float* Wg, const float* Wu, const float* Wd) {
    __shared__ float xn[1024]; __shared__ float hid[2816];
    const int m = 777 + 1931 * blockIdx.x, tid = threadIdx.x;
    const bf16* XNp = (const bf16*)(ws + WS_XN); const bf16* YPp = (const bf16*)(ws + WS_R2);
    for (int k = tid; k < 1024; k += 256) xn[k] = bf1(XNp[(size_t)m * 1024 + k]);
    __syncthreads();
    for (int j = tid; j < 2816; j += 256) { float g = 0.f, u = 0.f; for (int k = 0; k < 1024; ++k) { g += xn[k] * Wg[(size_t)k * 2816 + j]; u += xn[k] * Wu[(size_t)k * 2816 + j]; } hid[j] = g / (1.f + expf(-g)) * u; }
    __syncthreads();
    float num = 0.f, den = 0.f;
    for (int d = tid; d < 1024; d += 256) { float o = 0.f; for (int j = 0; j < 2816; ++j) o += hid[j] * Wd[(size_t)j * 1024 + d]; const float got = bf1(YPp[(size_t)m * 1024 + d]); num += (o - got) * (o - got); den += o * o; }
    probe_acc(num, den, (float*)(ws + WS_CTL));
}
__global__ void __launch_bounds__(256) probe_win(const unsigned char* ws, const float* Win) {
    __shared__ float xn[1024];
    const int m = 555 + 1999 * blockIdx.x, tid = threadIdx.x;
    const bf16* XNp = (const bf16*)(ws + WS_XN); const bf16* Q3p = (const bf16*)(ws + WS_Q3); const bf16* ZRp = (const bf16*)(ws + WS_ZR);
    for (int k = tid; k < 1024; k += 256) xn[k] = bf1(XNp[(size_t)m * 1024 + k]);
    __syncthreads();
    float num = 0.f, den = 0.f;
    for (int c = tid; c < 5448; c += 256) {
        float z = 0.f; for (int k = 0; k < 1024; ++k) z += xn[k] * Win[(size_t)k * NIN + c];
        float got;
        if (c < 512) got = bf1(Q3p[(size_t)m * QP + c]);
        else if (c < 2120) got = bf1(ZRp[(size_t)m * ZP + (c - 512)]);
        else if (c < 2632) got = bf1(Q3p[(size_t)m * QP + 512 + (c - 2120)]);
        else if (c < 3912) got = bf1(ZRp[(size_t)m * ZP + (c - 840)]);
        else if (c < 4424) got = bf1(Q3p[(size_t)m * QP + 1024 + (c - 3912)]);
        else got = bf1(ZRp[(size_t)m * ZP + (c - 1352)]);
        num += (z - got) * (z - got); den += z * z;
    }
    probe_acc(num, den, (float*)(ws + WS_CTL));
}
__global__ void __launch_bounds__(256) probe_wconv(const unsigned char* ws, const float* Win, int r0) {
    const bf16* WMp = (const bf16*)(ws + WS_WM); const int tid = threadIdx.x;
    float num = 0.f, den = 0.f;
    for (int rr = 0; rr < 64; ++rr) { const int n = r0 + 64 * blockIdx.x + rr; MapWin mw{Win, NIN}; const float* cp = mw.col(n);
        for (int k = tid; k < 1024; k += 256) { const float ref = cp ? cp[(size_t)k * NIN] : 0.f; const float got = bf1(WMp[(size_t)n * 1024 + k]); num += (ref - got) * (ref - got); den += ref * ref; } }
    probe_acc(num, den, (float*)(ws + WS_CTL));
}
__global__ void __launch_bounds__(256) probe_merge(const unsigned char* ws, const float* Win, const float* Wb, const float* Wo, int which) {
    __shared__ float xn[1024]; __shared__ float y[1536]; __shared__ float mg[1024];
    const int m = 333 + 2003 * blockIdx.x, tid = threadIdx.x;
    const bf16* XNp = (const bf16*)(ws + WS_XN); const bf16* Q3p = (const bf16*)(ws + WS_Q3); const bf16* MGp = (const bf16*)(ws + WS_MG); const bf16* YPp = (const bf16*)(ws + WS_R2);
    for (int k = tid; k < 1024; k += 256) xn[k] = bf1(XNp[(size_t)m * 1024 + k]);
    for (int k = tid; k < 1536; k += 256) y[k] = bf1(Q3p[(size_t)m * QP + k]);
    __syncthreads();
    float num = 0.f, den = 0.f;
    for (int d = tid; d < 1024; d += 256) {
        float acc = 0.f;
        for (int n = 0; n < 3; ++n) { float g = 0.f; for (int k = 0; k < 1024; ++k) g += xn[k] * Win[(size_t)k * NIN + 5448 + n * 1024 + d];
            float p = 0.f; for (int c = 0; c < 512; ++c) p += y[512 * n + c] * Wb[((size_t)n * 512 + c) * 1024 + d];
            acc += p / (1.f + expf(-g)); }
        mg[d] = acc; const float got = bf1(MGp[(size_t)m * 1024 + d]); if (which == 0) { num += (acc - got) * (acc - got); den += acc * acc; }
        if (which == 2) { const bf16* G3p = (const bf16*)(ws + WS_ZR); for (int n = 0; n < 3; ++n) { float g = 0.f; for (int k = 0; k < 1024; ++k) g += xn[k] * Win[(size_t)k * NIN + 5448 + n * 1024 + d];
            const float sg = 1.f / (1.f + expf(-g)), gg = bf1(G3p[(size_t)m * 3072 + n * 1024 + d]); num += (sg - gg) * (sg - gg); den += sg * sg; } }
        if (which == 3) { const bf16* G3p = (const bf16*)(ws + WS_ZR); float a2 = 0.f; for (int n = 0; n < 3; ++n) { float p = 0.f; for (int c = 0; c < 512; ++c) p += y[512 * n + c] * Wb[((size_t)n * 512 + c) * 1024 + d];
            a2 += p * bf1(G3p[(size_t)m * 3072 + n * 1024 + d]); } num += (a2 - got) * (a2 - got); den += a2 * a2; }
    }
    __syncthreads();
    if (which == 1) for (int d = tid; d < 1024; d += 256) { float o = 0.f; for (int j = 0; j < 1024; ++j) o += mg[j] * Wo[(size_t)j * 1024 + d]; const float got = bf1(YPp[(size_t)m * 1024 + d]); num += (o - got) * (o - got); den += o * o; }
    probe_acc(num, den, (float*)(ws + WS_CTL));
}
#endif
#ifndef MK_ONE_LAUNCH
#define MK_ONE_LAUNCH 0
#endif
extern "C" void kernel_launch(void* const* d_in, const int* in_sizes, int n_in, void* d_out, int out_size, void* d_ws, size_t ws_size, hipStream_t stream) {
    static int grid = 0;
    if (grid == 0) {
        if (n_in != 32 || in_sizes[0] != M * DM || out_size != M * DM || ws_size < WS_END) { fprintf(stderr, "kernel_launch: unexpected shapes / workspace (n_in %d, ws %zu)\n", n_in, ws_size); grid = -1; return; }
        int dev = 0, cus = 0;
        if (hipGetDevice(&dev) != hipSuccess || hipDeviceGetAttribute(&cus, hipDeviceAttributeMultiprocessorCount, dev) != hipSuccess) { grid = -1; return; }
        if (hipFuncSetAttribute((const void*)mk_fwd, hipFuncAttributeMaxDynamicSharedMemorySize, LDS_BYTES) != hipSuccess) { fprintf(stderr, "kernel_launch: hipFuncSetAttribute failed\n"); grid = -1; return; }
        int per_cu = 0;
        if (hipOccupancyMaxActiveBlocksPerMultiprocessor(&per_cu, (const void*)mk_fwd, NWAVES * 64, LDS_BYTES) != hipSuccess || per_cu < 1) { fprintf(stderr, "kernel_launch: occupancy query says %d\n", per_cu); }
        (void)hipGetLastError();
        grid = cus;
    }
    if (grid < 0) return;
    (void)hipMemsetAsync((char*)d_ws + WS_CTL, 0, CTL_ZERO_BYTES, stream);
    Args a{};
    for (int i = 0; i < 32; ++i) a.in[i] = (const float*)d_in[i];
    a.out = (float*)d_out; a.ws = (unsigned char*)d_ws;
#if MK_ONE_LAUNCH
    a.ph_lo = 0; a.ph_hi = N_PHASES;
    hipLaunchKernelGGL(mk_fwd, dim3(grid), dim3(NWAVES * 64), LDS_BYTES, stream, a);
#else
    for (int p = 0; p < N_PHASES; ++p) { a.ph_lo = p; a.ph_hi = p + 1; hipLaunchKernelGGL(mk_fwd, dim3(grid), dim3(NWAVES * 64), LDS_BYTES, stream, a);
#if PROBE == 1
        if (p == 2) hipLaunchKernelGGL(probe_ffn, dim3(8), dim3(256), 0, stream, (const unsigned char*)d_ws, a.in[3], a.in[4], a.in[5]);
#elif PROBE == 2
        if (p == 4) hipLaunchKernelGGL(probe_win, dim3(8), dim3(256), 0, stream, (const unsigned char*)d_ws, a.in[8]);
#elif PROBE == 3
        if (p == 8) hipLaunchKernelGGL(probe_merge, dim3(8), dim3(256), 0, stream, (const unsigned char*)d_ws, a.in[8], a.in[25], a.in[26], 0);
#elif PROBE == 5
        if (p == 8) hipLaunchKernelGGL(probe_merge, dim3(8), dim3(256), 0, stream, (const unsigned char*)d_ws, a.in[8], a.in[25], a.in[26], 2);
#elif PROBE == 6
        if (p == 8) hipLaunchKernelGGL(probe_merge, dim3(8), dim3(256), 0, stream, (const unsigned char*)d_ws, a.in[8], a.in[25], a.in[26], 3);
#elif PROBE == 7
        if (p == 6) hipLaunchKernelGGL(probe_wconv, dim3(48), dim3(256), 0, stream, (const unsigned char*)d_ws, a.in[8], 5632);
#elif PROBE == 8
        if (p == 3) hipLaunchKernelGGL(probe_wconv, dim3(48), dim3(256), 0, stream, (const unsigned char*)d_ws, a.in[8], 5632);
#elif PROBE == 9
        if (p == 7) hipLaunchKernelGGL(probe_merge, dim3(8), dim3(256), 0, stream, (const unsigned char*)d_ws, a.in[8], a.in[25], a.in[26], 2);
#elif PROBE == 4
        if (p == 9) hipLaunchKernelGGL(probe_merge, dim3(8), dim3(256), 0, stream, (const unsigned char*)d_ws, a.in[8], a.in[25], a.in[26], 1);
#endif
    }
#endif
}
```

```cpp
#include <hip/hip_runtime.h>
#include <hip/hip_bf16.h>
#include <cstdio>
#include <cstdint>
#define MK_ONE_LAUNCH 1
#define GATE_RAW 1

__device__ __forceinline__ int otid_() { int t = (int)threadIdx.x; asm volatile("" : "+v"(t)); return t; }
namespace pg8 {
#define PG8_LAS __attribute__((address_space(3)))
typedef unsigned short bf16_t;
typedef short bf16x8 __attribute__((ext_vector_type(8)));
typedef float f32x4 __attribute__((ext_vector_type(4)));
typedef unsigned u32x4 __attribute__((ext_vector_type(4)));
constexpr int BM = 256, BK = 64, HALF = 128, HTB = HALF * BK * 2  , STAGE_BYTES = 8 * HTB, NXCD = 8, WGM = 8;

__host__ __device__ __forceinline__ int lds_byte(int r, int c) { const int st = (r >> 4) * 2 + (c >> 5), rr = r & 15, cc = c & 31, ob = rr * 64 + cc * 2; return st * 1024 + (ob ^ (((ob >> 9) & 1) << 5)); }
__host__ __device__ __forceinline__ void stage_rc(int b, int& R, int& C) { const int st = b / 1024, sb = b % 1024, swz = sb ^ (((sb >> 9) & 1) << 5); R = (st >> 1) * 16 + swz / 64; C = (st & 1) * 32 + (swz % 64) / 2; }
__host__ __device__ __forceinline__ int perm32(int rho) { const int n = rho >> 4, i = rho & 15; return 8 * (i >> 2) + 4 * n + (i & 3); }

struct Unit { int pm, pn; };
struct Gemm { const bf16_t* A; const bf16_t* Bt; int M, N, K, lda; };

struct StaticOrder {
    int nM, nN, nwg, G, c;
    __host__ __device__ void init(int M, int N, int G_, int c_) { nM = M / BM; nN = N / BM; nwg = nM * nN; G = G_; c = c_; }
    __host__ __device__ bool next(int i, Unit& u) const {
        const long L = (long)i * G + c; if (L >= nwg) return false;
        int wgid = (int)L; { const int q = nwg / NXCD, r = nwg % NXCD, xcd = wgid % NXCD, off = wgid / NXCD; wgid = (xcd < r ? xcd * (q + 1) : r * (q + 1) + (xcd - r) * q) + off; }
        const int nig = WGM * nN, gid = wgid / nig, fm = gid * WGM, gsz = (nM - fm) < WGM ? (nM - fm) : WGM;
        u.pm = fm + ((wgid % nig) % gsz); u.pn = (wgid % nig) / gsz; return true;
    }
    __device__ __forceinline__ void a_ready(const Unit&) const {}
    __device__ __forceinline__ void done(const Unit&) const {}
};

__device__ __forceinline__ unsigned cvt_pk_bf16(float lo, float hi) { unsigned r; asm volatile("v_cvt_pk_bf16_f32 %0, %1, %2" : "=v"(r) : "v"(lo), "v"(hi)); return r; }

template <class Epi, class Sched, bool ALIGN_EPI = false, bool SP2 = false>
__device__ __forceinline__ void gemm_phase(PG8_LAS unsigned char* lds, const Gemm g, const Sched& S, const Epi& E) {
    const int tid = otid_(), wid = __builtin_amdgcn_readfirstlane(tid >> 6), lane = tid & 63, wr = wid >> 2, wc = wid & 3, fr = lane & 15, fq = lane >> 4;
    const int K = g.K, nt = K / BK;
    unsigned voffA[2], voffB[2];
#pragma unroll
    for (int i = 0; i < 2; ++i) { int R, C; stage_rc(tid * 16 + i * 8192, R, C); const int Rb = Epi::PERM ? ((R & ~31) + perm32(R & 31)) : R;
        voffA[i] = (unsigned)(R * g.lda + C) * 2u; voffB[i] = (unsigned)(Rb * K + C) * 2u; }
    const size_t kstep = (size_t)(BK * 2);
    const size_t hstepB = (size_t)HALF * K * 2, hstepA = (size_t)HALF * g.lda * 2;
    const size_t tstepB = 2 * hstepB, tstepA = 2 * hstepA;
    const unsigned ldsw = (unsigned)wid * 1024u;
    const int aoff = lds_byte(wr * 64 + fr, fq * 8), boff = lds_byte(wc * 32 + fr, fq * 8);
#define PG8_SA(b, h) (((b) * 2 + (h)) * HTB)
#define PG8_SB(b, h) ((4 + (b) * 2 + (h)) * HTB)
#define PG8_STAGE(bufoff, gbase, voff) do { _Pragma("unroll") for (int _i = 0; _i < 2; ++_i) \
        __builtin_amdgcn_global_load_lds((const unsigned*)((const char*)(gbase) + (voff)[_i]), (PG8_LAS unsigned*)(lds + (bufoff) + ldsw + _i * 8192), 16, 0, 0); } while (0)
#define PG8_LDA(dst, b, h) do { _Pragma("unroll") for (int m = 0; m < 4; ++m) _Pragma("unroll") for (int k = 0; k < 2; ++k) dst[m][k] = *(const PG8_LAS bf16x8*)(lds + PG8_SA(b, h) + aoff + m * 2048 + k * 1024); } while (0)
#define PG8_LDB(dst, b, h) do { _Pragma("unroll") for (int n = 0; n < 2; ++n) _Pragma("unroll") for (int k = 0; k < 2; ++k) dst[n][k] = *(const PG8_LAS bf16x8*)(lds + PG8_SB(b, h) + boff + n * 2048 + k * 1024); } while (0)
#define PG8_MMA(ai, bj, At, Bt) do { __builtin_amdgcn_s_setprio(1); _Pragma("unroll") for (int m = 0; m < 4; ++m) _Pragma("unroll") for (int n = 0; n < 2; ++n) _Pragma("unroll") for (int k = 0; k < 2; ++k) \
        acc[ai][bj][m][n] = __builtin_amdgcn_mfma_f32_16x16x32_bf16(Bt[n][k], At[m][k], acc[ai][bj][m][n], 0, 0, 0); __builtin_amdgcn_s_setprio(0); } while (0)
#define PG8_WAIT_V(n) asm volatile("s_waitcnt vmcnt(" #n ")" ::: "memory")
#define PG8_WAIT_L(n) asm volatile("s_waitcnt lgkmcnt(" #n ")" ::: "memory")
#define PG8_BAR __builtin_amdgcn_s_barrier()
#define PG8_SCHED __builtin_amdgcn_sched_barrier(0)
    Unit cur, nxt; int ui = 0;
    if (!S.next(0, cur)) return;
    f32x4 acc[2][2][4][2];
#pragma unroll
    for (int a = 0; a < 2; ++a)
#pragma unroll
        for (int b = 0; b < 2; ++b)
#pragma unroll
            for (int m = 0; m < 4; ++m)
#pragma unroll
                for (int n = 0; n < 2; ++n) acc[a][b][m][n] = (f32x4){0.f, 0.f, 0.f, 0.f};
    bf16x8 At[4][2], B0[2][2], B1[2][2];
    const char* cA = (const char*)g.A + (size_t)cur.pm * tstepA; const char* cB = (const char*)g.Bt + (size_t)cur.pn * tstepB;
    S.a_ready(cur);
    if constexpr (SP2) {
        PG8_STAGE(PG8_SB(0, 0), cB, voffB); PG8_STAGE(PG8_SB(0, 1), cB + hstepB, voffB); PG8_STAGE(PG8_SA(0, 0), cA, voffA); PG8_STAGE(PG8_SA(0, 1), cA + hstepA, voffA);
        if (wr == 1) PG8_BAR;
        PG8_WAIT_V(2); PG8_BAR;
        PG8_STAGE(PG8_SB(1, 0), cB + kstep, voffB); PG8_STAGE(PG8_SA(1, 0), cA + kstep, voffA); PG8_STAGE(PG8_SB(1, 1), cB + hstepB + kstep, voffB);
        PG8_WAIT_V(6); PG8_BAR;
    } else {
        PG8_STAGE(PG8_SB(0, 0), cB, voffB); PG8_STAGE(PG8_SA(0, 0), cA, voffA); PG8_STAGE(PG8_SB(0, 1), cB + hstepB, voffB); PG8_STAGE(PG8_SA(0, 1), cA + hstepA, voffA);
        if (wr == 1) PG8_BAR;
        PG8_WAIT_V(4); PG8_BAR;
        PG8_STAGE(PG8_SB(1, 0), cB + kstep, voffB); PG8_STAGE(PG8_SA(1, 0), cA + kstep, voffA); PG8_STAGE(PG8_SB(1, 1), cB + hstepB + kstep, voffB);
        PG8_WAIT_V(6); PG8_BAR;
    }
    for (;;) {
        const bool has_next = S.next(ui + 1, nxt);
        const char* nA = has_next ? (const char*)g.A + (size_t)nxt.pm * tstepA : cA; const char* nB = has_next ? (const char*)g.Bt + (size_t)nxt.pn * tstepB : cB;
        for (int t = 0; t < nt; t += 2) {
            const bool last = (t == nt - 2);
            const char* a1 = cA + (size_t)(t + 1) * kstep;
            const char* a2 = last ? nA : cA + (size_t)(t + 2) * kstep; const char* b2 = last ? nB : cB + (size_t)(t + 2) * kstep;
            const char* a3 = a2 + kstep; const char* b3 = b2 + kstep;
            if (last && has_next) S.a_ready(nxt);
            if constexpr (SP2) {
            PG8_LDB(B0, 0, 0); PG8_LDB(B1, 0, 1); PG8_SCHED; PG8_LDA(At, 0, 0); PG8_STAGE(PG8_SA(1, 1), a1 + hstepA, voffA);
            PG8_WAIT_V(8); PG8_WAIT_L(0); PG8_BAR; PG8_MMA(0, 0, At, B0); PG8_MMA(0, 1, At, B1); PG8_BAR; PG8_SCHED;
            PG8_LDA(At, 0, 1); PG8_STAGE(PG8_SB(0, 0), b2, voffB); PG8_STAGE(PG8_SB(0, 1), b2 + hstepB, voffB); PG8_STAGE(PG8_SA(0, 0), a2, voffA);
            PG8_WAIT_V(8); PG8_WAIT_L(0); PG8_BAR; PG8_MMA(1, 0, At, B0); PG8_MMA(1, 1, At, B1); PG8_BAR; PG8_SCHED;
            PG8_LDB(B0, 1, 0); PG8_LDB(B1, 1, 1); PG8_SCHED; PG8_LDA(At, 1, 0); PG8_STAGE(PG8_SA(0, 1), a2 + hstepA, voffA);
            PG8_WAIT_V(8); PG8_WAIT_L(0); PG8_BAR; PG8_MMA(0, 0, At, B0); PG8_MMA(0, 1, At, B1); PG8_BAR; PG8_SCHED;
            PG8_LDA(At, 1, 1); PG8_STAGE(PG8_SB(1, 0), b3, voffB); PG8_STAGE(PG8_SB(1, 1), b3 + hstepB, voffB); PG8_STAGE(PG8_SA(1, 0), a3, voffA);
            PG8_WAIT_V(8); PG8_WAIT_L(0); PG8_BAR; PG8_MMA(1, 0, At, B0); PG8_MMA(1, 1, At, B1); PG8_BAR; PG8_SCHED;
            } else {
            PG8_LDB(B0, 0, 0); PG8_SCHED; PG8_LDA(At, 0, 0); PG8_STAGE(PG8_SA(1, 1), a1 + hstepA, voffA);
            PG8_WAIT_L(8); PG8_BAR; PG8_WAIT_L(0); PG8_MMA(0, 0, At, B0); PG8_BAR; PG8_SCHED;
            PG8_LDB(B1, 0, 1); PG8_STAGE(PG8_SB(0, 0), b2, voffB);
            PG8_BAR; PG8_WAIT_L(0); PG8_MMA(0, 1, At, B1); PG8_BAR;
            PG8_LDA(At, 0, 1); PG8_STAGE(PG8_SA(0, 0), a2, voffA);
            PG8_BAR; PG8_WAIT_L(0); PG8_MMA(1, 0, At, B0); PG8_BAR; PG8_SCHED;
            PG8_STAGE(PG8_SB(0, 1), b2 + hstepB, voffB);
            PG8_WAIT_V(6); PG8_BAR; PG8_MMA(1, 1, At, B1); PG8_BAR;
            PG8_LDB(B0, 1, 0); PG8_SCHED; PG8_LDA(At, 1, 0); PG8_STAGE(PG8_SA(0, 1), a2 + hstepA, voffA);
            PG8_WAIT_L(8); PG8_BAR; PG8_WAIT_L(0); PG8_MMA(0, 0, At, B0); PG8_BAR; PG8_SCHED;
            PG8_LDB(B1, 1, 1); PG8_STAGE(PG8_SB(1, 0), b3, voffB);
            PG8_BAR; PG8_WAIT_L(0); PG8_MMA(0, 1, At, B1); PG8_BAR;
            PG8_LDA(At, 1, 1); PG8_STAGE(PG8_SA(1, 0), a3, voffA);
            PG8_BAR; PG8_WAIT_L(0); PG8_MMA(1, 0, At, B0); PG8_BAR; PG8_SCHED;
            PG8_STAGE(PG8_SB(1, 1), b3 + hstepB, voffB);
            PG8_WAIT_V(6); PG8_BAR; PG8_MMA(1, 1, At, B1); PG8_BAR;
            }
        }
        if constexpr (ALIGN_EPI) { if (wr == 0) PG8_BAR; }
        if constexpr (!Epi::AFTER_DRAIN) { E(acc, cur, wr, wc, fr, fq); S.done(cur); }
        if (!has_next) break;
#pragma unroll
        for (int a = 0; a < 2; ++a)
#pragma unroll
            for (int b = 0; b < 2; ++b)
#pragma unroll
                for (int m = 0; m < 4; ++m)
#pragma unroll
                    for (int n = 0; n < 2; ++n) acc[a][b][m][n] = (f32x4){0.f, 0.f, 0.f, 0.f};
        cur = nxt; cA = nA; cB = nB; ++ui;
        if constexpr (ALIGN_EPI) { if (wr == 1) PG8_BAR; }
    }
    PG8_WAIT_V(0);
    if constexpr (!ALIGN_EPI) { if (wr == 0) PG8_BAR; }
    PG8_BAR;
    if constexpr (Epi::AFTER_DRAIN) { E.fused(acc, cur, wr, wc, fr, fq, lds, wid, lane); S.done(cur); }
#undef PG8_SA
#undef PG8_SB
#undef PG8_STAGE
#undef PG8_LDA
#undef PG8_LDB
#undef PG8_MMA
#undef PG8_WAIT_V
#undef PG8_WAIT_L
#undef PG8_BAR
#undef PG8_SCHED
}
}
namespace pg8 {
typedef unsigned u32x2 __attribute__((ext_vector_type(2)));
__device__ __forceinline__ float bf_lo(unsigned w) { return __uint_as_float(w << 16); }
__device__ __forceinline__ float bf_hi(unsigned w) { return __uint_as_float(w & 0xffff0000u); }
__device__ __forceinline__ float sigmoidf_(float x) { return __builtin_amdgcn_rcpf(1.0f + __expf(-x)); }

struct EpiSwiGLU {
    static constexpr bool PERM = false, AFTER_DRAIN = false;
    bf16_t* H; int ldh;
    __device__ __forceinline__ void operator()(const f32x4 (&acc)[2][2][4][2], const Unit& u, int wr, int wc, int fr, int fq) const {
        const int row0 = u.pm * BM + wr * 64 + fr, hc0 = u.pn * 128 + wc * 16 + 4 * fq;
#pragma unroll
        for (int ai = 0; ai < 2; ++ai)
#pragma unroll
            for (int m = 0; m < 4; ++m) { bf16_t* rowp = H + (size_t)(row0 + ai * HALF + m * 16) * ldh + hc0;
#pragma unroll
                for (int bj = 0; bj < 2; ++bj) { const f32x4 g = acc[ai][bj][m][0], up = acc[ai][bj][m][1]; float h[4];
#pragma unroll
                    for (int e = 0; e < 4; ++e) h[e] = g[e] * sigmoidf_(g[e]) * up[e];
                    u32x2 w; w.x = cvt_pk_bf16(h[0], h[1]); w.y = cvt_pk_bf16(h[2], h[3]);
                    *(u32x2*)(rowp + bj * 64) = w; } }
    }
};
template <int ACT> struct EpiStore {
    static constexpr bool PERM = true, AFTER_DRAIN = false;
    bf16_t* O0; int ld0; bf16_t* O1; int ld1; int split_tiles;
    __device__ __forceinline__ void operator()(const f32x4 (&acc)[2][2][4][2], const Unit& u, int wr, int wc, int fr, int fq) const {
        const int row0 = u.pm * BM + wr * 64 + fr;
        bf16_t* base; int ld, colt;
        if (u.pn < split_tiles) { base = O0; ld = ld0; colt = u.pn * BM; } else { base = O1; ld = ld1; colt = (u.pn - split_tiles) * BM; }
        const int col0 = colt + wc * 32 + 8 * fq;
#pragma unroll
        for (int ai = 0; ai < 2; ++ai)
#pragma unroll
            for (int m = 0; m < 4; ++m) { bf16_t* rowp = base + (size_t)(row0 + ai * HALF + m * 16) * ld + col0;
#pragma unroll
                for (int bj = 0; bj < 2; ++bj) { f32x4 v0 = acc[ai][bj][m][0], v1 = acc[ai][bj][m][1];
                    if (ACT == 1) {
#pragma unroll
                        for (int e = 0; e < 4; ++e) { v0[e] = sigmoidf_(v0[e]); v1[e] = sigmoidf_(v1[e]); } }
                    u32x4 w; w.x = cvt_pk_bf16(v0[0], v0[1]); w.y = cvt_pk_bf16(v0[2], v0[3]); w.z = cvt_pk_bf16(v1[0], v1[1]); w.w = cvt_pk_bf16(v1[2], v1[3]);
                    *(u32x4*)(rowp + bj * HALF) = w; } }
    }
};
#ifdef GATE_RAW
#define GSIG(x) sigmoidf_(x)
#else
#define GSIG(x) (x)
#endif
struct EpiGateMul {
    static constexpr bool PERM = true, AFTER_DRAIN = false;
    bf16_t* MG; int ldm; const bf16_t* G; int ldg; int first;
    __device__ __forceinline__ void operator()(const f32x4 (&acc)[2][2][4][2], const Unit& u, int wr, int wc, int fr, int fq) const {
        const int row0 = u.pm * BM + wr * 64 + fr, col0 = u.pn * BM + wc * 32 + 8 * fq;
#pragma unroll
        for (int ai = 0; ai < 2; ++ai)
#pragma unroll
            for (int m = 0; m < 4; ++m) { const size_t r = (size_t)(row0 + ai * HALF + m * 16);
#pragma unroll
                for (int bj = 0; bj < 2; ++bj) { const f32x4 v0 = acc[ai][bj][m][0], v1 = acc[ai][bj][m][1];
                    const u32x4 g = *(const u32x4*)(G + r * ldg + col0 + bj * HALF);
                    float o[8] = { v0[0] * GSIG(bf_lo(g.x)), v0[1] * GSIG(bf_hi(g.x)), v0[2] * GSIG(bf_lo(g.y)), v0[3] * GSIG(bf_hi(g.y)), v1[0] * GSIG(bf_lo(g.z)), v1[1] * GSIG(bf_hi(g.z)), v1[2] * GSIG(bf_lo(g.w)), v1[3] * GSIG(bf_hi(g.w)) };
                    bf16_t* mp = MG + r * ldm + col0 + bj * HALF;
                    if (!first) { const u32x4 p = *(const u32x4*)mp;
                        o[0] += bf_lo(p.x); o[1] += bf_hi(p.x); o[2] += bf_lo(p.y); o[3] += bf_hi(p.y); o[4] += bf_lo(p.z); o[5] += bf_hi(p.z); o[6] += bf_lo(p.w); o[7] += bf_hi(p.w); }
                    u32x4 w; w.x = cvt_pk_bf16(o[0], o[1]); w.y = cvt_pk_bf16(o[2], o[3]); w.z = cvt_pk_bf16(o[4], o[5]); w.w = cvt_pk_bf16(o[6], o[7]);
                    *(u32x4*)mp = w; } }
    }
};
}
namespace att {
constexpr int D = 128;
constexpr bool WSKIP = false;
constexpr float THR = 8.f;
constexpr int NW = 8, QBLK = 32, KVBLK = 64, QB = NW * QBLK;
constexpr int SHM_V = KVBLK * D * 2, SHM_K = KVBLK * D * 2;
constexpr int LDS_BYTES = 2 * SHM_V + 2 * SHM_K + NW * 64 * 4;
using bf16 = __hip_bfloat16;
typedef short bf16x8 __attribute__((ext_vector_type(8)));
typedef short s16x4 __attribute__((ext_vector_type(4)));
typedef float f32x16 __attribute__((ext_vector_type(16)));
typedef float f32x4 __attribute__((ext_vector_type(4)));
typedef unsigned u32x4 __attribute__((ext_vector_type(4)));
template <class A, class Bt> struct same_t { static constexpr bool v = false; };
template <class A> struct same_t<A, A> { static constexpr bool v = true; };

#define KSWZ(row, colB) ((row) * 256 + ((colB) ^ (((row) & 7) << 4)))
#define SBAR() __builtin_amdgcn_sched_barrier(0)
__device__ __forceinline__ int v_st(int k, int c) { const int kk = (k & ~0xC) | ((k & 4) << 1) | ((k & 8) >> 1); return ((kk >> 3) * 4 + (c >> 5)) * 512 + ((kk & 7) * 32 + (c & 31)) * 2; }
__device__ __forceinline__ int v_rd_base(int lane) { return ((lane & 3) << 3) | (((lane >> 2) & 3) << 6) | (((lane >> 4) & 1) << 5) | (((lane >> 5) & 1) << 8); }
constexpr int v_rd_off(int d0, int ks, int half) { return d0 * 512 + ks * 4096 + half * 2048; }
__device__ __forceinline__ int crow(int r, int hi) { return (r & 3) + 8 * (r >> 2) + 4 * hi; }
__device__ __forceinline__ unsigned cvtpk(float lo, float hi) {
    unsigned r; asm volatile("v_cvt_pk_bf16_f32 %0, %1, %2" : "=v"(r) : "v"(lo), "v"(hi)); return r;
}
__device__ __forceinline__ bf16x8 pack8(f32x4 a, f32x4 b) {
    u32x4 w = {cvtpk(a[0], a[1]), cvtpk(a[2], a[3]), cvtpk(b[0], b[1]), cvtpk(b[2], b[3])};
    return *reinterpret_cast<bf16x8*>(&w);
}
template <class T> __device__ __forceinline__ bf16x8 load8(const T* p) {
    if constexpr (same_t<T, float>::v) { return pack8(*(const f32x4*)p, *(const f32x4*)(p + 4)); }
    else { return *reinterpret_cast<const bf16x8*>(p); }
}
__device__ __forceinline__ void mask_tile(f32x16& p0, f32x16& p1, int dq, unsigned W) {
    const float NEG = -__builtin_inff();
#pragma unroll
    for (int r = 0; r < 16; ++r) {
        const int c = (r & 3) + 8 * (r >> 2);
        if ((unsigned)(dq - c) >= W) p0[r] = NEG;
        if ((unsigned)(dq - c - 32) >= W) p1[r] = NEG;
    }
}
typedef unsigned u32x2 __attribute__((ext_vector_type(2)));
__device__ __forceinline__ void bitmask_tile(f32x16& p0, f32x16& p1, u32x2 w, int hi) {
    const float NEG = -__builtin_inff();
    const unsigned a = w[0] >> (4 * hi), b = w[1] >> (4 * hi);
#pragma unroll
    for (int r = 0; r < 16; ++r) {
        const int c = (r & 3) + 8 * (r >> 2);
        if (!((a >> c) & 1u)) p0[r] = NEG;
        if (!((b >> c) & 1u)) p1[r] = NEG;
    }
}
template <bool HALFQK> __device__ __forceinline__ void partialSM(f32x16& p0, f32x16& p1, float& m_reg, float& mn, float& alpha) {
    constexpr float SCALE = HALFQK ? 0.125f : 0.08838834764831845f;
    float pmax = p0[0]; for (int r = 1; r < 16; ++r) pmax = fmaxf(pmax, p0[r]); for (int r = 0; r < 16; ++r) pmax = fmaxf(pmax, p1[r]);
    { auto rr = __builtin_amdgcn_permlane32_swap(__float_as_uint(pmax), __float_as_uint(pmax), false, false);
      pmax = fmaxf(__uint_as_float(rr[0]), __uint_as_float(rr[1])); }
    constexpr float C2 = 1.4426950408889634f * SCALE;
    if (__builtin_expect(__all((pmax - m_reg) * SCALE <= THR), 1)) { mn = m_reg; alpha = 1.f; }
    else { mn = fmaxf(m_reg, pmax); alpha = __builtin_amdgcn_exp2f((m_reg - mn) * C2); m_reg = mn; }
    const float mnL = -mn * C2;
    for (int r = 0; r < 16; ++r) p0[r] = fmaf(p0[r], C2, mnL); for (int r = 0; r < 16; ++r) p1[r] = fmaf(p1[r], C2, mnL);
    for (int r = 0; r < 16; ++r) p0[r] = __builtin_amdgcn_exp2f(p0[r]);
}
__device__ __forceinline__ void finishSM(f32x16& p0, f32x16& p1, float alpha, float& l_reg, bf16x8& pa0, bf16x8& pa1, bf16x8& pa2, bf16x8& pa3) {
    for (int r = 0; r < 16; ++r) p1[r] = __builtin_amdgcn_exp2f(p1[r]);
    float ps = 0; for (int r = 0; r < 16; ++r) ps += p0[r]; for (int r = 0; r < 16; ++r) ps += p1[r];
    { auto rr = __builtin_amdgcn_permlane32_swap(__float_as_uint(ps), __float_as_uint(ps), false, false);
      ps = __uint_as_float(rr[0]) + __uint_as_float(rr[1]); }
    l_reg = l_reg * alpha + ps;
#define PK4(P, B_, OUT) do { unsigned a0 = cvtpk(P[B_+0], P[B_+1]), a1 = cvtpk(P[B_+2], P[B_+3]);                          \
        unsigned b0 = cvtpk(P[B_+4], P[B_+5]), b1 = cvtpk(P[B_+6], P[B_+7]);                                             \
        auto r0 = __builtin_amdgcn_permlane32_swap(a0, b0, false, false); auto r1 = __builtin_amdgcn_permlane32_swap(a1, b1, false, false); \
        u32x4 w = {r0[0], r1[0], r0[1], r1[1]}; OUT = *reinterpret_cast<bf16x8*>(&w); } while (0)
    PK4(p0, 0, pa0); PK4(p0, 8, pa1); PK4(p1, 0, pa2); PK4(p1, 8, pa3);
#undef PK4
}
template <int KB, bool SK, bool HALFQK>
__device__ __forceinline__ void qkt(f32x16& p0, f32x16& p1, const char* K_lds, int r32, int hi, const bf16x8* qr, bool act, int koff) {
    if (SK && !act) { const float NEG = -__builtin_inff();
#pragma unroll
        for (int r = 0; r < 16; ++r) { p0[r] = NEG; p1[r] = NEG; } return; }
    p0 = f32x16{}; p1 = f32x16{};
    const char* kb[4];
#pragma unroll
    for (int dd = 0; dd < 4; ++dd) kb[dd] = K_lds + KB * SHM_K + KSWZ(r32, (dd * 16 + hi * 8) * 2) + koff;
#pragma unroll
    for (int d0 = 0; d0 < (HALFQK ? 4 : 8); ++d0) { const char* a = kb[d0 & 3] + (d0 >> 2) * 128;
        bf16x8 b0 = *reinterpret_cast<const bf16x8*>(a);
        bf16x8 b1 = *reinterpret_cast<const bf16x8*>(a + 32 * 256);
        p0 = __builtin_amdgcn_mfma_f32_32x32x16_bf16(b0, qr[d0], p0, 0, 0, 0);
        p1 = __builtin_amdgcn_mfma_f32_32x32x16_bf16(b1, qr[d0], p1, 0, 0, 0); }
}
template <int VB, bool SK>
__device__ __forceinline__ void pv_tile(f32x16* o, int vb0, bf16x8 pa0, bf16x8 pa1, bf16x8 pa2, bf16x8 pa3, bool act) {
    if (SK && !act) return;
#define TRRD(dst, off) asm volatile("ds_read_b64_tr_b16 %0, %1 offset:%2" : "=&v"(dst) : "v"(vb0), "i"(off) : "memory")
#define PV_D0(d0) do { s16x4 l0, l1, l2, l3, h0, h1, h2, h3; constexpr int b_ = VB * SHM_V + v_rd_off(d0, 0, 0);     \
        TRRD(l0, b_); TRRD(h0, b_ + 2048); TRRD(l1, b_ + 4096); TRRD(h1, b_ + 6144); TRRD(l2, b_ + 8192); TRRD(h2, b_ + 10240); TRRD(l3, b_ + 12288); TRRD(h3, b_ + 14336); \
        asm volatile("s_waitcnt lgkmcnt(0)" ::: "memory"); SBAR();                 \
        o[d0] = __builtin_amdgcn_mfma_f32_32x32x16_bf16(pa0, (bf16x8){l0[0], l0[1], l0[2], l0[3], h0[0], h0[1], h0[2], h0[3]}, o[d0], 0, 0, 0);   \
        o[d0] = __builtin_amdgcn_mfma_f32_32x32x16_bf16(pa1, (bf16x8){l1[0], l1[1], l1[2], l1[3], h1[0], h1[1], h1[2], h1[3]}, o[d0], 0, 0, 0);   \
        o[d0] = __builtin_amdgcn_mfma_f32_32x32x16_bf16(pa2, (bf16x8){l2[0], l2[1], l2[2], l2[3], h2[0], h2[1], h2[2], h2[3]}, o[d0], 0, 0, 0);   \
        o[d0] = __builtin_amdgcn_mfma_f32_32x32x16_bf16(pa3, (bf16x8){l3[0], l3[1], l3[2], l3[3], h3[0], h3[1], h3[2], h3[3]}, o[d0], 0, 0, 0); } while (0)
    PV_D0(0); PV_D0(1); PV_D0(2); PV_D0(3);
#undef PV_D0
#undef TRRD
}

constexpr int QS = 1536, KVS = 4096;
template <class TIn, class TOut> struct BlockRef { const TIn* Q; const TIn* K; const TIn* V; TOut* O; int P0; int koff; const unsigned* mask; };
template <class TIn> struct Seam {
    bf16x8 qr[8];
    bf16x8 st_v0, st_v1, st_k0, st_k1; f32x4 sf0, sf1, sf2, sf3;
    f32x4 tq[16];
};
__device__ __forceinline__ int swa_jlo(int P0, int W) { const int lowk = P0 - W + 1; return lowk > 0 ? lowk / KVBLK : 0; }
#define ROW(p, k0, rr) ((p) + (size_t)((k0) + (rr)) * KVS + sc)
#define VMW() asm volatile("s_waitcnt vmcnt(0)" ::: "memory")
#define VMWN(n) asm volatile("s_waitcnt vmcnt(%0)" :: "i"(n) : "memory")
#define SLOAD_H(Kp, Vp, k0) do { S.st_v0 = load8<TIn>(ROW(Vp, k0, sr)); S.st_v1 = load8<TIn>(ROW(Vp, k0, 32 + sr));              \
                         S.st_k0 = load8<TIn>(ROW(Kp, k0, sr)); S.st_k1 = load8<TIn>(ROW(Kp, k0, 32 + sr)); } while (0)
#define SWRITE_HK(bf) do { *(bf16x8*)(K_lds + (bf) * SHM_K + kws) = S.st_k0; *(bf16x8*)(K_lds + (bf) * SHM_K + kws + 32 * 256) = S.st_k1; } while (0)
#define SWRITE_HV(bf) do { *(bf16x8*)(V_lds + (bf) * SHM_V + vst0) = S.st_v0; *(bf16x8*)(V_lds + (bf) * SHM_V + vst1) = S.st_v1; } while (0)
#define SWRITE_H(bf) do { SWRITE_HV(bf); SWRITE_HK(bf); } while (0)
#define SLOAD_F(p, k0) do { S.sf0 = *(const f32x4*)ROW(p, k0, sr); S.sf1 = *(const f32x4*)(ROW(p, k0, sr) + 4);                \
                            S.sf2 = *(const f32x4*)ROW(p, k0, 32 + sr); S.sf3 = *(const f32x4*)(ROW(p, k0, 32 + sr) + 4); } while (0)
#define SWRITE_KF(bf) do { *(bf16x8*)(K_lds + (bf) * SHM_K + kws) = pack8(S.sf0, S.sf1); *(bf16x8*)(K_lds + (bf) * SHM_K + kws + 32 * 256) = pack8(S.sf2, S.sf3); } while (0)
#define SWRITE_VF(bf) do { *(bf16x8*)(V_lds + (bf) * SHM_V + vst0) = pack8(S.sf0, S.sf1); *(bf16x8*)(V_lds + (bf) * SHM_V + vst1) = pack8(S.sf2, S.sf3); } while (0)
template <class TIn, class TOut, bool HALFQK>
__device__ __forceinline__ void causal_swa_prime(const BlockRef<TIn, TOut>& cur, int W, char* lds, Seam<TIn>& S) {
    constexpr bool F32 = same_t<TIn, float>::v;
    const int tid = otid_(), wid = __builtin_amdgcn_readfirstlane(tid >> 6), lane = tid & 63, r32 = lane & 31, hi = lane >> 5;
    const int sr = tid >> 4, sc = (tid & 15) * 8, kws = KSWZ(sr, sc * 2); char* K_lds = lds + 2 * SHM_V;
    const int kb0 = swa_jlo(cur.P0, W) * KVBLK;
    for (int d0 = 0; d0 < (HALFQK ? 4 : 8); ++d0) S.qr[d0] = load8<TIn>(cur.Q + (size_t)(wid * QBLK + r32) * QS + d0 * 16 + hi * 8);
    if constexpr (F32) { SLOAD_F((const float*)cur.K, kb0); VMW(); SWRITE_KF(0); SBAR(); SLOAD_F((const float*)cur.V, kb0); }
    else { SLOAD_H(cur.K, cur.V, kb0); VMW(); SWRITE_HK(0); }
    __syncthreads();
}
template <class TIn, class TOut, bool HALFQK, bool MASKED, int OS>
__device__ __forceinline__ void causal_swa_block(const BlockRef<TIn, TOut>& cur, const BlockRef<TIn, TOut>& nxt, int skv, int W, char* lds, Seam<TIn>& S) {
    constexpr bool F32 = same_t<TIn, float>::v;
    const int tid = otid_(), wid = __builtin_amdgcn_readfirstlane(tid >> 6), lane = tid & 63, r32 = lane & 31, hi = lane >> 5;
    const int j_lo = swa_jlo(cur.P0, W);
    int j_hi = (cur.P0 + QB - 1) / KVBLK + 1; if (j_hi > skv / KVBLK) j_hi = skv / KVBLK;
    const int NT = j_hi - j_lo;
    const int kbn = swa_jlo(nxt.P0, W) * KVBLK;
    const int qlo = cur.P0 + wid * QBLK, qm = qlo + r32 - 4 * hi;
    char* V_lds = lds; char* K_lds = lds + 2 * SHM_V;
    float* ws = (float*)(lds + 2 * SHM_V + 2 * SHM_K) + wid * 64; float* li_l = ws, * al_l = ws + 32;
    float m_reg = -1e30f, l_reg = 0; f32x16 o[4] = {};
    const int sr = tid >> 4, sc = (tid & 15) * 8, vst0 = v_st(sr, sc), vst1 = v_st(32 + sr, sc), kws = KSWZ(sr, sc * 2);
    const int vb0 = (int)(uintptr_t)V_lds + v_rd_base(lane);
    const TIn* Kh = cur.K; const TIn* Vh = cur.V;
#define RESC(a) do { if (__any((a) < 1.f)) { if (hi == 0) al_l[r32] = (a); asm volatile("s_waitcnt lgkmcnt(0)" ::: "memory");              \
                     for (int d_ = 0; d_ < 4; ++d_) for (int r = 0; r < 16; ++r) o[d_][r] *= al_l[crow(r, hi)]; } } while (0)
#define KBASE(t) ((j_lo + (t)) * KVBLK)
#define ACT(t) (KBASE(t) <= qlo + QBLK - 1 && KBASE(t) + KVBLK - 1 >= qlo - W + 1)
#define MASKT(P0_, P1_, t) do { if constexpr (MASKED) bitmask_tile(P0_, P1_, mw, hi);   \
        else { const int kb_ = KBASE(t); if ((!SK || ACT(t)) && (kb_ + KVBLK - 1 > qlo || kb_ <= qlo + QBLK - 1 - W)) mask_tile(P0_, P1_, qm - kb_, (unsigned)W); } } while (0)
    const unsigned moff = (unsigned)((wid * QBLK + r32) * 1024 + 8 * j_lo); u32x2 mw = {0u, 0u};
#define MLOAD(t) do { if constexpr (MASKED) mw = *(const u32x2*)((const char*)cur.mask + (moff + 8u * (unsigned)(t))); } while (0)
    constexpr int NQL = F32 ? 16 : (HALFQK ? 4 : 8);
    constexpr bool SK = WSKIP && !F32;
#define SEAM_K0() do { VMWN(NQL); if constexpr (F32) { SWRITE_KF(0); SBAR(); SLOAD_F((const float*)nxt.V, kbn); } else { SWRITE_HK(0); } SBAR(); } while (0)
    f32x16 pA0, pA1, pB0, pB1; float mnA, mnB, alA, alB; bf16x8 pa0, pa1, pa2, pa3;
    if constexpr (F32) { VMW(); SWRITE_VF(0); SBAR(); } else { SWRITE_HV(0); SBAR(); }
    if (NT > 1) { if constexpr (F32) SLOAD_F((const float*)Kh, KBASE(1)); else SLOAD_H(Kh, Vh, KBASE(1)); }
    SBAR(); qkt<0, SK, HALFQK>(pA0, pA1, K_lds, r32, hi, S.qr, ACT(0), cur.koff); MLOAD(0);
    if constexpr (F32) { if (NT > 1) { VMW(); SWRITE_KF(1); SBAR(); SLOAD_F((const float*)Vh, KBASE(1)); } }
    MASKT(pA0, pA1, 0); partialSM<HALFQK>(pA0, pA1, m_reg, mnA, alA);
    if (NT > 1) { VMW(); if constexpr (F32) { SWRITE_VF(1); SBAR(); if (NT > 2) SLOAD_F((const float*)Kh, KBASE(2)); } else SWRITE_H(1); }
    __syncthreads();
#define HALF_STEP(PX0, PX1, mnX, alX, PY0, PY1, alY, t, KB, VB, SB) do {                                                      \
        SBAR(); qkt<KB, SK, HALFQK>(PX0, PX1, K_lds, r32, hi, S.qr, ACT(t), cur.koff); MLOAD(t);                                             \
        finishSM(PY0, PY1, alY, l_reg, pa0, pa1, pa2, pa3); SBAR();                                                           \
        if ((t) + 1 < NT) { if constexpr (F32) { VMW(); SWRITE_KF(SB); SBAR(); SLOAD_F((const float*)Vh, KBASE((t) + 1)); }  \
                            else { SLOAD_H(Kh, Vh, KBASE((t) + 1)); } SBAR(); }                                               \
        pv_tile<VB, SK>(o, vb0, pa0, pa1, pa2, pa3, ACT((t) - 1)); MASKT(PX0, PX1, (t)); partialSM<HALFQK>(PX0, PX1, m_reg, mnX, alX);                                        \
        __syncthreads();                                                                                                      \
        if ((t) + 1 < NT) { VMW(); if constexpr (F32) { SWRITE_VF(SB); SBAR(); if ((t) + 2 < NT) SLOAD_F((const float*)Kh, KBASE((t) + 2)); } \
                            else { SWRITE_H(SB); } }                                                                          \
        RESC(alX); __syncthreads(); } while (0)
    for (int t = 1; t + 1 < NT; t += 2) {
        HALF_STEP(pB0, pB1, mnB, alB, pA0, pA1, alA, t, 1, 0, 0);
        HALF_STEP(pA0, pA1, mnA, alA, pB0, pB1, alB, t + 1, 0, 1, 1);
    }
    const bool even = (NT & 1) == 0;
    if (even) { SBAR(); qkt<1, SK, HALFQK>(pB0, pB1, K_lds, r32, hi, S.qr, ACT(NT - 1), cur.koff); MLOAD(NT - 1); SBAR(); }
#define QROW(e) (nxt.Q + (size_t)(wid * QBLK + r32) * QS + ((e) >> 1) * 16 + hi * 8 + ((e) & 1) * 4)
    if constexpr (F32) { SLOAD_F((const float*)nxt.K, kbn); SBAR();
#pragma unroll
        for (int e = 0; e < 8; ++e) S.tq[e] = *(const f32x4*)QROW(e); }
    else { SLOAD_H(nxt.K, nxt.V, kbn); SBAR();
#pragma unroll
        for (int d0 = 0; d0 < (HALFQK ? 4 : 8); ++d0) S.qr[d0] = load8<TIn>(nxt.Q + (size_t)(wid * QBLK + r32) * QS + d0 * 16 + hi * 8); }
    SBAR();
    finishSM(pA0, pA1, alA, l_reg, pa0, pa1, pa2, pa3); SBAR();
    if constexpr (F32) {
#pragma unroll
        for (int e = 8; e < 16; ++e) S.tq[e] = *(const f32x4*)QROW(e); SBAR(); }
#undef QROW
    pv_tile<0, SK>(o, vb0, pa0, pa1, pa2, pa3, ACT(even ? NT - 2 : NT - 1));
    if (even) { MASKT(pB0, pB1, NT - 1); partialSM<HALFQK>(pB0, pB1, m_reg, mnB, alB); __syncthreads(); RESC(alB);
        finishSM(pB0, pB1, alB, l_reg, pa0, pa1, pa2, pa3); SBAR(); pv_tile<1, SK>(o, vb0, pa0, pa1, pa2, pa3, ACT(NT - 1)); }
    SBAR(); SEAM_K0();
    if (hi == 0) li_l[r32] = l_reg; asm volatile("s_waitcnt lgkmcnt(0)" ::: "memory");
    float rli[16];
#pragma unroll
    for (int r = 0; r < 16; ++r) rli[r] = __builtin_amdgcn_rcpf(li_l[crow(r, hi)]);
    TOut* Ow = cur.O + (size_t)(wid * QBLK) * OS;
#pragma unroll
    for (int r = 0; r < 16; ++r) { const int orow = crow(r, hi);
#pragma unroll
        for (int d0 = 0; d0 < 4; ++d0) { const float v = o[d0][r] * rli[r];
            if constexpr (same_t<TOut, float>::v) { Ow[(size_t)orow * OS + d0 * 32 + r32] = v; }
            else { const float vn = __shfl_xor(v, 1);
                   if ((r32 & 1) == 0) *(unsigned*)(Ow + (size_t)orow * OS + d0 * 32 + r32) = cvtpk(v, vn); } } }
    if constexpr (F32) {
#pragma unroll
        for (int d0 = 0; d0 < 8; ++d0) S.qr[d0] = pack8(S.tq[2 * d0], S.tq[2 * d0 + 1]); }
    __syncthreads();
#undef RESC
#undef KBASE
#undef ACT
#undef MASKT
#undef MLOAD
#undef SEAM_K0
#undef HALF_STEP
}
#undef ROW
#undef VMW
#undef VMWN
#undef SLOAD_H
#undef SWRITE_HK
#undef SWRITE_HV
#undef SWRITE_H
#undef SLOAD_F
#undef SWRITE_KF
#undef SWRITE_VF
}
#ifndef PROBE
#define PROBE 0
#endif
constexpr int NWAVES = 8;
constexpr int NB = 2, T = 8192, M = NB * T, DM = 1024, FF = 2816, NIN = 8520, NLAYER = 2;
constexpr float NORM_EPS = 1e-6f;
constexpr size_t MiB = 1u << 20;
constexpr size_t WS_CTL = 0, CTL_ZERO_BYTES = 1 * MiB;
constexpr size_t WS_WF = 1 * MiB;
constexpr size_t WS_WF_DOWN = WS_WF + 11 * MiB;
constexpr size_t WS_WM = 18 * MiB;
constexpr size_t WS_WM_BR = WS_WM + 17 * MiB, WS_WM_OUT = WS_WM + 20 * MiB;
constexpr size_t WS_XN = 40 * MiB;
constexpr size_t WS_Q3 = 72 * MiB;
constexpr size_t WS_ZR = 120 * MiB;
constexpr size_t WS_R2 = 248 * MiB;
constexpr size_t WS_END = 280 * MiB;
constexpr size_t WS_MG = WS_ZR + 96 * MiB;
constexpr size_t WS_YRAW = WS_WF;
constexpr size_t WS_X1 = WS_XN + 16 * MiB;
constexpr size_t WS_A8 = WS_WM;
constexpr size_t WS_KID = WS_WM + 8 * MiB;
constexpr size_t WS_BITM = WS_XN;
constexpr size_t WS_RDOTK = WS_WF + 16 * MiB;
constexpr int QP = 1536, ZP = 4096;
constexpr int ZC_DK = 0, ZC_DV = 512, ZC_QI = 1024, ZC_KI = 1536, ZC_WI = 1600, ZC_RK = 1792, ZC_RV = 2304, ZC_WC = 2816, ZC_AC = 2880, ZC_GC = 2944, ZC_FK = 3072, ZC_FV = 3584;
constexpr int CW_TMO = 0;
constexpr int CW_BAR = 4096;
constexpr int CW_Q = 8192;
constexpr int CW_PROBE = 2048;
constexpr int CW_DONE = 12288;
constexpr int LDS_MISC = 160 * 1024 - 256;
constexpr int LDS_BYTES = 160 * 1024;

#define GAS __attribute__((address_space(1)))
#define LAS __attribute__((address_space(3)))
typedef unsigned short bf16;
typedef unsigned v4u __attribute__((ext_vector_type(4)));
typedef unsigned v2u __attribute__((ext_vector_type(2)));
typedef float f32x4 __attribute__((ext_vector_type(4)));
typedef float f32x2 __attribute__((ext_vector_type(2)));
typedef float f32x16 __attribute__((ext_vector_type(16)));
typedef short bf16x8 __attribute__((ext_vector_type(8)));
typedef GAS unsigned gu32;
#define RLX_AGENT __ATOMIC_RELAXED, __HIP_MEMORY_SCOPE_AGENT
#define LDS_WAIT() asm volatile("s_waitcnt lgkmcnt(0)" ::: "memory")
#define VM_WAIT() asm volatile("s_waitcnt vmcnt(0)" ::: "memory")
__device__ __forceinline__ unsigned f2bf(float f) { unsigned u = __builtin_bit_cast(unsigned, f); return (u + 0x7fffu + ((u >> 16) & 1u)) >> 16; }
__device__ __forceinline__ unsigned pk2(float lo, float hi) { return f2bf(lo) | (f2bf(hi) << 16); }
__device__ __forceinline__ float bflo(unsigned w) { return __uint_as_float(w << 16); }
__device__ __forceinline__ float bfhi(unsigned w) { return __uint_as_float(w & 0xffff0000u); }
__device__ __forceinline__ float bf1(bf16 h) { return __uint_as_float((unsigned)h << 16); }
__device__ __forceinline__ float wave_sum(float v) {
#pragma unroll
    for (int o = 1; o < 64; o <<= 1) v += __shfl_xor(v, o);
    return v;
}
__device__ __forceinline__ float sigm(float x) { return __builtin_amdgcn_rcpf(1.0f + __expf(-x)); }

#define XB_TMO      128
#define XB_XCNT(j)  (256  + 64 * (j))
#define XB_XSUB(j)  (1280 + 64 * (j))
#define XB_XGEN(j)  (2304 + 64 * (j))
#define XB_TOP      3328
#define XB_TOPGEN   3392
#define XCD_BAR_WORDS 3456
#define XB_SPIN_CAP (1u << 22)
__device__ __forceinline__ unsigned xb_ld(unsigned* p)              { return __hip_atomic_load(p, __ATOMIC_RELAXED, __HIP_MEMORY_SCOPE_AGENT); }
__device__ __forceinline__ unsigned xb_add(unsigned* p, unsigned v) { return __hip_atomic_fetch_add(p, v, __ATOMIC_RELAXED, __HIP_MEMORY_SCOPE_AGENT); }
__device__ __forceinline__ unsigned xb_xcc_id() { return (unsigned)__builtin_amdgcn_s_getreg((3 << 11) | 20) & 0xFu; }
#define XB_SPIN(cond, bar) do { unsigned _sp = 0; while (cond) { __builtin_amdgcn_s_sleep(1); \
    if ((++_sp & 255u) == 0u) { if (xb_ld(&(bar)[XB_TMO])) break; if (_sp > XB_SPIN_CAP) { atomicAdd(&(bar)[XB_TMO], 1u); break; } } } } while (0)
struct XcdBarrier { unsigned* bar; unsigned x; volatile LAS unsigned* st; };
__device__ __forceinline__ XcdBarrier xcd_barrier_post(unsigned* bar, volatile LAS unsigned* st) {
    XcdBarrier b; b.bar = bar; b.x = xb_xcc_id(); b.st = st;
    if (threadIdx.x == 0) (void)xb_add(&bar[XB_XCNT(b.x)], 1u);
    return b;
}
__device__ __forceinline__ void xcd_barrier_complete(unsigned* bar, unsigned x, unsigned& nloc, unsigned& nx) {
    const unsigned G = gridDim.x * gridDim.y * gridDim.z;
    unsigned sum, cnt, mine, sp = 0u;
    for (;;) {
        sum = 0u; cnt = 0u; mine = 0u;
#pragma unroll
        for (unsigned j = 0; j < 16; ++j) { const unsigned c = xb_ld(&bar[XB_XCNT(j)]); sum += c; cnt += (c > 0u) ? 1u : 0u; mine = (j == x) ? c : mine; }
        if (sum == G) break;
        __builtin_amdgcn_s_sleep(1);
        if ((++sp & 255u) == 0u) { if (xb_ld(&bar[XB_TMO])) break; if (sp > XB_SPIN_CAP) { atomicAdd(&bar[XB_TMO], 1u); break; } }
    }
    nloc = mine > 0u ? mine : 1u; nx = cnt > 0u ? cnt : 1u;
}
__device__ __forceinline__ void xcd_barrier(const XcdBarrier& b) {
    asm volatile("s_waitcnt vmcnt(0)" ::: "memory");
    __syncthreads();
    if (threadIdx.x == 0) {
        unsigned* bar = b.bar;
        __builtin_amdgcn_s_waitcnt(0);
        unsigned nloc = b.st[0], nx = b.st[1];
        if (nloc == 0u) { xcd_barrier_complete(bar, b.x, nloc, nx); b.st[0] = nloc; b.st[1] = nx; }
        const unsigned old = xb_add(&bar[XB_XSUB(b.x)], 1u);
        const unsigned gen = old / nloc;
        if (old + 1u == (gen + 1u) * nloc) {
            __builtin_amdgcn_fence(__ATOMIC_RELEASE, "agent");
            asm volatile("s_waitcnt vmcnt(0)" ::: "memory");
            const unsigned og = xb_add(&bar[XB_TOP], 1u);
            const unsigned tg = og / nx;
            if (og + 1u == (tg + 1u) * nx) xb_add(&bar[XB_TOPGEN], 1u);
            else XB_SPIN(xb_ld(&bar[XB_TOPGEN]) == tg, bar);
            __builtin_amdgcn_fence(__ATOMIC_ACQUIRE, "agent");
            xb_add(&bar[XB_XGEN(b.x)], 1u);
            asm volatile("s_waitcnt vmcnt(0)" ::: "memory");
        } else {
            XB_SPIN(xb_ld(&bar[XB_XGEN(b.x)]) == gen, bar);
            __builtin_amdgcn_fence(__ATOMIC_ACQUIRE, "agent");
            asm volatile("s_waitcnt vmcnt(0)" ::: "memory");
        }
    }
    __syncthreads();
}

struct MapIdent { const float* W; int ld; __device__ __forceinline__ const float* col(int n) const { return W + n; } };
struct MapUp {
    const float* G; const float* U; int ld;
    __device__ __forceinline__ const float* col(int n) const { const int g = n >> 5, j = n & 31; return j < 16 ? G + 16 * g + j : U + 16 * g + (j - 16); }
};
struct MapWin {
    const float* W; int ld;
    __device__ __forceinline__ const float* col(int n) const {
        int src;
        if (n < 512) src = n; else if (n < 1024) src = 2120 + (n - 512); else if (n < 1536) src = 3912 + (n - 1024);
        else if (n < 5632) { const int z = n - 1536; if (z < 1608) src = 512 + z; else if (z < 1792) src = -1; else if (z < 3072) src = 840 + z; else src = 1352 + z; }
        else src = 5448 + (n - 5632);
        return src < 0 ? nullptr : W + src;
    }
};
template <class Map>
__device__ __forceinline__ void conv_item(const Map& mp, int K, bf16* WT, LAS float* scr, int item, int nblk, int lane) {
    const int kb = item / nblk, nb = item % nblk, k0 = 64 * kb, n0 = 32 * nb;
    const float* cp = mp.col(n0 + (lane & 31)); const size_t ld = (size_t)mp.ld;
#pragma unroll 8
    for (int i = 0; i < 32; ++i) { const int kk = 2 * i + (lane >> 5); scr[kk * 33 + (lane & 31)] = cp ? cp[(size_t)(k0 + kk) * ld] : 0.f; }
    LDS_WAIT(); asm volatile("" ::: "memory");
    const int c = lane & 7;
#pragma unroll
    for (int j = 0; j < 4; ++j) { const int n = (lane >> 3) + 8 * j; const LAS float* s = scr + (8 * c) * 33 + n;
        v4u o; o.x = pk2(s[0 * 33], s[1 * 33]); o.y = pk2(s[2 * 33], s[3 * 33]); o.z = pk2(s[4 * 33], s[5 * 33]); o.w = pk2(s[6 * 33], s[7 * 33]);
        *(GAS v4u*)(WT + (size_t)(n0 + n) * K + k0 + 8 * c) = o; }
    LDS_WAIT(); asm volatile("" ::: "memory");
}
template <class Map>
__device__ __forceinline__ void conv_matrix(const Map& mp, int K, int N, bf16* WT, LAS float* scr, int gw, int NGW, int lane) {
    const int nblk = N / 32, nitems = (K / 64) * nblk;
    for (int it = gw; it < nitems; it += NGW) conv_item(mp, K, WT, scr, it, nblk, lane);
}

__device__ __forceinline__ void rownorm_rows(const float* base, const bf16* Y, float s, const float* gpost, float* out, const float* gnext, bf16* XN, int gw, int NGW, int lane, float oscale = 1.f) {
    for (int m = gw; m < M; m += NGW) {
        f32x4 v[4];
#pragma unroll
        for (int j = 0; j < 4; ++j) v[j] = ((const GAS f32x4*)(base + (size_t)m * DM))[lane + 64 * j];
        if (Y) {
            f32x4 y[4]; float ss = 0.f;
#pragma unroll
            for (int j = 0; j < 4; ++j) { const v2u w = ((const GAS v2u*)(Y + (size_t)m * DM))[lane + 64 * j]; y[j] = (f32x4){bflo(w.x), bfhi(w.x), bflo(w.y), bfhi(w.y)};
                ss += (y[j].x * y[j].x + y[j].y * y[j].y) + (y[j].z * y[j].z + y[j].w * y[j].w); }
            const float r = s * __builtin_amdgcn_rsqf(wave_sum(ss) * (1.f / DM) + NORM_EPS);
#pragma unroll
            for (int j = 0; j < 4; ++j) { const f32x4 g = ((const GAS f32x4*)gpost)[lane + 64 * j]; v[j] = v[j] + y[j] * g * r; ((GAS f32x4*)(out + (size_t)m * DM))[lane + 64 * j] = v[j] * oscale; }
        }
        if (XN) {
            float ss = 0.f;
#pragma unroll
            for (int j = 0; j < 4; ++j) ss += (v[j].x * v[j].x + v[j].y * v[j].y) + (v[j].z * v[j].z + v[j].w * v[j].w);
            const float r = __builtin_amdgcn_rsqf(wave_sum(ss) * (1.f / DM) + NORM_EPS);
#pragma unroll
            for (int j = 0; j < 4; ++j) { const f32x4 g = ((const GAS f32x4*)gnext)[lane + 64 * j]; const f32x4 o = v[j] * g * r;
                v2u w; w.x = pk2(o.x, o.y); w.y = pk2(o.z, o.w); ((GAS v2u*)(XN + (size_t)m * DM))[lane + 64 * j] = w; }
        }
    }
}

namespace scan {
template <int CTRL> __device__ __forceinline__ float dpp_add(float x) {
    const int y = __builtin_amdgcn_update_dpp(0, __builtin_bit_cast(int, x), CTRL, 0xF, 0xF, false);
    return x + __builtin_bit_cast(float, y);
}
__device__ __forceinline__ float red8(float x) { x = dpp_add<0xB1>(x); x = dpp_add<0x4E>(x); x = dpp_add<0x141>(x); return x; }
__device__ __forceinline__ float red16(float x) { x = dpp_add<0xB1>(x); x = dpp_add<0x4E>(x); x = dpp_add<0x141>(x); x = dpp_add<0x140>(x); return x; }
__device__ __forceinline__ void ld8(const bf16* p, float (&o)[8]) { const v4u w = *(const GAS v4u*)p; o[0] = bflo(w.x); o[1] = bfhi(w.x); o[2] = bflo(w.y); o[3] = bfhi(w.y); o[4] = bflo(w.z); o[5] = bfhi(w.z); o[6] = bflo(w.w); o[7] = bfhi(w.w); }
}
struct PrepP { const bf16* ZR; bf16* X1; unsigned char* A8; bf16* KI; const float *mu, *w0, *wup, *a0, *aup; };
__device__ __forceinline__ void rwkv_prep(const PrepP& P, LAS unsigned char* lds) {
    const int tid = otid_(), lane = tid & 63, h = __builtin_amdgcn_readfirstlane(tid >> 6), c16 = lane & 15, quad = lane >> 4;
    constexpr int SP = 144;
    LAS unsigned char* TA = lds; LAS unsigned char* AA = lds + 64 * SP;
    bf16x8 bw[4][2], ba[4][2];
#pragma unroll
    for (int ct = 0; ct < 4; ++ct)
#pragma unroll
        for (int s = 0; s < 2; ++s) { const size_t o = (size_t)(32 * s + 8 * quad) * 512 + 64 * h + 16 * ct + c16; const float* gw_ = P.wup + o; const float* ga_ = P.aup + o;
            v4u w; w.x = pk2(gw_[0], gw_[512]); w.y = pk2(gw_[1024], gw_[1536]); w.z = pk2(gw_[2048], gw_[2560]); w.w = pk2(gw_[3072], gw_[3584]); bw[ct][s] = __builtin_bit_cast(bf16x8, w);
            v4u a; a.x = pk2(ga_[0], ga_[512]); a.y = pk2(ga_[1024], ga_[1536]); a.z = pk2(ga_[2048], ga_[2560]); a.w = pk2(ga_[3072], ga_[3584]); ba[ct][s] = __builtin_bit_cast(bf16x8, a); }
    float w0v[4], a0v[4];
#pragma unroll
    for (int ct = 0; ct < 4; ++ct) { w0v[ct] = P.w0[64 * h + 16 * ct + c16]; a0v[ct] = P.a0[64 * h + 16 * ct + c16]; }
    const int stok = tid >> 3, sseg = tid & 7;
#pragma unroll 1
    for (int m0 = blockIdx.x * 64; m0 < M; m0 += gridDim.x * 64) {
        {   const size_t m = (size_t)m0 + stok; const int t = (int)(m & (T - 1));
            *(GAS v4u*)(P.KI + m * 64 + 8 * sseg) = *(const GAS v4u*)(P.ZR + m * ZP + ZC_KI + 8 * sseg);
            float wc[8], ac[8], p8[8];
            scan::ld8(P.ZR + m * ZP + ZC_WC + 8 * sseg, wc); scan::ld8(P.ZR + m * ZP + ZC_AC + 8 * sseg, ac);
            if (t > 0) { scan::ld8(P.ZR + (m - 1) * ZP + ZC_WC + 8 * sseg, p8);
#pragma unroll
                for (int e = 0; e < 8; ++e) wc[e] += (p8[e] - wc[e]) * P.mu[1536 + 8 * sseg + e];
                scan::ld8(P.ZR + (m - 1) * ZP + ZC_AC + 8 * sseg, p8);
#pragma unroll
                for (int e = 0; e < 8; ++e) ac[e] += (p8[e] - ac[e]) * P.mu[1600 + 8 * sseg + e]; }
            else {
#pragma unroll
                for (int e = 0; e < 8; ++e) { wc[e] -= wc[e] * P.mu[1536 + 8 * sseg + e]; ac[e] -= ac[e] * P.mu[1600 + 8 * sseg + e]; } }
            float th[8];
#pragma unroll
            for (int e = 0; e < 8; ++e) th[e] = 1.f - 2.f * __builtin_amdgcn_rcpf(__expf(2.f * wc[e]) + 1.f);
            v4u o; o.x = pk2(th[0], th[1]); o.y = pk2(th[2], th[3]); o.z = pk2(th[4], th[5]); o.w = pk2(th[6], th[7]); *(LAS v4u*)(TA + stok * SP + 16 * sseg) = o;
            v4u q; q.x = pk2(ac[0], ac[1]); q.y = pk2(ac[2], ac[3]); q.z = pk2(ac[4], ac[5]); q.w = pk2(ac[6], ac[7]); *(LAS v4u*)(AA + stok * SP + 16 * sseg) = q;
        }
        __syncthreads();
#pragma unroll 1
        for (int rt = 0; rt < 4; ++rt) {
            f32x4 accw[4], acca[4];
#pragma unroll
            for (int ct = 0; ct < 4; ++ct) { accw[ct] = (f32x4){0.f, 0.f, 0.f, 0.f}; acca[ct] = (f32x4){0.f, 0.f, 0.f, 0.f}; }
#pragma unroll
            for (int s = 0; s < 2; ++s) { const bf16x8 fw = *(const LAS bf16x8*)(TA + (16 * rt + c16) * SP + (32 * s + 8 * quad) * 2), fa = *(const LAS bf16x8*)(AA + (16 * rt + c16) * SP + (32 * s + 8 * quad) * 2);
#pragma unroll
                for (int ct = 0; ct < 4; ++ct) { accw[ct] = __builtin_amdgcn_mfma_f32_16x16x32_bf16(fw, bw[ct][s], accw[ct], 0, 0, 0); acca[ct] = __builtin_amdgcn_mfma_f32_16x16x32_bf16(fa, ba[ct][s], acca[ct], 0, 0, 0); } }
#pragma unroll
            for (int j = 0; j < 4; ++j) { const size_t m = (size_t)m0 + 16 * rt + 4 * quad + j;
#pragma unroll
                for (int ct = 0; ct < 4; ++ct) { const int ch = 64 * h + 16 * ct + c16;
                    const float sg = sigm(w0v[ct] + accw[ct][j]);
                    const float x1 = 1.f - __expf(-0.6065306597126334f * sg);
                    const float a = sigm(a0v[ct] + acca[ct][j]);
                    P.X1[m * 512 + ch] = (bf16)f2bf(x1);
                    P.A8[m * 512 + ch] = (unsigned char)(int)(a * 255.f + 0.5f); } }
        }
        __syncthreads();
    }
}

struct ScanP { const bf16* Q3; const bf16* ZR; const bf16* X1; const unsigned char* A8; bf16* yraw; float* rdotk; const float *mu, *k_k, *k_a, *r_k; };
namespace scan {
constexpr int TB = 32, NBLK = T / TB;
constexpr int CB_W = 0, CB_B = 8192, CB_K = 16384, CB_KW = 24576, CB_V = 40960, CB_BR = 43008, CB_KR = 43136, CB_SA = 43264, CB_YP = 45312, CBSZ = 78080;
constexpr int L_END = 2 * CBSZ;
static_assert(L_END <= LDS_MISC, "scan LDS");
}
__device__ __forceinline__ void rwkv_scan_unit(const ScanP& P, int unit, LAS unsigned char* lds) {
    using namespace scan;
    const int tid = otid_(), wid = __builtin_amdgcn_readfirstlane(tid >> 6), lane = tid & 63;
    const int b = unit >> 5, h = (unit >> 2) & 7, vq = unit & 3;
    const size_t mrow0 = (size_t)b * T;
    if (wid >= 4) {
        const int pw = wid - 4, tokl = lane >> 3, seg = lane & 7, c0 = 8 * seg, hc0 = 64 * h + c0;
        float mu_r[8], mu_k[8], kkv[8], kav[8], rkv[8];
#pragma unroll
        for (int e = 0; e < 8; ++e) { mu_r[e] = P.mu[hc0 + e]; mu_k[e] = P.mu[512 + hc0 + e]; kkv[e] = P.k_k[hc0 + e]; kav[e] = P.k_a[hc0 + e]; rkv[e] = P.r_k[hc0 + e]; }
        const int vc0 = 64 * h + 16 * vq + 2 * seg;
        const float mu_v0 = P.mu[1024 + vc0], mu_v1 = P.mu[1024 + vc0 + 1];
        const int ptid = pw * 64 + lane;
        for (int blk = -1; blk < NBLK; ++blk) {
            const int nb = blk + 1;
            LAS unsigned char* cb = lds + (nb & 1) * CBSZ;
            if (blk >= 1) {
                const int tok = ptid >> 3, v2 = (ptid & 7) * 2;
                const LAS float* YPp = (const LAS float*)(cb + CB_YP) + (tok * 16 + v2) * 16;
                float y0 = 0.f, y1 = 0.f;
#pragma unroll
                for (int q4 = 0; q4 < 4; ++q4) { const f32x4 a = *(const LAS f32x4*)(YPp + 4 * q4), c = *(const LAS f32x4*)(YPp + 16 + 4 * q4); y0 += (a.x + a.y) + (a.z + a.w); y1 += (c.x + c.y) + (c.z + c.w); }
                const float br = *(const LAS float*)(cb + CB_BR + tok * 4), kr = *(const LAS float*)(cb + CB_KR + tok * 4);
                const f32x2 sa = *(const LAS f32x2*)(cb + CB_SA + (tok * 16 + v2) * 4), vv = *(const LAS f32x2*)(cb + CB_V + (tok * 16 + v2) * 4);
                y0 += sa.x * br + vv.x * kr; y1 += sa.y * br + vv.y * kr;
                const size_t m = mrow0 + (size_t)(blk - 1) * TB + tok;
                *(GAS unsigned*)(P.yraw + m * 512 + 64 * h + 16 * vq + v2) = pk2(y0, y1);
                LDS_WAIT(); asm volatile("" ::: "memory");
            }
            if (nb < NBLK) {
                const int t = nb * TB + 8 * pw + tokl; const size_t m = mrow0 + t;
                float r8[8], k8[8], p8[8], x8[8], a8[8];
                ld8(P.Q3 + m * QP + 512 + hc0, r8); ld8(P.ZR + m * ZP + ZC_RK + hc0, k8); ld8(P.X1 + m * 512 + hc0, x8);
                { const v2u aw = *(const GAS v2u*)(P.A8 + m * 512 + hc0); const float sc = 1.f / 255.f;
                  a8[0] = (float)(aw.x & 255u) * sc; a8[1] = (float)((aw.x >> 8) & 255u) * sc; a8[2] = (float)((aw.x >> 16) & 255u) * sc; a8[3] = (float)(aw.x >> 24) * sc;
                  a8[4] = (float)(aw.y & 255u) * sc; a8[5] = (float)((aw.y >> 8) & 255u) * sc; a8[6] = (float)((aw.y >> 16) & 255u) * sc; a8[7] = (float)(aw.y >> 24) * sc; }
                const unsigned vw = *(const GAS unsigned*)(P.ZR + m * ZP + ZC_RV + vc0); float v0 = bflo(vw), v1 = bfhi(vw);
                if (t > 0) {
                    ld8(P.Q3 + (m - 1) * QP + 512 + hc0, p8);
#pragma unroll
                    for (int e = 0; e < 8; ++e) r8[e] += (p8[e] - r8[e]) * mu_r[e];
                    ld8(P.ZR + (m - 1) * ZP + ZC_RK + hc0, p8);
#pragma unroll
                    for (int e = 0; e < 8; ++e) k8[e] += (p8[e] - k8[e]) * mu_k[e];
                    const unsigned pv = *(const GAS unsigned*)(P.ZR + (m - 1) * ZP + ZC_RV + vc0);
                    v0 += (bflo(pv) - v0) * mu_v0; v1 += (bfhi(pv) - v1) * mu_v1;
                } else {
#pragma unroll
                    for (int e = 0; e < 8; ++e) { r8[e] -= r8[e] * mu_r[e]; k8[e] -= k8[e] * mu_k[e]; }
                    v0 -= v0 * mu_v0; v1 -= v1 * mu_v1;
                }
                float kk8[8]; { float ss = 0.f;
#pragma unroll
                  for (int e = 0; e < 8; ++e) { kk8[e] = k8[e] * kkv[e]; ss += kk8[e] * kk8[e]; }
                  ss = red8(ss); const float inv = 1.f / fmaxf(sqrtf(ss), 1e-12f);
#pragma unroll
                  for (int e = 0; e < 8; ++e) kk8[e] *= inv; }
                float w8[8], bb[8], km[8], wr[8]; float brp = 0.f, krp = 0.f, rkp = 0.f;
#pragma unroll
                for (int e = 0; e < 8; ++e) {
                    w8[e] = 1.f - x8[e];
                    bb[e] = kk8[e] * a8[e]; km[e] = k8[e] * (1.f + (a8[e] - 1.f) * kav[e]); wr[e] = w8[e] * r8[e];
                    brp += bb[e] * r8[e]; krp += km[e] * r8[e]; rkp += r8[e] * km[e] * rkv[e];
                }
                brp = red8(brp); krp = red8(krp); rkp = red8(rkp);
                const int ti = 8 * pw + tokl;
                *(LAS f32x4*)(cb + CB_W + (ti * 64 + c0) * 4) = (f32x4){w8[0], w8[1], w8[2], w8[3]}; *(LAS f32x4*)(cb + CB_W + (ti * 64 + c0 + 4) * 4) = (f32x4){w8[4], w8[5], w8[6], w8[7]};
                *(LAS f32x4*)(cb + CB_B + (ti * 64 + c0) * 4) = (f32x4){bb[0], bb[1], bb[2], bb[3]}; *(LAS f32x4*)(cb + CB_B + (ti * 64 + c0 + 4) * 4) = (f32x4){bb[4], bb[5], bb[6], bb[7]};
                *(LAS f32x4*)(cb + CB_K + (ti * 64 + c0) * 4) = (f32x4){km[0], km[1], km[2], km[3]}; *(LAS f32x4*)(cb + CB_K + (ti * 64 + c0 + 4) * 4) = (f32x4){km[4], km[5], km[6], km[7]};
#pragma unroll
                for (int e = 0; e < 8; e += 2) *(LAS f32x4*)(cb + CB_KW + (ti * 64 + c0 + e) * 8) = (f32x4){kk8[e], wr[e], kk8[e + 1], wr[e + 1]};
                *(LAS f32x2*)(cb + CB_V + (ti * 16 + 2 * seg) * 4) = (f32x2){v0, v1};
                if (seg == 0) { *(LAS float*)(cb + CB_BR + ti * 4) = brp; *(LAS float*)(cb + CB_KR + ti * 4) = krp; if (vq == 0) P.rdotk[m * 8 + h] = rkp; }
            }
            __syncthreads();
        }
        { const LAS unsigned char* cb = lds + ((NBLK - 1) & 1) * CBSZ;
          const int tok = ptid >> 3, v2 = (ptid & 7) * 2;
          const LAS float* YPp = (const LAS float*)(cb + CB_YP) + (tok * 16 + v2) * 16;
          float y0 = 0.f, y1 = 0.f;
#pragma unroll
          for (int q4 = 0; q4 < 4; ++q4) { const f32x4 a = *(const LAS f32x4*)(YPp + 4 * q4), c = *(const LAS f32x4*)(YPp + 16 + 4 * q4); y0 += (a.x + a.y) + (a.z + a.w); y1 += (c.x + c.y) + (c.z + c.w); }
          const float br = *(const LAS float*)(cb + CB_BR + tok * 4), kr = *(const LAS float*)(cb + CB_KR + tok * 4);
          const f32x2 sa = *(const LAS f32x2*)(cb + CB_SA + (tok * 16 + v2) * 4), vv = *(const LAS f32x2*)(cb + CB_V + (tok * 16 + v2) * 4);
          y0 += sa.x * br + vv.x * kr; y1 += sa.y * br + vv.y * kr;
          const size_t m = mrow0 + (size_t)(NBLK - 1) * TB + tok;
          *(GAS unsigned*)(P.yraw + m * 512 + 64 * h + 16 * vq + v2) = pk2(y0, y1); }
    } else {
        const int vi = 4 * wid + (lane >> 4), cg = lane & 15;
        f32x2 s01 = {0.f, 0.f}, s23 = {0.f, 0.f};
        __syncthreads();
        __builtin_amdgcn_s_setprio(3);
        const unsigned lo4 = (unsigned)(4 * cg) * 4u, lo8 = (unsigned)(4 * cg) * 8u;
        for (int blk = 0; blk < NBLK; ++blk) {
            const LAS unsigned char* cb = lds + (blk & 1) * CBSZ;
            f32x4 kwa = *(const LAS f32x4*)(cb + CB_KW + lo8), kwb = *(const LAS f32x4*)(cb + CB_KW + lo8 + 16);
            f32x4 w4 = *(const LAS f32x4*)(cb + CB_W + lo4), b4 = *(const LAS f32x4*)(cb + CB_B + lo4), k4 = *(const LAS f32x4*)(cb + CB_K + lo4);
            float vv = *(const LAS float*)(cb + CB_V + vi * 4);
#pragma unroll 4
            for (int tok = 0; tok < TB; ++tok) {
                const int tn = tok + 1 < TB ? tok + 1 : tok;
                const f32x4 nkwa = *(const LAS f32x4*)(cb + CB_KW + tn * 512 + lo8), nkwb = *(const LAS f32x4*)(cb + CB_KW + tn * 512 + lo8 + 16);
                const f32x4 nw4 = *(const LAS f32x4*)(cb + CB_W + tn * 256 + lo4), nb4 = *(const LAS f32x4*)(cb + CB_B + tn * 256 + lo4), nk4 = *(const LAS f32x4*)(cb + CB_K + tn * 256 + lo4);
                const float nvv = *(const LAS float*)(cb + CB_V + (tn * 16 + vi) * 4);
                f32x2 p = (f32x2){s01.x, s01.x} * (f32x2){kwa.x, kwa.y};
                p += (f32x2){s01.y, s01.y} * (f32x2){kwa.z, kwa.w};
                p += (f32x2){s23.x, s23.x} * (f32x2){kwb.x, kwb.y};
                p += (f32x2){s23.y, s23.y} * (f32x2){kwb.z, kwb.w};
                *(LAS float*)(cb + CB_YP + ((tok * 16 + vi) * 16 + cg) * 4) = p.y;
                const f32x2 t01 = s01 * (f32x2){w4.x, w4.y} + (f32x2){k4.x, k4.y} * vv, t23 = s23 * (f32x2){w4.z, w4.w} + (f32x2){k4.z, k4.w} * vv;
                const float d1 = red16(p.x);
                s01 = t01 - (f32x2){b4.x, b4.y} * d1; s23 = t23 - (f32x2){b4.z, b4.w} * d1;
                *(LAS float*)(cb + CB_SA + (tok * 16 + vi) * 4) = -d1;
                kwa = nkwa; kwb = nkwb; w4 = nw4; b4 = nb4; k4 = nk4; vv = nvv;
            }
            __syncthreads();
        }
        __builtin_amdgcn_s_setprio(0);
    }
    __syncthreads();
}

struct Dsa1P { const bf16* ZR; const bf16* KI; unsigned* bitm; gu32* done; };
namespace dsa1 {
constexpr int CAP = 769  , PRUNE_AT = 512, KEEP = 256;
constexpr int L_BUF = 0, L_CNT = 32 * CAP * 4, L_THR = L_CNT + 128, L_THRK = L_THR + 128, L_HIST = ((L_THRK + 128 + 15) / 16) * 16, L_MROW = L_HIST + 8 * 1024, L_QF = L_MROW + 8 * 1024, QFP = 1040, L_END = L_QF + 32 * QFP;
static_assert(L_END <= LDS_MISC, "dsa1 LDS");
__device__ __forceinline__ unsigned packkey(float s, int keyidx) { const unsigned bits = __float_as_uint(s); const unsigned u = bits ^ ((unsigned)((int)bits >> 31) | 0x80000000u); return (u & 0xFFFFE000u) | (unsigned)(8191 - keyidx); }
__device__ __forceinline__ float thr_of(unsigned key) { const unsigned u = key & 0xFFFFE000u; const unsigned bits = (u & 0x80000000u) ? (u ^ 0x80000000u) : ~u; return __uint_as_float(bits); }
__device__ __forceinline__ void prune(LAS unsigned char* lds, int qq, int wid, int lane, bool exact) {
    asm volatile("" : "+v"(lane));
    LAS unsigned* buf = (LAS unsigned*)(lds + L_BUF) + qq * CAP; LAS unsigned* cnt = (LAS unsigned*)(lds + L_CNT); LAS float* thr = (LAS float*)(lds + L_THR); LAS unsigned* thrk = (LAS unsigned*)(lds + L_THRK);
    LAS unsigned* hist = (LAS unsigned*)(lds + L_HIST) + wid * 256;
    const int n = (int)cnt[qq];
    unsigned e[12];
#pragma unroll
    for (int k = 0; k < 12; ++k) e[k] = (lane + 64 * k < n) ? buf[lane + 64 * k] : 0u;
    const unsigned tk = thrk[qq];
    unsigned cut = 0u; bool have = false;
    if (!exact && tk != 0u) {
        const unsigned base16 = tk >> 16;
        *(LAS v4u*)(hist + 4 * lane) = (v4u){0u, 0u, 0u, 0u};
        LDS_WAIT(); asm volatile("" ::: "memory");
#pragma unroll
        for (int k = 0; k < 12; ++k) if (lane + 64 * k < n) { unsigned bn = (e[k] >> 16) - base16; bn = bn > 255u ? 255u : bn; (void)__hip_atomic_fetch_add(hist + bn, 1u, __ATOMIC_RELAXED, __HIP_MEMORY_SCOPE_WORKGROUP); }
        LDS_WAIT(); asm volatile("" ::: "memory");
        const v4u hv = *(const LAS v4u*)(hist + 4 * lane);
        const int tot = (int)(hv.x + hv.y + hv.z + hv.w);
        int suf = tot;
#pragma unroll
        for (int off = 1; off < 64; off <<= 1) { const int t = __shfl_down(suf, off); if (lane + off < 64) suf += t; }
        int above = suf - tot; int dsel = -1, csel = 0;
        { const int h3 = (int)hv.w, h2 = (int)hv.z, h1 = (int)hv.y, h0 = (int)hv.x;
          if (above < KEEP && KEEP <= above + h3) { dsel = 4 * lane + 3; csel = above + h3; } above += h3;
          if (above < KEEP && KEEP <= above + h2) { dsel = 4 * lane + 2; csel = above + h2; } above += h2;
          if (above < KEEP && KEEP <= above + h1) { dsel = 4 * lane + 1; csel = above + h1; } above += h1;
          if (above < KEEP && KEEP <= above + h0) { dsel = 4 * lane + 0; csel = above + h0; } }
        const unsigned long long bm = __ballot(dsel >= 0);
        const int src = bm ? (int)__builtin_ctzll(bm) : 0;
        const int d = __shfl(dsel, src), cd = __shfl(csel, src);
        LDS_WAIT(); asm volatile("" ::: "memory");
        if (bm != 0ull && cd <= KEEP + 128) { cut = (base16 + (unsigned)d) << 16; have = true; }
    }
    if (!have) {
        unsigned prefix = 0u; int want = KEEP;
#pragma unroll 1
        for (int p = 0; p < 4; ++p) {
            const int shift = 24 - 8 * p;
            *(LAS v4u*)(hist + 4 * lane) = (v4u){0u, 0u, 0u, 0u};
            LDS_WAIT(); asm volatile("" ::: "memory");
#pragma unroll
            for (int k = 0; k < 12; ++k) { const bool in = (lane + 64 * k < n) && (p == 0 || (e[k] >> (shift + 8)) == (prefix >> (shift + 8)));
                if (in) (void)__hip_atomic_fetch_add(hist + ((e[k] >> shift) & 255u), 1u, __ATOMIC_RELAXED, __HIP_MEMORY_SCOPE_WORKGROUP); }
            LDS_WAIT(); asm volatile("" ::: "memory");
            const v4u hv = *(const LAS v4u*)(hist + 4 * lane);
            const int tot = (int)(hv.x + hv.y + hv.z + hv.w);
            int suf = tot;
#pragma unroll
            for (int off = 1; off < 64; off <<= 1) { const int t = __shfl_down(suf, off); if (lane + off < 64) suf += t; }
            int above = suf - tot;
            int dsel = -1, asel = 0;
            { const int h3 = (int)hv.w, h2 = (int)hv.z, h1 = (int)hv.y, h0 = (int)hv.x;
              if (above < want && want <= above + h3) { dsel = 4 * lane + 3; asel = above; } above += h3;
              if (above < want && want <= above + h2) { dsel = 4 * lane + 2; asel = above; } above += h2;
              if (above < want && want <= above + h1) { dsel = 4 * lane + 1; asel = above; } above += h1;
              if (above < want && want <= above + h0) { dsel = 4 * lane + 0; asel = above; } }
            const unsigned long long bm = __ballot(dsel >= 0);
            const int src = bm ? (int)__builtin_ctzll(bm) : 0;
            const int d = __shfl(dsel, src), ab = __shfl(asel, src);
            prefix |= ((unsigned)(d < 0 ? 0 : d)) << shift; want -= ab;
            LDS_WAIT(); asm volatile("" ::: "memory");
        }
        cut = prefix;
    }
    int base = 0;
#pragma unroll
    for (int k = 0; k < 12; ++k) { const bool keep = (lane + 64 * k < n) && e[k] >= cut; const unsigned long long mk = __ballot(keep);
        const int pos = base + (int)__builtin_amdgcn_mbcnt_hi((unsigned)(mk >> 32), __builtin_amdgcn_mbcnt_lo((unsigned)mk, 0u));
        if (keep) buf[pos] = e[k]; base += (int)__builtin_popcountll(mk); }
    if (lane == 0) { cnt[qq] = (unsigned)base; thr[qq] = thr_of(cut); thrk[qq] = cut; }
    LDS_WAIT(); asm volatile("" ::: "memory");
}
}
__device__ __forceinline__ void dsa1_unit(const Dsa1P& P, int u, LAS unsigned char* lds) {
    using namespace dsa1;
    const int tid = otid_(), wid = __builtin_amdgcn_readfirstlane(tid >> 6), lane = tid & 63, q = lane & 31, hi = lane >> 5;
    const int b = u & 1, qb32 = 255 - (u >> 1), t0 = 32 * qb32;
    const size_t brow = (size_t)b * T;
    LAS unsigned* buf = (LAS unsigned*)(lds + L_BUF); LAS unsigned* cnt = (LAS unsigned*)(lds + L_CNT); LAS float* thr = (LAS float*)(lds + L_THR);
    if (tid < 32) { cnt[tid] = 0u; thr[tid] = -__builtin_inff(); ((LAS unsigned*)(lds + L_THRK))[tid] = 0u; }
    const bf16* qrow = P.ZR + (brow + t0 + q) * ZP;
    { const int r = tid >> 4, sg = tid & 15; const bf16* src = P.ZR + (brow + t0 + r) * ZP + ZC_QI + 32 * sg;
#pragma unroll
      for (int j = 0; j < 4; ++j) *(LAS v4u*)(lds + L_QF + r * QFP + 64 * sg + 16 * j) = *(const GAS v4u*)(src + 8 * j); }
    float wq[8];
    { const v4u w = *(const GAS v4u*)(qrow + ZC_WI); const float c = 0.35355339059327373f * 0.125f;
      wq[0] = bflo(w.x) * c; wq[1] = bfhi(w.x) * c; wq[2] = bflo(w.y) * c; wq[3] = bfhi(w.y) * c; wq[4] = bflo(w.z) * c; wq[5] = bfhi(w.z) * c; wq[6] = bflo(w.w) * c; wq[7] = bfhi(w.w) * c; }
    const int tq = t0 + q;
    const int nsteps = (t0 + 32 + 255) >> 8;
    __syncthreads();
    float th = -__builtin_inff();
    bf16x8 afn[4];
    { const int k0 = 32 * wid; const bf16* krow = P.KI + (brow + (k0 <= t0 + 31 ? k0 : 0) + q) * 64 + 8 * hi;
#pragma unroll
      for (int s = 0; s < 4; ++s) afn[s] = *(const GAS bf16x8*)(krow + 16 * s); }
    for (int st = 0; st < nsteps; ++st) {
        const int key0 = 256 * st + 32 * wid;
        bf16x8 af[4];
#pragma unroll
        for (int s = 0; s < 4; ++s) af[s] = afn[s];
        { const int k1 = key0 + 256; const bf16* krow = P.KI + (brow + (k1 <= t0 + 31 ? k1 : 0) + q) * 64 + 8 * hi;
#pragma unroll
          for (int s = 0; s < 4; ++s) afn[s] = *(const GAS bf16x8*)(krow + 16 * s); }
        if (key0 <= t0 + 31) {
            f32x16 sc;
#pragma unroll
            for (int i = 0; i < 16; ++i) sc[i] = 0.f;
            unsigned qfo = (unsigned)(L_QF + q * QFP + 16 * hi); asm volatile("" : "+v"(qfo));
#pragma unroll
            for (int hd = 0; hd < 8; ++hd) {
                f32x16 acc;
#pragma unroll
                for (int i = 0; i < 16; ++i) acc[i] = 0.f;
#pragma unroll
                for (int s = 0; s < 4; ++s) { const bf16x8 qb = *(const LAS bf16x8*)(lds + qfo + hd * 128 + 32 * s);
                    acc = __builtin_amdgcn_mfma_f32_32x32x16_bf16(af[s], qb, acc, 0, 0, 0); }
#pragma unroll
                for (int i = 0; i < 16; ++i) sc[i] = fmaf(fmaxf(acc[i], 0.f), wq[hd], sc[i]);
                __builtin_amdgcn_sched_barrier(0);
            }
            const bool diag = key0 + 31 > t0;
            unsigned pm = 0u;
#pragma unroll
            for (int i = 0; i < 16; ++i) { const int kidx = key0 + (i & 3) + 8 * (i >> 2) + 4 * hi; const bool ok = (sc[i] >= th) && (!diag || kidx <= tq); pm |= ok ? (1u << i) : 0u; }
            const int np = __builtin_popcount(pm);
            if (np > 0) {
                int pos = (int)__hip_atomic_fetch_add(cnt + q, (unsigned)np, __ATOMIC_RELAXED, __HIP_MEMORY_SCOPE_WORKGROUP);
                LAS unsigned* bq = buf + q * CAP;
#pragma unroll
                for (int i = 0; i < 16; ++i) if (pm & (1u << i)) { const int kidx = key0 + (i & 3) + 8 * (i >> 2) + 4 * hi; bq[pos] = packkey(sc[i], kidx); ++pos; }
            }
        }
        __syncthreads();
        { unsigned nm = (unsigned)__ballot(cnt[q] > (unsigned)PRUNE_AT); int i = 0;
          while (nm) { const int qq = __builtin_ctz(nm); nm &= nm - 1u; if ((i & 7) == wid) prune(lds, qq, wid, lane, false); ++i; } }
        __syncthreads();
        th = thr[q];
    }
    LAS unsigned* mrow = (LAS unsigned*)(lds + L_MROW) + wid * 256;
#pragma unroll 1
    for (int k = 0; k < 4; ++k) {
        const int qq = wid + 8 * k;
        if (cnt[qq] > (unsigned)KEEP) prune(lds, qq, wid, lane, true);
        const int nf = (int)cnt[qq];
        *(LAS v4u*)(mrow + 4 * lane) = (v4u){0u, 0u, 0u, 0u};
        LDS_WAIT(); asm volatile("" ::: "memory");
#pragma unroll
        for (int j = 0; j < 4; ++j) { const int idx = lane + 64 * j; if (idx < nf) { const unsigned e = buf[qq * CAP + idx]; const unsigned key = 8191u - (e & 0x1FFFu); (void)__hip_atomic_fetch_or(mrow + (key >> 5), 1u << (key & 31u), __ATOMIC_RELAXED, __HIP_MEMORY_SCOPE_WORKGROUP); } }
        LDS_WAIT(); asm volatile("" ::: "memory");
        unsigned long long* grow = (unsigned long long*)(P.bitm + (brow + t0 + qq) * 256);
#pragma unroll
        for (int j = 0; j < 2; ++j) { const int w2 = lane + 64 * j; const unsigned long long v = (unsigned long long)mrow[2 * w2] | ((unsigned long long)mrow[2 * w2 + 1] << 32);
            __hip_atomic_store(grow + w2, v, RLX_AGENT); }
        LDS_WAIT(); asm volatile("" ::: "memory");
    }
    VM_WAIT();
    __syncthreads();
    if (tid == 0) __hip_atomic_fetch_add(P.done + 64 * (b * 32 + (t0 >> 8)), 1u, RLX_AGENT);
}

struct RPostP { const bf16* ZR; bf16* Q3; const bf16* yraw; const float* rdotk; const float *mu, *gup, *lnw, *lnb; };
__device__ __forceinline__ void rwkv_post(const RPostP& P, LAS unsigned char* lds) {
    const int tid = otid_(), lane = tid & 63, h = __builtin_amdgcn_readfirstlane(tid >> 6), c16 = lane & 15, quad = lane >> 4;
    constexpr int SP = 272;
    LAS float* GT = (LAS float*)(lds + 64 * SP);
    bf16x8 bfr[4][4];
#pragma unroll
    for (int ct = 0; ct < 4; ++ct)
#pragma unroll
        for (int s = 0; s < 4; ++s) { const float* gp = P.gup + (size_t)(32 * s + 8 * quad) * 512 + 64 * h + 16 * ct + c16;
            v4u w; w.x = pk2(gp[0], gp[512]); w.y = pk2(gp[1024], gp[1536]); w.z = pk2(gp[2048], gp[2560]); w.w = pk2(gp[3072], gp[3584]); bfr[ct][s] = __builtin_bit_cast(bf16x8, w); }
    float muv[4], lnw[4], lnb[4];
#pragma unroll
    for (int ct = 0; ct < 4; ++ct) { const int ch = 64 * h + 16 * ct + c16; muv[ct] = P.mu[1024 + ch]; lnw[ct] = P.lnw[ch]; lnb[ct] = P.lnb[ch]; }
    const int stok = tid >> 3, sseg = tid & 7;
#pragma unroll 1
    for (int m0 = blockIdx.x * 64; m0 < M; m0 += gridDim.x * 64) {
        {   const size_t m = (size_t)m0 + stok; const int t = (int)(m & (T - 1));
            float gv[16], pv[16];
            { const v4u a = *(const GAS v4u*)(P.ZR + m * ZP + ZC_GC + 16 * sseg), c = *(const GAS v4u*)(P.ZR + m * ZP + ZC_GC + 16 * sseg + 8);
              gv[0] = bflo(a.x); gv[1] = bfhi(a.x); gv[2] = bflo(a.y); gv[3] = bfhi(a.y); gv[4] = bflo(a.z); gv[5] = bfhi(a.z); gv[6] = bflo(a.w); gv[7] = bfhi(a.w);
              gv[8] = bflo(c.x); gv[9] = bfhi(c.x); gv[10] = bflo(c.y); gv[11] = bfhi(c.y); gv[12] = bflo(c.z); gv[13] = bfhi(c.z); gv[14] = bflo(c.w); gv[15] = bfhi(c.w); }
            if (t > 0) { const v4u a = *(const GAS v4u*)(P.ZR + (m - 1) * ZP + ZC_GC + 16 * sseg), c = *(const GAS v4u*)(P.ZR + (m - 1) * ZP + ZC_GC + 16 * sseg + 8);
              pv[0] = bflo(a.x); pv[1] = bfhi(a.x); pv[2] = bflo(a.y); pv[3] = bfhi(a.y); pv[4] = bflo(a.z); pv[5] = bfhi(a.z); pv[6] = bflo(a.w); pv[7] = bfhi(a.w);
              pv[8] = bflo(c.x); pv[9] = bfhi(c.x); pv[10] = bflo(c.y); pv[11] = bfhi(c.y); pv[12] = bflo(c.z); pv[13] = bfhi(c.z); pv[14] = bflo(c.w); pv[15] = bfhi(c.w); }
            else {
#pragma unroll
              for (int e = 0; e < 16; ++e) pv[e] = 0.f; }
            float sg[16];
#pragma unroll
            for (int e = 0; e < 16; ++e) { const float mu = P.mu[1664 + 16 * sseg + e]; sg[e] = sigm(gv[e] + (pv[e] - gv[e]) * mu); }
            v4u o0, o1; o0.x = pk2(sg[0], sg[1]); o0.y = pk2(sg[2], sg[3]); o0.z = pk2(sg[4], sg[5]); o0.w = pk2(sg[6], sg[7]); o1.x = pk2(sg[8], sg[9]); o1.y = pk2(sg[10], sg[11]); o1.z = pk2(sg[12], sg[13]); o1.w = pk2(sg[14], sg[15]);
            *(LAS v4u*)(lds + stok * SP + 32 * sseg) = o0; *(LAS v4u*)(lds + stok * SP + 32 * sseg + 16) = o1;
        }
        __syncthreads();
#pragma unroll 1
        for (int rt = 0; rt < 4; ++rt) {
            f32x4 acc[4];
#pragma unroll
            for (int ct = 0; ct < 4; ++ct) acc[ct] = (f32x4){0.f, 0.f, 0.f, 0.f};
#pragma unroll
            for (int s = 0; s < 4; ++s) { const bf16x8 af = *(const LAS bf16x8*)(lds + (16 * rt + c16) * SP + (32 * s + 8 * quad) * 2);
#pragma unroll
                for (int ct = 0; ct < 4; ++ct) acc[ct] = __builtin_amdgcn_mfma_f32_16x16x32_bf16(af, bfr[ct][s], acc[ct], 0, 0, 0); }
#pragma unroll
            for (int ct = 0; ct < 4; ++ct)
#pragma unroll
                for (int j = 0; j < 4; ++j) GT[(4 * quad + j) * 512 + 64 * h + 16 * ct + c16] = acc[ct][j];
            __syncthreads();
            {   const int vtok = tid >> 5, vseg = tid & 31, ch0 = 16 * vseg, vh = vseg >> 2;
                const size_t m = (size_t)m0 + 16 * rt + vtok; const int t = (int)(m & (T - 1));
                float y[16], vv[16], vp[16], g[16];
                { const v4u a = *(const GAS v4u*)(P.yraw + m * 512 + ch0), c = *(const GAS v4u*)(P.yraw + m * 512 + ch0 + 8);
                  y[0] = bflo(a.x); y[1] = bfhi(a.x); y[2] = bflo(a.y); y[3] = bfhi(a.y); y[4] = bflo(a.z); y[5] = bfhi(a.z); y[6] = bflo(a.w); y[7] = bfhi(a.w);
                  y[8] = bflo(c.x); y[9] = bfhi(c.x); y[10] = bflo(c.y); y[11] = bfhi(c.y); y[12] = bflo(c.z); y[13] = bfhi(c.z); y[14] = bflo(c.w); y[15] = bfhi(c.w); }
                { const v4u a = *(const GAS v4u*)(P.ZR + m * ZP + ZC_RV + ch0), c = *(const GAS v4u*)(P.ZR + m * ZP + ZC_RV + ch0 + 8);
                  vv[0] = bflo(a.x); vv[1] = bfhi(a.x); vv[2] = bflo(a.y); vv[3] = bfhi(a.y); vv[4] = bflo(a.z); vv[5] = bfhi(a.z); vv[6] = bflo(a.w); vv[7] = bfhi(a.w);
                  vv[8] = bflo(c.x); vv[9] = bfhi(c.x); vv[10] = bflo(c.y); vv[11] = bfhi(c.y); vv[12] = bflo(c.z); vv[13] = bfhi(c.z); vv[14] = bflo(c.w); vv[15] = bfhi(c.w); }
                if (t > 0) { const v4u a = *(const GAS v4u*)(P.ZR + (m - 1) * ZP + ZC_RV + ch0), c = *(const GAS v4u*)(P.ZR + (m - 1) * ZP + ZC_RV + ch0 + 8);
                  vp[0] = bflo(a.x); vp[1] = bfhi(a.x); vp[2] = bflo(a.y); vp[3] = bfhi(a.y); vp[4] = bflo(a.z); vp[5] = bfhi(a.z); vp[6] = bflo(a.w); vp[7] = bfhi(a.w);
                  vp[8] = bflo(c.x); vp[9] = bfhi(c.x); vp[10] = bflo(c.y); vp[11] = bfhi(c.y); vp[12] = bflo(c.z); vp[13] = bfhi(c.z); vp[14] = bflo(c.w); vp[15] = bfhi(c.w); }
                else {
#pragma unroll
                  for (int e = 0; e < 16; ++e) vp[e] = 0.f; }
#pragma unroll
                for (int e4 = 0; e4 < 4; ++e4) { const f32x4 gq = *(const LAS f32x4*)(GT + vtok * 512 + ch0 + 4 * e4); g[4 * e4] = gq.x; g[4 * e4 + 1] = gq.y; g[4 * e4 + 2] = gq.z; g[4 * e4 + 3] = gq.w; }
                float sm = 0.f;
#pragma unroll
                for (int e = 0; e < 16; ++e) sm += y[e];
                sm = scan::dpp_add<0xB1>(sm); sm = scan::dpp_add<0x4E>(sm);
                const float mean = sm * (1.f / 64.f); float vs = 0.f;
#pragma unroll
                for (int e = 0; e < 16; ++e) { y[e] -= mean; vs += y[e] * y[e]; }
                vs = scan::dpp_add<0xB1>(vs); vs = scan::dpp_add<0x4E>(vs);
                const float rstd = __builtin_amdgcn_rsqf(vs * (1.f / 64.f) + 64e-5f);
                const float rk = P.rdotk[m * 8 + vh];
                unsigned ow[8];
#pragma unroll
                for (int e = 0; e < 16; e += 2) { float o2[2];
#pragma unroll
                    for (int d = 0; d < 2; ++d) { const int ch = ch0 + e + d; const float v = vv[e + d] + (vp[e + d] - vv[e + d]) * P.mu[1024 + ch];
                        o2[d] = (y[e + d] * rstd * P.lnw[ch] + P.lnb[ch] + rk * v) * g[e + d]; }
                    ow[e >> 1] = pk2(o2[0], o2[1]); }
                *(GAS v4u*)(P.Q3 + m * QP + 512 + ch0) = (v4u){ow[0], ow[1], ow[2], ow[3]}; *(GAS v4u*)(P.Q3 + m * QP + 512 + ch0 + 8) = (v4u){ow[4], ow[5], ow[6], ow[7]};
            }
            __syncthreads();
        }
        __syncthreads();
    }
}
struct DPostP { const bf16* O1; const bf16* O2; bf16* Q3; const float *lq1, *lk1, *lq2, *lk2, *subln; float lambda_init; };
__device__ __forceinline__ void diff_post(const DPostP& P, int gw, int NGW, int lane) {
    const float lam = __expf(wave_sum(P.lq1[lane] * P.lk1[lane])) - __expf(wave_sum(P.lq2[lane] * P.lk2[lane])) + P.lambda_init;
    const float s0 = P.subln[2 * lane] * (1.f - P.lambda_init), s1 = P.subln[2 * lane + 1] * (1.f - P.lambda_init);
    for (int it = gw; it < M * 4; it += NGW) {
        const size_t m = (size_t)(it >> 2); const int hh = it & 3;
        const unsigned a = *(const GAS unsigned*)(P.O1 + m * 512 + 128 * hh + 2 * lane), c = *(const GAS unsigned*)(P.O2 + m * 512 + 128 * hh + 2 * lane);
        const float x0 = bflo(a) - lam * bflo(c), x1 = bfhi(a) - lam * bfhi(c);
        const float r = __builtin_amdgcn_rsqf(wave_sum(x0 * x0 + x1 * x1) * (1.f / 128.f) + NORM_EPS);
        *(GAS unsigned*)(P.Q3 + m * QP + 1024 + 128 * hh + 2 * lane) = pk2(x0 * r * s0, x1 * r * s1);
    }
}

__device__ __forceinline__ int q_fetch(gu32* head, volatile LAS int* slot) {
    if (threadIdx.x == 0) *slot = (int)__hip_atomic_fetch_add(head, 1u, RLX_AGENT);
    __syncthreads();
    const int v = __builtin_amdgcn_readfirstlane(*slot);
    __syncthreads();
    return v;
}

struct Args { const float* in[32]; float* out; unsigned char* ws; int ph_lo, ph_hi; };
__device__ __forceinline__ const float* kin_(int i) { const char* ka = (const char*)__builtin_amdgcn_kernarg_segment_ptr(); unsigned off = (unsigned)i * 8u; asm volatile("" : "+s"(off)); return *(const float* const*)(ka + off); }
#define KIN(i) kin_(i)
#define XOUT ((float*)kin_(32))
__device__ __forceinline__ unsigned char* kws_() { return (unsigned char*)kin_(33); }
__device__ __forceinline__ int kint_(int byteoff) { const char* ka = (const char*)__builtin_amdgcn_kernarg_segment_ptr(); unsigned off = (unsigned)byteoff; asm volatile("" : "+s"(off)); return *(const int*)(ka + off); }
constexpr int PH_L = 14;
constexpr int N_PHASES = 1 + NLAYER * PH_L;

#define G ((int)gridDim.x)
#define bid ((int)blockIdx.x)
#define gw (bid * NWAVES + wave)
#define NGW (G * NWAVES)
#define MISC ((volatile LAS unsigned*)(lds + LDS_MISC))
#define IN(k) (kint_(272) <= (k) && (k) < kint_(276))
#define SEAM(k) do { if ((k) + 1 < kint_(276)) { XcdBarrier bar_; bar_.bar = (unsigned*)(kws_() + WS_CTL) + CW_BAR; bar_.x = xb_xcc_id(); bar_.st = MISC + 8; xcd_barrier(bar_); } } while (0)
#define WSL() unsigned char* wsl = kws_(); const int tid = otid_(), lane = tid & 63, wave = __builtin_amdgcn_readfirstlane(tid >> 6); (void)lane; (void)wave
#define WFu ((bf16*)(wsl + WS_WF))
#define WFd ((bf16*)(wsl + WS_WF_DOWN))
#define WMi ((bf16*)(wsl + WS_WM))
#define WMb ((bf16*)(wsl + WS_WM_BR))
#define WMo ((bf16*)(wsl + WS_WM_OUT))
#define XN ((bf16*)(wsl + WS_XN))
#define Q3 ((bf16*)(wsl + WS_Q3))
#define ZR ((bf16*)(wsl + WS_ZR))
#define YP ((bf16*)(wsl + WS_R2))
#define HB ZR
#define G3 ZR
#define MG ((bf16*)(wsl + WS_MG))
#define O1 ((bf16*)(wsl + WS_R2))
#define O2 ((bf16*)(wsl + WS_R2) + (size_t)M * 512)
#define YRAW ((bf16*)(wsl + WS_YRAW))
#define BITM ((unsigned*)(wsl + WS_BITM))
#define RDOTK ((float*)(wsl + WS_RDOTK))
#define X1B ((bf16*)(wsl + WS_X1))
#define KID ((bf16*)(wsl + WS_KID))
#define A8B ((unsigned char*)(wsl + WS_A8))
#define CTL ((gu32*)(wsl + WS_CTL))
#define cscr ((LAS float*)(lds + wave * 16384))

#define CONV_FFN(l_, f_) do { const int gi_ = (f_) ? 29 : 3; \
        MapUp mu_{KIN(gi_) + (size_t)(l_) * DM * FF, KIN(gi_ + 1) + (size_t)(l_) * DM * FF, FF}; conv_matrix(mu_, DM, 2 * FF, WFu, cscr, gw, NGW, lane); \
        MapIdent md_{KIN(gi_ + 2) + (size_t)(l_) * FF * DM, DM}; conv_matrix(md_, FF, DM, WFd, cscr, gw, NGW, lane); } while (0)
#define CONV_MIX(l_) do { MapWin mw_{KIN(8) + (size_t)(l_) * DM * NIN, NIN}; conv_matrix(mw_, DM, 8704, WMi, cscr, gw, NGW, lane); \
        for (int n_ = 0; n_ < 3; ++n_) { MapIdent mb_{KIN(25) + ((size_t)(l_) * 3 + n_) * 512 * DM, DM}; conv_matrix(mb_, 512, DM, WMb + (size_t)n_ * DM * 512, cscr, gw, NGW, lane); } \
        MapIdent mo_{KIN(26) + (size_t)(l_) * DM * DM, DM}; conv_matrix(mo_, DM, DM, WMo, cscr, gw, NGW, lane); } while (0)

template <int L, int F> __device__ __forceinline__ void ffn_part(LAS unsigned char* lds) {
    constexpr int l = L, f = F, pb = 1 + PH_L * L, pf = pb + (F ? 11 : 0);
            if (IN(pf + 0)) { WSL();
                pg8::Gemm g{XN, WFu, M, 2 * FF, DM, DM}; pg8::StaticOrder S; S.init(M, 2 * FF, G, bid);
                pg8::EpiSwiGLU E{HB, FF};
                pg8::gemm_phase<pg8::EpiSwiGLU, pg8::StaticOrder, true, true>(lds, g, S, E);
                SEAM(pf + 0);
            }
            if (IN(pf + 1)) { WSL();
                pg8::Gemm g{HB, WFd, M, DM, FF, FF}; pg8::StaticOrder S; S.init(M, DM, G, bid);
                pg8::EpiStore<0> E{YP, DM, YP, DM, 1 << 30};
                pg8::gemm_phase<pg8::EpiStore<0>, pg8::StaticOrder, true, true>(lds, g, S, E);
                SEAM(pf + 1);
            }
            if (IN(pf + 2)) { WSL();
                const float* base = (l == 0 && f == 0) ? KIN(0) : XOUT;
                const float* gpost = KIN(f ? 28 : 2) + l * DM;
                const float* gnext = f == 0 ? KIN(6) + l * DM : (l + 1 < NLAYER ? KIN(1) + (l + 1) * DM : nullptr);
#if PROBE
                float osc = 1.f;
                if (l == NLAYER - 1 && f == 1) { const float num = *(const float*)(wsl + WS_CTL + 4 * CW_PROBE), den = *(const float*)(wsl + WS_CTL + 4 * (CW_PROBE + 1)); osc = 1.f + 4.f * sqrtf(num / fmaxf(den, 1e-30f)); }
                rownorm_rows(base, YP, 0.5f, gpost, XOUT, gnext, gnext ? XN : nullptr, gw, NGW, lane, osc);
#else
                rownorm_rows(base, YP, 0.5f, gpost, XOUT, gnext, gnext ? XN : nullptr, gw, NGW, lane);
#endif
                if (f == 1 && l + 1 < NLAYER) { CONV_FFN(l + 1, 0); CONV_MIX(l + 1); }
                SEAM(pf + 2);
            }
}
template <int L> __device__ __forceinline__ void mixer_part(LAS unsigned char* lds, unsigned char* lds_) {
    constexpr int l = L, pb = 1 + PH_L * L;
            const int pm = pb + 3;
            if (IN(pm + 0)) { WSL();
                pg8::Gemm g{XN, WMi, M, 5632, DM, DM}; pg8::StaticOrder S; S.init(M, 5632, G, bid);
                pg8::EpiStore<0> E{Q3, QP, ZR, ZP, 6};
                pg8::gemm_phase<pg8::EpiStore<0>, pg8::StaticOrder, true, true>(lds, g, S, E);
                SEAM(pm + 0);
            }
            if (IN(pm + 1)) { WSL();
                PrepP pp{ZR, X1B, A8B, KID, KIN(9) + l * 1792, KIN(10) + l * 512, KIN(11) + l * 64 * 512, KIN(12) + l * 512, KIN(13) + l * 64 * 512};
                rwkv_prep(pp, lds);
                SEAM(pm + 1);
            }
            if (IN(pm + 2)) { WSL();
                volatile LAS int* slot = (volatile LAS int*)(MISC + 16);
                if (bid < 64) {
                    ScanP sp{Q3, ZR, X1B, A8B, YRAW, RDOTK, KIN(9) + l * 1792, KIN(15) + l * 512, KIN(16) + l * 512, KIN(17) + l * 512};
#ifndef NO_SCAN
                    rwkv_scan_unit(sp, bid, lds);
#ifdef SCAN_TWICE
                    rwkv_scan_unit(sp, bid, lds);
#endif
#endif
                }
                {
                    Dsa1P dp{ZR, KID, BITM, CTL + CW_DONE + 64 * 64 * l};
                    gu32* head = CTL + CW_Q + 64 * (3 * l + 0);
                    #ifndef NO_DSA1
                    for (int u = q_fetch(head, slot); u < 512; u = q_fetch(head, slot)) dsa1_unit(dp, u, lds);
#ifdef DUP_DSA1
                    { gu32* head2 = CTL + 10240 + 64 * (2 * l + 0); for (int u = q_fetch(head2, slot); u < 512; u = q_fetch(head2, slot)) dsa1_unit(dp, u, lds); }
#endif
#endif
                }
                {
                    gu32* head = CTL + CW_Q + 64 * (3 * l + 1);
                    typedef att::BlockRef<att::bf16, att::bf16> Ref;
#define DSA2_REF(i_, r_) do { const int qb_ = 31 - ((i_) >> 3), b_ = ((i_) >> 2) & 1, h_ = (i_) & 3; const size_t row_ = (size_t)b_ * T + 256 * qb_; \
        r_.Q = (const att::bf16*)(Q3 + row_ * QP + 128 * h_); r_.O = (att::bf16*)(Q3 + row_ * QP + 128 * h_); r_.K = (const att::bf16*)(ZR + (size_t)b_ * T * ZP + ZC_DK + 128 * h_); \
        r_.V = (const att::bf16*)(ZR + (size_t)b_ * T * ZP + ZC_DV + 128 * h_); r_.P0 = 256 * qb_; r_.koff = 0; r_.mask = BITM + row_ * 256; } while (0)
                    int ic = q_fetch(head, slot);
                    if (ic < 256) {
                        int in_ = q_fetch(head, slot);
                        Ref cur; DSA2_REF(ic, cur);
                        att::Seam<att::bf16> S;
                        att::causal_swa_prime<att::bf16, att::bf16, false>(cur, T, (char*)lds_, S);
                        for (;;) {
                            const bool last = in_ >= 256;
                            Ref nxt = cur; if (!last) DSA2_REF(in_, nxt);
                            {
                                if (tid == 0) { gu32* dw = CTL + CW_DONE + 64 * (64 * l + (((ic >> 2) & 1) * 32 + (31 - (ic >> 3)))); unsigned sp = 0;
                                    while (__hip_atomic_load(dw, RLX_AGENT) < 8u) { __builtin_amdgcn_s_sleep(2); if (++sp > (1u << 24)) { __hip_atomic_store(CTL + CW_TMO, 1u, RLX_AGENT); break; } }
                                    __builtin_amdgcn_fence(__ATOMIC_ACQUIRE, "agent"); asm volatile("s_waitcnt vmcnt(0)" ::: "memory"); }
                                __syncthreads();
                            }
#ifndef NO_DSA2
                            att::causal_swa_block<att::bf16, att::bf16, false, true, QP>(cur, nxt, T, T, (char*)lds_, S);
#endif
                            if (last) break;
                            cur = nxt; ic = in_; in_ = q_fetch(head, slot);
                        }
                    }
                }
                {
#ifdef DUP_DIFF
                  for (int rep_ = 0; rep_ < 2; ++rep_) {
                    gu32* head = rep_ ? CTL + 10240 + 64 * (2 * l + 1) : CTL + CW_Q + 64 * (3 * l + 2);
#else
                  {
                    gu32* head = CTL + CW_Q + 64 * (3 * l + 2);
#endif
                    typedef att::BlockRef<att::bf16, att::bf16> Ref;
#define DIFF_REF(i_, r_) do { const int qb_ = 31 - ((i_) >> 4), b_ = ((i_) >> 3) & 1, h_ = ((i_) >> 1) & 3, mp_ = (i_) & 1; const size_t row_ = (size_t)b_ * T + 256 * qb_; \
        r_.Q = (const att::bf16*)(Q3 + row_ * QP + 1024 + 128 * h_ + 64 * mp_); r_.O = (att::bf16*)((mp_ ? O2 : O1) + row_ * 512 + 128 * h_); \
        r_.K = (const att::bf16*)(ZR + (size_t)b_ * T * ZP + ZC_FK + 128 * h_); r_.V = (const att::bf16*)(ZR + (size_t)b_ * T * ZP + ZC_FV + 128 * h_); r_.P0 = 256 * qb_; r_.koff = 128 * mp_; r_.mask = nullptr; } while (0)
                    int ic = q_fetch(head, slot);
                    if (ic < 512) {
                        int in_ = q_fetch(head, slot);
                        Ref cur; DIFF_REF(ic, cur);
                        att::Seam<att::bf16> S;
                        att::causal_swa_prime<att::bf16, att::bf16, true>(cur, T, (char*)lds_, S);
                        for (;;) {
                            const bool last = in_ >= 512;
                            Ref nxt = cur; if (!last) DIFF_REF(in_, nxt);
#ifndef NO_DIFF
                            att::causal_swa_block<att::bf16, att::bf16, true, false, 512>(cur, nxt, T, T, (char*)lds_, S);
#endif
                            if (last) break;
                            cur = nxt; ic = in_; in_ = q_fetch(head, slot);
                        }
                    }
                  }
                }
                SEAM(pm + 2);
            }
            if (IN(pm + 3)) { WSL();
                RPostP rp{ZR, Q3, YRAW, RDOTK, KIN(9) + l * 1792, KIN(14) + l * 128 * 512, KIN(18) + l * 512, KIN(19) + l * 512};
#ifndef NO_RPOST
                rwkv_post(rp, lds);
#endif
                constexpr float lambda_init = L == 0 ? 0.2f : 0.35550906759096927f;
                DPostP dq{O1, O2, Q3, KIN(20) + l * 64, KIN(21) + l * 64, KIN(22) + l * 64, KIN(23) + l * 64, KIN(24) + l * 128, lambda_init};
                diff_post(dq, gw, NGW, lane);
                rownorm_rows(XOUT, nullptr, 0.f, nullptr, nullptr, KIN(6) + l * DM, XN, gw, NGW, lane);
                SEAM(pm + 3);
            }
            if (IN(pm + 4)) { WSL();
                pg8::Gemm g{XN, WMi + (size_t)5632 * DM, M, 3072, DM, DM}; pg8::StaticOrder S; S.init(M, 3072, G, bid);
#ifdef GATE_RAW
                pg8::EpiStore<0> E{G3, 3072, G3, 3072, 1 << 30};
                pg8::gemm_phase<pg8::EpiStore<0>, pg8::StaticOrder, true, true>(lds, g, S, E);
#else
                pg8::EpiStore<1> E{G3, 3072, G3, 3072, 1 << 30};
                pg8::gemm_phase<pg8::EpiStore<1>, pg8::StaticOrder, true, true>(lds, g, S, E);
#endif
                SEAM(pm + 4);
            }
            if (IN(pm + 5)) { WSL();
#pragma unroll 1
                for (int n = 0; n < 3; ++n) {
                    pg8::Gemm g{Q3 + 512 * n, WMb + (size_t)n * DM * 512, M, DM, 512, QP}; pg8::StaticOrder S; S.init(M, DM, G, bid);
                    pg8::EpiGateMul E{MG, DM, G3 + 1024 * n, 3072, n == 0 ? 1 : 0};
                    pg8::gemm_phase<pg8::EpiGateMul, pg8::StaticOrder, false, true>(lds, g, S, E);
                    VM_WAIT(); __syncthreads();
                }
                SEAM(pm + 5);
            }
            if (IN(pm + 6)) { WSL();
                pg8::Gemm g{MG, WMo, M, DM, DM, DM}; pg8::StaticOrder S; S.init(M, DM, G, bid);
                pg8::EpiStore<0> E{YP, DM, YP, DM, 1 << 30};
                pg8::gemm_phase<pg8::EpiStore<0>, pg8::StaticOrder, false, true>(lds, g, S, E);
                SEAM(pm + 6);
            }
            if (IN(pm + 7)) { WSL();
                rownorm_rows(XOUT, YP, 1.0f, KIN(7) + l * DM, XOUT, KIN(27) + l * DM, XN, gw, NGW, lane);
                CONV_FFN(l, 1);
                SEAM(pm + 7);
            }
}

__global__ void __launch_bounds__(NWAVES * 64, 2) mk_fwd(Args args) {
    extern __shared__ __attribute__((aligned(16))) unsigned char lds_[];
    LAS unsigned char* lds = (LAS unsigned char*)lds_;
    { const int tid = otid_(); if (tid < 64) MISC[tid] = 0u; }
    __syncthreads();
    (void)xcd_barrier_post((unsigned*)(kws_() + WS_CTL) + CW_BAR, MISC + 8);
    if (IN(0)) { WSL();
        CONV_FFN(0, 0); CONV_MIX(0);
        rownorm_rows(KIN(0), nullptr, 0.f, nullptr, nullptr, KIN(1), XN, gw, NGW, lane);
        SEAM(0);
    }
    ffn_part<0, 0>(lds); mixer_part<0>(lds, lds_); ffn_part<0, 1>(lds);
    ffn_part<1, 0>(lds); mixer_part<1>(lds, lds_); ffn_part<1, 1>(lds);
}

#if PROBE
__device__ __forceinline__ void probe_acc(float num, float den, float* ctlf) {
    __shared__ float rn[256], rd[256];
    rn[threadIdx.x] = num; rd[threadIdx.x] = den; __syncthreads();
    for (int o = 128; o > 0; o >>= 1) { if ((int)threadIdx.x < o) { rn[threadIdx.x] += rn[threadIdx.x + o]; rd[threadIdx.x] += rd[threadIdx.x + o]; } __syncthreads(); }
    if (threadIdx.x == 0) { atomicAdd(ctlf + CW_PROBE, rn[0]); atomicAdd(ctlf + CW_PROBE + 1, rd[0]); }
}
__global__ void __launch_bounds__(256) probe_ffn(const unsigned char* ws, const float* Wg, const float* Wu, const float* Wd) {
    __shared__ float xn[1024]; __shared__ float hid[2816];
    const int m = 777 + 1931 * blockIdx.x, tid = threadIdx.x;
    const bf16* XNp = (const bf16*)(ws + WS_XN); const bf16* YPp = (const bf16*)(ws + WS_R2);
    for (int k = tid; k < 1024; k += 256) xn[k] = bf1(XNp[(size_t)m * 1024 + k]);
    __syncthreads();
    for (int j = tid; j < 2816; j += 256) { float g = 0.f, u = 0.f; for (int k = 0; k < 1024; ++k) { g += xn[k] * Wg[(size_t)k * 2816 + j]; u += xn[k] * Wu[(size_t)k * 2816 + j]; } hid[j] = g / (1.f + expf(-g)) * u; }
    __syncthreads();
    float num = 0.f, den = 0.f;
    for (int d = tid; d < 1024; d += 256) { float o = 0.f; for (int j = 0; j < 2816; ++j) o += hid[j] * Wd[(size_t)j * 1024 + d]; const float got = bf1(YPp[(size_t)m * 1024 + d]); num += (o - got) * (o - got); den += o * o; }
    probe_acc(num, den, (float*)(ws + WS_CTL));
}
__global__ void __launch_bounds__(256) probe_win(const unsigned char* ws, const float* Win) {
    __shared__ float xn[1024];
    const int m = 555 + 1999 * blockIdx.x, tid = threadIdx.x;
    const bf16* XNp = (const bf16*)(ws + WS_XN); const bf16* Q3p = (const bf16*)(ws + WS_Q3); const bf16* ZRp = (const bf16*)(ws + WS_ZR);
    for (int k = tid; k < 1024; k += 256) xn[k] = bf1(XNp[(size_t)m * 1024 + k]);
    __syncthreads();
    float num = 0.f, den = 0.f;
    for (int c = tid; c < 5448; c += 256) {
        float z = 0.f; for (int k = 0; k < 1024; ++k) z += xn[k] * Win[(size_t)k * NIN + c];
        float got;
        if (c < 512) got = bf1(Q3p[(size_t)m * QP + c]);
        else if (c < 2120) got = bf1(ZRp[(size_t)m * ZP + (c - 512)]);
        else if (c < 2632) got = bf1(Q3p[(size_t)m * QP + 512 + (c - 2120)]);
        else if (c < 3912) got = bf1(ZRp[(size_t)m * ZP + (c - 840)]);
        else if (c < 4424) got = bf1(Q3p[(size_t)m * QP + 1024 + (c - 3912)]);
        else got = bf1(ZRp[(size_t)m * ZP + (c - 1352)]);
        num += (z - got) * (z - got); den += z * z;
    }
    probe_acc(num, den, (float*)(ws + WS_CTL));
}
__global__ void __launch_bounds__(256) probe_wconv(const unsigned char* ws, const float* Win, int r0) {
    const bf16* WMp = (const bf16*)(ws + WS_WM); const int tid = threadIdx.x;
    float num = 0.f, den = 0.f;
    for (int rr = 0; rr < 64; ++rr) { const int n = r0 + 64 * blockIdx.x + rr; MapWin mw{Win, NIN}; const float* cp = mw.col(n);
        for (int k = tid; k < 1024; k += 256) { const float ref = cp ? cp[(size_t)k * NIN] : 0.f; const float got = bf1(WMp[(size_t)n * 1024 + k]); num += (ref - got) * (ref - got); den += ref * ref; } }
    probe_acc(num, den, (float*)(ws + WS_CTL));
}
__global__ void __launch_bounds__(256) probe_merge(const unsigned char* ws, const float* Win, const float* Wb, const float* Wo, int which) {
    __shared__ float xn[1024]; __shared__ float y[1536]; __shared__ float mg[1024];
    const int m = 333 + 2003 * blockIdx.x, tid = threadIdx.x;
    const bf16* XNp = (const bf16*)(ws + WS_XN); const bf16* Q3p = (const bf16*)(ws + WS_Q3); const bf16* MGp = (const bf16*)(ws + WS_MG); const bf16* YPp = (const bf16*)(ws + WS_R2);
    for (int k = tid; k < 1024; k += 256) xn[k] = bf1(XNp[(size_t)m * 1024 + k]);
    for (int k = tid; k < 1536; k += 256) y[k] = bf1(Q3p[(size_t)m * QP + k]);
    __syncthreads();
    float num = 0.f, den = 0.f;
    for (int d = tid; d < 1024; d += 256) {
        float acc = 0.f;
        for (int n = 0; n < 3; ++n) { float g = 0.f; for (int k = 0; k < 1024; ++k) g += xn[k] * Win[(size_t)k * NIN + 5448 + n * 1024 + d];
            float p = 0.f; for (int c = 0; c < 512; ++c) p += y[512 * n + c] * Wb[((size_t)n * 512 + c) * 1024 + d];
            acc += p / (1.f + expf(-g)); }
        mg[d] = acc; const float got = bf1(MGp[(size_t)m * 1024 + d]); if (which == 0) { num += (acc - got) * (acc - got); den += acc * acc; }
        if (which == 2) { const bf16* G3p = (const bf16*)(ws + WS_ZR); for (int n = 0; n < 3; ++n) { float g = 0.f; for (int k = 0; k < 1024; ++k) g += xn[k] * Win[(size_t)k * NIN + 5448 + n * 1024 + d];
            const float sg = 1.f / (1.f + expf(-g)), gg = bf1(G3p[(size_t)m * 3072 + n * 1024 + d]); num += (sg - gg) * (sg - gg); den += sg * sg; } }
        if (which == 3) { const bf16* G3p = (const bf16*)(ws + WS_ZR); float a2 = 0.f; for (int n = 0; n < 3; ++n) { float p = 0.f; for (int c = 0; c < 512; ++c) p += y[512 * n + c] * Wb[((size_t)n * 512 + c) * 1024 + d];
            a2 += p * bf1(G3p[(size_t)m * 3072 + n * 1024 + d]); } num += (a2 - got) * (a2 - got); den += a2 * a2; }
    }
    __syncthreads();
    if (which == 1) for (int d = tid; d < 1024; d += 256) { float o = 0.f; for (int j = 0; j < 1024; ++j) o += mg[j] * Wo[(size_t)j * 1024 + d]; const float got = bf1(YPp[(size_t)m * 1024 + d]); num += (o - got) * (o - got); den += o * o; }
    probe_acc(num, den, (float*)(ws + WS_CTL));
}
#endif
#ifndef MK_ONE_LAUNCH
#define MK_ONE_LAUNCH 0
#endif
extern "C" void kernel_launch(void* const* d_in, const int* in_sizes, int n_in, void* d_out, int out_size, void* d_ws, size_t ws_size, hipStream_t stream) {
    static int grid = 0;
    if (grid == 0) {
        if (n_in != 32 || in_sizes[0] != M * DM || out_size != M * DM || ws_size < WS_END) { fprintf(stderr, "kernel_launch: unexpected shapes / workspace (n_in %d, ws %zu)\n", n_in, ws_size); grid = -1; return; }
        int dev = 0, cus = 0;
        if (hipGetDevice(&dev) != hipSuccess || hipDeviceGetAttribute(&cus, hipDeviceAttributeMultiprocessorCount, dev) != hipSuccess) { grid = -1; return; }
        if (hipFuncSetAttribute((const void*)mk_fwd, hipFuncAttributeMaxDynamicSharedMemorySize, LDS_BYTES) != hipSuccess) { fprintf(stderr, "kernel_launch: hipFuncSetAttribute failed\n"); grid = -1; return; }
        int per_cu = 0;
        if (hipOccupancyMaxActiveBlocksPerMultiprocessor(&per_cu, (const void*)mk_fwd, NWAVES * 64, LDS_BYTES) != hipSuccess || per_cu < 1) { fprintf(stderr, "kernel_launch: occupancy query says %d\n", per_cu); }
        (void)hipGetLastError();
        grid = cus;
    }
    if (grid < 0) return;
    (void)hipMemsetAsync((char*)d_ws + WS_CTL, 0, CTL_ZERO_BYTES, stream);
    Args a{};
    for (int i = 0; i < 32; ++i) a.in[i] = (const float*)d_in[i];
    a.out = (float*)d_out; a.ws = (unsigned char*)d_ws;
#if MK_ONE_LAUNCH
    a.ph_lo = 0; a.ph_hi = N_PHASES;
    hipLaunchKernelGGL(mk_fwd, dim3(grid), dim3(NWAVES * 64), LDS_BYTES, stream, a);
#else
    for (int p = 0; p < N_PHASES; ++p) { a.ph_lo = p; a.ph_hi = p + 1; hipLaunchKernelGGL(mk_fwd, dim3(grid), dim3(NWAVES * 64), LDS_BYTES, stream, a);
#if PROBE == 1
        if (p == 2) hipLaunchKernelGGL(probe_ffn, dim3(8), dim3(256), 0, stream, (const unsigned char*)d_ws, a.in[3], a.in[4], a.in[5]);
#elif PROBE == 2
        if (p == 4) hipLaunchKernelGGL(probe_win, dim3(8), dim3(256), 0, stream, (const unsigned char*)d_ws, a.in[8]);
#elif PROBE == 3
        if (p == 8) hipLaunchKernelGGL(probe_merge, dim3(8), dim3(256), 0, stream, (const unsigned char*)d_ws, a.in[8], a.in[25], a.in[26], 0);
#elif PROBE == 5
        if (p == 8) hipLaunchKernelGGL(probe_merge, dim3(8), dim3(256), 0, stream, (const unsigned char*)d_ws, a.in[8], a.in[25], a.in[26], 2);
#elif PROBE == 6
        if (p == 8) hipLaunchKernelGGL(probe_merge, dim3(8), dim3(256), 0, stream, (const unsigned char*)d_ws, a.in[8], a.in[25], a.in[26], 3);
#elif PROBE == 7
        if (p == 6) hipLaunchKernelGGL(probe_wconv, dim3(48), dim3(256), 0, stream, (const unsigned char*)d_ws, a.in[8], 5632);
#elif PROBE == 8
        if (p == 3) hipLaunchKernelGGL(probe_wconv, dim3(48), dim3(256), 0, stream, (const unsigned char*)d_ws, a.in[8], 5632);
#elif PROBE == 9
        if (p == 7) hipLaunchKernelGGL(probe_merge, dim3(8), dim3(256), 0, stream, (const unsigned char*)d_ws, a.in[8], a.in[25], a.in[26], 2);
#elif PROBE == 4
        if (p == 9) hipLaunchKernelGGL(probe_merge, dim3(8), dim3(256), 0, stream, (const unsigned char*)d_ws, a.in[8], a.in[25], a.in[26], 1);
#endif
    }
#endif
}
```

```cpp
#include <hip/hip_runtime.h>
#include <hip/hip_bf16.h>
#include <cstdio>
#include <cstdint>
#define MK_ONE_LAUNCH 1
#define GATE_RAW 1

__device__ __forceinline__ int otid_() { int t = (int)threadIdx.x; asm volatile("" : "+v"(t)); return t; }
namespace pg8 {
#define PG8_LAS __attribute__((address_space(3)))
typedef unsigned short bf16_t;
typedef short bf16x8 __attribute__((ext_vector_type(8)));
typedef float f32x4 __attribute__((ext_vector_type(4)));
typedef unsigned u32x4 __attribute__((ext_vector_type(4)));
constexpr int BM = 256, BK = 64, HALF = 128, HTB = HALF * BK * 2  , STAGE_BYTES = 8 * HTB, NXCD = 8, WGM = 8;

__host__ __device__ __forceinline__ int lds_byte(int r, int c) { const int st = (r >> 4) * 2 + (c >> 5), rr = r & 15, cc = c & 31, ob = rr * 64 + cc * 2; return st * 1024 + (ob ^ (((ob >> 9) & 1) << 5)); }
__host__ __device__ __forceinline__ void stage_rc(int b, int& R, int& C) { const int st = b / 1024, sb = b % 1024, swz = sb ^ (((sb >> 9) & 1) << 5); R = (st >> 1) * 16 + swz / 64; C = (st & 1) * 32 + (swz % 64) / 2; }
__host__ __device__ __forceinline__ int perm32(int rho) { const int n = rho >> 4, i = rho & 15; return 8 * (i >> 2) + 4 * n + (i & 3); }

struct Unit { int pm, pn; };
struct Gemm { const bf16_t* A; const bf16_t* Bt; int M, N, K, lda; };

struct StaticOrder {
    int nM, nN, nwg, G, c;
    __host__ __device__ void init(int M, int N, int G_, int c_) { nM = M / BM; nN = N / BM; nwg = nM * nN; G = G_; c = c_; }
    __host__ __device__ bool next(int i, Unit& u) const {
        const long L = (long)i * G + c; if (L >= nwg) return false;
        int wgid = (int)L; { const int q = nwg / NXCD, r = nwg % NXCD, xcd = wgid % NXCD, off = wgid / NXCD; wgid = (xcd < r ? xcd * (q + 1) : r * (q + 1) + (xcd - r) * q) + off; }
        const int nig = WGM * nN, gid = wgid / nig, fm = gid * WGM, gsz = (nM - fm) < WGM ? (nM - fm) : WGM;
        u.pm = fm + ((wgid % nig) % gsz); u.pn = (wgid % nig) / gsz; return true;
    }
    __device__ __forceinline__ void a_ready(const Unit&) const {}
    __device__ __forceinline__ void done(const Unit&) const {}
};

__device__ __forceinline__ unsigned cvt_pk_bf16(float lo, float hi) { unsigned r; asm volatile("v_cvt_pk_bf16_f32 %0, %1, %2" : "=v"(r) : "v"(lo), "v"(hi)); return r; }

template <class Epi, class Sched, bool ALIGN_EPI = false, bool SP2 = false>
__device__ __forceinline__ void gemm_phase(PG8_LAS unsigned char* lds, const Gemm g, const Sched& S, const Epi& E) {
    const int tid = otid_(), wid = __builtin_amdgcn_readfirstlane(tid >> 6), lane = tid & 63, wr = wid >> 2, wc = wid & 3, fr = lane & 15, fq = lane >> 4;
    const int K = g.K, nt = K / BK;
    unsigned voffA[2], voffB[2];
#pragma unroll
    for (int i = 0; i < 2; ++i) { int R, C; stage_rc(tid * 16 + i * 8192, R, C); const int Rb = Epi::PERM ? ((R & ~31) + perm32(R & 31)) : R;
        voffA[i] = (unsigned)(R * g.lda + C) * 2u; voffB[i] = (unsigned)(Rb * K + C) * 2u; }
    const size_t kstep = (size_t)(BK * 2);
    const size_t hstepB = (size_t)HALF * K * 2, hstepA = (size_t)HALF * g.lda * 2;
    const size_t tstepB = 2 * hstepB, tstepA = 2 * hstepA;
    const unsigned ldsw = (unsigned)wid * 1024u;
    const int aoff = lds_byte(wr * 64 + fr, fq * 8), boff = lds_byte(wc * 32 + fr, fq * 8);
#define PG8_SA(b, h) (((b) * 2 + (h)) * HTB)
#define PG8_SB(b, h) ((4 + (b) * 2 + (h)) * HTB)
#define PG8_STAGE(bufoff, gbase, voff) do { _Pragma("unroll") for (int _i = 0; _i < 2; ++_i) \
        __builtin_amdgcn_global_load_lds((const unsigned*)((const char*)(gbase) + (voff)[_i]), (PG8_LAS unsigned*)(lds + (bufoff) + ldsw + _i * 8192), 16, 0, 0); } while (0)
#define PG8_LDA(dst, b, h) do { _Pragma("unroll") for (int m = 0; m < 4; ++m) _Pragma("unroll") for (int k = 0; k < 2; ++k) dst[m][k] = *(const PG8_LAS bf16x8*)(lds + PG8_SA(b, h) + aoff + m * 2048 + k * 1024); } while (0)
#define PG8_LDB(dst, b, h) do { _Pragma("unroll") for (int n = 0; n < 2; ++n) _Pragma("unroll") for (int k = 0; k < 2; ++k) dst[n][k] = *(const PG8_LAS bf16x8*)(lds + PG8_SB(b, h) + boff + n * 2048 + k * 1024); } while (0)
#define PG8_MMA(ai, bj, At, Bt) do { __builtin_amdgcn_s_setprio(1); _Pragma("unroll") for (int m = 0; m < 4; ++m) _Pragma("unroll") for (int n = 0; n < 2; ++n) _Pragma("unroll") for (int k = 0; k < 2; ++k) \
        acc[ai][bj][m][n] = __builtin_amdgcn_mfma_f32_16x16x32_bf16(Bt[n][k], At[m][k], acc[ai][bj][m][n], 0, 0, 0); __builtin_amdgcn_s_setprio(0); } while (0)
#define PG8_WAIT_V(n) asm volatile("s_waitcnt vmcnt(" #n ")" ::: "memory")
#define PG8_WAIT_L(n) asm volatile("s_waitcnt lgkmcnt(" #n ")" ::: "memory")
#define PG8_BAR __builtin_amdgcn_s_barrier()
#define PG8_SCHED __builtin_amdgcn_sched_barrier(0)
    Unit cur, nxt; int ui = 0;
    if (!S.next(0, cur)) return;
    f32x4 acc[2][2][4][2];
#pragma unroll
    for (int a = 0; a < 2; ++a)
#pragma unroll
        for (int b = 0; b < 2; ++b)
#pragma unroll
            for (int m = 0; m < 4; ++m)
#pragma unroll
                for (int n = 0; n < 2; ++n) acc[a][b][m][n] = (f32x4){0.f, 0.f, 0.f, 0.f};
    bf16x8 At[4][2], B0[2][2], B1[2][2];
    const char* cA = (const char*)g.A + (size_t)cur.pm * tstepA; const char* cB = (const char*)g.Bt + (size_t)cur.pn * tstepB;
    S.a_ready(cur);
    if constexpr (SP2) {
        PG8_STAGE(PG8_SB(0, 0), cB, voffB); PG8_STAGE(PG8_SB(0, 1), cB + hstepB, voffB); PG8_STAGE(PG8_SA(0, 0), cA, voffA); PG8_STAGE(PG8_SA(0, 1), cA + hstepA, voffA);
        if (wr == 1) PG8_BAR;
        PG8_WAIT_V(2); PG8_BAR;
        PG8_STAGE(PG8_SB(1, 0), cB + kstep, voffB); PG8_STAGE(PG8_SA(1, 0), cA + kstep, voffA); PG8_STAGE(PG8_SB(1, 1), cB + hstepB + kstep, voffB);
        PG8_WAIT_V(6); PG8_BAR;
    } else {
        PG8_STAGE(PG8_SB(0, 0), cB, voffB); PG8_STAGE(PG8_SA(0, 0), cA, voffA); PG8_STAGE(PG8_SB(0, 1), cB + hstepB, voffB); PG8_STAGE(PG8_SA(0, 1), cA + hstepA, voffA);
        if (wr == 1) PG8_BAR;
        PG8_WAIT_V(4); PG8_BAR;
        PG8_STAGE(PG8_SB(1, 0), cB + kstep, voffB); PG8_STAGE(PG8_SA(1, 0), cA + kstep, voffA); PG8_STAGE(PG8_SB(1, 1), cB + hstepB + kstep, voffB);
        PG8_WAIT_V(6); PG8_BAR;
    }
    for (;;) {
        const bool has_next = S.next(ui + 1, nxt);
        const char* nA = has_next ? (const char*)g.A + (size_t)nxt.pm * tstepA : cA; const char* nB = has_next ? (const char*)g.Bt + (size_t)nxt.pn * tstepB : cB;
        for (int t = 0; t < nt; t += 2) {
            const bool last = (t == nt - 2);
            const char* a1 = cA + (size_t)(t + 1) * kstep;
            const char* a2 = last ? nA : cA + (size_t)(t + 2) * kstep; const char* b2 = last ? nB : cB + (size_t)(t + 2) * kstep;
            const char* a3 = a2 + kstep; const char* b3 = b2 + kstep;
            if (last && has_next) S.a_ready(nxt);
            if constexpr (SP2) {
            PG8_LDB(B0, 0, 0); PG8_LDB(B1, 0, 1); PG8_SCHED; PG8_LDA(At, 0, 0); PG8_STAGE(PG8_SA(1, 1), a1 + hstepA, voffA);
            PG8_WAIT_V(8); PG8_WAIT_L(0); PG8_BAR; PG8_MMA(0, 0, At, B0); PG8_MMA(0, 1, At, B1); PG8_BAR; PG8_SCHED;
            PG8_LDA(At, 0, 1); PG8_STAGE(PG8_SB(0, 0), b2, voffB); PG8_STAGE(PG8_SB(0, 1), b2 + hstepB, voffB); PG8_STAGE(PG8_SA(0, 0), a2, voffA);
            PG8_WAIT_V(8); PG8_WAIT_L(0); PG8_BAR; PG8_MMA(1, 0, At, B0); PG8_MMA(1, 1, At, B1); PG8_BAR; PG8_SCHED;
            PG8_LDB(B0, 1, 0); PG8_LDB(B1, 1, 1); PG8_SCHED; PG8_LDA(At, 1, 0); PG8_STAGE(PG8_SA(0, 1), a2 + hstepA, voffA);
            PG8_WAIT_V(8); PG8_WAIT_L(0); PG8_BAR; PG8_MMA(0, 0, At, B0); PG8_MMA(0, 1, At, B1); PG8_BAR; PG8_SCHED;
            PG8_LDA(At, 1, 1); PG8_STAGE(PG8_SB(1, 0), b3, voffB); PG8_STAGE(PG8_SB(1, 1), b3 + hstepB, voffB); PG8_STAGE(PG8_SA(1, 0), a3, voffA);
            PG8_WAIT_V(8); PG8_WAIT_L(0); PG8_BAR; PG8_MMA(1, 0, At, B0); PG8_MMA(1, 1, At, B1); PG8_BAR; PG8_SCHED;
            } else {
            PG8_LDB(B0, 0, 0); PG8_SCHED; PG8_LDA(At, 0, 0); PG8_STAGE(PG8_SA(1, 1), a1 + hstepA, voffA);
            PG8_WAIT_L(8); PG8_BAR; PG8_WAIT_L(0); PG8_MMA(0, 0, At, B0); PG8_BAR; PG8_SCHED;
            PG8_LDB(B1, 0, 1); PG8_STAGE(PG8_SB(0, 0), b2, voffB);
            PG8_BAR; PG8_WAIT_L(0); PG8_MMA(0, 1, At, B1); PG8_BAR;
            PG8_LDA(At, 0, 1); PG8_STAGE(PG8_SA(0, 0), a2, voffA);
            PG8_BAR; PG8_WAIT_L(0); PG8_MMA(1, 0, At, B0); PG8_BAR; PG8_SCHED;
            PG8_STAGE(PG8_SB(0, 1), b2 + hstepB, voffB);
            PG8_WAIT_V(6); PG8_BAR; PG8_MMA(1, 1, At, B1); PG8_BAR;
            PG8_LDB(B0, 1, 0); PG8_SCHED; PG8_LDA(At, 1, 0); PG8_STAGE(PG8_SA(0, 1), a2 + hstepA, voffA);
            PG8_WAIT_L(8); PG8_BAR; PG8_WAIT_L(0); PG8_MMA(0, 0, At, B0); PG8_BAR; PG8_SCHED;
            PG8_LDB(B1, 1, 1); PG8_STAGE(PG8_SB(1, 0), b3, voffB);
            PG8_BAR; PG8_WAIT_L(0); PG8_MMA(0, 1, At, B1); PG8_BAR;
            PG8_LDA(At, 1, 1); PG8_STAGE(PG8_SA(1, 0), a3, voffA);
            PG8_BAR; PG8_WAIT_L(0); PG8_MMA(1, 0, At, B0); PG8_BAR; PG8_SCHED;
            PG8_STAGE(PG8_SB(1, 1), b3 + hstepB, voffB);
            PG8_WAIT_V(6); PG8_BAR; PG8_MMA(1, 1, At, B1); PG8_BAR;
            }
        }
        if constexpr (ALIGN_EPI) { if (wr == 0) PG8_BAR; }
        if constexpr (!Epi::AFTER_DRAIN) { E(acc, cur, wr, wc, fr, fq); S.done(cur); }
        if (!has_next) break;
#pragma unroll
        for (int a = 0; a < 2; ++a)
#pragma unroll
            for (int b = 0; b < 2; ++b)
#pragma unroll
                for (int m = 0; m < 4; ++m)
#pragma unroll
                    for (int n = 0; n < 2; ++n) acc[a][b][m][n] = (f32x4){0.f, 0.f, 0.f, 0.f};
        cur = nxt; cA = nA; cB = nB; ++ui;
        if constexpr (ALIGN_EPI) { if (wr == 1) PG8_BAR; }
    }
    PG8_WAIT_V(0);
    if constexpr (!ALIGN_EPI) { if (wr == 0) PG8_BAR; }
    PG8_BAR;
    if constexpr (Epi::AFTER_DRAIN) { E.fused(acc, cur, wr, wc, fr, fq, lds, wid, lane); S.done(cur); }
#undef PG8_SA
#undef PG8_SB
#undef PG8_STAGE
#undef PG8_LDA
#undef PG8_LDB
#undef PG8_MMA
#undef PG8_WAIT_V
#undef PG8_WAIT_L
#undef PG8_BAR
#undef PG8_SCHED
}
}
namespace pg8 {
typedef unsigned u32x2 __attribute__((ext_vector_type(2)));
__device__ __forceinline__ float bf_lo(unsigned w) { return __uint_as_float(w << 16); }
__device__ __forceinline__ float bf_hi(unsigned w) { return __uint_as_float(w & 0xffff0000u); }
__device__ __forceinline__ float sigmoidf_(float x) { return __builtin_amdgcn_rcpf(1.0f + __expf(-x)); }

struct EpiSwiGLU {
    static constexpr bool PERM = false, AFTER_DRAIN = false;
    bf16_t* H; int ldh;
    __device__ __forceinline__ void operator()(const f32x4 (&acc)[2][2][4][2], const Unit& u, int wr, int wc, int fr, int fq) const {
        const int row0 = u.pm * BM + wr * 64 + fr, hc0 = u.pn * 128 + wc * 16 + 4 * fq;
#pragma unroll
        for (int ai = 0; ai < 2; ++ai)
#pragma unroll
            for (int m = 0; m < 4; ++m) { bf16_t* rowp = H + (size_t)(row0 + ai * HALF + m * 16) * ldh + hc0;
#pragma unroll
                for (int bj = 0; bj < 2; ++bj) { const f32x4 g = acc[ai][bj][m][0], up = acc[ai][bj][m][1]; float h[4];
#pragma unroll
                    for (int e = 0; e < 4; ++e) h[e] = g[e] * sigmoidf_(g[e]) * up[e];
                    u32x2 w; w.x = cvt_pk_bf16(h[0], h[1]); w.y = cvt_pk_bf16(h[2], h[3]);
                    *(u32x2*)(rowp + bj * 64) = w; } }
    }
};
template <int ACT> struct EpiStore {
    static constexpr bool PERM = true, AFTER_DRAIN = false;
    bf16_t* O0; int ld0; bf16_t* O1; int ld1; int split_tiles;
    __device__ __forceinline__ void operator()(const f32x4 (&acc)[2][2][4][2], const Unit& u, int wr, int wc, int fr, int fq) const {
        const int row0 = u.pm * BM + wr * 64 + fr;
        bf16_t* base; int ld, colt;
        if (u.pn < split_tiles) { base = O0; ld = ld0; colt = u.pn * BM; } else { base = O1; ld = ld1; colt = (u.pn - split_tiles) * BM; }
        const int col0 = colt + wc * 32 + 8 * fq;
#pragma unroll
        for (int ai = 0; ai < 2; ++ai)
#pragma unroll
            for (int m = 0; m < 4; ++m) { bf16_t* rowp = base + (size_t)(row0 + ai * HALF + m * 16) * ld + col0;
#pragma unroll
                for (int bj = 0; bj < 2; ++bj) { f32x4 v0 = acc[ai][bj][m][0], v1 = acc[ai][bj][m][1];
                    if (ACT == 1) {
#pragma unroll
                        for (int e = 0; e < 4; ++e) { v0[e] = sigmoidf_(v0[e]); v1[e] = sigmoidf_(v1[e]); } }
                    u32x4 w; w.x = cvt_pk_bf16(v0[0], v0[1]); w.y = cvt_pk_bf16(v0[2], v0[3]); w.z = cvt_pk_bf16(v1[0], v1[1]); w.w = cvt_pk_bf16(v1[2], v1[3]);
                    *(u32x4*)(rowp + bj * HALF) = w; } }
    }
};
#ifdef GATE_RAW
#define GSIG(x) sigmoidf_(x)
#else
#define GSIG(x) (x)
#endif
struct EpiGateMul {
    static constexpr bool PERM = true, AFTER_DRAIN = false;
    bf16_t* MG; int ldm; const bf16_t* G; int ldg; int first;
    __device__ __forceinline__ void operator()(const f32x4 (&acc)[2][2][4][2], const Unit& u, int wr, int wc, int fr, int fq) const {
        const int row0 = u.pm * BM + wr * 64 + fr, col0 = u.pn * BM + wc * 32 + 8 * fq;
#pragma unroll
        for (int ai = 0; ai < 2; ++ai)
#pragma unroll
            for (int m = 0; m < 4; ++m) { const size_t r = (size_t)(row0 + ai * HALF + m * 16);
#pragma unroll
                for (int bj = 0; bj < 2; ++bj) { const f32x4 v0 = acc[ai][bj][m][0], v1 = acc[ai][bj][m][1];
                    const u32x4 g = *(const u32x4*)(G + r * ldg + col0 + bj * HALF);
                    float o[8] = { v0[0] * GSIG(bf_lo(g.x)), v0[1] * GSIG(bf_hi(g.x)), v0[2] * GSIG(bf_lo(g.y)), v0[3] * GSIG(bf_hi(g.y)), v1[0] * GSIG(bf_lo(g.z)), v1[1] * GSIG(bf_hi(g.z)), v1[2] * GSIG(bf_lo(g.w)), v1[3] * GSIG(bf_hi(g.w)) };
                    bf16_t* mp = MG + r * ldm + col0 + bj * HALF;
                    if (!first) { const u32x4 p = *(const u32x4*)mp;
                        o[0] += bf_lo(p.x); o[1] += bf_hi(p.x); o[2] += bf_lo(p.y); o[3] += bf_hi(p.y); o[4] += bf_lo(p.z); o[5] += bf_hi(p.z); o[6] += bf_lo(p.w); o[7] += bf_hi(p.w); }
                    u32x4 w; w.x = cvt_pk_bf16(o[0], o[1]); w.y = cvt_pk_bf16(o[2], o[3]); w.z = cvt_pk_bf16(o[4], o[5]); w.w = cvt_pk_bf16(o[6], o[7]);
                    *(u32x4*)mp = w; } }
    }
};
}
namespace att {
constexpr int D = 128;
constexpr bool WSKIP = false;
constexpr float THR = 8.f;
constexpr int NW = 8, QBLK = 32, KVBLK = 64, QB = NW * QBLK;
constexpr int SHM_V = KVBLK * D * 2, SHM_K = KVBLK * D * 2;
constexpr int LDS_BYTES = 2 * SHM_V + 2 * SHM_K + NW * 64 * 4;
using bf16 = __hip_bfloat16;
typedef short bf16x8 __attribute__((ext_vector_type(8)));
typedef short s16x4 __attribute__((ext_vector_type(4)));
typedef float f32x16 __attribute__((ext_vector_type(16)));
typedef float f32x4 __attribute__((ext_vector_type(4)));
typedef unsigned u32x4 __attribute__((ext_vector_type(4)));
template <class A, class Bt> struct same_t { static constexpr bool v = false; };
template <class A> struct same_t<A, A> { static constexpr bool v = true; };

#define KSWZ(row, colB) ((row) * 256 + ((colB) ^ (((row) & 7) << 4)))
#define SBAR() __builtin_amdgcn_sched_barrier(0)
__device__ __forceinline__ int v_st(int k, int c) { const int kk = (k & ~0xC) | ((k & 4) << 1) | ((k & 8) >> 1); return ((kk >> 3) * 4 + (c >> 5)) * 512 + ((kk & 7) * 32 + (c & 31)) * 2; }
__device__ __forceinline__ int v_rd_base(int lane) { return ((lane & 3) << 3) | (((lane >> 2) & 3) << 6) | (((lane >> 4) & 1) << 5) | (((lane >> 5) & 1) << 8); }
constexpr int v_rd_off(int d0, int ks, int half) { return d0 * 512 + ks * 4096 + half * 2048; }
__device__ __forceinline__ int crow(int r, int hi) { return (r & 3) + 8 * (r >> 2) + 4 * hi; }
__device__ __forceinline__ unsigned cvtpk(float lo, float hi) {
    unsigned r; asm volatile("v_cvt_pk_bf16_f32 %0, %1, %2" : "=v"(r) : "v"(lo), "v"(hi)); return r;
}
__device__ __forceinline__ bf16x8 pack8(f32x4 a, f32x4 b) {
    u32x4 w = {cvtpk(a[0], a[1]), cvtpk(a[2], a[3]), cvtpk(b[0], b[1]), cvtpk(b[2], b[3])};
    return *reinterpret_cast<bf16x8*>(&w);
}
template <class T> __device__ __forceinline__ bf16x8 load8(const T* p) {
    if constexpr (same_t<T, float>::v) { return pack8(*(const f32x4*)p, *(const f32x4*)(p + 4)); }
    else { return *reinterpret_cast<const bf16x8*>(p); }
}
__device__ __forceinline__ void mask_tile(f32x16& p0, f32x16& p1, int dq, unsigned W) {
    const float NEG = -__builtin_inff();
#pragma unroll
    for (int r = 0; r < 16; ++r) {
        const int c = (r & 3) + 8 * (r >> 2);
        if ((unsigned)(dq - c) >= W) p0[r] = NEG;
        if ((unsigned)(dq - c - 32) >= W) p1[r] = NEG;
    }
}
typedef unsigned u32x2 __attribute__((ext_vector_type(2)));
__device__ __forceinline__ void bitmask_tile(f32x16& p0, f32x16& p1, u32x2 w, int hi) {
    const float NEG = -__builtin_inff();
    const unsigned a = w[0] >> (4 * hi), b = w[1] >> (4 * hi);
#pragma unroll
    for (int r = 0; r < 16; ++r) {
        const int c = (r & 3) + 8 * (r >> 2);
        if (!((a >> c) & 1u)) p0[r] = NEG;
        if (!((b >> c) & 1u)) p1[r] = NEG;
    }
}
template <bool HALFQK> __device__ __forceinline__ void partialSM(f32x16& p0, f32x16& p1, float& m_reg, float& mn, float& alpha) {
    constexpr float SCALE = HALFQK ? 0.125f : 0.08838834764831845f;
    float pmax = p0[0]; for (int r = 1; r < 16; ++r) pmax = fmaxf(pmax, p0[r]); for (int r = 0; r < 16; ++r) pmax = fmaxf(pmax, p1[r]);
    { auto rr = __builtin_amdgcn_permlane32_swap(__float_as_uint(pmax), __float_as_uint(pmax), false, false);
      pmax = fmaxf(__uint_as_float(rr[0]), __uint_as_float(rr[1])); }
    constexpr float C2 = 1.4426950408889634f * SCALE;
    if (__builtin_expect(__all((pmax - m_reg) * SCALE <= THR), 1)) { mn = m_reg; alpha = 1.f; }
    else { mn = fmaxf(m_reg, pmax); alpha = __builtin_amdgcn_exp2f((m_reg - mn) * C2); m_reg = mn; }
    const float mnL = -mn * C2;
    for (int r = 0; r < 16; ++r) p0[r] = fmaf(p0[r], C2, mnL); for (int r = 0; r < 16; ++r) p1[r] = fmaf(p1[r], C2, mnL);
    for (int r = 0; r < 16; ++r) p0[r] = __builtin_amdgcn_exp2f(p0[r]);
}
__device__ __forceinline__ void finishSM(f32x16& p0, f32x16& p1, float alpha, float& l_reg, bf16x8& pa0, bf16x8& pa1, bf16x8& pa2, bf16x8& pa3) {
    for (int r = 0; r < 16; ++r) p1[r] = __builtin_amdgcn_exp2f(p1[r]);
    float ps = 0; for (int r = 0; r < 16; ++r) ps += p0[r]; for (int r = 0; r < 16; ++r) ps += p1[r];
    { auto rr = __builtin_amdgcn_permlane32_swap(__float_as_uint(ps), __float_as_uint(ps), false, false);
      ps = __uint_as_float(rr[0]) + __uint_as_float(rr[1]); }
    l_reg = l_reg * alpha + ps;
#define PK4(P, B_, OUT) do { unsigned a0 = cvtpk(P[B_+0], P[B_+1]), a1 = cvtpk(P[B_+2], P[B_+3]);                          \
        unsigned b0 = cvtpk(P[B_+4], P[B_+5]), b1 = cvtpk(P[B_+6], P[B_+7]);                                             \
        auto r0 = __builtin_amdgcn_permlane32_swap(a0, b0, false, false); auto r1 = __builtin_amdgcn_permlane32_swap(a1, b1, false, false); \
        u32x4 w = {r0[0], r1[0], r0[1], r1[1]}; OUT = *reinterpret_cast<bf16x8*>(&w); } while (0)
    PK4(p0, 0, pa0); PK4(p0, 8, pa1); PK4(p1, 0, pa2); PK4(p1, 8, pa3);
#undef PK4
}
template <int KB, bool SK, bool HALFQK>
__device__ __forceinline__ void qkt(f32x16& p0, f32x16& p1, const char* K_lds, int r32, int hi, const bf16x8* qr, bool act, int koff) {
    if (SK && !act) { const float NEG = -__builtin_inff();
#pragma unroll
        for (int r = 0; r < 16; ++r) { p0[r] = NEG; p1[r] = NEG; } return; }
    p0 = f32x16{}; p1 = f32x16{};
    const char* kb[4];
#pragma unroll
    for (int dd = 0; dd < 4; ++dd) kb[dd] = K_lds + KB * SHM_K + KSWZ(r32, (dd * 16 + hi * 8) * 2) + koff;
#pragma unroll
    for (int d0 = 0; d0 < (HALFQK ? 4 : 8); ++d0) { const char* a = kb[d0 & 3] + (d0 >> 2) * 128;
        bf16x8 b0 = *reinterpret_cast<const bf16x8*>(a);
        bf16x8 b1 = *reinterpret_cast<const bf16x8*>(a + 32 * 256);
        p0 = __builtin_amdgcn_mfma_f32_32x32x16_bf16(b0, qr[d0], p0, 0, 0, 0);
        p1 = __builtin_amdgcn_mfma_f32_32x32x16_bf16(b1, qr[d0], p1, 0, 0, 0); }
}
template <int VB, bool SK>
__device__ __forceinline__ void pv_tile(f32x16* o, int vb0, bf16x8 pa0, bf16x8 pa1, bf16x8 pa2, bf16x8 pa3, bool act) {
    if (SK && !act) return;
#define TRRD(dst, off) asm volatile("ds_read_b64_tr_b16 %0, %1 offset:%2" : "=&v"(dst) : "v"(vb0), "i"(off) : "memory")
#define PV_D0(d0) do { s16x4 l0, l1, l2, l3, h0, h1, h2, h3; constexpr int b_ = VB * SHM_V + v_rd_off(d0, 0, 0);     \
        TRRD(l0, b_); TRRD(h0, b_ + 2048); TRRD(l1, b_ + 4096); TRRD(h1, b_ + 6144); TRRD(l2, b_ + 8192); TRRD(h2, b_ + 10240); TRRD(l3, b_ + 12288); TRRD(h3, b_ + 14336); \
        asm volatile("s_waitcnt lgkmcnt(0)" ::: "memory"); SBAR();                 \
        o[d0] = __builtin_amdgcn_mfma_f32_32x32x16_bf16(pa0, (bf16x8){l0[0], l0[1], l0[2], l0[3], h0[0], h0[1], h0[2], h0[3]}, o[d0], 0, 0, 0);   \
        o[d0] = __builtin_amdgcn_mfma_f32_32x32x16_bf16(pa1, (bf16x8){l1[0], l1[1], l1[2], l1[3], h1[0], h1[1], h1[2], h1[3]}, o[d0], 0, 0, 0);   \
        o[d0] = __builtin_amdgcn_mfma_f32_32x32x16_bf16(pa2, (bf16x8){l2[0], l2[1], l2[2], l2[3], h2[0], h2[1], h2[2], h2[3]}, o[d0], 0, 0, 0);   \
        o[d0] = __builtin_amdgcn_mfma_f32_32x32x16_bf16(pa3, (bf16x8){l3[0], l3[1], l3[2], l3[3], h3[0], h3[1], h3[2], h3[3]}, o[d0], 0, 0, 0); } while (0)
    PV_D0(0); PV_D0(1); PV_D0(2); PV_D0(3);
#undef PV_D0
#undef TRRD
}

constexpr int QS = 1536, KVS = 4096;
template <class TIn, class TOut> struct BlockRef { const TIn* Q; const TIn* K; const TIn* V; TOut* O; int P0; int koff; const unsigned* mask; };
template <class TIn> struct Seam {
    bf16x8 qr[8];
    bf16x8 st_v0, st_v1, st_k0, st_k1; f32x4 sf0, sf1, sf2, sf3;
    f32x4 tq[16];
};
__device__ __forceinline__ int swa_jlo(int P0, int W) { const int lowk = P0 - W + 1; return lowk > 0 ? lowk / KVBLK : 0; }
#define ROW(p, k0, rr) ((p) + (size_t)((k0) + (rr)) * KVS + sc)
#define VMW() asm volatile("s_waitcnt vmcnt(0)" ::: "memory")
#define VMWN(n) asm volatile("s_waitcnt vmcnt(%0)" :: "i"(n) : "memory")
#define SLOAD_H(Kp, Vp, k0) do { S.st_v0 = load8<TIn>(ROW(Vp, k0, sr)); S.st_v1 = load8<TIn>(ROW(Vp, k0, 32 + sr));              \
                         S.st_k0 = load8<TIn>(ROW(Kp, k0, sr)); S.st_k1 = load8<TIn>(ROW(Kp, k0, 32 + sr)); } while (0)
#define SWRITE_HK(bf) do { *(bf16x8*)(K_lds + (bf) * SHM_K + kws) = S.st_k0; *(bf16x8*)(K_lds + (bf) * SHM_K + kws + 32 * 256) = S.st_k1; } while (0)
#define SWRITE_HV(bf) do { *(bf16x8*)(V_lds + (bf) * SHM_V + vst0) = S.st_v0; *(bf16x8*)(V_lds + (bf) * SHM_V + vst1) = S.st_v1; } while (0)
#define SWRITE_H(bf) do { SWRITE_HV(bf); SWRITE_HK(bf); } while (0)
#define SLOAD_F(p, k0) do { S.sf0 = *(const f32x4*)ROW(p, k0, sr); S.sf1 = *(const f32x4*)(ROW(p, k0, sr) + 4);                \
                            S.sf2 = *(const f32x4*)ROW(p, k0, 32 + sr); S.sf3 = *(const f32x4*)(ROW(p, k0, 32 + sr) + 4); } while (0)
#define SWRITE_KF(bf) do { *(bf16x8*)(K_lds + (bf) * SHM_K + kws) = pack8(S.sf0, S.sf1); *(bf16x8*)(K_lds + (bf) * SHM_K + kws + 32 * 256) = pack8(S.sf2, S.sf3); } while (0)
#define SWRITE_VF(bf) do { *(bf16x8*)(V_lds + (bf) * SHM_V + vst0) = pack8(S.sf0, S.sf1); *(bf16x8*)(V_lds + (bf) * SHM_V + vst1) = pack8(S.sf2, S.sf3); } while (0)
template <class TIn, class TOut, bool HALFQK>
__device__ __forceinline__ void causal_swa_prime(const BlockRef<TIn, TOut>& cur, int W, char* lds, Seam<TIn>& S) {
    constexpr bool F32 = same_t<TIn, float>::v;
    const int tid = otid_(), wid = __builtin_amdgcn_readfirstlane(tid >> 6), lane = tid & 63, r32 = lane & 31, hi = lane >> 5;
    const int sr = tid >> 4, sc = (tid & 15) * 8, kws = KSWZ(sr, sc * 2); char* K_lds = lds + 2 * SHM_V;
    const int kb0 = swa_jlo(cur.P0, W) * KVBLK;
    for (int d0 = 0; d0 < (HALFQK ? 4 : 8); ++d0) S.qr[d0] = load8<TIn>(cur.Q + (size_t)(wid * QBLK + r32) * QS + d0 * 16 + hi * 8);
    if constexpr (F32) { SLOAD_F((const float*)cur.K, kb0); VMW(); SWRITE_KF(0); SBAR(); SLOAD_F((const float*)cur.V, kb0); }
    else { SLOAD_H(cur.K, cur.V, kb0); VMW(); SWRITE_HK(0); }
    __syncthreads();
}
template <class TIn, class TOut, bool HALFQK, bool MASKED, int OS>
__device__ __forceinline__ void causal_swa_block(const BlockRef<TIn, TOut>& cur, const BlockRef<TIn, TOut>& nxt, int skv, int W, char* lds, Seam<TIn>& S) {
    constexpr bool F32 = same_t<TIn, float>::v;
    const int tid = otid_(), wid = __builtin_amdgcn_readfirstlane(tid >> 6), lane = tid & 63, r32 = lane & 31, hi = lane >> 5;
    const int j_lo = swa_jlo(cur.P0, W);
    int j_hi = (cur.P0 + QB - 1) / KVBLK + 1; if (j_hi > skv / KVBLK) j_hi = skv / KVBLK;
    const int NT = j_hi - j_lo;
    const int kbn = swa_jlo(nxt.P0, W) * KVBLK;
    const int qlo = cur.P0 + wid * QBLK, qm = qlo + r32 - 4 * hi;
    char* V_lds = lds; char* K_lds = lds + 2 * SHM_V;
    float* ws = (float*)(lds + 2 * SHM_V + 2 * SHM_K) + wid * 64; float* li_l = ws, * al_l = ws + 32;
    float m_reg = -1e30f, l_reg = 0; f32x16 o[4] = {};
    const int sr = tid >> 4, sc = (tid & 15) * 8, vst0 = v_st(sr, sc), vst1 = v_st(32 + sr, sc), kws = KSWZ(sr, sc * 2);
    const int vb0 = (int)(uintptr_t)V_lds + v_rd_base(lane);
    const TIn* Kh = cur.K; const TIn* Vh = cur.V;
#define RESC(a) do { if (__any((a) < 1.f)) { if (hi == 0) al_l[r32] = (a); asm volatile("s_waitcnt lgkmcnt(0)" ::: "memory");              \
                     for (int d_ = 0; d_ < 4; ++d_) for (int r = 0; r < 16; ++r) o[d_][r] *= al_l[crow(r, hi)]; } } while (0)
#define KBASE(t) ((j_lo + (t)) * KVBLK)
#define ACT(t) (KBASE(t) <= qlo + QBLK - 1 && KBASE(t) + KVBLK - 1 >= qlo - W + 1)
#define MASKT(P0_, P1_, t) do { if constexpr (MASKED) bitmask_tile(P0_, P1_, mw, hi);   \
        else { const int kb_ = KBASE(t); if ((!SK || ACT(t)) && (kb_ + KVBLK - 1 > qlo || kb_ <= qlo + QBLK - 1 - W)) mask_tile(P0_, P1_, qm - kb_, (unsigned)W); } } while (0)
    const unsigned moff = (unsigned)((wid * QBLK + r32) * 1024 + 8 * j_lo); u32x2 mw = {0u, 0u};
#define MLOAD(t) do { if constexpr (MASKED) mw = *(const u32x2*)((const char*)cur.mask + (moff + 8u * (unsigned)(t))); } while (0)
    constexpr int NQL = F32 ? 16 : (HALFQK ? 4 : 8);
    constexpr bool SK = WSKIP && !F32;
#define SEAM_K0() do { VMWN(NQL); if constexpr (F32) { SWRITE_KF(0); SBAR(); SLOAD_F((const float*)nxt.V, kbn); } else { SWRITE_HK(0); } SBAR(); } while (0)
    f32x16 pA0, pA1, pB0, pB1; float mnA, mnB, alA, alB; bf16x8 pa0, pa1, pa2, pa3;
    if constexpr (F32) { VMW(); SWRITE_VF(0); SBAR(); } else { SWRITE_HV(0); SBAR(); }
    if (NT > 1) { if constexpr (F32) SLOAD_F((const float*)Kh, KBASE(1)); else SLOAD_H(Kh, Vh, KBASE(1)); }
    SBAR(); qkt<0, SK, HALFQK>(pA0, pA1, K_lds, r32, hi, S.qr, ACT(0), cur.koff); MLOAD(0);
    if constexpr (F32) { if (NT > 1) { VMW(); SWRITE_KF(1); SBAR(); SLOAD_F((const float*)Vh, KBASE(1)); } }
    MASKT(pA0, pA1, 0); partialSM<HALFQK>(pA0, pA1, m_reg, mnA, alA);
    if (NT > 1) { VMW(); if constexpr (F32) { SWRITE_VF(1); SBAR(); if (NT > 2) SLOAD_F((const float*)Kh, KBASE(2)); } else SWRITE_H(1); }
    __syncthreads();
#define HALF_STEP(PX0, PX1, mnX, alX, PY0, PY1, alY, t, KB, VB, SB) do {                                                      \
        SBAR(); qkt<KB, SK, HALFQK>(PX0, PX1, K_lds, r32, hi, S.qr, ACT(t), cur.koff); MLOAD(t);                                             \
        finishSM(PY0, PY1, alY, l_reg, pa0, pa1, pa2, pa3); SBAR();                                                           \
        if ((t) + 1 < NT) { if constexpr (F32) { VMW(); SWRITE_KF(SB); SBAR(); SLOAD_F((const float*)Vh, KBASE((t) + 1)); }  \
                            else { SLOAD_H(Kh, Vh, KBASE((t) + 1)); } SBAR(); }                                               \
        pv_tile<VB, SK>(o, vb0, pa0, pa1, pa2, pa3, ACT((t) - 1)); MASKT(PX0, PX1, (t)); partialSM<HALFQK>(PX0, PX1, m_reg, mnX, alX);                                        \
        __syncthreads();                                                                                                      \
        if ((t) + 1 < NT) { VMW(); if constexpr (F32) { SWRITE_VF(SB); SBAR(); if ((t) + 2 < NT) SLOAD_F((const float*)Kh, KBASE((t) + 2)); } \
                            else { SWRITE_H(SB); } }                                                                          \
        RESC(alX); __syncthreads(); } while (0)
    for (int t = 1; t + 1 < NT; t += 2) {
        HALF_STEP(pB0, pB1, mnB, alB, pA0, pA1, alA, t, 1, 0, 0);
        HALF_STEP(pA0, pA1, mnA, alA, pB0, pB1, alB, t + 1, 0, 1, 1);
    }
    const bool even = (NT & 1) == 0;
    if (even) { SBAR(); qkt<1, SK, HALFQK>(pB0, pB1, K_lds, r32, hi, S.qr, ACT(NT - 1), cur.koff); MLOAD(NT - 1); SBAR(); }
#define QROW(e) (nxt.Q + (size_t)(wid * QBLK + r32) * QS + ((e) >> 1) * 16 + hi * 8 + ((e) & 1) * 4)
    if constexpr (F32) { SLOAD_F((const float*)nxt.K, kbn); SBAR();
#pragma unroll
        for (int e = 0; e < 8; ++e) S.tq[e] = *(const f32x4*)QROW(e); }
    else { SLOAD_H(nxt.K, nxt.V, kbn); SBAR();
#pragma unroll
        for (int d0 = 0; d0 < (HALFQK ? 4 : 8); ++d0) S.qr[d0] = load8<TIn>(nxt.Q + (size_t)(wid * QBLK + r32) * QS + d0 * 16 + hi * 8); }
    SBAR();
    finishSM(pA0, pA1, alA, l_reg, pa0, pa1, pa2, pa3); SBAR();
    if constexpr (F32) {
#pragma unroll
        for (int e = 8; e < 16; ++e) S.tq[e] = *(const f32x4*)QROW(e); SBAR(); }
#undef QROW
    pv_tile<0, SK>(o, vb0, pa0, pa1, pa2, pa3, ACT(even ? NT - 2 : NT - 1));
    if (even) { MASKT(pB0, pB1, NT - 1); partialSM<HALFQK>(pB0, pB1, m_reg, mnB, alB); __syncthreads(); RESC(alB);
        finishSM(pB0, pB1, alB, l_reg, pa0, pa1, pa2, pa3); SBAR(); pv_tile<1, SK>(o, vb0, pa0, pa1, pa2, pa3, ACT(NT - 1)); }
    SBAR(); SEAM_K0();
    if (hi == 0) li_l[r32] = l_reg; asm volatile("s_waitcnt lgkmcnt(0)" ::: "memory");
    float rli[16];
#pragma unroll
    for (int r = 0; r < 16; ++r) rli[r] = __builtin_amdgcn_rcpf(li_l[crow(r, hi)]);
    TOut* Ow = cur.O + (size_t)(wid * QBLK) * OS;
#pragma unroll
    for (int r = 0; r < 16; ++r) { const int orow = crow(r, hi);
#pragma unroll
        for (int d0 = 0; d0 < 4; ++d0) { const float v = o[d0][r] * rli[r];
            if constexpr (same_t<TOut, float>::v) { Ow[(size_t)orow * OS + d0 * 32 + r32] = v; }
            else { const float vn = __shfl_xor(v, 1);
                   if ((r32 & 1) == 0) *(unsigned*)(Ow + (size_t)orow * OS + d0 * 32 + r32) = cvtpk(v, vn); } } }
    if constexpr (F32) {
#pragma unroll
        for (int d0 = 0; d0 < 8; ++d0) S.qr[d0] = pack8(S.tq[2 * d0], S.tq[2 * d0 + 1]); }
    __syncthreads();
#undef RESC
#undef KBASE
#undef ACT
#undef MASKT
#undef MLOAD
#undef SEAM_K0
#undef HALF_STEP
}
#undef ROW
#undef VMW
#undef VMWN
#undef SLOAD_H
#undef SWRITE_HK
#undef SWRITE_HV
#undef SWRITE_H
#undef SLOAD_F
#undef SWRITE_KF
#undef SWRITE_VF
}
#ifndef PROBE
#define PROBE 0
#endif
constexpr int NWAVES = 8;
constexpr int NB = 2, T = 8192, M = NB * T, DM = 1024, FF = 2816, NIN = 8520, NLAYER = 2;
constexpr float NORM_EPS = 1e-6f;
constexpr size_t MiB = 1u << 20;
constexpr size_t WS_CTL = 0, CTL_ZERO_BYTES = 1 * MiB;
constexpr size_t WS_WF = 1 * MiB;
constexpr size_t WS_WF_DOWN = WS_WF + 11 * MiB;
constexpr size_t WS_WM = 18 * MiB;
constexpr size_t WS_WM_BR = WS_WM + 17 * MiB, WS_WM_OUT = WS_WM + 20 * MiB;
constexpr size_t WS_XN = 40 * MiB;
constexpr size_t WS_Q3 = 72 * MiB;
constexpr size_t WS_ZR = 120 * MiB;
constexpr size_t WS_R2 = 248 * MiB;
constexpr size_t WS_END = 280 * MiB;
constexpr size_t WS_MG = WS_ZR + 96 * MiB;
constexpr size_t WS_YRAW = WS_WF;
constexpr size_t WS_X1 = WS_XN + 16 * MiB;
constexpr size_t WS_A8 = WS_WM;
constexpr size_t WS_KID = WS_WM + 8 * MiB;
constexpr size_t WS_BITM = WS_XN;
constexpr size_t WS_RDOTK = WS_WF + 16 * MiB;
constexpr int QP = 1536, ZP = 4096;
constexpr int ZC_DK = 0, ZC_DV = 512, ZC_QI = 1024, ZC_KI = 1536, ZC_WI = 1600, ZC_RK = 1792, ZC_RV = 2304, ZC_WC = 2816, ZC_AC = 2880, ZC_GC = 2944, ZC_FK = 3072, ZC_FV = 3584;
constexpr int CW_TMO = 0;
constexpr int CW_BAR = 4096;
constexpr int CW_Q = 8192;
constexpr int CW_PROBE = 2048;
constexpr int CW_DONE = 12288;
constexpr int LDS_MISC = 160 * 1024 - 256;
constexpr int LDS_BYTES = 160 * 1024;

#define GAS __attribute__((address_space(1)))
#define LAS __attribute__((address_space(3)))
typedef unsigned short bf16;
typedef unsigned v4u __attribute__((ext_vector_type(4)));
typedef unsigned v2u __attribute__((ext_vector_type(2)));
typedef float f32x4 __attribute__((ext_vector_type(4)));
typedef float f32x2 __attribute__((ext_vector_type(2)));
typedef float f32x16 __attribute__((ext_vector_type(16)));
typedef short bf16x8 __attribute__((ext_vector_type(8)));
typedef GAS unsigned gu32;
#define RLX_AGENT __ATOMIC_RELAXED, __HIP_MEMORY_SCOPE_AGENT
#define LDS_WAIT() asm volatile("s_waitcnt lgkmcnt(0)" ::: "memory")
#define VM_WAIT() asm volatile("s_waitcnt vmcnt(0)" ::: "memory")
__device__ __forceinline__ unsigned f2bf(float f) { unsigned u = __builtin_bit_cast(unsigned, f); return (u + 0x7fffu + ((u >> 16) & 1u)) >> 16; }
__device__ __forceinline__ unsigned pk2(float lo, float hi) { return f2bf(lo) | (f2bf(hi) << 16); }
__device__ __forceinline__ float bflo(unsigned w) { return __uint_as_float(w << 16); }
__device__ __forceinline__ float bfhi(unsigned w) { return __uint_as_float(w & 0xffff0000u); }
__device__ __forceinline__ float bf1(bf16 h) { return __uint_as_float((unsigned)h << 16); }
__device__ __forceinline__ float wave_sum(float v) {
#pragma unroll
    for (int o = 1; o < 64; o <<= 1) v += __shfl_xor(v, o);
    return v;
}
__device__ __forceinline__ float sigm(float x) { return __builtin_amdgcn_rcpf(1.0f + __expf(-x)); }

#define XB_TMO      128
#define XB_XCNT(j)  (256  + 64 * (j))
#define XB_XSUB(j)  (1280 + 64 * (j))
#define XB_XGEN(j)  (2304 + 64 * (j))
#define XB_TOP      3328
#define XB_TOPGEN   3392
#define XCD_BAR_WORDS 3456
#define XB_SPIN_CAP (1u << 22)
__device__ __forceinline__ unsigned xb_ld(unsigned* p)              { return __hip_atomic_load(p, __ATOMIC_RELAXED, __HIP_MEMORY_SCOPE_AGENT); }
__device__ __forceinline__ unsigned xb_add(unsigned* p, unsigned v) { return __hip_atomic_fetch_add(p, v, __ATOMIC_RELAXED, __HIP_MEMORY_SCOPE_AGENT); }
__device__ __forceinline__ unsigned xb_xcc_id() { return (unsigned)__builtin_amdgcn_s_getreg((3 << 11) | 20) & 0xFu; }
#define XB_SPIN(cond, bar) do { unsigned _sp = 0; while (cond) { __builtin_amdgcn_s_sleep(1); \
    if ((++_sp & 255u) == 0u) { if (xb_ld(&(bar)[XB_TMO])) break; if (_sp > XB_SPIN_CAP) { atomicAdd(&(bar)[XB_TMO], 1u); break; } } } } while (0)
struct XcdBarrier { unsigned* bar; unsigned x; volatile LAS unsigned* st; };
__device__ __forceinline__ XcdBarrier xcd_barrier_post(unsigned* bar, volatile LAS unsigned* st) {
    XcdBarrier b; b.bar = bar; b.x = xb_xcc_id(); b.st = st;
    if (threadIdx.x == 0) (void)xb_add(&bar[XB_XCNT(b.x)], 1u);
    return b;
}
__device__ __forceinline__ void xcd_barrier_complete(unsigned* bar, unsigned x, unsigned& nloc, unsigned& nx) {
    const unsigned G = gridDim.x * gridDim.y * gridDim.z;
    unsigned sum, cnt, mine, sp = 0u;
    for (;;) {
        sum = 0u; cnt = 0u; mine = 0u;
#pragma unroll
        for (unsigned j = 0; j < 16; ++j) { const unsigned c = xb_ld(&bar[XB_XCNT(j)]); sum += c; cnt += (c > 0u) ? 1u : 0u; mine = (j == x) ? c : mine; }
        if (sum == G) break;
        __builtin_amdgcn_s_sleep(1);
        if ((++sp & 255u) == 0u) { if (xb_ld(&bar[XB_TMO])) break; if (sp > XB_SPIN_CAP) { atomicAdd(&bar[XB_TMO], 1u); break; } }
    }
    nloc = mine > 0u ? mine : 1u; nx = cnt > 0u ? cnt : 1u;
}
__device__ __forceinline__ void xcd_barrier(const XcdBarrier& b) {
    asm volatile("s_waitcnt vmcnt(0)" ::: "memory");
    __syncthreads();
    if (threadIdx.x == 0) {
        unsigned* bar = b.bar;
        __builtin_amdgcn_s_waitcnt(0);
        unsigned nloc = b.st[0], nx = b.st[1];
        if (nloc == 0u) { xcd_barrier_complete(bar, b.x, nloc, nx); b.st[0] = nloc; b.st[1] = nx; }
        const unsigned old = xb_add(&bar[XB_XSUB(b.x)], 1u);
        const unsigned gen = old / nloc;
        if (old + 1u == (gen + 1u) * nloc) {
            __builtin_amdgcn_fence(__ATOMIC_RELEASE, "agent");
            asm volatile("s_waitcnt vmcnt(0)" ::: "memory");
            const unsigned og = xb_add(&bar[XB_TOP], 1u);
            const unsigned tg = og / nx;
            if (og + 1u == (tg + 1u) * nx) xb_add(&bar[XB_TOPGEN], 1u);
            else XB_SPIN(xb_ld(&bar[XB_TOPGEN]) == tg, bar);
            __builtin_amdgcn_fence(__ATOMIC_ACQUIRE, "agent");
            xb_add(&bar[XB_XGEN(b.x)], 1u);
            asm volatile("s_waitcnt vmcnt(0)" ::: "memory");
        } else {
            XB_SPIN(xb_ld(&bar[XB_XGEN(b.x)]) == gen, bar);
            __builtin_amdgcn_fence(__ATOMIC_ACQUIRE, "agent");
            asm volatile("s_waitcnt vmcnt(0)" ::: "memory");
        }
    }
    __syncthreads();
}

struct MapIdent { const float* W; int ld; __device__ __forceinline__ const float* col(int n) const { return W + n; } };
struct MapUp {
    const float* G; const float* U; int ld;
    __device__ __forceinline__ const float* col(int n) const { const int g = n >> 5, j = n & 31; return j < 16 ? G + 16 * g + j : U + 16 * g + (j - 16); }
};
struct MapWin {
    const float* W; int ld;
    __device__ __forceinline__ const float* col(int n) const {
        int src;
        if (n < 512) src = n; else if (n < 1024) src = 2120 + (n - 512); else if (n < 1536) src = 3912 + (n - 1024);
        else if (n < 5632) { const int z = n - 1536; if (z < 1608) src = 512 + z; else if (z < 1792) src = -1; else if (z < 3072) src = 840 + z; else src = 1352 + z; }
        else src = 5448 + (n - 5632);
        return src < 0 ? nullptr : W + src;
    }
};
template <class Map>
__device__ __forceinline__ void conv_item(const Map& mp, int K, bf16* WT, LAS float* scr, int item, int nblk, int lane) {
    const int kb = item / nblk, nb = item % nblk, k0 = 32 * kb, n0 = 32 * nb;
    const float* cp = mp.col(n0 + (lane & 31)); const size_t ld = (size_t)mp.ld;
#pragma unroll
    for (int i = 0; i < 16; ++i) { const int kk = 2 * i + (lane >> 5); scr[kk * 33 + (lane & 31)] = cp ? cp[(size_t)(k0 + kk) * ld] : 0.f; }
    LDS_WAIT(); asm volatile("" ::: "memory");
    const int c = lane & 3;
#pragma unroll
    for (int j = 0; j < 2; ++j) { const int n = (lane >> 2) + 16 * j; const LAS float* s = scr + (8 * c) * 33 + n;
        v4u o; o.x = pg8::cvt_pk_bf16(s[0 * 33], s[1 * 33]); o.y = pg8::cvt_pk_bf16(s[2 * 33], s[3 * 33]); o.z = pg8::cvt_pk_bf16(s[4 * 33], s[5 * 33]); o.w = pg8::cvt_pk_bf16(s[6 * 33], s[7 * 33]);
        *(GAS v4u*)(WT + (size_t)(n0 + n) * K + k0 + 8 * c) = o; }
    LDS_WAIT(); asm volatile("" ::: "memory");
}
__host__ __device__ constexpr int conv_items(int K, int N) { return (K / 32) * (N / 32); }

__device__ __forceinline__ void rownorm_rows(const float* base, const bf16* Y, float s, const float* gpost, float* out, const float* gnext, bf16* XN, int gw, int NGW, int lane, float oscale = 1.f) {
    for (int m = gw; m < M; m += NGW) {
        f32x4 v[4];
#pragma unroll
        for (int j = 0; j < 4; ++j) v[j] = ((const GAS f32x4*)(base + (size_t)m * DM))[lane + 64 * j];
        if (Y) {
            f32x4 y[4]; float ss = 0.f;
#pragma unroll
            for (int j = 0; j < 4; ++j) { const v2u w = ((const GAS v2u*)(Y + (size_t)m * DM))[lane + 64 * j]; y[j] = (f32x4){bflo(w.x), bfhi(w.x), bflo(w.y), bfhi(w.y)};
                ss += (y[j].x * y[j].x + y[j].y * y[j].y) + (y[j].z * y[j].z + y[j].w * y[j].w); }
            const float r = s * __builtin_amdgcn_rsqf(wave_sum(ss) * (1.f / DM) + NORM_EPS);
#pragma unroll
            for (int j = 0; j < 4; ++j) { const f32x4 g = ((const GAS f32x4*)gpost)[lane + 64 * j]; v[j] = v[j] + y[j] * g * r; ((GAS f32x4*)(out + (size_t)m * DM))[lane + 64 * j] = v[j] * oscale; }
        }
        if (XN) {
            float ss = 0.f;
#pragma unroll
            for (int j = 0; j < 4; ++j) ss += (v[j].x * v[j].x + v[j].y * v[j].y) + (v[j].z * v[j].z + v[j].w * v[j].w);
            const float r = __builtin_amdgcn_rsqf(wave_sum(ss) * (1.f / DM) + NORM_EPS);
#pragma unroll
            for (int j = 0; j < 4; ++j) { const f32x4 g = ((const GAS f32x4*)gnext)[lane + 64 * j]; const f32x4 o = v[j] * g * r;
                v2u w; w.x = pk2(o.x, o.y); w.y = pk2(o.z, o.w); ((GAS v2u*)(XN + (size_t)m * DM))[lane + 64 * j] = w; }
        }
    }
}

namespace scan {
template <int CTRL> __device__ __forceinline__ float dpp_add(float x) {
    const int y = __builtin_amdgcn_update_dpp(0, __builtin_bit_cast(int, x), CTRL, 0xF, 0xF, false);
    return x + __builtin_bit_cast(float, y);
}
__device__ __forceinline__ float red8(float x) { x = dpp_add<0xB1>(x); x = dpp_add<0x4E>(x); x = dpp_add<0x141>(x); return x; }
__device__ __forceinline__ float red16(float x) { x = dpp_add<0xB1>(x); x = dpp_add<0x4E>(x); x = dpp_add<0x141>(x); x = dpp_add<0x140>(x); return x; }
__device__ __forceinline__ void ld8(const bf16* p, float (&o)[8]) { const v4u w = *(const GAS v4u*)p; o[0] = bflo(w.x); o[1] = bfhi(w.x); o[2] = bflo(w.y); o[3] = bfhi(w.y); o[4] = bflo(w.z); o[5] = bfhi(w.z); o[6] = bflo(w.w); o[7] = bfhi(w.w); }
}
struct PrepP { const bf16* ZR; bf16* X1; unsigned char* A8; bf16* KI; const float *mu, *w0, *wup, *a0, *aup; };
__device__ __forceinline__ void rwkv_prep(const PrepP& P, LAS unsigned char* lds) {
    const int tid = otid_(), lane = tid & 63, h = __builtin_amdgcn_readfirstlane(tid >> 6), c16 = lane & 15, quad = lane >> 4;
    constexpr int SP = 144;
    LAS unsigned char* TA = lds; LAS unsigned char* AA = lds + 64 * SP;
    bf16x8 bw[4][2], ba[4][2];
#pragma unroll
    for (int ct = 0; ct < 4; ++ct)
#pragma unroll
        for (int s = 0; s < 2; ++s) { const size_t o = (size_t)(32 * s + 8 * quad) * 512 + 64 * h + 16 * ct + c16; const float* gw_ = P.wup + o; const float* ga_ = P.aup + o;
            v4u w; w.x = pk2(gw_[0], gw_[512]); w.y = pk2(gw_[1024], gw_[1536]); w.z = pk2(gw_[2048], gw_[2560]); w.w = pk2(gw_[3072], gw_[3584]); bw[ct][s] = __builtin_bit_cast(bf16x8, w);
            v4u a; a.x = pk2(ga_[0], ga_[512]); a.y = pk2(ga_[1024], ga_[1536]); a.z = pk2(ga_[2048], ga_[2560]); a.w = pk2(ga_[3072], ga_[3584]); ba[ct][s] = __builtin_bit_cast(bf16x8, a); }
    float w0v[4], a0v[4];
#pragma unroll
    for (int ct = 0; ct < 4; ++ct) { w0v[ct] = P.w0[64 * h + 16 * ct + c16]; a0v[ct] = P.a0[64 * h + 16 * ct + c16]; }
    const int stok = tid >> 3, sseg = tid & 7;
#pragma unroll 1
    for (int m0 = blockIdx.x * 64; m0 < M; m0 += gridDim.x * 64) {
        {   const size_t m = (size_t)m0 + stok; const int t = (int)(m & (T - 1));
            *(GAS v4u*)(P.KI + m * 64 + 8 * sseg) = *(const GAS v4u*)(P.ZR + m * ZP + ZC_KI + 8 * sseg);
            float wc[8], ac[8], p8[8];
            scan::ld8(P.ZR + m * ZP + ZC_WC + 8 * sseg, wc); scan::ld8(P.ZR + m * ZP + ZC_AC + 8 * sseg, ac);
            if (t > 0) { scan::ld8(P.ZR + (m - 1) * ZP + ZC_WC + 8 * sseg, p8);
#pragma unroll
                for (int e = 0; e < 8; ++e) wc[e] += (p8[e] - wc[e]) * P.mu[1536 + 8 * sseg + e];
                scan::ld8(P.ZR + (m - 1) * ZP + ZC_AC + 8 * sseg, p8);
#pragma unroll
                for (int e = 0; e < 8; ++e) ac[e] += (p8[e] - ac[e]) * P.mu[1600 + 8 * sseg + e]; }
            else {
#pragma unroll
                for (int e = 0; e < 8; ++e) { wc[e] -= wc[e] * P.mu[1536 + 8 * sseg + e]; ac[e] -= ac[e] * P.mu[1600 + 8 * sseg + e]; } }
            float th[8];
#pragma unroll
            for (int e = 0; e < 8; ++e) th[e] = 1.f - 2.f * __builtin_amdgcn_rcpf(__expf(2.f * wc[e]) + 1.f);
            v4u o; o.x = pk2(th[0], th[1]); o.y = pk2(th[2], th[3]); o.z = pk2(th[4], th[5]); o.w = pk2(th[6], th[7]); *(LAS v4u*)(TA + stok * SP + 16 * sseg) = o;
            v4u q; q.x = pk2(ac[0], ac[1]); q.y = pk2(ac[2], ac[3]); q.z = pk2(ac[4], ac[5]); q.w = pk2(ac[6], ac[7]); *(LAS v4u*)(AA + stok * SP + 16 * sseg) = q;
        }
        __syncthreads();
#pragma unroll 1
        for (int rt = 0; rt < 4; ++rt) {
            f32x4 accw[4], acca[4];
#pragma unroll
            for (int ct = 0; ct < 4; ++ct) { accw[ct] = (f32x4){0.f, 0.f, 0.f, 0.f}; acca[ct] = (f32x4){0.f, 0.f, 0.f, 0.f}; }
#pragma unroll
            for (int s = 0; s < 2; ++s) { const bf16x8 fw = *(const LAS bf16x8*)(TA + (16 * rt + c16) * SP + (32 * s + 8 * quad) * 2), fa = *(const LAS bf16x8*)(AA + (16 * rt + c16) * SP + (32 * s + 8 * quad) * 2);
#pragma unroll
                for (int ct = 0; ct < 4; ++ct) { accw[ct] = __builtin_amdgcn_mfma_f32_16x16x32_bf16(fw, bw[ct][s], accw[ct], 0, 0, 0); acca[ct] = __builtin_amdgcn_mfma_f32_16x16x32_bf16(fa, ba[ct][s], acca[ct], 0, 0, 0); } }
#pragma unroll
            for (int j = 0; j < 4; ++j) { const size_t m = (size_t)m0 + 16 * rt + 4 * quad + j;
#pragma unroll
                for (int ct = 0; ct < 4; ++ct) { const int ch = 64 * h + 16 * ct + c16;
                    const float sg = sigm(w0v[ct] + accw[ct][j]);
                    const float x1 = 1.f - __expf(-0.6065306597126334f * sg);
                    const float a = sigm(a0v[ct] + acca[ct][j]);
                    P.X1[m * 512 + ch] = (bf16)f2bf(x1);
                    P.A8[m * 512 + ch] = (unsigned char)(int)(a * 255.f + 0.5f); } }
        }
        __syncthreads();
    }
}

struct ScanP { const bf16* Q3; const bf16* ZR; const bf16* X1; const unsigned char* A8; bf16* yraw; float* rdotk; const float *mu, *k_k, *k_a, *r_k; };
namespace scan {
constexpr int TB = 32, NBLK = T / TB;
constexpr int CB_W = 0, CB_B = 8192, CB_K = 16384, CB_KW = 24576, CB_V = 40960, CB_BR = 43008, CB_KR = 43136, CB_SA = 43264, CB_YP = 45312, CBSZ = 78080;
constexpr int L_END = 2 * CBSZ;
static_assert(L_END <= LDS_MISC, "scan LDS");
}
__device__ __forceinline__ void rwkv_scan_unit(const ScanP& P, int unit, LAS unsigned char* lds) {
    using namespace scan;
    const int tid = otid_(), wid = __builtin_amdgcn_readfirstlane(tid >> 6), lane = tid & 63;
    const int b = unit >> 5, h = (unit >> 2) & 7, vq = unit & 3;
    const size_t mrow0 = (size_t)b * T;
    if (wid >= 4) {
        const int pw = wid - 4, tokl = lane >> 3, seg = lane & 7, c0 = 8 * seg, hc0 = 64 * h + c0;
        float mu_r[8], mu_k[8], kkv[8], kav[8], rkv[8];
#pragma unroll
        for (int e = 0; e < 8; ++e) { mu_r[e] = P.mu[hc0 + e]; mu_k[e] = P.mu[512 + hc0 + e]; kkv[e] = P.k_k[hc0 + e]; kav[e] = P.k_a[hc0 + e]; rkv[e] = P.r_k[hc0 + e]; }
        const int vc0 = 64 * h + 16 * vq + 2 * seg;
        const float mu_v0 = P.mu[1024 + vc0], mu_v1 = P.mu[1024 + vc0 + 1];
        const int ptid = pw * 64 + lane;
        for (int blk = -1; blk < NBLK; ++blk) {
            const int nb = blk + 1;
            LAS unsigned char* cb = lds + (nb & 1) * CBSZ;
            if (blk >= 1) {
                const int tok = ptid >> 3, v2 = (ptid & 7) * 2;
                const LAS float* YPp = (const LAS float*)(cb + CB_YP) + (tok * 16 + v2) * 16;
                float y0 = 0.f, y1 = 0.f;
#pragma unroll
                for (int q4 = 0; q4 < 4; ++q4) { const f32x4 a = *(const LAS f32x4*)(YPp + 4 * q4), c = *(const LAS f32x4*)(YPp + 16 + 4 * q4); y0 += (a.x + a.y) + (a.z + a.w); y1 += (c.x + c.y) + (c.z + c.w); }
                const float br = *(const LAS float*)(cb + CB_BR + tok * 4), kr = *(const LAS float*)(cb + CB_KR + tok * 4);
                const f32x2 sa = *(const LAS f32x2*)(cb + CB_SA + (tok * 16 + v2) * 4), vv = *(const LAS f32x2*)(cb + CB_V + (tok * 16 + v2) * 4);
                y0 += sa.x * br + vv.x * kr; y1 += sa.y * br + vv.y * kr;
                const size_t m = mrow0 + (size_t)(blk - 1) * TB + tok;
                *(GAS unsigned*)(P.yraw + m * 512 + 64 * h + 16 * vq + v2) = pk2(y0, y1);
                LDS_WAIT(); asm volatile("" ::: "memory");
            }
            if (nb < NBLK) {
                const int t = nb * TB + 8 * pw + tokl; const size_t m = mrow0 + t;
                float r8[8], k8[8], p8[8], x8[8], a8[8];
                ld8(P.Q3 + m * QP + 512 + hc0, r8); ld8(P.ZR + m * ZP + ZC_RK + hc0, k8); ld8(P.X1 + m * 512 + hc0, x8);
                { const v2u aw = *(const GAS v2u*)(P.A8 + m * 512 + hc0); const float sc = 1.f / 255.f;
                  a8[0] = (float)(aw.x & 255u) * sc; a8[1] = (float)((aw.x >> 8) & 255u) * sc; a8[2] = (float)((aw.x >> 16) & 255u) * sc; a8[3] = (float)(aw.x >> 24) * sc;
                  a8[4] = (float)(aw.y & 255u) * sc; a8[5] = (float)((aw.y >> 8) & 255u) * sc; a8[6] = (float)((aw.y >> 16) & 255u) * sc; a8[7] = (float)(aw.y >> 24) * sc; }
                const unsigned vw = *(const GAS unsigned*)(P.ZR + m * ZP + ZC_RV + vc0); float v0 = bflo(vw), v1 = bfhi(vw);
                if (t > 0) {
                    ld8(P.Q3 + (m - 1) * QP + 512 + hc0, p8);
#pragma unroll
                    for (int e = 0; e < 8; ++e) r8[e] += (p8[e] - r8[e]) * mu_r[e];
                    ld8(P.ZR + (m - 1) * ZP + ZC_RK + hc0, p8);
#pragma unroll
                    for (int e = 0; e < 8; ++e) k8[e] += (p8[e] - k8[e]) * mu_k[e];
                    const unsigned pv = *(const GAS unsigned*)(P.ZR + (m - 1) * ZP + ZC_RV + vc0);
                    v0 += (bflo(pv) - v0) * mu_v0; v1 += (bfhi(pv) - v1) * mu_v1;
                } else {
#pragma unroll
                    for (int e = 0; e < 8; ++e) { r8[e] -= r8[e] * mu_r[e]; k8[e] -= k8[e] * mu_k[e]; }
                    v0 -= v0 * mu_v0; v1 -= v1 * mu_v1;
                }
                float kk8[8]; { float ss = 0.f;
#pragma unroll
                  for (int e = 0; e < 8; ++e) { kk8[e] = k8[e] * kkv[e]; ss += kk8[e] * kk8[e]; }
                  ss = red8(ss); const float inv = 1.f / fmaxf(sqrtf(ss), 1e-12f);
#pragma unroll
                  for (int e = 0; e < 8; ++e) kk8[e] *= inv; }
                float w8[8], bb[8], km[8], wr[8]; float brp = 0.f, krp = 0.f, rkp = 0.f;
#pragma unroll
                for (int e = 0; e < 8; ++e) {
                    w8[e] = 1.f - x8[e];
                    bb[e] = kk8[e] * a8[e]; km[e] = k8[e] * (1.f + (a8[e] - 1.f) * kav[e]); wr[e] = w8[e] * r8[e];
                    brp += bb[e] * r8[e]; krp += km[e] * r8[e]; rkp += r8[e] * km[e] * rkv[e];
                }
                brp = red8(brp); krp = red8(krp); rkp = red8(rkp);
                const int ti = 8 * pw + tokl;
                *(LAS f32x4*)(cb + CB_W + (ti * 64 + c0) * 4) = (f32x4){w8[0], w8[1], w8[2], w8[3]}; *(LAS f32x4*)(cb + CB_W + (ti * 64 + c0 + 4) * 4) = (f32x4){w8[4], w8[5], w8[6], w8[7]};
                *(LAS f32x4*)(cb + CB_B + (ti * 64 + c0) * 4) = (f32x4){bb[0], bb[1], bb[2], bb[3]}; *(LAS f32x4*)(cb + CB_B + (ti * 64 + c0 + 4) * 4) = (f32x4){bb[4], bb[5], bb[6], bb[7]};
                *(LAS f32x4*)(cb + CB_K + (ti * 64 + c0) * 4) = (f32x4){km[0], km[1], km[2], km[3]}; *(LAS f32x4*)(cb + CB_K + (ti * 64 + c0 + 4) * 4) = (f32x4){km[4], km[5], km[6], km[7]};
#pragma unroll
                for (int e = 0; e < 8; e += 2) *(LAS f32x4*)(cb + CB_KW + (ti * 64 + c0 + e) * 8) = (f32x4){kk8[e], wr[e], kk8[e + 1], wr[e + 1]};
                *(LAS f32x2*)(cb + CB_V + (ti * 16 + 2 * seg) * 4) = (f32x2){v0, v1};
                if (seg == 0) { *(LAS float*)(cb + CB_BR + ti * 4) = brp; *(LAS float*)(cb + CB_KR + ti * 4) = krp; if (vq == 0) P.rdotk[m * 8 + h] = rkp; }
            }
            __syncthreads();
        }
        { const LAS unsigned char* cb = lds + ((NBLK - 1) & 1) * CBSZ;
          const int tok = ptid >> 3, v2 = (ptid & 7) * 2;
          const LAS float* YPp = (const LAS float*)(cb + CB_YP) + (tok * 16 + v2) * 16;
          float y0 = 0.f, y1 = 0.f;
#pragma unroll
          for (int q4 = 0; q4 < 4; ++q4) { const f32x4 a = *(const LAS f32x4*)(YPp + 4 * q4), c = *(const LAS f32x4*)(YPp + 16 + 4 * q4); y0 += (a.x + a.y) + (a.z + a.w); y1 += (c.x + c.y) + (c.z + c.w); }
          const float br = *(const LAS float*)(cb + CB_BR + tok * 4), kr = *(const LAS float*)(cb + CB_KR + tok * 4);
          const f32x2 sa = *(const LAS f32x2*)(cb + CB_SA + (tok * 16 + v2) * 4), vv = *(const LAS f32x2*)(cb + CB_V + (tok * 16 + v2) * 4);
          y0 += sa.x * br + vv.x * kr; y1 += sa.y * br + vv.y * kr;
          const size_t m = mrow0 + (size_t)(NBLK - 1) * TB + tok;
          *(GAS unsigned*)(P.yraw + m * 512 + 64 * h + 16 * vq + v2) = pk2(y0, y1); }
    } else {
        const int vi = 4 * wid + (lane >> 4), cg = lane & 15;
        f32x2 s01 = {0.f, 0.f}, s23 = {0.f, 0.f};
        __syncthreads();
        __builtin_amdgcn_s_setprio(3);
        const unsigned lo4 = (unsigned)(4 * cg) * 4u, lo8 = (unsigned)(4 * cg) * 8u;
        for (int blk = 0; blk < NBLK; ++blk) {
            const LAS unsigned char* cb = lds + (blk & 1) * CBSZ;
            f32x4 kwa = *(const LAS f32x4*)(cb + CB_KW + lo8), kwb = *(const LAS f32x4*)(cb + CB_KW + lo8 + 16);
            f32x4 w4 = *(const LAS f32x4*)(cb + CB_W + lo4), b4 = *(const LAS f32x4*)(cb + CB_B + lo4), k4 = *(const LAS f32x4*)(cb + CB_K + lo4);
            float vv = *(const LAS float*)(cb + CB_V + vi * 4);
#pragma unroll 4
            for (int tok = 0; tok < TB; ++tok) {
                const int tn = tok + 1 < TB ? tok + 1 : tok;
                const f32x4 nkwa = *(const LAS f32x4*)(cb + CB_KW + tn * 512 + lo8), nkwb = *(const LAS f32x4*)(cb + CB_KW + tn * 512 + lo8 + 16);
                const f32x4 nw4 = *(const LAS f32x4*)(cb + CB_W + tn * 256 + lo4), nb4 = *(const LAS f32x4*)(cb + CB_B + tn * 256 + lo4), nk4 = *(const LAS f32x4*)(cb + CB_K + tn * 256 + lo4);
                const float nvv = *(const LAS float*)(cb + CB_V + (tn * 16 + vi) * 4);
                f32x2 p = (f32x2){s01.x, s01.x} * (f32x2){kwa.x, kwa.y};
                p += (f32x2){s01.y, s01.y} * (f32x2){kwa.z, kwa.w};
                p += (f32x2){s23.x, s23.x} * (f32x2){kwb.x, kwb.y};
                p += (f32x2){s23.y, s23.y} * (f32x2){kwb.z, kwb.w};
                *(LAS float*)(cb + CB_YP + ((tok * 16 + vi) * 16 + cg) * 4) = p.y;
                const f32x2 t01 = s01 * (f32x2){w4.x, w4.y} + (f32x2){k4.x, k4.y} * vv, t23 = s23 * (f32x2){w4.z, w4.w} + (f32x2){k4.z, k4.w} * vv;
                const float d1 = red16(p.x);
                s01 = t01 - (f32x2){b4.x, b4.y} * d1; s23 = t23 - (f32x2){b4.z, b4.w} * d1;
                *(LAS float*)(cb + CB_SA + (tok * 16 + vi) * 4) = -d1;
                kwa = nkwa; kwb = nkwb; w4 = nw4; b4 = nb4; k4 = nk4; vv = nvv;
            }
            __syncthreads();
        }
        __builtin_amdgcn_s_setprio(0);
    }
    __syncthreads();
}

struct Dsa1P { const bf16* ZR; const bf16* KI; unsigned* bitm; gu32* done; };
namespace dsa1 {
constexpr int CAP = 769  , PRUNE_AT = 512, KEEP = 256;
constexpr int L_BUF = 0, L_CNT = 32 * CAP * 4, L_THR = L_CNT + 128, L_THRK = L_THR + 128, L_HIST = ((L_THRK + 128 + 15) / 16) * 16, L_MROW = L_HIST + 8 * 1024, L_QF = L_MROW + 8 * 1024, QFP = 1040, L_END = L_QF + 32 * QFP;
static_assert(L_END <= LDS_MISC, "dsa1 LDS");
__device__ __forceinline__ unsigned packkey(float s, int keyidx) { const unsigned bits = __float_as_uint(s); const unsigned u = bits ^ ((unsigned)((int)bits >> 31) | 0x80000000u); return (u & 0xFFFFE000u) | (unsigned)(8191 - keyidx); }
__device__ __forceinline__ float thr_of(unsigned key) { const unsigned u = key & 0xFFFFE000u; const unsigned bits = (u & 0x80000000u) ? (u ^ 0x80000000u) : ~u; return __uint_as_float(bits); }
__device__ __forceinline__ void prune(LAS unsigned char* lds, int qq, int wid, int lane, bool exact) {
    asm volatile("" : "+v"(lane));
    LAS unsigned* buf = (LAS unsigned*)(lds + L_BUF) + qq * CAP; LAS unsigned* cnt = (LAS unsigned*)(lds + L_CNT); LAS float* thr = (LAS float*)(lds + L_THR); LAS unsigned* thrk = (LAS unsigned*)(lds + L_THRK);
    LAS unsigned* hist = (LAS unsigned*)(lds + L_HIST) + wid * 256;
    const int n = (int)cnt[qq];
    unsigned e[12];
#pragma unroll
    for (int k = 0; k < 12; ++k) e[k] = (lane + 64 * k < n) ? buf[lane + 64 * k] : 0u;
    const unsigned tk = thrk[qq];
    unsigned cut = 0u; bool have = false;
    if (!exact && tk != 0u) {
        const unsigned base16 = tk >> 16;
        *(LAS v4u*)(hist + 4 * lane) = (v4u){0u, 0u, 0u, 0u};
        LDS_WAIT(); asm volatile("" ::: "memory");
#pragma unroll
        for (int k = 0; k < 12; ++k) if (lane + 64 * k < n) { unsigned bn = (e[k] >> 16) - base16; bn = bn > 255u ? 255u : bn; (void)__hip_atomic_fetch_add(hist + bn, 1u, __ATOMIC_RELAXED, __HIP_MEMORY_SCOPE_WORKGROUP); }
        LDS_WAIT(); asm volatile("" ::: "memory");
        const v4u hv = *(const LAS v4u*)(hist + 4 * lane);
        const int tot = (int)(hv.x + hv.y + hv.z + hv.w);
        int suf = tot;
#pragma unroll
        for (int off = 1; off < 64; off <<= 1) { const int t = __shfl_down(suf, off); if (lane + off < 64) suf += t; }
        int above = suf - tot; int dsel = -1, csel = 0;
        { const int h3 = (int)hv.w, h2 = (int)hv.z, h1 = (int)hv.y, h0 = (int)hv.x;
          if (above < KEEP && KEEP <= above + h3) { dsel = 4 * lane + 3; csel = above + h3; } above += h3;
          if (above < KEEP && KEEP <= above + h2) { dsel = 4 * lane + 2; csel = above + h2; } above += h2;
          if (above < KEEP && KEEP <= above + h1) { dsel = 4 * lane + 1; csel = above + h1; } above += h1;
          if (above < KEEP && KEEP <= above + h0) { dsel = 4 * lane + 0; csel = above + h0; } }
        const unsigned long long bm = __ballot(dsel >= 0);
        const int src = bm ? (int)__builtin_ctzll(bm) : 0;
        const int d = __shfl(dsel, src), cd = __shfl(csel, src);
        LDS_WAIT(); asm volatile("" ::: "memory");
        if (bm != 0ull && cd <= KEEP + 128) { cut = (base16 + (unsigned)d) << 16; have = true; }
    }
    if (!have) {
        unsigned prefix = 0u; int want = KEEP;
#pragma unroll 1
        for (int p = 0; p < 4; ++p) {
            const int shift = 24 - 8 * p;
            *(LAS v4u*)(hist + 4 * lane) = (v4u){0u, 0u, 0u, 0u};
            LDS_WAIT(); asm volatile("" ::: "memory");
#pragma unroll
            for (int k = 0; k < 12; ++k) { const bool in = (lane + 64 * k < n) && (p == 0 || (e[k] >> (shift + 8)) == (prefix >> (shift + 8)));
                if (in) (void)__hip_atomic_fetch_add(hist + ((e[k] >> shift) & 255u), 1u, __ATOMIC_RELAXED, __HIP_MEMORY_SCOPE_WORKGROUP); }
            LDS_WAIT(); asm volatile("" ::: "memory");
            const v4u hv = *(const LAS v4u*)(hist + 4 * lane);
            const int tot = (int)(hv.x + hv.y + hv.z + hv.w);
            int suf = tot;
#pragma unroll
            for (int off = 1; off < 64; off <<= 1) { const int t = __shfl_down(suf, off); if (lane + off < 64) suf += t; }
            int above = suf - tot;
            int dsel = -1, asel = 0;
            { const int h3 = (int)hv.w, h2 = (int)hv.z, h1 = (int)hv.y, h0 = (int)hv.x;
              if (above < want && want <= above + h3) { dsel = 4 * lane + 3; asel = above; } above += h3;
              if (above < want && want <= above + h2) { dsel = 4 * lane + 2; asel = above; } above += h2;
              if (above < want && want <= above + h1) { dsel = 4 * lane + 1; asel = above; } above += h1;
              if (above < want && want <= above + h0) { dsel = 4 * lane + 0; asel = above; } }
            const unsigned long long bm = __ballot(dsel >= 0);
            const int src = bm ? (int)__builtin_ctzll(bm) : 0;
            const int d = __shfl(dsel, src), ab = __shfl(asel, src);
            prefix |= ((unsigned)(d < 0 ? 0 : d)) << shift; want -= ab;
            LDS_WAIT(); asm volatile("" ::: "memory");
        }
        cut = prefix;
    }
    int base = 0;
#pragma unroll
    for (int k = 0; k < 12; ++k) { const bool keep = (lane + 64 * k < n) && e[k] >= cut; const unsigned long long mk = __ballot(keep);
        const int pos = base + (int)__builtin_amdgcn_mbcnt_hi((unsigned)(mk >> 32), __builtin_amdgcn_mbcnt_lo((unsigned)mk, 0u));
        if (keep) buf[pos] = e[k]; base += (int)__builtin_popcountll(mk); }
    if (lane == 0) { cnt[qq] = (unsigned)base; thr[qq] = thr_of(cut); thrk[qq] = cut; }
    LDS_WAIT(); asm volatile("" ::: "memory");
}
}
__device__ __forceinline__ void dsa1_unit(const Dsa1P& P, int u, LAS unsigned char* lds) {
    using namespace dsa1;
    const int tid = otid_(), wid = __builtin_amdgcn_readfirstlane(tid >> 6), lane = tid & 63, q = lane & 31, hi = lane >> 5;
    const int b = u & 1, qb32 = 255 - (u >> 1), t0 = 32 * qb32;
    const size_t brow = (size_t)b * T;
    LAS unsigned* buf = (LAS unsigned*)(lds + L_BUF); LAS unsigned* cnt = (LAS unsigned*)(lds + L_CNT); LAS float* thr = (LAS float*)(lds + L_THR);
    if (tid < 32) { cnt[tid] = 0u; thr[tid] = -__builtin_inff(); ((LAS unsigned*)(lds + L_THRK))[tid] = 0u; }
    const bf16* qrow = P.ZR + (brow + t0 + q) * ZP;
    { const int r = tid >> 4, sg = tid & 15; const bf16* src = P.ZR + (brow + t0 + r) * ZP + ZC_QI + 32 * sg;
#pragma unroll
      for (int j = 0; j < 4; ++j) *(LAS v4u*)(lds + L_QF + r * QFP + 64 * sg + 16 * j) = *(const GAS v4u*)(src + 8 * j); }
    float wq[8];
    { const v4u w = *(const GAS v4u*)(qrow + ZC_WI); const float c = 0.35355339059327373f * 0.125f;
      wq[0] = bflo(w.x) * c; wq[1] = bfhi(w.x) * c; wq[2] = bflo(w.y) * c; wq[3] = bfhi(w.y) * c; wq[4] = bflo(w.z) * c; wq[5] = bfhi(w.z) * c; wq[6] = bflo(w.w) * c; wq[7] = bfhi(w.w) * c; }
    const int tq = t0 + q;
    const int nsteps = (t0 + 32 + 255) >> 8;
    __syncthreads();
    float th = -__builtin_inff();
    bf16x8 afn[4];
    { const int k0 = 32 * wid; const bf16* krow = P.KI + (brow + (k0 <= t0 + 31 ? k0 : 0) + q) * 64 + 8 * hi;
#pragma unroll
      for (int s = 0; s < 4; ++s) afn[s] = *(const GAS bf16x8*)(krow + 16 * s); }
    for (int st = 0; st < nsteps; ++st) {
        const int key0 = 256 * st + 32 * wid;
        bf16x8 af[4];
#pragma unroll
        for (int s = 0; s < 4; ++s) af[s] = afn[s];
        { const int k1 = key0 + 256; const bf16* krow = P.KI + (brow + (k1 <= t0 + 31 ? k1 : 0) + q) * 64 + 8 * hi;
#pragma unroll
          for (int s = 0; s < 4; ++s) afn[s] = *(const GAS bf16x8*)(krow + 16 * s); }
        if (key0 <= t0 + 31) {
            f32x16 sc;
#pragma unroll
            for (int i = 0; i < 16; ++i) sc[i] = 0.f;
            unsigned qfo = (unsigned)(L_QF + q * QFP + 16 * hi); asm volatile("" : "+v"(qfo));
#pragma unroll
            for (int hd = 0; hd < 8; ++hd) {
                f32x16 acc;
#pragma unroll
                for (int i = 0; i < 16; ++i) acc[i] = 0.f;
#pragma unroll
                for (int s = 0; s < 4; ++s) { const bf16x8 qb = *(const LAS bf16x8*)(lds + qfo + hd * 128 + 32 * s);
                    acc = __builtin_amdgcn_mfma_f32_32x32x16_bf16(af[s], qb, acc, 0, 0, 0); }
#pragma unroll
                for (int i = 0; i < 16; ++i) sc[i] = fmaf(fmaxf(acc[i], 0.f), wq[hd], sc[i]);
                __builtin_amdgcn_sched_barrier(0);
            }
            const bool diag = key0 + 31 > t0;
            unsigned pm = 0u;
#pragma unroll
            for (int i = 0; i < 16; ++i) { const int kidx = key0 + (i & 3) + 8 * (i >> 2) + 4 * hi; const bool ok = (sc[i] >= th) && (!diag || kidx <= tq); pm |= ok ? (1u << i) : 0u; }
            const int np = __builtin_popcount(pm);
            if (np > 0) {
                int pos = (int)__hip_atomic_fetch_add(cnt + q, (unsigned)np, __ATOMIC_RELAXED, __HIP_MEMORY_SCOPE_WORKGROUP);
                LAS unsigned* bq = buf + q * CAP;
#pragma unroll
                for (int i = 0; i < 16; ++i) if (pm & (1u << i)) { const int kidx = key0 + (i & 3) + 8 * (i >> 2) + 4 * hi; bq[pos] = packkey(sc[i], kidx); ++pos; }
            }
        }
        __syncthreads();
        { unsigned nm = (unsigned)__ballot(cnt[q] > (unsigned)PRUNE_AT); int i = 0;
          while (nm) { const int qq = __builtin_ctz(nm); nm &= nm - 1u; if ((i & 7) == wid) prune(lds, qq, wid, lane, false); ++i; } }
        __syncthreads();
        th = thr[q];
    }
    LAS unsigned* mrow = (LAS unsigned*)(lds + L_MROW) + wid * 256;
#pragma unroll 1
    for (int k = 0; k < 4; ++k) {
        const int qq = wid + 8 * k;
        if (cnt[qq] > (unsigned)KEEP) prune(lds, qq, wid, lane, true);
        const int nf = (int)cnt[qq];
        *(LAS v4u*)(mrow + 4 * lane) = (v4u){0u, 0u, 0u, 0u};
        LDS_WAIT(); asm volatile("" ::: "memory");
#pragma unroll
        for (int j = 0; j < 4; ++j) { const int idx = lane + 64 * j; if (idx < nf) { const unsigned e = buf[qq * CAP + idx]; const unsigned key = 8191u - (e & 0x1FFFu); (void)__hip_atomic_fetch_or(mrow + (key >> 5), 1u << (key & 31u), __ATOMIC_RELAXED, __HIP_MEMORY_SCOPE_WORKGROUP); } }
        LDS_WAIT(); asm volatile("" ::: "memory");
        unsigned long long* grow = (unsigned long long*)(P.bitm + (brow + t0 + qq) * 256);
#pragma unroll
        for (int j = 0; j < 2; ++j) { const int w2 = lane + 64 * j; const unsigned long long v = (unsigned long long)mrow[2 * w2] | ((unsigned long long)mrow[2 * w2 + 1] << 32);
            __hip_atomic_store(grow + w2, v, RLX_AGENT); }
        LDS_WAIT(); asm volatile("" ::: "memory");
    }
    VM_WAIT();
    __syncthreads();
    if (tid == 0) __hip_atomic_fetch_add(P.done + 64 * (b * 32 + (t0 >> 8)), 1u, RLX_AGENT);
}

struct RPostP { const bf16* ZR; bf16* Q3; const bf16* yraw; const float* rdotk; const float *mu, *gup, *lnw, *lnb; };
__device__ __forceinline__ void rwkv_post(const RPostP& P, LAS unsigned char* lds) {
    const int tid = otid_(), lane = tid & 63, h = __builtin_amdgcn_readfirstlane(tid >> 6), c16 = lane & 15, quad = lane >> 4;
    constexpr int SP = 272;
    LAS float* GT = (LAS float*)(lds + 64 * SP);
    bf16x8 bfr[4][4];
#pragma unroll
    for (int ct = 0; ct < 4; ++ct)
#pragma unroll
        for (int s = 0; s < 4; ++s) { const float* gp = P.gup + (size_t)(32 * s + 8 * quad) * 512 + 64 * h + 16 * ct + c16;
            v4u w; w.x = pk2(gp[0], gp[512]); w.y = pk2(gp[1024], gp[1536]); w.z = pk2(gp[2048], gp[2560]); w.w = pk2(gp[3072], gp[3584]); bfr[ct][s] = __builtin_bit_cast(bf16x8, w); }
    float muv[4], lnw[4], lnb[4];
#pragma unroll
    for (int ct = 0; ct < 4; ++ct) { const int ch = 64 * h + 16 * ct + c16; muv[ct] = P.mu[1024 + ch]; lnw[ct] = P.lnw[ch]; lnb[ct] = P.lnb[ch]; }
    const int stok = tid >> 3, sseg = tid & 7;
#pragma unroll 1
    for (int m0 = blockIdx.x * 64; m0 < M; m0 += gridDim.x * 64) {
        {   const size_t m = (size_t)m0 + stok; const int t = (int)(m & (T - 1));
            float gv[16], pv[16];
            { const v4u a = *(const GAS v4u*)(P.ZR + m * ZP + ZC_GC + 16 * sseg), c = *(const GAS v4u*)(P.ZR + m * ZP + ZC_GC + 16 * sseg + 8);
              gv[0] = bflo(a.x); gv[1] = bfhi(a.x); gv[2] = bflo(a.y); gv[3] = bfhi(a.y); gv[4] = bflo(a.z); gv[5] = bfhi(a.z); gv[6] = bflo(a.w); gv[7] = bfhi(a.w);
              gv[8] = bflo(c.x); gv[9] = bfhi(c.x); gv[10] = bflo(c.y); gv[11] = bfhi(c.y); gv[12] = bflo(c.z); gv[13] = bfhi(c.z); gv[14] = bflo(c.w); gv[15] = bfhi(c.w); }
            if (t > 0) { const v4u a = *(const GAS v4u*)(P.ZR + (m - 1) * ZP + ZC_GC + 16 * sseg), c = *(const GAS v4u*)(P.ZR + (m - 1) * ZP + ZC_GC + 16 * sseg + 8);
              pv[0] = bflo(a.x); pv[1] = bfhi(a.x); pv[2] = bflo(a.y); pv[3] = bfhi(a.y); pv[4] = bflo(a.z); pv[5] = bfhi(a.z); pv[6] = bflo(a.w); pv[7] = bfhi(a.w);
              pv[8] = bflo(c.x); pv[9] = bfhi(c.x); pv[10] = bflo(c.y); pv[11] = bfhi(c.y); pv[12] = bflo(c.z); pv[13] = bfhi(c.z); pv[14] = bflo(c.w); pv[15] = bfhi(c.w); }
            else {
#pragma unroll
              for (int e = 0; e < 16; ++e) pv[e] = 0.f; }
            float sg[16];
#pragma unroll
            for (int e = 0; e < 16; ++e) { const float mu = P.mu[1664 + 16 * sseg + e]; sg[e] = sigm(gv[e] + (pv[e] - gv[e]) * mu); }
            v4u o0, o1; o0.x = pk2(sg[0], sg[1]); o0.y = pk2(sg[2], sg[3]); o0.z = pk2(sg[4], sg[5]); o0.w = pk2(sg[6], sg[7]); o1.x = pk2(sg[8], sg[9]); o1.y = pk2(sg[10], sg[11]); o1.z = pk2(sg[12], sg[13]); o1.w = pk2(sg[14], sg[15]);
            *(LAS v4u*)(lds + stok * SP + 32 * sseg) = o0; *(LAS v4u*)(lds + stok * SP + 32 * sseg + 16) = o1;
        }
        __syncthreads();
#pragma unroll 1
        for (int rt = 0; rt < 4; ++rt) {
            f32x4 acc[4];
#pragma unroll
            for (int ct = 0; ct < 4; ++ct) acc[ct] = (f32x4){0.f, 0.f, 0.f, 0.f};
#pragma unroll
            for (int s = 0; s < 4; ++s) { const bf16x8 af = *(const LAS bf16x8*)(lds + (16 * rt + c16) * SP + (32 * s + 8 * quad) * 2);
#pragma unroll
                for (int ct = 0; ct < 4; ++ct) acc[ct] = __builtin_amdgcn_mfma_f32_16x16x32_bf16(af, bfr[ct][s], acc[ct], 0, 0, 0); }
#pragma unroll
            for (int ct = 0; ct < 4; ++ct)
#pragma unroll
                for (int j = 0; j < 4; ++j) GT[(4 * quad + j) * 512 + 64 * h + 16 * ct + c16] = acc[ct][j];
            __syncthreads();
            {   const int vtok = tid >> 5, vseg = tid & 31, ch0 = 16 * vseg, vh = vseg >> 2;
                const size_t m = (size_t)m0 + 16 * rt + vtok; const int t = (int)(m & (T - 1));
                float y[16], vv[16], vp[16], g[16];
                { const v4u a = *(const GAS v4u*)(P.yraw + m * 512 + ch0), c = *(const GAS v4u*)(P.yraw + m * 512 + ch0 + 8);
                  y[0] = bflo(a.x); y[1] = bfhi(a.x); y[2] = bflo(a.y); y[3] = bfhi(a.y); y[4] = bflo(a.z); y[5] = bfhi(a.z); y[6] = bflo(a.w); y[7] = bfhi(a.w);
                  y[8] = bflo(c.x); y[9] = bfhi(c.x); y[10] = bflo(c.y); y[11] = bfhi(c.y); y[12] = bflo(c.z); y[13] = bfhi(c.z); y[14] = bflo(c.w); y[15] = bfhi(c.w); }
                { const v4u a = *(const GAS v4u*)(P.ZR + m * ZP + ZC_RV + ch0), c = *(const GAS v4u*)(P.ZR + m * ZP + ZC_RV + ch0 + 8);
                  vv[0] = bflo(a.x); vv[1] = bfhi(a.x); vv[2] = bflo(a.y); vv[3] = bfhi(a.y); vv[4] = bflo(a.z); vv[5] = bfhi(a.z); vv[6] = bflo(a.w); vv[7] = bfhi(a.w);
                  vv[8] = bflo(c.x); vv[9] = bfhi(c.x); vv[10] = bflo(c.y); vv[11] = bfhi(c.y); vv[12] = bflo(c.z); vv[13] = bfhi(c.z); vv[14] = bflo(c.w); vv[15] = bfhi(c.w); }
                if (t > 0) { const v4u a = *(const GAS v4u*)(P.ZR + (m - 1) * ZP + ZC_RV + ch0), c = *(const GAS v4u*)(P.ZR + (m - 1) * ZP + ZC_RV + ch0 + 8);
                  vp[0] = bflo(a.x); vp[1] = bfhi(a.x); vp[2] = bflo(a.y); vp[3] = bfhi(a.y); vp[4] = bflo(a.z); vp[5] = bfhi(a.z); vp[6] = bflo(a.w); vp[7] = bfhi(a.w);
                  vp[8] = bflo(c.x); vp[9] = bfhi(c.x); vp[10] = bflo(c.y); vp[11] = bfhi(c.y); vp[12] = bflo(c.z); vp[13] = bfhi(c.z); vp[14] = bflo(c.w); vp[15] = bfhi(c.w); }
                else {
#pragma unroll
                  for (int e = 0; e < 16; ++e) vp[e] = 0.f; }
#pragma unroll
                for (int e4 = 0; e4 < 4; ++e4) { const f32x4 gq = *(const LAS f32x4*)(GT + vtok * 512 + ch0 + 4 * e4); g[4 * e4] = gq.x; g[4 * e4 + 1] = gq.y; g[4 * e4 + 2] = gq.z; g[4 * e4 + 3] = gq.w; }
                float sm = 0.f;
#pragma unroll
                for (int e = 0; e < 16; ++e) sm += y[e];
                sm = scan::dpp_add<0xB1>(sm); sm = scan::dpp_add<0x4E>(sm);
                const float mean = sm * (1.f / 64.f); float vs = 0.f;
#pragma unroll
                for (int e = 0; e < 16; ++e) { y[e] -= mean; vs += y[e] * y[e]; }
                vs = scan::dpp_add<0xB1>(vs); vs = scan::dpp_add<0x4E>(vs);
                const float rstd = __builtin_amdgcn_rsqf(vs * (1.f / 64.f) + 64e-5f);
                const float rk = P.rdotk[m * 8 + vh];
                unsigned ow[8];
#pragma unroll
                for (int e = 0; e < 16; e += 2) { float o2[2];
#pragma unroll
                    for (int d = 0; d < 2; ++d) { const int ch = ch0 + e + d; const float v = vv[e + d] + (vp[e + d] - vv[e + d]) * P.mu[1024 + ch];
                        o2[d] = (y[e + d] * rstd * P.lnw[ch] + P.lnb[ch] + rk * v) * g[e + d]; }
                    ow[e >> 1] = pk2(o2[0], o2[1]); }
                *(GAS v4u*)(P.Q3 + m * QP + 512 + ch0) = (v4u){ow[0], ow[1], ow[2], ow[3]}; *(GAS v4u*)(P.Q3 + m * QP + 512 + ch0 + 8) = (v4u){ow[4], ow[5], ow[6], ow[7]};
            }
            __syncthreads();
        }
        __syncthreads();
    }
}
struct DPostP { const bf16* O1; const bf16* O2; bf16* Q3; const float *lq1, *lk1, *lq2, *lk2, *subln; float lambda_init; };
__device__ __forceinline__ void diff_post(const DPostP& P, int gw, int NGW, int lane) {
    const float lam = __expf(wave_sum(P.lq1[lane] * P.lk1[lane])) - __expf(wave_sum(P.lq2[lane] * P.lk2[lane])) + P.lambda_init;
    const float s0 = P.subln[2 * lane] * (1.f - P.lambda_init), s1 = P.subln[2 * lane + 1] * (1.f - P.lambda_init);
    for (int it = gw; it < M * 4; it += NGW) {
        const size_t m = (size_t)(it >> 2); const int hh = it & 3;
        const unsigned a = *(const GAS unsigned*)(P.O1 + m * 512 + 128 * hh + 2 * lane), c = *(const GAS unsigned*)(P.O2 + m * 512 + 128 * hh + 2 * lane);
        const float x0 = bflo(a) - lam * bflo(c), x1 = bfhi(a) - lam * bfhi(c);
        const float r = __builtin_amdgcn_rsqf(wave_sum(x0 * x0 + x1 * x1) * (1.f / 128.f) + NORM_EPS);
        *(GAS unsigned*)(P.Q3 + m * QP + 1024 + 128 * hh + 2 * lane) = pk2(x0 * r * s0, x1 * r * s1);
    }
}

__device__ __forceinline__ int q_fetch(gu32* head, volatile LAS int* slot) {
    if (threadIdx.x == 0) *slot = (int)__hip_atomic_fetch_add(head, 1u, RLX_AGENT);
    __syncthreads();
    const int v = __builtin_amdgcn_readfirstlane(*slot);
    __syncthreads();
    return v;
}

struct Args { const float* in[32]; float* out; unsigned char* ws; int ph_lo, ph_hi; };
__device__ __forceinline__ const float* kin_(int i) { const char* ka = (const char*)__builtin_amdgcn_kernarg_segment_ptr(); unsigned off = (unsigned)i * 8u; asm volatile("" : "+s"(off)); return *(const float* const*)(ka + off); }
#define KIN(i) kin_(i)
#define XOUT ((float*)kin_(32))
__device__ __forceinline__ unsigned char* kws_() { return (unsigned char*)kin_(33); }
__device__ __forceinline__ int kint_(int byteoff) { const char* ka = (const char*)__builtin_amdgcn_kernarg_segment_ptr(); unsigned off = (unsigned)byteoff; asm volatile("" : "+s"(off)); return *(const int*)(ka + off); }
constexpr int PH_L = 14;
constexpr int N_PHASES = 1 + NLAYER * PH_L;

#define G ((int)gridDim.x)
#define bid ((int)blockIdx.x)
#define gw (bid * NWAVES + wave)
#define NGW (G * NWAVES)
#define MISC ((volatile LAS unsigned*)(lds + LDS_MISC))
#define IN(k) (kint_(272) <= (k) && (k) < kint_(276))
#define SEAM(k) do { if ((k) + 1 < kint_(276)) { XcdBarrier bar_; bar_.bar = (unsigned*)(kws_() + WS_CTL) + CW_BAR; bar_.x = xb_xcc_id(); bar_.st = MISC + 8; xcd_barrier(bar_); } } while (0)
#define WSL() unsigned char* wsl = kws_(); const int tid = otid_(), lane = tid & 63, wave = __builtin_amdgcn_readfirstlane(tid >> 6); (void)lane; (void)wave
#define WFu ((bf16*)(wsl + WS_WF))
#define WFd ((bf16*)(wsl + WS_WF_DOWN))
#define WMi ((bf16*)(wsl + WS_WM))
#define WMb ((bf16*)(wsl + WS_WM_BR))
#define WMo ((bf16*)(wsl + WS_WM_OUT))
#define XN ((bf16*)(wsl + WS_XN))
#define Q3 ((bf16*)(wsl + WS_Q3))
#define ZR ((bf16*)(wsl + WS_ZR))
#define YP ((bf16*)(wsl + WS_R2))
#define HB ZR
#define G3 ZR
#define MG ((bf16*)(wsl + WS_MG))
#define O1 ((bf16*)(wsl + WS_R2))
#define O2 ((bf16*)(wsl + WS_R2) + (size_t)M * 512)
#define YRAW ((bf16*)(wsl + WS_YRAW))
#define BITM ((unsigned*)(wsl + WS_BITM))
#define RDOTK ((float*)(wsl + WS_RDOTK))
#define X1B ((bf16*)(wsl + WS_X1))
#define KID ((bf16*)(wsl + WS_KID))
#define A8B ((unsigned char*)(wsl + WS_A8))
#define CTL ((gu32*)(wsl + WS_CTL))
#define cscr ((LAS float*)(lds + wave * 16384))

#define CONV_FFN(l_, f_) do { const int gi_ = (f_) ? 29 : 3; \
        MapUp mu_{KIN(gi_) + (size_t)(l_) * DM * FF, KIN(gi_ + 1) + (size_t)(l_) * DM * FF, FF}; MapIdent md_{KIN(gi_ + 2) + (size_t)(l_) * FF * DM, DM}; \
        constexpr int nu_ = conv_items(DM, 2 * FF), nd_ = conv_items(FF, DM); \
        for (int it_ = gw; it_ < nu_ + nd_; it_ += NGW) { if (it_ < nu_) conv_item(mu_, DM, WFu, cscr, it_, 2 * FF / 32, lane); else conv_item(md_, FF, WFd, cscr, it_ - nu_, DM / 32, lane); } } while (0)
#define CONV_MIX(l_) do { MapWin mw_{KIN(8) + (size_t)(l_) * DM * NIN, NIN}; MapIdent mo_{KIN(26) + (size_t)(l_) * DM * DM, DM}; \
        constexpr int ni_ = conv_items(DM, 8704), nb_ = conv_items(512, DM), no_ = conv_items(DM, DM); \
        for (int it_ = gw; it_ < ni_ + 3 * nb_ + no_; it_ += NGW) { \
            if (it_ < ni_) conv_item(mw_, DM, WMi, cscr, it_, 8704 / 32, lane); \
            else if (it_ < ni_ + 3 * nb_) { const int r_ = it_ - ni_, n_ = r_ / nb_; MapIdent mb_{KIN(25) + ((size_t)(l_) * 3 + n_) * 512 * DM, DM}; conv_item(mb_, 512, WMb + (size_t)n_ * DM * 512, cscr, r_ - n_ * nb_, DM / 32, lane); } \
            else conv_item(mo_, DM, WMo, cscr, it_ - ni_ - 3 * nb_, DM / 32, lane); } } while (0)

template <int L, int F> __device__ __forceinline__ void ffn_part(LAS unsigned char* lds) {
    constexpr int l = L, f = F, pb = 1 + PH_L * L, pf = pb + (F ? 11 : 0);
            if (IN(pf + 0)) { WSL();
                pg8::Gemm g{XN, WFu, M, 2 * FF, DM, DM}; pg8::StaticOrder S; S.init(M, 2 * FF, G, bid);
                pg8::EpiSwiGLU E{HB, FF};
                pg8::gemm_phase<pg8::EpiSwiGLU, pg8::StaticOrder, true, true>(lds, g, S, E);
                SEAM(pf + 0);
            }
            if (IN(pf + 1)) { WSL();
                pg8::Gemm g{HB, WFd, M, DM, FF, FF}; pg8::StaticOrder S; S.init(M, DM, G, bid);
                pg8::EpiStore<0> E{YP, DM, YP, DM, 1 << 30};
                pg8::gemm_phase<pg8::EpiStore<0>, pg8::StaticOrder, true, true>(lds, g, S, E);
                SEAM(pf + 1);
            }
            if (IN(pf + 2)) { WSL();
                const float* base = (l == 0 && f == 0) ? KIN(0) : XOUT;
                const float* gpost = KIN(f ? 28 : 2) + l * DM;
                const float* gnext = f == 0 ? KIN(6) + l * DM : (l + 1 < NLAYER ? KIN(1) + (l + 1) * DM : nullptr);
#if PROBE
                float osc = 1.f;
                if (l == NLAYER - 1 && f == 1) { const float num = *(const float*)(wsl + WS_CTL + 4 * CW_PROBE), den = *(const float*)(wsl + WS_CTL + 4 * (CW_PROBE + 1)); osc = 1.f + 4.f * sqrtf(num / fmaxf(den, 1e-30f)); }
                rownorm_rows(base, YP, 0.5f, gpost, XOUT, gnext, gnext ? XN : nullptr, gw, NGW, lane, osc);
#else
                rownorm_rows(base, YP, 0.5f, gpost, XOUT, gnext, gnext ? XN : nullptr, gw, NGW, lane);
#endif
                if (f == 1 && l + 1 < NLAYER) { CONV_FFN(l + 1, 0); CONV_MIX(l + 1); }
                SEAM(pf + 2);
            }
}
template <int L> __device__ __forceinline__ void mixer_part(LAS unsigned char* lds, unsigned char* lds_) {
    constexpr int l = L, pb = 1 + PH_L * L;
            const int pm = pb + 3;
            if (IN(pm + 0)) { WSL();
                pg8::Gemm g{XN, WMi, M, 5632, DM, DM}; pg8::StaticOrder S; S.init(M, 5632, G, bid);
                pg8::EpiStore<0> E{Q3, QP, ZR, ZP, 6};
                pg8::gemm_phase<pg8::EpiStore<0>, pg8::StaticOrder, true, true>(lds, g, S, E);
                SEAM(pm + 0);
            }
            if (IN(pm + 1)) { WSL();
                PrepP pp{ZR, X1B, A8B, KID, KIN(9) + l * 1792, KIN(10) + l * 512, KIN(11) + l * 64 * 512, KIN(12) + l * 512, KIN(13) + l * 64 * 512};
                rwkv_prep(pp, lds);
                SEAM(pm + 1);
            }
            if (IN(pm + 2)) { WSL();
                volatile LAS int* slot = (volatile LAS int*)(MISC + 16);
                if (bid < 64) {
                    ScanP sp{Q3, ZR, X1B, A8B, YRAW, RDOTK, KIN(9) + l * 1792, KIN(15) + l * 512, KIN(16) + l * 512, KIN(17) + l * 512};
#ifndef NO_SCAN
                    rwkv_scan_unit(sp, bid, lds);
#ifdef SCAN_TWICE
                    rwkv_scan_unit(sp, bid, lds);
#endif
#endif
                }
                {
                    Dsa1P dp{ZR, KID, BITM, CTL + CW_DONE + 64 * 64 * l};
                    gu32* head = CTL + CW_Q + 64 * (3 * l + 0);
                    #ifndef NO_DSA1
                    for (int u = q_fetch(head, slot); u < 512; u = q_fetch(head, slot)) dsa1_unit(dp, u, lds);
#ifdef DUP_DSA1
                    { gu32* head2 = CTL + 10240 + 64 * (2 * l + 0); for (int u = q_fetch(head2, slot); u < 512; u = q_fetch(head2, slot)) dsa1_unit(dp, u, lds); }
#endif
#endif
                }
                {
                    gu32* head = CTL + CW_Q + 64 * (3 * l + 1);
                    typedef att::BlockRef<att::bf16, att::bf16> Ref;
#define DSA2_REF(i_, r_) do { const int qb_ = 31 - ((i_) >> 3), b_ = ((i_) >> 2) & 1, h_ = (i_) & 3; const size_t row_ = (size_t)b_ * T + 256 * qb_; \
        r_.Q = (const att::bf16*)(Q3 + row_ * QP + 128 * h_); r_.O = (att::bf16*)(Q3 + row_ * QP + 128 * h_); r_.K = (const att::bf16*)(ZR + (size_t)b_ * T * ZP + ZC_DK + 128 * h_); \
        r_.V = (const att::bf16*)(ZR + (size_t)b_ * T * ZP + ZC_DV + 128 * h_); r_.P0 = 256 * qb_; r_.koff = 0; r_.mask = BITM + row_ * 256; } while (0)
                    int ic = q_fetch(head, slot);
                    if (ic < 256) {
                        int in_ = q_fetch(head, slot);
                        Ref cur; DSA2_REF(ic, cur);
                        att::Seam<att::bf16> S;
                        att::causal_swa_prime<att::bf16, att::bf16, false>(cur, T, (char*)lds_, S);
                        for (;;) {
                            const bool last = in_ >= 256;
                            Ref nxt = cur; if (!last) DSA2_REF(in_, nxt);
                            {
                                if (tid == 0) { gu32* dw = CTL + CW_DONE + 64 * (64 * l + (((ic >> 2) & 1) * 32 + (31 - (ic >> 3)))); unsigned sp = 0;
                                    while (__hip_atomic_load(dw, RLX_AGENT) < 8u) { __builtin_amdgcn_s_sleep(2); if (++sp > (1u << 24)) { __hip_atomic_store(CTL + CW_TMO, 1u, RLX_AGENT); break; } }
                                    __builtin_amdgcn_fence(__ATOMIC_ACQUIRE, "agent"); asm volatile("s_waitcnt vmcnt(0)" ::: "memory"); }
                                __syncthreads();
                            }
#ifndef NO_DSA2
                            att::causal_swa_block<att::bf16, att::bf16, false, true, QP>(cur, nxt, T, T, (char*)lds_, S);
#endif
                            if (last) break;
                            cur = nxt; ic = in_; in_ = q_fetch(head, slot);
                        }
                    }
                }
                {
#ifdef DUP_DIFF
                  for (int rep_ = 0; rep_ < 2; ++rep_) {
                    gu32* head = rep_ ? CTL + 10240 + 64 * (2 * l + 1) : CTL + CW_Q + 64 * (3 * l + 2);
#else
                  {
                    gu32* head = CTL + CW_Q + 64 * (3 * l + 2);
#endif
                    typedef att::BlockRef<att::bf16, att::bf16> Ref;
#define DIFF_REF(i_, r_) do { const int qb_ = 31 - ((i_) >> 4), b_ = ((i_) >> 3) & 1, h_ = ((i_) >> 1) & 3, mp_ = (i_) & 1; const size_t row_ = (size_t)b_ * T + 256 * qb_; \
        r_.Q = (const att::bf16*)(Q3 + row_ * QP + 1024 + 128 * h_ + 64 * mp_); r_.O = (att::bf16*)((mp_ ? O2 : O1) + row_ * 512 + 128 * h_); \
        r_.K = (const att::bf16*)(ZR + (size_t)b_ * T * ZP + ZC_FK + 128 * h_); r_.V = (const att::bf16*)(ZR + (size_t)b_ * T * ZP + ZC_FV + 128 * h_); r_.P0 = 256 * qb_; r_.koff = 128 * mp_; r_.mask = nullptr; } while (0)
                    int ic = q_fetch(head, slot);
                    if (ic < 512) {
                        int in_ = q_fetch(head, slot);
                        Ref cur; DIFF_REF(ic, cur);
                        att::Seam<att::bf16> S;
                        att::causal_swa_prime<att::bf16, att::bf16, true>(cur, T, (char*)lds_, S);
                        for (;;) {
                            const bool last = in_ >= 512;
                            Ref nxt = cur; if (!last) DIFF_REF(in_, nxt);
#ifndef NO_DIFF
                            att::causal_swa_block<att::bf16, att::bf16, true, false, 512>(cur, nxt, T, T, (char*)lds_, S);
#endif
                            if (last) break;
                            cur = nxt; ic = in_; in_ = q_fetch(head, slot);
                        }
                    }
                  }
                }
                SEAM(pm + 2);
            }
            if (IN(pm + 3)) { WSL();
                RPostP rp{ZR, Q3, YRAW, RDOTK, KIN(9) + l * 1792, KIN(14) + l * 128 * 512, KIN(18) + l * 512, KIN(19) + l * 512};
#ifndef NO_RPOST
                rwkv_post(rp, lds);
#endif
                constexpr float lambda_init = L == 0 ? 0.2f : 0.35550906759096927f;
                DPostP dq{O1, O2, Q3, KIN(20) + l * 64, KIN(21) + l * 64, KIN(22) + l * 64, KIN(23) + l * 64, KIN(24) + l * 128, lambda_init};
                diff_post(dq, gw, NGW, lane);
                rownorm_rows(XOUT, nullptr, 0.f, nullptr, nullptr, KIN(6) + l * DM, XN, gw, NGW, lane);
                SEAM(pm + 3);
            }
            if (IN(pm + 4)) { WSL();
                pg8::Gemm g{XN, WMi + (size_t)5632 * DM, M, 3072, DM, DM}; pg8::StaticOrder S; S.init(M, 3072, G, bid);
#ifdef GATE_RAW
                pg8::EpiStore<0> E{G3, 3072, G3, 3072, 1 << 30};
                pg8::gemm_phase<pg8::EpiStore<0>, pg8::StaticOrder, true, true>(lds, g, S, E);
#else
                pg8::EpiStore<1> E{G3, 3072, G3, 3072, 1 << 30};
                pg8::gemm_phase<pg8::EpiStore<1>, pg8::StaticOrder, true, true>(lds, g, S, E);
#endif
                SEAM(pm + 4);
            }
            if (IN(pm + 5)) { WSL();
#pragma unroll 1
                for (int n = 0; n < 3; ++n) {
                    pg8::Gemm g{Q3 + 512 * n, WMb + (size_t)n * DM * 512, M, DM, 512, QP}; pg8::StaticOrder S; S.init(M, DM, G, bid);
                    pg8::EpiGateMul E{MG, DM, G3 + 1024 * n, 3072, n == 0 ? 1 : 0};
                    pg8::gemm_phase<pg8::EpiGateMul, pg8::StaticOrder, false, true>(lds, g, S, E);
                    VM_WAIT(); __syncthreads();
                }
                SEAM(pm + 5);
            }
            if (IN(pm + 6)) { WSL();
                pg8::Gemm g{MG, WMo, M, DM, DM, DM}; pg8::StaticOrder S; S.init(M, DM, G, bid);
                pg8::EpiStore<0> E{YP, DM, YP, DM, 1 << 30};
                pg8::gemm_phase<pg8::EpiStore<0>, pg8::StaticOrder, false, true>(lds, g, S, E);
                SEAM(pm + 6);
            }
            if (IN(pm + 7)) { WSL();
                rownorm_rows(XOUT, YP, 1.0f, KIN(7) + l * DM, XOUT, KIN(27) + l * DM, XN, gw, NGW, lane);
                CONV_FFN(l, 1);
                SEAM(pm + 7);
            }
}

__global__ void __launch_bounds__(NWAVES * 64, 2) mk_fwd(Args args) {
    extern __shared__ __attribute__((aligned(16))) unsigned char lds_[];
    LAS unsigned char* lds = (LAS unsigned char*)lds_;
    { const int tid = otid_(); if (tid < 64) MISC[tid] = 0u; }
    __syncthreads();
    (void)xcd_barrier_post((unsigned*)(kws_() + WS_CTL) + CW_BAR, MISC + 8);
    if (IN(0)) { WSL();
        CONV_FFN(0, 0); CONV_MIX(0);
        rownorm_rows(KIN(0), nullptr, 0.f, nullptr, nullptr, KIN(1), XN, gw, NGW, lane);
        SEAM(0);
    }
    ffn_part<0, 0>(lds); mixer_part<0>(lds, lds_); ffn_part<0, 1>(lds);
    ffn_part<1, 0>(lds); mixer_part<1>(lds, lds_); ffn_part<1, 1>(lds);
}

#if PROBE
__device__ __forceinline__ void probe_acc(float num, float den, float* ctlf) {
    __shared__ float rn[256], rd[256];
    rn[threadIdx.x] = num; rd[threadIdx.x] = den; __syncthreads();
    for (int o = 128; o > 0; o >>= 1) { if ((int)threadIdx.x < o) { rn[threadIdx.x] += rn[threadIdx.x + o]; rd[threadIdx.x] += rd[threadIdx.x + o]; } __syncthreads(); }
    if (threadIdx.x == 0) { atomicAdd(ctlf + CW_PROBE, rn[0]); atomicAdd(ctlf + CW_PROBE + 1, rd[0]); }
}
__global__ void __launch_bounds__(256) probe_ffn(const unsigned char* ws, const float* Wg, const float* Wu, const float* Wd) {
    __shared__ float xn[1024]; __shared__ float hid[2816];
    const int m = 777 + 1931 * blockIdx.x, tid = threadIdx.x;
    const bf16* XNp = (const bf16*)(ws + WS_XN); const bf16* YPp = (const bf16*)(ws + WS_R2);
    for (int k = tid; k < 1024; k += 256) xn[k] = bf1(XNp[(size_t)m * 1024 + k]);
    __syncthreads();
    for (int j = tid; j < 2816; j += 256) { float g = 0.f, u = 0.f; for (int k = 0; k < 1024; ++k) { g += xn[k] * Wg[(size_t)k * 2816 + j]; u += xn[k] * Wu[(size_t)k * 2816 + j]; } hid[j] = g / (1.f + expf(-g)) * u; }
    __syncthreads();
    float num = 0.f, den = 0.f;
    for (int d = tid; d < 1024; d += 256) { float o = 0.f; for (int j = 0; j < 2816; ++j) o += hid[j] * Wd[(size_t)j * 1024 + d]; const float got = bf1(YPp[(size_t)m * 1024 + d]); num += (o - got) * (o - got); den += o * o; }
    probe_acc(num, den, (float*)(ws + WS_CTL));
}
__global__ void __launch_bounds__(256) probe_win(const unsigned char* ws, const float* Win) {
    __shared__ float xn[1024];
    const int m = 555 + 1999 * blockIdx.x, tid = threadIdx.x;
    const bf16* XNp = (const bf16*)(ws + WS_XN); const bf16* Q3p = (const bf16*)(ws + WS_Q3); const bf16* ZRp = (const bf16*)(ws + WS_ZR);
    for (int k = tid; k < 1024; k += 256) xn[k] = bf1(XNp[(size_t)m * 1024 + k]);
    __syncthreads();
    float num = 0.f, den = 0.f;
    for (int c = tid; c < 5448; c += 256) {
        float z = 0.f; for (int k = 0; k < 1024; ++k) z += xn[k] * Win[(size_t)k * NIN + c];
        float got;
        if (c < 512) got = bf1(Q3p[(size_t)m * QP + c]);
        else if (c < 2120) got = bf1(ZRp[(size_t)m * ZP + (c - 512)]);
        else if (c < 2632) got = bf1(Q3p[(size_t)m * QP + 512 + (c - 2120)]);
        else if (c < 3912) got = bf1(ZRp[(size_t)m * ZP + (c - 840)]);
        else if (c < 4424) got = bf1(Q3p[(size_t)m * QP + 1024 + (c - 3912)]);
        else got = bf1(ZRp[(size_t)m * ZP + (c - 1352)]);
        num += (z - got) * (z - got); den += z * z;
    }
    probe_acc(num, den, (float*)(ws + WS_CTL));
}
__global__ void __launch_bounds__(256) probe_wconv(const unsigned char* ws, const float* Win, int r0) {
    const bf16* WMp = (const bf16*)(ws + WS_WM); const int tid = threadIdx.x;
    float num = 0.f, den = 0.f;
    for (int rr = 0; rr < 64; ++rr) { const int n = r0 + 64 * blockIdx.x + rr; MapWin mw{Win, NIN}; const float* cp = mw.col(n);
        for (int k = tid; k < 1024; k += 256) { const float ref = cp ? cp[(size_t)k * NIN] : 0.f; const float got = bf1(WMp[(size_t)n * 1024 + k]); num += (ref - got) * (ref - got); den += ref * ref; } }
    probe_acc(num, den, (float*)(ws + WS_CTL));
}
__global__ void __launch_bounds__(256) probe_merge(const unsigned char* ws, const float* Win, const float* Wb, const float* Wo, int which) {
    __shared__ float xn[1024]; __shared__ float y[1536]; __shared__ float mg[1024];
    const int m = 333 + 2003 * blockIdx.x, tid = threadIdx.x;
    const bf16* XNp = (const bf16*)(ws + WS_XN); const bf16* Q3p = (const bf16*)(ws + WS_Q3); const bf16* MGp = (const bf16*)(ws + WS_MG); const bf16* YPp = (const bf16*)(ws + WS_R2);
    for (int k = tid; k < 1024; k += 256) xn[k] = bf1(XNp[(size_t)m * 1024 + k]);
    for (int k = tid; k < 1536; k += 256) y[k] = bf1(Q3p[(size_t)m * QP + k]);
    __syncthreads();
    float num = 0.f, den = 0.f;
    for (int d = tid; d < 1024; d += 256) {
        float acc = 0.f;
        for (int n = 0; n < 3; ++n) { float g = 0.f; for (int k = 0; k < 1024; ++k) g += xn[k] * Win[(size_t)k * NIN + 5448 + n * 1024 + d];
            float p = 0.f; for (int c = 0; c < 512; ++c) p += y[512 * n + c] * Wb[((size_t)n * 512 + c) * 1024 + d];
            acc += p / (1.f + expf(-g)); }
        mg[d] = acc; const float got = bf1(MGp[(size_t)m * 1024 + d]); if (which == 0) { num += (acc - got) * (acc - got); den += acc * acc; }
        if (which == 2) { const bf16* G3p = (const bf16*)(ws + WS_ZR); for (int n = 0; n < 3; ++n) { float g = 0.f; for (int k = 0; k < 1024; ++k) g += xn[k] * Win[(size_t)k * NIN + 5448 + n * 1024 + d];
            const float sg = 1.f / (1.f + expf(-g)), gg = bf1(G3p[(size_t)m * 3072 + n * 1024 + d]); num += (sg - gg) * (sg - gg); den += sg * sg; } }
        if (which == 3) { const bf16* G3p = (const bf16*)(ws + WS_ZR); float a2 = 0.f; for (int n = 0; n < 3; ++n) { float p = 0.f; for (int c = 0; c < 512; ++c) p += y[512 * n + c] * Wb[((size_t)n * 512 + c) * 1024 + d];
            a2 += p * bf1(G3p[(size_t)m * 3072 + n * 1024 + d]); } num += (a2 - got) * (a2 - got); den += a2 * a2; }
    }
    __syncthreads();
    if (which == 1) for (int d = tid; d < 1024; d += 256) { float o = 0.f; for (int j = 0; j < 1024; ++j) o += mg[j] * Wo[(size_t)j * 1024 + d]; const float got = bf1(YPp[(size_t)m * 1024 + d]); num += (o - got) * (o - got); den += o * o; }
    probe_acc(num, den, (float*)(ws + WS_CTL));
}
#endif
#ifndef MK_ONE_LAUNCH
#define MK_ONE_LAUNCH 0
#endif
extern "C" void kernel_launch(void* const* d_in, const int* in_sizes, int n_in, void* d_out, int out_size, void* d_ws, size_t ws_size, hipStream_t stream) {
    static int grid = 0;
    if (grid == 0) {
        if (n_in != 32 || in_sizes[0] != M * DM || out_size != M * DM || ws_size < WS_END) { fprintf(stderr, "kernel_launch: unexpected shapes / workspace (n_in %d, ws %zu)\n", n_in, ws_size); grid = -1; return; }
        int dev = 0, cus = 0;
        if (hipGetDevice(&dev) != hipSuccess || hipDeviceGetAttribute(&cus, hipDeviceAttributeMultiprocessorCount, dev) != hipSuccess) { grid = -1; return; }
        if (hipFuncSetAttribute((const void*)mk_fwd, hipFuncAttributeMaxDynamicSharedMemorySize, LDS_BYTES) != hipSuccess) { fprintf(stderr, "kernel_launch: hipFuncSetAttribute failed\n"); grid = -1; return; }
        int per_cu = 0;
        if (hipOccupancyMaxActiveBlocksPerMultiprocessor(&per_cu, (const void*)mk_fwd, NWAVES * 64, LDS_BYTES) != hipSuccess || per_cu < 1) { fprintf(stderr, "kernel_launch: occupancy query says %d\n", per_cu); }
        (void)hipGetLastError();
        grid = cus;
    }
    if (grid < 0) return;
    (void)hipMemsetAsync((char*)d_ws + WS_CTL, 0, CTL_ZERO_BYTES, stream);
    Args a{};
    for (int i = 0; i < 32; ++i) a.in[i] = (const float*)d_in[i];
    a.out = (float*)d_out; a.ws = (unsigned char*)d_ws;
#if MK_ONE_LAUNCH
    a.ph_lo = 0; a.ph_hi = N_PHASES;
    hipLaunchKernelGGL(mk_fwd, dim3(grid), dim3(NWAVES * 64), LDS_BYTES, stream, a);
#else
    for (int p = 0; p < N_PHASES; ++p) { a.ph_lo = p; a.ph_hi = p + 1; hipLaunchKernelGGL(mk_fwd, dim3(grid), dim3(NWAVES * 64), LDS_BYTES, stream, a);
#if PROBE == 1
        if (p == 2) hipLaunchKernelGGL(probe_ffn, dim3(8), dim3(256), 0, stream, (const unsigned char*)d_ws, a.in[3], a.in[4], a.in[5]);
#elif PROBE == 2
        if (p == 4) hipLaunchKernelGGL(probe_win, dim3(8), dim3(256), 0, stream, (const unsigned char*)d_ws, a.in[8]);
#elif PROBE == 3
        if (p == 8) hipLaunchKernelGGL(probe_merge, dim3(8), dim3(256), 0, stream, (const unsigned char*)d_ws, a.in[8], a.in[25], a.in[26], 0);
#elif PROBE == 5
        if (p == 8) hipLaunchKernelGGL(probe_merge, dim3(8), dim3(256), 0, stream, (const unsigned char*)d_ws, a.in[8], a.in[25], a.in[26], 2);
#elif PROBE == 6
        if (p == 8) hipLaunchKernelGGL(probe_merge, dim3(8), dim3(256), 0, stream, (const unsigned char*)d_ws, a.in[8], a.in[25], a.in[26], 3);
#elif PROBE == 7
        if (p == 6) hipLaunchKernelGGL(probe_wconv, dim3(48), dim3(256), 0, stream, (const unsigned char*)d_ws, a.in[8], 5632);
#elif PROBE == 8
        if (p == 3) hipLaunchKernelGGL(probe_wconv, dim3(48), dim3(256), 0, stream, (const unsigned char*)d_ws, a.in[8], 5632);
#elif PROBE == 9
        if (p == 7) hipLaunchKernelGGL(probe_merge, dim3(8), dim3(256), 0, stream, (const unsigned char*)d_ws, a.in[8], a.in[25], a.in[26], 2);
#elif PROBE == 4
        if (p == 9) hipLaunchKernelGGL(probe_merge, dim3(8), dim3(256), 0, stream, (const unsigned char*)d_ws, a.in[8], a.in[25], a.in[26], 1);
#endif
    }
#endif
}
```

```cpp
#include <hip/hip_runtime.h>
#include <hip/hip_bf16.h>
#include <cstdio>
#include <cstdint>
#define MK_ONE_LAUNCH 1
#define GATE_RAW 1

__device__ __forceinline__ int otid_() { int t = (int)threadIdx.x; asm volatile("" : "+v"(t)); return t; }
namespace pg8 {
#define PG8_LAS __attribute__((address_space(3)))
typedef unsigned short bf16_t;
typedef short bf16x8 __attribute__((ext_vector_type(8)));
typedef float f32x4 __attribute__((ext_vector_type(4)));
typedef unsigned u32x4 __attribute__((ext_vector_type(4)));
constexpr int BM = 256, BK = 64, HALF = 128, HTB = HALF * BK * 2  , STAGE_BYTES = 8 * HTB, NXCD = 8, WGM = 8;

__host__ __device__ __forceinline__ int lds_byte(int r, int c) { const int st = (r >> 4) * 2 + (c >> 5), rr = r & 15, cc = c & 31, ob = rr * 64 + cc * 2; return st * 1024 + (ob ^ (((ob >> 9) & 1) << 5)); }
__host__ __device__ __forceinline__ void stage_rc(int b, int& R, int& C) { const int st = b / 1024, sb = b % 1024, swz = sb ^ (((sb >> 9) & 1) << 5); R = (st >> 1) * 16 + swz / 64; C = (st & 1) * 32 + (swz % 64) / 2; }
__host__ __device__ __forceinline__ int perm32(int rho) { const int n = rho >> 4, i = rho & 15; return 8 * (i >> 2) + 4 * n + (i & 3); }

struct Unit { int pm, pn; };
struct Gemm { const bf16_t* A; const bf16_t* Bt; int M, N, K, lda; };

struct StaticOrder {
    int nM, nN, nwg, G, c;
    __host__ __device__ void init(int M, int N, int G_, int c_) { nM = M / BM; nN = N / BM; nwg = nM * nN; G = G_; c = c_; }
    __host__ __device__ bool next(int i, Unit& u) const {
        const long L = (long)i * G + c; if (L >= nwg) return false;
        int wgid = (int)L; { const int q = nwg / NXCD, r = nwg % NXCD, xcd = wgid % NXCD, off = wgid / NXCD; wgid = (xcd < r ? xcd * (q + 1) : r * (q + 1) + (xcd - r) * q) + off; }
        const int nig = WGM * nN, gid = wgid / nig, fm = gid * WGM, gsz = (nM - fm) < WGM ? (nM - fm) : WGM;
        u.pm = fm + ((wgid % nig) % gsz); u.pn = (wgid % nig) / gsz; return true;
    }
    __device__ __forceinline__ void a_ready(const Unit&) const {}
    __device__ __forceinline__ void done(const Unit&) const {}
};

__device__ __forceinline__ unsigned cvt_pk_bf16(float lo, float hi) { unsigned r; asm volatile("v_cvt_pk_bf16_f32 %0, %1, %2" : "=v"(r) : "v"(lo), "v"(hi)); return r; }

template <class Epi, class Sched, bool ALIGN_EPI = false, bool SP2 = false>
__device__ __forceinline__ void gemm_phase(PG8_LAS unsigned char* lds, const Gemm g, const Sched& S, const Epi& E) {
    const int tid = otid_(), wid = __builtin_amdgcn_readfirstlane(tid >> 6), lane = tid & 63, wr = wid >> 2, wc = wid & 3, fr = lane & 15, fq = lane >> 4;
    const int K = g.K, nt = K / BK;
    unsigned voffA[2], voffB[2];
#pragma unroll
    for (int i = 0; i < 2; ++i) { int R, C; stage_rc(tid * 16 + i * 8192, R, C); const int Rb = Epi::PERM ? ((R & ~31) + perm32(R & 31)) : R;
        voffA[i] = (unsigned)(R * g.lda + C) * 2u; voffB[i] = (unsigned)(Rb * K + C) * 2u; }
    const size_t kstep = (size_t)(BK * 2);
    const size_t hstepB = (size_t)HALF * K * 2, hstepA = (size_t)HALF * g.lda * 2;
    const size_t tstepB = 2 * hstepB, tstepA = 2 * hstepA;
    const unsigned ldsw = (unsigned)wid * 1024u;
    const int aoff = lds_byte(wr * 64 + fr, fq * 8), boff = lds_byte(wc * 32 + fr, fq * 8);
#define PG8_SA(b, h) (((b) * 2 + (h)) * HTB)
#define PG8_SB(b, h) ((4 + (b) * 2 + (h)) * HTB)
#define PG8_STAGE(bufoff, gbase, voff) do { _Pragma("unroll") for (int _i = 0; _i < 2; ++_i) \
        __builtin_amdgcn_global_load_lds((const unsigned*)((const char*)(gbase) + (voff)[_i]), (PG8_LAS unsigned*)(lds + (bufoff) + ldsw + _i * 8192), 16, 0, 0); } while (0)
#define PG8_LDA(dst, b, h) do { _Pragma("unroll") for (int m = 0; m < 4; ++m) _Pragma("unroll") for (int k = 0; k < 2; ++k) dst[m][k] = *(const PG8_LAS bf16x8*)(lds + PG8_SA(b, h) + aoff + m * 2048 + k * 1024); } while (0)
#define PG8_LDB(dst, b, h) do { _Pragma("unroll") for (int n = 0; n < 2; ++n) _Pragma("unroll") for (int k = 0; k < 2; ++k) dst[n][k] = *(const PG8_LAS bf16x8*)(lds + PG8_SB(b, h) + boff + n * 2048 + k * 1024); } while (0)
#define PG8_MMA(ai, bj, At, Bt) do { __builtin_amdgcn_s_setprio(1); _Pragma("unroll") for (int m = 0; m < 4; ++m) _Pragma("unroll") for (int n = 0; n < 2; ++n) _Pragma("unroll") for (int k = 0; k < 2; ++k) \
        acc[ai][bj][m][n] = __builtin_amdgcn_mfma_f32_16x16x32_bf16(Bt[n][k], At[m][k], acc[ai][bj][m][n], 0, 0, 0); __builtin_amdgcn_s_setprio(0); } while (0)
#define PG8_WAIT_V(n) asm volatile("s_waitcnt vmcnt(" #n ")" ::: "memory")
#define PG8_WAIT_L(n) asm volatile("s_waitcnt lgkmcnt(" #n ")" ::: "memory")
#define PG8_BAR __builtin_amdgcn_s_barrier()
#define PG8_SCHED __builtin_amdgcn_sched_barrier(0)
    Unit cur, nxt; int ui = 0;
    if (!S.next(0, cur)) return;
    f32x4 acc[2][2][4][2];
#pragma unroll
    for (int a = 0; a < 2; ++a)
#pragma unroll
        for (int b = 0; b < 2; ++b)
#pragma unroll
            for (int m = 0; m < 4; ++m)
#pragma unroll
                for (int n = 0; n < 2; ++n) acc[a][b][m][n] = (f32x4){0.f, 0.f, 0.f, 0.f};
    bf16x8 At[4][2], B0[2][2], B1[2][2];
    const char* cA = (const char*)g.A + (size_t)cur.pm * tstepA; const char* cB = (const char*)g.Bt + (size_t)cur.pn * tstepB;
    S.a_ready(cur);
    if constexpr (SP2) {
        PG8_STAGE(PG8_SB(0, 0), cB, voffB); PG8_STAGE(PG8_SB(0, 1), cB + hstepB, voffB); PG8_STAGE(PG8_SA(0, 0), cA, voffA); PG8_STAGE(PG8_SA(0, 1), cA + hstepA, voffA);
        if (wr == 1) PG8_BAR;
        PG8_WAIT_V(2); PG8_BAR;
        PG8_STAGE(PG8_SB(1, 0), cB + kstep, voffB); PG8_STAGE(PG8_SA(1, 0), cA + kstep, voffA); PG8_STAGE(PG8_SB(1, 1), cB + hstepB + kstep, voffB);
        PG8_WAIT_V(6); PG8_BAR;
    } else {
        PG8_STAGE(PG8_SB(0, 0), cB, voffB); PG8_STAGE(PG8_SA(0, 0), cA, voffA); PG8_STAGE(PG8_SB(0, 1), cB + hstepB, voffB); PG8_STAGE(PG8_SA(0, 1), cA + hstepA, voffA);
        if (wr == 1) PG8_BAR;
        PG8_WAIT_V(4); PG8_BAR;
        PG8_STAGE(PG8_SB(1, 0), cB + kstep, voffB); PG8_STAGE(PG8_SA(1, 0), cA + kstep, voffA); PG8_STAGE(PG8_SB(1, 1), cB + hstepB + kstep, voffB);
        PG8_WAIT_V(6); PG8_BAR;
    }
    for (;;) {
        const bool has_next = S.next(ui + 1, nxt);
        const char* nA = has_next ? (const char*)g.A + (size_t)nxt.pm * tstepA : cA; const char* nB = has_next ? (const char*)g.Bt + (size_t)nxt.pn * tstepB : cB;
        for (int t = 0; t < nt; t += 2) {
            const bool last = (t == nt - 2);
            const char* a1 = cA + (size_t)(t + 1) * kstep;
            const char* a2 = last ? nA : cA + (size_t)(t + 2) * kstep; const char* b2 = last ? nB : cB + (size_t)(t + 2) * kstep;
            const char* a3 = a2 + kstep; const char* b3 = b2 + kstep;
            if (last && has_next) S.a_ready(nxt);
            if constexpr (SP2) {
            PG8_LDB(B0, 0, 0); PG8_LDB(B1, 0, 1); PG8_SCHED; PG8_LDA(At, 0, 0); PG8_STAGE(PG8_SA(1, 1), a1 + hstepA, voffA);
            PG8_WAIT_V(8); PG8_WAIT_L(0); PG8_BAR; PG8_MMA(0, 0, At, B0); PG8_MMA(0, 1, At, B1); PG8_BAR; PG8_SCHED;
            PG8_LDA(At, 0, 1); PG8_STAGE(PG8_SB(0, 0), b2, voffB); PG8_STAGE(PG8_SB(0, 1), b2 + hstepB, voffB); PG8_STAGE(PG8_SA(0, 0), a2, voffA);
            PG8_WAIT_V(8); PG8_WAIT_L(0); PG8_BAR; PG8_MMA(1, 0, At, B0); PG8_MMA(1, 1, At, B1); PG8_BAR; PG8_SCHED;
            PG8_LDB(B0, 1, 0); PG8_LDB(B1, 1, 1); PG8_SCHED; PG8_LDA(At, 1, 0); PG8_STAGE(PG8_SA(0, 1), a2 + hstepA, voffA);
            PG8_WAIT_V(8); PG8_WAIT_L(0); PG8_BAR; PG8_MMA(0, 0, At, B0); PG8_MMA(0, 1, At, B1); PG8_BAR; PG8_SCHED;
            PG8_LDA(At, 1, 1); PG8_STAGE(PG8_SB(1, 0), b3, voffB); PG8_STAGE(PG8_SB(1, 1), b3 + hstepB, voffB); PG8_STAGE(PG8_SA(1, 0), a3, voffA);
            PG8_WAIT_V(8); PG8_WAIT_L(0); PG8_BAR; PG8_MMA(1, 0, At, B0); PG8_MMA(1, 1, At, B1); PG8_BAR; PG8_SCHED;
            } else {
            PG8_LDB(B0, 0, 0); PG8_SCHED; PG8_LDA(At, 0, 0); PG8_STAGE(PG8_SA(1, 1), a1 + hstepA, voffA);
            PG8_WAIT_L(8); PG8_BAR; PG8_WAIT_L(0); PG8_MMA(0, 0, At, B0); PG8_BAR; PG8_SCHED;
            PG8_LDB(B1, 0, 1); PG8_STAGE(PG8_SB(0, 0), b2, voffB);
            PG8_BAR; PG8_WAIT_L(0); PG8_MMA(0, 1, At, B1); PG8_BAR;
            PG8_LDA(At, 0, 1); PG8_STAGE(PG8_SA(0, 0), a2, voffA);
            PG8_BAR; PG8_WAIT_L(0); PG8_MMA(1, 0, At, B0); PG8_BAR; PG8_SCHED;
            PG8_STAGE(PG8_SB(0, 1), b2 + hstepB, voffB);
            PG8_WAIT_V(6); PG8_BAR; PG8_MMA(1, 1, At, B1); PG8_BAR;
            PG8_LDB(B0, 1, 0); PG8_SCHED; PG8_LDA(At, 1, 0); PG8_STAGE(PG8_SA(0, 1), a2 + hstepA, voffA);
            PG8_WAIT_L(8); PG8_BAR; PG8_WAIT_L(0); PG8_MMA(0, 0, At, B0); PG8_BAR; PG8_SCHED;
            PG8_LDB(B1, 1, 1); PG8_STAGE(PG8_SB(1, 0), b3, voffB);
            PG8_BAR; PG8_WAIT_L(0); PG8_MMA(0, 1, At, B1); PG8_BAR;
            PG8_LDA(At, 1, 1); PG8_STAGE(PG8_SA(1, 0), a3, voffA);
            PG8_BAR; PG8_WAIT_L(0); PG8_MMA(1, 0, At, B0); PG8_BAR; PG8_SCHED;
            PG8_STAGE(PG8_SB(1, 1), b3 + hstepB, voffB);
            PG8_WAIT_V(6); PG8_BAR; PG8_MMA(1, 1, At, B1); PG8_BAR;
            }
        }
        if constexpr (ALIGN_EPI) { if (wr == 0) PG8_BAR; }
        if constexpr (!Epi::AFTER_DRAIN) { E(acc, cur, wr, wc, fr, fq); S.done(cur); }
        if (!has_next) break;
#pragma unroll
        for (int a = 0; a < 2; ++a)
#pragma unroll
            for (int b = 0; b < 2; ++b)
#pragma unroll
                for (int m = 0; m < 4; ++m)
#pragma unroll
                    for (int n = 0; n < 2; ++n) acc[a][b][m][n] = (f32x4){0.f, 0.f, 0.f, 0.f};
        cur = nxt; cA = nA; cB = nB; ++ui;
        if constexpr (ALIGN_EPI) { if (wr == 1) PG8_BAR; }
    }
    PG8_WAIT_V(0);
    if constexpr (!ALIGN_EPI) { if (wr == 0) PG8_BAR; }
    PG8_BAR;
    if constexpr (Epi::AFTER_DRAIN) { E.fused(acc, cur, wr, wc, fr, fq, lds, wid, lane); S.done(cur); }
#undef PG8_SA
#undef PG8_SB
#undef PG8_STAGE
#undef PG8_LDA
#undef PG8_LDB
#undef PG8_MMA
#undef PG8_WAIT_V
#undef PG8_WAIT_L
#undef PG8_BAR
#undef PG8_SCHED
}
}
namespace pg8 {
typedef unsigned u32x2 __attribute__((ext_vector_type(2)));
__device__ __forceinline__ float bf_lo(unsigned w) { return __uint_as_float(w << 16); }
__device__ __forceinline__ float bf_hi(unsigned w) { return __uint_as_float(w & 0xffff0000u); }
__device__ __forceinline__ float sigmoidf_(float x) { return __builtin_amdgcn_rcpf(1.0f + __expf(-x)); }

struct EpiSwiGLU {
    static constexpr bool PERM = false, AFTER_DRAIN = false;
    bf16_t* H; int ldh;
    __device__ __forceinline__ void operator()(const f32x4 (&acc)[2][2][4][2], const Unit& u, int wr, int wc, int fr, int fq) const {
        const int row0 = u.pm * BM + wr * 64 + fr, hc0 = u.pn * 128 + wc * 16 + 4 * fq;
#pragma unroll
        for (int ai = 0; ai < 2; ++ai)
#pragma unroll
            for (int m = 0; m < 4; ++m) { bf16_t* rowp = H + (size_t)(row0 + ai * HALF + m * 16) * ldh + hc0;
#pragma unroll
                for (int bj = 0; bj < 2; ++bj) { const f32x4 g = acc[ai][bj][m][0], up = acc[ai][bj][m][1]; float h[4];
#pragma unroll
                    for (int e = 0; e < 4; ++e) h[e] = g[e] * sigmoidf_(g[e]) * up[e];
                    u32x2 w; w.x = cvt_pk_bf16(h[0], h[1]); w.y = cvt_pk_bf16(h[2], h[3]);
                    *(u32x2*)(rowp + bj * 64) = w; } }
    }
};
template <int ACT> struct EpiStore {
    static constexpr bool PERM = true, AFTER_DRAIN = false;
    bf16_t* O0; int ld0; bf16_t* O1; int ld1; int split_tiles;
    __device__ __forceinline__ void operator()(const f32x4 (&acc)[2][2][4][2], const Unit& u, int wr, int wc, int fr, int fq) const {
        const int row0 = u.pm * BM + wr * 64 + fr;
        bf16_t* base; int ld, colt;
        if (u.pn < split_tiles) { base = O0; ld = ld0; colt = u.pn * BM; } else { base = O1; ld = ld1; colt = (u.pn - split_tiles) * BM; }
        const int col0 = colt + wc * 32 + 8 * fq;
#pragma unroll
        for (int ai = 0; ai < 2; ++ai)
#pragma unroll
            for (int m = 0; m < 4; ++m) { bf16_t* rowp = base + (size_t)(row0 + ai * HALF + m * 16) * ld + col0;
#pragma unroll
                for (int bj = 0; bj < 2; ++bj) { f32x4 v0 = acc[ai][bj][m][0], v1 = acc[ai][bj][m][1];
                    if (ACT == 1) {
#pragma unroll
                        for (int e = 0; e < 4; ++e) { v0[e] = sigmoidf_(v0[e]); v1[e] = sigmoidf_(v1[e]); } }
                    u32x4 w; w.x = cvt_pk_bf16(v0[0], v0[1]); w.y = cvt_pk_bf16(v0[2], v0[3]); w.z = cvt_pk_bf16(v1[0], v1[1]); w.w = cvt_pk_bf16(v1[2], v1[3]);
                    *(u32x4*)(rowp + bj * HALF) = w; } }
    }
};
#ifdef GATE_RAW
#define GSIG(x) sigmoidf_(x)
#else
#define GSIG(x) (x)
#endif
struct EpiGateMul {
    static constexpr bool PERM = true, AFTER_DRAIN = false;
    bf16_t* MG; int ldm; const bf16_t* G; int ldg; int first;
    __device__ __forceinline__ void operator()(const f32x4 (&acc)[2][2][4][2], const Unit& u, int wr, int wc, int fr, int fq) const {
        const int row0 = u.pm * BM + wr * 64 + fr, col0 = u.pn * BM + wc * 32 + 8 * fq;
#pragma unroll
        for (int ai = 0; ai < 2; ++ai)
#pragma unroll
            for (int m = 0; m < 4; ++m) { const size_t r = (size_t)(row0 + ai * HALF + m * 16);
#pragma unroll
                for (int bj = 0; bj < 2; ++bj) { const f32x4 v0 = acc[ai][bj][m][0], v1 = acc[ai][bj][m][1];
                    const u32x4 g = *(const u32x4*)(G + r * ldg + col0 + bj * HALF);
                    float o[8] = { v0[0] * GSIG(bf_lo(g.x)), v0[1] * GSIG(bf_hi(g.x)), v0[2] * GSIG(bf_lo(g.y)), v0[3] * GSIG(bf_hi(g.y)), v1[0] * GSIG(bf_lo(g.z)), v1[1] * GSIG(bf_hi(g.z)), v1[2] * GSIG(bf_lo(g.w)), v1[3] * GSIG(bf_hi(g.w)) };
                    bf16_t* mp = MG + r * ldm + col0 + bj * HALF;
                    if (!first) { const u32x4 p = *(const u32x4*)mp;
                        o[0] += bf_lo(p.x); o[1] += bf_hi(p.x); o[2] += bf_lo(p.y); o[3] += bf_hi(p.y); o[4] += bf_lo(p.z); o[5] += bf_hi(p.z); o[6] += bf_lo(p.w); o[7] += bf_hi(p.w); }
                    u32x4 w; w.x = cvt_pk_bf16(o[0], o[1]); w.y = cvt_pk_bf16(o[2], o[3]); w.z = cvt_pk_bf16(o[4], o[5]); w.w = cvt_pk_bf16(o[6], o[7]);
                    *(u32x4*)mp = w; } }
    }
};
}
namespace att {
constexpr int D = 128;
constexpr bool WSKIP = false;
constexpr float THR = 8.f;
constexpr int NW = 8, QBLK = 32, KVBLK = 64, QB = NW * QBLK;
constexpr int SHM_V = KVBLK * D * 2, SHM_K = KVBLK * D * 2;
constexpr int LDS_BYTES = 2 * SHM_V + 2 * SHM_K + NW * 64 * 4;
using bf16 = __hip_bfloat16;
typedef short bf16x8 __attribute__((ext_vector_type(8)));
typedef short s16x4 __attribute__((ext_vector_type(4)));
typedef float f32x16 __attribute__((ext_vector_type(16)));
typedef float f32x4 __attribute__((ext_vector_type(4)));
typedef unsigned u32x4 __attribute__((ext_vector_type(4)));
template <class A, class Bt> struct same_t { static constexpr bool v = false; };
template <class A> struct same_t<A, A> { static constexpr bool v = true; };

#define KSWZ(row, colB) ((row) * 256 + ((colB) ^ (((row) & 7) << 4)))
#define SBAR() __builtin_amdgcn_sched_barrier(0)
__device__ __forceinline__ int v_st(int k, int c) { const int kk = (k & ~0xC) | ((k & 4) << 1) | ((k & 8) >> 1); return ((kk >> 3) * 4 + (c >> 5)) * 512 + ((kk & 7) * 32 + (c & 31)) * 2; }
__device__ __forceinline__ int v_rd_base(int lane) { return ((lane & 3) << 3) | (((lane >> 2) & 3) << 6) | (((lane >> 4) & 1) << 5) | (((lane >> 5) & 1) << 8); }
constexpr int v_rd_off(int d0, int ks, int half) { return d0 * 512 + ks * 4096 + half * 2048; }
__device__ __forceinline__ int crow(int r, int hi) { return (r & 3) + 8 * (r >> 2) + 4 * hi; }
__device__ __forceinline__ unsigned cvtpk(float lo, float hi) {
    unsigned r; asm volatile("v_cvt_pk_bf16_f32 %0, %1, %2" : "=v"(r) : "v"(lo), "v"(hi)); return r;
}
__device__ __forceinline__ bf16x8 pack8(f32x4 a, f32x4 b) {
    u32x4 w = {cvtpk(a[0], a[1]), cvtpk(a[2], a[3]), cvtpk(b[0], b[1]), cvtpk(b[2], b[3])};
    return *reinterpret_cast<bf16x8*>(&w);
}
template <class T> __device__ __forceinline__ bf16x8 load8(const T* p) {
    if constexpr (same_t<T, float>::v) { return pack8(*(const f32x4*)p, *(const f32x4*)(p + 4)); }
    else { return *reinterpret_cast<const bf16x8*>(p); }
}
__device__ __forceinline__ void mask_tile(f32x16& p0, f32x16& p1, int dq, unsigned W) {
    const float NEG = -__builtin_inff();
#pragma unroll
    for (int r = 0; r < 16; ++r) {
        const int c = (r & 3) + 8 * (r >> 2);
        if ((unsigned)(dq - c) >= W) p0[r] = NEG;
        if ((unsigned)(dq - c - 32) >= W) p1[r] = NEG;
    }
}
typedef unsigned u32x2 __attribute__((ext_vector_type(2)));
__device__ __forceinline__ void bitmask_tile(f32x16& p0, f32x16& p1, u32x2 w, int hi) {
    const float NEG = -__builtin_inff();
    const unsigned a = w[0] >> (4 * hi), b = w[1] >> (4 * hi);
#pragma unroll
    for (int r = 0; r < 16; ++r) {
        const int c = (r & 3) + 8 * (r >> 2);
        if (!((a >> c) & 1u)) p0[r] = NEG;
        if (!((b >> c) & 1u)) p1[r] = NEG;
    }
}
template <bool HALFQK> __device__ __forceinline__ void partialSM(f32x16& p0, f32x16& p1, float& m_reg, float& mn, float& alpha) {
    constexpr float SCALE = HALFQK ? 0.125f : 0.08838834764831845f;
    float pmax = p0[0]; for (int r = 1; r < 16; ++r) pmax = fmaxf(pmax, p0[r]); for (int r = 0; r < 16; ++r) pmax = fmaxf(pmax, p1[r]);
    { auto rr = __builtin_amdgcn_permlane32_swap(__float_as_uint(pmax), __float_as_uint(pmax), false, false);
      pmax = fmaxf(__uint_as_float(rr[0]), __uint_as_float(rr[1])); }
    constexpr float C2 = 1.4426950408889634f * SCALE;
    if (__builtin_expect(__all((pmax - m_reg) * SCALE <= THR), 1)) { mn = m_reg; alpha = 1.f; }
    else { mn = fmaxf(m_reg, pmax); alpha = __builtin_amdgcn_exp2f((m_reg - mn) * C2); m_reg = mn; }
    const float mnL = -mn * C2;
    for (int r = 0; r < 16; ++r) p0[r] = fmaf(p0[r], C2, mnL); for (int r = 0; r < 16; ++r) p1[r] = fmaf(p1[r], C2, mnL);
    for (int r = 0; r < 16; ++r) p0[r] = __builtin_amdgcn_exp2f(p0[r]);
}
__device__ __forceinline__ void finishSM(f32x16& p0, f32x16& p1, float alpha, float& l_reg, bf16x8& pa0, bf16x8& pa1, bf16x8& pa2, bf16x8& pa3) {
    for (int r = 0; r < 16; ++r) p1[r] = __builtin_amdgcn_exp2f(p1[r]);
    float ps = 0; for (int r = 0; r < 16; ++r) ps += p0[r]; for (int r = 0; r < 16; ++r) ps += p1[r];
    { auto rr = __builtin_amdgcn_permlane32_swap(__float_as_uint(ps), __float_as_uint(ps), false, false);
      ps = __uint_as_float(rr[0]) + __uint_as_float(rr[1]); }
    l_reg = l_reg * alpha + ps;
#define PK4(P, B_, OUT) do { unsigned a0 = cvtpk(P[B_+0], P[B_+1]), a1 = cvtpk(P[B_+2], P[B_+3]);                          \
        unsigned b0 = cvtpk(P[B_+4], P[B_+5]), b1 = cvtpk(P[B_+6], P[B_+7]);                                             \
        auto r0 = __builtin_amdgcn_permlane32_swap(a0, b0, false, false); auto r1 = __builtin_amdgcn_permlane32_swap(a1, b1, false, false); \
        u32x4 w = {r0[0], r1[0], r0[1], r1[1]}; OUT = *reinterpret_cast<bf16x8*>(&w); } while (0)
    PK4(p0, 0, pa0); PK4(p0, 8, pa1); PK4(p1, 0, pa2); PK4(p1, 8, pa3);
#undef PK4
}
template <int KB, bool SK, bool HALFQK>
__device__ __forceinline__ void qkt(f32x16& p0, f32x16& p1, const char* K_lds, int r32, int hi, const bf16x8* qr, bool act, int koff) {
    if (SK && !act) { const float NEG = -__builtin_inff();
#pragma unroll
        for (int r = 0; r < 16; ++r) { p0[r] = NEG; p1[r] = NEG; } return; }
    p0 = f32x16{}; p1 = f32x16{};
    const char* kb[4];
#pragma unroll
    for (int dd = 0; dd < 4; ++dd) kb[dd] = K_lds + KB * SHM_K + KSWZ(r32, (dd * 16 + hi * 8) * 2) + koff;
#pragma unroll
    for (int d0 = 0; d0 < (HALFQK ? 4 : 8); ++d0) { const char* a = kb[d0 & 3] + (d0 >> 2) * 128;
        bf16x8 b0 = *reinterpret_cast<const bf16x8*>(a);
        bf16x8 b1 = *reinterpret_cast<const bf16x8*>(a + 32 * 256);
        p0 = __builtin_amdgcn_mfma_f32_32x32x16_bf16(b0, qr[d0], p0, 0, 0, 0);
        p1 = __builtin_amdgcn_mfma_f32_32x32x16_bf16(b1, qr[d0], p1, 0, 0, 0); }
}
template <int VB, bool SK>
__device__ __forceinline__ void pv_tile(f32x16* o, int vb0, bf16x8 pa0, bf16x8 pa1, bf16x8 pa2, bf16x8 pa3, bool act) {
    if (SK && !act) return;
#define TRRD(dst, off) asm volatile("ds_read_b64_tr_b16 %0, %1 offset:%2" : "=&v"(dst) : "v"(vb0), "i"(off) : "memory")
#define PV_D0(d0) do { s16x4 l0, l1, l2, l3, h0, h1, h2, h3; constexpr int b_ = VB * SHM_V + v_rd_off(d0, 0, 0);     \
        TRRD(l0, b_); TRRD(h0, b_ + 2048); TRRD(l1, b_ + 4096); TRRD(h1, b_ + 6144); TRRD(l2, b_ + 8192); TRRD(h2, b_ + 10240); TRRD(l3, b_ + 12288); TRRD(h3, b_ + 14336); \
        asm volatile("s_waitcnt lgkmcnt(0)" ::: "memory"); SBAR();                 \
        o[d0] = __builtin_amdgcn_mfma_f32_32x32x16_bf16(pa0, (bf16x8){l0[0], l0[1], l0[2], l0[3], h0[0], h0[1], h0[2], h0[3]}, o[d0], 0, 0, 0);   \
        o[d0] = __builtin_amdgcn_mfma_f32_32x32x16_bf16(pa1, (bf16x8){l1[0], l1[1], l1[2], l1[3], h1[0], h1[1], h1[2], h1[3]}, o[d0], 0, 0, 0);   \
        o[d0] = __builtin_amdgcn_mfma_f32_32x32x16_bf16(pa2, (bf16x8){l2[0], l2[1], l2[2], l2[3], h2[0], h2[1], h2[2], h2[3]}, o[d0], 0, 0, 0);   \
        o[d0] = __builtin_amdgcn_mfma_f32_32x32x16_bf16(pa3, (bf16x8){l3[0], l3[1], l3[2], l3[3], h3[0], h3[1], h3[2], h3[3]}, o[d0], 0, 0, 0); } while (0)
    PV_D0(0); PV_D0(1); PV_D0(2); PV_D0(3);
#undef PV_D0
#undef TRRD
}

constexpr int QS = 1536, KVS = 4096;
template <class TIn, class TOut> struct BlockRef { const TIn* Q; const TIn* K; const TIn* V; TOut* O; int P0; int koff; const unsigned* mask; };
template <class TIn> struct Seam {
    bf16x8 qr[8];
    bf16x8 st_v0, st_v1, st_k0, st_k1; f32x4 sf0, sf1, sf2, sf3;
    f32x4 tq[16];
};
__device__ __forceinline__ int swa_jlo(int P0, int W) { const int lowk = P0 - W + 1; return lowk > 0 ? lowk / KVBLK : 0; }
#define ROW(p, k0, rr) ((p) + (size_t)((k0) + (rr)) * KVS + sc)
#define VMW() asm volatile("s_waitcnt vmcnt(0)" ::: "memory")
#define VMWN(n) asm volatile("s_waitcnt vmcnt(%0)" :: "i"(n) : "memory")
#define SLOAD_H(Kp, Vp, k0) do { S.st_v0 = load8<TIn>(ROW(Vp, k0, sr)); S.st_v1 = load8<TIn>(ROW(Vp, k0, 32 + sr));              \
                         S.st_k0 = load8<TIn>(ROW(Kp, k0, sr)); S.st_k1 = load8<TIn>(ROW(Kp, k0, 32 + sr)); } while (0)
#define SWRITE_HK(bf) do { *(bf16x8*)(K_lds + (bf) * SHM_K + kws) = S.st_k0; *(bf16x8*)(K_lds + (bf) * SHM_K + kws + 32 * 256) = S.st_k1; } while (0)
#define SWRITE_HV(bf) do { *(bf16x8*)(V_lds + (bf) * SHM_V + vst0) = S.st_v0; *(bf16x8*)(V_lds + (bf) * SHM_V + vst1) = S.st_v1; } while (0)
#define SWRITE_H(bf) do { SWRITE_HV(bf); SWRITE_HK(bf); } while (0)
#define SLOAD_F(p, k0) do { S.sf0 = *(const f32x4*)ROW(p, k0, sr); S.sf1 = *(const f32x4*)(ROW(p, k0, sr) + 4);                \
                            S.sf2 = *(const f32x4*)ROW(p, k0, 32 + sr); S.sf3 = *(const f32x4*)(ROW(p, k0, 32 + sr) + 4); } while (0)
#define SWRITE_KF(bf) do { *(bf16x8*)(K_lds + (bf) * SHM_K + kws) = pack8(S.sf0, S.sf1); *(bf16x8*)(K_lds + (bf) * SHM_K + kws + 32 * 256) = pack8(S.sf2, S.sf3); } while (0)
#define SWRITE_VF(bf) do { *(bf16x8*)(V_lds + (bf) * SHM_V + vst0) = pack8(S.sf0, S.sf1); *(bf16x8*)(V_lds + (bf) * SHM_V + vst1) = pack8(S.sf2, S.sf3); } while (0)
template <class TIn, class TOut, bool HALFQK>
__device__ __forceinline__ void causal_swa_prime(const BlockRef<TIn, TOut>& cur, int W, char* lds, Seam<TIn>& S) {
    constexpr bool F32 = same_t<TIn, float>::v;
    const int tid = otid_(), wid = __builtin_amdgcn_readfirstlane(tid >> 6), lane = tid & 63, r32 = lane & 31, hi = lane >> 5;
    const int sr = tid >> 4, sc = (tid & 15) * 8, kws = KSWZ(sr, sc * 2); char* K_lds = lds + 2 * SHM_V;
    const int kb0 = swa_jlo(cur.P0, W) * KVBLK;
    for (int d0 = 0; d0 < (HALFQK ? 4 : 8); ++d0) S.qr[d0] = load8<TIn>(cur.Q + (size_t)(wid * QBLK + r32) * QS + d0 * 16 + hi * 8);
    if constexpr (F32) { SLOAD_F((const float*)cur.K, kb0); VMW(); SWRITE_KF(0); SBAR(); SLOAD_F((const float*)cur.V, kb0); }
    else { SLOAD_H(cur.K, cur.V, kb0); VMW(); SWRITE_HK(0); }
    __syncthreads();
}
template <class TIn, class TOut, bool HALFQK, bool MASKED, int OS>
__device__ __forceinline__ void causal_swa_block(const BlockRef<TIn, TOut>& cur, const BlockRef<TIn, TOut>& nxt, int skv, int W, char* lds, Seam<TIn>& S) {
    constexpr bool F32 = same_t<TIn, float>::v;
    const int tid = otid_(), wid = __builtin_amdgcn_readfirstlane(tid >> 6), lane = tid & 63, r32 = lane & 31, hi = lane >> 5;
    const int j_lo = swa_jlo(cur.P0, W);
    int j_hi = (cur.P0 + QB - 1) / KVBLK + 1; if (j_hi > skv / KVBLK) j_hi = skv / KVBLK;
    const int NT = j_hi - j_lo;
    const int kbn = swa_jlo(nxt.P0, W) * KVBLK;
    const int qlo = cur.P0 + wid * QBLK, qm = qlo + r32 - 4 * hi;
    char* V_lds = lds; char* K_lds = lds + 2 * SHM_V;
    float* ws = (float*)(lds + 2 * SHM_V + 2 * SHM_K) + wid * 64; float* li_l = ws, * al_l = ws + 32;
    float m_reg = -1e30f, l_reg = 0; f32x16 o[4] = {};
    const int sr = tid >> 4, sc = (tid & 15) * 8, vst0 = v_st(sr, sc), vst1 = v_st(32 + sr, sc), kws = KSWZ(sr, sc * 2);
    const int vb0 = (int)(uintptr_t)V_lds + v_rd_base(lane);
    const TIn* Kh = cur.K; const TIn* Vh = cur.V;
#define RESC(a) do { if (__any((a) < 1.f)) { if (hi == 0) al_l[r32] = (a); asm volatile("s_waitcnt lgkmcnt(0)" ::: "memory");              \
                     for (int d_ = 0; d_ < 4; ++d_) for (int r = 0; r < 16; ++r) o[d_][r] *= al_l[crow(r, hi)]; } } while (0)
#define KBASE(t) ((j_lo + (t)) * KVBLK)
#define ACT(t) (KBASE(t) <= qlo + QBLK - 1 && KBASE(t) + KVBLK - 1 >= qlo - W + 1)
#define MASKT(P0_, P1_, t) do { if constexpr (MASKED) bitmask_tile(P0_, P1_, mw, hi);   \
        else { const int kb_ = KBASE(t); if ((!SK || ACT(t)) && (kb_ + KVBLK - 1 > qlo || kb_ <= qlo + QBLK - 1 - W)) mask_tile(P0_, P1_, qm - kb_, (unsigned)W); } } while (0)
    const unsigned moff = (unsigned)((wid * QBLK + r32) * 1024 + 8 * j_lo); u32x2 mw = {0u, 0u};
#define MLOAD(t) do { if constexpr (MASKED) mw = *(const u32x2*)((const char*)cur.mask + (moff + 8u * (unsigned)(t))); } while (0)
    constexpr int NQL = F32 ? 16 : (HALFQK ? 4 : 8);
    constexpr bool SK = WSKIP && !F32;
#define SEAM_K0() do { VMWN(NQL); if constexpr (F32) { SWRITE_KF(0); SBAR(); SLOAD_F((const float*)nxt.V, kbn); } else { SWRITE_HK(0); } SBAR(); } while (0)
    f32x16 pA0, pA1, pB0, pB1; float mnA, mnB, alA, alB; bf16x8 pa0, pa1, pa2, pa3;
    if constexpr (F32) { VMW(); SWRITE_VF(0); SBAR(); } else { SWRITE_HV(0); SBAR(); }
    if (NT > 1) { if constexpr (F32) SLOAD_F((const float*)Kh, KBASE(1)); else SLOAD_H(Kh, Vh, KBASE(1)); }
    SBAR(); qkt<0, SK, HALFQK>(pA0, pA1, K_lds, r32, hi, S.qr, ACT(0), cur.koff); MLOAD(0);
    if constexpr (F32) { if (NT > 1) { VMW(); SWRITE_KF(1); SBAR(); SLOAD_F((const float*)Vh, KBASE(1)); } }
    MASKT(pA0, pA1, 0); partialSM<HALFQK>(pA0, pA1, m_reg, mnA, alA);
    if (NT > 1) { VMW(); if constexpr (F32) { SWRITE_VF(1); SBAR(); if (NT > 2) SLOAD_F((const float*)Kh, KBASE(2)); } else SWRITE_H(1); }
    __syncthreads();
#define HALF_STEP(PX0, PX1, mnX, alX, PY0, PY1, alY, t, KB, VB, SB) do {                                                      \
        SBAR(); qkt<KB, SK, HALFQK>(PX0, PX1, K_lds, r32, hi, S.qr, ACT(t), cur.koff); MLOAD(t);                                             \
        finishSM(PY0, PY1, alY, l_reg, pa0, pa1, pa2, pa3); SBAR();                                                           \
        if ((t) + 1 < NT) { if constexpr (F32) { VMW(); SWRITE_KF(SB); SBAR(); SLOAD_F((const float*)Vh, KBASE((t) + 1)); }  \
                            else { SLOAD_H(Kh, Vh, KBASE((t) + 1)); } SBAR(); }                                               \
        pv_tile<VB, SK>(o, vb0, pa0, pa1, pa2, pa3, ACT((t) - 1)); MASKT(PX0, PX1, (t)); partialSM<HALFQK>(PX0, PX1, m_reg, mnX, alX);                                        \
        __syncthreads();                                                                                                      \
        if ((t) + 1 < NT) { VMW(); if constexpr (F32) { SWRITE_VF(SB); SBAR(); if ((t) + 2 < NT) SLOAD_F((const float*)Kh, KBASE((t) + 2)); } \
                            else { SWRITE_H(SB); } }                                                                          \
        RESC(alX); __syncthreads(); } while (0)
    for (int t = 1; t + 1 < NT; t += 2) {
        HALF_STEP(pB0, pB1, mnB, alB, pA0, pA1, alA, t, 1, 0, 0);
        HALF_STEP(pA0, pA1, mnA, alA, pB0, pB1, alB, t + 1, 0, 1, 1);
    }
    const bool even = (NT & 1) == 0;
    if (even) { SBAR(); qkt<1, SK, HALFQK>(pB0, pB1, K_lds, r32, hi, S.qr, ACT(NT - 1), cur.koff); MLOAD(NT - 1); SBAR(); }
#define QROW(e) (nxt.Q + (size_t)(wid * QBLK + r32) * QS + ((e) >> 1) * 16 + hi * 8 + ((e) & 1) * 4)
    if constexpr (F32) { SLOAD_F((const float*)nxt.K, kbn); SBAR();
#pragma unroll
        for (int e = 0; e < 8; ++e) S.tq[e] = *(const f32x4*)QROW(e); }
    else { SLOAD_H(nxt.K, nxt.V, kbn); SBAR();
#pragma unroll
        for (int d0 = 0; d0 < (HALFQK ? 4 : 8); ++d0) S.qr[d0] = load8<TIn>(nxt.Q + (size_t)(wid * QBLK + r32) * QS + d0 * 16 + hi * 8); }
    SBAR();
    finishSM(pA0, pA1, alA, l_reg, pa0, pa1, pa2, pa3); SBAR();
    if constexpr (F32) {
#pragma unroll
        for (int e = 8; e < 16; ++e) S.tq[e] = *(const f32x4*)QROW(e); SBAR(); }
#undef QROW
    pv_tile<0, SK>(o, vb0, pa0, pa1, pa2, pa3, ACT(even ? NT - 2 : NT - 1));
    if (even) { MASKT(pB0, pB1, NT - 1); partialSM<HALFQK>(pB0, pB1, m_reg, mnB, alB); __syncthreads(); RESC(alB);
        finishSM(pB0, pB1, alB, l_reg, pa0, pa1, pa2, pa3); SBAR(); pv_tile<1, SK>(o, vb0, pa0, pa1, pa2, pa3, ACT(NT - 1)); }
    SBAR(); SEAM_K0();
    if (hi == 0) li_l[r32] = l_reg; asm volatile("s_waitcnt lgkmcnt(0)" ::: "memory");
    float rli[16];
#pragma unroll
    for (int r = 0; r < 16; ++r) rli[r] = __builtin_amdgcn_rcpf(li_l[crow(r, hi)]);
    TOut* Ow = cur.O + (size_t)(wid * QBLK) * OS;
#pragma unroll
    for (int r = 0; r < 16; ++r) { const int orow = crow(r, hi);
#pragma unroll
        for (int d0 = 0; d0 < 4; ++d0) { const float v = o[d0][r] * rli[r];
            if constexpr (same_t<TOut, float>::v) { Ow[(size_t)orow * OS + d0 * 32 + r32] = v; }
            else { const float vn = __shfl_xor(v, 1);
                   if ((r32 & 1) == 0) *(unsigned*)(Ow + (size_t)orow * OS + d0 * 32 + r32) = cvtpk(v, vn); } } }
    if constexpr (F32) {
#pragma unroll
        for (int d0 = 0; d0 < 8; ++d0) S.qr[d0] = pack8(S.tq[2 * d0], S.tq[2 * d0 + 1]); }
    __syncthreads();
#undef RESC
#undef KBASE
#undef ACT
#undef MASKT
#undef MLOAD
#undef SEAM_K0
#undef HALF_STEP
}
#undef ROW
#undef VMW
#undef VMWN
#undef SLOAD_H
#undef SWRITE_HK
#undef SWRITE_HV
#undef SWRITE_H
#undef SLOAD_F
#undef SWRITE_KF
#undef SWRITE_VF
}
#ifndef PROBE
#define PROBE 0
#endif
constexpr int NWAVES = 8;
constexpr int NB = 2, T = 8192, M = NB * T, DM = 1024, FF = 2816, NIN = 8520, NLAYER = 2;
constexpr float NORM_EPS = 1e-6f;
constexpr size_t MiB = 1u << 20;
constexpr size_t WS_CTL = 0, CTL_ZERO_BYTES = 1 * MiB;
constexpr size_t WS_WF = 1 * MiB;
constexpr size_t WS_WF_DOWN = WS_WF + 11 * MiB;
constexpr size_t WS_WM = 18 * MiB;
constexpr size_t WS_WM_BR = WS_WM + 17 * MiB, WS_WM_OUT = WS_WM + 20 * MiB;
constexpr size_t WS_XN = 40 * MiB;
constexpr size_t WS_Q3 = 72 * MiB;
constexpr size_t WS_ZR = 120 * MiB;
constexpr size_t WS_R2 = 248 * MiB;
constexpr size_t WS_END = 280 * MiB;
constexpr size_t WS_MG = WS_ZR + 96 * MiB;
constexpr size_t WS_YRAW = WS_WF;
constexpr size_t WS_X1 = WS_XN + 16 * MiB;
constexpr size_t WS_A8 = WS_WM;
constexpr size_t WS_KID = WS_WM + 8 * MiB;
constexpr size_t WS_BITM = WS_XN;
constexpr size_t WS_RDOTK = WS_WF + 16 * MiB;
constexpr int QP = 1536, ZP = 4096;
constexpr int ZC_DK = 0, ZC_DV = 512, ZC_QI = 1024, ZC_KI = 1536, ZC_WI = 1600, ZC_RK = 1792, ZC_RV = 2304, ZC_WC = 2816, ZC_AC = 2880, ZC_GC = 2944, ZC_FK = 3072, ZC_FV = 3584;
constexpr int CW_TMO = 0;
constexpr int CW_BAR = 4096;
constexpr int CW_Q = 8192;
constexpr int CW_PROBE = 2048;
constexpr int CW_DONE = 12288;
constexpr int LDS_MISC = 160 * 1024 - 256;
constexpr int LDS_BYTES = 160 * 1024;

#define GAS __attribute__((address_space(1)))
#define LAS __attribute__((address_space(3)))
typedef unsigned short bf16;
typedef unsigned v4u __attribute__((ext_vector_type(4)));
typedef unsigned v2u __attribute__((ext_vector_type(2)));
typedef float f32x4 __attribute__((ext_vector_type(4)));
typedef float f32x2 __attribute__((ext_vector_type(2)));
typedef float f32x16 __attribute__((ext_vector_type(16)));
typedef short bf16x8 __attribute__((ext_vector_type(8)));
typedef GAS unsigned gu32;
#define RLX_AGENT __ATOMIC_RELAXED, __HIP_MEMORY_SCOPE_AGENT
#define LDS_WAIT() asm volatile("s_waitcnt lgkmcnt(0)" ::: "memory")
#define VM_WAIT() asm volatile("s_waitcnt vmcnt(0)" ::: "memory")
__device__ __forceinline__ unsigned f2bf(float f) { unsigned u = __builtin_bit_cast(unsigned, f); return (u + 0x7fffu + ((u >> 16) & 1u)) >> 16; }
__device__ __forceinline__ unsigned pk2(float lo, float hi) { return f2bf(lo) | (f2bf(hi) << 16); }
__device__ __forceinline__ float bflo(unsigned w) { return __uint_as_float(w << 16); }
__device__ __forceinline__ float bfhi(unsigned w) { return __uint_as_float(w & 0xffff0000u); }
__device__ __forceinline__ float bf1(bf16 h) { return __uint_as_float((unsigned)h << 16); }
__device__ __forceinline__ float wave_sum(float v) {
#pragma unroll
    for (int o = 1; o < 64; o <<= 1) v += __shfl_xor(v, o);
    return v;
}
__device__ __forceinline__ float sigm(float x) { return __builtin_amdgcn_rcpf(1.0f + __expf(-x)); }

#define XB_TMO      128
#define XB_XCNT(j)  (256  + 64 * (j))
#define XB_XSUB(j)  (1280 + 64 * (j))
#define XB_XGEN(j)  (2304 + 64 * (j))
#define XB_TOP      3328
#define XB_TOPGEN   3392
#define XCD_BAR_WORDS 3456
#define XB_SPIN_CAP (1u << 22)
__device__ __forceinline__ unsigned xb_ld(unsigned* p)              { return __hip_atomic_load(p, __ATOMIC_RELAXED, __HIP_MEMORY_SCOPE_AGENT); }
__device__ __forceinline__ unsigned xb_add(unsigned* p, unsigned v) { return __hip_atomic_fetch_add(p, v, __ATOMIC_RELAXED, __HIP_MEMORY_SCOPE_AGENT); }
__device__ __forceinline__ unsigned xb_xcc_id() { return (unsigned)__builtin_amdgcn_s_getreg((3 << 11) | 20) & 0xFu; }
#define XB_SPIN(cond, bar) do { unsigned _sp = 0; while (cond) { __builtin_amdgcn_s_sleep(1); \
    if ((++_sp & 255u) == 0u) { if (xb_ld(&(bar)[XB_TMO])) break; if (_sp > XB_SPIN_CAP) { atomicAdd(&(bar)[XB_TMO], 1u); break; } } } } while (0)
struct XcdBarrier { unsigned* bar; unsigned x; volatile LAS unsigned* st; };
__device__ __forceinline__ XcdBarrier xcd_barrier_post(unsigned* bar, volatile LAS unsigned* st) {
    XcdBarrier b; b.bar = bar; b.x = xb_xcc_id(); b.st = st;
    if (threadIdx.x == 0) (void)xb_add(&bar[XB_XCNT(b.x)], 1u);
    return b;
}
__device__ __forceinline__ void xcd_barrier_complete(unsigned* bar, unsigned x, unsigned& nloc, unsigned& nx) {
    const unsigned G = gridDim.x * gridDim.y * gridDim.z;
    unsigned sum, cnt, mine, sp = 0u;
    for (;;) {
        sum = 0u; cnt = 0u; mine = 0u;
#pragma unroll
        for (unsigned j = 0; j < 16; ++j) { const unsigned c = xb_ld(&bar[XB_XCNT(j)]); sum += c; cnt += (c > 0u) ? 1u : 0u; mine = (j == x) ? c : mine; }
        if (sum == G) break;
        __builtin_amdgcn_s_sleep(1);
        if ((++sp & 255u) == 0u) { if (xb_ld(&bar[XB_TMO])) break; if (sp > XB_SPIN_CAP) { atomicAdd(&bar[XB_TMO], 1u); break; } }
    }
    nloc = mine > 0u ? mine : 1u; nx = cnt > 0u ? cnt : 1u;
}
__device__ __forceinline__ void xcd_barrier(const XcdBarrier& b) {
    asm volatile("s_waitcnt vmcnt(0)" ::: "memory");
    __syncthreads();
    if (threadIdx.x == 0) {
        unsigned* bar = b.bar;
        __builtin_amdgcn_s_waitcnt(0);
        unsigned nloc = b.st[0], nx = b.st[1];
        if (nloc == 0u) { xcd_barrier_complete(bar, b.x, nloc, nx); b.st[0] = nloc; b.st[1] = nx; }
        const unsigned old = xb_add(&bar[XB_XSUB(b.x)], 1u);
        const unsigned gen = old / nloc;
        if (old + 1u == (gen + 1u) * nloc) {
            __builtin_amdgcn_fence(__ATOMIC_RELEASE, "agent");
            asm volatile("s_waitcnt vmcnt(0)" ::: "memory");
            const unsigned og = xb_add(&bar[XB_TOP], 1u);
            const unsigned tg = og / nx;
            if (og + 1u == (tg + 1u) * nx) xb_add(&bar[XB_TOPGEN], 1u);
            else XB_SPIN(xb_ld(&bar[XB_TOPGEN]) == tg, bar);
            __builtin_amdgcn_fence(__ATOMIC_ACQUIRE, "agent");
            xb_add(&bar[XB_XGEN(b.x)], 1u);
            asm volatile("s_waitcnt vmcnt(0)" ::: "memory");
        } else {
            XB_SPIN(xb_ld(&bar[XB_XGEN(b.x)]) == gen, bar);
            __builtin_amdgcn_fence(__ATOMIC_ACQUIRE, "agent");
            asm volatile("s_waitcnt vmcnt(0)" ::: "memory");
        }
    }
    __syncthreads();
}

struct MapIdent { const float* W; int ld; __device__ __forceinline__ const float* col(int n) const { return W + n; } };
struct MapUp {
    const float* G; const float* U; int ld;
    __device__ __forceinline__ const float* col(int n) const { const int g = n >> 5, j = n & 31; return j < 16 ? G + 16 * g + j : U + 16 * g + (j - 16); }
};
struct MapWin {
    const float* W; int ld;
    __device__ __forceinline__ const float* col(int n) const {
        int src;
        if (n < 512) src = n; else if (n < 1024) src = 2120 + (n - 512); else if (n < 1536) src = 3912 + (n - 1024);
        else if (n < 5632) { const int z = n - 1536; if (z < 1608) src = 512 + z; else if (z < 1792) src = -1; else if (z < 3072) src = 840 + z; else src = 1352 + z; }
        else src = 5448 + (n - 5632);
        return src < 0 ? nullptr : W + src;
    }
};
template <class Map>
__device__ __forceinline__ void conv_item(const Map& mp, int K, bf16* WT, LAS float* scr, int item, int nblk, int lane) {
    const int kb = item / nblk, nb = item % nblk, k0 = 32 * kb, n0 = 32 * nb;
    const float* cp = mp.col(n0 + (lane & 31)); const size_t ld = (size_t)mp.ld;
#pragma unroll
    for (int i = 0; i < 16; ++i) { const int kk = 2 * i + (lane >> 5); scr[kk * 33 + (lane & 31)] = cp ? cp[(size_t)(k0 + kk) * ld] : 0.f; }
    LDS_WAIT(); asm volatile("" ::: "memory");
    const int c = lane & 3;
#pragma unroll
    for (int j = 0; j < 2; ++j) { const int n = (lane >> 2) + 16 * j; const LAS float* s = scr + (8 * c) * 33 + n;
        v4u o; o.x = pg8::cvt_pk_bf16(s[0 * 33], s[1 * 33]); o.y = pg8::cvt_pk_bf16(s[2 * 33], s[3 * 33]); o.z = pg8::cvt_pk_bf16(s[4 * 33], s[5 * 33]); o.w = pg8::cvt_pk_bf16(s[6 * 33], s[7 * 33]);
        *(GAS v4u*)(WT + (size_t)(n0 + n) * K + k0 + 8 * c) = o; }
    LDS_WAIT(); asm volatile("" ::: "memory");
}
__host__ __device__ constexpr int conv_items(int K, int N) { return (K / 32) * (N / 32); }

__device__ __forceinline__ void rownorm_rows(const float* base, const bf16* Y, float s, const float* gpost, float* out, const float* gnext, bf16* XN, int gw, int NGW, int lane, float oscale = 1.f) {
    for (int m = gw; m < M; m += NGW) {
        f32x4 v[4];
#pragma unroll
        for (int j = 0; j < 4; ++j) v[j] = ((const GAS f32x4*)(base + (size_t)m * DM))[lane + 64 * j];
        if (Y) {
            f32x4 y[4]; float ss = 0.f;
#pragma unroll
            for (int j = 0; j < 4; ++j) { const v2u w = ((const GAS v2u*)(Y + (size_t)m * DM))[lane + 64 * j]; y[j] = (f32x4){bflo(w.x), bfhi(w.x), bflo(w.y), bfhi(w.y)};
                ss += (y[j].x * y[j].x + y[j].y * y[j].y) + (y[j].z * y[j].z + y[j].w * y[j].w); }
            const float r = s * __builtin_amdgcn_rsqf(wave_sum(ss) * (1.f / DM) + NORM_EPS);
#pragma unroll
            for (int j = 0; j < 4; ++j) { const f32x4 g = ((const GAS f32x4*)gpost)[lane + 64 * j]; v[j] = v[j] + y[j] * g * r; ((GAS f32x4*)(out + (size_t)m * DM))[lane + 64 * j] = v[j] * oscale; }
        }
        if (XN) {
            float ss = 0.f;
#pragma unroll
            for (int j = 0; j < 4; ++j) ss += (v[j].x * v[j].x + v[j].y * v[j].y) + (v[j].z * v[j].z + v[j].w * v[j].w);
            const float r = __builtin_amdgcn_rsqf(wave_sum(ss) * (1.f / DM) + NORM_EPS);
#pragma unroll
            for (int j = 0; j < 4; ++j) { const f32x4 g = ((const GAS f32x4*)gnext)[lane + 64 * j]; const f32x4 o = v[j] * g * r;
                v2u w; w.x = pk2(o.x, o.y); w.y = pk2(o.z, o.w); ((GAS v2u*)(XN + (size_t)m * DM))[lane + 64 * j] = w; }
        }
    }
}

namespace scan {
template <int CTRL> __device__ __forceinline__ float dpp_add(float x) {
    const int y = __builtin_amdgcn_update_dpp(0, __builtin_bit_cast(int, x), CTRL, 0xF, 0xF, false);
    return x + __builtin_bit_cast(float, y);
}
__device__ __forceinline__ float red8(float x) { x = dpp_add<0xB1>(x); x = dpp_add<0x4E>(x); x = dpp_add<0x141>(x); return x; }
__device__ __forceinline__ float red16(float x) { x = dpp_add<0xB1>(x); x = dpp_add<0x4E>(x); x = dpp_add<0x141>(x); x = dpp_add<0x140>(x); return x; }
__device__ __forceinline__ void ld8(const bf16* p, float (&o)[8]) { const v4u w = *(const GAS v4u*)p; o[0] = bflo(w.x); o[1] = bfhi(w.x); o[2] = bflo(w.y); o[3] = bfhi(w.y); o[4] = bflo(w.z); o[5] = bfhi(w.z); o[6] = bflo(w.w); o[7] = bfhi(w.w); }
}
struct PrepP { const bf16* ZR; bf16* X1; unsigned char* A8; bf16* KI; const float *mu, *w0, *wup, *a0, *aup; };
__device__ __forceinline__ void rwkv_prep(const PrepP& P, LAS unsigned char* lds) {
    const int tid = otid_(), lane = tid & 63, h = __builtin_amdgcn_readfirstlane(tid >> 6), c16 = lane & 15, quad = lane >> 4;
    constexpr int SP = 144;
    LAS unsigned char* TA = lds; LAS unsigned char* AA = lds + 64 * SP;
    bf16x8 bw[4][2], ba[4][2];
#pragma unroll
    for (int ct = 0; ct < 4; ++ct)
#pragma unroll
        for (int s = 0; s < 2; ++s) { const size_t o = (size_t)(32 * s + 8 * quad) * 512 + 64 * h + 16 * ct + c16; const float* gw_ = P.wup + o; const float* ga_ = P.aup + o;
            v4u w; w.x = pk2(gw_[0], gw_[512]); w.y = pk2(gw_[1024], gw_[1536]); w.z = pk2(gw_[2048], gw_[2560]); w.w = pk2(gw_[3072], gw_[3584]); bw[ct][s] = __builtin_bit_cast(bf16x8, w);
            v4u a; a.x = pk2(ga_[0], ga_[512]); a.y = pk2(ga_[1024], ga_[1536]); a.z = pk2(ga_[2048], ga_[2560]); a.w = pk2(ga_[3072], ga_[3584]); ba[ct][s] = __builtin_bit_cast(bf16x8, a); }
    float w0v[4], a0v[4];
#pragma unroll
    for (int ct = 0; ct < 4; ++ct) { w0v[ct] = P.w0[64 * h + 16 * ct + c16]; a0v[ct] = P.a0[64 * h + 16 * ct + c16]; }
    const int stok = tid >> 3, sseg = tid & 7;
#pragma unroll 1
    for (int m0 = blockIdx.x * 64; m0 < M; m0 += gridDim.x * 64) {
        {   const size_t m = (size_t)m0 + stok; const int t = (int)(m & (T - 1));
            *(GAS v4u*)(P.KI + m * 64 + 8 * sseg) = *(const GAS v4u*)(P.ZR + m * ZP + ZC_KI + 8 * sseg);
            float wc[8], ac[8], p8[8];
            scan::ld8(P.ZR + m * ZP + ZC_WC + 8 * sseg, wc); scan::ld8(P.ZR + m * ZP + ZC_AC + 8 * sseg, ac);
            if (t > 0) { scan::ld8(P.ZR + (m - 1) * ZP + ZC_WC + 8 * sseg, p8);
#pragma unroll
                for (int e = 0; e < 8; ++e) wc[e] += (p8[e] - wc[e]) * P.mu[1536 + 8 * sseg + e];
                scan::ld8(P.ZR + (m - 1) * ZP + ZC_AC + 8 * sseg, p8);
#pragma unroll
                for (int e = 0; e < 8; ++e) ac[e] += (p8[e] - ac[e]) * P.mu[1600 + 8 * sseg + e]; }
            else {
#pragma unroll
                for (int e = 0; e < 8; ++e) { wc[e] -= wc[e] * P.mu[1536 + 8 * sseg + e]; ac[e] -= ac[e] * P.mu[1600 + 8 * sseg + e]; } }
            float th[8];
#pragma unroll
            for (int e = 0; e < 8; ++e) th[e] = 1.f - 2.f * __builtin_amdgcn_rcpf(__expf(2.f * wc[e]) + 1.f);
            v4u o; o.x = pk2(th[0], th[1]); o.y = pk2(th[2], th[3]); o.z = pk2(th[4], th[5]); o.w = pk2(th[6], th[7]); *(LAS v4u*)(TA + stok * SP + 16 * sseg) = o;
            v4u q; q.x = pk2(ac[0], ac[1]); q.y = pk2(ac[2], ac[3]); q.z = pk2(ac[4], ac[5]); q.w = pk2(ac[6], ac[7]); *(LAS v4u*)(AA + stok * SP + 16 * sseg) = q;
        }
        __syncthreads();
#pragma unroll 1
        for (int rt = 0; rt < 4; ++rt) {
            f32x4 accw[4], acca[4];
#pragma unroll
            for (int ct = 0; ct < 4; ++ct) { accw[ct] = (f32x4){0.f, 0.f, 0.f, 0.f}; acca[ct] = (f32x4){0.f, 0.f, 0.f, 0.f}; }
#pragma unroll
            for (int s = 0; s < 2; ++s) { const bf16x8 fw = *(const LAS bf16x8*)(TA + (16 * rt + c16) * SP + (32 * s + 8 * quad) * 2), fa = *(const LAS bf16x8*)(AA + (16 * rt + c16) * SP + (32 * s + 8 * quad) * 2);
#pragma unroll
                for (int ct = 0; ct < 4; ++ct) { accw[ct] = __builtin_amdgcn_mfma_f32_16x16x32_bf16(fw, bw[ct][s], accw[ct], 0, 0, 0); acca[ct] = __builtin_amdgcn_mfma_f32_16x16x32_bf16(fa, ba[ct][s], acca[ct], 0, 0, 0); } }
#pragma unroll
            for (int j = 0; j < 4; ++j) { const size_t m = (size_t)m0 + 16 * rt + 4 * quad + j;
#pragma unroll
                for (int ct = 0; ct < 4; ++ct) { const int ch = 64 * h + 16 * ct + c16;
                    const float sg = sigm(w0v[ct] + accw[ct][j]);
                    const float x1 = 1.f - __expf(-0.6065306597126334f * sg);
                    const float a = sigm(a0v[ct] + acca[ct][j]);
                    P.X1[m * 512 + ch] = (bf16)f2bf(x1);
                    P.A8[m * 512 + ch] = (unsigned char)(int)(a * 255.f + 0.5f); } }
        }
        __syncthreads();
    }
}

struct ScanP { const bf16* Q3; const bf16* ZR; const bf16* X1; const unsigned char* A8; bf16* yraw; float* rdotk; const float *mu, *k_k, *k_a, *r_k; };
namespace scan {
constexpr int TB = 32, NBLK = T / TB;
constexpr int CB_W = 0, CB_B = 8192, CB_K = 16384, CB_KW = 24576, CB_V = 40960, CB_BR = 43008, CB_KR = 43136, CB_SA = 43264, CB_YP = 45312, CBSZ = 78080;
constexpr int L_END = 2 * CBSZ;
static_assert(L_END <= LDS_MISC, "scan LDS");
}
__device__ __forceinline__ void rwkv_scan_unit(const ScanP& P, int unit, LAS unsigned char* lds) {
    using namespace scan;
    const int tid = otid_(), wid = __builtin_amdgcn_readfirstlane(tid >> 6), lane = tid & 63;
    const int b = unit >> 5, h = (unit >> 2) & 7, vq = unit & 3;
    const size_t mrow0 = (size_t)b * T;
    if (wid >= 4) {
        const int pw = wid - 4, tokl = lane >> 3, seg = lane & 7, c0 = 8 * seg, hc0 = 64 * h + c0;
        float mu_r[8], mu_k[8], kkv[8], kav[8], rkv[8];
#pragma unroll
        for (int e = 0; e < 8; ++e) { mu_r[e] = P.mu[hc0 + e]; mu_k[e] = P.mu[512 + hc0 + e]; kkv[e] = P.k_k[hc0 + e]; kav[e] = P.k_a[hc0 + e]; rkv[e] = P.r_k[hc0 + e]; }
        const int vc0 = 64 * h + 16 * vq + 2 * seg;
        const float mu_v0 = P.mu[1024 + vc0], mu_v1 = P.mu[1024 + vc0 + 1];
        const int ptid = pw * 64 + lane;
        for (int blk = -1; blk < NBLK; ++blk) {
            const int nb = blk + 1;
            LAS unsigned char* cb = lds + (nb & 1) * CBSZ;
            if (blk >= 1) {
                const int tok = ptid >> 3, v2 = (ptid & 7) * 2;
                const LAS float* YPp = (const LAS float*)(cb + CB_YP) + (tok * 16 + v2) * 16;
                float y0 = 0.f, y1 = 0.f;
#pragma unroll
                for (int q4 = 0; q4 < 4; ++q4) { const f32x4 a = *(const LAS f32x4*)(YPp + 4 * q4), c = *(const LAS f32x4*)(YPp + 16 + 4 * q4); y0 += (a.x + a.y) + (a.z + a.w); y1 += (c.x + c.y) + (c.z + c.w); }
                const float br = *(const LAS float*)(cb + CB_BR + tok * 4), kr = *(const LAS float*)(cb + CB_KR + tok * 4);
                const f32x2 sa = *(const LAS f32x2*)(cb + CB_SA + (tok * 16 + v2) * 4), vv = *(const LAS f32x2*)(cb + CB_V + (tok * 16 + v2) * 4);
                y0 += sa.x * br + vv.x * kr; y1 += sa.y * br + vv.y * kr;
                const size_t m = mrow0 + (size_t)(blk - 1) * TB + tok;
                *(GAS unsigned*)(P.yraw + m * 512 + 64 * h + 16 * vq + v2) = pk2(y0, y1);
                LDS_WAIT(); asm volatile("" ::: "memory");
            }
            if (nb < NBLK) {
                const int t = nb * TB + 8 * pw + tokl; const size_t m = mrow0 + t;
                float r8[8], k8[8], p8[8], x8[8], a8[8];
                ld8(P.Q3 + m * QP + 512 + hc0, r8); ld8(P.ZR + m * ZP + ZC_RK + hc0, k8); ld8(P.X1 + m * 512 + hc0, x8);
                { const v2u aw = *(const GAS v2u*)(P.A8 + m * 512 + hc0); const float sc = 1.f / 255.f;
                  a8[0] = (float)(aw.x & 255u) * sc; a8[1] = (float)((aw.x >> 8) & 255u) * sc; a8[2] = (float)((aw.x >> 16) & 255u) * sc; a8[3] = (float)(aw.x >> 24) * sc;
                  a8[4] = (float)(aw.y & 255u) * sc; a8[5] = (float)((aw.y >> 8) & 255u) * sc; a8[6] = (float)((aw.y >> 16) & 255u) * sc; a8[7] = (float)(aw.y >> 24) * sc; }
                const unsigned vw = *(const GAS unsigned*)(P.ZR + m * ZP + ZC_RV + vc0); float v0 = bflo(vw), v1 = bfhi(vw);
                if (t > 0) {
                    ld8(P.Q3 + (m - 1) * QP + 512 + hc0, p8);
#pragma unroll
                    for (int e = 0; e < 8; ++e) r8[e] += (p8[e] - r8[e]) * mu_r[e];
                    ld8(P.ZR + (m - 1) * ZP + ZC_RK + hc0, p8);
#pragma unroll
                    for (int e = 0; e < 8; ++e) k8[e] += (p8[e] - k8[e]) * mu_k[e];
                    const unsigned pv = *(const GAS unsigned*)(P.ZR + (m - 1) * ZP + ZC_RV + vc0);
                    v0 += (bflo(pv) - v0) * mu_v0; v1 += (bfhi(pv) - v1) * mu_v1;
                } else {
#pragma unroll
                    for (int e = 0; e < 8; ++e) { r8[e] -= r8[e] * mu_r[e]; k8[e] -= k8[e] * mu_k[e]; }
                    v0 -= v0 * mu_v0; v1 -= v1 * mu_v1;
                }
                float kk8[8]; { float ss = 0.f;
#pragma unroll
                  for (int e = 0; e < 8; ++e) { kk8[e] = k8[e] * kkv[e]; ss += kk8[e] * kk8[e]; }
                  ss = red8(ss); const float inv = 1.f / fmaxf(sqrtf(ss), 1e-12f);
#pragma unroll
                  for (int e = 0; e < 8; ++e) kk8[e] *= inv; }
                float w8[8], bb[8], km[8], wr[8]; float brp = 0.f, krp = 0.f, rkp = 0.f;
#pragma unroll
                for (int e = 0; e < 8; ++e) {
                    w8[e] = 1.f - x8[e];
                    bb[e] = kk8[e] * a8[e]; km[e] = k8[e] * (1.f + (a8[e] - 1.f) * kav[e]); wr[e] = w8[e] * r8[e];
                    brp += bb[e] * r8[e]; krp += km[e] * r8[e]; rkp += r8[e] * km[e] * rkv[e];
                }
                brp = red8(brp); krp = red8(krp); rkp = red8(rkp);
                const int ti = 8 * pw + tokl;
                *(LAS f32x4*)(cb + CB_W + (ti * 64 + c0) * 4) = (f32x4){w8[0], w8[1], w8[2], w8[3]}; *(LAS f32x4*)(cb + CB_W + (ti * 64 + c0 + 4) * 4) = (f32x4){w8[4], w8[5], w8[6], w8[7]};
                *(LAS f32x4*)(cb + CB_B + (ti * 64 + c0) * 4) = (f32x4){bb[0], bb[1], bb[2], bb[3]}; *(LAS f32x4*)(cb + CB_B + (ti * 64 + c0 + 4) * 4) = (f32x4){bb[4], bb[5], bb[6], bb[7]};
                *(LAS f32x4*)(cb + CB_K + (ti * 64 + c0) * 4) = (f32x4){km[0], km[1], km[2], km[3]}; *(LAS f32x4*)(cb + CB_K + (ti * 64 + c0 + 4) * 4) = (f32x4){km[4], km[5], km[6], km[7]};
#pragma unroll
                for (int e = 0; e < 8; e += 2) *(LAS f32x4*)(cb + CB_KW + (ti * 64 + c0 + e) * 8) = (f32x4){kk8[e], wr[e], kk8[e + 1], wr[e + 1]};
                *(LAS f32x2*)(cb + CB_V + (ti * 16 + 2 * seg) * 4) = (f32x2){v0, v1};
                if (seg == 0) { *(LAS float*)(cb + CB_BR + ti * 4) = brp; *(LAS float*)(cb + CB_KR + ti * 4) = krp; if (vq == 0) P.rdotk[m * 8 + h] = rkp; }
            }
            __syncthreads();
        }
        { const LAS unsigned char* cb = lds + ((NBLK - 1) & 1) * CBSZ;
          const int tok = ptid >> 3, v2 = (ptid & 7) * 2;
          const LAS float* YPp = (const LAS float*)(cb + CB_YP) + (tok * 16 + v2) * 16;
          float y0 = 0.f, y1 = 0.f;
#pragma unroll
          for (int q4 = 0; q4 < 4; ++q4) { const f32x4 a = *(const LAS f32x4*)(YPp + 4 * q4), c = *(const LAS f32x4*)(YPp + 16 + 4 * q4); y0 += (a.x + a.y) + (a.z + a.w); y1 += (c.x + c.y) + (c.z + c.w); }
          const float br = *(const LAS float*)(cb + CB_BR + tok * 4), kr = *(const LAS float*)(cb + CB_KR + tok * 4);
          const f32x2 sa = *(const LAS f32x2*)(cb + CB_SA + (tok * 16 + v2) * 4), vv = *(const LAS f32x2*)(cb + CB_V + (tok * 16 + v2) * 4);
          y0 += sa.x * br + vv.x * kr; y1 += sa.y * br + vv.y * kr;
          const size_t m = mrow0 + (size_t)(NBLK - 1) * TB + tok;
          *(GAS unsigned*)(P.yraw + m * 512 + 64 * h + 16 * vq + v2) = pk2(y0, y1); }
    } else {
        const int vi = 4 * wid + (lane >> 4), cg = lane & 15;
        f32x2 s01 = {0.f, 0.f}, s23 = {0.f, 0.f};
        __syncthreads();
        __builtin_amdgcn_s_setprio(3);
        const unsigned lo4 = (unsigned)(4 * cg) * 4u, lo8 = (unsigned)(4 * cg) * 8u;
        for (int blk = 0; blk < NBLK; ++blk) {
            const LAS unsigned char* cb = lds + (blk & 1) * CBSZ;
            f32x4 kwa = *(const LAS f32x4*)(cb + CB_KW + lo8), kwb = *(const LAS f32x4*)(cb + CB_KW + lo8 + 16);
            f32x4 w4 = *(const LAS f32x4*)(cb + CB_W + lo4), b4 = *(const LAS f32x4*)(cb + CB_B + lo4), k4 = *(const LAS f32x4*)(cb + CB_K + lo4);
            float vv = *(const LAS float*)(cb + CB_V + vi * 4);
#pragma unroll 4
            for (int tok = 0; tok < TB; ++tok) {
                const int tn = tok + 1 < TB ? tok + 1 : tok;
                const f32x4 nkwa = *(const LAS f32x4*)(cb + CB_KW + tn * 512 + lo8), nkwb = *(const LAS f32x4*)(cb + CB_KW + tn * 512 + lo8 + 16);
                const f32x4 nw4 = *(const LAS f32x4*)(cb + CB_W + tn * 256 + lo4), nb4 = *(const LAS f32x4*)(cb + CB_B + tn * 256 + lo4), nk4 = *(const LAS f32x4*)(cb + CB_K + tn * 256 + lo4);
                const float nvv = *(const LAS float*)(cb + CB_V + (tn * 16 + vi) * 4);
                f32x2 p = (f32x2){s01.x, s01.x} * (f32x2){kwa.x, kwa.y};
                p += (f32x2){s01.y, s01.y} * (f32x2){kwa.z, kwa.w};
                p += (f32x2){s23.x, s23.x} * (f32x2){kwb.x, kwb.y};
                p += (f32x2){s23.y, s23.y} * (f32x2){kwb.z, kwb.w};
                *(LAS float*)(cb + CB_YP + ((tok * 16 + vi) * 16 + cg) * 4) = p.y;
                const f32x2 t01 = s01 * (f32x2){w4.x, w4.y} + (f32x2){k4.x, k4.y} * vv, t23 = s23 * (f32x2){w4.z, w4.w} + (f32x2){k4.z, k4.w} * vv;
                const float d1 = red16(p.x);
                s01 = t01 - (f32x2){b4.x, b4.y} * d1; s23 = t23 - (f32x2){b4.z, b4.w} * d1;
                *(LAS float*)(cb + CB_SA + (tok * 16 + vi) * 4) = -d1;
                kwa = nkwa; kwb = nkwb; w4 = nw4; b4 = nb4; k4 = nk4; vv = nvv;
            }
            __syncthreads();
        }
        __builtin_amdgcn_s_setprio(0);
    }
    __syncthreads();
}

struct Dsa1P { const bf16* ZR; const bf16* KI; unsigned* bitm; gu32* done; };
namespace dsa1 {
constexpr int CAP = 769  , PRUNE_AT = 512, KEEP = 256;
constexpr int L_BUF = 0, L_CNT = 32 * CAP * 4, L_THR = L_CNT + 128, L_THRK = L_THR + 128, L_HIST = ((L_THRK + 128 + 15) / 16) * 16, L_MROW = L_HIST + 8 * 1024, L_QF = L_MROW + 8 * 1024, QFP = 1040, L_END = L_QF + 32 * QFP;
static_assert(L_END <= LDS_MISC, "dsa1 LDS");
__device__ __forceinline__ unsigned packkey(float s, int keyidx) { const unsigned bits = __float_as_uint(s); const unsigned u = bits ^ ((unsigned)((int)bits >> 31) | 0x80000000u); return (u & 0xFFFFE000u) | (unsigned)(8191 - keyidx); }
__device__ __forceinline__ float thr_of(unsigned key) { const unsigned u = key & 0xFFFFE000u; const unsigned bits = (u & 0x80000000u) ? (u ^ 0x80000000u) : ~u; return __uint_as_float(bits); }
__device__ __forceinline__ int wave_prefix_incl(int v) {
    v += __builtin_amdgcn_update_dpp(0, v, 0x111, 0xF, 0xF, true);
    v += __builtin_amdgcn_update_dpp(0, v, 0x112, 0xF, 0xF, true);
    v += __builtin_amdgcn_update_dpp(0, v, 0x114, 0xF, 0xF, true);
    v += __builtin_amdgcn_update_dpp(0, v, 0x118, 0xF, 0xF, true);
    v += __builtin_amdgcn_update_dpp(0, v, 0x142, 0xA, 0xF, false);
    v += __builtin_amdgcn_update_dpp(0, v, 0x143, 0xC, 0xF, false);
    return v;
}
__device__ __forceinline__ void prune(LAS unsigned char* lds, int qq, int wid, int lane, bool exact) {
    asm volatile("" : "+v"(lane));
    LAS unsigned* buf = (LAS unsigned*)(lds + L_BUF) + qq * CAP; LAS unsigned* cnt = (LAS unsigned*)(lds + L_CNT); LAS float* thr = (LAS float*)(lds + L_THR); LAS unsigned* thrk = (LAS unsigned*)(lds + L_THRK);
    LAS unsigned* hist = (LAS unsigned*)(lds + L_HIST) + wid * 256;
    const int n = (int)cnt[qq];
    unsigned e[12];
#pragma unroll
    for (int k = 0; k < 12; ++k) e[k] = (lane + 64 * k < n) ? buf[lane + 64 * k] : 0u;
    const unsigned tk = thrk[qq];
    unsigned cut = 0u; bool have = false;
    if (!exact && tk != 0u) {
        const unsigned base16 = tk >> 16;
        *(LAS v4u*)(hist + 4 * lane) = (v4u){0u, 0u, 0u, 0u};
        LDS_WAIT(); asm volatile("" ::: "memory");
#pragma unroll
        for (int k = 0; k < 12; ++k) if (lane + 64 * k < n) { unsigned bn = (e[k] >> 16) - base16; bn = bn > 255u ? 255u : bn; (void)__hip_atomic_fetch_add(hist + bn, 1u, __ATOMIC_RELAXED, __HIP_MEMORY_SCOPE_WORKGROUP); }
        LDS_WAIT(); asm volatile("" ::: "memory");
        const int rl = 63 - lane;
        const v4u hv = *(const LAS v4u*)(hist + 4 * rl);
        const int tot = (int)(hv.x + hv.y + hv.z + hv.w);
        int above = wave_prefix_incl(tot) - tot; int dsel = -1, csel = 0;
        { const int h3 = (int)hv.w, h2 = (int)hv.z, h1 = (int)hv.y, h0 = (int)hv.x;
          if (above < KEEP && KEEP <= above + h3) { dsel = 4 * rl + 3; csel = above + h3; } above += h3;
          if (above < KEEP && KEEP <= above + h2) { dsel = 4 * rl + 2; csel = above + h2; } above += h2;
          if (above < KEEP && KEEP <= above + h1) { dsel = 4 * rl + 1; csel = above + h1; } above += h1;
          if (above < KEEP && KEEP <= above + h0) { dsel = 4 * rl + 0; csel = above + h0; } }
        const unsigned long long bm = __ballot(dsel >= 0);
        const int src = bm ? (int)__builtin_ctzll(bm) : 0;
        const int d = __builtin_amdgcn_readlane(dsel, src), cd = __builtin_amdgcn_readlane(csel, src);
        LDS_WAIT(); asm volatile("" ::: "memory");
        if (bm != 0ull && cd <= KEEP + 128) { cut = (base16 + (unsigned)d) << 16; have = true; }
    }
    if (!have) {
        unsigned prefix = 0u; int want = KEEP;
#pragma unroll 1
        for (int p = 0; p < 4; ++p) {
            const int shift = 24 - 8 * p;
            *(LAS v4u*)(hist + 4 * lane) = (v4u){0u, 0u, 0u, 0u};
            LDS_WAIT(); asm volatile("" ::: "memory");
#pragma unroll
            for (int k = 0; k < 12; ++k) { const bool in = (lane + 64 * k < n) && (p == 0 || (e[k] >> (shift + 8)) == (prefix >> (shift + 8)));
                if (in) (void)__hip_atomic_fetch_add(hist + ((e[k] >> shift) & 255u), 1u, __ATOMIC_RELAXED, __HIP_MEMORY_SCOPE_WORKGROUP); }
            LDS_WAIT(); asm volatile("" ::: "memory");
            const int rl = 63 - lane;
            const v4u hv = *(const LAS v4u*)(hist + 4 * rl);
            const int tot = (int)(hv.x + hv.y + hv.z + hv.w);
            int above = wave_prefix_incl(tot) - tot;
            int dsel = -1, asel = 0;
            { const int h3 = (int)hv.w, h2 = (int)hv.z, h1 = (int)hv.y, h0 = (int)hv.x;
              if (above < want && want <= above + h3) { dsel = 4 * rl + 3; asel = above; } above += h3;
              if (above < want && want <= above + h2) { dsel = 4 * rl + 2; asel = above; } above += h2;
              if (above < want && want <= above + h1) { dsel = 4 * rl + 1; asel = above; } above += h1;
              if (above < want && want <= above + h0) { dsel = 4 * rl + 0; asel = above; } }
            const unsigned long long bm = __ballot(dsel >= 0);
            const int src = bm ? (int)__builtin_ctzll(bm) : 0;
            const int d = __builtin_amdgcn_readlane(dsel, src), ab = __builtin_amdgcn_readlane(asel, src);
            prefix |= ((unsigned)(d < 0 ? 0 : d)) << shift; want -= ab;
            LDS_WAIT(); asm volatile("" ::: "memory");
        }
        cut = prefix;
    }
    int base = 0;
#pragma unroll
    for (int k = 0; k < 12; ++k) { const bool keep = (lane + 64 * k < n) && e[k] >= cut; const unsigned long long mk = __ballot(keep);
        const int pos = base + (int)__builtin_amdgcn_mbcnt_hi((unsigned)(mk >> 32), __builtin_amdgcn_mbcnt_lo((unsigned)mk, 0u));
        if (keep) buf[pos] = e[k]; base += (int)__builtin_popcountll(mk); }
    if (lane == 0) { cnt[qq] = (unsigned)base; thr[qq] = thr_of(cut); thrk[qq] = cut; }
    LDS_WAIT(); asm volatile("" ::: "memory");
}
}
__device__ __forceinline__ void dsa1_unit(const Dsa1P& P, int u, LAS unsigned char* lds) {
    using namespace dsa1;
    const int tid = otid_(), wid = __builtin_amdgcn_readfirstlane(tid >> 6), lane = tid & 63, q = lane & 31, hi = lane >> 5;
    const int b = u & 1, qb32 = 255 - (u >> 1), t0 = 32 * qb32;
    const size_t brow = (size_t)b * T;
    LAS unsigned* buf = (LAS unsigned*)(lds + L_BUF); LAS unsigned* cnt = (LAS unsigned*)(lds + L_CNT); LAS float* thr = (LAS float*)(lds + L_THR);
    if (tid < 32) { cnt[tid] = 0u; thr[tid] = -__builtin_inff(); ((LAS unsigned*)(lds + L_THRK))[tid] = 0u; }
    const bf16* qrow = P.ZR + (brow + t0 + q) * ZP;
    { const int r = tid >> 4, sg = tid & 15; const bf16* src = P.ZR + (brow + t0 + r) * ZP + ZC_QI + 32 * sg;
#pragma unroll
      for (int j = 0; j < 4; ++j) *(LAS v4u*)(lds + L_QF + r * QFP + 64 * sg + 16 * j) = *(const GAS v4u*)(src + 8 * j); }
    float wq[8];
    { const v4u w = *(const GAS v4u*)(qrow + ZC_WI); const float c = 0.35355339059327373f * 0.125f;
      wq[0] = bflo(w.x) * c; wq[1] = bfhi(w.x) * c; wq[2] = bflo(w.y) * c; wq[3] = bfhi(w.y) * c; wq[4] = bflo(w.z) * c; wq[5] = bfhi(w.z) * c; wq[6] = bflo(w.w) * c; wq[7] = bfhi(w.w) * c; }
    const int tq = t0 + q;
    const int nsteps = (t0 + 32 + 255) >> 8;
    __syncthreads();
    float th = -__builtin_inff();
    bf16x8 afn[4];
    { const int k0 = 32 * wid; const bf16* krow = P.KI + (brow + (k0 <= t0 + 31 ? k0 : 0) + q) * 64 + 8 * hi;
#pragma unroll
      for (int s = 0; s < 4; ++s) afn[s] = *(const GAS bf16x8*)(krow + 16 * s); }
    for (int st = 0; st < nsteps; ++st) {
        const int key0 = 256 * st + 32 * wid;
        bf16x8 af[4];
#pragma unroll
        for (int s = 0; s < 4; ++s) af[s] = afn[s];
        { const int k1 = key0 + 256; const bf16* krow = P.KI + (brow + (k1 <= t0 + 31 ? k1 : 0) + q) * 64 + 8 * hi;
#pragma unroll
          for (int s = 0; s < 4; ++s) afn[s] = *(const GAS bf16x8*)(krow + 16 * s); }
        if (key0 <= t0 + 31) {
            f32x16 sc;
#pragma unroll
            for (int i = 0; i < 16; ++i) sc[i] = 0.f;
            unsigned qfo = (unsigned)(L_QF + q * QFP + 16 * hi); asm volatile("" : "+v"(qfo));
#pragma unroll
            for (int hd = 0; hd < 8; ++hd) {
                f32x16 acc;
#pragma unroll
                for (int i = 0; i < 16; ++i) acc[i] = 0.f;
#pragma unroll
                for (int s = 0; s < 4; ++s) { const bf16x8 qb = *(const LAS bf16x8*)(lds + qfo + hd * 128 + 32 * s);
                    acc = __builtin_amdgcn_mfma_f32_32x32x16_bf16(af[s], qb, acc, 0, 0, 0); }
#pragma unroll
                for (int i = 0; i < 16; ++i) sc[i] = fmaf(fmaxf(acc[i], 0.f), wq[hd], sc[i]);
                __builtin_amdgcn_sched_barrier(0);
            }
            const bool diag = key0 + 31 > t0;
            unsigned pm = 0u;
#pragma unroll
            for (int i = 0; i < 16; ++i) { const int kidx = key0 + (i & 3) + 8 * (i >> 2) + 4 * hi; const bool ok = (sc[i] >= th) && (!diag || kidx <= tq); pm |= ok ? (1u << i) : 0u; }
            const int np = __builtin_popcount(pm);
            if (np > 0) {
                int pos = (int)__hip_atomic_fetch_add(cnt + q, (unsigned)np, __ATOMIC_RELAXED, __HIP_MEMORY_SCOPE_WORKGROUP);
                LAS unsigned* bq = buf + q * CAP;
#pragma unroll
                for (int i = 0; i < 16; ++i) if (pm & (1u << i)) { const int kidx = key0 + (i & 3) + 8 * (i >> 2) + 4 * hi; bq[pos] = packkey(sc[i], kidx); ++pos; }
            }
        }
        __syncthreads();
        { unsigned nm = (unsigned)__ballot(cnt[q] > (unsigned)PRUNE_AT); int i = 0;
          while (nm) { const int qq = __builtin_ctz(nm); nm &= nm - 1u; if ((i & 7) == wid) prune(lds, qq, wid, lane, false); ++i; } }
        __syncthreads();
        th = thr[q];
    }
    LAS unsigned* mrow = (LAS unsigned*)(lds + L_MROW) + wid * 256;
#pragma unroll 1
    for (int k = 0; k < 4; ++k) {
        const int qq = wid + 8 * k;
        if (cnt[qq] > (unsigned)KEEP) prune(lds, qq, wid, lane, true);
        const int nf = (int)cnt[qq];
        *(LAS v4u*)(mrow + 4 * lane) = (v4u){0u, 0u, 0u, 0u};
        LDS_WAIT(); asm volatile("" ::: "memory");
#pragma unroll
        for (int j = 0; j < 4; ++j) { const int idx = lane + 64 * j; if (idx < nf) { const unsigned e = buf[qq * CAP + idx]; const unsigned key = 8191u - (e & 0x1FFFu); (void)__hip_atomic_fetch_or(mrow + (key >> 5), 1u << (key & 31u), __ATOMIC_RELAXED, __HIP_MEMORY_SCOPE_WORKGROUP); } }
        LDS_WAIT(); asm volatile("" ::: "memory");
        unsigned long long* grow = (unsigned long long*)(P.bitm + (brow + t0 + qq) * 256);
#pragma unroll
        for (int j = 0; j < 2; ++j) { const int w2 = lane + 64 * j; const unsigned long long v = (unsigned long long)mrow[2 * w2] | ((unsigned long long)mrow[2 * w2 + 1] << 32);
            __hip_atomic_store(grow + w2, v, RLX_AGENT); }
        LDS_WAIT(); asm volatile("" ::: "memory");
    }
    VM_WAIT();
    __syncthreads();
    if (tid == 0) __hip_atomic_fetch_add(P.done + 64 * (b * 32 + (t0 >> 8)), 1u, RLX_AGENT);
}

struct RPostP { const bf16* ZR; bf16* Q3; const bf16* yraw; const float* rdotk; const float *mu, *gup, *lnw, *lnb; };
__device__ __forceinline__ void rwkv_post(const RPostP& P, LAS unsigned char* lds) {
    const int tid = otid_(), lane = tid & 63, h = __builtin_amdgcn_readfirstlane(tid >> 6), c16 = lane & 15, quad = lane >> 4;
    constexpr int SP = 272;
    LAS float* GT = (LAS float*)(lds + 64 * SP);
    bf16x8 bfr[4][4];
#pragma unroll
    for (int ct = 0; ct < 4; ++ct)
#pragma unroll
        for (int s = 0; s < 4; ++s) { const float* gp = P.gup + (size_t)(32 * s + 8 * quad) * 512 + 64 * h + 16 * ct + c16;
            v4u w; w.x = pk2(gp[0], gp[512]); w.y = pk2(gp[1024], gp[1536]); w.z = pk2(gp[2048], gp[2560]); w.w = pk2(gp[3072], gp[3584]); bfr[ct][s] = __builtin_bit_cast(bf16x8, w); }
    float muv[4], lnw[4], lnb[4];
#pragma unroll
    for (int ct = 0; ct < 4; ++ct) { const int ch = 64 * h + 16 * ct + c16; muv[ct] = P.mu[1024 + ch]; lnw[ct] = P.lnw[ch]; lnb[ct] = P.lnb[ch]; }
    const int stok = tid >> 3, sseg = tid & 7;
#pragma unroll 1
    for (int m0 = blockIdx.x * 64; m0 < M; m0 += gridDim.x * 64) {
        {   const size_t m = (size_t)m0 + stok; const int t = (int)(m & (T - 1));
            float gv[16], pv[16];
            { const v4u a = *(const GAS v4u*)(P.ZR + m * ZP + ZC_GC + 16 * sseg), c = *(const GAS v4u*)(P.ZR + m * ZP + ZC_GC + 16 * sseg + 8);
              gv[0] = bflo(a.x); gv[1] = bfhi(a.x); gv[2] = bflo(a.y); gv[3] = bfhi(a.y); gv[4] = bflo(a.z); gv[5] = bfhi(a.z); gv[6] = bflo(a.w); gv[7] = bfhi(a.w);
              gv[8] = bflo(c.x); gv[9] = bfhi(c.x); gv[10] = bflo(c.y); gv[11] = bfhi(c.y); gv[12] = bflo(c.z); gv[13] = bfhi(c.z); gv[14] = bflo(c.w); gv[15] = bfhi(c.w); }
            if (t > 0) { const v4u a = *(const GAS v4u*)(P.ZR + (m - 1) * ZP + ZC_GC + 16 * sseg), c = *(const GAS v4u*)(P.ZR + (m - 1) * ZP + ZC_GC + 16 * sseg + 8);
              pv[0] = bflo(a.x); pv[1] = bfhi(a.x); pv[2] = bflo(a.y); pv[3] = bfhi(a.y); pv[4] = bflo(a.z); pv[5] = bfhi(a.z); pv[6] = bflo(a.w); pv[7] = bfhi(a.w);
              pv[8] = bflo(c.x); pv[9] = bfhi(c.x); pv[10] = bflo(c.y); pv[11] = bfhi(c.y); pv[12] = bflo(c.z); pv[13] = bfhi(c.z); pv[14] = bflo(c.w); pv[15] = bfhi(c.w); }
            else {
#pragma unroll
              for (int e = 0; e < 16; ++e) pv[e] = 0.f; }
            float sg[16];
#pragma unroll
            for (int e = 0; e < 16; ++e) { const float mu = P.mu[1664 + 16 * sseg + e]; sg[e] = sigm(gv[e] + (pv[e] - gv[e]) * mu); }
            v4u o0, o1; o0.x = pk2(sg[0], sg[1]); o0.y = pk2(sg[2], sg[3]); o0.z = pk2(sg[4], sg[5]); o0.w = pk2(sg[6], sg[7]); o1.x = pk2(sg[8], sg[9]); o1.y = pk2(sg[10], sg[11]); o1.z = pk2(sg[12], sg[13]); o1.w = pk2(sg[14], sg[15]);
            *(LAS v4u*)(lds + stok * SP + 32 * sseg) = o0; *(LAS v4u*)(lds + stok * SP + 32 * sseg + 16) = o1;
        }
        __syncthreads();
#pragma unroll 1
        for (int rt = 0; rt < 4; ++rt) {
            f32x4 acc[4];
#pragma unroll
            for (int ct = 0; ct < 4; ++ct) acc[ct] = (f32x4){0.f, 0.f, 0.f, 0.f};
#pragma unroll
            for (int s = 0; s < 4; ++s) { const bf16x8 af = *(const LAS bf16x8*)(lds + (16 * rt + c16) * SP + (32 * s + 8 * quad) * 2);
#pragma unroll
                for (int ct = 0; ct < 4; ++ct) acc[ct] = __builtin_amdgcn_mfma_f32_16x16x32_bf16(af, bfr[ct][s], acc[ct], 0, 0, 0); }
#pragma unroll
            for (int ct = 0; ct < 4; ++ct)
#pragma unroll
                for (int j = 0; j < 4; ++j) GT[(4 * quad + j) * 512 + 64 * h + 16 * ct + c16] = acc[ct][j];
            __syncthreads();
            {   const int vtok = tid >> 5, vseg = tid & 31, ch0 = 16 * vseg, vh = vseg >> 2;
                const size_t m = (size_t)m0 + 16 * rt + vtok; const int t = (int)(m & (T - 1));
                float y[16], vv[16], vp[16], g[16];
                { const v4u a = *(const GAS v4u*)(P.yraw + m * 512 + ch0), c = *(const GAS v4u*)(P.yraw + m * 512 + ch0 + 8);
                  y[0] = bflo(a.x); y[1] = bfhi(a.x); y[2] = bflo(a.y); y[3] = bfhi(a.y); y[4] = bflo(a.z); y[5] = bfhi(a.z); y[6] = bflo(a.w); y[7] = bfhi(a.w);
                  y[8] = bflo(c.x); y[9] = bfhi(c.x); y[10] = bflo(c.y); y[11] = bfhi(c.y); y[12] = bflo(c.z); y[13] = bfhi(c.z); y[14] = bflo(c.w); y[15] = bfhi(c.w); }
                { const v4u a = *(const GAS v4u*)(P.ZR + m * ZP + ZC_RV + ch0), c = *(const GAS v4u*)(P.ZR + m * ZP + ZC_RV + ch0 + 8);
                  vv[0] = bflo(a.x); vv[1] = bfhi(a.x); vv[2] = bflo(a.y); vv[3] = bfhi(a.y); vv[4] = bflo(a.z); vv[5] = bfhi(a.z); vv[6] = bflo(a.w); vv[7] = bfhi(a.w);
                  vv[8] = bflo(c.x); vv[9] = bfhi(c.x); vv[10] = bflo(c.y); vv[11] = bfhi(c.y); vv[12] = bflo(c.z); vv[13] = bfhi(c.z); vv[14] = bflo(c.w); vv[15] = bfhi(c.w); }
                if (t > 0) { const v4u a = *(const GAS v4u*)(P.ZR + (m - 1) * ZP + ZC_RV + ch0), c = *(const GAS v4u*)(P.ZR + (m - 1) * ZP + ZC_RV + ch0 + 8);
                  vp[0] = bflo(a.x); vp[1] = bfhi(a.x); vp[2] = bflo(a.y); vp[3] = bfhi(a.y); vp[4] = bflo(a.z); vp[5] = bfhi(a.z); vp[6] = bflo(a.w); vp[7] = bfhi(a.w);
                  vp[8] = bflo(c.x); vp[9] = bfhi(c.x); vp[10] = bflo(c.y); vp[11] = bfhi(c.y); vp[12] = bflo(c.z); vp[13] = bfhi(c.z); vp[14] = bflo(c.w); vp[15] = bfhi(c.w); }
                else {
#pragma unroll
                  for (int e = 0; e < 16; ++e) vp[e] = 0.f; }
#pragma unroll
                for (int e4 = 0; e4 < 4; ++e4) { const f32x4 gq = *(const LAS f32x4*)(GT + vtok * 512 + ch0 + 4 * e4); g[4 * e4] = gq.x; g[4 * e4 + 1] = gq.y; g[4 * e4 + 2] = gq.z; g[4 * e4 + 3] = gq.w; }
                float sm = 0.f;
#pragma unroll
                for (int e = 0; e < 16; ++e) sm += y[e];
                sm = scan::dpp_add<0xB1>(sm); sm = scan::dpp_add<0x4E>(sm);
                const float mean = sm * (1.f / 64.f); float vs = 0.f;
#pragma unroll
                for (int e = 0; e < 16; ++e) { y[e] -= mean; vs += y[e] * y[e]; }
                vs = scan::dpp_add<0xB1>(vs); vs = scan::dpp_add<0x4E>(vs);
                const float rstd = __builtin_amdgcn_rsqf(vs * (1.f / 64.f) + 64e-5f);
                const float rk = P.rdotk[m * 8 + vh];
                unsigned ow[8];
#pragma unroll
                for (int e = 0; e < 16; e += 2) { float o2[2];
#pragma unroll
                    for (int d = 0; d < 2; ++d) { const int ch = ch0 + e + d; const float v = vv[e + d] + (vp[e + d] - vv[e + d]) * P.mu[1024 + ch];
                        o2[d] = (y[e + d] * rstd * P.lnw[ch] + P.lnb[ch] + rk * v) * g[e + d]; }
                    ow[e >> 1] = pk2(o2[0], o2[1]); }
                *(GAS v4u*)(P.Q3 + m * QP + 512 + ch0) = (v4u){ow[0], ow[1], ow[2], ow[3]}; *(GAS v4u*)(P.Q3 + m * QP + 512 + ch0 + 8) = (v4u){ow[4], ow[5], ow[6], ow[7]};
            }
            __syncthreads();
        }
        __syncthreads();
    }
}
struct DPostP { const bf16* O1; const bf16* O2; bf16* Q3; const float *lq1, *lk1, *lq2, *lk2, *subln; float lambda_init; };
__device__ __forceinline__ void diff_post(const DPostP& P, int gw, int NGW, int lane) {
    const float lam = __expf(wave_sum(P.lq1[lane] * P.lk1[lane])) - __expf(wave_sum(P.lq2[lane] * P.lk2[lane])) + P.lambda_init;
    const float s0 = P.subln[2 * lane] * (1.f - P.lambda_init), s1 = P.subln[2 * lane + 1] * (1.f - P.lambda_init);
    for (int it = gw; it < M * 4; it += NGW) {
        const size_t m = (size_t)(it >> 2); const int hh = it & 3;
        const unsigned a = *(const GAS unsigned*)(P.O1 + m * 512 + 128 * hh + 2 * lane), c = *(const GAS unsigned*)(P.O2 + m * 512 + 128 * hh + 2 * lane);
        const float x0 = bflo(a) - lam * bflo(c), x1 = bfhi(a) - lam * bfhi(c);
        const float r = __builtin_amdgcn_rsqf(wave_sum(x0 * x0 + x1 * x1) * (1.f / 128.f) + NORM_EPS);
        *(GAS unsigned*)(P.Q3 + m * QP + 1024 + 128 * hh + 2 * lane) = pk2(x0 * r * s0, x1 * r * s1);
    }
}

__device__ __forceinline__ int q_fetch(gu32* head, volatile LAS int* slot) {
    if (threadIdx.x == 0) *slot = (int)__hip_atomic_fetch_add(head, 1u, RLX_AGENT);
    __syncthreads();
    const int v = __builtin_amdgcn_readfirstlane(*slot);
    __syncthreads();
    return v;
}

struct Args { const float* in[32]; float* out; unsigned char* ws; int ph_lo, ph_hi; };
__device__ __forceinline__ const float* kin_(int i) { const char* ka = (const char*)__builtin_amdgcn_kernarg_segment_ptr(); unsigned off = (unsigned)i * 8u; asm volatile("" : "+s"(off)); return *(const float* const*)(ka + off); }
#define KIN(i) kin_(i)
#define XOUT ((float*)kin_(32))
__device__ __forceinline__ unsigned char* kws_() { return (unsigned char*)kin_(33); }
__device__ __forceinline__ int kint_(int byteoff) { const char* ka = (const char*)__builtin_amdgcn_kernarg_segment_ptr(); unsigned off = (unsigned)byteoff; asm volatile("" : "+s"(off)); return *(const int*)(ka + off); }
constexpr int PH_L = 14;
constexpr int N_PHASES = 1 + NLAYER * PH_L;

#define G ((int)gridDim.x)
#define bid ((int)blockIdx.x)
#define gw (bid * NWAVES + wave)
#define NGW (G * NWAVES)
#define MISC ((volatile LAS unsigned*)(lds + LDS_MISC))
#define IN(k) (kint_(272) <= (k) && (k) < kint_(276))
#define SEAM(k) do { if ((k) + 1 < kint_(276)) { XcdBarrier bar_; bar_.bar = (unsigned*)(kws_() + WS_CTL) + CW_BAR; bar_.x = xb_xcc_id(); bar_.st = MISC + 8; xcd_barrier(bar_); } } while (0)
#define WSL() unsigned char* wsl = kws_(); const int tid = otid_(), lane = tid & 63, wave = __builtin_amdgcn_readfirstlane(tid >> 6); (void)lane; (void)wave
#define WFu ((bf16*)(wsl + WS_WF))
#define WFd ((bf16*)(wsl + WS_WF_DOWN))
#define WMi ((bf16*)(wsl + WS_WM))
#define WMb ((bf16*)(wsl + WS_WM_BR))
#define WMo ((bf16*)(wsl + WS_WM_OUT))
#define XN ((bf16*)(wsl + WS_XN))
#define Q3 ((bf16*)(wsl + WS_Q3))
#define ZR ((bf16*)(wsl + WS_ZR))
#define YP ((bf16*)(wsl + WS_R2))
#define HB ZR
#define G3 ZR
#define MG ((bf16*)(wsl + WS_MG))
#define O1 ((bf16*)(wsl + WS_R2))
#define O2 ((bf16*)(wsl + WS_R2) + (size_t)M * 512)
#define YRAW ((bf16*)(wsl + WS_YRAW))
#define BITM ((unsigned*)(wsl + WS_BITM))
#define RDOTK ((float*)(wsl + WS_RDOTK))
#define X1B ((bf16*)(wsl + WS_X1))
#define KID ((bf16*)(wsl + WS_KID))
#define A8B ((unsigned char*)(wsl + WS_A8))
#define CTL ((gu32*)(wsl + WS_CTL))
#define cscr ((LAS float*)(lds + wave * 16384))

#define CONV_FFN(l_, f_) do { const int gi_ = (f_) ? 29 : 3; \
        MapUp mu_{KIN(gi_) + (size_t)(l_) * DM * FF, KIN(gi_ + 1) + (size_t)(l_) * DM * FF, FF}; MapIdent md_{KIN(gi_ + 2) + (size_t)(l_) * FF * DM, DM}; \
        constexpr int nu_ = conv_items(DM, 2 * FF), nd_ = conv_items(FF, DM); \
        for (int it_ = gw; it_ < nu_ + nd_; it_ += NGW) { if (it_ < nu_) conv_item(mu_, DM, WFu, cscr, it_, 2 * FF / 32, lane); else conv_item(md_, FF, WFd, cscr, it_ - nu_, DM / 32, lane); } } while (0)
#define CONV_MIX(l_) do { MapWin mw_{KIN(8) + (size_t)(l_) * DM * NIN, NIN}; MapIdent mo_{KIN(26) + (size_t)(l_) * DM * DM, DM}; \
        constexpr int ni_ = conv_items(DM, 8704), nb_ = conv_items(512, DM), no_ = conv_items(DM, DM); \
        for (int it_ = gw; it_ < ni_ + 3 * nb_ + no_; it_ += NGW) { \
            if (it_ < ni_) conv_item(mw_, DM, WMi, cscr, it_, 8704 / 32, lane); \
            else if (it_ < ni_ + 3 * nb_) { const int r_ = it_ - ni_, n_ = r_ / nb_; MapIdent mb_{KIN(25) + ((size_t)(l_) * 3 + n_) * 512 * DM, DM}; conv_item(mb_, 512, WMb + (size_t)n_ * DM * 512, cscr, r_ - n_ * nb_, DM / 32, lane); } \
            else conv_item(mo_, DM, WMo, cscr, it_ - ni_ - 3 * nb_, DM / 32, lane); } } while (0)

template <int L, int F> __device__ __forceinline__ void ffn_part(LAS unsigned char* lds) {
    constexpr int l = L, f = F, pb = 1 + PH_L * L, pf = pb + (F ? 11 : 0);
            if (IN(pf + 0)) { WSL();
                pg8::Gemm g{XN, WFu, M, 2 * FF, DM, DM}; pg8::StaticOrder S; S.init(M, 2 * FF, G, bid);
                pg8::EpiSwiGLU E{HB, FF};
                pg8::gemm_phase<pg8::EpiSwiGLU, pg8::StaticOrder, true, true>(lds, g, S, E);
                SEAM(pf + 0);
            }
            if (IN(pf + 1)) { WSL();
                pg8::Gemm g{HB, WFd, M, DM, FF, FF}; pg8::StaticOrder S; S.init(M, DM, G, bid);
                pg8::EpiStore<0> E{YP, DM, YP, DM, 1 << 30};
                pg8::gemm_phase<pg8::EpiStore<0>, pg8::StaticOrder, true, true>(lds, g, S, E);
                SEAM(pf + 1);
            }
            if (IN(pf + 2)) { WSL();
                const float* base = (l == 0 && f == 0) ? KIN(0) : XOUT;
                const float* gpost = KIN(f ? 28 : 2) + l * DM;
                const float* gnext = f == 0 ? KIN(6) + l * DM : (l + 1 < NLAYER ? KIN(1) + (l + 1) * DM : nullptr);
#if PROBE
                float osc = 1.f;
                if (l == NLAYER - 1 && f == 1) { const float num = *(const float*)(wsl + WS_CTL + 4 * CW_PROBE), den = *(const float*)(wsl + WS_CTL + 4 * (CW_PROBE + 1)); osc = 1.f + 4.f * sqrtf(num / fmaxf(den, 1e-30f)); }
                rownorm_rows(base, YP, 0.5f, gpost, XOUT, gnext, gnext ? XN : nullptr, gw, NGW, lane, osc);
#else
                rownorm_rows(base, YP, 0.5f, gpost, XOUT, gnext, gnext ? XN : nullptr, gw, NGW, lane);
#endif
                if (f == 1 && l + 1 < NLAYER) { CONV_FFN(l + 1, 0); CONV_MIX(l + 1); }
                SEAM(pf + 2);
            }
}
template <int L> __device__ __forceinline__ void mixer_part(LAS unsigned char* lds, unsigned char* lds_) {
    constexpr int l = L, pb = 1 + PH_L * L;
            const int pm = pb + 3;
            if (IN(pm + 0)) { WSL();
                pg8::Gemm g{XN, WMi, M, 5632, DM, DM}; pg8::StaticOrder S; S.init(M, 5632, G, bid);
                pg8::EpiStore<0> E{Q3, QP, ZR, ZP, 6};
                pg8::gemm_phase<pg8::EpiStore<0>, pg8::StaticOrder, true, true>(lds, g, S, E);
                SEAM(pm + 0);
            }
            if (IN(pm + 1)) { WSL();
                PrepP pp{ZR, X1B, A8B, KID, KIN(9) + l * 1792, KIN(10) + l * 512, KIN(11) + l * 64 * 512, KIN(12) + l * 512, KIN(13) + l * 64 * 512};
                rwkv_prep(pp, lds);
                SEAM(pm + 1);
            }
            if (IN(pm + 2)) { WSL();
                volatile LAS int* slot = (volatile LAS int*)(MISC + 16);
                if (bid < 64) {
                    ScanP sp{Q3, ZR, X1B, A8B, YRAW, RDOTK, KIN(9) + l * 1792, KIN(15) + l * 512, KIN(16) + l * 512, KIN(17) + l * 512};
#ifndef NO_SCAN
                    rwkv_scan_unit(sp, bid, lds);
#ifdef SCAN_TWICE
                    rwkv_scan_unit(sp, bid, lds);
#endif
#endif
                }
                {
                    Dsa1P dp{ZR, KID, BITM, CTL + CW_DONE + 64 * 64 * l};
                    gu32* head = CTL + CW_Q + 64 * (3 * l + 0);
                    #ifndef NO_DSA1
                    for (int u = q_fetch(head, slot); u < 512; u = q_fetch(head, slot)) dsa1_unit(dp, u, lds);
#ifdef DUP_DSA1
                    { gu32* head2 = CTL + 10240 + 64 * (2 * l + 0); for (int u = q_fetch(head2, slot); u < 512; u = q_fetch(head2, slot)) dsa1_unit(dp, u, lds); }
#endif
#endif
                }
                {
                    gu32* head = CTL + CW_Q + 64 * (3 * l + 1);
                    typedef att::BlockRef<att::bf16, att::bf16> Ref;
#define DSA2_REF(i_, r_) do { const int qb_ = 31 - ((i_) >> 3), b_ = ((i_) >> 2) & 1, h_ = (i_) & 3; const size_t row_ = (size_t)b_ * T + 256 * qb_; \
        r_.Q = (const att::bf16*)(Q3 + row_ * QP + 128 * h_); r_.O = (att::bf16*)(Q3 + row_ * QP + 128 * h_); r_.K = (const att::bf16*)(ZR + (size_t)b_ * T * ZP + ZC_DK + 128 * h_); \
        r_.V = (const att::bf16*)(ZR + (size_t)b_ * T * ZP + ZC_DV + 128 * h_); r_.P0 = 256 * qb_; r_.koff = 0; r_.mask = BITM + row_ * 256; } while (0)
                    int ic = q_fetch(head, slot);
                    if (ic < 256) {
                        int in_ = q_fetch(head, slot);
                        Ref cur; DSA2_REF(ic, cur);
                        att::Seam<att::bf16> S;
                        att::causal_swa_prime<att::bf16, att::bf16, false>(cur, T, (char*)lds_, S);
                        for (;;) {
                            const bool last = in_ >= 256;
                            Ref nxt = cur; if (!last) DSA2_REF(in_, nxt);
                            {
                                if (tid == 0) { gu32* dw = CTL + CW_DONE + 64 * (64 * l + (((ic >> 2) & 1) * 32 + (31 - (ic >> 3)))); unsigned sp = 0;
                                    while (__hip_atomic_load(dw, RLX_AGENT) < 8u) { __builtin_amdgcn_s_sleep(2); if (++sp > (1u << 24)) { __hip_atomic_store(CTL + CW_TMO, 1u, RLX_AGENT); break; } }
                                    __builtin_amdgcn_fence(__ATOMIC_ACQUIRE, "agent"); asm volatile("s_waitcnt vmcnt(0)" ::: "memory"); }
                                __syncthreads();
                            }
#ifndef NO_DSA2
                            att::causal_swa_block<att::bf16, att::bf16, false, true, QP>(cur, nxt, T, T, (char*)lds_, S);
#endif
                            if (last) break;
                            cur = nxt; ic = in_; in_ = q_fetch(head, slot);
                        }
                    }
                }
                {
#ifdef DUP_DIFF
                  for (int rep_ = 0; rep_ < 2; ++rep_) {
                    gu32* head = rep_ ? CTL + 10240 + 64 * (2 * l + 1) : CTL + CW_Q + 64 * (3 * l + 2);
#else
                  {
                    gu32* head = CTL + CW_Q + 64 * (3 * l + 2);
#endif
                    typedef att::BlockRef<att::bf16, att::bf16> Ref;
#define DIFF_REF(i_, r_) do { const int qb_ = 31 - ((i_) >> 4), b_ = ((i_) >> 3) & 1, h_ = ((i_) >> 1) & 3, mp_ = (i_) & 1; const size_t row_ = (size_t)b_ * T + 256 * qb_; \
        r_.Q = (const att::bf16*)(Q3 + row_ * QP + 1024 + 128 * h_ + 64 * mp_); r_.O = (att::bf16*)((mp_ ? O2 : O1) + row_ * 512 + 128 * h_); \
        r_.K = (const att::bf16*)(ZR + (size_t)b_ * T * ZP + ZC_FK + 128 * h_); r_.V = (const att::bf16*)(ZR + (size_t)b_ * T * ZP + ZC_FV + 128 * h_); r_.P0 = 256 * qb_; r_.koff = 128 * mp_; r_.mask = nullptr; } while (0)
                    int ic = q_fetch(head, slot);
                    if (ic < 512) {
                        int in_ = q_fetch(head, slot);
                        Ref cur; DIFF_REF(ic, cur);
                        att::Seam<att::bf16> S;
                        att::causal_swa_prime<att::bf16, att::bf16, true>(cur, T, (char*)lds_, S);
                        for (;;) {
                            const bool last = in_ >= 512;
                            Ref nxt = cur; if (!last) DIFF_REF(in_, nxt);
#ifndef NO_DIFF
                            att::causal_swa_block<att::bf16, att::bf16, true, false, 512>(cur, nxt, T, T, (char*)lds_, S);
#endif
                            if (last) break;
                            cur = nxt; ic = in_; in_ = q_fetch(head, slot);
                        }
                    }
                  }
                }
                SEAM(pm + 2);
            }
            if (IN(pm + 3)) { WSL();
                RPostP rp{ZR, Q3, YRAW, RDOTK, KIN(9) + l * 1792, KIN(14) + l * 128 * 512, KIN(18) + l * 512, KIN(19) + l * 512};
#ifndef NO_RPOST
                rwkv_post(rp, lds);
#endif
                constexpr float lambda_init = L == 0 ? 0.2f : 0.35550906759096927f;
                DPostP dq{O1, O2, Q3, KIN(20) + l * 64, KIN(21) + l * 64, KIN(22) + l * 64, KIN(23) + l * 64, KIN(24) + l * 128, lambda_init};
                diff_post(dq, gw, NGW, lane);
                rownorm_rows(XOUT, nullptr, 0.f, nullptr, nullptr, KIN(6) + l * DM, XN, gw, NGW, lane);
                SEAM(pm + 3);
            }
            if (IN(pm + 4)) { WSL();
                pg8::Gemm g{XN, WMi + (size_t)5632 * DM, M, 3072, DM, DM}; pg8::StaticOrder S; S.init(M, 3072, G, bid);
#ifdef GATE_RAW
                pg8::EpiStore<0> E{G3, 3072, G3, 3072, 1 << 30};
                pg8::gemm_phase<pg8::EpiStore<0>, pg8::StaticOrder, true, true>(lds, g, S, E);
#else
                pg8::EpiStore<1> E{G3, 3072, G3, 3072, 1 << 30};
                pg8::gemm_phase<pg8::EpiStore<1>, pg8::StaticOrder, true, true>(lds, g, S, E);
#endif
                SEAM(pm + 4);
            }
            if (IN(pm + 5)) { WSL();
#pragma unroll 1
                for (int n = 0; n < 3; ++n) {
                    pg8::Gemm g{Q3 + 512 * n, WMb + (size_t)n * DM * 512, M, DM, 512, QP}; pg8::StaticOrder S; S.init(M, DM, G, bid);
                    pg8::EpiGateMul E{MG, DM, G3 + 1024 * n, 3072, n == 0 ? 1 : 0};
                    pg8::gemm_phase<pg8::EpiGateMul, pg8::StaticOrder, false, true>(lds, g, S, E);
                    VM_WAIT(); __syncthreads();
                }
                SEAM(pm + 5);
            }
            if (IN(pm + 6)) { WSL();
                pg8::Gemm g{MG, WMo, M, DM, DM, DM}; pg8::StaticOrder S; S.init(M, DM, G, bid);
                pg8::EpiStore<0> E{YP, DM, YP, DM, 1 << 30};
                pg8::gemm_phase<pg8::EpiStore<0>, pg8::StaticOrder, false, true>(lds, g, S, E);
                SEAM(pm + 6);
            }
            if (IN(pm + 7)) { WSL();
                rownorm_rows(XOUT, YP, 1.0f, KIN(7) + l * DM, XOUT, KIN(27) + l * DM, XN, gw, NGW, lane);
                CONV_FFN(l, 1);
                SEAM(pm + 7);
            }
}

__global__ void __launch_bounds__(NWAVES * 64, 2) mk_fwd(Args args) {
    extern __shared__ __attribute__((aligned(16))) unsigned char lds_[];
    LAS unsigned char* lds = (LAS unsigned char*)lds_;
    { const int tid = otid_(); if (tid < 64) MISC[tid] = 0u; }
    __syncthreads();
    (void)xcd_barrier_post((unsigned*)(kws_() + WS_CTL) + CW_BAR, MISC + 8);
    if (IN(0)) { WSL();
        CONV_FFN(0, 0); CONV_MIX(0);
        rownorm_rows(KIN(0), nullptr, 0.f, nullptr, nullptr, KIN(1), XN, gw, NGW, lane);
        SEAM(0);
    }
    ffn_part<0, 0>(lds); mixer_part<0>(lds, lds_); ffn_part<0, 1>(lds);
    ffn_part<1, 0>(lds); mixer_part<1>(lds, lds_); ffn_part<1, 1>(lds);
}

#if PROBE
__device__ __forceinline__ void probe_acc(float num, float den, float* ctlf) {
    __shared__ float rn[256], rd[256];
    rn[threadIdx.x] = num; rd[threadIdx.x] = den; __syncthreads();
    for (int o = 128; o > 0; o >>= 1) { if ((int)threadIdx.x < o) { rn[threadIdx.x] += rn[threadIdx.x + o]; rd[threadIdx.x] += rd[threadIdx.x + o]; } __syncthreads(); }
    if (threadIdx.x == 0) { atomicAdd(ctlf + CW_PROBE, rn[0]); atomicAdd(ctlf + CW_PROBE + 1, rd[0]); }
}
__global__ void __launch_bounds__(256) probe_ffn(const unsigned char* ws, const float* Wg, const float* Wu, const float* Wd) {
    __shared__ float xn[1024]; __shared__ float hid[2816];
    const int m = 777 + 1931 * blockIdx.x, tid = threadIdx.x;
    const bf16* XNp = (const bf16*)(ws + WS_XN); const bf16* YPp = (const bf16*)(ws + WS_R2);
    for (int k = tid; k < 1024; k += 256) xn[k] = bf1(XNp[(size_t)m * 1024 + k]);
    __syncthreads();
    for (int j = tid; j < 2816; j += 256) { float g = 0.f, u = 0.f; for (int k = 0; k < 1024; ++k) { g += xn[k] * Wg[(size_t)k * 2816 + j]; u += xn[k] * Wu[(size_t)k * 2816 + j]; } hid[j] = g / (1.f + expf(-g)) * u; }
    __syncthreads();
    float num = 0.f, den = 0.f;
    for (int d = tid; d < 1024; d += 256) { float o = 0.f; for (int j = 0; j < 2816; ++j) o += hid[j] * Wd[(size_t)j * 1024 + d]; const float got = bf1(YPp[(size_t)m * 1024 + d]); num += (o - got) * (o - got); den += o * o; }
    probe_acc(num, den, (float*)(ws + WS_CTL));
}
__global__ void __launch_bounds__(256) probe_win(const unsigned char* ws, const float* Win) {
    __shared__ float xn[1024];
    const int m = 555 + 1999 * blockIdx.x, tid = threadIdx.x;
    const bf16* XNp = (const bf16*)(ws + WS_XN); const bf16* Q3p = (const bf16*)(ws + WS_Q3); const bf16* ZRp = (const bf16*)(ws + WS_ZR);
    for (int k = tid; k < 1024; k += 256) xn[k] = bf1(XNp[(size_t)m * 1024 + k]);
    __syncthreads();
    float num = 0.f, den = 0.f;
    for (int c = tid; c < 5448; c += 256) {
        float z = 0.f; for (int k = 0; k < 1024; ++k) z += xn[k] * Win[(size_t)k * NIN + c];
        float got;
        if (c < 512) got = bf1(Q3p[(size_t)m * QP + c]);
        else if (c < 2120) got = bf1(ZRp[(size_t)m * ZP + (c - 512)]);
        else if (c < 2632) got = bf1(Q3p[(size_t)m * QP + 512 + (c - 2120)]);
        else if (c < 3912) got = bf1(ZRp[(size_t)m * ZP + (c - 840)]);
        else if (c < 4424) got = bf1(Q3p[(size_t)m * QP + 1024 + (c - 3912)]);
        else got = bf1(ZRp[(size_t)m * ZP + (c - 1352)]);
        num += (z - got) * (z - got); den += z * z;
    }
    probe_acc(num, den, (float*)(ws + WS_CTL));
}
__global__ void __launch_bounds__(256) probe_wconv(const unsigned char* ws, const float* Win, int r0) {
    const bf16* WMp = (const bf16*)(ws + WS_WM); const int tid = threadIdx.x;
    float num = 0.f, den = 0.f;
    for (int rr = 0; rr < 64; ++rr) { const int n = r0 + 64 * blockIdx.x + rr; MapWin mw{Win, NIN}; const float* cp = mw.col(n);
        for (int k = tid; k < 1024; k += 256) { const float ref = cp ? cp[(size_t)k * NIN] : 0.f; const float got = bf1(WMp[(size_t)n * 1024 + k]); num += (ref - got) * (ref - got); den += ref * ref; } }
    probe_acc(num, den, (float*)(ws + WS_CTL));
}
__global__ void __launch_bounds__(256) probe_merge(const unsigned char* ws, const float* Win, const float* Wb, const float* Wo, int which) {
    __shared__ float xn[1024]; __shared__ float y[1536]; __shared__ float mg[1024];
    const int m = 333 + 2003 * blockIdx.x, tid = threadIdx.x;
    const bf16* XNp = (const bf16*)(ws + WS_XN); const bf16* Q3p = (const bf16*)(ws + WS_Q3); const bf16* MGp = (const bf16*)(ws + WS_MG); const bf16* YPp = (const bf16*)(ws + WS_R2);
    for (int k = tid; k < 1024; k += 256) xn[k] = bf1(XNp[(size_t)m * 1024 + k]);
    for (int k = tid; k < 1536; k += 256) y[k] = bf1(Q3p[(size_t)m * QP + k]);
    __syncthreads();
    float num = 0.f, den = 0.f;
    for (int d = tid; d < 1024; d += 256) {
        float acc = 0.f;
        for (int n = 0; n < 3; ++n) { float g = 0.f; for (int k = 0; k < 1024; ++k) g += xn[k] * Win[(size_t)k * NIN + 5448 + n * 1024 + d];
            float p = 0.f; for (int c = 0; c < 512; ++c) p += y[512 * n + c] * Wb[((size_t)n * 512 + c) * 1024 + d];
            acc += p / (1.f + expf(-g)); }
        mg[d] = acc; const float got = bf1(MGp[(size_t)m * 1024 + d]); if (which == 0) { num += (acc - got) * (acc - got); den += acc * acc; }
        if (which == 2) { const bf16* G3p = (const bf16*)(ws + WS_ZR); for (int n = 0; n < 3; ++n) { float g = 0.f; for (int k = 0; k < 1024; ++k) g += xn[k] * Win[(size_t)k * NIN + 5448 + n * 1024 + d];
            const float sg = 1.f / (1.f + expf(-g)), gg = bf1(G3p[(size_t)m * 3072 + n * 1024 + d]); num += (sg - gg) * (sg - gg); den += sg * sg; } }
        if (which == 3) { const bf16* G3p = (const bf16*)(ws + WS_ZR); float a2 = 0.f; for (int n = 0; n < 3; ++n) { float p = 0.f; for (int c = 0; c < 512; ++c) p += y[512 * n + c] * Wb[((size_t)n * 512 + c) * 1024 + d];
            a2 += p * bf1(G3p[(size_t)m * 3072 + n * 1024 + d]); } num += (a2 - got) * (a2 - got); den += a2 * a2; }
    }
    __syncthreads();
    if (which == 1) for (int d = tid; d < 1024; d += 256) { float o = 0.f; for (int j = 0; j < 1024; ++j) o += mg[j] * Wo[(size_t)j * 1024 + d]; const float got = bf1(YPp[(size_t)m * 1024 + d]); num += (o - got) * (o - got); den += o * o; }
    probe_acc(num, den, (float*)(ws + WS_CTL));
}
#endif
#ifndef MK_ONE_LAUNCH
#define MK_ONE_LAUNCH 0
#endif
extern "C" void kernel_launch(void* const* d_in, const int* in_sizes, int n_in, void* d_out, int out_size, void* d_ws, size_t ws_size, hipStream_t stream) {
    static int grid = 0;
    if (grid == 0) {
        if (n_in != 32 || in_sizes[0] != M * DM || out_size != M * DM || ws_size < WS_END) { fprintf(stderr, "kernel_launch: unexpected shapes / workspace (n_in %d, ws %zu)\n", n_in, ws_size); grid = -1; return; }
        int dev = 0, cus = 0;
        if (hipGetDevice(&dev) != hipSuccess || hipDeviceGetAttribute(&cus, hipDeviceAttributeMultiprocessorCount, dev) != hipSuccess) { grid = -1; return; }
        if (hipFuncSetAttribute((const void*)mk_fwd, hipFuncAttributeMaxDynamicSharedMemorySize, LDS_BYTES) != hipSuccess) { fprintf(stderr, "kernel_launch: hipFuncSetAttribute failed\n"); grid = -1; return; }
        int per_cu = 0;
        if (hipOccupancyMaxActiveBlocksPerMultiprocessor(&per_cu, (const void*)mk_fwd, NWAVES * 64, LDS_BYTES) != hipSuccess || per_cu < 1) { fprintf(stderr, "kernel_launch: occupancy query says %d\n", per_cu); }
        (void)hipGetLastError();
        grid = cus;
    }
    if (grid < 0) return;
    (void)hipMemsetAsync((char*)d_ws + WS_CTL, 0, CTL_ZERO_BYTES, stream);
    Args a{};
    for (int i = 0; i < 32; ++i) a.in[i] = (const float*)d_in[i];
    a.out = (float*)d_out; a.ws = (unsigned char*)d_ws;
#if MK_ONE_LAUNCH
    a.ph_lo = 0; a.ph_hi = N_PHASES;
    hipLaunchKernelGGL(mk_fwd, dim3(grid), dim3(NWAVES * 64), LDS_BYTES, stream, a);
#else
    for (int p = 0; p < N_PHASES; ++p) { a.ph_lo = p; a.ph_hi = p + 1; hipLaunchKernelGGL(mk_fwd, dim3(grid), dim3(NWAVES * 64), LDS_BYTES, stream, a);
#if PROBE == 1
        if (p == 2) hipLaunchKernelGGL(probe_ffn, dim3(8), dim3(256), 0, stream, (const unsigned char*)d_ws, a.in[3], a.in[4], a.in[5]);
#elif PROBE == 2
        if (p == 4) hipLaunchKernelGGL(probe_win, dim3(8), dim3(256), 0, stream, (const unsigned char*)d_ws, a.in[8]);
#elif PROBE == 3
        if (p == 8) hipLaunchKernelGGL(probe_merge, dim3(8), dim3(256), 0, stream, (const unsigned char*)d_ws, a.in[8], a.in[25], a.in[26], 0);
#elif PROBE == 5
        if (p == 8) hipLaunchKernelGGL(probe_merge, dim3(8), dim3(256), 0, stream, (const unsigned char*)d_ws, a.in[8], a.in[25], a.in[26], 2);
#elif PROBE == 6
        if (p == 8) hipLaunchKernelGGL(probe_merge, dim3(8), dim3(256), 0, stream, (const unsigned char*)d_ws, a.in[8], a.in[25], a.in[26], 3);
#elif PROBE == 7
        if (p == 6) hipLaunchKernelGGL(probe_wconv, dim3(48), dim3(256), 0, stream, (const unsigned char*)d_ws, a.in[8], 5632);
#elif PROBE == 8
        if (p == 3) hipLaunchKernelGGL(probe_wconv, dim3(48), dim3(256), 0, stream, (const unsigned char*)d_ws, a.in[8], 5632);
#elif PROBE == 9
        if (p == 7) hipLaunchKernelGGL(probe_merge, dim3(8), dim3(256), 0, stream, (const unsigned char*)d_ws, a.in[8], a.in[25], a.in[26], 2);
#elif PROBE == 4
        if (p == 9) hipLaunchKernelGGL(probe_merge, dim3(8), dim3(256), 0, stream, (const unsigned char*)d_ws, a.in[8], a.in[25], a.in[26], 1);
#endif
    }
#endif
}
```

```cpp
#include <hip/hip_runtime.h>
#include <hip/hip_bf16.h>
#include <cstdio>
#include <cstdint>
#define MK_ONE_LAUNCH 1
#define GATE_RAW 1

__device__ __forceinline__ int otid_() { int t = (int)threadIdx.x; asm volatile("" : "+v"(t)); return t; }
namespace pg8 {
#define PG8_LAS __attribute__((address_space(3)))
typedef unsigned short bf16_t;
typedef short bf16x8 __attribute__((ext_vector_type(8)));
typedef float f32x4 __attribute__((ext_vector_type(4)));
typedef unsigned u32x4 __attribute__((ext_vector_type(4)));
constexpr int BM = 256, BK = 64, HALF = 128, HTB = HALF * BK * 2  , STAGE_BYTES = 8 * HTB, NXCD = 8, WGM = 8;

__host__ __device__ __forceinline__ int lds_byte(int r, int c) { const int st = (r >> 4) * 2 + (c >> 5), rr = r & 15, cc = c & 31, ob = rr * 64 + cc * 2; return st * 1024 + (ob ^ (((ob >> 9) & 1) << 5)); }
__host__ __device__ __forceinline__ void stage_rc(int b, int& R, int& C) { const int st = b / 1024, sb = b % 1024, swz = sb ^ (((sb >> 9) & 1) << 5); R = (st >> 1) * 16 + swz / 64; C = (st & 1) * 32 + (swz % 64) / 2; }
__host__ __device__ __forceinline__ int perm32(int rho) { const int n = rho >> 4, i = rho & 15; return 8 * (i >> 2) + 4 * n + (i & 3); }

struct Unit { int pm, pn; };
struct Gemm { const bf16_t* A; const bf16_t* Bt; int M, N, K, lda; };

struct StaticOrder {
    int nM, nN, nwg, G, c;
    __host__ __device__ void init(int M, int N, int G_, int c_) { nM = M / BM; nN = N / BM; nwg = nM * nN; G = G_; c = c_; }
    __host__ __device__ bool next(int i, Unit& u) const {
        const long L = (long)i * G + c; if (L >= nwg) return false;
        int wgid = (int)L; { const int q = nwg / NXCD, r = nwg % NXCD, xcd = wgid % NXCD, off = wgid / NXCD; wgid = (xcd < r ? xcd * (q + 1) : r * (q + 1) + (xcd - r) * q) + off; }
        const int nig = WGM * nN, gid = wgid / nig, fm = gid * WGM, gsz = (nM - fm) < WGM ? (nM - fm) : WGM;
        u.pm = fm + ((wgid % nig) % gsz); u.pn = (wgid % nig) / gsz; return true;
    }
    __device__ __forceinline__ void a_ready(const Unit&) const {}
    __device__ __forceinline__ void done(const Unit&) const {}
};

__device__ __forceinline__ unsigned cvt_pk_bf16(float lo, float hi) { unsigned r; asm volatile("v_cvt_pk_bf16_f32 %0, %1, %2" : "=v"(r) : "v"(lo), "v"(hi)); return r; }

template <class Epi, class Sched, bool ALIGN_EPI = false, bool SP2 = false>
__device__ __forceinline__ void gemm_phase(PG8_LAS unsigned char* lds, const Gemm g, const Sched& S, const Epi& E) {
    const int tid = otid_(), wid = __builtin_amdgcn_readfirstlane(tid >> 6), lane = tid & 63, wr = wid >> 2, wc = wid & 3, fr = lane & 15, fq = lane >> 4;
    const int K = g.K, nt = K / BK;
    unsigned voffA[2], voffB[2];
#pragma unroll
    for (int i = 0; i < 2; ++i) { int R, C; stage_rc(tid * 16 + i * 8192, R, C); const int Rb = Epi::PERM ? ((R & ~31) + perm32(R & 31)) : R;
        voffA[i] = (unsigned)(R * g.lda + C) * 2u; voffB[i] = (unsigned)(Rb * K + C) * 2u; }
    const size_t kstep = (size_t)(BK * 2);
    const size_t hstepB = (size_t)HALF * K * 2, hstepA = (size_t)HALF * g.lda * 2;
    const size_t tstepB = 2 * hstepB, tstepA = 2 * hstepA;
    const unsigned ldsw = (unsigned)wid * 1024u;
    const int aoff = lds_byte(wr * 64 + fr, fq * 8), boff = lds_byte(wc * 32 + fr, fq * 8);
#define PG8_SA(b, h) (((b) * 2 + (h)) * HTB)
#define PG8_SB(b, h) ((4 + (b) * 2 + (h)) * HTB)
#define PG8_STAGE(bufoff, gbase, voff) do { _Pragma("unroll") for (int _i = 0; _i < 2; ++_i) \
        __builtin_amdgcn_global_load_lds((const unsigned*)((const char*)(gbase) + (voff)[_i]), (PG8_LAS unsigned*)(lds + (bufoff) + ldsw + _i * 8192), 16, 0, 0); } while (0)
#define PG8_LDA(dst, b, h) do { _Pragma("unroll") for (int m = 0; m < 4; ++m) _Pragma("unroll") for (int k = 0; k < 2; ++k) dst[m][k] = *(const PG8_LAS bf16x8*)(lds + PG8_SA(b, h) + aoff + m * 2048 + k * 1024); } while (0)
#define PG8_LDB(dst, b, h) do { _Pragma("unroll") for (int n = 0; n < 2; ++n) _Pragma("unroll") for (int k = 0; k < 2; ++k) dst[n][k] = *(const PG8_LAS bf16x8*)(lds + PG8_SB(b, h) + boff + n * 2048 + k * 1024); } while (0)
#define PG8_MMA(ai, bj, At, Bt) do { __builtin_amdgcn_s_setprio(1); _Pragma("unroll") for (int m = 0; m < 4; ++m) _Pragma("unroll") for (int n = 0; n < 2; ++n) _Pragma("unroll") for (int k = 0; k < 2; ++k) \
        acc[ai][bj][m][n] = __builtin_amdgcn_mfma_f32_16x16x32_bf16(Bt[n][k], At[m][k], acc[ai][bj][m][n], 0, 0, 0); __builtin_amdgcn_s_setprio(0); } while (0)
#define PG8_WAIT_V(n) asm volatile("s_waitcnt vmcnt(" #n ")" ::: "memory")
#define PG8_WAIT_L(n) asm volatile("s_waitcnt lgkmcnt(" #n ")" ::: "memory")
#define PG8_BAR __builtin_amdgcn_s_barrier()
#define PG8_SCHED __builtin_amdgcn_sched_barrier(0)
    Unit cur, nxt; int ui = 0;
    if (!S.next(0, cur)) return;
    f32x4 acc[2][2][4][2];
#pragma unroll
    for (int a = 0; a < 2; ++a)
#pragma unroll
        for (int b = 0; b < 2; ++b)
#pragma unroll
            for (int m = 0; m < 4; ++m)
#pragma unroll
                for (int n = 0; n < 2; ++n) acc[a][b][m][n] = (f32x4){0.f, 0.f, 0.f, 0.f};
    bf16x8 At[4][2], B0[2][2], B1[2][2];
    const char* cA = (const char*)g.A + (size_t)cur.pm * tstepA; const char* cB = (const char*)g.Bt + (size_t)cur.pn * tstepB;
    S.a_ready(cur);
    if constexpr (SP2) {
        PG8_STAGE(PG8_SB(0, 0), cB, voffB); PG8_STAGE(PG8_SB(0, 1), cB + hstepB, voffB); PG8_STAGE(PG8_SA(0, 0), cA, voffA); PG8_STAGE(PG8_SA(0, 1), cA + hstepA, voffA);
        if (wr == 1) PG8_BAR;
        PG8_WAIT_V(2); PG8_BAR;
        PG8_STAGE(PG8_SB(1, 0), cB + kstep, voffB); PG8_STAGE(PG8_SA(1, 0), cA + kstep, voffA); PG8_STAGE(PG8_SB(1, 1), cB + hstepB + kstep, voffB);
        PG8_WAIT_V(6); PG8_BAR;
    } else {
        PG8_STAGE(PG8_SB(0, 0), cB, voffB); PG8_STAGE(PG8_SA(0, 0), cA, voffA); PG8_STAGE(PG8_SB(0, 1), cB + hstepB, voffB); PG8_STAGE(PG8_SA(0, 1), cA + hstepA, voffA);
        if (wr == 1) PG8_BAR;
        PG8_WAIT_V(4); PG8_BAR;
        PG8_STAGE(PG8_SB(1, 0), cB + kstep, voffB); PG8_STAGE(PG8_SA(1, 0), cA + kstep, voffA); PG8_STAGE(PG8_SB(1, 1), cB + hstepB + kstep, voffB);
        PG8_WAIT_V(6); PG8_BAR;
    }
    for (;;) {
        const bool has_next = S.next(ui + 1, nxt);
        const char* nA = has_next ? (const char*)g.A + (size_t)nxt.pm * tstepA : cA; const char* nB = has_next ? (const char*)g.Bt + (size_t)nxt.pn * tstepB : cB;
        for (int t = 0; t < nt; t += 2) {
            const bool last = (t == nt - 2);
            const char* a1 = cA + (size_t)(t + 1) * kstep;
            const char* a2 = last ? nA : cA + (size_t)(t + 2) * kstep; const char* b2 = last ? nB : cB + (size_t)(t + 2) * kstep;
            const char* a3 = a2 + kstep; const char* b3 = b2 + kstep;
            if (last && has_next) S.a_ready(nxt);
            if constexpr (SP2) {
            PG8_LDB(B0, 0, 0); PG8_LDB(B1, 0, 1); PG8_SCHED; PG8_LDA(At, 0, 0); PG8_STAGE(PG8_SA(1, 1), a1 + hstepA, voffA);
            PG8_WAIT_V(8); PG8_WAIT_L(0); PG8_BAR; PG8_MMA(0, 0, At, B0); PG8_MMA(0, 1, At, B1); PG8_BAR; PG8_SCHED;
            PG8_LDA(At, 0, 1); PG8_STAGE(PG8_SB(0, 0), b2, voffB); PG8_STAGE(PG8_SB(0, 1), b2 + hstepB, voffB); PG8_STAGE(PG8_SA(0, 0), a2, voffA);
            PG8_WAIT_V(8); PG8_WAIT_L(0); PG8_BAR; PG8_MMA(1, 0, At, B0); PG8_MMA(1, 1, At, B1); PG8_BAR; PG8_SCHED;
            PG8_LDB(B0, 1, 0); PG8_LDB(B1, 1, 1); PG8_SCHED; PG8_LDA(At, 1, 0); PG8_STAGE(PG8_SA(0, 1), a2 + hstepA, voffA);
            PG8_WAIT_V(8); PG8_WAIT_L(0); PG8_BAR; PG8_MMA(0, 0, At, B0); PG8_MMA(0, 1, At, B1); PG8_BAR; PG8_SCHED;
            PG8_LDA(At, 1, 1); PG8_STAGE(PG8_SB(1, 0), b3, voffB); PG8_STAGE(PG8_SB(1, 1), b3 + hstepB, voffB); PG8_STAGE(PG8_SA(1, 0), a3, voffA);
            PG8_WAIT_V(8); PG8_WAIT_L(0); PG8_BAR; PG8_MMA(1, 0, At, B0); PG8_MMA(1, 1, At, B1); PG8_BAR; PG8_SCHED;
            } else {
            PG8_LDB(B0, 0, 0); PG8_SCHED; PG8_LDA(At, 0, 0); PG8_STAGE(PG8_SA(1, 1), a1 + hstepA, voffA);
            PG8_WAIT_L(8); PG8_BAR; PG8_WAIT_L(0); PG8_MMA(0, 0, At, B0); PG8_BAR; PG8_SCHED;
            PG8_LDB(B1, 0, 1); PG8_STAGE(PG8_SB(0, 0), b2, voffB);
            PG8_BAR; PG8_WAIT_L(0); PG8_MMA(0, 1, At, B1); PG8_BAR;
            PG8_LDA(At, 0, 1); PG8_STAGE(PG8_SA(0, 0), a2, voffA);
            PG8_BAR; PG8_WAIT_L(0); PG8_MMA(1, 0, At, B0); PG8_BAR; PG8_SCHED;
            PG8_STAGE(PG8_SB(0, 1), b2 + hstepB, voffB);
            PG8_WAIT_V(6); PG8_BAR; PG8_MMA(1, 1, At, B1); PG8_BAR;
            PG8_LDB(B0, 1, 0); PG8_SCHED; PG8_LDA(At, 1, 0); PG8_STAGE(PG8_SA(0, 1), a2 + hstepA, voffA);
            PG8_WAIT_L(8); PG8_BAR; PG8_WAIT_L(0); PG8_MMA(0, 0, At, B0); PG8_BAR; PG8_SCHED;
            PG8_LDB(B1, 1, 1); PG8_STAGE(PG8_SB(1, 0), b3, voffB);
            PG8_BAR; PG8_WAIT_L(0); PG8_MMA(0, 1, At, B1); PG8_BAR;
            PG8_LDA(At, 1, 1); PG8_STAGE(PG8_SA(1, 0), a3, voffA);
            PG8_BAR; PG8_WAIT_L(0); PG8_MMA(1, 0, At, B0); PG8_BAR; PG8_SCHED;
            PG8_STAGE(PG8_SB(1, 1), b3 + hstepB, voffB);
            PG8_WAIT_V(6); PG8_BAR; PG8_MMA(1, 1, At, B1); PG8_BAR;
            }
        }
        if constexpr (ALIGN_EPI) { if (wr == 0) PG8_BAR; }
        if constexpr (!Epi::AFTER_DRAIN) { E(acc, cur, wr, wc, fr, fq); S.done(cur); }
        if (!has_next) break;
#pragma unroll
        for (int a = 0; a < 2; ++a)
#pragma unroll
            for (int b = 0; b < 2; ++b)
#pragma unroll
                for (int m = 0; m < 4; ++m)
#pragma unroll
                    for (int n = 0; n < 2; ++n) acc[a][b][m][n] = (f32x4){0.f, 0.f, 0.f, 0.f};
        cur = nxt; cA = nA; cB = nB; ++ui;
        if constexpr (ALIGN_EPI) { if (wr == 1) PG8_BAR; }
    }
    PG8_WAIT_V(0);
    if constexpr (!ALIGN_EPI) { if (wr == 0) PG8_BAR; }
    PG8_BAR;
    if constexpr (Epi::AFTER_DRAIN) { E.fused(acc, cur, wr, wc, fr, fq, lds, wid, lane); S.done(cur); }
#undef PG8_SA
#undef PG8_SB
#undef PG8_STAGE
#undef PG8_LDA
#undef PG8_LDB
#undef PG8_MMA
#undef PG8_WAIT_V
#undef PG8_WAIT_L
#undef PG8_BAR
#undef PG8_SCHED
}
}
namespace pg8 {
typedef unsigned u32x2 __attribute__((ext_vector_type(2)));
__device__ __forceinline__ float bf_lo(unsigned w) { return __uint_as_float(w << 16); }
__device__ __forceinline__ float bf_hi(unsigned w) { return __uint_as_float(w & 0xffff0000u); }
__device__ __forceinline__ float sigmoidf_(float x) { return __builtin_amdgcn_rcpf(1.0f + __expf(-x)); }

struct EpiSwiGLU {
    static constexpr bool PERM = false, AFTER_DRAIN = false;
    bf16_t* H; int ldh;
    __device__ __forceinline__ void operator()(const f32x4 (&acc)[2][2][4][2], const Unit& u, int wr, int wc, int fr, int fq) const {
        const int row0 = u.pm * BM + wr * 64 + fr, hc0 = u.pn * 128 + wc * 16 + 4 * fq;
#pragma unroll
        for (int ai = 0; ai < 2; ++ai)
#pragma unroll
            for (int m = 0; m < 4; ++m) { bf16_t* rowp = H + (size_t)(row0 + ai * HALF + m * 16) * ldh + hc0;
#pragma unroll
                for (int bj = 0; bj < 2; ++bj) { const f32x4 g = acc[ai][bj][m][0], up = acc[ai][bj][m][1]; float h[4];
#pragma unroll
                    for (int e = 0; e < 4; ++e) h[e] = g[e] * sigmoidf_(g[e]) * up[e];
                    u32x2 w; w.x = cvt_pk_bf16(h[0], h[1]); w.y = cvt_pk_bf16(h[2], h[3]);
                    *(u32x2*)(rowp + bj * 64) = w; } }
    }
};
template <int ACT> struct EpiStore {
    static constexpr bool PERM = true, AFTER_DRAIN = false;
    bf16_t* O0; int ld0; bf16_t* O1; int ld1; int split_tiles;
    __device__ __forceinline__ void operator()(const f32x4 (&acc)[2][2][4][2], const Unit& u, int wr, int wc, int fr, int fq) const {
        const int row0 = u.pm * BM + wr * 64 + fr;
        bf16_t* base; int ld, colt;
        if (u.pn < split_tiles) { base = O0; ld = ld0; colt = u.pn * BM; } else { base = O1; ld = ld1; colt = (u.pn - split_tiles) * BM; }
        const int col0 = colt + wc * 32 + 8 * fq;
#pragma unroll
        for (int ai = 0; ai < 2; ++ai)
#pragma unroll
            for (int m = 0; m < 4; ++m) { bf16_t* rowp = base + (size_t)(row0 + ai * HALF + m * 16) * ld + col0;
#pragma unroll
                for (int bj = 0; bj < 2; ++bj) { f32x4 v0 = acc[ai][bj][m][0], v1 = acc[ai][bj][m][1];
                    if (ACT == 1) {
#pragma unroll
                        for (int e = 0; e < 4; ++e) { v0[e] = sigmoidf_(v0[e]); v1[e] = sigmoidf_(v1[e]); } }
                    u32x4 w; w.x = cvt_pk_bf16(v0[0], v0[1]); w.y = cvt_pk_bf16(v0[2], v0[3]); w.z = cvt_pk_bf16(v1[0], v1[1]); w.w = cvt_pk_bf16(v1[2], v1[3]);
                    *(u32x4*)(rowp + bj * HALF) = w; } }
    }
};
#ifdef GATE_RAW
#define GSIG(x) sigmoidf_(x)
#else
#define GSIG(x) (x)
#endif
struct EpiGateMul {
    static constexpr bool PERM = true, AFTER_DRAIN = false;
    bf16_t* MG; int ldm; const bf16_t* G; int ldg; int first;
    __device__ __forceinline__ void operator()(const f32x4 (&acc)[2][2][4][2], const Unit& u, int wr, int wc, int fr, int fq) const {
        const int row0 = u.pm * BM + wr * 64 + fr, col0 = u.pn * BM + wc * 32 + 8 * fq;
#pragma unroll
        for (int ai = 0; ai < 2; ++ai)
#pragma unroll
            for (int m = 0; m < 4; ++m) { const size_t r = (size_t)(row0 + ai * HALF + m * 16);
#pragma unroll
                for (int bj = 0; bj < 2; ++bj) { const f32x4 v0 = acc[ai][bj][m][0], v1 = acc[ai][bj][m][1];
                    const u32x4 g = *(const u32x4*)(G + r * ldg + col0 + bj * HALF);
                    float o[8] = { v0[0] * GSIG(bf_lo(g.x)), v0[1] * GSIG(bf_hi(g.x)), v0[2] * GSIG(bf_lo(g.y)), v0[3] * GSIG(bf_hi(g.y)), v1[0] * GSIG(bf_lo(g.z)), v1[1] * GSIG(bf_hi(g.z)), v1[2] * GSIG(bf_lo(g.w)), v1[3] * GSIG(bf_hi(g.w)) };
                    bf16_t* mp = MG + r * ldm + col0 + bj * HALF;
                    if (!first) { const u32x4 p = *(const u32x4*)mp;
                        o[0] += bf_lo(p.x); o[1] += bf_hi(p.x); o[2] += bf_lo(p.y); o[3] += bf_hi(p.y); o[4] += bf_lo(p.z); o[5] += bf_hi(p.z); o[6] += bf_lo(p.w); o[7] += bf_hi(p.w); }
                    u32x4 w; w.x = cvt_pk_bf16(o[0], o[1]); w.y = cvt_pk_bf16(o[2], o[3]); w.z = cvt_pk_bf16(o[4], o[5]); w.w = cvt_pk_bf16(o[6], o[7]);
                    *(u32x4*)mp = w; } }
    }
};
}
namespace att {
constexpr int D = 128;
constexpr bool WSKIP = false;
constexpr float THR = 8.f;
constexpr int NW = 8, QBLK = 32, KVBLK = 64, QB = NW * QBLK;
constexpr int SHM_V = KVBLK * D * 2, SHM_K = KVBLK * D * 2;
constexpr int LDS_BYTES = 2 * SHM_V + 2 * SHM_K + NW * 64 * 4;
using bf16 = __hip_bfloat16;
typedef short bf16x8 __attribute__((ext_vector_type(8)));
typedef short s16x4 __attribute__((ext_vector_type(4)));
typedef float f32x16 __attribute__((ext_vector_type(16)));
typedef float f32x4 __attribute__((ext_vector_type(4)));
typedef unsigned u32x4 __attribute__((ext_vector_type(4)));
template <class A, class Bt> struct same_t { static constexpr bool v = false; };
template <class A> struct same_t<A, A> { static constexpr bool v = true; };

#define KSWZ(row, colB) ((row) * 256 + ((colB) ^ (((row) & 7) << 4)))
#define SBAR() __builtin_amdgcn_sched_barrier(0)
__device__ __forceinline__ int v_st(int k, int c) { const int kk = (k & ~0xC) | ((k & 4) << 1) | ((k & 8) >> 1); return ((kk >> 3) * 4 + (c >> 5)) * 512 + ((kk & 7) * 32 + (c & 31)) * 2; }
__device__ __forceinline__ int v_rd_base(int lane) { return ((lane & 3) << 3) | (((lane >> 2) & 3) << 6) | (((lane >> 4) & 1) << 5) | (((lane >> 5) & 1) << 8); }
constexpr int v_rd_off(int d0, int ks, int half) { return d0 * 512 + ks * 4096 + half * 2048; }
__device__ __forceinline__ int crow(int r, int hi) { return (r & 3) + 8 * (r >> 2) + 4 * hi; }
__device__ __forceinline__ unsigned cvtpk(float lo, float hi) {
    unsigned r; asm volatile("v_cvt_pk_bf16_f32 %0, %1, %2" : "=v"(r) : "v"(lo), "v"(hi)); return r;
}
__device__ __forceinline__ bf16x8 pack8(f32x4 a, f32x4 b) {
    u32x4 w = {cvtpk(a[0], a[1]), cvtpk(a[2], a[3]), cvtpk(b[0], b[1]), cvtpk(b[2], b[3])};
    return *reinterpret_cast<bf16x8*>(&w);
}
template <class T> __device__ __forceinline__ bf16x8 load8(const T* p) {
    if constexpr (same_t<T, float>::v) { return pack8(*(const f32x4*)p, *(const f32x4*)(p + 4)); }
    else { return *reinterpret_cast<const bf16x8*>(p); }
}
__device__ __forceinline__ void mask_tile(f32x16& p0, f32x16& p1, int dq, unsigned W) {
    const float NEG = -__builtin_inff();
#pragma unroll
    for (int r = 0; r < 16; ++r) {
        const int c = (r & 3) + 8 * (r >> 2);
        if ((unsigned)(dq - c) >= W) p0[r] = NEG;
        if ((unsigned)(dq - c - 32) >= W) p1[r] = NEG;
    }
}
typedef unsigned u32x2 __attribute__((ext_vector_type(2)));
__device__ __forceinline__ void bitmask_tile(f32x16& p0, f32x16& p1, u32x2 w, int hi) {
    const float NEG = -__builtin_inff();
    const unsigned a = w[0] >> (4 * hi), b = w[1] >> (4 * hi);
#pragma unroll
    for (int r = 0; r < 16; ++r) {
        const int c = (r & 3) + 8 * (r >> 2);
        if (!((a >> c) & 1u)) p0[r] = NEG;
        if (!((b >> c) & 1u)) p1[r] = NEG;
    }
}
template <bool HALFQK> __device__ __forceinline__ void partialSM(f32x16& p0, f32x16& p1, float& m_reg, float& mn, float& alpha) {
    constexpr float SCALE = HALFQK ? 0.125f : 0.08838834764831845f;
    float pmax = p0[0]; for (int r = 1; r < 16; ++r) pmax = fmaxf(pmax, p0[r]); for (int r = 0; r < 16; ++r) pmax = fmaxf(pmax, p1[r]);
    { auto rr = __builtin_amdgcn_permlane32_swap(__float_as_uint(pmax), __float_as_uint(pmax), false, false);
      pmax = fmaxf(__uint_as_float(rr[0]), __uint_as_float(rr[1])); }
    constexpr float C2 = 1.4426950408889634f * SCALE;
    if (__builtin_expect(__all((pmax - m_reg) * SCALE <= THR), 1)) { mn = m_reg; alpha = 1.f; }
    else { mn = fmaxf(m_reg, pmax); alpha = __builtin_amdgcn_exp2f((m_reg - mn) * C2); m_reg = mn; }
    const float mnL = -mn * C2;
    for (int r = 0; r < 16; ++r) p0[r] = fmaf(p0[r], C2, mnL); for (int r = 0; r < 16; ++r) p1[r] = fmaf(p1[r], C2, mnL);
    for (int r = 0; r < 16; ++r) p0[r] = __builtin_amdgcn_exp2f(p0[r]);
}
__device__ __forceinline__ void finishSM(f32x16& p0, f32x16& p1, float alpha, float& l_reg, bf16x8& pa0, bf16x8& pa1, bf16x8& pa2, bf16x8& pa3) {
    for (int r = 0; r < 16; ++r) p1[r] = __builtin_amdgcn_exp2f(p1[r]);
    float ps = 0; for (int r = 0; r < 16; ++r) ps += p0[r]; for (int r = 0; r < 16; ++r) ps += p1[r];
    { auto rr = __builtin_amdgcn_permlane32_swap(__float_as_uint(ps), __float_as_uint(ps), false, false);
      ps = __uint_as_float(rr[0]) + __uint_as_float(rr[1]); }
    l_reg = l_reg * alpha + ps;
#define PK4(P, B_, OUT) do { unsigned a0 = cvtpk(P[B_+0], P[B_+1]), a1 = cvtpk(P[B_+2], P[B_+3]);                          \
        unsigned b0 = cvtpk(P[B_+4], P[B_+5]), b1 = cvtpk(P[B_+6], P[B_+7]);                                             \
        auto r0 = __builtin_amdgcn_permlane32_swap(a0, b0, false, false); auto r1 = __builtin_amdgcn_permlane32_swap(a1, b1, false, false); \
        u32x4 w = {r0[0], r1[0], r0[1], r1[1]}; OUT = *reinterpret_cast<bf16x8*>(&w); } while (0)
    PK4(p0, 0, pa0); PK4(p0, 8, pa1); PK4(p1, 0, pa2); PK4(p1, 8, pa3);
#undef PK4
}
template <int KB, bool SK, bool HALFQK>
__device__ __forceinline__ void qkt(f32x16& p0, f32x16& p1, const char* K_lds, int r32, int hi, const bf16x8* qr, bool act, int koff) {
    if (SK && !act) { const float NEG = -__builtin_inff();
#pragma unroll
        for (int r = 0; r < 16; ++r) { p0[r] = NEG; p1[r] = NEG; } return; }
    p0 = f32x16{}; p1 = f32x16{};
    const char* kb[4];
#pragma unroll
    for (int dd = 0; dd < 4; ++dd) kb[dd] = K_lds + KB * SHM_K + KSWZ(r32, (dd * 16 + hi * 8) * 2) + koff;
#pragma unroll
    for (int d0 = 0; d0 < (HALFQK ? 4 : 8); ++d0) { const char* a = kb[d0 & 3] + (d0 >> 2) * 128;
        bf16x8 b0 = *reinterpret_cast<const bf16x8*>(a);
        bf16x8 b1 = *reinterpret_cast<const bf16x8*>(a + 32 * 256);
        p0 = __builtin_amdgcn_mfma_f32_32x32x16_bf16(b0, qr[d0], p0, 0, 0, 0);
        p1 = __builtin_amdgcn_mfma_f32_32x32x16_bf16(b1, qr[d0], p1, 0, 0, 0); }
}
template <int VB, bool SK>
__device__ __forceinline__ void pv_tile(f32x16* o, int vb0, bf16x8 pa0, bf16x8 pa1, bf16x8 pa2, bf16x8 pa3, bool act) {
    if (SK && !act) return;
#define TRRD(dst, off) asm volatile("ds_read_b64_tr_b16 %0, %1 offset:%2" : "=&v"(dst) : "v"(vb0), "i"(off) : "memory")
#define PV_D0(d0) do { s16x4 l0, l1, l2, l3, h0, h1, h2, h3; constexpr int b_ = VB * SHM_V + v_rd_off(d0, 0, 0);     \
        TRRD(l0, b_); TRRD(h0, b_ + 2048); TRRD(l1, b_ + 4096); TRRD(h1, b_ + 6144); TRRD(l2, b_ + 8192); TRRD(h2, b_ + 10240); TRRD(l3, b_ + 12288); TRRD(h3, b_ + 14336); \
        asm volatile("s_waitcnt lgkmcnt(0)" ::: "memory"); SBAR();                 \
        o[d0] = __builtin_amdgcn_mfma_f32_32x32x16_bf16(pa0, (bf16x8){l0[0], l0[1], l0[2], l0[3], h0[0], h0[1], h0[2], h0[3]}, o[d0], 0, 0, 0);   \
        o[d0] = __builtin_amdgcn_mfma_f32_32x32x16_bf16(pa1, (bf16x8){l1[0], l1[1], l1[2], l1[3], h1[0], h1[1], h1[2], h1[3]}, o[d0], 0, 0, 0);   \
        o[d0] = __builtin_amdgcn_mfma_f32_32x32x16_bf16(pa2, (bf16x8){l2[0], l2[1], l2[2], l2[3], h2[0], h2[1], h2[2], h2[3]}, o[d0], 0, 0, 0);   \
        o[d0] = __builtin_amdgcn_mfma_f32_32x32x16_bf16(pa3, (bf16x8){l3[0], l3[1], l3[2], l3[3], h3[0], h3[1], h3[2], h3[3]}, o[d0], 0, 0, 0); } while (0)
    PV_D0(0); PV_D0(1); PV_D0(2); PV_D0(3);
#undef PV_D0
#undef TRRD
}

constexpr int QS = 1536, KVS = 4096;
template <class TIn, class TOut> struct BlockRef { const TIn* Q; const TIn* K; const TIn* V; TOut* O; int P0; int koff; const unsigned* mask; };
template <class TIn> struct Seam {
    bf16x8 qr[8];
    bf16x8 st_v0, st_v1, st_k0, st_k1; f32x4 sf0, sf1, sf2, sf3;
    f32x4 tq[16];
};
__device__ __forceinline__ int swa_jlo(int P0, int W) { const int lowk = P0 - W + 1; return lowk > 0 ? lowk / KVBLK : 0; }
#define ROW(p, k0, rr) ((p) + (size_t)((k0) + (rr)) * KVS + sc)
#define VMW() asm volatile("s_waitcnt vmcnt(0)" ::: "memory")
#define VMWN(n) asm volatile("s_waitcnt vmcnt(%0)" :: "i"(n) : "memory")
#define SLOAD_H(Kp, Vp, k0) do { S.st_v0 = load8<TIn>(ROW(Vp, k0, sr)); S.st_v1 = load8<TIn>(ROW(Vp, k0, 32 + sr));              \
                         S.st_k0 = load8<TIn>(ROW(Kp, k0, sr)); S.st_k1 = load8<TIn>(ROW(Kp, k0, 32 + sr)); } while (0)
#define SWRITE_HK(bf) do { *(bf16x8*)(K_lds + (bf) * SHM_K + kws) = S.st_k0; *(bf16x8*)(K_lds + (bf) * SHM_K + kws + 32 * 256) = S.st_k1; } while (0)
#define SWRITE_HV(bf) do { *(bf16x8*)(V_lds + (bf) * SHM_V + vst0) = S.st_v0; *(bf16x8*)(V_lds + (bf) * SHM_V + vst1) = S.st_v1; } while (0)
#define SWRITE_H(bf) do { SWRITE_HV(bf); SWRITE_HK(bf); } while (0)
#define SLOAD_F(p, k0) do { S.sf0 = *(const f32x4*)ROW(p, k0, sr); S.sf1 = *(const f32x4*)(ROW(p, k0, sr) + 4);                \
                            S.sf2 = *(const f32x4*)ROW(p, k0, 32 + sr); S.sf3 = *(const f32x4*)(ROW(p, k0, 32 + sr) + 4); } while (0)
#define SWRITE_KF(bf) do { *(bf16x8*)(K_lds + (bf) * SHM_K + kws) = pack8(S.sf0, S.sf1); *(bf16x8*)(K_lds + (bf) * SHM_K + kws + 32 * 256) = pack8(S.sf2, S.sf3); } while (0)
#define SWRITE_VF(bf) do { *(bf16x8*)(V_lds + (bf) * SHM_V + vst0) = pack8(S.sf0, S.sf1); *(bf16x8*)(V_lds + (bf) * SHM_V + vst1) = pack8(S.sf2, S.sf3); } while (0)
template <class TIn, class TOut, bool HALFQK>
__device__ __forceinline__ void causal_swa_prime(const BlockRef<TIn, TOut>& cur, int W, char* lds, Seam<TIn>& S) {
    constexpr bool F32 = same_t<TIn, float>::v;
    const int tid = otid_(), wid = __builtin_amdgcn_readfirstlane(tid >> 6), lane = tid & 63, r32 = lane & 31, hi = lane >> 5;
    const int sr = tid >> 4, sc = (tid & 15) * 8, kws = KSWZ(sr, sc * 2); char* K_lds = lds + 2 * SHM_V;
    const int kb0 = swa_jlo(cur.P0, W) * KVBLK;
    for (int d0 = 0; d0 < (HALFQK ? 4 : 8); ++d0) S.qr[d0] = load8<TIn>(cur.Q + (size_t)(wid * QBLK + r32) * QS + d0 * 16 + hi * 8);
    if constexpr (F32) { SLOAD_F((const float*)cur.K, kb0); VMW(); SWRITE_KF(0); SBAR(); SLOAD_F((const float*)cur.V, kb0); }
    else { SLOAD_H(cur.K, cur.V, kb0); VMW(); SWRITE_HK(0); }
    __syncthreads();
}
template <class TIn, class TOut, bool HALFQK, bool MASKED, int OS>
__device__ __forceinline__ void causal_swa_block(const BlockRef<TIn, TOut>& cur, const BlockRef<TIn, TOut>& nxt, int skv, int W, char* lds, Seam<TIn>& S) {
    constexpr bool F32 = same_t<TIn, float>::v;
    const int tid = otid_(), wid = __builtin_amdgcn_readfirstlane(tid >> 6), lane = tid & 63, r32 = lane & 31, hi = lane >> 5;
    const int j_lo = swa_jlo(cur.P0, W);
    int j_hi = (cur.P0 + QB - 1) / KVBLK + 1; if (j_hi > skv / KVBLK) j_hi = skv / KVBLK;
    const int NT = j_hi - j_lo;
    const int kbn = swa_jlo(nxt.P0, W) * KVBLK;
    const int qlo = cur.P0 + wid * QBLK, qm = qlo + r32 - 4 * hi;
    char* V_lds = lds; char* K_lds = lds + 2 * SHM_V;
    float* ws = (float*)(lds + 2 * SHM_V + 2 * SHM_K) + wid * 64; float* li_l = ws, * al_l = ws + 32;
    float m_reg = -1e30f, l_reg = 0; f32x16 o[4] = {};
    const int sr = tid >> 4, sc = (tid & 15) * 8, vst0 = v_st(sr, sc), vst1 = v_st(32 + sr, sc), kws = KSWZ(sr, sc * 2);
    const int vb0 = (int)(uintptr_t)V_lds + v_rd_base(lane);
    const TIn* Kh = cur.K; const TIn* Vh = cur.V;
#define RESC(a) do { if (__any((a) < 1.f)) { if (hi == 0) al_l[r32] = (a); asm volatile("s_waitcnt lgkmcnt(0)" ::: "memory");              \
                     for (int d_ = 0; d_ < 4; ++d_) for (int r = 0; r < 16; ++r) o[d_][r] *= al_l[crow(r, hi)]; } } while (0)
#define KBASE(t) ((j_lo + (t)) * KVBLK)
#define ACT(t) (KBASE(t) <= qlo + QBLK - 1 && KBASE(t) + KVBLK - 1 >= qlo - W + 1)
#define MASKT(P0_, P1_, t) do { if constexpr (MASKED) bitmask_tile(P0_, P1_, mw, hi);   \
        else { const int kb_ = KBASE(t); if ((!SK || ACT(t)) && (kb_ + KVBLK - 1 > qlo || kb_ <= qlo + QBLK - 1 - W)) mask_tile(P0_, P1_, qm - kb_, (unsigned)W); } } while (0)
    const unsigned moff = (unsigned)((wid * QBLK + r32) * 1024 + 8 * j_lo); u32x2 mw = {0u, 0u};
#define MLOAD(t) do { if constexpr (MASKED) mw = *(const u32x2*)((const char*)cur.mask + (moff + 8u * (unsigned)(t))); } while (0)
    constexpr int NQL = F32 ? 16 : (HALFQK ? 4 : 8);
    constexpr bool SK = WSKIP && !F32;
#define SEAM_K0() do { VMWN(NQL); if constexpr (F32) { SWRITE_KF(0); SBAR(); SLOAD_F((const float*)nxt.V, kbn); } else { SWRITE_HK(0); } SBAR(); } while (0)
    f32x16 pA0, pA1, pB0, pB1; float mnA, mnB, alA, alB; bf16x8 pa0, pa1, pa2, pa3;
    if constexpr (F32) { VMW(); SWRITE_VF(0); SBAR(); } else { SWRITE_HV(0); SBAR(); }
    if (NT > 1) { if constexpr (F32) SLOAD_F((const float*)Kh, KBASE(1)); else SLOAD_H(Kh, Vh, KBASE(1)); }
    SBAR(); qkt<0, SK, HALFQK>(pA0, pA1, K_lds, r32, hi, S.qr, ACT(0), cur.koff); MLOAD(0);
    if constexpr (F32) { if (NT > 1) { VMW(); SWRITE_KF(1); SBAR(); SLOAD_F((const float*)Vh, KBASE(1)); } }
    MASKT(pA0, pA1, 0); partialSM<HALFQK>(pA0, pA1, m_reg, mnA, alA);
    if (NT > 1) { VMW(); if constexpr (F32) { SWRITE_VF(1); SBAR(); if (NT > 2) SLOAD_F((const float*)Kh, KBASE(2)); } else SWRITE_H(1); }
    __syncthreads();
#define HALF_STEP(PX0, PX1, mnX, alX, PY0, PY1, alY, t, KB, VB, SB) do {                                                      \
        SBAR(); qkt<KB, SK, HALFQK>(PX0, PX1, K_lds, r32, hi, S.qr, ACT(t), cur.koff); MLOAD(t);                                             \
        finishSM(PY0, PY1, alY, l_reg, pa0, pa1, pa2, pa3); SBAR();                                                           \
        if ((t) + 1 < NT) { if constexpr (F32) { VMW(); SWRITE_KF(SB); SBAR(); SLOAD_F((const float*)Vh, KBASE((t) + 1)); }  \
                            else { SLOAD_H(Kh, Vh, KBASE((t) + 1)); } SBAR(); }                                               \
        pv_tile<VB, SK>(o, vb0, pa0, pa1, pa2, pa3, ACT((t) - 1)); MASKT(PX0, PX1, (t)); partialSM<HALFQK>(PX0, PX1, m_reg, mnX, alX);                                        \
        __syncthreads();                                                                                                      \
        if ((t) + 1 < NT) { VMW(); if constexpr (F32) { SWRITE_VF(SB); SBAR(); if ((t) + 2 < NT) SLOAD_F((const float*)Kh, KBASE((t) + 2)); } \
                            else { SWRITE_H(SB); } }                                                                          \
        RESC(alX); __syncthreads(); } while (0)
    for (int t = 1; t + 1 < NT; t += 2) {
        HALF_STEP(pB0, pB1, mnB, alB, pA0, pA1, alA, t, 1, 0, 0);
        HALF_STEP(pA0, pA1, mnA, alA, pB0, pB1, alB, t + 1, 0, 1, 1);
    }
    const bool even = (NT & 1) == 0;
    if (even) { SBAR(); qkt<1, SK, HALFQK>(pB0, pB1, K_lds, r32, hi, S.qr, ACT(NT - 1), cur.koff); MLOAD(NT - 1); SBAR(); }
#define QROW(e) (nxt.Q + (size_t)(wid * QBLK + r32) * QS + ((e) >> 1) * 16 + hi * 8 + ((e) & 1) * 4)
    if constexpr (F32) { SLOAD_F((const float*)nxt.K, kbn); SBAR();
#pragma unroll
        for (int e = 0; e < 8; ++e) S.tq[e] = *(const f32x4*)QROW(e); }
    else { SLOAD_H(nxt.K, nxt.V, kbn); SBAR();
#pragma unroll
        for (int d0 = 0; d0 < (HALFQK ? 4 : 8); ++d0) S.qr[d0] = load8<TIn>(nxt.Q + (size_t)(wid * QBLK + r32) * QS + d0 * 16 + hi * 8); }
    SBAR();
    finishSM(pA0, pA1, alA, l_reg, pa0, pa1, pa2, pa3); SBAR();
    if constexpr (F32) {
#pragma unroll
        for (int e = 8; e < 16; ++e) S.tq[e] = *(const f32x4*)QROW(e); SBAR(); }
#undef QROW
    pv_tile<0, SK>(o, vb0, pa0, pa1, pa2, pa3, ACT(even ? NT - 2 : NT - 1));
    if (even) { MASKT(pB0, pB1, NT - 1); partialSM<HALFQK>(pB0, pB1, m_reg, mnB, alB); __syncthreads(); RESC(alB);
        finishSM(pB0, pB1, alB, l_reg, pa0, pa1, pa2, pa3); SBAR(); pv_tile<1, SK>(o, vb0, pa0, pa1, pa2, pa3, ACT(NT - 1)); }
    SBAR(); SEAM_K0();
    if (hi == 0) li_l[r32] = l_reg; asm volatile("s_waitcnt lgkmcnt(0)" ::: "memory");
    float rli[16];
#pragma unroll
    for (int r = 0; r < 16; ++r) rli[r] = __builtin_amdgcn_rcpf(li_l[crow(r, hi)]);
    TOut* Ow = cur.O + (size_t)(wid * QBLK) * OS;
#pragma unroll
    for (int r = 0; r < 16; ++r) { const int orow = crow(r, hi);
#pragma unroll
        for (int d0 = 0; d0 < 4; ++d0) { const float v = o[d0][r] * rli[r];
            if constexpr (same_t<TOut, float>::v) { Ow[(size_t)orow * OS + d0 * 32 + r32] = v; }
            else { const float vn = __shfl_xor(v, 1);
                   if ((r32 & 1) == 0) *(unsigned*)(Ow + (size_t)orow * OS + d0 * 32 + r32) = cvtpk(v, vn); } } }
    if constexpr (F32) {
#pragma unroll
        for (int d0 = 0; d0 < 8; ++d0) S.qr[d0] = pack8(S.tq[2 * d0], S.tq[2 * d0 + 1]); }
    __syncthreads();
#undef RESC
#undef KBASE
#undef ACT
#undef MASKT
#undef MLOAD
#undef SEAM_K0
#undef HALF_STEP
}
#undef ROW
#undef VMW
#undef VMWN
#undef SLOAD_H
#undef SWRITE_HK
#undef SWRITE_HV
#undef SWRITE_H
#undef SLOAD_F
#undef SWRITE_KF
#undef SWRITE_VF
}
#ifndef PROBE
#define PROBE 0
#endif
constexpr int NWAVES = 8;
constexpr int NB = 2, T = 8192, M = NB * T, DM = 1024, FF = 2816, NIN = 8520, NLAYER = 2;
constexpr float NORM_EPS = 1e-6f;
constexpr size_t MiB = 1u << 20;
constexpr size_t WS_CTL = 0, CTL_ZERO_BYTES = 1 * MiB;
constexpr size_t WS_WF = 1 * MiB;
constexpr size_t WS_WF_DOWN = WS_WF + 11 * MiB;
constexpr size_t WS_WM = 18 * MiB;
constexpr size_t WS_WM_BR = WS_WM + 17 * MiB, WS_WM_OUT = WS_WM + 20 * MiB;
constexpr size_t WS_XN = 40 * MiB;
constexpr size_t WS_Q3 = 72 * MiB;
constexpr size_t WS_ZR = 120 * MiB;
constexpr size_t WS_R2 = 248 * MiB;
constexpr size_t WS_END = 280 * MiB;
constexpr size_t WS_MG = WS_ZR + 96 * MiB;
constexpr size_t WS_YRAW = WS_WF;
constexpr size_t WS_X1 = WS_XN + 16 * MiB;
constexpr size_t WS_A8 = WS_WM;
constexpr size_t WS_KID = WS_WM + 8 * MiB;
constexpr size_t WS_BITM = WS_XN;
constexpr size_t WS_RDOTK = WS_WF + 16 * MiB;
constexpr int QP = 1536, ZP = 4096;
constexpr int ZC_DK = 0, ZC_DV = 512, ZC_QI = 1024, ZC_KI = 1536, ZC_WI = 1600, ZC_RK = 1792, ZC_RV = 2304, ZC_WC = 2816, ZC_AC = 2880, ZC_GC = 2944, ZC_FK = 3072, ZC_FV = 3584;
constexpr int CW_TMO = 0;
constexpr int CW_BAR = 4096;
constexpr int CW_Q = 8192;
constexpr int CW_PROBE = 2048;
constexpr int CW_DONE = 12288;
constexpr int LDS_MISC = 160 * 1024 - 256;
constexpr int LDS_BYTES = 160 * 1024;

#define GAS __attribute__((address_space(1)))
#define LAS __attribute__((address_space(3)))
typedef unsigned short bf16;
typedef unsigned v4u __attribute__((ext_vector_type(4)));
typedef unsigned v2u __attribute__((ext_vector_type(2)));
typedef float f32x4 __attribute__((ext_vector_type(4)));
typedef float f32x2 __attribute__((ext_vector_type(2)));
typedef float f32x16 __attribute__((ext_vector_type(16)));
typedef short bf16x8 __attribute__((ext_vector_type(8)));
typedef GAS unsigned gu32;
#define RLX_AGENT __ATOMIC_RELAXED, __HIP_MEMORY_SCOPE_AGENT
#define LDS_WAIT() asm volatile("s_waitcnt lgkmcnt(0)" ::: "memory")
#define VM_WAIT() asm volatile("s_waitcnt vmcnt(0)" ::: "memory")
__device__ __forceinline__ unsigned f2bf(float f) { unsigned u = __builtin_bit_cast(unsigned, f); return (u + 0x7fffu + ((u >> 16) & 1u)) >> 16; }
__device__ __forceinline__ unsigned pk2(float lo, float hi) { return f2bf(lo) | (f2bf(hi) << 16); }
__device__ __forceinline__ float bflo(unsigned w) { return __uint_as_float(w << 16); }
__device__ __forceinline__ float bfhi(unsigned w) { return __uint_as_float(w & 0xffff0000u); }
__device__ __forceinline__ float bf1(bf16 h) { return __uint_as_float((unsigned)h << 16); }
__device__ __forceinline__ float wave_sum(float v) {
#pragma unroll
    for (int o = 1; o < 64; o <<= 1) v += __shfl_xor(v, o);
    return v;
}
__device__ __forceinline__ float sigm(float x) { return __builtin_amdgcn_rcpf(1.0f + __expf(-x)); }

#define XB_TMO      128
#define XB_XCNT(j)  (256  + 64 * (j))
#define XB_XSUB(j)  (1280 + 64 * (j))
#define XB_XGEN(j)  (2304 + 64 * (j))
#define XB_TOP      3328
#define XB_TOPGEN   3392
#define XCD_BAR_WORDS 3456
#define XB_SPIN_CAP (1u << 22)
__device__ __forceinline__ unsigned xb_ld(unsigned* p)              { return __hip_atomic_load(p, __ATOMIC_RELAXED, __HIP_MEMORY_SCOPE_AGENT); }
__device__ __forceinline__ unsigned xb_add(unsigned* p, unsigned v) { return __hip_atomic_fetch_add(p, v, __ATOMIC_RELAXED, __HIP_MEMORY_SCOPE_AGENT); }
__device__ __forceinline__ unsigned xb_xcc_id() { return (unsigned)__builtin_amdgcn_s_getreg((3 << 11) | 20) & 0xFu; }
#define XB_SPIN(cond, bar) do { unsigned _sp = 0; while (cond) { __builtin_amdgcn_s_sleep(1); \
    if ((++_sp & 255u) == 0u) { if (xb_ld(&(bar)[XB_TMO])) break; if (_sp > XB_SPIN_CAP) { atomicAdd(&(bar)[XB_TMO], 1u); break; } } } } while (0)
struct XcdBarrier { unsigned* bar; unsigned x; volatile LAS unsigned* st; };
__device__ __forceinline__ XcdBarrier xcd_barrier_post(unsigned* bar, volatile LAS unsigned* st) {
    XcdBarrier b; b.bar = bar; b.x = xb_xcc_id(); b.st = st;
    if (threadIdx.x == 0) (void)xb_add(&bar[XB_XCNT(b.x)], 1u);
    return b;
}
__device__ __forceinline__ void xcd_barrier_complete(unsigned* bar, unsigned x, unsigned& nloc, unsigned& nx) {
    const unsigned G = gridDim.x * gridDim.y * gridDim.z;
    unsigned sum, cnt, mine, sp = 0u;
    for (;;) {
        sum = 0u; cnt = 0u; mine = 0u;
#pragma unroll
        for (unsigned j = 0; j < 16; ++j) { const unsigned c = xb_ld(&bar[XB_XCNT(j)]); sum += c; cnt += (c > 0u) ? 1u : 0u; mine = (j == x) ? c : mine; }
        if (sum == G) break;
        __builtin_amdgcn_s_sleep(1);
        if ((++sp & 255u) == 0u) { if (xb_ld(&bar[XB_TMO])) break; if (sp > XB_SPIN_CAP) { atomicAdd(&bar[XB_TMO], 1u); break; } }
    }
    nloc = mine > 0u ? mine : 1u; nx = cnt > 0u ? cnt : 1u;
}
__device__ __forceinline__ void xcd_barrier(const XcdBarrier& b) {
    asm volatile("s_waitcnt vmcnt(0)" ::: "memory");
    __syncthreads();
    if (threadIdx.x == 0) {
        unsigned* bar = b.bar;
        __builtin_amdgcn_s_waitcnt(0);
        unsigned nloc = b.st[0], nx = b.st[1];
        if (nloc == 0u) { xcd_barrier_complete(bar, b.x, nloc, nx); b.st[0] = nloc; b.st[1] = nx; }
        const unsigned old = xb_add(&bar[XB_XSUB(b.x)], 1u);
        const unsigned gen = old / nloc;
        if (old + 1u == (gen + 1u) * nloc) {
            __builtin_amdgcn_fence(__ATOMIC_RELEASE, "agent");
            asm volatile("s_waitcnt vmcnt(0)" ::: "memory");
            const unsigned og = xb_add(&bar[XB_TOP], 1u);
            const unsigned tg = og / nx;
            if (og + 1u == (tg + 1u) * nx) xb_add(&bar[XB_TOPGEN], 1u);
            else XB_SPIN(xb_ld(&bar[XB_TOPGEN]) == tg, bar);
            __builtin_amdgcn_fence(__ATOMIC_ACQUIRE, "agent");
            xb_add(&bar[XB_XGEN(b.x)], 1u);
            asm volatile("s_waitcnt vmcnt(0)" ::: "memory");
        } else {
            XB_SPIN(xb_ld(&bar[XB_XGEN(b.x)]) == gen, bar);
            __builtin_amdgcn_fence(__ATOMIC_ACQUIRE, "agent");
            asm volatile("s_waitcnt vmcnt(0)" ::: "memory");
        }
    }
    __syncthreads();
}

struct MapIdent { const float* W; int ld; __device__ __forceinline__ const float* col(int n) const { return W + n; } };
struct MapUp {
    const float* G; const float* U; int ld;
    __device__ __forceinline__ const float* col(int n) const { const int g = n >> 5, j = n & 31; return j < 16 ? G + 16 * g + j : U + 16 * g + (j - 16); }
};
struct MapWin {
    const float* W; int ld;
    __device__ __forceinline__ const float* col(int n) const {
        int src;
        if (n < 512) src = n; else if (n < 1024) src = 2120 + (n - 512); else if (n < 1536) src = 3912 + (n - 1024);
        else if (n < 5632) { const int z = n - 1536; if (z < 1608) src = 512 + z; else if (z < 1792) src = -1; else if (z < 3072) src = 840 + z; else src = 1352 + z; }
        else src = 5448 + (n - 5632);
        return src < 0 ? nullptr : W + src;
    }
};
template <class Map>
__device__ __forceinline__ void conv_item(const Map& mp, int K, bf16* WT, LAS float* scr, int item, int nblk, int lane) {
    const int kb = item / nblk, nb = item % nblk, k0 = 32 * kb, n0 = 32 * nb;
    const float* cp = mp.col(n0 + (lane & 31)); const size_t ld = (size_t)mp.ld;
#pragma unroll
    for (int i = 0; i < 16; ++i) { const int kk = 2 * i + (lane >> 5); scr[kk * 33 + (lane & 31)] = cp ? cp[(size_t)(k0 + kk) * ld] : 0.f; }
    LDS_WAIT(); asm volatile("" ::: "memory");
    const int c = lane & 3;
#pragma unroll
    for (int j = 0; j < 2; ++j) { const int n = (lane >> 2) + 16 * j; const LAS float* s = scr + (8 * c) * 33 + n;
        v4u o; o.x = pg8::cvt_pk_bf16(s[0 * 33], s[1 * 33]); o.y = pg8::cvt_pk_bf16(s[2 * 33], s[3 * 33]); o.z = pg8::cvt_pk_bf16(s[4 * 33], s[5 * 33]); o.w = pg8::cvt_pk_bf16(s[6 * 33], s[7 * 33]);
        *(GAS v4u*)(WT + (size_t)(n0 + n) * K + k0 + 8 * c) = o; }
    LDS_WAIT(); asm volatile("" ::: "memory");
}
__host__ __device__ constexpr int conv_items(int K, int N) { return (K / 32) * (N / 32); }

__device__ __forceinline__ void rownorm_rows(const float* base, const bf16* Y, float s, const float* gpost, float* out, const float* gnext, bf16* XN, int gw, int NGW, int lane, float oscale = 1.f) {
    for (int m = gw; m < M; m += NGW) {
        f32x4 v[4];
#pragma unroll
        for (int j = 0; j < 4; ++j) v[j] = ((const GAS f32x4*)(base + (size_t)m * DM))[lane + 64 * j];
        if (Y) {
            f32x4 y[4]; float ss = 0.f;
#pragma unroll
            for (int j = 0; j < 4; ++j) { const v2u w = ((const GAS v2u*)(Y + (size_t)m * DM))[lane + 64 * j]; y[j] = (f32x4){bflo(w.x), bfhi(w.x), bflo(w.y), bfhi(w.y)};
                ss += (y[j].x * y[j].x + y[j].y * y[j].y) + (y[j].z * y[j].z + y[j].w * y[j].w); }
            const float r = s * __builtin_amdgcn_rsqf(wave_sum(ss) * (1.f / DM) + NORM_EPS);
#pragma unroll
            for (int j = 0; j < 4; ++j) { const f32x4 g = ((const GAS f32x4*)gpost)[lane + 64 * j]; v[j] = v[j] + y[j] * g * r; ((GAS f32x4*)(out + (size_t)m * DM))[lane + 64 * j] = v[j] * oscale; }
        }
        if (XN) {
            float ss = 0.f;
#pragma unroll
            for (int j = 0; j < 4; ++j) ss += (v[j].x * v[j].x + v[j].y * v[j].y) + (v[j].z * v[j].z + v[j].w * v[j].w);
            const float r = __builtin_amdgcn_rsqf(wave_sum(ss) * (1.f / DM) + NORM_EPS);
#pragma unroll
            for (int j = 0; j < 4; ++j) { const f32x4 g = ((const GAS f32x4*)gnext)[lane + 64 * j]; const f32x4 o = v[j] * g * r;
                v2u w; w.x = pk2(o.x, o.y); w.y = pk2(o.z, o.w); ((GAS v2u*)(XN + (size_t)m * DM))[lane + 64 * j] = w; }
        }
    }
}

namespace scan {
template <int CTRL> __device__ __forceinline__ float dpp_add(float x) {
    const int y = __builtin_amdgcn_update_dpp(0, __builtin_bit_cast(int, x), CTRL, 0xF, 0xF, false);
    return x + __builtin_bit_cast(float, y);
}
__device__ __forceinline__ float red8(float x) { x = dpp_add<0xB1>(x); x = dpp_add<0x4E>(x); x = dpp_add<0x141>(x); return x; }
__device__ __forceinline__ float red16(float x) { x = dpp_add<0xB1>(x); x = dpp_add<0x4E>(x); x = dpp_add<0x141>(x); x = dpp_add<0x140>(x); return x; }
__device__ __forceinline__ void ld8(const bf16* p, float (&o)[8]) { const v4u w = *(const GAS v4u*)p; o[0] = bflo(w.x); o[1] = bfhi(w.x); o[2] = bflo(w.y); o[3] = bfhi(w.y); o[4] = bflo(w.z); o[5] = bfhi(w.z); o[6] = bflo(w.w); o[7] = bfhi(w.w); }
}
struct PrepP { const bf16* ZR; bf16* X1; unsigned char* A8; bf16* KI; const float *mu, *w0, *wup, *a0, *aup; };
__device__ __forceinline__ void rwkv_prep(const PrepP& P, LAS unsigned char* lds) {
    const int tid = otid_(), lane = tid & 63, h = __builtin_amdgcn_readfirstlane(tid >> 6), c16 = lane & 15, quad = lane >> 4;
    constexpr int SP = 144;
    LAS unsigned char* TA = lds; LAS unsigned char* AA = lds + 64 * SP;
    bf16x8 bw[4][2], ba[4][2];
#pragma unroll
    for (int ct = 0; ct < 4; ++ct)
#pragma unroll
        for (int s = 0; s < 2; ++s) { const size_t o = (size_t)(32 * s + 8 * quad) * 512 + 64 * h + 16 * ct + c16; const float* gw_ = P.wup + o; const float* ga_ = P.aup + o;
            v4u w; w.x = pk2(gw_[0], gw_[512]); w.y = pk2(gw_[1024], gw_[1536]); w.z = pk2(gw_[2048], gw_[2560]); w.w = pk2(gw_[3072], gw_[3584]); bw[ct][s] = __builtin_bit_cast(bf16x8, w);
            v4u a; a.x = pk2(ga_[0], ga_[512]); a.y = pk2(ga_[1024], ga_[1536]); a.z = pk2(ga_[2048], ga_[2560]); a.w = pk2(ga_[3072], ga_[3584]); ba[ct][s] = __builtin_bit_cast(bf16x8, a); }
    float w0v[4], a0v[4];
#pragma unroll
    for (int ct = 0; ct < 4; ++ct) { w0v[ct] = P.w0[64 * h + 16 * ct + c16]; a0v[ct] = P.a0[64 * h + 16 * ct + c16]; }
    const int stok = tid >> 3, sseg = tid & 7;
#pragma unroll 1
    for (int m0 = blockIdx.x * 64; m0 < M; m0 += gridDim.x * 64) {
        {   const size_t m = (size_t)m0 + stok; const int t = (int)(m & (T - 1));
            *(GAS v4u*)(P.KI + m * 64 + 8 * sseg) = *(const GAS v4u*)(P.ZR + m * ZP + ZC_KI + 8 * sseg);
            float wc[8], ac[8], p8[8];
            scan::ld8(P.ZR + m * ZP + ZC_WC + 8 * sseg, wc); scan::ld8(P.ZR + m * ZP + ZC_AC + 8 * sseg, ac);
            if (t > 0) { scan::ld8(P.ZR + (m - 1) * ZP + ZC_WC + 8 * sseg, p8);
#pragma unroll
                for (int e = 0; e < 8; ++e) wc[e] += (p8[e] - wc[e]) * P.mu[1536 + 8 * sseg + e];
                scan::ld8(P.ZR + (m - 1) * ZP + ZC_AC + 8 * sseg, p8);
#pragma unroll
                for (int e = 0; e < 8; ++e) ac[e] += (p8[e] - ac[e]) * P.mu[1600 + 8 * sseg + e]; }
            else {
#pragma unroll
                for (int e = 0; e < 8; ++e) { wc[e] -= wc[e] * P.mu[1536 + 8 * sseg + e]; ac[e] -= ac[e] * P.mu[1600 + 8 * sseg + e]; } }
            float th[8];
#pragma unroll
            for (int e = 0; e < 8; ++e) th[e] = 1.f - 2.f * __builtin_amdgcn_rcpf(__expf(2.f * wc[e]) + 1.f);
            v4u o; o.x = pk2(th[0], th[1]); o.y = pk2(th[2], th[3]); o.z = pk2(th[4], th[5]); o.w = pk2(th[6], th[7]); *(LAS v4u*)(TA + stok * SP + 16 * sseg) = o;
            v4u q; q.x = pk2(ac[0], ac[1]); q.y = pk2(ac[2], ac[3]); q.z = pk2(ac[4], ac[5]); q.w = pk2(ac[6], ac[7]); *(LAS v4u*)(AA + stok * SP + 16 * sseg) = q;
        }
        __syncthreads();
#pragma unroll 1
        for (int rt = 0; rt < 4; ++rt) {
            f32x4 accw[4], acca[4];
#pragma unroll
            for (int ct = 0; ct < 4; ++ct) { accw[ct] = (f32x4){0.f, 0.f, 0.f, 0.f}; acca[ct] = (f32x4){0.f, 0.f, 0.f, 0.f}; }
#pragma unroll
            for (int s = 0; s < 2; ++s) { const bf16x8 fw = *(const LAS bf16x8*)(TA + (16 * rt + c16) * SP + (32 * s + 8 * quad) * 2), fa = *(const LAS bf16x8*)(AA + (16 * rt + c16) * SP + (32 * s + 8 * quad) * 2);
#pragma unroll
                for (int ct = 0; ct < 4; ++ct) { accw[ct] = __builtin_amdgcn_mfma_f32_16x16x32_bf16(fw, bw[ct][s], accw[ct], 0, 0, 0); acca[ct] = __builtin_amdgcn_mfma_f32_16x16x32_bf16(fa, ba[ct][s], acca[ct], 0, 0, 0); } }
#pragma unroll
            for (int j = 0; j < 4; ++j) { const size_t m = (size_t)m0 + 16 * rt + 4 * quad + j;
#pragma unroll
                for (int ct = 0; ct < 4; ++ct) { const int ch = 64 * h + 16 * ct + c16;
                    const float sg = sigm(w0v[ct] + accw[ct][j]);
                    const float x1 = 1.f - __expf(-0.6065306597126334f * sg);
                    const float a = sigm(a0v[ct] + acca[ct][j]);
                    P.X1[m * 512 + ch] = (bf16)f2bf(x1);
                    P.A8[m * 512 + ch] = (unsigned char)(int)(a * 255.f + 0.5f); } }
        }
        __syncthreads();
    }
}

struct ScanP { const bf16* Q3; const bf16* ZR; const bf16* X1; const unsigned char* A8; bf16* yraw; float* rdotk; const float *mu, *k_k, *k_a, *r_k; };
namespace scan {
constexpr int TB = 32, NBLK = T / TB;
constexpr int CB_W = 0, CB_B = 8192, CB_K = 16384, CB_KW = 24576, CB_V = 40960, CB_BR = 43008, CB_KR = 43136, CB_SA = 43264, CB_YP = 45312, CBSZ = 78080;
constexpr int L_END = 2 * CBSZ;
static_assert(L_END <= LDS_MISC, "scan LDS");
}
__device__ __forceinline__ void rwkv_scan_unit(const ScanP& P, int unit, LAS unsigned char* lds) {
    using namespace scan;
    const int tid = otid_(), wid = __builtin_amdgcn_readfirstlane(tid >> 6), lane = tid & 63;
    const int b = unit >> 5, h = (unit >> 2) & 7, vq = unit & 3;
    const size_t mrow0 = (size_t)b * T;
    if (wid >= 4) {
        const int pw = wid - 4, tokl = lane >> 3, seg = lane & 7, c0 = 8 * seg, hc0 = 64 * h + c0;
        float mu_r[8], mu_k[8], kkv[8], kav[8], rkv[8];
#pragma unroll
        for (int e = 0; e < 8; ++e) { mu_r[e] = P.mu[hc0 + e]; mu_k[e] = P.mu[512 + hc0 + e]; kkv[e] = P.k_k[hc0 + e]; kav[e] = P.k_a[hc0 + e]; rkv[e] = P.r_k[hc0 + e]; }
        const int vc0 = 64 * h + 16 * vq + 2 * seg;
        const float mu_v0 = P.mu[1024 + vc0], mu_v1 = P.mu[1024 + vc0 + 1];
        const int ptid = pw * 64 + lane;
        v4u nr, nrp, nk, nkp, nx; v2u na; unsigned nv, nvp;
#define SCAN_LOAD(nb_) do { const int t_ = (nb_) * TB + 8 * pw + tokl; const size_t m_ = mrow0 + t_, mp_ = t_ > 0 ? m_ - 1 : m_; \
            nr = *(const GAS v4u*)(P.Q3 + m_ * QP + 512 + hc0); nrp = *(const GAS v4u*)(P.Q3 + mp_ * QP + 512 + hc0); \
            nk = *(const GAS v4u*)(P.ZR + m_ * ZP + ZC_RK + hc0); nkp = *(const GAS v4u*)(P.ZR + mp_ * ZP + ZC_RK + hc0); \
            nx = *(const GAS v4u*)(P.X1 + m_ * 512 + hc0); na = *(const GAS v2u*)(P.A8 + m_ * 512 + hc0); \
            nv = *(const GAS unsigned*)(P.ZR + m_ * ZP + ZC_RV + vc0); nvp = *(const GAS unsigned*)(P.ZR + mp_ * ZP + ZC_RV + vc0); } while (0)
#define UNPK8(w_, o_) do { o_[0] = bflo(w_.x); o_[1] = bfhi(w_.x); o_[2] = bflo(w_.y); o_[3] = bfhi(w_.y); o_[4] = bflo(w_.z); o_[5] = bfhi(w_.z); o_[6] = bflo(w_.w); o_[7] = bfhi(w_.w); } while (0)
        SCAN_LOAD(0);
        for (int blk = -1; blk < NBLK; ++blk) {
            const int nb = blk + 1;
            LAS unsigned char* cb = lds + (nb & 1) * CBSZ;
            if (blk >= 1) {
                const int tok = ptid >> 3, v2 = (ptid & 7) * 2;
                const LAS float* YPp = (const LAS float*)(cb + CB_YP) + (tok * 16 + v2) * 16;
                float y0 = 0.f, y1 = 0.f;
#pragma unroll
                for (int q4 = 0; q4 < 4; ++q4) { const f32x4 a = *(const LAS f32x4*)(YPp + 4 * q4), c = *(const LAS f32x4*)(YPp + 16 + 4 * q4); y0 += (a.x + a.y) + (a.z + a.w); y1 += (c.x + c.y) + (c.z + c.w); }
                const float br = *(const LAS float*)(cb + CB_BR + tok * 4), kr = *(const LAS float*)(cb + CB_KR + tok * 4);
                const f32x2 sa = *(const LAS f32x2*)(cb + CB_SA + (tok * 16 + v2) * 4), vv = *(const LAS f32x2*)(cb + CB_V + (tok * 16 + v2) * 4);
                y0 += sa.x * br + vv.x * kr; y1 += sa.y * br + vv.y * kr;
                const size_t m = mrow0 + (size_t)(blk - 1) * TB + tok;
                *(GAS unsigned*)(P.yraw + m * 512 + 64 * h + 16 * vq + v2) = pk2(y0, y1);
                LDS_WAIT(); asm volatile("" ::: "memory");
            }
            if (nb < NBLK) {
                const int t = nb * TB + 8 * pw + tokl; const size_t m = mrow0 + t;
                float r8[8], k8[8], p8[8], x8[8], a8[8];
                const v4u cr = nr, crp = nrp, ck = nk, ckp = nkp, cx = nx; const v2u ca = na; const unsigned cv = nv, cvp = nvp;
                if (nb + 1 < NBLK) SCAN_LOAD(nb + 1);
                UNPK8(cr, r8); UNPK8(ck, k8); UNPK8(cx, x8);
                { const float sc = 1.f / 255.f;
                  a8[0] = (float)(ca.x & 255u) * sc; a8[1] = (float)((ca.x >> 8) & 255u) * sc; a8[2] = (float)((ca.x >> 16) & 255u) * sc; a8[3] = (float)(ca.x >> 24) * sc;
                  a8[4] = (float)(ca.y & 255u) * sc; a8[5] = (float)((ca.y >> 8) & 255u) * sc; a8[6] = (float)((ca.y >> 16) & 255u) * sc; a8[7] = (float)(ca.y >> 24) * sc; }
                float v0 = bflo(cv), v1 = bfhi(cv);
                if (t > 0) {
                    UNPK8(crp, p8);
#pragma unroll
                    for (int e = 0; e < 8; ++e) r8[e] += (p8[e] - r8[e]) * mu_r[e];
                    UNPK8(ckp, p8);
#pragma unroll
                    for (int e = 0; e < 8; ++e) k8[e] += (p8[e] - k8[e]) * mu_k[e];
                    v0 += (bflo(cvp) - v0) * mu_v0; v1 += (bfhi(cvp) - v1) * mu_v1;
                } else {
#pragma unroll
                    for (int e = 0; e < 8; ++e) { r8[e] -= r8[e] * mu_r[e]; k8[e] -= k8[e] * mu_k[e]; }
                    v0 -= v0 * mu_v0; v1 -= v1 * mu_v1;
                }
                float kk8[8]; { float ss = 0.f;
#pragma unroll
                  for (int e = 0; e < 8; ++e) { kk8[e] = k8[e] * kkv[e]; ss += kk8[e] * kk8[e]; }
                  ss = red8(ss); const float inv = 1.f / fmaxf(sqrtf(ss), 1e-12f);
#pragma unroll
                  for (int e = 0; e < 8; ++e) kk8[e] *= inv; }
                float w8[8], bb[8], km[8], wr[8]; float brp = 0.f, krp = 0.f, rkp = 0.f;
#pragma unroll
                for (int e = 0; e < 8; ++e) {
                    w8[e] = 1.f - x8[e];
                    bb[e] = kk8[e] * a8[e]; km[e] = k8[e] * (1.f + (a8[e] - 1.f) * kav[e]); wr[e] = w8[e] * r8[e];
                    brp += bb[e] * r8[e]; krp += km[e] * r8[e]; rkp += r8[e] * km[e] * rkv[e];
                }
                brp = red8(brp); krp = red8(krp); rkp = red8(rkp);
                const int ti = 8 * pw + tokl;
                *(LAS f32x4*)(cb + CB_W + (ti * 64 + c0) * 4) = (f32x4){w8[0], w8[1], w8[2], w8[3]}; *(LAS f32x4*)(cb + CB_W + (ti * 64 + c0 + 4) * 4) = (f32x4){w8[4], w8[5], w8[6], w8[7]};
                *(LAS f32x4*)(cb + CB_B + (ti * 64 + c0) * 4) = (f32x4){bb[0], bb[1], bb[2], bb[3]}; *(LAS f32x4*)(cb + CB_B + (ti * 64 + c0 + 4) * 4) = (f32x4){bb[4], bb[5], bb[6], bb[7]};
                *(LAS f32x4*)(cb + CB_K + (ti * 64 + c0) * 4) = (f32x4){km[0], km[1], km[2], km[3]}; *(LAS f32x4*)(cb + CB_K + (ti * 64 + c0 + 4) * 4) = (f32x4){km[4], km[5], km[6], km[7]};
#pragma unroll
                for (int e = 0; e < 8; e += 2) *(LAS f32x4*)(cb + CB_KW + (ti * 64 + c0 + e) * 8) = (f32x4){kk8[e], wr[e], kk8[e + 1], wr[e + 1]};
                *(LAS f32x2*)(cb + CB_V + (ti * 16 + 2 * seg) * 4) = (f32x2){v0, v1};
                if (seg == 0) { *(LAS float*)(cb + CB_BR + ti * 4) = brp; *(LAS float*)(cb + CB_KR + ti * 4) = krp; if (vq == 0) P.rdotk[m * 8 + h] = rkp; }
            }
            __syncthreads();
        }
        { const LAS unsigned char* cb = lds + ((NBLK - 1) & 1) * CBSZ;
          const int tok = ptid >> 3, v2 = (ptid & 7) * 2;
          const LAS float* YPp = (const LAS float*)(cb + CB_YP) + (tok * 16 + v2) * 16;
          float y0 = 0.f, y1 = 0.f;
#pragma unroll
          for (int q4 = 0; q4 < 4; ++q4) { const f32x4 a = *(const LAS f32x4*)(YPp + 4 * q4), c = *(const LAS f32x4*)(YPp + 16 + 4 * q4); y0 += (a.x + a.y) + (a.z + a.w); y1 += (c.x + c.y) + (c.z + c.w); }
          const float br = *(const LAS float*)(cb + CB_BR + tok * 4), kr = *(const LAS float*)(cb + CB_KR + tok * 4);
          const f32x2 sa = *(const LAS f32x2*)(cb + CB_SA + (tok * 16 + v2) * 4), vv = *(const LAS f32x2*)(cb + CB_V + (tok * 16 + v2) * 4);
          y0 += sa.x * br + vv.x * kr; y1 += sa.y * br + vv.y * kr;
          const size_t m = mrow0 + (size_t)(NBLK - 1) * TB + tok;
          *(GAS unsigned*)(P.yraw + m * 512 + 64 * h + 16 * vq + v2) = pk2(y0, y1); }
    } else {
        const int vi = 4 * wid + (lane >> 4), cg = lane & 15;
        f32x2 s01 = {0.f, 0.f}, s23 = {0.f, 0.f};
        __syncthreads();
        __builtin_amdgcn_s_setprio(3);
        const unsigned lo4 = (unsigned)(4 * cg) * 4u, lo8 = (unsigned)(4 * cg) * 8u;
        for (int blk = 0; blk < NBLK; ++blk) {
            const LAS unsigned char* cb = lds + (blk & 1) * CBSZ;
            f32x4 kwa = *(const LAS f32x4*)(cb + CB_KW + lo8), kwb = *(const LAS f32x4*)(cb + CB_KW + lo8 + 16);
            f32x4 w4 = *(const LAS f32x4*)(cb + CB_W + lo4), b4 = *(const LAS f32x4*)(cb + CB_B + lo4), k4 = *(const LAS f32x4*)(cb + CB_K + lo4);
            float vv = *(const LAS float*)(cb + CB_V + vi * 4);
#pragma unroll 4
            for (int tok = 0; tok < TB; ++tok) {
                const int tn = tok + 1 < TB ? tok + 1 : tok;
                const f32x4 nkwa = *(const LAS f32x4*)(cb + CB_KW + tn * 512 + lo8), nkwb = *(const LAS f32x4*)(cb + CB_KW + tn * 512 + lo8 + 16);
                const f32x4 nw4 = *(const LAS f32x4*)(cb + CB_W + tn * 256 + lo4), nb4 = *(const LAS f32x4*)(cb + CB_B + tn * 256 + lo4), nk4 = *(const LAS f32x4*)(cb + CB_K + tn * 256 + lo4);
                const float nvv = *(const LAS float*)(cb + CB_V + (tn * 16 + vi) * 4);
                f32x2 p = (f32x2){s01.x, s01.x} * (f32x2){kwa.x, kwa.y};
                p += (f32x2){s01.y, s01.y} * (f32x2){kwa.z, kwa.w};
                p += (f32x2){s23.x, s23.x} * (f32x2){kwb.x, kwb.y};
                p += (f32x2){s23.y, s23.y} * (f32x2){kwb.z, kwb.w};
                *(LAS float*)(cb + CB_YP + ((tok * 16 + vi) * 16 + cg) * 4) = p.y;
                const f32x2 t01 = s01 * (f32x2){w4.x, w4.y} + (f32x2){k4.x, k4.y} * vv, t23 = s23 * (f32x2){w4.z, w4.w} + (f32x2){k4.z, k4.w} * vv;
                const float d1 = red16(p.x);
                s01 = t01 - (f32x2){b4.x, b4.y} * d1; s23 = t23 - (f32x2){b4.z, b4.w} * d1;
                *(LAS float*)(cb + CB_SA + (tok * 16 + vi) * 4) = -d1;
                kwa = nkwa; kwb = nkwb; w4 = nw4; b4 = nb4; k4 = nk4; vv = nvv;
            }
            __syncthreads();
        }
        __builtin_amdgcn_s_setprio(0);
    }
    __syncthreads();
}

struct Dsa1P { const bf16* ZR; const bf16* KI; unsigned* bitm; gu32* done; };
namespace dsa1 {
constexpr int CAP = 769  , PRUNE_AT = 512, KEEP = 256;
constexpr int L_BUF = 0, L_CNT = 32 * CAP * 4, L_THR = L_CNT + 128, L_THRK = L_THR + 128, L_HIST = ((L_THRK + 128 + 15) / 16) * 16, L_MROW = L_HIST + 8 * 1024, L_QF = L_MROW + 8 * 1024, QFP = 1040, L_END = L_QF + 32 * QFP;
static_assert(L_END <= LDS_MISC, "dsa1 LDS");
__device__ __forceinline__ unsigned packkey(float s, int keyidx) { const unsigned bits = __float_as_uint(s); const unsigned u = bits ^ ((unsigned)((int)bits >> 31) | 0x80000000u); return (u & 0xFFFFE000u) | (unsigned)(8191 - keyidx); }
__device__ __forceinline__ float thr_of(unsigned key) { const unsigned u = key & 0xFFFFE000u; const unsigned bits = (u & 0x80000000u) ? (u ^ 0x80000000u) : ~u; return __uint_as_float(bits); }
__device__ __forceinline__ int wave_prefix_incl(int v) {
    v += __builtin_amdgcn_update_dpp(0, v, 0x111, 0xF, 0xF, true);
    v += __builtin_amdgcn_update_dpp(0, v, 0x112, 0xF, 0xF, true);
    v += __builtin_amdgcn_update_dpp(0, v, 0x114, 0xF, 0xF, true);
    v += __builtin_amdgcn_update_dpp(0, v, 0x118, 0xF, 0xF, true);
    v += __builtin_amdgcn_update_dpp(0, v, 0x142, 0xA, 0xF, false);
    v += __builtin_amdgcn_update_dpp(0, v, 0x143, 0xC, 0xF, false);
    return v;
}
__device__ __forceinline__ void prune(LAS unsigned char* lds, int qq, int wid, int lane, bool exact) {
    asm volatile("" : "+v"(lane));
    LAS unsigned* buf = (LAS unsigned*)(lds + L_BUF) + qq * CAP; LAS unsigned* cnt = (LAS unsigned*)(lds + L_CNT); LAS float* thr = (LAS float*)(lds + L_THR); LAS unsigned* thrk = (LAS unsigned*)(lds + L_THRK);
    LAS unsigned* hist = (LAS unsigned*)(lds + L_HIST) + wid * 256;
    const int n = (int)cnt[qq];
    unsigned e[12];
#pragma unroll
    for (int k = 0; k < 12; ++k) e[k] = (lane + 64 * k < n) ? buf[lane + 64 * k] : 0u;
    const unsigned tk = thrk[qq];
    unsigned cut = 0u; bool have = false;
    if (!exact && tk != 0u) {
        const unsigned base16 = tk >> 16;
        *(LAS v4u*)(hist + 4 * lane) = (v4u){0u, 0u, 0u, 0u};
        LDS_WAIT(); asm volatile("" ::: "memory");
#pragma unroll
        for (int k = 0; k < 12; ++k) if (lane + 64 * k < n) { unsigned bn = (e[k] >> 16) - base16; bn = bn > 255u ? 255u : bn; (void)__hip_atomic_fetch_add(hist + bn, 1u, __ATOMIC_RELAXED, __HIP_MEMORY_SCOPE_WORKGROUP); }
        LDS_WAIT(); asm volatile("" ::: "memory");
        const int rl = 63 - lane;
        const v4u hv = *(const LAS v4u*)(hist + 4 * rl);
        const int tot = (int)(hv.x + hv.y + hv.z + hv.w);
        int above = wave_prefix_incl(tot) - tot; int dsel = -1, csel = 0;
        { const int h3 = (int)hv.w, h2 = (int)hv.z, h1 = (int)hv.y, h0 = (int)hv.x;
          if (above < KEEP && KEEP <= above + h3) { dsel = 4 * rl + 3; csel = above + h3; } above += h3;
          if (above < KEEP && KEEP <= above + h2) { dsel = 4 * rl + 2; csel = above + h2; } above += h2;
          if (above < KEEP && KEEP <= above + h1) { dsel = 4 * rl + 1; csel = above + h1; } above += h1;
          if (above < KEEP && KEEP <= above + h0) { dsel = 4 * rl + 0; csel = above + h0; } }
        const unsigned long long bm = __ballot(dsel >= 0);
        const int src = bm ? (int)__builtin_ctzll(bm) : 0;
        const int d = __builtin_amdgcn_readlane(dsel, src), cd = __builtin_amdgcn_readlane(csel, src);
        LDS_WAIT(); asm volatile("" ::: "memory");
        if (bm != 0ull && cd <= KEEP + 128) { cut = (base16 + (unsigned)d) << 16; have = true; }
    }
    if (!have) {
        unsigned prefix = 0u; int want = KEEP;
#pragma unroll 1
        for (int p = 0; p < 4; ++p) {
            const int shift = 24 - 8 * p;
            *(LAS v4u*)(hist + 4 * lane) = (v4u){0u, 0u, 0u, 0u};
            LDS_WAIT(); asm volatile("" ::: "memory");
#pragma unroll
            for (int k = 0; k < 12; ++k) { const bool in = (lane + 64 * k < n) && (p == 0 || (e[k] >> (shift + 8)) == (prefix >> (shift + 8)));
                if (in) (void)__hip_atomic_fetch_add(hist + ((e[k] >> shift) & 255u), 1u, __ATOMIC_RELAXED, __HIP_MEMORY_SCOPE_WORKGROUP); }
            LDS_WAIT(); asm volatile("" ::: "memory");
            const int rl = 63 - lane;
            const v4u hv = *(const LAS v4u*)(hist + 4 * rl);
            const int tot = (int)(hv.x + hv.y + hv.z + hv.w);
            int above = wave_prefix_incl(tot) - tot;
            int dsel = -1, asel = 0;
            { const int h3 = (int)hv.w, h2 = (int)hv.z, h1 = (int)hv.y, h0 = (int)hv.x;
              if (above < want && want <= above + h3) { dsel = 4 * rl + 3; asel = above; } above += h3;
              if (above < want && want <= above + h2) { dsel = 4 * rl + 2; asel = above; } above += h2;
              if (above < want && want <= above + h1) { dsel = 4 * rl + 1; asel = above; } above += h1;
              if (above < want && want <= above + h0) { dsel = 4 * rl + 0; asel = above; } }
            const unsigned long long bm = __ballot(dsel >= 0);
            const int src = bm ? (int)__builtin_ctzll(bm) : 0;
            const int d = __builtin_amdgcn_readlane(dsel, src), ab = __builtin_amdgcn_readlane(asel, src);
            prefix |= ((unsigned)(d < 0 ? 0 : d)) << shift; want -= ab;
            LDS_WAIT(); asm volatile("" ::: "memory");
        }
        cut = prefix;
    }
    int base = 0;
#pragma unroll
    for (int k = 0; k < 12; ++k) { const bool keep = (lane + 64 * k < n) && e[k] >= cut; const unsigned long long mk = __ballot(keep);
        const int pos = base + (int)__builtin_amdgcn_mbcnt_hi((unsigned)(mk >> 32), __builtin_amdgcn_mbcnt_lo((unsigned)mk, 0u));
        if (keep) buf[pos] = e[k]; base += (int)__builtin_popcountll(mk); }
    if (lane == 0) { cnt[qq] = (unsigned)base; thr[qq] = thr_of(cut); thrk[qq] = cut; }
    LDS_WAIT(); asm volatile("" ::: "memory");
}
}
__device__ __forceinline__ void dsa1_unit(const Dsa1P& P, int u, LAS unsigned char* lds) {
    using namespace dsa1;
    const int tid = otid_(), wid = __builtin_amdgcn_readfirstlane(tid >> 6), lane = tid & 63, q = lane & 31, hi = lane >> 5;
    const int b = u & 1, qb32 = 255 - (u >> 1), t0 = 32 * qb32;
    const size_t brow = (size_t)b * T;
    LAS unsigned* buf = (LAS unsigned*)(lds + L_BUF); LAS unsigned* cnt = (LAS unsigned*)(lds + L_CNT); LAS float* thr = (LAS float*)(lds + L_THR);
    if (tid < 32) { cnt[tid] = 0u; thr[tid] = -__builtin_inff(); ((LAS unsigned*)(lds + L_THRK))[tid] = 0u; }
    const bf16* qrow = P.ZR + (brow + t0 + q) * ZP;
    { const int r = tid >> 4, sg = tid & 15; const bf16* src = P.ZR + (brow + t0 + r) * ZP + ZC_QI + 32 * sg;
#pragma unroll
      for (int j = 0; j < 4; ++j) *(LAS v4u*)(lds + L_QF + r * QFP + 64 * sg + 16 * j) = *(const GAS v4u*)(src + 8 * j); }
    float wq[8];
    { const v4u w = *(const GAS v4u*)(qrow + ZC_WI); const float c = 0.35355339059327373f * 0.125f;
      wq[0] = bflo(w.x) * c; wq[1] = bfhi(w.x) * c; wq[2] = bflo(w.y) * c; wq[3] = bfhi(w.y) * c; wq[4] = bflo(w.z) * c; wq[5] = bfhi(w.z) * c; wq[6] = bflo(w.w) * c; wq[7] = bfhi(w.w) * c; }
    const int tq = t0 + q;
    const int nsteps = (t0 + 32 + 255) >> 8;
    __syncthreads();
    float th = -__builtin_inff();
    bf16x8 afn[4];
    { const int k0 = 32 * wid; const bf16* krow = P.KI + (brow + (k0 <= t0 + 31 ? k0 : 0) + q) * 64 + 8 * hi;
#pragma unroll
      for (int s = 0; s < 4; ++s) afn[s] = *(const GAS bf16x8*)(krow + 16 * s); }
    for (int st = 0; st < nsteps; ++st) {
        const int key0 = 256 * st + 32 * wid;
        bf16x8 af[4];
#pragma unroll
        for (int s = 0; s < 4; ++s) af[s] = afn[s];
        { const int k1 = key0 + 256; const bf16* krow = P.KI + (brow + (k1 <= t0 + 31 ? k1 : 0) + q) * 64 + 8 * hi;
#pragma unroll
          for (int s = 0; s < 4; ++s) afn[s] = *(const GAS bf16x8*)(krow + 16 * s); }
        if (key0 <= t0 + 31) {
            f32x16 sc;
#pragma unroll
            for (int i = 0; i < 16; ++i) sc[i] = 0.f;
            unsigned qfo = (unsigned)(L_QF + q * QFP + 16 * hi); asm volatile("" : "+v"(qfo));
#pragma unroll
            for (int hd = 0; hd < 8; ++hd) {
                f32x16 acc;
#pragma unroll
                for (int i = 0; i < 16; ++i) acc[i] = 0.f;
#pragma unroll
                for (int s = 0; s < 4; ++s) { const bf16x8 qb = *(const LAS bf16x8*)(lds + qfo + hd * 128 + 32 * s);
                    acc = __builtin_amdgcn_mfma_f32_32x32x16_bf16(af[s], qb, acc, 0, 0, 0); }
#pragma unroll
                for (int i = 0; i < 16; ++i) sc[i] = fmaf(fmaxf(acc[i], 0.f), wq[hd], sc[i]);
                __builtin_amdgcn_sched_barrier(0);
            }
            const bool diag = key0 + 31 > t0;
            unsigned pm = 0u;
#pragma unroll
            for (int i = 0; i < 16; ++i) { const int kidx = key0 + (i & 3) + 8 * (i >> 2) + 4 * hi; const bool ok = (sc[i] >= th) && (!diag || kidx <= tq); pm |= ok ? (1u << i) : 0u; }
            const int np = __builtin_popcount(pm);
            if (np > 0) {
                int pos = (int)__hip_atomic_fetch_add(cnt + q, (unsigned)np, __ATOMIC_RELAXED, __HIP_MEMORY_SCOPE_WORKGROUP);
                LAS unsigned* bq = buf + q * CAP;
#pragma unroll
                for (int i = 0; i < 16; ++i) if (pm & (1u << i)) { const int kidx = key0 + (i & 3) + 8 * (i >> 2) + 4 * hi; bq[pos] = packkey(sc[i], kidx); ++pos; }
            }
        }
        __syncthreads();
        { unsigned nm = (unsigned)__ballot(cnt[q] > (unsigned)PRUNE_AT); int i = 0;
          while (nm) { const int qq = __builtin_ctz(nm); nm &= nm - 1u; if ((i & 7) == wid) prune(lds, qq, wid, lane, false); ++i; } }
        __syncthreads();
        th = thr[q];
    }
    LAS unsigned* mrow = (LAS unsigned*)(lds + L_MROW) + wid * 256;
#pragma unroll 1
    for (int k = 0; k < 4; ++k) {
        const int qq = wid + 8 * k;
        if (cnt[qq] > (unsigned)KEEP) prune(lds, qq, wid, lane, true);
        const int nf = (int)cnt[qq];
        *(LAS v4u*)(mrow + 4 * lane) = (v4u){0u, 0u, 0u, 0u};
        LDS_WAIT(); asm volatile("" ::: "memory");
#pragma unroll
        for (int j = 0; j < 4; ++j) { const int idx = lane + 64 * j; if (idx < nf) { const unsigned e = buf[qq * CAP + idx]; const unsigned key = 8191u - (e & 0x1FFFu); (void)__hip_atomic_fetch_or(mrow + (key >> 5), 1u << (key & 31u), __ATOMIC_RELAXED, __HIP_MEMORY_SCOPE_WORKGROUP); } }
        LDS_WAIT(); asm volatile("" ::: "memory");
        unsigned long long* grow = (unsigned long long*)(P.bitm + (brow + t0 + qq) * 256);
#pragma unroll
        for (int j = 0; j < 2; ++j) { const int w2 = lane + 64 * j; const unsigned long long v = (unsigned long long)mrow[2 * w2] | ((unsigned long long)mrow[2 * w2 + 1] << 32);
            __hip_atomic_store(grow + w2, v, RLX_AGENT); }
        LDS_WAIT(); asm volatile("" ::: "memory");
    }
    VM_WAIT();
    __syncthreads();
    if (tid == 0) __hip_atomic_fetch_add(P.done + 64 * (b * 32 + (t0 >> 8)), 1u, RLX_AGENT);
}

struct RPostP { const bf16* ZR; bf16* Q3; const bf16* yraw; const float* rdotk; const float *mu, *gup, *lnw, *lnb; };
__device__ __forceinline__ void rwkv_post(const RPostP& P, LAS unsigned char* lds) {
    const int tid = otid_(), lane = tid & 63, h = __builtin_amdgcn_readfirstlane(tid >> 6), c16 = lane & 15, quad = lane >> 4;
    constexpr int SP = 272;
    LAS float* GT = (LAS float*)(lds + 64 * SP);
    bf16x8 bfr[4][4];
#pragma unroll
    for (int ct = 0; ct < 4; ++ct)
#pragma unroll
        for (int s = 0; s < 4; ++s) { const float* gp = P.gup + (size_t)(32 * s + 8 * quad) * 512 + 64 * h + 16 * ct + c16;
            v4u w; w.x = pk2(gp[0], gp[512]); w.y = pk2(gp[1024], gp[1536]); w.z = pk2(gp[2048], gp[2560]); w.w = pk2(gp[3072], gp[3584]); bfr[ct][s] = __builtin_bit_cast(bf16x8, w); }
    float muv[4], lnw[4], lnb[4];
#pragma unroll
    for (int ct = 0; ct < 4; ++ct) { const int ch = 64 * h + 16 * ct + c16; muv[ct] = P.mu[1024 + ch]; lnw[ct] = P.lnw[ch]; lnb[ct] = P.lnb[ch]; }
    const int stok = tid >> 3, sseg = tid & 7;
#pragma unroll 1
    for (int m0 = blockIdx.x * 64; m0 < M; m0 += gridDim.x * 64) {
        {   const size_t m = (size_t)m0 + stok; const int t = (int)(m & (T - 1));
            float gv[16], pv[16];
            { const v4u a = *(const GAS v4u*)(P.ZR + m * ZP + ZC_GC + 16 * sseg), c = *(const GAS v4u*)(P.ZR + m * ZP + ZC_GC + 16 * sseg + 8);
              gv[0] = bflo(a.x); gv[1] = bfhi(a.x); gv[2] = bflo(a.y); gv[3] = bfhi(a.y); gv[4] = bflo(a.z); gv[5] = bfhi(a.z); gv[6] = bflo(a.w); gv[7] = bfhi(a.w);
              gv[8] = bflo(c.x); gv[9] = bfhi(c.x); gv[10] = bflo(c.y); gv[11] = bfhi(c.y); gv[12] = bflo(c.z); gv[13] = bfhi(c.z); gv[14] = bflo(c.w); gv[15] = bfhi(c.w); }
            if (t > 0) { const v4u a = *(const GAS v4u*)(P.ZR + (m - 1) * ZP + ZC_GC + 16 * sseg), c = *(const GAS v4u*)(P.ZR + (m - 1) * ZP + ZC_GC + 16 * sseg + 8);
              pv[0] = bflo(a.x); pv[1] = bfhi(a.x); pv[2] = bflo(a.y); pv[3] = bfhi(a.y); pv[4] = bflo(a.z); pv[5] = bfhi(a.z); pv[6] = bflo(a.w); pv[7] = bfhi(a.w);
              pv[8] = bflo(c.x); pv[9] = bfhi(c.x); pv[10] = bflo(c.y); pv[11] = bfhi(c.y); pv[12] = bflo(c.z); pv[13] = bfhi(c.z); pv[14] = bflo(c.w); pv[15] = bfhi(c.w); }
            else {
#pragma unroll
              for (int e = 0; e < 16; ++e) pv[e] = 0.f; }
            float sg[16];
#pragma unroll
            for (int e = 0; e < 16; ++e) { const float mu = P.mu[1664 + 16 * sseg + e]; sg[e] = sigm(gv[e] + (pv[e] - gv[e]) * mu); }
            v4u o0, o1; o0.x = pk2(sg[0], sg[1]); o0.y = pk2(sg[2], sg[3]); o0.z = pk2(sg[4], sg[5]); o0.w = pk2(sg[6], sg[7]); o1.x = pk2(sg[8], sg[9]); o1.y = pk2(sg[10], sg[11]); o1.z = pk2(sg[12], sg[13]); o1.w = pk2(sg[14], sg[15]);
            *(LAS v4u*)(lds + stok * SP + 32 * sseg) = o0; *(LAS v4u*)(lds + stok * SP + 32 * sseg + 16) = o1;
        }
        __syncthreads();
#pragma unroll 1
        for (int rt = 0; rt < 4; ++rt) {
            f32x4 acc[4];
#pragma unroll
            for (int ct = 0; ct < 4; ++ct) acc[ct] = (f32x4){0.f, 0.f, 0.f, 0.f};
#pragma unroll
            for (int s = 0; s < 4; ++s) { const bf16x8 af = *(const LAS bf16x8*)(lds + (16 * rt + c16) * SP + (32 * s + 8 * quad) * 2);
#pragma unroll
                for (int ct = 0; ct < 4; ++ct) acc[ct] = __builtin_amdgcn_mfma_f32_16x16x32_bf16(af, bfr[ct][s], acc[ct], 0, 0, 0); }
#pragma unroll
            for (int ct = 0; ct < 4; ++ct)
#pragma unroll
                for (int j = 0; j < 4; ++j) GT[(4 * quad + j) * 512 + 64 * h + 16 * ct + c16] = acc[ct][j];
            __syncthreads();
            {   const int vtok = tid >> 5, vseg = tid & 31, ch0 = 16 * vseg, vh = vseg >> 2;
                const size_t m = (size_t)m0 + 16 * rt + vtok; const int t = (int)(m & (T - 1));
                float y[16], vv[16], vp[16], g[16];
                { const v4u a = *(const GAS v4u*)(P.yraw + m * 512 + ch0), c = *(const GAS v4u*)(P.yraw + m * 512 + ch0 + 8);
                  y[0] = bflo(a.x); y[1] = bfhi(a.x); y[2] = bflo(a.y); y[3] = bfhi(a.y); y[4] = bflo(a.z); y[5] = bfhi(a.z); y[6] = bflo(a.w); y[7] = bfhi(a.w);
                  y[8] = bflo(c.x); y[9] = bfhi(c.x); y[10] = bflo(c.y); y[11] = bfhi(c.y); y[12] = bflo(c.z); y[13] = bfhi(c.z); y[14] = bflo(c.w); y[15] = bfhi(c.w); }
                { const v4u a = *(const GAS v4u*)(P.ZR + m * ZP + ZC_RV + ch0), c = *(const GAS v4u*)(P.ZR + m * ZP + ZC_RV + ch0 + 8);
                  vv[0] = bflo(a.x); vv[1] = bfhi(a.x); vv[2] = bflo(a.y); vv[3] = bfhi(a.y); vv[4] = bflo(a.z); vv[5] = bfhi(a.z); vv[6] = bflo(a.w); vv[7] = bfhi(a.w);
                  vv[8] = bflo(c.x); vv[9] = bfhi(c.x); vv[10] = bflo(c.y); vv[11] = bfhi(c.y); vv[12] = bflo(c.z); vv[13] = bfhi(c.z); vv[14] = bflo(c.w); vv[15] = bfhi(c.w); }
                if (t > 0) { const v4u a = *(const GAS v4u*)(P.ZR + (m - 1) * ZP + ZC_RV + ch0), c = *(const GAS v4u*)(P.ZR + (m - 1) * ZP + ZC_RV + ch0 + 8);
                  vp[0] = bflo(a.x); vp[1] = bfhi(a.x); vp[2] = bflo(a.y); vp[3] = bfhi(a.y); vp[4] = bflo(a.z); vp[5] = bfhi(a.z); vp[6] = bflo(a.w); vp[7] = bfhi(a.w);
                  vp[8] = bflo(c.x); vp[9] = bfhi(c.x); vp[10] = bflo(c.y); vp[11] = bfhi(c.y); vp[12] = bflo(c.z); vp[13] = bfhi(c.z); vp[14] = bflo(c.w); vp[15] = bfhi(c.w); }
                else {
#pragma unroll
                  for (int e = 0; e < 16; ++e) vp[e] = 0.f; }
#pragma unroll
                for (int e4 = 0; e4 < 4; ++e4) { const f32x4 gq = *(const LAS f32x4*)(GT + vtok * 512 + ch0 + 4 * e4); g[4 * e4] = gq.x; g[4 * e4 + 1] = gq.y; g[4 * e4 + 2] = gq.z; g[4 * e4 + 3] = gq.w; }
                float sm = 0.f;
#pragma unroll
                for (int e = 0; e < 16; ++e) sm += y[e];
                sm = scan::dpp_add<0xB1>(sm); sm = scan::dpp_add<0x4E>(sm);
                const float mean = sm * (1.f / 64.f); float vs = 0.f;
#pragma unroll
                for (int e = 0; e < 16; ++e) { y[e] -= mean; vs += y[e] * y[e]; }
                vs = scan::dpp_add<0xB1>(vs); vs = scan::dpp_add<0x4E>(vs);
                const float rstd = __builtin_amdgcn_rsqf(vs * (1.f / 64.f) + 64e-5f);
                const float rk = P.rdotk[m * 8 + vh];
                unsigned ow[8];
#pragma unroll
                for (int e = 0; e < 16; e += 2) { float o2[2];
#pragma unroll
                    for (int d = 0; d < 2; ++d) { const int ch = ch0 + e + d; const float v = vv[e + d] + (vp[e + d] - vv[e + d]) * P.mu[1024 + ch];
                        o2[d] = (y[e + d] * rstd * P.lnw[ch] + P.lnb[ch] + rk * v) * g[e + d]; }
                    ow[e >> 1] = pk2(o2[0], o2[1]); }
                *(GAS v4u*)(P.Q3 + m * QP + 512 + ch0) = (v4u){ow[0], ow[1], ow[2], ow[3]}; *(GAS v4u*)(P.Q3 + m * QP + 512 + ch0 + 8) = (v4u){ow[4], ow[5], ow[6], ow[7]};
            }
            __syncthreads();
        }
        __syncthreads();
    }
}
struct DPostP { const bf16* O1; const bf16* O2; bf16* Q3; const float *lq1, *lk1, *lq2, *lk2, *subln; float lambda_init; };
__device__ __forceinline__ void diff_post(const DPostP& P, int gw, int NGW, int lane) {
    const float lam = __expf(wave_sum(P.lq1[lane] * P.lk1[lane])) - __expf(wave_sum(P.lq2[lane] * P.lk2[lane])) + P.lambda_init;
    const float s0 = P.subln[2 * lane] * (1.f - P.lambda_init), s1 = P.subln[2 * lane + 1] * (1.f - P.lambda_init);
    for (int it = gw; it < M * 4; it += NGW) {
        const size_t m = (size_t)(it >> 2); const int hh = it & 3;
        const unsigned a = *(const GAS unsigned*)(P.O1 + m * 512 + 128 * hh + 2 * lane), c = *(const GAS unsigned*)(P.O2 + m * 512 + 128 * hh + 2 * lane);
        const float x0 = bflo(a) - lam * bflo(c), x1 = bfhi(a) - lam * bfhi(c);
        const float r = __builtin_amdgcn_rsqf(wave_sum(x0 * x0 + x1 * x1) * (1.f / 128.f) + NORM_EPS);
        *(GAS unsigned*)(P.Q3 + m * QP + 1024 + 128 * hh + 2 * lane) = pk2(x0 * r * s0, x1 * r * s1);
    }
}

__device__ __forceinline__ int q_fetch(gu32* head, volatile LAS int* slot) {
    if (threadIdx.x == 0) *slot = (int)__hip_atomic_fetch_add(head, 1u, RLX_AGENT);
    __syncthreads();
    const int v = __builtin_amdgcn_readfirstlane(*slot);
    __syncthreads();
    return v;
}

struct Args { const float* in[32]; float* out; unsigned char* ws; int ph_lo, ph_hi; };
__device__ __forceinline__ const float* kin_(int i) { const char* ka = (const char*)__builtin_amdgcn_kernarg_segment_ptr(); unsigned off = (unsigned)i * 8u; asm volatile("" : "+s"(off)); return *(const float* const*)(ka + off); }
#define KIN(i) kin_(i)
#define XOUT ((float*)kin_(32))
__device__ __forceinline__ unsigned char* kws_() { return (unsigned char*)kin_(33); }
__device__ __forceinline__ int kint_(int byteoff) { const char* ka = (const char*)__builtin_amdgcn_kernarg_segment_ptr(); unsigned off = (unsigned)byteoff; asm volatile("" : "+s"(off)); return *(const int*)(ka + off); }
constexpr int PH_L = 14;
constexpr int N_PHASES = 1 + NLAYER * PH_L;

#define G ((int)gridDim.x)
#define bid ((int)blockIdx.x)
#define gw (bid * NWAVES + wave)
#define NGW (G * NWAVES)
#define MISC ((volatile LAS unsigned*)(lds + LDS_MISC))
#define IN(k) (kint_(272) <= (k) && (k) < kint_(276))
#define SEAM(k) do { if ((k) + 1 < kint_(276)) { XcdBarrier bar_; bar_.bar = (unsigned*)(kws_() + WS_CTL) + CW_BAR; bar_.x = xb_xcc_id(); bar_.st = MISC + 8; xcd_barrier(bar_); } } while (0)
#define WSL() unsigned char* wsl = kws_(); const int tid = otid_(), lane = tid & 63, wave = __builtin_amdgcn_readfirstlane(tid >> 6); (void)lane; (void)wave
#define WFu ((bf16*)(wsl + WS_WF))
#define WFd ((bf16*)(wsl + WS_WF_DOWN))
#define WMi ((bf16*)(wsl + WS_WM))
#define WMb ((bf16*)(wsl + WS_WM_BR))
#define WMo ((bf16*)(wsl + WS_WM_OUT))
#define XN ((bf16*)(wsl + WS_XN))
#define Q3 ((bf16*)(wsl + WS_Q3))
#define ZR ((bf16*)(wsl + WS_ZR))
#define YP ((bf16*)(wsl + WS_R2))
#define HB ZR
#define G3 ZR
#define MG ((bf16*)(wsl + WS_MG))
#define O1 ((bf16*)(wsl + WS_R2))
#define O2 ((bf16*)(wsl + WS_R2) + (size_t)M * 512)
#define YRAW ((bf16*)(wsl + WS_YRAW))
#define BITM ((unsigned*)(wsl + WS_BITM))
#define RDOTK ((float*)(wsl + WS_RDOTK))
#define X1B ((bf16*)(wsl + WS_X1))
#define KID ((bf16*)(wsl + WS_KID))
#define A8B ((unsigned char*)(wsl + WS_A8))
#define CTL ((gu32*)(wsl + WS_CTL))
#define cscr ((LAS float*)(lds + wave * 16384))

#define CONV_FFN(l_, f_) do { const int gi_ = (f_) ? 29 : 3; \
        MapUp mu_{KIN(gi_) + (size_t)(l_) * DM * FF, KIN(gi_ + 1) + (size_t)(l_) * DM * FF, FF}; MapIdent md_{KIN(gi_ + 2) + (size_t)(l_) * FF * DM, DM}; \
        constexpr int nu_ = conv_items(DM, 2 * FF), nd_ = conv_items(FF, DM); \
        for (int it_ = gw; it_ < nu_ + nd_; it_ += NGW) { if (it_ < nu_) conv_item(mu_, DM, WFu, cscr, it_, 2 * FF / 32, lane); else conv_item(md_, FF, WFd, cscr, it_ - nu_, DM / 32, lane); } } while (0)
#define CONV_MIX(l_) do { MapWin mw_{KIN(8) + (size_t)(l_) * DM * NIN, NIN}; MapIdent mo_{KIN(26) + (size_t)(l_) * DM * DM, DM}; \
        constexpr int ni_ = conv_items(DM, 8704), nb_ = conv_items(512, DM), no_ = conv_items(DM, DM); \
        for (int it_ = gw; it_ < ni_ + 3 * nb_ + no_; it_ += NGW) { \
            if (it_ < ni_) conv_item(mw_, DM, WMi, cscr, it_, 8704 / 32, lane); \
            else if (it_ < ni_ + 3 * nb_) { const int r_ = it_ - ni_, n_ = r_ / nb_; MapIdent mb_{KIN(25) + ((size_t)(l_) * 3 + n_) * 512 * DM, DM}; conv_item(mb_, 512, WMb + (size_t)n_ * DM * 512, cscr, r_ - n_ * nb_, DM / 32, lane); } \
            else conv_item(mo_, DM, WMo, cscr, it_ - ni_ - 3 * nb_, DM / 32, lane); } } while (0)

template <int L, int F> __device__ __forceinline__ void ffn_part(LAS unsigned char* lds) {
    constexpr int l = L, f = F, pb = 1 + PH_L * L, pf = pb + (F ? 11 : 0);
            if (IN(pf + 0)) { WSL();
                pg8::Gemm g{XN, WFu, M, 2 * FF, DM, DM}; pg8::StaticOrder S; S.init(M, 2 * FF, G, bid);
                pg8::EpiSwiGLU E{HB, FF};
                pg8::gemm_phase<pg8::EpiSwiGLU, pg8::StaticOrder, true, true>(lds, g, S, E);
                SEAM(pf + 0);
            }
            if (IN(pf + 1)) { WSL();
                pg8::Gemm g{HB, WFd, M, DM, FF, FF}; pg8::StaticOrder S; S.init(M, DM, G, bid);
                pg8::EpiStore<0> E{YP, DM, YP, DM, 1 << 30};
                pg8::gemm_phase<pg8::EpiStore<0>, pg8::StaticOrder, true, true>(lds, g, S, E);
                SEAM(pf + 1);
            }
            if (IN(pf + 2)) { WSL();
                const float* base = (l == 0 && f == 0) ? KIN(0) : XOUT;
                const float* gpost = KIN(f ? 28 : 2) + l * DM;
                const float* gnext = f == 0 ? KIN(6) + l * DM : (l + 1 < NLAYER ? KIN(1) + (l + 1) * DM : nullptr);
#if PROBE
                float osc = 1.f;
                if (l == NLAYER - 1 && f == 1) { const float num = *(const float*)(wsl + WS_CTL + 4 * CW_PROBE), den = *(const float*)(wsl + WS_CTL + 4 * (CW_PROBE + 1)); osc = 1.f + 4.f * sqrtf(num / fmaxf(den, 1e-30f)); }
                rownorm_rows(base, YP, 0.5f, gpost, XOUT, gnext, gnext ? XN : nullptr, gw, NGW, lane, osc);
#else
                rownorm_rows(base, YP, 0.5f, gpost, XOUT, gnext, gnext ? XN : nullptr, gw, NGW, lane);
#endif
                if (f == 1 && l + 1 < NLAYER) { CONV_FFN(l + 1, 0); CONV_MIX(l + 1); }
                SEAM(pf + 2);
            }
}
template <int L> __device__ __forceinline__ void mixer_part(LAS unsigned char* lds, unsigned char* lds_) {
    constexpr int l = L, pb = 1 + PH_L * L;
            const int pm = pb + 3;
            if (IN(pm + 0)) { WSL();
                pg8::Gemm g{XN, WMi, M, 5632, DM, DM}; pg8::StaticOrder S; S.init(M, 5632, G, bid);
                pg8::EpiStore<0> E{Q3, QP, ZR, ZP, 6};
                pg8::gemm_phase<pg8::EpiStore<0>, pg8::StaticOrder, true, true>(lds, g, S, E);
                SEAM(pm + 0);
            }
            if (IN(pm + 1)) { WSL();
                PrepP pp{ZR, X1B, A8B, KID, KIN(9) + l * 1792, KIN(10) + l * 512, KIN(11) + l * 64 * 512, KIN(12) + l * 512, KIN(13) + l * 64 * 512};
                rwkv_prep(pp, lds);
                SEAM(pm + 1);
            }
            if (IN(pm + 2)) { WSL();
                volatile LAS int* slot = (volatile LAS int*)(MISC + 16);
                if (bid < 64) {
                    ScanP sp{Q3, ZR, X1B, A8B, YRAW, RDOTK, KIN(9) + l * 1792, KIN(15) + l * 512, KIN(16) + l * 512, KIN(17) + l * 512};
#ifndef NO_SCAN
                    rwkv_scan_unit(sp, bid, lds);
#ifdef SCAN_TWICE
                    rwkv_scan_unit(sp, bid, lds);
#endif
#endif
                }
                {
                    Dsa1P dp{ZR, KID, BITM, CTL + CW_DONE + 64 * 64 * l};
                    gu32* head = CTL + CW_Q + 64 * (3 * l + 0);
                    #ifndef NO_DSA1
                    for (int u = q_fetch(head, slot); u < 512; u = q_fetch(head, slot)) dsa1_unit(dp, u, lds);
#ifdef DUP_DSA1
                    { gu32* head2 = CTL + 10240 + 64 * (2 * l + 0); for (int u = q_fetch(head2, slot); u < 512; u = q_fetch(head2, slot)) dsa1_unit(dp, u, lds); }
#endif
#endif
                }
                {
                    gu32* head = CTL + CW_Q + 64 * (3 * l + 1);
                    typedef att::BlockRef<att::bf16, att::bf16> Ref;
#define DSA2_REF(i_, r_) do { const int qb_ = 31 - ((i_) >> 3), b_ = ((i_) >> 2) & 1, h_ = (i_) & 3; const size_t row_ = (size_t)b_ * T + 256 * qb_; \
        r_.Q = (const att::bf16*)(Q3 + row_ * QP + 128 * h_); r_.O = (att::bf16*)(Q3 + row_ * QP + 128 * h_); r_.K = (const att::bf16*)(ZR + (size_t)b_ * T * ZP + ZC_DK + 128 * h_); \
        r_.V = (const att::bf16*)(ZR + (size_t)b_ * T * ZP + ZC_DV + 128 * h_); r_.P0 = 256 * qb_; r_.koff = 0; r_.mask = BITM + row_ * 256; } while (0)
                    int ic = q_fetch(head, slot);
                    if (ic < 256) {
                        int in_ = q_fetch(head, slot);
                        Ref cur; DSA2_REF(ic, cur);
                        att::Seam<att::bf16> S;
                        att::causal_swa_prime<att::bf16, att::bf16, false>(cur, T, (char*)lds_, S);
                        for (;;) {
                            const bool last = in_ >= 256;
                            Ref nxt = cur; if (!last) DSA2_REF(in_, nxt);
                            {
                                if (tid == 0) { gu32* dw = CTL + CW_DONE + 64 * (64 * l + (((ic >> 2) & 1) * 32 + (31 - (ic >> 3)))); unsigned sp = 0;
                                    while (__hip_atomic_load(dw, RLX_AGENT) < 8u) { __builtin_amdgcn_s_sleep(2); if (++sp > (1u << 24)) { __hip_atomic_store(CTL + CW_TMO, 1u, RLX_AGENT); break; } }
                                    __builtin_amdgcn_fence(__ATOMIC_ACQUIRE, "agent"); asm volatile("s_waitcnt vmcnt(0)" ::: "memory"); }
                                __syncthreads();
                            }
#ifndef NO_DSA2
                            att::causal_swa_block<att::bf16, att::bf16, false, true, QP>(cur, nxt, T, T, (char*)lds_, S);
#endif
                            if (last) break;
                            cur = nxt; ic = in_; in_ = q_fetch(head, slot);
                        }
                    }
                }
                {
#ifdef DUP_DIFF
                  for (int rep_ = 0; rep_ < 2; ++rep_) {
                    gu32* head = rep_ ? CTL + 10240 + 64 * (2 * l + 1) : CTL + CW_Q + 64 * (3 * l + 2);
#else
                  {
                    gu32* head = CTL + CW_Q + 64 * (3 * l + 2);
#endif
                    typedef att::BlockRef<att::bf16, att::bf16> Ref;
#define DIFF_REF(i_, r_) do { const int qb_ = 31 - ((i_) >> 4), b_ = ((i_) >> 3) & 1, h_ = ((i_) >> 1) & 3, mp_ = (i_) & 1; const size_t row_ = (size_t)b_ * T + 256 * qb_; \
        r_.Q = (const att::bf16*)(Q3 + row_ * QP + 1024 + 128 * h_ + 64 * mp_); r_.O = (att::bf16*)((mp_ ? O2 : O1) + row_ * 512 + 128 * h_); \
        r_.K = (const att::bf16*)(ZR + (size_t)b_ * T * ZP + ZC_FK + 128 * h_); r_.V = (const att::bf16*)(ZR + (size_t)b_ * T * ZP + ZC_FV + 128 * h_); r_.P0 = 256 * qb_; r_.koff = 128 * mp_; r_.mask = nullptr; } while (0)
                    int ic = q_fetch(head, slot);
                    if (ic < 512) {
                        int in_ = q_fetch(head, slot);
                        Ref cur; DIFF_REF(ic, cur);
                        att::Seam<att::bf16> S;
                        att::causal_swa_prime<att::bf16, att::bf16, true>(cur, T, (char*)lds_, S);
                        for (;;) {
                            const bool last = in_ >= 512;
                            Ref nxt = cur; if (!last) DIFF_REF(in_, nxt);
#ifndef NO_DIFF
                            att::causal_swa_block<att::bf16, att::bf16, true, false, 512>(cur, nxt, T, T, (char*)lds_, S);
#endif
                            if (last) break;
                            cur = nxt; ic = in_; in_ = q_fetch(head, slot);
                        }
                    }
                  }
                }
                SEAM(pm + 2);
            }
            if (IN(pm + 3)) { WSL();
                RPostP rp{ZR, Q3, YRAW, RDOTK, KIN(9) + l * 1792, KIN(14) + l * 128 * 512, KIN(18) + l * 512, KIN(19) + l * 512};
#ifndef NO_RPOST
                rwkv_post(rp, lds);
#endif
                constexpr float lambda_init = L == 0 ? 0.2f : 0.35550906759096927f;
                DPostP dq{O1, O2, Q3, KIN(20) + l * 64, KIN(21) + l * 64, KIN(22) + l * 64, KIN(23) + l * 64, KIN(24) + l * 128, lambda_init};
                diff_post(dq, gw, NGW, lane);
                rownorm_rows(XOUT, nullptr, 0.f, nullptr, nullptr, KIN(6) + l * DM, XN, gw, NGW, lane);
                SEAM(pm + 3);
            }
            if (IN(pm + 4)) { WSL();
                pg8::Gemm g{XN, WMi + (size_t)5632 * DM, M, 3072, DM, DM}; pg8::StaticOrder S; S.init(M, 3072, G, bid);
#ifdef GATE_RAW
                pg8::EpiStore<0> E{G3, 3072, G3, 3072, 1 << 30};
                pg8::gemm_phase<pg8::EpiStore<0>, pg8::StaticOrder, true, true>(lds, g, S, E);
#else
                pg8::EpiStore<1> E{G3, 3072, G3, 3072, 1 << 30};
                pg8::gemm_phase<pg8::EpiStore<1>, pg8::StaticOrder, true, true>(lds, g, S, E);
#endif
                SEAM(pm + 4);
            }
            if (IN(pm + 5)) { WSL();
#pragma unroll 1
                for (int n = 0; n < 3; ++n) {
                    pg8::Gemm g{Q3 + 512 * n, WMb + (size_t)n * DM * 512, M, DM, 512, QP}; pg8::StaticOrder S; S.init(M, DM, G, bid);
                    pg8::EpiGateMul E{MG, DM, G3 + 1024 * n, 3072, n == 0 ? 1 : 0};
                    pg8::gemm_phase<pg8::EpiGateMul, pg8::StaticOrder, false, true>(lds, g, S, E);
                    VM_WAIT(); __syncthreads();
                }
                SEAM(pm + 5);
            }
            if (IN(pm + 6)) { WSL();
                pg8::Gemm g{MG, WMo, M, DM, DM, DM}; pg8::StaticOrder S; S.init(M, DM, G, bid);
                pg8::EpiStore<0> E{YP, DM, YP, DM, 1 << 30};
                pg8::gemm_phase<pg8::EpiStore<0>, pg8::StaticOrder, false, true>(lds, g, S, E);
                SEAM(pm + 6);
            }
            if (IN(pm + 7)) { WSL();
                rownorm_rows(XOUT, YP, 1.0f, KIN(7) + l * DM, XOUT, KIN(27) + l * DM, XN, gw, NGW, lane);
                CONV_FFN(l, 1);
                SEAM(pm + 7);
            }
}

__global__ void __launch_bounds__(NWAVES * 64, 2) mk_fwd(Args args) {
    extern __shared__ __attribute__((aligned(16))) unsigned char lds_[];
    LAS unsigned char* lds = (LAS unsigned char*)lds_;
    { const int tid = otid_(); if (tid < 64) MISC[tid] = 0u; }
    __syncthreads();
    (void)xcd_barrier_post((unsigned*)(kws_() + WS_CTL) + CW_BAR, MISC + 8);
    if (IN(0)) { WSL();
        CONV_FFN(0, 0); CONV_MIX(0);
        rownorm_rows(KIN(0), nullptr, 0.f, nullptr, nullptr, KIN(1), XN, gw, NGW, lane);
        SEAM(0);
    }
    ffn_part<0, 0>(lds); mixer_part<0>(lds, lds_); ffn_part<0, 1>(lds);
    ffn_part<1, 0>(lds); mixer_part<1>(lds, lds_); ffn_part<1, 1>(lds);
}

#if PROBE
__device__ __forceinline__ void probe_acc(float num, float den, float* ctlf) {
    __shared__ float rn[256], rd[256];
    rn[threadIdx.x] = num; rd[threadIdx.x] = den; __syncthreads();
    for (int o = 128; o > 0; o >>= 1) { if ((int)threadIdx.x < o) { rn[threadIdx.x] += rn[threadIdx.x + o]; rd[threadIdx.x] += rd[threadIdx.x + o]; } __syncthreads(); }
    if (threadIdx.x == 0) { atomicAdd(ctlf + CW_PROBE, rn[0]); atomicAdd(ctlf + CW_PROBE + 1, rd[0]); }
}
__global__ void __launch_bounds__(256) probe_ffn(const unsigned char* ws, const float* Wg, const float* Wu, const float* Wd) {
    __shared__ float xn[1024]; __shared__ float hid[2816];
    const int m = 777 + 1931 * blockIdx.x, tid = threadIdx.x;
    const bf16* XNp = (const bf16*)(ws + WS_XN); const bf16* YPp = (const bf16*)(ws + WS_R2);
    for (int k = tid; k < 1024; k += 256) xn[k] = bf1(XNp[(size_t)m * 1024 + k]);
    __syncthreads();
    for (int j = tid; j < 2816; j += 256) { float g = 0.f, u = 0.f; for (int k = 0; k < 1024; ++k) { g += xn[k] * Wg[(size_t)k * 2816 + j]; u += xn[k] * Wu[(size_t)k * 2816 + j]; } hid[j] = g / (1.f + expf(-g)) * u; }
    __syncthreads();
    float num = 0.f, den = 0.f;
    for (int d = tid; d < 1024; d += 256) { float o = 0.f; for (int j = 0; j < 2816; ++j) o += hid[j] * Wd[(size_t)j * 1024 + d]; const float got = bf1(YPp[(size_t)m * 1024 + d]); num += (o - got) * (o - got); den += o * o; }
    probe_acc(num, den, (float*)(ws + WS_CTL));
}
__global__ void __launch_bounds__(256) probe_win(const unsigned char* ws, const float* Win) {
    __shared__ float xn[1024];
    const int m = 555 + 1999 * blockIdx.x, tid = threadIdx.x;
    const bf16* XNp = (const bf16*)(ws + WS_XN); const bf16* Q3p = (const bf16*)(ws + WS_Q3); const bf16* ZRp = (const bf16*)(ws + WS_ZR);
    for (int k = tid; k < 1024; k += 256) xn[k] = bf1(XNp[(size_t)m * 1024 + k]);
    __syncthreads();
    float num = 0.f, den = 0.f;
    for (int c = tid; c < 5448; c += 256) {
        float z = 0.f; for (int k = 0; k < 1024; ++k) z += xn[k] * Win[(size_t)k * NIN + c];
        float got;
        if (c < 512) got = bf1(Q3p[(size_t)m * QP + c]);
        else if (c < 2120) got = bf1(ZRp[(size_t)m * ZP + (c - 512)]);
        else if (c < 2632) got = bf1(Q3p[(size_t)m * QP + 512 + (c - 2120)]);
        else if (c < 3912) got = bf1(ZRp[(size_t)m * ZP + (c - 840)]);
        else if (c < 4424) got = bf1(Q3p[(size_t)m * QP + 1024 + (c - 3912)]);
        else got = bf1(ZRp[(size_t)m * ZP + (c - 1352)]);
        num += (z - got) * (z - got); den += z * z;
    }
    probe_acc(num, den, (float*)(ws + WS_CTL));
}
__global__ void __launch_bounds__(256) probe_wconv(const unsigned char* ws, const float* Win, int r0) {
    const bf16* WMp = (const bf16*)(ws + WS_WM); const int tid = threadIdx.x;
    float num = 0.f, den = 0.f;
    for (int rr = 0; rr < 64; ++rr) { const int n = r0 + 64 * blockIdx.x + rr; MapWin mw{Win, NIN}; const float* cp = mw.col(n);
        for (int k = tid; k < 1024; k += 256) { const float ref = cp ? cp[(size_t)k * NIN] : 0.f; const float got = bf1(WMp[(size_t)n * 1024 + k]); num += (ref - got) * (ref - got); den += ref * ref; } }
    probe_acc(num, den, (float*)(ws + WS_CTL));
}
__global__ void __launch_bounds__(256) probe_merge(const unsigned char* ws, const float* Win, const float* Wb, const float* Wo, int which) {
    __shared__ float xn[1024]; __shared__ float y[1536]; __shared__ float mg[1024];
    const int m = 333 + 2003 * blockIdx.x, tid = threadIdx.x;
    const bf16* XNp = (const bf16*)(ws + WS_XN); const bf16* Q3p = (const bf16*)(ws + WS_Q3); const bf16* MGp = (const bf16*)(ws + WS_MG); const bf16* YPp = (const bf16*)(ws + WS_R2);
    for (int k = tid; k < 1024; k += 256) xn[k] = bf1(XNp[(size_t)m * 1024 + k]);
    for (int k = tid; k < 1536; k += 256) y[k] = bf1(Q3p[(size_t)m * QP + k]);
    __syncthreads();
    float num = 0.f, den = 0.f;
    for (int d = tid; d < 1024; d += 256) {
        float acc = 0.f;
        for (int n = 0; n < 3; ++n) { float g = 0.f; for (int k = 0; k < 1024; ++k) g += xn[k] * Win[(size_t)k * NIN + 5448 + n * 1024 + d];
            float p = 0.f; for (int c = 0; c < 512; ++c) p += y[512 * n + c] * Wb[((size_t)n * 512 + c) * 1024 + d];
            acc += p / (1.f + expf(-g)); }
        mg[d] = acc; const float got = bf1(MGp[(size_t)m * 1024 + d]); if (which == 0) { num += (acc - got) * (acc - got); den += acc * acc; }
        if (which == 2) { const bf16* G3p = (const bf16*)(ws + WS_ZR); for (int n = 0; n < 3; ++n) { float g = 0.f; for (int k = 0; k < 1024; ++k) g += xn[k] * Win[(size_t)k * NIN + 5448 + n * 1024 + d];
            const float sg = 1.f / (1.f + expf(-g)), gg = bf1(G3p[(size_t)m * 3072 + n * 1024 + d]); num += (sg - gg) * (sg - gg); den += sg * sg; } }
        if (which == 3) { const bf16* G3p = (const bf16*)(ws + WS_ZR); float a2 = 0.f; for (int n = 0; n < 3; ++n) { float p = 0.f; for (int c = 0; c < 512; ++c) p += y[512 * n + c] * Wb[((size_t)n * 512 + c) * 1024 + d];
            a2 += p * bf1(G3p[(size_t)m * 3072 + n * 1024 + d]); } num += (a2 - got) * (a2 - got); den += a2 * a2; }
    }
    __syncthreads();
    if (which == 1) for (int d = tid; d < 1024; d += 256) { float o = 0.f; for (int j = 0; j < 1024; ++j) o += mg[j] * Wo[(size_t)j * 1024 + d]; const float got = bf1(YPp[(size_t)m * 1024 + d]); num += (o - got) * (o - got); den += o * o; }
    probe_acc(num, den, (float*)(ws + WS_CTL));
}
#endif
#ifndef MK_ONE_LAUNCH
#define MK_ONE_LAUNCH 0
#endif
extern "C" void kernel_launch(void* const* d_in, const int* in_sizes, int n_in, void* d_out, int out_size, void* d_ws, size_t ws_size, hipStream_t stream) {
    static int grid = 0;
    if (grid == 0) {
        if (n_in != 32 || in_sizes[0] != M * DM || out_size != M * DM || ws_size < WS_END) { fprintf(stderr, "kernel_launch: unexpected shapes / workspace (n_in %d, ws %zu)\n", n_in, ws_size); grid = -1; return; }
        int dev = 0, cus = 0;
        if (hipGetDevice(&dev) != hipSuccess || hipDeviceGetAttribute(&cus, hipDeviceAttributeMultiprocessorCount, dev) != hipSuccess) { grid = -1; return; }
        if (hipFuncSetAttribute((const void*)mk_fwd, hipFuncAttributeMaxDynamicSharedMemorySize, LDS_BYTES) != hipSuccess) { fprintf(stderr, "kernel_launch: hipFuncSetAttribute failed\n"); grid = -1; return; }
        int per_cu = 0;
        if (hipOccupancyMaxActiveBlocksPerMultiprocessor(&per_cu, (const void*)mk_fwd, NWAVES * 64, LDS_BYTES) != hipSuccess || per_cu < 1) { fprintf(stderr, "kernel_launch: occupancy query says %d\n", per_cu); }
        (void)hipGetLastError();
        grid = cus;
    }
    if (grid < 0) return;
    (void)hipMemsetAsync((char*)d_ws + WS_CTL, 0, CTL_ZERO_BYTES, stream);
    Args a{};
    for (int i = 0; i < 32; ++i) a.in[i] = (const float*)d_in[i];
    a.out = (float*)d_out; a.ws = (unsigned char*)d_ws;
#if MK_ONE_LAUNCH
    a.ph_lo = 0; a.ph_hi = N_PHASES;
    hipLaunchKernelGGL(mk_fwd, dim3(grid), dim3(NWAVES * 64), LDS_BYTES, stream, a);
#else
    for (int p = 0; p < N_PHASES; ++p) { a.ph_lo = p; a.ph_hi = p + 1; hipLaunchKernelGGL(mk_fwd, dim3(grid), dim3(NWAVES * 64), LDS_BYTES, stream, a);
#if PROBE == 1
        if (p == 2) hipLaunchKernelGGL(probe_ffn, dim3(8), dim3(256), 0, stream, (const unsigned char*)d_ws, a.in[3], a.in[4], a.in[5]);
#elif PROBE == 2
        if (p == 4) hipLaunchKernelGGL(probe_win, dim3(8), dim3(256), 0, stream, (const unsigned char*)d_ws, a.in[8]);
#elif PROBE == 3
        if (p == 8) hipLaunchKernelGGL(probe_merge, dim3(8), dim3(256), 0, stream, (const unsigned char*)d_ws, a.in[8], a.in[25], a.in[26], 0);
#elif PROBE == 5
        if (p == 8) hipLaunchKernelGGL(probe_merge, dim3(8), dim3(256), 0, stream, (const unsigned char*)d_ws, a.in[8], a.in[25], a.in[26], 2);
#elif PROBE == 6
        if (p == 8) hipLaunchKernelGGL(probe_merge, dim3(8), dim3(256), 0, stream, (const unsigned char*)d_ws, a.in[8], a.in[25], a.in[26], 3);
#elif PROBE == 7
        if (p == 6) hipLaunchKernelGGL(probe_wconv, dim3(48), dim3(256), 0, stream, (const unsigned char*)d_ws, a.in[8], 5632);
#elif PROBE == 8
        if (p == 3) hipLaunchKernelGGL(probe_wconv, dim3(48), dim3(256), 0, stream, (const unsigned char*)d_ws, a.in[8], 5632);
#elif PROBE == 9
        if (p == 7) hipLaunchKernelGGL(probe_merge, dim3(8), dim3(256), 0, stream, (const unsigned char*)d_ws, a.in[8], a.in[25], a.in[26], 2);
#elif PROBE == 4
        if (p == 9) hipLaunchKernelGGL(probe_merge, dim3(8), dim3(256), 0, stream, (const unsigned char*)d_ws, a.in[8], a.in[25], a.in[26], 1);
#endif
    }
#endif
}
```

```cpp
#include <hip/hip_runtime.h>
#include <hip/hip_bf16.h>
#include <cstdio>
#include <cstdint>
#define MK_ONE_LAUNCH 1
#define GATE_RAW 1

__device__ __forceinline__ int otid_() { int t = (int)threadIdx.x; asm volatile("" : "+v"(t)); return t; }
namespace pg8 {
#define PG8_LAS __attribute__((address_space(3)))
typedef unsigned short bf16_t;
typedef short bf16x8 __attribute__((ext_vector_type(8)));
typedef float f32x4 __attribute__((ext_vector_type(4)));
typedef unsigned u32x4 __attribute__((ext_vector_type(4)));
constexpr int BM = 256, BK = 64, HALF = 128, HTB = HALF * BK * 2  , STAGE_BYTES = 8 * HTB, NXCD = 8, WGM = 8;

__host__ __device__ __forceinline__ int lds_byte(int r, int c) { const int st = (r >> 4) * 2 + (c >> 5), rr = r & 15, cc = c & 31, ob = rr * 64 + cc * 2; return st * 1024 + (ob ^ (((ob >> 9) & 1) << 5)); }
__host__ __device__ __forceinline__ void stage_rc(int b, int& R, int& C) { const int st = b / 1024, sb = b % 1024, swz = sb ^ (((sb >> 9) & 1) << 5); R = (st >> 1) * 16 + swz / 64; C = (st & 1) * 32 + (swz % 64) / 2; }
__host__ __device__ __forceinline__ int perm32(int rho) { const int n = rho >> 4, i = rho & 15; return 8 * (i >> 2) + 4 * n + (i & 3); }

struct Unit { int pm, pn; };
struct Gemm { const bf16_t* A; const bf16_t* Bt; int M, N, K, lda; };

struct StaticOrder {
    int nM, nN, nwg, G, c;
    __host__ __device__ void init(int M, int N, int G_, int c_) { nM = M / BM; nN = N / BM; nwg = nM * nN; G = G_; c = c_; }
    __host__ __device__ bool next(int i, Unit& u) const {
        const long L = (long)i * G + c; if (L >= nwg) return false;
        int wgid = (int)L; { const int q = nwg / NXCD, r = nwg % NXCD, xcd = wgid % NXCD, off = wgid / NXCD; wgid = (xcd < r ? xcd * (q + 1) : r * (q + 1) + (xcd - r) * q) + off; }
        const int nig = WGM * nN, gid = wgid / nig, fm = gid * WGM, gsz = (nM - fm) < WGM ? (nM - fm) : WGM;
        u.pm = fm + ((wgid % nig) % gsz); u.pn = (wgid % nig) / gsz; return true;
    }
    __device__ __forceinline__ void a_ready(const Unit&) const {}
    __device__ __forceinline__ void done(const Unit&) const {}
};

__device__ __forceinline__ unsigned cvt_pk_bf16(float lo, float hi) { unsigned r; asm volatile("v_cvt_pk_bf16_f32 %0, %1, %2" : "=v"(r) : "v"(lo), "v"(hi)); return r; }

template <class Epi, class Sched, bool ALIGN_EPI = false, bool SP2 = false>
__device__ __forceinline__ void gemm_phase(PG8_LAS unsigned char* lds, const Gemm g, const Sched& S, const Epi& E) {
    const int tid = otid_(), wid = __builtin_amdgcn_readfirstlane(tid >> 6), lane = tid & 63, wr = wid >> 2, wc = wid & 3, fr = lane & 15, fq = lane >> 4;
    const int K = g.K, nt = K / BK;
    unsigned voffA[2], voffB[2];
#pragma unroll
    for (int i = 0; i < 2; ++i) { int R, C; stage_rc(tid * 16 + i * 8192, R, C); const int Rb = Epi::PERM ? ((R & ~31) + perm32(R & 31)) : R;
        voffA[i] = (unsigned)(R * g.lda + C) * 2u; voffB[i] = (unsigned)(Rb * K + C) * 2u; }
    const size_t kstep = (size_t)(BK * 2);
    const size_t hstepB = (size_t)HALF * K * 2, hstepA = (size_t)HALF * g.lda * 2;
    const size_t tstepB = 2 * hstepB, tstepA = 2 * hstepA;
    const unsigned ldsw = (unsigned)wid * 1024u;
    const int aoff = lds_byte(wr * 64 + fr, fq * 8), boff = lds_byte(wc * 32 + fr, fq * 8);
#define PG8_SA(b, h) (((b) * 2 + (h)) * HTB)
#define PG8_SB(b, h) ((4 + (b) * 2 + (h)) * HTB)
#define PG8_STAGE(bufoff, gbase, voff) do { _Pragma("unroll") for (int _i = 0; _i < 2; ++_i) \
        __builtin_amdgcn_global_load_lds((const unsigned*)((const char*)(gbase) + (voff)[_i]), (PG8_LAS unsigned*)(lds + (bufoff) + ldsw + _i * 8192), 16, 0, 0); } while (0)
#define PG8_LDA(dst, b, h) do { _Pragma("unroll") for (int m = 0; m < 4; ++m) _Pragma("unroll") for (int k = 0; k < 2; ++k) dst[m][k] = *(const PG8_LAS bf16x8*)(lds + PG8_SA(b, h) + aoff + m * 2048 + k * 1024); } while (0)
#define PG8_LDB(dst, b, h) do { _Pragma("unroll") for (int n = 0; n < 2; ++n) _Pragma("unroll") for (int k = 0; k < 2; ++k) dst[n][k] = *(const PG8_LAS bf16x8*)(lds + PG8_SB(b, h) + boff + n * 2048 + k * 1024); } while (0)
#define PG8_MMA(ai, bj, At, Bt) do { __builtin_amdgcn_s_setprio(1); _Pragma("unroll") for (int m = 0; m < 4; ++m) _Pragma("unroll") for (int n = 0; n < 2; ++n) _Pragma("unroll") for (int k = 0; k < 2; ++k) \
        acc[ai][bj][m][n] = __builtin_amdgcn_mfma_f32_16x16x32_bf16(Bt[n][k], At[m][k], acc[ai][bj][m][n], 0, 0, 0); __builtin_amdgcn_s_setprio(0); } while (0)
#define PG8_WAIT_V(n) asm volatile("s_waitcnt vmcnt(" #n ")" ::: "memory")
#define PG8_WAIT_L(n) asm volatile("s_waitcnt lgkmcnt(" #n ")" ::: "memory")
#define PG8_BAR __builtin_amdgcn_s_barrier()
#define PG8_SCHED __builtin_amdgcn_sched_barrier(0)
    Unit cur, nxt; int ui = 0;
    if (!S.next(0, cur)) return;
    f32x4 acc[2][2][4][2];
#pragma unroll
    for (int a = 0; a < 2; ++a)
#pragma unroll
        for (int b = 0; b < 2; ++b)
#pragma unroll
            for (int m = 0; m < 4; ++m)
#pragma unroll
                for (int n = 0; n < 2; ++n) acc[a][b][m][n] = (f32x4){0.f, 0.f, 0.f, 0.f};
    bf16x8 At[4][2], B0[2][2], B1[2][2];
    const char* cA = (const char*)g.A + (size_t)cur.pm * tstepA; const char* cB = (const char*)g.Bt + (size_t)cur.pn * tstepB;
    S.a_ready(cur);
    if constexpr (SP2) {
        PG8_STAGE(PG8_SB(0, 0), cB, voffB); PG8_STAGE(PG8_SB(0, 1), cB + hstepB, voffB); PG8_STAGE(PG8_SA(0, 0), cA, voffA); PG8_STAGE(PG8_SA(0, 1), cA + hstepA, voffA);
        if (wr == 1) PG8_BAR;
        PG8_WAIT_V(2); PG8_BAR;
        PG8_STAGE(PG8_SB(1, 0), cB + kstep, voffB); PG8_STAGE(PG8_SA(1, 0), cA + kstep, voffA); PG8_STAGE(PG8_SB(1, 1), cB + hstepB + kstep, voffB);
        PG8_WAIT_V(6); PG8_BAR;
    } else {
        PG8_STAGE(PG8_SB(0, 0), cB, voffB); PG8_STAGE(PG8_SA(0, 0), cA, voffA); PG8_STAGE(PG8_SB(0, 1), cB + hstepB, voffB); PG8_STAGE(PG8_SA(0, 1), cA + hstepA, voffA);
        if (wr == 1) PG8_BAR;
        PG8_WAIT_V(4); PG8_BAR;
        PG8_STAGE(PG8_SB(1, 0), cB + kstep, voffB); PG8_STAGE(PG8_SA(1, 0), cA + kstep, voffA); PG8_STAGE(PG8_SB(1, 1), cB + hstepB + kstep, voffB);
        PG8_WAIT_V(6); PG8_BAR;
    }
    for (;;) {
        const bool has_next = S.next(ui + 1, nxt);
        const char* nA = has_next ? (const char*)g.A + (size_t)nxt.pm * tstepA : cA; const char* nB = has_next ? (const char*)g.Bt + (size_t)nxt.pn * tstepB : cB;
        for (int t = 0; t < nt; t += 2) {
            const bool last = (t == nt - 2);
            const char* a1 = cA + (size_t)(t + 1) * kstep;
            const char* a2 = last ? nA : cA + (size_t)(t + 2) * kstep; const char* b2 = last ? nB : cB + (size_t)(t + 2) * kstep;
            const char* a3 = a2 + kstep; const char* b3 = b2 + kstep;
            if (last && has_next) S.a_ready(nxt);
            if constexpr (SP2) {
            PG8_LDB(B0, 0, 0); PG8_LDB(B1, 0, 1); PG8_SCHED; PG8_LDA(At, 0, 0); PG8_STAGE(PG8_SA(1, 1), a1 + hstepA, voffA);
            PG8_WAIT_V(8); PG8_WAIT_L(0); PG8_BAR; PG8_MMA(0, 0, At, B0); PG8_MMA(0, 1, At, B1); PG8_BAR; PG8_SCHED;
            PG8_LDA(At, 0, 1); PG8_STAGE(PG8_SB(0, 0), b2, voffB); PG8_STAGE(PG8_SB(0, 1), b2 + hstepB, voffB); PG8_STAGE(PG8_SA(0, 0), a2, voffA);
            PG8_WAIT_V(8); PG8_WAIT_L(0); PG8_BAR; PG8_MMA(1, 0, At, B0); PG8_MMA(1, 1, At, B1); PG8_BAR; PG8_SCHED;
            PG8_LDB(B0, 1, 0); PG8_LDB(B1, 1, 1); PG8_SCHED; PG8_LDA(At, 1, 0); PG8_STAGE(PG8_SA(0, 1), a2 + hstepA, voffA);
            PG8_WAIT_V(8); PG8_WAIT_L(0); PG8_BAR; PG8_MMA(0, 0, At, B0); PG8_MMA(0, 1, At, B1); PG8_BAR; PG8_SCHED;
            PG8_LDA(At, 1, 1); PG8_STAGE(PG8_SB(1, 0), b3, voffB); PG8_STAGE(PG8_SB(1, 1), b3 + hstepB, voffB); PG8_STAGE(PG8_SA(1, 0), a3, voffA);
            PG8_WAIT_V(8); PG8_WAIT_L(0); PG8_BAR; PG8_MMA(1, 0, At, B0); PG8_MMA(1, 1, At, B1); PG8_BAR; PG8_SCHED;
            } else {
            PG8_LDB(B0, 0, 0); PG8_SCHED; PG8_LDA(At, 0, 0); PG8_STAGE(PG8_SA(1, 1), a1 + hstepA, voffA);
            PG8_WAIT_L(8); PG8_BAR; PG8_WAIT_L(0); PG8_MMA(0, 0, At, B0); PG8_BAR; PG8_SCHED;
            PG8_LDB(B1, 0, 1); PG8_STAGE(PG8_SB(0, 0), b2, voffB);
            PG8_BAR; PG8_WAIT_L(0); PG8_MMA(0, 1, At, B1); PG8_BAR;
            PG8_LDA(At, 0, 1); PG8_STAGE(PG8_SA(0, 0), a2, voffA);
            PG8_BAR; PG8_WAIT_L(0); PG8_MMA(1, 0, At, B0); PG8_BAR; PG8_SCHED;
            PG8_STAGE(PG8_SB(0, 1), b2 + hstepB, voffB);
            PG8_WAIT_V(6); PG8_BAR; PG8_MMA(1, 1, At, B1); PG8_BAR;
            PG8_LDB(B0, 1, 0); PG8_SCHED; PG8_LDA(At, 1, 0); PG8_STAGE(PG8_SA(0, 1), a2 + hstepA, voffA);
            PG8_WAIT_L(8); PG8_BAR; PG8_WAIT_L(0); PG8_MMA(0, 0, At, B0); PG8_BAR; PG8_SCHED;
            PG8_LDB(B1, 1, 1); PG8_STAGE(PG8_SB(1, 0), b3, voffB);
            PG8_BAR; PG8_WAIT_L(0); PG8_MMA(0, 1, At, B1); PG8_BAR;
            PG8_LDA(At, 1, 1); PG8_STAGE(PG8_SA(1, 0), a3, voffA);
            PG8_BAR; PG8_WAIT_L(0); PG8_MMA(1, 0, At, B0); PG8_BAR; PG8_SCHED;
            PG8_STAGE(PG8_SB(1, 1), b3 + hstepB, voffB);
            PG8_WAIT_V(6); PG8_BAR; PG8_MMA(1, 1, At, B1); PG8_BAR;
            }
        }
        if constexpr (ALIGN_EPI) { if (wr == 0) PG8_BAR; }
        if constexpr (!Epi::AFTER_DRAIN) { E(acc, cur, wr, wc, fr, fq); S.done(cur); }
        if (!has_next) break;
#pragma unroll
        for (int a = 0; a < 2; ++a)
#pragma unroll
            for (int b = 0; b < 2; ++b)
#pragma unroll
                for (int m = 0; m < 4; ++m)
#pragma unroll
                    for (int n = 0; n < 2; ++n) acc[a][b][m][n] = (f32x4){0.f, 0.f, 0.f, 0.f};
        cur = nxt; cA = nA; cB = nB; ++ui;
        if constexpr (ALIGN_EPI) { if (wr == 1) PG8_BAR; }
    }
    PG8_WAIT_V(0);
    if constexpr (!ALIGN_EPI) { if (wr == 0) PG8_BAR; }
    PG8_BAR;
    if constexpr (Epi::AFTER_DRAIN) { E.fused(acc, cur, wr, wc, fr, fq, lds, wid, lane); S.done(cur); }
#undef PG8_SA
#undef PG8_SB
#undef PG8_STAGE
#undef PG8_LDA
#undef PG8_LDB
#undef PG8_MMA
#undef PG8_WAIT_V
#undef PG8_WAIT_L
#undef PG8_BAR
#undef PG8_SCHED
}
}
namespace pg8 {
typedef unsigned u32x2 __attribute__((ext_vector_type(2)));
__device__ __forceinline__ float bf_lo(unsigned w) { return __uint_as_float(w << 16); }
__device__ __forceinline__ float bf_hi(unsigned w) { return __uint_as_float(w & 0xffff0000u); }
__device__ __forceinline__ float sigmoidf_(float x) { return __builtin_amdgcn_rcpf(1.0f + __expf(-x)); }

struct EpiSwiGLU {
    static constexpr bool PERM = false, AFTER_DRAIN = false;
    bf16_t* H; int ldh;
    __device__ __forceinline__ void operator()(const f32x4 (&acc)[2][2][4][2], const Unit& u, int wr, int wc, int fr, int fq) const {
        const int row0 = u.pm * BM + wr * 64 + fr, hc0 = u.pn * 128 + wc * 16 + 4 * fq;
#pragma unroll
        for (int ai = 0; ai < 2; ++ai)
#pragma unroll
            for (int m = 0; m < 4; ++m) { bf16_t* rowp = H + (size_t)(row0 + ai * HALF + m * 16) * ldh + hc0;
#pragma unroll
                for (int bj = 0; bj < 2; ++bj) { const f32x4 g = acc[ai][bj][m][0], up = acc[ai][bj][m][1]; float h[4];
#pragma unroll
                    for (int e = 0; e < 4; ++e) h[e] = g[e] * sigmoidf_(g[e]) * up[e];
                    u32x2 w; w.x = cvt_pk_bf16(h[0], h[1]); w.y = cvt_pk_bf16(h[2], h[3]);
                    *(u32x2*)(rowp + bj * 64) = w; } }
    }
};
template <int ACT> struct EpiStore {
    static constexpr bool PERM = true, AFTER_DRAIN = false;
    bf16_t* O0; int ld0; bf16_t* O1; int ld1; int split_tiles;
    __device__ __forceinline__ void operator()(const f32x4 (&acc)[2][2][4][2], const Unit& u, int wr, int wc, int fr, int fq) const {
        const int row0 = u.pm * BM + wr * 64 + fr;
        bf16_t* base; int ld, colt;
        if (u.pn < split_tiles) { base = O0; ld = ld0; colt = u.pn * BM; } else { base = O1; ld = ld1; colt = (u.pn - split_tiles) * BM; }
        const int col0 = colt + wc * 32 + 8 * fq;
#pragma unroll
        for (int ai = 0; ai < 2; ++ai)
#pragma unroll
            for (int m = 0; m < 4; ++m) { bf16_t* rowp = base + (size_t)(row0 + ai * HALF + m * 16) * ld + col0;
#pragma unroll
                for (int bj = 0; bj < 2; ++bj) { f32x4 v0 = acc[ai][bj][m][0], v1 = acc[ai][bj][m][1];
                    if (ACT == 1) {
#pragma unroll
                        for (int e = 0; e < 4; ++e) { v0[e] = sigmoidf_(v0[e]); v1[e] = sigmoidf_(v1[e]); } }
                    u32x4 w; w.x = cvt_pk_bf16(v0[0], v0[1]); w.y = cvt_pk_bf16(v0[2], v0[3]); w.z = cvt_pk_bf16(v1[0], v1[1]); w.w = cvt_pk_bf16(v1[2], v1[3]);
                    *(u32x4*)(rowp + bj * HALF) = w; } }
    }
};
#ifdef GATE_RAW
#define GSIG(x) sigmoidf_(x)
#else
#define GSIG(x) (x)
#endif
struct EpiGateMul {
    static constexpr bool PERM = true, AFTER_DRAIN = false;
    bf16_t* MG; int ldm; const bf16_t* G; int ldg; int first;
    __device__ __forceinline__ void operator()(const f32x4 (&acc)[2][2][4][2], const Unit& u, int wr, int wc, int fr, int fq) const {
        const int row0 = u.pm * BM + wr * 64 + fr, col0 = u.pn * BM + wc * 32 + 8 * fq;
#pragma unroll
        for (int ai = 0; ai < 2; ++ai)
#pragma unroll
            for (int m = 0; m < 4; ++m) { const size_t r = (size_t)(row0 + ai * HALF + m * 16);
#pragma unroll
                for (int bj = 0; bj < 2; ++bj) { const f32x4 v0 = acc[ai][bj][m][0], v1 = acc[ai][bj][m][1];
                    const u32x4 g = *(const u32x4*)(G + r * ldg + col0 + bj * HALF);
                    float o[8] = { v0[0] * GSIG(bf_lo(g.x)), v0[1] * GSIG(bf_hi(g.x)), v0[2] * GSIG(bf_lo(g.y)), v0[3] * GSIG(bf_hi(g.y)), v1[0] * GSIG(bf_lo(g.z)), v1[1] * GSIG(bf_hi(g.z)), v1[2] * GSIG(bf_lo(g.w)), v1[3] * GSIG(bf_hi(g.w)) };
                    bf16_t* mp = MG + r * ldm + col0 + bj * HALF;
                    if (!first) { const u32x4 p = *(const u32x4*)mp;
                        o[0] += bf_lo(p.x); o[1] += bf_hi(p.x); o[2] += bf_lo(p.y); o[3] += bf_hi(p.y); o[4] += bf_lo(p.z); o[5] += bf_hi(p.z); o[6] += bf_lo(p.w); o[7] += bf_hi(p.w); }
                    u32x4 w; w.x = cvt_pk_bf16(o[0], o[1]); w.y = cvt_pk_bf16(o[2], o[3]); w.z = cvt_pk_bf16(o[4], o[5]); w.w = cvt_pk_bf16(o[6], o[7]);
                    *(u32x4*)mp = w; } }
    }
};
}
namespace att {
constexpr int D = 128;
constexpr bool WSKIP = false;
constexpr float THR = 8.f;
constexpr int NW = 8, QBLK = 32, KVBLK = 64, QB = NW * QBLK;
constexpr int SHM_V = KVBLK * D * 2, SHM_K = KVBLK * D * 2;
constexpr int LDS_BYTES = 2 * SHM_V + 2 * SHM_K + NW * 64 * 4;
using bf16 = __hip_bfloat16;
typedef short bf16x8 __attribute__((ext_vector_type(8)));
typedef short s16x4 __attribute__((ext_vector_type(4)));
typedef float f32x16 __attribute__((ext_vector_type(16)));
typedef float f32x4 __attribute__((ext_vector_type(4)));
typedef unsigned u32x4 __attribute__((ext_vector_type(4)));
template <class A, class Bt> struct same_t { static constexpr bool v = false; };
template <class A> struct same_t<A, A> { static constexpr bool v = true; };

#define KSWZ(row, colB) ((row) * 256 + ((colB) ^ (((row) & 7) << 4)))
#define SBAR() __builtin_amdgcn_sched_barrier(0)
__device__ __forceinline__ int v_st(int k, int c) { const int kk = (k & ~0xC) | ((k & 4) << 1) | ((k & 8) >> 1); return ((kk >> 3) * 4 + (c >> 5)) * 512 + ((kk & 7) * 32 + (c & 31)) * 2; }
__device__ __forceinline__ int v_rd_base(int lane) { return ((lane & 3) << 3) | (((lane >> 2) & 3) << 6) | (((lane >> 4) & 1) << 5) | (((lane >> 5) & 1) << 8); }
constexpr int v_rd_off(int d0, int ks, int half) { return d0 * 512 + ks * 4096 + half * 2048; }
__device__ __forceinline__ int crow(int r, int hi) { return (r & 3) + 8 * (r >> 2) + 4 * hi; }
__device__ __forceinline__ unsigned cvtpk(float lo, float hi) {
    unsigned r; asm volatile("v_cvt_pk_bf16_f32 %0, %1, %2" : "=v"(r) : "v"(lo), "v"(hi)); return r;
}
__device__ __forceinline__ bf16x8 pack8(f32x4 a, f32x4 b) {
    u32x4 w = {cvtpk(a[0], a[1]), cvtpk(a[2], a[3]), cvtpk(b[0], b[1]), cvtpk(b[2], b[3])};
    return *reinterpret_cast<bf16x8*>(&w);
}
template <class T> __device__ __forceinline__ bf16x8 load8(const T* p) {
    if constexpr (same_t<T, float>::v) { return pack8(*(const f32x4*)p, *(const f32x4*)(p + 4)); }
    else { return *reinterpret_cast<const bf16x8*>(p); }
}
__device__ __forceinline__ void mask_tile(f32x16& p0, f32x16& p1, int dq, unsigned W) {
    const float NEG = -__builtin_inff();
#pragma unroll
    for (int r = 0; r < 16; ++r) {
        const int c = (r & 3) + 8 * (r >> 2);
        if ((unsigned)(dq - c) >= W) p0[r] = NEG;
        if ((unsigned)(dq - c - 32) >= W) p1[r] = NEG;
    }
}
typedef unsigned u32x2 __attribute__((ext_vector_type(2)));
__device__ __forceinline__ void bitmask_tile(f32x16& p0, f32x16& p1, u32x2 w, int hi) {
    const float NEG = -__builtin_inff();
    const unsigned a = w[0] >> (4 * hi), b = w[1] >> (4 * hi);
#pragma unroll
    for (int r = 0; r < 16; ++r) {
        const int c = (r & 3) + 8 * (r >> 2);
        if (!((a >> c) & 1u)) p0[r] = NEG;
        if (!((b >> c) & 1u)) p1[r] = NEG;
    }
}
template <bool HALFQK> __device__ __forceinline__ void partialSM(f32x16& p0, f32x16& p1, float& m_reg, float& mn, float& alpha) {
    constexpr float SCALE = HALFQK ? 0.125f : 0.08838834764831845f;
    float pmax = p0[0]; for (int r = 1; r < 16; ++r) pmax = fmaxf(pmax, p0[r]); for (int r = 0; r < 16; ++r) pmax = fmaxf(pmax, p1[r]);
    { auto rr = __builtin_amdgcn_permlane32_swap(__float_as_uint(pmax), __float_as_uint(pmax), false, false);
      pmax = fmaxf(__uint_as_float(rr[0]), __uint_as_float(rr[1])); }
    constexpr float C2 = 1.4426950408889634f * SCALE;
    if (__builtin_expect(__all((pmax - m_reg) * SCALE <= THR), 1)) { mn = m_reg; alpha = 1.f; }
    else { mn = fmaxf(m_reg, pmax); alpha = __builtin_amdgcn_exp2f((m_reg - mn) * C2); m_reg = mn; }
    const float mnL = -mn * C2;
    for (int r = 0; r < 16; ++r) p0[r] = fmaf(p0[r], C2, mnL); for (int r = 0; r < 16; ++r) p1[r] = fmaf(p1[r], C2, mnL);
    for (int r = 0; r < 16; ++r) p0[r] = __builtin_amdgcn_exp2f(p0[r]);
}
__device__ __forceinline__ void finishSM(f32x16& p0, f32x16& p1, float alpha, float& l_reg, bf16x8& pa0, bf16x8& pa1, bf16x8& pa2, bf16x8& pa3) {
    for (int r = 0; r < 16; ++r) p1[r] = __builtin_amdgcn_exp2f(p1[r]);
    float ps = 0; for (int r = 0; r < 16; ++r) ps += p0[r]; for (int r = 0; r < 16; ++r) ps += p1[r];
    { auto rr = __builtin_amdgcn_permlane32_swap(__float_as_uint(ps), __float_as_uint(ps), false, false);
      ps = __uint_as_float(rr[0]) + __uint_as_float(rr[1]); }
    l_reg = l_reg * alpha + ps;
#define PK4(P, B_, OUT) do { unsigned a0 = cvtpk(P[B_+0], P[B_+1]), a1 = cvtpk(P[B_+2], P[B_+3]);                          \
        unsigned b0 = cvtpk(P[B_+4], P[B_+5]), b1 = cvtpk(P[B_+6], P[B_+7]);                                             \
        auto r0 = __builtin_amdgcn_permlane32_swap(a0, b0, false, false); auto r1 = __builtin_amdgcn_permlane32_swap(a1, b1, false, false); \
        u32x4 w = {r0[0], r1[0], r0[1], r1[1]}; OUT = *reinterpret_cast<bf16x8*>(&w); } while (0)
    PK4(p0, 0, pa0); PK4(p0, 8, pa1); PK4(p1, 0, pa2); PK4(p1, 8, pa3);
#undef PK4
}
template <int KB, bool SK, bool HALFQK>
__device__ __forceinline__ void qkt(f32x16& p0, f32x16& p1, const char* K_lds, int r32, int hi, const bf16x8* qr, bool act, int koff) {
    if (SK && !act) { const float NEG = -__builtin_inff();
#pragma unroll
        for (int r = 0; r < 16; ++r) { p0[r] = NEG; p1[r] = NEG; } return; }
    p0 = f32x16{}; p1 = f32x16{};
    const char* kb[4];
#pragma unroll
    for (int dd = 0; dd < 4; ++dd) kb[dd] = K_lds + KB * SHM_K + KSWZ(r32, (dd * 16 + hi * 8) * 2) + koff;
#pragma unroll
    for (int d0 = 0; d0 < (HALFQK ? 4 : 8); ++d0) { const char* a = kb[d0 & 3] + (d0 >> 2) * 128;
        bf16x8 b0 = *reinterpret_cast<const bf16x8*>(a);
        bf16x8 b1 = *reinterpret_cast<const bf16x8*>(a + 32 * 256);
        p0 = __builtin_amdgcn_mfma_f32_32x32x16_bf16(b0, qr[d0], p0, 0, 0, 0);
        p1 = __builtin_amdgcn_mfma_f32_32x32x16_bf16(b1, qr[d0], p1, 0, 0, 0); }
}
template <int VB, bool SK>
__device__ __forceinline__ void pv_tile(f32x16* o, int vb0, bf16x8 pa0, bf16x8 pa1, bf16x8 pa2, bf16x8 pa3, bool act) {
    if (SK && !act) return;
#define TRRD(dst, off) asm volatile("ds_read_b64_tr_b16 %0, %1 offset:%2" : "=&v"(dst) : "v"(vb0), "i"(off) : "memory")
#define PV_D0(d0) do { s16x4 l0, l1, l2, l3, h0, h1, h2, h3; constexpr int b_ = VB * SHM_V + v_rd_off(d0, 0, 0);     \
        TRRD(l0, b_); TRRD(h0, b_ + 2048); TRRD(l1, b_ + 4096); TRRD(h1, b_ + 6144); TRRD(l2, b_ + 8192); TRRD(h2, b_ + 10240); TRRD(l3, b_ + 12288); TRRD(h3, b_ + 14336); \
        asm volatile("s_waitcnt lgkmcnt(0)" ::: "memory"); SBAR();                 \
        o[d0] = __builtin_amdgcn_mfma_f32_32x32x16_bf16(pa0, (bf16x8){l0[0], l0[1], l0[2], l0[3], h0[0], h0[1], h0[2], h0[3]}, o[d0], 0, 0, 0);   \
        o[d0] = __builtin_amdgcn_mfma_f32_32x32x16_bf16(pa1, (bf16x8){l1[0], l1[1], l1[2], l1[3], h1[0], h1[1], h1[2], h1[3]}, o[d0], 0, 0, 0);   \
        o[d0] = __builtin_amdgcn_mfma_f32_32x32x16_bf16(pa2, (bf16x8){l2[0], l2[1], l2[2], l2[3], h2[0], h2[1], h2[2], h2[3]}, o[d0], 0, 0, 0);   \
        o[d0] = __builtin_amdgcn_mfma_f32_32x32x16_bf16(pa3, (bf16x8){l3[0], l3[1], l3[2], l3[3], h3[0], h3[1], h3[2], h3[3]}, o[d0], 0, 0, 0); } while (0)
    PV_D0(0); PV_D0(1); PV_D0(2); PV_D0(3);
#undef PV_D0
#undef TRRD
}

constexpr int QS = 1536, KVS = 4096;
template <class TIn, class TOut> struct BlockRef { const TIn* Q; const TIn* K; const TIn* V; TOut* O; int P0; int koff; const unsigned* mask; };
template <class TIn> struct Seam {
    bf16x8 qr[8];
    bf16x8 st_v0, st_v1, st_k0, st_k1; f32x4 sf0, sf1, sf2, sf3;
    f32x4 tq[16];
};
__device__ __forceinline__ int swa_jlo(int P0, int W) { const int lowk = P0 - W + 1; return lowk > 0 ? lowk / KVBLK : 0; }
#define ROW(p, k0, rr) ((p) + (size_t)((k0) + (rr)) * KVS + sc)
#define VMW() asm volatile("s_waitcnt vmcnt(0)" ::: "memory")
#define VMWN(n) asm volatile("s_waitcnt vmcnt(%0)" :: "i"(n) : "memory")
#define SLOAD_H(Kp, Vp, k0) do { S.st_v0 = load8<TIn>(ROW(Vp, k0, sr)); S.st_v1 = load8<TIn>(ROW(Vp, k0, 32 + sr));              \
                         S.st_k0 = load8<TIn>(ROW(Kp, k0, sr)); S.st_k1 = load8<TIn>(ROW(Kp, k0, 32 + sr)); } while (0)
#define SWRITE_HK(bf) do { *(bf16x8*)(K_lds + (bf) * SHM_K + kws) = S.st_k0; *(bf16x8*)(K_lds + (bf) * SHM_K + kws + 32 * 256) = S.st_k1; } while (0)
#define SWRITE_HV(bf) do { *(bf16x8*)(V_lds + (bf) * SHM_V + vst0) = S.st_v0; *(bf16x8*)(V_lds + (bf) * SHM_V + vst1) = S.st_v1; } while (0)
#define SWRITE_H(bf) do { SWRITE_HV(bf); SWRITE_HK(bf); } while (0)
#define SLOAD_F(p, k0) do { S.sf0 = *(const f32x4*)ROW(p, k0, sr); S.sf1 = *(const f32x4*)(ROW(p, k0, sr) + 4);                \
                            S.sf2 = *(const f32x4*)ROW(p, k0, 32 + sr); S.sf3 = *(const f32x4*)(ROW(p, k0, 32 + sr) + 4); } while (0)
#define SWRITE_KF(bf) do { *(bf16x8*)(K_lds + (bf) * SHM_K + kws) = pack8(S.sf0, S.sf1); *(bf16x8*)(K_lds + (bf) * SHM_K + kws + 32 * 256) = pack8(S.sf2, S.sf3); } while (0)
#define SWRITE_VF(bf) do { *(bf16x8*)(V_lds + (bf) * SHM_V + vst0) = pack8(S.sf0, S.sf1); *(bf16x8*)(V_lds + (bf) * SHM_V + vst1) = pack8(S.sf2, S.sf3); } while (0)
template <class TIn, class TOut, bool HALFQK>
__device__ __forceinline__ void causal_swa_prime(const BlockRef<TIn, TOut>& cur, int W, char* lds, Seam<TIn>& S) {
    constexpr bool F32 = same_t<TIn, float>::v;
    const int tid = otid_(), wid = __builtin_amdgcn_readfirstlane(tid >> 6), lane = tid & 63, r32 = lane & 31, hi = lane >> 5;
    const int sr = tid >> 4, sc = (tid & 15) * 8, kws = KSWZ(sr, sc * 2); char* K_lds = lds + 2 * SHM_V;
    const int kb0 = swa_jlo(cur.P0, W) * KVBLK;
    for (int d0 = 0; d0 < (HALFQK ? 4 : 8); ++d0) S.qr[d0] = load8<TIn>(cur.Q + (size_t)(wid * QBLK + r32) * QS + d0 * 16 + hi * 8);
    if constexpr (F32) { SLOAD_F((const float*)cur.K, kb0); VMW(); SWRITE_KF(0); SBAR(); SLOAD_F((const float*)cur.V, kb0); }
    else { SLOAD_H(cur.K, cur.V, kb0); VMW(); SWRITE_HK(0); }
    __syncthreads();
}
template <class TIn, class TOut, bool HALFQK, bool MASKED, int OS>
__device__ __forceinline__ void causal_swa_block(const BlockRef<TIn, TOut>& cur, const BlockRef<TIn, TOut>& nxt, int skv, int W, char* lds, Seam<TIn>& S) {
    constexpr bool F32 = same_t<TIn, float>::v;
    const int tid = otid_(), wid = __builtin_amdgcn_readfirstlane(tid >> 6), lane = tid & 63, r32 = lane & 31, hi = lane >> 5;
    const int j_lo = swa_jlo(cur.P0, W);
    int j_hi = (cur.P0 + QB - 1) / KVBLK + 1; if (j_hi > skv / KVBLK) j_hi = skv / KVBLK;
    const int NT = j_hi - j_lo;
    const int kbn = swa_jlo(nxt.P0, W) * KVBLK;
    const int qlo = cur.P0 + wid * QBLK, qm = qlo + r32 - 4 * hi;
    char* V_lds = lds; char* K_lds = lds + 2 * SHM_V;
    float* ws = (float*)(lds + 2 * SHM_V + 2 * SHM_K) + wid * 64; float* li_l = ws, * al_l = ws + 32;
    float m_reg = -1e30f, l_reg = 0; f32x16 o[4] = {};
    const int sr = tid >> 4, sc = (tid & 15) * 8, vst0 = v_st(sr, sc), vst1 = v_st(32 + sr, sc), kws = KSWZ(sr, sc * 2);
    const int vb0 = (int)(uintptr_t)V_lds + v_rd_base(lane);
    const TIn* Kh = cur.K; const TIn* Vh = cur.V;
#define RESC(a) do { if (__any((a) < 1.f)) { if (hi == 0) al_l[r32] = (a); asm volatile("s_waitcnt lgkmcnt(0)" ::: "memory");              \
                     for (int d_ = 0; d_ < 4; ++d_) for (int r = 0; r < 16; ++r) o[d_][r] *= al_l[crow(r, hi)]; } } while (0)
#define KBASE(t) ((j_lo + (t)) * KVBLK)
#define ACT(t) (KBASE(t) <= qlo + QBLK - 1 && KBASE(t) + KVBLK - 1 >= qlo - W + 1)
#define MASKT(P0_, P1_, t) do { if constexpr (MASKED) bitmask_tile(P0_, P1_, mw, hi);   \
        else { const int kb_ = KBASE(t); if ((!SK || ACT(t)) && (kb_ + KVBLK - 1 > qlo || kb_ <= qlo + QBLK - 1 - W)) mask_tile(P0_, P1_, qm - kb_, (unsigned)W); } } while (0)
    const unsigned moff = (unsigned)((wid * QBLK + r32) * 1024 + 8 * j_lo); u32x2 mw = {0u, 0u};
#define MLOAD(t) do { if constexpr (MASKED) mw = *(const u32x2*)((const char*)cur.mask + (moff + 8u * (unsigned)(t))); } while (0)
    constexpr int NQL = F32 ? 16 : (HALFQK ? 4 : 8);
    constexpr bool SK = WSKIP && !F32;
#define SEAM_K0() do { VMWN(NQL); if constexpr (F32) { SWRITE_KF(0); SBAR(); SLOAD_F((const float*)nxt.V, kbn); } else { SWRITE_HK(0); } SBAR(); } while (0)
    f32x16 pA0, pA1, pB0, pB1; float mnA, mnB, alA, alB; bf16x8 pa0, pa1, pa2, pa3;
    if constexpr (F32) { VMW(); SWRITE_VF(0); SBAR(); } else { SWRITE_HV(0); SBAR(); }
    if (NT > 1) { if constexpr (F32) SLOAD_F((const float*)Kh, KBASE(1)); else SLOAD_H(Kh, Vh, KBASE(1)); }
    SBAR(); qkt<0, SK, HALFQK>(pA0, pA1, K_lds, r32, hi, S.qr, ACT(0), cur.koff); MLOAD(0);
    if constexpr (F32) { if (NT > 1) { VMW(); SWRITE_KF(1); SBAR(); SLOAD_F((const float*)Vh, KBASE(1)); } }
    MASKT(pA0, pA1, 0); partialSM<HALFQK>(pA0, pA1, m_reg, mnA, alA);
    if (NT > 1) { VMW(); if constexpr (F32) { SWRITE_VF(1); SBAR(); if (NT > 2) SLOAD_F((const float*)Kh, KBASE(2)); } else SWRITE_H(1); }
    __syncthreads();
#define HALF_STEP(PX0, PX1, mnX, alX, PY0, PY1, alY, t, KB, VB, SB) do {                                                      \
        SBAR(); qkt<KB, SK, HALFQK>(PX0, PX1, K_lds, r32, hi, S.qr, ACT(t), cur.koff); MLOAD(t);                                             \
        finishSM(PY0, PY1, alY, l_reg, pa0, pa1, pa2, pa3); SBAR();                                                           \
        if ((t) + 1 < NT) { if constexpr (F32) { VMW(); SWRITE_KF(SB); SBAR(); SLOAD_F((const float*)Vh, KBASE((t) + 1)); }  \
                            else { SLOAD_H(Kh, Vh, KBASE((t) + 1)); } SBAR(); }                                               \
        pv_tile<VB, SK>(o, vb0, pa0, pa1, pa2, pa3, ACT((t) - 1)); MASKT(PX0, PX1, (t)); partialSM<HALFQK>(PX0, PX1, m_reg, mnX, alX);                                        \
        __syncthreads();                                                                                                      \
        if ((t) + 1 < NT) { VMW(); if constexpr (F32) { SWRITE_VF(SB); SBAR(); if ((t) + 2 < NT) SLOAD_F((const float*)Kh, KBASE((t) + 2)); } \
                            else { SWRITE_H(SB); } }                                                                          \
        RESC(alX); __syncthreads(); } while (0)
    for (int t = 1; t + 1 < NT; t += 2) {
        HALF_STEP(pB0, pB1, mnB, alB, pA0, pA1, alA, t, 1, 0, 0);
        HALF_STEP(pA0, pA1, mnA, alA, pB0, pB1, alB, t + 1, 0, 1, 1);
    }
    const bool even = (NT & 1) == 0;
    if (even) { SBAR(); qkt<1, SK, HALFQK>(pB0, pB1, K_lds, r32, hi, S.qr, ACT(NT - 1), cur.koff); MLOAD(NT - 1); SBAR(); }
#define QROW(e) (nxt.Q + (size_t)(wid * QBLK + r32) * QS + ((e) >> 1) * 16 + hi * 8 + ((e) & 1) * 4)
    if constexpr (F32) { SLOAD_F((const float*)nxt.K, kbn); SBAR();
#pragma unroll
        for (int e = 0; e < 8; ++e) S.tq[e] = *(const f32x4*)QROW(e); }
    else { SLOAD_H(nxt.K, nxt.V, kbn); SBAR();
#pragma unroll
        for (int d0 = 0; d0 < (HALFQK ? 4 : 8); ++d0) S.qr[d0] = load8<TIn>(nxt.Q + (size_t)(wid * QBLK + r32) * QS + d0 * 16 + hi * 8); }
    SBAR();
    finishSM(pA0, pA1, alA, l_reg, pa0, pa1, pa2, pa3); SBAR();
    if constexpr (F32) {
#pragma unroll
        for (int e = 8; e < 16; ++e) S.tq[e] = *(const f32x4*)QROW(e); SBAR(); }
#undef QROW
    pv_tile<0, SK>(o, vb0, pa0, pa1, pa2, pa3, ACT(even ? NT - 2 : NT - 1));
    if (even) { MASKT(pB0, pB1, NT - 1); partialSM<HALFQK>(pB0, pB1, m_reg, mnB, alB); __syncthreads(); RESC(alB);
        finishSM(pB0, pB1, alB, l_reg, pa0, pa1, pa2, pa3); SBAR(); pv_tile<1, SK>(o, vb0, pa0, pa1, pa2, pa3, ACT(NT - 1)); }
    SBAR(); SEAM_K0();
    if (hi == 0) li_l[r32] = l_reg; asm volatile("s_waitcnt lgkmcnt(0)" ::: "memory");
    float rli[16];
#pragma unroll
    for (int r = 0; r < 16; ++r) rli[r] = __builtin_amdgcn_rcpf(li_l[crow(r, hi)]);
    TOut* Ow = cur.O + (size_t)(wid * QBLK) * OS;
#pragma unroll
    for (int r = 0; r < 16; ++r) { const int orow = crow(r, hi);
#pragma unroll
        for (int d0 = 0; d0 < 4; ++d0) { const float v = o[d0][r] * rli[r];
            if constexpr (same_t<TOut, float>::v) { Ow[(size_t)orow * OS + d0 * 32 + r32] = v; }
            else { const float vn = __shfl_xor(v, 1);
                   if ((r32 & 1) == 0) *(unsigned*)(Ow + (size_t)orow * OS + d0 * 32 + r32) = cvtpk(v, vn); } } }
    if constexpr (F32) {
#pragma unroll
        for (int d0 = 0; d0 < 8; ++d0) S.qr[d0] = pack8(S.tq[2 * d0], S.tq[2 * d0 + 1]); }
    __syncthreads();
#undef RESC
#undef KBASE
#undef ACT
#undef MASKT
#undef MLOAD
#undef SEAM_K0
#undef HALF_STEP
}
#undef ROW
#undef VMW
#undef VMWN
#undef SLOAD_H
#undef SWRITE_HK
#undef SWRITE_HV
#undef SWRITE_H
#undef SLOAD_F
#undef SWRITE_KF
#undef SWRITE_VF
}
#ifndef PROBE
#define PROBE 0
#endif
constexpr int NWAVES = 8;
constexpr int NB = 2, T = 8192, M = NB * T, DM = 1024, FF = 2816, NIN = 8520, NLAYER = 2;
constexpr float NORM_EPS = 1e-6f;
constexpr size_t MiB = 1u << 20;
constexpr size_t WS_CTL = 0, CTL_ZERO_BYTES = 1 * MiB;
constexpr size_t WS_WF = 1 * MiB;
constexpr size_t WS_WF_DOWN = WS_WF + 11 * MiB;
constexpr size_t WS_WM = 18 * MiB;
constexpr size_t WS_WM_BR = WS_WM + 17 * MiB, WS_WM_OUT = WS_WM + 20 * MiB;
constexpr size_t WS_XN = 40 * MiB;
constexpr size_t WS_Q3 = 72 * MiB;
constexpr size_t WS_ZR = 120 * MiB;
constexpr size_t WS_R2 = 248 * MiB;
constexpr size_t WS_END = 280 * MiB;
constexpr size_t WS_MG = WS_ZR + 96 * MiB;
constexpr size_t WS_YRAW = WS_WF;
constexpr size_t WS_X1 = WS_XN + 16 * MiB;
constexpr size_t WS_A8 = WS_WM;
constexpr size_t WS_KID = WS_WM + 8 * MiB;
constexpr size_t WS_BITM = WS_XN;
constexpr size_t WS_RDOTK = WS_WF + 16 * MiB;
constexpr int QP = 1536, ZP = 4096;
constexpr int ZC_DK = 0, ZC_DV = 512, ZC_QI = 1024, ZC_KI = 1536, ZC_WI = 1600, ZC_RK = 1792, ZC_RV = 2304, ZC_WC = 2816, ZC_AC = 2880, ZC_GC = 2944, ZC_FK = 3072, ZC_FV = 3584;
constexpr int CW_TMO = 0;
constexpr int CW_BAR = 4096;
constexpr int CW_Q = 8192;
constexpr int CW_PROBE = 2048;
constexpr int CW_DONE = 12288;
constexpr int LDS_MISC = 160 * 1024 - 256;
constexpr int LDS_BYTES = 160 * 1024;

#define GAS __attribute__((address_space(1)))
#define LAS __attribute__((address_space(3)))
typedef unsigned short bf16;
typedef unsigned v4u __attribute__((ext_vector_type(4)));
typedef unsigned v2u __attribute__((ext_vector_type(2)));
typedef float f32x4 __attribute__((ext_vector_type(4)));
typedef float f32x2 __attribute__((ext_vector_type(2)));
typedef float f32x16 __attribute__((ext_vector_type(16)));
typedef short bf16x8 __attribute__((ext_vector_type(8)));
typedef GAS unsigned gu32;
#define RLX_AGENT __ATOMIC_RELAXED, __HIP_MEMORY_SCOPE_AGENT
#define LDS_WAIT() asm volatile("s_waitcnt lgkmcnt(0)" ::: "memory")
#define VM_WAIT() asm volatile("s_waitcnt vmcnt(0)" ::: "memory")
__device__ __forceinline__ unsigned f2bf(float f) { unsigned u = __builtin_bit_cast(unsigned, f); return (u + 0x7fffu + ((u >> 16) & 1u)) >> 16; }
__device__ __forceinline__ unsigned pk2(float lo, float hi) { return f2bf(lo) | (f2bf(hi) << 16); }
__device__ __forceinline__ float bflo(unsigned w) { return __uint_as_float(w << 16); }
__device__ __forceinline__ float bfhi(unsigned w) { return __uint_as_float(w & 0xffff0000u); }
__device__ __forceinline__ float bf1(bf16 h) { return __uint_as_float((unsigned)h << 16); }
__device__ __forceinline__ float wave_sum(float v) {
#pragma unroll
    for (int o = 1; o < 64; o <<= 1) v += __shfl_xor(v, o);
    return v;
}
__device__ __forceinline__ float sigm(float x) { return __builtin_amdgcn_rcpf(1.0f + __expf(-x)); }

#define XB_TMO      128
#define XB_XCNT(j)  (256  + 64 * (j))
#define XB_XSUB(j)  (1280 + 64 * (j))
#define XB_XGEN(j)  (2304 + 64 * (j))
#define XB_TOP      3328
#define XB_TOPGEN   3392
#define XCD_BAR_WORDS 3456
#define XB_SPIN_CAP (1u << 22)
__device__ __forceinline__ unsigned xb_ld(unsigned* p)              { return __hip_atomic_load(p, __ATOMIC_RELAXED, __HIP_MEMORY_SCOPE_AGENT); }
__device__ __forceinline__ unsigned xb_add(unsigned* p, unsigned v) { return __hip_atomic_fetch_add(p, v, __ATOMIC_RELAXED, __HIP_MEMORY_SCOPE_AGENT); }
__device__ __forceinline__ unsigned xb_xcc_id() { return (unsigned)__builtin_amdgcn_s_getreg((3 << 11) | 20) & 0xFu; }
#define XB_SPIN(cond, bar) do { unsigned _sp = 0; while (cond) { __builtin_amdgcn_s_sleep(1); \
    if ((++_sp & 255u) == 0u) { if (xb_ld(&(bar)[XB_TMO])) break; if (_sp > XB_SPIN_CAP) { atomicAdd(&(bar)[XB_TMO], 1u); break; } } } } while (0)
struct XcdBarrier { unsigned* bar; unsigned x; volatile LAS unsigned* st; };
__device__ __forceinline__ XcdBarrier xcd_barrier_post(unsigned* bar, volatile LAS unsigned* st) {
    XcdBarrier b; b.bar = bar; b.x = xb_xcc_id(); b.st = st;
    if (threadIdx.x == 0) (void)xb_add(&bar[XB_XCNT(b.x)], 1u);
    return b;
}
__device__ __forceinline__ void xcd_barrier_complete(unsigned* bar, unsigned x, unsigned& nloc, unsigned& nx) {
    const unsigned G = gridDim.x * gridDim.y * gridDim.z;
    unsigned sum, cnt, mine, sp = 0u;
    for (;;) {
        sum = 0u; cnt = 0u; mine = 0u;
#pragma unroll
        for (unsigned j = 0; j < 16; ++j) { const unsigned c = xb_ld(&bar[XB_XCNT(j)]); sum += c; cnt += (c > 0u) ? 1u : 0u; mine = (j == x) ? c : mine; }
        if (sum == G) break;
        __builtin_amdgcn_s_sleep(1);
        if ((++sp & 255u) == 0u) { if (xb_ld(&bar[XB_TMO])) break; if (sp > XB_SPIN_CAP) { atomicAdd(&bar[XB_TMO], 1u); break; } }
    }
    nloc = mine > 0u ? mine : 1u; nx = cnt > 0u ? cnt : 1u;
}
__device__ __forceinline__ void xcd_barrier(const XcdBarrier& b) {
    asm volatile("s_waitcnt vmcnt(0)" ::: "memory");
    __syncthreads();
    if (threadIdx.x == 0) {
        unsigned* bar = b.bar;
        __builtin_amdgcn_s_waitcnt(0);
        unsigned nloc = b.st[0], nx = b.st[1];
        if (nloc == 0u) { xcd_barrier_complete(bar, b.x, nloc, nx); b.st[0] = nloc; b.st[1] = nx; }
        const unsigned old = xb_add(&bar[XB_XSUB(b.x)], 1u);
        const unsigned gen = old / nloc;
        if (old + 1u == (gen + 1u) * nloc) {
            __builtin_amdgcn_fence(__ATOMIC_RELEASE, "agent");
            asm volatile("s_waitcnt vmcnt(0)" ::: "memory");
            const unsigned og = xb_add(&bar[XB_TOP], 1u);
            const unsigned tg = og / nx;
            if (og + 1u == (tg + 1u) * nx) xb_add(&bar[XB_TOPGEN], 1u);
            else XB_SPIN(xb_ld(&bar[XB_TOPGEN]) == tg, bar);
            __builtin_amdgcn_fence(__ATOMIC_ACQUIRE, "agent");
            xb_add(&bar[XB_XGEN(b.x)], 1u);
            asm volatile("s_waitcnt vmcnt(0)" ::: "memory");
        } else {
            XB_SPIN(xb_ld(&bar[XB_XGEN(b.x)]) == gen, bar);
            __builtin_amdgcn_fence(__ATOMIC_ACQUIRE, "agent");
            asm volatile("s_waitcnt vmcnt(0)" ::: "memory");
        }
    }
    __syncthreads();
}

struct MapIdent { const float* W; int ld; __device__ __forceinline__ const float* col(int n) const { return W + n; } };
struct MapUp {
    const float* G; const float* U; int ld;
    __device__ __forceinline__ const float* col(int n) const { const int g = n >> 5, j = n & 31; return j < 16 ? G + 16 * g + j : U + 16 * g + (j - 16); }
};
struct MapWin {
    const float* W; int ld;
    __device__ __forceinline__ const float* col(int n) const {
        int src;
        if (n < 512) src = n; else if (n < 1024) src = 2120 + (n - 512); else if (n < 1536) src = 3912 + (n - 1024);
        else if (n < 5632) { const int z = n - 1536; if (z < 1608) src = 512 + z; else if (z < 1792) src = -1; else if (z < 3072) src = 840 + z; else src = 1352 + z; }
        else src = 5448 + (n - 5632);
        return src < 0 ? nullptr : W + src;
    }
};
template <class Map>
__device__ __forceinline__ void conv_item(const Map& mp, int K, bf16* WT, LAS float* scr, int item, int nblk, int lane) {
    const int kb = item / nblk, nb = item % nblk, k0 = 32 * kb, n0 = 32 * nb;
    const float* cp = mp.col(n0 + (lane & 31)); const size_t ld = (size_t)mp.ld;
#pragma unroll
    for (int i = 0; i < 16; ++i) { const int kk = 2 * i + (lane >> 5); scr[kk * 33 + (lane & 31)] = cp ? cp[(size_t)(k0 + kk) * ld] : 0.f; }
    LDS_WAIT(); asm volatile("" ::: "memory");
    const int c = lane & 3;
#pragma unroll
    for (int j = 0; j < 2; ++j) { const int n = (lane >> 2) + 16 * j; const LAS float* s = scr + (8 * c) * 33 + n;
        v4u o; o.x = pg8::cvt_pk_bf16(s[0 * 33], s[1 * 33]); o.y = pg8::cvt_pk_bf16(s[2 * 33], s[3 * 33]); o.z = pg8::cvt_pk_bf16(s[4 * 33], s[5 * 33]); o.w = pg8::cvt_pk_bf16(s[6 * 33], s[7 * 33]);
        *(GAS v4u*)(WT + (size_t)(n0 + n) * K + k0 + 8 * c) = o; }
    LDS_WAIT(); asm volatile("" ::: "memory");
}
__host__ __device__ constexpr int conv_items(int K, int N) { return (K / 32) * (N / 32); }

__device__ __forceinline__ void rownorm_rows(const float* base, const bf16* Y, float s, const float* gpost, float* out, const float* gnext, bf16* XN, int gw, int NGW, int lane, float oscale = 1.f) {
    for (int m = gw; m < M; m += NGW) {
        f32x4 v[4];
#pragma unroll
        for (int j = 0; j < 4; ++j) v[j] = ((const GAS f32x4*)(base + (size_t)m * DM))[lane + 64 * j];
        if (Y) {
            f32x4 y[4]; float ss = 0.f;
#pragma unroll
            for (int j = 0; j < 4; ++j) { const v2u w = ((const GAS v2u*)(Y + (size_t)m * DM))[lane + 64 * j]; y[j] = (f32x4){bflo(w.x), bfhi(w.x), bflo(w.y), bfhi(w.y)};
                ss += (y[j].x * y[j].x + y[j].y * y[j].y) + (y[j].z * y[j].z + y[j].w * y[j].w); }
            const float r = s * __builtin_amdgcn_rsqf(wave_sum(ss) * (1.f / DM) + NORM_EPS);
#pragma unroll
            for (int j = 0; j < 4; ++j) { const f32x4 g = ((const GAS f32x4*)gpost)[lane + 64 * j]; v[j] = v[j] + y[j] * g * r; ((GAS f32x4*)(out + (size_t)m * DM))[lane + 64 * j] = v[j] * oscale; }
        }
        if (XN) {
            float ss = 0.f;
#pragma unroll
            for (int j = 0; j < 4; ++j) ss += (v[j].x * v[j].x + v[j].y * v[j].y) + (v[j].z * v[j].z + v[j].w * v[j].w);
            const float r = __builtin_amdgcn_rsqf(wave_sum(ss) * (1.f / DM) + NORM_EPS);
#pragma unroll
            for (int j = 0; j < 4; ++j) { const f32x4 g = ((const GAS f32x4*)gnext)[lane + 64 * j]; const f32x4 o = v[j] * g * r;
                v2u w; w.x = pk2(o.x, o.y); w.y = pk2(o.z, o.w); ((GAS v2u*)(XN + (size_t)m * DM))[lane + 64 * j] = w; }
        }
    }
}

namespace scan {
template <int CTRL> __device__ __forceinline__ float dpp_add(float x) {
    const int y = __builtin_amdgcn_update_dpp(0, __builtin_bit_cast(int, x), CTRL, 0xF, 0xF, false);
    return x + __builtin_bit_cast(float, y);
}
__device__ __forceinline__ float red8(float x) { x = dpp_add<0xB1>(x); x = dpp_add<0x4E>(x); x = dpp_add<0x141>(x); return x; }
__device__ __forceinline__ float red16(float x) { x = dpp_add<0xB1>(x); x = dpp_add<0x4E>(x); x = dpp_add<0x141>(x); x = dpp_add<0x140>(x); return x; }
__device__ __forceinline__ void ld8(const bf16* p, float (&o)[8]) { const v4u w = *(const GAS v4u*)p; o[0] = bflo(w.x); o[1] = bfhi(w.x); o[2] = bflo(w.y); o[3] = bfhi(w.y); o[4] = bflo(w.z); o[5] = bfhi(w.z); o[6] = bflo(w.w); o[7] = bfhi(w.w); }
}
struct PrepP { const bf16* ZR; bf16* X1; unsigned char* A8; bf16* KI; const float *mu, *w0, *wup, *a0, *aup; };
__device__ __forceinline__ void rwkv_prep(const PrepP& P, LAS unsigned char* lds) {
    const int tid = otid_(), lane = tid & 63, h = __builtin_amdgcn_readfirstlane(tid >> 6), c16 = lane & 15, quad = lane >> 4;
    constexpr int SP = 144;
    LAS unsigned char* TA = lds; LAS unsigned char* AA = lds + 64 * SP;
    bf16x8 bw[4][2], ba[4][2];
#pragma unroll
    for (int ct = 0; ct < 4; ++ct)
#pragma unroll
        for (int s = 0; s < 2; ++s) { const size_t o = (size_t)(32 * s + 8 * quad) * 512 + 64 * h + 16 * ct + c16; const float* gw_ = P.wup + o; const float* ga_ = P.aup + o;
            v4u w; w.x = pk2(gw_[0], gw_[512]); w.y = pk2(gw_[1024], gw_[1536]); w.z = pk2(gw_[2048], gw_[2560]); w.w = pk2(gw_[3072], gw_[3584]); bw[ct][s] = __builtin_bit_cast(bf16x8, w);
            v4u a; a.x = pk2(ga_[0], ga_[512]); a.y = pk2(ga_[1024], ga_[1536]); a.z = pk2(ga_[2048], ga_[2560]); a.w = pk2(ga_[3072], ga_[3584]); ba[ct][s] = __builtin_bit_cast(bf16x8, a); }
    float w0v[4], a0v[4];
#pragma unroll
    for (int ct = 0; ct < 4; ++ct) { w0v[ct] = P.w0[64 * h + 16 * ct + c16]; a0v[ct] = P.a0[64 * h + 16 * ct + c16]; }
    const int stok = tid >> 3, sseg = tid & 7;
#pragma unroll 1
    for (int m0 = blockIdx.x * 64; m0 < M; m0 += gridDim.x * 64) {
        {   const size_t m = (size_t)m0 + stok; const int t = (int)(m & (T - 1));
            *(GAS v4u*)(P.KI + m * 64 + 8 * sseg) = *(const GAS v4u*)(P.ZR + m * ZP + ZC_KI + 8 * sseg);
            float wc[8], ac[8], p8[8];
            scan::ld8(P.ZR + m * ZP + ZC_WC + 8 * sseg, wc); scan::ld8(P.ZR + m * ZP + ZC_AC + 8 * sseg, ac);
            if (t > 0) { scan::ld8(P.ZR + (m - 1) * ZP + ZC_WC + 8 * sseg, p8);
#pragma unroll
                for (int e = 0; e < 8; ++e) wc[e] += (p8[e] - wc[e]) * P.mu[1536 + 8 * sseg + e];
                scan::ld8(P.ZR + (m - 1) * ZP + ZC_AC + 8 * sseg, p8);
#pragma unroll
                for (int e = 0; e < 8; ++e) ac[e] += (p8[e] - ac[e]) * P.mu[1600 + 8 * sseg + e]; }
            else {
#pragma unroll
                for (int e = 0; e < 8; ++e) { wc[e] -= wc[e] * P.mu[1536 + 8 * sseg + e]; ac[e] -= ac[e] * P.mu[1600 + 8 * sseg + e]; } }
            float th[8];
#pragma unroll
            for (int e = 0; e < 8; ++e) th[e] = 1.f - 2.f * __builtin_amdgcn_rcpf(__expf(2.f * wc[e]) + 1.f);
            v4u o; o.x = pk2(th[0], th[1]); o.y = pk2(th[2], th[3]); o.z = pk2(th[4], th[5]); o.w = pk2(th[6], th[7]); *(LAS v4u*)(TA + stok * SP + 16 * sseg) = o;
            v4u q; q.x = pk2(ac[0], ac[1]); q.y = pk2(ac[2], ac[3]); q.z = pk2(ac[4], ac[5]); q.w = pk2(ac[6], ac[7]); *(LAS v4u*)(AA + stok * SP + 16 * sseg) = q;
        }
        __syncthreads();
#pragma unroll 1
        for (int rt = 0; rt < 4; ++rt) {
            f32x4 accw[4], acca[4];
#pragma unroll
            for (int ct = 0; ct < 4; ++ct) { accw[ct] = (f32x4){0.f, 0.f, 0.f, 0.f}; acca[ct] = (f32x4){0.f, 0.f, 0.f, 0.f}; }
#pragma unroll
            for (int s = 0; s < 2; ++s) { const bf16x8 fw = *(const LAS bf16x8*)(TA + (16 * rt + c16) * SP + (32 * s + 8 * quad) * 2), fa = *(const LAS bf16x8*)(AA + (16 * rt + c16) * SP + (32 * s + 8 * quad) * 2);
#pragma unroll
                for (int ct = 0; ct < 4; ++ct) { accw[ct] = __builtin_amdgcn_mfma_f32_16x16x32_bf16(fw, bw[ct][s], accw[ct], 0, 0, 0); acca[ct] = __builtin_amdgcn_mfma_f32_16x16x32_bf16(fa, ba[ct][s], acca[ct], 0, 0, 0); } }
#pragma unroll
            for (int j = 0; j < 4; ++j) { const size_t m = (size_t)m0 + 16 * rt + 4 * quad + j;
#pragma unroll
                for (int ct = 0; ct < 4; ++ct) { const int ch = 64 * h + 16 * ct + c16;
                    const float sg = sigm(w0v[ct] + accw[ct][j]);
                    const float x1 = 1.f - __expf(-0.6065306597126334f * sg);
                    const float a = sigm(a0v[ct] + acca[ct][j]);
                    P.X1[m * 512 + ch] = (bf16)f2bf(x1);
                    P.A8[m * 512 + ch] = (unsigned char)(int)(a * 255.f + 0.5f); } }
        }
        __syncthreads();
    }
}

struct ScanP { const bf16* Q3; const bf16* ZR; const bf16* X1; const unsigned char* A8; bf16* yraw; float* rdotk; const float *mu, *k_k, *k_a, *r_k; };
namespace scan {
constexpr int TB = 32, NBLK = T / TB;
constexpr int CB_W = 0, CB_B = 8192, CB_K = 16384, CB_KW = 24576, CB_V = 40960, CB_BR = 43008, CB_KR = 43136, CB_SA = 43264, CB_YP = 45312, CBSZ = 78080;
constexpr int L_END = 2 * CBSZ;
static_assert(L_END <= LDS_MISC, "scan LDS");
}
__device__ __forceinline__ void rwkv_scan_unit(const ScanP& P, int unit, LAS unsigned char* lds) {
    using namespace scan;
    const int tid = otid_(), wid = __builtin_amdgcn_readfirstlane(tid >> 6), lane = tid & 63;
    const int b = unit >> 5, h = (unit >> 2) & 7, vq = unit & 3;
    const size_t mrow0 = (size_t)b * T;
    if (wid >= 4) {
        const int pw = wid - 4, tokl = lane >> 3, seg = lane & 7, c0 = 8 * seg, hc0 = 64 * h + c0;
        float mu_r[8], mu_k[8], kkv[8], kav[8], rkv[8];
#pragma unroll
        for (int e = 0; e < 8; ++e) { mu_r[e] = P.mu[hc0 + e]; mu_k[e] = P.mu[512 + hc0 + e]; kkv[e] = P.k_k[hc0 + e]; kav[e] = P.k_a[hc0 + e]; rkv[e] = P.r_k[hc0 + e]; }
        const int vc0 = 64 * h + 16 * vq + 2 * seg;
        const float mu_v0 = P.mu[1024 + vc0], mu_v1 = P.mu[1024 + vc0 + 1];
        const int ptid = pw * 64 + lane;
        v4u nr, nrp, nk, nkp, nx; v2u na; unsigned nv, nvp;
#define SCAN_LOAD(nb_) do { const int t_ = (nb_) * TB + 8 * pw + tokl; const size_t m_ = mrow0 + t_, mp_ = t_ > 0 ? m_ - 1 : m_; \
            nr = *(const GAS v4u*)(P.Q3 + m_ * QP + 512 + hc0); nrp = *(const GAS v4u*)(P.Q3 + mp_ * QP + 512 + hc0); \
            nk = *(const GAS v4u*)(P.ZR + m_ * ZP + ZC_RK + hc0); nkp = *(const GAS v4u*)(P.ZR + mp_ * ZP + ZC_RK + hc0); \
            nx = *(const GAS v4u*)(P.X1 + m_ * 512 + hc0); na = *(const GAS v2u*)(P.A8 + m_ * 512 + hc0); \
            nv = *(const GAS unsigned*)(P.ZR + m_ * ZP + ZC_RV + vc0); nvp = *(const GAS unsigned*)(P.ZR + mp_ * ZP + ZC_RV + vc0); } while (0)
#define UNPK8(w_, o_) do { o_[0] = bflo(w_.x); o_[1] = bfhi(w_.x); o_[2] = bflo(w_.y); o_[3] = bfhi(w_.y); o_[4] = bflo(w_.z); o_[5] = bfhi(w_.z); o_[6] = bflo(w_.w); o_[7] = bfhi(w_.w); } while (0)
        SCAN_LOAD(0);
        for (int blk = -1; blk < NBLK; ++blk) {
            const int nb = blk + 1;
            LAS unsigned char* cb = lds + (nb & 1) * CBSZ;
            if (blk >= 1) {
                const int tok = ptid >> 3, v2 = (ptid & 7) * 2;
                const LAS float* YPp = (const LAS float*)(cb + CB_YP) + (tok * 16 + v2) * 16;
                float y0 = 0.f, y1 = 0.f;
#pragma unroll
                for (int q4 = 0; q4 < 4; ++q4) { const f32x4 a = *(const LAS f32x4*)(YPp + 4 * q4), c = *(const LAS f32x4*)(YPp + 16 + 4 * q4); y0 += (a.x + a.y) + (a.z + a.w); y1 += (c.x + c.y) + (c.z + c.w); }
                const float kr = *(const LAS float*)(cb + CB_KR + tok * 4);
                const f32x2 vv = *(const LAS f32x2*)(cb + CB_V + (tok * 16 + v2) * 4);
                y0 += vv.x * kr; y1 += vv.y * kr;
                const size_t m = mrow0 + (size_t)(blk - 1) * TB + tok;
                *(GAS unsigned*)(P.yraw + m * 512 + 64 * h + 16 * vq + v2) = pk2(y0, y1);
                LDS_WAIT(); asm volatile("" ::: "memory");
            }
            if (nb < NBLK) {
                const int t = nb * TB + 8 * pw + tokl; const size_t m = mrow0 + t;
                float r8[8], k8[8], p8[8], x8[8], a8[8];
                const v4u cr = nr, crp = nrp, ck = nk, ckp = nkp, cx = nx; const v2u ca = na; const unsigned cv = nv, cvp = nvp;
                if (nb + 1 < NBLK) SCAN_LOAD(nb + 1);
                UNPK8(cr, r8); UNPK8(ck, k8); UNPK8(cx, x8);
                { const float sc = 1.f / 255.f;
                  a8[0] = (float)(ca.x & 255u) * sc; a8[1] = (float)((ca.x >> 8) & 255u) * sc; a8[2] = (float)((ca.x >> 16) & 255u) * sc; a8[3] = (float)(ca.x >> 24) * sc;
                  a8[4] = (float)(ca.y & 255u) * sc; a8[5] = (float)((ca.y >> 8) & 255u) * sc; a8[6] = (float)((ca.y >> 16) & 255u) * sc; a8[7] = (float)(ca.y >> 24) * sc; }
                float v0 = bflo(cv), v1 = bfhi(cv);
                if (t > 0) {
                    UNPK8(crp, p8);
#pragma unroll
                    for (int e = 0; e < 8; ++e) r8[e] += (p8[e] - r8[e]) * mu_r[e];
                    UNPK8(ckp, p8);
#pragma unroll
                    for (int e = 0; e < 8; ++e) k8[e] += (p8[e] - k8[e]) * mu_k[e];
                    v0 += (bflo(cvp) - v0) * mu_v0; v1 += (bfhi(cvp) - v1) * mu_v1;
                } else {
#pragma unroll
                    for (int e = 0; e < 8; ++e) { r8[e] -= r8[e] * mu_r[e]; k8[e] -= k8[e] * mu_k[e]; }
                    v0 -= v0 * mu_v0; v1 -= v1 * mu_v1;
                }
                float kk8[8]; { float ss = 0.f;
#pragma unroll
                  for (int e = 0; e < 8; ++e) { kk8[e] = k8[e] * kkv[e]; ss += kk8[e] * kk8[e]; }
                  ss = red8(ss); const float inv = 1.f / fmaxf(sqrtf(ss), 1e-12f);
#pragma unroll
                  for (int e = 0; e < 8; ++e) kk8[e] *= inv; }
                float w8[8], bb[8], km[8], wr[8]; float brp = 0.f, krp = 0.f, rkp = 0.f;
#pragma unroll
                for (int e = 0; e < 8; ++e) {
                    w8[e] = 1.f - x8[e];
                    bb[e] = kk8[e] * a8[e]; km[e] = k8[e] * (1.f + (a8[e] - 1.f) * kav[e]);
                    brp += bb[e] * r8[e]; krp += km[e] * r8[e]; rkp += r8[e] * km[e] * rkv[e];
                }
                brp = red8(brp); krp = red8(krp); rkp = red8(rkp);
#pragma unroll
                for (int e = 0; e < 8; ++e) wr[e] = w8[e] * r8[e] - kk8[e] * brp;
                const int ti = 8 * pw + tokl;
                *(LAS f32x4*)(cb + CB_W + (ti * 64 + c0) * 4) = (f32x4){w8[0], w8[1], w8[2], w8[3]}; *(LAS f32x4*)(cb + CB_W + (ti * 64 + c0 + 4) * 4) = (f32x4){w8[4], w8[5], w8[6], w8[7]};
                *(LAS f32x4*)(cb + CB_B + (ti * 64 + c0) * 4) = (f32x4){bb[0], bb[1], bb[2], bb[3]}; *(LAS f32x4*)(cb + CB_B + (ti * 64 + c0 + 4) * 4) = (f32x4){bb[4], bb[5], bb[6], bb[7]};
                *(LAS f32x4*)(cb + CB_K + (ti * 64 + c0) * 4) = (f32x4){km[0], km[1], km[2], km[3]}; *(LAS f32x4*)(cb + CB_K + (ti * 64 + c0 + 4) * 4) = (f32x4){km[4], km[5], km[6], km[7]};
#pragma unroll
                for (int e = 0; e < 8; e += 2) *(LAS f32x4*)(cb + CB_KW + ti * 512 + ((e >> 1) & 1) * 256 + (2 * seg + (e >> 2)) * 16) = (f32x4){kk8[e], wr[e], kk8[e + 1], wr[e + 1]};
                *(LAS f32x2*)(cb + CB_V + (ti * 16 + 2 * seg) * 4) = (f32x2){v0, v1};
                if (seg == 0) { *(LAS float*)(cb + CB_KR + ti * 4) = krp; if (vq == 0) P.rdotk[m * 8 + h] = rkp; }
            }
            __syncthreads();
        }
        { const LAS unsigned char* cb = lds + ((NBLK - 1) & 1) * CBSZ;
          const int tok = ptid >> 3, v2 = (ptid & 7) * 2;
          const LAS float* YPp = (const LAS float*)(cb + CB_YP) + (tok * 16 + v2) * 16;
          float y0 = 0.f, y1 = 0.f;
#pragma unroll
          for (int q4 = 0; q4 < 4; ++q4) { const f32x4 a = *(const LAS f32x4*)(YPp + 4 * q4), c = *(const LAS f32x4*)(YPp + 16 + 4 * q4); y0 += (a.x + a.y) + (a.z + a.w); y1 += (c.x + c.y) + (c.z + c.w); }
          const float kr = *(const LAS float*)(cb + CB_KR + tok * 4);
          const f32x2 vv = *(const LAS f32x2*)(cb + CB_V + (tok * 16 + v2) * 4);
          y0 += vv.x * kr; y1 += vv.y * kr;
          const size_t m = mrow0 + (size_t)(NBLK - 1) * TB + tok;
          *(GAS unsigned*)(P.yraw + m * 512 + 64 * h + 16 * vq + v2) = pk2(y0, y1); }
    } else {
        const int vi = 4 * wid + (lane >> 4), cg = lane & 15;
        f32x2 s01 = {0.f, 0.f}, s23 = {0.f, 0.f};
        __syncthreads();
        __builtin_amdgcn_s_setprio(3);
        const unsigned lo4 = (unsigned)(4 * cg) * 4u;
        for (int blk = 0; blk < NBLK; ++blk) {
            const LAS unsigned char* cb = lds + (blk & 1) * CBSZ;
            f32x4 kwa = *(const LAS f32x4*)(cb + CB_KW + lo4), kwb = *(const LAS f32x4*)(cb + CB_KW + 256 + lo4);
            f32x4 w4 = *(const LAS f32x4*)(cb + CB_W + lo4), b4 = *(const LAS f32x4*)(cb + CB_B + lo4), k4 = *(const LAS f32x4*)(cb + CB_K + lo4);
            float vv = *(const LAS float*)(cb + CB_V + vi * 4);
#pragma unroll 4
            for (int tok = 0; tok < TB; ++tok) {
                const int tn = tok + 1 < TB ? tok + 1 : tok;
                const f32x4 nkwa = *(const LAS f32x4*)(cb + CB_KW + tn * 512 + lo4), nkwb = *(const LAS f32x4*)(cb + CB_KW + tn * 512 + 256 + lo4);
                const f32x4 nw4 = *(const LAS f32x4*)(cb + CB_W + tn * 256 + lo4), nb4 = *(const LAS f32x4*)(cb + CB_B + tn * 256 + lo4), nk4 = *(const LAS f32x4*)(cb + CB_K + tn * 256 + lo4);
                const float nvv = *(const LAS float*)(cb + CB_V + (tn * 16 + vi) * 4);
                f32x2 p = (f32x2){s01.x, s01.x} * (f32x2){kwa.x, kwa.y};
                p += (f32x2){s01.y, s01.y} * (f32x2){kwa.z, kwa.w};
                p += (f32x2){s23.x, s23.x} * (f32x2){kwb.x, kwb.y};
                p += (f32x2){s23.y, s23.y} * (f32x2){kwb.z, kwb.w};
                *(LAS float*)(cb + CB_YP + ((tok * 16 + vi) * 16 + cg) * 4) = p.y;
                const f32x2 t01 = s01 * (f32x2){w4.x, w4.y} + (f32x2){k4.x, k4.y} * vv, t23 = s23 * (f32x2){w4.z, w4.w} + (f32x2){k4.z, k4.w} * vv;
                const float d1 = red16(p.x);
                s01 = t01 - (f32x2){b4.x, b4.y} * d1; s23 = t23 - (f32x2){b4.z, b4.w} * d1;
                kwa = nkwa; kwb = nkwb; w4 = nw4; b4 = nb4; k4 = nk4; vv = nvv;
            }
            __syncthreads();
        }
        __builtin_amdgcn_s_setprio(0);
    }
    __syncthreads();
}

struct Dsa1P { const bf16* ZR; const bf16* KI; unsigned* bitm; gu32* done; };
namespace dsa1 {
constexpr int CAP = 769  , PRUNE_AT = 512, KEEP = 256;
constexpr int L_BUF = 0, L_CNT = 32 * CAP * 4, L_THR = L_CNT + 128, L_THRK = L_THR + 128, L_HIST = ((L_THRK + 128 + 15) / 16) * 16, L_MROW = L_HIST + 8 * 1024, L_QF = L_MROW + 8 * 1024, QFP = 1040, L_END = L_QF + 32 * QFP;
static_assert(L_END <= LDS_MISC, "dsa1 LDS");
__device__ __forceinline__ unsigned packkey(float s, int keyidx) { const unsigned bits = __float_as_uint(s); const unsigned u = bits ^ ((unsigned)((int)bits >> 31) | 0x80000000u); return (u & 0xFFFFE000u) | (unsigned)(8191 - keyidx); }
__device__ __forceinline__ float thr_of(unsigned key) { const unsigned u = key & 0xFFFFE000u; const unsigned bits = (u & 0x80000000u) ? (u ^ 0x80000000u) : ~u; return __uint_as_float(bits); }
__device__ __forceinline__ int wave_prefix_incl(int v) {
    v += __builtin_amdgcn_update_dpp(0, v, 0x111, 0xF, 0xF, true);
    v += __builtin_amdgcn_update_dpp(0, v, 0x112, 0xF, 0xF, true);
    v += __builtin_amdgcn_update_dpp(0, v, 0x114, 0xF, 0xF, true);
    v += __builtin_amdgcn_update_dpp(0, v, 0x118, 0xF, 0xF, true);
    v += __builtin_amdgcn_update_dpp(0, v, 0x142, 0xA, 0xF, false);
    v += __builtin_amdgcn_update_dpp(0, v, 0x143, 0xC, 0xF, false);
    return v;
}
__device__ __forceinline__ void prune(LAS unsigned char* lds, int qq, int wid, int lane, bool exact) {
    asm volatile("" : "+v"(lane));
    LAS unsigned* buf = (LAS unsigned*)(lds + L_BUF) + qq * CAP; LAS unsigned* cnt = (LAS unsigned*)(lds + L_CNT); LAS float* thr = (LAS float*)(lds + L_THR); LAS unsigned* thrk = (LAS unsigned*)(lds + L_THRK);
    LAS unsigned* hist = (LAS unsigned*)(lds + L_HIST) + wid * 256;
    const int n = (int)cnt[qq];
    unsigned e[12];
#pragma unroll
    for (int k = 0; k < 12; ++k) e[k] = (lane + 64 * k < n) ? buf[lane + 64 * k] : 0u;
    const unsigned tk = thrk[qq];
    unsigned cut = 0u; bool have = false;
    if (!exact && tk != 0u) {
        const unsigned base16 = tk >> 16;
        *(LAS v4u*)(hist + 4 * lane) = (v4u){0u, 0u, 0u, 0u};
        LDS_WAIT(); asm volatile("" ::: "memory");
#pragma unroll
        for (int k = 0; k < 12; ++k) if (lane + 64 * k < n) { unsigned bn = (e[k] >> 16) - base16; bn = bn > 255u ? 255u : bn; (void)__hip_atomic_fetch_add(hist + bn, 1u, __ATOMIC_RELAXED, __HIP_MEMORY_SCOPE_WORKGROUP); }
        LDS_WAIT(); asm volatile("" ::: "memory");
        const int rl = 63 - lane;
        const v4u hv = *(const LAS v4u*)(hist + 4 * rl);
        const int tot = (int)(hv.x + hv.y + hv.z + hv.w);
        int above = wave_prefix_incl(tot) - tot; int dsel = -1, csel = 0;
        { const int h3 = (int)hv.w, h2 = (int)hv.z, h1 = (int)hv.y, h0 = (int)hv.x;
          if (above < KEEP && KEEP <= above + h3) { dsel = 4 * rl + 3; csel = above + h3; } above += h3;
          if (above < KEEP && KEEP <= above + h2) { dsel = 4 * rl + 2; csel = above + h2; } above += h2;
          if (above < KEEP && KEEP <= above + h1) { dsel = 4 * rl + 1; csel = above + h1; } above += h1;
          if (above < KEEP && KEEP <= above + h0) { dsel = 4 * rl + 0; csel = above + h0; } }
        const unsigned long long bm = __ballot(dsel >= 0);
        const int src = bm ? (int)__builtin_ctzll(bm) : 0;
        const int d = __builtin_amdgcn_readlane(dsel, src), cd = __builtin_amdgcn_readlane(csel, src);
        LDS_WAIT(); asm volatile("" ::: "memory");
        if (bm != 0ull && cd <= KEEP + 128) { cut = (base16 + (unsigned)d) << 16; have = true; }
    }
    if (!have) {
        unsigned prefix = 0u; int want = KEEP;
#pragma unroll 1
        for (int p = 0; p < 4; ++p) {
            const int shift = 24 - 8 * p;
            *(LAS v4u*)(hist + 4 * lane) = (v4u){0u, 0u, 0u, 0u};
            LDS_WAIT(); asm volatile("" ::: "memory");
#pragma unroll
            for (int k = 0; k < 12; ++k) { const bool in = (lane + 64 * k < n) && (p == 0 || (e[k] >> (shift + 8)) == (prefix >> (shift + 8)));
                if (in) (void)__hip_atomic_fetch_add(hist + ((e[k] >> shift) & 255u), 1u, __ATOMIC_RELAXED, __HIP_MEMORY_SCOPE_WORKGROUP); }
            LDS_WAIT(); asm volatile("" ::: "memory");
            const int rl = 63 - lane;
            const v4u hv = *(const LAS v4u*)(hist + 4 * rl);
            const int tot = (int)(hv.x + hv.y + hv.z + hv.w);
            int above = wave_prefix_incl(tot) - tot;
            int dsel = -1, asel = 0;
            { const int h3 = (int)hv.w, h2 = (int)hv.z, h1 = (int)hv.y, h0 = (int)hv.x;
              if (above < want && want <= above + h3) { dsel = 4 * rl + 3; asel = above; } above += h3;
              if (above < want && want <= above + h2) { dsel = 4 * rl + 2; asel = above; } above += h2;
              if (above < want && want <= above + h1) { dsel = 4 * rl + 1; asel = above; } above += h1;
              if (above < want && want <= above + h0) { dsel = 4 * rl + 0; asel = above; } }
            const unsigned long long bm = __ballot(dsel >= 0);
            const int src = bm ? (int)__builtin_ctzll(bm) : 0;
            const int d = __builtin_amdgcn_readlane(dsel, src), ab = __builtin_amdgcn_readlane(asel, src);
            prefix |= ((unsigned)(d < 0 ? 0 : d)) << shift; want -= ab;
            LDS_WAIT(); asm volatile("" ::: "memory");
        }
        cut = prefix;
    }
    int base = 0;
#pragma unroll
    for (int k = 0; k < 12; ++k) { const bool keep = (lane + 64 * k < n) && e[k] >= cut; const unsigned long long mk = __ballot(keep);
        const int pos = base + (int)__builtin_amdgcn_mbcnt_hi((unsigned)(mk >> 32), __builtin_amdgcn_mbcnt_lo((unsigned)mk, 0u));
        if (keep) buf[pos] = e[k]; base += (int)__builtin_popcountll(mk); }
    if (lane == 0) { cnt[qq] = (unsigned)base; thr[qq] = thr_of(cut); thrk[qq] = cut; }
    LDS_WAIT(); asm volatile("" ::: "memory");
}
}
__device__ __forceinline__ void dsa1_unit(const Dsa1P& P, int u, LAS unsigned char* lds) {
    using namespace dsa1;
    const int tid = otid_(), wid = __builtin_amdgcn_readfirstlane(tid >> 6), lane = tid & 63, q = lane & 31, hi = lane >> 5;
    const int b = u & 1, qb32 = 255 - (u >> 1), t0 = 32 * qb32;
    const size_t brow = (size_t)b * T;
    LAS unsigned* buf = (LAS unsigned*)(lds + L_BUF); LAS unsigned* cnt = (LAS unsigned*)(lds + L_CNT); LAS float* thr = (LAS float*)(lds + L_THR);
    if (tid < 32) { cnt[tid] = 0u; thr[tid] = -__builtin_inff(); ((LAS unsigned*)(lds + L_THRK))[tid] = 0u; }
    const bf16* qrow = P.ZR + (brow + t0 + q) * ZP;
    { const int r = tid >> 4, sg = tid & 15; const bf16* src = P.ZR + (brow + t0 + r) * ZP + ZC_QI + 32 * sg;
#pragma unroll
      for (int j = 0; j < 4; ++j) *(LAS v4u*)(lds + L_QF + r * QFP + 64 * sg + 16 * j) = *(const GAS v4u*)(src + 8 * j); }
    float wq[8];
    { const v4u w = *(const GAS v4u*)(qrow + ZC_WI); const float c = 0.35355339059327373f * 0.125f;
      wq[0] = bflo(w.x) * c; wq[1] = bfhi(w.x) * c; wq[2] = bflo(w.y) * c; wq[3] = bfhi(w.y) * c; wq[4] = bflo(w.z) * c; wq[5] = bfhi(w.z) * c; wq[6] = bflo(w.w) * c; wq[7] = bfhi(w.w) * c; }
    const int tq = t0 + q;
    const int nsteps = (t0 + 32 + 255) >> 8;
    __syncthreads();
    float th = -__builtin_inff();
    bf16x8 afn[4];
    { const int k0 = 32 * wid; const bf16* krow = P.KI + (brow + (k0 <= t0 + 31 ? k0 : 0) + q) * 64 + 8 * hi;
#pragma unroll
      for (int s = 0; s < 4; ++s) afn[s] = *(const GAS bf16x8*)(krow + 16 * s); }
    for (int st = 0; st < nsteps; ++st) {
        const int key0 = 256 * st + 32 * wid;
        bf16x8 af[4];
#pragma unroll
        for (int s = 0; s < 4; ++s) af[s] = afn[s];
        { const int k1 = key0 + 256; const bf16* krow = P.KI + (brow + (k1 <= t0 + 31 ? k1 : 0) + q) * 64 + 8 * hi;
#pragma unroll
          for (int s = 0; s < 4; ++s) afn[s] = *(const GAS bf16x8*)(krow + 16 * s); }
        if (key0 <= t0 + 31) {
            f32x16 sc;
#pragma unroll
            for (int i = 0; i < 16; ++i) sc[i] = 0.f;
            unsigned qfo = (unsigned)(L_QF + q * QFP + 16 * hi); asm volatile("" : "+v"(qfo));
#pragma unroll
            for (int hd = 0; hd < 8; ++hd) {
                f32x16 acc;
#pragma unroll
                for (int i = 0; i < 16; ++i) acc[i] = 0.f;
#pragma unroll
                for (int s = 0; s < 4; ++s) { const bf16x8 qb = *(const LAS bf16x8*)(lds + qfo + hd * 128 + 32 * s);
                    acc = __builtin_amdgcn_mfma_f32_32x32x16_bf16(af[s], qb, acc, 0, 0, 0); }
#pragma unroll
                for (int i = 0; i < 16; ++i) sc[i] = fmaf(fmaxf(acc[i], 0.f), wq[hd], sc[i]);
                __builtin_amdgcn_sched_barrier(0);
            }
            const bool diag = key0 + 31 > t0;
            unsigned pm = 0u;
#pragma unroll
            for (int i = 0; i < 16; ++i) { const int kidx = key0 + (i & 3) + 8 * (i >> 2) + 4 * hi; const bool ok = (sc[i] >= th) && (!diag || kidx <= tq); pm |= ok ? (1u << i) : 0u; }
            const int np = __builtin_popcount(pm);
            if (np > 0) {
                int pos = (int)__hip_atomic_fetch_add(cnt + q, (unsigned)np, __ATOMIC_RELAXED, __HIP_MEMORY_SCOPE_WORKGROUP);
                LAS unsigned* bq = buf + q * CAP;
#pragma unroll
                for (int i = 0; i < 16; ++i) if (pm & (1u << i)) { const int kidx = key0 + (i & 3) + 8 * (i >> 2) + 4 * hi; bq[pos] = packkey(sc[i], kidx); ++pos; }
            }
        }
        __syncthreads();
        { unsigned nm = (unsigned)__ballot(cnt[q] > (unsigned)PRUNE_AT); int i = 0;
          while (nm) { const int qq = __builtin_ctz(nm); nm &= nm - 1u; if ((i & 7) == wid) prune(lds, qq, wid, lane, false); ++i; } }
        __syncthreads();
        th = thr[q];
    }
    LAS unsigned* mrow = (LAS unsigned*)(lds + L_MROW) + wid * 256;
#pragma unroll 1
    for (int k = 0; k < 4; ++k) {
        const int qq = wid + 8 * k;
        if (cnt[qq] > (unsigned)KEEP) prune(lds, qq, wid, lane, true);
        const int nf = (int)cnt[qq];
        *(LAS v4u*)(mrow + 4 * lane) = (v4u){0u, 0u, 0u, 0u};
        LDS_WAIT(); asm volatile("" ::: "memory");
#pragma unroll
        for (int j = 0; j < 4; ++j) { const int idx = lane + 64 * j; if (idx < nf) { const unsigned e = buf[qq * CAP + idx]; const unsigned key = 8191u - (e & 0x1FFFu); (void)__hip_atomic_fetch_or(mrow + (key >> 5), 1u << (key & 31u), __ATOMIC_RELAXED, __HIP_MEMORY_SCOPE_WORKGROUP); } }
        LDS_WAIT(); asm volatile("" ::: "memory");
        unsigned long long* grow = (unsigned long long*)(P.bitm + (brow + t0 + qq) * 256);
#pragma unroll
        for (int j = 0; j < 2; ++j) { const int w2 = lane + 64 * j; const unsigned long long v = (unsigned long long)mrow[2 * w2] | ((unsigned long long)mrow[2 * w2 + 1] << 32);
            __hip_atomic_store(grow + w2, v, RLX_AGENT); }
        LDS_WAIT(); asm volatile("" ::: "memory");
    }
    VM_WAIT();
    __syncthreads();
    if (tid == 0) __hip_atomic_fetch_add(P.done + 64 * (b * 32 + (t0 >> 8)), 1u, RLX_AGENT);
}

struct RPostP { const bf16* ZR; bf16* Q3; const bf16* yraw; const float* rdotk; const float *mu, *gup, *lnw, *lnb; };
__device__ __forceinline__ void rwkv_post(const RPostP& P, LAS unsigned char* lds) {
    const int tid = otid_(), lane = tid & 63, h = __builtin_amdgcn_readfirstlane(tid >> 6), c16 = lane & 15, quad = lane >> 4;
    constexpr int SP = 272;
    LAS float* GT = (LAS float*)(lds + 64 * SP);
    bf16x8 bfr[4][4];
#pragma unroll
    for (int ct = 0; ct < 4; ++ct)
#pragma unroll
        for (int s = 0; s < 4; ++s) { const float* gp = P.gup + (size_t)(32 * s + 8 * quad) * 512 + 64 * h + 16 * ct + c16;
            v4u w; w.x = pk2(gp[0], gp[512]); w.y = pk2(gp[1024], gp[1536]); w.z = pk2(gp[2048], gp[2560]); w.w = pk2(gp[3072], gp[3584]); bfr[ct][s] = __builtin_bit_cast(bf16x8, w); }
    float muv[4], lnw[4], lnb[4];
#pragma unroll
    for (int ct = 0; ct < 4; ++ct) { const int ch = 64 * h + 16 * ct + c16; muv[ct] = P.mu[1024 + ch]; lnw[ct] = P.lnw[ch]; lnb[ct] = P.lnb[ch]; }
    const int stok = tid >> 3, sseg = tid & 7;
#pragma unroll 1
    for (int m0 = blockIdx.x * 64; m0 < M; m0 += gridDim.x * 64) {
        {   const size_t m = (size_t)m0 + stok; const int t = (int)(m & (T - 1));
            float gv[16], pv[16];
            { const v4u a = *(const GAS v4u*)(P.ZR + m * ZP + ZC_GC + 16 * sseg), c = *(const GAS v4u*)(P.ZR + m * ZP + ZC_GC + 16 * sseg + 8);
              gv[0] = bflo(a.x); gv[1] = bfhi(a.x); gv[2] = bflo(a.y); gv[3] = bfhi(a.y); gv[4] = bflo(a.z); gv[5] = bfhi(a.z); gv[6] = bflo(a.w); gv[7] = bfhi(a.w);
              gv[8] = bflo(c.x); gv[9] = bfhi(c.x); gv[10] = bflo(c.y); gv[11] = bfhi(c.y); gv[12] = bflo(c.z); gv[13] = bfhi(c.z); gv[14] = bflo(c.w); gv[15] = bfhi(c.w); }
            if (t > 0) { const v4u a = *(const GAS v4u*)(P.ZR + (m - 1) * ZP + ZC_GC + 16 * sseg), c = *(const GAS v4u*)(P.ZR + (m - 1) * ZP + ZC_GC + 16 * sseg + 8);
              pv[0] = bflo(a.x); pv[1] = bfhi(a.x); pv[2] = bflo(a.y); pv[3] = bfhi(a.y); pv[4] = bflo(a.z); pv[5] = bfhi(a.z); pv[6] = bflo(a.w); pv[7] = bfhi(a.w);
              pv[8] = bflo(c.x); pv[9] = bfhi(c.x); pv[10] = bflo(c.y); pv[11] = bfhi(c.y); pv[12] = bflo(c.z); pv[13] = bfhi(c.z); pv[14] = bflo(c.w); pv[15] = bfhi(c.w); }
            else {
#pragma unroll
              for (int e = 0; e < 16; ++e) pv[e] = 0.f; }
            float sg[16];
#pragma unroll
            for (int e = 0; e < 16; ++e) { const float mu = P.mu[1664 + 16 * sseg + e]; sg[e] = sigm(gv[e] + (pv[e] - gv[e]) * mu); }
            v4u o0, o1; o0.x = pk2(sg[0], sg[1]); o0.y = pk2(sg[2], sg[3]); o0.z = pk2(sg[4], sg[5]); o0.w = pk2(sg[6], sg[7]); o1.x = pk2(sg[8], sg[9]); o1.y = pk2(sg[10], sg[11]); o1.z = pk2(sg[12], sg[13]); o1.w = pk2(sg[14], sg[15]);
            *(LAS v4u*)(lds + stok * SP + 32 * sseg) = o0; *(LAS v4u*)(lds + stok * SP + 32 * sseg + 16) = o1;
        }
        __syncthreads();
#pragma unroll 1
        for (int rt = 0; rt < 4; ++rt) {
            f32x4 acc[4];
#pragma unroll
            for (int ct = 0; ct < 4; ++ct) acc[ct] = (f32x4){0.f, 0.f, 0.f, 0.f};
#pragma unroll
            for (int s = 0; s < 4; ++s) { const bf16x8 af = *(const LAS bf16x8*)(lds + (16 * rt + c16) * SP + (32 * s + 8 * quad) * 2);
#pragma unroll
                for (int ct = 0; ct < 4; ++ct) acc[ct] = __builtin_amdgcn_mfma_f32_16x16x32_bf16(af, bfr[ct][s], acc[ct], 0, 0, 0); }
#pragma unroll
            for (int ct = 0; ct < 4; ++ct)
#pragma unroll
                for (int j = 0; j < 4; ++j) GT[(4 * quad + j) * 512 + 64 * h + 16 * ct + c16] = acc[ct][j];
            __syncthreads();
            {   const int vtok = tid >> 5, vseg = tid & 31, ch0 = 16 * vseg, vh = vseg >> 2;
                const size_t m = (size_t)m0 + 16 * rt + vtok; const int t = (int)(m & (T - 1));
                float y[16], vv[16], vp[16], g[16];
                { const v4u a = *(const GAS v4u*)(P.yraw + m * 512 + ch0), c = *(const GAS v4u*)(P.yraw + m * 512 + ch0 + 8);
                  y[0] = bflo(a.x); y[1] = bfhi(a.x); y[2] = bflo(a.y); y[3] = bfhi(a.y); y[4] = bflo(a.z); y[5] = bfhi(a.z); y[6] = bflo(a.w); y[7] = bfhi(a.w);
                  y[8] = bflo(c.x); y[9] = bfhi(c.x); y[10] = bflo(c.y); y[11] = bfhi(c.y); y[12] = bflo(c.z); y[13] = bfhi(c.z); y[14] = bflo(c.w); y[15] = bfhi(c.w); }
                { const v4u a = *(const GAS v4u*)(P.ZR + m * ZP + ZC_RV + ch0), c = *(const GAS v4u*)(P.ZR + m * ZP + ZC_RV + ch0 + 8);
                  vv[0] = bflo(a.x); vv[1] = bfhi(a.x); vv[2] = bflo(a.y); vv[3] = bfhi(a.y); vv[4] = bflo(a.z); vv[5] = bfhi(a.z); vv[6] = bflo(a.w); vv[7] = bfhi(a.w);
                  vv[8] = bflo(c.x); vv[9] = bfhi(c.x); vv[10] = bflo(c.y); vv[11] = bfhi(c.y); vv[12] = bflo(c.z); vv[13] = bfhi(c.z); vv[14] = bflo(c.w); vv[15] = bfhi(c.w); }
                if (t > 0) { const v4u a = *(const GAS v4u*)(P.ZR + (m - 1) * ZP + ZC_RV + ch0), c = *(const GAS v4u*)(P.ZR + (m - 1) * ZP + ZC_RV + ch0 + 8);
                  vp[0] = bflo(a.x); vp[1] = bfhi(a.x); vp[2] = bflo(a.y); vp[3] = bfhi(a.y); vp[4] = bflo(a.z); vp[5] = bfhi(a.z); vp[6] = bflo(a.w); vp[7] = bfhi(a.w);
                  vp[8] = bflo(c.x); vp[9] = bfhi(c.x); vp[10] = bflo(c.y); vp[11] = bfhi(c.y); vp[12] = bflo(c.z); vp[13] = bfhi(c.z); vp[14] = bflo(c.w); vp[15] = bfhi(c.w); }
                else {
#pragma unroll
                  for (int e = 0; e < 16; ++e) vp[e] = 0.f; }
#pragma unroll
                for (int e4 = 0; e4 < 4; ++e4) { const f32x4 gq = *(const LAS f32x4*)(GT + vtok * 512 + ch0 + 4 * e4); g[4 * e4] = gq.x; g[4 * e4 + 1] = gq.y; g[4 * e4 + 2] = gq.z; g[4 * e4 + 3] = gq.w; }
                float sm = 0.f;
#pragma unroll
                for (int e = 0; e < 16; ++e) sm += y[e];
                sm = scan::dpp_add<0xB1>(sm); sm = scan::dpp_add<0x4E>(sm);
                const float mean = sm * (1.f / 64.f); float vs = 0.f;
#pragma unroll
                for (int e = 0; e < 16; ++e) { y[e] -= mean; vs += y[e] * y[e]; }
                vs = scan::dpp_add<0xB1>(vs); vs = scan::dpp_add<0x4E>(vs);
                const float rstd = __builtin_amdgcn_rsqf(vs * (1.f / 64.f) + 64e-5f);
                const float rk = P.rdotk[m * 8 + vh];
                unsigned ow[8];
#pragma unroll
                for (int e = 0; e < 16; e += 2) { float o2[2];
#pragma unroll
                    for (int d = 0; d < 2; ++d) { const int ch = ch0 + e + d; const float v = vv[e + d] + (vp[e + d] - vv[e + d]) * P.mu[1024 + ch];
                        o2[d] = (y[e + d] * rstd * P.lnw[ch] + P.lnb[ch] + rk * v) * g[e + d]; }
                    ow[e >> 1] = pk2(o2[0], o2[1]); }
                *(GAS v4u*)(P.Q3 + m * QP + 512 + ch0) = (v4u){ow[0], ow[1], ow[2], ow[3]}; *(GAS v4u*)(P.Q3 + m * QP + 512 + ch0 + 8) = (v4u){ow[4], ow[5], ow[6], ow[7]};
            }
            __syncthreads();
        }
        __syncthreads();
    }
}
struct DPostP { const bf16* O1; const bf16* O2; bf16* Q3; const float *lq1, *lk1, *lq2, *lk2, *subln; float lambda_init; };
__device__ __forceinline__ void diff_post(const DPostP& P, int gw, int NGW, int lane) {
    const float lam = __expf(wave_sum(P.lq1[lane] * P.lk1[lane])) - __expf(wave_sum(P.lq2[lane] * P.lk2[lane])) + P.lambda_init;
    const float s0 = P.subln[2 * lane] * (1.f - P.lambda_init), s1 = P.subln[2 * lane + 1] * (1.f - P.lambda_init);
    for (int it = gw; it < M * 4; it += NGW) {
        const size_t m = (size_t)(it >> 2); const int hh = it & 3;
        const unsigned a = *(const GAS unsigned*)(P.O1 + m * 512 + 128 * hh + 2 * lane), c = *(const GAS unsigned*)(P.O2 + m * 512 + 128 * hh + 2 * lane);
        const float x0 = bflo(a) - lam * bflo(c), x1 = bfhi(a) - lam * bfhi(c);
        const float r = __builtin_amdgcn_rsqf(wave_sum(x0 * x0 + x1 * x1) * (1.f / 128.f) + NORM_EPS);
        *(GAS unsigned*)(P.Q3 + m * QP + 1024 + 128 * hh + 2 * lane) = pk2(x0 * r * s0, x1 * r * s1);
    }
}

__device__ __forceinline__ int q_fetch(gu32* head, volatile LAS int* slot) {
    if (threadIdx.x == 0) *slot = (int)__hip_atomic_fetch_add(head, 1u, RLX_AGENT);
    __syncthreads();
    const int v = __builtin_amdgcn_readfirstlane(*slot);
    __syncthreads();
    return v;
}

struct Args { const float* in[32]; float* out; unsigned char* ws; int ph_lo, ph_hi; };
__device__ __forceinline__ const float* kin_(int i) { const char* ka = (const char*)__builtin_amdgcn_kernarg_segment_ptr(); unsigned off = (unsigned)i * 8u; asm volatile("" : "+s"(off)); return *(const float* const*)(ka + off); }
#define KIN(i) kin_(i)
#define XOUT ((float*)kin_(32))
__device__ __forceinline__ unsigned char* kws_() { return (unsigned char*)kin_(33); }
__device__ __forceinline__ int kint_(int byteoff) { const char* ka = (const char*)__builtin_amdgcn_kernarg_segment_ptr(); unsigned off = (unsigned)byteoff; asm volatile("" : "+s"(off)); return *(const int*)(ka + off); }
constexpr int PH_L = 14;
constexpr int N_PHASES = 1 + NLAYER * PH_L;

#define G ((int)gridDim.x)
#define bid ((int)blockIdx.x)
#define gw (bid * NWAVES + wave)
#define NGW (G * NWAVES)
#define MISC ((volatile LAS unsigned*)(lds + LDS_MISC))
#define IN(k) (kint_(272) <= (k) && (k) < kint_(276))
#define SEAM(k) do { if ((k) + 1 < kint_(276)) { XcdBarrier bar_; bar_.bar = (unsigned*)(kws_() + WS_CTL) + CW_BAR; bar_.x = xb_xcc_id(); bar_.st = MISC + 8; xcd_barrier(bar_); } } while (0)
#define WSL() unsigned char* wsl = kws_(); const int tid = otid_(), lane = tid & 63, wave = __builtin_amdgcn_readfirstlane(tid >> 6); (void)lane; (void)wave
#define WFu ((bf16*)(wsl + WS_WF))
#define WFd ((bf16*)(wsl + WS_WF_DOWN))
#define WMi ((bf16*)(wsl + WS_WM))
#define WMb ((bf16*)(wsl + WS_WM_BR))
#define WMo ((bf16*)(wsl + WS_WM_OUT))
#define XN ((bf16*)(wsl + WS_XN))
#define Q3 ((bf16*)(wsl + WS_Q3))
#define ZR ((bf16*)(wsl + WS_ZR))
#define YP ((bf16*)(wsl + WS_R2))
#define HB ZR
#define G3 ZR
#define MG ((bf16*)(wsl + WS_MG))
#define O1 ((bf16*)(wsl + WS_R2))
#define O2 ((bf16*)(wsl + WS_R2) + (size_t)M * 512)
#define YRAW ((bf16*)(wsl + WS_YRAW))
#define BITM ((unsigned*)(wsl + WS_BITM))
#define RDOTK ((float*)(wsl + WS_RDOTK))
#define X1B ((bf16*)(wsl + WS_X1))
#define KID ((bf16*)(wsl + WS_KID))
#define A8B ((unsigned char*)(wsl + WS_A8))
#define CTL ((gu32*)(wsl + WS_CTL))
#define cscr ((LAS float*)(lds + wave * 16384))

#define CONV_FFN(l_, f_) do { const int gi_ = (f_) ? 29 : 3; \
        MapUp mu_{KIN(gi_) + (size_t)(l_) * DM * FF, KIN(gi_ + 1) + (size_t)(l_) * DM * FF, FF}; MapIdent md_{KIN(gi_ + 2) + (size_t)(l_) * FF * DM, DM}; \
        constexpr int nu_ = conv_items(DM, 2 * FF), nd_ = conv_items(FF, DM); \
        for (int it_ = gw; it_ < nu_ + nd_; it_ += NGW) { if (it_ < nu_) conv_item(mu_, DM, WFu, cscr, it_, 2 * FF / 32, lane); else conv_item(md_, FF, WFd, cscr, it_ - nu_, DM / 32, lane); } } while (0)
#define CONV_MIX(l_) do { MapWin mw_{KIN(8) + (size_t)(l_) * DM * NIN, NIN}; MapIdent mo_{KIN(26) + (size_t)(l_) * DM * DM, DM}; \
        constexpr int ni_ = conv_items(DM, 8704), nb_ = conv_items(512, DM), no_ = conv_items(DM, DM); \
        for (int it_ = gw; it_ < ni_ + 3 * nb_ + no_; it_ += NGW) { \
            if (it_ < ni_) conv_item(mw_, DM, WMi, cscr, it_, 8704 / 32, lane); \
            else if (it_ < ni_ + 3 * nb_) { const int r_ = it_ - ni_, n_ = r_ / nb_; MapIdent mb_{KIN(25) + ((size_t)(l_) * 3 + n_) * 512 * DM, DM}; conv_item(mb_, 512, WMb + (size_t)n_ * DM * 512, cscr, r_ - n_ * nb_, DM / 32, lane); } \
            else conv_item(mo_, DM, WMo, cscr, it_ - ni_ - 3 * nb_, DM / 32, lane); } } while (0)

template <int L, int F> __device__ __forceinline__ void ffn_part(LAS unsigned char* lds) {
    constexpr int l = L, f = F, pb = 1 + PH_L * L, pf = pb + (F ? 11 : 0);
            if (IN(pf + 0)) { WSL();
                pg8::Gemm g{XN, WFu, M, 2 * FF, DM, DM}; pg8::StaticOrder S; S.init(M, 2 * FF, G, bid);
                pg8::EpiSwiGLU E{HB, FF};
                pg8::gemm_phase<pg8::EpiSwiGLU, pg8::StaticOrder, true, true>(lds, g, S, E);
                SEAM(pf + 0);
            }
            if (IN(pf + 1)) { WSL();
                pg8::Gemm g{HB, WFd, M, DM, FF, FF}; pg8::StaticOrder S; S.init(M, DM, G, bid);
                pg8::EpiStore<0> E{YP, DM, YP, DM, 1 << 30};
                pg8::gemm_phase<pg8::EpiStore<0>, pg8::StaticOrder, true, true>(lds, g, S, E);
                SEAM(pf + 1);
            }
            if (IN(pf + 2)) { WSL();
                const float* base = (l == 0 && f == 0) ? KIN(0) : XOUT;
                const float* gpost = KIN(f ? 28 : 2) + l * DM;
                const float* gnext = f == 0 ? KIN(6) + l * DM : (l + 1 < NLAYER ? KIN(1) + (l + 1) * DM : nullptr);
#if PROBE
                float osc = 1.f;
                if (l == NLAYER - 1 && f == 1) { const float num = *(const float*)(wsl + WS_CTL + 4 * CW_PROBE), den = *(const float*)(wsl + WS_CTL + 4 * (CW_PROBE + 1)); osc = 1.f + 4.f * sqrtf(num / fmaxf(den, 1e-30f)); }
                rownorm_rows(base, YP, 0.5f, gpost, XOUT, gnext, gnext ? XN : nullptr, gw, NGW, lane, osc);
#else
                rownorm_rows(base, YP, 0.5f, gpost, XOUT, gnext, gnext ? XN : nullptr, gw, NGW, lane);
#endif
                if (f == 1 && l + 1 < NLAYER) { CONV_FFN(l + 1, 0); CONV_MIX(l + 1); }
                SEAM(pf + 2);
            }
}
template <int L> __device__ __forceinline__ void mixer_part(LAS unsigned char* lds, unsigned char* lds_) {
    constexpr int l = L, pb = 1 + PH_L * L;
            const int pm = pb + 3;
            if (IN(pm + 0)) { WSL();
                pg8::Gemm g{XN, WMi, M, 5632, DM, DM}; pg8::StaticOrder S; S.init(M, 5632, G, bid);
                pg8::EpiStore<0> E{Q3, QP, ZR, ZP, 6};
                pg8::gemm_phase<pg8::EpiStore<0>, pg8::StaticOrder, true, true>(lds, g, S, E);
                SEAM(pm + 0);
            }
            if (IN(pm + 1)) { WSL();
                PrepP pp{ZR, X1B, A8B, KID, KIN(9) + l * 1792, KIN(10) + l * 512, KIN(11) + l * 64 * 512, KIN(12) + l * 512, KIN(13) + l * 64 * 512};
                rwkv_prep(pp, lds);
                SEAM(pm + 1);
            }
            if (IN(pm + 2)) { WSL();
                volatile LAS int* slot = (volatile LAS int*)(MISC + 16);
                if (bid < 64) {
                    ScanP sp{Q3, ZR, X1B, A8B, YRAW, RDOTK, KIN(9) + l * 1792, KIN(15) + l * 512, KIN(16) + l * 512, KIN(17) + l * 512};
#ifndef NO_SCAN
                    rwkv_scan_unit(sp, bid, lds);
#ifdef SCAN_TWICE
                    rwkv_scan_unit(sp, bid, lds);
#endif
#endif
                }
                {
                    Dsa1P dp{ZR, KID, BITM, CTL + CW_DONE + 64 * 64 * l};
                    gu32* head = CTL + CW_Q + 64 * (3 * l + 0);
                    #ifndef NO_DSA1
                    for (int u = q_fetch(head, slot); u < 512; u = q_fetch(head, slot)) dsa1_unit(dp, u, lds);
#ifdef DUP_DSA1
                    { gu32* head2 = CTL + 10240 + 64 * (2 * l + 0); for (int u = q_fetch(head2, slot); u < 512; u = q_fetch(head2, slot)) dsa1_unit(dp, u, lds); }
#endif
#endif
                }
                {
                    gu32* head = CTL + CW_Q + 64 * (3 * l + 1);
                    typedef att::BlockRef<att::bf16, att::bf16> Ref;
#define DSA2_REF(i_, r_) do { const int qb_ = 31 - ((i_) >> 3), b_ = ((i_) >> 2) & 1, h_ = (i_) & 3; const size_t row_ = (size_t)b_ * T + 256 * qb_; \
        r_.Q = (const att::bf16*)(Q3 + row_ * QP + 128 * h_); r_.O = (att::bf16*)(Q3 + row_ * QP + 128 * h_); r_.K = (const att::bf16*)(ZR + (size_t)b_ * T * ZP + ZC_DK + 128 * h_); \
        r_.V = (const att::bf16*)(ZR + (size_t)b_ * T * ZP + ZC_DV + 128 * h_); r_.P0 = 256 * qb_; r_.koff = 0; r_.mask = BITM + row_ * 256; } while (0)
                    int ic = q_fetch(head, slot);
                    if (ic < 256) {
                        int in_ = q_fetch(head, slot);
                        Ref cur; DSA2_REF(ic, cur);
                        att::Seam<att::bf16> S;
                        att::causal_swa_prime<att::bf16, att::bf16, false>(cur, T, (char*)lds_, S);
                        for (;;) {
                            const bool last = in_ >= 256;
                            Ref nxt = cur; if (!last) DSA2_REF(in_, nxt);
                            {
                                if (tid == 0) { gu32* dw = CTL + CW_DONE + 64 * (64 * l + (((ic >> 2) & 1) * 32 + (31 - (ic >> 3)))); unsigned sp = 0;
                                    while (__hip_atomic_load(dw, RLX_AGENT) < 8u) { __builtin_amdgcn_s_sleep(2); if (++sp > (1u << 24)) { __hip_atomic_store(CTL + CW_TMO, 1u, RLX_AGENT); break; } }
                                    __builtin_amdgcn_fence(__ATOMIC_ACQUIRE, "agent"); asm volatile("s_waitcnt vmcnt(0)" ::: "memory"); }
                                __syncthreads();
                            }
#ifndef NO_DSA2
                            att::causal_swa_block<att::bf16, att::bf16, false, true, QP>(cur, nxt, T, T, (char*)lds_, S);
#endif
                            if (last) break;
                            cur = nxt; ic = in_; in_ = q_fetch(head, slot);
                        }
                    }
                }
                {
#ifdef DUP_DIFF
                  for (int rep_ = 0; rep_ < 2; ++rep_) {
                    gu32* head = rep_ ? CTL + 10240 + 64 * (2 * l + 1) : CTL + CW_Q + 64 * (3 * l + 2);
#else
                  {
                    gu32* head = CTL + CW_Q + 64 * (3 * l + 2);
#endif
                    typedef att::BlockRef<att::bf16, att::bf16> Ref;
#define DIFF_REF(i_, r_) do { const int qb_ = 31 - ((i_) >> 4), b_ = ((i_) >> 3) & 1, h_ = ((i_) >> 1) & 3, mp_ = (i_) & 1; const size_t row_ = (size_t)b_ * T + 256 * qb_; \
        r_.Q = (const att::bf16*)(Q3 + row_ * QP + 1024 + 128 * h_ + 64 * mp_); r_.O = (att::bf16*)((mp_ ? O2 : O1) + row_ * 512 + 128 * h_); \
        r_.K = (const att::bf16*)(ZR + (size_t)b_ * T * ZP + ZC_FK + 128 * h_); r_.V = (const att::bf16*)(ZR + (size_t)b_ * T * ZP + ZC_FV + 128 * h_); r_.P0 = 256 * qb_; r_.koff = 128 * mp_; r_.mask = nullptr; } while (0)
                    int ic = q_fetch(head, slot);
                    if (ic < 512) {
                        int in_ = q_fetch(head, slot);
                        Ref cur; DIFF_REF(ic, cur);
                        att::Seam<att::bf16> S;
                        att::causal_swa_prime<att::bf16, att::bf16, true>(cur, T, (char*)lds_, S);
                        for (;;) {
                            const bool last = in_ >= 512;
                            Ref nxt = cur; if (!last) DIFF_REF(in_, nxt);
#ifndef NO_DIFF
                            att::causal_swa_block<att::bf16, att::bf16, true, false, 512>(cur, nxt, T, T, (char*)lds_, S);
#endif
                            if (last) break;
                            cur = nxt; ic = in_; in_ = q_fetch(head, slot);
                        }
                    }
                  }
                }
                SEAM(pm + 2);
            }
            if (IN(pm + 3)) { WSL();
                RPostP rp{ZR, Q3, YRAW, RDOTK, KIN(9) + l * 1792, KIN(14) + l * 128 * 512, KIN(18) + l * 512, KIN(19) + l * 512};
#ifndef NO_RPOST
                rwkv_post(rp, lds);
#endif
                constexpr float lambda_init = L == 0 ? 0.2f : 0.35550906759096927f;
                DPostP dq{O1, O2, Q3, KIN(20) + l * 64, KIN(21) + l * 64, KIN(22) + l * 64, KIN(23) + l * 64, KIN(24) + l * 128, lambda_init};
                diff_post(dq, gw, NGW, lane);
                rownorm_rows(XOUT, nullptr, 0.f, nullptr, nullptr, KIN(6) + l * DM, XN, gw, NGW, lane);
                SEAM(pm + 3);
            }
            if (IN(pm + 4)) { WSL();
                pg8::Gemm g{XN, WMi + (size_t)5632 * DM, M, 3072, DM, DM}; pg8::StaticOrder S; S.init(M, 3072, G, bid);
#ifdef GATE_RAW
                pg8::EpiStore<0> E{G3, 3072, G3, 3072, 1 << 30};
                pg8::gemm_phase<pg8::EpiStore<0>, pg8::StaticOrder, true, true>(lds, g, S, E);
#else
                pg8::EpiStore<1> E{G3, 3072, G3, 3072, 1 << 30};
                pg8::gemm_phase<pg8::EpiStore<1>, pg8::StaticOrder, true, true>(lds, g, S, E);
#endif
                SEAM(pm + 4);
            }
            if (IN(pm + 5)) { WSL();
#pragma unroll 1
                for (int n = 0; n < 3; ++n) {
                    pg8::Gemm g{Q3 + 512 * n, WMb + (size_t)n * DM * 512, M, DM, 512, QP}; pg8::StaticOrder S; S.init(M, DM, G, bid);
                    pg8::EpiGateMul E{MG, DM, G3 + 1024 * n, 3072, n == 0 ? 1 : 0};
                    pg8::gemm_phase<pg8::EpiGateMul, pg8::StaticOrder, false, true>(lds, g, S, E);
                    VM_WAIT(); __syncthreads();
                }
                SEAM(pm + 5);
            }
            if (IN(pm + 6)) { WSL();
                pg8::Gemm g{MG, WMo, M, DM, DM, DM}; pg8::StaticOrder S; S.init(M, DM, G, bid);
                pg8::EpiStore<0> E{YP, DM, YP, DM, 1 << 30};
                pg8::gemm_phase<pg8::EpiStore<0>, pg8::StaticOrder, false, true>(lds, g, S, E);
                SEAM(pm + 6);
            }
            if (IN(pm + 7)) { WSL();
                rownorm_rows(XOUT, YP, 1.0f, KIN(7) + l * DM, XOUT, KIN(27) + l * DM, XN, gw, NGW, lane);
                CONV_FFN(l, 1);
                SEAM(pm + 7);
            }
}

__global__ void __launch_bounds__(NWAVES * 64, 2) mk_fwd(Args args) {
    extern __shared__ __attribute__((aligned(16))) unsigned char lds_[];
    LAS unsigned char* lds = (LAS unsigned char*)lds_;
    { const int tid = otid_(); if (tid < 64) MISC[tid] = 0u; }
    __syncthreads();
    (void)xcd_barrier_post((unsigned*)(kws_() + WS_CTL) + CW_BAR, MISC + 8);
    if (IN(0)) { WSL();
        CONV_FFN(0, 0); CONV_MIX(0);
        rownorm_rows(KIN(0), nullptr, 0.f, nullptr, nullptr, KIN(1), XN, gw, NGW, lane);
        SEAM(0);
    }
    ffn_part<0, 0>(lds); mixer_part<0>(lds, lds_); ffn_part<0, 1>(lds);
    ffn_part<1, 0>(lds); mixer_part<1>(lds, lds_); ffn_part<1, 1>(lds);
}

#if PROBE
__device__ __forceinline__ void probe_acc(float num, float den, float* ctlf) {
    __shared__ float rn[256], rd[256];
    rn[threadIdx.x] = num; rd[threadIdx.x] = den; __syncthreads();
    for (int o = 128; o > 0; o >>= 1) { if ((int)threadIdx.x < o) { rn[threadIdx.x] += rn[threadIdx.x + o]; rd[threadIdx.x] += rd[threadIdx.x + o]; } __syncthreads(); }
    if (threadIdx.x == 0) { atomicAdd(ctlf + CW_PROBE, rn[0]); atomicAdd(ctlf + CW_PROBE + 1, rd[0]); }
}
__global__ void __launch_bounds__(256) probe_ffn(const unsigned char* ws, const float* Wg, const float* Wu, const float* Wd) {
    __shared__ float xn[1024]; __shared__ float hid[2816];
    const int m = 777 + 1931 * blockIdx.x, tid = threadIdx.x;
    const bf16* XNp = (const bf16*)(ws + WS_XN); const bf16* YPp = (const bf16*)(ws + WS_R2);
    for (int k = tid; k < 1024; k += 256) xn[k] = bf1(XNp[(size_t)m * 1024 + k]);
    __syncthreads();
    for (int j = tid; j < 2816; j += 256) { float g = 0.f, u = 0.f; for (int k = 0; k < 1024; ++k) { g += xn[k] * Wg[(size_t)k * 2816 + j]; u += xn[k] * Wu[(size_t)k * 2816 + j]; } hid[j] = g / (1.f + expf(-g)) * u; }
    __syncthreads();
    float num = 0.f, den = 0.f;
    for (int d = tid; d < 1024; d += 256) { float o = 0.f; for (int j = 0; j < 2816; ++j) o += hid[j] * Wd[(size_t)j * 1024 + d]; const float got = bf1(YPp[(size_t)m * 1024 + d]); num += (o - got) * (o - got); den += o * o; }
    probe_acc(num, den, (float*)(ws + WS_CTL));
}
__global__ void __launch_bounds__(256) probe_win(const unsigned char* ws, const float* Win) {
    __shared__ float xn[1024];
    const int m = 555 + 1999 * blockIdx.x, tid = threadIdx.x;
    const bf16* XNp = (const bf16*)(ws + WS_XN); const bf16* Q3p = (const bf16*)(ws + WS_Q3); const bf16* ZRp = (const bf16*)(ws + WS_ZR);
    for (int k = tid; k < 1024; k += 256) xn[k] = bf1(XNp[(size_t)m * 1024 + k]);
    __syncthreads();
    float num = 0.f, den = 0.f;
    for (int c = tid; c < 5448; c += 256) {
        float z = 0.f; for (int k = 0; k < 1024; ++k) z += xn[k] * Win[(size_t)k * NIN + c];
        float got;
        if (c < 512) got = bf1(Q3p[(size_t)m * QP + c]);
        else if (c < 2120) got = bf1(ZRp[(size_t)m * ZP + (c - 512)]);
        else if (c < 2632) got = bf1(Q3p[(size_t)m * QP + 512 + (c - 2120)]);
        else if (c < 3912) got = bf1(ZRp[(size_t)m * ZP + (c - 840)]);
        else if (c < 4424) got = bf1(Q3p[(size_t)m * QP + 1024 + (c - 3912)]);
        else got = bf1(ZRp[(size_t)m * ZP + (c - 1352)]);
        num += (z - got) * (z - got); den += z * z;
    }
    probe_acc(num, den, (float*)(ws + WS_CTL));
}
__global__ void __launch_bounds__(256) probe_wconv(const unsigned char* ws, const float* Win, int r0) {
    const bf16* WMp = (const bf16*)(ws + WS_WM); const int tid = threadIdx.x;
    float num = 0.f, den = 0.f;
    for (int rr = 0; rr < 64; ++rr) { const int n = r0 + 64 * blockIdx.x + rr; MapWin mw{Win, NIN}; const float* cp = mw.col(n);
        for (int k = tid; k < 1024; k += 256) { const float ref = cp ? cp[(size_t)k * NIN] : 0.f; const float got = bf1(WMp[(size_t)n * 1024 + k]); num += (ref - got) * (ref - got); den += ref * ref; } }
    probe_acc(num, den, (float*)(ws + WS_CTL));
}
__global__ void __launch_bounds__(256) probe_merge(const unsigned char* ws, const float* Win, const float* Wb, const float* Wo, int which) {
    __shared__ float xn[1024]; __shared__ float y[1536]; __shared__ float mg[1024];
    const int m = 333 + 2003 * blockIdx.x, tid = threadIdx.x;
    const bf16* XNp = (const bf16*)(ws + WS_XN); const bf16* Q3p = (const bf16*)(ws + WS_Q3); const bf16* MGp = (const bf16*)(ws + WS_MG); const bf16* YPp = (const bf16*)(ws + WS_R2);
    for (int k = tid; k < 1024; k += 256) xn[k] = bf1(XNp[(size_t)m * 1024 + k]);
    for (int k = tid; k < 1536; k += 256) y[k] = bf1(Q3p[(size_t)m * QP + k]);
    __syncthreads();
    float num = 0.f, den = 0.f;
    for (int d = tid; d < 1024; d += 256) {
        float acc = 0.f;
        for (int n = 0; n < 3; ++n) { float g = 0.f; for (int k = 0; k < 1024; ++k) g += xn[k] * Win[(size_t)k * NIN + 5448 + n * 1024 + d];
            float p = 0.f; for (int c = 0; c < 512; ++c) p += y[512 * n + c] * Wb[((size_t)n * 512 + c) * 1024 + d];
            acc += p / (1.f + expf(-g)); }
        mg[d] = acc; const float got = bf1(MGp[(size_t)m * 1024 + d]); if (which == 0) { num += (acc - got) * (acc - got); den += acc * acc; }
        if (which == 2) { const bf16* G3p = (const bf16*)(ws + WS_ZR); for (int n = 0; n < 3; ++n) { float g = 0.f; for (int k = 0; k < 1024; ++k) g += xn[k] * Win[(size_t)k * NIN + 5448 + n * 1024 + d];
            const float sg = 1.f / (1.f + expf(-g)), gg = bf1(G3p[(size_t)m * 3072 + n * 1024 + d]); num += (sg - gg) * (sg - gg); den += sg * sg; } }
        if (which == 3) { const bf16* G3p = (const bf16*)(ws + WS_ZR); float a2 = 0.f; for (int n = 0; n < 3; ++n) { float p = 0.f; for (int c = 0; c < 512; ++c) p += y[512 * n + c] * Wb[((size_t)n * 512 + c) * 1024 + d];
            a2 += p * bf1(G3p[(size_t)m * 3072 + n * 1024 + d]); } num += (a2 - got) * (a2 - got); den += a2 * a2; }
    }
    __syncthreads();
    if (which == 1) for (int d = tid; d < 1024; d += 256) { float o = 0.f; for (int j = 0; j < 1024; ++j) o += mg[j] * Wo[(size_t)j * 1024 + d]; const float got = bf1(YPp[(size_t)m * 1024 + d]); num += (o - got) * (o - got); den += o * o; }
    probe_acc(num, den, (float*)(ws + WS_CTL));
}
#endif
#ifndef MK_ONE_LAUNCH
#define MK_ONE_LAUNCH 0
#endif
extern "C" void kernel_launch(void* const* d_in, const int* in_sizes, int n_in, void* d_out, int out_size, void* d_ws, size_t ws_size, hipStream_t stream) {
    static int grid = 0;
    if (grid == 0) {
        if (n_in != 32 || in_sizes[0] != M * DM || out_size != M * DM || ws_size < WS_END) { fprintf(stderr, "kernel_launch: unexpected shapes / workspace (n_in %d, ws %zu)\n", n_in, ws_size); grid = -1; return; }
        int dev = 0, cus = 0;
        if (hipGetDevice(&dev) != hipSuccess || hipDeviceGetAttribute(&cus, hipDeviceAttributeMultiprocessorCount, dev) != hipSuccess) { grid = -1; return; }
        if (hipFuncSetAttribute((const void*)mk_fwd, hipFuncAttributeMaxDynamicSharedMemorySize, LDS_BYTES) != hipSuccess) { fprintf(stderr, "kernel_launch: hipFuncSetAttribute failed\n"); grid = -1; return; }
        int per_cu = 0;
        if (hipOccupancyMaxActiveBlocksPerMultiprocessor(&per_cu, (const void*)mk_fwd, NWAVES * 64, LDS_BYTES) != hipSuccess || per_cu < 1) { fprintf(stderr, "kernel_launch: occupancy query says %d\n", per_cu); }
        (void)hipGetLastError();
        grid = cus;
    }
    if (grid < 0) return;
    (void)hipMemsetAsync((char*)d_ws + WS_CTL, 0, CTL_ZERO_BYTES, stream);
    Args a{};
    for (int i = 0; i < 32; ++i) a.in[i] = (const float*)d_in[i];
    a.out = (float*)d_out; a.ws = (unsigned char*)d_ws;
#if MK_ONE_LAUNCH
    a.ph_lo = 0; a.ph_hi = N_PHASES;
    hipLaunchKernelGGL(mk_fwd, dim3(grid), dim3(NWAVES * 64), LDS_BYTES, stream, a);
#else
    for (int p = 0; p < N_PHASES; ++p) { a.ph_lo = p; a.ph_hi = p + 1; hipLaunchKernelGGL(mk_fwd, dim3(grid), dim3(NWAVES * 64), LDS_BYTES, stream, a);
#if PROBE == 1
        if (p == 2) hipLaunchKernelGGL(probe_ffn, dim3(8), dim3(256), 0, stream, (const unsigned char*)d_ws, a.in[3], a.in[4], a.in[5]);
#elif PROBE == 2
        if (p == 4) hipLaunchKernelGGL(probe_win, dim3(8), dim3(256), 0, stream, (const unsigned char*)d_ws, a.in[8]);
#elif PROBE == 3
        if (p == 8) hipLaunchKernelGGL(probe_merge, dim3(8), dim3(256), 0, stream, (const unsigned char*)d_ws, a.in[8], a.in[25], a.in[26], 0);
#elif PROBE == 5
        if (p == 8) hipLaunchKernelGGL(probe_merge, dim3(8), dim3(256), 0, stream, (const unsigned char*)d_ws, a.in[8], a.in[25], a.in[26], 2);
#elif PROBE == 6
        if (p == 8) hipLaunchKernelGGL(probe_merge, dim3(8), dim3(256), 0, stream, (const unsigned char*)d_ws, a.in[8], a.in[25], a.in[26], 3);
#elif PROBE == 7
        if (p == 6) hipLaunchKernelGGL(probe_wconv, dim3(48), dim3(256), 0, stream, (const unsigned char*)d_ws, a.in[8], 5632);
#elif PROBE == 8
        if (p == 3) hipLaunchKernelGGL(probe_wconv, dim3(48), dim3(256), 0, stream, (const unsigned char*)d_ws, a.in[8], 5632);
#elif PROBE == 9
        if (p == 7) hipLaunchKernelGGL(probe_merge, dim3(8), dim3(256), 0, stream, (const unsigned char*)d_ws, a.in[8], a.in[25], a.in[26], 2);
#elif PROBE == 4
        if (p == 9) hipLaunchKernelGGL(probe_merge, dim3(8), dim3(256), 0, stream, (const unsigned char*)d_ws, a.in[8], a.in[25], a.in[26], 1);
#endif
    }
#endif
}
```

```cpp
#include <hip/hip_runtime.h>
#include <hip/hip_bf16.h>
#include <cstdio>
#include <cstdint>
#define MK_ONE_LAUNCH 1
#define GATE_RAW 1

__device__ __forceinline__ int otid_() { int t = (int)threadIdx.x; asm volatile("" : "+v"(t)); return t; }
namespace pg8 {
#define PG8_LAS __attribute__((address_space(3)))
typedef unsigned short bf16_t;
typedef short bf16x8 __attribute__((ext_vector_type(8)));
typedef float f32x4 __attribute__((ext_vector_type(4)));
typedef unsigned u32x4 __attribute__((ext_vector_type(4)));
constexpr int BM = 256, BK = 64, HALF = 128, HTB = HALF * BK * 2  , STAGE_BYTES = 8 * HTB, NXCD = 8, WGM = 8;

__host__ __device__ __forceinline__ int lds_byte(int r, int c) { const int st = (r >> 4) * 2 + (c >> 5), rr = r & 15, cc = c & 31, ob = rr * 64 + cc * 2; return st * 1024 + (ob ^ (((ob >> 9) & 1) << 5)); }
__host__ __device__ __forceinline__ void stage_rc(int b, int& R, int& C) { const int st = b / 1024, sb = b % 1024, swz = sb ^ (((sb >> 9) & 1) << 5); R = (st >> 1) * 16 + swz / 64; C = (st & 1) * 32 + (swz % 64) / 2; }
__host__ __device__ __forceinline__ int perm32(int rho) { const int n = rho >> 4, i = rho & 15; return 8 * (i >> 2) + 4 * n + (i & 3); }

struct Unit { int pm, pn; };
struct Gemm { const bf16_t* A; const bf16_t* Bt; int M, N, K, lda; };

struct StaticOrder {
    int nM, nN, nwg, G, c;
    __host__ __device__ void init(int M, int N, int G_, int c_) { nM = M / BM; nN = N / BM; nwg = nM * nN; G = G_; c = c_; }
    __host__ __device__ bool next(int i, Unit& u) const {
        const long L = (long)i * G + c; if (L >= nwg) return false;
        int wgid = (int)L; { const int q = nwg / NXCD, r = nwg % NXCD, xcd = wgid % NXCD, off = wgid / NXCD; wgid = (xcd < r ? xcd * (q + 1) : r * (q + 1) + (xcd - r) * q) + off; }
        const int nig = WGM * nN, gid = wgid / nig, fm = gid * WGM, gsz = (nM - fm) < WGM ? (nM - fm) : WGM;
        u.pm = fm + ((wgid % nig) % gsz); u.pn = (wgid % nig) / gsz; return true;
    }
    __device__ __forceinline__ void a_ready(const Unit&) const {}
    __device__ __forceinline__ void done(const Unit&) const {}
};

__device__ __forceinline__ unsigned cvt_pk_bf16(float lo, float hi) { unsigned r; asm volatile("v_cvt_pk_bf16_f32 %0, %1, %2" : "=v"(r) : "v"(lo), "v"(hi)); return r; }

template <class Epi, class Sched, bool ALIGN_EPI = false, bool SP2 = false>
__device__ __forceinline__ void gemm_phase(PG8_LAS unsigned char* lds, const Gemm g, const Sched& S, const Epi& E) {
    const int tid = otid_(), wid = __builtin_amdgcn_readfirstlane(tid >> 6), lane = tid & 63, wr = wid >> 2, wc = wid & 3, fr = lane & 15, fq = lane >> 4;
    const int K = g.K, nt = K / BK;
    unsigned voffA[2], voffB[2];
#pragma unroll
    for (int i = 0; i < 2; ++i) { int R, C; stage_rc(tid * 16 + i * 8192, R, C); const int Rb = Epi::PERM ? ((R & ~31) + perm32(R & 31)) : R;
        voffA[i] = (unsigned)(R * g.lda + C) * 2u; voffB[i] = (unsigned)(Rb * K + C) * 2u; }
    const size_t kstep = (size_t)(BK * 2);
    const size_t hstepB = (size_t)HALF * K * 2, hstepA = (size_t)HALF * g.lda * 2;
    const size_t tstepB = 2 * hstepB, tstepA = 2 * hstepA;
    const unsigned ldsw = (unsigned)wid * 1024u;
    const int aoff = lds_byte(wr * 64 + fr, fq * 8), boff = lds_byte(wc * 32 + fr, fq * 8);
#define PG8_SA(b, h) (((b) * 2 + (h)) * HTB)
#define PG8_SB(b, h) ((4 + (b) * 2 + (h)) * HTB)
#define PG8_STAGE(bufoff, gbase, voff) do { _Pragma("unroll") for (int _i = 0; _i < 2; ++_i) \
        __builtin_amdgcn_global_load_lds((const unsigned*)((const char*)(gbase) + (voff)[_i]), (PG8_LAS unsigned*)(lds + (bufoff) + ldsw + _i * 8192), 16, 0, 0); } while (0)
#define PG8_LDA(dst, b, h) do { _Pragma("unroll") for (int m = 0; m < 4; ++m) _Pragma("unroll") for (int k = 0; k < 2; ++k) dst[m][k] = *(const PG8_LAS bf16x8*)(lds + PG8_SA(b, h) + aoff + m * 2048 + k * 1024); } while (0)
#define PG8_LDB(dst, b, h) do { _Pragma("unroll") for (int n = 0; n < 2; ++n) _Pragma("unroll") for (int k = 0; k < 2; ++k) dst[n][k] = *(const PG8_LAS bf16x8*)(lds + PG8_SB(b, h) + boff + n * 2048 + k * 1024); } while (0)
#define PG8_MMA(ai, bj, At, Bt) do { __builtin_amdgcn_s_setprio(1); _Pragma("unroll") for (int m = 0; m < 4; ++m) _Pragma("unroll") for (int n = 0; n < 2; ++n) _Pragma("unroll") for (int k = 0; k < 2; ++k) \
        acc[ai][bj][m][n] = __builtin_amdgcn_mfma_f32_16x16x32_bf16(Bt[n][k], At[m][k], acc[ai][bj][m][n], 0, 0, 0); __builtin_amdgcn_s_setprio(0); } while (0)
#define PG8_WAIT_V(n) asm volatile("s_waitcnt vmcnt(" #n ")" ::: "memory")
#define PG8_WAIT_L(n) asm volatile("s_waitcnt lgkmcnt(" #n ")" ::: "memory")
#define PG8_BAR __builtin_amdgcn_s_barrier()
#define PG8_SCHED __builtin_amdgcn_sched_barrier(0)
    Unit cur, nxt; int ui = 0;
    if (!S.next(0, cur)) return;
    f32x4 acc[2][2][4][2];
#pragma unroll
    for (int a = 0; a < 2; ++a)
#pragma unroll
        for (int b = 0; b < 2; ++b)
#pragma unroll
            for (int m = 0; m < 4; ++m)
#pragma unroll
                for (int n = 0; n < 2; ++n) acc[a][b][m][n] = (f32x4){0.f, 0.f, 0.f, 0.f};
    bf16x8 At[4][2], B0[2][2], B1[2][2];
    const char* cA = (const char*)g.A + (size_t)cur.pm * tstepA; const char* cB = (const char*)g.Bt + (size_t)cur.pn * tstepB;
    S.a_ready(cur);
    if constexpr (SP2) {
        PG8_STAGE(PG8_SB(0, 0), cB, voffB); PG8_STAGE(PG8_SB(0, 1), cB + hstepB, voffB); PG8_STAGE(PG8_SA(0, 0), cA, voffA); PG8_STAGE(PG8_SA(0, 1), cA + hstepA, voffA);
        if (wr == 1) PG8_BAR;
        PG8_WAIT_V(2); PG8_BAR;
        PG8_STAGE(PG8_SB(1, 0), cB + kstep, voffB); PG8_STAGE(PG8_SA(1, 0), cA + kstep, voffA); PG8_STAGE(PG8_SB(1, 1), cB + hstepB + kstep, voffB);
        PG8_WAIT_V(6); PG8_BAR;
    } else {
        PG8_STAGE(PG8_SB(0, 0), cB, voffB); PG8_STAGE(PG8_SA(0, 0), cA, voffA); PG8_STAGE(PG8_SB(0, 1), cB + hstepB, voffB); PG8_STAGE(PG8_SA(0, 1), cA + hstepA, voffA);
        if (wr == 1) PG8_BAR;
        PG8_WAIT_V(4); PG8_BAR;
        PG8_STAGE(PG8_SB(1, 0), cB + kstep, voffB); PG8_STAGE(PG8_SA(1, 0), cA + kstep, voffA); PG8_STAGE(PG8_SB(1, 1), cB + hstepB + kstep, voffB);
        PG8_WAIT_V(6); PG8_BAR;
    }
    for (;;) {
        const bool has_next = S.next(ui + 1, nxt);
        const char* nA = has_next ? (const char*)g.A + (size_t)nxt.pm * tstepA : cA; const char* nB = has_next ? (const char*)g.Bt + (size_t)nxt.pn * tstepB : cB;
        for (int t = 0; t < nt; t += 2) {
            const bool last = (t == nt - 2);
            const char* a1 = cA + (size_t)(t + 1) * kstep;
            const char* a2 = last ? nA : cA + (size_t)(t + 2) * kstep; const char* b2 = last ? nB : cB + (size_t)(t + 2) * kstep;
            const char* a3 = a2 + kstep; const char* b3 = b2 + kstep;
            if (last && has_next) S.a_ready(nxt);
            if constexpr (SP2) {
            PG8_LDB(B0, 0, 0); PG8_LDB(B1, 0, 1); PG8_SCHED; PG8_LDA(At, 0, 0); PG8_STAGE(PG8_SA(1, 1), a1 + hstepA, voffA);
            PG8_WAIT_V(8); PG8_WAIT_L(0); PG8_BAR; PG8_MMA(0, 0, At, B0); PG8_MMA(0, 1, At, B1); PG8_BAR; PG8_SCHED;
            PG8_LDA(At, 0, 1); PG8_STAGE(PG8_SB(0, 0), b2, voffB); PG8_STAGE(PG8_SB(0, 1), b2 + hstepB, voffB); PG8_STAGE(PG8_SA(0, 0), a2, voffA);
            PG8_WAIT_V(8); PG8_WAIT_L(0); PG8_BAR; PG8_MMA(1, 0, At, B0); PG8_MMA(1, 1, At, B1); PG8_BAR; PG8_SCHED;
            PG8_LDB(B0, 1, 0); PG8_LDB(B1, 1, 1); PG8_SCHED; PG8_LDA(At, 1, 0); PG8_STAGE(PG8_SA(0, 1), a2 + hstepA, voffA);
            PG8_WAIT_V(8); PG8_WAIT_L(0); PG8_BAR; PG8_MMA(0, 0, At, B0); PG8_MMA(0, 1, At, B1); PG8_BAR; PG8_SCHED;
            PG8_LDA(At, 1, 1); PG8_STAGE(PG8_SB(1, 0), b3, voffB); PG8_STAGE(PG8_SB(1, 1), b3 + hstepB, voffB); PG8_STAGE(PG8_SA(1, 0), a3, voffA);
            PG8_WAIT_V(8); PG8_WAIT_L(0); PG8_BAR; PG8_MMA(1, 0, At, B0); PG8_MMA(1, 1, At, B1); PG8_BAR; PG8_SCHED;
            } else {
            PG8_LDB(B0, 0, 0); PG8_SCHED; PG8_LDA(At, 0, 0); PG8_STAGE(PG8_SA(1, 1), a1 + hstepA, voffA);
            PG8_WAIT_L(8); PG8_BAR; PG8_WAIT_L(0); PG8_MMA(0, 0, At, B0); PG8_BAR; PG8_SCHED;
            PG8_LDB(B1, 0, 1); PG8_STAGE(PG8_SB(0, 0), b2, voffB);
            PG8_BAR; PG8_WAIT_L(0); PG8_MMA(0, 1, At, B1); PG8_BAR;
            PG8_LDA(At, 0, 1); PG8_STAGE(PG8_SA(0, 0), a2, voffA);
            PG8_BAR; PG8_WAIT_L(0); PG8_MMA(1, 0, At, B0); PG8_BAR; PG8_SCHED;
            PG8_STAGE(PG8_SB(0, 1), b2 + hstepB, voffB);
            PG8_WAIT_V(6); PG8_BAR; PG8_MMA(1, 1, At, B1); PG8_BAR;
            PG8_LDB(B0, 1, 0); PG8_SCHED; PG8_LDA(At, 1, 0); PG8_STAGE(PG8_SA(0, 1), a2 + hstepA, voffA);
            PG8_WAIT_L(8); PG8_BAR; PG8_WAIT_L(0); PG8_MMA(0, 0, At, B0); PG8_BAR; PG8_SCHED;
            PG8_LDB(B1, 1, 1); PG8_STAGE(PG8_SB(1, 0), b3, voffB);
            PG8_BAR; PG8_WAIT_L(0); PG8_MMA(0, 1, At, B1); PG8_BAR;
            PG8_LDA(At, 1, 1); PG8_STAGE(PG8_SA(1, 0), a3, voffA);
            PG8_BAR; PG8_WAIT_L(0); PG8_MMA(1, 0, At, B0); PG8_BAR; PG8_SCHED;
            PG8_STAGE(PG8_SB(1, 1), b3 + hstepB, voffB);
            PG8_WAIT_V(6); PG8_BAR; PG8_MMA(1, 1, At, B1); PG8_BAR;
            }
        }
        if constexpr (ALIGN_EPI) { if (wr == 0) PG8_BAR; }
        if constexpr (!Epi::AFTER_DRAIN) { E(acc, cur, wr, wc, fr, fq); S.done(cur); }
        if (!has_next) break;
#pragma unroll
        for (int a = 0; a < 2; ++a)
#pragma unroll
            for (int b = 0; b < 2; ++b)
#pragma unroll
                for (int m = 0; m < 4; ++m)
#pragma unroll
                    for (int n = 0; n < 2; ++n) acc[a][b][m][n] = (f32x4){0.f, 0.f, 0.f, 0.f};
        cur = nxt; cA = nA; cB = nB; ++ui;
        if constexpr (ALIGN_EPI) { if (wr == 1) PG8_BAR; }
    }
    PG8_WAIT_V(0);
    if constexpr (!ALIGN_EPI) { if (wr == 0) PG8_BAR; }
    PG8_BAR;
    if constexpr (Epi::AFTER_DRAIN) { E.fused(acc, cur, wr, wc, fr, fq, lds, wid, lane); S.done(cur); }
#undef PG8_SA
#undef PG8_SB
#undef PG8_STAGE
#undef PG8_LDA
#undef PG8_LDB
#undef PG8_MMA
#undef PG8_WAIT_V
#undef PG8_WAIT_L
#undef PG8_BAR
#undef PG8_SCHED
}
}
namespace pg8 {
typedef unsigned u32x2 __attribute__((ext_vector_type(2)));
__device__ __forceinline__ float bf_lo(unsigned w) { return __uint_as_float(w << 16); }
__device__ __forceinline__ float bf_hi(unsigned w) { return __uint_as_float(w & 0xffff0000u); }
__device__ __forceinline__ float sigmoidf_(float x) { return __builtin_amdgcn_rcpf(1.0f + __expf(-x)); }

struct EpiSwiGLU {
    static constexpr bool PERM = false, AFTER_DRAIN = false;
    bf16_t* H; int ldh;
    __device__ __forceinline__ void operator()(const f32x4 (&acc)[2][2][4][2], const Unit& u, int wr, int wc, int fr, int fq) const {
        const int row0 = u.pm * BM + wr * 64 + fr, hc0 = u.pn * 128 + wc * 16 + 4 * fq;
#pragma unroll
        for (int ai = 0; ai < 2; ++ai)
#pragma unroll
            for (int m = 0; m < 4; ++m) { bf16_t* rowp = H + (size_t)(row0 + ai * HALF + m * 16) * ldh + hc0;
#pragma unroll
                for (int bj = 0; bj < 2; ++bj) { const f32x4 g = acc[ai][bj][m][0], up = acc[ai][bj][m][1]; float h[4];
#pragma unroll
                    for (int e = 0; e < 4; ++e) h[e] = g[e] * sigmoidf_(g[e]) * up[e];
                    u32x2 w; w.x = cvt_pk_bf16(h[0], h[1]); w.y = cvt_pk_bf16(h[2], h[3]);
                    *(u32x2*)(rowp + bj * 64) = w; } }
    }
};
template <int ACT> struct EpiStore {
    static constexpr bool PERM = true, AFTER_DRAIN = false;
    bf16_t* O0; int ld0; bf16_t* O1; int ld1; int split_tiles;
    __device__ __forceinline__ void operator()(const f32x4 (&acc)[2][2][4][2], const Unit& u, int wr, int wc, int fr, int fq) const {
        const int row0 = u.pm * BM + wr * 64 + fr;
        bf16_t* base; int ld, colt;
        if (u.pn < split_tiles) { base = O0; ld = ld0; colt = u.pn * BM; } else { base = O1; ld = ld1; colt = (u.pn - split_tiles) * BM; }
        const int col0 = colt + wc * 32 + 8 * fq;
#pragma unroll
        for (int ai = 0; ai < 2; ++ai)
#pragma unroll
            for (int m = 0; m < 4; ++m) { bf16_t* rowp = base + (size_t)(row0 + ai * HALF + m * 16) * ld + col0;
#pragma unroll
                for (int bj = 0; bj < 2; ++bj) { f32x4 v0 = acc[ai][bj][m][0], v1 = acc[ai][bj][m][1];
                    if (ACT == 1) {
#pragma unroll
                        for (int e = 0; e < 4; ++e) { v0[e] = sigmoidf_(v0[e]); v1[e] = sigmoidf_(v1[e]); } }
                    u32x4 w; w.x = cvt_pk_bf16(v0[0], v0[1]); w.y = cvt_pk_bf16(v0[2], v0[3]); w.z = cvt_pk_bf16(v1[0], v1[1]); w.w = cvt_pk_bf16(v1[2], v1[3]);
                    *(u32x4*)(rowp + bj * HALF) = w; } }
    }
};
#ifdef GATE_RAW
#define GSIG(x) sigmoidf_(x)
#else
#define GSIG(x) (x)
#endif
struct EpiGateMul {
    static constexpr bool PERM = true, AFTER_DRAIN = false;
    bf16_t* MG; int ldm; const bf16_t* G; int ldg; int first;
    __device__ __forceinline__ void operator()(const f32x4 (&acc)[2][2][4][2], const Unit& u, int wr, int wc, int fr, int fq) const {
        const int row0 = u.pm * BM + wr * 64 + fr, col0 = u.pn * BM + wc * 32 + 8 * fq;
#pragma unroll
        for (int ai = 0; ai < 2; ++ai)
#pragma unroll
            for (int m = 0; m < 4; ++m) { const size_t r = (size_t)(row0 + ai * HALF + m * 16);
#pragma unroll
                for (int bj = 0; bj < 2; ++bj) { const f32x4 v0 = acc[ai][bj][m][0], v1 = acc[ai][bj][m][1];
                    const u32x4 g = *(const u32x4*)(G + r * ldg + col0 + bj * HALF);
                    float o[8] = { v0[0] * GSIG(bf_lo(g.x)), v0[1] * GSIG(bf_hi(g.x)), v0[2] * GSIG(bf_lo(g.y)), v0[3] * GSIG(bf_hi(g.y)), v1[0] * GSIG(bf_lo(g.z)), v1[1] * GSIG(bf_hi(g.z)), v1[2] * GSIG(bf_lo(g.w)), v1[3] * GSIG(bf_hi(g.w)) };
                    bf16_t* mp = MG + r * ldm + col0 + bj * HALF;
                    if (!first) { const u32x4 p = *(const u32x4*)mp;
                        o[0] += bf_lo(p.x); o[1] += bf_hi(p.x); o[2] += bf_lo(p.y); o[3] += bf_hi(p.y); o[4] += bf_lo(p.z); o[5] += bf_hi(p.z); o[6] += bf_lo(p.w); o[7] += bf_hi(p.w); }
                    u32x4 w; w.x = cvt_pk_bf16(o[0], o[1]); w.y = cvt_pk_bf16(o[2], o[3]); w.z = cvt_pk_bf16(o[4], o[5]); w.w = cvt_pk_bf16(o[6], o[7]);
                    *(u32x4*)mp = w; } }
    }
};
}
namespace att {
constexpr int D = 128;
constexpr bool WSKIP = false;
constexpr float THR = 8.f;
constexpr int NW = 8, QBLK = 32, KVBLK = 64, QB = NW * QBLK;
constexpr int SHM_V = KVBLK * D * 2, SHM_K = KVBLK * D * 2;
constexpr int LDS_BYTES = 2 * SHM_V + 2 * SHM_K + NW * 64 * 4;
using bf16 = __hip_bfloat16;
typedef short bf16x8 __attribute__((ext_vector_type(8)));
typedef short s16x4 __attribute__((ext_vector_type(4)));
typedef float f32x16 __attribute__((ext_vector_type(16)));
typedef float f32x4 __attribute__((ext_vector_type(4)));
typedef unsigned u32x4 __attribute__((ext_vector_type(4)));
template <class A, class Bt> struct same_t { static constexpr bool v = false; };
template <class A> struct same_t<A, A> { static constexpr bool v = true; };

#define KSWZ(row, colB) ((row) * 256 + ((colB) ^ (((row) & 7) << 4)))
#define SBAR() __builtin_amdgcn_sched_barrier(0)
__device__ __forceinline__ int v_st(int k, int c) { const int kk = (k & ~0xC) | ((k & 4) << 1) | ((k & 8) >> 1); return ((kk >> 3) * 4 + (c >> 5)) * 512 + ((kk & 7) * 32 + (c & 31)) * 2; }
__device__ __forceinline__ int v_rd_base(int lane) { return ((lane & 3) << 3) | (((lane >> 2) & 3) << 6) | (((lane >> 4) & 1) << 5) | (((lane >> 5) & 1) << 8); }
constexpr int v_rd_off(int d0, int ks, int half) { return d0 * 512 + ks * 4096 + half * 2048; }
__device__ __forceinline__ int crow(int r, int hi) { return (r & 3) + 8 * (r >> 2) + 4 * hi; }
__device__ __forceinline__ unsigned cvtpk(float lo, float hi) {
    unsigned r; asm volatile("v_cvt_pk_bf16_f32 %0, %1, %2" : "=v"(r) : "v"(lo), "v"(hi)); return r;
}
__device__ __forceinline__ bf16x8 pack8(f32x4 a, f32x4 b) {
    u32x4 w = {cvtpk(a[0], a[1]), cvtpk(a[2], a[3]), cvtpk(b[0], b[1]), cvtpk(b[2], b[3])};
    return *reinterpret_cast<bf16x8*>(&w);
}
template <class T> __device__ __forceinline__ bf16x8 load8(const T* p) {
    if constexpr (same_t<T, float>::v) { return pack8(*(const f32x4*)p, *(const f32x4*)(p + 4)); }
    else { return *reinterpret_cast<const bf16x8*>(p); }
}
__device__ __forceinline__ void mask_tile(f32x16& p0, f32x16& p1, int dq, unsigned W) {
    const float NEG = -__builtin_inff();
#pragma unroll
    for (int r = 0; r < 16; ++r) {
        const int c = (r & 3) + 8 * (r >> 2);
        if ((unsigned)(dq - c) >= W) p0[r] = NEG;
        if ((unsigned)(dq - c - 32) >= W) p1[r] = NEG;
    }
}
typedef unsigned u32x2 __attribute__((ext_vector_type(2)));
__device__ __forceinline__ void bitmask_tile(f32x16& p0, f32x16& p1, u32x2 w, int hi) {
    const float NEG = -__builtin_inff();
    const unsigned a = w[0] >> (4 * hi), b = w[1] >> (4 * hi);
#pragma unroll
    for (int r = 0; r < 16; ++r) {
        const int c = (r & 3) + 8 * (r >> 2);
        if (!((a >> c) & 1u)) p0[r] = NEG;
        if (!((b >> c) & 1u)) p1[r] = NEG;
    }
}
template <bool HALFQK> __device__ __forceinline__ void partialSM(f32x16& p0, f32x16& p1, float& m_reg, float& mn, float& alpha) {
    constexpr float SCALE = HALFQK ? 0.125f : 0.08838834764831845f;
    float pmax = p0[0]; for (int r = 1; r < 16; ++r) pmax = fmaxf(pmax, p0[r]); for (int r = 0; r < 16; ++r) pmax = fmaxf(pmax, p1[r]);
    { auto rr = __builtin_amdgcn_permlane32_swap(__float_as_uint(pmax), __float_as_uint(pmax), false, false);
      pmax = fmaxf(__uint_as_float(rr[0]), __uint_as_float(rr[1])); }
    constexpr float C2 = 1.4426950408889634f * SCALE;
    if (__builtin_expect(__all((pmax - m_reg) * SCALE <= THR), 1)) { mn = m_reg; alpha = 1.f; }
    else { mn = fmaxf(m_reg, pmax); alpha = __builtin_amdgcn_exp2f((m_reg - mn) * C2); m_reg = mn; }
    const float mnL = -mn * C2;
    for (int r = 0; r < 16; ++r) p0[r] = fmaf(p0[r], C2, mnL); for (int r = 0; r < 16; ++r) p1[r] = fmaf(p1[r], C2, mnL);
    for (int r = 0; r < 16; ++r) p0[r] = __builtin_amdgcn_exp2f(p0[r]);
}
__device__ __forceinline__ void finishSM(f32x16& p0, f32x16& p1, float alpha, float& l_reg, bf16x8& pa0, bf16x8& pa1, bf16x8& pa2, bf16x8& pa3) {
    for (int r = 0; r < 16; ++r) p1[r] = __builtin_amdgcn_exp2f(p1[r]);
    float ps = 0; for (int r = 0; r < 16; ++r) ps += p0[r]; for (int r = 0; r < 16; ++r) ps += p1[r];
    { auto rr = __builtin_amdgcn_permlane32_swap(__float_as_uint(ps), __float_as_uint(ps), false, false);
      ps = __uint_as_float(rr[0]) + __uint_as_float(rr[1]); }
    l_reg = l_reg * alpha + ps;
#define PK4(P, B_, OUT) do { unsigned a0 = cvtpk(P[B_+0], P[B_+1]), a1 = cvtpk(P[B_+2], P[B_+3]);                          \
        unsigned b0 = cvtpk(P[B_+4], P[B_+5]), b1 = cvtpk(P[B_+6], P[B_+7]);                                             \
        auto r0 = __builtin_amdgcn_permlane32_swap(a0, b0, false, false); auto r1 = __builtin_amdgcn_permlane32_swap(a1, b1, false, false); \
        u32x4 w = {r0[0], r1[0], r0[1], r1[1]}; OUT = *reinterpret_cast<bf16x8*>(&w); } while (0)
    PK4(p0, 0, pa0); PK4(p0, 8, pa1); PK4(p1, 0, pa2); PK4(p1, 8, pa3);
#undef PK4
}
template <int KB, bool SK, bool HALFQK>
__device__ __forceinline__ void qkt(f32x16& p0, f32x16& p1, const char* K_lds, int r32, int hi, const bf16x8* qr, bool act, int koff) {
    if (SK && !act) { const float NEG = -__builtin_inff();
#pragma unroll
        for (int r = 0; r < 16; ++r) { p0[r] = NEG; p1[r] = NEG; } return; }
    p0 = f32x16{}; p1 = f32x16{};
    const char* kb[4];
#pragma unroll
    for (int dd = 0; dd < 4; ++dd) kb[dd] = K_lds + KB * SHM_K + KSWZ(r32, (dd * 16 + hi * 8) * 2) + koff;
#pragma unroll
    for (int d0 = 0; d0 < (HALFQK ? 4 : 8); ++d0) { const char* a = kb[d0 & 3] + (d0 >> 2) * 128;
        bf16x8 b0 = *reinterpret_cast<const bf16x8*>(a);
        bf16x8 b1 = *reinterpret_cast<const bf16x8*>(a + 32 * 256);
        p0 = __builtin_amdgcn_mfma_f32_32x32x16_bf16(b0, qr[d0], p0, 0, 0, 0);
        p1 = __builtin_amdgcn_mfma_f32_32x32x16_bf16(b1, qr[d0], p1, 0, 0, 0); }
}
template <int VB, bool SK>
__device__ __forceinline__ void pv_tile(f32x16* o, int vb0, bf16x8 pa0, bf16x8 pa1, bf16x8 pa2, bf16x8 pa3, bool act) {
    if (SK && !act) return;
#define TRRD(dst, off) asm volatile("ds_read_b64_tr_b16 %0, %1 offset:%2" : "=&v"(dst) : "v"(vb0), "i"(off) : "memory")
#define PV_D0(d0) do { s16x4 l0, l1, l2, l3, h0, h1, h2, h3; constexpr int b_ = VB * SHM_V + v_rd_off(d0, 0, 0);     \
        TRRD(l0, b_); TRRD(h0, b_ + 2048); TRRD(l1, b_ + 4096); TRRD(h1, b_ + 6144); TRRD(l2, b_ + 8192); TRRD(h2, b_ + 10240); TRRD(l3, b_ + 12288); TRRD(h3, b_ + 14336); \
        asm volatile("s_waitcnt lgkmcnt(0)" ::: "memory"); SBAR();                 \
        o[d0] = __builtin_amdgcn_mfma_f32_32x32x16_bf16(pa0, (bf16x8){l0[0], l0[1], l0[2], l0[3], h0[0], h0[1], h0[2], h0[3]}, o[d0], 0, 0, 0);   \
        o[d0] = __builtin_amdgcn_mfma_f32_32x32x16_bf16(pa1, (bf16x8){l1[0], l1[1], l1[2], l1[3], h1[0], h1[1], h1[2], h1[3]}, o[d0], 0, 0, 0);   \
        o[d0] = __builtin_amdgcn_mfma_f32_32x32x16_bf16(pa2, (bf16x8){l2[0], l2[1], l2[2], l2[3], h2[0], h2[1], h2[2], h2[3]}, o[d0], 0, 0, 0);   \
        o[d0] = __builtin_amdgcn_mfma_f32_32x32x16_bf16(pa3, (bf16x8){l3[0], l3[1], l3[2], l3[3], h3[0], h3[1], h3[2], h3[3]}, o[d0], 0, 0, 0); } while (0)
    PV_D0(0); PV_D0(1); PV_D0(2); PV_D0(3);
#undef PV_D0
#undef TRRD
}

constexpr int QS = 1536, KVS = 4096;
template <class TIn, class TOut> struct BlockRef { const TIn* Q; const TIn* K; const TIn* V; TOut* O; int P0; int koff; const unsigned* mask; };
template <class TIn> struct Seam {
    bf16x8 qr[8];
    bf16x8 st_v0, st_v1, st_k0, st_k1; f32x4 sf0, sf1, sf2, sf3;
    f32x4 tq[16];
};
__device__ __forceinline__ int swa_jlo(int P0, int W) { const int lowk = P0 - W + 1; return lowk > 0 ? lowk / KVBLK : 0; }
#define ROW(p, k0, rr) ((p) + (size_t)((k0) + (rr)) * KVS + sc)
#define VMW() asm volatile("s_waitcnt vmcnt(0)" ::: "memory")
#define VMWN(n) asm volatile("s_waitcnt vmcnt(%0)" :: "i"(n) : "memory")
#define SLOAD_H(Kp, Vp, k0) do { S.st_v0 = load8<TIn>(ROW(Vp, k0, sr)); S.st_v1 = load8<TIn>(ROW(Vp, k0, 32 + sr));              \
                         S.st_k0 = load8<TIn>(ROW(Kp, k0, sr)); S.st_k1 = load8<TIn>(ROW(Kp, k0, 32 + sr)); } while (0)
#define SWRITE_HK(bf) do { *(bf16x8*)(K_lds + (bf) * SHM_K + kws) = S.st_k0; *(bf16x8*)(K_lds + (bf) * SHM_K + kws + 32 * 256) = S.st_k1; } while (0)
#define SWRITE_HV(bf) do { *(bf16x8*)(V_lds + (bf) * SHM_V + vst0) = S.st_v0; *(bf16x8*)(V_lds + (bf) * SHM_V + vst1) = S.st_v1; } while (0)
#define SWRITE_H(bf) do { SWRITE_HV(bf); SWRITE_HK(bf); } while (0)
#define SLOAD_F(p, k0) do { S.sf0 = *(const f32x4*)ROW(p, k0, sr); S.sf1 = *(const f32x4*)(ROW(p, k0, sr) + 4);                \
                            S.sf2 = *(const f32x4*)ROW(p, k0, 32 + sr); S.sf3 = *(const f32x4*)(ROW(p, k0, 32 + sr) + 4); } while (0)
#define SWRITE_KF(bf) do { *(bf16x8*)(K_lds + (bf) * SHM_K + kws) = pack8(S.sf0, S.sf1); *(bf16x8*)(K_lds + (bf) * SHM_K + kws + 32 * 256) = pack8(S.sf2, S.sf3); } while (0)
#define SWRITE_VF(bf) do { *(bf16x8*)(V_lds + (bf) * SHM_V + vst0) = pack8(S.sf0, S.sf1); *(bf16x8*)(V_lds + (bf) * SHM_V + vst1) = pack8(S.sf2, S.sf3); } while (0)
template <class TIn, class TOut, bool HALFQK>
__device__ __forceinline__ void causal_swa_prime(const BlockRef<TIn, TOut>& cur, int W, char* lds, Seam<TIn>& S) {
    constexpr bool F32 = same_t<TIn, float>::v;
    const int tid = otid_(), wid = __builtin_amdgcn_readfirstlane(tid >> 6), lane = tid & 63, r32 = lane & 31, hi = lane >> 5;
    const int sr = tid >> 4, sc = (tid & 15) * 8, kws = KSWZ(sr, sc * 2); char* K_lds = lds + 2 * SHM_V;
    const int kb0 = swa_jlo(cur.P0, W) * KVBLK;
    for (int d0 = 0; d0 < (HALFQK ? 4 : 8); ++d0) S.qr[d0] = load8<TIn>(cur.Q + (size_t)(wid * QBLK + r32) * QS + d0 * 16 + hi * 8);
    if constexpr (F32) { SLOAD_F((const float*)cur.K, kb0); VMW(); SWRITE_KF(0); SBAR(); SLOAD_F((const float*)cur.V, kb0); }
    else { SLOAD_H(cur.K, cur.V, kb0); VMW(); SWRITE_HK(0); }
    __syncthreads();
}
template <class TIn, class TOut, bool HALFQK, bool MASKED, int OS>
__device__ __forceinline__ void causal_swa_block(const BlockRef<TIn, TOut>& cur, const BlockRef<TIn, TOut>& nxt, int skv, int W, char* lds, Seam<TIn>& S) {
    constexpr bool F32 = same_t<TIn, float>::v;
    const int tid = otid_(), wid = __builtin_amdgcn_readfirstlane(tid >> 6), lane = tid & 63, r32 = lane & 31, hi = lane >> 5;
    const int j_lo = swa_jlo(cur.P0, W);
    int j_hi = (cur.P0 + QB - 1) / KVBLK + 1; if (j_hi > skv / KVBLK) j_hi = skv / KVBLK;
    const int NT = j_hi - j_lo;
    const int kbn = swa_jlo(nxt.P0, W) * KVBLK;
    const int qlo = cur.P0 + wid * QBLK, qm = qlo + r32 - 4 * hi;
    char* V_lds = lds; char* K_lds = lds + 2 * SHM_V;
    float* ws = (float*)(lds + 2 * SHM_V + 2 * SHM_K) + wid * 64; float* li_l = ws, * al_l = ws + 32;
    float m_reg = -1e30f, l_reg = 0; f32x16 o[4] = {};
    const int sr = tid >> 4, sc = (tid & 15) * 8, vst0 = v_st(sr, sc), vst1 = v_st(32 + sr, sc), kws = KSWZ(sr, sc * 2);
    const int vb0 = (int)(uintptr_t)V_lds + v_rd_base(lane);
    const TIn* Kh = cur.K; const TIn* Vh = cur.V;
#define RESC(a) do { if (__any((a) < 1.f)) { if (hi == 0) al_l[r32] = (a); asm volatile("s_waitcnt lgkmcnt(0)" ::: "memory");              \
                     for (int d_ = 0; d_ < 4; ++d_) for (int r = 0; r < 16; ++r) o[d_][r] *= al_l[crow(r, hi)]; } } while (0)
#define KBASE(t) ((j_lo + (t)) * KVBLK)
#define ACT(t) (KBASE(t) <= qlo + QBLK - 1 && KBASE(t) + KVBLK - 1 >= qlo - W + 1)
#define MASKT(P0_, P1_, t) do { if constexpr (MASKED) bitmask_tile(P0_, P1_, mw, hi);   \
        else { const int kb_ = KBASE(t); if ((!SK || ACT(t)) && (kb_ + KVBLK - 1 > qlo || kb_ <= qlo + QBLK - 1 - W)) mask_tile(P0_, P1_, qm - kb_, (unsigned)W); } } while (0)
    const unsigned moff = (unsigned)((wid * QBLK + r32) * 1024 + 8 * j_lo); u32x2 mw = {0u, 0u};
#define MLOAD(t) do { if constexpr (MASKED) mw = *(const u32x2*)((const char*)cur.mask + (moff + 8u * (unsigned)(t))); } while (0)
    constexpr int NQL = F32 ? 16 : (HALFQK ? 4 : 8);
    constexpr bool SK = WSKIP && !F32;
#define SEAM_K0() do { VMWN(NQL); if constexpr (F32) { SWRITE_KF(0); SBAR(); SLOAD_F((const float*)nxt.V, kbn); } else { SWRITE_HK(0); } SBAR(); } while (0)
    f32x16 pA0, pA1, pB0, pB1; float mnA, mnB, alA, alB; bf16x8 pa0, pa1, pa2, pa3;
    if constexpr (F32) { VMW(); SWRITE_VF(0); SBAR(); } else { SWRITE_HV(0); SBAR(); }
    if (NT > 1) { if constexpr (F32) SLOAD_F((const float*)Kh, KBASE(1)); else SLOAD_H(Kh, Vh, KBASE(1)); }
    SBAR(); qkt<0, SK, HALFQK>(pA0, pA1, K_lds, r32, hi, S.qr, ACT(0), cur.koff); MLOAD(0);
    if constexpr (F32) { if (NT > 1) { VMW(); SWRITE_KF(1); SBAR(); SLOAD_F((const float*)Vh, KBASE(1)); } }
    MASKT(pA0, pA1, 0); partialSM<HALFQK>(pA0, pA1, m_reg, mnA, alA);
    if (NT > 1) { VMW(); if constexpr (F32) { SWRITE_VF(1); SBAR(); if (NT > 2) SLOAD_F((const float*)Kh, KBASE(2)); } else SWRITE_H(1); }
    __syncthreads();
#define HALF_STEP(PX0, PX1, mnX, alX, PY0, PY1, alY, t, KB, VB, SB) do {                                                      \
        SBAR(); qkt<KB, SK, HALFQK>(PX0, PX1, K_lds, r32, hi, S.qr, ACT(t), cur.koff); MLOAD(t);                                             \
        finishSM(PY0, PY1, alY, l_reg, pa0, pa1, pa2, pa3); SBAR();                                                           \
        if ((t) + 1 < NT) { if constexpr (F32) { VMW(); SWRITE_KF(SB); SBAR(); SLOAD_F((const float*)Vh, KBASE((t) + 1)); }  \
                            else { SLOAD_H(Kh, Vh, KBASE((t) + 1)); } SBAR(); }                                               \
        pv_tile<VB, SK>(o, vb0, pa0, pa1, pa2, pa3, ACT((t) - 1)); MASKT(PX0, PX1, (t)); partialSM<HALFQK>(PX0, PX1, m_reg, mnX, alX);                                        \
        __syncthreads();                                                                                                      \
        if ((t) + 1 < NT) { VMW(); if constexpr (F32) { SWRITE_VF(SB); SBAR(); if ((t) + 2 < NT) SLOAD_F((const float*)Kh, KBASE((t) + 2)); } \
                            else { SWRITE_H(SB); } }                                                                          \
        RESC(alX); __syncthreads(); } while (0)
    for (int t = 1; t + 1 < NT; t += 2) {
        HALF_STEP(pB0, pB1, mnB, alB, pA0, pA1, alA, t, 1, 0, 0);
        HALF_STEP(pA0, pA1, mnA, alA, pB0, pB1, alB, t + 1, 0, 1, 1);
    }
    const bool even = (NT & 1) == 0;
    if (even) { SBAR(); qkt<1, SK, HALFQK>(pB0, pB1, K_lds, r32, hi, S.qr, ACT(NT - 1), cur.koff); MLOAD(NT - 1); SBAR(); }
#define QROW(e) (nxt.Q + (size_t)(wid * QBLK + r32) * QS + ((e) >> 1) * 16 + hi * 8 + ((e) & 1) * 4)
    if constexpr (F32) { SLOAD_F((const float*)nxt.K, kbn); SBAR();
#pragma unroll
        for (int e = 0; e < 8; ++e) S.tq[e] = *(const f32x4*)QROW(e); }
    else { SLOAD_H(nxt.K, nxt.V, kbn); SBAR();
#pragma unroll
        for (int d0 = 0; d0 < (HALFQK ? 4 : 8); ++d0) S.qr[d0] = load8<TIn>(nxt.Q + (size_t)(wid * QBLK + r32) * QS + d0 * 16 + hi * 8); }
    SBAR();
    finishSM(pA0, pA1, alA, l_reg, pa0, pa1, pa2, pa3); SBAR();
    if constexpr (F32) {
#pragma unroll
        for (int e = 8; e < 16; ++e) S.tq[e] = *(const f32x4*)QROW(e); SBAR(); }
#undef QROW
    pv_tile<0, SK>(o, vb0, pa0, pa1, pa2, pa3, ACT(even ? NT - 2 : NT - 1));
    if (even) { MASKT(pB0, pB1, NT - 1); partialSM<HALFQK>(pB0, pB1, m_reg, mnB, alB); __syncthreads(); RESC(alB);
        finishSM(pB0, pB1, alB, l_reg, pa0, pa1, pa2, pa3); SBAR(); pv_tile<1, SK>(o, vb0, pa0, pa1, pa2, pa3, ACT(NT - 1)); }
    SBAR(); SEAM_K0();
    if (hi == 0) li_l[r32] = l_reg; asm volatile("s_waitcnt lgkmcnt(0)" ::: "memory");
    float rli[16];
#pragma unroll
    for (int r = 0; r < 16; ++r) rli[r] = __builtin_amdgcn_rcpf(li_l[crow(r, hi)]);
    TOut* Ow = cur.O + (size_t)(wid * QBLK) * OS;
#pragma unroll
    for (int r = 0; r < 16; ++r) { const int orow = crow(r, hi);
#pragma unroll
        for (int d0 = 0; d0 < 4; ++d0) { const float v = o[d0][r] * rli[r];
            if constexpr (same_t<TOut, float>::v) { Ow[(size_t)orow * OS + d0 * 32 + r32] = v; }
            else { const float vn = __shfl_xor(v, 1);
                   if ((r32 & 1) == 0) *(unsigned*)(Ow + (size_t)orow * OS + d0 * 32 + r32) = cvtpk(v, vn); } } }
    if constexpr (F32) {
#pragma unroll
        for (int d0 = 0; d0 < 8; ++d0) S.qr[d0] = pack8(S.tq[2 * d0], S.tq[2 * d0 + 1]); }
    __syncthreads();
#undef RESC
#undef KBASE
#undef ACT
#undef MASKT
#undef MLOAD
#undef SEAM_K0
#undef HALF_STEP
}
#undef ROW
#undef VMW
#undef VMWN
#undef SLOAD_H
#undef SWRITE_HK
#undef SWRITE_HV
#undef SWRITE_H
#undef SLOAD_F
#undef SWRITE_KF
#undef SWRITE_VF
}
#ifndef PROBE
#define PROBE 0
#endif
constexpr int NWAVES = 8;
constexpr int NB = 2, T = 8192, M = NB * T, DM = 1024, FF = 2816, NIN = 8520, NLAYER = 2;
constexpr float NORM_EPS = 1e-6f;
constexpr size_t MiB = 1u << 20;
constexpr size_t WS_CTL = 0, CTL_ZERO_BYTES = 1 * MiB;
constexpr size_t WS_WF = 1 * MiB;
constexpr size_t WS_WF_DOWN = WS_WF + 11 * MiB;
constexpr size_t WS_WM = 18 * MiB;
constexpr size_t WS_WM_BR = WS_WM + 17 * MiB, WS_WM_OUT = WS_WM + 20 * MiB;
constexpr size_t WS_XN = 40 * MiB;
constexpr size_t WS_Q3 = 72 * MiB;
constexpr size_t WS_ZR = 120 * MiB;
constexpr size_t WS_R2 = 248 * MiB;
constexpr size_t WS_END = 280 * MiB;
constexpr size_t WS_MG = WS_ZR + 96 * MiB;
constexpr size_t WS_YRAW = WS_WF;
constexpr size_t WS_A8 = WS_WM;
constexpr size_t WS_KID = WS_WM + 8 * MiB;
constexpr size_t WS_RDOTK = WS_WF + 16 * MiB;
constexpr int QP = 1536, ZP = 4096;
constexpr int ZC_DK = 0, ZC_DV = 512, ZC_QI = 1024, ZC_KI = 1536, ZC_WI = 1600, ZC_RK = 1792, ZC_RV = 2304, ZC_WC = 2816, ZC_AC = 2880, ZC_GC = 2944, ZC_FK = 3072, ZC_FV = 3584;
constexpr int CW_TMO = 0;
constexpr int CW_BAR = 4096;
constexpr int CW_Q = 8192;
constexpr int CW_PROBE = 2048;
constexpr int CW_DONE = 12288;
constexpr int LDS_MISC = 160 * 1024 - 256;
constexpr int LDS_BYTES = 160 * 1024;

#define GAS __attribute__((address_space(1)))
#define LAS __attribute__((address_space(3)))
typedef unsigned short bf16;
typedef unsigned v4u __attribute__((ext_vector_type(4)));
typedef unsigned v2u __attribute__((ext_vector_type(2)));
typedef float f32x4 __attribute__((ext_vector_type(4)));
typedef float f32x2 __attribute__((ext_vector_type(2)));
typedef float f32x16 __attribute__((ext_vector_type(16)));
typedef short bf16x8 __attribute__((ext_vector_type(8)));
typedef GAS unsigned gu32;
#define RLX_AGENT __ATOMIC_RELAXED, __HIP_MEMORY_SCOPE_AGENT
#define LDS_WAIT() asm volatile("s_waitcnt lgkmcnt(0)" ::: "memory")
#define VM_WAIT() asm volatile("s_waitcnt vmcnt(0)" ::: "memory")
__device__ __forceinline__ unsigned f2bf(float f) { unsigned u = __builtin_bit_cast(unsigned, f); return (u + 0x7fffu + ((u >> 16) & 1u)) >> 16; }
__device__ __forceinline__ unsigned pk2(float lo, float hi) { return f2bf(lo) | (f2bf(hi) << 16); }
__device__ __forceinline__ float bflo(unsigned w) { return __uint_as_float(w << 16); }
__device__ __forceinline__ float bfhi(unsigned w) { return __uint_as_float(w & 0xffff0000u); }
__device__ __forceinline__ float bf1(bf16 h) { return __uint_as_float((unsigned)h << 16); }
__device__ __forceinline__ float wave_sum(float v) {
#pragma unroll
    for (int o = 1; o < 64; o <<= 1) v += __shfl_xor(v, o);
    return v;
}
__device__ __forceinline__ float sigm(float x) { return __builtin_amdgcn_rcpf(1.0f + __expf(-x)); }

#define XB_TMO      128
#define XB_XCNT(j)  (256  + 64 * (j))
#define XB_XSUB(j)  (1280 + 64 * (j))
#define XB_XGEN(j)  (2304 + 64 * (j))
#define XB_TOP      3328
#define XB_TOPGEN   3392
#define XCD_BAR_WORDS 3456
#define XB_SPIN_CAP (1u << 22)
__device__ __forceinline__ unsigned xb_ld(unsigned* p)              { return __hip_atomic_load(p, __ATOMIC_RELAXED, __HIP_MEMORY_SCOPE_AGENT); }
__device__ __forceinline__ unsigned xb_add(unsigned* p, unsigned v) { return __hip_atomic_fetch_add(p, v, __ATOMIC_RELAXED, __HIP_MEMORY_SCOPE_AGENT); }
__device__ __forceinline__ unsigned xb_xcc_id() { return (unsigned)__builtin_amdgcn_s_getreg((3 << 11) | 20) & 0xFu; }
#define XB_SPIN(cond, bar) do { unsigned _sp = 0; while (cond) { __builtin_amdgcn_s_sleep(1); \
    if ((++_sp & 255u) == 0u) { if (xb_ld(&(bar)[XB_TMO])) break; if (_sp > XB_SPIN_CAP) { atomicAdd(&(bar)[XB_TMO], 1u); break; } } } } while (0)
struct XcdBarrier { unsigned* bar; unsigned x; volatile LAS unsigned* st; };
__device__ __forceinline__ XcdBarrier xcd_barrier_post(unsigned* bar, volatile LAS unsigned* st) {
    XcdBarrier b; b.bar = bar; b.x = xb_xcc_id(); b.st = st;
    if (threadIdx.x == 0) (void)xb_add(&bar[XB_XCNT(b.x)], 1u);
    return b;
}
__device__ __forceinline__ void xcd_barrier_complete(unsigned* bar, unsigned x, unsigned& nloc, unsigned& nx) {
    const unsigned G = gridDim.x * gridDim.y * gridDim.z;
    unsigned sum, cnt, mine, sp = 0u;
    for (;;) {
        sum = 0u; cnt = 0u; mine = 0u;
#pragma unroll
        for (unsigned j = 0; j < 16; ++j) { const unsigned c = xb_ld(&bar[XB_XCNT(j)]); sum += c; cnt += (c > 0u) ? 1u : 0u; mine = (j == x) ? c : mine; }
        if (sum == G) break;
        __builtin_amdgcn_s_sleep(1);
        if ((++sp & 255u) == 0u) { if (xb_ld(&bar[XB_TMO])) break; if (sp > XB_SPIN_CAP) { atomicAdd(&bar[XB_TMO], 1u); break; } }
    }
    nloc = mine > 0u ? mine : 1u; nx = cnt > 0u ? cnt : 1u;
}
__device__ __forceinline__ void xcd_barrier(const XcdBarrier& b) {
    asm volatile("s_waitcnt vmcnt(0)" ::: "memory");
    __syncthreads();
    if (threadIdx.x == 0) {
        unsigned* bar = b.bar;
        __builtin_amdgcn_s_waitcnt(0);
        unsigned nloc = b.st[0], nx = b.st[1];
        if (nloc == 0u) { xcd_barrier_complete(bar, b.x, nloc, nx); b.st[0] = nloc; b.st[1] = nx; }
        const unsigned old = xb_add(&bar[XB_XSUB(b.x)], 1u);
        const unsigned gen = old / nloc;
        if (old + 1u == (gen + 1u) * nloc) {
            __builtin_amdgcn_fence(__ATOMIC_RELEASE, "agent");
            asm volatile("s_waitcnt vmcnt(0)" ::: "memory");
            const unsigned og = xb_add(&bar[XB_TOP], 1u);
            const unsigned tg = og / nx;
            if (og + 1u == (tg + 1u) * nx) xb_add(&bar[XB_TOPGEN], 1u);
            else XB_SPIN(xb_ld(&bar[XB_TOPGEN]) == tg, bar);
            __builtin_amdgcn_fence(__ATOMIC_ACQUIRE, "agent");
            xb_add(&bar[XB_XGEN(b.x)], 1u);
            asm volatile("s_waitcnt vmcnt(0)" ::: "memory");
        } else {
            XB_SPIN(xb_ld(&bar[XB_XGEN(b.x)]) == gen, bar);
            __builtin_amdgcn_fence(__ATOMIC_ACQUIRE, "agent");
            asm volatile("s_waitcnt vmcnt(0)" ::: "memory");
        }
    }
    __syncthreads();
}

struct MapIdent { const float* W; int ld; __device__ __forceinline__ const float* col(int n) const { return W + n; } };
struct MapUp {
    const float* G; const float* U; int ld;
    __device__ __forceinline__ const float* col(int n) const { const int g = n >> 5, j = n & 31; return j < 16 ? G + 16 * g + j : U + 16 * g + (j - 16); }
};
struct MapWin {
    const float* W; int ld;
    __device__ __forceinline__ const float* col(int n) const {
        int src;
        if (n < 512) src = n; else if (n < 1024) src = 2120 + (n - 512); else if (n < 1536) src = 3912 + (n - 1024);
        else if (n < 5632) { const int z = n - 1536; if (z < 1608) src = 512 + z; else if (z < 1792) src = -1; else if (z < 3072) src = 840 + z; else src = 1352 + z; }
        else src = 5448 + (n - 5632);
        return src < 0 ? nullptr : W + src;
    }
};
template <class Map>
__device__ __forceinline__ void conv_item(const Map& mp, int K, bf16* WT, LAS float* scr, int item, int nblk, int lane) {
    const int kb = item / nblk, nb = item % nblk, k0 = 32 * kb, n0 = 32 * nb;
    const float* cp = mp.col(n0 + (lane & 31)); const size_t ld = (size_t)mp.ld;
#pragma unroll
    for (int i = 0; i < 16; ++i) { const int kk = 2 * i + (lane >> 5); scr[kk * 33 + (lane & 31)] = cp ? cp[(size_t)(k0 + kk) * ld] : 0.f; }
    LDS_WAIT(); asm volatile("" ::: "memory");
    const int c = lane & 3;
#pragma unroll
    for (int j = 0; j < 2; ++j) { const int n = (lane >> 2) + 16 * j; const LAS float* s = scr + (8 * c) * 33 + n;
        v4u o; o.x = pg8::cvt_pk_bf16(s[0 * 33], s[1 * 33]); o.y = pg8::cvt_pk_bf16(s[2 * 33], s[3 * 33]); o.z = pg8::cvt_pk_bf16(s[4 * 33], s[5 * 33]); o.w = pg8::cvt_pk_bf16(s[6 * 33], s[7 * 33]);
        *(GAS v4u*)(WT + (size_t)(n0 + n) * K + k0 + 8 * c) = o; }
    LDS_WAIT(); asm volatile("" ::: "memory");
}
__host__ __device__ constexpr int conv_items(int K, int N) { return (K / 32) * (N / 32); }

template <bool INB, bool OUTB>
__device__ __forceinline__ void rownorm_rows(const void* base, const bf16* Y, float s, const float* gpost, void* out, const float* gnext, bf16* XN, int gw, int NGW, int lane, float oscale = 1.f) {
    for (int m = gw; m < M; m += NGW) {
        f32x4 v[4];
#pragma unroll
        for (int j = 0; j < 4; ++j) {
            if constexpr (INB) { const v2u w = ((const GAS v2u*)((const bf16*)base + (size_t)m * DM))[lane + 64 * j]; v[j] = (f32x4){bflo(w.x), bfhi(w.x), bflo(w.y), bfhi(w.y)}; }
            else v[j] = ((const GAS f32x4*)((const float*)base + (size_t)m * DM))[lane + 64 * j]; }
        if (Y) {
            f32x4 y[4]; float ss = 0.f;
#pragma unroll
            for (int j = 0; j < 4; ++j) { const v2u w = ((const GAS v2u*)(Y + (size_t)m * DM))[lane + 64 * j]; y[j] = (f32x4){bflo(w.x), bfhi(w.x), bflo(w.y), bfhi(w.y)};
                ss += (y[j].x * y[j].x + y[j].y * y[j].y) + (y[j].z * y[j].z + y[j].w * y[j].w); }
            const float r = s * __builtin_amdgcn_rsqf(wave_sum(ss) * (1.f / DM) + NORM_EPS);
#pragma unroll
            for (int j = 0; j < 4; ++j) { const f32x4 g = ((const GAS f32x4*)gpost)[lane + 64 * j]; v[j] = v[j] + y[j] * g * r;
                if constexpr (OUTB) { v2u w; w.x = pk2(v[j].x, v[j].y); w.y = pk2(v[j].z, v[j].w); ((GAS v2u*)((bf16*)out + (size_t)m * DM))[lane + 64 * j] = w; }
                else ((GAS f32x4*)((float*)out + (size_t)m * DM))[lane + 64 * j] = v[j] * oscale; }
        }
        if (XN) {
            float ss = 0.f;
#pragma unroll
            for (int j = 0; j < 4; ++j) ss += (v[j].x * v[j].x + v[j].y * v[j].y) + (v[j].z * v[j].z + v[j].w * v[j].w);
            const float r = __builtin_amdgcn_rsqf(wave_sum(ss) * (1.f / DM) + NORM_EPS);
#pragma unroll
            for (int j = 0; j < 4; ++j) { const f32x4 g = ((const GAS f32x4*)gnext)[lane + 64 * j]; const f32x4 o = v[j] * g * r;
                v2u w; w.x = pk2(o.x, o.y); w.y = pk2(o.z, o.w); ((GAS v2u*)(XN + (size_t)m * DM))[lane + 64 * j] = w; }
        }
    }
}

namespace scan {
template <int CTRL> __device__ __forceinline__ float dpp_add(float x) {
    const int y = __builtin_amdgcn_update_dpp(0, __builtin_bit_cast(int, x), CTRL, 0xF, 0xF, false);
    return x + __builtin_bit_cast(float, y);
}
__device__ __forceinline__ float red8(float x) { x = dpp_add<0xB1>(x); x = dpp_add<0x4E>(x); x = dpp_add<0x141>(x); return x; }
__device__ __forceinline__ float red16(float x) { x = dpp_add<0xB1>(x); x = dpp_add<0x4E>(x); x = dpp_add<0x141>(x); x = dpp_add<0x140>(x); return x; }
__device__ __forceinline__ void ld8(const bf16* p, float (&o)[8]) { const v4u w = *(const GAS v4u*)p; o[0] = bflo(w.x); o[1] = bfhi(w.x); o[2] = bflo(w.y); o[3] = bfhi(w.y); o[4] = bflo(w.z); o[5] = bfhi(w.z); o[6] = bflo(w.w); o[7] = bfhi(w.w); }
}
struct PrepP { const bf16* ZR; bf16* X1; unsigned char* A8; bf16* KI; const float *mu, *w0, *wup, *a0, *aup; };
__device__ __forceinline__ void rwkv_prep(const PrepP& P, LAS unsigned char* lds) {
    const int tid = otid_(), lane = tid & 63, h = __builtin_amdgcn_readfirstlane(tid >> 6), c16 = lane & 15, quad = lane >> 4;
    constexpr int SP = 144;
    LAS unsigned char* TA = lds; LAS unsigned char* AA = lds + 64 * SP;
    bf16x8 bw[4][2], ba[4][2];
#pragma unroll
    for (int ct = 0; ct < 4; ++ct)
#pragma unroll
        for (int s = 0; s < 2; ++s) { const size_t o = (size_t)(32 * s + 8 * quad) * 512 + 64 * h + 16 * ct + c16; const float* gw_ = P.wup + o; const float* ga_ = P.aup + o;
            v4u w; w.x = pk2(gw_[0], gw_[512]); w.y = pk2(gw_[1024], gw_[1536]); w.z = pk2(gw_[2048], gw_[2560]); w.w = pk2(gw_[3072], gw_[3584]); bw[ct][s] = __builtin_bit_cast(bf16x8, w);
            v4u a; a.x = pk2(ga_[0], ga_[512]); a.y = pk2(ga_[1024], ga_[1536]); a.z = pk2(ga_[2048], ga_[2560]); a.w = pk2(ga_[3072], ga_[3584]); ba[ct][s] = __builtin_bit_cast(bf16x8, a); }
    float w0v[4], a0v[4];
#pragma unroll
    for (int ct = 0; ct < 4; ++ct) { w0v[ct] = P.w0[64 * h + 16 * ct + c16]; a0v[ct] = P.a0[64 * h + 16 * ct + c16]; }
    const int stok = tid >> 3, sseg = tid & 7;
#pragma unroll 1
    for (int m0 = blockIdx.x * 64; m0 < M; m0 += gridDim.x * 64) {
        {   const size_t m = (size_t)m0 + stok; const int t = (int)(m & (T - 1));
            *(GAS v4u*)(P.KI + m * 64 + 8 * sseg) = *(const GAS v4u*)(P.ZR + m * ZP + ZC_KI + 8 * sseg);
            float wc[8], ac[8], p8[8];
            scan::ld8(P.ZR + m * ZP + ZC_WC + 8 * sseg, wc); scan::ld8(P.ZR + m * ZP + ZC_AC + 8 * sseg, ac);
            if (t > 0) { scan::ld8(P.ZR + (m - 1) * ZP + ZC_WC + 8 * sseg, p8);
#pragma unroll
                for (int e = 0; e < 8; ++e) wc[e] += (p8[e] - wc[e]) * P.mu[1536 + 8 * sseg + e];
                scan::ld8(P.ZR + (m - 1) * ZP + ZC_AC + 8 * sseg, p8);
#pragma unroll
                for (int e = 0; e < 8; ++e) ac[e] += (p8[e] - ac[e]) * P.mu[1600 + 8 * sseg + e]; }
            else {
#pragma unroll
                for (int e = 0; e < 8; ++e) { wc[e] -= wc[e] * P.mu[1536 + 8 * sseg + e]; ac[e] -= ac[e] * P.mu[1600 + 8 * sseg + e]; } }
            float th[8];
#pragma unroll
            for (int e = 0; e < 8; ++e) th[e] = 1.f - 2.f * __builtin_amdgcn_rcpf(__expf(2.f * wc[e]) + 1.f);
            v4u o; o.x = pk2(th[0], th[1]); o.y = pk2(th[2], th[3]); o.z = pk2(th[4], th[5]); o.w = pk2(th[6], th[7]); *(LAS v4u*)(TA + stok * SP + 16 * sseg) = o;
            v4u q; q.x = pk2(ac[0], ac[1]); q.y = pk2(ac[2], ac[3]); q.z = pk2(ac[4], ac[5]); q.w = pk2(ac[6], ac[7]); *(LAS v4u*)(AA + stok * SP + 16 * sseg) = q;
        }
        __syncthreads();
#pragma unroll 1
        for (int rt = 0; rt < 4; ++rt) {
            f32x4 accw[4], acca[4];
#pragma unroll
            for (int ct = 0; ct < 4; ++ct) { accw[ct] = (f32x4){0.f, 0.f, 0.f, 0.f}; acca[ct] = (f32x4){0.f, 0.f, 0.f, 0.f}; }
#pragma unroll
            for (int s = 0; s < 2; ++s) { const bf16x8 fw = *(const LAS bf16x8*)(TA + (16 * rt + c16) * SP + (32 * s + 8 * quad) * 2), fa = *(const LAS bf16x8*)(AA + (16 * rt + c16) * SP + (32 * s + 8 * quad) * 2);
#pragma unroll
                for (int ct = 0; ct < 4; ++ct) { accw[ct] = __builtin_amdgcn_mfma_f32_16x16x32_bf16(fw, bw[ct][s], accw[ct], 0, 0, 0); acca[ct] = __builtin_amdgcn_mfma_f32_16x16x32_bf16(fa, ba[ct][s], acca[ct], 0, 0, 0); } }
#pragma unroll
            for (int j = 0; j < 4; ++j) { const size_t m = (size_t)m0 + 16 * rt + 4 * quad + j;
#pragma unroll
                for (int ct = 0; ct < 4; ++ct) { const int ch = 64 * h + 16 * ct + c16;
                    const float sg = sigm(w0v[ct] + accw[ct][j]);
                    const float x1 = 1.f - __expf(-0.6065306597126334f * sg);
                    const float a = sigm(a0v[ct] + acca[ct][j]);
                    P.X1[m * 512 + ch] = (bf16)f2bf(x1);
                    P.A8[m * 512 + ch] = (unsigned char)(int)(a * 255.f + 0.5f); } }
        }
        __syncthreads();
    }
}

struct ScanP { const bf16* Q3; const bf16* ZR; const bf16* X1; const unsigned char* A8; bf16* yraw; float* rdotk; const float *mu, *k_k, *k_a, *r_k; };
namespace scan {
constexpr int TB = 32, NBLK = T / TB;
constexpr int CB_W = 0, CB_B = 8192, CB_K = 16384, CB_KW = 24576, CB_V = 40960, CB_BR = 43008, CB_KR = 43136, CB_SA = 43264, CB_YP = 45312, CBSZ = 78080;
constexpr int L_END = 2 * CBSZ;
static_assert(L_END <= LDS_MISC, "scan LDS");
}
__device__ __forceinline__ void rwkv_scan_unit(const ScanP& P, int unit, LAS unsigned char* lds) {
    using namespace scan;
    const int tid = otid_(), wid = __builtin_amdgcn_readfirstlane(tid >> 6), lane = tid & 63;
    const int b = unit >> 5, h = (unit >> 2) & 7, vq = unit & 3;
    const size_t mrow0 = (size_t)b * T;
    if (wid >= 4) {
        const int pw = wid - 4, tokl = lane >> 3, seg = lane & 7, c0 = 8 * seg, hc0 = 64 * h + c0;
        float mu_r[8], mu_k[8], kkv[8], kav[8], rkv[8];
#pragma unroll
        for (int e = 0; e < 8; ++e) { mu_r[e] = P.mu[hc0 + e]; mu_k[e] = P.mu[512 + hc0 + e]; kkv[e] = P.k_k[hc0 + e]; kav[e] = P.k_a[hc0 + e]; rkv[e] = P.r_k[hc0 + e]; }
        const int vc0 = 64 * h + 16 * vq + 2 * seg;
        const float mu_v0 = P.mu[1024 + vc0], mu_v1 = P.mu[1024 + vc0 + 1];
        const int ptid = pw * 64 + lane;
        v4u nr, nrp, nk, nkp, nx; v2u na; unsigned nv, nvp;
#define SCAN_LOAD(nb_) do { const int t_ = (nb_) * TB + 8 * pw + tokl; const size_t m_ = mrow0 + t_, mp_ = t_ > 0 ? m_ - 1 : m_; \
            nr = *(const GAS v4u*)(P.Q3 + m_ * QP + 512 + hc0); nrp = *(const GAS v4u*)(P.Q3 + mp_ * QP + 512 + hc0); \
            nk = *(const GAS v4u*)(P.ZR + m_ * ZP + ZC_RK + hc0); nkp = *(const GAS v4u*)(P.ZR + mp_ * ZP + ZC_RK + hc0); \
            nx = *(const GAS v4u*)(P.X1 + m_ * 512 + hc0); na = *(const GAS v2u*)(P.A8 + m_ * 512 + hc0); \
            nv = *(const GAS unsigned*)(P.ZR + m_ * ZP + ZC_RV + vc0); nvp = *(const GAS unsigned*)(P.ZR + mp_ * ZP + ZC_RV + vc0); } while (0)
#define UNPK8(w_, o_) do { o_[0] = bflo(w_.x); o_[1] = bfhi(w_.x); o_[2] = bflo(w_.y); o_[3] = bfhi(w_.y); o_[4] = bflo(w_.z); o_[5] = bfhi(w_.z); o_[6] = bflo(w_.w); o_[7] = bfhi(w_.w); } while (0)
        SCAN_LOAD(0);
        for (int blk = -1; blk < NBLK; ++blk) {
            const int nb = blk + 1;
            LAS unsigned char* cb = lds + (nb & 1) * CBSZ;
            if (blk >= 1) {
                const int tok = ptid >> 3, v2 = (ptid & 7) * 2;
                const LAS float* YPp = (const LAS float*)(cb + CB_YP) + (tok * 16 + v2) * 16;
                float y0 = 0.f, y1 = 0.f;
#pragma unroll
                for (int q4 = 0; q4 < 4; ++q4) { const f32x4 a = *(const LAS f32x4*)(YPp + 4 * q4), c = *(const LAS f32x4*)(YPp + 16 + 4 * q4); y0 += (a.x + a.y) + (a.z + a.w); y1 += (c.x + c.y) + (c.z + c.w); }
                const float kr = *(const LAS float*)(cb + CB_KR + tok * 4);
                const f32x2 vv = *(const LAS f32x2*)(cb + CB_V + (tok * 16 + v2) * 4);
                y0 += vv.x * kr; y1 += vv.y * kr;
                const size_t m = mrow0 + (size_t)(blk - 1) * TB + tok;
                *(GAS unsigned*)(P.yraw + m * 512 + 64 * h + 16 * vq + v2) = pk2(y0, y1);
                LDS_WAIT(); asm volatile("" ::: "memory");
            }
            if (nb < NBLK) {
                const int t = nb * TB + 8 * pw + tokl; const size_t m = mrow0 + t;
                float r8[8], k8[8], p8[8], x8[8], a8[8];
                const v4u cr = nr, crp = nrp, ck = nk, ckp = nkp, cx = nx; const v2u ca = na; const unsigned cv = nv, cvp = nvp;
                if (nb + 1 < NBLK) SCAN_LOAD(nb + 1);
                UNPK8(cr, r8); UNPK8(ck, k8); UNPK8(cx, x8);
                { const float sc = 1.f / 255.f;
                  a8[0] = (float)(ca.x & 255u) * sc; a8[1] = (float)((ca.x >> 8) & 255u) * sc; a8[2] = (float)((ca.x >> 16) & 255u) * sc; a8[3] = (float)(ca.x >> 24) * sc;
                  a8[4] = (float)(ca.y & 255u) * sc; a8[5] = (float)((ca.y >> 8) & 255u) * sc; a8[6] = (float)((ca.y >> 16) & 255u) * sc; a8[7] = (float)(ca.y >> 24) * sc; }
                float v0 = bflo(cv), v1 = bfhi(cv);
                if (t > 0) {
                    UNPK8(crp, p8);
#pragma unroll
                    for (int e = 0; e < 8; ++e) r8[e] += (p8[e] - r8[e]) * mu_r[e];
                    UNPK8(ckp, p8);
#pragma unroll
                    for (int e = 0; e < 8; ++e) k8[e] += (p8[e] - k8[e]) * mu_k[e];
                    v0 += (bflo(cvp) - v0) * mu_v0; v1 += (bfhi(cvp) - v1) * mu_v1;
                } else {
#pragma unroll
                    for (int e = 0; e < 8; ++e) { r8[e] -= r8[e] * mu_r[e]; k8[e] -= k8[e] * mu_k[e]; }
                    v0 -= v0 * mu_v0; v1 -= v1 * mu_v1;
                }
                float kk8[8]; { float ss = 0.f;
#pragma unroll
                  for (int e = 0; e < 8; ++e) { kk8[e] = k8[e] * kkv[e]; ss += kk8[e] * kk8[e]; }
                  ss = red8(ss); const float inv = 1.f / fmaxf(sqrtf(ss), 1e-12f);
#pragma unroll
                  for (int e = 0; e < 8; ++e) kk8[e] *= inv; }
                float w8[8], bb[8], km[8], wr[8]; float brp = 0.f, krp = 0.f, rkp = 0.f;
#pragma unroll
                for (int e = 0; e < 8; ++e) {
                    w8[e] = 1.f - x8[e];
                    bb[e] = kk8[e] * a8[e]; km[e] = k8[e] * (1.f + (a8[e] - 1.f) * kav[e]);
                    brp += bb[e] * r8[e]; krp += km[e] * r8[e]; rkp += r8[e] * km[e] * rkv[e];
                }
                brp = red8(brp); krp = red8(krp); rkp = red8(rkp);
#pragma unroll
                for (int e = 0; e < 8; ++e) wr[e] = w8[e] * r8[e] - kk8[e] * brp;
                const int ti = 8 * pw + tokl;
                *(LAS f32x4*)(cb + CB_W + (ti * 64 + c0) * 4) = (f32x4){w8[0], w8[1], w8[2], w8[3]}; *(LAS f32x4*)(cb + CB_W + (ti * 64 + c0 + 4) * 4) = (f32x4){w8[4], w8[5], w8[6], w8[7]};
                *(LAS f32x4*)(cb + CB_B + (ti * 64 + c0) * 4) = (f32x4){bb[0], bb[1], bb[2], bb[3]}; *(LAS f32x4*)(cb + CB_B + (ti * 64 + c0 + 4) * 4) = (f32x4){bb[4], bb[5], bb[6], bb[7]};
                *(LAS f32x4*)(cb + CB_K + (ti * 64 + c0) * 4) = (f32x4){km[0], km[1], km[2], km[3]}; *(LAS f32x4*)(cb + CB_K + (ti * 64 + c0 + 4) * 4) = (f32x4){km[4], km[5], km[6], km[7]};
#pragma unroll
                for (int e = 0; e < 8; e += 2) *(LAS f32x4*)(cb + CB_KW + ti * 512 + ((e >> 1) & 1) * 256 + (2 * seg + (e >> 2)) * 16) = (f32x4){kk8[e], wr[e], kk8[e + 1], wr[e + 1]};
                *(LAS f32x2*)(cb + CB_V + (ti * 16 + 2 * seg) * 4) = (f32x2){v0, v1};
                if (seg == 0) { *(LAS float*)(cb + CB_KR + ti * 4) = krp; if (vq == 0) P.rdotk[m * 8 + h] = rkp; }
            }
            __syncthreads();
        }
        { const LAS unsigned char* cb = lds + ((NBLK - 1) & 1) * CBSZ;
          const int tok = ptid >> 3, v2 = (ptid & 7) * 2;
          const LAS float* YPp = (const LAS float*)(cb + CB_YP) + (tok * 16 + v2) * 16;
          float y0 = 0.f, y1 = 0.f;
#pragma unroll
          for (int q4 = 0; q4 < 4; ++q4) { const f32x4 a = *(const LAS f32x4*)(YPp + 4 * q4), c = *(const LAS f32x4*)(YPp + 16 + 4 * q4); y0 += (a.x + a.y) + (a.z + a.w); y1 += (c.x + c.y) + (c.z + c.w); }
          const float kr = *(const LAS float*)(cb + CB_KR + tok * 4);
          const f32x2 vv = *(const LAS f32x2*)(cb + CB_V + (tok * 16 + v2) * 4);
          y0 += vv.x * kr; y1 += vv.y * kr;
          const size_t m = mrow0 + (size_t)(NBLK - 1) * TB + tok;
          *(GAS unsigned*)(P.yraw + m * 512 + 64 * h + 16 * vq + v2) = pk2(y0, y1); }
    } else {
        const int vi = 4 * wid + (lane >> 4), cg = lane & 15;
        f32x2 s01 = {0.f, 0.f}, s23 = {0.f, 0.f};
        __syncthreads();
        __builtin_amdgcn_s_setprio(3);
        const unsigned lo4 = (unsigned)(4 * cg) * 4u;
        for (int blk = 0; blk < NBLK; ++blk) {
            const LAS unsigned char* cb = lds + (blk & 1) * CBSZ;
            f32x4 kwa = *(const LAS f32x4*)(cb + CB_KW + lo4), kwb = *(const LAS f32x4*)(cb + CB_KW + 256 + lo4);
            f32x4 w4 = *(const LAS f32x4*)(cb + CB_W + lo4), b4 = *(const LAS f32x4*)(cb + CB_B + lo4), k4 = *(const LAS f32x4*)(cb + CB_K + lo4);
            float vv = *(const LAS float*)(cb + CB_V + vi * 4);
#pragma unroll 4
            for (int tok = 0; tok < TB; ++tok) {
                const int tn = tok + 1 < TB ? tok + 1 : tok;
                const f32x4 nkwa = *(const LAS f32x4*)(cb + CB_KW + tn * 512 + lo4), nkwb = *(const LAS f32x4*)(cb + CB_KW + tn * 512 + 256 + lo4);
                const f32x4 nw4 = *(const LAS f32x4*)(cb + CB_W + tn * 256 + lo4), nb4 = *(const LAS f32x4*)(cb + CB_B + tn * 256 + lo4), nk4 = *(const LAS f32x4*)(cb + CB_K + tn * 256 + lo4);
                const float nvv = *(const LAS float*)(cb + CB_V + (tn * 16 + vi) * 4);
                f32x2 p = (f32x2){s01.x, s01.x} * (f32x2){kwa.x, kwa.y};
                p += (f32x2){s01.y, s01.y} * (f32x2){kwa.z, kwa.w};
                p += (f32x2){s23.x, s23.x} * (f32x2){kwb.x, kwb.y};
                p += (f32x2){s23.y, s23.y} * (f32x2){kwb.z, kwb.w};
                *(LAS float*)(cb + CB_YP + ((tok * 16 + vi) * 16 + cg) * 4) = p.y;
                const f32x2 t01 = s01 * (f32x2){w4.x, w4.y} + (f32x2){k4.x, k4.y} * vv, t23 = s23 * (f32x2){w4.z, w4.w} + (f32x2){k4.z, k4.w} * vv;
                const float d1 = red16(p.x);
                s01 = t01 - (f32x2){b4.x, b4.y} * d1; s23 = t23 - (f32x2){b4.z, b4.w} * d1;
                kwa = nkwa; kwb = nkwb; w4 = nw4; b4 = nb4; k4 = nk4; vv = nvv;
            }
            __syncthreads();
        }
        __builtin_amdgcn_s_setprio(0);
    }
    __syncthreads();
}

struct Dsa1P { const bf16* ZR; const bf16* KI; unsigned* bitm; gu32* done; };
namespace dsa1 {
constexpr int CAP = 769  , PRUNE_AT = 512, KEEP = 256;
constexpr int L_BUF = 0, L_CNT = 32 * CAP * 4, L_THR = L_CNT + 128, L_THRK = L_THR + 128, L_HIST = ((L_THRK + 128 + 15) / 16) * 16, L_MROW = L_HIST + 8 * 1024, L_QF = L_MROW + 8 * 1024, QFP = 1040, L_END = L_QF + 32 * QFP;
static_assert(L_END <= LDS_MISC, "dsa1 LDS");
__device__ __forceinline__ unsigned packkey(float s, int keyidx) { const unsigned bits = __float_as_uint(s); const unsigned u = bits ^ ((unsigned)((int)bits >> 31) | 0x80000000u); return (u & 0xFFFFE000u) | (unsigned)(8191 - keyidx); }
__device__ __forceinline__ float thr_of(unsigned key) { const unsigned u = key & 0xFFFFE000u; const unsigned bits = (u & 0x80000000u) ? (u ^ 0x80000000u) : ~u; return __uint_as_float(bits); }
__device__ __forceinline__ int wave_prefix_incl(int v) {
    v += __builtin_amdgcn_update_dpp(0, v, 0x111, 0xF, 0xF, true);
    v += __builtin_amdgcn_update_dpp(0, v, 0x112, 0xF, 0xF, true);
    v += __builtin_amdgcn_update_dpp(0, v, 0x114, 0xF, 0xF, true);
    v += __builtin_amdgcn_update_dpp(0, v, 0x118, 0xF, 0xF, true);
    v += __builtin_amdgcn_update_dpp(0, v, 0x142, 0xA, 0xF, false);
    v += __builtin_amdgcn_update_dpp(0, v, 0x143, 0xC, 0xF, false);
    return v;
}
__device__ __forceinline__ void prune(LAS unsigned char* lds, int qq, int wid, int lane, bool exact) {
    asm volatile("" : "+v"(lane));
    LAS unsigned* buf = (LAS unsigned*)(lds + L_BUF) + qq * CAP; LAS unsigned* cnt = (LAS unsigned*)(lds + L_CNT); LAS float* thr = (LAS float*)(lds + L_THR); LAS unsigned* thrk = (LAS unsigned*)(lds + L_THRK);
    LAS unsigned* hist = (LAS unsigned*)(lds + L_HIST) + wid * 256;
    const int n = (int)cnt[qq];
    unsigned e[12];
#pragma unroll
    for (int k = 0; k < 12; ++k) e[k] = (lane + 64 * k < n) ? buf[lane + 64 * k] : 0u;
    const unsigned tk = thrk[qq];
    unsigned cut = 0u; bool have = false;
    if (!exact && tk != 0u) {
        const unsigned base16 = tk >> 16;
        *(LAS v4u*)(hist + 4 * lane) = (v4u){0u, 0u, 0u, 0u};
        LDS_WAIT(); asm volatile("" ::: "memory");
#pragma unroll
        for (int k = 0; k < 12; ++k) if (lane + 64 * k < n) { unsigned bn = (e[k] >> 16) - base16; bn = bn > 255u ? 255u : bn; (void)__hip_atomic_fetch_add(hist + bn, 1u, __ATOMIC_RELAXED, __HIP_MEMORY_SCOPE_WORKGROUP); }
        LDS_WAIT(); asm volatile("" ::: "memory");
        const int rl = 63 - lane;
        const v4u hv = *(const LAS v4u*)(hist + 4 * rl);
        const int tot = (int)(hv.x + hv.y + hv.z + hv.w);
        int above = wave_prefix_incl(tot) - tot; int dsel = -1, csel = 0;
        { const int h3 = (int)hv.w, h2 = (int)hv.z, h1 = (int)hv.y, h0 = (int)hv.x;
          if (above < KEEP && KEEP <= above + h3) { dsel = 4 * rl + 3; csel = above + h3; } above += h3;
          if (above < KEEP && KEEP <= above + h2) { dsel = 4 * rl + 2; csel = above + h2; } above += h2;
          if (above < KEEP && KEEP <= above + h1) { dsel = 4 * rl + 1; csel = above + h1; } above += h1;
          if (above < KEEP && KEEP <= above + h0) { dsel = 4 * rl + 0; csel = above + h0; } }
        const unsigned long long bm = __ballot(dsel >= 0);
        const int src = bm ? (int)__builtin_ctzll(bm) : 0;
        const int d = __builtin_amdgcn_readlane(dsel, src), cd = __builtin_amdgcn_readlane(csel, src);
        LDS_WAIT(); asm volatile("" ::: "memory");
        if (bm != 0ull && cd <= KEEP + 128) { cut = (base16 + (unsigned)d) << 16; have = true; }
    }
    if (!have) {
        unsigned prefix = 0u; int want = KEEP;
#pragma unroll 1
        for (int p = 0; p < 4; ++p) {
            const int shift = 24 - 8 * p;
            *(LAS v4u*)(hist + 4 * lane) = (v4u){0u, 0u, 0u, 0u};
            LDS_WAIT(); asm volatile("" ::: "memory");
#pragma unroll
            for (int k = 0; k < 12; ++k) { const bool in = (lane + 64 * k < n) && (p == 0 || (e[k] >> (shift + 8)) == (prefix >> (shift + 8)));
                if (in) (void)__hip_atomic_fetch_add(hist + ((e[k] >> shift) & 255u), 1u, __ATOMIC_RELAXED, __HIP_MEMORY_SCOPE_WORKGROUP); }
            LDS_WAIT(); asm volatile("" ::: "memory");
            const int rl = 63 - lane;
            const v4u hv = *(const LAS v4u*)(hist + 4 * rl);
            const int tot = (int)(hv.x + hv.y + hv.z + hv.w);
            int above = wave_prefix_incl(tot) - tot;
            int dsel = -1, asel = 0;
            { const int h3 = (int)hv.w, h2 = (int)hv.z, h1 = (int)hv.y, h0 = (int)hv.x;
              if (above < want && want <= above + h3) { dsel = 4 * rl + 3; asel = above; } above += h3;
              if (above < want && want <= above + h2) { dsel = 4 * rl + 2; asel = above; } above += h2;
              if (above < want && want <= above + h1) { dsel = 4 * rl + 1; asel = above; } above += h1;
              if (above < want && want <= above + h0) { dsel = 4 * rl + 0; asel = above; } }
            const unsigned long long bm = __ballot(dsel >= 0);
            const int src = bm ? (int)__builtin_ctzll(bm) : 0;
            const int d = __builtin_amdgcn_readlane(dsel, src), ab = __builtin_amdgcn_readlane(asel, src);
            prefix |= ((unsigned)(d < 0 ? 0 : d)) << shift; want -= ab;
            LDS_WAIT(); asm volatile("" ::: "memory");
        }
        cut = prefix;
    }
    int base = 0;
#pragma unroll
    for (int k = 0; k < 12; ++k) { const bool keep = (lane + 64 * k < n) && e[k] >= cut; const unsigned long long mk = __ballot(keep);
        const int pos = base + (int)__builtin_amdgcn_mbcnt_hi((unsigned)(mk >> 32), __builtin_amdgcn_mbcnt_lo((unsigned)mk, 0u));
        if (keep) buf[pos] = e[k]; base += (int)__builtin_popcountll(mk); }
    if (lane == 0) { cnt[qq] = (unsigned)base; thr[qq] = thr_of(cut); thrk[qq] = cut; }
    LDS_WAIT(); asm volatile("" ::: "memory");
}
}
__device__ __forceinline__ void dsa1_unit(const Dsa1P& P, int u, LAS unsigned char* lds) {
    using namespace dsa1;
    const int tid = otid_(), wid = __builtin_amdgcn_readfirstlane(tid >> 6), lane = tid & 63, q = lane & 31, hi = lane >> 5;
    const int b = u & 1, qb32 = 255 - (u >> 1), t0 = 32 * qb32;
    const size_t brow = (size_t)b * T;
    LAS unsigned* buf = (LAS unsigned*)(lds + L_BUF); LAS unsigned* cnt = (LAS unsigned*)(lds + L_CNT); LAS float* thr = (LAS float*)(lds + L_THR);
    if (tid < 32) { cnt[tid] = 0u; thr[tid] = -__builtin_inff(); ((LAS unsigned*)(lds + L_THRK))[tid] = 0u; }
    const bf16* qrow = P.ZR + (brow + t0 + q) * ZP;
    { const int r = tid >> 4, sg = tid & 15; const bf16* src = P.ZR + (brow + t0 + r) * ZP + ZC_QI + 32 * sg;
#pragma unroll
      for (int j = 0; j < 4; ++j) *(LAS v4u*)(lds + L_QF + r * QFP + 64 * sg + 16 * j) = *(const GAS v4u*)(src + 8 * j); }
    float wq[8];
    { const v4u w = *(const GAS v4u*)(qrow + ZC_WI); const float c = 0.35355339059327373f * 0.125f;
      wq[0] = bflo(w.x) * c; wq[1] = bfhi(w.x) * c; wq[2] = bflo(w.y) * c; wq[3] = bfhi(w.y) * c; wq[4] = bflo(w.z) * c; wq[5] = bfhi(w.z) * c; wq[6] = bflo(w.w) * c; wq[7] = bfhi(w.w) * c; }
    const int tq = t0 + q;
    const int nsteps = (t0 + 32 + 255) >> 8;
    __syncthreads();
    float th = -__builtin_inff();
    bf16x8 afn[4];
    { const int k0 = 32 * wid; const bf16* krow = P.KI + (brow + (k0 <= t0 + 31 ? k0 : 0) + q) * 64 + 8 * hi;
#pragma unroll
      for (int s = 0; s < 4; ++s) afn[s] = *(const GAS bf16x8*)(krow + 16 * s); }
    for (int st = 0; st < nsteps; ++st) {
        const int key0 = 256 * st + 32 * wid;
        bf16x8 af[4];
#pragma unroll
        for (int s = 0; s < 4; ++s) af[s] = afn[s];
        { const int k1 = key0 + 256; const bf16* krow = P.KI + (brow + (k1 <= t0 + 31 ? k1 : 0) + q) * 64 + 8 * hi;
#pragma unroll
          for (int s = 0; s < 4; ++s) afn[s] = *(const GAS bf16x8*)(krow + 16 * s); }
        if (key0 <= t0 + 31) {
            f32x16 sc;
#pragma unroll
            for (int i = 0; i < 16; ++i) sc[i] = 0.f;
            unsigned qfo = (unsigned)(L_QF + q * QFP + 16 * hi); asm volatile("" : "+v"(qfo));
#pragma unroll
            for (int hd = 0; hd < 8; ++hd) {
                f32x16 acc;
#pragma unroll
                for (int i = 0; i < 16; ++i) acc[i] = 0.f;
#pragma unroll
                for (int s = 0; s < 4; ++s) { const bf16x8 qb = *(const LAS bf16x8*)(lds + qfo + hd * 128 + 32 * s);
                    acc = __builtin_amdgcn_mfma_f32_32x32x16_bf16(af[s], qb, acc, 0, 0, 0); }
#pragma unroll
                for (int i = 0; i < 16; ++i) sc[i] = fmaf(fmaxf(acc[i], 0.f), wq[hd], sc[i]);
                __builtin_amdgcn_sched_barrier(0);
            }
            const bool diag = key0 + 31 > t0;
            unsigned pm = 0u;
#pragma unroll
            for (int i = 0; i < 16; ++i) { const int kidx = key0 + (i & 3) + 8 * (i >> 2) + 4 * hi; const bool ok = (sc[i] >= th) && (!diag || kidx <= tq); pm |= ok ? (1u << i) : 0u; }
            const int np = __builtin_popcount(pm);
            if (np > 0) {
                int pos = (int)__hip_atomic_fetch_add(cnt + q, (unsigned)np, __ATOMIC_RELAXED, __HIP_MEMORY_SCOPE_WORKGROUP);
                LAS unsigned* bq = buf + q * CAP;
#pragma unroll
                for (int i = 0; i < 16; ++i) if (pm & (1u << i)) { const int kidx = key0 + (i & 3) + 8 * (i >> 2) + 4 * hi; bq[pos] = packkey(sc[i], kidx); ++pos; }
            }
        }
        __syncthreads();
        { unsigned nm = (unsigned)__ballot(cnt[q] > (unsigned)PRUNE_AT); int i = 0;
          while (nm) { const int qq = __builtin_ctz(nm); nm &= nm - 1u; if ((i & 7) == wid) prune(lds, qq, wid, lane, false); ++i; } }
        __syncthreads();
        th = thr[q];
    }
    LAS unsigned* mrow = (LAS unsigned*)(lds + L_MROW) + wid * 256;
#pragma unroll 1
    for (int k = 0; k < 4; ++k) {
        const int qq = wid + 8 * k;
        if (cnt[qq] > (unsigned)KEEP) prune(lds, qq, wid, lane, true);
        const int nf = (int)cnt[qq];
        *(LAS v4u*)(mrow + 4 * lane) = (v4u){0u, 0u, 0u, 0u};
        LDS_WAIT(); asm volatile("" ::: "memory");
#pragma unroll
        for (int j = 0; j < 4; ++j) { const int idx = lane + 64 * j; if (idx < nf) { const unsigned e = buf[qq * CAP + idx]; const unsigned key = 8191u - (e & 0x1FFFu); (void)__hip_atomic_fetch_or(mrow + (key >> 5), 1u << (key & 31u), __ATOMIC_RELAXED, __HIP_MEMORY_SCOPE_WORKGROUP); } }
        LDS_WAIT(); asm volatile("" ::: "memory");
        unsigned long long* grow = (unsigned long long*)(P.bitm + (brow + t0 + qq) * 256);
#pragma unroll
        for (int j = 0; j < 2; ++j) { const int w2 = lane + 64 * j; const unsigned long long v = (unsigned long long)mrow[2 * w2] | ((unsigned long long)mrow[2 * w2 + 1] << 32);
            __hip_atomic_store(grow + w2, v, RLX_AGENT); }
        LDS_WAIT(); asm volatile("" ::: "memory");
    }
    VM_WAIT();
    __syncthreads();
    if (tid == 0) __hip_atomic_fetch_add(P.done + 64 * (b * 32 + (t0 >> 8)), 1u, RLX_AGENT);
}

struct RPostP { const bf16* ZR; bf16* Q3; const bf16* yraw; const float* rdotk; const float *mu, *gup, *lnw, *lnb; };
__device__ __forceinline__ void rwkv_post(const RPostP& P, LAS unsigned char* lds) {
    const int tid = otid_(), lane = tid & 63, h = __builtin_amdgcn_readfirstlane(tid >> 6), c16 = lane & 15, quad = lane >> 4;
    constexpr int SP = 272;
    LAS float* GT = (LAS float*)(lds + 64 * SP);
    bf16x8 bfr[4][4];
#pragma unroll
    for (int ct = 0; ct < 4; ++ct)
#pragma unroll
        for (int s = 0; s < 4; ++s) { const float* gp = P.gup + (size_t)(32 * s + 8 * quad) * 512 + 64 * h + 16 * ct + c16;
            v4u w; w.x = pk2(gp[0], gp[512]); w.y = pk2(gp[1024], gp[1536]); w.z = pk2(gp[2048], gp[2560]); w.w = pk2(gp[3072], gp[3584]); bfr[ct][s] = __builtin_bit_cast(bf16x8, w); }
    float muv[4], lnw[4], lnb[4];
#pragma unroll
    for (int ct = 0; ct < 4; ++ct) { const int ch = 64 * h + 16 * ct + c16; muv[ct] = P.mu[1024 + ch]; lnw[ct] = P.lnw[ch]; lnb[ct] = P.lnb[ch]; }
    const int stok = tid >> 3, sseg = tid & 7;
#pragma unroll 1
    for (int m0 = blockIdx.x * 64; m0 < M; m0 += gridDim.x * 64) {
        {   const size_t m = (size_t)m0 + stok; const int t = (int)(m & (T - 1));
            float gv[16], pv[16];
            { const v4u a = *(const GAS v4u*)(P.ZR + m * ZP + ZC_GC + 16 * sseg), c = *(const GAS v4u*)(P.ZR + m * ZP + ZC_GC + 16 * sseg + 8);
              gv[0] = bflo(a.x); gv[1] = bfhi(a.x); gv[2] = bflo(a.y); gv[3] = bfhi(a.y); gv[4] = bflo(a.z); gv[5] = bfhi(a.z); gv[6] = bflo(a.w); gv[7] = bfhi(a.w);
              gv[8] = bflo(c.x); gv[9] = bfhi(c.x); gv[10] = bflo(c.y); gv[11] = bfhi(c.y); gv[12] = bflo(c.z); gv[13] = bfhi(c.z); gv[14] = bflo(c.w); gv[15] = bfhi(c.w); }
            if (t > 0) { const v4u a = *(const GAS v4u*)(P.ZR + (m - 1) * ZP + ZC_GC + 16 * sseg), c = *(const GAS v4u*)(P.ZR + (m - 1) * ZP + ZC_GC + 16 * sseg + 8);
              pv[0] = bflo(a.x); pv[1] = bfhi(a.x); pv[2] = bflo(a.y); pv[3] = bfhi(a.y); pv[4] = bflo(a.z); pv[5] = bfhi(a.z); pv[6] = bflo(a.w); pv[7] = bfhi(a.w);
              pv[8] = bflo(c.x); pv[9] = bfhi(c.x); pv[10] = bflo(c.y); pv[11] = bfhi(c.y); pv[12] = bflo(c.z); pv[13] = bfhi(c.z); pv[14] = bflo(c.w); pv[15] = bfhi(c.w); }
            else {
#pragma unroll
              for (int e = 0; e < 16; ++e) pv[e] = 0.f; }
            float sg[16];
#pragma unroll
            for (int e = 0; e < 16; ++e) { const float mu = P.mu[1664 + 16 * sseg + e]; sg[e] = sigm(gv[e] + (pv[e] - gv[e]) * mu); }
            v4u o0, o1; o0.x = pk2(sg[0], sg[1]); o0.y = pk2(sg[2], sg[3]); o0.z = pk2(sg[4], sg[5]); o0.w = pk2(sg[6], sg[7]); o1.x = pk2(sg[8], sg[9]); o1.y = pk2(sg[10], sg[11]); o1.z = pk2(sg[12], sg[13]); o1.w = pk2(sg[14], sg[15]);
            *(LAS v4u*)(lds + stok * SP + 32 * sseg) = o0; *(LAS v4u*)(lds + stok * SP + 32 * sseg + 16) = o1;
        }
        __syncthreads();
#pragma unroll 1
        for (int rt = 0; rt < 4; ++rt) {
            f32x4 acc[4];
#pragma unroll
            for (int ct = 0; ct < 4; ++ct) acc[ct] = (f32x4){0.f, 0.f, 0.f, 0.f};
#pragma unroll
            for (int s = 0; s < 4; ++s) { const bf16x8 af = *(const LAS bf16x8*)(lds + (16 * rt + c16) * SP + (32 * s + 8 * quad) * 2);
#pragma unroll
                for (int ct = 0; ct < 4; ++ct) acc[ct] = __builtin_amdgcn_mfma_f32_16x16x32_bf16(af, bfr[ct][s], acc[ct], 0, 0, 0); }
#pragma unroll
            for (int ct = 0; ct < 4; ++ct)
#pragma unroll
                for (int j = 0; j < 4; ++j) GT[(4 * quad + j) * 512 + 64 * h + 16 * ct + c16] = acc[ct][j];
            __syncthreads();
            {   const int vtok = tid >> 5, vseg = tid & 31, ch0 = 16 * vseg, vh = vseg >> 2;
                const size_t m = (size_t)m0 + 16 * rt + vtok; const int t = (int)(m & (T - 1));
                float y[16], vv[16], vp[16], g[16];
                { const v4u a = *(const GAS v4u*)(P.yraw + m * 512 + ch0), c = *(const GAS v4u*)(P.yraw + m * 512 + ch0 + 8);
                  y[0] = bflo(a.x); y[1] = bfhi(a.x); y[2] = bflo(a.y); y[3] = bfhi(a.y); y[4] = bflo(a.z); y[5] = bfhi(a.z); y[6] = bflo(a.w); y[7] = bfhi(a.w);
                  y[8] = bflo(c.x); y[9] = bfhi(c.x); y[10] = bflo(c.y); y[11] = bfhi(c.y); y[12] = bflo(c.z); y[13] = bfhi(c.z); y[14] = bflo(c.w); y[15] = bfhi(c.w); }
                { const v4u a = *(const GAS v4u*)(P.ZR + m * ZP + ZC_RV + ch0), c = *(const GAS v4u*)(P.ZR + m * ZP + ZC_RV + ch0 + 8);
                  vv[0] = bflo(a.x); vv[1] = bfhi(a.x); vv[2] = bflo(a.y); vv[3] = bfhi(a.y); vv[4] = bflo(a.z); vv[5] = bfhi(a.z); vv[6] = bflo(a.w); vv[7] = bfhi(a.w);
                  vv[8] = bflo(c.x); vv[9] = bfhi(c.x); vv[10] = bflo(c.y); vv[11] = bfhi(c.y); vv[12] = bflo(c.z); vv[13] = bfhi(c.z); vv[14] = bflo(c.w); vv[15] = bfhi(c.w); }
                if (t > 0) { const v4u a = *(const GAS v4u*)(P.ZR + (m - 1) * ZP + ZC_RV + ch0), c = *(const GAS v4u*)(P.ZR + (m - 1) * ZP + ZC_RV + ch0 + 8);
                  vp[0] = bflo(a.x); vp[1] = bfhi(a.x); vp[2] = bflo(a.y); vp[3] = bfhi(a.y); vp[4] = bflo(a.z); vp[5] = bfhi(a.z); vp[6] = bflo(a.w); vp[7] = bfhi(a.w);
                  vp[8] = bflo(c.x); vp[9] = bfhi(c.x); vp[10] = bflo(c.y); vp[11] = bfhi(c.y); vp[12] = bflo(c.z); vp[13] = bfhi(c.z); vp[14] = bflo(c.w); vp[15] = bfhi(c.w); }
                else {
#pragma unroll
                  for (int e = 0; e < 16; ++e) vp[e] = 0.f; }
#pragma unroll
                for (int e4 = 0; e4 < 4; ++e4) { const f32x4 gq = *(const LAS f32x4*)(GT + vtok * 512 + ch0 + 4 * e4); g[4 * e4] = gq.x; g[4 * e4 + 1] = gq.y; g[4 * e4 + 2] = gq.z; g[4 * e4 + 3] = gq.w; }
                float sm = 0.f;
#pragma unroll
                for (int e = 0; e < 16; ++e) sm += y[e];
                sm = scan::dpp_add<0xB1>(sm); sm = scan::dpp_add<0x4E>(sm);
                const float mean = sm * (1.f / 64.f); float vs = 0.f;
#pragma unroll
                for (int e = 0; e < 16; ++e) { y[e] -= mean; vs += y[e] * y[e]; }
                vs = scan::dpp_add<0xB1>(vs); vs = scan::dpp_add<0x4E>(vs);
                const float rstd = __builtin_amdgcn_rsqf(vs * (1.f / 64.f) + 64e-5f);
                const float rk = P.rdotk[m * 8 + vh];
                unsigned ow[8];
#pragma unroll
                for (int e = 0; e < 16; e += 2) { float o2[2];
#pragma unroll
                    for (int d = 0; d < 2; ++d) { const int ch = ch0 + e + d; const float v = vv[e + d] + (vp[e + d] - vv[e + d]) * P.mu[1024 + ch];
                        o2[d] = (y[e + d] * rstd * P.lnw[ch] + P.lnb[ch] + rk * v) * g[e + d]; }
                    ow[e >> 1] = pk2(o2[0], o2[1]); }
                *(GAS v4u*)(P.Q3 + m * QP + 512 + ch0) = (v4u){ow[0], ow[1], ow[2], ow[3]}; *(GAS v4u*)(P.Q3 + m * QP + 512 + ch0 + 8) = (v4u){ow[4], ow[5], ow[6], ow[7]};
            }
            __syncthreads();
        }
        __syncthreads();
    }
}
struct DPostP { const bf16* O1; const bf16* O2; bf16* Q3; const float *lq1, *lk1, *lq2, *lk2, *subln; float lambda_init; };
__device__ __forceinline__ void diff_post(const DPostP& P, int gw, int NGW, int lane) {
    const float lam = __expf(wave_sum(P.lq1[lane] * P.lk1[lane])) - __expf(wave_sum(P.lq2[lane] * P.lk2[lane])) + P.lambda_init;
    const float s0 = P.subln[2 * lane] * (1.f - P.lambda_init), s1 = P.subln[2 * lane + 1] * (1.f - P.lambda_init);
    for (int it = gw; it < M * 4; it += NGW) {
        const size_t m = (size_t)(it >> 2); const int hh = it & 3;
        const unsigned a = *(const GAS unsigned*)(P.O1 + m * 512 + 128 * hh + 2 * lane), c = *(const GAS unsigned*)(P.O2 + m * 512 + 128 * hh + 2 * lane);
        const float x0 = bflo(a) - lam * bflo(c), x1 = bfhi(a) - lam * bfhi(c);
        const float r = __builtin_amdgcn_rsqf(wave_sum(x0 * x0 + x1 * x1) * (1.f / 128.f) + NORM_EPS);
        *(GAS unsigned*)(P.Q3 + m * QP + 1024 + 128 * hh + 2 * lane) = pk2(x0 * r * s0, x1 * r * s1);
    }
}

__device__ __forceinline__ int q_fetch(gu32* head, volatile LAS int* slot) {
    if (threadIdx.x == 0) *slot = (int)__hip_atomic_fetch_add(head, 1u, RLX_AGENT);
    __syncthreads();
    const int v = __builtin_amdgcn_readfirstlane(*slot);
    __syncthreads();
    return v;
}

struct Args { const float* in[32]; float* out; unsigned char* ws; int ph_lo, ph_hi; };
__device__ __forceinline__ const float* kin_(int i) { const char* ka = (const char*)__builtin_amdgcn_kernarg_segment_ptr(); unsigned off = (unsigned)i * 8u; asm volatile("" : "+s"(off)); return *(const float* const*)(ka + off); }
#define KIN(i) kin_(i)
#define XOUT ((float*)kin_(32))
#define XB ((bf16*)kin_(32))
#define XB2 ((bf16*)(wsl + WS_Q3))
#define OUTHI ((unsigned char*)kin_(32) + 32 * MiB)
__device__ __forceinline__ unsigned char* kws_() { return (unsigned char*)kin_(33); }
__device__ __forceinline__ int kint_(int byteoff) { const char* ka = (const char*)__builtin_amdgcn_kernarg_segment_ptr(); unsigned off = (unsigned)byteoff; asm volatile("" : "+s"(off)); return *(const int*)(ka + off); }
constexpr int PH_L = 14;
constexpr int N_PHASES = 1 + NLAYER * PH_L;

#define G ((int)gridDim.x)
#define bid ((int)blockIdx.x)
#define gw (bid * NWAVES + wave)
#define NGW (G * NWAVES)
#define MISC ((volatile LAS unsigned*)(lds + LDS_MISC))
#define IN(k) (kint_(272) <= (k) && (k) < kint_(276))
#define SEAM(k) do { if ((k) + 1 < kint_(276)) { XcdBarrier bar_; bar_.bar = (unsigned*)(kws_() + WS_CTL) + CW_BAR; bar_.x = xb_xcc_id(); bar_.st = MISC + 8; xcd_barrier(bar_); } } while (0)
#define WSL() unsigned char* wsl = kws_(); const int tid = otid_(), lane = tid & 63, wave = __builtin_amdgcn_readfirstlane(tid >> 6); (void)lane; (void)wave
#define WFu ((bf16*)(wsl + WS_WF))
#define WFd ((bf16*)(wsl + WS_WF_DOWN))
#define WMi ((bf16*)(wsl + WS_WM))
#define WMb ((bf16*)(wsl + WS_WM_BR))
#define WMo ((bf16*)(wsl + WS_WM_OUT))
#define XN ((bf16*)(wsl + WS_XN))
#define Q3 ((bf16*)(wsl + WS_Q3))
#define ZR ((bf16*)(wsl + WS_ZR))
#define YP ((bf16*)(wsl + WS_R2))
#define HB ZR
#define G3 ZR
#define MG ((bf16*)(wsl + WS_MG))
#define O1 ((bf16*)(wsl + WS_R2))
#define O2 ((bf16*)(wsl + WS_R2) + (size_t)M * 512)
#define YRAW ((bf16*)(wsl + WS_YRAW))
#define BITM ((unsigned*)OUTHI)
#define RDOTK ((float*)(wsl + WS_RDOTK))
#define X1B ((bf16*)(OUTHI + 16 * MiB))
#define KID ((bf16*)(wsl + WS_KID))
#define A8B ((unsigned char*)(wsl + WS_A8))
#define CTL ((gu32*)(wsl + WS_CTL))
#define cscr ((LAS float*)(lds + wave * 16384))

#define CONV_FFN(l_, f_) do { const int gi_ = (f_) ? 29 : 3; \
        MapUp mu_{KIN(gi_) + (size_t)(l_) * DM * FF, KIN(gi_ + 1) + (size_t)(l_) * DM * FF, FF}; MapIdent md_{KIN(gi_ + 2) + (size_t)(l_) * FF * DM, DM}; \
        constexpr int nu_ = conv_items(DM, 2 * FF), nd_ = conv_items(FF, DM); \
        for (int it_ = gw; it_ < nu_ + nd_; it_ += NGW) { if (it_ < nu_) conv_item(mu_, DM, WFu, cscr, it_, 2 * FF / 32, lane); else conv_item(md_, FF, WFd, cscr, it_ - nu_, DM / 32, lane); } } while (0)
#define CONV_MIX(l_) do { MapWin mw_{KIN(8) + (size_t)(l_) * DM * NIN, NIN}; MapIdent mo_{KIN(26) + (size_t)(l_) * DM * DM, DM}; \
        constexpr int ni_ = conv_items(DM, 8704), nb_ = conv_items(512, DM), no_ = conv_items(DM, DM); \
        for (int it_ = gw; it_ < ni_ + 3 * nb_ + no_; it_ += NGW) { \
            if (it_ < ni_) conv_item(mw_, DM, WMi, cscr, it_, 8704 / 32, lane); \
            else if (it_ < ni_ + 3 * nb_) { const int r_ = it_ - ni_, n_ = r_ / nb_; MapIdent mb_{KIN(25) + ((size_t)(l_) * 3 + n_) * 512 * DM, DM}; conv_item(mb_, 512, WMb + (size_t)n_ * DM * 512, cscr, r_ - n_ * nb_, DM / 32, lane); } \
            else conv_item(mo_, DM, WMo, cscr, it_ - ni_ - 3 * nb_, DM / 32, lane); } } while (0)

template <int L, int F> __device__ __forceinline__ void ffn_part(LAS unsigned char* lds) {
    constexpr int l = L, f = F, pb = 1 + PH_L * L, pf = pb + (F ? 11 : 0);
            if (IN(pf + 0)) { WSL();
                pg8::Gemm g{XN, WFu, M, 2 * FF, DM, DM}; pg8::StaticOrder S; S.init(M, 2 * FF, G, bid);
                pg8::EpiSwiGLU E{HB, FF};
                pg8::gemm_phase<pg8::EpiSwiGLU, pg8::StaticOrder, true, true>(lds, g, S, E);
                SEAM(pf + 0);
            }
            if (IN(pf + 1)) { WSL();
                pg8::Gemm g{HB, WFd, M, DM, FF, FF}; pg8::StaticOrder S; S.init(M, DM, G, bid);
                pg8::EpiStore<0> E{YP, DM, YP, DM, 1 << 30};
                pg8::gemm_phase<pg8::EpiStore<0>, pg8::StaticOrder, true, true>(lds, g, S, E);
                SEAM(pf + 1);
            }
            if (IN(pf + 2)) { WSL();
                const float* gpost = KIN(f ? 28 : 2) + l * DM;
                const float* gnext = f == 0 ? KIN(6) + l * DM : (l + 1 < NLAYER ? KIN(1) + (l + 1) * DM : nullptr);
#if PROBE
                float osc = 1.f;
                if (l == NLAYER - 1 && f == 1) { const float num = *(const float*)(wsl + WS_CTL + 4 * CW_PROBE), den = *(const float*)(wsl + WS_CTL + 4 * (CW_PROBE + 1)); osc = 1.f + 4.f * sqrtf(num / fmaxf(den, 1e-30f)); }
#else
                const float osc = 1.f;
#endif
                if constexpr (l == 0 && f == 0) rownorm_rows<false, true>(KIN(0), YP, 0.5f, gpost, XB, gnext, XN, gw, NGW, lane);
                else if constexpr (l == NLAYER - 1 && f == 1) rownorm_rows<true, false>(XB2, YP, 0.5f, gpost, XOUT, nullptr, nullptr, gw, NGW, lane, osc);
                else rownorm_rows<true, true>(XB, YP, 0.5f, gpost, XB, gnext, XN, gw, NGW, lane);
                if (f == 1 && l + 1 < NLAYER) { CONV_FFN(l + 1, 0); CONV_MIX(l + 1); }
                SEAM(pf + 2);
            }
}
template <int L> __device__ __forceinline__ void mixer_part(LAS unsigned char* lds, unsigned char* lds_) {
    constexpr int l = L, pb = 1 + PH_L * L;
            const int pm = pb + 3;
            if (IN(pm + 0)) { WSL();
                pg8::Gemm g{XN, WMi, M, 5632, DM, DM}; pg8::StaticOrder S; S.init(M, 5632, G, bid);
                pg8::EpiStore<0> E{Q3, QP, ZR, ZP, 6};
                pg8::gemm_phase<pg8::EpiStore<0>, pg8::StaticOrder, true, true>(lds, g, S, E);
                SEAM(pm + 0);
            }
            if (IN(pm + 1)) { WSL();
                PrepP pp{ZR, X1B, A8B, KID, KIN(9) + l * 1792, KIN(10) + l * 512, KIN(11) + l * 64 * 512, KIN(12) + l * 512, KIN(13) + l * 64 * 512};
                rwkv_prep(pp, lds);
                SEAM(pm + 1);
            }
            if (IN(pm + 2)) { WSL();
                volatile LAS int* slot = (volatile LAS int*)(MISC + 16);
                if (bid < 64) {
                    ScanP sp{Q3, ZR, X1B, A8B, YRAW, RDOTK, KIN(9) + l * 1792, KIN(15) + l * 512, KIN(16) + l * 512, KIN(17) + l * 512};
#ifndef NO_SCAN
                    rwkv_scan_unit(sp, bid, lds);
#ifdef SCAN_TWICE
                    rwkv_scan_unit(sp, bid, lds);
#endif
#endif
                }
                {
                    Dsa1P dp{ZR, KID, BITM, CTL + CW_DONE + 64 * 64 * l};
                    gu32* head = CTL + CW_Q + 64 * (3 * l + 0);
                    #ifndef NO_DSA1
                    for (int u = q_fetch(head, slot); u < 512; u = q_fetch(head, slot)) dsa1_unit(dp, u, lds);
#ifdef DUP_DSA1
                    { gu32* head2 = CTL + 10240 + 64 * (2 * l + 0); for (int u = q_fetch(head2, slot); u < 512; u = q_fetch(head2, slot)) dsa1_unit(dp, u, lds); }
#endif
#endif
                }
                {
                    gu32* head = CTL + CW_Q + 64 * (3 * l + 1);
                    typedef att::BlockRef<att::bf16, att::bf16> Ref;
#define DSA2_REF(i_, r_) do { const int qb_ = 31 - ((i_) >> 3), b_ = ((i_) >> 2) & 1, h_ = (i_) & 3; const size_t row_ = (size_t)b_ * T + 256 * qb_; \
        r_.Q = (const att::bf16*)(Q3 + row_ * QP + 128 * h_); r_.O = (att::bf16*)(Q3 + row_ * QP + 128 * h_); r_.K = (const att::bf16*)(ZR + (size_t)b_ * T * ZP + ZC_DK + 128 * h_); \
        r_.V = (const att::bf16*)(ZR + (size_t)b_ * T * ZP + ZC_DV + 128 * h_); r_.P0 = 256 * qb_; r_.koff = 0; r_.mask = BITM + row_ * 256; } while (0)
                    int ic = q_fetch(head, slot);
                    if (ic < 256) {
                        int in_ = q_fetch(head, slot);
                        Ref cur; DSA2_REF(ic, cur);
                        att::Seam<att::bf16> S;
                        att::causal_swa_prime<att::bf16, att::bf16, false>(cur, T, (char*)lds_, S);
                        for (;;) {
                            const bool last = in_ >= 256;
                            Ref nxt = cur; if (!last) DSA2_REF(in_, nxt);
                            {
                                if (tid == 0) { gu32* dw = CTL + CW_DONE + 64 * (64 * l + (((ic >> 2) & 1) * 32 + (31 - (ic >> 3)))); unsigned sp = 0;
                                    while (__hip_atomic_load(dw, RLX_AGENT) < 8u) { __builtin_amdgcn_s_sleep(2); if (++sp > (1u << 24)) { __hip_atomic_store(CTL + CW_TMO, 1u, RLX_AGENT); break; } }
                                    __builtin_amdgcn_fence(__ATOMIC_ACQUIRE, "agent"); asm volatile("s_waitcnt vmcnt(0)" ::: "memory"); }
                                __syncthreads();
                            }
#ifndef NO_DSA2
                            att::causal_swa_block<att::bf16, att::bf16, false, true, QP>(cur, nxt, T, T, (char*)lds_, S);
#endif
                            if (last) break;
                            cur = nxt; ic = in_; in_ = q_fetch(head, slot);
                        }
                    }
                }
                {
#ifdef DUP_DIFF
                  for (int rep_ = 0; rep_ < 2; ++rep_) {
                    gu32* head = rep_ ? CTL + 10240 + 64 * (2 * l + 1) : CTL + CW_Q + 64 * (3 * l + 2);
#else
                  {
                    gu32* head = CTL + CW_Q + 64 * (3 * l + 2);
#endif
                    typedef att::BlockRef<att::bf16, att::bf16> Ref;
#define DIFF_REF(i_, r_) do { const int qb_ = 31 - ((i_) >> 4), b_ = ((i_) >> 3) & 1, h_ = ((i_) >> 1) & 3, mp_ = (i_) & 1; const size_t row_ = (size_t)b_ * T + 256 * qb_; \
        r_.Q = (const att::bf16*)(Q3 + row_ * QP + 1024 + 128 * h_ + 64 * mp_); r_.O = (att::bf16*)((mp_ ? O2 : O1) + row_ * 512 + 128 * h_); \
        r_.K = (const att::bf16*)(ZR + (size_t)b_ * T * ZP + ZC_FK + 128 * h_); r_.V = (const att::bf16*)(ZR + (size_t)b_ * T * ZP + ZC_FV + 128 * h_); r_.P0 = 256 * qb_; r_.koff = 128 * mp_; r_.mask = nullptr; } while (0)
                    int ic = q_fetch(head, slot);
                    if (ic < 512) {
                        int in_ = q_fetch(head, slot);
                        Ref cur; DIFF_REF(ic, cur);
                        att::Seam<att::bf16> S;
                        att::causal_swa_prime<att::bf16, att::bf16, true>(cur, T, (char*)lds_, S);
                        for (;;) {
                            const bool last = in_ >= 512;
                            Ref nxt = cur; if (!last) DIFF_REF(in_, nxt);
#ifndef NO_DIFF
                            att::causal_swa_block<att::bf16, att::bf16, true, false, 512>(cur, nxt, T, T, (char*)lds_, S);
#endif
                            if (last) break;
                            cur = nxt; ic = in_; in_ = q_fetch(head, slot);
                        }
                    }
                  }
                }
                SEAM(pm + 2);
            }
            if (IN(pm + 3)) { WSL();
                RPostP rp{ZR, Q3, YRAW, RDOTK, KIN(9) + l * 1792, KIN(14) + l * 128 * 512, KIN(18) + l * 512, KIN(19) + l * 512};
#ifndef NO_RPOST
                rwkv_post(rp, lds);
#endif
                constexpr float lambda_init = L == 0 ? 0.2f : 0.35550906759096927f;
                DPostP dq{O1, O2, Q3, KIN(20) + l * 64, KIN(21) + l * 64, KIN(22) + l * 64, KIN(23) + l * 64, KIN(24) + l * 128, lambda_init};
                diff_post(dq, gw, NGW, lane);
                SEAM(pm + 3);
            }
            if (IN(pm + 4)) { WSL();
                pg8::Gemm g{XN, WMi + (size_t)5632 * DM, M, 3072, DM, DM}; pg8::StaticOrder S; S.init(M, 3072, G, bid);
#ifdef GATE_RAW
                pg8::EpiStore<0> E{G3, 3072, G3, 3072, 1 << 30};
                pg8::gemm_phase<pg8::EpiStore<0>, pg8::StaticOrder, true, true>(lds, g, S, E);
#else
                pg8::EpiStore<1> E{G3, 3072, G3, 3072, 1 << 30};
                pg8::gemm_phase<pg8::EpiStore<1>, pg8::StaticOrder, true, true>(lds, g, S, E);
#endif
                SEAM(pm + 4);
            }
            if (IN(pm + 5)) { WSL();
#pragma unroll 1
                for (int n = 0; n < 3; ++n) {
                    pg8::Gemm g{Q3 + 512 * n, WMb + (size_t)n * DM * 512, M, DM, 512, QP}; pg8::StaticOrder S; S.init(M, DM, G, bid);
                    pg8::EpiGateMul E{MG, DM, G3 + 1024 * n, 3072, n == 0 ? 1 : 0};
                    pg8::gemm_phase<pg8::EpiGateMul, pg8::StaticOrder, false, true>(lds, g, S, E);
                    VM_WAIT(); __syncthreads();
                }
                SEAM(pm + 5);
            }
            if (IN(pm + 6)) { WSL();
                pg8::Gemm g{MG, WMo, M, DM, DM, DM}; pg8::StaticOrder S; S.init(M, DM, G, bid);
                pg8::EpiStore<0> E{YP, DM, YP, DM, 1 << 30};
                pg8::gemm_phase<pg8::EpiStore<0>, pg8::StaticOrder, false, true>(lds, g, S, E);
                SEAM(pm + 6);
            }
            if (IN(pm + 7)) { WSL();
                rownorm_rows<true, true>(XB, YP, 1.0f, KIN(7) + l * DM, l == NLAYER - 1 ? XB2 : XB, KIN(27) + l * DM, XN, gw, NGW, lane);
                CONV_FFN(l, 1);
                SEAM(pm + 7);
            }
}

__global__ void __launch_bounds__(NWAVES * 64, 2) mk_fwd(Args args) {
    extern __shared__ __attribute__((aligned(16))) unsigned char lds_[];
    LAS unsigned char* lds = (LAS unsigned char*)lds_;
    { const int tid = otid_(); if (tid < 64) MISC[tid] = 0u; }
    __syncthreads();
    (void)xcd_barrier_post((unsigned*)(kws_() + WS_CTL) + CW_BAR, MISC + 8);
    if (IN(0)) { WSL();
        CONV_FFN(0, 0); CONV_MIX(0);
        rownorm_rows<false, false>(KIN(0), nullptr, 0.f, nullptr, nullptr, KIN(1), XN, gw, NGW, lane);
        SEAM(0);
    }
    ffn_part<0, 0>(lds); mixer_part<0>(lds, lds_); ffn_part<0, 1>(lds);
    ffn_part<1, 0>(lds); mixer_part<1>(lds, lds_); ffn_part<1, 1>(lds);
}

#if PROBE
__device__ __forceinline__ void probe_acc(float num, float den, float* ctlf) {
    __shared__ float rn[256], rd[256];
    rn[threadIdx.x] = num; rd[threadIdx.x] = den; __syncthreads();
    for (int o = 128; o > 0; o >>= 1) { if ((int)threadIdx.x < o) { rn[threadIdx.x] += rn[threadIdx.x + o]; rd[threadIdx.x] += rd[threadIdx.x + o]; } __syncthreads(); }
    if (threadIdx.x == 0) { atomicAdd(ctlf + CW_PROBE, rn[0]); atomicAdd(ctlf + CW_PROBE + 1, rd[0]); }
}
__global__ void __launch_bounds__(256) probe_ffn(const unsigned char* ws, const float* Wg, const float* Wu, const float* Wd) {
    __shared__ float xn[1024]; __shared__ float hid[2816];
    const int m = 777 + 1931 * blockIdx.x, tid = threadIdx.x;
    const bf16* XNp = (const bf16*)(ws + WS_XN); const bf16* YPp = (const bf16*)(ws + WS_R2);
    for (int k = tid; k < 1024; k += 256) xn[k] = bf1(XNp[(size_t)m * 1024 + k]);
    __syncthreads();
    for (int j = tid; j < 2816; j += 256) { float g = 0.f, u = 0.f; for (int k = 0; k < 1024; ++k) { g += xn[k] * Wg[(size_t)k * 2816 + j]; u += xn[k] * Wu[(size_t)k * 2816 + j]; } hid[j] = g / (1.f + expf(-g)) * u; }
    __syncthreads();
    float num = 0.f, den = 0.f;
    for (int d = tid; d < 1024; d += 256) { float o = 0.f; for (int j = 0; j < 2816; ++j) o += hid[j] * Wd[(size_t)j * 1024 + d]; const float got = bf1(YPp[(size_t)m * 1024 + d]); num += (o - got) * (o - got); den += o * o; }
    probe_acc(num, den, (float*)(ws + WS_CTL));
}
__global__ void __launch_bounds__(256) probe_win(const unsigned char* ws, const float* Win) {
    __shared__ float xn[1024];
    const int m = 555 + 1999 * blockIdx.x, tid = threadIdx.x;
    const bf16* XNp = (const bf16*)(ws + WS_XN); const bf16* Q3p = (const bf16*)(ws + WS_Q3); const bf16* ZRp = (const bf16*)(ws + WS_ZR);
    for (int k = tid; k < 1024; k += 256) xn[k] = bf1(XNp[(size_t)m * 1024 + k]);
    __syncthreads();
    float num = 0.f, den = 0.f;
    for (int c = tid; c < 5448; c += 256) {
        float z = 0.f; for (int k = 0; k < 1024; ++k) z += xn[k] * Win[(size_t)k * NIN + c];
        float got;
        if (c < 512) got = bf1(Q3p[(size_t)m * QP + c]);
        else if (c < 2120) got = bf1(ZRp[(size_t)m * ZP + (c - 512)]);
        else if (c < 2632) got = bf1(Q3p[(size_t)m * QP + 512 + (c - 2120)]);
        else if (c < 3912) got = bf1(ZRp[(size_t)m * ZP + (c - 840)]);
        else if (c < 4424) got = bf1(Q3p[(size_t)m * QP + 1024 + (c - 3912)]);
        else got = bf1(ZRp[(size_t)m * ZP + (c - 1352)]);
        num += (z - got) * (z - got); den += z * z;
    }
    probe_acc(num, den, (float*)(ws + WS_CTL));
}
__global__ void __launch_bounds__(256) probe_wconv(const unsigned char* ws, const float* Win, int r0) {
    const bf16* WMp = (const bf16*)(ws + WS_WM); const int tid = threadIdx.x;
    float num = 0.f, den = 0.f;
    for (int rr = 0; rr < 64; ++rr) { const int n = r0 + 64 * blockIdx.x + rr; MapWin mw{Win, NIN}; const float* cp = mw.col(n);
        for (int k = tid; k < 1024; k += 256) { const float ref = cp ? cp[(size_t)k * NIN] : 0.f; const float got = bf1(WMp[(size_t)n * 1024 + k]); num += (ref - got) * (ref - got); den += ref * ref; } }
    probe_acc(num, den, (float*)(ws + WS_CTL));
}
__global__ void __launch_bounds__(256) probe_merge(const unsigned char* ws, const float* Win, const float* Wb, const float* Wo, int which) {
    __shared__ float xn[1024]; __shared__ float y[1536]; __shared__ float mg[1024];
    const int m = 333 + 2003 * blockIdx.x, tid = threadIdx.x;
    const bf16* XNp = (const bf16*)(ws + WS_XN); const bf16* Q3p = (const bf16*)(ws + WS_Q3); const bf16* MGp = (const bf16*)(ws + WS_MG); const bf16* YPp = (const bf16*)(ws + WS_R2);
    for (int k = tid; k < 1024; k += 256) xn[k] = bf1(XNp[(size_t)m * 1024 + k]);
    for (int k = tid; k < 1536; k += 256) y[k] = bf1(Q3p[(size_t)m * QP + k]);
    __syncthreads();
    float num = 0.f, den = 0.f;
    for (int d = tid; d < 1024; d += 256) {
        float acc = 0.f;
        for (int n = 0; n < 3; ++n) { float g = 0.f; for (int k = 0; k < 1024; ++k) g += xn[k] * Win[(size_t)k * NIN + 5448 + n * 1024 + d];
            float p = 0.f; for (int c = 0; c < 512; ++c) p += y[512 * n + c] * Wb[((size_t)n * 512 + c) * 1024 + d];
            acc += p / (1.f + expf(-g)); }
        mg[d] = acc; const float got = bf1(MGp[(size_t)m * 1024 + d]); if (which == 0) { num += (acc - got) * (acc - got); den += acc * acc; }
        if (which == 2) { const bf16* G3p = (const bf16*)(ws + WS_ZR); for (int n = 0; n < 3; ++n) { float g = 0.f; for (int k = 0; k < 1024; ++k) g += xn[k] * Win[(size_t)k * NIN + 5448 + n * 1024 + d];
            const float sg = 1.f / (1.f + expf(-g)), gg = bf1(G3p[(size_t)m * 3072 + n * 1024 + d]); num += (sg - gg) * (sg - gg); den += sg * sg; } }
        if (which == 3) { const bf16* G3p = (const bf16*)(ws + WS_ZR); float a2 = 0.f; for (int n = 0; n < 3; ++n) { float p = 0.f; for (int c = 0; c < 512; ++c) p += y[512 * n + c] * Wb[((size_t)n * 512 + c) * 1024 + d];
            a2 += p * bf1(G3p[(size_t)m * 3072 + n * 1024 + d]); } num += (a2 - got) * (a2 - got); den += a2 * a2; }
    }
    __syncthreads();
    if (which == 1) for (int d = tid; d < 1024; d += 256) { float o = 0.f; for (int j = 0; j < 1024; ++j) o += mg[j] * Wo[(size_t)j * 1024 + d]; const float got = bf1(YPp[(size_t)m * 1024 + d]); num += (o - got) * (o - got); den += o * o; }
    probe_acc(num, den, (float*)(ws + WS_CTL));
}
#endif
#ifndef MK_ONE_LAUNCH
#define MK_ONE_LAUNCH 0
#endif
extern "C" void kernel_launch(void* const* d_in, const int* in_sizes, int n_in, void* d_out, int out_size, void* d_ws, size_t ws_size, hipStream_t stream) {
    static int grid = 0;
    if (grid == 0) {
        if (n_in != 32 || in_sizes[0] != M * DM || out_size != M * DM || ws_size < WS_END) { fprintf(stderr, "kernel_launch: unexpected shapes / workspace (n_in %d, ws %zu)\n", n_in, ws_size); grid = -1; return; }
        int dev = 0, cus = 0;
        if (hipGetDevice(&dev) != hipSuccess || hipDeviceGetAttribute(&cus, hipDeviceAttributeMultiprocessorCount, dev) != hipSuccess) { grid = -1; return; }
        if (hipFuncSetAttribute((const void*)mk_fwd, hipFuncAttributeMaxDynamicSharedMemorySize, LDS_BYTES) != hipSuccess) { fprintf(stderr, "kernel_launch: hipFuncSetAttribute failed\n"); grid = -1; return; }
        int per_cu = 0;
        if (hipOccupancyMaxActiveBlocksPerMultiprocessor(&per_cu, (const void*)mk_fwd, NWAVES * 64, LDS_BYTES) != hipSuccess || per_cu < 1) { fprintf(stderr, "kernel_launch: occupancy query says %d\n", per_cu); }
        (void)hipGetLastError();
        grid = cus;
    }
    if (grid < 0) return;
    (void)hipMemsetAsync((char*)d_ws + WS_CTL, 0, CTL_ZERO_BYTES, stream);
    Args a{};
    for (int i = 0; i < 32; ++i) a.in[i] = (const float*)d_in[i];
    a.out = (float*)d_out; a.ws = (unsigned char*)d_ws;
#if MK_ONE_LAUNCH
    a.ph_lo = 0; a.ph_hi = N_PHASES;
    hipLaunchKernelGGL(mk_fwd, dim3(grid), dim3(NWAVES * 64), LDS_BYTES, stream, a);
#else
    for (int p = 0; p < N_PHASES; ++p) { a.ph_lo = p; a.ph_hi = p + 1; hipLaunchKernelGGL(mk_fwd, dim3(grid), dim3(NWAVES * 64), LDS_BYTES, stream, a);
#if PROBE == 1
        if (p == 2) hipLaunchKernelGGL(probe_ffn, dim3(8), dim3(256), 0, stream, (const unsigned char*)d_ws, a.in[3], a.in[4], a.in[5]);
#elif PROBE == 2
        if (p == 4) hipLaunchKernelGGL(probe_win, dim3(8), dim3(256), 0, stream, (const unsigned char*)d_ws, a.in[8]);
#elif PROBE == 3
        if (p == 8) hipLaunchKernelGGL(probe_merge, dim3(8), dim3(256), 0, stream, (const unsigned char*)d_ws, a.in[8], a.in[25], a.in[26], 0);
#elif PROBE == 5
        if (p == 8) hipLaunchKernelGGL(probe_merge, dim3(8), dim3(256), 0, stream, (const unsigned char*)d_ws, a.in[8], a.in[25], a.in[26], 2);
#elif PROBE == 6
        if (p == 8) hipLaunchKernelGGL(probe_merge, dim3(8), dim3(256), 0, stream, (const unsigned char*)d_ws, a.in[8], a.in[25], a.in[26], 3);
#elif PROBE == 7
        if (p == 6) hipLaunchKernelGGL(probe_wconv, dim3(48), dim3(256), 0, stream, (const unsigned char*)d_ws, a.in[8], 5632);
#elif PROBE == 8
        if (p == 3) hipLaunchKernelGGL(probe_wconv, dim3(48), dim3(256), 0, stream, (const unsigned char*)d_ws, a.in[8], 5632);
#elif PROBE == 9
        if (p == 7) hipLaunchKernelGGL(probe_merge, dim3(8), dim3(256), 0, stream, (const unsigned char*)d_ws, a.in[8], a.in[25], a.in[26], 2);
#elif PROBE == 4
        if (p == 9) hipLaunchKernelGGL(probe_merge, dim3(8), dim3(256), 0, stream, (const unsigned char*)d_ws, a.in[8], a.in[25], a.in[26], 1);
#endif
    }
#endif
}
```

```cpp
#include <hip/hip_runtime.h>
#include <hip/hip_bf16.h>
#include <cstdio>
#include <cstdint>
#define MK_ONE_LAUNCH 1
#define GATE_RAW 1

__device__ __forceinline__ int otid_() { int t = (int)threadIdx.x; asm volatile("" : "+v"(t)); return t; }
namespace pg8 {
#define PG8_LAS __attribute__((address_space(3)))
typedef unsigned short bf16_t;
typedef short bf16x8 __attribute__((ext_vector_type(8)));
typedef float f32x4 __attribute__((ext_vector_type(4)));
typedef unsigned u32x4 __attribute__((ext_vector_type(4)));
constexpr int BM = 256, BK = 64, HALF = 128, HTB = HALF * BK * 2  , STAGE_BYTES = 8 * HTB, NXCD = 8, WGM = 8;

__host__ __device__ __forceinline__ int lds_byte(int r, int c) { const int st = (r >> 4) * 2 + (c >> 5), rr = r & 15, cc = c & 31, ob = rr * 64 + cc * 2; return st * 1024 + (ob ^ (((ob >> 9) & 1) << 5)); }
__host__ __device__ __forceinline__ void stage_rc(int b, int& R, int& C) { const int st = b / 1024, sb = b % 1024, swz = sb ^ (((sb >> 9) & 1) << 5); R = (st >> 1) * 16 + swz / 64; C = (st & 1) * 32 + (swz % 64) / 2; }
__host__ __device__ __forceinline__ int perm32(int rho) { const int n = rho >> 4, i = rho & 15; return 8 * (i >> 2) + 4 * n + (i & 3); }

struct Unit { int pm, pn; };
struct Gemm { const bf16_t* A; const bf16_t* Bt; int M, N, K, lda; };

struct StaticOrder {
    int nM, nN, nwg, G, c;
    __host__ __device__ void init(int M, int N, int G_, int c_) { nM = M / BM; nN = N / BM; nwg = nM * nN; G = G_; c = c_; }
    __host__ __device__ bool next(int i, Unit& u) const {
        const long L = (long)i * G + c; if (L >= nwg) return false;
        int wgid = (int)L; { const int q = nwg / NXCD, r = nwg % NXCD, xcd = wgid % NXCD, off = wgid / NXCD; wgid = (xcd < r ? xcd * (q + 1) : r * (q + 1) + (xcd - r) * q) + off; }
        const int nig = WGM * nN, gid = wgid / nig, fm = gid * WGM, gsz = (nM - fm) < WGM ? (nM - fm) : WGM;
        u.pm = fm + ((wgid % nig) % gsz); u.pn = (wgid % nig) / gsz; return true;
    }
    __device__ __forceinline__ void a_ready(const Unit&) const {}
    __device__ __forceinline__ void done(const Unit&) const {}
};

__device__ __forceinline__ unsigned cvt_pk_bf16(float lo, float hi) { unsigned r; asm volatile("v_cvt_pk_bf16_f32 %0, %1, %2" : "=v"(r) : "v"(lo), "v"(hi)); return r; }

template <class Epi, class Sched, bool ALIGN_EPI = false, bool SP2 = false>
__device__ __forceinline__ void gemm_phase(PG8_LAS unsigned char* lds, const Gemm g, const Sched& S, const Epi& E) {
    const int tid = otid_(), wid = __builtin_amdgcn_readfirstlane(tid >> 6), lane = tid & 63, wr = wid >> 2, wc = wid & 3, fr = lane & 15, fq = lane >> 4;
    const int K = g.K, nt = K / BK;
    unsigned voffA[2], voffB[2];
#pragma unroll
    for (int i = 0; i < 2; ++i) { int R, C; stage_rc(tid * 16 + i * 8192, R, C); const int Rb = Epi::PERM ? ((R & ~31) + perm32(R & 31)) : R;
        voffA[i] = (unsigned)(R * g.lda + C) * 2u; voffB[i] = (unsigned)(Rb * K + C) * 2u; }
    const size_t kstep = (size_t)(BK * 2);
    const size_t hstepB = (size_t)HALF * K * 2, hstepA = (size_t)HALF * g.lda * 2;
    const size_t tstepB = 2 * hstepB, tstepA = 2 * hstepA;
    const unsigned ldsw = (unsigned)wid * 1024u;
    const int aoff = lds_byte(wr * 64 + fr, fq * 8), boff = lds_byte(wc * 32 + fr, fq * 8);
#define PG8_SA(b, h) (((b) * 2 + (h)) * HTB)
#define PG8_SB(b, h) ((4 + (b) * 2 + (h)) * HTB)
#define PG8_STAGE(bufoff, gbase, voff) do { _Pragma("unroll") for (int _i = 0; _i < 2; ++_i) \
        __builtin_amdgcn_global_load_lds((const unsigned*)((const char*)(gbase) + (voff)[_i]), (PG8_LAS unsigned*)(lds + (bufoff) + ldsw + _i * 8192), 16, 0, 0); } while (0)
#define PG8_LDA(dst, b, h) do { _Pragma("unroll") for (int m = 0; m < 4; ++m) _Pragma("unroll") for (int k = 0; k < 2; ++k) dst[m][k] = *(const PG8_LAS bf16x8*)(lds + PG8_SA(b, h) + aoff + m * 2048 + k * 1024); } while (0)
#define PG8_LDB(dst, b, h) do { _Pragma("unroll") for (int n = 0; n < 2; ++n) _Pragma("unroll") for (int k = 0; k < 2; ++k) dst[n][k] = *(const PG8_LAS bf16x8*)(lds + PG8_SB(b, h) + boff + n * 2048 + k * 1024); } while (0)
#define PG8_MMA(ai, bj, At, Bt) do { __builtin_amdgcn_s_setprio(1); _Pragma("unroll") for (int m = 0; m < 4; ++m) _Pragma("unroll") for (int n = 0; n < 2; ++n) _Pragma("unroll") for (int k = 0; k < 2; ++k) \
        acc[ai][bj][m][n] = __builtin_amdgcn_mfma_f32_16x16x32_bf16(Bt[n][k], At[m][k], acc[ai][bj][m][n], 0, 0, 0); __builtin_amdgcn_s_setprio(0); } while (0)
#define PG8_WAIT_V(n) asm volatile("s_waitcnt vmcnt(" #n ")" ::: "memory")
#define PG8_WAIT_L(n) asm volatile("s_waitcnt lgkmcnt(" #n ")" ::: "memory")
#define PG8_BAR __builtin_amdgcn_s_barrier()
#define PG8_SCHED __builtin_amdgcn_sched_barrier(0)
    Unit cur, nxt; int ui = 0;
    if (!S.next(0, cur)) return;
    f32x4 acc[2][2][4][2];
#pragma unroll
    for (int a = 0; a < 2; ++a)
#pragma unroll
        for (int b = 0; b < 2; ++b)
#pragma unroll
            for (int m = 0; m < 4; ++m)
#pragma unroll
                for (int n = 0; n < 2; ++n) acc[a][b][m][n] = (f32x4){0.f, 0.f, 0.f, 0.f};
    bf16x8 At[4][2], B0[2][2], B1[2][2];
    const char* cA = (const char*)g.A + (size_t)cur.pm * tstepA; const char* cB = (const char*)g.Bt + (size_t)cur.pn * tstepB;
    S.a_ready(cur);
    if constexpr (SP2) {
        PG8_STAGE(PG8_SB(0, 0), cB, voffB); PG8_STAGE(PG8_SB(0, 1), cB + hstepB, voffB); PG8_STAGE(PG8_SA(0, 0), cA, voffA); PG8_STAGE(PG8_SA(0, 1), cA + hstepA, voffA);
        if (wr == 1) PG8_BAR;
        PG8_WAIT_V(2); PG8_BAR;
        PG8_STAGE(PG8_SB(1, 0), cB + kstep, voffB); PG8_STAGE(PG8_SA(1, 0), cA + kstep, voffA); PG8_STAGE(PG8_SB(1, 1), cB + hstepB + kstep, voffB);
        PG8_WAIT_V(6); PG8_BAR;
    } else {
        PG8_STAGE(PG8_SB(0, 0), cB, voffB); PG8_STAGE(PG8_SA(0, 0), cA, voffA); PG8_STAGE(PG8_SB(0, 1), cB + hstepB, voffB); PG8_STAGE(PG8_SA(0, 1), cA + hstepA, voffA);
        if (wr == 1) PG8_BAR;
        PG8_WAIT_V(4); PG8_BAR;
        PG8_STAGE(PG8_SB(1, 0), cB + kstep, voffB); PG8_STAGE(PG8_SA(1, 0), cA + kstep, voffA); PG8_STAGE(PG8_SB(1, 1), cB + hstepB + kstep, voffB);
        PG8_WAIT_V(6); PG8_BAR;
    }
    for (;;) {
        const bool has_next = S.next(ui + 1, nxt);
        const char* nA = has_next ? (const char*)g.A + (size_t)nxt.pm * tstepA : cA; const char* nB = has_next ? (const char*)g.Bt + (size_t)nxt.pn * tstepB : cB;
        for (int t = 0; t < nt; t += 2) {
            const bool last = (t == nt - 2);
            const char* a1 = cA + (size_t)(t + 1) * kstep;
            const char* a2 = last ? nA : cA + (size_t)(t + 2) * kstep; const char* b2 = last ? nB : cB + (size_t)(t + 2) * kstep;
            const char* a3 = a2 + kstep; const char* b3 = b2 + kstep;
            if (last && has_next) S.a_ready(nxt);
            if constexpr (SP2) {
            PG8_LDB(B0, 0, 0); PG8_LDB(B1, 0, 1); PG8_SCHED; PG8_LDA(At, 0, 0); PG8_STAGE(PG8_SA(1, 1), a1 + hstepA, voffA);
            PG8_WAIT_V(8); PG8_WAIT_L(0); PG8_BAR; PG8_MMA(0, 0, At, B0); PG8_MMA(0, 1, At, B1); PG8_BAR; PG8_SCHED;
            PG8_LDA(At, 0, 1); PG8_STAGE(PG8_SB(0, 0), b2, voffB); PG8_STAGE(PG8_SB(0, 1), b2 + hstepB, voffB); PG8_STAGE(PG8_SA(0, 0), a2, voffA);
            PG8_WAIT_V(8); PG8_WAIT_L(0); PG8_BAR; PG8_MMA(1, 0, At, B0); PG8_MMA(1, 1, At, B1); PG8_BAR; PG8_SCHED;
            PG8_LDB(B0, 1, 0); PG8_LDB(B1, 1, 1); PG8_SCHED; PG8_LDA(At, 1, 0); PG8_STAGE(PG8_SA(0, 1), a2 + hstepA, voffA);
            PG8_WAIT_V(8); PG8_WAIT_L(0); PG8_BAR; PG8_MMA(0, 0, At, B0); PG8_MMA(0, 1, At, B1); PG8_BAR; PG8_SCHED;
            PG8_LDA(At, 1, 1); PG8_STAGE(PG8_SB(1, 0), b3, voffB); PG8_STAGE(PG8_SB(1, 1), b3 + hstepB, voffB); PG8_STAGE(PG8_SA(1, 0), a3, voffA);
            PG8_WAIT_V(8); PG8_WAIT_L(0); PG8_BAR; PG8_MMA(1, 0, At, B0); PG8_MMA(1, 1, At, B1); PG8_BAR; PG8_SCHED;
            } else {
            PG8_LDB(B0, 0, 0); PG8_SCHED; PG8_LDA(At, 0, 0); PG8_STAGE(PG8_SA(1, 1), a1 + hstepA, voffA);
            PG8_WAIT_L(8); PG8_BAR; PG8_WAIT_L(0); PG8_MMA(0, 0, At, B0); PG8_BAR; PG8_SCHED;
            PG8_LDB(B1, 0, 1); PG8_STAGE(PG8_SB(0, 0), b2, voffB);
            PG8_BAR; PG8_WAIT_L(0); PG8_MMA(0, 1, At, B1); PG8_BAR;
            PG8_LDA(At, 0, 1); PG8_STAGE(PG8_SA(0, 0), a2, voffA);
            PG8_BAR; PG8_WAIT_L(0); PG8_MMA(1, 0, At, B0); PG8_BAR; PG8_SCHED;
            PG8_STAGE(PG8_SB(0, 1), b2 + hstepB, voffB);
            PG8_WAIT_V(6); PG8_BAR; PG8_MMA(1, 1, At, B1); PG8_BAR;
            PG8_LDB(B0, 1, 0); PG8_SCHED; PG8_LDA(At, 1, 0); PG8_STAGE(PG8_SA(0, 1), a2 + hstepA, voffA);
            PG8_WAIT_L(8); PG8_BAR; PG8_WAIT_L(0); PG8_MMA(0, 0, At, B0); PG8_BAR; PG8_SCHED;
            PG8_LDB(B1, 1, 1); PG8_STAGE(PG8_SB(1, 0), b3, voffB);
            PG8_BAR; PG8_WAIT_L(0); PG8_MMA(0, 1, At, B1); PG8_BAR;
            PG8_LDA(At, 1, 1); PG8_STAGE(PG8_SA(1, 0), a3, voffA);
            PG8_BAR; PG8_WAIT_L(0); PG8_MMA(1, 0, At, B0); PG8_BAR; PG8_SCHED;
            PG8_STAGE(PG8_SB(1, 1), b3 + hstepB, voffB);
            PG8_WAIT_V(6); PG8_BAR; PG8_MMA(1, 1, At, B1); PG8_BAR;
            }
        }
        if constexpr (ALIGN_EPI) { if (wr == 0) PG8_BAR; }
        if constexpr (!Epi::AFTER_DRAIN) { E(acc, cur, wr, wc, fr, fq); S.done(cur); }
        if (!has_next) break;
#pragma unroll
        for (int a = 0; a < 2; ++a)
#pragma unroll
            for (int b = 0; b < 2; ++b)
#pragma unroll
                for (int m = 0; m < 4; ++m)
#pragma unroll
                    for (int n = 0; n < 2; ++n) acc[a][b][m][n] = (f32x4){0.f, 0.f, 0.f, 0.f};
        cur = nxt; cA = nA; cB = nB; ++ui;
        if constexpr (ALIGN_EPI) { if (wr == 1) PG8_BAR; }
    }
    PG8_WAIT_V(0);
    if constexpr (!ALIGN_EPI) { if (wr == 0) PG8_BAR; }
    PG8_BAR;
    if constexpr (Epi::AFTER_DRAIN) { E.fused(acc, cur, wr, wc, fr, fq, lds, wid, lane); S.done(cur); }
#undef PG8_SA
#undef PG8_SB
#undef PG8_STAGE
#undef PG8_LDA
#undef PG8_LDB
#undef PG8_MMA
#undef PG8_WAIT_V
#undef PG8_WAIT_L
#undef PG8_BAR
#undef PG8_SCHED
}
}
namespace pg8 {
typedef unsigned u32x2 __attribute__((ext_vector_type(2)));
__device__ __forceinline__ float bf_lo(unsigned w) { return __uint_as_float(w << 16); }
__device__ __forceinline__ float bf_hi(unsigned w) { return __uint_as_float(w & 0xffff0000u); }
__device__ __forceinline__ float sigmoidf_(float x) { return __builtin_amdgcn_rcpf(1.0f + __expf(-x)); }

struct EpiSwiGLU {
    static constexpr bool PERM = false, AFTER_DRAIN = false;
    bf16_t* H; int ldh;
    __device__ __forceinline__ void operator()(const f32x4 (&acc)[2][2][4][2], const Unit& u, int wr, int wc, int fr, int fq) const {
        const int row0 = u.pm * BM + wr * 64 + fr, hc0 = u.pn * 128 + wc * 16 + 4 * fq;
#pragma unroll
        for (int ai = 0; ai < 2; ++ai)
#pragma unroll
            for (int m = 0; m < 4; ++m) { bf16_t* rowp = H + (size_t)(row0 + ai * HALF + m * 16) * ldh + hc0;
#pragma unroll
                for (int bj = 0; bj < 2; ++bj) { const f32x4 g = acc[ai][bj][m][0], up = acc[ai][bj][m][1]; float h[4];
#pragma unroll
                    for (int e = 0; e < 4; ++e) h[e] = g[e] * sigmoidf_(g[e]) * up[e];
                    u32x2 w; w.x = cvt_pk_bf16(h[0], h[1]); w.y = cvt_pk_bf16(h[2], h[3]);
                    *(u32x2*)(rowp + bj * 64) = w; } }
    }
};
template <int ACT> struct EpiStore {
    static constexpr bool PERM = true, AFTER_DRAIN = false;
    bf16_t* O0; int ld0; bf16_t* O1; int ld1; int split_tiles;
    __device__ __forceinline__ void operator()(const f32x4 (&acc)[2][2][4][2], const Unit& u, int wr, int wc, int fr, int fq) const {
        const int row0 = u.pm * BM + wr * 64 + fr;
        bf16_t* base; int ld, colt;
        if (u.pn < split_tiles) { base = O0; ld = ld0; colt = u.pn * BM; } else { base = O1; ld = ld1; colt = (u.pn - split_tiles) * BM; }
        const int col0 = colt + wc * 32 + 8 * fq;
#pragma unroll
        for (int ai = 0; ai < 2; ++ai)
#pragma unroll
            for (int m = 0; m < 4; ++m) { bf16_t* rowp = base + (size_t)(row0 + ai * HALF + m * 16) * ld + col0;
#pragma unroll
                for (int bj = 0; bj < 2; ++bj) { f32x4 v0 = acc[ai][bj][m][0], v1 = acc[ai][bj][m][1];
                    if (ACT == 1) {
#pragma unroll
                        for (int e = 0; e < 4; ++e) { v0[e] = sigmoidf_(v0[e]); v1[e] = sigmoidf_(v1[e]); } }
                    u32x4 w; w.x = cvt_pk_bf16(v0[0], v0[1]); w.y = cvt_pk_bf16(v0[2], v0[3]); w.z = cvt_pk_bf16(v1[0], v1[1]); w.w = cvt_pk_bf16(v1[2], v1[3]);
                    *(u32x4*)(rowp + bj * HALF) = w; } }
    }
};
#ifdef GATE_RAW
#define GSIG(x) sigmoidf_(x)
#else
#define GSIG(x) (x)
#endif
struct EpiGateMul {
    static constexpr bool PERM = true, AFTER_DRAIN = false;
    bf16_t* MG; int ldm; const bf16_t* G; int ldg; int first;
    __device__ __forceinline__ void operator()(const f32x4 (&acc)[2][2][4][2], const Unit& u, int wr, int wc, int fr, int fq) const {
        const int row0 = u.pm * BM + wr * 64 + fr, col0 = u.pn * BM + wc * 32 + 8 * fq;
#pragma unroll
        for (int ai = 0; ai < 2; ++ai)
#pragma unroll
            for (int m = 0; m < 4; ++m) { const size_t r = (size_t)(row0 + ai * HALF + m * 16);
#pragma unroll
                for (int bj = 0; bj < 2; ++bj) { const f32x4 v0 = acc[ai][bj][m][0], v1 = acc[ai][bj][m][1];
                    const u32x4 g = *(const u32x4*)(G + r * ldg + col0 + bj * HALF);
                    float o[8] = { v0[0] * GSIG(bf_lo(g.x)), v0[1] * GSIG(bf_hi(g.x)), v0[2] * GSIG(bf_lo(g.y)), v0[3] * GSIG(bf_hi(g.y)), v1[0] * GSIG(bf_lo(g.z)), v1[1] * GSIG(bf_hi(g.z)), v1[2] * GSIG(bf_lo(g.w)), v1[3] * GSIG(bf_hi(g.w)) };
                    bf16_t* mp = MG + r * ldm + col0 + bj * HALF;
                    if (!first) { const u32x4 p = *(const u32x4*)mp;
                        o[0] += bf_lo(p.x); o[1] += bf_hi(p.x); o[2] += bf_lo(p.y); o[3] += bf_hi(p.y); o[4] += bf_lo(p.z); o[5] += bf_hi(p.z); o[6] += bf_lo(p.w); o[7] += bf_hi(p.w); }
                    u32x4 w; w.x = cvt_pk_bf16(o[0], o[1]); w.y = cvt_pk_bf16(o[2], o[3]); w.z = cvt_pk_bf16(o[4], o[5]); w.w = cvt_pk_bf16(o[6], o[7]);
                    *(u32x4*)mp = w; } }
    }
};
}
namespace att {
constexpr int D = 128;
constexpr bool WSKIP = false;
constexpr float THR = 8.f;
constexpr int NW = 8, QBLK = 32, KVBLK = 64, QB = NW * QBLK;
constexpr int SHM_V = KVBLK * D * 2, SHM_K = KVBLK * D * 2;
constexpr int LDS_BYTES = 2 * SHM_V + 2 * SHM_K + NW * 64 * 4;
using bf16 = __hip_bfloat16;
typedef short bf16x8 __attribute__((ext_vector_type(8)));
typedef short s16x4 __attribute__((ext_vector_type(4)));
typedef float f32x16 __attribute__((ext_vector_type(16)));
typedef float f32x4 __attribute__((ext_vector_type(4)));
typedef unsigned u32x4 __attribute__((ext_vector_type(4)));
template <class A, class Bt> struct same_t { static constexpr bool v = false; };
template <class A> struct same_t<A, A> { static constexpr bool v = true; };

#define KSWZ(row, colB) ((row) * 256 + ((colB) ^ (((row) & 7) << 4)))
#define SBAR() __builtin_amdgcn_sched_barrier(0)
__device__ __forceinline__ int v_st(int k, int c) { const int kk = (k & ~0xC) | ((k & 4) << 1) | ((k & 8) >> 1); return ((kk >> 3) * 4 + (c >> 5)) * 512 + ((kk & 7) * 32 + (c & 31)) * 2; }
__device__ __forceinline__ int v_rd_base(int lane) { return ((lane & 3) << 3) | (((lane >> 2) & 3) << 6) | (((lane >> 4) & 1) << 5) | (((lane >> 5) & 1) << 8); }
constexpr int v_rd_off(int d0, int ks, int half) { return d0 * 512 + ks * 4096 + half * 2048; }
__device__ __forceinline__ int crow(int r, int hi) { return (r & 3) + 8 * (r >> 2) + 4 * hi; }
__device__ __forceinline__ unsigned cvtpk(float lo, float hi) {
    unsigned r; asm volatile("v_cvt_pk_bf16_f32 %0, %1, %2" : "=v"(r) : "v"(lo), "v"(hi)); return r;
}
__device__ __forceinline__ bf16x8 pack8(f32x4 a, f32x4 b) {
    u32x4 w = {cvtpk(a[0], a[1]), cvtpk(a[2], a[3]), cvtpk(b[0], b[1]), cvtpk(b[2], b[3])};
    return *reinterpret_cast<bf16x8*>(&w);
}
template <class T> __device__ __forceinline__ bf16x8 load8(const T* p) {
    if constexpr (same_t<T, float>::v) { return pack8(*(const f32x4*)p, *(const f32x4*)(p + 4)); }
    else { return *reinterpret_cast<const bf16x8*>(p); }
}
__device__ __forceinline__ void mask_tile(f32x16& p0, f32x16& p1, int dq, unsigned W) {
    const float NEG = -__builtin_inff();
#pragma unroll
    for (int r = 0; r < 16; ++r) {
        const int c = (r & 3) + 8 * (r >> 2);
        if ((unsigned)(dq - c) >= W) p0[r] = NEG;
        if ((unsigned)(dq - c - 32) >= W) p1[r] = NEG;
    }
}
typedef unsigned u32x2 __attribute__((ext_vector_type(2)));
__device__ __forceinline__ void bitmask_tile(f32x16& p0, f32x16& p1, u32x2 w, int hi) {
    const float NEG = -__builtin_inff();
    const unsigned a = w[0] >> (4 * hi), b = w[1] >> (4 * hi);
#pragma unroll
    for (int r = 0; r < 16; ++r) {
        const int c = (r & 3) + 8 * (r >> 2);
        if (!((a >> c) & 1u)) p0[r] = NEG;
        if (!((b >> c) & 1u)) p1[r] = NEG;
    }
}
template <bool HALFQK> __device__ __forceinline__ void partialSM(f32x16& p0, f32x16& p1, float& m_reg, float& mn, float& alpha) {
    constexpr float SCALE = HALFQK ? 0.125f : 0.08838834764831845f;
    float pmax = p0[0]; for (int r = 1; r < 16; ++r) pmax = fmaxf(pmax, p0[r]); for (int r = 0; r < 16; ++r) pmax = fmaxf(pmax, p1[r]);
    { auto rr = __builtin_amdgcn_permlane32_swap(__float_as_uint(pmax), __float_as_uint(pmax), false, false);
      pmax = fmaxf(__uint_as_float(rr[0]), __uint_as_float(rr[1])); }
    constexpr float C2 = 1.4426950408889634f * SCALE;
    if (__builtin_expect(__all((pmax - m_reg) * SCALE <= THR), 1)) { mn = m_reg; alpha = 1.f; }
    else { mn = fmaxf(m_reg, pmax); alpha = __builtin_amdgcn_exp2f((m_reg - mn) * C2); m_reg = mn; }
    const float mnL = -mn * C2;
    for (int r = 0; r < 16; ++r) p0[r] = fmaf(p0[r], C2, mnL); for (int r = 0; r < 16; ++r) p1[r] = fmaf(p1[r], C2, mnL);
    for (int r = 0; r < 16; ++r) p0[r] = __builtin_amdgcn_exp2f(p0[r]);
}
__device__ __forceinline__ void finishSM(f32x16& p0, f32x16& p1, float alpha, float& l_reg, bf16x8& pa0, bf16x8& pa1, bf16x8& pa2, bf16x8& pa3) {
    for (int r = 0; r < 16; ++r) p1[r] = __builtin_amdgcn_exp2f(p1[r]);
    float ps = 0; for (int r = 0; r < 16; ++r) ps += p0[r]; for (int r = 0; r < 16; ++r) ps += p1[r];
    { auto rr = __builtin_amdgcn_permlane32_swap(__float_as_uint(ps), __float_as_uint(ps), false, false);
      ps = __uint_as_float(rr[0]) + __uint_as_float(rr[1]); }
    l_reg = l_reg * alpha + ps;
#define PK4(P, B_, OUT) do { unsigned a0 = cvtpk(P[B_+0], P[B_+1]), a1 = cvtpk(P[B_+2], P[B_+3]);                          \
        unsigned b0 = cvtpk(P[B_+4], P[B_+5]), b1 = cvtpk(P[B_+6], P[B_+7]);                                             \
        auto r0 = __builtin_amdgcn_permlane32_swap(a0, b0, false, false); auto r1 = __builtin_amdgcn_permlane32_swap(a1, b1, false, false); \
        u32x4 w = {r0[0], r1[0], r0[1], r1[1]}; OUT = *reinterpret_cast<bf16x8*>(&w); } while (0)
    PK4(p0, 0, pa0); PK4(p0, 8, pa1); PK4(p1, 0, pa2); PK4(p1, 8, pa3);
#undef PK4
}
template <int KB, bool SK, bool HALFQK>
__device__ __forceinline__ void qkt(f32x16& p0, f32x16& p1, const char* K_lds, int r32, int hi, const bf16x8* qr, bool act, int koff) {
    if (SK && !act) { const float NEG = -__builtin_inff();
#pragma unroll
        for (int r = 0; r < 16; ++r) { p0[r] = NEG; p1[r] = NEG; } return; }
    p0 = f32x16{}; p1 = f32x16{};
    const char* kb[4];
#pragma unroll
    for (int dd = 0; dd < 4; ++dd) kb[dd] = K_lds + KB * SHM_K + KSWZ(r32, (dd * 16 + hi * 8) * 2) + koff;
#pragma unroll
    for (int d0 = 0; d0 < (HALFQK ? 4 : 8); ++d0) { const char* a = kb[d0 & 3] + (d0 >> 2) * 128;
        bf16x8 b0 = *reinterpret_cast<const bf16x8*>(a);
        bf16x8 b1 = *reinterpret_cast<const bf16x8*>(a + 32 * 256);
        p0 = __builtin_amdgcn_mfma_f32_32x32x16_bf16(b0, qr[d0], p0, 0, 0, 0);
        p1 = __builtin_amdgcn_mfma_f32_32x32x16_bf16(b1, qr[d0], p1, 0, 0, 0); }
}
template <int VB, bool SK>
__device__ __forceinline__ void pv_tile(f32x16* o, int vb0, bf16x8 pa0, bf16x8 pa1, bf16x8 pa2, bf16x8 pa3, bool act) {
    if (SK && !act) return;
#define TRRD(dst, off) asm volatile("ds_read_b64_tr_b16 %0, %1 offset:%2" : "=&v"(dst) : "v"(vb0), "i"(off) : "memory")
#define PV_D0(d0) do { s16x4 l0, l1, l2, l3, h0, h1, h2, h3; constexpr int b_ = VB * SHM_V + v_rd_off(d0, 0, 0);     \
        TRRD(l0, b_); TRRD(h0, b_ + 2048); TRRD(l1, b_ + 4096); TRRD(h1, b_ + 6144); TRRD(l2, b_ + 8192); TRRD(h2, b_ + 10240); TRRD(l3, b_ + 12288); TRRD(h3, b_ + 14336); \
        asm volatile("s_waitcnt lgkmcnt(0)" ::: "memory"); SBAR();                 \
        o[d0] = __builtin_amdgcn_mfma_f32_32x32x16_bf16(pa0, (bf16x8){l0[0], l0[1], l0[2], l0[3], h0[0], h0[1], h0[2], h0[3]}, o[d0], 0, 0, 0);   \
        o[d0] = __builtin_amdgcn_mfma_f32_32x32x16_bf16(pa1, (bf16x8){l1[0], l1[1], l1[2], l1[3], h1[0], h1[1], h1[2], h1[3]}, o[d0], 0, 0, 0);   \
        o[d0] = __builtin_amdgcn_mfma_f32_32x32x16_bf16(pa2, (bf16x8){l2[0], l2[1], l2[2], l2[3], h2[0], h2[1], h2[2], h2[3]}, o[d0], 0, 0, 0);   \
        o[d0] = __builtin_amdgcn_mfma_f32_32x32x16_bf16(pa3, (bf16x8){l3[0], l3[1], l3[2], l3[3], h3[0], h3[1], h3[2], h3[3]}, o[d0], 0, 0, 0); } while (0)
    PV_D0(0); PV_D0(1); PV_D0(2); PV_D0(3);
#undef PV_D0
#undef TRRD
}

constexpr int QS = 1536, KVS = 4096;
template <class TIn, class TOut> struct BlockRef { const TIn* Q; const TIn* K; const TIn* V; TOut* O; int P0; int koff; const unsigned* mask; };
template <class TIn> struct Seam {
    bf16x8 qr[8];
    bf16x8 st_v0, st_v1, st_k0, st_k1; f32x4 sf0, sf1, sf2, sf3;
    f32x4 tq[16];
};
__device__ __forceinline__ int swa_jlo(int P0, int W) { const int lowk = P0 - W + 1; return lowk > 0 ? lowk / KVBLK : 0; }
#define ROW(p, k0, rr) ((p) + (size_t)((k0) + (rr)) * KVS + sc)
#define VMW() asm volatile("s_waitcnt vmcnt(0)" ::: "memory")
#define VMWN(n) asm volatile("s_waitcnt vmcnt(%0)" :: "i"(n) : "memory")
#define SLOAD_H(Kp, Vp, k0) do { S.st_v0 = load8<TIn>(ROW(Vp, k0, sr)); S.st_v1 = load8<TIn>(ROW(Vp, k0, 32 + sr));              \
                         S.st_k0 = load8<TIn>(ROW(Kp, k0, sr)); S.st_k1 = load8<TIn>(ROW(Kp, k0, 32 + sr)); } while (0)
#define SWRITE_HK(bf) do { *(bf16x8*)(K_lds + (bf) * SHM_K + kws) = S.st_k0; *(bf16x8*)(K_lds + (bf) * SHM_K + kws + 32 * 256) = S.st_k1; } while (0)
#define SWRITE_HV(bf) do { *(bf16x8*)(V_lds + (bf) * SHM_V + vst0) = S.st_v0; *(bf16x8*)(V_lds + (bf) * SHM_V + vst1) = S.st_v1; } while (0)
#define SWRITE_H(bf) do { SWRITE_HV(bf); SWRITE_HK(bf); } while (0)
#define SLOAD_F(p, k0) do { S.sf0 = *(const f32x4*)ROW(p, k0, sr); S.sf1 = *(const f32x4*)(ROW(p, k0, sr) + 4);                \
                            S.sf2 = *(const f32x4*)ROW(p, k0, 32 + sr); S.sf3 = *(const f32x4*)(ROW(p, k0, 32 + sr) + 4); } while (0)
#define SWRITE_KF(bf) do { *(bf16x8*)(K_lds + (bf) * SHM_K + kws) = pack8(S.sf0, S.sf1); *(bf16x8*)(K_lds + (bf) * SHM_K + kws + 32 * 256) = pack8(S.sf2, S.sf3); } while (0)
#define SWRITE_VF(bf) do { *(bf16x8*)(V_lds + (bf) * SHM_V + vst0) = pack8(S.sf0, S.sf1); *(bf16x8*)(V_lds + (bf) * SHM_V + vst1) = pack8(S.sf2, S.sf3); } while (0)
template <class TIn, class TOut, bool HALFQK>
__device__ __forceinline__ void causal_swa_prime(const BlockRef<TIn, TOut>& cur, int W, char* lds, Seam<TIn>& S) {
    constexpr bool F32 = same_t<TIn, float>::v;
    const int tid = otid_(), wid = __builtin_amdgcn_readfirstlane(tid >> 6), lane = tid & 63, r32 = lane & 31, hi = lane >> 5;
    const int sr = tid >> 4, sc = (tid & 15) * 8, kws = KSWZ(sr, sc * 2); char* K_lds = lds + 2 * SHM_V;
    const int kb0 = swa_jlo(cur.P0, W) * KVBLK;
    for (int d0 = 0; d0 < (HALFQK ? 4 : 8); ++d0) S.qr[d0] = load8<TIn>(cur.Q + (size_t)(wid * QBLK + r32) * QS + d0 * 16 + hi * 8);
    if constexpr (F32) { SLOAD_F((const float*)cur.K, kb0); VMW(); SWRITE_KF(0); SBAR(); SLOAD_F((const float*)cur.V, kb0); }
    else { SLOAD_H(cur.K, cur.V, kb0); VMW(); SWRITE_HK(0); }
    __syncthreads();
}
template <class TIn, class TOut, bool HALFQK, bool MASKED, int OS>
__device__ __forceinline__ void causal_swa_block(const BlockRef<TIn, TOut>& cur, const BlockRef<TIn, TOut>& nxt, int skv, int W, char* lds, Seam<TIn>& S) {
    constexpr bool F32 = same_t<TIn, float>::v;
    const int tid = otid_(), wid = __builtin_amdgcn_readfirstlane(tid >> 6), lane = tid & 63, r32 = lane & 31, hi = lane >> 5;
    const int j_lo = swa_jlo(cur.P0, W);
    int j_hi = (cur.P0 + QB - 1) / KVBLK + 1; if (j_hi > skv / KVBLK) j_hi = skv / KVBLK;
    const int NT = j_hi - j_lo;
    const int kbn = swa_jlo(nxt.P0, W) * KVBLK;
    const int qlo = cur.P0 + wid * QBLK, qm = qlo + r32 - 4 * hi;
    char* V_lds = lds; char* K_lds = lds + 2 * SHM_V;
    float* ws = (float*)(lds + 2 * SHM_V + 2 * SHM_K) + wid * 64; float* li_l = ws, * al_l = ws + 32;
    float m_reg = -1e30f, l_reg = 0; f32x16 o[4] = {};
    const int sr = tid >> 4, sc = (tid & 15) * 8, vst0 = v_st(sr, sc), vst1 = v_st(32 + sr, sc), kws = KSWZ(sr, sc * 2);
    const int vb0 = (int)(uintptr_t)V_lds + v_rd_base(lane);
    const TIn* Kh = cur.K; const TIn* Vh = cur.V;
#define RESC(a) do { if (__any((a) < 1.f)) { if (hi == 0) al_l[r32] = (a); asm volatile("s_waitcnt lgkmcnt(0)" ::: "memory");              \
                     for (int d_ = 0; d_ < 4; ++d_) for (int r = 0; r < 16; ++r) o[d_][r] *= al_l[crow(r, hi)]; } } while (0)
#define KBASE(t) ((j_lo + (t)) * KVBLK)
#define ACT(t) (KBASE(t) <= qlo + QBLK - 1 && KBASE(t) + KVBLK - 1 >= qlo - W + 1)
#define MASKT(P0_, P1_, t) do { if constexpr (MASKED) bitmask_tile(P0_, P1_, mw, hi);   \
        else { const int kb_ = KBASE(t); if ((!SK || ACT(t)) && (kb_ + KVBLK - 1 > qlo || kb_ <= qlo + QBLK - 1 - W)) mask_tile(P0_, P1_, qm - kb_, (unsigned)W); } } while (0)
    const unsigned moff = (unsigned)((wid * QBLK + r32) * 1024 + 8 * j_lo); u32x2 mw = {0u, 0u};
#define MLOAD(t) do { if constexpr (MASKED) mw = *(const u32x2*)((const char*)cur.mask + (moff + 8u * (unsigned)(t))); } while (0)
    constexpr int NQL = F32 ? 16 : (HALFQK ? 4 : 8);
    constexpr bool SK = WSKIP && !F32;
#define SEAM_K0() do { VMWN(NQL); if constexpr (F32) { SWRITE_KF(0); SBAR(); SLOAD_F((const float*)nxt.V, kbn); } else { SWRITE_HK(0); } SBAR(); } while (0)
    f32x16 pA0, pA1, pB0, pB1; float mnA, mnB, alA, alB; bf16x8 pa0, pa1, pa2, pa3;
    if constexpr (F32) { VMW(); SWRITE_VF(0); SBAR(); } else { SWRITE_HV(0); SBAR(); }
    if (NT > 1) { if constexpr (F32) SLOAD_F((const float*)Kh, KBASE(1)); else SLOAD_H(Kh, Vh, KBASE(1)); }
    SBAR(); qkt<0, SK, HALFQK>(pA0, pA1, K_lds, r32, hi, S.qr, ACT(0), cur.koff); MLOAD(0);
    if constexpr (F32) { if (NT > 1) { VMW(); SWRITE_KF(1); SBAR(); SLOAD_F((const float*)Vh, KBASE(1)); } }
    MASKT(pA0, pA1, 0); partialSM<HALFQK>(pA0, pA1, m_reg, mnA, alA);
    if (NT > 1) { VMW(); if constexpr (F32) { SWRITE_VF(1); SBAR(); if (NT > 2) SLOAD_F((const float*)Kh, KBASE(2)); } else SWRITE_H(1); }
    __syncthreads();
#define HALF_STEP(PX0, PX1, mnX, alX, PY0, PY1, alY, t, KB, VB, SB) do {                                                      \
        SBAR(); qkt<KB, SK, HALFQK>(PX0, PX1, K_lds, r32, hi, S.qr, ACT(t), cur.koff); MLOAD(t);                                             \
        finishSM(PY0, PY1, alY, l_reg, pa0, pa1, pa2, pa3); SBAR();                                                           \
        if ((t) + 1 < NT) { if constexpr (F32) { VMW(); SWRITE_KF(SB); SBAR(); SLOAD_F((const float*)Vh, KBASE((t) + 1)); }  \
                            else { SLOAD_H(Kh, Vh, KBASE((t) + 1)); } SBAR(); }                                               \
        pv_tile<VB, SK>(o, vb0, pa0, pa1, pa2, pa3, ACT((t) - 1)); MASKT(PX0, PX1, (t)); partialSM<HALFQK>(PX0, PX1, m_reg, mnX, alX);                                        \
        __syncthreads();                                                                                                      \
        if ((t) + 1 < NT) { VMW(); if constexpr (F32) { SWRITE_VF(SB); SBAR(); if ((t) + 2 < NT) SLOAD_F((const float*)Kh, KBASE((t) + 2)); } \
                            else { SWRITE_H(SB); } }                                                                          \
        RESC(alX); __syncthreads(); } while (0)
    for (int t = 1; t + 1 < NT; t += 2) {
        HALF_STEP(pB0, pB1, mnB, alB, pA0, pA1, alA, t, 1, 0, 0);
        HALF_STEP(pA0, pA1, mnA, alA, pB0, pB1, alB, t + 1, 0, 1, 1);
    }
    const bool even = (NT & 1) == 0;
    if (even) { SBAR(); qkt<1, SK, HALFQK>(pB0, pB1, K_lds, r32, hi, S.qr, ACT(NT - 1), cur.koff); MLOAD(NT - 1); SBAR(); }
#define QROW(e) (nxt.Q + (size_t)(wid * QBLK + r32) * QS + ((e) >> 1) * 16 + hi * 8 + ((e) & 1) * 4)
    if constexpr (F32) { SLOAD_F((const float*)nxt.K, kbn); SBAR();
#pragma unroll
        for (int e = 0; e < 8; ++e) S.tq[e] = *(const f32x4*)QROW(e); }
    else { SLOAD_H(nxt.K, nxt.V, kbn); SBAR();
#pragma unroll
        for (int d0 = 0; d0 < (HALFQK ? 4 : 8); ++d0) S.qr[d0] = load8<TIn>(nxt.Q + (size_t)(wid * QBLK + r32) * QS + d0 * 16 + hi * 8); }
    SBAR();
    finishSM(pA0, pA1, alA, l_reg, pa0, pa1, pa2, pa3); SBAR();
    if constexpr (F32) {
#pragma unroll
        for (int e = 8; e < 16; ++e) S.tq[e] = *(const f32x4*)QROW(e); SBAR(); }
#undef QROW
    pv_tile<0, SK>(o, vb0, pa0, pa1, pa2, pa3, ACT(even ? NT - 2 : NT - 1));
    if (even) { MASKT(pB0, pB1, NT - 1); partialSM<HALFQK>(pB0, pB1, m_reg, mnB, alB); __syncthreads(); RESC(alB);
        finishSM(pB0, pB1, alB, l_reg, pa0, pa1, pa2, pa3); SBAR(); pv_tile<1, SK>(o, vb0, pa0, pa1, pa2, pa3, ACT(NT - 1)); }
    SBAR(); SEAM_K0();
    if (hi == 0) li_l[r32] = l_reg; asm volatile("s_waitcnt lgkmcnt(0)" ::: "memory");
    float rli[16];
#pragma unroll
    for (int r = 0; r < 16; ++r) rli[r] = __builtin_amdgcn_rcpf(li_l[crow(r, hi)]);
    TOut* Ow = cur.O + (size_t)(wid * QBLK) * OS;
#pragma unroll
    for (int r = 0; r < 16; ++r) { const int orow = crow(r, hi);
#pragma unroll
        for (int d0 = 0; d0 < 4; ++d0) { const float v = o[d0][r] * rli[r];
            if constexpr (same_t<TOut, float>::v) { Ow[(size_t)orow * OS + d0 * 32 + r32] = v; }
            else { const float vn = __shfl_xor(v, 1);
                   if ((r32 & 1) == 0) *(unsigned*)(Ow + (size_t)orow * OS + d0 * 32 + r32) = cvtpk(v, vn); } } }
    if constexpr (F32) {
#pragma unroll
        for (int d0 = 0; d0 < 8; ++d0) S.qr[d0] = pack8(S.tq[2 * d0], S.tq[2 * d0 + 1]); }
    __syncthreads();
#undef RESC
#undef KBASE
#undef ACT
#undef MASKT
#undef MLOAD
#undef SEAM_K0
#undef HALF_STEP
}
#undef ROW
#undef VMW
#undef VMWN
#undef SLOAD_H
#undef SWRITE_HK
#undef SWRITE_HV
#undef SWRITE_H
#undef SLOAD_F
#undef SWRITE_KF
#undef SWRITE_VF
}
#ifndef PROBE
#define PROBE 0
#endif
constexpr int NWAVES = 8;
constexpr int NB = 2, T = 8192, M = NB * T, DM = 1024, FF = 2816, NIN = 8520, NLAYER = 2;
constexpr float NORM_EPS = 1e-6f;
constexpr size_t MiB = 1u << 20;
constexpr size_t WS_CTL = 0, CTL_ZERO_BYTES = 1 * MiB;
constexpr size_t WS_WF = 1 * MiB;
constexpr size_t WS_WF_DOWN = WS_WF + 11 * MiB;
constexpr size_t WS_WM = 18 * MiB;
constexpr size_t WS_WM_BR = WS_WM + 17 * MiB, WS_WM_OUT = WS_WM + 20 * MiB;
constexpr size_t WS_XN = 40 * MiB;
constexpr size_t WS_Q3 = 72 * MiB;
constexpr size_t WS_ZR = 120 * MiB;
constexpr size_t WS_R2 = 248 * MiB;
constexpr size_t WS_END = 280 * MiB;
constexpr size_t WS_MG = WS_ZR + 96 * MiB;
constexpr size_t WS_YRAW = WS_WF;
constexpr size_t WS_A8 = WS_WM;
constexpr size_t WS_KID = WS_WM + 8 * MiB;
constexpr size_t WS_RDOTK = WS_WF + 16 * MiB;
constexpr int QP = 1536, ZP = 4096;
constexpr int ZC_DK = 0, ZC_DV = 512, ZC_QI = 1024, ZC_KI = 1536, ZC_WI = 1600, ZC_RK = 1792, ZC_RV = 2304, ZC_WC = 2816, ZC_AC = 2880, ZC_GC = 2944, ZC_FK = 3072, ZC_FV = 3584;
constexpr int CW_TMO = 0;
constexpr int CW_BAR = 4096;
constexpr int CW_Q = 8192;
constexpr int CW_PROBE = 2048;
constexpr int CW_DONE = 12288;
constexpr int LDS_MISC = 160 * 1024 - 256;
constexpr int LDS_BYTES = 160 * 1024;

#define GAS __attribute__((address_space(1)))
#define LAS __attribute__((address_space(3)))
typedef unsigned short bf16;
typedef unsigned v4u __attribute__((ext_vector_type(4)));
typedef unsigned v2u __attribute__((ext_vector_type(2)));
typedef float f32x4 __attribute__((ext_vector_type(4)));
typedef float f32x2 __attribute__((ext_vector_type(2)));
typedef float f32x16 __attribute__((ext_vector_type(16)));
typedef short bf16x8 __attribute__((ext_vector_type(8)));
typedef GAS unsigned gu32;
#define RLX_AGENT __ATOMIC_RELAXED, __HIP_MEMORY_SCOPE_AGENT
#define LDS_WAIT() asm volatile("s_waitcnt lgkmcnt(0)" ::: "memory")
#define VM_WAIT() asm volatile("s_waitcnt vmcnt(0)" ::: "memory")
__device__ __forceinline__ unsigned f2bf(float f) { unsigned u = __builtin_bit_cast(unsigned, f); return (u + 0x7fffu + ((u >> 16) & 1u)) >> 16; }
__device__ __forceinline__ unsigned pk2(float lo, float hi) { return f2bf(lo) | (f2bf(hi) << 16); }
__device__ __forceinline__ float bflo(unsigned w) { return __uint_as_float(w << 16); }
__device__ __forceinline__ float bfhi(unsigned w) { return __uint_as_float(w & 0xffff0000u); }
__device__ __forceinline__ float bf1(bf16 h) { return __uint_as_float((unsigned)h << 16); }
__device__ __forceinline__ float wave_sum(float v) {
#pragma unroll
    for (int o = 1; o < 64; o <<= 1) v += __shfl_xor(v, o);
    return v;
}
__device__ __forceinline__ float sigm(float x) { return __builtin_amdgcn_rcpf(1.0f + __expf(-x)); }

#define XB_TMO      128
#define XB_XCNT(j)  (256  + 64 * (j))
#define XB_XSUB(j)  (1280 + 64 * (j))
#define XB_XGEN(j)  (2304 + 64 * (j))
#define XB_TOP      3328
#define XB_TOPGEN   3392
#define XCD_BAR_WORDS 3456
#define XB_SPIN_CAP (1u << 22)
__device__ __forceinline__ unsigned xb_ld(unsigned* p)              { return __hip_atomic_load(p, __ATOMIC_RELAXED, __HIP_MEMORY_SCOPE_AGENT); }
__device__ __forceinline__ unsigned xb_add(unsigned* p, unsigned v) { return __hip_atomic_fetch_add(p, v, __ATOMIC_RELAXED, __HIP_MEMORY_SCOPE_AGENT); }
__device__ __forceinline__ unsigned xb_xcc_id() { return (unsigned)__builtin_amdgcn_s_getreg((3 << 11) | 20) & 0xFu; }
#define XB_SPIN(cond, bar) do { unsigned _sp = 0; while (cond) { __builtin_amdgcn_s_sleep(1); \
    if ((++_sp & 255u) == 0u) { if (xb_ld(&(bar)[XB_TMO])) break; if (_sp > XB_SPIN_CAP) { atomicAdd(&(bar)[XB_TMO], 1u); break; } } } } while (0)
struct XcdBarrier { unsigned* bar; unsigned x; volatile LAS unsigned* st; };
__device__ __forceinline__ XcdBarrier xcd_barrier_post(unsigned* bar, volatile LAS unsigned* st) {
    XcdBarrier b; b.bar = bar; b.x = xb_xcc_id(); b.st = st;
    if (threadIdx.x == 0) (void)xb_add(&bar[XB_XCNT(b.x)], 1u);
    return b;
}
__device__ __forceinline__ void xcd_barrier_complete(unsigned* bar, unsigned x, unsigned& nloc, unsigned& nx) {
    const unsigned G = gridDim.x * gridDim.y * gridDim.z;
    unsigned sum, cnt, mine, sp = 0u;
    for (;;) {
        sum = 0u; cnt = 0u; mine = 0u;
#pragma unroll
        for (unsigned j = 0; j < 16; ++j) { const unsigned c = xb_ld(&bar[XB_XCNT(j)]); sum += c; cnt += (c > 0u) ? 1u : 0u; mine = (j == x) ? c : mine; }
        if (sum == G) break;
        __builtin_amdgcn_s_sleep(1);
        if ((++sp & 255u) == 0u) { if (xb_ld(&bar[XB_TMO])) break; if (sp > XB_SPIN_CAP) { atomicAdd(&bar[XB_TMO], 1u); break; } }
    }
    nloc = mine > 0u ? mine : 1u; nx = cnt > 0u ? cnt : 1u;
}
__device__ __forceinline__ void xcd_barrier(const XcdBarrier& b) {
    asm volatile("s_waitcnt vmcnt(0)" ::: "memory");
    __syncthreads();
    if (threadIdx.x == 0) {
        unsigned* bar = b.bar;
        __builtin_amdgcn_s_waitcnt(0);
        unsigned nloc = b.st[0], nx = b.st[1];
        if (nloc == 0u) { xcd_barrier_complete(bar, b.x, nloc, nx); b.st[0] = nloc; b.st[1] = nx; }
        const unsigned old = xb_add(&bar[XB_XSUB(b.x)], 1u);
        const unsigned gen = old / nloc;
        if (old + 1u == (gen + 1u) * nloc) {
            __builtin_amdgcn_fence(__ATOMIC_RELEASE, "agent");
            asm volatile("s_waitcnt vmcnt(0)" ::: "memory");
            const unsigned og = xb_add(&bar[XB_TOP], 1u);
            const unsigned tg = og / nx;
            if (og + 1u == (tg + 1u) * nx) xb_add(&bar[XB_TOPGEN], 1u);
            else XB_SPIN(xb_ld(&bar[XB_TOPGEN]) == tg, bar);
            __builtin_amdgcn_fence(__ATOMIC_ACQUIRE, "agent");
            xb_add(&bar[XB_XGEN(b.x)], 1u);
            asm volatile("s_waitcnt vmcnt(0)" ::: "memory");
        } else {
            XB_SPIN(xb_ld(&bar[XB_XGEN(b.x)]) == gen, bar);
            __builtin_amdgcn_fence(__ATOMIC_ACQUIRE, "agent");
            asm volatile("s_waitcnt vmcnt(0)" ::: "memory");
        }
    }
    __syncthreads();
}

struct MapIdent { const float* W; int ld; __device__ __forceinline__ const float* col(int n) const { return W + n; } };
struct MapUp {
    const float* G; const float* U; int ld;
    __device__ __forceinline__ const float* col(int n) const { const int g = n >> 5, j = n & 31; return j < 16 ? G + 16 * g + j : U + 16 * g + (j - 16); }
};
struct MapWin {
    const float* W; int ld;
    __device__ __forceinline__ const float* col(int n) const {
        int src;
        if (n < 512) src = n; else if (n < 1024) src = 2120 + (n - 512); else if (n < 1536) src = 3912 + (n - 1024);
        else if (n < 5632) { const int z = n - 1536; if (z < 1608) src = 512 + z; else if (z < 1792) src = -1; else if (z < 3072) src = 840 + z; else src = 1352 + z; }
        else src = 5448 + (n - 5632);
        return src < 0 ? nullptr : W + src;
    }
};
template <class Map>
__device__ __forceinline__ void conv_item(const Map& mp, int K, bf16* WT, LAS float* scr, int item, int nblk, int lane) {
    const int kb = item / nblk, nb = item % nblk, k0 = 32 * kb, n0 = 32 * nb;
    const float* cp = mp.col(n0 + (lane & 31)); const size_t ld = (size_t)mp.ld;
#pragma unroll
    for (int i = 0; i < 16; ++i) { const int kk = 2 * i + (lane >> 5); scr[kk * 33 + (lane & 31)] = cp ? cp[(size_t)(k0 + kk) * ld] : 0.f; }
    LDS_WAIT(); asm volatile("" ::: "memory");
    const int c = lane & 3;
#pragma unroll
    for (int j = 0; j < 2; ++j) { const int n = (lane >> 2) + 16 * j; const LAS float* s = scr + (8 * c) * 33 + n;
        v4u o; o.x = pg8::cvt_pk_bf16(s[0 * 33], s[1 * 33]); o.y = pg8::cvt_pk_bf16(s[2 * 33], s[3 * 33]); o.z = pg8::cvt_pk_bf16(s[4 * 33], s[5 * 33]); o.w = pg8::cvt_pk_bf16(s[6 * 33], s[7 * 33]);
        *(GAS v4u*)(WT + (size_t)(n0 + n) * K + k0 + 8 * c) = o; }
    LDS_WAIT(); asm volatile("" ::: "memory");
}
__host__ __device__ constexpr int conv_items(int K, int N) { return (K / 32) * (N / 32); }

template <bool INB, bool OUTB>
__device__ __forceinline__ void rownorm_rows(const void* base, const bf16* Y, float s, const float* gpost, void* out, const float* gnext, bf16* XN, int gw, int NGW, int lane, float oscale = 1.f) {
    constexpr int R = 4;
    for (int m0 = gw; m0 < M; m0 += R * NGW) {
        v2u xb[R][4], yw[R][4]; f32x4 xf[R][4];
#pragma unroll
        for (int q = 0; q < R; ++q) { const size_t m = (size_t)(m0 + q * NGW);
#pragma unroll
            for (int j = 0; j < 4; ++j) {
                if constexpr (INB) xb[q][j] = ((const GAS v2u*)((const bf16*)base + m * DM))[lane + 64 * j];
                else xf[q][j] = ((const GAS f32x4*)((const float*)base + m * DM))[lane + 64 * j];
                if (Y) yw[q][j] = ((const GAS v2u*)(Y + m * DM))[lane + 64 * j]; } }
#pragma unroll
        for (int q = 0; q < R; ++q) { const size_t m = (size_t)(m0 + q * NGW);
            f32x4 v[4];
#pragma unroll
            for (int j = 0; j < 4; ++j) { if constexpr (INB) v[j] = (f32x4){bflo(xb[q][j].x), bfhi(xb[q][j].x), bflo(xb[q][j].y), bfhi(xb[q][j].y)}; else v[j] = xf[q][j]; }
            if (Y) {
                f32x4 y[4]; float ss = 0.f;
#pragma unroll
                for (int j = 0; j < 4; ++j) { const v2u w = yw[q][j]; y[j] = (f32x4){bflo(w.x), bfhi(w.x), bflo(w.y), bfhi(w.y)};
                    ss += (y[j].x * y[j].x + y[j].y * y[j].y) + (y[j].z * y[j].z + y[j].w * y[j].w); }
                const float r = s * __builtin_amdgcn_rsqf(wave_sum(ss) * (1.f / DM) + NORM_EPS);
#pragma unroll
                for (int j = 0; j < 4; ++j) { const f32x4 g = ((const GAS f32x4*)gpost)[lane + 64 * j]; v[j] = v[j] + y[j] * g * r;
                    if constexpr (OUTB) { v2u w; w.x = pk2(v[j].x, v[j].y); w.y = pk2(v[j].z, v[j].w); ((GAS v2u*)((bf16*)out + m * DM))[lane + 64 * j] = w; }
                    else ((GAS f32x4*)((float*)out + m * DM))[lane + 64 * j] = v[j] * oscale; }
            }
            if (XN) {
                float ss = 0.f;
#pragma unroll
                for (int j = 0; j < 4; ++j) ss += (v[j].x * v[j].x + v[j].y * v[j].y) + (v[j].z * v[j].z + v[j].w * v[j].w);
                const float r = __builtin_amdgcn_rsqf(wave_sum(ss) * (1.f / DM) + NORM_EPS);
#pragma unroll
                for (int j = 0; j < 4; ++j) { const f32x4 g = ((const GAS f32x4*)gnext)[lane + 64 * j]; const f32x4 o = v[j] * g * r;
                    v2u w; w.x = pk2(o.x, o.y); w.y = pk2(o.z, o.w); ((GAS v2u*)(XN + m * DM))[lane + 64 * j] = w; }
            }
        }
    }
}

namespace scan {
template <int CTRL> __device__ __forceinline__ float dpp_add(float x) {
    const int y = __builtin_amdgcn_update_dpp(0, __builtin_bit_cast(int, x), CTRL, 0xF, 0xF, false);
    return x + __builtin_bit_cast(float, y);
}
__device__ __forceinline__ float red8(float x) { x = dpp_add<0xB1>(x); x = dpp_add<0x4E>(x); x = dpp_add<0x141>(x); return x; }
__device__ __forceinline__ float red16(float x) { x = dpp_add<0xB1>(x); x = dpp_add<0x4E>(x); x = dpp_add<0x141>(x); x = dpp_add<0x140>(x); return x; }
__device__ __forceinline__ void ld8(const bf16* p, float (&o)[8]) { const v4u w = *(const GAS v4u*)p; o[0] = bflo(w.x); o[1] = bfhi(w.x); o[2] = bflo(w.y); o[3] = bfhi(w.y); o[4] = bflo(w.z); o[5] = bfhi(w.z); o[6] = bflo(w.w); o[7] = bfhi(w.w); }
}
struct PrepP { const bf16* ZR; bf16* X1; unsigned char* A8; bf16* KI; const float *mu, *w0, *wup, *a0, *aup; };
__device__ __forceinline__ void rwkv_prep(const PrepP& P, LAS unsigned char* lds) {
    const int tid = otid_(), lane = tid & 63, h = __builtin_amdgcn_readfirstlane(tid >> 6), c16 = lane & 15, quad = lane >> 4;
    constexpr int SP = 144;
    LAS unsigned char* TA = lds; LAS unsigned char* AA = lds + 64 * SP;
    bf16x8 bw[4][2], ba[4][2];
#pragma unroll
    for (int ct = 0; ct < 4; ++ct)
#pragma unroll
        for (int s = 0; s < 2; ++s) { const size_t o = (size_t)(32 * s + 8 * quad) * 512 + 64 * h + 16 * ct + c16; const float* gw_ = P.wup + o; const float* ga_ = P.aup + o;
            v4u w; w.x = pk2(gw_[0], gw_[512]); w.y = pk2(gw_[1024], gw_[1536]); w.z = pk2(gw_[2048], gw_[2560]); w.w = pk2(gw_[3072], gw_[3584]); bw[ct][s] = __builtin_bit_cast(bf16x8, w);
            v4u a; a.x = pk2(ga_[0], ga_[512]); a.y = pk2(ga_[1024], ga_[1536]); a.z = pk2(ga_[2048], ga_[2560]); a.w = pk2(ga_[3072], ga_[3584]); ba[ct][s] = __builtin_bit_cast(bf16x8, a); }
    float w0v[4], a0v[4];
#pragma unroll
    for (int ct = 0; ct < 4; ++ct) { w0v[ct] = P.w0[64 * h + 16 * ct + c16]; a0v[ct] = P.a0[64 * h + 16 * ct + c16]; }
    const int stok = tid >> 3, sseg = tid & 7;
#pragma unroll 1
    for (int m0 = blockIdx.x * 64; m0 < M; m0 += gridDim.x * 64) {
        {   const size_t m = (size_t)m0 + stok; const int t = (int)(m & (T - 1));
            *(GAS v4u*)(P.KI + m * 64 + 8 * sseg) = *(const GAS v4u*)(P.ZR + m * ZP + ZC_KI + 8 * sseg);
            float wc[8], ac[8], p8[8];
            scan::ld8(P.ZR + m * ZP + ZC_WC + 8 * sseg, wc); scan::ld8(P.ZR + m * ZP + ZC_AC + 8 * sseg, ac);
            if (t > 0) { scan::ld8(P.ZR + (m - 1) * ZP + ZC_WC + 8 * sseg, p8);
#pragma unroll
                for (int e = 0; e < 8; ++e) wc[e] += (p8[e] - wc[e]) * P.mu[1536 + 8 * sseg + e];
                scan::ld8(P.ZR + (m - 1) * ZP + ZC_AC + 8 * sseg, p8);
#pragma unroll
                for (int e = 0; e < 8; ++e) ac[e] += (p8[e] - ac[e]) * P.mu[1600 + 8 * sseg + e]; }
            else {
#pragma unroll
                for (int e = 0; e < 8; ++e) { wc[e] -= wc[e] * P.mu[1536 + 8 * sseg + e]; ac[e] -= ac[e] * P.mu[1600 + 8 * sseg + e]; } }
            float th[8];
#pragma unroll
            for (int e = 0; e < 8; ++e) th[e] = 1.f - 2.f * __builtin_amdgcn_rcpf(__expf(2.f * wc[e]) + 1.f);
            v4u o; o.x = pk2(th[0], th[1]); o.y = pk2(th[2], th[3]); o.z = pk2(th[4], th[5]); o.w = pk2(th[6], th[7]); *(LAS v4u*)(TA + stok * SP + 16 * sseg) = o;
            v4u q; q.x = pk2(ac[0], ac[1]); q.y = pk2(ac[2], ac[3]); q.z = pk2(ac[4], ac[5]); q.w = pk2(ac[6], ac[7]); *(LAS v4u*)(AA + stok * SP + 16 * sseg) = q;
        }
        __syncthreads();
#pragma unroll 1
        for (int rt = 0; rt < 4; ++rt) {
            f32x4 accw[4], acca[4];
#pragma unroll
            for (int ct = 0; ct < 4; ++ct) { accw[ct] = (f32x4){0.f, 0.f, 0.f, 0.f}; acca[ct] = (f32x4){0.f, 0.f, 0.f, 0.f}; }
#pragma unroll
            for (int s = 0; s < 2; ++s) { const bf16x8 fw = *(const LAS bf16x8*)(TA + (16 * rt + c16) * SP + (32 * s + 8 * quad) * 2), fa = *(const LAS bf16x8*)(AA + (16 * rt + c16) * SP + (32 * s + 8 * quad) * 2);
#pragma unroll
                for (int ct = 0; ct < 4; ++ct) { accw[ct] = __builtin_amdgcn_mfma_f32_16x16x32_bf16(fw, bw[ct][s], accw[ct], 0, 0, 0); acca[ct] = __builtin_amdgcn_mfma_f32_16x16x32_bf16(fa, ba[ct][s], acca[ct], 0, 0, 0); } }
#pragma unroll
            for (int j = 0; j < 4; ++j) { const size_t m = (size_t)m0 + 16 * rt + 4 * quad + j;
#pragma unroll
                for (int ct = 0; ct < 4; ++ct) { const int ch = 64 * h + 16 * ct + c16;
                    const float sg = sigm(w0v[ct] + accw[ct][j]);
                    const float x1 = 1.f - __expf(-0.6065306597126334f * sg);
                    const float a = sigm(a0v[ct] + acca[ct][j]);
                    P.X1[m * 512 + ch] = (bf16)f2bf(x1);
                    P.A8[m * 512 + ch] = (unsigned char)(int)(a * 255.f + 0.5f); } }
        }
        __syncthreads();
    }
}

struct ScanP { const bf16* Q3; const bf16* ZR; const bf16* X1; const unsigned char* A8; bf16* yraw; float* rdotk; const float *mu, *k_k, *k_a, *r_k; };
namespace scan {
constexpr int TB = 32, NBLK = T / TB;
constexpr int CB_W = 0, CB_B = 8192, CB_K = 16384, CB_KW = 24576, CB_V = 40960, CB_BR = 43008, CB_KR = 43136, CB_SA = 43264, CB_YP = 45312, CBSZ = 78080;
constexpr int L_END = 2 * CBSZ;
static_assert(L_END <= LDS_MISC, "scan LDS");
}
__device__ __forceinline__ void rwkv_scan_unit(const ScanP& P, int unit, LAS unsigned char* lds) {
    using namespace scan;
    const int tid = otid_(), wid = __builtin_amdgcn_readfirstlane(tid >> 6), lane = tid & 63;
    const int b = unit >> 5, h = (unit >> 2) & 7, vq = unit & 3;
    const size_t mrow0 = (size_t)b * T;
    if (wid >= 4) {
        const int pw = wid - 4, tokl = lane >> 3, seg = lane & 7, c0 = 8 * seg, hc0 = 64 * h + c0;
        float mu_r[8], mu_k[8], kkv[8], kav[8], rkv[8];
#pragma unroll
        for (int e = 0; e < 8; ++e) { mu_r[e] = P.mu[hc0 + e]; mu_k[e] = P.mu[512 + hc0 + e]; kkv[e] = P.k_k[hc0 + e]; kav[e] = P.k_a[hc0 + e]; rkv[e] = P.r_k[hc0 + e]; }
        const int vc0 = 64 * h + 16 * vq + 2 * seg;
        const float mu_v0 = P.mu[1024 + vc0], mu_v1 = P.mu[1024 + vc0 + 1];
        const int ptid = pw * 64 + lane;
        v4u nr, nrp, nk, nkp, nx; v2u na; unsigned nv, nvp;
#define SCAN_LOAD(nb_) do { const int t_ = (nb_) * TB + 8 * pw + tokl; const size_t m_ = mrow0 + t_, mp_ = t_ > 0 ? m_ - 1 : m_; \
            nr = *(const GAS v4u*)(P.Q3 + m_ * QP + 512 + hc0); nrp = *(const GAS v4u*)(P.Q3 + mp_ * QP + 512 + hc0); \
            nk = *(const GAS v4u*)(P.ZR + m_ * ZP + ZC_RK + hc0); nkp = *(const GAS v4u*)(P.ZR + mp_ * ZP + ZC_RK + hc0); \
            nx = *(const GAS v4u*)(P.X1 + m_ * 512 + hc0); na = *(const GAS v2u*)(P.A8 + m_ * 512 + hc0); \
            nv = *(const GAS unsigned*)(P.ZR + m_ * ZP + ZC_RV + vc0); nvp = *(const GAS unsigned*)(P.ZR + mp_ * ZP + ZC_RV + vc0); } while (0)
#define UNPK8(w_, o_) do { o_[0] = bflo(w_.x); o_[1] = bfhi(w_.x); o_[2] = bflo(w_.y); o_[3] = bfhi(w_.y); o_[4] = bflo(w_.z); o_[5] = bfhi(w_.z); o_[6] = bflo(w_.w); o_[7] = bfhi(w_.w); } while (0)
        SCAN_LOAD(0);
        for (int blk = -1; blk < NBLK; ++blk) {
            const int nb = blk + 1;
            LAS unsigned char* cb = lds + (nb & 1) * CBSZ;
            if (blk >= 1) {
                const int tok = ptid >> 3, v2 = (ptid & 7) * 2;
                const LAS float* YPp = (const LAS float*)(cb + CB_YP) + (tok * 16 + v2) * 16;
                float y0 = 0.f, y1 = 0.f;
#pragma unroll
                for (int q4 = 0; q4 < 4; ++q4) { const f32x4 a = *(const LAS f32x4*)(YPp + 4 * q4), c = *(const LAS f32x4*)(YPp + 16 + 4 * q4); y0 += (a.x + a.y) + (a.z + a.w); y1 += (c.x + c.y) + (c.z + c.w); }
                const float kr = *(const LAS float*)(cb + CB_KR + tok * 4);
                const f32x2 vv = *(const LAS f32x2*)(cb + CB_V + (tok * 16 + v2) * 4);
                y0 += vv.x * kr; y1 += vv.y * kr;
                const size_t m = mrow0 + (size_t)(blk - 1) * TB + tok;
                *(GAS unsigned*)(P.yraw + m * 512 + 64 * h + 16 * vq + v2) = pk2(y0, y1);
                LDS_WAIT(); asm volatile("" ::: "memory");
            }
            if (nb < NBLK) {
                const int t = nb * TB + 8 * pw + tokl; const size_t m = mrow0 + t;
                float r8[8], k8[8], p8[8], x8[8], a8[8];
                const v4u cr = nr, crp = nrp, ck = nk, ckp = nkp, cx = nx; const v2u ca = na; const unsigned cv = nv, cvp = nvp;
                if (nb + 1 < NBLK) SCAN_LOAD(nb + 1);
                UNPK8(cr, r8); UNPK8(ck, k8); UNPK8(cx, x8);
                { const float sc = 1.f / 255.f;
                  a8[0] = (float)(ca.x & 255u) * sc; a8[1] = (float)((ca.x >> 8) & 255u) * sc; a8[2] = (float)((ca.x >> 16) & 255u) * sc; a8[3] = (float)(ca.x >> 24) * sc;
                  a8[4] = (float)(ca.y & 255u) * sc; a8[5] = (float)((ca.y >> 8) & 255u) * sc; a8[6] = (float)((ca.y >> 16) & 255u) * sc; a8[7] = (float)(ca.y >> 24) * sc; }
                float v0 = bflo(cv), v1 = bfhi(cv);
                if (t > 0) {
                    UNPK8(crp, p8);
#pragma unroll
                    for (int e = 0; e < 8; ++e) r8[e] += (p8[e] - r8[e]) * mu_r[e];
                    UNPK8(ckp, p8);
#pragma unroll
                    for (int e = 0; e < 8; ++e) k8[e] += (p8[e] - k8[e]) * mu_k[e];
                    v0 += (bflo(cvp) - v0) * mu_v0; v1 += (bfhi(cvp) - v1) * mu_v1;
                } else {
#pragma unroll
                    for (int e = 0; e < 8; ++e) { r8[e] -= r8[e] * mu_r[e]; k8[e] -= k8[e] * mu_k[e]; }
                    v0 -= v0 * mu_v0; v1 -= v1 * mu_v1;
                }
                float kk8[8]; { float ss = 0.f;
#pragma unroll
                  for (int e = 0; e < 8; ++e) { kk8[e] = k8[e] * kkv[e]; ss += kk8[e] * kk8[e]; }
                  ss = red8(ss); const float inv = 1.f / fmaxf(sqrtf(ss), 1e-12f);
#pragma unroll
                  for (int e = 0; e < 8; ++e) kk8[e] *= inv; }
                float w8[8], bb[8], km[8], wr[8]; float brp = 0.f, krp = 0.f, rkp = 0.f;
#pragma unroll
                for (int e = 0; e < 8; ++e) {
                    w8[e] = 1.f - x8[e];
                    bb[e] = kk8[e] * a8[e]; km[e] = k8[e] * (1.f + (a8[e] - 1.f) * kav[e]);
                    brp += bb[e] * r8[e]; krp += km[e] * r8[e]; rkp += r8[e] * km[e] * rkv[e];
                }
                brp = red8(brp); krp = red8(krp); rkp = red8(rkp);
#pragma unroll
                for (int e = 0; e < 8; ++e) wr[e] = w8[e] * r8[e] - kk8[e] * brp;
                const int ti = 8 * pw + tokl;
                *(LAS f32x4*)(cb + CB_W + (ti * 64 + c0) * 4) = (f32x4){w8[0], w8[1], w8[2], w8[3]}; *(LAS f32x4*)(cb + CB_W + (ti * 64 + c0 + 4) * 4) = (f32x4){w8[4], w8[5], w8[6], w8[7]};
                *(LAS f32x4*)(cb + CB_B + (ti * 64 + c0) * 4) = (f32x4){bb[0], bb[1], bb[2], bb[3]}; *(LAS f32x4*)(cb + CB_B + (ti * 64 + c0 + 4) * 4) = (f32x4){bb[4], bb[5], bb[6], bb[7]};
                *(LAS f32x4*)(cb + CB_K + (ti * 64 + c0) * 4) = (f32x4){km[0], km[1], km[2], km[3]}; *(LAS f32x4*)(cb + CB_K + (ti * 64 + c0 + 4) * 4) = (f32x4){km[4], km[5], km[6], km[7]};
#pragma unroll
                for (int e = 0; e < 8; e += 2) *(LAS f32x4*)(cb + CB_KW + ti * 512 + ((e >> 1) & 1) * 256 + (2 * seg + (e >> 2)) * 16) = (f32x4){kk8[e], wr[e], kk8[e + 1], wr[e + 1]};
                *(LAS f32x2*)(cb + CB_V + (ti * 16 + 2 * seg) * 4) = (f32x2){v0, v1};
                if (seg == 0) { *(LAS float*)(cb + CB_KR + ti * 4) = krp; if (vq == 0) P.rdotk[m * 8 + h] = rkp; }
            }
            __syncthreads();
        }
        { const LAS unsigned char* cb = lds + ((NBLK - 1) & 1) * CBSZ;
          const int tok = ptid >> 3, v2 = (ptid & 7) * 2;
          const LAS float* YPp = (const LAS float*)(cb + CB_YP) + (tok * 16 + v2) * 16;
          float y0 = 0.f, y1 = 0.f;
#pragma unroll
          for (int q4 = 0; q4 < 4; ++q4) { const f32x4 a = *(const LAS f32x4*)(YPp + 4 * q4), c = *(const LAS f32x4*)(YPp + 16 + 4 * q4); y0 += (a.x + a.y) + (a.z + a.w); y1 += (c.x + c.y) + (c.z + c.w); }
          const float kr = *(const LAS float*)(cb + CB_KR + tok * 4);
          const f32x2 vv = *(const LAS f32x2*)(cb + CB_V + (tok * 16 + v2) * 4);
          y0 += vv.x * kr; y1 += vv.y * kr;
          const size_t m = mrow0 + (size_t)(NBLK - 1) * TB + tok;
          *(GAS unsigned*)(P.yraw + m * 512 + 64 * h + 16 * vq + v2) = pk2(y0, y1); }
    } else {
        const int vi = 4 * wid + (lane >> 4), cg = lane & 15;
        f32x2 s01 = {0.f, 0.f}, s23 = {0.f, 0.f};
        __syncthreads();
        __builtin_amdgcn_s_setprio(3);
        const unsigned lo4 = (unsigned)(4 * cg) * 4u;
        for (int blk = 0; blk < NBLK; ++blk) {
            const LAS unsigned char* cb = lds + (blk & 1) * CBSZ;
            f32x4 kwa = *(const LAS f32x4*)(cb + CB_KW + lo4), kwb = *(const LAS f32x4*)(cb + CB_KW + 256 + lo4);
            f32x4 w4 = *(const LAS f32x4*)(cb + CB_W + lo4), b4 = *(const LAS f32x4*)(cb + CB_B + lo4), k4 = *(const LAS f32x4*)(cb + CB_K + lo4);
            float vv = *(const LAS float*)(cb + CB_V + vi * 4);
#pragma unroll 4
            for (int tok = 0; tok < TB; ++tok) {
                const int tn = tok + 1 < TB ? tok + 1 : tok;
                const f32x4 nkwa = *(const LAS f32x4*)(cb + CB_KW + tn * 512 + lo4), nkwb = *(const LAS f32x4*)(cb + CB_KW + tn * 512 + 256 + lo4);
                const f32x4 nw4 = *(const LAS f32x4*)(cb + CB_W + tn * 256 + lo4), nb4 = *(const LAS f32x4*)(cb + CB_B + tn * 256 + lo4), nk4 = *(const LAS f32x4*)(cb + CB_K + tn * 256 + lo4);
                const float nvv = *(const LAS float*)(cb + CB_V + (tn * 16 + vi) * 4);
                f32x2 p = (f32x2){s01.x, s01.x} * (f32x2){kwa.x, kwa.y};
                p += (f32x2){s01.y, s01.y} * (f32x2){kwa.z, kwa.w};
                p += (f32x2){s23.x, s23.x} * (f32x2){kwb.x, kwb.y};
                p += (f32x2){s23.y, s23.y} * (f32x2){kwb.z, kwb.w};
                *(LAS float*)(cb + CB_YP + ((tok * 16 + vi) * 16 + cg) * 4) = p.y;
                const f32x2 t01 = s01 * (f32x2){w4.x, w4.y} + (f32x2){k4.x, k4.y} * vv, t23 = s23 * (f32x2){w4.z, w4.w} + (f32x2){k4.z, k4.w} * vv;
                const float d1 = red16(p.x);
                s01 = t01 - (f32x2){b4.x, b4.y} * d1; s23 = t23 - (f32x2){b4.z, b4.w} * d1;
                kwa = nkwa; kwb = nkwb; w4 = nw4; b4 = nb4; k4 = nk4; vv = nvv;
            }
            __syncthreads();
        }
        __builtin_amdgcn_s_setprio(0);
    }
    __syncthreads();
}

struct Dsa1P { const bf16* ZR; const bf16* KI; unsigned* bitm; gu32* done; };
namespace dsa1 {
constexpr int CAP = 769  , PRUNE_AT = 512, KEEP = 256;
constexpr int L_BUF = 0, L_CNT = 32 * CAP * 4, L_THR = L_CNT + 128, L_THRK = L_THR + 128, L_HIST = ((L_THRK + 128 + 15) / 16) * 16, L_MROW = L_HIST + 8 * 1024, L_QF = L_MROW + 8 * 1024, QFP = 1040, L_END = L_QF + 32 * QFP;
static_assert(L_END <= LDS_MISC, "dsa1 LDS");
__device__ __forceinline__ unsigned packkey(float s, int keyidx) { const unsigned bits = __float_as_uint(s); const unsigned u = bits ^ ((unsigned)((int)bits >> 31) | 0x80000000u); return (u & 0xFFFFE000u) | (unsigned)(8191 - keyidx); }
__device__ __forceinline__ float thr_of(unsigned key) { const unsigned u = key & 0xFFFFE000u; const unsigned bits = (u & 0x80000000u) ? (u ^ 0x80000000u) : ~u; return __uint_as_float(bits); }
__device__ __forceinline__ int wave_prefix_incl(int v) {
    v += __builtin_amdgcn_update_dpp(0, v, 0x111, 0xF, 0xF, true);
    v += __builtin_amdgcn_update_dpp(0, v, 0x112, 0xF, 0xF, true);
    v += __builtin_amdgcn_update_dpp(0, v, 0x114, 0xF, 0xF, true);
    v += __builtin_amdgcn_update_dpp(0, v, 0x118, 0xF, 0xF, true);
    v += __builtin_amdgcn_update_dpp(0, v, 0x142, 0xA, 0xF, false);
    v += __builtin_amdgcn_update_dpp(0, v, 0x143, 0xC, 0xF, false);
    return v;
}
__device__ __forceinline__ void prune(LAS unsigned char* lds, int qq, int wid, int lane, bool exact) {
    asm volatile("" : "+v"(lane));
    LAS unsigned* buf = (LAS unsigned*)(lds + L_BUF) + qq * CAP; LAS unsigned* cnt = (LAS unsigned*)(lds + L_CNT); LAS float* thr = (LAS float*)(lds + L_THR); LAS unsigned* thrk = (LAS unsigned*)(lds + L_THRK);
    LAS unsigned* hist = (LAS unsigned*)(lds + L_HIST) + wid * 256;
    const int n = (int)cnt[qq];
    unsigned e[12];
#pragma unroll
    for (int k = 0; k < 12; ++k) e[k] = (lane + 64 * k < n) ? buf[lane + 64 * k] : 0u;
    const unsigned tk = thrk[qq];
    unsigned cut = 0u; bool have = false;
    if (!exact && tk != 0u) {
        const unsigned base16 = tk >> 16;
        *(LAS v4u*)(hist + 4 * lane) = (v4u){0u, 0u, 0u, 0u};
        LDS_WAIT(); asm volatile("" ::: "memory");
#pragma unroll
        for (int k = 0; k < 12; ++k) if (lane + 64 * k < n) { unsigned bn = (e[k] >> 16) - base16; bn = bn > 255u ? 255u : bn; (void)__hip_atomic_fetch_add(hist + bn, 1u, __ATOMIC_RELAXED, __HIP_MEMORY_SCOPE_WORKGROUP); }
        LDS_WAIT(); asm volatile("" ::: "memory");
        const int rl = 63 - lane;
        const v4u hv = *(const LAS v4u*)(hist + 4 * rl);
        const int tot = (int)(hv.x + hv.y + hv.z + hv.w);
        int above = wave_prefix_incl(tot) - tot; int dsel = -1, csel = 0;
        { const int h3 = (int)hv.w, h2 = (int)hv.z, h1 = (int)hv.y, h0 = (int)hv.x;
          if (above < KEEP && KEEP <= above + h3) { dsel = 4 * rl + 3; csel = above + h3; } above += h3;
          if (above < KEEP && KEEP <= above + h2) { dsel = 4 * rl + 2; csel = above + h2; } above += h2;
          if (above < KEEP && KEEP <= above + h1) { dsel = 4 * rl + 1; csel = above + h1; } above += h1;
          if (above < KEEP && KEEP <= above + h0) { dsel = 4 * rl + 0; csel = above + h0; } }
        const unsigned long long bm = __ballot(dsel >= 0);
        const int src = bm ? (int)__builtin_ctzll(bm) : 0;
        const int d = __builtin_amdgcn_readlane(dsel, src), cd = __builtin_amdgcn_readlane(csel, src);
        LDS_WAIT(); asm volatile("" ::: "memory");
        if (bm != 0ull && cd <= KEEP + 128) { cut = (base16 + (unsigned)d) << 16; have = true; }
    }
    if (!have) {
        unsigned prefix = 0u; int want = KEEP;
#pragma unroll 1
        for (int p = 0; p < 4; ++p) {
            const int shift = 24 - 8 * p;
            *(LAS v4u*)(hist + 4 * lane) = (v4u){0u, 0u, 0u, 0u};
            LDS_WAIT(); asm volatile("" ::: "memory");
#pragma unroll
            for (int k = 0; k < 12; ++k) { const bool in = (lane + 64 * k < n) && (p == 0 || (e[k] >> (shift + 8)) == (prefix >> (shift + 8)));
                if (in) (void)__hip_atomic_fetch_add(hist + ((e[k] >> shift) & 255u), 1u, __ATOMIC_RELAXED, __HIP_MEMORY_SCOPE_WORKGROUP); }
            LDS_WAIT(); asm volatile("" ::: "memory");
            const int rl = 63 - lane;
            const v4u hv = *(const LAS v4u*)(hist + 4 * rl);
            const int tot = (int)(hv.x + hv.y + hv.z + hv.w);
            int above = wave_prefix_incl(tot) - tot;
            int dsel = -1, asel = 0;
            { const int h3 = (int)hv.w, h2 = (int)hv.z, h1 = (int)hv.y, h0 = (int)hv.x;
              if (above < want && want <= above + h3) { dsel = 4 * rl + 3; asel = above; } above += h3;
              if (above < want && want <= above + h2) { dsel = 4 * rl + 2; asel = above; } above += h2;
              if (above < want && want <= above + h1) { dsel = 4 * rl + 1; asel = above; } above += h1;
              if (above < want && want <= above + h0) { dsel = 4 * rl + 0; asel = above; } }
            const unsigned long long bm = __ballot(dsel >= 0);
            const int src = bm ? (int)__builtin_ctzll(bm) : 0;
            const int d = __builtin_amdgcn_readlane(dsel, src), ab = __builtin_amdgcn_readlane(asel, src);
            prefix |= ((unsigned)(d < 0 ? 0 : d)) << shift; want -= ab;
            LDS_WAIT(); asm volatile("" ::: "memory");
        }
        cut = prefix;
    }
    int base = 0;
#pragma unroll
    for (int k = 0; k < 12; ++k) { const bool keep = (lane + 64 * k < n) && e[k] >= cut; const unsigned long long mk = __ballot(keep);
        const int pos = base + (int)__builtin_amdgcn_mbcnt_hi((unsigned)(mk >> 32), __builtin_amdgcn_mbcnt_lo((unsigned)mk, 0u));
        if (keep) buf[pos] = e[k]; base += (int)__builtin_popcountll(mk); }
    if (lane == 0) { cnt[qq] = (unsigned)base; thr[qq] = thr_of(cut); thrk[qq] = cut; }
    LDS_WAIT(); asm volatile("" ::: "memory");
}
}
__device__ __forceinline__ void dsa1_unit(const Dsa1P& P, int u, LAS unsigned char* lds) {
    using namespace dsa1;
    const int tid = otid_(), wid = __builtin_amdgcn_readfirstlane(tid >> 6), lane = tid & 63, q = lane & 31, hi = lane >> 5;
    const int b = u & 1, qb32 = 255 - (u >> 1), t0 = 32 * qb32;
    const size_t brow = (size_t)b * T;
    LAS unsigned* buf = (LAS unsigned*)(lds + L_BUF); LAS unsigned* cnt = (LAS unsigned*)(lds + L_CNT); LAS float* thr = (LAS float*)(lds + L_THR);
    if (tid < 32) { cnt[tid] = 0u; thr[tid] = -__builtin_inff(); ((LAS unsigned*)(lds + L_THRK))[tid] = 0u; }
    const bf16* qrow = P.ZR + (brow + t0 + q) * ZP;
    { const int r = tid >> 4, sg = tid & 15; const bf16* src = P.ZR + (brow + t0 + r) * ZP + ZC_QI + 32 * sg;
#pragma unroll
      for (int j = 0; j < 4; ++j) *(LAS v4u*)(lds + L_QF + r * QFP + 64 * sg + 16 * j) = *(const GAS v4u*)(src + 8 * j); }
    float wq[8];
    { const v4u w = *(const GAS v4u*)(qrow + ZC_WI); const float c = 0.35355339059327373f * 0.125f;
      wq[0] = bflo(w.x) * c; wq[1] = bfhi(w.x) * c; wq[2] = bflo(w.y) * c; wq[3] = bfhi(w.y) * c; wq[4] = bflo(w.z) * c; wq[5] = bfhi(w.z) * c; wq[6] = bflo(w.w) * c; wq[7] = bfhi(w.w) * c; }
    const int tq = t0 + q;
    const int nsteps = (t0 + 32 + 255) >> 8;
    __syncthreads();
    float th = -__builtin_inff();
    bf16x8 afn[4];
    { const int k0 = 32 * wid; const bf16* krow = P.KI + (brow + (k0 <= t0 + 31 ? k0 : 0) + q) * 64 + 8 * hi;
#pragma unroll
      for (int s = 0; s < 4; ++s) afn[s] = *(const GAS bf16x8*)(krow + 16 * s); }
    for (int st = 0; st < nsteps; ++st) {
        const int key0 = 256 * st + 32 * wid;
        bf16x8 af[4];
#pragma unroll
        for (int s = 0; s < 4; ++s) af[s] = afn[s];
        { const int k1 = key0 + 256; const bf16* krow = P.KI + (brow + (k1 <= t0 + 31 ? k1 : 0) + q) * 64 + 8 * hi;
#pragma unroll
          for (int s = 0; s < 4; ++s) afn[s] = *(const GAS bf16x8*)(krow + 16 * s); }
        if (key0 <= t0 + 31) {
            f32x16 sc;
#pragma unroll
            for (int i = 0; i < 16; ++i) sc[i] = 0.f;
            unsigned qfo = (unsigned)(L_QF + q * QFP + 16 * hi); asm volatile("" : "+v"(qfo));
#pragma unroll
            for (int hd = 0; hd < 8; ++hd) {
                f32x16 acc;
#pragma unroll
                for (int i = 0; i < 16; ++i) acc[i] = 0.f;
#pragma unroll
                for (int s = 0; s < 4; ++s) { const bf16x8 qb = *(const LAS bf16x8*)(lds + qfo + hd * 128 + 32 * s);
                    acc = __builtin_amdgcn_mfma_f32_32x32x16_bf16(af[s], qb, acc, 0, 0, 0); }
#pragma unroll
                for (int i = 0; i < 16; ++i) sc[i] = fmaf(fmaxf(acc[i], 0.f), wq[hd], sc[i]);
                __builtin_amdgcn_sched_barrier(0);
            }
            const bool diag = key0 + 31 > t0;
            unsigned pm = 0u;
#pragma unroll
            for (int i = 0; i < 16; ++i) { const int kidx = key0 + (i & 3) + 8 * (i >> 2) + 4 * hi; const bool ok = (sc[i] >= th) && (!diag || kidx <= tq); pm |= ok ? (1u << i) : 0u; }
            const int np = __builtin_popcount(pm);
            if (np > 0) {
                int pos = (int)__hip_atomic_fetch_add(cnt + q, (unsigned)np, __ATOMIC_RELAXED, __HIP_MEMORY_SCOPE_WORKGROUP);
                LAS unsigned* bq = buf + q * CAP;
#pragma unroll
                for (int i = 0; i < 16; ++i) if (pm & (1u << i)) { const int kidx = key0 + (i & 3) + 8 * (i >> 2) + 4 * hi; bq[pos] = packkey(sc[i], kidx); ++pos; }
            }
        }
        __syncthreads();
        { unsigned nm = (unsigned)__ballot(cnt[q] > (unsigned)PRUNE_AT); int i = 0;
          while (nm) { const int qq = __builtin_ctz(nm); nm &= nm - 1u; if ((i & 7) == wid) prune(lds, qq, wid, lane, false); ++i; } }
        __syncthreads();
        th = thr[q];
    }
    LAS unsigned* mrow = (LAS unsigned*)(lds + L_MROW) + wid * 256;
#pragma unroll 1
    for (int k = 0; k < 4; ++k) {
        const int qq = wid + 8 * k;
        if (cnt[qq] > (unsigned)KEEP) prune(lds, qq, wid, lane, true);
        const int nf = (int)cnt[qq];
        *(LAS v4u*)(mrow + 4 * lane) = (v4u){0u, 0u, 0u, 0u};
        LDS_WAIT(); asm volatile("" ::: "memory");
#pragma unroll
        for (int j = 0; j < 4; ++j) { const int idx = lane + 64 * j; if (idx < nf) { const unsigned e = buf[qq * CAP + idx]; const unsigned key = 8191u - (e & 0x1FFFu); (void)__hip_atomic_fetch_or(mrow + (key >> 5), 1u << (key & 31u), __ATOMIC_RELAXED, __HIP_MEMORY_SCOPE_WORKGROUP); } }
        LDS_WAIT(); asm volatile("" ::: "memory");
        unsigned long long* grow = (unsigned long long*)(P.bitm + (brow + t0 + qq) * 256);
#pragma unroll
        for (int j = 0; j < 2; ++j) { const int w2 = lane + 64 * j; const unsigned long long v = (unsigned long long)mrow[2 * w2] | ((unsigned long long)mrow[2 * w2 + 1] << 32);
            __hip_atomic_store(grow + w2, v, RLX_AGENT); }
        LDS_WAIT(); asm volatile("" ::: "memory");
    }
    VM_WAIT();
    __syncthreads();
    if (tid == 0) __hip_atomic_fetch_add(P.done + 64 * (b * 32 + (t0 >> 8)), 1u, RLX_AGENT);
}

struct RPostP { const bf16* ZR; bf16* Q3; const bf16* yraw; const float* rdotk; const float *mu, *gup, *lnw, *lnb; };
__device__ __forceinline__ void rwkv_post(const RPostP& P, LAS unsigned char* lds) {
    const int tid = otid_(), lane = tid & 63, h = __builtin_amdgcn_readfirstlane(tid >> 6), c16 = lane & 15, quad = lane >> 4;
    constexpr int SP = 272;
    LAS float* GT = (LAS float*)(lds + 64 * SP);
    bf16x8 bfr[4][4];
#pragma unroll
    for (int ct = 0; ct < 4; ++ct)
#pragma unroll
        for (int s = 0; s < 4; ++s) { const float* gp = P.gup + (size_t)(32 * s + 8 * quad) * 512 + 64 * h + 16 * ct + c16;
            v4u w; w.x = pk2(gp[0], gp[512]); w.y = pk2(gp[1024], gp[1536]); w.z = pk2(gp[2048], gp[2560]); w.w = pk2(gp[3072], gp[3584]); bfr[ct][s] = __builtin_bit_cast(bf16x8, w); }
    float muv[4], lnw[4], lnb[4];
#pragma unroll
    for (int ct = 0; ct < 4; ++ct) { const int ch = 64 * h + 16 * ct + c16; muv[ct] = P.mu[1024 + ch]; lnw[ct] = P.lnw[ch]; lnb[ct] = P.lnb[ch]; }
    const int stok = tid >> 3, sseg = tid & 7;
#pragma unroll 1
    for (int m0 = blockIdx.x * 64; m0 < M; m0 += gridDim.x * 64) {
        {   const size_t m = (size_t)m0 + stok; const int t = (int)(m & (T - 1));
            float gv[16], pv[16];
            { const v4u a = *(const GAS v4u*)(P.ZR + m * ZP + ZC_GC + 16 * sseg), c = *(const GAS v4u*)(P.ZR + m * ZP + ZC_GC + 16 * sseg + 8);
              gv[0] = bflo(a.x); gv[1] = bfhi(a.x); gv[2] = bflo(a.y); gv[3] = bfhi(a.y); gv[4] = bflo(a.z); gv[5] = bfhi(a.z); gv[6] = bflo(a.w); gv[7] = bfhi(a.w);
              gv[8] = bflo(c.x); gv[9] = bfhi(c.x); gv[10] = bflo(c.y); gv[11] = bfhi(c.y); gv[12] = bflo(c.z); gv[13] = bfhi(c.z); gv[14] = bflo(c.w); gv[15] = bfhi(c.w); }
            if (t > 0) { const v4u a = *(const GAS v4u*)(P.ZR + (m - 1) * ZP + ZC_GC + 16 * sseg), c = *(const GAS v4u*)(P.ZR + (m - 1) * ZP + ZC_GC + 16 * sseg + 8);
              pv[0] = bflo(a.x); pv[1] = bfhi(a.x); pv[2] = bflo(a.y); pv[3] = bfhi(a.y); pv[4] = bflo(a.z); pv[5] = bfhi(a.z); pv[6] = bflo(a.w); pv[7] = bfhi(a.w);
              pv[8] = bflo(c.x); pv[9] = bfhi(c.x); pv[10] = bflo(c.y); pv[11] = bfhi(c.y); pv[12] = bflo(c.z); pv[13] = bfhi(c.z); pv[14] = bflo(c.w); pv[15] = bfhi(c.w); }
            else {
#pragma unroll
              for (int e = 0; e < 16; ++e) pv[e] = 0.f; }
            float sg[16];
#pragma unroll
            for (int e = 0; e < 16; ++e) { const float mu = P.mu[1664 + 16 * sseg + e]; sg[e] = sigm(gv[e] + (pv[e] - gv[e]) * mu); }
            v4u o0, o1; o0.x = pk2(sg[0], sg[1]); o0.y = pk2(sg[2], sg[3]); o0.z = pk2(sg[4], sg[5]); o0.w = pk2(sg[6], sg[7]); o1.x = pk2(sg[8], sg[9]); o1.y = pk2(sg[10], sg[11]); o1.z = pk2(sg[12], sg[13]); o1.w = pk2(sg[14], sg[15]);
            *(LAS v4u*)(lds + stok * SP + 32 * sseg) = o0; *(LAS v4u*)(lds + stok * SP + 32 * sseg + 16) = o1;
        }
        __syncthreads();
#pragma unroll 1
        for (int rt = 0; rt < 4; ++rt) {
            f32x4 acc[4];
#pragma unroll
            for (int ct = 0; ct < 4; ++ct) acc[ct] = (f32x4){0.f, 0.f, 0.f, 0.f};
#pragma unroll
            for (int s = 0; s < 4; ++s) { const bf16x8 af = *(const LAS bf16x8*)(lds + (16 * rt + c16) * SP + (32 * s + 8 * quad) * 2);
#pragma unroll
                for (int ct = 0; ct < 4; ++ct) acc[ct] = __builtin_amdgcn_mfma_f32_16x16x32_bf16(af, bfr[ct][s], acc[ct], 0, 0, 0); }
#pragma unroll
            for (int ct = 0; ct < 4; ++ct)
#pragma unroll
                for (int j = 0; j < 4; ++j) GT[(4 * quad + j) * 512 + 64 * h + 16 * ct + c16] = acc[ct][j];
            __syncthreads();
            {   const int vtok = tid >> 5, vseg = tid & 31, ch0 = 16 * vseg, vh = vseg >> 2;
                const size_t m = (size_t)m0 + 16 * rt + vtok; const int t = (int)(m & (T - 1));
                float y[16], vv[16], vp[16], g[16];
                { const v4u a = *(const GAS v4u*)(P.yraw + m * 512 + ch0), c = *(const GAS v4u*)(P.yraw + m * 512 + ch0 + 8);
                  y[0] = bflo(a.x); y[1] = bfhi(a.x); y[2] = bflo(a.y); y[3] = bfhi(a.y); y[4] = bflo(a.z); y[5] = bfhi(a.z); y[6] = bflo(a.w); y[7] = bfhi(a.w);
                  y[8] = bflo(c.x); y[9] = bfhi(c.x); y[10] = bflo(c.y); y[11] = bfhi(c.y); y[12] = bflo(c.z); y[13] = bfhi(c.z); y[14] = bflo(c.w); y[15] = bfhi(c.w); }
                { const v4u a = *(const GAS v4u*)(P.ZR + m * ZP + ZC_RV + ch0), c = *(const GAS v4u*)(P.ZR + m * ZP + ZC_RV + ch0 + 8);
                  vv[0] = bflo(a.x); vv[1] = bfhi(a.x); vv[2] = bflo(a.y); vv[3] = bfhi(a.y); vv[4] = bflo(a.z); vv[5] = bfhi(a.z); vv[6] = bflo(a.w); vv[7] = bfhi(a.w);
                  vv[8] = bflo(c.x); vv[9] = bfhi(c.x); vv[10] = bflo(c.y); vv[11] = bfhi(c.y); vv[12] = bflo(c.z); vv[13] = bfhi(c.z); vv[14] = bflo(c.w); vv[15] = bfhi(c.w); }
                if (t > 0) { const v4u a = *(const GAS v4u*)(P.ZR + (m - 1) * ZP + ZC_RV + ch0), c = *(const GAS v4u*)(P.ZR + (m - 1) * ZP + ZC_RV + ch0 + 8);
                  vp[0] = bflo(a.x); vp[1] = bfhi(a.x); vp[2] = bflo(a.y); vp[3] = bfhi(a.y); vp[4] = bflo(a.z); vp[5] = bfhi(a.z); vp[6] = bflo(a.w); vp[7] = bfhi(a.w);
                  vp[8] = bflo(c.x); vp[9] = bfhi(c.x); vp[10] = bflo(c.y); vp[11] = bfhi(c.y); vp[12] = bflo(c.z); vp[13] = bfhi(c.z); vp[14] = bflo(c.w); vp[15] = bfhi(c.w); }
                else {
#pragma unroll
                  for (int e = 0; e < 16; ++e) vp[e] = 0.f; }
#pragma unroll
                for (int e4 = 0; e4 < 4; ++e4) { const f32x4 gq = *(const LAS f32x4*)(GT + vtok * 512 + ch0 + 4 * e4); g[4 * e4] = gq.x; g[4 * e4 + 1] = gq.y; g[4 * e4 + 2] = gq.z; g[4 * e4 + 3] = gq.w; }
                float sm = 0.f;
#pragma unroll
                for (int e = 0; e < 16; ++e) sm += y[e];
                sm = scan::dpp_add<0xB1>(sm); sm = scan::dpp_add<0x4E>(sm);
                const float mean = sm * (1.f / 64.f); float vs = 0.f;
#pragma unroll
                for (int e = 0; e < 16; ++e) { y[e] -= mean; vs += y[e] * y[e]; }
                vs = scan::dpp_add<0xB1>(vs); vs = scan::dpp_add<0x4E>(vs);
                const float rstd = __builtin_amdgcn_rsqf(vs * (1.f / 64.f) + 64e-5f);
                const float rk = P.rdotk[m * 8 + vh];
                unsigned ow[8];
#pragma unroll
                for (int e = 0; e < 16; e += 2) { float o2[2];
#pragma unroll
                    for (int d = 0; d < 2; ++d) { const int ch = ch0 + e + d; const float v = vv[e + d] + (vp[e + d] - vv[e + d]) * P.mu[1024 + ch];
                        o2[d] = (y[e + d] * rstd * P.lnw[ch] + P.lnb[ch] + rk * v) * g[e + d]; }
                    ow[e >> 1] = pk2(o2[0], o2[1]); }
                *(GAS v4u*)(P.Q3 + m * QP + 512 + ch0) = (v4u){ow[0], ow[1], ow[2], ow[3]}; *(GAS v4u*)(P.Q3 + m * QP + 512 + ch0 + 8) = (v4u){ow[4], ow[5], ow[6], ow[7]};
            }
            __syncthreads();
        }
        __syncthreads();
    }
}
struct DPostP { const bf16* O1; const bf16* O2; bf16* Q3; const float *lq1, *lk1, *lq2, *lk2, *subln; float lambda_init; };
__device__ __forceinline__ void diff_post(const DPostP& P, int gw, int NGW, int lane) {
    const float lam = __expf(wave_sum(P.lq1[lane] * P.lk1[lane])) - __expf(wave_sum(P.lq2[lane] * P.lk2[lane])) + P.lambda_init;
    const float s0 = P.subln[2 * lane] * (1.f - P.lambda_init), s1 = P.subln[2 * lane + 1] * (1.f - P.lambda_init);
    for (int it = gw; it < M * 4; it += NGW) {
        const size_t m = (size_t)(it >> 2); const int hh = it & 3;
        const unsigned a = *(const GAS unsigned*)(P.O1 + m * 512 + 128 * hh + 2 * lane), c = *(const GAS unsigned*)(P.O2 + m * 512 + 128 * hh + 2 * lane);
        const float x0 = bflo(a) - lam * bflo(c), x1 = bfhi(a) - lam * bfhi(c);
        const float r = __builtin_amdgcn_rsqf(wave_sum(x0 * x0 + x1 * x1) * (1.f / 128.f) + NORM_EPS);
        *(GAS unsigned*)(P.Q3 + m * QP + 1024 + 128 * hh + 2 * lane) = pk2(x0 * r * s0, x1 * r * s1);
    }
}

__device__ __forceinline__ int q_fetch(gu32* head, volatile LAS int* slot) {
    if (threadIdx.x == 0) *slot = (int)__hip_atomic_fetch_add(head, 1u, RLX_AGENT);
    __syncthreads();
    const int v = __builtin_amdgcn_readfirstlane(*slot);
    __syncthreads();
    return v;
}

struct Args { const float* in[32]; float* out; unsigned char* ws; int ph_lo, ph_hi; };
__device__ __forceinline__ const float* kin_(int i) { const char* ka = (const char*)__builtin_amdgcn_kernarg_segment_ptr(); unsigned off = (unsigned)i * 8u; asm volatile("" : "+s"(off)); return *(const float* const*)(ka + off); }
#define KIN(i) kin_(i)
#define XOUT ((float*)kin_(32))
#define XB ((bf16*)kin_(32))
#define XB2 ((bf16*)(wsl + WS_Q3))
#define OUTHI ((unsigned char*)kin_(32) + 32 * MiB)
__device__ __forceinline__ unsigned char* kws_() { return (unsigned char*)kin_(33); }
__device__ __forceinline__ int kint_(int byteoff) { const char* ka = (const char*)__builtin_amdgcn_kernarg_segment_ptr(); unsigned off = (unsigned)byteoff; asm volatile("" : "+s"(off)); return *(const int*)(ka + off); }
constexpr int PH_L = 14;
constexpr int N_PHASES = 1 + NLAYER * PH_L;

#define G ((int)gridDim.x)
#define bid ((int)blockIdx.x)
#define gw (bid * NWAVES + wave)
#define NGW (G * NWAVES)
#define MISC ((volatile LAS unsigned*)(lds + LDS_MISC))
#define IN(k) (kint_(272) <= (k) && (k) < kint_(276))
#define SEAM(k) do { if ((k) + 1 < kint_(276)) { XcdBarrier bar_; bar_.bar = (unsigned*)(kws_() + WS_CTL) + CW_BAR; bar_.x = xb_xcc_id(); bar_.st = MISC + 8; xcd_barrier(bar_); } } while (0)
#define WSL() unsigned char* wsl = kws_(); const int tid = otid_(), lane = tid & 63, wave = __builtin_amdgcn_readfirstlane(tid >> 6); (void)lane; (void)wave
#define WFu ((bf16*)(wsl + WS_WF))
#define WFd ((bf16*)(wsl + WS_WF_DOWN))
#define WMi ((bf16*)(wsl + WS_WM))
#define WMb ((bf16*)(wsl + WS_WM_BR))
#define WMo ((bf16*)(wsl + WS_WM_OUT))
#define XN ((bf16*)(wsl + WS_XN))
#define Q3 ((bf16*)(wsl + WS_Q3))
#define ZR ((bf16*)(wsl + WS_ZR))
#define YP ((bf16*)(wsl + WS_R2))
#define HB ZR
#define G3 ZR
#define MG ((bf16*)(wsl + WS_MG))
#define O1 ((bf16*)(wsl + WS_R2))
#define O2 ((bf16*)(wsl + WS_R2) + (size_t)M * 512)
#define YRAW ((bf16*)(wsl + WS_YRAW))
#define BITM ((unsigned*)OUTHI)
#define RDOTK ((float*)(wsl + WS_RDOTK))
#define X1B ((bf16*)(OUTHI + 16 * MiB))
#define KID ((bf16*)(wsl + WS_KID))
#define A8B ((unsigned char*)(wsl + WS_A8))
#define CTL ((gu32*)(wsl + WS_CTL))
#define cscr ((LAS float*)(lds + wave * 16384))

#define CONV_FFN(l_, f_) do { const int gi_ = (f_) ? 29 : 3; \
        MapUp mu_{KIN(gi_) + (size_t)(l_) * DM * FF, KIN(gi_ + 1) + (size_t)(l_) * DM * FF, FF}; MapIdent md_{KIN(gi_ + 2) + (size_t)(l_) * FF * DM, DM}; \
        constexpr int nu_ = conv_items(DM, 2 * FF), nd_ = conv_items(FF, DM); \
        for (int it_ = gw; it_ < nu_ + nd_; it_ += NGW) { if (it_ < nu_) conv_item(mu_, DM, WFu, cscr, it_, 2 * FF / 32, lane); else conv_item(md_, FF, WFd, cscr, it_ - nu_, DM / 32, lane); } } while (0)
#define CONV_MIX(l_) do { MapWin mw_{KIN(8) + (size_t)(l_) * DM * NIN, NIN}; MapIdent mo_{KIN(26) + (size_t)(l_) * DM * DM, DM}; \
        constexpr int ni_ = conv_items(DM, 8704), nb_ = conv_items(512, DM), no_ = conv_items(DM, DM); \
        for (int it_ = gw; it_ < ni_ + 3 * nb_ + no_; it_ += NGW) { \
            if (it_ < ni_) conv_item(mw_, DM, WMi, cscr, it_, 8704 / 32, lane); \
            else if (it_ < ni_ + 3 * nb_) { const int r_ = it_ - ni_, n_ = r_ / nb_; MapIdent mb_{KIN(25) + ((size_t)(l_) * 3 + n_) * 512 * DM, DM}; conv_item(mb_, 512, WMb + (size_t)n_ * DM * 512, cscr, r_ - n_ * nb_, DM / 32, lane); } \
            else conv_item(mo_, DM, WMo, cscr, it_ - ni_ - 3 * nb_, DM / 32, lane); } } while (0)

template <int L, int F> __device__ __forceinline__ void ffn_part(LAS unsigned char* lds) {
    constexpr int l = L, f = F, pb = 1 + PH_L * L, pf = pb + (F ? 11 : 0);
            if (IN(pf + 0)) { WSL();
                pg8::Gemm g{XN, WFu, M, 2 * FF, DM, DM}; pg8::StaticOrder S; S.init(M, 2 * FF, G, bid);
                pg8::EpiSwiGLU E{HB, FF};
                pg8::gemm_phase<pg8::EpiSwiGLU, pg8::StaticOrder, true, true>(lds, g, S, E);
                SEAM(pf + 0);
            }
            if (IN(pf + 1)) { WSL();
                pg8::Gemm g{HB, WFd, M, DM, FF, FF}; pg8::StaticOrder S; S.init(M, DM, G, bid);
                pg8::EpiStore<0> E{YP, DM, YP, DM, 1 << 30};
                pg8::gemm_phase<pg8::EpiStore<0>, pg8::StaticOrder, true, true>(lds, g, S, E);
                SEAM(pf + 1);
            }
            if (IN(pf + 2)) { WSL();
                const float* gpost = KIN(f ? 28 : 2) + l * DM;
                const float* gnext = f == 0 ? KIN(6) + l * DM : (l + 1 < NLAYER ? KIN(1) + (l + 1) * DM : nullptr);
#if PROBE
                float osc = 1.f;
                if (l == NLAYER - 1 && f == 1) { const float num = *(const float*)(wsl + WS_CTL + 4 * CW_PROBE), den = *(const float*)(wsl + WS_CTL + 4 * (CW_PROBE + 1)); osc = 1.f + 4.f * sqrtf(num / fmaxf(den, 1e-30f)); }
#else
                const float osc = 1.f;
#endif
                if constexpr (l == 0 && f == 0) rownorm_rows<false, true>(KIN(0), YP, 0.5f, gpost, XB, gnext, XN, gw, NGW, lane);
                else if constexpr (l == NLAYER - 1 && f == 1) rownorm_rows<true, false>(XB2, YP, 0.5f, gpost, XOUT, nullptr, nullptr, gw, NGW, lane, osc);
                else rownorm_rows<true, true>(XB, YP, 0.5f, gpost, XB, gnext, XN, gw, NGW, lane);
                if (f == 1 && l + 1 < NLAYER) { CONV_FFN(l + 1, 0); CONV_MIX(l + 1); }
                SEAM(pf + 2);
            }
}
template <int L> __device__ __forceinline__ void mixer_part(LAS unsigned char* lds, unsigned char* lds_) {
    constexpr int l = L, pb = 1 + PH_L * L;
            const int pm = pb + 3;
            if (IN(pm + 0)) { WSL();
                pg8::Gemm g{XN, WMi, M, 5632, DM, DM}; pg8::StaticOrder S; S.init(M, 5632, G, bid);
                pg8::EpiStore<0> E{Q3, QP, ZR, ZP, 6};
                pg8::gemm_phase<pg8::EpiStore<0>, pg8::StaticOrder, true, true>(lds, g, S, E);
                SEAM(pm + 0);
            }
            if (IN(pm + 1)) { WSL();
                PrepP pp{ZR, X1B, A8B, KID, KIN(9) + l * 1792, KIN(10) + l * 512, KIN(11) + l * 64 * 512, KIN(12) + l * 512, KIN(13) + l * 64 * 512};
                rwkv_prep(pp, lds);
                SEAM(pm + 1);
            }
            if (IN(pm + 2)) { WSL();
                volatile LAS int* slot = (volatile LAS int*)(MISC + 16);
                if (bid < 64) {
                    ScanP sp{Q3, ZR, X1B, A8B, YRAW, RDOTK, KIN(9) + l * 1792, KIN(15) + l * 512, KIN(16) + l * 512, KIN(17) + l * 512};
#ifndef NO_SCAN
                    rwkv_scan_unit(sp, bid, lds);
#ifdef SCAN_TWICE
                    rwkv_scan_unit(sp, bid, lds);
#endif
#endif
                }
                {
                    Dsa1P dp{ZR, KID, BITM, CTL + CW_DONE + 64 * 64 * l};
                    gu32* head = CTL + CW_Q + 64 * (3 * l + 0);
                    #ifndef NO_DSA1
                    for (int u = q_fetch(head, slot); u < 512; u = q_fetch(head, slot)) dsa1_unit(dp, u, lds);
#ifdef DUP_DSA1
                    { gu32* head2 = CTL + 10240 + 64 * (2 * l + 0); for (int u = q_fetch(head2, slot); u < 512; u = q_fetch(head2, slot)) dsa1_unit(dp, u, lds); }
#endif
#endif
                }
                {
                    gu32* head = CTL + CW_Q + 64 * (3 * l + 1);
                    typedef att::BlockRef<att::bf16, att::bf16> Ref;
#define DSA2_REF(i_, r_) do { const int qb_ = 31 - ((i_) >> 3), b_ = ((i_) >> 2) & 1, h_ = (i_) & 3; const size_t row_ = (size_t)b_ * T + 256 * qb_; \
        r_.Q = (const att::bf16*)(Q3 + row_ * QP + 128 * h_); r_.O = (att::bf16*)(Q3 + row_ * QP + 128 * h_); r_.K = (const att::bf16*)(ZR + (size_t)b_ * T * ZP + ZC_DK + 128 * h_); \
        r_.V = (const att::bf16*)(ZR + (size_t)b_ * T * ZP + ZC_DV + 128 * h_); r_.P0 = 256 * qb_; r_.koff = 0; r_.mask = BITM + row_ * 256; } while (0)
                    int ic = q_fetch(head, slot);
                    if (ic < 256) {
                        int in_ = q_fetch(head, slot);
                        Ref cur; DSA2_REF(ic, cur);
                        att::Seam<att::bf16> S;
                        att::causal_swa_prime<att::bf16, att::bf16, false>(cur, T, (char*)lds_, S);
                        for (;;) {
                            const bool last = in_ >= 256;
                            Ref nxt = cur; if (!last) DSA2_REF(in_, nxt);
                            {
                                if (tid == 0) { gu32* dw = CTL + CW_DONE + 64 * (64 * l + (((ic >> 2) & 1) * 32 + (31 - (ic >> 3)))); unsigned sp = 0;
                                    while (__hip_atomic_load(dw, RLX_AGENT) < 8u) { __builtin_amdgcn_s_sleep(2); if (++sp > (1u << 24)) { __hip_atomic_store(CTL + CW_TMO, 1u, RLX_AGENT); break; } }
                                    __builtin_amdgcn_fence(__ATOMIC_ACQUIRE, "agent"); asm volatile("s_waitcnt vmcnt(0)" ::: "memory"); }
                                __syncthreads();
                            }
#ifndef NO_DSA2
                            att::causal_swa_block<att::bf16, att::bf16, false, true, QP>(cur, nxt, T, T, (char*)lds_, S);
#endif
                            if (last) break;
                            cur = nxt; ic = in_; in_ = q_fetch(head, slot);
                        }
                    }
                }
                {
#ifdef DUP_DIFF
                  for (int rep_ = 0; rep_ < 2; ++rep_) {
                    gu32* head = rep_ ? CTL + 10240 + 64 * (2 * l + 1) : CTL + CW_Q + 64 * (3 * l + 2);
#else
                  {
                    gu32* head = CTL + CW_Q + 64 * (3 * l + 2);
#endif
                    typedef att::BlockRef<att::bf16, att::bf16> Ref;
#define DIFF_REF(i_, r_) do { const int qb_ = 31 - ((i_) >> 4), b_ = ((i_) >> 3) & 1, h_ = ((i_) >> 1) & 3, mp_ = (i_) & 1; const size_t row_ = (size_t)b_ * T + 256 * qb_; \
        r_.Q = (const att::bf16*)(Q3 + row_ * QP + 1024 + 128 * h_ + 64 * mp_); r_.O = (att::bf16*)((mp_ ? O2 : O1) + row_ * 512 + 128 * h_); \
        r_.K = (const att::bf16*)(ZR + (size_t)b_ * T * ZP + ZC_FK + 128 * h_); r_.V = (const att::bf16*)(ZR + (size_t)b_ * T * ZP + ZC_FV + 128 * h_); r_.P0 = 256 * qb_; r_.koff = 128 * mp_; r_.mask = nullptr; } while (0)
                    int ic = q_fetch(head, slot);
                    if (ic < 512) {
                        int in_ = q_fetch(head, slot);
                        Ref cur; DIFF_REF(ic, cur);
                        att::Seam<att::bf16> S;
                        att::causal_swa_prime<att::bf16, att::bf16, true>(cur, T, (char*)lds_, S);
                        for (;;) {
                            const bool last = in_ >= 512;
                            Ref nxt = cur; if (!last) DIFF_REF(in_, nxt);
#ifndef NO_DIFF
                            att::causal_swa_block<att::bf16, att::bf16, true, false, 512>(cur, nxt, T, T, (char*)lds_, S);
#endif
                            if (last) break;
                            cur = nxt; ic = in_; in_ = q_fetch(head, slot);
                        }
                    }
                  }
                }
                SEAM(pm + 2);
            }
            if (IN(pm + 3)) { WSL();
                RPostP rp{ZR, Q3, YRAW, RDOTK, KIN(9) + l * 1792, KIN(14) + l * 128 * 512, KIN(18) + l * 512, KIN(19) + l * 512};
#ifndef NO_RPOST
                rwkv_post(rp, lds);
#endif
                constexpr float lambda_init = L == 0 ? 0.2f : 0.35550906759096927f;
                DPostP dq{O1, O2, Q3, KIN(20) + l * 64, KIN(21) + l * 64, KIN(22) + l * 64, KIN(23) + l * 64, KIN(24) + l * 128, lambda_init};
                diff_post(dq, gw, NGW, lane);
                SEAM(pm + 3);
            }
            if (IN(pm + 4)) { WSL();
                pg8::Gemm g{XN, WMi + (size_t)5632 * DM, M, 3072, DM, DM}; pg8::StaticOrder S; S.init(M, 3072, G, bid);
#ifdef GATE_RAW
                pg8::EpiStore<0> E{G3, 3072, G3, 3072, 1 << 30};
                pg8::gemm_phase<pg8::EpiStore<0>, pg8::StaticOrder, true, true>(lds, g, S, E);
#else
                pg8::EpiStore<1> E{G3, 3072, G3, 3072, 1 << 30};
                pg8::gemm_phase<pg8::EpiStore<1>, pg8::StaticOrder, true, true>(lds, g, S, E);
#endif
                SEAM(pm + 4);
            }
            if (IN(pm + 5)) { WSL();
#pragma unroll 1
                for (int n = 0; n < 3; ++n) {
                    pg8::Gemm g{Q3 + 512 * n, WMb + (size_t)n * DM * 512, M, DM, 512, QP}; pg8::StaticOrder S; S.init(M, DM, G, bid);
                    pg8::EpiGateMul E{MG, DM, G3 + 1024 * n, 3072, n == 0 ? 1 : 0};
                    pg8::gemm_phase<pg8::EpiGateMul, pg8::StaticOrder, false, true>(lds, g, S, E);
                    VM_WAIT(); __syncthreads();
                }
                SEAM(pm + 5);
            }
            if (IN(pm + 6)) { WSL();
                pg8::Gemm g{MG, WMo, M, DM, DM, DM}; pg8::StaticOrder S; S.init(M, DM, G, bid);
                pg8::EpiStore<0> E{YP, DM, YP, DM, 1 << 30};
                pg8::gemm_phase<pg8::EpiStore<0>, pg8::StaticOrder, false, true>(lds, g, S, E);
                SEAM(pm + 6);
            }
            if (IN(pm + 7)) { WSL();
                rownorm_rows<true, true>(XB, YP, 1.0f, KIN(7) + l * DM, l == NLAYER - 1 ? XB2 : XB, KIN(27) + l * DM, XN, gw, NGW, lane);
                CONV_FFN(l, 1);
                SEAM(pm + 7);
            }
}

__global__ void __launch_bounds__(NWAVES * 64, 2) mk_fwd(Args args) {
    extern __shared__ __attribute__((aligned(16))) unsigned char lds_[];
    LAS unsigned char* lds = (LAS unsigned char*)lds_;
    { const int tid = otid_(); if (tid < 64) MISC[tid] = 0u; }
    __syncthreads();
    (void)xcd_barrier_post((unsigned*)(kws_() + WS_CTL) + CW_BAR, MISC + 8);
    if (IN(0)) { WSL();
        CONV_FFN(0, 0); CONV_MIX(0);
        rownorm_rows<false, false>(KIN(0), nullptr, 0.f, nullptr, nullptr, KIN(1), XN, gw, NGW, lane);
        SEAM(0);
    }
    ffn_part<0, 0>(lds); mixer_part<0>(lds, lds_); ffn_part<0, 1>(lds);
    ffn_part<1, 0>(lds); mixer_part<1>(lds, lds_); ffn_part<1, 1>(lds);
}

#if PROBE
__device__ __forceinline__ void probe_acc(float num, float den, float* ctlf) {
    __shared__ float rn[256], rd[256];
    rn[threadIdx.x] = num; rd[threadIdx.x] = den; __syncthreads();
    for (int o = 128; o > 0; o >>= 1) { if ((int)threadIdx.x < o) { rn[threadIdx.x] += rn[threadIdx.x + o]; rd[threadIdx.x] += rd[threadIdx.x + o]; } __syncthreads(); }
    if (threadIdx.x == 0) { atomicAdd(ctlf + CW_PROBE, rn[0]); atomicAdd(ctlf + CW_PROBE + 1, rd[0]); }
}
__global__ void __launch_bounds__(256) probe_ffn(const unsigned char* ws, const float* Wg, const float* Wu, const float* Wd) {
    __shared__ float xn[1024]; __shared__ float hid[2816];
    const int m = 777 + 1931 * blockIdx.x, tid = threadIdx.x;
    const bf16* XNp = (const bf16*)(ws + WS_XN); const bf16* YPp = (const bf16*)(ws + WS_R2);
    for (int k = tid; k < 1024; k += 256) xn[k] = bf1(XNp[(size_t)m * 1024 + k]);
    __syncthreads();
    for (int j = tid; j < 2816; j += 256) { float g = 0.f, u = 0.f; for (int k = 0; k < 1024; ++k) { g += xn[k] * Wg[(size_t)k * 2816 + j]; u += xn[k] * Wu[(size_t)k * 2816 + j]; } hid[j] = g / (1.f + expf(-g)) * u; }
    __syncthreads();
    float num = 0.f, den = 0.f;
    for (int d = tid; d < 1024; d += 256) { float o = 0.f; for (int j = 0; j < 2816; ++j) o += hid[j] * Wd[(size_t)j * 1024 + d]; const float got = bf1(YPp[(size_t)m * 1024 + d]); num += (o - got) * (o - got); den += o * o; }
    probe_acc(num, den, (float*)(ws + WS_CTL));
}
__global__ void __launch_bounds__(256) probe_win(const unsigned char* ws, const float* Win) {
    __shared__ float xn[1024];
    const int m = 555 + 1999 * blockIdx.x, tid = threadIdx.x;
    const bf16* XNp = (const bf16*)(ws + WS_XN); const bf16* Q3p = (const bf16*)(ws + WS_Q3); const bf16* ZRp = (const bf16*)(ws + WS_ZR);
    for (int k = tid; k < 1024; k += 256) xn[k] = bf1(XNp[(size_t)m * 1024 + k]);
    __syncthreads();
    float num = 0.f, den = 0.f;
    for (int c = tid; c < 5448; c += 256) {
        float z = 0.f; for (int k = 0; k < 1024; ++k) z += xn[k] * Win[(size_t)k * NIN + c];
        float got;
        if (c < 512) got = bf1(Q3p[(size_t)m * QP + c]);
        else if (c < 2120) got = bf1(ZRp[(size_t)m * ZP + (c - 512)]);
        else if (c < 2632) got = bf1(Q3p[(size_t)m * QP + 512 + (c - 2120)]);
        else if (c < 3912) got = bf1(ZRp[(size_t)m * ZP + (c - 840)]);
        else if (c < 4424) got = bf1(Q3p[(size_t)m * QP + 1024 + (c - 3912)]);
        else got = bf1(ZRp[(size_t)m * ZP + (c - 1352)]);
        num += (z - got) * (z - got); den += z * z;
    }
    probe_acc(num, den, (float*)(ws + WS_CTL));
}
__global__ void __launch_bounds__(256) probe_wconv(const unsigned char* ws, const float* Win, int r0) {
    const bf16* WMp = (const bf16*)(ws + WS_WM); const int tid = threadIdx.x;
    float num = 0.f, den = 0.f;
    for (int rr = 0; rr < 64; ++rr) { const int n = r0 + 64 * blockIdx.x + rr; MapWin mw{Win, NIN}; const float* cp = mw.col(n);
        for (int k = tid; k < 1024; k += 256) { const float ref = cp ? cp[(size_t)k * NIN] : 0.f; const float got = bf1(WMp[(size_t)n * 1024 + k]); num += (ref - got) * (ref - got); den += ref * ref; } }
    probe_acc(num, den, (float*)(ws + WS_CTL));
}
__global__ void __launch_bounds__(256) probe_merge(const unsigned char* ws, const float* Win, const float* Wb, const float* Wo, int which) {
    __shared__ float xn[1024]; __shared__ float y[1536]; __shared__ float mg[1024];
    const int m = 333 + 2003 * blockIdx.x, tid = threadIdx.x;
    const bf16* XNp = (const bf16*)(ws + WS_XN); const bf16* Q3p = (const bf16*)(ws + WS_Q3); const bf16* MGp = (const bf16*)(ws + WS_MG); const bf16* YPp = (const bf16*)(ws + WS_R2);
    for (int k = tid; k < 1024; k += 256) xn[k] = bf1(XNp[(size_t)m * 1024 + k]);
    for (int k = tid; k < 1536; k += 256) y[k] = bf1(Q3p[(size_t)m * QP + k]);
    __syncthreads();
    float num = 0.f, den = 0.f;
    for (int d = tid; d < 1024; d += 256) {
        float acc = 0.f;
        for (int n = 0; n < 3; ++n) { float g = 0.f; for (int k = 0; k < 1024; ++k) g += xn[k] * Win[(size_t)k * NIN + 5448 + n * 1024 + d];
            float p = 0.f; for (int c = 0; c < 512; ++c) p += y[512 * n + c] * Wb[((size_t)n * 512 + c) * 1024 + d];
            acc += p / (1.f + expf(-g)); }
        mg[d] = acc; const float got = bf1(MGp[(size_t)m * 1024 + d]); if (which == 0) { num += (acc - got) * (acc - got); den += acc * acc; }
        if (which == 2) { const bf16* G3p = (const bf16*)(ws + WS_ZR); for (int n = 0; n < 3; ++n) { float g = 0.f; for (int k = 0; k < 1024; ++k) g += xn[k] * Win[(size_t)k * NIN + 5448 + n * 1024 + d];
            const float sg = 1.f / (1.f + expf(-g)), gg = bf1(G3p[(size_t)m * 3072 + n * 1024 + d]); num += (sg - gg) * (sg - gg); den += sg * sg; } }
        if (which == 3) { const bf16* G3p = (const bf16*)(ws + WS_ZR); float a2 = 0.f; for (int n = 0; n < 3; ++n) { float p = 0.f; for (int c = 0; c < 512; ++c) p += y[512 * n + c] * Wb[((size_t)n * 512 + c) * 1024 + d];
            a2 += p * bf1(G3p[(size_t)m * 3072 + n * 1024 + d]); } num += (a2 - got) * (a2 - got); den += a2 * a2; }
    }
    __syncthreads();
    if (which == 1) for (int d = tid; d < 1024; d += 256) { float o = 0.f; for (int j = 0; j < 1024; ++j) o += mg[j] * Wo[(size_t)j * 1024 + d]; const float got = bf1(YPp[(size_t)m * 1024 + d]); num += (o - got) * (o - got); den += o * o; }
    probe_acc(num, den, (float*)(ws + WS_CTL));
}
#endif
#ifndef MK_ONE_LAUNCH
#define MK_ONE_LAUNCH 0
#endif
extern "C" void kernel_launch(void* const* d_in, const int* in_sizes, int n_in, void* d_out, int out_size, void* d_ws, size_t ws_size, hipStream_t stream) {
    static int grid = 0;
    if (grid == 0) {
        if (n_in != 32 || in_sizes[0] != M * DM || out_size != M * DM || ws_size < WS_END) { fprintf(stderr, "kernel_launch: unexpected shapes / workspace (n_in %d, ws %zu)\n", n_in, ws_size); grid = -1; return; }
        int dev = 0, cus = 0;
        if (hipGetDevice(&dev) != hipSuccess || hipDeviceGetAttribute(&cus, hipDeviceAttributeMultiprocessorCount, dev) != hipSuccess) { grid = -1; return; }
        if (hipFuncSetAttribute((const void*)mk_fwd, hipFuncAttributeMaxDynamicSharedMemorySize, LDS_BYTES) != hipSuccess) { fprintf(stderr, "kernel_launch: hipFuncSetAttribute failed\n"); grid = -1; return; }
        int per_cu = 0;
        if (hipOccupancyMaxActiveBlocksPerMultiprocessor(&per_cu, (const void*)mk_fwd, NWAVES * 64, LDS_BYTES) != hipSuccess || per_cu < 1) { fprintf(stderr, "kernel_launch: occupancy query says %d\n", per_cu); }
        (void)hipGetLastError();
        grid = cus;
    }
    if (grid < 0) return;
    (void)hipMemsetAsync((char*)d_ws + WS_CTL, 0, CTL_ZERO_BYTES, stream);
    Args a{};
    for (int i = 0; i < 32; ++i) a.in[i] = (const float*)d_in[i];
    a.out = (float*)d_out; a.ws = (unsigned char*)d_ws;
#if MK_ONE_LAUNCH
    a.ph_lo = 0; a.ph_hi = N_PHASES;
    hipLaunchKernelGGL(mk_fwd, dim3(grid), dim3(NWAVES * 64), LDS_BYTES, stream, a);
#else
    for (int p = 0; p < N_PHASES; ++p) { a.ph_lo = p; a.ph_hi = p + 1; hipLaunchKernelGGL(mk_fwd, dim3(grid), dim3(NWAVES * 64), LDS_BYTES, stream, a);
#if PROBE == 1
        if (p == 2) hipLaunchKernelGGL(probe_ffn, dim3(8), dim3(256), 0, stream, (const unsigned char*)d_ws, a.in[3], a.in[4], a.in[5]);
#elif PROBE == 2
        if (p == 4) hipLaunchKernelGGL(probe_win, dim3(8), dim3(256), 0, stream, (const unsigned char*)d_ws, a.in[8]);
#elif PROBE == 3
        if (p == 8) hipLaunchKernelGGL(probe_merge, dim3(8), dim3(256), 0, stream, (const unsigned char*)d_ws, a.in[8], a.in[25], a.in[26], 0);
#elif PROBE == 5
        if (p == 8) hipLaunchKernelGGL(probe_merge, dim3(8), dim3(256), 0, stream, (const unsigned char*)d_ws, a.in[8], a.in[25], a.in[26], 2);
#elif PROBE == 6
        if (p == 8) hipLaunchKernelGGL(probe_merge, dim3(8), dim3(256), 0, stream, (const unsigned char*)d_ws, a.in[8], a.in[25], a.in[26], 3);
#elif PROBE == 7
        if (p == 6) hipLaunchKernelGGL(probe_wconv, dim3(48), dim3(256), 0, stream, (const unsigned char*)d_ws, a.in[8], 5632);
#elif PROBE == 8
        if (p == 3) hipLaunchKernelGGL(probe_wconv, dim3(48), dim3(256), 0, stream, (const unsigned char*)d_ws, a.in[8], 5632);
#elif PROBE == 9
        if (p == 7) hipLaunchKernelGGL(probe_merge, dim3(8), dim3(256), 0, stream, (const unsigned char*)d_ws, a.in[8], a.in[25], a.in[26], 2);
#elif PROBE == 4
        if (p == 9) hipLaunchKernelGGL(probe_merge, dim3(8), dim3(256), 0, stream, (const unsigned char*)d_ws, a.in[8], a.in[25], a.in[26], 1);
#endif
    }
#endif
}
```

```cpp
#include <hip/hip_runtime.h>
#include <hip/hip_bf16.h>
#include <cstdio>
#include <cstdint>
#define MK_ONE_LAUNCH 1
#define GATE_RAW 1

__device__ __forceinline__ int otid_() { int t = (int)threadIdx.x; asm volatile("" : "+v"(t)); return t; }
namespace pg8 {
#define PG8_LAS __attribute__((address_space(3)))
typedef unsigned short bf16_t;
typedef short bf16x8 __attribute__((ext_vector_type(8)));
typedef float f32x4 __attribute__((ext_vector_type(4)));
typedef unsigned u32x4 __attribute__((ext_vector_type(4)));
constexpr int BM = 256, BK = 64, HALF = 128, HTB = HALF * BK * 2  , STAGE_BYTES = 8 * HTB, NXCD = 8, WGM = 8;

__host__ __device__ __forceinline__ int lds_byte(int r, int c) { const int st = (r >> 4) * 2 + (c >> 5), rr = r & 15, cc = c & 31, ob = rr * 64 + cc * 2; return st * 1024 + (ob ^ (((ob >> 9) & 1) << 5)); }
__host__ __device__ __forceinline__ void stage_rc(int b, int& R, int& C) { const int st = b / 1024, sb = b % 1024, swz = sb ^ (((sb >> 9) & 1) << 5); R = (st >> 1) * 16 + swz / 64; C = (st & 1) * 32 + (swz % 64) / 2; }
__host__ __device__ __forceinline__ int perm32(int rho) { const int n = rho >> 4, i = rho & 15; return 8 * (i >> 2) + 4 * n + (i & 3); }

struct Unit { int pm, pn; };
struct Gemm { const bf16_t* A; const bf16_t* Bt; int M, N, K, lda; };

struct StaticOrder {
    int nM, nN, nwg, G, c;
    __host__ __device__ void init(int M, int N, int G_, int c_) { nM = M / BM; nN = N / BM; nwg = nM * nN; G = G_; c = c_; }
    __host__ __device__ bool next(int i, Unit& u) const {
        const long L = (long)i * G + c; if (L >= nwg) return false;
        int wgid = (int)L; { const int q = nwg / NXCD, r = nwg % NXCD, xcd = wgid % NXCD, off = wgid / NXCD; wgid = (xcd < r ? xcd * (q + 1) : r * (q + 1) + (xcd - r) * q) + off; }
        const int nig = WGM * nN, gid = wgid / nig, fm = gid * WGM, gsz = (nM - fm) < WGM ? (nM - fm) : WGM;
        u.pm = fm + ((wgid % nig) % gsz); u.pn = (wgid % nig) / gsz; return true;
    }
    __device__ __forceinline__ void a_ready(const Unit&) const {}
    __device__ __forceinline__ void done(const Unit&) const {}
};

__device__ __forceinline__ unsigned cvt_pk_bf16(float lo, float hi) { unsigned r; asm volatile("v_cvt_pk_bf16_f32 %0, %1, %2" : "=v"(r) : "v"(lo), "v"(hi)); return r; }

template <class Epi, class Sched, bool ALIGN_EPI = false, bool SP2 = false>
__device__ __forceinline__ void gemm_phase(PG8_LAS unsigned char* lds, const Gemm g, const Sched& S, const Epi& E) {
    const int tid = otid_(), wid = __builtin_amdgcn_readfirstlane(tid >> 6), lane = tid & 63, wr = wid >> 2, wc = wid & 3, fr = lane & 15, fq = lane >> 4;
    const int K = g.K, nt = K / BK;
    unsigned voffA[2], voffB[2];
#pragma unroll
    for (int i = 0; i < 2; ++i) { int R, C; stage_rc(tid * 16 + i * 8192, R, C); const int Rb = Epi::PERM ? ((R & ~31) + perm32(R & 31)) : R;
        voffA[i] = (unsigned)(R * g.lda + C) * 2u; voffB[i] = (unsigned)(Rb * K + C) * 2u; }
    const size_t kstep = (size_t)(BK * 2);
    const size_t hstepB = (size_t)HALF * K * 2, hstepA = (size_t)HALF * g.lda * 2;
    const size_t tstepB = 2 * hstepB, tstepA = 2 * hstepA;
    const unsigned ldsw = (unsigned)wid * 1024u;
    const int aoff = lds_byte(wr * 64 + fr, fq * 8), boff = lds_byte(wc * 32 + fr, fq * 8);
#define PG8_SA(b, h) (((b) * 2 + (h)) * HTB)
#define PG8_SB(b, h) ((4 + (b) * 2 + (h)) * HTB)
#define PG8_STAGE(bufoff, gbase, voff) do { _Pragma("unroll") for (int _i = 0; _i < 2; ++_i) \
        __builtin_amdgcn_global_load_lds((const unsigned*)((const char*)(gbase) + (voff)[_i]), (PG8_LAS unsigned*)(lds + (bufoff) + ldsw + _i * 8192), 16, 0, 0); } while (0)
#define PG8_LDA(dst, b, h) do { _Pragma("unroll") for (int m = 0; m < 4; ++m) _Pragma("unroll") for (int k = 0; k < 2; ++k) dst[m][k] = *(const PG8_LAS bf16x8*)(lds + PG8_SA(b, h) + aoff + m * 2048 + k * 1024); } while (0)
#define PG8_LDB(dst, b, h) do { _Pragma("unroll") for (int n = 0; n < 2; ++n) _Pragma("unroll") for (int k = 0; k < 2; ++k) dst[n][k] = *(const PG8_LAS bf16x8*)(lds + PG8_SB(b, h) + boff + n * 2048 + k * 1024); } while (0)
#define PG8_MMA(ai, bj, At, Bt) do { __builtin_amdgcn_s_setprio(1); _Pragma("unroll") for (int m = 0; m < 4; ++m) _Pragma("unroll") for (int n = 0; n < 2; ++n) _Pragma("unroll") for (int k = 0; k < 2; ++k) \
        acc[ai][bj][m][n] = __builtin_amdgcn_mfma_f32_16x16x32_bf16(Bt[n][k], At[m][k], acc[ai][bj][m][n], 0, 0, 0); __builtin_amdgcn_s_setprio(0); } while (0)
#define PG8_WAIT_V(n) asm volatile("s_waitcnt vmcnt(" #n ")" ::: "memory")
#define PG8_WAIT_L(n) asm volatile("s_waitcnt lgkmcnt(" #n ")" ::: "memory")
#define PG8_BAR __builtin_amdgcn_s_barrier()
#define PG8_SCHED __builtin_amdgcn_sched_barrier(0)
    Unit cur, nxt; int ui = 0;
    if (!S.next(0, cur)) return;
    f32x4 acc[2][2][4][2];
#pragma unroll
    for (int a = 0; a < 2; ++a)
#pragma unroll
        for (int b = 0; b < 2; ++b)
#pragma unroll
            for (int m = 0; m < 4; ++m)
#pragma unroll
                for (int n = 0; n < 2; ++n) acc[a][b][m][n] = (f32x4){0.f, 0.f, 0.f, 0.f};
    bf16x8 At[4][2], B0[2][2], B1[2][2];
    const char* cA = (const char*)g.A + (size_t)cur.pm * tstepA; const char* cB = (const char*)g.Bt + (size_t)cur.pn * tstepB;
    S.a_ready(cur);
    if constexpr (SP2) {
        PG8_STAGE(PG8_SB(0, 0), cB, voffB); PG8_STAGE(PG8_SB(0, 1), cB + hstepB, voffB); PG8_STAGE(PG8_SA(0, 0), cA, voffA); PG8_STAGE(PG8_SA(0, 1), cA + hstepA, voffA);
        if (wr == 1) PG8_BAR;
        PG8_WAIT_V(2); PG8_BAR;
        PG8_STAGE(PG8_SB(1, 0), cB + kstep, voffB); PG8_STAGE(PG8_SA(1, 0), cA + kstep, voffA); PG8_STAGE(PG8_SB(1, 1), cB + hstepB + kstep, voffB);
        PG8_WAIT_V(6); PG8_BAR;
    } else {
        PG8_STAGE(PG8_SB(0, 0), cB, voffB); PG8_STAGE(PG8_SA(0, 0), cA, voffA); PG8_STAGE(PG8_SB(0, 1), cB + hstepB, voffB); PG8_STAGE(PG8_SA(0, 1), cA + hstepA, voffA);
        if (wr == 1) PG8_BAR;
        PG8_WAIT_V(4); PG8_BAR;
        PG8_STAGE(PG8_SB(1, 0), cB + kstep, voffB); PG8_STAGE(PG8_SA(1, 0), cA + kstep, voffA); PG8_STAGE(PG8_SB(1, 1), cB + hstepB + kstep, voffB);
        PG8_WAIT_V(6); PG8_BAR;
    }
    for (;;) {
        const bool has_next = S.next(ui + 1, nxt);
        const char* nA = has_next ? (const char*)g.A + (size_t)nxt.pm * tstepA : cA; const char* nB = has_next ? (const char*)g.Bt + (size_t)nxt.pn * tstepB : cB;
        for (int t = 0; t < nt; t += 2) {
            const bool last = (t == nt - 2);
            const char* a1 = cA + (size_t)(t + 1) * kstep;
            const char* a2 = last ? nA : cA + (size_t)(t + 2) * kstep; const char* b2 = last ? nB : cB + (size_t)(t + 2) * kstep;
            const char* a3 = a2 + kstep; const char* b3 = b2 + kstep;
            if (last && has_next) S.a_ready(nxt);
            if constexpr (SP2) {
            PG8_LDB(B0, 0, 0); PG8_LDB(B1, 0, 1); PG8_SCHED; PG8_LDA(At, 0, 0); PG8_STAGE(PG8_SA(1, 1), a1 + hstepA, voffA);
            PG8_WAIT_V(8); PG8_WAIT_L(0); PG8_BAR; PG8_MMA(0, 0, At, B0); PG8_MMA(0, 1, At, B1); PG8_BAR; PG8_SCHED;
            PG8_LDA(At, 0, 1); PG8_STAGE(PG8_SB(0, 0), b2, voffB); PG8_STAGE(PG8_SB(0, 1), b2 + hstepB, voffB); PG8_STAGE(PG8_SA(0, 0), a2, voffA);
            PG8_WAIT_V(8); PG8_WAIT_L(0); PG8_BAR; PG8_MMA(1, 0, At, B0); PG8_MMA(1, 1, At, B1); PG8_BAR; PG8_SCHED;
            PG8_LDB(B0, 1, 0); PG8_LDB(B1, 1, 1); PG8_SCHED; PG8_LDA(At, 1, 0); PG8_STAGE(PG8_SA(0, 1), a2 + hstepA, voffA);
            PG8_WAIT_V(8); PG8_WAIT_L(0); PG8_BAR; PG8_MMA(0, 0, At, B0); PG8_MMA(0, 1, At, B1); PG8_BAR; PG8_SCHED;
            PG8_LDA(At, 1, 1); PG8_STAGE(PG8_SB(1, 0), b3, voffB); PG8_STAGE(PG8_SB(1, 1), b3 + hstepB, voffB); PG8_STAGE(PG8_SA(1, 0), a3, voffA);
            PG8_WAIT_V(8); PG8_WAIT_L(0); PG8_BAR; PG8_MMA(1, 0, At, B0); PG8_MMA(1, 1, At, B1); PG8_BAR; PG8_SCHED;
            } else {
            PG8_LDB(B0, 0, 0); PG8_SCHED; PG8_LDA(At, 0, 0); PG8_STAGE(PG8_SA(1, 1), a1 + hstepA, voffA);
            PG8_WAIT_L(8); PG8_BAR; PG8_WAIT_L(0); PG8_MMA(0, 0, At, B0); PG8_BAR; PG8_SCHED;
            PG8_LDB(B1, 0, 1); PG8_STAGE(PG8_SB(0, 0), b2, voffB);
            PG8_BAR; PG8_WAIT_L(0); PG8_MMA(0, 1, At, B1); PG8_BAR;
            PG8_LDA(At, 0, 1); PG8_STAGE(PG8_SA(0, 0), a2, voffA);
            PG8_BAR; PG8_WAIT_L(0); PG8_MMA(1, 0, At, B0); PG8_BAR; PG8_SCHED;
            PG8_STAGE(PG8_SB(0, 1), b2 + hstepB, voffB);
            PG8_WAIT_V(6); PG8_BAR; PG8_MMA(1, 1, At, B1); PG8_BAR;
            PG8_LDB(B0, 1, 0); PG8_SCHED; PG8_LDA(At, 1, 0); PG8_STAGE(PG8_SA(0, 1), a2 + hstepA, voffA);
            PG8_WAIT_L(8); PG8_BAR; PG8_WAIT_L(0); PG8_MMA(0, 0, At, B0); PG8_BAR; PG8_SCHED;
            PG8_LDB(B1, 1, 1); PG8_STAGE(PG8_SB(1, 0), b3, voffB);
            PG8_BAR; PG8_WAIT_L(0); PG8_MMA(0, 1, At, B1); PG8_BAR;
            PG8_LDA(At, 1, 1); PG8_STAGE(PG8_SA(1, 0), a3, voffA);
            PG8_BAR; PG8_WAIT_L(0); PG8_MMA(1, 0, At, B0); PG8_BAR; PG8_SCHED;
            PG8_STAGE(PG8_SB(1, 1), b3 + hstepB, voffB);
            PG8_WAIT_V(6); PG8_BAR; PG8_MMA(1, 1, At, B1); PG8_BAR;
            }
        }
        if constexpr (ALIGN_EPI) { if (wr == 0) PG8_BAR; }
        if constexpr (!Epi::AFTER_DRAIN) { E(acc, cur, wr, wc, fr, fq); S.done(cur); }
        if (!has_next) break;
#pragma unroll
        for (int a = 0; a < 2; ++a)
#pragma unroll
            for (int b = 0; b < 2; ++b)
#pragma unroll
                for (int m = 0; m < 4; ++m)
#pragma unroll
                    for (int n = 0; n < 2; ++n) acc[a][b][m][n] = (f32x4){0.f, 0.f, 0.f, 0.f};
        cur = nxt; cA = nA; cB = nB; ++ui;
        if constexpr (ALIGN_EPI) { if (wr == 1) PG8_BAR; }
    }
    PG8_WAIT_V(0);
    if constexpr (!ALIGN_EPI) { if (wr == 0) PG8_BAR; }
    PG8_BAR;
    if constexpr (Epi::AFTER_DRAIN) { E.fused(acc, cur, wr, wc, fr, fq, lds, wid, lane); S.done(cur); }
#undef PG8_SA
#undef PG8_SB
#undef PG8_STAGE
#undef PG8_LDA
#undef PG8_LDB
#undef PG8_MMA
#undef PG8_WAIT_V
#undef PG8_WAIT_L
#undef PG8_BAR
#undef PG8_SCHED
}
}
namespace pg8 {
typedef unsigned u32x2 __attribute__((ext_vector_type(2)));
__device__ __forceinline__ float bf_lo(unsigned w) { return __uint_as_float(w << 16); }
__device__ __forceinline__ float bf_hi(unsigned w) { return __uint_as_float(w & 0xffff0000u); }
__device__ __forceinline__ float sigmoidf_(float x) { return __builtin_amdgcn_rcpf(1.0f + __expf(-x)); }

struct EpiSwiGLU {
    static constexpr bool PERM = false, AFTER_DRAIN = false;
    bf16_t* H; int ldh;
    __device__ __forceinline__ void operator()(const f32x4 (&acc)[2][2][4][2], const Unit& u, int wr, int wc, int fr, int fq) const {
        const int row0 = u.pm * BM + wr * 64 + fr, hc0 = u.pn * 128 + wc * 16 + 4 * fq;
#pragma unroll
        for (int ai = 0; ai < 2; ++ai)
#pragma unroll
            for (int m = 0; m < 4; ++m) { bf16_t* rowp = H + (size_t)(row0 + ai * HALF + m * 16) * ldh + hc0;
#pragma unroll
                for (int bj = 0; bj < 2; ++bj) { const f32x4 g = acc[ai][bj][m][0], up = acc[ai][bj][m][1]; float h[4];
#pragma unroll
                    for (int e = 0; e < 4; ++e) h[e] = g[e] * sigmoidf_(g[e]) * up[e];
                    u32x2 w; w.x = cvt_pk_bf16(h[0], h[1]); w.y = cvt_pk_bf16(h[2], h[3]);
                    *(u32x2*)(rowp + bj * 64) = w; } }
    }
};
template <int ACT> struct EpiStore {
    static constexpr bool PERM = true, AFTER_DRAIN = false;
    bf16_t* O0; int ld0; bf16_t* O1; int ld1; int split_tiles;
    __device__ __forceinline__ void operator()(const f32x4 (&acc)[2][2][4][2], const Unit& u, int wr, int wc, int fr, int fq) const {
        const int row0 = u.pm * BM + wr * 64 + fr;
        bf16_t* base; int ld, colt;
        if (u.pn < split_tiles) { base = O0; ld = ld0; colt = u.pn * BM; } else { base = O1; ld = ld1; colt = (u.pn - split_tiles) * BM; }
        const int col0 = colt + wc * 32 + 8 * fq;
#pragma unroll
        for (int ai = 0; ai < 2; ++ai)
#pragma unroll
            for (int m = 0; m < 4; ++m) { bf16_t* rowp = base + (size_t)(row0 + ai * HALF + m * 16) * ld + col0;
#pragma unroll
                for (int bj = 0; bj < 2; ++bj) { f32x4 v0 = acc[ai][bj][m][0], v1 = acc[ai][bj][m][1];
                    if (ACT == 1) {
#pragma unroll
                        for (int e = 0; e < 4; ++e) { v0[e] = sigmoidf_(v0[e]); v1[e] = sigmoidf_(v1[e]); } }
                    u32x4 w; w.x = cvt_pk_bf16(v0[0], v0[1]); w.y = cvt_pk_bf16(v0[2], v0[3]); w.z = cvt_pk_bf16(v1[0], v1[1]); w.w = cvt_pk_bf16(v1[2], v1[3]);
                    *(u32x4*)(rowp + bj * HALF) = w; } }
    }
};
#ifdef GATE_RAW
#define GSIG(x) sigmoidf_(x)
#else
#define GSIG(x) (x)
#endif
struct EpiGateMul {
    static constexpr bool PERM = true, AFTER_DRAIN = false;
    bf16_t* MG; int ldm; const bf16_t* G; int ldg; int first;
    __device__ __forceinline__ void operator()(const f32x4 (&acc)[2][2][4][2], const Unit& u, int wr, int wc, int fr, int fq) const {
        const int row0 = u.pm * BM + wr * 64 + fr, col0 = u.pn * BM + wc * 32 + 8 * fq;
#pragma unroll
        for (int ai = 0; ai < 2; ++ai)
#pragma unroll
            for (int m = 0; m < 4; ++m) { const size_t r = (size_t)(row0 + ai * HALF + m * 16);
#pragma unroll
                for (int bj = 0; bj < 2; ++bj) { const f32x4 v0 = acc[ai][bj][m][0], v1 = acc[ai][bj][m][1];
                    const u32x4 g = *(const u32x4*)(G + r * ldg + col0 + bj * HALF);
                    float o[8] = { v0[0] * GSIG(bf_lo(g.x)), v0[1] * GSIG(bf_hi(g.x)), v0[2] * GSIG(bf_lo(g.y)), v0[3] * GSIG(bf_hi(g.y)), v1[0] * GSIG(bf_lo(g.z)), v1[1] * GSIG(bf_hi(g.z)), v1[2] * GSIG(bf_lo(g.w)), v1[3] * GSIG(bf_hi(g.w)) };
                    bf16_t* mp = MG + r * ldm + col0 + bj * HALF;
                    if (!first) { const u32x4 p = *(const u32x4*)mp;
                        o[0] += bf_lo(p.x); o[1] += bf_hi(p.x); o[2] += bf_lo(p.y); o[3] += bf_hi(p.y); o[4] += bf_lo(p.z); o[5] += bf_hi(p.z); o[6] += bf_lo(p.w); o[7] += bf_hi(p.w); }
                    u32x4 w; w.x = cvt_pk_bf16(o[0], o[1]); w.y = cvt_pk_bf16(o[2], o[3]); w.z = cvt_pk_bf16(o[4], o[5]); w.w = cvt_pk_bf16(o[6], o[7]);
                    *(u32x4*)mp = w; } }
    }
};
}
namespace att {
constexpr int D = 128;
constexpr bool WSKIP = false;
constexpr float THR = 8.f;
constexpr int NW = 8, QBLK = 32, KVBLK = 64, QB = NW * QBLK;
constexpr int SHM_V = KVBLK * D * 2, SHM_K = KVBLK * D * 2;
constexpr int LDS_BYTES = 2 * SHM_V + 2 * SHM_K + NW * 64 * 4;
using bf16 = __hip_bfloat16;
typedef short bf16x8 __attribute__((ext_vector_type(8)));
typedef short s16x4 __attribute__((ext_vector_type(4)));
typedef float f32x16 __attribute__((ext_vector_type(16)));
typedef float f32x4 __attribute__((ext_vector_type(4)));
typedef unsigned u32x4 __attribute__((ext_vector_type(4)));
template <class A, class Bt> struct same_t { static constexpr bool v = false; };
template <class A> struct same_t<A, A> { static constexpr bool v = true; };

#define KSWZ(row, colB) ((row) * 256 + ((colB) ^ (((row) & 7) << 4)))
#define SBAR() __builtin_amdgcn_sched_barrier(0)
__device__ __forceinline__ int v_st(int k, int c) { const int kk = (k & ~0xC) | ((k & 4) << 1) | ((k & 8) >> 1); return ((kk >> 3) * 4 + (c >> 5)) * 512 + ((kk & 7) * 32 + (c & 31)) * 2; }
__device__ __forceinline__ int v_rd_base(int lane) { return ((lane & 3) << 3) | (((lane >> 2) & 3) << 6) | (((lane >> 4) & 1) << 5) | (((lane >> 5) & 1) << 8); }
constexpr int v_rd_off(int d0, int ks, int half) { return d0 * 512 + ks * 4096 + half * 2048; }
__device__ __forceinline__ int crow(int r, int hi) { return (r & 3) + 8 * (r >> 2) + 4 * hi; }
__device__ __forceinline__ unsigned cvtpk(float lo, float hi) {
    unsigned r; asm volatile("v_cvt_pk_bf16_f32 %0, %1, %2" : "=v"(r) : "v"(lo), "v"(hi)); return r;
}
__device__ __forceinline__ bf16x8 pack8(f32x4 a, f32x4 b) {
    u32x4 w = {cvtpk(a[0], a[1]), cvtpk(a[2], a[3]), cvtpk(b[0], b[1]), cvtpk(b[2], b[3])};
    return *reinterpret_cast<bf16x8*>(&w);
}
template <class T> __device__ __forceinline__ bf16x8 load8(const T* p) {
    if constexpr (same_t<T, float>::v) { return pack8(*(const f32x4*)p, *(const f32x4*)(p + 4)); }
    else { return *reinterpret_cast<const bf16x8*>(p); }
}
__device__ __forceinline__ void mask_tile(f32x16& p0, f32x16& p1, int dq, unsigned W) {
    const float NEG = -__builtin_inff();
#pragma unroll
    for (int r = 0; r < 16; ++r) {
        const int c = (r & 3) + 8 * (r >> 2);
        if ((unsigned)(dq - c) >= W) p0[r] = NEG;
        if ((unsigned)(dq - c - 32) >= W) p1[r] = NEG;
    }
}
typedef unsigned u32x2 __attribute__((ext_vector_type(2)));
__device__ __forceinline__ void bitmask_tile(f32x16& p0, f32x16& p1, u32x2 w, int hi) {
    const float NEG = -__builtin_inff();
    const unsigned a = w[0] >> (4 * hi), b = w[1] >> (4 * hi);
#pragma unroll
    for (int r = 0; r < 16; ++r) {
        const int c = (r & 3) + 8 * (r >> 2);
        if (!((a >> c) & 1u)) p0[r] = NEG;
        if (!((b >> c) & 1u)) p1[r] = NEG;
    }
}
template <bool HALFQK> __device__ __forceinline__ void partialSM(f32x16& p0, f32x16& p1, float& m_reg, float& mn, float& alpha) {
    constexpr float SCALE = HALFQK ? 0.125f : 0.08838834764831845f;
    float pmax = p0[0]; for (int r = 1; r < 16; ++r) pmax = fmaxf(pmax, p0[r]); for (int r = 0; r < 16; ++r) pmax = fmaxf(pmax, p1[r]);
    { auto rr = __builtin_amdgcn_permlane32_swap(__float_as_uint(pmax), __float_as_uint(pmax), false, false);
      pmax = fmaxf(__uint_as_float(rr[0]), __uint_as_float(rr[1])); }
    constexpr float C2 = 1.4426950408889634f * SCALE;
    if (__builtin_expect(__all((pmax - m_reg) * SCALE <= THR), 1)) { mn = m_reg; alpha = 1.f; }
    else { mn = fmaxf(m_reg, pmax); alpha = __builtin_amdgcn_exp2f((m_reg - mn) * C2); m_reg = mn; }
    const float mnL = -mn * C2;
    for (int r = 0; r < 16; ++r) p0[r] = fmaf(p0[r], C2, mnL); for (int r = 0; r < 16; ++r) p1[r] = fmaf(p1[r], C2, mnL);
    for (int r = 0; r < 16; ++r) p0[r] = __builtin_amdgcn_exp2f(p0[r]);
}
__device__ __forceinline__ void finishSM(f32x16& p0, f32x16& p1, float alpha, float& l_reg, bf16x8& pa0, bf16x8& pa1, bf16x8& pa2, bf16x8& pa3) {
    for (int r = 0; r < 16; ++r) p1[r] = __builtin_amdgcn_exp2f(p1[r]);
    float ps = 0; for (int r = 0; r < 16; ++r) ps += p0[r]; for (int r = 0; r < 16; ++r) ps += p1[r];
    { auto rr = __builtin_amdgcn_permlane32_swap(__float_as_uint(ps), __float_as_uint(ps), false, false);
      ps = __uint_as_float(rr[0]) + __uint_as_float(rr[1]); }
    l_reg = l_reg * alpha + ps;
#define PK4(P, B_, OUT) do { unsigned a0 = cvtpk(P[B_+0], P[B_+1]), a1 = cvtpk(P[B_+2], P[B_+3]);                          \
        unsigned b0 = cvtpk(P[B_+4], P[B_+5]), b1 = cvtpk(P[B_+6], P[B_+7]);                                             \
        auto r0 = __builtin_amdgcn_permlane32_swap(a0, b0, false, false); auto r1 = __builtin_amdgcn_permlane32_swap(a1, b1, false, false); \
        u32x4 w = {r0[0], r1[0], r0[1], r1[1]}; OUT = *reinterpret_cast<bf16x8*>(&w); } while (0)
    PK4(p0, 0, pa0); PK4(p0, 8, pa1); PK4(p1, 0, pa2); PK4(p1, 8, pa3);
#undef PK4
}
template <int KB, bool SK, bool HALFQK>
__device__ __forceinline__ void qkt(f32x16& p0, f32x16& p1, const char* K_lds, int r32, int hi, const bf16x8* qr, bool act, int koff) {
    if (SK && !act) { const float NEG = -__builtin_inff();
#pragma unroll
        for (int r = 0; r < 16; ++r) { p0[r] = NEG; p1[r] = NEG; } return; }
    p0 = f32x16{}; p1 = f32x16{};
    const char* kb[4];
#pragma unroll
    for (int dd = 0; dd < 4; ++dd) kb[dd] = K_lds + KB * SHM_K + KSWZ(r32, (dd * 16 + hi * 8) * 2) + koff;
#pragma unroll
    for (int d0 = 0; d0 < (HALFQK ? 4 : 8); ++d0) { const char* a = kb[d0 & 3] + (d0 >> 2) * 128;
        bf16x8 b0 = *reinterpret_cast<const bf16x8*>(a);
        bf16x8 b1 = *reinterpret_cast<const bf16x8*>(a + 32 * 256);
        p0 = __builtin_amdgcn_mfma_f32_32x32x16_bf16(b0, qr[d0], p0, 0, 0, 0);
        p1 = __builtin_amdgcn_mfma_f32_32x32x16_bf16(b1, qr[d0], p1, 0, 0, 0); }
}
template <int VB, bool SK>
__device__ __forceinline__ void pv_tile(f32x16* o, int vb0, bf16x8 pa0, bf16x8 pa1, bf16x8 pa2, bf16x8 pa3, bool act) {
    if (SK && !act) return;
#define TRRD(dst, off) asm volatile("ds_read_b64_tr_b16 %0, %1 offset:%2" : "=&v"(dst) : "v"(vb0), "i"(off) : "memory")
#define PV_D0(d0) do { s16x4 l0, l1, l2, l3, h0, h1, h2, h3; constexpr int b_ = VB * SHM_V + v_rd_off(d0, 0, 0);     \
        TRRD(l0, b_); TRRD(h0, b_ + 2048); TRRD(l1, b_ + 4096); TRRD(h1, b_ + 6144); TRRD(l2, b_ + 8192); TRRD(h2, b_ + 10240); TRRD(l3, b_ + 12288); TRRD(h3, b_ + 14336); \
        asm volatile("s_waitcnt lgkmcnt(0)" ::: "memory"); SBAR();                 \
        o[d0] = __builtin_amdgcn_mfma_f32_32x32x16_bf16(pa0, (bf16x8){l0[0], l0[1], l0[2], l0[3], h0[0], h0[1], h0[2], h0[3]}, o[d0], 0, 0, 0);   \
        o[d0] = __builtin_amdgcn_mfma_f32_32x32x16_bf16(pa1, (bf16x8){l1[0], l1[1], l1[2], l1[3], h1[0], h1[1], h1[2], h1[3]}, o[d0], 0, 0, 0);   \
        o[d0] = __builtin_amdgcn_mfma_f32_32x32x16_bf16(pa2, (bf16x8){l2[0], l2[1], l2[2], l2[3], h2[0], h2[1], h2[2], h2[3]}, o[d0], 0, 0, 0);   \
        o[d0] = __builtin_amdgcn_mfma_f32_32x32x16_bf16(pa3, (bf16x8){l3[0], l3[1], l3[2], l3[3], h3[0], h3[1], h3[2], h3[3]}, o[d0], 0, 0, 0); } while (0)
    PV_D0(0); PV_D0(1); PV_D0(2); PV_D0(3);
#undef PV_D0
#undef TRRD
}

constexpr int QS = 1536, KVS = 4096;
template <class TIn, class TOut> struct BlockRef { const TIn* Q; const TIn* K; const TIn* V; TOut* O; int P0; int koff; const unsigned* mask; };
template <class TIn> struct Seam {
    bf16x8 qr[8];
    bf16x8 st_v0, st_v1, st_k0, st_k1; f32x4 sf0, sf1, sf2, sf3;
    f32x4 tq[16];
};
__device__ __forceinline__ int swa_jlo(int P0, int W) { const int lowk = P0 - W + 1; return lowk > 0 ? lowk / KVBLK : 0; }
#define ROW(p, k0, rr) ((p) + (size_t)((k0) + (rr)) * KVS + sc)
#define VMW() asm volatile("s_waitcnt vmcnt(0)" ::: "memory")
#define VMWN(n) asm volatile("s_waitcnt vmcnt(%0)" :: "i"(n) : "memory")
#define SLOAD_H(Kp, Vp, k0) do { S.st_v0 = load8<TIn>(ROW(Vp, k0, sr)); S.st_v1 = load8<TIn>(ROW(Vp, k0, 32 + sr));              \
                         S.st_k0 = load8<TIn>(ROW(Kp, k0, sr)); S.st_k1 = load8<TIn>(ROW(Kp, k0, 32 + sr)); } while (0)
#define SWRITE_HK(bf) do { *(bf16x8*)(K_lds + (bf) * SHM_K + kws) = S.st_k0; *(bf16x8*)(K_lds + (bf) * SHM_K + kws + 32 * 256) = S.st_k1; } while (0)
#define SWRITE_HV(bf) do { *(bf16x8*)(V_lds + (bf) * SHM_V + vst0) = S.st_v0; *(bf16x8*)(V_lds + (bf) * SHM_V + vst1) = S.st_v1; } while (0)
#define SWRITE_H(bf) do { SWRITE_HV(bf); SWRITE_HK(bf); } while (0)
#define SLOAD_F(p, k0) do { S.sf0 = *(const f32x4*)ROW(p, k0, sr); S.sf1 = *(const f32x4*)(ROW(p, k0, sr) + 4);                \
                            S.sf2 = *(const f32x4*)ROW(p, k0, 32 + sr); S.sf3 = *(const f32x4*)(ROW(p, k0, 32 + sr) + 4); } while (0)
#define SWRITE_KF(bf) do { *(bf16x8*)(K_lds + (bf) * SHM_K + kws) = pack8(S.sf0, S.sf1); *(bf16x8*)(K_lds + (bf) * SHM_K + kws + 32 * 256) = pack8(S.sf2, S.sf3); } while (0)
#define SWRITE_VF(bf) do { *(bf16x8*)(V_lds + (bf) * SHM_V + vst0) = pack8(S.sf0, S.sf1); *(bf16x8*)(V_lds + (bf) * SHM_V + vst1) = pack8(S.sf2, S.sf3); } while (0)
template <class TIn, class TOut, bool HALFQK>
__device__ __forceinline__ void causal_swa_prime(const BlockRef<TIn, TOut>& cur, int W, char* lds, Seam<TIn>& S) {
    constexpr bool F32 = same_t<TIn, float>::v;
    const int tid = otid_(), wid = __builtin_amdgcn_readfirstlane(tid >> 6), lane = tid & 63, r32 = lane & 31, hi = lane >> 5;
    const int sr = tid >> 4, sc = (tid & 15) * 8, kws = KSWZ(sr, sc * 2); char* K_lds = lds + 2 * SHM_V;
    const int kb0 = swa_jlo(cur.P0, W) * KVBLK;
    for (int d0 = 0; d0 < (HALFQK ? 4 : 8); ++d0) S.qr[d0] = load8<TIn>(cur.Q + (size_t)(wid * QBLK + r32) * QS + d0 * 16 + hi * 8);
    if constexpr (F32) { SLOAD_F((const float*)cur.K, kb0); VMW(); SWRITE_KF(0); SBAR(); SLOAD_F((const float*)cur.V, kb0); }
    else { SLOAD_H(cur.K, cur.V, kb0); VMW(); SWRITE_HK(0); }
    __syncthreads();
}
template <class TIn, class TOut, bool HALFQK, bool MASKED, int OS>
__device__ __forceinline__ void causal_swa_block(const BlockRef<TIn, TOut>& cur, const BlockRef<TIn, TOut>& nxt, int skv, int W, char* lds, Seam<TIn>& S) {
    constexpr bool F32 = same_t<TIn, float>::v;
    const int tid = otid_(), wid = __builtin_amdgcn_readfirstlane(tid >> 6), lane = tid & 63, r32 = lane & 31, hi = lane >> 5;
    const int j_lo = swa_jlo(cur.P0, W);
    int j_hi = (cur.P0 + QB - 1) / KVBLK + 1; if (j_hi > skv / KVBLK) j_hi = skv / KVBLK;
    const int NT = j_hi - j_lo;
    const int kbn = swa_jlo(nxt.P0, W) * KVBLK;
    const int qlo = cur.P0 + wid * QBLK, qm = qlo + r32 - 4 * hi;
    char* V_lds = lds; char* K_lds = lds + 2 * SHM_V;
    float* ws = (float*)(lds + 2 * SHM_V + 2 * SHM_K) + wid * 64; float* li_l = ws, * al_l = ws + 32;
    float m_reg = -1e30f, l_reg = 0; f32x16 o[4] = {};
    const int sr = tid >> 4, sc = (tid & 15) * 8, vst0 = v_st(sr, sc), vst1 = v_st(32 + sr, sc), kws = KSWZ(sr, sc * 2);
    const int vb0 = (int)(uintptr_t)V_lds + v_rd_base(lane);
    const TIn* Kh = cur.K; const TIn* Vh = cur.V;
#define RESC(a) do { if (__any((a) < 1.f)) { if (hi == 0) al_l[r32] = (a); asm volatile("s_waitcnt lgkmcnt(0)" ::: "memory");              \
                     for (int d_ = 0; d_ < 4; ++d_) for (int r = 0; r < 16; ++r) o[d_][r] *= al_l[crow(r, hi)]; } } while (0)
#define KBASE(t) ((j_lo + (t)) * KVBLK)
#define ACT(t) (KBASE(t) <= qlo + QBLK - 1 && KBASE(t) + KVBLK - 1 >= qlo - W + 1)
#define MASKT(P0_, P1_, t) do { if constexpr (MASKED) bitmask_tile(P0_, P1_, mw, hi);   \
        else { const int kb_ = KBASE(t); if ((!SK || ACT(t)) && (kb_ + KVBLK - 1 > qlo || kb_ <= qlo + QBLK - 1 - W)) mask_tile(P0_, P1_, qm - kb_, (unsigned)W); } } while (0)
    const unsigned moff = (unsigned)((wid * QBLK + r32) * 1024 + 8 * j_lo); u32x2 mw = {0u, 0u};
#define MLOAD(t) do { if constexpr (MASKED) mw = *(const u32x2*)((const char*)cur.mask + (moff + 8u * (unsigned)(t))); } while (0)
    constexpr int NQL = F32 ? 16 : (HALFQK ? 4 : 8);
    constexpr bool SK = WSKIP && !F32;
#define SEAM_K0() do { VMWN(NQL); if constexpr (F32) { SWRITE_KF(0); SBAR(); SLOAD_F((const float*)nxt.V, kbn); } else { SWRITE_HK(0); } SBAR(); } while (0)
    f32x16 pA0, pA1, pB0, pB1; float mnA, mnB, alA, alB; bf16x8 pa0, pa1, pa2, pa3;
    if constexpr (F32) { VMW(); SWRITE_VF(0); SBAR(); } else { SWRITE_HV(0); SBAR(); }
    if (NT > 1) { if constexpr (F32) SLOAD_F((const float*)Kh, KBASE(1)); else SLOAD_H(Kh, Vh, KBASE(1)); }
    SBAR(); qkt<0, SK, HALFQK>(pA0, pA1, K_lds, r32, hi, S.qr, ACT(0), cur.koff); MLOAD(0);
    if constexpr (F32) { if (NT > 1) { VMW(); SWRITE_KF(1); SBAR(); SLOAD_F((const float*)Vh, KBASE(1)); } }
    MASKT(pA0, pA1, 0); partialSM<HALFQK>(pA0, pA1, m_reg, mnA, alA);
    if (NT > 1) { VMW(); if constexpr (F32) { SWRITE_VF(1); SBAR(); if (NT > 2) SLOAD_F((const float*)Kh, KBASE(2)); } else SWRITE_H(1); }
    __syncthreads();
#define HALF_STEP(PX0, PX1, mnX, alX, PY0, PY1, alY, t, KB, VB, SB) do {                                                      \
        SBAR(); qkt<KB, SK, HALFQK>(PX0, PX1, K_lds, r32, hi, S.qr, ACT(t), cur.koff); MLOAD(t);                                             \
        finishSM(PY0, PY1, alY, l_reg, pa0, pa1, pa2, pa3); SBAR();                                                           \
        if ((t) + 1 < NT) { if constexpr (F32) { VMW(); SWRITE_KF(SB); SBAR(); SLOAD_F((const float*)Vh, KBASE((t) + 1)); }  \
                            else { SLOAD_H(Kh, Vh, KBASE((t) + 1)); } SBAR(); }                                               \
        pv_tile<VB, SK>(o, vb0, pa0, pa1, pa2, pa3, ACT((t) - 1)); MASKT(PX0, PX1, (t)); partialSM<HALFQK>(PX0, PX1, m_reg, mnX, alX);                                        \
        __syncthreads();                                                                                                      \
        if ((t) + 1 < NT) { VMW(); if constexpr (F32) { SWRITE_VF(SB); SBAR(); if ((t) + 2 < NT) SLOAD_F((const float*)Kh, KBASE((t) + 2)); } \
                            else { SWRITE_H(SB); } }                                                                          \
        RESC(alX); __syncthreads(); } while (0)
    for (int t = 1; t + 1 < NT; t += 2) {
        HALF_STEP(pB0, pB1, mnB, alB, pA0, pA1, alA, t, 1, 0, 0);
        HALF_STEP(pA0, pA1, mnA, alA, pB0, pB1, alB, t + 1, 0, 1, 1);
    }
    const bool even = (NT & 1) == 0;
    if (even) { SBAR(); qkt<1, SK, HALFQK>(pB0, pB1, K_lds, r32, hi, S.qr, ACT(NT - 1), cur.koff); MLOAD(NT - 1); SBAR(); }
#define QROW(e) (nxt.Q + (size_t)(wid * QBLK + r32) * QS + ((e) >> 1) * 16 + hi * 8 + ((e) & 1) * 4)
    if constexpr (F32) { SLOAD_F((const float*)nxt.K, kbn); SBAR();
#pragma unroll
        for (int e = 0; e < 8; ++e) S.tq[e] = *(const f32x4*)QROW(e); }
    else { SLOAD_H(nxt.K, nxt.V, kbn); SBAR();
#pragma unroll
        for (int d0 = 0; d0 < (HALFQK ? 4 : 8); ++d0) S.qr[d0] = load8<TIn>(nxt.Q + (size_t)(wid * QBLK + r32) * QS + d0 * 16 + hi * 8); }
    SBAR();
    finishSM(pA0, pA1, alA, l_reg, pa0, pa1, pa2, pa3); SBAR();
    if constexpr (F32) {
#pragma unroll
        for (int e = 8; e < 16; ++e) S.tq[e] = *(const f32x4*)QROW(e); SBAR(); }
#undef QROW
    pv_tile<0, SK>(o, vb0, pa0, pa1, pa2, pa3, ACT(even ? NT - 2 : NT - 1));
    if (even) { MASKT(pB0, pB1, NT - 1); partialSM<HALFQK>(pB0, pB1, m_reg, mnB, alB); __syncthreads(); RESC(alB);
        finishSM(pB0, pB1, alB, l_reg, pa0, pa1, pa2, pa3); SBAR(); pv_tile<1, SK>(o, vb0, pa0, pa1, pa2, pa3, ACT(NT - 1)); }
    SBAR(); SEAM_K0();
    if (hi == 0) li_l[r32] = l_reg; asm volatile("s_waitcnt lgkmcnt(0)" ::: "memory");
    float rli[16];
#pragma unroll
    for (int r = 0; r < 16; ++r) rli[r] = __builtin_amdgcn_rcpf(li_l[crow(r, hi)]);
    TOut* Ow = cur.O + (size_t)(wid * QBLK) * OS;
#pragma unroll
    for (int r = 0; r < 16; ++r) { const int orow = crow(r, hi);
#pragma unroll
        for (int d0 = 0; d0 < 4; ++d0) { const float v = o[d0][r] * rli[r];
            if constexpr (same_t<TOut, float>::v) { Ow[(size_t)orow * OS + d0 * 32 + r32] = v; }
            else { const float vn = __shfl_xor(v, 1);
                   if ((r32 & 1) == 0) *(unsigned*)(Ow + (size_t)orow * OS + d0 * 32 + r32) = cvtpk(v, vn); } } }
    if constexpr (F32) {
#pragma unroll
        for (int d0 = 0; d0 < 8; ++d0) S.qr[d0] = pack8(S.tq[2 * d0], S.tq[2 * d0 + 1]); }
    __syncthreads();
#undef RESC
#undef KBASE
#undef ACT
#undef MASKT
#undef MLOAD
#undef SEAM_K0
#undef HALF_STEP
}
#undef ROW
#undef VMW
#undef VMWN
#undef SLOAD_H
#undef SWRITE_HK
#undef SWRITE_HV
#undef SWRITE_H
#undef SLOAD_F
#undef SWRITE_KF
#undef SWRITE_VF
}
#ifndef PROBE
#define PROBE 0
#endif
constexpr int NWAVES = 8;
constexpr int NB = 2, T = 8192, M = NB * T, DM = 1024, FF = 2816, NIN = 8520, NLAYER = 2;
constexpr float NORM_EPS = 1e-6f;
constexpr size_t MiB = 1u << 20;
constexpr size_t WS_CTL = 0, CTL_ZERO_BYTES = 1 * MiB;
constexpr size_t WS_WF = 1 * MiB;
constexpr size_t WS_WF_DOWN = WS_WF + 11 * MiB;
constexpr size_t WS_WM = 18 * MiB;
constexpr size_t WS_WM_BR = WS_WM + 17 * MiB, WS_WM_OUT = WS_WM + 20 * MiB;
constexpr size_t WS_XN = 40 * MiB;
constexpr size_t WS_Q3 = 72 * MiB;
constexpr size_t WS_ZR = 120 * MiB;
constexpr size_t WS_R2 = 248 * MiB;
constexpr size_t WS_END = 280 * MiB;
constexpr size_t WS_MG = WS_ZR + 96 * MiB;
constexpr size_t WS_YRAW = WS_WF;
constexpr size_t WS_A8 = WS_WM;
constexpr size_t WS_KID = WS_WM + 8 * MiB;
constexpr size_t WS_RDOTK = WS_WF + 16 * MiB;
constexpr int QP = 1536, ZP = 4096;
constexpr int ZC_DK = 0, ZC_DV = 512, ZC_QI = 1024, ZC_KI = 1536, ZC_WI = 1600, ZC_RK = 1792, ZC_RV = 2304, ZC_WC = 2816, ZC_AC = 2880, ZC_GC = 2944, ZC_FK = 3072, ZC_FV = 3584;
constexpr int CW_TMO = 0;
constexpr int CW_BAR = 4096;
constexpr int CW_Q = 8192;
constexpr int CW_PROBE = 2048;
constexpr int CW_DONE = 12288;
constexpr int LDS_MISC = 160 * 1024 - 256;
constexpr int LDS_BYTES = 160 * 1024;

#define GAS __attribute__((address_space(1)))
#define LAS __attribute__((address_space(3)))
typedef unsigned short bf16;
typedef unsigned v4u __attribute__((ext_vector_type(4)));
typedef unsigned v2u __attribute__((ext_vector_type(2)));
typedef float f32x4 __attribute__((ext_vector_type(4)));
typedef float f32x2 __attribute__((ext_vector_type(2)));
typedef float f32x16 __attribute__((ext_vector_type(16)));
typedef short bf16x8 __attribute__((ext_vector_type(8)));
typedef GAS unsigned gu32;
#define RLX_AGENT __ATOMIC_RELAXED, __HIP_MEMORY_SCOPE_AGENT
#define LDS_WAIT() asm volatile("s_waitcnt lgkmcnt(0)" ::: "memory")
#define VM_WAIT() asm volatile("s_waitcnt vmcnt(0)" ::: "memory")
__device__ __forceinline__ unsigned f2bf(float f) { unsigned u = __builtin_bit_cast(unsigned, f); return (u + 0x7fffu + ((u >> 16) & 1u)) >> 16; }
__device__ __forceinline__ unsigned pk2(float lo, float hi) { return f2bf(lo) | (f2bf(hi) << 16); }
__device__ __forceinline__ float bflo(unsigned w) { return __uint_as_float(w << 16); }
__device__ __forceinline__ float bfhi(unsigned w) { return __uint_as_float(w & 0xffff0000u); }
__device__ __forceinline__ float bf1(bf16 h) { return __uint_as_float((unsigned)h << 16); }
__device__ __forceinline__ float wave_sum(float v) {
#pragma unroll
    for (int o = 1; o < 64; o <<= 1) v += __shfl_xor(v, o);
    return v;
}
__device__ __forceinline__ float sigm(float x) { return __builtin_amdgcn_rcpf(1.0f + __expf(-x)); }

#define XB_TMO      128
#define XB_XCNT(j)  (256  + 64 * (j))
#define XB_XSUB(j)  (1280 + 64 * (j))
#define XB_XGEN(j)  (2304 + 64 * (j))
#define XB_TOP      3328
#define XB_TOPGEN   3392
#define XCD_BAR_WORDS 3456
#define XB_SPIN_CAP (1u << 22)
__device__ __forceinline__ unsigned xb_ld(unsigned* p)              { return __hip_atomic_load(p, __ATOMIC_RELAXED, __HIP_MEMORY_SCOPE_AGENT); }
__device__ __forceinline__ unsigned xb_add(unsigned* p, unsigned v) { return __hip_atomic_fetch_add(p, v, __ATOMIC_RELAXED, __HIP_MEMORY_SCOPE_AGENT); }
__device__ __forceinline__ unsigned xb_xcc_id() { return (unsigned)__builtin_amdgcn_s_getreg((3 << 11) | 20) & 0xFu; }
#define XB_SPIN(cond, bar) do { unsigned _sp = 0; while (cond) { __builtin_amdgcn_s_sleep(1); \
    if ((++_sp & 255u) == 0u) { if (xb_ld(&(bar)[XB_TMO])) break; if (_sp > XB_SPIN_CAP) { atomicAdd(&(bar)[XB_TMO], 1u); break; } } } } while (0)
struct XcdBarrier { unsigned* bar; unsigned x; volatile LAS unsigned* st; };
__device__ __forceinline__ XcdBarrier xcd_barrier_post(unsigned* bar, volatile LAS unsigned* st) {
    XcdBarrier b; b.bar = bar; b.x = xb_xcc_id(); b.st = st;
    if (threadIdx.x == 0) (void)xb_add(&bar[XB_XCNT(b.x)], 1u);
    return b;
}
__device__ __forceinline__ void xcd_barrier_complete(unsigned* bar, unsigned x, unsigned& nloc, unsigned& nx) {
    const unsigned G = gridDim.x * gridDim.y * gridDim.z;
    unsigned sum, cnt, mine, sp = 0u;
    for (;;) {
        sum = 0u; cnt = 0u; mine = 0u;
#pragma unroll
        for (unsigned j = 0; j < 16; ++j) { const unsigned c = xb_ld(&bar[XB_XCNT(j)]); sum += c; cnt += (c > 0u) ? 1u : 0u; mine = (j == x) ? c : mine; }
        if (sum == G) break;
        __builtin_amdgcn_s_sleep(1);
        if ((++sp & 255u) == 0u) { if (xb_ld(&bar[XB_TMO])) break; if (sp > XB_SPIN_CAP) { atomicAdd(&bar[XB_TMO], 1u); break; } }
    }
    nloc = mine > 0u ? mine : 1u; nx = cnt > 0u ? cnt : 1u;
}
__device__ __forceinline__ void xcd_barrier(const XcdBarrier& b) {
    asm volatile("s_waitcnt vmcnt(0)" ::: "memory");
    __syncthreads();
    if (threadIdx.x == 0) {
        unsigned* bar = b.bar;
        __builtin_amdgcn_s_waitcnt(0);
        unsigned nloc = b.st[0], nx = b.st[1];
        if (nloc == 0u) { xcd_barrier_complete(bar, b.x, nloc, nx); b.st[0] = nloc; b.st[1] = nx; }
        const unsigned old = xb_add(&bar[XB_XSUB(b.x)], 1u);
        const unsigned gen = old / nloc;
        if (old + 1u == (gen + 1u) * nloc) {
            __builtin_amdgcn_fence(__ATOMIC_RELEASE, "agent");
            asm volatile("s_waitcnt vmcnt(0)" ::: "memory");
            const unsigned og = xb_add(&bar[XB_TOP], 1u);
            const unsigned tg = og / nx;
            if (og + 1u == (tg + 1u) * nx) xb_add(&bar[XB_TOPGEN], 1u);
            else XB_SPIN(xb_ld(&bar[XB_TOPGEN]) == tg, bar);
            __builtin_amdgcn_fence(__ATOMIC_ACQUIRE, "agent");
            xb_add(&bar[XB_XGEN(b.x)], 1u);
            asm volatile("s_waitcnt vmcnt(0)" ::: "memory");
        } else {
            XB_SPIN(xb_ld(&bar[XB_XGEN(b.x)]) == gen, bar);
            __builtin_amdgcn_fence(__ATOMIC_ACQUIRE, "agent");
            asm volatile("s_waitcnt vmcnt(0)" ::: "memory");
        }
    }
    __syncthreads();
}

struct MapIdent { const float* W; int ld; __device__ __forceinline__ const float* col(int n) const { return W + n; } };
struct MapUp {
    const float* G; const float* U; int ld;
    __device__ __forceinline__ const float* col(int n) const { const int g = n >> 5, j = n & 31; return j < 16 ? G + 16 * g + j : U + 16 * g + (j - 16); }
};
struct MapWin {
    const float* W; int ld;
    __device__ __forceinline__ const float* col(int n) const {
        int src;
        if (n < 512) src = n; else if (n < 1024) src = 2120 + (n - 512); else if (n < 1536) src = 3912 + (n - 1024);
        else if (n < 5632) { const int z = n - 1536; if (z < 1608) src = 512 + z; else if (z < 1792) src = -1; else if (z < 3072) src = 840 + z; else src = 1352 + z; }
        else src = 5448 + (n - 5632);
        return src < 0 ? nullptr : W + src;
    }
};
template <class Map>
__device__ __forceinline__ void conv_item(const Map& mp, int K, bf16* WT, LAS float* scr, int item, int nblk, int lane) {
    const int kb = item / nblk, nb = item % nblk, k0 = 32 * kb, n0 = 32 * nb;
    const float* cp = mp.col(n0 + (lane & 31)); const size_t ld = (size_t)mp.ld;
#pragma unroll
    for (int i = 0; i < 16; ++i) { const int kk = 2 * i + (lane >> 5); scr[kk * 33 + (lane & 31)] = cp ? cp[(size_t)(k0 + kk) * ld] : 0.f; }
    LDS_WAIT(); asm volatile("" ::: "memory");
    const int c = lane & 3;
#pragma unroll
    for (int j = 0; j < 2; ++j) { const int n = (lane >> 2) + 16 * j; const LAS float* s = scr + (8 * c) * 33 + n;
        v4u o; o.x = pg8::cvt_pk_bf16(s[0 * 33], s[1 * 33]); o.y = pg8::cvt_pk_bf16(s[2 * 33], s[3 * 33]); o.z = pg8::cvt_pk_bf16(s[4 * 33], s[5 * 33]); o.w = pg8::cvt_pk_bf16(s[6 * 33], s[7 * 33]);
        *(GAS v4u*)(WT + (size_t)(n0 + n) * K + k0 + 8 * c) = o; }
    LDS_WAIT(); asm volatile("" ::: "memory");
}
__host__ __device__ constexpr int conv_items(int K, int N) { return (K / 32) * (N / 32); }

template <bool INB, bool OUTB>
__device__ __forceinline__ void rownorm_rows(const void* base, const bf16* Y, float s, const float* gpost, void* out, const float* gnext, bf16* XN, int gw, int NGW, int lane, float oscale = 1.f) {
    constexpr int R = INB ? 8 : 4;
    for (int m0 = gw; m0 < M; m0 += R * NGW) {
        v2u xb[R][4], yw[R][4]; f32x4 xf[R][4];
#pragma unroll
        for (int q = 0; q < R; ++q) { const size_t m = (size_t)(m0 + q * NGW);
#pragma unroll
            for (int j = 0; j < 4; ++j) {
                if constexpr (INB) xb[q][j] = ((const GAS v2u*)((const bf16*)base + m * DM))[lane + 64 * j];
                else xf[q][j] = ((const GAS f32x4*)((const float*)base + m * DM))[lane + 64 * j];
                if (Y) yw[q][j] = ((const GAS v2u*)(Y + m * DM))[lane + 64 * j]; } }
#pragma unroll
        for (int q = 0; q < R; ++q) { const size_t m = (size_t)(m0 + q * NGW);
            f32x4 v[4];
#pragma unroll
            for (int j = 0; j < 4; ++j) { if constexpr (INB) v[j] = (f32x4){bflo(xb[q][j].x), bfhi(xb[q][j].x), bflo(xb[q][j].y), bfhi(xb[q][j].y)}; else v[j] = xf[q][j]; }
            if (Y) {
                f32x4 y[4]; float ss = 0.f;
#pragma unroll
                for (int j = 0; j < 4; ++j) { const v2u w = yw[q][j]; y[j] = (f32x4){bflo(w.x), bfhi(w.x), bflo(w.y), bfhi(w.y)};
                    ss += (y[j].x * y[j].x + y[j].y * y[j].y) + (y[j].z * y[j].z + y[j].w * y[j].w); }
                const float r = s * __builtin_amdgcn_rsqf(wave_sum(ss) * (1.f / DM) + NORM_EPS);
#pragma unroll
                for (int j = 0; j < 4; ++j) { const f32x4 g = ((const GAS f32x4*)gpost)[lane + 64 * j]; v[j] = v[j] + y[j] * g * r;
                    if constexpr (OUTB) { v2u w; w.x = pk2(v[j].x, v[j].y); w.y = pk2(v[j].z, v[j].w); ((GAS v2u*)((bf16*)out + m * DM))[lane + 64 * j] = w; }
                    else ((GAS f32x4*)((float*)out + m * DM))[lane + 64 * j] = v[j] * oscale; }
            }
            if (XN) {
                float ss = 0.f;
#pragma unroll
                for (int j = 0; j < 4; ++j) ss += (v[j].x * v[j].x + v[j].y * v[j].y) + (v[j].z * v[j].z + v[j].w * v[j].w);
                const float r = __builtin_amdgcn_rsqf(wave_sum(ss) * (1.f / DM) + NORM_EPS);
#pragma unroll
                for (int j = 0; j < 4; ++j) { const f32x4 g = ((const GAS f32x4*)gnext)[lane + 64 * j]; const f32x4 o = v[j] * g * r;
                    v2u w; w.x = pk2(o.x, o.y); w.y = pk2(o.z, o.w); ((GAS v2u*)(XN + m * DM))[lane + 64 * j] = w; }
            }
        }
    }
}

namespace scan {
template <int CTRL> __device__ __forceinline__ float dpp_add(float x) {
    const int y = __builtin_amdgcn_update_dpp(0, __builtin_bit_cast(int, x), CTRL, 0xF, 0xF, false);
    return x + __builtin_bit_cast(float, y);
}
__device__ __forceinline__ float red8(float x) { x = dpp_add<0xB1>(x); x = dpp_add<0x4E>(x); x = dpp_add<0x141>(x); return x; }
__device__ __forceinline__ float red16(float x) { x = dpp_add<0xB1>(x); x = dpp_add<0x4E>(x); x = dpp_add<0x141>(x); x = dpp_add<0x140>(x); return x; }
__device__ __forceinline__ void ld8(const bf16* p, float (&o)[8]) { const v4u w = *(const GAS v4u*)p; o[0] = bflo(w.x); o[1] = bfhi(w.x); o[2] = bflo(w.y); o[3] = bfhi(w.y); o[4] = bflo(w.z); o[5] = bfhi(w.z); o[6] = bflo(w.w); o[7] = bfhi(w.w); }
}
struct PrepP { const bf16* ZR; bf16* X1; unsigned char* A8; bf16* KI; const float *mu, *w0, *wup, *a0, *aup; };
__device__ __forceinline__ void rwkv_prep(const PrepP& P, LAS unsigned char* lds) {
    const int tid = otid_(), lane = tid & 63, h = __builtin_amdgcn_readfirstlane(tid >> 6), c16 = lane & 15, quad = lane >> 4;
    constexpr int SP = 144;
    LAS unsigned char* TA = lds; LAS unsigned char* AA = lds + 64 * SP;
    bf16x8 bw[4][2], ba[4][2];
#pragma unroll
    for (int ct = 0; ct < 4; ++ct)
#pragma unroll
        for (int s = 0; s < 2; ++s) { const size_t o = (size_t)(32 * s + 8 * quad) * 512 + 64 * h + 16 * ct + c16; const float* gw_ = P.wup + o; const float* ga_ = P.aup + o;
            v4u w; w.x = pk2(gw_[0], gw_[512]); w.y = pk2(gw_[1024], gw_[1536]); w.z = pk2(gw_[2048], gw_[2560]); w.w = pk2(gw_[3072], gw_[3584]); bw[ct][s] = __builtin_bit_cast(bf16x8, w);
            v4u a; a.x = pk2(ga_[0], ga_[512]); a.y = pk2(ga_[1024], ga_[1536]); a.z = pk2(ga_[2048], ga_[2560]); a.w = pk2(ga_[3072], ga_[3584]); ba[ct][s] = __builtin_bit_cast(bf16x8, a); }
    float w0v[4], a0v[4];
#pragma unroll
    for (int ct = 0; ct < 4; ++ct) { w0v[ct] = P.w0[64 * h + 16 * ct + c16]; a0v[ct] = P.a0[64 * h + 16 * ct + c16]; }
    const int stok = tid >> 3, sseg = tid & 7;
#pragma unroll 1
    for (int m0 = blockIdx.x * 64; m0 < M; m0 += gridDim.x * 64) {
        {   const size_t m = (size_t)m0 + stok; const int t = (int)(m & (T - 1));
            *(GAS v4u*)(P.KI + m * 64 + 8 * sseg) = *(const GAS v4u*)(P.ZR + m * ZP + ZC_KI + 8 * sseg);
            float wc[8], ac[8], p8[8];
            scan::ld8(P.ZR + m * ZP + ZC_WC + 8 * sseg, wc); scan::ld8(P.ZR + m * ZP + ZC_AC + 8 * sseg, ac);
            if (t > 0) { scan::ld8(P.ZR + (m - 1) * ZP + ZC_WC + 8 * sseg, p8);
#pragma unroll
                for (int e = 0; e < 8; ++e) wc[e] += (p8[e] - wc[e]) * P.mu[1536 + 8 * sseg + e];
                scan::ld8(P.ZR + (m - 1) * ZP + ZC_AC + 8 * sseg, p8);
#pragma unroll
                for (int e = 0; e < 8; ++e) ac[e] += (p8[e] - ac[e]) * P.mu[1600 + 8 * sseg + e]; }
            else {
#pragma unroll
                for (int e = 0; e < 8; ++e) { wc[e] -= wc[e] * P.mu[1536 + 8 * sseg + e]; ac[e] -= ac[e] * P.mu[1600 + 8 * sseg + e]; } }
            float th[8];
#pragma unroll
            for (int e = 0; e < 8; ++e) th[e] = 1.f - 2.f * __builtin_amdgcn_rcpf(__expf(2.f * wc[e]) + 1.f);
            v4u o; o.x = pk2(th[0], th[1]); o.y = pk2(th[2], th[3]); o.z = pk2(th[4], th[5]); o.w = pk2(th[6], th[7]); *(LAS v4u*)(TA + stok * SP + 16 * sseg) = o;
            v4u q; q.x = pk2(ac[0], ac[1]); q.y = pk2(ac[2], ac[3]); q.z = pk2(ac[4], ac[5]); q.w = pk2(ac[6], ac[7]); *(LAS v4u*)(AA + stok * SP + 16 * sseg) = q;
        }
        __syncthreads();
#pragma unroll 1
        for (int rt = 0; rt < 4; ++rt) {
            f32x4 accw[4], acca[4];
#pragma unroll
            for (int ct = 0; ct < 4; ++ct) { accw[ct] = (f32x4){0.f, 0.f, 0.f, 0.f}; acca[ct] = (f32x4){0.f, 0.f, 0.f, 0.f}; }
#pragma unroll
            for (int s = 0; s < 2; ++s) { const bf16x8 fw = *(const LAS bf16x8*)(TA + (16 * rt + c16) * SP + (32 * s + 8 * quad) * 2), fa = *(const LAS bf16x8*)(AA + (16 * rt + c16) * SP + (32 * s + 8 * quad) * 2);
#pragma unroll
                for (int ct = 0; ct < 4; ++ct) { accw[ct] = __builtin_amdgcn_mfma_f32_16x16x32_bf16(fw, bw[ct][s], accw[ct], 0, 0, 0); acca[ct] = __builtin_amdgcn_mfma_f32_16x16x32_bf16(fa, ba[ct][s], acca[ct], 0, 0, 0); } }
#pragma unroll
            for (int j = 0; j < 4; ++j) { const size_t m = (size_t)m0 + 16 * rt + 4 * quad + j;
#pragma unroll
                for (int ct = 0; ct < 4; ++ct) { const int ch = 64 * h + 16 * ct + c16;
                    const float sg = sigm(w0v[ct] + accw[ct][j]);
                    const float x1 = 1.f - __expf(-0.6065306597126334f * sg);
                    const float a = sigm(a0v[ct] + acca[ct][j]);
                    P.X1[m * 512 + ch] = (bf16)f2bf(x1);
                    P.A8[m * 512 + ch] = (unsigned char)(int)(a * 255.f + 0.5f); } }
        }
        __syncthreads();
    }
}

struct ScanP { const bf16* Q3; const bf16* ZR; const bf16* X1; const unsigned char* A8; bf16* yraw; float* rdotk; const float *mu, *k_k, *k_a, *r_k; };
namespace scan {
constexpr int TB = 32, NBLK = T / TB;
constexpr int CB_W = 0, CB_B = 8192, CB_K = 16384, CB_KW = 24576, CB_V = 40960, CB_BR = 43008, CB_KR = 43136, CB_SA = 43264, CB_YP = 45312, CBSZ = 78080;
constexpr int L_END = 2 * CBSZ;
static_assert(L_END <= LDS_MISC, "scan LDS");
}
__device__ __forceinline__ void rwkv_scan_unit(const ScanP& P, int unit, LAS unsigned char* lds) {
    using namespace scan;
    const int tid = otid_(), wid = __builtin_amdgcn_readfirstlane(tid >> 6), lane = tid & 63;
    const int b = unit >> 5, h = (unit >> 2) & 7, vq = unit & 3;
    const size_t mrow0 = (size_t)b * T;
    if (wid >= 4) {
        const int pw = wid - 4, tokl = lane >> 3, seg = lane & 7, c0 = 8 * seg, hc0 = 64 * h + c0;
        float mu_r[8], mu_k[8], kkv[8], kav[8], rkv[8];
#pragma unroll
        for (int e = 0; e < 8; ++e) { mu_r[e] = P.mu[hc0 + e]; mu_k[e] = P.mu[512 + hc0 + e]; kkv[e] = P.k_k[hc0 + e]; kav[e] = P.k_a[hc0 + e]; rkv[e] = P.r_k[hc0 + e]; }
        const int vc0 = 64 * h + 16 * vq + 2 * seg;
        const float mu_v0 = P.mu[1024 + vc0], mu_v1 = P.mu[1024 + vc0 + 1];
        const int ptid = pw * 64 + lane;
        v4u nr, nrp, nk, nkp, nx; v2u na; unsigned nv, nvp;
#define SCAN_LOAD(nb_) do { const int t_ = (nb_) * TB + 8 * pw + tokl; const size_t m_ = mrow0 + t_, mp_ = t_ > 0 ? m_ - 1 : m_; \
            nr = *(const GAS v4u*)(P.Q3 + m_ * QP + 512 + hc0); nrp = *(const GAS v4u*)(P.Q3 + mp_ * QP + 512 + hc0); \
            nk = *(const GAS v4u*)(P.ZR + m_ * ZP + ZC_RK + hc0); nkp = *(const GAS v4u*)(P.ZR + mp_ * ZP + ZC_RK + hc0); \
            nx = *(const GAS v4u*)(P.X1 + m_ * 512 + hc0); na = *(const GAS v2u*)(P.A8 + m_ * 512 + hc0); \
            nv = *(const GAS unsigned*)(P.ZR + m_ * ZP + ZC_RV + vc0); nvp = *(const GAS unsigned*)(P.ZR + mp_ * ZP + ZC_RV + vc0); } while (0)
#define UNPK8(w_, o_) do { o_[0] = bflo(w_.x); o_[1] = bfhi(w_.x); o_[2] = bflo(w_.y); o_[3] = bfhi(w_.y); o_[4] = bflo(w_.z); o_[5] = bfhi(w_.z); o_[6] = bflo(w_.w); o_[7] = bfhi(w_.w); } while (0)
        SCAN_LOAD(0);
        for (int blk = -1; blk < NBLK; ++blk) {
            const int nb = blk + 1;
            LAS unsigned char* cb = lds + (nb & 1) * CBSZ;
            if (blk >= 1) {
                const int tok = ptid >> 3, v2 = (ptid & 7) * 2;
                const LAS float* YPp = (const LAS float*)(cb + CB_YP) + (tok * 16 + v2) * 16;
                float y0 = 0.f, y1 = 0.f;
#pragma unroll
                for (int q4 = 0; q4 < 4; ++q4) { const f32x4 a = *(const LAS f32x4*)(YPp + 4 * q4), c = *(const LAS f32x4*)(YPp + 16 + 4 * q4); y0 += (a.x + a.y) + (a.z + a.w); y1 += (c.x + c.y) + (c.z + c.w); }
                const float kr = *(const LAS float*)(cb + CB_KR + tok * 4);
                const f32x2 vv = *(const LAS f32x2*)(cb + CB_V + (tok * 16 + v2) * 4);
                y0 += vv.x * kr; y1 += vv.y * kr;
                const size_t m = mrow0 + (size_t)(blk - 1) * TB + tok;
                *(GAS unsigned*)(P.yraw + m * 512 + 64 * h + 16 * vq + v2) = pk2(y0, y1);
                LDS_WAIT(); asm volatile("" ::: "memory");
            }
            if (nb < NBLK) {
                const int t = nb * TB + 8 * pw + tokl; const size_t m = mrow0 + t;
                float r8[8], k8[8], p8[8], x8[8], a8[8];
                const v4u cr = nr, crp = nrp, ck = nk, ckp = nkp, cx = nx; const v2u ca = na; const unsigned cv = nv, cvp = nvp;
                if (nb + 1 < NBLK) SCAN_LOAD(nb + 1);
                UNPK8(cr, r8); UNPK8(ck, k8); UNPK8(cx, x8);
                { const float sc = 1.f / 255.f;
                  a8[0] = (float)(ca.x & 255u) * sc; a8[1] = (float)((ca.x >> 8) & 255u) * sc; a8[2] = (float)((ca.x >> 16) & 255u) * sc; a8[3] = (float)(ca.x >> 24) * sc;
                  a8[4] = (float)(ca.y & 255u) * sc; a8[5] = (float)((ca.y >> 8) & 255u) * sc; a8[6] = (float)((ca.y >> 16) & 255u) * sc; a8[7] = (float)(ca.y >> 24) * sc; }
                float v0 = bflo(cv), v1 = bfhi(cv);
                if (t > 0) {
                    UNPK8(crp, p8);
#pragma unroll
                    for (int e = 0; e < 8; ++e) r8[e] += (p8[e] - r8[e]) * mu_r[e];
                    UNPK8(ckp, p8);
#pragma unroll
                    for (int e = 0; e < 8; ++e) k8[e] += (p8[e] - k8[e]) * mu_k[e];
                    v0 += (bflo(cvp) - v0) * mu_v0; v1 += (bfhi(cvp) - v1) * mu_v1;
                } else {
#pragma unroll
                    for (int e = 0; e < 8; ++e) { r8[e] -= r8[e] * mu_r[e]; k8[e] -= k8[e] * mu_k[e]; }
                    v0 -= v0 * mu_v0; v1 -= v1 * mu_v1;
                }
                float kk8[8]; { float ss = 0.f;
#pragma unroll
                  for (int e = 0; e < 8; ++e) { kk8[e] = k8[e] * kkv[e]; ss += kk8[e] * kk8[e]; }
                  ss = red8(ss); const float inv = 1.f / fmaxf(sqrtf(ss), 1e-12f);
#pragma unroll
                  for (int e = 0; e < 8; ++e) kk8[e] *= inv; }
                float w8[8], bb[8], km[8], wr[8]; float brp = 0.f, krp = 0.f, rkp = 0.f;
#pragma unroll
                for (int e = 0; e < 8; ++e) {
                    w8[e] = 1.f - x8[e];
                    bb[e] = kk8[e] * a8[e]; km[e] = k8[e] * (1.f + (a8[e] - 1.f) * kav[e]);
                    brp += bb[e] * r8[e]; krp += km[e] * r8[e]; rkp += r8[e] * km[e] * rkv[e];
                }
                brp = red8(brp); krp = red8(krp); rkp = red8(rkp);
#pragma unroll
                for (int e = 0; e < 8; ++e) wr[e] = w8[e] * r8[e] - kk8[e] * brp;
                const int ti = 8 * pw + tokl;
                *(LAS f32x4*)(cb + CB_W + (ti * 64 + c0) * 4) = (f32x4){w8[0], w8[1], w8[2], w8[3]}; *(LAS f32x4*)(cb + CB_W + (ti * 64 + c0 + 4) * 4) = (f32x4){w8[4], w8[5], w8[6], w8[7]};
                *(LAS f32x4*)(cb + CB_B + (ti * 64 + c0) * 4) = (f32x4){bb[0], bb[1], bb[2], bb[3]}; *(LAS f32x4*)(cb + CB_B + (ti * 64 + c0 + 4) * 4) = (f32x4){bb[4], bb[5], bb[6], bb[7]};
                *(LAS f32x4*)(cb + CB_K + (ti * 64 + c0) * 4) = (f32x4){km[0], km[1], km[2], km[3]}; *(LAS f32x4*)(cb + CB_K + (ti * 64 + c0 + 4) * 4) = (f32x4){km[4], km[5], km[6], km[7]};
#pragma unroll
                for (int e = 0; e < 8; e += 2) *(LAS f32x4*)(cb + CB_KW + ti * 512 + ((e >> 1) & 1) * 256 + (2 * seg + (e >> 2)) * 16) = (f32x4){kk8[e], wr[e], kk8[e + 1], wr[e + 1]};
                *(LAS f32x2*)(cb + CB_V + (ti * 16 + 2 * seg) * 4) = (f32x2){v0, v1};
                if (seg == 0) { *(LAS float*)(cb + CB_KR + ti * 4) = krp; if (vq == 0) P.rdotk[m * 8 + h] = rkp; }
            }
            __syncthreads();
        }
        { const LAS unsigned char* cb = lds + ((NBLK - 1) & 1) * CBSZ;
          const int tok = ptid >> 3, v2 = (ptid & 7) * 2;
          const LAS float* YPp = (const LAS float*)(cb + CB_YP) + (tok * 16 + v2) * 16;
          float y0 = 0.f, y1 = 0.f;
#pragma unroll
          for (int q4 = 0; q4 < 4; ++q4) { const f32x4 a = *(const LAS f32x4*)(YPp + 4 * q4), c = *(const LAS f32x4*)(YPp + 16 + 4 * q4); y0 += (a.x + a.y) + (a.z + a.w); y1 += (c.x + c.y) + (c.z + c.w); }
          const float kr = *(const LAS float*)(cb + CB_KR + tok * 4);
          const f32x2 vv = *(const LAS f32x2*)(cb + CB_V + (tok * 16 + v2) * 4);
          y0 += vv.x * kr; y1 += vv.y * kr;
          const size_t m = mrow0 + (size_t)(NBLK - 1) * TB + tok;
          *(GAS unsigned*)(P.yraw + m * 512 + 64 * h + 16 * vq + v2) = pk2(y0, y1); }
    } else {
        const int vi = 4 * wid + (lane >> 4), cg = lane & 15;
        f32x2 s01 = {0.f, 0.f}, s23 = {0.f, 0.f};
        __syncthreads();
        __builtin_amdgcn_s_setprio(3);
        const unsigned lo4 = (unsigned)(4 * cg) * 4u;
        for (int blk = 0; blk < NBLK; ++blk) {
            const LAS unsigned char* cb = lds + (blk & 1) * CBSZ;
            f32x4 kwa = *(const LAS f32x4*)(cb + CB_KW + lo4), kwb = *(const LAS f32x4*)(cb + CB_KW + 256 + lo4);
            f32x4 w4 = *(const LAS f32x4*)(cb + CB_W + lo4), b4 = *(const LAS f32x4*)(cb + CB_B + lo4), k4 = *(const LAS f32x4*)(cb + CB_K + lo4);
            float vv = *(const LAS float*)(cb + CB_V + vi * 4);
#pragma unroll 4
            for (int tok = 0; tok < TB; ++tok) {
                const int tn = tok + 1 < TB ? tok + 1 : tok;
                const f32x4 nkwa = *(const LAS f32x4*)(cb + CB_KW + tn * 512 + lo4), nkwb = *(const LAS f32x4*)(cb + CB_KW + tn * 512 + 256 + lo4);
                const f32x4 nw4 = *(const LAS f32x4*)(cb + CB_W + tn * 256 + lo4), nb4 = *(const LAS f32x4*)(cb + CB_B + tn * 256 + lo4), nk4 = *(const LAS f32x4*)(cb + CB_K + tn * 256 + lo4);
                const float nvv = *(const LAS float*)(cb + CB_V + (tn * 16 + vi) * 4);
                f32x2 p = (f32x2){s01.x, s01.x} * (f32x2){kwa.x, kwa.y};
                p += (f32x2){s01.y, s01.y} * (f32x2){kwa.z, kwa.w};
                p += (f32x2){s23.x, s23.x} * (f32x2){kwb.x, kwb.y};
                p += (f32x2){s23.y, s23.y} * (f32x2){kwb.z, kwb.w};
                *(LAS float*)(cb + CB_YP + ((tok * 16 + vi) * 16 + cg) * 4) = p.y;
                const f32x2 t01 = s01 * (f32x2){w4.x, w4.y} + (f32x2){k4.x, k4.y} * vv, t23 = s23 * (f32x2){w4.z, w4.w} + (f32x2){k4.z, k4.w} * vv;
                const float d1 = red16(p.x);
                s01 = t01 - (f32x2){b4.x, b4.y} * d1; s23 = t23 - (f32x2){b4.z, b4.w} * d1;
                kwa = nkwa; kwb = nkwb; w4 = nw4; b4 = nb4; k4 = nk4; vv = nvv;
            }
            __syncthreads();
        }
        __builtin_amdgcn_s_setprio(0);
    }
    __syncthreads();
}

struct Dsa1P { const bf16* ZR; const bf16* KI; unsigned* bitm; gu32* done; };
namespace dsa1 {
constexpr int CAP = 769  , PRUNE_AT = 512, KEEP = 256;
constexpr int L_BUF = 0, L_CNT = 32 * CAP * 4, L_THR = L_CNT + 128, L_THRK = L_THR + 128, L_HIST = ((L_THRK + 128 + 15) / 16) * 16, L_MROW = L_HIST + 8 * 1024, L_QF = L_MROW + 8 * 1024, QFP = 1040, L_END = L_QF + 32 * QFP;
static_assert(L_END <= LDS_MISC, "dsa1 LDS");
__device__ __forceinline__ unsigned packkey(float s, int keyidx) { const unsigned bits = __float_as_uint(s); const unsigned u = bits ^ ((unsigned)((int)bits >> 31) | 0x80000000u); return (u & 0xFFFFE000u) | (unsigned)(8191 - keyidx); }
__device__ __forceinline__ float thr_of(unsigned key) { const unsigned u = key & 0xFFFFE000u; const unsigned bits = (u & 0x80000000u) ? (u ^ 0x80000000u) : ~u; return __uint_as_float(bits); }
__device__ __forceinline__ int wave_prefix_incl(int v) {
    v += __builtin_amdgcn_update_dpp(0, v, 0x111, 0xF, 0xF, true);
    v += __builtin_amdgcn_update_dpp(0, v, 0x112, 0xF, 0xF, true);
    v += __builtin_amdgcn_update_dpp(0, v, 0x114, 0xF, 0xF, true);
    v += __builtin_amdgcn_update_dpp(0, v, 0x118, 0xF, 0xF, true);
    v += __builtin_amdgcn_update_dpp(0, v, 0x142, 0xA, 0xF, false);
    v += __builtin_amdgcn_update_dpp(0, v, 0x143, 0xC, 0xF, false);
    return v;
}
__device__ __forceinline__ void prune(LAS unsigned char* lds, int qq, int wid, int lane, bool exact) {
    asm volatile("" : "+v"(lane));
    LAS unsigned* buf = (LAS unsigned*)(lds + L_BUF) + qq * CAP; LAS unsigned* cnt = (LAS unsigned*)(lds + L_CNT); LAS float* thr = (LAS float*)(lds + L_THR); LAS unsigned* thrk = (LAS unsigned*)(lds + L_THRK);
    LAS unsigned* hist = (LAS unsigned*)(lds + L_HIST) + wid * 256;
    const int n = (int)cnt[qq];
    unsigned e[12];
#pragma unroll
    for (int k = 0; k < 12; ++k) e[k] = (lane + 64 * k < n) ? buf[lane + 64 * k] : 0u;
    const unsigned tk = thrk[qq];
    unsigned cut = 0u; bool have = false;
    if (!exact && tk != 0u) {
        const unsigned base16 = tk >> 16;
        *(LAS v4u*)(hist + 4 * lane) = (v4u){0u, 0u, 0u, 0u};
        LDS_WAIT(); asm volatile("" ::: "memory");
#pragma unroll
        for (int k = 0; k < 12; ++k) if (lane + 64 * k < n) { unsigned bn = (e[k] >> 16) - base16; bn = bn > 255u ? 255u : bn; (void)__hip_atomic_fetch_add(hist + bn, 1u, __ATOMIC_RELAXED, __HIP_MEMORY_SCOPE_WORKGROUP); }
        LDS_WAIT(); asm volatile("" ::: "memory");
        const int rl = 63 - lane;
        const v4u hv = *(const LAS v4u*)(hist + 4 * rl);
        const int tot = (int)(hv.x + hv.y + hv.z + hv.w);
        int above = wave_prefix_incl(tot) - tot; int dsel = -1, csel = 0;
        { const int h3 = (int)hv.w, h2 = (int)hv.z, h1 = (int)hv.y, h0 = (int)hv.x;
          if (above < KEEP && KEEP <= above + h3) { dsel = 4 * rl + 3; csel = above + h3; } above += h3;
          if (above < KEEP && KEEP <= above + h2) { dsel = 4 * rl + 2; csel = above + h2; } above += h2;
          if (above < KEEP && KEEP <= above + h1) { dsel = 4 * rl + 1; csel = above + h1; } above += h1;
          if (above < KEEP && KEEP <= above + h0) { dsel = 4 * rl + 0; csel = above + h0; } }
        const unsigned long long bm = __ballot(dsel >= 0);
        const int src = bm ? (int)__builtin_ctzll(bm) : 0;
        const int d = __builtin_amdgcn_readlane(dsel, src), cd = __builtin_amdgcn_readlane(csel, src);
        LDS_WAIT(); asm volatile("" ::: "memory");
        if (bm != 0ull && cd <= KEEP + 128) { cut = (base16 + (unsigned)d) << 16; have = true; }
    }
    if (!have) {
        unsigned prefix = 0u; int want = KEEP;
#pragma unroll 1
        for (int p = 0; p < 4; ++p) {
            const int shift = 24 - 8 * p;
            *(LAS v4u*)(hist + 4 * lane) = (v4u){0u, 0u, 0u, 0u};
            LDS_WAIT(); asm volatile("" ::: "memory");
#pragma unroll
            for (int k = 0; k < 12; ++k) { const bool in = (lane + 64 * k < n) && (p == 0 || (e[k] >> (shift + 8)) == (prefix >> (shift + 8)));
                if (in) (void)__hip_atomic_fetch_add(hist + ((e[k] >> shift) & 255u), 1u, __ATOMIC_RELAXED, __HIP_MEMORY_SCOPE_WORKGROUP); }
            LDS_WAIT(); asm volatile("" ::: "memory");
            const int rl = 63 - lane;
            const v4u hv = *(const LAS v4u*)(hist + 4 * rl);
            const int tot = (int)(hv.x + hv.y + hv.z + hv.w);
            int above = wave_prefix_incl(tot) - tot;
            int dsel = -1, asel = 0;
            { const int h3 = (int)hv.w, h2 = (int)hv.z, h1 = (int)hv.y, h0 = (int)hv.x;
              if (above < want && want <= above + h3) { dsel = 4 * rl + 3; asel = above; } above += h3;
              if (above < want && want <= above + h2) { dsel = 4 * rl + 2; asel = above; } above += h2;
              if (above < want && want <= above + h1) { dsel = 4 * rl + 1; asel = above; } above += h1;
              if (above < want && want <= above + h0) { dsel = 4 * rl + 0; asel = above; } }
            const unsigned long long bm = __ballot(dsel >= 0);
            const int src = bm ? (int)__builtin_ctzll(bm) : 0;
            const int d = __builtin_amdgcn_readlane(dsel, src), ab = __builtin_amdgcn_readlane(asel, src);
            prefix |= ((unsigned)(d < 0 ? 0 : d)) << shift; want -= ab;
            LDS_WAIT(); asm volatile("" ::: "memory");
        }
        cut = prefix;
    }
    int base = 0;
#pragma unroll
    for (int k = 0; k < 12; ++k) { const bool keep = (lane + 64 * k < n) && e[k] >= cut; const unsigned long long mk = __ballot(keep);
        const int pos = base + (int)__builtin_amdgcn_mbcnt_hi((unsigned)(mk >> 32), __builtin_amdgcn_mbcnt_lo((unsigned)mk, 0u));
        if (keep) buf[pos] = e[k]; base += (int)__builtin_popcountll(mk); }
    if (lane == 0) { cnt[qq] = (unsigned)base; thr[qq] = thr_of(cut); thrk[qq] = cut; }
    LDS_WAIT(); asm volatile("" ::: "memory");
}
}
__device__ __forceinline__ void dsa1_unit(const Dsa1P& P, int u, LAS unsigned char* lds) {
    using namespace dsa1;
    const int tid = otid_(), wid = __builtin_amdgcn_readfirstlane(tid >> 6), lane = tid & 63, q = lane & 31, hi = lane >> 5;
    const int b = u & 1, qb32 = 255 - (u >> 1), t0 = 32 * qb32;
    const size_t brow = (size_t)b * T;
    LAS unsigned* buf = (LAS unsigned*)(lds + L_BUF); LAS unsigned* cnt = (LAS unsigned*)(lds + L_CNT); LAS float* thr = (LAS float*)(lds + L_THR);
    if (tid < 32) { cnt[tid] = 0u; thr[tid] = -__builtin_inff(); ((LAS unsigned*)(lds + L_THRK))[tid] = 0u; }
    const bf16* qrow = P.ZR + (brow + t0 + q) * ZP;
    { const int r = tid >> 4, sg = tid & 15; const bf16* src = P.ZR + (brow + t0 + r) * ZP + ZC_QI + 32 * sg;
#pragma unroll
      for (int j = 0; j < 4; ++j) *(LAS v4u*)(lds + L_QF + r * QFP + 64 * sg + 16 * j) = *(const GAS v4u*)(src + 8 * j); }
    float wq[8];
    { const v4u w = *(const GAS v4u*)(qrow + ZC_WI); const float c = 0.35355339059327373f * 0.125f;
      wq[0] = bflo(w.x) * c; wq[1] = bfhi(w.x) * c; wq[2] = bflo(w.y) * c; wq[3] = bfhi(w.y) * c; wq[4] = bflo(w.z) * c; wq[5] = bfhi(w.z) * c; wq[6] = bflo(w.w) * c; wq[7] = bfhi(w.w) * c; }
    const int tq = t0 + q;
    const int nsteps = (t0 + 32 + 255) >> 8;
    __syncthreads();
    float th = -__builtin_inff();
    bf16x8 afn[4];
    { const int k0 = 32 * wid; const bf16* krow = P.KI + (brow + (k0 <= t0 + 31 ? k0 : 0) + q) * 64 + 8 * hi;
#pragma unroll
      for (int s = 0; s < 4; ++s) afn[s] = *(const GAS bf16x8*)(krow + 16 * s); }
    for (int st = 0; st < nsteps; ++st) {
        const int key0 = 256 * st + 32 * wid;
        bf16x8 af[4];
#pragma unroll
        for (int s = 0; s < 4; ++s) af[s] = afn[s];
        { const int k1 = key0 + 256; const bf16* krow = P.KI + (brow + (k1 <= t0 + 31 ? k1 : 0) + q) * 64 + 8 * hi;
#pragma unroll
          for (int s = 0; s < 4; ++s) afn[s] = *(const GAS bf16x8*)(krow + 16 * s); }
        if (key0 <= t0 + 31) {
            f32x16 sc;
#pragma unroll
            for (int i = 0; i < 16; ++i) sc[i] = 0.f;
            unsigned qfo = (unsigned)(L_QF + q * QFP + 16 * hi); asm volatile("" : "+v"(qfo));
#pragma unroll
            for (int hd = 0; hd < 8; ++hd) {
                f32x16 acc;
#pragma unroll
                for (int i = 0; i < 16; ++i) acc[i] = 0.f;
#pragma unroll
                for (int s = 0; s < 4; ++s) { const bf16x8 qb = *(const LAS bf16x8*)(lds + qfo + hd * 128 + 32 * s);
                    acc = __builtin_amdgcn_mfma_f32_32x32x16_bf16(af[s], qb, acc, 0, 0, 0); }
#pragma unroll
                for (int i = 0; i < 16; ++i) sc[i] = fmaf(fmaxf(acc[i], 0.f), wq[hd], sc[i]);
                __builtin_amdgcn_sched_barrier(0);
            }
            const bool diag = key0 + 31 > t0;
            unsigned pm = 0u;
#pragma unroll
            for (int i = 0; i < 16; ++i) { const int kidx = key0 + (i & 3) + 8 * (i >> 2) + 4 * hi; const bool ok = (sc[i] >= th) && (!diag || kidx <= tq); pm |= ok ? (1u << i) : 0u; }
            const int np = __builtin_popcount(pm);
            if (np > 0) {
                int pos = (int)__hip_atomic_fetch_add(cnt + q, (unsigned)np, __ATOMIC_RELAXED, __HIP_MEMORY_SCOPE_WORKGROUP);
                LAS unsigned* bq = buf + q * CAP;
#pragma unroll
                for (int i = 0; i < 16; ++i) if (pm & (1u << i)) { const int kidx = key0 + (i & 3) + 8 * (i >> 2) + 4 * hi; bq[pos] = packkey(sc[i], kidx); ++pos; }
            }
        }
        __syncthreads();
        { unsigned nm = (unsigned)__ballot(cnt[q] > (unsigned)PRUNE_AT); int i = 0;
          while (nm) { const int qq = __builtin_ctz(nm); nm &= nm - 1u; if ((i & 7) == wid) prune(lds, qq, wid, lane, false); ++i; } }
        __syncthreads();
        th = thr[q];
    }
    LAS unsigned* mrow = (LAS unsigned*)(lds + L_MROW) + wid * 256;
#pragma unroll 1
    for (int k = 0; k < 4; ++k) {
        const int qq = wid + 8 * k;
        if (cnt[qq] > (unsigned)KEEP) prune(lds, qq, wid, lane, true);
        const int nf = (int)cnt[qq];
        *(LAS v4u*)(mrow + 4 * lane) = (v4u){0u, 0u, 0u, 0u};
        LDS_WAIT(); asm volatile("" ::: "memory");
#pragma unroll
        for (int j = 0; j < 4; ++j) { const int idx = lane + 64 * j; if (idx < nf) { const unsigned e = buf[qq * CAP + idx]; const unsigned key = 8191u - (e & 0x1FFFu); (void)__hip_atomic_fetch_or(mrow + (key >> 5), 1u << (key & 31u), __ATOMIC_RELAXED, __HIP_MEMORY_SCOPE_WORKGROUP); } }
        LDS_WAIT(); asm volatile("" ::: "memory");
        unsigned long long* grow = (unsigned long long*)(P.bitm + (brow + t0 + qq) * 256);
#pragma unroll
        for (int j = 0; j < 2; ++j) { const int w2 = lane + 64 * j; const unsigned long long v = (unsigned long long)mrow[2 * w2] | ((unsigned long long)mrow[2 * w2 + 1] << 32);
            __hip_atomic_store(grow + w2, v, RLX_AGENT); }
        LDS_WAIT(); asm volatile("" ::: "memory");
    }
    VM_WAIT();
    __syncthreads();
    if (tid == 0) __hip_atomic_fetch_add(P.done + 64 * (b * 32 + (t0 >> 8)), 1u, RLX_AGENT);
}

struct RPostP { const bf16* ZR; bf16* Q3; const bf16* yraw; const float* rdotk; const float *mu, *gup, *lnw, *lnb; };
__device__ __forceinline__ void rwkv_post(const RPostP& P, LAS unsigned char* lds) {
    const int tid = otid_(), lane = tid & 63, h = __builtin_amdgcn_readfirstlane(tid >> 6), c16 = lane & 15, quad = lane >> 4;
    constexpr int SP = 272;
    LAS float* GT = (LAS float*)(lds + 64 * SP);
    bf16x8 bfr[4][4];
#pragma unroll
    for (int ct = 0; ct < 4; ++ct)
#pragma unroll
        for (int s = 0; s < 4; ++s) { const float* gp = P.gup + (size_t)(32 * s + 8 * quad) * 512 + 64 * h + 16 * ct + c16;
            v4u w; w.x = pk2(gp[0], gp[512]); w.y = pk2(gp[1024], gp[1536]); w.z = pk2(gp[2048], gp[2560]); w.w = pk2(gp[3072], gp[3584]); bfr[ct][s] = __builtin_bit_cast(bf16x8, w); }
    float muv[4], lnw[4], lnb[4];
#pragma unroll
    for (int ct = 0; ct < 4; ++ct) { const int ch = 64 * h + 16 * ct + c16; muv[ct] = P.mu[1024 + ch]; lnw[ct] = P.lnw[ch]; lnb[ct] = P.lnb[ch]; }
    const int stok = tid >> 3, sseg = tid & 7;
#pragma unroll 1
    for (int m0 = blockIdx.x * 64; m0 < M; m0 += gridDim.x * 64) {
        {   const size_t m = (size_t)m0 + stok; const int t = (int)(m & (T - 1));
            float gv[16], pv[16];
            { const v4u a = *(const GAS v4u*)(P.ZR + m * ZP + ZC_GC + 16 * sseg), c = *(const GAS v4u*)(P.ZR + m * ZP + ZC_GC + 16 * sseg + 8);
              gv[0] = bflo(a.x); gv[1] = bfhi(a.x); gv[2] = bflo(a.y); gv[3] = bfhi(a.y); gv[4] = bflo(a.z); gv[5] = bfhi(a.z); gv[6] = bflo(a.w); gv[7] = bfhi(a.w);
              gv[8] = bflo(c.x); gv[9] = bfhi(c.x); gv[10] = bflo(c.y); gv[11] = bfhi(c.y); gv[12] = bflo(c.z); gv[13] = bfhi(c.z); gv[14] = bflo(c.w); gv[15] = bfhi(c.w); }
            if (t > 0) { const v4u a = *(const GAS v4u*)(P.ZR + (m - 1) * ZP + ZC_GC + 16 * sseg), c = *(const GAS v4u*)(P.ZR + (m - 1) * ZP + ZC_GC + 16 * sseg + 8);
              pv[0] = bflo(a.x); pv[1] = bfhi(a.x); pv[2] = bflo(a.y); pv[3] = bfhi(a.y); pv[4] = bflo(a.z); pv[5] = bfhi(a.z); pv[6] = bflo(a.w); pv[7] = bfhi(a.w);
              pv[8] = bflo(c.x); pv[9] = bfhi(c.x); pv[10] = bflo(c.y); pv[11] = bfhi(c.y); pv[12] = bflo(c.z); pv[13] = bfhi(c.z); pv[14] = bflo(c.w); pv[15] = bfhi(c.w); }
            else {
#pragma unroll
              for (int e = 0; e < 16; ++e) pv[e] = 0.f; }
            float sg[16];
#pragma unroll
            for (int e = 0; e < 16; ++e) { const float mu = P.mu[1664 + 16 * sseg + e]; sg[e] = sigm(gv[e] + (pv[e] - gv[e]) * mu); }
            v4u o0, o1; o0.x = pk2(sg[0], sg[1]); o0.y = pk2(sg[2], sg[3]); o0.z = pk2(sg[4], sg[5]); o0.w = pk2(sg[6], sg[7]); o1.x = pk2(sg[8], sg[9]); o1.y = pk2(sg[10], sg[11]); o1.z = pk2(sg[12], sg[13]); o1.w = pk2(sg[14], sg[15]);
            *(LAS v4u*)(lds + stok * SP + 32 * sseg) = o0; *(LAS v4u*)(lds + stok * SP + 32 * sseg + 16) = o1;
        }
        __syncthreads();
#pragma unroll 1
        for (int rt = 0; rt < 4; ++rt) {
            f32x4 acc[4];
#pragma unroll
            for (int ct = 0; ct < 4; ++ct) acc[ct] = (f32x4){0.f, 0.f, 0.f, 0.f};
#pragma unroll
            for (int s = 0; s < 4; ++s) { const bf16x8 af = *(const LAS bf16x8*)(lds + (16 * rt + c16) * SP + (32 * s + 8 * quad) * 2);
#pragma unroll
                for (int ct = 0; ct < 4; ++ct) acc[ct] = __builtin_amdgcn_mfma_f32_16x16x32_bf16(af, bfr[ct][s], acc[ct], 0, 0, 0); }
#pragma unroll
            for (int ct = 0; ct < 4; ++ct)
#pragma unroll
                for (int j = 0; j < 4; ++j) GT[(4 * quad + j) * 512 + 64 * h + 16 * ct + c16] = acc[ct][j];
            __syncthreads();
            {   const int vtok = tid >> 5, vseg = tid & 31, ch0 = 16 * vseg, vh = vseg >> 2;
                const size_t m = (size_t)m0 + 16 * rt + vtok; const int t = (int)(m & (T - 1));
                float y[16], vv[16], vp[16], g[16];
                { const v4u a = *(const GAS v4u*)(P.yraw + m * 512 + ch0), c = *(const GAS v4u*)(P.yraw + m * 512 + ch0 + 8);
                  y[0] = bflo(a.x); y[1] = bfhi(a.x); y[2] = bflo(a.y); y[3] = bfhi(a.y); y[4] = bflo(a.z); y[5] = bfhi(a.z); y[6] = bflo(a.w); y[7] = bfhi(a.w);
                  y[8] = bflo(c.x); y[9] = bfhi(c.x); y[10] = bflo(c.y); y[11] = bfhi(c.y); y[12] = bflo(c.z); y[13] = bfhi(c.z); y[14] = bflo(c.w); y[15] = bfhi(c.w); }
                { const v4u a = *(const GAS v4u*)(P.ZR + m * ZP + ZC_RV + ch0), c = *(const GAS v4u*)(P.ZR + m * ZP + ZC_RV + ch0 + 8);
                  vv[0] = bflo(a.x); vv[1] = bfhi(a.x); vv[2] = bflo(a.y); vv[3] = bfhi(a.y); vv[4] = bflo(a.z); vv[5] = bfhi(a.z); vv[6] = bflo(a.w); vv[7] = bfhi(a.w);
                  vv[8] = bflo(c.x); vv[9] = bfhi(c.x); vv[10] = bflo(c.y); vv[11] = bfhi(c.y); vv[12] = bflo(c.z); vv[13] = bfhi(c.z); vv[14] = bflo(c.w); vv[15] = bfhi(c.w); }
                if (t > 0) { const v4u a = *(const GAS v4u*)(P.ZR + (m - 1) * ZP + ZC_RV + ch0), c = *(const GAS v4u*)(P.ZR + (m - 1) * ZP + ZC_RV + ch0 + 8);
                  vp[0] = bflo(a.x); vp[1] = bfhi(a.x); vp[2] = bflo(a.y); vp[3] = bfhi(a.y); vp[4] = bflo(a.z); vp[5] = bfhi(a.z); vp[6] = bflo(a.w); vp[7] = bfhi(a.w);
                  vp[8] = bflo(c.x); vp[9] = bfhi(c.x); vp[10] = bflo(c.y); vp[11] = bfhi(c.y); vp[12] = bflo(c.z); vp[13] = bfhi(c.z); vp[14] = bflo(c.w); vp[15] = bfhi(c.w); }
                else {
#pragma unroll
                  for (int e = 0; e < 16; ++e) vp[e] = 0.f; }
#pragma unroll
                for (int e4 = 0; e4 < 4; ++e4) { const f32x4 gq = *(const LAS f32x4*)(GT + vtok * 512 + ch0 + 4 * e4); g[4 * e4] = gq.x; g[4 * e4 + 1] = gq.y; g[4 * e4 + 2] = gq.z; g[4 * e4 + 3] = gq.w; }
                float sm = 0.f;
#pragma unroll
                for (int e = 0; e < 16; ++e) sm += y[e];
                sm = scan::dpp_add<0xB1>(sm); sm = scan::dpp_add<0x4E>(sm);
                const float mean = sm * (1.f / 64.f); float vs = 0.f;
#pragma unroll
                for (int e = 0; e < 16; ++e) { y[e] -= mean; vs += y[e] * y[e]; }
                vs = scan::dpp_add<0xB1>(vs); vs = scan::dpp_add<0x4E>(vs);
                const float rstd = __builtin_amdgcn_rsqf(vs * (1.f / 64.f) + 64e-5f);
                const float rk = P.rdotk[m * 8 + vh];
                unsigned ow[8];
#pragma unroll
                for (int e = 0; e < 16; e += 2) { float o2[2];
#pragma unroll
                    for (int d = 0; d < 2; ++d) { const int ch = ch0 + e + d; const float v = vv[e + d] + (vp[e + d] - vv[e + d]) * P.mu[1024 + ch];
                        o2[d] = (y[e + d] * rstd * P.lnw[ch] + P.lnb[ch] + rk * v) * g[e + d]; }
                    ow[e >> 1] = pk2(o2[0], o2[1]); }
                *(GAS v4u*)(P.Q3 + m * QP + 512 + ch0) = (v4u){ow[0], ow[1], ow[2], ow[3]}; *(GAS v4u*)(P.Q3 + m * QP + 512 + ch0 + 8) = (v4u){ow[4], ow[5], ow[6], ow[7]};
            }
            __syncthreads();
        }
        __syncthreads();
    }
}
struct DPostP { const bf16* O1; const bf16* O2; bf16* Q3; const float *lq1, *lk1, *lq2, *lk2, *subln; float lambda_init; };
__device__ __forceinline__ void diff_post(const DPostP& P, int gw, int NGW, int lane) {
    const float lam = __expf(wave_sum(P.lq1[lane] * P.lk1[lane])) - __expf(wave_sum(P.lq2[lane] * P.lk2[lane])) + P.lambda_init;
    const float s0 = P.subln[2 * lane] * (1.f - P.lambda_init), s1 = P.subln[2 * lane + 1] * (1.f - P.lambda_init);
    for (int it = gw; it < M * 4; it += NGW) {
        const size_t m = (size_t)(it >> 2); const int hh = it & 3;
        const unsigned a = *(const GAS unsigned*)(P.O1 + m * 512 + 128 * hh + 2 * lane), c = *(const GAS unsigned*)(P.O2 + m * 512 + 128 * hh + 2 * lane);
        const float x0 = bflo(a) - lam * bflo(c), x1 = bfhi(a) - lam * bfhi(c);
        const float r = __builtin_amdgcn_rsqf(wave_sum(x0 * x0 + x1 * x1) * (1.f / 128.f) + NORM_EPS);
        *(GAS unsigned*)(P.Q3 + m * QP + 1024 + 128 * hh + 2 * lane) = pk2(x0 * r * s0, x1 * r * s1);
    }
}

__device__ __forceinline__ int q_fetch(gu32* head, volatile LAS int* slot) {
    if (threadIdx.x == 0) *slot = (int)__hip_atomic_fetch_add(head, 1u, RLX_AGENT);
    __syncthreads();
    const int v = __builtin_amdgcn_readfirstlane(*slot);
    __syncthreads();
    return v;
}

struct Args { const float* in[32]; float* out; unsigned char* ws; int ph_lo, ph_hi; };
__device__ __forceinline__ const float* kin_(int i) { const char* ka = (const char*)__builtin_amdgcn_kernarg_segment_ptr(); unsigned off = (unsigned)i * 8u; asm volatile("" : "+s"(off)); return *(const float* const*)(ka + off); }
#define KIN(i) kin_(i)
#define XOUT ((float*)kin_(32))
#define XB ((bf16*)kin_(32))
#define XB2 ((bf16*)(wsl + WS_Q3))
#define OUTHI ((unsigned char*)kin_(32) + 32 * MiB)
__device__ __forceinline__ unsigned char* kws_() { return (unsigned char*)kin_(33); }
__device__ __forceinline__ int kint_(int byteoff) { const char* ka = (const char*)__builtin_amdgcn_kernarg_segment_ptr(); unsigned off = (unsigned)byteoff; asm volatile("" : "+s"(off)); return *(const int*)(ka + off); }
constexpr int PH_L = 14;
constexpr int N_PHASES = 1 + NLAYER * PH_L;

#define G ((int)gridDim.x)
#define bid ((int)blockIdx.x)
#define gw (bid * NWAVES + wave)
#define NGW (G * NWAVES)
#define MISC ((volatile LAS unsigned*)(lds + LDS_MISC))
#define IN(k) (kint_(272) <= (k) && (k) < kint_(276))
#define SEAM(k) do { if ((k) + 1 < kint_(276)) { XcdBarrier bar_; bar_.bar = (unsigned*)(kws_() + WS_CTL) + CW_BAR; bar_.x = xb_xcc_id(); bar_.st = MISC + 8; xcd_barrier(bar_); } } while (0)
#define WSL() unsigned char* wsl = kws_(); const int tid = otid_(), lane = tid & 63, wave = __builtin_amdgcn_readfirstlane(tid >> 6); (void)lane; (void)wave
#define WFu ((bf16*)(wsl + WS_WF))
#define WFd ((bf16*)(wsl + WS_WF_DOWN))
#define WMi ((bf16*)(wsl + WS_WM))
#define WMb ((bf16*)(wsl + WS_WM_BR))
#define WMo ((bf16*)(wsl + WS_WM_OUT))
#define XN ((bf16*)(wsl + WS_XN))
#define Q3 ((bf16*)(wsl + WS_Q3))
#define ZR ((bf16*)(wsl + WS_ZR))
#define YP ((bf16*)(wsl + WS_R2))
#define HB ZR
#define G3 ZR
#define MG ((bf16*)(wsl + WS_MG))
#define O1 ((bf16*)(wsl + WS_R2))
#define O2 ((bf16*)(wsl + WS_R2) + (size_t)M * 512)
#define YRAW ((bf16*)(wsl + WS_YRAW))
#define BITM ((unsigned*)OUTHI)
#define RDOTK ((float*)(wsl + WS_RDOTK))
#define X1B ((bf16*)(OUTHI + 16 * MiB))
#define KID ((bf16*)(wsl + WS_KID))
#define A8B ((unsigned char*)(wsl + WS_A8))
#define CTL ((gu32*)(wsl + WS_CTL))
#define cscr ((LAS float*)(lds + wave * 16384))

#define CONV_FFN(l_, f_) do { const int gi_ = (f_) ? 29 : 3; \
        MapUp mu_{KIN(gi_) + (size_t)(l_) * DM * FF, KIN(gi_ + 1) + (size_t)(l_) * DM * FF, FF}; MapIdent md_{KIN(gi_ + 2) + (size_t)(l_) * FF * DM, DM}; \
        constexpr int nu_ = conv_items(DM, 2 * FF), nd_ = conv_items(FF, DM); \
        for (int it_ = gw; it_ < nu_ + nd_; it_ += NGW) { if (it_ < nu_) conv_item(mu_, DM, WFu, cscr, it_, 2 * FF / 32, lane); else conv_item(md_, FF, WFd, cscr, it_ - nu_, DM / 32, lane); } } while (0)
#define CONV_MIX(l_) do { MapWin mw_{KIN(8) + (size_t)(l_) * DM * NIN, NIN}; MapIdent mo_{KIN(26) + (size_t)(l_) * DM * DM, DM}; \
        constexpr int ni_ = conv_items(DM, 8704), nb_ = conv_items(512, DM), no_ = conv_items(DM, DM); \
        for (int it_ = gw; it_ < ni_ + 3 * nb_ + no_; it_ += NGW) { \
            if (it_ < ni_) conv_item(mw_, DM, WMi, cscr, it_, 8704 / 32, lane); \
            else if (it_ < ni_ + 3 * nb_) { const int r_ = it_ - ni_, n_ = r_ / nb_; MapIdent mb_{KIN(25) + ((size_t)(l_) * 3 + n_) * 512 * DM, DM}; conv_item(mb_, 512, WMb + (size_t)n_ * DM * 512, cscr, r_ - n_ * nb_, DM / 32, lane); } \
            else conv_item(mo_, DM, WMo, cscr, it_ - ni_ - 3 * nb_, DM / 32, lane); } } while (0)

template <int L, int F> __device__ __forceinline__ void ffn_part(LAS unsigned char* lds) {
    constexpr int l = L, f = F, pb = 1 + PH_L * L, pf = pb + (F ? 11 : 0);
            if (IN(pf + 0)) { WSL();
                pg8::Gemm g{XN, WFu, M, 2 * FF, DM, DM}; pg8::StaticOrder S; S.init(M, 2 * FF, G, bid);
                pg8::EpiSwiGLU E{HB, FF};
                pg8::gemm_phase<pg8::EpiSwiGLU, pg8::StaticOrder, true, true>(lds, g, S, E);
                SEAM(pf + 0);
            }
            if (IN(pf + 1)) { WSL();
                pg8::Gemm g{HB, WFd, M, DM, FF, FF}; pg8::StaticOrder S; S.init(M, DM, G, bid);
                pg8::EpiStore<0> E{YP, DM, YP, DM, 1 << 30};
                pg8::gemm_phase<pg8::EpiStore<0>, pg8::StaticOrder, true, true>(lds, g, S, E);
                SEAM(pf + 1);
            }
            if (IN(pf + 2)) { WSL();
                const float* gpost = KIN(f ? 28 : 2) + l * DM;
                const float* gnext = f == 0 ? KIN(6) + l * DM : (l + 1 < NLAYER ? KIN(1) + (l + 1) * DM : nullptr);
#if PROBE
                float osc = 1.f;
                if (l == NLAYER - 1 && f == 1) { const float num = *(const float*)(wsl + WS_CTL + 4 * CW_PROBE), den = *(const float*)(wsl + WS_CTL + 4 * (CW_PROBE + 1)); osc = 1.f + 4.f * sqrtf(num / fmaxf(den, 1e-30f)); }
#else
                const float osc = 1.f;
#endif
                if constexpr (l == 0 && f == 0) rownorm_rows<false, true>(KIN(0), YP, 0.5f, gpost, XB, gnext, XN, gw, NGW, lane);
                else if constexpr (l == NLAYER - 1 && f == 1) rownorm_rows<true, false>(XB2, YP, 0.5f, gpost, XOUT, nullptr, nullptr, gw, NGW, lane, osc);
                else rownorm_rows<true, true>(XB, YP, 0.5f, gpost, XB, gnext, XN, gw, NGW, lane);
                if (f == 1 && l + 1 < NLAYER) { CONV_FFN(l + 1, 0); CONV_MIX(l + 1); }
                SEAM(pf + 2);
            }
}
template <int L> __device__ __forceinline__ void mixer_part(LAS unsigned char* lds, unsigned char* lds_) {
    constexpr int l = L, pb = 1 + PH_L * L;
            const int pm = pb + 3;
            if (IN(pm + 0)) { WSL();
                pg8::Gemm g{XN, WMi, M, 5632, DM, DM}; pg8::StaticOrder S; S.init(M, 5632, G, bid);
                pg8::EpiStore<0> E{Q3, QP, ZR, ZP, 6};
                pg8::gemm_phase<pg8::EpiStore<0>, pg8::StaticOrder, true, true>(lds, g, S, E);
                SEAM(pm + 0);
            }
            if (IN(pm + 1)) { WSL();
                PrepP pp{ZR, X1B, A8B, KID, KIN(9) + l * 1792, KIN(10) + l * 512, KIN(11) + l * 64 * 512, KIN(12) + l * 512, KIN(13) + l * 64 * 512};
                rwkv_prep(pp, lds);
                SEAM(pm + 1);
            }
            if (IN(pm + 2)) { WSL();
                volatile LAS int* slot = (volatile LAS int*)(MISC + 16);
                if (bid < 64) {
                    ScanP sp{Q3, ZR, X1B, A8B, YRAW, RDOTK, KIN(9) + l * 1792, KIN(15) + l * 512, KIN(16) + l * 512, KIN(17) + l * 512};
#ifndef NO_SCAN
                    rwkv_scan_unit(sp, bid, lds);
#ifdef SCAN_TWICE
                    rwkv_scan_unit(sp, bid, lds);
#endif
#endif
                }
                {
                    Dsa1P dp{ZR, KID, BITM, CTL + CW_DONE + 64 * 64 * l};
                    gu32* head = CTL + CW_Q + 64 * (3 * l + 0);
                    #ifndef NO_DSA1
                    for (int u = q_fetch(head, slot); u < 512; u = q_fetch(head, slot)) dsa1_unit(dp, u, lds);
#ifdef DUP_DSA1
                    { gu32* head2 = CTL + 10240 + 64 * (2 * l + 0); for (int u = q_fetch(head2, slot); u < 512; u = q_fetch(head2, slot)) dsa1_unit(dp, u, lds); }
#endif
#endif
                }
                {
                    gu32* head = CTL + CW_Q + 64 * (3 * l + 1);
                    typedef att::BlockRef<att::bf16, att::bf16> Ref;
#define DSA2_REF(i_, r_) do { const int qb_ = 31 - ((i_) >> 3), b_ = ((i_) >> 2) & 1, h_ = (i_) & 3; const size_t row_ = (size_t)b_ * T + 256 * qb_; \
        r_.Q = (const att::bf16*)(Q3 + row_ * QP + 128 * h_); r_.O = (att::bf16*)(Q3 + row_ * QP + 128 * h_); r_.K = (const att::bf16*)(ZR + (size_t)b_ * T * ZP + ZC_DK + 128 * h_); \
        r_.V = (const att::bf16*)(ZR + (size_t)b_ * T * ZP + ZC_DV + 128 * h_); r_.P0 = 256 * qb_; r_.koff = 0; r_.mask = BITM + row_ * 256; } while (0)
                    int ic = q_fetch(head, slot);
                    if (ic < 256) {
                        int in_ = q_fetch(head, slot);
                        Ref cur; DSA2_REF(ic, cur);
                        att::Seam<att::bf16> S;
                        att::causal_swa_prime<att::bf16, att::bf16, false>(cur, T, (char*)lds_, S);
                        for (;;) {
                            const bool last = in_ >= 256;
                            Ref nxt = cur; if (!last) DSA2_REF(in_, nxt);
                            {
                                if (tid == 0) { gu32* dw = CTL + CW_DONE + 64 * (64 * l + (((ic >> 2) & 1) * 32 + (31 - (ic >> 3)))); unsigned sp = 0;
                                    while (__hip_atomic_load(dw, RLX_AGENT) < 8u) { __builtin_amdgcn_s_sleep(2); if (++sp > (1u << 24)) { __hip_atomic_store(CTL + CW_TMO, 1u, RLX_AGENT); break; } }
                                    __builtin_amdgcn_fence(__ATOMIC_ACQUIRE, "agent"); asm volatile("s_waitcnt vmcnt(0)" ::: "memory"); }
                                __syncthreads();
                            }
#ifndef NO_DSA2
                            att::causal_swa_block<att::bf16, att::bf16, false, true, QP>(cur, nxt, T, T, (char*)lds_, S);
#endif
                            if (last) break;
                            cur = nxt; ic = in_; in_ = q_fetch(head, slot);
                        }
                    }
                }
                {
#ifdef DUP_DIFF
                  for (int rep_ = 0; rep_ < 2; ++rep_) {
                    gu32* head = rep_ ? CTL + 10240 + 64 * (2 * l + 1) : CTL + CW_Q + 64 * (3 * l + 2);
#else
                  {
                    gu32* head = CTL + CW_Q + 64 * (3 * l + 2);
#endif
                    typedef att::BlockRef<att::bf16, att::bf16> Ref;
#define DIFF_REF(i_, r_) do { const int qb_ = 31 - ((i_) >> 4), b_ = ((i_) >> 3) & 1, h_ = ((i_) >> 1) & 3, mp_ = (i_) & 1; const size_t row_ = (size_t)b_ * T + 256 * qb_; \
        r_.Q = (const att::bf16*)(Q3 + row_ * QP + 1024 + 128 * h_ + 64 * mp_); r_.O = (att::bf16*)((mp_ ? O2 : O1) + row_ * 512 + 128 * h_); \
        r_.K = (const att::bf16*)(ZR + (size_t)b_ * T * ZP + ZC_FK + 128 * h_); r_.V = (const att::bf16*)(ZR + (size_t)b_ * T * ZP + ZC_FV + 128 * h_); r_.P0 = 256 * qb_; r_.koff = 128 * mp_; r_.mask = nullptr; } while (0)
                    int ic = q_fetch(head, slot);
                    if (ic < 512) {
                        int in_ = q_fetch(head, slot);
                        Ref cur; DIFF_REF(ic, cur);
                        att::Seam<att::bf16> S;
                        att::causal_swa_prime<att::bf16, att::bf16, true>(cur, T, (char*)lds_, S);
                        for (;;) {
                            const bool last = in_ >= 512;
                            Ref nxt = cur; if (!last) DIFF_REF(in_, nxt);
#ifndef NO_DIFF
                            att::causal_swa_block<att::bf16, att::bf16, true, false, 512>(cur, nxt, T, T, (char*)lds_, S);
#endif
                            if (last) break;
                            cur = nxt; ic = in_; in_ = q_fetch(head, slot);
                        }
                    }
                  }
                }
                SEAM(pm + 2);
            }
            if (IN(pm + 3)) { WSL();
                RPostP rp{ZR, Q3, YRAW, RDOTK, KIN(9) + l * 1792, KIN(14) + l * 128 * 512, KIN(18) + l * 512, KIN(19) + l * 512};
#ifndef NO_RPOST
                rwkv_post(rp, lds);
#endif
                constexpr float lambda_init = L == 0 ? 0.2f : 0.35550906759096927f;
                DPostP dq{O1, O2, Q3, KIN(20) + l * 64, KIN(21) + l * 64, KIN(22) + l * 64, KIN(23) + l * 64, KIN(24) + l * 128, lambda_init};
                diff_post(dq, gw, NGW, lane);
                SEAM(pm + 3);
            }
            if (IN(pm + 4)) { WSL();
                pg8::Gemm g{XN, WMi + (size_t)5632 * DM, M, 3072, DM, DM}; pg8::StaticOrder S; S.init(M, 3072, G, bid);
#ifdef GATE_RAW
                pg8::EpiStore<0> E{G3, 3072, G3, 3072, 1 << 30};
                pg8::gemm_phase<pg8::EpiStore<0>, pg8::StaticOrder, true, true>(lds, g, S, E);
#else
                pg8::EpiStore<1> E{G3, 3072, G3, 3072, 1 << 30};
                pg8::gemm_phase<pg8::EpiStore<1>, pg8::StaticOrder, true, true>(lds, g, S, E);
#endif
                SEAM(pm + 4);
            }
            if (IN(pm + 5)) { WSL();
#pragma unroll 1
                for (int n = 0; n < 3; ++n) {
                    pg8::Gemm g{Q3 + 512 * n, WMb + (size_t)n * DM * 512, M, DM, 512, QP}; pg8::StaticOrder S; S.init(M, DM, G, bid);
                    pg8::EpiGateMul E{MG, DM, G3 + 1024 * n, 3072, n == 0 ? 1 : 0};
                    pg8::gemm_phase<pg8::EpiGateMul, pg8::StaticOrder, false, true>(lds, g, S, E);
                    VM_WAIT(); __syncthreads();
                }
                SEAM(pm + 5);
            }
            if (IN(pm + 6)) { WSL();
                pg8::Gemm g{MG, WMo, M, DM, DM, DM}; pg8::StaticOrder S; S.init(M, DM, G, bid);
                pg8::EpiStore<0> E{YP, DM, YP, DM, 1 << 30};
                pg8::gemm_phase<pg8::EpiStore<0>, pg8::StaticOrder, false, true>(lds, g, S, E);
                SEAM(pm + 6);
            }
            if (IN(pm + 7)) { WSL();
                rownorm_rows<true, true>(XB, YP, 1.0f, KIN(7) + l * DM, l == NLAYER - 1 ? XB2 : XB, KIN(27) + l * DM, XN, gw, NGW, lane);
                CONV_FFN(l, 1);
                SEAM(pm + 7);
            }
}

__global__ void __launch_bounds__(NWAVES * 64, 2) mk_fwd(Args args) {
    extern __shared__ __attribute__((aligned(16))) unsigned char lds_[];
    LAS unsigned char* lds = (LAS unsigned char*)lds_;
    { const int tid = otid_(); if (tid < 64) MISC[tid] = 0u; }
    __syncthreads();
    (void)xcd_barrier_post((unsigned*)(kws_() + WS_CTL) + CW_BAR, MISC + 8);
    if (IN(0)) { WSL();
        CONV_FFN(0, 0); CONV_MIX(0);
        rownorm_rows<false, false>(KIN(0), nullptr, 0.f, nullptr, nullptr, KIN(1), XN, gw, NGW, lane);
        SEAM(0);
    }
    ffn_part<0, 0>(lds); mixer_part<0>(lds, lds_); ffn_part<0, 1>(lds);
    ffn_part<1, 0>(lds); mixer_part<1>(lds, lds_); ffn_part<1, 1>(lds);
}

#if PROBE
__device__ __forceinline__ void probe_acc(float num, float den, float* ctlf) {
    __shared__ float rn[256], rd[256];
    rn[threadIdx.x] = num; rd[threadIdx.x] = den; __syncthreads();
    for (int o = 128; o > 0; o >>= 1) { if ((int)threadIdx.x < o) { rn[threadIdx.x] += rn[threadIdx.x + o]; rd[threadIdx.x] += rd[threadIdx.x + o]; } __syncthreads(); }
    if (threadIdx.x == 0) { atomicAdd(ctlf + CW_PROBE, rn[0]); atomicAdd(ctlf + CW_PROBE + 1, rd[0]); }
}
__global__ void __launch_bounds__(256) probe_ffn(const unsigned char* ws, const float* Wg, const float* Wu, const float* Wd) {
    __shared__ float xn[1024]; __shared__ float hid[2816];
    const int m = 777 + 1931 * blockIdx.x, tid = threadIdx.x;
    const bf16* XNp = (const bf16*)(ws + WS_XN); const bf16* YPp = (const bf16*)(ws + WS_R2);
    for (int k = tid; k < 1024; k += 256) xn[k] = bf1(XNp[(size_t)m * 1024 + k]);
    __syncthreads();
    for (int j = tid; j < 2816; j += 256) { float g = 0.f, u = 0.f; for (int k = 0; k < 1024; ++k) { g += xn[k] * Wg[(size_t)k * 2816 + j]; u += xn[k] * Wu[(size_t)k * 2816 + j]; } hid[j] = g / (1.f + expf(-g)) * u; }
    __syncthreads();
    float num = 0.f, den = 0.f;
    for (int d = tid; d < 1024; d += 256) { float o = 0.f; for (int j = 0; j < 2816; ++j) o += hid[j] * Wd[(size_t)j * 1024 + d]; const float got = bf1(YPp[(size_t)m * 1024 + d]); num += (o - got) * (o - got); den += o * o; }
    probe_acc(num, den, (float*)(ws + WS_CTL));
}
__global__ void __launch_bounds__(256) probe_win(const unsigned char* ws, const float* Win) {
    __shared__ float xn[1024];
    const int m = 555 + 1999 * blockIdx.x, tid = threadIdx.x;
    const bf16* XNp = (const bf16*)(ws + WS_XN); const bf16* Q3p = (const bf16*)(ws + WS_Q3); const bf16* ZRp = (const bf16*)(ws + WS_ZR);
    for (int k = tid; k < 1024; k += 256) xn[k] = bf1(XNp[(size_t)m * 1024 + k]);
    __syncthreads();
    float num = 0.f, den = 0.f;
    for (int c = tid; c < 5448; c += 256) {
        float z = 0.f; for (int k = 0; k < 1024; ++k) z += xn[k] * Win[(size_t)k * NIN + c];
        float got;
        if (c < 512) got = bf1(Q3p[(size_t)m * QP + c]);
        else if (c < 2120) got = bf1(ZRp[(size_t)m * ZP + (c - 512)]);
        else if (c < 2632) got = bf1(Q3p[(size_t)m * QP + 512 + (c - 2120)]);
        else if (c < 3912) got = bf1(ZRp[(size_t)m * ZP + (c - 840)]);
        else if (c < 4424) got = bf1(Q3p[(size_t)m * QP + 1024 + (c - 3912)]);
        else got = bf1(ZRp[(size_t)m * ZP + (c - 1352)]);
        num += (z - got) * (z - got); den += z * z;
    }
    probe_acc(num, den, (float*)(ws + WS_CTL));
}
__global__ void __launch_bounds__(256) probe_wconv(const unsigned char* ws, const float* Win, int r0) {
    const bf16* WMp = (const bf16*)(ws + WS_WM); const int tid = threadIdx.x;
    float num = 0.f, den = 0.f;
    for (int rr = 0; rr < 64; ++rr) { const int n = r0 + 64 * blockIdx.x + rr; MapWin mw{Win, NIN}; const float* cp = mw.col(n);
        for (int k = tid; k < 1024; k += 256) { const float ref = cp ? cp[(size_t)k * NIN] : 0.f; const float got = bf1(WMp[(size_t)n * 1024 + k]); num += (ref - got) * (ref - got); den += ref * ref; } }
    probe_acc(num, den, (float*)(ws + WS_CTL));
}
__global__ void __launch_bounds__(256) probe_merge(const unsigned char* ws, const float* Win, const float* Wb, const float* Wo, int which) {
    __shared__ float xn[1024]; __shared__ float y[1536]; __shared__ float mg[1024];
    const int m = 333 + 2003 * blockIdx.x, tid = threadIdx.x;
    const bf16* XNp = (const bf16*)(ws + WS_XN); const bf16* Q3p = (const bf16*)(ws + WS_Q3); const bf16* MGp = (const bf16*)(ws + WS_MG); const bf16* YPp = (const bf16*)(ws + WS_R2);
    for (int k = tid; k < 1024; k += 256) xn[k] = bf1(XNp[(size_t)m * 1024 + k]);
    for (int k = tid; k < 1536; k += 256) y[k] = bf1(Q3p[(size_t)m * QP + k]);
    __syncthreads();
    float num = 0.f, den = 0.f;
    for (int d = tid; d < 1024; d += 256) {
        float acc = 0.f;
        for (int n = 0; n < 3; ++n) { float g = 0.f; for (int k = 0; k < 1024; ++k) g += xn[k] * Win[(size_t)k * NIN + 5448 + n * 1024 + d];
            float p = 0.f; for (int c = 0; c < 512; ++c) p += y[512 * n + c] * Wb[((size_t)n * 512 + c) * 1024 + d];
            acc += p / (1.f + expf(-g)); }
        mg[d] = acc; const float got = bf1(MGp[(size_t)m * 1024 + d]); if (which == 0) { num += (acc - got) * (acc - got); den += acc * acc; }
        if (which == 2) { const bf16* G3p = (const bf16*)(ws + WS_ZR); for (int n = 0; n < 3; ++n) { float g = 0.f; for (int k = 0; k < 1024; ++k) g += xn[k] * Win[(size_t)k * NIN + 5448 + n * 1024 + d];
            const float sg = 1.f / (1.f + expf(-g)), gg = bf1(G3p[(size_t)m * 3072 + n * 1024 + d]); num += (sg - gg) * (sg - gg); den += sg * sg; } }
        if (which == 3) { const bf16* G3p = (const bf16*)(ws + WS_ZR); float a2 = 0.f; for (int n = 0; n < 3; ++n) { float p = 0.f; for (int c = 0; c < 512; ++c) p += y[512 * n + c] * Wb[((size_t)n * 512 + c) * 1024 + d];
            a2 += p * bf1(G3p[(size_t)m * 3072 + n * 1024 + d]); } num += (a2 - got) * (a2 - got); den += a2 * a2; }
    }
    __syncthreads();
    if (which == 1) for (int d = tid; d < 1024; d += 256) { float o = 0.f; for (int j = 0; j < 1024; ++j) o += mg[j] * Wo[(size_t)j * 1024 + d]; const float got = bf1(YPp[(size_t)m * 1024 + d]); num += (o - got) * (o - got); den += o * o; }
    probe_acc(num, den, (float*)(ws + WS_CTL));
}
#endif
#ifndef MK_ONE_LAUNCH
#define MK_ONE_LAUNCH 0
#endif
extern "C" void kernel_launch(void* const* d_in, const int* in_sizes, int n_in, void* d_out, int out_size, void* d_ws, size_t ws_size, hipStream_t stream) {
    static int grid = 0;
    if (grid == 0) {
        if (n_in != 32 || in_sizes[0] != M * DM || out_size != M * DM || ws_size < WS_END) { fprintf(stderr, "kernel_launch: unexpected shapes / workspace (n_in %d, ws %zu)\n", n_in, ws_size); grid = -1; return; }
        int dev = 0, cus = 0;
        if (hipGetDevice(&dev) != hipSuccess || hipDeviceGetAttribute(&cus, hipDeviceAttributeMultiprocessorCount, dev) != hipSuccess) { grid = -1; return; }
        if (hipFuncSetAttribute((const void*)mk_fwd, hipFuncAttributeMaxDynamicSharedMemorySize, LDS_BYTES) != hipSuccess) { fprintf(stderr, "kernel_launch: hipFuncSetAttribute failed\n"); grid = -1; return; }
        int per_cu = 0;
        if (hipOccupancyMaxActiveBlocksPerMultiprocessor(&per_cu, (const void*)mk_fwd, NWAVES * 64, LDS_BYTES) != hipSuccess || per_cu < 1) { fprintf(stderr, "kernel_launch: occupancy query says %d\n", per_cu); }
        (void)hipGetLastError();
        grid = cus;
    }
    if (grid < 0) return;
    (void)hipMemsetAsync((char*)d_ws + WS_CTL, 0, CTL_ZERO_BYTES, stream);
    Args a{};
    for (int i = 0; i < 32; ++i) a.in[i] = (const float*)d_in[i];
    a.out = (float*)d_out; a.ws = (unsigned char*)d_ws;
#if MK_ONE_LAUNCH
    a.ph_lo = 0; a.ph_hi = N_PHASES;
    hipLaunchKernelGGL(mk_fwd, dim3(grid), dim3(NWAVES * 64), LDS_BYTES, stream, a);
#else
    for (int p = 0; p < N_PHASES; ++p) { a.ph_lo = p; a.ph_hi = p + 1; hipLaunchKernelGGL(mk_fwd, dim3(grid), dim3(NWAVES * 64), LDS_BYTES, stream, a);
#if PROBE == 1
        if (p == 2) hipLaunchKernelGGL(probe_ffn, dim3(8), dim3(256), 0, stream, (const unsigned char*)d_ws, a.in[3], a.in[4], a.in[5]);
#elif PROBE == 2
        if (p == 4) hipLaunchKernelGGL(probe_win, dim3(8), dim3(256), 0, stream, (const unsigned char*)d_ws, a.in[8]);
#elif PROBE == 3
        if (p == 8) hipLaunchKernelGGL(probe_merge, dim3(8), dim3(256), 0, stream, (const unsigned char*)d_ws, a.in[8], a.in[25], a.in[26], 0);
#elif PROBE == 5
        if (p == 8) hipLaunchKernelGGL(probe_merge, dim3(8), dim3(256), 0, stream, (const unsigned char*)d_ws, a.in[8], a.in[25], a.in[26], 2);
#elif PROBE == 6
        if (p == 8) hipLaunchKernelGGL(probe_merge, dim3(8), dim3(256), 0, stream, (const unsigned char*)d_ws, a.in[8], a.in[25], a.in[26], 3);
#elif PROBE == 7
        if (p == 6) hipLaunchKernelGGL(probe_wconv, dim3(48), dim3(256), 0, stream, (const unsigned char*)d_ws, a.in[8], 5632);
#elif PROBE == 8
        if (p == 3) hipLaunchKernelGGL(probe_wconv, dim3(48), dim3(256), 0, stream, (const unsigned char*)d_ws, a.in[8], 5632);
#elif PROBE == 9
        if (p == 7) hipLaunchKernelGGL(probe_merge, dim3(8), dim3(256), 0, stream, (const unsigned char*)d_ws, a.in[8], a.in[25], a.in[26], 2);
#elif PROBE == 4
        if (p == 9) hipLaunchKernelGGL(probe_merge, dim3(8), dim3(256), 0, stream, (const unsigned char*)d_ws, a.in[8], a.in[25], a.in[26], 1);
#endif
    }
#endif
}
```

```cpp
#include <hip/hip_runtime.h>
#include <hip/hip_bf16.h>
#include <cstdio>
#include <cstdint>
#define MK_ONE_LAUNCH 1
#define GATE_RAW 1

__device__ __forceinline__ int otid_() { int t = (int)threadIdx.x; asm volatile("" : "+v"(t)); return t; }
namespace pg8 {
#define PG8_LAS __attribute__((address_space(3)))
typedef unsigned short bf16_t;
typedef short bf16x8 __attribute__((ext_vector_type(8)));
typedef float f32x4 __attribute__((ext_vector_type(4)));
typedef unsigned u32x4 __attribute__((ext_vector_type(4)));
constexpr int BM = 256, BK = 64, HALF = 128, HTB = HALF * BK * 2  , STAGE_BYTES = 8 * HTB, NXCD = 8, WGM = 8;

__host__ __device__ __forceinline__ int lds_byte(int r, int c) { const int st = (r >> 4) * 2 + (c >> 5), rr = r & 15, cc = c & 31, ob = rr * 64 + cc * 2; return st * 1024 + (ob ^ (((ob >> 9) & 1) << 5)); }
__host__ __device__ __forceinline__ void stage_rc(int b, int& R, int& C) { const int st = b / 1024, sb = b % 1024, swz = sb ^ (((sb >> 9) & 1) << 5); R = (st >> 1) * 16 + swz / 64; C = (st & 1) * 32 + (swz % 64) / 2; }
__host__ __device__ __forceinline__ int perm32(int rho) { const int n = rho >> 4, i = rho & 15; return 8 * (i >> 2) + 4 * n + (i & 3); }

struct Unit { int pm, pn; };
struct Gemm { const bf16_t* A; const bf16_t* Bt; int M, N, K, lda; };

struct StaticOrder {
    int nM, nN, nwg, G, c;
    __host__ __device__ void init(int M, int N, int G_, int c_) { nM = M / BM; nN = N / BM; nwg = nM * nN; G = G_; c = c_; }
    __host__ __device__ bool next(int i, Unit& u) const {
        const long L = (long)i * G + c; if (L >= nwg) return false;
        int wgid = (int)L; { const int q = nwg / NXCD, r = nwg % NXCD, xcd = wgid % NXCD, off = wgid / NXCD; wgid = (xcd < r ? xcd * (q + 1) : r * (q + 1) + (xcd - r) * q) + off; }
        const int nig = WGM * nN, gid = wgid / nig, fm = gid * WGM, gsz = (nM - fm) < WGM ? (nM - fm) : WGM;
        u.pm = fm + ((wgid % nig) % gsz); u.pn = (wgid % nig) / gsz; return true;
    }
    __device__ __forceinline__ void a_ready(const Unit&) const {}
    __device__ __forceinline__ void done(const Unit&) const {}
};

__device__ __forceinline__ unsigned cvt_pk_bf16(float lo, float hi) { unsigned r; asm volatile("v_cvt_pk_bf16_f32 %0, %1, %2" : "=v"(r) : "v"(lo), "v"(hi)); return r; }

template <class Epi, class Sched, bool ALIGN_EPI = false, bool SP2 = false>
__device__ __forceinline__ void gemm_phase(PG8_LAS unsigned char* lds, const Gemm g, const Sched& S, const Epi& E) {
    const int tid = otid_(), wid = __builtin_amdgcn_readfirstlane(tid >> 6), lane = tid & 63, wr = wid >> 2, wc = wid & 3, fr = lane & 15, fq = lane >> 4;
    const int K = g.K, nt = K / BK;
    unsigned voffA[2], voffB[2];
#pragma unroll
    for (int i = 0; i < 2; ++i) { int R, C; stage_rc(tid * 16 + i * 8192, R, C); const int Rb = Epi::PERM ? ((R & ~31) + perm32(R & 31)) : R;
        voffA[i] = (unsigned)(R * g.lda + C) * 2u; voffB[i] = (unsigned)(Rb * K + C) * 2u; }
    const size_t kstep = (size_t)(BK * 2);
    const size_t hstepB = (size_t)HALF * K * 2, hstepA = (size_t)HALF * g.lda * 2;
    const size_t tstepB = 2 * hstepB, tstepA = 2 * hstepA;
    const unsigned ldsw = (unsigned)wid * 1024u;
    const int aoff = lds_byte(wr * 64 + fr, fq * 8), boff = lds_byte(wc * 32 + fr, fq * 8);
#define PG8_SA(b, h) (((b) * 2 + (h)) * HTB)
#define PG8_SB(b, h) ((4 + (b) * 2 + (h)) * HTB)
#define PG8_STAGE(bufoff, gbase, voff) do { _Pragma("unroll") for (int _i = 0; _i < 2; ++_i) \
        __builtin_amdgcn_global_load_lds((const unsigned*)((const char*)(gbase) + (voff)[_i]), (PG8_LAS unsigned*)(lds + (bufoff) + ldsw + _i * 8192), 16, 0, 0); } while (0)
#define PG8_LDA(dst, b, h) do { _Pragma("unroll") for (int m = 0; m < 4; ++m) _Pragma("unroll") for (int k = 0; k < 2; ++k) dst[m][k] = *(const PG8_LAS bf16x8*)(lds + PG8_SA(b, h) + aoff + m * 2048 + k * 1024); } while (0)
#define PG8_LDB(dst, b, h) do { _Pragma("unroll") for (int n = 0; n < 2; ++n) _Pragma("unroll") for (int k = 0; k < 2; ++k) dst[n][k] = *(const PG8_LAS bf16x8*)(lds + PG8_SB(b, h) + boff + n * 2048 + k * 1024); } while (0)
#define PG8_MMA(ai, bj, At, Bt) do { __builtin_amdgcn_s_setprio(1); _Pragma("unroll") for (int m = 0; m < 4; ++m) _Pragma("unroll") for (int n = 0; n < 2; ++n) _Pragma("unroll") for (int k = 0; k < 2; ++k) \
        acc[ai][bj][m][n] = __builtin_amdgcn_mfma_f32_16x16x32_bf16(Bt[n][k], At[m][k], acc[ai][bj][m][n], 0, 0, 0); __builtin_amdgcn_s_setprio(0); } while (0)
#define PG8_WAIT_V(n) asm volatile("s_waitcnt vmcnt(" #n ")" ::: "memory")
#define PG8_WAIT_L(n) asm volatile("s_waitcnt lgkmcnt(" #n ")" ::: "memory")
#define PG8_BAR __builtin_amdgcn_s_barrier()
#define PG8_SCHED __builtin_amdgcn_sched_barrier(0)
    Unit cur, nxt; int ui = 0;
    if (!S.next(0, cur)) return;
    f32x4 acc[2][2][4][2];
#pragma unroll
    for (int a = 0; a < 2; ++a)
#pragma unroll
        for (int b = 0; b < 2; ++b)
#pragma unroll
            for (int m = 0; m < 4; ++m)
#pragma unroll
                for (int n = 0; n < 2; ++n) acc[a][b][m][n] = (f32x4){0.f, 0.f, 0.f, 0.f};
    bf16x8 At[4][2], B0[2][2], B1[2][2];
    const char* cA = (const char*)g.A + (size_t)cur.pm * tstepA; const char* cB = (const char*)g.Bt + (size_t)cur.pn * tstepB;
    S.a_ready(cur);
    if constexpr (SP2) {
        PG8_STAGE(PG8_SB(0, 0), cB, voffB); PG8_STAGE(PG8_SB(0, 1), cB + hstepB, voffB); PG8_STAGE(PG8_SA(0, 0), cA, voffA); PG8_STAGE(PG8_SA(0, 1), cA + hstepA, voffA);
        if (wr == 1) PG8_BAR;
        PG8_WAIT_V(2); PG8_BAR;
        PG8_STAGE(PG8_SB(1, 0), cB + kstep, voffB); PG8_STAGE(PG8_SA(1, 0), cA + kstep, voffA); PG8_STAGE(PG8_SB(1, 1), cB + hstepB + kstep, voffB);
        PG8_WAIT_V(6); PG8_BAR;
    } else {
        PG8_STAGE(PG8_SB(0, 0), cB, voffB); PG8_STAGE(PG8_SA(0, 0), cA, voffA); PG8_STAGE(PG8_SB(0, 1), cB + hstepB, voffB); PG8_STAGE(PG8_SA(0, 1), cA + hstepA, voffA);
        if (wr == 1) PG8_BAR;
        PG8_WAIT_V(4); PG8_BAR;
        PG8_STAGE(PG8_SB(1, 0), cB + kstep, voffB); PG8_STAGE(PG8_SA(1, 0), cA + kstep, voffA); PG8_STAGE(PG8_SB(1, 1), cB + hstepB + kstep, voffB);
        PG8_WAIT_V(6); PG8_BAR;
    }
    for (;;) {
        const bool has_next = S.next(ui + 1, nxt);
        const char* nA = has_next ? (const char*)g.A + (size_t)nxt.pm * tstepA : cA; const char* nB = has_next ? (const char*)g.Bt + (size_t)nxt.pn * tstepB : cB;
        for (int t = 0; t < nt; t += 2) {
            const bool last = (t == nt - 2);
            const char* a1 = cA + (size_t)(t + 1) * kstep;
            const char* a2 = last ? nA : cA + (size_t)(t + 2) * kstep; const char* b2 = last ? nB : cB + (size_t)(t + 2) * kstep;
            const char* a3 = a2 + kstep; const char* b3 = b2 + kstep;
            if (last && has_next) S.a_ready(nxt);
            if constexpr (SP2) {
            PG8_LDB(B0, 0, 0); PG8_LDB(B1, 0, 1); PG8_SCHED; PG8_LDA(At, 0, 0); PG8_STAGE(PG8_SA(1, 1), a1 + hstepA, voffA);
            PG8_WAIT_V(8); PG8_WAIT_L(0); PG8_BAR; PG8_MMA(0, 0, At, B0); PG8_MMA(0, 1, At, B1); PG8_BAR; PG8_SCHED;
            PG8_LDA(At, 0, 1); PG8_STAGE(PG8_SB(0, 0), b2, voffB); PG8_STAGE(PG8_SB(0, 1), b2 + hstepB, voffB); PG8_STAGE(PG8_SA(0, 0), a2, voffA);
            PG8_WAIT_V(8); PG8_WAIT_L(0); PG8_BAR; PG8_MMA(1, 0, At, B0); PG8_MMA(1, 1, At, B1); PG8_BAR; PG8_SCHED;
            PG8_LDB(B0, 1, 0); PG8_LDB(B1, 1, 1); PG8_SCHED; PG8_LDA(At, 1, 0); PG8_STAGE(PG8_SA(0, 1), a2 + hstepA, voffA);
            PG8_WAIT_V(8); PG8_WAIT_L(0); PG8_BAR; PG8_MMA(0, 0, At, B0); PG8_MMA(0, 1, At, B1); PG8_BAR; PG8_SCHED;
            PG8_LDA(At, 1, 1); PG8_STAGE(PG8_SB(1, 0), b3, voffB); PG8_STAGE(PG8_SB(1, 1), b3 + hstepB, voffB); PG8_STAGE(PG8_SA(1, 0), a3, voffA);
            PG8_WAIT_V(8); PG8_WAIT_L(0); PG8_BAR; PG8_MMA(1, 0, At, B0); PG8_MMA(1, 1, At, B1); PG8_BAR; PG8_SCHED;
            } else {
            PG8_LDB(B0, 0, 0); PG8_SCHED; PG8_LDA(At, 0, 0); PG8_STAGE(PG8_SA(1, 1), a1 + hstepA, voffA);
            PG8_WAIT_L(8); PG8_BAR; PG8_WAIT_L(0); PG8_MMA(0, 0, At, B0); PG8_BAR; PG8_SCHED;
            PG8_LDB(B1, 0, 1); PG8_STAGE(PG8_SB(0, 0), b2, voffB);
            PG8_BAR; PG8_WAIT_L(0); PG8_MMA(0, 1, At, B1); PG8_BAR;
            PG8_LDA(At, 0, 1); PG8_STAGE(PG8_SA(0, 0), a2, voffA);
            PG8_BAR; PG8_WAIT_L(0); PG8_MMA(1, 0, At, B0); PG8_BAR; PG8_SCHED;
            PG8_STAGE(PG8_SB(0, 1), b2 + hstepB, voffB);
            PG8_WAIT_V(6); PG8_BAR; PG8_MMA(1, 1, At, B1); PG8_BAR;
            PG8_LDB(B0, 1, 0); PG8_SCHED; PG8_LDA(At, 1, 0); PG8_STAGE(PG8_SA(0, 1), a2 + hstepA, voffA);
            PG8_WAIT_L(8); PG8_BAR; PG8_WAIT_L(0); PG8_MMA(0, 0, At, B0); PG8_BAR; PG8_SCHED;
            PG8_LDB(B1, 1, 1); PG8_STAGE(PG8_SB(1, 0), b3, voffB);
            PG8_BAR; PG8_WAIT_L(0); PG8_MMA(0, 1, At, B1); PG8_BAR;
            PG8_LDA(At, 1, 1); PG8_STAGE(PG8_SA(1, 0), a3, voffA);
            PG8_BAR; PG8_WAIT_L(0); PG8_MMA(1, 0, At, B0); PG8_BAR; PG8_SCHED;
            PG8_STAGE(PG8_SB(1, 1), b3 + hstepB, voffB);
            PG8_WAIT_V(6); PG8_BAR; PG8_MMA(1, 1, At, B1); PG8_BAR;
            }
        }
        if constexpr (ALIGN_EPI) { if (wr == 0) PG8_BAR; }
        if constexpr (!Epi::AFTER_DRAIN) { E(acc, cur, wr, wc, fr, fq); S.done(cur); }
        if (!has_next) break;
#pragma unroll
        for (int a = 0; a < 2; ++a)
#pragma unroll
            for (int b = 0; b < 2; ++b)
#pragma unroll
                for (int m = 0; m < 4; ++m)
#pragma unroll
                    for (int n = 0; n < 2; ++n) acc[a][b][m][n] = (f32x4){0.f, 0.f, 0.f, 0.f};
        cur = nxt; cA = nA; cB = nB; ++ui;
        if constexpr (ALIGN_EPI) { if (wr == 1) PG8_BAR; }
    }
    PG8_WAIT_V(0);
    if constexpr (!ALIGN_EPI) { if (wr == 0) PG8_BAR; }
    PG8_BAR;
    if constexpr (Epi::AFTER_DRAIN) { E.fused(acc, cur, wr, wc, fr, fq, lds, wid, lane); S.done(cur); }
#undef PG8_SA
#undef PG8_SB
#undef PG8_STAGE
#undef PG8_LDA
#undef PG8_LDB
#undef PG8_MMA
#undef PG8_WAIT_V
#undef PG8_WAIT_L
#undef PG8_BAR
#undef PG8_SCHED
}
}
namespace pg8 {
typedef unsigned u32x2 __attribute__((ext_vector_type(2)));
__device__ __forceinline__ float bf_lo(unsigned w) { return __uint_as_float(w << 16); }
__device__ __forceinline__ float bf_hi(unsigned w) { return __uint_as_float(w & 0xffff0000u); }
__device__ __forceinline__ float sigmoidf_(float x) { return __builtin_amdgcn_rcpf(1.0f + __expf(-x)); }

struct EpiSwiGLU {
    static constexpr bool PERM = false, AFTER_DRAIN = false;
    bf16_t* H; int ldh;
    __device__ __forceinline__ void operator()(const f32x4 (&acc)[2][2][4][2], const Unit& u, int wr, int wc, int fr, int fq) const {
        const int row0 = u.pm * BM + wr * 64 + fr, hc0 = u.pn * 128 + wc * 16 + 4 * fq;
#pragma unroll
        for (int ai = 0; ai < 2; ++ai)
#pragma unroll
            for (int m = 0; m < 4; ++m) { bf16_t* rowp = H + (size_t)(row0 + ai * HALF + m * 16) * ldh + hc0;
#pragma unroll
                for (int bj = 0; bj < 2; ++bj) { const f32x4 g = acc[ai][bj][m][0], up = acc[ai][bj][m][1]; float h[4];
#pragma unroll
                    for (int e = 0; e < 4; ++e) h[e] = g[e] * sigmoidf_(g[e]) * up[e];
                    u32x2 w; w.x = cvt_pk_bf16(h[0], h[1]); w.y = cvt_pk_bf16(h[2], h[3]);
                    *(u32x2*)(rowp + bj * 64) = w; } }
    }
};
template <int ACT> struct EpiStore {
    static constexpr bool PERM = true, AFTER_DRAIN = false;
    bf16_t* O0; int ld0; bf16_t* O1; int ld1; int split_tiles;
    __device__ __forceinline__ void operator()(const f32x4 (&acc)[2][2][4][2], const Unit& u, int wr, int wc, int fr, int fq) const {
        const int row0 = u.pm * BM + wr * 64 + fr;
        bf16_t* base; int ld, colt;
        if (u.pn < split_tiles) { base = O0; ld = ld0; colt = u.pn * BM; } else { base = O1; ld = ld1; colt = (u.pn - split_tiles) * BM; }
        const int col0 = colt + wc * 32 + 8 * fq;
#pragma unroll
        for (int ai = 0; ai < 2; ++ai)
#pragma unroll
            for (int m = 0; m < 4; ++m) { bf16_t* rowp = base + (size_t)(row0 + ai * HALF + m * 16) * ld + col0;
#pragma unroll
                for (int bj = 0; bj < 2; ++bj) { f32x4 v0 = acc[ai][bj][m][0], v1 = acc[ai][bj][m][1];
                    if (ACT == 1) {
#pragma unroll
                        for (int e = 0; e < 4; ++e) { v0[e] = sigmoidf_(v0[e]); v1[e] = sigmoidf_(v1[e]); } }
                    u32x4 w; w.x = cvt_pk_bf16(v0[0], v0[1]); w.y = cvt_pk_bf16(v0[2], v0[3]); w.z = cvt_pk_bf16(v1[0], v1[1]); w.w = cvt_pk_bf16(v1[2], v1[3]);
                    *(u32x4*)(rowp + bj * HALF) = w; } }
    }
};
#ifdef GATE_RAW
#define GSIG(x) sigmoidf_(x)
#else
#define GSIG(x) (x)
#endif
struct EpiGateMul {
    static constexpr bool PERM = true, AFTER_DRAIN = false;
    bf16_t* MG; int ldm; const bf16_t* G; int ldg; int first;
    __device__ __forceinline__ void operator()(const f32x4 (&acc)[2][2][4][2], const Unit& u, int wr, int wc, int fr, int fq) const {
        const int row0 = u.pm * BM + wr * 64 + fr, col0 = u.pn * BM + wc * 32 + 8 * fq;
#pragma unroll
        for (int ai = 0; ai < 2; ++ai)
#pragma unroll
            for (int m = 0; m < 4; ++m) { const size_t r = (size_t)(row0 + ai * HALF + m * 16);
#pragma unroll
                for (int bj = 0; bj < 2; ++bj) { const f32x4 v0 = acc[ai][bj][m][0], v1 = acc[ai][bj][m][1];
                    const u32x4 g = *(const u32x4*)(G + r * ldg + col0 + bj * HALF);
                    float o[8] = { v0[0] * GSIG(bf_lo(g.x)), v0[1] * GSIG(bf_hi(g.x)), v0[2] * GSIG(bf_lo(g.y)), v0[3] * GSIG(bf_hi(g.y)), v1[0] * GSIG(bf_lo(g.z)), v1[1] * GSIG(bf_hi(g.z)), v1[2] * GSIG(bf_lo(g.w)), v1[3] * GSIG(bf_hi(g.w)) };
                    bf16_t* mp = MG + r * ldm + col0 + bj * HALF;
                    if (!first) { const u32x4 p = *(const u32x4*)mp;
                        o[0] += bf_lo(p.x); o[1] += bf_hi(p.x); o[2] += bf_lo(p.y); o[3] += bf_hi(p.y); o[4] += bf_lo(p.z); o[5] += bf_hi(p.z); o[6] += bf_lo(p.w); o[7] += bf_hi(p.w); }
                    u32x4 w; w.x = cvt_pk_bf16(o[0], o[1]); w.y = cvt_pk_bf16(o[2], o[3]); w.z = cvt_pk_bf16(o[4], o[5]); w.w = cvt_pk_bf16(o[6], o[7]);
                    *(u32x4*)mp = w; } }
    }
};
}
namespace att {
constexpr int D = 128;
constexpr bool WSKIP = false;
constexpr float THR = 8.f;
constexpr int NW = 8, QBLK = 32, KVBLK = 64, QB = NW * QBLK;
constexpr int SHM_V = KVBLK * D * 2, SHM_K = KVBLK * D * 2;
constexpr int LDS_BYTES = 2 * SHM_V + 2 * SHM_K + NW * 64 * 4;
using bf16 = __hip_bfloat16;
typedef short bf16x8 __attribute__((ext_vector_type(8)));
typedef short s16x4 __attribute__((ext_vector_type(4)));
typedef float f32x16 __attribute__((ext_vector_type(16)));
typedef float f32x4 __attribute__((ext_vector_type(4)));
typedef unsigned u32x4 __attribute__((ext_vector_type(4)));
template <class A, class Bt> struct same_t { static constexpr bool v = false; };
template <class A> struct same_t<A, A> { static constexpr bool v = true; };

#define KSWZ(row, colB) ((row) * 256 + ((colB) ^ (((row) & 7) << 4)))
#define SBAR() __builtin_amdgcn_sched_barrier(0)
__device__ __forceinline__ int v_st(int k, int c) { const int kk = (k & ~0xC) | ((k & 4) << 1) | ((k & 8) >> 1); return ((kk >> 3) * 4 + (c >> 5)) * 512 + ((kk & 7) * 32 + (c & 31)) * 2; }
__device__ __forceinline__ int v_rd_base(int lane) { return ((lane & 3) << 3) | (((lane >> 2) & 3) << 6) | (((lane >> 4) & 1) << 5) | (((lane >> 5) & 1) << 8); }
constexpr int v_rd_off(int d0, int ks, int half) { return d0 * 512 + ks * 4096 + half * 2048; }
__device__ __forceinline__ int crow(int r, int hi) { return (r & 3) + 8 * (r >> 2) + 4 * hi; }
__device__ __forceinline__ unsigned cvtpk(float lo, float hi) {
    unsigned r; asm volatile("v_cvt_pk_bf16_f32 %0, %1, %2" : "=v"(r) : "v"(lo), "v"(hi)); return r;
}
__device__ __forceinline__ bf16x8 pack8(f32x4 a, f32x4 b) {
    u32x4 w = {cvtpk(a[0], a[1]), cvtpk(a[2], a[3]), cvtpk(b[0], b[1]), cvtpk(b[2], b[3])};
    return *reinterpret_cast<bf16x8*>(&w);
}
template <class T> __device__ __forceinline__ bf16x8 load8(const T* p) {
    if constexpr (same_t<T, float>::v) { return pack8(*(const f32x4*)p, *(const f32x4*)(p + 4)); }
    else { return *reinterpret_cast<const bf16x8*>(p); }
}
__device__ __forceinline__ void mask_tile(f32x16& p0, f32x16& p1, int dq, unsigned W) {
    const float NEG = -__builtin_inff();
#pragma unroll
    for (int r = 0; r < 16; ++r) {
        const int c = (r & 3) + 8 * (r >> 2);
        if ((unsigned)(dq - c) >= W) p0[r] = NEG;
        if ((unsigned)(dq - c - 32) >= W) p1[r] = NEG;
    }
}
typedef unsigned u32x2 __attribute__((ext_vector_type(2)));
__device__ __forceinline__ void bitmask_tile(f32x16& p0, f32x16& p1, u32x2 w, int hi) {
    const float NEG = -__builtin_inff();
    const unsigned a = w[0] >> (4 * hi), b = w[1] >> (4 * hi);
#pragma unroll
    for (int r = 0; r < 16; ++r) {
        const int c = (r & 3) + 8 * (r >> 2);
        if (!((a >> c) & 1u)) p0[r] = NEG;
        if (!((b >> c) & 1u)) p1[r] = NEG;
    }
}
template <bool HALFQK> __device__ __forceinline__ void partialSM(f32x16& p0, f32x16& p1, float& m_reg, float& mn, float& alpha) {
    constexpr float SCALE = HALFQK ? 0.125f : 0.08838834764831845f;
    float pmax = p0[0]; for (int r = 1; r < 16; ++r) pmax = fmaxf(pmax, p0[r]); for (int r = 0; r < 16; ++r) pmax = fmaxf(pmax, p1[r]);
    { auto rr = __builtin_amdgcn_permlane32_swap(__float_as_uint(pmax), __float_as_uint(pmax), false, false);
      pmax = fmaxf(__uint_as_float(rr[0]), __uint_as_float(rr[1])); }
    constexpr float C2 = 1.4426950408889634f * SCALE;
    if (__builtin_expect(__all((pmax - m_reg) * SCALE <= THR), 1)) { mn = m_reg; alpha = 1.f; }
    else { mn = fmaxf(m_reg, pmax); alpha = __builtin_amdgcn_exp2f((m_reg - mn) * C2); m_reg = mn; }
    const float mnL = -mn * C2;
    for (int r = 0; r < 16; ++r) p0[r] = fmaf(p0[r], C2, mnL); for (int r = 0; r < 16; ++r) p1[r] = fmaf(p1[r], C2, mnL);
    for (int r = 0; r < 16; ++r) p0[r] = __builtin_amdgcn_exp2f(p0[r]);
}
__device__ __forceinline__ void finishSM(f32x16& p0, f32x16& p1, float alpha, float& l_reg, bf16x8& pa0, bf16x8& pa1, bf16x8& pa2, bf16x8& pa3) {
    for (int r = 0; r < 16; ++r) p1[r] = __builtin_amdgcn_exp2f(p1[r]);
    float ps = 0; for (int r = 0; r < 16; ++r) ps += p0[r]; for (int r = 0; r < 16; ++r) ps += p1[r];
    { auto rr = __builtin_amdgcn_permlane32_swap(__float_as_uint(ps), __float_as_uint(ps), false, false);
      ps = __uint_as_float(rr[0]) + __uint_as_float(rr[1]); }
    l_reg = l_reg * alpha + ps;
#define PK4(P, B_, OUT) do { unsigned a0 = cvtpk(P[B_+0], P[B_+1]), a1 = cvtpk(P[B_+2], P[B_+3]);                          \
        unsigned b0 = cvtpk(P[B_+4], P[B_+5]), b1 = cvtpk(P[B_+6], P[B_+7]);                                             \
        auto r0 = __builtin_amdgcn_permlane32_swap(a0, b0, false, false); auto r1 = __builtin_amdgcn_permlane32_swap(a1, b1, false, false); \
        u32x4 w = {r0[0], r1[0], r0[1], r1[1]}; OUT = *reinterpret_cast<bf16x8*>(&w); } while (0)
    PK4(p0, 0, pa0); PK4(p0, 8, pa1); PK4(p1, 0, pa2); PK4(p1, 8, pa3);
#undef PK4
}
template <int KB, bool SK, bool HALFQK>
__device__ __forceinline__ void qkt(f32x16& p0, f32x16& p1, const char* K_lds, int r32, int hi, const bf16x8* qr, bool act, int koff) {
    if (SK && !act) { const float NEG = -__builtin_inff();
#pragma unroll
        for (int r = 0; r < 16; ++r) { p0[r] = NEG; p1[r] = NEG; } return; }
    p0 = f32x16{}; p1 = f32x16{};
    const char* kb[4];
#pragma unroll
    for (int dd = 0; dd < 4; ++dd) kb[dd] = K_lds + KB * SHM_K + KSWZ(r32, (dd * 16 + hi * 8) * 2) + koff;
#pragma unroll
    for (int d0 = 0; d0 < (HALFQK ? 4 : 8); ++d0) { const char* a = kb[d0 & 3] + (d0 >> 2) * 128;
        bf16x8 b0 = *reinterpret_cast<const bf16x8*>(a);
        bf16x8 b1 = *reinterpret_cast<const bf16x8*>(a + 32 * 256);
        p0 = __builtin_amdgcn_mfma_f32_32x32x16_bf16(b0, qr[d0], p0, 0, 0, 0);
        p1 = __builtin_amdgcn_mfma_f32_32x32x16_bf16(b1, qr[d0], p1, 0, 0, 0); }
}
template <int VB, bool SK>
__device__ __forceinline__ void pv_tile(f32x16* o, int vb0, bf16x8 pa0, bf16x8 pa1, bf16x8 pa2, bf16x8 pa3, bool act) {
    if (SK && !act) return;
#define TRRD(dst, off) asm volatile("ds_read_b64_tr_b16 %0, %1 offset:%2" : "=&v"(dst) : "v"(vb0), "i"(off) : "memory")
#define PV_D0(d0) do { s16x4 l0, l1, l2, l3, h0, h1, h2, h3; constexpr int b_ = VB * SHM_V + v_rd_off(d0, 0, 0);     \
        TRRD(l0, b_); TRRD(h0, b_ + 2048); TRRD(l1, b_ + 4096); TRRD(h1, b_ + 6144); TRRD(l2, b_ + 8192); TRRD(h2, b_ + 10240); TRRD(l3, b_ + 12288); TRRD(h3, b_ + 14336); \
        asm volatile("s_waitcnt lgkmcnt(0)" ::: "memory"); SBAR();                 \
        o[d0] = __builtin_amdgcn_mfma_f32_32x32x16_bf16(pa0, (bf16x8){l0[0], l0[1], l0[2], l0[3], h0[0], h0[1], h0[2], h0[3]}, o[d0], 0, 0, 0);   \
        o[d0] = __builtin_amdgcn_mfma_f32_32x32x16_bf16(pa1, (bf16x8){l1[0], l1[1], l1[2], l1[3], h1[0], h1[1], h1[2], h1[3]}, o[d0], 0, 0, 0);   \
        o[d0] = __builtin_amdgcn_mfma_f32_32x32x16_bf16(pa2, (bf16x8){l2[0], l2[1], l2[2], l2[3], h2[0], h2[1], h2[2], h2[3]}, o[d0], 0, 0, 0);   \
        o[d0] = __builtin_amdgcn_mfma_f32_32x32x16_bf16(pa3, (bf16x8){l3[0], l3[1], l3[2], l3[3], h3[0], h3[1], h3[2], h3[3]}, o[d0], 0, 0, 0); } while (0)
    PV_D0(0); PV_D0(1); PV_D0(2); PV_D0(3);
#undef PV_D0
#undef TRRD
}

constexpr int QS = 1536, KVS = 4096;
template <class TIn, class TOut> struct BlockRef { const TIn* Q; const TIn* K; const TIn* V; TOut* O; int P0; int koff; const unsigned* mask; };
template <class TIn> struct Seam {
    bf16x8 qr[8];
    bf16x8 st_v0, st_v1, st_k0, st_k1; f32x4 sf0, sf1, sf2, sf3;
    f32x4 tq[16];
};
__device__ __forceinline__ int swa_jlo(int P0, int W) { const int lowk = P0 - W + 1; return lowk > 0 ? lowk / KVBLK : 0; }
#define ROW(p, k0, rr) ((p) + (size_t)((k0) + (rr)) * KVS + sc)
#define VMW() asm volatile("s_waitcnt vmcnt(0)" ::: "memory")
#define VMWN(n) asm volatile("s_waitcnt vmcnt(%0)" :: "i"(n) : "memory")
#define SLOAD_H(Kp, Vp, k0) do { S.st_v0 = load8<TIn>(ROW(Vp, k0, sr)); S.st_v1 = load8<TIn>(ROW(Vp, k0, 32 + sr));              \
                         S.st_k0 = load8<TIn>(ROW(Kp, k0, sr)); S.st_k1 = load8<TIn>(ROW(Kp, k0, 32 + sr)); } while (0)
#define SWRITE_HK(bf) do { *(bf16x8*)(K_lds + (bf) * SHM_K + kws) = S.st_k0; *(bf16x8*)(K_lds + (bf) * SHM_K + kws + 32 * 256) = S.st_k1; } while (0)
#define SWRITE_HV(bf) do { *(bf16x8*)(V_lds + (bf) * SHM_V + vst0) = S.st_v0; *(bf16x8*)(V_lds + (bf) * SHM_V + vst1) = S.st_v1; } while (0)
#define SWRITE_H(bf) do { SWRITE_HV(bf); SWRITE_HK(bf); } while (0)
#define SLOAD_F(p, k0) do { S.sf0 = *(const f32x4*)ROW(p, k0, sr); S.sf1 = *(const f32x4*)(ROW(p, k0, sr) + 4);                \
                            S.sf2 = *(const f32x4*)ROW(p, k0, 32 + sr); S.sf3 = *(const f32x4*)(ROW(p, k0, 32 + sr) + 4); } while (0)
#define SWRITE_KF(bf) do { *(bf16x8*)(K_lds + (bf) * SHM_K + kws) = pack8(S.sf0, S.sf1); *(bf16x8*)(K_lds + (bf) * SHM_K + kws + 32 * 256) = pack8(S.sf2, S.sf3); } while (0)
#define SWRITE_VF(bf) do { *(bf16x8*)(V_lds + (bf) * SHM_V + vst0) = pack8(S.sf0, S.sf1); *(bf16x8*)(V_lds + (bf) * SHM_V + vst1) = pack8(S.sf2, S.sf3); } while (0)
template <class TIn, class TOut, bool HALFQK>
__device__ __forceinline__ void causal_swa_prime(const BlockRef<TIn, TOut>& cur, int W, char* lds, Seam<TIn>& S) {
    constexpr bool F32 = same_t<TIn, float>::v;
    const int tid = otid_(), wid = __builtin_amdgcn_readfirstlane(tid >> 6), lane = tid & 63, r32 = lane & 31, hi = lane >> 5;
    const int sr = tid >> 4, sc = (tid & 15) * 8, kws = KSWZ(sr, sc * 2); char* K_lds = lds + 2 * SHM_V;
    const int kb0 = swa_jlo(cur.P0, W) * KVBLK;
    for (int d0 = 0; d0 < (HALFQK ? 4 : 8); ++d0) S.qr[d0] = load8<TIn>(cur.Q + (size_t)(wid * QBLK + r32) * QS + d0 * 16 + hi * 8);
    if constexpr (F32) { SLOAD_F((const float*)cur.K, kb0); VMW(); SWRITE_KF(0); SBAR(); SLOAD_F((const float*)cur.V, kb0); }
    else { SLOAD_H(cur.K, cur.V, kb0); VMW(); SWRITE_HK(0); }
    __syncthreads();
}
template <class TIn, class TOut, bool HALFQK, bool MASKED, int OS>
__device__ __forceinline__ void causal_swa_block(const BlockRef<TIn, TOut>& cur, const BlockRef<TIn, TOut>& nxt, int skv, int W, char* lds, Seam<TIn>& S) {
    constexpr bool F32 = same_t<TIn, float>::v;
    const int tid = otid_(), wid = __builtin_amdgcn_readfirstlane(tid >> 6), lane = tid & 63, r32 = lane & 31, hi = lane >> 5;
    const int j_lo = swa_jlo(cur.P0, W);
    int j_hi = (cur.P0 + QB - 1) / KVBLK + 1; if (j_hi > skv / KVBLK) j_hi = skv / KVBLK;
    const int NT = j_hi - j_lo;
    const int kbn = swa_jlo(nxt.P0, W) * KVBLK;
    const int qlo = cur.P0 + wid * QBLK, qm = qlo + r32 - 4 * hi;
    char* V_lds = lds; char* K_lds = lds + 2 * SHM_V;
    float* ws = (float*)(lds + 2 * SHM_V + 2 * SHM_K) + wid * 64; float* li_l = ws, * al_l = ws + 32;
    float m_reg = -1e30f, l_reg = 0; f32x16 o[4] = {};
    const int sr = tid >> 4, sc = (tid & 15) * 8, vst0 = v_st(sr, sc), vst1 = v_st(32 + sr, sc), kws = KSWZ(sr, sc * 2);
    const int vb0 = (int)(uintptr_t)V_lds + v_rd_base(lane);
    const TIn* Kh = cur.K; const TIn* Vh = cur.V;
#define RESC(a) do { if (__any((a) < 1.f)) { if (hi == 0) al_l[r32] = (a); asm volatile("s_waitcnt lgkmcnt(0)" ::: "memory");              \
                     for (int d_ = 0; d_ < 4; ++d_) for (int r = 0; r < 16; ++r) o[d_][r] *= al_l[crow(r, hi)]; } } while (0)
#define KBASE(t) ((j_lo + (t)) * KVBLK)
#define ACT(t) (KBASE(t) <= qlo + QBLK - 1 && KBASE(t) + KVBLK - 1 >= qlo - W + 1)
#define MASKT(P0_, P1_, t) do { if constexpr (MASKED) bitmask_tile(P0_, P1_, mw, hi);   \
        else { const int kb_ = KBASE(t); if ((!SK || ACT(t)) && (kb_ + KVBLK - 1 > qlo || kb_ <= qlo + QBLK - 1 - W)) mask_tile(P0_, P1_, qm - kb_, (unsigned)W); } } while (0)
    const unsigned moff = (unsigned)((wid * QBLK + r32) * 1024 + 8 * j_lo); u32x2 mw = {0u, 0u};
#define MLOAD(t) do { if constexpr (MASKED) mw = *(const u32x2*)((const char*)cur.mask + (moff + 8u * (unsigned)(t))); } while (0)
    constexpr int NQL = F32 ? 16 : (HALFQK ? 4 : 8);
    constexpr bool SK = WSKIP && !F32;
#define SEAM_K0() do { VMWN(NQL); if constexpr (F32) { SWRITE_KF(0); SBAR(); SLOAD_F((const float*)nxt.V, kbn); } else { SWRITE_HK(0); } SBAR(); } while (0)
    f32x16 pA0, pA1, pB0, pB1; float mnA, mnB, alA, alB; bf16x8 pa0, pa1, pa2, pa3;
    if constexpr (F32) { VMW(); SWRITE_VF(0); SBAR(); } else { SWRITE_HV(0); SBAR(); }
    if (NT > 1) { if constexpr (F32) SLOAD_F((const float*)Kh, KBASE(1)); else SLOAD_H(Kh, Vh, KBASE(1)); }
    SBAR(); qkt<0, SK, HALFQK>(pA0, pA1, K_lds, r32, hi, S.qr, ACT(0), cur.koff); MLOAD(0);
    if constexpr (F32) { if (NT > 1) { VMW(); SWRITE_KF(1); SBAR(); SLOAD_F((const float*)Vh, KBASE(1)); } }
    MASKT(pA0, pA1, 0); partialSM<HALFQK>(pA0, pA1, m_reg, mnA, alA);
    if (NT > 1) { VMW(); if constexpr (F32) { SWRITE_VF(1); SBAR(); if (NT > 2) SLOAD_F((const float*)Kh, KBASE(2)); } else SWRITE_H(1); }
    __syncthreads();
#define HALF_STEP(PX0, PX1, mnX, alX, PY0, PY1, alY, t, KB, VB, SB) do {                                                      \
        SBAR(); qkt<KB, SK, HALFQK>(PX0, PX1, K_lds, r32, hi, S.qr, ACT(t), cur.koff); MLOAD(t);                                             \
        finishSM(PY0, PY1, alY, l_reg, pa0, pa1, pa2, pa3); SBAR();                                                           \
        if ((t) + 1 < NT) { if constexpr (F32) { VMW(); SWRITE_KF(SB); SBAR(); SLOAD_F((const float*)Vh, KBASE((t) + 1)); }  \
                            else { SLOAD_H(Kh, Vh, KBASE((t) + 1)); } SBAR(); }                                               \
        pv_tile<VB, SK>(o, vb0, pa0, pa1, pa2, pa3, ACT((t) - 1)); MASKT(PX0, PX1, (t)); partialSM<HALFQK>(PX0, PX1, m_reg, mnX, alX);                                        \
        __syncthreads();                                                                                                      \
        if ((t) + 1 < NT) { VMW(); if constexpr (F32) { SWRITE_VF(SB); SBAR(); if ((t) + 2 < NT) SLOAD_F((const float*)Kh, KBASE((t) + 2)); } \
                            else { SWRITE_H(SB); } }                                                                          \
        RESC(alX); __syncthreads(); } while (0)
    for (int t = 1; t + 1 < NT; t += 2) {
        HALF_STEP(pB0, pB1, mnB, alB, pA0, pA1, alA, t, 1, 0, 0);
        HALF_STEP(pA0, pA1, mnA, alA, pB0, pB1, alB, t + 1, 0, 1, 1);
    }
    const bool even = (NT & 1) == 0;
    if (even) { SBAR(); qkt<1, SK, HALFQK>(pB0, pB1, K_lds, r32, hi, S.qr, ACT(NT - 1), cur.koff); MLOAD(NT - 1); SBAR(); }
#define QROW(e) (nxt.Q + (size_t)(wid * QBLK + r32) * QS + ((e) >> 1) * 16 + hi * 8 + ((e) & 1) * 4)
    if constexpr (F32) { SLOAD_F((const float*)nxt.K, kbn); SBAR();
#pragma unroll
        for (int e = 0; e < 8; ++e) S.tq[e] = *(const f32x4*)QROW(e); }
    else { SLOAD_H(nxt.K, nxt.V, kbn); SBAR();
#pragma unroll
        for (int d0 = 0; d0 < (HALFQK ? 4 : 8); ++d0) S.qr[d0] = load8<TIn>(nxt.Q + (size_t)(wid * QBLK + r32) * QS + d0 * 16 + hi * 8); }
    SBAR();
    finishSM(pA0, pA1, alA, l_reg, pa0, pa1, pa2, pa3); SBAR();
    if constexpr (F32) {
#pragma unroll
        for (int e = 8; e < 16; ++e) S.tq[e] = *(const f32x4*)QROW(e); SBAR(); }
#undef QROW
    pv_tile<0, SK>(o, vb0, pa0, pa1, pa2, pa3, ACT(even ? NT - 2 : NT - 1));
    if (even) { MASKT(pB0, pB1, NT - 1); partialSM<HALFQK>(pB0, pB1, m_reg, mnB, alB); __syncthreads(); RESC(alB);
        finishSM(pB0, pB1, alB, l_reg, pa0, pa1, pa2, pa3); SBAR(); pv_tile<1, SK>(o, vb0, pa0, pa1, pa2, pa3, ACT(NT - 1)); }
    SBAR(); SEAM_K0();
    if (hi == 0) li_l[r32] = l_reg; asm volatile("s_waitcnt lgkmcnt(0)" ::: "memory");
    float rli[16];
#pragma unroll
    for (int r = 0; r < 16; ++r) rli[r] = __builtin_amdgcn_rcpf(li_l[crow(r, hi)]);
    TOut* Ow = cur.O + (size_t)(wid * QBLK) * OS;
#pragma unroll
    for (int r = 0; r < 16; ++r) { const int orow = crow(r, hi);
#pragma unroll
        for (int d0 = 0; d0 < 4; ++d0) { const float v = o[d0][r] * rli[r];
            if constexpr (same_t<TOut, float>::v) { Ow[(size_t)orow * OS + d0 * 32 + r32] = v; }
            else { const float vn = __shfl_xor(v, 1);
                   if ((r32 & 1) == 0) *(unsigned*)(Ow + (size_t)orow * OS + d0 * 32 + r32) = cvtpk(v, vn); } } }
    if constexpr (F32) {
#pragma unroll
        for (int d0 = 0; d0 < 8; ++d0) S.qr[d0] = pack8(S.tq[2 * d0], S.tq[2 * d0 + 1]); }
    __syncthreads();
#undef RESC
#undef KBASE
#undef ACT
#undef MASKT
#undef MLOAD
#undef SEAM_K0
#undef HALF_STEP
}
#undef ROW
#undef VMW
#undef VMWN
#undef SLOAD_H
#undef SWRITE_HK
#undef SWRITE_HV
#undef SWRITE_H
#undef SLOAD_F
#undef SWRITE_KF
#undef SWRITE_VF
}
#ifndef PROBE
#define PROBE 0
#endif
constexpr int NWAVES = 8;
constexpr int NB = 2, T = 8192, M = NB * T, DM = 1024, FF = 2816, NIN = 8520, NLAYER = 2;
constexpr float NORM_EPS = 1e-6f;
constexpr size_t MiB = 1u << 20;
constexpr size_t WS_CTL = 0, CTL_ZERO_BYTES = 1 * MiB;
constexpr size_t WS_WF = 1 * MiB;
constexpr size_t WS_WF_DOWN = WS_WF + 11 * MiB;
constexpr size_t WS_WM = 18 * MiB;
constexpr size_t WS_WM_BR = WS_WM + 17 * MiB, WS_WM_OUT = WS_WM + 20 * MiB;
constexpr size_t WS_XN = 40 * MiB;
constexpr size_t WS_Q3 = 72 * MiB;
constexpr size_t WS_ZR = 120 * MiB;
constexpr size_t WS_R2 = 248 * MiB;
constexpr size_t WS_END = 280 * MiB;
constexpr size_t WS_MG = WS_ZR + 96 * MiB;
constexpr size_t WS_YRAW = WS_WF;
constexpr size_t WS_A8 = WS_WM;
constexpr size_t WS_KID = WS_WM + 8 * MiB;
constexpr size_t WS_RDOTK = WS_WF + 16 * MiB;
constexpr int QP = 1536, ZP = 4096;
constexpr int ZC_DK = 0, ZC_DV = 512, ZC_QI = 1024, ZC_KI = 1536, ZC_WI = 1600, ZC_RK = 1792, ZC_RV = 2304, ZC_WC = 2816, ZC_AC = 2880, ZC_GC = 2944, ZC_FK = 3072, ZC_FV = 3584;
constexpr int CW_TMO = 0;
constexpr int CW_BAR = 4096;
constexpr int CW_Q = 8192;
constexpr int CW_PROBE = 2048;
constexpr int CW_DONE = 12288;
constexpr int LDS_MISC = 160 * 1024 - 256;
constexpr int LDS_BYTES = 160 * 1024;

#define GAS __attribute__((address_space(1)))
#define LAS __attribute__((address_space(3)))
typedef unsigned short bf16;
typedef unsigned v4u __attribute__((ext_vector_type(4)));
typedef unsigned v2u __attribute__((ext_vector_type(2)));
typedef float f32x4 __attribute__((ext_vector_type(4)));
typedef float f32x2 __attribute__((ext_vector_type(2)));
typedef float f32x16 __attribute__((ext_vector_type(16)));
typedef short bf16x8 __attribute__((ext_vector_type(8)));
typedef GAS unsigned gu32;
#define RLX_AGENT __ATOMIC_RELAXED, __HIP_MEMORY_SCOPE_AGENT
#define LDS_WAIT() asm volatile("s_waitcnt lgkmcnt(0)" ::: "memory")
#define VM_WAIT() asm volatile("s_waitcnt vmcnt(0)" ::: "memory")
__device__ __forceinline__ unsigned f2bf(float f) { unsigned u = __builtin_bit_cast(unsigned, f); return (u + 0x7fffu + ((u >> 16) & 1u)) >> 16; }
__device__ __forceinline__ unsigned pk2(float lo, float hi) { return f2bf(lo) | (f2bf(hi) << 16); }
__device__ __forceinline__ float bflo(unsigned w) { return __uint_as_float(w << 16); }
__device__ __forceinline__ float bfhi(unsigned w) { return __uint_as_float(w & 0xffff0000u); }
__device__ __forceinline__ float bf1(bf16 h) { return __uint_as_float((unsigned)h << 16); }
__device__ __forceinline__ float wave_sum(float v) {
#pragma unroll
    for (int o = 1; o < 64; o <<= 1) v += __shfl_xor(v, o);
    return v;
}
__device__ __forceinline__ float sigm(float x) { return __builtin_amdgcn_rcpf(1.0f + __expf(-x)); }

#define XB_TMO      128
#define XB_XCNT(j)  (256  + 64 * (j))
#define XB_XSUB(j)  (1280 + 64 * (j))
#define XB_XGEN(j)  (2304 + 64 * (j))
#define XB_TOP      3328
#define XB_TOPGEN   3392
#define XCD_BAR_WORDS 3456
#define XB_SPIN_CAP (1u << 22)
__device__ __forceinline__ unsigned xb_ld(unsigned* p)              { return __hip_atomic_load(p, __ATOMIC_RELAXED, __HIP_MEMORY_SCOPE_AGENT); }
__device__ __forceinline__ unsigned xb_add(unsigned* p, unsigned v) { return __hip_atomic_fetch_add(p, v, __ATOMIC_RELAXED, __HIP_MEMORY_SCOPE_AGENT); }
__device__ __forceinline__ unsigned xb_xcc_id() { return (unsigned)__builtin_amdgcn_s_getreg((3 << 11) | 20) & 0xFu; }
#define XB_SPIN(cond, bar) do { unsigned _sp = 0; while (cond) { __builtin_amdgcn_s_sleep(1); \
    if ((++_sp & 255u) == 0u) { if (xb_ld(&(bar)[XB_TMO])) break; if (_sp > XB_SPIN_CAP) { atomicAdd(&(bar)[XB_TMO], 1u); break; } } } } while (0)
struct XcdBarrier { unsigned* bar; unsigned x; volatile LAS unsigned* st; };
__device__ __forceinline__ XcdBarrier xcd_barrier_post(unsigned* bar, volatile LAS unsigned* st) {
    XcdBarrier b; b.bar = bar; b.x = xb_xcc_id(); b.st = st;
    if (threadIdx.x == 0) (void)xb_add(&bar[XB_XCNT(b.x)], 1u);
    return b;
}
__device__ __forceinline__ void xcd_barrier_complete(unsigned* bar, unsigned x, unsigned& nloc, unsigned& nx) {
    const unsigned G = gridDim.x * gridDim.y * gridDim.z;
    unsigned sum, cnt, mine, sp = 0u;
    for (;;) {
        sum = 0u; cnt = 0u; mine = 0u;
#pragma unroll
        for (unsigned j = 0; j < 16; ++j) { const unsigned c = xb_ld(&bar[XB_XCNT(j)]); sum += c; cnt += (c > 0u) ? 1u : 0u; mine = (j == x) ? c : mine; }
        if (sum == G) break;
        __builtin_amdgcn_s_sleep(1);
        if ((++sp & 255u) == 0u) { if (xb_ld(&bar[XB_TMO])) break; if (sp > XB_SPIN_CAP) { atomicAdd(&bar[XB_TMO], 1u); break; } }
    }
    nloc = mine > 0u ? mine : 1u; nx = cnt > 0u ? cnt : 1u;
}
__device__ __forceinline__ void xcd_barrier(const XcdBarrier& b) {
    asm volatile("s_waitcnt vmcnt(0)" ::: "memory");
    __syncthreads();
    if (threadIdx.x == 0) {
        unsigned* bar = b.bar;
        __builtin_amdgcn_s_waitcnt(0);
        unsigned nloc = b.st[0], nx = b.st[1];
        if (nloc == 0u) { xcd_barrier_complete(bar, b.x, nloc, nx); b.st[0] = nloc; b.st[1] = nx; }
        const unsigned old = xb_add(&bar[XB_XSUB(b.x)], 1u);
        const unsigned gen = old / nloc;
        if (old + 1u == (gen + 1u) * nloc) {
            __builtin_amdgcn_fence(__ATOMIC_RELEASE, "agent");
            asm volatile("s_waitcnt vmcnt(0)" ::: "memory");
            const unsigned og = xb_add(&bar[XB_TOP], 1u);
            const unsigned tg = og / nx;
            if (og + 1u == (tg + 1u) * nx) xb_add(&bar[XB_TOPGEN], 1u);
            else XB_SPIN(xb_ld(&bar[XB_TOPGEN]) == tg, bar);
            __builtin_amdgcn_fence(__ATOMIC_ACQUIRE, "agent");
            xb_add(&bar[XB_XGEN(b.x)], 1u);
            asm volatile("s_waitcnt vmcnt(0)" ::: "memory");
        } else {
            XB_SPIN(xb_ld(&bar[XB_XGEN(b.x)]) == gen, bar);
            __builtin_amdgcn_fence(__ATOMIC_ACQUIRE, "agent");
            asm volatile("s_waitcnt vmcnt(0)" ::: "memory");
        }
    }
    __syncthreads();
}

struct MapIdent { const float* W; int ld; __device__ __forceinline__ const float* col(int n) const { return W + n; } };
struct MapUp {
    const float* G; const float* U; int ld;
    __device__ __forceinline__ const float* col(int n) const { const int g = n >> 5, j = n & 31; return j < 16 ? G + 16 * g + j : U + 16 * g + (j - 16); }
};
struct MapWin {
    const float* W; int ld;
    __device__ __forceinline__ const float* col(int n) const {
        int src;
        if (n < 512) src = n; else if (n < 1024) src = 2120 + (n - 512); else if (n < 1536) src = 3912 + (n - 1024);
        else if (n < 5632) { const int z = n - 1536; if (z < 1608) src = 512 + z; else if (z < 1792) src = -1; else if (z < 3072) src = 840 + z; else src = 1352 + z; }
        else src = 5448 + (n - 5632);
        return src < 0 ? nullptr : W + src;
    }
};
template <class Map>
__device__ __forceinline__ void conv_item(const Map& mp, int K, bf16* WT, LAS float* scr, int item, int nblk, int lane) {
    const int kb = item / nblk, nb = item % nblk, k0 = 32 * kb, n0 = 32 * nb;
    const float* cp = mp.col(n0 + (lane & 31)); const size_t ld = (size_t)mp.ld;
#pragma unroll
    for (int i = 0; i < 16; ++i) { const int kk = 2 * i + (lane >> 5); scr[kk * 33 + (lane & 31)] = cp ? cp[(size_t)(k0 + kk) * ld] : 0.f; }
    LDS_WAIT(); asm volatile("" ::: "memory");
    const int c = lane & 3;
#pragma unroll
    for (int j = 0; j < 2; ++j) { const int n = (lane >> 2) + 16 * j; const LAS float* s = scr + (8 * c) * 33 + n;
        v4u o; o.x = pg8::cvt_pk_bf16(s[0 * 33], s[1 * 33]); o.y = pg8::cvt_pk_bf16(s[2 * 33], s[3 * 33]); o.z = pg8::cvt_pk_bf16(s[4 * 33], s[5 * 33]); o.w = pg8::cvt_pk_bf16(s[6 * 33], s[7 * 33]);
        *(GAS v4u*)(WT + (size_t)(n0 + n) * K + k0 + 8 * c) = o; }
    LDS_WAIT(); asm volatile("" ::: "memory");
}
__host__ __device__ constexpr int conv_items(int K, int N) { return (K / 32) * (N / 32); }

template <bool INB, bool OUTB>
__device__ __forceinline__ void rownorm_rows(const void* base, const bf16* Y, float s, const float* gpost, void* out, const float* gnext, bf16* XN, int gw, int NGW, int lane, float oscale = 1.f) {
    constexpr int R = INB ? 8 : 4;
    for (int m0 = gw; m0 < M; m0 += R * NGW) {
        v2u xb[R][4], yw[R][4]; f32x4 xf[R][4];
#pragma unroll
        for (int q = 0; q < R; ++q) { const size_t m = (size_t)(m0 + q * NGW);
#pragma unroll
            for (int j = 0; j < 4; ++j) {
                if constexpr (INB) xb[q][j] = ((const GAS v2u*)((const bf16*)base + m * DM))[lane + 64 * j];
                else xf[q][j] = ((const GAS f32x4*)((const float*)base + m * DM))[lane + 64 * j];
                if (Y) yw[q][j] = ((const GAS v2u*)(Y + m * DM))[lane + 64 * j]; } }
#pragma unroll
        for (int q = 0; q < R; ++q) { const size_t m = (size_t)(m0 + q * NGW);
            f32x4 v[4];
#pragma unroll
            for (int j = 0; j < 4; ++j) { if constexpr (INB) v[j] = (f32x4){bflo(xb[q][j].x), bfhi(xb[q][j].x), bflo(xb[q][j].y), bfhi(xb[q][j].y)}; else v[j] = xf[q][j]; }
            if (Y) {
                f32x4 y[4]; float ss = 0.f;
#pragma unroll
                for (int j = 0; j < 4; ++j) { const v2u w = yw[q][j]; y[j] = (f32x4){bflo(w.x), bfhi(w.x), bflo(w.y), bfhi(w.y)};
                    ss += (y[j].x * y[j].x + y[j].y * y[j].y) + (y[j].z * y[j].z + y[j].w * y[j].w); }
                const float r = s * __builtin_amdgcn_rsqf(wave_sum(ss) * (1.f / DM) + NORM_EPS);
#pragma unroll
                for (int j = 0; j < 4; ++j) { const f32x4 g = ((const GAS f32x4*)gpost)[lane + 64 * j]; v[j] = v[j] + y[j] * g * r;
                    if constexpr (OUTB) { v2u w; w.x = pk2(v[j].x, v[j].y); w.y = pk2(v[j].z, v[j].w); ((GAS v2u*)((bf16*)out + m * DM))[lane + 64 * j] = w; }
                    else ((GAS f32x4*)((float*)out + m * DM))[lane + 64 * j] = v[j] * oscale; }
            }
            if (XN) {
                float ss = 0.f;
#pragma unroll
                for (int j = 0; j < 4; ++j) ss += (v[j].x * v[j].x + v[j].y * v[j].y) + (v[j].z * v[j].z + v[j].w * v[j].w);
                const float r = __builtin_amdgcn_rsqf(wave_sum(ss) * (1.f / DM) + NORM_EPS);
#pragma unroll
                for (int j = 0; j < 4; ++j) { const f32x4 g = ((const GAS f32x4*)gnext)[lane + 64 * j]; const f32x4 o = v[j] * g * r;
                    v2u w; w.x = pk2(o.x, o.y); w.y = pk2(o.z, o.w); ((GAS v2u*)(XN + m * DM))[lane + 64 * j] = w; }
            }
        }
    }
}

namespace scan {
template <int CTRL> __device__ __forceinline__ float dpp_add(float x) {
    const int y = __builtin_amdgcn_update_dpp(0, __builtin_bit_cast(int, x), CTRL, 0xF, 0xF, false);
    return x + __builtin_bit_cast(float, y);
}
__device__ __forceinline__ float red8(float x) { x = dpp_add<0xB1>(x); x = dpp_add<0x4E>(x); x = dpp_add<0x141>(x); return x; }
__device__ __forceinline__ float red16(float x) { x = dpp_add<0xB1>(x); x = dpp_add<0x4E>(x); x = dpp_add<0x141>(x); x = dpp_add<0x140>(x); return x; }
__device__ __forceinline__ void ld8(const bf16* p, float (&o)[8]) { const v4u w = *(const GAS v4u*)p; o[0] = bflo(w.x); o[1] = bfhi(w.x); o[2] = bflo(w.y); o[3] = bfhi(w.y); o[4] = bflo(w.z); o[5] = bfhi(w.z); o[6] = bflo(w.w); o[7] = bfhi(w.w); }
}
struct PrepP { const bf16* ZR; bf16* X1; unsigned char* A8; bf16* KI; const float *mu, *w0, *wup, *a0, *aup; };
__device__ __forceinline__ void rwkv_prep(const PrepP& P, LAS unsigned char* lds) {
    const int tid = otid_(), lane = tid & 63, h = __builtin_amdgcn_readfirstlane(tid >> 6), c16 = lane & 15, quad = lane >> 4;
    constexpr int SP = 144;
    LAS unsigned char* TA = lds; LAS unsigned char* AA = lds + 64 * SP;
    bf16x8 bw[4][2], ba[4][2];
#pragma unroll
    for (int ct = 0; ct < 4; ++ct)
#pragma unroll
        for (int s = 0; s < 2; ++s) { const size_t o = (size_t)(32 * s + 8 * quad) * 512 + 64 * h + 16 * ct + c16; const float* gw_ = P.wup + o; const float* ga_ = P.aup + o;
            v4u w; w.x = pk2(gw_[0], gw_[512]); w.y = pk2(gw_[1024], gw_[1536]); w.z = pk2(gw_[2048], gw_[2560]); w.w = pk2(gw_[3072], gw_[3584]); bw[ct][s] = __builtin_bit_cast(bf16x8, w);
            v4u a; a.x = pk2(ga_[0], ga_[512]); a.y = pk2(ga_[1024], ga_[1536]); a.z = pk2(ga_[2048], ga_[2560]); a.w = pk2(ga_[3072], ga_[3584]); ba[ct][s] = __builtin_bit_cast(bf16x8, a); }
    float w0v[4], a0v[4];
#pragma unroll
    for (int ct = 0; ct < 4; ++ct) { w0v[ct] = P.w0[64 * h + 16 * ct + c16]; a0v[ct] = P.a0[64 * h + 16 * ct + c16]; }
    const int stok = tid >> 3, sseg = tid & 7;
#pragma unroll 1
    for (int m0 = blockIdx.x * 64; m0 < M; m0 += gridDim.x * 64) {
        {   const size_t m = (size_t)m0 + stok; const int t = (int)(m & (T - 1));
            *(GAS v4u*)(P.KI + m * 64 + 8 * sseg) = *(const GAS v4u*)(P.ZR + m * ZP + ZC_KI + 8 * sseg);
            float wc[8], ac[8], p8[8];
            scan::ld8(P.ZR + m * ZP + ZC_WC + 8 * sseg, wc); scan::ld8(P.ZR + m * ZP + ZC_AC + 8 * sseg, ac);
            if (t > 0) { scan::ld8(P.ZR + (m - 1) * ZP + ZC_WC + 8 * sseg, p8);
#pragma unroll
                for (int e = 0; e < 8; ++e) wc[e] += (p8[e] - wc[e]) * P.mu[1536 + 8 * sseg + e];
                scan::ld8(P.ZR + (m - 1) * ZP + ZC_AC + 8 * sseg, p8);
#pragma unroll
                for (int e = 0; e < 8; ++e) ac[e] += (p8[e] - ac[e]) * P.mu[1600 + 8 * sseg + e]; }
            else {
#pragma unroll
                for (int e = 0; e < 8; ++e) { wc[e] -= wc[e] * P.mu[1536 + 8 * sseg + e]; ac[e] -= ac[e] * P.mu[1600 + 8 * sseg + e]; } }
            float th[8];
#pragma unroll
            for (int e = 0; e < 8; ++e) th[e] = 1.f - 2.f * __builtin_amdgcn_rcpf(__expf(2.f * wc[e]) + 1.f);
            v4u o; o.x = pk2(th[0], th[1]); o.y = pk2(th[2], th[3]); o.z = pk2(th[4], th[5]); o.w = pk2(th[6], th[7]); *(LAS v4u*)(TA + stok * SP + 16 * sseg) = o;
            v4u q; q.x = pk2(ac[0], ac[1]); q.y = pk2(ac[2], ac[3]); q.z = pk2(ac[4], ac[5]); q.w = pk2(ac[6], ac[7]); *(LAS v4u*)(AA + stok * SP + 16 * sseg) = q;
        }
        __syncthreads();
#pragma unroll 1
        for (int rt = 0; rt < 4; ++rt) {
            f32x4 accw[4], acca[4];
#pragma unroll
            for (int ct = 0; ct < 4; ++ct) { accw[ct] = (f32x4){0.f, 0.f, 0.f, 0.f}; acca[ct] = (f32x4){0.f, 0.f, 0.f, 0.f}; }
#pragma unroll
            for (int s = 0; s < 2; ++s) { const bf16x8 fw = *(const LAS bf16x8*)(TA + (16 * rt + c16) * SP + (32 * s + 8 * quad) * 2), fa = *(const LAS bf16x8*)(AA + (16 * rt + c16) * SP + (32 * s + 8 * quad) * 2);
#pragma unroll
                for (int ct = 0; ct < 4; ++ct) { accw[ct] = __builtin_amdgcn_mfma_f32_16x16x32_bf16(fw, bw[ct][s], accw[ct], 0, 0, 0); acca[ct] = __builtin_amdgcn_mfma_f32_16x16x32_bf16(fa, ba[ct][s], acca[ct], 0, 0, 0); } }
#pragma unroll
            for (int j = 0; j < 4; ++j) { const size_t m = (size_t)m0 + 16 * rt + 4 * quad + j;
#pragma unroll
                for (int ct = 0; ct < 4; ++ct) { const int ch = 64 * h + 16 * ct + c16;
                    const float sg = sigm(w0v[ct] + accw[ct][j]);
                    const float x1 = 1.f - __expf(-0.6065306597126334f * sg);
                    const float a = sigm(a0v[ct] + acca[ct][j]);
                    P.X1[m * 512 + ch] = (bf16)f2bf(x1);
                    P.A8[m * 512 + ch] = (unsigned char)(int)(a * 255.f + 0.5f); } }
        }
        __syncthreads();
    }
}

struct ScanP { const bf16* Q3; const bf16* ZR; const bf16* X1; const unsigned char* A8; bf16* yraw; float* rdotk; const float *mu, *k_k, *k_a, *r_k; };
namespace scan {
constexpr int TB = 32, NBLK = T / TB;
constexpr int CB_W = 0, CB_B = 8192, CB_K = 16384, CB_KW = 24576, CB_V = 40960, CB_BR = 43008, CB_KR = 43136, CB_SA = 43264, CB_YP = 45312, CBSZ = 78080;
constexpr int L_END = 2 * CBSZ;
static_assert(L_END <= LDS_MISC, "scan LDS");
}
__device__ __forceinline__ void rwkv_scan_unit(const ScanP& P, int unit, LAS unsigned char* lds) {
    using namespace scan;
    const int tid = otid_(), wid = __builtin_amdgcn_readfirstlane(tid >> 6), lane = tid & 63;
    const int b = unit >> 5, h = (unit >> 2) & 7, vq = unit & 3;
    const size_t mrow0 = (size_t)b * T;
    if (wid >= 4) {
        const int pw = wid - 4, tokl = lane >> 3, seg = lane & 7, c0 = 8 * seg, hc0 = 64 * h + c0;
        float mu_r[8], mu_k[8], kkv[8], kav[8], rkv[8];
#pragma unroll
        for (int e = 0; e < 8; ++e) { mu_r[e] = P.mu[hc0 + e]; mu_k[e] = P.mu[512 + hc0 + e]; kkv[e] = P.k_k[hc0 + e]; kav[e] = P.k_a[hc0 + e]; rkv[e] = P.r_k[hc0 + e]; }
        const int vc0 = 64 * h + 16 * vq + 2 * seg;
        const float mu_v0 = P.mu[1024 + vc0], mu_v1 = P.mu[1024 + vc0 + 1];
        const int ptid = pw * 64 + lane;
        v4u nr, nrp, nk, nkp, nx; v2u na; unsigned nv, nvp;
#define SCAN_LOAD(nb_) do { const int t_ = (nb_) * TB + 8 * pw + tokl; const size_t m_ = mrow0 + t_, mp_ = t_ > 0 ? m_ - 1 : m_; \
            nr = *(const GAS v4u*)(P.Q3 + m_ * QP + 512 + hc0); nrp = *(const GAS v4u*)(P.Q3 + mp_ * QP + 512 + hc0); \
            nk = *(const GAS v4u*)(P.ZR + m_ * ZP + ZC_RK + hc0); nkp = *(const GAS v4u*)(P.ZR + mp_ * ZP + ZC_RK + hc0); \
            nx = *(const GAS v4u*)(P.X1 + m_ * 512 + hc0); na = *(const GAS v2u*)(P.A8 + m_ * 512 + hc0); \
            nv = *(const GAS unsigned*)(P.ZR + m_ * ZP + ZC_RV + vc0); nvp = *(const GAS unsigned*)(P.ZR + mp_ * ZP + ZC_RV + vc0); } while (0)
#define UNPK8(w_, o_) do { o_[0] = bflo(w_.x); o_[1] = bfhi(w_.x); o_[2] = bflo(w_.y); o_[3] = bfhi(w_.y); o_[4] = bflo(w_.z); o_[5] = bfhi(w_.z); o_[6] = bflo(w_.w); o_[7] = bfhi(w_.w); } while (0)
        SCAN_LOAD(0);
        for (int blk = -1; blk < NBLK; ++blk) {
            const int nb = blk + 1;
            LAS unsigned char* cb = lds + (nb & 1) * CBSZ;
            if (blk >= 1) {
                const int tok = ptid >> 3, v2 = (ptid & 7) * 2;
                const LAS float* YPp = (const LAS float*)(cb + CB_YP) + (tok * 16 + v2) * 16;
                float y0 = 0.f, y1 = 0.f;
#pragma unroll
                for (int q4 = 0; q4 < 4; ++q4) { const f32x4 a = *(const LAS f32x4*)(YPp + 4 * q4), c = *(const LAS f32x4*)(YPp + 16 + 4 * q4); y0 += (a.x + a.y) + (a.z + a.w); y1 += (c.x + c.y) + (c.z + c.w); }
                const float kr = *(const LAS float*)(cb + CB_KR + tok * 4);
                const f32x2 vv = *(const LAS f32x2*)(cb + CB_V + (tok * 16 + v2) * 4);
                y0 += vv.x * kr; y1 += vv.y * kr;
                const size_t m = mrow0 + (size_t)(blk - 1) * TB + tok;
                *(GAS unsigned*)(P.yraw + m * 512 + 64 * h + 16 * vq + v2) = pk2(y0, y1);
                LDS_WAIT(); asm volatile("" ::: "memory");
            }
            if (nb < NBLK) {
                const int t = nb * TB + 8 * pw + tokl; const size_t m = mrow0 + t;
                float r8[8], k8[8], p8[8], x8[8], a8[8];
                const v4u cr = nr, crp = nrp, ck = nk, ckp = nkp, cx = nx; const v2u ca = na; const unsigned cv = nv, cvp = nvp;
                if (nb + 1 < NBLK) SCAN_LOAD(nb + 1);
                UNPK8(cr, r8); UNPK8(ck, k8); UNPK8(cx, x8);
                { const float sc = 1.f / 255.f;
                  a8[0] = (float)(ca.x & 255u) * sc; a8[1] = (float)((ca.x >> 8) & 255u) * sc; a8[2] = (float)((ca.x >> 16) & 255u) * sc; a8[3] = (float)(ca.x >> 24) * sc;
                  a8[4] = (float)(ca.y & 255u) * sc; a8[5] = (float)((ca.y >> 8) & 255u) * sc; a8[6] = (float)((ca.y >> 16) & 255u) * sc; a8[7] = (float)(ca.y >> 24) * sc; }
                float v0 = bflo(cv), v1 = bfhi(cv);
                if (t > 0) {
                    UNPK8(crp, p8);
#pragma unroll
                    for (int e = 0; e < 8; ++e) r8[e] += (p8[e] - r8[e]) * mu_r[e];
                    UNPK8(ckp, p8);
#pragma unroll
                    for (int e = 0; e < 8; ++e) k8[e] += (p8[e] - k8[e]) * mu_k[e];
                    v0 += (bflo(cvp) - v0) * mu_v0; v1 += (bfhi(cvp) - v1) * mu_v1;
                } else {
#pragma unroll
                    for (int e = 0; e < 8; ++e) { r8[e] -= r8[e] * mu_r[e]; k8[e] -= k8[e] * mu_k[e]; }
                    v0 -= v0 * mu_v0; v1 -= v1 * mu_v1;
                }
                float kk8[8]; { float ss = 0.f;
#pragma unroll
                  for (int e = 0; e < 8; ++e) { kk8[e] = k8[e] * kkv[e]; ss += kk8[e] * kk8[e]; }
                  ss = red8(ss); const float inv = 1.f / fmaxf(sqrtf(ss), 1e-12f);
#pragma unroll
                  for (int e = 0; e < 8; ++e) kk8[e] *= inv; }
                float w8[8], bb[8], km[8], wr[8]; float brp = 0.f, krp = 0.f, rkp = 0.f;
#pragma unroll
                for (int e = 0; e < 8; ++e) {
                    w8[e] = 1.f - x8[e];
                    bb[e] = kk8[e] * a8[e]; km[e] = k8[e] * (1.f + (a8[e] - 1.f) * kav[e]);
                    brp += bb[e] * r8[e]; krp += km[e] * r8[e]; rkp += r8[e] * km[e] * rkv[e];
                }
                brp = red8(brp); krp = red8(krp); rkp = red8(rkp);
#pragma unroll
                for (int e = 0; e < 8; ++e) wr[e] = w8[e] * r8[e] - kk8[e] * brp;
                const int ti = 8 * pw + tokl;
                *(LAS f32x4*)(cb + CB_W + (ti * 64 + c0) * 4) = (f32x4){w8[0], w8[1], w8[2], w8[3]}; *(LAS f32x4*)(cb + CB_W + (ti * 64 + c0 + 4) * 4) = (f32x4){w8[4], w8[5], w8[6], w8[7]};
                *(LAS f32x4*)(cb + CB_B + (ti * 64 + c0) * 4) = (f32x4){bb[0], bb[1], bb[2], bb[3]}; *(LAS f32x4*)(cb + CB_B + (ti * 64 + c0 + 4) * 4) = (f32x4){bb[4], bb[5], bb[6], bb[7]};
                *(LAS f32x4*)(cb + CB_K + (ti * 64 + c0) * 4) = (f32x4){km[0], km[1], km[2], km[3]}; *(LAS f32x4*)(cb + CB_K + (ti * 64 + c0 + 4) * 4) = (f32x4){km[4], km[5], km[6], km[7]};
#pragma unroll
                for (int e = 0; e < 8; e += 2) *(LAS f32x4*)(cb + CB_KW + ti * 512 + ((e >> 1) & 1) * 256 + (2 * seg + (e >> 2)) * 16) = (f32x4){kk8[e], wr[e], kk8[e + 1], wr[e + 1]};
                *(LAS f32x2*)(cb + CB_V + (ti * 16 + 2 * seg) * 4) = (f32x2){v0, v1};
                if (seg == 0) { *(LAS float*)(cb + CB_KR + ti * 4) = krp; if (vq == 0) P.rdotk[m * 8 + h] = rkp; }
            }
            __syncthreads();
        }
        { const LAS unsigned char* cb = lds + ((NBLK - 1) & 1) * CBSZ;
          const int tok = ptid >> 3, v2 = (ptid & 7) * 2;
          const LAS float* YPp = (const LAS float*)(cb + CB_YP) + (tok * 16 + v2) * 16;
          float y0 = 0.f, y1 = 0.f;
#pragma unroll
          for (int q4 = 0; q4 < 4; ++q4) { const f32x4 a = *(const LAS f32x4*)(YPp + 4 * q4), c = *(const LAS f32x4*)(YPp + 16 + 4 * q4); y0 += (a.x + a.y) + (a.z + a.w); y1 += (c.x + c.y) + (c.z + c.w); }
          const float kr = *(const LAS float*)(cb + CB_KR + tok * 4);
          const f32x2 vv = *(const LAS f32x2*)(cb + CB_V + (tok * 16 + v2) * 4);
          y0 += vv.x * kr; y1 += vv.y * kr;
          const size_t m = mrow0 + (size_t)(NBLK - 1) * TB + tok;
          *(GAS unsigned*)(P.yraw + m * 512 + 64 * h + 16 * vq + v2) = pk2(y0, y1); }
    } else {
        const int vi = 4 * wid + (lane >> 4), cg = lane & 15;
        f32x2 s01 = {0.f, 0.f}, s23 = {0.f, 0.f};
        __syncthreads();
        __builtin_amdgcn_s_setprio(3);
        const unsigned lo4 = (unsigned)(4 * cg) * 4u;
        for (int blk = 0; blk < NBLK; ++blk) {
            const LAS unsigned char* cb = lds + (blk & 1) * CBSZ;
            f32x4 kwa = *(const LAS f32x4*)(cb + CB_KW + lo4), kwb = *(const LAS f32x4*)(cb + CB_KW + 256 + lo4);
            f32x4 w4 = *(const LAS f32x4*)(cb + CB_W + lo4), b4 = *(const LAS f32x4*)(cb + CB_B + lo4), k4 = *(const LAS f32x4*)(cb + CB_K + lo4);
            float vv = *(const LAS float*)(cb + CB_V + vi * 4);
#pragma unroll 4
            for (int tok = 0; tok < TB; ++tok) {
                const int tn = tok + 1 < TB ? tok + 1 : tok;
                const f32x4 nkwa = *(const LAS f32x4*)(cb + CB_KW + tn * 512 + lo4), nkwb = *(const LAS f32x4*)(cb + CB_KW + tn * 512 + 256 + lo4);
                const f32x4 nw4 = *(const LAS f32x4*)(cb + CB_W + tn * 256 + lo4), nb4 = *(const LAS f32x4*)(cb + CB_B + tn * 256 + lo4), nk4 = *(const LAS f32x4*)(cb + CB_K + tn * 256 + lo4);
                const float nvv = *(const LAS float*)(cb + CB_V + (tn * 16 + vi) * 4);
                f32x2 p = (f32x2){s01.x, s01.x} * (f32x2){kwa.x, kwa.y};
                p += (f32x2){s01.y, s01.y} * (f32x2){kwa.z, kwa.w};
                p += (f32x2){s23.x, s23.x} * (f32x2){kwb.x, kwb.y};
                p += (f32x2){s23.y, s23.y} * (f32x2){kwb.z, kwb.w};
                *(LAS float*)(cb + CB_YP + ((tok * 16 + vi) * 16 + cg) * 4) = p.y;
                const f32x2 t01 = s01 * (f32x2){w4.x, w4.y} + (f32x2){k4.x, k4.y} * vv, t23 = s23 * (f32x2){w4.z, w4.w} + (f32x2){k4.z, k4.w} * vv;
                const float d1 = red16(p.x);
                s01 = t01 - (f32x2){b4.x, b4.y} * d1; s23 = t23 - (f32x2){b4.z, b4.w} * d1;
                kwa = nkwa; kwb = nkwb; w4 = nw4; b4 = nb4; k4 = nk4; vv = nvv;
            }
            __syncthreads();
        }
        __builtin_amdgcn_s_setprio(0);
    }
    __syncthreads();
}

struct Dsa1P { const bf16* ZR; const bf16* KI; unsigned* bitm; gu32* done; };
namespace dsa1 {
constexpr int CAP = 769  , PRUNE_AT = 512, KEEP = 256;
constexpr int L_BUF = 0, L_CNT = 32 * CAP * 4, L_THR = L_CNT + 128, L_THRK = L_THR + 128, L_HIST = ((L_THRK + 128 + 15) / 16) * 16, L_MROW = L_HIST + 8 * 1024, L_QF = L_MROW + 8 * 1024, QFP = 1040, L_END = L_QF + 32 * QFP;
static_assert(L_END <= LDS_MISC, "dsa1 LDS");
__device__ __forceinline__ unsigned packkey(float s, int keyidx) { const unsigned bits = __float_as_uint(s); const unsigned u = bits ^ ((unsigned)((int)bits >> 31) | 0x80000000u); return (u & 0xFFFFE000u) | (unsigned)(8191 - keyidx); }
__device__ __forceinline__ float thr_of(unsigned key) { const unsigned u = key & 0xFFFFE000u; const unsigned bits = (u & 0x80000000u) ? (u ^ 0x80000000u) : ~u; return __uint_as_float(bits); }
__device__ __forceinline__ int wave_prefix_incl(int v) {
    v += __builtin_amdgcn_update_dpp(0, v, 0x111, 0xF, 0xF, true);
    v += __builtin_amdgcn_update_dpp(0, v, 0x112, 0xF, 0xF, true);
    v += __builtin_amdgcn_update_dpp(0, v, 0x114, 0xF, 0xF, true);
    v += __builtin_amdgcn_update_dpp(0, v, 0x118, 0xF, 0xF, true);
    v += __builtin_amdgcn_update_dpp(0, v, 0x142, 0xA, 0xF, false);
    v += __builtin_amdgcn_update_dpp(0, v, 0x143, 0xC, 0xF, false);
    return v;
}
__device__ __forceinline__ void prune(LAS unsigned char* lds, int qq, int wid, int lane, bool exact) {
    asm volatile("" : "+v"(lane));
    LAS unsigned* buf = (LAS unsigned*)(lds + L_BUF) + qq * CAP; LAS unsigned* cnt = (LAS unsigned*)(lds + L_CNT); LAS float* thr = (LAS float*)(lds + L_THR); LAS unsigned* thrk = (LAS unsigned*)(lds + L_THRK);
    LAS unsigned* hist = (LAS unsigned*)(lds + L_HIST) + wid * 256;
    const int n = (int)cnt[qq];
    unsigned e[12];
#pragma unroll
    for (int k = 0; k < 12; ++k) e[k] = (lane + 64 * k < n) ? buf[lane + 64 * k] : 0u;
    const unsigned tk = thrk[qq];
    unsigned cut = 0u; bool have = false;
    if (!exact && tk != 0u) {
        const unsigned base16 = tk >> 16;
        *(LAS v4u*)(hist + 4 * lane) = (v4u){0u, 0u, 0u, 0u};
        LDS_WAIT(); asm volatile("" ::: "memory");
#pragma unroll
        for (int k = 0; k < 12; ++k) if (lane + 64 * k < n) { unsigned bn = (e[k] >> 16) - base16; bn = bn > 255u ? 255u : bn; (void)__hip_atomic_fetch_add(hist + bn, 1u, __ATOMIC_RELAXED, __HIP_MEMORY_SCOPE_WORKGROUP); }
        LDS_WAIT(); asm volatile("" ::: "memory");
        const int rl = 63 - lane;
        const v4u hv = *(const LAS v4u*)(hist + 4 * rl);
        const int tot = (int)(hv.x + hv.y + hv.z + hv.w);
        int above = wave_prefix_incl(tot) - tot; int dsel = -1, csel = 0;
        { const int h3 = (int)hv.w, h2 = (int)hv.z, h1 = (int)hv.y, h0 = (int)hv.x;
          if (above < KEEP && KEEP <= above + h3) { dsel = 4 * rl + 3; csel = above + h3; } above += h3;
          if (above < KEEP && KEEP <= above + h2) { dsel = 4 * rl + 2; csel = above + h2; } above += h2;
          if (above < KEEP && KEEP <= above + h1) { dsel = 4 * rl + 1; csel = above + h1; } above += h1;
          if (above < KEEP && KEEP <= above + h0) { dsel = 4 * rl + 0; csel = above + h0; } }
        const unsigned long long bm = __ballot(dsel >= 0);
        const int src = bm ? (int)__builtin_ctzll(bm) : 0;
        const int d = __builtin_amdgcn_readlane(dsel, src), cd = __builtin_amdgcn_readlane(csel, src);
        LDS_WAIT(); asm volatile("" ::: "memory");
        if (bm != 0ull && cd <= KEEP + 128) { cut = (base16 + (unsigned)d) << 16; have = true; }
    }
    if (!have) {
        unsigned prefix = 0u; int want = KEEP;
#pragma unroll 1
        for (int p = 0; p < 4; ++p) {
            const int shift = 24 - 8 * p;
            *(LAS v4u*)(hist + 4 * lane) = (v4u){0u, 0u, 0u, 0u};
            LDS_WAIT(); asm volatile("" ::: "memory");
#pragma unroll
            for (int k = 0; k < 12; ++k) { const bool in = (lane + 64 * k < n) && (p == 0 || (e[k] >> (shift + 8)) == (prefix >> (shift + 8)));
                if (in) (void)__hip_atomic_fetch_add(hist + ((e[k] >> shift) & 255u), 1u, __ATOMIC_RELAXED, __HIP_MEMORY_SCOPE_WORKGROUP); }
            LDS_WAIT(); asm volatile("" ::: "memory");
            const int rl = 63 - lane;
            const v4u hv = *(const LAS v4u*)(hist + 4 * rl);
            const int tot = (int)(hv.x + hv.y + hv.z + hv.w);
            int above = wave_prefix_incl(tot) - tot;
            int dsel = -1, asel = 0;
            { const int h3 = (int)hv.w, h2 = (int)hv.z, h1 = (int)hv.y, h0 = (int)hv.x;
              if (above < want && want <= above + h3) { dsel = 4 * rl + 3; asel = above; } above += h3;
              if (above < want && want <= above + h2) { dsel = 4 * rl + 2; asel = above; } above += h2;
              if (above < want && want <= above + h1) { dsel = 4 * rl + 1; asel = above; } above += h1;
              if (above < want && want <= above + h0) { dsel = 4 * rl + 0; asel = above; } }
            const unsigned long long bm = __ballot(dsel >= 0);
            const int src = bm ? (int)__builtin_ctzll(bm) : 0;
            const int d = __builtin_amdgcn_readlane(dsel, src), ab = __builtin_amdgcn_readlane(asel, src);
            prefix |= ((unsigned)(d < 0 ? 0 : d)) << shift; want -= ab;
            LDS_WAIT(); asm volatile("" ::: "memory");
        }
        cut = prefix;
    }
    int base = 0;
#pragma unroll
    for (int k = 0; k < 12; ++k) { const bool keep = (lane + 64 * k < n) && e[k] >= cut; const unsigned long long mk = __ballot(keep);
        const int pos = base + (int)__builtin_amdgcn_mbcnt_hi((unsigned)(mk >> 32), __builtin_amdgcn_mbcnt_lo((unsigned)mk, 0u));
        if (keep) buf[pos] = e[k]; base += (int)__builtin_popcountll(mk); }
    if (lane == 0) { cnt[qq] = (unsigned)base; thr[qq] = thr_of(cut); thrk[qq] = cut; }
    LDS_WAIT(); asm volatile("" ::: "memory");
}
}
__device__ __forceinline__ void dsa1_unit(const Dsa1P& P, int u, LAS unsigned char* lds) {
    using namespace dsa1;
    const int tid = otid_(), wid = __builtin_amdgcn_readfirstlane(tid >> 6), lane = tid & 63, q = lane & 31, hi = lane >> 5;
    const int b = u & 1, qb32 = 255 - (u >> 1), t0 = 32 * qb32;
    const size_t brow = (size_t)b * T;
    LAS unsigned* buf = (LAS unsigned*)(lds + L_BUF); LAS unsigned* cnt = (LAS unsigned*)(lds + L_CNT); LAS float* thr = (LAS float*)(lds + L_THR);
    if (tid < 32) { cnt[tid] = 0u; thr[tid] = -__builtin_inff(); ((LAS unsigned*)(lds + L_THRK))[tid] = 0u; }
    const bf16* qrow = P.ZR + (brow + t0 + q) * ZP;
    { const int r = tid >> 4, sg = tid & 15; const bf16* src = P.ZR + (brow + t0 + r) * ZP + ZC_QI + 32 * sg;
#pragma unroll
      for (int j = 0; j < 4; ++j) *(LAS v4u*)(lds + L_QF + r * QFP + 64 * sg + 16 * j) = *(const GAS v4u*)(src + 8 * j); }
    float wq[8];
    { const v4u w = *(const GAS v4u*)(qrow + ZC_WI); const float c = 0.35355339059327373f * 0.125f;
      wq[0] = bflo(w.x) * c; wq[1] = bfhi(w.x) * c; wq[2] = bflo(w.y) * c; wq[3] = bfhi(w.y) * c; wq[4] = bflo(w.z) * c; wq[5] = bfhi(w.z) * c; wq[6] = bflo(w.w) * c; wq[7] = bfhi(w.w) * c; }
    const int tq = t0 + q;
    const int nsteps = (t0 + 32 + 255) >> 8;
    __syncthreads();
    float th = -__builtin_inff();
    bf16x8 afn[4];
    { const int k0 = 32 * wid; const bf16* krow = P.KI + (brow + (k0 <= t0 + 31 ? k0 : 0) + q) * 64 + 8 * hi;
#pragma unroll
      for (int s = 0; s < 4; ++s) afn[s] = *(const GAS bf16x8*)(krow + 16 * s); }
    for (int st = 0; st < nsteps; ++st) {
        const int key0 = 256 * st + 32 * wid;
        bf16x8 af[4];
#pragma unroll
        for (int s = 0; s < 4; ++s) af[s] = afn[s];
        { const int k1 = key0 + 256; const bf16* krow = P.KI + (brow + (k1 <= t0 + 31 ? k1 : 0) + q) * 64 + 8 * hi;
#pragma unroll
          for (int s = 0; s < 4; ++s) afn[s] = *(const GAS bf16x8*)(krow + 16 * s); }
        if (key0 <= t0 + 31) {
            f32x16 sc;
#pragma unroll
            for (int i = 0; i < 16; ++i) sc[i] = 0.f;
            unsigned qfo = (unsigned)(L_QF + q * QFP + 16 * hi); asm volatile("" : "+v"(qfo));
#pragma unroll
            for (int hd = 0; hd < 8; ++hd) {
                f32x16 acc;
#pragma unroll
                for (int i = 0; i < 16; ++i) acc[i] = 0.f;
#pragma unroll
                for (int s = 0; s < 4; ++s) { const bf16x8 qb = *(const LAS bf16x8*)(lds + qfo + hd * 128 + 32 * s);
                    acc = __builtin_amdgcn_mfma_f32_32x32x16_bf16(af[s], qb, acc, 0, 0, 0); }
#pragma unroll
                for (int i = 0; i < 16; ++i) sc[i] = fmaf(fmaxf(acc[i], 0.f), wq[hd], sc[i]);
                __builtin_amdgcn_sched_barrier(0);
            }
            const bool diag = key0 + 31 > t0;
            unsigned pm = 0u;
#pragma unroll
            for (int i = 0; i < 16; ++i) { const int kidx = key0 + (i & 3) + 8 * (i >> 2) + 4 * hi; const bool ok = (sc[i] >= th) && (!diag || kidx <= tq); pm |= ok ? (1u << i) : 0u; }
            const int np = __builtin_popcount(pm);
            if (np > 0) {
                int pos = (int)__hip_atomic_fetch_add(cnt + q, (unsigned)np, __ATOMIC_RELAXED, __HIP_MEMORY_SCOPE_WORKGROUP);
                LAS unsigned* bq = buf + q * CAP;
#pragma unroll
                for (int i = 0; i < 16; ++i) if (pm & (1u << i)) { const int kidx = key0 + (i & 3) + 8 * (i >> 2) + 4 * hi; bq[pos] = packkey(sc[i], kidx); ++pos; }
            }
        }
        __syncthreads();
        { unsigned nm = (unsigned)__ballot(cnt[q] > (unsigned)PRUNE_AT); int i = 0;
          while (nm) { const int qq = __builtin_ctz(nm); nm &= nm - 1u; if ((i & 7) == wid) prune(lds, qq, wid, lane, false); ++i; } }
        __syncthreads();
        th = thr[q];
    }
    LAS unsigned* mrow = (LAS unsigned*)(lds + L_MROW) + wid * 256;
#pragma unroll 1
    for (int k = 0; k < 4; ++k) {
        const int qq = wid + 8 * k;
        if (cnt[qq] > (unsigned)KEEP) prune(lds, qq, wid, lane, true);
        const int nf = (int)cnt[qq];
        *(LAS v4u*)(mrow + 4 * lane) = (v4u){0u, 0u, 0u, 0u};
        LDS_WAIT(); asm volatile("" ::: "memory");
#pragma unroll
        for (int j = 0; j < 4; ++j) { const int idx = lane + 64 * j; if (idx < nf) { const unsigned e = buf[qq * CAP + idx]; const unsigned key = 8191u - (e & 0x1FFFu); (void)__hip_atomic_fetch_or(mrow + (key >> 5), 1u << (key & 31u), __ATOMIC_RELAXED, __HIP_MEMORY_SCOPE_WORKGROUP); } }
        LDS_WAIT(); asm volatile("" ::: "memory");
        unsigned long long* grow = (unsigned long long*)(P.bitm + (brow + t0 + qq) * 256);
#pragma unroll
        for (int j = 0; j < 2; ++j) { const int w2 = lane + 64 * j; const unsigned long long v = (unsigned long long)mrow[2 * w2] | ((unsigned long long)mrow[2 * w2 + 1] << 32);
            __hip_atomic_store(grow + w2, v, RLX_AGENT); }
        LDS_WAIT(); asm volatile("" ::: "memory");
    }
    VM_WAIT();
    __syncthreads();
    if (tid == 0) __hip_atomic_fetch_add(P.done + 64 * (b * 32 + (t0 >> 8)), 1u, RLX_AGENT);
}

struct RPostP { const bf16* ZR; bf16* Q3; const bf16* yraw; const float* rdotk; const float *mu, *gup, *lnw, *lnb; };
__device__ __forceinline__ void rwkv_post(const RPostP& P, LAS unsigned char* lds) {
    const int tid = otid_(), lane = tid & 63, h = __builtin_amdgcn_readfirstlane(tid >> 6), c16 = lane & 15, quad = lane >> 4;
    constexpr int SP = 272;
    LAS float* GT = (LAS float*)(lds + 64 * SP);
    bf16x8 bfr[4][4];
#pragma unroll
    for (int ct = 0; ct < 4; ++ct)
#pragma unroll
        for (int s = 0; s < 4; ++s) { const float* gp = P.gup + (size_t)(32 * s + 8 * quad) * 512 + 64 * h + 16 * ct + c16;
            v4u w; w.x = pk2(gp[0], gp[512]); w.y = pk2(gp[1024], gp[1536]); w.z = pk2(gp[2048], gp[2560]); w.w = pk2(gp[3072], gp[3584]); bfr[ct][s] = __builtin_bit_cast(bf16x8, w); }
    float muv[4], lnw[4], lnb[4];
#pragma unroll
    for (int ct = 0; ct < 4; ++ct) { const int ch = 64 * h + 16 * ct + c16; muv[ct] = P.mu[1024 + ch]; lnw[ct] = P.lnw[ch]; lnb[ct] = P.lnb[ch]; }
    const int stok = tid >> 3, sseg = tid & 7;
#pragma unroll 1
    for (int m0 = blockIdx.x * 64; m0 < M; m0 += gridDim.x * 64) {
        {   const size_t m = (size_t)m0 + stok; const int t = (int)(m & (T - 1));
            float gv[16], pv[16];
            { const v4u a = *(const GAS v4u*)(P.ZR + m * ZP + ZC_GC + 16 * sseg), c = *(const GAS v4u*)(P.ZR + m * ZP + ZC_GC + 16 * sseg + 8);
              gv[0] = bflo(a.x); gv[1] = bfhi(a.x); gv[2] = bflo(a.y); gv[3] = bfhi(a.y); gv[4] = bflo(a.z); gv[5] = bfhi(a.z); gv[6] = bflo(a.w); gv[7] = bfhi(a.w);
              gv[8] = bflo(c.x); gv[9] = bfhi(c.x); gv[10] = bflo(c.y); gv[11] = bfhi(c.y); gv[12] = bflo(c.z); gv[13] = bfhi(c.z); gv[14] = bflo(c.w); gv[15] = bfhi(c.w); }
            if (t > 0) { const v4u a = *(const GAS v4u*)(P.ZR + (m - 1) * ZP + ZC_GC + 16 * sseg), c = *(const GAS v4u*)(P.ZR + (m - 1) * ZP + ZC_GC + 16 * sseg + 8);
              pv[0] = bflo(a.x); pv[1] = bfhi(a.x); pv[2] = bflo(a.y); pv[3] = bfhi(a.y); pv[4] = bflo(a.z); pv[5] = bfhi(a.z); pv[6] = bflo(a.w); pv[7] = bfhi(a.w);
              pv[8] = bflo(c.x); pv[9] = bfhi(c.x); pv[10] = bflo(c.y); pv[11] = bfhi(c.y); pv[12] = bflo(c.z); pv[13] = bfhi(c.z); pv[14] = bflo(c.w); pv[15] = bfhi(c.w); }
            else {
#pragma unroll
              for (int e = 0; e < 16; ++e) pv[e] = 0.f; }
            float sg[16];
#pragma unroll
            for (int e = 0; e < 16; ++e) { const float mu = P.mu[1664 + 16 * sseg + e]; sg[e] = sigm(gv[e] + (pv[e] - gv[e]) * mu); }
            v4u o0, o1; o0.x = pk2(sg[0], sg[1]); o0.y = pk2(sg[2], sg[3]); o0.z = pk2(sg[4], sg[5]); o0.w = pk2(sg[6], sg[7]); o1.x = pk2(sg[8], sg[9]); o1.y = pk2(sg[10], sg[11]); o1.z = pk2(sg[12], sg[13]); o1.w = pk2(sg[14], sg[15]);
            *(LAS v4u*)(lds + stok * SP + 32 * sseg) = o0; *(LAS v4u*)(lds + stok * SP + 32 * sseg + 16) = o1;
        }
        __syncthreads();
#pragma unroll 1
        for (int rt = 0; rt < 4; ++rt) {
            f32x4 acc[4];
#pragma unroll
            for (int ct = 0; ct < 4; ++ct) acc[ct] = (f32x4){0.f, 0.f, 0.f, 0.f};
#pragma unroll
            for (int s = 0; s < 4; ++s) { const bf16x8 af = *(const LAS bf16x8*)(lds + (16 * rt + c16) * SP + (32 * s + 8 * quad) * 2);
#pragma unroll
                for (int ct = 0; ct < 4; ++ct) acc[ct] = __builtin_amdgcn_mfma_f32_16x16x32_bf16(af, bfr[ct][s], acc[ct], 0, 0, 0); }
#pragma unroll
            for (int ct = 0; ct < 4; ++ct)
#pragma unroll
                for (int j = 0; j < 4; ++j) GT[(4 * quad + j) * 512 + 64 * h + 16 * ct + c16] = acc[ct][j];
            __syncthreads();
            {   const int vtok = tid >> 5, vseg = tid & 31, ch0 = 16 * vseg, vh = vseg >> 2;
                const size_t m = (size_t)m0 + 16 * rt + vtok; const int t = (int)(m & (T - 1));
                float y[16], vv[16], vp[16], g[16];
                { const v4u a = *(const GAS v4u*)(P.yraw + m * 512 + ch0), c = *(const GAS v4u*)(P.yraw + m * 512 + ch0 + 8);
                  y[0] = bflo(a.x); y[1] = bfhi(a.x); y[2] = bflo(a.y); y[3] = bfhi(a.y); y[4] = bflo(a.z); y[5] = bfhi(a.z); y[6] = bflo(a.w); y[7] = bfhi(a.w);
                  y[8] = bflo(c.x); y[9] = bfhi(c.x); y[10] = bflo(c.y); y[11] = bfhi(c.y); y[12] = bflo(c.z); y[13] = bfhi(c.z); y[14] = bflo(c.w); y[15] = bfhi(c.w); }
                { const v4u a = *(const GAS v4u*)(P.ZR + m * ZP + ZC_RV + ch0), c = *(const GAS v4u*)(P.ZR + m * ZP + ZC_RV + ch0 + 8);
                  vv[0] = bflo(a.x); vv[1] = bfhi(a.x); vv[2] = bflo(a.y); vv[3] = bfhi(a.y); vv[4] = bflo(a.z); vv[5] = bfhi(a.z); vv[6] = bflo(a.w); vv[7] = bfhi(a.w);
                  vv[8] = bflo(c.x); vv[9] = bfhi(c.x); vv[10] = bflo(c.y); vv[11] = bfhi(c.y); vv[12] = bflo(c.z); vv[13] = bfhi(c.z); vv[14] = bflo(c.w); vv[15] = bfhi(c.w); }
                if (t > 0) { const v4u a = *(const GAS v4u*)(P.ZR + (m - 1) * ZP + ZC_RV + ch0), c = *(const GAS v4u*)(P.ZR + (m - 1) * ZP + ZC_RV + ch0 + 8);
                  vp[0] = bflo(a.x); vp[1] = bfhi(a.x); vp[2] = bflo(a.y); vp[3] = bfhi(a.y); vp[4] = bflo(a.z); vp[5] = bfhi(a.z); vp[6] = bflo(a.w); vp[7] = bfhi(a.w);
                  vp[8] = bflo(c.x); vp[9] = bfhi(c.x); vp[10] = bflo(c.y); vp[11] = bfhi(c.y); vp[12] = bflo(c.z); vp[13] = bfhi(c.z); vp[14] = bflo(c.w); vp[15] = bfhi(c.w); }
                else {
#pragma unroll
                  for (int e = 0; e < 16; ++e) vp[e] = 0.f; }
#pragma unroll
                for (int e4 = 0; e4 < 4; ++e4) { const f32x4 gq = *(const LAS f32x4*)(GT + vtok * 512 + ch0 + 4 * e4); g[4 * e4] = gq.x; g[4 * e4 + 1] = gq.y; g[4 * e4 + 2] = gq.z; g[4 * e4 + 3] = gq.w; }
                float sm = 0.f;
#pragma unroll
                for (int e = 0; e < 16; ++e) sm += y[e];
                sm = scan::dpp_add<0xB1>(sm); sm = scan::dpp_add<0x4E>(sm);
                const float mean = sm * (1.f / 64.f); float vs = 0.f;
#pragma unroll
                for (int e = 0; e < 16; ++e) { y[e] -= mean; vs += y[e] * y[e]; }
                vs = scan::dpp_add<0xB1>(vs); vs = scan::dpp_add<0x4E>(vs);
                const float rstd = __builtin_amdgcn_rsqf(vs * (1.f / 64.f) + 64e-5f);
                const float rk = P.rdotk[m * 8 + vh];
                unsigned ow[8];
#pragma unroll
                for (int e = 0; e < 16; e += 2) { float o2[2];
#pragma unroll
                    for (int d = 0; d < 2; ++d) { const int ch = ch0 + e + d; const float v = vv[e + d] + (vp[e + d] - vv[e + d]) * P.mu[1024 + ch];
                        o2[d] = (y[e + d] * rstd * P.lnw[ch] + P.lnb[ch] + rk * v) * g[e + d]; }
                    ow[e >> 1] = pk2(o2[0], o2[1]); }
                *(GAS v4u*)(P.Q3 + m * QP + 512 + ch0) = (v4u){ow[0], ow[1], ow[2], ow[3]}; *(GAS v4u*)(P.Q3 + m * QP + 512 + ch0 + 8) = (v4u){ow[4], ow[5], ow[6], ow[7]};
            }
            __syncthreads();
        }
        __syncthreads();
    }
}
struct DPostP { const bf16* O1; const bf16* O2; bf16* Q3; const float *lq1, *lk1, *lq2, *lk2, *subln; float lambda_init; };
__device__ __forceinline__ void diff_post(const DPostP& P, int gw, int NGW, int lane) {
    const float lam = __expf(wave_sum(P.lq1[lane] * P.lk1[lane])) - __expf(wave_sum(P.lq2[lane] * P.lk2[lane])) + P.lambda_init;
    float sw[8];
#pragma unroll
    for (int e = 0; e < 8; ++e) sw[e] = P.subln[8 * (lane & 15) + e] * (1.f - P.lambda_init);
    constexpr int R = 8;
    for (int m0 = gw; m0 < M; m0 += R * NGW) {
        v4u a[R], c[R];
#pragma unroll
        for (int q = 0; q < R; ++q) { const size_t m = (size_t)(m0 + q * NGW); a[q] = *(const GAS v4u*)(P.O1 + m * 512 + 8 * lane); c[q] = *(const GAS v4u*)(P.O2 + m * 512 + 8 * lane); }
#pragma unroll
        for (int q = 0; q < R; ++q) { const size_t m = (size_t)(m0 + q * NGW);
            float x[8];
            x[0] = bflo(a[q].x) - lam * bflo(c[q].x); x[1] = bfhi(a[q].x) - lam * bfhi(c[q].x); x[2] = bflo(a[q].y) - lam * bflo(c[q].y); x[3] = bfhi(a[q].y) - lam * bfhi(c[q].y);
            x[4] = bflo(a[q].z) - lam * bflo(c[q].z); x[5] = bfhi(a[q].z) - lam * bfhi(c[q].z); x[6] = bflo(a[q].w) - lam * bflo(c[q].w); x[7] = bfhi(a[q].w) - lam * bfhi(c[q].w);
            float ss = 0.f;
#pragma unroll
            for (int e = 0; e < 8; ++e) ss += x[e] * x[e];
            const float r = __builtin_amdgcn_rsqf(scan::red16(ss) * (1.f / 128.f) + NORM_EPS);
            v4u o; o.x = pk2(x[0] * r * sw[0], x[1] * r * sw[1]); o.y = pk2(x[2] * r * sw[2], x[3] * r * sw[3]); o.z = pk2(x[4] * r * sw[4], x[5] * r * sw[5]); o.w = pk2(x[6] * r * sw[6], x[7] * r * sw[7]);
            *(GAS v4u*)(P.Q3 + m * QP + 1024 + 8 * lane) = o;
        }
    }
}

__device__ __forceinline__ int q_fetch(gu32* head, volatile LAS int* slot) {
    if (threadIdx.x == 0) *slot = (int)__hip_atomic_fetch_add(head, 1u, RLX_AGENT);
    __syncthreads();
    const int v = __builtin_amdgcn_readfirstlane(*slot);
    __syncthreads();
    return v;
}

struct Args { const float* in[32]; float* out; unsigned char* ws; int ph_lo, ph_hi; };
__device__ __forceinline__ const float* kin_(int i) { const char* ka = (const char*)__builtin_amdgcn_kernarg_segment_ptr(); unsigned off = (unsigned)i * 8u; asm volatile("" : "+s"(off)); return *(const float* const*)(ka + off); }
#define KIN(i) kin_(i)
#define XOUT ((float*)kin_(32))
#define XB ((bf16*)kin_(32))
#define XB2 ((bf16*)(wsl + WS_Q3))
#define OUTHI ((unsigned char*)kin_(32) + 32 * MiB)
__device__ __forceinline__ unsigned char* kws_() { return (unsigned char*)kin_(33); }
__device__ __forceinline__ int kint_(int byteoff) { const char* ka = (const char*)__builtin_amdgcn_kernarg_segment_ptr(); unsigned off = (unsigned)byteoff; asm volatile("" : "+s"(off)); return *(const int*)(ka + off); }
constexpr int PH_L = 14;
constexpr int N_PHASES = 1 + NLAYER * PH_L;

#define G ((int)gridDim.x)
#define bid ((int)blockIdx.x)
#define gw (bid * NWAVES + wave)
#define NGW (G * NWAVES)
#define MISC ((volatile LAS unsigned*)(lds + LDS_MISC))
#define IN(k) (kint_(272) <= (k) && (k) < kint_(276))
#define SEAM(k) do { if ((k) + 1 < kint_(276)) { XcdBarrier bar_; bar_.bar = (unsigned*)(kws_() + WS_CTL) + CW_BAR; bar_.x = xb_xcc_id(); bar_.st = MISC + 8; xcd_barrier(bar_); } } while (0)
#define WSL() unsigned char* wsl = kws_(); const int tid = otid_(), lane = tid & 63, wave = __builtin_amdgcn_readfirstlane(tid >> 6); (void)lane; (void)wave
#define WFu ((bf16*)(wsl + WS_WF))
#define WFd ((bf16*)(wsl + WS_WF_DOWN))
#define WMi ((bf16*)(wsl + WS_WM))
#define WMb ((bf16*)(wsl + WS_WM_BR))
#define WMo ((bf16*)(wsl + WS_WM_OUT))
#define XN ((bf16*)(wsl + WS_XN))
#define Q3 ((bf16*)(wsl + WS_Q3))
#define ZR ((bf16*)(wsl + WS_ZR))
#define YP ((bf16*)(wsl + WS_R2))
#define HB ZR
#define G3 ZR
#define MG ((bf16*)(wsl + WS_MG))
#define O1 ((bf16*)(wsl + WS_R2))
#define O2 ((bf16*)(wsl + WS_R2) + (size_t)M * 512)
#define YRAW ((bf16*)(wsl + WS_YRAW))
#define BITM ((unsigned*)OUTHI)
#define RDOTK ((float*)(wsl + WS_RDOTK))
#define X1B ((bf16*)(OUTHI + 16 * MiB))
#define KID ((bf16*)(wsl + WS_KID))
#define A8B ((unsigned char*)(wsl + WS_A8))
#define CTL ((gu32*)(wsl + WS_CTL))
#define cscr ((LAS float*)(lds + wave * 16384))

#define CONV_FFN(l_, f_) do { const int gi_ = (f_) ? 29 : 3; \
        MapUp mu_{KIN(gi_) + (size_t)(l_) * DM * FF, KIN(gi_ + 1) + (size_t)(l_) * DM * FF, FF}; MapIdent md_{KIN(gi_ + 2) + (size_t)(l_) * FF * DM, DM}; \
        constexpr int nu_ = conv_items(DM, 2 * FF), nd_ = conv_items(FF, DM); \
        for (int it_ = gw; it_ < nu_ + nd_; it_ += NGW) { if (it_ < nu_) conv_item(mu_, DM, WFu, cscr, it_, 2 * FF / 32, lane); else conv_item(md_, FF, WFd, cscr, it_ - nu_, DM / 32, lane); } } while (0)
#define CONV_MIX(l_) do { MapWin mw_{KIN(8) + (size_t)(l_) * DM * NIN, NIN}; MapIdent mo_{KIN(26) + (size_t)(l_) * DM * DM, DM}; \
        constexpr int ni_ = conv_items(DM, 8704), nb_ = conv_items(512, DM), no_ = conv_items(DM, DM); \
        for (int it_ = gw; it_ < ni_ + 3 * nb_ + no_; it_ += NGW) { \
            if (it_ < ni_) conv_item(mw_, DM, WMi, cscr, it_, 8704 / 32, lane); \
            else if (it_ < ni_ + 3 * nb_) { const int r_ = it_ - ni_, n_ = r_ / nb_; MapIdent mb_{KIN(25) + ((size_t)(l_) * 3 + n_) * 512 * DM, DM}; conv_item(mb_, 512, WMb + (size_t)n_ * DM * 512, cscr, r_ - n_ * nb_, DM / 32, lane); } \
            else conv_item(mo_, DM, WMo, cscr, it_ - ni_ - 3 * nb_, DM / 32, lane); } } while (0)

template <int L, int F> __device__ __forceinline__ void ffn_part(LAS unsigned char* lds) {
    constexpr int l = L, f = F, pb = 1 + PH_L * L, pf = pb + (F ? 11 : 0);
            if (IN(pf + 0)) { WSL();
                pg8::Gemm g{XN, WFu, M, 2 * FF, DM, DM}; pg8::StaticOrder S; S.init(M, 2 * FF, G, bid);
                pg8::EpiSwiGLU E{HB, FF};
                pg8::gemm_phase<pg8::EpiSwiGLU, pg8::StaticOrder, true, true>(lds, g, S, E);
                SEAM(pf + 0);
            }
            if (IN(pf + 1)) { WSL();
                pg8::Gemm g{HB, WFd, M, DM, FF, FF}; pg8::StaticOrder S; S.init(M, DM, G, bid);
                pg8::EpiStore<0> E{YP, DM, YP, DM, 1 << 30};
                pg8::gemm_phase<pg8::EpiStore<0>, pg8::StaticOrder, true, true>(lds, g, S, E);
                SEAM(pf + 1);
            }
            if (IN(pf + 2)) { WSL();
                const float* gpost = KIN(f ? 28 : 2) + l * DM;
                const float* gnext = f == 0 ? KIN(6) + l * DM : (l + 1 < NLAYER ? KIN(1) + (l + 1) * DM : nullptr);
#if PROBE
                float osc = 1.f;
                if (l == NLAYER - 1 && f == 1) { const float num = *(const float*)(wsl + WS_CTL + 4 * CW_PROBE), den = *(const float*)(wsl + WS_CTL + 4 * (CW_PROBE + 1)); osc = 1.f + 4.f * sqrtf(num / fmaxf(den, 1e-30f)); }
#else
                const float osc = 1.f;
#endif
                if constexpr (l == 0 && f == 0) rownorm_rows<false, true>(KIN(0), YP, 0.5f, gpost, XB, gnext, XN, gw, NGW, lane);
                else if constexpr (l == NLAYER - 1 && f == 1) rownorm_rows<true, false>(XB2, YP, 0.5f, gpost, XOUT, nullptr, nullptr, gw, NGW, lane, osc);
                else rownorm_rows<true, true>(XB, YP, 0.5f, gpost, XB, gnext, XN, gw, NGW, lane);
                if (f == 1 && l + 1 < NLAYER) { CONV_FFN(l + 1, 0); CONV_MIX(l + 1); }
                SEAM(pf + 2);
            }
}
template <int L> __device__ __forceinline__ void mixer_part(LAS unsigned char* lds, unsigned char* lds_) {
    constexpr int l = L, pb = 1 + PH_L * L;
            const int pm = pb + 3;
            if (IN(pm + 0)) { WSL();
                pg8::Gemm g{XN, WMi, M, 5632, DM, DM}; pg8::StaticOrder S; S.init(M, 5632, G, bid);
                pg8::EpiStore<0> E{Q3, QP, ZR, ZP, 6};
                pg8::gemm_phase<pg8::EpiStore<0>, pg8::StaticOrder, true, true>(lds, g, S, E);
                SEAM(pm + 0);
            }
            if (IN(pm + 1)) { WSL();
                PrepP pp{ZR, X1B, A8B, KID, KIN(9) + l * 1792, KIN(10) + l * 512, KIN(11) + l * 64 * 512, KIN(12) + l * 512, KIN(13) + l * 64 * 512};
                rwkv_prep(pp, lds);
                SEAM(pm + 1);
            }
            if (IN(pm + 2)) { WSL();
                volatile LAS int* slot = (volatile LAS int*)(MISC + 16);
                if (bid < 64) {
                    ScanP sp{Q3, ZR, X1B, A8B, YRAW, RDOTK, KIN(9) + l * 1792, KIN(15) + l * 512, KIN(16) + l * 512, KIN(17) + l * 512};
#ifndef NO_SCAN
                    rwkv_scan_unit(sp, bid, lds);
#ifdef SCAN_TWICE
                    rwkv_scan_unit(sp, bid, lds);
#endif
#endif
                }
                {
                    Dsa1P dp{ZR, KID, BITM, CTL + CW_DONE + 64 * 64 * l};
                    gu32* head = CTL + CW_Q + 64 * (3 * l + 0);
                    #ifndef NO_DSA1
                    for (int u = q_fetch(head, slot); u < 512; u = q_fetch(head, slot)) dsa1_unit(dp, u, lds);
#ifdef DUP_DSA1
                    { gu32* head2 = CTL + 10240 + 64 * (2 * l + 0); for (int u = q_fetch(head2, slot); u < 512; u = q_fetch(head2, slot)) dsa1_unit(dp, u, lds); }
#endif
#endif
                }
                {
                    gu32* head = CTL + CW_Q + 64 * (3 * l + 1);
                    typedef att::BlockRef<att::bf16, att::bf16> Ref;
#define DSA2_REF(i_, r_) do { const int qb_ = 31 - ((i_) >> 3), b_ = ((i_) >> 2) & 1, h_ = (i_) & 3; const size_t row_ = (size_t)b_ * T + 256 * qb_; \
        r_.Q = (const att::bf16*)(Q3 + row_ * QP + 128 * h_); r_.O = (att::bf16*)(Q3 + row_ * QP + 128 * h_); r_.K = (const att::bf16*)(ZR + (size_t)b_ * T * ZP + ZC_DK + 128 * h_); \
        r_.V = (const att::bf16*)(ZR + (size_t)b_ * T * ZP + ZC_DV + 128 * h_); r_.P0 = 256 * qb_; r_.koff = 0; r_.mask = BITM + row_ * 256; } while (0)
                    int ic = q_fetch(head, slot);
                    if (ic < 256) {
                        int in_ = q_fetch(head, slot);
                        Ref cur; DSA2_REF(ic, cur);
                        att::Seam<att::bf16> S;
                        att::causal_swa_prime<att::bf16, att::bf16, false>(cur, T, (char*)lds_, S);
                        for (;;) {
                            const bool last = in_ >= 256;
                            Ref nxt = cur; if (!last) DSA2_REF(in_, nxt);
                            {
                                if (tid == 0) { gu32* dw = CTL + CW_DONE + 64 * (64 * l + (((ic >> 2) & 1) * 32 + (31 - (ic >> 3)))); unsigned sp = 0;
                                    while (__hip_atomic_load(dw, RLX_AGENT) < 8u) { __builtin_amdgcn_s_sleep(2); if (++sp > (1u << 24)) { __hip_atomic_store(CTL + CW_TMO, 1u, RLX_AGENT); break; } }
                                    __builtin_amdgcn_fence(__ATOMIC_ACQUIRE, "agent"); asm volatile("s_waitcnt vmcnt(0)" ::: "memory"); }
                                __syncthreads();
                            }
#ifndef NO_DSA2
                            att::causal_swa_block<att::bf16, att::bf16, false, true, QP>(cur, nxt, T, T, (char*)lds_, S);
#endif
                            if (last) break;
                            cur = nxt; ic = in_; in_ = q_fetch(head, slot);
                        }
                    }
                }
                {
#ifdef DUP_DIFF
                  for (int rep_ = 0; rep_ < 2; ++rep_) {
                    gu32* head = rep_ ? CTL + 10240 + 64 * (2 * l + 1) : CTL + CW_Q + 64 * (3 * l + 2);
#else
                  {
                    gu32* head = CTL + CW_Q + 64 * (3 * l + 2);
#endif
                    typedef att::BlockRef<att::bf16, att::bf16> Ref;
#define DIFF_REF(i_, r_) do { const int qb_ = 31 - ((i_) >> 4), b_ = ((i_) >> 3) & 1, h_ = ((i_) >> 1) & 3, mp_ = (i_) & 1; const size_t row_ = (size_t)b_ * T + 256 * qb_; \
        r_.Q = (const att::bf16*)(Q3 + row_ * QP + 1024 + 128 * h_ + 64 * mp_); r_.O = (att::bf16*)((mp_ ? O2 : O1) + row_ * 512 + 128 * h_); \
        r_.K = (const att::bf16*)(ZR + (size_t)b_ * T * ZP + ZC_FK + 128 * h_); r_.V = (const att::bf16*)(ZR + (size_t)b_ * T * ZP + ZC_FV + 128 * h_); r_.P0 = 256 * qb_; r_.koff = 128 * mp_; r_.mask = nullptr; } while (0)
                    int ic = q_fetch(head, slot);
                    if (ic < 512) {
                        int in_ = q_fetch(head, slot);
                        Ref cur; DIFF_REF(ic, cur);
                        att::Seam<att::bf16> S;
                        att::causal_swa_prime<att::bf16, att::bf16, true>(cur, T, (char*)lds_, S);
                        for (;;) {
                            const bool last = in_ >= 512;
                            Ref nxt = cur; if (!last) DIFF_REF(in_, nxt);
#ifndef NO_DIFF
                            att::causal_swa_block<att::bf16, att::bf16, true, false, 512>(cur, nxt, T, T, (char*)lds_, S);
#endif
                            if (last) break;
                            cur = nxt; ic = in_; in_ = q_fetch(head, slot);
                        }
                    }
                  }
                }
                SEAM(pm + 2);
            }
            if (IN(pm + 3)) { WSL();
                RPostP rp{ZR, Q3, YRAW, RDOTK, KIN(9) + l * 1792, KIN(14) + l * 128 * 512, KIN(18) + l * 512, KIN(19) + l * 512};
#ifndef NO_RPOST
                rwkv_post(rp, lds);
#endif
                constexpr float lambda_init = L == 0 ? 0.2f : 0.35550906759096927f;
                DPostP dq{O1, O2, Q3, KIN(20) + l * 64, KIN(21) + l * 64, KIN(22) + l * 64, KIN(23) + l * 64, KIN(24) + l * 128, lambda_init};
                diff_post(dq, gw, NGW, lane);
                SEAM(pm + 3);
            }
            if (IN(pm + 4)) { WSL();
                pg8::Gemm g{XN, WMi + (size_t)5632 * DM, M, 3072, DM, DM}; pg8::StaticOrder S; S.init(M, 3072, G, bid);
#ifdef GATE_RAW
                pg8::EpiStore<0> E{G3, 3072, G3, 3072, 1 << 30};
                pg8::gemm_phase<pg8::EpiStore<0>, pg8::StaticOrder, true, true>(lds, g, S, E);
#else
                pg8::EpiStore<1> E{G3, 3072, G3, 3072, 1 << 30};
                pg8::gemm_phase<pg8::EpiStore<1>, pg8::StaticOrder, true, true>(lds, g, S, E);
#endif
                SEAM(pm + 4);
            }
            if (IN(pm + 5)) { WSL();
#pragma unroll 1
                for (int n = 0; n < 3; ++n) {
                    pg8::Gemm g{Q3 + 512 * n, WMb + (size_t)n * DM * 512, M, DM, 512, QP}; pg8::StaticOrder S; S.init(M, DM, G, bid);
                    pg8::EpiGateMul E{MG, DM, G3 + 1024 * n, 3072, n == 0 ? 1 : 0};
                    pg8::gemm_phase<pg8::EpiGateMul, pg8::StaticOrder, false, true>(lds, g, S, E);
                    VM_WAIT(); __syncthreads();
                }
                SEAM(pm + 5);
            }
            if (IN(pm + 6)) { WSL();
                pg8::Gemm g{MG, WMo, M, DM, DM, DM}; pg8::StaticOrder S; S.init(M, DM, G, bid);
                pg8::EpiStore<0> E{YP, DM, YP, DM, 1 << 30};
                pg8::gemm_phase<pg8::EpiStore<0>, pg8::StaticOrder, false, true>(lds, g, S, E);
                SEAM(pm + 6);
            }
            if (IN(pm + 7)) { WSL();
                rownorm_rows<true, true>(XB, YP, 1.0f, KIN(7) + l * DM, l == NLAYER - 1 ? XB2 : XB, KIN(27) + l * DM, XN, gw, NGW, lane);
                CONV_FFN(l, 1);
                SEAM(pm + 7);
            }
}

__global__ void __launch_bounds__(NWAVES * 64, 2) mk_fwd(Args args) {
    extern __shared__ __attribute__((aligned(16))) unsigned char lds_[];
    LAS unsigned char* lds = (LAS unsigned char*)lds_;
    { const int tid = otid_(); if (tid < 64) MISC[tid] = 0u; }
    __syncthreads();
    (void)xcd_barrier_post((unsigned*)(kws_() + WS_CTL) + CW_BAR, MISC + 8);
    if (IN(0)) { WSL();
        CONV_FFN(0, 0); CONV_MIX(0);
        rownorm_rows<false, false>(KIN(0), nullptr, 0.f, nullptr, nullptr, KIN(1), XN, gw, NGW, lane);
        SEAM(0);
    }
    ffn_part<0, 0>(lds); mixer_part<0>(lds, lds_); ffn_part<0, 1>(lds);
    ffn_part<1, 0>(lds); mixer_part<1>(lds, lds_); ffn_part<1, 1>(lds);
}

#if PROBE
__device__ __forceinline__ void probe_acc(float num, float den, float* ctlf) {
    __shared__ float rn[256], rd[256];
    rn[threadIdx.x] = num; rd[threadIdx.x] = den; __syncthreads();
    for (int o = 128; o > 0; o >>= 1) { if ((int)threadIdx.x < o) { rn[threadIdx.x] += rn[threadIdx.x + o]; rd[threadIdx.x] += rd[threadIdx.x + o]; } __syncthreads(); }
    if (threadIdx.x == 0) { atomicAdd(ctlf + CW_PROBE, rn[0]); atomicAdd(ctlf + CW_PROBE + 1, rd[0]); }
}
__global__ void __launch_bounds__(256) probe_ffn(const unsigned char* ws, const float* Wg, const float* Wu, const float* Wd) {
    __shared__ float xn[1024]; __shared__ float hid[2816];
    const int m = 777 + 1931 * blockIdx.x, tid = threadIdx.x;
    const bf16* XNp = (const bf16*)(ws + WS_XN); const bf16* YPp = (const bf16*)(ws + WS_R2);
    for (int k = tid; k < 1024; k += 256) xn[k] = bf1(XNp[(size_t)m * 1024 + k]);
    __syncthreads();
    for (int j = tid; j < 2816; j += 256) { float g = 0.f, u = 0.f; for (int k = 0; k < 1024; ++k) { g += xn[k] * Wg[(size_t)k * 2816 + j]; u += xn[k] * Wu[(size_t)k * 2816 + j]; } hid[j] = g / (1.f + expf(-g)) * u; }
    __syncthreads();
    float num = 0.f, den = 0.f;
    for (int d = tid; d < 1024; d += 256) { float o = 0.f; for (int j = 0; j < 2816; ++j) o += hid[j] * Wd[(size_t)j * 1024 + d]; const float got = bf1(YPp[(size_t)m * 1024 + d]); num += (o - got) * (o - got); den += o * o; }
    probe_acc(num, den, (float*)(ws + WS_CTL));
}
__global__ void __launch_bounds__(256) probe_win(const unsigned char* ws, const float* Win) {
    __shared__ float xn[1024];
    const int m = 555 + 1999 * blockIdx.x, tid = threadIdx.x;
    const bf16* XNp = (const bf16*)(ws + WS_XN); const bf16* Q3p = (const bf16*)(ws + WS_Q3); const bf16* ZRp = (const bf16*)(ws + WS_ZR);
    for (int k = tid; k < 1024; k += 256) xn[k] = bf1(XNp[(size_t)m * 1024 + k]);
    __syncthreads();
    float num = 0.f, den = 0.f;
    for (int c = tid; c < 5448; c += 256) {
        float z = 0.f; for (int k = 0; k < 1024; ++k) z += xn[k] * Win[(size_t)k * NIN + c];
        float got;
        if (c < 512) got = bf1(Q3p[(size_t)m * QP + c]);
        else if (c < 2120) got = bf1(ZRp[(size_t)m * ZP + (c - 512)]);
        else if (c < 2632) got = bf1(Q3p[(size_t)m * QP + 512 + (c - 2120)]);
        else if (c < 3912) got = bf1(ZRp[(size_t)m * ZP + (c - 840)]);
        else if (c < 4424) got = bf1(Q3p[(size_t)m * QP + 1024 + (c - 3912)]);
        else got = bf1(ZRp[(size_t)m * ZP + (c - 1352)]);
        num += (z - got) * (z - got); den += z * z;
    }
    probe_acc(num, den, (float*)(ws + WS_CTL));
}
__global__ void __launch_bounds__(256) probe_wconv(const unsigned char* ws, const float* Win, int r0) {
    const bf16* WMp = (const bf16*)(ws + WS_WM); const int tid = threadIdx.x;
    float num = 0.f, den = 0.f;
    for (int rr = 0; rr < 64; ++rr) { const int n = r0 + 64 * blockIdx.x + rr; MapWin mw{Win, NIN}; const float* cp = mw.col(n);
        for (int k = tid; k < 1024; k += 256) { const float ref = cp ? cp[(size_t)k * NIN] : 0.f; const float got = bf1(WMp[(size_t)n * 1024 + k]); num += (ref - got) * (ref - got); den += ref * ref; } }
    probe_acc(num, den, (float*)(ws + WS_CTL));
}
__global__ void __launch_bounds__(256) probe_merge(const unsigned char* ws, const float* Win, const float* Wb, const float* Wo, int which) {
    __shared__ float xn[1024]; __shared__ float y[1536]; __shared__ float mg[1024];
    const int m = 333 + 2003 * blockIdx.x, tid = threadIdx.x;
    const bf16* XNp = (const bf16*)(ws + WS_XN); const bf16* Q3p = (const bf16*)(ws + WS_Q3); const bf16* MGp = (const bf16*)(ws + WS_MG); const bf16* YPp = (const bf16*)(ws + WS_R2);
    for (int k = tid; k < 1024; k += 256) xn[k] = bf1(XNp[(size_t)m * 1024 + k]);
    for (int k = tid; k < 1536; k += 256) y[k] = bf1(Q3p[(size_t)m * QP + k]);
    __syncthreads();
    float num = 0.f, den = 0.f;
    for (int d = tid; d < 1024; d += 256) {
        float acc = 0.f;
        for (int n = 0; n < 3; ++n) { float g = 0.f; for (int k = 0; k < 1024; ++k) g += xn[k] * Win[(size_t)k * NIN + 5448 + n * 1024 + d];
            float p = 0.f; for (int c = 0; c < 512; ++c) p += y[512 * n + c] * Wb[((size_t)n * 512 + c) * 1024 + d];
            acc += p / (1.f + expf(-g)); }
        mg[d] = acc; const float got = bf1(MGp[(size_t)m * 1024 + d]); if (which == 0) { num += (acc - got) * (acc - got); den += acc * acc; }
        if (which == 2) { const bf16* G3p = (const bf16*)(ws + WS_ZR); for (int n = 0; n < 3; ++n) { float g = 0.f; for (int k = 0; k < 1024; ++k) g += xn[k] * Win[(size_t)k * NIN + 5448 + n * 1024 + d];
            const float sg = 1.f / (1.f + expf(-g)), gg = bf1(G3p[(size_t)m * 3072 + n * 1024 + d]); num += (sg - gg) * (sg - gg); den += sg * sg; } }
        if (which == 3) { const bf16* G3p = (const bf16*)(ws + WS_ZR); float a2 = 0.f; for (int n = 0; n < 3; ++n) { float p = 0.f; for (int c = 0; c < 512; ++c) p += y[512 * n + c] * Wb[((size_t)n * 512 + c) * 1024 + d];
            a2 += p * bf1(G3p[(size_t)m * 3072 + n * 1024 + d]); } num += (a2 - got) * (a2 - got); den += a2 * a2; }
    }
    __syncthreads();
    if (which == 1) for (int d = tid; d < 1024; d += 256) { float o = 0.f; for (int j = 0; j < 1024; ++j) o += mg[j] * Wo[(size_t)j * 1024 + d]; const float got = bf1(YPp[(size_t)m * 1024 + d]); num += (o - got) * (o - got); den += o * o; }
    probe_acc(num, den, (float*)(ws + WS_CTL));
}
#endif
#ifndef MK_ONE_LAUNCH
#define MK_ONE_LAUNCH 0
#endif
extern "C" void kernel_launch(void* const* d_in, const int* in_sizes, int n_in, void* d_out, int out_size, void* d_ws, size_t ws_size, hipStream_t stream) {
    static int grid = 0;
    if (grid == 0) {
        if (n_in != 32 || in_sizes[0] != M * DM || out_size != M * DM || ws_size < WS_END) { fprintf(stderr, "kernel_launch: unexpected shapes / workspace (n_in %d, ws %zu)\n", n_in, ws_size); grid = -1; return; }
        int dev = 0, cus = 0;
        if (hipGetDevice(&dev) != hipSuccess || hipDeviceGetAttribute(&cus, hipDeviceAttributeMultiprocessorCount, dev) != hipSuccess) { grid = -1; return; }
        if (hipFuncSetAttribute((const void*)mk_fwd, hipFuncAttributeMaxDynamicSharedMemorySize, LDS_BYTES) != hipSuccess) { fprintf(stderr, "kernel_launch: hipFuncSetAttribute failed\n"); grid = -1; return; }
        int per_cu = 0;
        if (hipOccupancyMaxActiveBlocksPerMultiprocessor(&per_cu, (const void*)mk_fwd, NWAVES * 64, LDS_BYTES) != hipSuccess || per_cu < 1) { fprintf(stderr, "kernel_launch: occupancy query says %d\n", per_cu); }
        (void)hipGetLastError();
        grid = cus;
    }
    if (grid < 0) return;
    (void)hipMemsetAsync((char*)d_ws + WS_CTL, 0, CTL_ZERO_BYTES, stream);
    Args a{};
    for (int i = 0; i < 32; ++i) a.in[i] = (const float*)d_in[i];
    a.out = (float*)d_out; a.ws = (unsigned char*)d_ws;
#if MK_ONE_LAUNCH
    a.ph_lo = 0; a.ph_hi = N_PHASES;
    hipLaunchKernelGGL(mk_fwd, dim3(grid), dim3(NWAVES * 64), LDS_BYTES, stream, a);
#else
    for (int p = 0; p < N_PHASES; ++p) { a.ph_lo = p; a.ph_hi = p + 1; hipLaunchKernelGGL(mk_fwd, dim3(grid), dim3(NWAVES * 64), LDS_BYTES, stream, a);
#if PROBE == 1
        if (p == 2) hipLaunchKernelGGL(probe_ffn, dim3(8), dim3(256), 0, stream, (const unsigned char*)d_ws, a.in[3], a.in[4], a.in[5]);
#elif PROBE == 2
        if (p == 4) hipLaunchKernelGGL(probe_win, dim3(8), dim3(256), 0, stream, (const unsigned char*)d_ws, a.in[8]);
#elif PROBE == 3
        if (p == 8) hipLaunchKernelGGL(probe_merge, dim3(8), dim3(256), 0, stream, (const unsigned char*)d_ws, a.in[8], a.in[25], a.in[26], 0);
#elif PROBE == 5
        if (p == 8) hipLaunchKernelGGL(probe_merge, dim3(8), dim3(256), 0, stream, (const unsigned char*)d_ws, a.in[8], a.in[25], a.in[26], 2);
#elif PROBE == 6
        if (p == 8) hipLaunchKernelGGL(probe_merge, dim3(8), dim3(256), 0, stream, (const unsigned char*)d_ws, a.in[8], a.in[25], a.in[26], 3);
#elif PROBE == 7
        if (p == 6) hipLaunchKernelGGL(probe_wconv, dim3(48), dim3(256), 0, stream, (const unsigned char*)d_ws, a.in[8], 5632);
#elif PROBE == 8
        if (p == 3) hipLaunchKernelGGL(probe_wconv, dim3(48), dim3(256), 0, stream, (const unsigned char*)d_ws, a.in[8], 5632);
#elif PROBE == 9
        if (p == 7) hipLaunchKernelGGL(probe_merge, dim3(8), dim3(256), 0, stream, (const unsigned char*)d_ws, a.in[8], a.in[25], a.in[26], 2);
#elif PROBE == 4
        if (p == 9) hipLaunchKernelGGL(probe_merge, dim3(8), dim3(256), 0, stream, (const unsigned char*)d_ws, a.in[8], a.in[25], a.in[26], 1);
#endif
    }
#endif
}
```

```cpp
#include <hip/hip_runtime.h>
#include <hip/hip_bf16.h>
#include <cstdio>
#include <cstdint>
#define MK_ONE_LAUNCH 1
#define GATE_RAW 1

__device__ __forceinline__ int otid_() { int t = (int)threadIdx.x; asm volatile("" : "+v"(t)); return t; }
namespace pg8 {
#define PG8_LAS __attribute__((address_space(3)))
typedef unsigned short bf16_t;
typedef short bf16x8 __attribute__((ext_vector_type(8)));
typedef float f32x4 __attribute__((ext_vector_type(4)));
typedef unsigned u32x4 __attribute__((ext_vector_type(4)));
constexpr int BM = 256, BK = 64, HALF = 128, HTB = HALF * BK * 2  , STAGE_BYTES = 8 * HTB, NXCD = 8, WGM = 8;

__host__ __device__ __forceinline__ int lds_byte(int r, int c) { const int st = (r >> 4) * 2 + (c >> 5), rr = r & 15, cc = c & 31, ob = rr * 64 + cc * 2; return st * 1024 + (ob ^ (((ob >> 9) & 1) << 5)); }
__host__ __device__ __forceinline__ void stage_rc(int b, int& R, int& C) { const int st = b / 1024, sb = b % 1024, swz = sb ^ (((sb >> 9) & 1) << 5); R = (st >> 1) * 16 + swz / 64; C = (st & 1) * 32 + (swz % 64) / 2; }
__host__ __device__ __forceinline__ int perm32(int rho) { const int n = rho >> 4, i = rho & 15; return 8 * (i >> 2) + 4 * n + (i & 3); }

struct Unit { int pm, pn; };
struct Gemm { const bf16_t* A; const bf16_t* Bt; int M, N, K, lda; };

struct StaticOrder {
    int nM, nN, nwg, G, c;
    __host__ __device__ void init(int M, int N, int G_, int c_) { nM = M / BM; nN = N / BM; nwg = nM * nN; G = G_; c = c_; }
    __host__ __device__ bool next(int i, Unit& u) const {
        const long L = (long)i * G + c; if (L >= nwg) return false;
        int wgid = (int)L; { const int q = nwg / NXCD, r = nwg % NXCD, xcd = wgid % NXCD, off = wgid / NXCD; wgid = (xcd < r ? xcd * (q + 1) : r * (q + 1) + (xcd - r) * q) + off; }
        const int nig = WGM * nN, gid = wgid / nig, fm = gid * WGM, gsz = (nM - fm) < WGM ? (nM - fm) : WGM;
        u.pm = fm + ((wgid % nig) % gsz); u.pn = (wgid % nig) / gsz; return true;
    }
    __device__ __forceinline__ void a_ready(const Unit&) const {}
    __device__ __forceinline__ void done(const Unit&) const {}
};

__device__ __forceinline__ unsigned cvt_pk_bf16(float lo, float hi) { unsigned r; asm volatile("v_cvt_pk_bf16_f32 %0, %1, %2" : "=v"(r) : "v"(lo), "v"(hi)); return r; }

template <class Epi, class Sched, bool ALIGN_EPI = false, bool SP2 = false>
__device__ __forceinline__ void gemm_phase(PG8_LAS unsigned char* lds, const Gemm g, const Sched& S, const Epi& E) {
    const int tid = otid_(), wid = __builtin_amdgcn_readfirstlane(tid >> 6), lane = tid & 63, wr = wid >> 2, wc = wid & 3, fr = lane & 15, fq = lane >> 4;
    const int K = g.K, nt = K / BK;
    unsigned voffA[2], voffB[2];
#pragma unroll
    for (int i = 0; i < 2; ++i) { int R, C; stage_rc(tid * 16 + i * 8192, R, C); const int Rb = Epi::PERM ? ((R & ~31) + perm32(R & 31)) : R;
        voffA[i] = (unsigned)(R * g.lda + C) * 2u; voffB[i] = (unsigned)(Rb * K + C) * 2u; }
    const size_t kstep = (size_t)(BK * 2);
    const size_t hstepB = (size_t)HALF * K * 2, hstepA = (size_t)HALF * g.lda * 2;
    const size_t tstepB = 2 * hstepB, tstepA = 2 * hstepA;
    const unsigned ldsw = (unsigned)wid * 1024u;
    const int aoff = lds_byte(wr * 64 + fr, fq * 8), boff = lds_byte(wc * 32 + fr, fq * 8);
#define PG8_SA(b, h) (((b) * 2 + (h)) * HTB)
#define PG8_SB(b, h) ((4 + (b) * 2 + (h)) * HTB)
#define PG8_STAGE(bufoff, gbase, voff) do { _Pragma("unroll") for (int _i = 0; _i < 2; ++_i) \
        __builtin_amdgcn_global_load_lds((const unsigned*)((const char*)(gbase) + (voff)[_i]), (PG8_LAS unsigned*)(lds + (bufoff) + ldsw + _i * 8192), 16, 0, 0); } while (0)
#define PG8_LDA(dst, b, h) do { _Pragma("unroll") for (int m = 0; m < 4; ++m) _Pragma("unroll") for (int k = 0; k < 2; ++k) dst[m][k] = *(const PG8_LAS bf16x8*)(lds + PG8_SA(b, h) + aoff + m * 2048 + k * 1024); } while (0)
#define PG8_LDB(dst, b, h) do { _Pragma("unroll") for (int n = 0; n < 2; ++n) _Pragma("unroll") for (int k = 0; k < 2; ++k) dst[n][k] = *(const PG8_LAS bf16x8*)(lds + PG8_SB(b, h) + boff + n * 2048 + k * 1024); } while (0)
#define PG8_MMA(ai, bj, At, Bt) do { __builtin_amdgcn_s_setprio(1); _Pragma("unroll") for (int m = 0; m < 4; ++m) _Pragma("unroll") for (int n = 0; n < 2; ++n) _Pragma("unroll") for (int k = 0; k < 2; ++k) \
        acc[ai][bj][m][n] = __builtin_amdgcn_mfma_f32_16x16x32_bf16(Bt[n][k], At[m][k], acc[ai][bj][m][n], 0, 0, 0); __builtin_amdgcn_s_setprio(0); } while (0)
#define PG8_WAIT_V(n) asm volatile("s_waitcnt vmcnt(" #n ")" ::: "memory")
#define PG8_WAIT_L(n) asm volatile("s_waitcnt lgkmcnt(" #n ")" ::: "memory")
#define PG8_BAR __builtin_amdgcn_s_barrier()
#define PG8_SCHED __builtin_amdgcn_sched_barrier(0)
    Unit cur, nxt; int ui = 0;
    if (!S.next(0, cur)) return;
    f32x4 acc[2][2][4][2];
#pragma unroll
    for (int a = 0; a < 2; ++a)
#pragma unroll
        for (int b = 0; b < 2; ++b)
#pragma unroll
            for (int m = 0; m < 4; ++m)
#pragma unroll
                for (int n = 0; n < 2; ++n) acc[a][b][m][n] = (f32x4){0.f, 0.f, 0.f, 0.f};
    bf16x8 At[4][2], B0[2][2], B1[2][2];
    const char* cA = (const char*)g.A + (size_t)cur.pm * tstepA; const char* cB = (const char*)g.Bt + (size_t)cur.pn * tstepB;
    S.a_ready(cur);
    if constexpr (SP2) {
        PG8_STAGE(PG8_SB(0, 0), cB, voffB); PG8_STAGE(PG8_SB(0, 1), cB + hstepB, voffB); PG8_STAGE(PG8_SA(0, 0), cA, voffA); PG8_STAGE(PG8_SA(0, 1), cA + hstepA, voffA);
        if (wr == 1) PG8_BAR;
        PG8_WAIT_V(2); PG8_BAR;
        PG8_STAGE(PG8_SB(1, 0), cB + kstep, voffB); PG8_STAGE(PG8_SA(1, 0), cA + kstep, voffA); PG8_STAGE(PG8_SB(1, 1), cB + hstepB + kstep, voffB);
        PG8_WAIT_V(6); PG8_BAR;
    } else {
        PG8_STAGE(PG8_SB(0, 0), cB, voffB); PG8_STAGE(PG8_SA(0, 0), cA, voffA); PG8_STAGE(PG8_SB(0, 1), cB + hstepB, voffB); PG8_STAGE(PG8_SA(0, 1), cA + hstepA, voffA);
        if (wr == 1) PG8_BAR;
        PG8_WAIT_V(4); PG8_BAR;
        PG8_STAGE(PG8_SB(1, 0), cB + kstep, voffB); PG8_STAGE(PG8_SA(1, 0), cA + kstep, voffA); PG8_STAGE(PG8_SB(1, 1), cB + hstepB + kstep, voffB);
        PG8_WAIT_V(6); PG8_BAR;
    }
    for (;;) {
        const bool has_next = S.next(ui + 1, nxt);
        const char* nA = has_next ? (const char*)g.A + (size_t)nxt.pm * tstepA : cA; const char* nB = has_next ? (const char*)g.Bt + (size_t)nxt.pn * tstepB : cB;
        for (int t = 0; t < nt; t += 2) {
            const bool last = (t == nt - 2);
            const char* a1 = cA + (size_t)(t + 1) * kstep;
            const char* a2 = last ? nA : cA + (size_t)(t + 2) * kstep; const char* b2 = last ? nB : cB + (size_t)(t + 2) * kstep;
            const char* a3 = a2 + kstep; const char* b3 = b2 + kstep;
            if (last && has_next) S.a_ready(nxt);
            if constexpr (SP2) {
            PG8_LDB(B0, 0, 0); PG8_LDB(B1, 0, 1); PG8_SCHED; PG8_LDA(At, 0, 0); PG8_STAGE(PG8_SA(1, 1), a1 + hstepA, voffA);
            PG8_WAIT_V(8); PG8_WAIT_L(0); PG8_BAR; PG8_MMA(0, 0, At, B0); PG8_MMA(0, 1, At, B1); PG8_BAR; PG8_SCHED;
            PG8_LDA(At, 0, 1); PG8_STAGE(PG8_SB(0, 0), b2, voffB); PG8_STAGE(PG8_SB(0, 1), b2 + hstepB, voffB); PG8_STAGE(PG8_SA(0, 0), a2, voffA);
            PG8_WAIT_V(8); PG8_WAIT_L(0); PG8_BAR; PG8_MMA(1, 0, At, B0); PG8_MMA(1, 1, At, B1); PG8_BAR; PG8_SCHED;
            PG8_LDB(B0, 1, 0); PG8_LDB(B1, 1, 1); PG8_SCHED; PG8_LDA(At, 1, 0); PG8_STAGE(PG8_SA(0, 1), a2 + hstepA, voffA);
            PG8_WAIT_V(8); PG8_WAIT_L(0); PG8_BAR; PG8_MMA(0, 0, At, B0); PG8_MMA(0, 1, At, B1); PG8_BAR; PG8_SCHED;
            PG8_LDA(At, 1, 1); PG8_STAGE(PG8_SB(1, 0), b3, voffB); PG8_STAGE(PG8_SB(1, 1), b3 + hstepB, voffB); PG8_STAGE(PG8_SA(1, 0), a3, voffA);
            PG8_WAIT_V(8); PG8_WAIT_L(0); PG8_BAR; PG8_MMA(1, 0, At, B0); PG8_MMA(1, 1, At, B1); PG8_BAR; PG8_SCHED;
            } else {
            PG8_LDB(B0, 0, 0); PG8_SCHED; PG8_LDA(At, 0, 0); PG8_STAGE(PG8_SA(1, 1), a1 + hstepA, voffA);
            PG8_WAIT_L(8); PG8_BAR; PG8_WAIT_L(0); PG8_MMA(0, 0, At, B0); PG8_BAR; PG8_SCHED;
            PG8_LDB(B1, 0, 1); PG8_STAGE(PG8_SB(0, 0), b2, voffB);
            PG8_BAR; PG8_WAIT_L(0); PG8_MMA(0, 1, At, B1); PG8_BAR;
            PG8_LDA(At, 0, 1); PG8_STAGE(PG8_SA(0, 0), a2, voffA);
            PG8_BAR; PG8_WAIT_L(0); PG8_MMA(1, 0, At, B0); PG8_BAR; PG8_SCHED;
            PG8_STAGE(PG8_SB(0, 1), b2 + hstepB, voffB);
            PG8_WAIT_V(6); PG8_BAR; PG8_MMA(1, 1, At, B1); PG8_BAR;
            PG8_LDB(B0, 1, 0); PG8_SCHED; PG8_LDA(At, 1, 0); PG8_STAGE(PG8_SA(0, 1), a2 + hstepA, voffA);
            PG8_WAIT_L(8); PG8_BAR; PG8_WAIT_L(0); PG8_MMA(0, 0, At, B0); PG8_BAR; PG8_SCHED;
            PG8_LDB(B1, 1, 1); PG8_STAGE(PG8_SB(1, 0), b3, voffB);
            PG8_BAR; PG8_WAIT_L(0); PG8_MMA(0, 1, At, B1); PG8_BAR;
            PG8_LDA(At, 1, 1); PG8_STAGE(PG8_SA(1, 0), a3, voffA);
            PG8_BAR; PG8_WAIT_L(0); PG8_MMA(1, 0, At, B0); PG8_BAR; PG8_SCHED;
            PG8_STAGE(PG8_SB(1, 1), b3 + hstepB, voffB);
            PG8_WAIT_V(6); PG8_BAR; PG8_MMA(1, 1, At, B1); PG8_BAR;
            }
        }
        if constexpr (ALIGN_EPI) { if (wr == 0) PG8_BAR; }
        if constexpr (!Epi::AFTER_DRAIN) { E(acc, cur, wr, wc, fr, fq); S.done(cur); }
        if (!has_next) break;
#pragma unroll
        for (int a = 0; a < 2; ++a)
#pragma unroll
            for (int b = 0; b < 2; ++b)
#pragma unroll
                for (int m = 0; m < 4; ++m)
#pragma unroll
                    for (int n = 0; n < 2; ++n) acc[a][b][m][n] = (f32x4){0.f, 0.f, 0.f, 0.f};
        cur = nxt; cA = nA; cB = nB; ++ui;
        if constexpr (ALIGN_EPI) { if (wr == 1) PG8_BAR; }
    }
    PG8_WAIT_V(0);
    if constexpr (!ALIGN_EPI) { if (wr == 0) PG8_BAR; }
    PG8_BAR;
    if constexpr (Epi::AFTER_DRAIN) { E.fused(acc, cur, wr, wc, fr, fq, lds, wid, lane); S.done(cur); }
#undef PG8_SA
#undef PG8_SB
#undef PG8_STAGE
#undef PG8_LDA
#undef PG8_LDB
#undef PG8_MMA
#undef PG8_WAIT_V
#undef PG8_WAIT_L
#undef PG8_BAR
#undef PG8_SCHED
}
}
namespace pg8 {
typedef unsigned u32x2 __attribute__((ext_vector_type(2)));
__device__ __forceinline__ float bf_lo(unsigned w) { return __uint_as_float(w << 16); }
__device__ __forceinline__ float bf_hi(unsigned w) { return __uint_as_float(w & 0xffff0000u); }
__device__ __forceinline__ float sigmoidf_(float x) { return __builtin_amdgcn_rcpf(1.0f + __expf(-x)); }

struct EpiSwiGLU {
    static constexpr bool PERM = false, AFTER_DRAIN = false;
    bf16_t* H; int ldh;
    __device__ __forceinline__ void operator()(const f32x4 (&acc)[2][2][4][2], const Unit& u, int wr, int wc, int fr, int fq) const {
        const int row0 = u.pm * BM + wr * 64 + fr, hc0 = u.pn * 128 + wc * 16 + 4 * fq;
#pragma unroll
        for (int ai = 0; ai < 2; ++ai)
#pragma unroll
            for (int m = 0; m < 4; ++m) { bf16_t* rowp = H + (size_t)(row0 + ai * HALF + m * 16) * ldh + hc0;
#pragma unroll
                for (int bj = 0; bj < 2; ++bj) { const f32x4 g = acc[ai][bj][m][0], up = acc[ai][bj][m][1]; float h[4];
#pragma unroll
                    for (int e = 0; e < 4; ++e) h[e] = g[e] * sigmoidf_(g[e]) * up[e];
                    u32x2 w; w.x = cvt_pk_bf16(h[0], h[1]); w.y = cvt_pk_bf16(h[2], h[3]);
                    *(u32x2*)(rowp + bj * 64) = w; } }
    }
};
template <int ACT> struct EpiStore {
    static constexpr bool PERM = true, AFTER_DRAIN = false;
    bf16_t* O0; int ld0; bf16_t* O1; int ld1; int split_tiles;
    __device__ __forceinline__ void operator()(const f32x4 (&acc)[2][2][4][2], const Unit& u, int wr, int wc, int fr, int fq) const {
        const int row0 = u.pm * BM + wr * 64 + fr;
        bf16_t* base; int ld, colt;
        if (u.pn < split_tiles) { base = O0; ld = ld0; colt = u.pn * BM; } else { base = O1; ld = ld1; colt = (u.pn - split_tiles) * BM; }
        const int col0 = colt + wc * 32 + 8 * fq;
#pragma unroll
        for (int ai = 0; ai < 2; ++ai)
#pragma unroll
            for (int m = 0; m < 4; ++m) { bf16_t* rowp = base + (size_t)(row0 + ai * HALF + m * 16) * ld + col0;
#pragma unroll
                for (int bj = 0; bj < 2; ++bj) { f32x4 v0 = acc[ai][bj][m][0], v1 = acc[ai][bj][m][1];
                    if (ACT == 1) {
#pragma unroll
                        for (int e = 0; e < 4; ++e) { v0[e] = sigmoidf_(v0[e]); v1[e] = sigmoidf_(v1[e]); } }
                    u32x4 w; w.x = cvt_pk_bf16(v0[0], v0[1]); w.y = cvt_pk_bf16(v0[2], v0[3]); w.z = cvt_pk_bf16(v1[0], v1[1]); w.w = cvt_pk_bf16(v1[2], v1[3]);
                    *(u32x4*)(rowp + bj * HALF) = w; } }
    }
};
#ifdef GATE_RAW
#define GSIG(x) sigmoidf_(x)
#else
#define GSIG(x) (x)
#endif
struct EpiGateMul {
    static constexpr bool PERM = true, AFTER_DRAIN = false;
    bf16_t* MG; int ldm; const bf16_t* G; int ldg; int first;
    __device__ __forceinline__ void operator()(const f32x4 (&acc)[2][2][4][2], const Unit& u, int wr, int wc, int fr, int fq) const {
        const int row0 = u.pm * BM + wr * 64 + fr, col0 = u.pn * BM + wc * 32 + 8 * fq;
#pragma unroll
        for (int ai = 0; ai < 2; ++ai) {
            u32x4 g[8], p[8];
#pragma unroll
            for (int m = 0; m < 4; ++m)
#pragma unroll
                for (int bj = 0; bj < 2; ++bj) { const size_t r = (size_t)(row0 + ai * HALF + m * 16);
                    g[2 * m + bj] = *(const u32x4*)(G + r * ldg + col0 + bj * HALF);
                    if (!first) p[2 * m + bj] = *(const u32x4*)(MG + r * ldm + col0 + bj * HALF); }
#pragma unroll
            for (int m = 0; m < 4; ++m)
#pragma unroll
                for (int bj = 0; bj < 2; ++bj) { const size_t r = (size_t)(row0 + ai * HALF + m * 16);
                    const f32x4 v0 = acc[ai][bj][m][0], v1 = acc[ai][bj][m][1]; const u32x4 gg = g[2 * m + bj];
                    float o[8] = { v0[0] * GSIG(bf_lo(gg.x)), v0[1] * GSIG(bf_hi(gg.x)), v0[2] * GSIG(bf_lo(gg.y)), v0[3] * GSIG(bf_hi(gg.y)), v1[0] * GSIG(bf_lo(gg.z)), v1[1] * GSIG(bf_hi(gg.z)), v1[2] * GSIG(bf_lo(gg.w)), v1[3] * GSIG(bf_hi(gg.w)) };
                    if (!first) { const u32x4 pp = p[2 * m + bj];
                        o[0] += bf_lo(pp.x); o[1] += bf_hi(pp.x); o[2] += bf_lo(pp.y); o[3] += bf_hi(pp.y); o[4] += bf_lo(pp.z); o[5] += bf_hi(pp.z); o[6] += bf_lo(pp.w); o[7] += bf_hi(pp.w); }
                    u32x4 w; w.x = cvt_pk_bf16(o[0], o[1]); w.y = cvt_pk_bf16(o[2], o[3]); w.z = cvt_pk_bf16(o[4], o[5]); w.w = cvt_pk_bf16(o[6], o[7]);
                    *(u32x4*)(MG + r * ldm + col0 + bj * HALF) = w; }
        }
    }
};
}
namespace att {
constexpr int D = 128;
constexpr bool WSKIP = false;
constexpr float THR = 8.f;
constexpr int NW = 8, QBLK = 32, KVBLK = 64, QB = NW * QBLK;
constexpr int SHM_V = KVBLK * D * 2, SHM_K = KVBLK * D * 2;
constexpr int LDS_BYTES = 2 * SHM_V + 2 * SHM_K + NW * 64 * 4;
using bf16 = __hip_bfloat16;
typedef short bf16x8 __attribute__((ext_vector_type(8)));
typedef short s16x4 __attribute__((ext_vector_type(4)));
typedef float f32x16 __attribute__((ext_vector_type(16)));
typedef float f32x4 __attribute__((ext_vector_type(4)));
typedef unsigned u32x4 __attribute__((ext_vector_type(4)));
template <class A, class Bt> struct same_t { static constexpr bool v = false; };
template <class A> struct same_t<A, A> { static constexpr bool v = true; };

#define KSWZ(row, colB) ((row) * 256 + ((colB) ^ (((row) & 7) << 4)))
#define SBAR() __builtin_amdgcn_sched_barrier(0)
__device__ __forceinline__ int v_st(int k, int c) { const int kk = (k & ~0xC) | ((k & 4) << 1) | ((k & 8) >> 1); return ((kk >> 3) * 4 + (c >> 5)) * 512 + ((kk & 7) * 32 + (c & 31)) * 2; }
__device__ __forceinline__ int v_rd_base(int lane) { return ((lane & 3) << 3) | (((lane >> 2) & 3) << 6) | (((lane >> 4) & 1) << 5) | (((lane >> 5) & 1) << 8); }
constexpr int v_rd_off(int d0, int ks, int half) { return d0 * 512 + ks * 4096 + half * 2048; }
__device__ __forceinline__ int crow(int r, int hi) { return (r & 3) + 8 * (r >> 2) + 4 * hi; }
__device__ __forceinline__ unsigned cvtpk(float lo, float hi) {
    unsigned r; asm volatile("v_cvt_pk_bf16_f32 %0, %1, %2" : "=v"(r) : "v"(lo), "v"(hi)); return r;
}
__device__ __forceinline__ bf16x8 pack8(f32x4 a, f32x4 b) {
    u32x4 w = {cvtpk(a[0], a[1]), cvtpk(a[2], a[3]), cvtpk(b[0], b[1]), cvtpk(b[2], b[3])};
    return *reinterpret_cast<bf16x8*>(&w);
}
template <class T> __device__ __forceinline__ bf16x8 load8(const T* p) {
    if constexpr (same_t<T, float>::v) { return pack8(*(const f32x4*)p, *(const f32x4*)(p + 4)); }
    else { return *reinterpret_cast<const bf16x8*>(p); }
}
__device__ __forceinline__ void mask_tile(f32x16& p0, f32x16& p1, int dq, unsigned W) {
    const float NEG = -__builtin_inff();
#pragma unroll
    for (int r = 0; r < 16; ++r) {
        const int c = (r & 3) + 8 * (r >> 2);
        if ((unsigned)(dq - c) >= W) p0[r] = NEG;
        if ((unsigned)(dq - c - 32) >= W) p1[r] = NEG;
    }
}
typedef unsigned u32x2 __attribute__((ext_vector_type(2)));
__device__ __forceinline__ void bitmask_tile(f32x16& p0, f32x16& p1, u32x2 w, int hi) {
    const float NEG = -__builtin_inff();
    const unsigned a = w[0] >> (4 * hi), b = w[1] >> (4 * hi);
#pragma unroll
    for (int r = 0; r < 16; ++r) {
        const int c = (r & 3) + 8 * (r >> 2);
        if (!((a >> c) & 1u)) p0[r] = NEG;
        if (!((b >> c) & 1u)) p1[r] = NEG;
    }
}
template <bool HALFQK> __device__ __forceinline__ void partialSM(f32x16& p0, f32x16& p1, float& m_reg, float& mn, float& alpha) {
    constexpr float SCALE = HALFQK ? 0.125f : 0.08838834764831845f;
    float pmax = p0[0]; for (int r = 1; r < 16; ++r) pmax = fmaxf(pmax, p0[r]); for (int r = 0; r < 16; ++r) pmax = fmaxf(pmax, p1[r]);
    { auto rr = __builtin_amdgcn_permlane32_swap(__float_as_uint(pmax), __float_as_uint(pmax), false, false);
      pmax = fmaxf(__uint_as_float(rr[0]), __uint_as_float(rr[1])); }
    constexpr float C2 = 1.4426950408889634f * SCALE;
    if (__builtin_expect(__all((pmax - m_reg) * SCALE <= THR), 1)) { mn = m_reg; alpha = 1.f; }
    else { mn = fmaxf(m_reg, pmax); alpha = __builtin_amdgcn_exp2f((m_reg - mn) * C2); m_reg = mn; }
    const float mnL = -mn * C2;
    for (int r = 0; r < 16; ++r) p0[r] = fmaf(p0[r], C2, mnL); for (int r = 0; r < 16; ++r) p1[r] = fmaf(p1[r], C2, mnL);
    for (int r = 0; r < 16; ++r) p0[r] = __builtin_amdgcn_exp2f(p0[r]);
}
__device__ __forceinline__ void finishSM(f32x16& p0, f32x16& p1, float alpha, float& l_reg, bf16x8& pa0, bf16x8& pa1, bf16x8& pa2, bf16x8& pa3) {
    for (int r = 0; r < 16; ++r) p1[r] = __builtin_amdgcn_exp2f(p1[r]);
    float ps = 0; for (int r = 0; r < 16; ++r) ps += p0[r]; for (int r = 0; r < 16; ++r) ps += p1[r];
    { auto rr = __builtin_amdgcn_permlane32_swap(__float_as_uint(ps), __float_as_uint(ps), false, false);
      ps = __uint_as_float(rr[0]) + __uint_as_float(rr[1]); }
    l_reg = l_reg * alpha + ps;
#define PK4(P, B_, OUT) do { unsigned a0 = cvtpk(P[B_+0], P[B_+1]), a1 = cvtpk(P[B_+2], P[B_+3]);                          \
        unsigned b0 = cvtpk(P[B_+4], P[B_+5]), b1 = cvtpk(P[B_+6], P[B_+7]);                                             \
        auto r0 = __builtin_amdgcn_permlane32_swap(a0, b0, false, false); auto r1 = __builtin_amdgcn_permlane32_swap(a1, b1, false, false); \
        u32x4 w = {r0[0], r1[0], r0[1], r1[1]}; OUT = *reinterpret_cast<bf16x8*>(&w); } while (0)
    PK4(p0, 0, pa0); PK4(p0, 8, pa1); PK4(p1, 0, pa2); PK4(p1, 8, pa3);
#undef PK4
}
template <int KB, bool SK, bool HALFQK>
__device__ __forceinline__ void qkt(f32x16& p0, f32x16& p1, const char* K_lds, int r32, int hi, const bf16x8* qr, bool act, int koff) {
    if (SK && !act) { const float NEG = -__builtin_inff();
#pragma unroll
        for (int r = 0; r < 16; ++r) { p0[r] = NEG; p1[r] = NEG; } return; }
    p0 = f32x16{}; p1 = f32x16{};
    const char* kb[4];
#pragma unroll
    for (int dd = 0; dd < 4; ++dd) kb[dd] = K_lds + KB * SHM_K + KSWZ(r32, (dd * 16 + hi * 8) * 2) + koff;
#pragma unroll
    for (int d0 = 0; d0 < (HALFQK ? 4 : 8); ++d0) { const char* a = kb[d0 & 3] + (d0 >> 2) * 128;
        bf16x8 b0 = *reinterpret_cast<const bf16x8*>(a);
        bf16x8 b1 = *reinterpret_cast<const bf16x8*>(a + 32 * 256);
        p0 = __builtin_amdgcn_mfma_f32_32x32x16_bf16(b0, qr[d0], p0, 0, 0, 0);
        p1 = __builtin_amdgcn_mfma_f32_32x32x16_bf16(b1, qr[d0], p1, 0, 0, 0); }
}
template <int VB, bool SK>
__device__ __forceinline__ void pv_tile(f32x16* o, int vb0, bf16x8 pa0, bf16x8 pa1, bf16x8 pa2, bf16x8 pa3, bool act) {
    if (SK && !act) return;
#define TRRD(dst, off) asm volatile("ds_read_b64_tr_b16 %0, %1 offset:%2" : "=&v"(dst) : "v"(vb0), "i"(off) : "memory")
#define PV_D0(d0) do { s16x4 l0, l1, l2, l3, h0, h1, h2, h3; constexpr int b_ = VB * SHM_V + v_rd_off(d0, 0, 0);     \
        TRRD(l0, b_); TRRD(h0, b_ + 2048); TRRD(l1, b_ + 4096); TRRD(h1, b_ + 6144); TRRD(l2, b_ + 8192); TRRD(h2, b_ + 10240); TRRD(l3, b_ + 12288); TRRD(h3, b_ + 14336); \
        asm volatile("s_waitcnt lgkmcnt(0)" ::: "memory"); SBAR();                 \
        o[d0] = __builtin_amdgcn_mfma_f32_32x32x16_bf16(pa0, (bf16x8){l0[0], l0[1], l0[2], l0[3], h0[0], h0[1], h0[2], h0[3]}, o[d0], 0, 0, 0);   \
        o[d0] = __builtin_amdgcn_mfma_f32_32x32x16_bf16(pa1, (bf16x8){l1[0], l1[1], l1[2], l1[3], h1[0], h1[1], h1[2], h1[3]}, o[d0], 0, 0, 0);   \
        o[d0] = __builtin_amdgcn_mfma_f32_32x32x16_bf16(pa2, (bf16x8){l2[0], l2[1], l2[2], l2[3], h2[0], h2[1], h2[2], h2[3]}, o[d0], 0, 0, 0);   \
        o[d0] = __builtin_amdgcn_mfma_f32_32x32x16_bf16(pa3, (bf16x8){l3[0], l3[1], l3[2], l3[3], h3[0], h3[1], h3[2], h3[3]}, o[d0], 0, 0, 0); } while (0)
    PV_D0(0); PV_D0(1); PV_D0(2); PV_D0(3);
#undef PV_D0
#undef TRRD
}

constexpr int QS = 1536, KVS = 4096;
template <class TIn, class TOut> struct BlockRef { const TIn* Q; const TIn* K; const TIn* V; TOut* O; int P0; int koff; const unsigned* mask; };
template <class TIn> struct Seam {
    bf16x8 qr[8];
    bf16x8 st_v0, st_v1, st_k0, st_k1; f32x4 sf0, sf1, sf2, sf3;
    f32x4 tq[16];
};
__device__ __forceinline__ int swa_jlo(int P0, int W) { const int lowk = P0 - W + 1; return lowk > 0 ? lowk / KVBLK : 0; }
#define ROW(p, k0, rr) ((p) + (size_t)((k0) + (rr)) * KVS + sc)
#define VMW() asm volatile("s_waitcnt vmcnt(0)" ::: "memory")
#define VMWN(n) asm volatile("s_waitcnt vmcnt(%0)" :: "i"(n) : "memory")
#define SLOAD_H(Kp, Vp, k0) do { S.st_v0 = load8<TIn>(ROW(Vp, k0, sr)); S.st_v1 = load8<TIn>(ROW(Vp, k0, 32 + sr));              \
                         S.st_k0 = load8<TIn>(ROW(Kp, k0, sr)); S.st_k1 = load8<TIn>(ROW(Kp, k0, 32 + sr)); } while (0)
#define SWRITE_HK(bf) do { *(bf16x8*)(K_lds + (bf) * SHM_K + kws) = S.st_k0; *(bf16x8*)(K_lds + (bf) * SHM_K + kws + 32 * 256) = S.st_k1; } while (0)
#define SWRITE_HV(bf) do { *(bf16x8*)(V_lds + (bf) * SHM_V + vst0) = S.st_v0; *(bf16x8*)(V_lds + (bf) * SHM_V + vst1) = S.st_v1; } while (0)
#define SWRITE_H(bf) do { SWRITE_HV(bf); SWRITE_HK(bf); } while (0)
#define SLOAD_F(p, k0) do { S.sf0 = *(const f32x4*)ROW(p, k0, sr); S.sf1 = *(const f32x4*)(ROW(p, k0, sr) + 4);                \
                            S.sf2 = *(const f32x4*)ROW(p, k0, 32 + sr); S.sf3 = *(const f32x4*)(ROW(p, k0, 32 + sr) + 4); } while (0)
#define SWRITE_KF(bf) do { *(bf16x8*)(K_lds + (bf) * SHM_K + kws) = pack8(S.sf0, S.sf1); *(bf16x8*)(K_lds + (bf) * SHM_K + kws + 32 * 256) = pack8(S.sf2, S.sf3); } while (0)
#define SWRITE_VF(bf) do { *(bf16x8*)(V_lds + (bf) * SHM_V + vst0) = pack8(S.sf0, S.sf1); *(bf16x8*)(V_lds + (bf) * SHM_V + vst1) = pack8(S.sf2, S.sf3); } while (0)
template <class TIn, class TOut, bool HALFQK>
__device__ __forceinline__ void causal_swa_prime(const BlockRef<TIn, TOut>& cur, int W, char* lds, Seam<TIn>& S) {
    constexpr bool F32 = same_t<TIn, float>::v;
    const int tid = otid_(), wid = __builtin_amdgcn_readfirstlane(tid >> 6), lane = tid & 63, r32 = lane & 31, hi = lane >> 5;
    const int sr = tid >> 4, sc = (tid & 15) * 8, kws = KSWZ(sr, sc * 2); char* K_lds = lds + 2 * SHM_V;
    const int kb0 = swa_jlo(cur.P0, W) * KVBLK;
    for (int d0 = 0; d0 < (HALFQK ? 4 : 8); ++d0) S.qr[d0] = load8<TIn>(cur.Q + (size_t)(wid * QBLK + r32) * QS + d0 * 16 + hi * 8);
    if constexpr (F32) { SLOAD_F((const float*)cur.K, kb0); VMW(); SWRITE_KF(0); SBAR(); SLOAD_F((const float*)cur.V, kb0); }
    else { SLOAD_H(cur.K, cur.V, kb0); VMW(); SWRITE_HK(0); }
    __syncthreads();
}
template <class TIn, class TOut, bool HALFQK, bool MASKED, int OS>
__device__ __forceinline__ void causal_swa_block(const BlockRef<TIn, TOut>& cur, const BlockRef<TIn, TOut>& nxt, int skv, int W, char* lds, Seam<TIn>& S) {
    constexpr bool F32 = same_t<TIn, float>::v;
    const int tid = otid_(), wid = __builtin_amdgcn_readfirstlane(tid >> 6), lane = tid & 63, r32 = lane & 31, hi = lane >> 5;
    const int j_lo = swa_jlo(cur.P0, W);
    int j_hi = (cur.P0 + QB - 1) / KVBLK + 1; if (j_hi > skv / KVBLK) j_hi = skv / KVBLK;
    const int NT = j_hi - j_lo;
    const int kbn = swa_jlo(nxt.P0, W) * KVBLK;
    const int qlo = cur.P0 + wid * QBLK, qm = qlo + r32 - 4 * hi;
    char* V_lds = lds; char* K_lds = lds + 2 * SHM_V;
    float* ws = (float*)(lds + 2 * SHM_V + 2 * SHM_K) + wid * 64; float* li_l = ws, * al_l = ws + 32;
    float m_reg = -1e30f, l_reg = 0; f32x16 o[4] = {};
    const int sr = tid >> 4, sc = (tid & 15) * 8, vst0 = v_st(sr, sc), vst1 = v_st(32 + sr, sc), kws = KSWZ(sr, sc * 2);
    const int vb0 = (int)(uintptr_t)V_lds + v_rd_base(lane);
    const TIn* Kh = cur.K; const TIn* Vh = cur.V;
#define RESC(a) do { if (__any((a) < 1.f)) { if (hi == 0) al_l[r32] = (a); asm volatile("s_waitcnt lgkmcnt(0)" ::: "memory");              \
                     for (int d_ = 0; d_ < 4; ++d_) for (int r = 0; r < 16; ++r) o[d_][r] *= al_l[crow(r, hi)]; } } while (0)
#define KBASE(t) ((j_lo + (t)) * KVBLK)
#define ACT(t) (KBASE(t) <= qlo + QBLK - 1 && KBASE(t) + KVBLK - 1 >= qlo - W + 1)
#define MASKT(P0_, P1_, t) do { if constexpr (MASKED) bitmask_tile(P0_, P1_, mw, hi);   \
        else { const int kb_ = KBASE(t); if ((!SK || ACT(t)) && (kb_ + KVBLK - 1 > qlo || kb_ <= qlo + QBLK - 1 - W)) mask_tile(P0_, P1_, qm - kb_, (unsigned)W); } } while (0)
    const unsigned moff = (unsigned)((wid * QBLK + r32) * 1024 + 8 * j_lo); u32x2 mw = {0u, 0u};
#define MLOAD(t) do { if constexpr (MASKED) mw = *(const u32x2*)((const char*)cur.mask + (moff + 8u * (unsigned)(t))); } while (0)
    constexpr int NQL = F32 ? 16 : (HALFQK ? 4 : 8);
    constexpr bool SK = WSKIP && !F32;
#define SEAM_K0() do { VMWN(NQL); if constexpr (F32) { SWRITE_KF(0); SBAR(); SLOAD_F((const float*)nxt.V, kbn); } else { SWRITE_HK(0); } SBAR(); } while (0)
    f32x16 pA0, pA1, pB0, pB1; float mnA, mnB, alA, alB; bf16x8 pa0, pa1, pa2, pa3;
    if constexpr (F32) { VMW(); SWRITE_VF(0); SBAR(); } else { SWRITE_HV(0); SBAR(); }
    if (NT > 1) { if constexpr (F32) SLOAD_F((const float*)Kh, KBASE(1)); else SLOAD_H(Kh, Vh, KBASE(1)); }
    SBAR(); qkt<0, SK, HALFQK>(pA0, pA1, K_lds, r32, hi, S.qr, ACT(0), cur.koff); MLOAD(0);
    if constexpr (F32) { if (NT > 1) { VMW(); SWRITE_KF(1); SBAR(); SLOAD_F((const float*)Vh, KBASE(1)); } }
    MASKT(pA0, pA1, 0); partialSM<HALFQK>(pA0, pA1, m_reg, mnA, alA);
    if (NT > 1) { VMW(); if constexpr (F32) { SWRITE_VF(1); SBAR(); if (NT > 2) SLOAD_F((const float*)Kh, KBASE(2)); } else SWRITE_H(1); }
    __syncthreads();
#define HALF_STEP(PX0, PX1, mnX, alX, PY0, PY1, alY, t, KB, VB, SB) do {                                                      \
        SBAR(); qkt<KB, SK, HALFQK>(PX0, PX1, K_lds, r32, hi, S.qr, ACT(t), cur.koff); MLOAD(t);                                             \
        finishSM(PY0, PY1, alY, l_reg, pa0, pa1, pa2, pa3); SBAR();                                                           \
        if ((t) + 1 < NT) { if constexpr (F32) { VMW(); SWRITE_KF(SB); SBAR(); SLOAD_F((const float*)Vh, KBASE((t) + 1)); }  \
                            else { SLOAD_H(Kh, Vh, KBASE((t) + 1)); } SBAR(); }                                               \
        pv_tile<VB, SK>(o, vb0, pa0, pa1, pa2, pa3, ACT((t) - 1)); MASKT(PX0, PX1, (t)); partialSM<HALFQK>(PX0, PX1, m_reg, mnX, alX);                                        \
        __syncthreads();                                                                                                      \
        if ((t) + 1 < NT) { VMW(); if constexpr (F32) { SWRITE_VF(SB); SBAR(); if ((t) + 2 < NT) SLOAD_F((const float*)Kh, KBASE((t) + 2)); } \
                            else { SWRITE_H(SB); } }                                                                          \
        RESC(alX); __syncthreads(); } while (0)
    for (int t = 1; t + 1 < NT; t += 2) {
        HALF_STEP(pB0, pB1, mnB, alB, pA0, pA1, alA, t, 1, 0, 0);
        HALF_STEP(pA0, pA1, mnA, alA, pB0, pB1, alB, t + 1, 0, 1, 1);
    }
    const bool even = (NT & 1) == 0;
    if (even) { SBAR(); qkt<1, SK, HALFQK>(pB0, pB1, K_lds, r32, hi, S.qr, ACT(NT - 1), cur.koff); MLOAD(NT - 1); SBAR(); }
#define QROW(e) (nxt.Q + (size_t)(wid * QBLK + r32) * QS + ((e) >> 1) * 16 + hi * 8 + ((e) & 1) * 4)
    if constexpr (F32) { SLOAD_F((const float*)nxt.K, kbn); SBAR();
#pragma unroll
        for (int e = 0; e < 8; ++e) S.tq[e] = *(const f32x4*)QROW(e); }
    else { SLOAD_H(nxt.K, nxt.V, kbn); SBAR();
#pragma unroll
        for (int d0 = 0; d0 < (HALFQK ? 4 : 8); ++d0) S.qr[d0] = load8<TIn>(nxt.Q + (size_t)(wid * QBLK + r32) * QS + d0 * 16 + hi * 8); }
    SBAR();
    finishSM(pA0, pA1, alA, l_reg, pa0, pa1, pa2, pa3); SBAR();
    if constexpr (F32) {
#pragma unroll
        for (int e = 8; e < 16; ++e) S.tq[e] = *(const f32x4*)QROW(e); SBAR(); }
#undef QROW
    pv_tile<0, SK>(o, vb0, pa0, pa1, pa2, pa3, ACT(even ? NT - 2 : NT - 1));
    if (even) { MASKT(pB0, pB1, NT - 1); partialSM<HALFQK>(pB0, pB1, m_reg, mnB, alB); __syncthreads(); RESC(alB);
        finishSM(pB0, pB1, alB, l_reg, pa0, pa1, pa2, pa3); SBAR(); pv_tile<1, SK>(o, vb0, pa0, pa1, pa2, pa3, ACT(NT - 1)); }
    SBAR(); SEAM_K0();
    if (hi == 0) li_l[r32] = l_reg; asm volatile("s_waitcnt lgkmcnt(0)" ::: "memory");
    float rli[16];
#pragma unroll
    for (int r = 0; r < 16; ++r) rli[r] = __builtin_amdgcn_rcpf(li_l[crow(r, hi)]);
    TOut* Ow = cur.O + (size_t)(wid * QBLK) * OS;
#pragma unroll
    for (int r = 0; r < 16; ++r) { const int orow = crow(r, hi);
#pragma unroll
        for (int d0 = 0; d0 < 4; ++d0) { const float v = o[d0][r] * rli[r];
            if constexpr (same_t<TOut, float>::v) { Ow[(size_t)orow * OS + d0 * 32 + r32] = v; }
            else { const float vn = __shfl_xor(v, 1);
                   if ((r32 & 1) == 0) *(unsigned*)(Ow + (size_t)orow * OS + d0 * 32 + r32) = cvtpk(v, vn); } } }
    if constexpr (F32) {
#pragma unroll
        for (int d0 = 0; d0 < 8; ++d0) S.qr[d0] = pack8(S.tq[2 * d0], S.tq[2 * d0 + 1]); }
    __syncthreads();
#undef RESC
#undef KBASE
#undef ACT
#undef MASKT
#undef MLOAD
#undef SEAM_K0
#undef HALF_STEP
}
#undef ROW
#undef VMW
#undef VMWN
#undef SLOAD_H
#undef SWRITE_HK
#undef SWRITE_HV
#undef SWRITE_H
#undef SLOAD_F
#undef SWRITE_KF
#undef SWRITE_VF
}
#ifndef TSPROBE
#define TSPROBE 0
#endif
#ifndef TSQ
#define TSQ 32.f
#endif
#ifndef PROBE
#define PROBE 0
#endif
constexpr int NWAVES = 8;
constexpr int NB = 2, T = 8192, M = NB * T, DM = 1024, FF = 2816, NIN = 8520, NLAYER = 2;
constexpr float NORM_EPS = 1e-6f;
constexpr size_t MiB = 1u << 20;
constexpr size_t WS_CTL = 0, CTL_ZERO_BYTES = 1 * MiB;
constexpr size_t WS_WF = 1 * MiB;
constexpr size_t WS_WF_DOWN = WS_WF + 11 * MiB;
constexpr size_t WS_WM = 18 * MiB;
constexpr size_t WS_WM_BR = WS_WM + 17 * MiB, WS_WM_OUT = WS_WM + 20 * MiB;
constexpr size_t WS_XN = 40 * MiB;
constexpr size_t WS_Q3 = 72 * MiB;
constexpr size_t WS_ZR = 120 * MiB;
constexpr size_t WS_R2 = 248 * MiB;
constexpr size_t WS_END = 280 * MiB;
constexpr size_t WS_MG = WS_ZR + 96 * MiB;
constexpr size_t WS_YRAW = WS_WF;
constexpr size_t WS_A8 = WS_WM;
constexpr size_t WS_KID = WS_WM + 8 * MiB;
constexpr size_t WS_RDOTK = WS_WF + 16 * MiB;
constexpr int QP = 1536, ZP = 4096;
constexpr int ZC_DK = 0, ZC_DV = 512, ZC_QI = 1024, ZC_KI = 1536, ZC_WI = 1600, ZC_RK = 1792, ZC_RV = 2304, ZC_WC = 2816, ZC_AC = 2880, ZC_GC = 2944, ZC_FK = 3072, ZC_FV = 3584;
constexpr int CW_TMO = 0;
constexpr int CW_BAR = 4096;
constexpr int CW_Q = 8192;
constexpr int CW_CQ = 8576;
constexpr int CW_PROBE = 2048;
constexpr int CW_DONE = 12288;
constexpr int LDS_MISC = 160 * 1024 - 256;
constexpr int LDS_BYTES = 160 * 1024;

#define GAS __attribute__((address_space(1)))
#define LAS __attribute__((address_space(3)))
typedef unsigned short bf16;
typedef unsigned v4u __attribute__((ext_vector_type(4)));
typedef unsigned v2u __attribute__((ext_vector_type(2)));
typedef float f32x4 __attribute__((ext_vector_type(4)));
typedef float f32x2 __attribute__((ext_vector_type(2)));
typedef float f32x16 __attribute__((ext_vector_type(16)));
typedef short bf16x8 __attribute__((ext_vector_type(8)));
typedef GAS unsigned gu32;
#define RLX_AGENT __ATOMIC_RELAXED, __HIP_MEMORY_SCOPE_AGENT
#define LDS_WAIT() asm volatile("s_waitcnt lgkmcnt(0)" ::: "memory")
#define VM_WAIT() asm volatile("s_waitcnt vmcnt(0)" ::: "memory")
__device__ __forceinline__ unsigned f2bf(float f) { unsigned u = __builtin_bit_cast(unsigned, f); return (u + 0x7fffu + ((u >> 16) & 1u)) >> 16; }
__device__ __forceinline__ unsigned pk2(float lo, float hi) { return f2bf(lo) | (f2bf(hi) << 16); }
__device__ __forceinline__ float bflo(unsigned w) { return __uint_as_float(w << 16); }
__device__ __forceinline__ float bfhi(unsigned w) { return __uint_as_float(w & 0xffff0000u); }
__device__ __forceinline__ float bf1(bf16 h) { return __uint_as_float((unsigned)h << 16); }
__device__ __forceinline__ float wave_sum(float v) {
#pragma unroll
    for (int o = 1; o < 64; o <<= 1) v += __shfl_xor(v, o);
    return v;
}
__device__ __forceinline__ float sigm(float x) { return __builtin_amdgcn_rcpf(1.0f + __expf(-x)); }

#define XB_TMO      128
#define XB_XCNT(j)  (256  + 64 * (j))
#define XB_XSUB(j)  (1280 + 64 * (j))
#define XB_XGEN(j)  (2304 + 64 * (j))
#define XB_TOP      3328
#define XB_TOPGEN   3392
#define XCD_BAR_WORDS 3456
#define XB_SPIN_CAP (1u << 22)
__device__ __forceinline__ unsigned xb_ld(unsigned* p)              { return __hip_atomic_load(p, __ATOMIC_RELAXED, __HIP_MEMORY_SCOPE_AGENT); }
__device__ __forceinline__ unsigned xb_add(unsigned* p, unsigned v) { return __hip_atomic_fetch_add(p, v, __ATOMIC_RELAXED, __HIP_MEMORY_SCOPE_AGENT); }
__device__ __forceinline__ unsigned xb_xcc_id() { return (unsigned)__builtin_amdgcn_s_getreg((3 << 11) | 20) & 0xFu; }
#define XB_SPIN(cond, bar) do { unsigned _sp = 0; while (cond) { __builtin_amdgcn_s_sleep(1); \
    if ((++_sp & 255u) == 0u) { if (xb_ld(&(bar)[XB_TMO])) break; if (_sp > XB_SPIN_CAP) { atomicAdd(&(bar)[XB_TMO], 1u); break; } } } } while (0)
struct XcdBarrier { unsigned* bar; unsigned x; volatile LAS unsigned* st; };
__device__ __forceinline__ XcdBarrier xcd_barrier_post(unsigned* bar, volatile LAS unsigned* st) {
    XcdBarrier b; b.bar = bar; b.x = xb_xcc_id(); b.st = st;
    if (threadIdx.x == 0) (void)xb_add(&bar[XB_XCNT(b.x)], 1u);
    return b;
}
__device__ __forceinline__ void xcd_barrier_complete(unsigned* bar, unsigned x, unsigned& nloc, unsigned& nx) {
    const unsigned G = gridDim.x * gridDim.y * gridDim.z;
    unsigned sum, cnt, mine, sp = 0u;
    for (;;) {
        sum = 0u; cnt = 0u; mine = 0u;
#pragma unroll
        for (unsigned j = 0; j < 16; ++j) { const unsigned c = xb_ld(&bar[XB_XCNT(j)]); sum += c; cnt += (c > 0u) ? 1u : 0u; mine = (j == x) ? c : mine; }
        if (sum == G) break;
        __builtin_amdgcn_s_sleep(1);
        if ((++sp & 255u) == 0u) { if (xb_ld(&bar[XB_TMO])) break; if (sp > XB_SPIN_CAP) { atomicAdd(&bar[XB_TMO], 1u); break; } }
    }
    nloc = mine > 0u ? mine : 1u; nx = cnt > 0u ? cnt : 1u;
}
__device__ __forceinline__ void xcd_barrier(const XcdBarrier& b) {
    asm volatile("s_waitcnt vmcnt(0)" ::: "memory");
    __syncthreads();
    if (threadIdx.x == 0) {
        unsigned* bar = b.bar;
        __builtin_amdgcn_s_waitcnt(0);
        unsigned nloc = b.st[0], nx = b.st[1];
        if (nloc == 0u) { xcd_barrier_complete(bar, b.x, nloc, nx); b.st[0] = nloc; b.st[1] = nx; }
        const unsigned old = xb_add(&bar[XB_XSUB(b.x)], 1u);
        const unsigned gen = old / nloc;
        if (old + 1u == (gen + 1u) * nloc) {
            __builtin_amdgcn_fence(__ATOMIC_RELEASE, "agent");
            asm volatile("s_waitcnt vmcnt(0)" ::: "memory");
            const unsigned og = xb_add(&bar[XB_TOP], 1u);
            const unsigned tg = og / nx;
            if (og + 1u == (tg + 1u) * nx) xb_add(&bar[XB_TOPGEN], 1u);
            else XB_SPIN(xb_ld(&bar[XB_TOPGEN]) == tg, bar);
            __builtin_amdgcn_fence(__ATOMIC_ACQUIRE, "agent");
            xb_add(&bar[XB_XGEN(b.x)], 1u);
            asm volatile("s_waitcnt vmcnt(0)" ::: "memory");
        } else {
            XB_SPIN(xb_ld(&bar[XB_XGEN(b.x)]) == gen, bar);
            __builtin_amdgcn_fence(__ATOMIC_ACQUIRE, "agent");
            asm volatile("s_waitcnt vmcnt(0)" ::: "memory");
        }
    }
    __syncthreads();
}

struct MapIdent { const float* W; int ld; __device__ __forceinline__ const float* col(int n) const { return W + n; } };
struct MapUp {
    const float* G; const float* U; int ld;
    __device__ __forceinline__ const float* col(int n) const { const int g = n >> 5, j = n & 31; return j < 16 ? G + 16 * g + j : U + 16 * g + (j - 16); }
};
struct MapWin {
    const float* W; int ld;
    __device__ __forceinline__ const float* col(int n) const {
        int src;
        if (n < 512) src = n; else if (n < 1024) src = 2120 + (n - 512); else if (n < 1536) src = 3912 + (n - 1024);
        else if (n < 5632) { const int z = n - 1536; if (z < 1608) src = 512 + z; else if (z < 1792) src = -1; else if (z < 3072) src = 840 + z; else src = 1352 + z; }
        else src = 5448 + (n - 5632);
        return src < 0 ? nullptr : W + src;
    }
};
struct ConvDesc { const float* cp; size_t ld; bf16* dst; int K; };
template <class Map>
__device__ __forceinline__ ConvDesc conv_desc(const Map& mp, int K, bf16* WT, int item, int nblk, int lane) {
    const int kb = item / nblk, nb = item % nblk, k0 = 32 * kb, n0 = 32 * nb;
    const float* cp = mp.col(n0 + (lane & 31)); const size_t ld = (size_t)mp.ld;
    return ConvDesc{cp ? cp + (size_t)(k0 + (lane >> 5)) * ld : nullptr, ld, WT + (size_t)n0 * K + k0, K};
}
__device__ __forceinline__ void conv_load(const ConvDesc& d, float (&v)[16]) {
#pragma unroll
    for (int i = 0; i < 16; ++i) v[i] = d.cp ? d.cp[(size_t)(2 * i) * d.ld] : 0.f;
}
__device__ __forceinline__ void conv_store(const ConvDesc& d, const float (&v)[16], LAS float* scr, int lane) {
#pragma unroll
    for (int i = 0; i < 16; ++i) scr[(2 * i + (lane >> 5)) * 33 + (lane & 31)] = v[i];
    LDS_WAIT(); asm volatile("" ::: "memory");
    const int c = lane & 3;
#pragma unroll
    for (int j = 0; j < 2; ++j) { const int n = (lane >> 2) + 16 * j; const LAS float* s = scr + (8 * c) * 33 + n;
        v4u o; o.x = pg8::cvt_pk_bf16(s[0 * 33], s[1 * 33]); o.y = pg8::cvt_pk_bf16(s[2 * 33], s[3 * 33]); o.z = pg8::cvt_pk_bf16(s[4 * 33], s[5 * 33]); o.w = pg8::cvt_pk_bf16(s[6 * 33], s[7 * 33]);
        *(GAS v4u*)(d.dst + (size_t)n * d.K + 8 * c) = o; }
    LDS_WAIT(); asm volatile("" ::: "memory");
}
template <class D>
__device__ __forceinline__ void conv_batch(D desc, int n, LAS float* scr, int gw_, int ngw_, int lane) {
    constexpr int Q = 1;
    for (int it = gw_; it < n; it += Q * ngw_) {
        ConvDesc d[Q]; float v[Q][16];
#pragma unroll
        for (int q = 0; q < Q; ++q) if (it + q * ngw_ < n) { d[q] = desc(it + q * ngw_); conv_load(d[q], v[q]); }
#pragma unroll
        for (int q = 0; q < Q; ++q) if (it + q * ngw_ < n) conv_store(d[q], v[q], scr, lane);
    }
}
template <class D>
__device__ __forceinline__ void conv_queue(D desc, int n, LAS float* scr, gu32* head, int lane) {
    constexpr int CH = 4;
    for (;;) {
        unsigned b0 = 0u; if (lane == 0) b0 = __hip_atomic_fetch_add(head, (unsigned)CH, RLX_AGENT);
        const int base = (int)__builtin_amdgcn_readfirstlane(b0);
        if (base >= n) break;
#pragma unroll 1
        for (int j = 0; j < CH; ++j) { const int it = base + j; if (it < n) { const ConvDesc d = desc(it); float v[16]; conv_load(d, v); conv_store(d, v, scr, lane); } }
    }
}
__host__ __device__ constexpr int conv_items(int K, int N) { return (K / 32) * (N / 32); }

template <bool INB, bool OUTB>
__device__ __forceinline__ void rownorm_rows(const void* base, const bf16* Y, float s, const float* gpost, void* out, const float* gnext, bf16* XN, int gw, int NGW, int lane, float oscale = 1.f) {
    constexpr int R = 8;
    for (int m0 = gw; m0 < M; m0 += R * NGW) {
        v2u xb[R][4], yw[R][4]; f32x4 xf[R][4];
#pragma unroll
        for (int q = 0; q < R; ++q) { const size_t m = (size_t)(m0 + q * NGW);
#pragma unroll
            for (int j = 0; j < 4; ++j) {
                if constexpr (INB) xb[q][j] = ((const GAS v2u*)((const bf16*)base + m * DM))[lane + 64 * j];
                else xf[q][j] = ((const GAS f32x4*)((const float*)base + m * DM))[lane + 64 * j];
                if (Y) yw[q][j] = ((const GAS v2u*)(Y + m * DM))[lane + 64 * j]; } }
#pragma unroll
        for (int q = 0; q < R; ++q) { const size_t m = (size_t)(m0 + q * NGW);
            f32x4 v[4];
#pragma unroll
            for (int j = 0; j < 4; ++j) { if constexpr (INB) v[j] = (f32x4){bflo(xb[q][j].x), bfhi(xb[q][j].x), bflo(xb[q][j].y), bfhi(xb[q][j].y)}; else v[j] = xf[q][j]; }
            if (Y) {
                f32x4 y[4]; float ss = 0.f;
#pragma unroll
                for (int j = 0; j < 4; ++j) { const v2u w = yw[q][j]; y[j] = (f32x4){bflo(w.x), bfhi(w.x), bflo(w.y), bfhi(w.y)};
                    ss += (y[j].x * y[j].x + y[j].y * y[j].y) + (y[j].z * y[j].z + y[j].w * y[j].w); }
                const float r = s * __builtin_amdgcn_rsqf(wave_sum(ss) * (1.f / DM) + NORM_EPS);
#pragma unroll
                for (int j = 0; j < 4; ++j) { const f32x4 g = ((const GAS f32x4*)gpost)[lane + 64 * j]; v[j] = v[j] + y[j] * g * r;
                    if constexpr (OUTB) { v2u w; w.x = pk2(v[j].x, v[j].y); w.y = pk2(v[j].z, v[j].w); ((GAS v2u*)((bf16*)out + m * DM))[lane + 64 * j] = w; }
                    else ((GAS f32x4*)((float*)out + m * DM))[lane + 64 * j] = v[j] * oscale; }
            }
            if (XN) {
                float ss = 0.f;
#pragma unroll
                for (int j = 0; j < 4; ++j) ss += (v[j].x * v[j].x + v[j].y * v[j].y) + (v[j].z * v[j].z + v[j].w * v[j].w);
                const float r = __builtin_amdgcn_rsqf(wave_sum(ss) * (1.f / DM) + NORM_EPS);
#pragma unroll
                for (int j = 0; j < 4; ++j) { const f32x4 g = ((const GAS f32x4*)gnext)[lane + 64 * j]; const f32x4 o = v[j] * g * r;
                    v2u w; w.x = pk2(o.x, o.y); w.y = pk2(o.z, o.w); ((GAS v2u*)(XN + m * DM))[lane + 64 * j] = w; }
            }
        }
    }
}

namespace scan {
template <int CTRL> __device__ __forceinline__ float dpp_add(float x) {
    const int y = __builtin_amdgcn_update_dpp(0, __builtin_bit_cast(int, x), CTRL, 0xF, 0xF, false);
    return x + __builtin_bit_cast(float, y);
}
__device__ __forceinline__ float red8(float x) { x = dpp_add<0xB1>(x); x = dpp_add<0x4E>(x); x = dpp_add<0x141>(x); return x; }
__device__ __forceinline__ float red16(float x) { x = dpp_add<0xB1>(x); x = dpp_add<0x4E>(x); x = dpp_add<0x141>(x); x = dpp_add<0x140>(x); return x; }
__device__ __forceinline__ float prefix8tok(float x, int lane) {
    const bool half = (lane >> 3) & 1; const int row = lane >> 4;
    const float t1 = __builtin_bit_cast(float, __builtin_amdgcn_update_dpp(0x3f800000, __builtin_bit_cast(int, x), 0x118  , 0xF, 0xF, false));
    float P = x * t1;
    const float o1 = __builtin_bit_cast(float, __builtin_amdgcn_update_dpp(0, __builtin_bit_cast(int, P), 0x128  , 0xF, 0xF, false));
    const float R = half ? P : o1;
    { auto r16 = __builtin_amdgcn_permlane16_swap(__float_as_uint(R), __float_as_uint(R), false, false);
      const float m = (row & 1) ? __uint_as_float(r16[0]) : 1.f; P *= m; }
    const float o2 = __builtin_bit_cast(float, __builtin_amdgcn_update_dpp(0, __builtin_bit_cast(int, P), 0x128, 0xF, 0xF, false));
    const float T = half ? P : o2;
    { auto q16 = __builtin_amdgcn_permlane16_swap(__float_as_uint(T), __float_as_uint(T), false, false);
      auto r32 = __builtin_amdgcn_permlane32_swap(q16[1], q16[1], false, false);
      const float m = (row >= 2) ? __uint_as_float(r32[0]) : 1.f; P *= m; }
    return P;
}
__device__ __forceinline__ void ld8(const bf16* p, float (&o)[8]) { const v4u w = *(const GAS v4u*)p; o[0] = bflo(w.x); o[1] = bfhi(w.x); o[2] = bflo(w.y); o[3] = bfhi(w.y); o[4] = bflo(w.z); o[5] = bfhi(w.z); o[6] = bflo(w.w); o[7] = bfhi(w.w); }
}
struct PrepP { const bf16* ZR; bf16* X1; unsigned char* A8; bf16* KI; const float *mu, *w0, *wup, *a0, *aup; };
__device__ __forceinline__ void rwkv_prep(const PrepP& P, LAS unsigned char* lds) {
    const int tid = otid_(), lane = tid & 63, h = __builtin_amdgcn_readfirstlane(tid >> 6), c16 = lane & 15, quad = lane >> 4;
    constexpr int SP = 144;
    LAS unsigned char* TA = lds; LAS unsigned char* AA = lds + 64 * SP;
    bf16x8 bw[4][2], ba[4][2];
#pragma unroll
    for (int ct = 0; ct < 4; ++ct)
#pragma unroll
        for (int s = 0; s < 2; ++s) { const size_t o = (size_t)(32 * s + 8 * quad) * 512 + 64 * h + 16 * ct + c16; const float* gw_ = P.wup + o; const float* ga_ = P.aup + o;
            v4u w; w.x = pk2(gw_[0], gw_[512]); w.y = pk2(gw_[1024], gw_[1536]); w.z = pk2(gw_[2048], gw_[2560]); w.w = pk2(gw_[3072], gw_[3584]); bw[ct][s] = __builtin_bit_cast(bf16x8, w);
            v4u a; a.x = pk2(ga_[0], ga_[512]); a.y = pk2(ga_[1024], ga_[1536]); a.z = pk2(ga_[2048], ga_[2560]); a.w = pk2(ga_[3072], ga_[3584]); ba[ct][s] = __builtin_bit_cast(bf16x8, a); }
    float w0v[4], a0v[4];
#pragma unroll
    for (int ct = 0; ct < 4; ++ct) { w0v[ct] = P.w0[64 * h + 16 * ct + c16]; a0v[ct] = P.a0[64 * h + 16 * ct + c16]; }
    const int stok = tid >> 3, sseg = tid & 7;
#pragma unroll 1
    for (int m0 = blockIdx.x * 64; m0 < M; m0 += gridDim.x * 64) {
        {   const size_t m = (size_t)m0 + stok; const int t = (int)(m & (T - 1));
            *(GAS v4u*)(P.KI + m * 64 + 8 * sseg) = *(const GAS v4u*)(P.ZR + m * ZP + ZC_KI + 8 * sseg);
            float wc[8], ac[8], p8[8];
            scan::ld8(P.ZR + m * ZP + ZC_WC + 8 * sseg, wc); scan::ld8(P.ZR + m * ZP + ZC_AC + 8 * sseg, ac);
            if (t > 0) { scan::ld8(P.ZR + (m - 1) * ZP + ZC_WC + 8 * sseg, p8);
#pragma unroll
                for (int e = 0; e < 8; ++e) wc[e] += (p8[e] - wc[e]) * P.mu[1536 + 8 * sseg + e];
                scan::ld8(P.ZR + (m - 1) * ZP + ZC_AC + 8 * sseg, p8);
#pragma unroll
                for (int e = 0; e < 8; ++e) ac[e] += (p8[e] - ac[e]) * P.mu[1600 + 8 * sseg + e]; }
            else {
#pragma unroll
                for (int e = 0; e < 8; ++e) { wc[e] -= wc[e] * P.mu[1536 + 8 * sseg + e]; ac[e] -= ac[e] * P.mu[1600 + 8 * sseg + e]; } }
            float th[8];
#pragma unroll
            for (int e = 0; e < 8; ++e) th[e] = 1.f - 2.f * __builtin_amdgcn_rcpf(__expf(2.f * wc[e]) + 1.f);
            v4u o; o.x = pk2(th[0], th[1]); o.y = pk2(th[2], th[3]); o.z = pk2(th[4], th[5]); o.w = pk2(th[6], th[7]); *(LAS v4u*)(TA + stok * SP + 16 * sseg) = o;
            v4u q; q.x = pk2(ac[0], ac[1]); q.y = pk2(ac[2], ac[3]); q.z = pk2(ac[4], ac[5]); q.w = pk2(ac[6], ac[7]); *(LAS v4u*)(AA + stok * SP + 16 * sseg) = q;
        }
        __syncthreads();
#pragma unroll 1
        for (int rt = 0; rt < 4; ++rt) {
            f32x4 accw[4], acca[4];
#pragma unroll
            for (int ct = 0; ct < 4; ++ct) { accw[ct] = (f32x4){0.f, 0.f, 0.f, 0.f}; acca[ct] = (f32x4){0.f, 0.f, 0.f, 0.f}; }
#pragma unroll
            for (int s = 0; s < 2; ++s) { const bf16x8 fw = *(const LAS bf16x8*)(TA + (16 * rt + c16) * SP + (32 * s + 8 * quad) * 2), fa = *(const LAS bf16x8*)(AA + (16 * rt + c16) * SP + (32 * s + 8 * quad) * 2);
#pragma unroll
                for (int ct = 0; ct < 4; ++ct) { accw[ct] = __builtin_amdgcn_mfma_f32_16x16x32_bf16(fw, bw[ct][s], accw[ct], 0, 0, 0); acca[ct] = __builtin_amdgcn_mfma_f32_16x16x32_bf16(fa, ba[ct][s], acca[ct], 0, 0, 0); } }
#pragma unroll
            for (int j = 0; j < 4; ++j) { const size_t m = (size_t)m0 + 16 * rt + 4 * quad + j;
#pragma unroll
                for (int ct = 0; ct < 4; ++ct) { const int ch = 64 * h + 16 * ct + c16;
                    const float sg = sigm(w0v[ct] + accw[ct][j]);
                    const float x1 = 1.f - __expf(-0.6065306597126334f * sg);
                    const float a = sigm(a0v[ct] + acca[ct][j]);
                    P.X1[m * 512 + ch] = (bf16)f2bf(x1);
                    P.A8[m * 512 + ch] = (unsigned char)(int)(a * 255.f + 0.5f); } }
        }
        __syncthreads();
    }
}

struct ScanP { const bf16* Q3; const bf16* ZR; const bf16* X1; const unsigned char* A8; bf16* yraw; float* rdotk; const float *mu, *k_k, *k_a, *r_k; };
namespace scan {
constexpr int TB = 32, NBLK = T / TB;
constexpr int CB_W = 0, CB_B = 8192, CB_K = 16384, CB_KW = 24576, CB_V = 40960, CB_BR = 43008, CB_KR = 43136, CB_SA = 43264, CB_YP = 45312, CBSZ = 78080;
constexpr int L_END = 2 * CBSZ;
static_assert(L_END <= LDS_MISC, "scan LDS");
}
__device__ __forceinline__ void rwkv_scan_unit(const ScanP& P, int unit, LAS unsigned char* lds) {
    using namespace scan;
    const int tid = otid_(), wid = __builtin_amdgcn_readfirstlane(tid >> 6), lane = tid & 63;
    const int b = unit >> 5, h = (unit >> 2) & 7, vq = unit & 3;
    const size_t mrow0 = (size_t)b * T;
    if (wid >= 4) {
        const int pw = wid - 4, tokl = lane >> 3, seg = lane & 7, c0 = 8 * seg, hc0 = 64 * h + c0;
        float mu_r[8], mu_k[8], kkv[8], kav[8], rkv[8];
#pragma unroll
        for (int e = 0; e < 8; ++e) { mu_r[e] = P.mu[hc0 + e]; mu_k[e] = P.mu[512 + hc0 + e]; kkv[e] = P.k_k[hc0 + e]; kav[e] = P.k_a[hc0 + e]; rkv[e] = P.r_k[hc0 + e]; }
        const int vc0 = 64 * h + 16 * vq + 2 * seg;
        const float mu_v0 = P.mu[1024 + vc0], mu_v1 = P.mu[1024 + vc0 + 1];
        const int ptid = pw * 64 + lane;
        v4u nr, nrp, nk, nkp, nx; v2u na; unsigned nv, nvp;
#define SCAN_LOAD(nb_) do { const int t_ = (nb_) * TB + 8 * pw + tokl; const size_t m_ = mrow0 + t_, mp_ = t_ > 0 ? m_ - 1 : m_; \
            nr = *(const GAS v4u*)(P.Q3 + m_ * QP + 512 + hc0); nrp = *(const GAS v4u*)(P.Q3 + mp_ * QP + 512 + hc0); \
            nk = *(const GAS v4u*)(P.ZR + m_ * ZP + ZC_RK + hc0); nkp = *(const GAS v4u*)(P.ZR + mp_ * ZP + ZC_RK + hc0); \
            nx = *(const GAS v4u*)(P.X1 + m_ * 512 + hc0); na = *(const GAS v2u*)(P.A8 + m_ * 512 + hc0); \
            nv = *(const GAS unsigned*)(P.ZR + m_ * ZP + ZC_RV + vc0); nvp = *(const GAS unsigned*)(P.ZR + mp_ * ZP + ZC_RV + vc0); } while (0)
#define UNPK8(w_, o_) do { o_[0] = bflo(w_.x); o_[1] = bfhi(w_.x); o_[2] = bflo(w_.y); o_[3] = bfhi(w_.y); o_[4] = bflo(w_.z); o_[5] = bfhi(w_.z); o_[6] = bflo(w_.w); o_[7] = bfhi(w_.w); } while (0)
        SCAN_LOAD(0);
        for (int blk = -1; blk < NBLK; ++blk) {
            const int nb = blk + 1;
            LAS unsigned char* cb = lds + (nb & 1) * CBSZ;
            if (blk >= 1) {
                const int tok = ptid >> 3, v2 = (ptid & 7) * 2;
                const LAS float* YPp = (const LAS float*)(cb + CB_YP) + (tok * 16 + v2) * 16;
                float y0 = 0.f, y1 = 0.f;
#pragma unroll
                for (int q4 = 0; q4 < 4; ++q4) { const f32x4 a = *(const LAS f32x4*)(YPp + 4 * q4), c = *(const LAS f32x4*)(YPp + 16 + 4 * q4); y0 += (a.x + a.y) + (a.z + a.w); y1 += (c.x + c.y) + (c.z + c.w); }
                const float kr = *(const LAS float*)(cb + CB_KR + tok * 4);
                const f32x2 vv = *(const LAS f32x2*)(cb + CB_V + (tok * 16 + v2) * 4);
                y0 += vv.x * kr; y1 += vv.y * kr;
                const size_t m = mrow0 + (size_t)(blk - 1) * TB + tok;
                *(GAS unsigned*)(P.yraw + m * 512 + 64 * h + 16 * vq + v2) = pk2(y0, y1);
                LDS_WAIT(); asm volatile("" ::: "memory");
            }
            if (nb < NBLK) {
                const int t = nb * TB + 8 * pw + tokl; const size_t m = mrow0 + t;
                float r8[8], k8[8], p8[8], x8[8], a8[8];
                const v4u cr = nr, crp = nrp, ck = nk, ckp = nkp, cx = nx; const v2u ca = na; const unsigned cv = nv, cvp = nvp;
                if (nb + 1 < NBLK) SCAN_LOAD(nb + 1);
                UNPK8(cr, r8); UNPK8(ck, k8); UNPK8(cx, x8);
                { const float sc = 1.f / 255.f;
                  a8[0] = (float)(ca.x & 255u) * sc; a8[1] = (float)((ca.x >> 8) & 255u) * sc; a8[2] = (float)((ca.x >> 16) & 255u) * sc; a8[3] = (float)(ca.x >> 24) * sc;
                  a8[4] = (float)(ca.y & 255u) * sc; a8[5] = (float)((ca.y >> 8) & 255u) * sc; a8[6] = (float)((ca.y >> 16) & 255u) * sc; a8[7] = (float)(ca.y >> 24) * sc; }
                float v0 = bflo(cv), v1 = bfhi(cv);
                if (t > 0) {
                    UNPK8(crp, p8);
#pragma unroll
                    for (int e = 0; e < 8; ++e) r8[e] += (p8[e] - r8[e]) * mu_r[e];
                    UNPK8(ckp, p8);
#pragma unroll
                    for (int e = 0; e < 8; ++e) k8[e] += (p8[e] - k8[e]) * mu_k[e];
                    v0 += (bflo(cvp) - v0) * mu_v0; v1 += (bfhi(cvp) - v1) * mu_v1;
                } else {
#pragma unroll
                    for (int e = 0; e < 8; ++e) { r8[e] -= r8[e] * mu_r[e]; k8[e] -= k8[e] * mu_k[e]; }
                    v0 -= v0 * mu_v0; v1 -= v1 * mu_v1;
                }
                float kk8[8]; { float ss = 0.f;
#pragma unroll
                  for (int e = 0; e < 8; ++e) { kk8[e] = k8[e] * kkv[e]; ss += kk8[e] * kk8[e]; }
                  ss = red8(ss); const float inv = 1.f / fmaxf(sqrtf(ss), 1e-12f);
#pragma unroll
                  for (int e = 0; e < 8; ++e) kk8[e] *= inv; }
                float w8[8], bb[8], km[8], wr[8]; float brp = 0.f, krp = 0.f, rkp = 0.f;
#pragma unroll
                for (int e = 0; e < 8; ++e) {
                    bb[e] = kk8[e] * a8[e]; km[e] = k8[e] * (1.f + (a8[e] - 1.f) * kav[e]);
                    brp += bb[e] * r8[e]; krp += km[e] * r8[e]; rkp += r8[e] * km[e] * rkv[e];
                }
                brp = red8(brp); krp = red8(krp); rkp = red8(rkp);
#pragma unroll
                for (int e = 0; e < 8; ++e) {
                    const float wd = 1.f - x8[e], wc = prefix8tok(wd, lane), iwc = __builtin_amdgcn_rcpf(wc), wp = wc * __builtin_amdgcn_rcpf(wd);
                    w8[e] = wc; kk8[e] *= wp; bb[e] *= iwc; km[e] *= iwc; wr[e] = wc * r8[e] - kk8[e] * brp;
                }
                const int ti = 8 * pw + tokl;
                if (tokl == 7) { *(LAS f32x4*)(cb + CB_W + (pw * 64 + c0) * 4) = (f32x4){w8[0], w8[1], w8[2], w8[3]}; *(LAS f32x4*)(cb + CB_W + (pw * 64 + c0 + 4) * 4) = (f32x4){w8[4], w8[5], w8[6], w8[7]}; }
                *(LAS f32x4*)(cb + CB_B + (ti * 64 + c0) * 4) = (f32x4){bb[0], bb[1], bb[2], bb[3]}; *(LAS f32x4*)(cb + CB_B + (ti * 64 + c0 + 4) * 4) = (f32x4){bb[4], bb[5], bb[6], bb[7]};
                *(LAS f32x4*)(cb + CB_K + (ti * 64 + c0) * 4) = (f32x4){km[0], km[1], km[2], km[3]}; *(LAS f32x4*)(cb + CB_K + (ti * 64 + c0 + 4) * 4) = (f32x4){km[4], km[5], km[6], km[7]};
#pragma unroll
                for (int e = 0; e < 8; e += 2) *(LAS f32x4*)(cb + CB_KW + ti * 512 + ((e >> 1) & 1) * 256 + (2 * seg + (e >> 2)) * 16) = (f32x4){kk8[e], wr[e], kk8[e + 1], wr[e + 1]};
                *(LAS f32x2*)(cb + CB_V + (ti * 16 + 2 * seg) * 4) = (f32x2){v0, v1};
                if (seg == 0) { *(LAS float*)(cb + CB_KR + ti * 4) = krp; if (vq == 0) P.rdotk[m * 8 + h] = rkp; }
            }
            __syncthreads();
        }
        { const LAS unsigned char* cb = lds + ((NBLK - 1) & 1) * CBSZ;
          const int tok = ptid >> 3, v2 = (ptid & 7) * 2;
          const LAS float* YPp = (const LAS float*)(cb + CB_YP) + (tok * 16 + v2) * 16;
          float y0 = 0.f, y1 = 0.f;
#pragma unroll
          for (int q4 = 0; q4 < 4; ++q4) { const f32x4 a = *(const LAS f32x4*)(YPp + 4 * q4), c = *(const LAS f32x4*)(YPp + 16 + 4 * q4); y0 += (a.x + a.y) + (a.z + a.w); y1 += (c.x + c.y) + (c.z + c.w); }
          const float kr = *(const LAS float*)(cb + CB_KR + tok * 4);
          const f32x2 vv = *(const LAS f32x2*)(cb + CB_V + (tok * 16 + v2) * 4);
          y0 += vv.x * kr; y1 += vv.y * kr;
          const size_t m = mrow0 + (size_t)(NBLK - 1) * TB + tok;
          *(GAS unsigned*)(P.yraw + m * 512 + 64 * h + 16 * vq + v2) = pk2(y0, y1); }
    } else {
        const int vi = 4 * wid + (lane >> 4), cg = lane & 15;
        f32x2 s01 = {0.f, 0.f}, s23 = {0.f, 0.f};
        __syncthreads();
        __builtin_amdgcn_s_setprio(3);
        const unsigned lo4 = (unsigned)(4 * cg) * 4u;
        for (int blk = 0; blk < NBLK; ++blk) {
            const LAS unsigned char* cb = lds + (blk & 1) * CBSZ;
            f32x4 kwa = *(const LAS f32x4*)(cb + CB_KW + lo4), kwb = *(const LAS f32x4*)(cb + CB_KW + 256 + lo4);
            f32x4 b4 = *(const LAS f32x4*)(cb + CB_B + lo4), k4 = *(const LAS f32x4*)(cb + CB_K + lo4), wg4 = {1.f, 1.f, 1.f, 1.f};
            float vv = *(const LAS float*)(cb + CB_V + vi * 4);
#pragma unroll 8
            for (int tok = 0; tok < TB; ++tok) {
                const int tn = tok + 1 < TB ? tok + 1 : tok;
                const f32x4 nkwa = *(const LAS f32x4*)(cb + CB_KW + tn * 512 + lo4), nkwb = *(const LAS f32x4*)(cb + CB_KW + tn * 512 + 256 + lo4);
                const f32x4 nb4 = *(const LAS f32x4*)(cb + CB_B + tn * 256 + lo4), nk4 = *(const LAS f32x4*)(cb + CB_K + tn * 256 + lo4);
                if ((tok & 7) == 0) wg4 = *(const LAS f32x4*)(cb + CB_W + (tok >> 3) * 256 + lo4);
                const float nvv = *(const LAS float*)(cb + CB_V + (tn * 16 + vi) * 4);
                f32x2 p = (f32x2){s01.x, s01.x} * (f32x2){kwa.x, kwa.y};
                p += (f32x2){s01.y, s01.y} * (f32x2){kwa.z, kwa.w};
                p += (f32x2){s23.x, s23.x} * (f32x2){kwb.x, kwb.y};
                p += (f32x2){s23.y, s23.y} * (f32x2){kwb.z, kwb.w};
                *(LAS float*)(cb + CB_YP + ((tok * 16 + vi) * 16 + cg) * 4) = p.y;
                const f32x2 t01 = s01 + (f32x2){k4.x, k4.y} * vv, t23 = s23 + (f32x2){k4.z, k4.w} * vv;
                const float d1 = red16(p.x);
                s01 = t01 - (f32x2){b4.x, b4.y} * d1; s23 = t23 - (f32x2){b4.z, b4.w} * d1;
                if ((tok & 7) == 7) { s01 *= (f32x2){wg4.x, wg4.y}; s23 *= (f32x2){wg4.z, wg4.w}; }
                kwa = nkwa; kwb = nkwb; b4 = nb4; k4 = nk4; vv = nvv;
            }
            __syncthreads();
        }
        __builtin_amdgcn_s_setprio(0);
    }
    __syncthreads();
}

struct Dsa1P { const bf16* ZR; const bf16* KI; unsigned* bitm; gu32* done; };
namespace dsa1 {
constexpr int CAP = 769  , PRUNE_AT = 512, PRUNE_LO = 400, KEEP = 256;
constexpr int L_BUF = 0, L_CNT = 32 * CAP * 4, L_THR = L_CNT + 128, L_THRK = L_THR + 128, L_HIST = ((L_THRK + 128 + 15) / 16) * 16, L_MROW = L_HIST + 8 * 1024, L_QF = L_MROW + 8 * 1024, QFP = 1040, L_END = L_QF + 32 * QFP;
static_assert(L_END <= LDS_MISC, "dsa1 LDS");
__device__ __forceinline__ unsigned packkey(float s, int keyidx) { const unsigned bits = __float_as_uint(s); const unsigned u = bits ^ ((unsigned)((int)bits >> 31) | 0x80000000u); return (u & 0xFFFFE000u) | (unsigned)(8191 - keyidx); }
__device__ __forceinline__ float thr_of(unsigned key) { const unsigned u = key & 0xFFFFE000u; const unsigned bits = (u & 0x80000000u) ? (u ^ 0x80000000u) : ~u; return __uint_as_float(bits); }
__device__ __forceinline__ int wave_prefix_incl(int v) {
    v += __builtin_amdgcn_update_dpp(0, v, 0x111, 0xF, 0xF, true);
    v += __builtin_amdgcn_update_dpp(0, v, 0x112, 0xF, 0xF, true);
    v += __builtin_amdgcn_update_dpp(0, v, 0x114, 0xF, 0xF, true);
    v += __builtin_amdgcn_update_dpp(0, v, 0x118, 0xF, 0xF, true);
    v += __builtin_amdgcn_update_dpp(0, v, 0x142, 0xA, 0xF, false);
    v += __builtin_amdgcn_update_dpp(0, v, 0x143, 0xC, 0xF, false);
    return v;
}
__device__ __forceinline__ void prune(LAS unsigned char* lds, int qq, int wid, int lane, bool exact) {
    asm volatile("" : "+v"(lane));
    LAS unsigned* buf = (LAS unsigned*)(lds + L_BUF) + qq * CAP; LAS unsigned* cnt = (LAS unsigned*)(lds + L_CNT); LAS float* thr = (LAS float*)(lds + L_THR); LAS unsigned* thrk = (LAS unsigned*)(lds + L_THRK);
    LAS unsigned* hist = (LAS unsigned*)(lds + L_HIST) + wid * 256;
    const int n = (int)cnt[qq];
    unsigned e[12];
#pragma unroll
    for (int k = 0; k < 12; ++k) e[k] = (lane + 64 * k < n) ? buf[lane + 64 * k] : 0u;
    const unsigned tk = thrk[qq];
    unsigned cut = 0u; bool have = false;
    if (!exact && tk != 0u) {
        const unsigned base16 = tk >> 16;
        *(LAS v4u*)(hist + 4 * lane) = (v4u){0u, 0u, 0u, 0u};
        LDS_WAIT(); asm volatile("" ::: "memory");
#pragma unroll
        for (int k = 0; k < 12; ++k) if (lane + 64 * k < n) { unsigned bn = (e[k] >> 16) - base16; bn = bn > 255u ? 255u : bn; (void)__hip_atomic_fetch_add(hist + bn, 1u, __ATOMIC_RELAXED, __HIP_MEMORY_SCOPE_WORKGROUP); }
        LDS_WAIT(); asm volatile("" ::: "memory");
        const int rl = 63 - lane;
        const v4u hv = *(const LAS v4u*)(hist + 4 * rl);
        const int tot = (int)(hv.x + hv.y + hv.z + hv.w);
        int above = wave_prefix_incl(tot) - tot; int dsel = -1, csel = 0;
        { const int h3 = (int)hv.w, h2 = (int)hv.z, h1 = (int)hv.y, h0 = (int)hv.x;
          if (above < KEEP && KEEP <= above + h3) { dsel = 4 * rl + 3; csel = above + h3; } above += h3;
          if (above < KEEP && KEEP <= above + h2) { dsel = 4 * rl + 2; csel = above + h2; } above += h2;
          if (above < KEEP && KEEP <= above + h1) { dsel = 4 * rl + 1; csel = above + h1; } above += h1;
          if (above < KEEP && KEEP <= above + h0) { dsel = 4 * rl + 0; csel = above + h0; } }
        const unsigned long long bm = __ballot(dsel >= 0);
        const int src = bm ? (int)__builtin_ctzll(bm) : 0;
        const int d = __builtin_amdgcn_readlane(dsel, src), cd = __builtin_amdgcn_readlane(csel, src);
        LDS_WAIT(); asm volatile("" ::: "memory");
        if (bm != 0ull && cd <= KEEP + 128) { cut = (base16 + (unsigned)d) << 16; have = true; }
    }
    if (!have) {
        unsigned prefix = 0u; int want = KEEP;
#pragma unroll 1
        for (int p = 0; p < 4; ++p) {
            const int shift = 24 - 8 * p;
            *(LAS v4u*)(hist + 4 * lane) = (v4u){0u, 0u, 0u, 0u};
            LDS_WAIT(); asm volatile("" ::: "memory");
#pragma unroll
            for (int k = 0; k < 12; ++k) { const bool in = (lane + 64 * k < n) && (p == 0 || (e[k] >> (shift + 8)) == (prefix >> (shift + 8)));
                if (in) (void)__hip_atomic_fetch_add(hist + ((e[k] >> shift) & 255u), 1u, __ATOMIC_RELAXED, __HIP_MEMORY_SCOPE_WORKGROUP); }
            LDS_WAIT(); asm volatile("" ::: "memory");
            const int rl = 63 - lane;
            const v4u hv = *(const LAS v4u*)(hist + 4 * rl);
            const int tot = (int)(hv.x + hv.y + hv.z + hv.w);
            int above = wave_prefix_incl(tot) - tot;
            int dsel = -1, asel = 0, hsel = 0;
            { const int h3 = (int)hv.w, h2 = (int)hv.z, h1 = (int)hv.y, h0 = (int)hv.x;
              if (above < want && want <= above + h3) { dsel = 4 * rl + 3; asel = above; hsel = h3; } above += h3;
              if (above < want && want <= above + h2) { dsel = 4 * rl + 2; asel = above; hsel = h2; } above += h2;
              if (above < want && want <= above + h1) { dsel = 4 * rl + 1; asel = above; hsel = h1; } above += h1;
              if (above < want && want <= above + h0) { dsel = 4 * rl + 0; asel = above; hsel = h0; } }
            const unsigned long long bm = __ballot(dsel >= 0);
            const int src = bm ? (int)__builtin_ctzll(bm) : 0;
            const int d = __builtin_amdgcn_readlane(dsel, src), ab = __builtin_amdgcn_readlane(asel, src), hd = __builtin_amdgcn_readlane(hsel, src);
            prefix |= ((unsigned)(d < 0 ? 0 : d)) << shift;
            LDS_WAIT(); asm volatile("" ::: "memory");
            if (!exact && bm != 0ull && (KEEP - want) + ab + hd <= KEEP + 128) break;
            want -= ab;
        }
        cut = prefix;
    }
    int base = 0;
#pragma unroll
    for (int k = 0; k < 12; ++k) { const bool keep = (lane + 64 * k < n) && e[k] >= cut; const unsigned long long mk = __ballot(keep);
        const int pos = base + (int)__builtin_amdgcn_mbcnt_hi((unsigned)(mk >> 32), __builtin_amdgcn_mbcnt_lo((unsigned)mk, 0u));
        if (keep) buf[pos] = e[k]; base += (int)__builtin_popcountll(mk); }
    if (lane == 0) { cnt[qq] = (unsigned)base; thr[qq] = thr_of(cut); thrk[qq] = cut; }
    LDS_WAIT(); asm volatile("" ::: "memory");
}
}
__device__ __forceinline__ void dsa1_unit_lists(const Dsa1P& P, int u, LAS unsigned char* lds) {
    using namespace dsa1;
    const int tid = otid_(), wid = __builtin_amdgcn_readfirstlane(tid >> 6), lane = tid & 63, q = lane & 31, hi = lane >> 5;
    const int b = u & 1, qb32 = 255 - (u >> 1), t0 = 32 * qb32;
    const size_t brow = (size_t)b * T;
    LAS unsigned* buf = (LAS unsigned*)(lds + L_BUF); LAS unsigned* cnt = (LAS unsigned*)(lds + L_CNT); LAS float* thr = (LAS float*)(lds + L_THR);
    if (tid < 32) { cnt[tid] = 0u; thr[tid] = -__builtin_inff(); ((LAS unsigned*)(lds + L_THRK))[tid] = 0u; }
    const bf16* qrow = P.ZR + (brow + t0 + q) * ZP;
    { const int r = tid >> 4, sg = tid & 15; const bf16* src = P.ZR + (brow + t0 + r) * ZP + ZC_QI + 32 * sg;
#pragma unroll
      for (int j = 0; j < 4; ++j) *(LAS v4u*)(lds + L_QF + r * QFP + 64 * sg + 16 * j) = *(const GAS v4u*)(src + 8 * j); }
    float wq[8];
    { const v4u w = *(const GAS v4u*)(qrow + ZC_WI); const float c = 0.35355339059327373f * 0.125f;
      wq[0] = bflo(w.x) * c; wq[1] = bfhi(w.x) * c; wq[2] = bflo(w.y) * c; wq[3] = bfhi(w.y) * c; wq[4] = bflo(w.z) * c; wq[5] = bfhi(w.z) * c; wq[6] = bflo(w.w) * c; wq[7] = bfhi(w.w) * c; }
    const int tq = t0 + q;
    const int nsteps = (t0 + 32 + 255) >> 8;
    __syncthreads();
    float th = -__builtin_inff();
    bf16x8 afn[4];
    { const int k0 = 32 * wid; const bf16* krow = P.KI + (brow + (k0 <= t0 + 31 ? k0 : 0) + q) * 64 + 8 * hi;
#pragma unroll
      for (int s = 0; s < 4; ++s) afn[s] = *(const GAS bf16x8*)(krow + 16 * s); }
    for (int st = 0; st < nsteps; ++st) {
        const int key0 = 256 * st + 32 * wid;
        bf16x8 af[4];
#pragma unroll
        for (int s = 0; s < 4; ++s) af[s] = afn[s];
        { const int k1 = key0 + 256; const bf16* krow = P.KI + (brow + (k1 <= t0 + 31 ? k1 : 0) + q) * 64 + 8 * hi;
#pragma unroll
          for (int s = 0; s < 4; ++s) afn[s] = *(const GAS bf16x8*)(krow + 16 * s); }
        if (key0 <= t0 + 31) {
            f32x16 sc;
#pragma unroll
            for (int i = 0; i < 16; ++i) sc[i] = 0.f;
            unsigned qfo = (unsigned)(L_QF + q * QFP + 16 * hi); asm volatile("" : "+v"(qfo));
#pragma unroll
            for (int hd = 0; hd < 8; ++hd) {
                f32x16 acc;
#pragma unroll
                for (int i = 0; i < 16; ++i) acc[i] = 0.f;
#pragma unroll
                for (int s = 0; s < 4; ++s) { const bf16x8 qb = *(const LAS bf16x8*)(lds + qfo + hd * 128 + 32 * s);
                    acc = __builtin_amdgcn_mfma_f32_32x32x16_bf16(af[s], qb, acc, 0, 0, 0); }
#pragma unroll
                for (int i = 0; i < 16; ++i) sc[i] = fmaf(__builtin_amdgcn_fmed3f(acc[i], 0.f, 3.0e38f), wq[hd], sc[i]);
                __builtin_amdgcn_sched_barrier(0);
            }
            const bool diag = key0 + 31 > t0;
            unsigned pm = 0u;
#pragma unroll
            for (int i = 0; i < 16; ++i) { const int kidx = key0 + (i & 3) + 8 * (i >> 2) + 4 * hi; const bool ok = (sc[i] >= th) && (!diag || kidx <= tq); pm |= ok ? (1u << i) : 0u; }
            const int np = __builtin_popcount(pm);
            if (np > 0) {
                int pos = (int)__hip_atomic_fetch_add(cnt + q, (unsigned)np, __ATOMIC_RELAXED, __HIP_MEMORY_SCOPE_WORKGROUP);
                LAS unsigned* bq = buf + q * CAP;
#pragma unroll
                for (int i = 0; i < 16; ++i) if (pm & (1u << i)) { const int kidx = key0 + (i & 3) + 8 * (i >> 2) + 4 * hi; bq[pos] = packkey(sc[i], kidx); ++pos; }
            }
        }
        __syncthreads();
        { const unsigned cq = cnt[q]; unsigned nm = (unsigned)__ballot(cq > (unsigned)PRUNE_AT); if (nm) nm = (unsigned)__ballot(cq > (unsigned)PRUNE_LO); int i = 0;
          while (nm) { const int qq = __builtin_ctz(nm); nm &= nm - 1u; if ((i & 7) == wid) prune(lds, qq, wid, lane, false); ++i; } }
        __syncthreads();
        th = thr[q];
    }
    LAS unsigned* mrow = (LAS unsigned*)(lds + L_MROW) + wid * 256;
#pragma unroll 1
    for (int k = 0; k < 4; ++k) {
        const int qq = wid + 8 * k;
        if (cnt[qq] > (unsigned)KEEP) prune(lds, qq, wid, lane, true);
        const int nf = (int)cnt[qq];
        *(LAS v4u*)(mrow + 4 * lane) = (v4u){0u, 0u, 0u, 0u};
        LDS_WAIT(); asm volatile("" ::: "memory");
#pragma unroll
        for (int j = 0; j < 4; ++j) { const int idx = lane + 64 * j; if (idx < nf) { const unsigned e = buf[qq * CAP + idx]; const unsigned key = 8191u - (e & 0x1FFFu); (void)__hip_atomic_fetch_or(mrow + (key >> 5), 1u << (key & 31u), __ATOMIC_RELAXED, __HIP_MEMORY_SCOPE_WORKGROUP); } }
        LDS_WAIT(); asm volatile("" ::: "memory");
        unsigned long long* grow = (unsigned long long*)(P.bitm + (brow + t0 + qq) * 256);
#pragma unroll
        for (int j = 0; j < 2; ++j) { const int w2 = lane + 64 * j; const unsigned long long v = (unsigned long long)mrow[2 * w2] | ((unsigned long long)mrow[2 * w2 + 1] << 32);
            __hip_atomic_store(grow + w2, v, RLX_AGENT); }
        LDS_WAIT(); asm volatile("" ::: "memory");
    }
    VM_WAIT();
    __syncthreads();
    if (tid == 0) __hip_atomic_fetch_add(P.done + 64 * (b * 32 + (t0 >> 8)), 1u, RLX_AGENT);
}

namespace dsa1h {
constexpr int NBINS = 512, CAPB = 64, KEEP = 256;
constexpr int L_HIST = 0, L_MROW = 65536, L_BL = L_MROW + 32768, L_RMIN = L_BL + 32 * CAPB * 8, L_RMAX = L_RMIN + 128, L_BST = L_RMAX + 128, L_NEED = L_BST + 128, L_BCNT = L_NEED + 128, L_FLAG = L_BCNT + 128,
              L_QF = L_FLAG + 128, QFP = 1168  , L_END = L_QF + 32 * QFP;
static_assert(L_END <= LDS_MISC, "dsa1h LDS");
__device__ __forceinline__ unsigned ordu(float x) { const unsigned b = __float_as_uint(x); return b ^ ((unsigned)((int)b >> 31) | 0x80000000u); }
__device__ __forceinline__ float unordu(unsigned u) { const unsigned b = (u & 0x80000000u) ? (u ^ 0x80000000u) : ~u; return __uint_as_float(b); }
}
__device__ __forceinline__ bool dsa1_unit_hist(const Dsa1P& P, int u, LAS unsigned char* lds) {
    using namespace dsa1h;
    const int tid = otid_(), wid = __builtin_amdgcn_readfirstlane(tid >> 6), lane = tid & 63, q = lane & 31, hi = lane >> 5;
    const int b = u & 1, qb32 = 255 - (u >> 1), t0 = 32 * qb32;
    const size_t brow = (size_t)b * T;
    LAS unsigned* hist = (LAS unsigned*)(lds + L_HIST); LAS unsigned* mrow = (LAS unsigned*)(lds + L_MROW);
    LAS unsigned* rmin = (LAS unsigned*)(lds + L_RMIN); LAS unsigned* rmax = (LAS unsigned*)(lds + L_RMAX); LAS int* bst = (LAS int*)(lds + L_BST); LAS int* need = (LAS int*)(lds + L_NEED);
    LAS unsigned* bcnt = (LAS unsigned*)(lds + L_BCNT); LAS unsigned* flag = (LAS unsigned*)(lds + L_FLAG);
#pragma unroll
    for (int j = 0; j < 12; ++j) *(LAS v4u*)(lds + L_HIST + (j * 512 + tid) * 16) = (v4u){0u, 0u, 0u, 0u};
    if (tid < 32) { rmin[tid] = 0xFFFFFFFFu; rmax[tid] = 0u; bcnt[tid] = 0u; if (tid == 0) flag[0] = 0u; }
    const bf16* qrow = P.ZR + (brow + t0 + q) * ZP;
    { const int r = tid >> 4, sg = tid & 15; const bf16* src = P.ZR + (brow + t0 + r) * ZP + ZC_QI + 32 * sg;
#pragma unroll
      for (int j = 0; j < 4; ++j) *(LAS v4u*)(lds + L_QF + r * QFP + 64 * sg + 16 * j) = *(const GAS v4u*)(src + 8 * j); }
    float wq[8];
    { const v4u w = *(const GAS v4u*)(qrow + ZC_WI); const float c = 0.35355339059327373f * 0.125f;
      wq[0] = bflo(w.x) * c; wq[1] = bfhi(w.x) * c; wq[2] = bflo(w.y) * c; wq[3] = bfhi(w.y) * c; wq[4] = bflo(w.z) * c; wq[5] = bfhi(w.z) * c; wq[6] = bflo(w.w) * c; wq[7] = bfhi(w.w) * c; }
    const int tq = t0 + q;
    const int nsteps = (t0 + 32 + 255) >> 8;
    __syncthreads();
    if (tid < 256) { const int r = tid >> 3, ds = tid & 7;
        const v4u w = *(const GAS v4u*)(P.ZR + (brow + t0 + r) * ZP + ZC_WI); const float c2 = 0.35355339059327373f * 0.125f * 0.5f;
        const float wh[8] = {bflo(w.x) * c2, bfhi(w.x) * c2, bflo(w.y) * c2, bfhi(w.y) * c2, bflo(w.z) * c2, bfhi(w.z) * c2, bflo(w.w) * c2, bfhi(w.w) * c2};
        float ql[8] = {0.f, 0.f, 0.f, 0.f, 0.f, 0.f, 0.f, 0.f};
#pragma unroll
        for (int hd = 0; hd < 8; ++hd) { const v4u qv = *(const LAS v4u*)(lds + L_QF + r * QFP + hd * 128 + 16 * ds);
            ql[0] += wh[hd] * bflo(qv.x); ql[1] += wh[hd] * bfhi(qv.x); ql[2] += wh[hd] * bflo(qv.y); ql[3] += wh[hd] * bfhi(qv.y);
            ql[4] += wh[hd] * bflo(qv.z); ql[5] += wh[hd] * bfhi(qv.z); ql[6] += wh[hd] * bflo(qv.w); ql[7] += wh[hd] * bfhi(qv.w); }
        *(LAS v4u*)(lds + L_QF + r * QFP + 1024 + 16 * ds) = (v4u){pk2(ql[0], ql[1]), pk2(ql[2], ql[3]), pk2(ql[4], ql[5]), pk2(ql[6], ql[7])}; }
#pragma unroll
    for (int e = 0; e < 8; ++e) wq[e] *= 0.5f;
    __syncthreads();
    bf16x8 afn[4];
#define DSA1H_FIRST() do { const int k0_ = 32 * wid; const bf16* krow_ = P.KI + (brow + (k0_ <= t0 + 31 ? k0_ : 0) + q) * 64 + 8 * hi; \
        _Pragma("unroll") for (int s_ = 0; s_ < 4; ++s_) afn[s_] = *(const GAS bf16x8*)(krow_ + 16 * s_); } while (0)
#define DSA1H_LQ(buf_, hd_) do { _Pragma("unroll") for (int s_ = 0; s_ < 4; ++s_) buf_[s_] = *(const LAS bf16x8*)(lds + qfo_ + (hd_) * 128 + 32 * s_); } while (0)
#define DSA1H_MM(acc_, buf_) do { _Pragma("unroll") for (int i_ = 0; i_ < 16; ++i_) acc_[i_] = 0.f; \
        _Pragma("unroll") for (int s_ = 0; s_ < 4; ++s_) acc_ = __builtin_amdgcn_mfma_f32_32x32x16_bf16(af_[s_], buf_[s_], acc_, 0, 0, 0); } while (0)
#define DSA1H_RW(sc_, acc_, hd_) do { _Pragma("unroll") for (int i_ = 0; i_ < 16; ++i_) { float t_ = fmaf(__builtin_fabsf(acc_[i_]), wq[hd_], sc_[i_]); \
        asm volatile("" : "+v"(t_));   sc_[i_] = t_; } } while (0)
#define DSA1H_SB() __builtin_amdgcn_sched_barrier(0)
#define DSA1H_SCORES(st_, key0_, sc_) \
        bf16x8 af_[4]; \
        _Pragma("unroll") for (int s_ = 0; s_ < 4; ++s_) af_[s_] = afn[s_]; \
        { const int k1_ = (key0_) + 256; const bf16* krow_ = P.KI + (brow + (k1_ <= t0 + 31 ? k1_ : 0) + q) * 64 + 8 * hi; \
          _Pragma("unroll") for (int s_ = 0; s_ < 4; ++s_) afn[s_] = *(const GAS bf16x8*)(krow_ + 16 * s_); } \
        f32x16 sc_; \
        { unsigned qfo_ = (unsigned)(L_QF + q * QFP + 16 * hi); asm volatile("" : "+v"(qfo_)); \
          bf16x8 qa_[4], qb_[4]; f32x16 accA_, accB_; \
          DSA1H_LQ(qa_, 8); DSA1H_LQ(qb_, 0); DSA1H_SB(); \
          DSA1H_MM(sc_, qa_); DSA1H_SB();                                    \
          DSA1H_LQ(qa_, 1); DSA1H_MM(accA_, qb_); DSA1H_SB(); \
          DSA1H_LQ(qb_, 2); DSA1H_MM(accB_, qa_); DSA1H_RW(sc_, accA_, 0); DSA1H_SB(); \
          DSA1H_LQ(qa_, 3); DSA1H_MM(accA_, qb_); DSA1H_RW(sc_, accB_, 1); DSA1H_SB(); \
          DSA1H_LQ(qb_, 4); DSA1H_MM(accB_, qa_); DSA1H_RW(sc_, accA_, 2); DSA1H_SB(); \
          DSA1H_LQ(qa_, 5); DSA1H_MM(accA_, qb_); DSA1H_RW(sc_, accB_, 3); DSA1H_SB(); \
          DSA1H_LQ(qb_, 6); DSA1H_MM(accB_, qa_); DSA1H_RW(sc_, accA_, 4); DSA1H_SB(); \
          DSA1H_LQ(qa_, 7); DSA1H_MM(accA_, qb_); DSA1H_RW(sc_, accB_, 5); DSA1H_SB(); \
          DSA1H_MM(accB_, qa_); DSA1H_RW(sc_, accA_, 6); DSA1H_SB(); \
          DSA1H_RW(sc_, accB_, 7); DSA1H_SB(); }
    float lo, scale;
    DSA1H_FIRST();
    {   const int key0 = 32 * wid;
        DSA1H_SCORES(0, key0, sc0);
        float mn = sc0[0], mx = sc0[0];
#pragma unroll
        for (int i = 1; i < 16; ++i) { mn = fminf(mn, sc0[i]); mx = fmaxf(mx, sc0[i]); }
        (void)__hip_atomic_fetch_min(rmin + q, ordu(mn), __ATOMIC_RELAXED, __HIP_MEMORY_SCOPE_WORKGROUP);
        (void)__hip_atomic_fetch_max(rmax + q, ordu(mx), __ATOMIC_RELAXED, __HIP_MEMORY_SCOPE_WORKGROUP);
        __syncthreads();
        const float fmn = unordu(rmin[q]), fmx = unordu(rmax[q]), rg = fmx - fmn;
        scale = rg > 0.f ? (float)NBINS / (2.f * rg) : 0.f; lo = -(fmn - 0.5f * rg) * scale;
        if (!(rg > 0.f) || !(rg < 3.0e37f)) { if (lane < 32) flag[0] = 1u; }
    }
#define DSA1H_BIN(x_) ({ unsigned b_ = (unsigned)fmaf((x_), scale, lo);   (int)(b_ > (unsigned)(NBINS - 1) ? (unsigned)(NBINS - 1) : b_); })
    DSA1H_FIRST();
    for (int st = 0; st < nsteps; ++st) {
        const int key0 = 256 * st + 32 * wid;
        if (key0 <= t0 + 31) {
            DSA1H_SCORES(st, key0, sc);
            const bool diag = key0 + 31 > t0;
            LAS unsigned* hq = hist + q * NBINS;
            if (!diag) {
#pragma unroll
                for (int i = 0; i < 16; ++i) { const int bn = DSA1H_BIN(sc[i]); (void)__hip_atomic_fetch_add(hq + bn, 1u, __ATOMIC_RELAXED, __HIP_MEMORY_SCOPE_WORKGROUP); }
            } else {
#pragma unroll
                for (int i = 0; i < 16; ++i) { const int kidx = key0 + (i & 3) + 8 * (i >> 2) + 4 * hi;
                    if (kidx <= tq) { const int bn = DSA1H_BIN(sc[i]); (void)__hip_atomic_fetch_add(hq + bn, 1u, __ATOMIC_RELAXED, __HIP_MEMORY_SCOPE_WORKGROUP); } }
            }
        } else { bf16x8 af_[4]; (void)af_; }
    }
    __syncthreads();
#pragma unroll 1
    for (int k = 0; k < 4; ++k) {
        const int qq = wid + 8 * k; const int rl = 63 - lane;
        const v4u ha = *(const LAS v4u*)(hist + qq * NBINS + 8 * rl), hb = *(const LAS v4u*)(hist + qq * NBINS + 8 * rl + 4);
        const unsigned hw[8] = {ha.x, ha.y, ha.z, ha.w, hb.x, hb.y, hb.z, hb.w};
        int tot = 0;
#pragma unroll
        for (int j = 0; j < 8; ++j) tot += (int)hw[j];
        int above = dsa1::wave_prefix_incl(tot) - tot; int bsel = -1, asel = 0, csel = 0;
#pragma unroll
        for (int j = 7; j >= 0; --j) { const int c = (int)hw[j];
            if (above < KEEP && KEEP <= above + c) { bsel = 8 * rl + j; asel = above; csel = c; } above += c; }
        const unsigned long long bm = __ballot(bsel >= 0);
        const int src = bm ? (int)__builtin_ctzll(bm) : 0;
        const int bs = __builtin_amdgcn_readlane(bsel, src), ab = __builtin_amdgcn_readlane(asel, src), cs = __builtin_amdgcn_readlane(csel, src);
        if (lane == 0) { bst[qq] = bs; need[qq] = KEEP - ab; if (bm == 0ull || cs > CAPB) flag[0] = 1u; }
    }
    __syncthreads();
    if (flag[0] != 0u) { __syncthreads(); return false; }
    const int mybst = bst[q];
    const float thr_lo = mybst == 0 ? -__builtin_inff() : (float)mybst, thr_hi = mybst == NBINS - 1 ? __builtin_inff() : (float)(mybst + 1);
    LAS unsigned* mq = mrow + q * 256; LAS unsigned long long* bl = (LAS unsigned long long*)(lds + L_BL) + q * CAPB;
    DSA1H_FIRST();
    for (int st = 0; st < nsteps; ++st) {
        const int key0 = 256 * st + 32 * wid;
        if (key0 <= t0 + 31) {
            DSA1H_SCORES(st, key0, sc);
            unsigned selw = 0u, bndw = 0u;
#pragma unroll
            for (int i = 0; i < 16; ++i) { const float y = fmaf(sc[i], scale, lo); const unsigned bit = 1u << ((i & 3) + 8 * (i >> 2));
                selw |= (y >= thr_hi) ? bit : 0u; bndw |= (y >= thr_lo) ? bit : 0u; }
            const int dk = tq - key0;
            const unsigned vmask = dk >= 31 ? 0xFFFFFFFFu : (dk < 0 ? 0u : ((2u << dk) - 1u));
            selw = (selw << (4 * hi)) & vmask; bndw = (bndw << (4 * hi)) & vmask & ~selw;
            if (selw) (void)__hip_atomic_fetch_or(mq + (key0 >> 5), selw, __ATOMIC_RELAXED, __HIP_MEMORY_SCOPE_WORKGROUP);
            while (bndw) {
                const int pos = __builtin_ctz(bndw); bndw &= bndw - 1u;
                const int pl = pos - 4 * hi, idx = (pl & 3) + 4 * (pl >> 3);
                const float e0 = (idx & 1) ? sc[1] : sc[0], e1 = (idx & 1) ? sc[3] : sc[2], e2 = (idx & 1) ? sc[5] : sc[4], e3 = (idx & 1) ? sc[7] : sc[6],
                            e4 = (idx & 1) ? sc[9] : sc[8], e5 = (idx & 1) ? sc[11] : sc[10], e6 = (idx & 1) ? sc[13] : sc[12], e7 = (idx & 1) ? sc[15] : sc[14];
                const float f0 = (idx & 2) ? e1 : e0, f1 = (idx & 2) ? e3 : e2, f2 = (idx & 2) ? e5 : e4, f3 = (idx & 2) ? e7 : e6;
                const float g0 = (idx & 4) ? f1 : f0, g1 = (idx & 4) ? f3 : f2;
                const float sv = (idx & 8) ? g1 : g0;
                const unsigned p = __hip_atomic_fetch_add(bcnt + q, 1u, __ATOMIC_RELAXED, __HIP_MEMORY_SCOPE_WORKGROUP);
                if (p < (unsigned)CAPB) bl[p] = ((unsigned long long)ordu(sv) << 32) | (unsigned)(8191 - (key0 + pos));
            }
        }
    }
    __syncthreads();
#pragma unroll 1
    for (int k = 0; k < 4; ++k) {
        const int qq = wid + 8 * k; const int m = (int)bcnt[qq], nd = need[qq];
        const LAS unsigned long long* blq = (const LAS unsigned long long*)(lds + L_BL) + qq * CAPB;
        const unsigned long long mine = lane < m ? blq[lane] : 0ull;
        int rank = 0;
        for (int j = 0; j < m; ++j) { const unsigned long long o = blq[j]; rank += (o > mine) ? 1 : 0; }
        LAS unsigned* mr = mrow + qq * 256;
        if (lane < m && rank < nd) { const unsigned key = 8191u - (unsigned)(mine & 0x1FFFu); (void)__hip_atomic_fetch_or(mr + (key >> 5), 1u << (key & 31u), __ATOMIC_RELAXED, __HIP_MEMORY_SCOPE_WORKGROUP); }
        LDS_WAIT(); asm volatile("" ::: "memory");
        unsigned long long* grow = (unsigned long long*)(P.bitm + (brow + t0 + qq) * 256);
#pragma unroll
        for (int j = 0; j < 2; ++j) { const int w2 = lane + 64 * j; const unsigned long long v = (unsigned long long)mr[2 * w2] | ((unsigned long long)mr[2 * w2 + 1] << 32);
            __hip_atomic_store(grow + w2, v, RLX_AGENT); }
    }
    VM_WAIT();
    __syncthreads();
    if (tid == 0) __hip_atomic_fetch_add(P.done + 64 * (b * 32 + (t0 >> 8)), 1u, RLX_AGENT);
    return true;
#undef DSA1H_FIRST
#undef DSA1H_SCORES
#undef DSA1H_LQ
#undef DSA1H_MM
#undef DSA1H_RW
#undef DSA1H_SB
#undef DSA1H_BIN
}
__device__ __forceinline__ void dsa1_unit(const Dsa1P& P, int u, LAS unsigned char* lds) {
    const int qb32 = 255 - (u >> 1);
    if (qb32 >= 8) { if (dsa1_unit_hist(P, u, lds)) return; }
    dsa1_unit_lists(P, u, lds);
}

struct RPostP { const bf16* ZR; bf16* Q3; const bf16* yraw; const float* rdotk; const float *mu, *gup, *lnw, *lnb; };
__device__ __forceinline__ void rwkv_post(const RPostP& P, LAS unsigned char* lds) {
    const int tid = otid_(), lane = tid & 63, h = __builtin_amdgcn_readfirstlane(tid >> 6), c16 = lane & 15, quad = lane >> 4;
    constexpr int SP = 272;
    LAS float* GT = (LAS float*)(lds + 64 * SP);
    bf16x8 bfr[4][4];
#pragma unroll
    for (int ct = 0; ct < 4; ++ct)
#pragma unroll
        for (int s = 0; s < 4; ++s) { const float* gp = P.gup + (size_t)(32 * s + 8 * quad) * 512 + 64 * h + 16 * ct + c16;
            v4u w; w.x = pk2(gp[0], gp[512]); w.y = pk2(gp[1024], gp[1536]); w.z = pk2(gp[2048], gp[2560]); w.w = pk2(gp[3072], gp[3584]); bfr[ct][s] = __builtin_bit_cast(bf16x8, w); }
    float muv[4], lnw[4], lnb[4];
#pragma unroll
    for (int ct = 0; ct < 4; ++ct) { const int ch = 64 * h + 16 * ct + c16; muv[ct] = P.mu[1024 + ch]; lnw[ct] = P.lnw[ch]; lnb[ct] = P.lnb[ch]; }
    const int stok = tid >> 3, sseg = tid & 7;
    const int vtok = tid >> 5, vseg = tid & 31, ch0 = 16 * vseg, vh = vseg >> 2;
#pragma unroll 1
    for (int m0 = blockIdx.x * 64; m0 < M; m0 += gridDim.x * 64) {
        {   const size_t m = (size_t)m0 + stok; const int t = (int)(m & (T - 1));
            float gv[16], pv[16];
            { const v4u a = *(const GAS v4u*)(P.ZR + m * ZP + ZC_GC + 16 * sseg), c = *(const GAS v4u*)(P.ZR + m * ZP + ZC_GC + 16 * sseg + 8);
              gv[0] = bflo(a.x); gv[1] = bfhi(a.x); gv[2] = bflo(a.y); gv[3] = bfhi(a.y); gv[4] = bflo(a.z); gv[5] = bfhi(a.z); gv[6] = bflo(a.w); gv[7] = bfhi(a.w);
              gv[8] = bflo(c.x); gv[9] = bfhi(c.x); gv[10] = bflo(c.y); gv[11] = bfhi(c.y); gv[12] = bflo(c.z); gv[13] = bfhi(c.z); gv[14] = bflo(c.w); gv[15] = bfhi(c.w); }
            if (t > 0) { const v4u a = *(const GAS v4u*)(P.ZR + (m - 1) * ZP + ZC_GC + 16 * sseg), c = *(const GAS v4u*)(P.ZR + (m - 1) * ZP + ZC_GC + 16 * sseg + 8);
              pv[0] = bflo(a.x); pv[1] = bfhi(a.x); pv[2] = bflo(a.y); pv[3] = bfhi(a.y); pv[4] = bflo(a.z); pv[5] = bfhi(a.z); pv[6] = bflo(a.w); pv[7] = bfhi(a.w);
              pv[8] = bflo(c.x); pv[9] = bfhi(c.x); pv[10] = bflo(c.y); pv[11] = bfhi(c.y); pv[12] = bflo(c.z); pv[13] = bfhi(c.z); pv[14] = bflo(c.w); pv[15] = bfhi(c.w); }
            else {
#pragma unroll
              for (int e = 0; e < 16; ++e) pv[e] = 0.f; }
            float sg[16];
#pragma unroll
            for (int e = 0; e < 16; ++e) { const float mu = P.mu[1664 + 16 * sseg + e]; sg[e] = sigm(gv[e] + (pv[e] - gv[e]) * mu); }
            v4u o0, o1; o0.x = pk2(sg[0], sg[1]); o0.y = pk2(sg[2], sg[3]); o0.z = pk2(sg[4], sg[5]); o0.w = pk2(sg[6], sg[7]); o1.x = pk2(sg[8], sg[9]); o1.y = pk2(sg[10], sg[11]); o1.z = pk2(sg[12], sg[13]); o1.w = pk2(sg[14], sg[15]);
            *(LAS v4u*)(lds + stok * SP + 32 * sseg) = o0; *(LAS v4u*)(lds + stok * SP + 32 * sseg + 16) = o1;
        }
        __syncthreads();
#pragma unroll 1
        for (int rt = 0; rt < 4; ++rt) {
            const size_t m = (size_t)m0 + 16 * rt + vtok; const int t = (int)(m & (T - 1)); const size_t mp = t > 0 ? m - 1 : m;
            const v4u ya = *(const GAS v4u*)(P.yraw + m * 512 + ch0), yc = *(const GAS v4u*)(P.yraw + m * 512 + ch0 + 8);
            const v4u va = *(const GAS v4u*)(P.ZR + m * ZP + ZC_RV + ch0), vc = *(const GAS v4u*)(P.ZR + m * ZP + ZC_RV + ch0 + 8);
            const v4u pa = *(const GAS v4u*)(P.ZR + mp * ZP + ZC_RV + ch0), pc = *(const GAS v4u*)(P.ZR + mp * ZP + ZC_RV + ch0 + 8);
            const float rk = P.rdotk[m * 8 + vh];
            f32x4 acc[4];
#pragma unroll
            for (int ct = 0; ct < 4; ++ct) acc[ct] = (f32x4){0.f, 0.f, 0.f, 0.f};
#pragma unroll
            for (int s = 0; s < 4; ++s) { const bf16x8 af = *(const LAS bf16x8*)(lds + (16 * rt + c16) * SP + (32 * s + 8 * quad) * 2);
#pragma unroll
                for (int ct = 0; ct < 4; ++ct) acc[ct] = __builtin_amdgcn_mfma_f32_16x16x32_bf16(af, bfr[ct][s], acc[ct], 0, 0, 0); }
#pragma unroll
            for (int ct = 0; ct < 4; ++ct)
#pragma unroll
                for (int j = 0; j < 4; ++j) GT[(4 * quad + j) * 512 + 64 * h + 16 * ct + c16] = acc[ct][j];
            __syncthreads();
            {   float y[16], vv[16], vp[16], g[16];
                { const v4u a = ya, c = yc;
                  y[0] = bflo(a.x); y[1] = bfhi(a.x); y[2] = bflo(a.y); y[3] = bfhi(a.y); y[4] = bflo(a.z); y[5] = bfhi(a.z); y[6] = bflo(a.w); y[7] = bfhi(a.w);
                  y[8] = bflo(c.x); y[9] = bfhi(c.x); y[10] = bflo(c.y); y[11] = bfhi(c.y); y[12] = bflo(c.z); y[13] = bfhi(c.z); y[14] = bflo(c.w); y[15] = bfhi(c.w); }
                { const v4u a = va, c = vc;
                  vv[0] = bflo(a.x); vv[1] = bfhi(a.x); vv[2] = bflo(a.y); vv[3] = bfhi(a.y); vv[4] = bflo(a.z); vv[5] = bfhi(a.z); vv[6] = bflo(a.w); vv[7] = bfhi(a.w);
                  vv[8] = bflo(c.x); vv[9] = bfhi(c.x); vv[10] = bflo(c.y); vv[11] = bfhi(c.y); vv[12] = bflo(c.z); vv[13] = bfhi(c.z); vv[14] = bflo(c.w); vv[15] = bfhi(c.w); }
                if (t > 0) { const v4u a = pa, c = pc;
                  vp[0] = bflo(a.x); vp[1] = bfhi(a.x); vp[2] = bflo(a.y); vp[3] = bfhi(a.y); vp[4] = bflo(a.z); vp[5] = bfhi(a.z); vp[6] = bflo(a.w); vp[7] = bfhi(a.w);
                  vp[8] = bflo(c.x); vp[9] = bfhi(c.x); vp[10] = bflo(c.y); vp[11] = bfhi(c.y); vp[12] = bflo(c.z); vp[13] = bfhi(c.z); vp[14] = bflo(c.w); vp[15] = bfhi(c.w); }
                else {
#pragma unroll
                  for (int e = 0; e < 16; ++e) vp[e] = 0.f; }
#pragma unroll
                for (int e4 = 0; e4 < 4; ++e4) { const f32x4 gq = *(const LAS f32x4*)(GT + vtok * 512 + ch0 + 4 * e4); g[4 * e4] = gq.x; g[4 * e4 + 1] = gq.y; g[4 * e4 + 2] = gq.z; g[4 * e4 + 3] = gq.w; }
                float sm = 0.f;
#pragma unroll
                for (int e = 0; e < 16; ++e) sm += y[e];
                sm = scan::dpp_add<0xB1>(sm); sm = scan::dpp_add<0x4E>(sm);
                const float mean = sm * (1.f / 64.f); float vs = 0.f;
#pragma unroll
                for (int e = 0; e < 16; ++e) { y[e] -= mean; vs += y[e] * y[e]; }
                vs = scan::dpp_add<0xB1>(vs); vs = scan::dpp_add<0x4E>(vs);
                const float rstd = __builtin_amdgcn_rsqf(vs * (1.f / 64.f) + 64e-5f);
                unsigned ow[8];
#pragma unroll
                for (int e = 0; e < 16; e += 2) { float o2[2];
#pragma unroll
                    for (int d = 0; d < 2; ++d) { const int ch = ch0 + e + d; const float v = vv[e + d] + (vp[e + d] - vv[e + d]) * P.mu[1024 + ch];
                        o2[d] = (y[e + d] * rstd * P.lnw[ch] + P.lnb[ch] + rk * v) * g[e + d]; }
                    ow[e >> 1] = pk2(o2[0], o2[1]); }
                *(GAS v4u*)(P.Q3 + m * QP + 512 + ch0) = (v4u){ow[0], ow[1], ow[2], ow[3]}; *(GAS v4u*)(P.Q3 + m * QP + 512 + ch0 + 8) = (v4u){ow[4], ow[5], ow[6], ow[7]};
            }
            __syncthreads();
        }
        __syncthreads();
    }
}
struct DPostP { const bf16* O1; const bf16* O2; bf16* Q3; const float *lq1, *lk1, *lq2, *lk2, *subln; float lambda_init; };
__device__ __forceinline__ void diff_post(const DPostP& P, int gw, int NGW, int lane) {
    const float lam = __expf(wave_sum(P.lq1[lane] * P.lk1[lane])) - __expf(wave_sum(P.lq2[lane] * P.lk2[lane])) + P.lambda_init;
    float sw[8];
#pragma unroll
    for (int e = 0; e < 8; ++e) sw[e] = P.subln[8 * (lane & 15) + e] * (1.f - P.lambda_init);
    constexpr int R = 8;
    for (int m0 = gw; m0 < M; m0 += R * NGW) {
        v4u a[R], c[R];
#pragma unroll
        for (int q = 0; q < R; ++q) { const size_t m = (size_t)(m0 + q * NGW); a[q] = *(const GAS v4u*)(P.O1 + m * 512 + 8 * lane); c[q] = *(const GAS v4u*)(P.O2 + m * 512 + 8 * lane); }
#pragma unroll
        for (int q = 0; q < R; ++q) { const size_t m = (size_t)(m0 + q * NGW);
            float x[8];
            x[0] = bflo(a[q].x) - lam * bflo(c[q].x); x[1] = bfhi(a[q].x) - lam * bfhi(c[q].x); x[2] = bflo(a[q].y) - lam * bflo(c[q].y); x[3] = bfhi(a[q].y) - lam * bfhi(c[q].y);
            x[4] = bflo(a[q].z) - lam * bflo(c[q].z); x[5] = bfhi(a[q].z) - lam * bfhi(c[q].z); x[6] = bflo(a[q].w) - lam * bflo(c[q].w); x[7] = bfhi(a[q].w) - lam * bfhi(c[q].w);
            float ss = 0.f;
#pragma unroll
            for (int e = 0; e < 8; ++e) ss += x[e] * x[e];
            const float r = __builtin_amdgcn_rsqf(scan::red16(ss) * (1.f / 128.f) + NORM_EPS);
            v4u o; o.x = pk2(x[0] * r * sw[0], x[1] * r * sw[1]); o.y = pk2(x[2] * r * sw[2], x[3] * r * sw[3]); o.z = pk2(x[4] * r * sw[4], x[5] * r * sw[5]); o.w = pk2(x[6] * r * sw[6], x[7] * r * sw[7]);
            *(GAS v4u*)(P.Q3 + m * QP + 1024 + 8 * lane) = o;
        }
    }
}

__device__ __forceinline__ int q_fetch(gu32* head, volatile LAS int* slot) {
    if (threadIdx.x == 0) *slot = (int)__hip_atomic_fetch_add(head, 1u, RLX_AGENT);
    __syncthreads();
    const int v = __builtin_amdgcn_readfirstlane(*slot);
    __syncthreads();
    return v;
}

struct Args { const float* in[32]; float* out; unsigned char* ws; int ph_lo, ph_hi; };
__device__ __forceinline__ const float* kin_(int i) { const char* ka = (const char*)__builtin_amdgcn_kernarg_segment_ptr(); unsigned off = (unsigned)i * 8u; asm volatile("" : "+s"(off)); return *(const float* const*)(ka + off); }
#define KIN(i) kin_(i)
#define XOUT ((float*)kin_(32))
#define XB ((bf16*)kin_(32))
#define XB2 ((bf16*)(wsl + WS_Q3))
#define OUTHI ((unsigned char*)kin_(32) + 32 * MiB)
__device__ __forceinline__ unsigned char* kws_() { return (unsigned char*)kin_(33); }
__device__ __forceinline__ int kint_(int byteoff) { const char* ka = (const char*)__builtin_amdgcn_kernarg_segment_ptr(); unsigned off = (unsigned)byteoff; asm volatile("" : "+s"(off)); return *(const int*)(ka + off); }
constexpr int PH_L = 14;
constexpr int N_PHASES = 1 + NLAYER * PH_L;

#define G ((int)gridDim.x)
#define bid ((int)blockIdx.x)
#define gw (bid * NWAVES + wave)
#define NGW (G * NWAVES)
#define MISC ((volatile LAS unsigned*)(lds + LDS_MISC))
#define IN(k) (kint_(272) <= (k) && (k) < kint_(276))
#define SEAM(k) do { if ((k) + 1 < kint_(276)) { XcdBarrier bar_; bar_.bar = (unsigned*)(kws_() + WS_CTL) + CW_BAR; bar_.x = xb_xcc_id(); bar_.st = MISC + 8; xcd_barrier(bar_); } } while (0)
#if TSPROBE
#define WSL() unsigned char* wsl = kws_(); const int tid = otid_(), lane = tid & 63, wave = __builtin_amdgcn_readfirstlane(tid >> 6); (void)lane; (void)wave; \
    if (blockIdx.x == 0 && tid == 0) { gu32* tc_ = (gu32*)(wsl + WS_CTL) + 3072; const unsigned n_ = __hip_atomic_fetch_add(tc_, 1u, RLX_AGENT); *(GAS unsigned long long*)(tc_ + 2 + 2 * n_) = __builtin_amdgcn_s_memrealtime(); }
#else
#define WSL() unsigned char* wsl = kws_(); const int tid = otid_(), lane = tid & 63, wave = __builtin_amdgcn_readfirstlane(tid >> 6); (void)lane; (void)wave
#endif
#define WFu ((bf16*)(wsl + WS_WF))
#define WFd ((bf16*)(wsl + WS_WF_DOWN))
#define WMi ((bf16*)(wsl + WS_WM))
#define WMb ((bf16*)(wsl + WS_WM_BR))
#define WMo ((bf16*)(wsl + WS_WM_OUT))
#define XN ((bf16*)(wsl + WS_XN))
#define Q3 ((bf16*)(wsl + WS_Q3))
#define ZR ((bf16*)(wsl + WS_ZR))
#define YP ((bf16*)(wsl + WS_R2))
#define HB ZR
#define G3 ZR
#define MG ((bf16*)(wsl + WS_MG))
#define O1 ((bf16*)(wsl + WS_R2))
#define O2 ((bf16*)(wsl + WS_R2) + (size_t)M * 512)
#define YRAW ((bf16*)(wsl + WS_YRAW))
#define BITM ((unsigned*)OUTHI)
#define RDOTK ((float*)(wsl + WS_RDOTK))
#define X1B ((bf16*)(OUTHI + 16 * MiB))
#define KID ((bf16*)(wsl + WS_KID))
#define A8B ((unsigned char*)(wsl + WS_A8))
#define CTL ((gu32*)(wsl + WS_CTL))
#define cscr ((LAS float*)(lds + wave * 16384))

#define CONV_FFN(l_, f_) do { const int gi_ = (f_) ? 29 : 3; \
        const MapUp mu_{KIN(gi_) + (size_t)(l_) * DM * FF, KIN(gi_ + 1) + (size_t)(l_) * DM * FF, FF}; const MapIdent md_{KIN(gi_ + 2) + (size_t)(l_) * FF * DM, DM}; \
        constexpr int nu_ = conv_items(DM, 2 * FF), nd_ = conv_items(FF, DM); \
        bf16* const wu_ = WFu; bf16* const wd_ = WFd; \
        conv_batch([&](int it_) { return it_ < nu_ ? conv_desc(mu_, DM, wu_, it_, 2 * FF / 32, lane) : conv_desc(md_, FF, wd_, it_ - nu_, DM / 32, lane); }, nu_ + nd_, cscr, gw, NGW, lane); } while (0)
#define CONV_MIX(l_) do { const MapWin mw_{KIN(8) + (size_t)(l_) * DM * NIN, NIN}; const MapIdent mo_{KIN(26) + (size_t)(l_) * DM * DM, DM}; const float* const wb_ = KIN(25) + (size_t)(l_) * 3 * 512 * DM; \
        constexpr int ni_ = conv_items(DM, 8704), nb_ = conv_items(512, DM), no_ = conv_items(DM, DM); \
        bf16* const wi_ = WMi; bf16* const wbr_ = WMb; bf16* const wo_ = WMo; \
        conv_batch([&](int it_) { \
            if (it_ < ni_) return conv_desc(mw_, DM, wi_, it_, 8704 / 32, lane); \
            if (it_ < ni_ + 3 * nb_) { const int r_ = it_ - ni_, n_ = r_ / nb_; const MapIdent mb_{wb_ + (size_t)n_ * 512 * DM, DM}; return conv_desc(mb_, 512, wbr_ + (size_t)n_ * DM * 512, r_ - n_ * nb_, DM / 32, lane); } \
            return conv_desc(mo_, DM, wo_, it_ - ni_ - 3 * nb_, DM / 32, lane); }, ni_ + 3 * nb_ + no_, cscr, gw, NGW, lane); } while (0)
#define CONV_MIX_Q(l_) do { const MapWin mw_{KIN(8) + (size_t)(l_) * DM * NIN, NIN}; const MapIdent mo_{KIN(26) + (size_t)(l_) * DM * DM, DM}; const float* const wb_ = KIN(25) + (size_t)(l_) * 3 * 512 * DM; \
        constexpr int ni_ = conv_items(DM, 8704), nb_ = conv_items(512, DM), no_ = conv_items(DM, DM); \
        bf16* const wi_ = WMi; bf16* const wbr_ = WMb; bf16* const wo_ = WMo; \
        conv_queue([&](int it_) { \
            if (it_ < ni_) return conv_desc(mw_, DM, wi_, it_, 8704 / 32, lane); \
            if (it_ < ni_ + 3 * nb_) { const int r_ = it_ - ni_, n_ = r_ / nb_; const MapIdent mb_{wb_ + (size_t)n_ * 512 * DM, DM}; return conv_desc(mb_, 512, wbr_ + (size_t)n_ * DM * 512, r_ - n_ * nb_, DM / 32, lane); } \
            return conv_desc(mo_, DM, wo_, it_ - ni_ - 3 * nb_, DM / 32, lane); }, ni_ + 3 * nb_ + no_, cscr, CTL + CW_CQ + 64 * (l_), lane); } while (0)

template <int L, int F> __device__ __forceinline__ void ffn_part(LAS unsigned char* lds) {
    constexpr int l = L, f = F, pb = 1 + PH_L * L, pf = pb + (F ? 11 : 0);
            if (IN(pf + 0)) { WSL();
                pg8::Gemm g{XN, WFu, M, 2 * FF, DM, DM}; pg8::StaticOrder S; S.init(M, 2 * FF, G, bid);
                pg8::EpiSwiGLU E{HB, FF};
                pg8::gemm_phase<pg8::EpiSwiGLU, pg8::StaticOrder, true, true>(lds, g, S, E);
                if constexpr (f == 0) { CONV_MIX_Q(l); }
                SEAM(pf + 0);
            }
            if (IN(pf + 1)) { WSL();
                pg8::Gemm g{HB, WFd, M, DM, FF, FF}; pg8::StaticOrder S; S.init(M, DM, G, bid);
                pg8::EpiStore<0> E{YP, DM, YP, DM, 1 << 30};
                pg8::gemm_phase<pg8::EpiStore<0>, pg8::StaticOrder, true, true>(lds, g, S, E);
                SEAM(pf + 1);
            }
            if (IN(pf + 2)) { WSL();
                const float* gpost = KIN(f ? 28 : 2) + l * DM;
                const float* gnext = f == 0 ? KIN(6) + l * DM : (l + 1 < NLAYER ? KIN(1) + (l + 1) * DM : nullptr);
#if PROBE
                float osc = 1.f;
                if (l == NLAYER - 1 && f == 1) { const float num = *(const float*)(wsl + WS_CTL + 4 * CW_PROBE), den = *(const float*)(wsl + WS_CTL + 4 * (CW_PROBE + 1)); osc = 1.f + 4.f * sqrtf(num / fmaxf(den, 1e-30f)); }
#elif TSPROBE
                float osc = 1.f;
                if (l == NLAYER - 1 && f == 1) { const GAS unsigned long long* ts_ = (const GAS unsigned long long*)((gu32*)(wsl + WS_CTL) + 3072 + 2); const unsigned long long tot = ts_[N_PHASES - 2] - ts_[0]; unsigned long long sel = 0;
                    for (int p_ = 0; p_ < N_PHASES - 2; ++p_) if ((TSPROBE_MASK >> p_) & 1ull) sel += ts_[p_ + 1] - ts_[p_];
                    float fr_ = (float)sel / (float)tot;
#if TSPROBE == 2
                    fr_ = (float)(ts_[100 + TSPROBE_L] - ts_[6 + 14 * TSPROBE_L]) / (float)(ts_[7 + 14 * TSPROBE_L] - ts_[6 + 14 * TSPROBE_L]);
#endif
                    osc = 1.f + floorf(fr_ * TSQ + 0.5f) * (1.f / TSQ); }
#else
                const float osc = 1.f;
#endif
                if constexpr (l == 0 && f == 0) rownorm_rows<false, true>(KIN(0), YP, 0.5f, gpost, XB, gnext, XN, gw, NGW, lane);
                else if constexpr (l == NLAYER - 1 && f == 1) rownorm_rows<true, false>(XB2, YP, 0.5f, gpost, XOUT, nullptr, nullptr, gw, NGW, lane, osc);
                else rownorm_rows<true, true>(XB, YP, 0.5f, gpost, XB, gnext, XN, gw, NGW, lane);
                if (f == 1 && l + 1 < NLAYER) { CONV_FFN(l + 1, 0); }
                SEAM(pf + 2);
            }
}
template <int L> __device__ __forceinline__ void mixer_part(LAS unsigned char* lds, unsigned char* lds_) {
    constexpr int l = L, pb = 1 + PH_L * L;
            const int pm = pb + 3;
            if (IN(pm + 0)) { WSL();
                pg8::Gemm g{XN, WMi, M, 5632, DM, DM}; pg8::StaticOrder S; S.init(M, 5632, G, bid);
                pg8::EpiStore<0> E{Q3, QP, ZR, ZP, 6};
                pg8::gemm_phase<pg8::EpiStore<0>, pg8::StaticOrder, true, true>(lds, g, S, E);
                SEAM(pm + 0);
            }
            if (IN(pm + 1)) { WSL();
                PrepP pp{ZR, X1B, A8B, KID, KIN(9) + l * 1792, KIN(10) + l * 512, KIN(11) + l * 64 * 512, KIN(12) + l * 512, KIN(13) + l * 64 * 512};
                rwkv_prep(pp, lds);
                SEAM(pm + 1);
            }
            if (IN(pm + 2)) { WSL();
                volatile LAS int* slot = (volatile LAS int*)(MISC + 16);
                if (bid < 64) {
                    ScanP sp{Q3, ZR, X1B, A8B, YRAW, RDOTK, KIN(9) + l * 1792, KIN(15) + l * 512, KIN(16) + l * 512, KIN(17) + l * 512};
#ifndef NO_SCAN
                    rwkv_scan_unit(sp, bid, lds);
#if TSPROBE == 2
                    if (bid == 5 && otid_() == 0) *(GAS unsigned long long*)((gu32*)(wsl + WS_CTL) + 3072 + 2 + 2 * (100 + l)) = __builtin_amdgcn_s_memrealtime();
#endif
#ifdef SCAN_TWICE
                    rwkv_scan_unit(sp, bid, lds);
#endif
#endif
                }
                {
                    Dsa1P dp{ZR, KID, BITM, CTL + CW_DONE + 64 * 64 * l};
                    gu32* head = CTL + CW_Q + 64 * (3 * l + 0);
                    #ifndef NO_DSA1
                    for (int u = q_fetch(head, slot); u < 512; u = q_fetch(head, slot)) dsa1_unit(dp, u, lds);
#ifdef DUP_DSA1
                    { gu32* head2 = CTL + 10240 + 64 * (2 * l + 0); for (int u = q_fetch(head2, slot); u < 512; u = q_fetch(head2, slot)) dsa1_unit(dp, u, lds); }
#endif
#endif
                }
                {
                    gu32* head = CTL + CW_Q + 64 * (3 * l + 1);
                    typedef att::BlockRef<att::bf16, att::bf16> Ref;
#define DSA2_REF(i_, r_) do { const int qb_ = 31 - ((i_) >> 3), b_ = ((i_) >> 2) & 1, h_ = (i_) & 3; const size_t row_ = (size_t)b_ * T + 256 * qb_; \
        r_.Q = (const att::bf16*)(Q3 + row_ * QP + 128 * h_); r_.O = (att::bf16*)(Q3 + row_ * QP + 128 * h_); r_.K = (const att::bf16*)(ZR + (size_t)b_ * T * ZP + ZC_DK + 128 * h_); \
        r_.V = (const att::bf16*)(ZR + (size_t)b_ * T * ZP + ZC_DV + 128 * h_); r_.P0 = 256 * qb_; r_.koff = 0; r_.mask = BITM + row_ * 256; } while (0)
                    int ic = q_fetch(head, slot);
                    if (ic < 256) {
                        int in_ = q_fetch(head, slot);
                        Ref cur; DSA2_REF(ic, cur);
                        att::Seam<att::bf16> S;
                        att::causal_swa_prime<att::bf16, att::bf16, false>(cur, T, (char*)lds_, S);
                        for (;;) {
                            const bool last = in_ >= 256;
                            Ref nxt = cur; if (!last) DSA2_REF(in_, nxt);
                            {
                                if (tid == 0) { gu32* dw = CTL + CW_DONE + 64 * (64 * l + (((ic >> 2) & 1) * 32 + (31 - (ic >> 3)))); unsigned sp = 0;
                                    while (__hip_atomic_load(dw, RLX_AGENT) < 8u) { __builtin_amdgcn_s_sleep(2); if (++sp > (1u << 24)) { __hip_atomic_store(CTL + CW_TMO, 1u, RLX_AGENT); break; } }
                                    __builtin_amdgcn_fence(__ATOMIC_ACQUIRE, "agent"); asm volatile("s_waitcnt vmcnt(0)" ::: "memory"); }
                                __syncthreads();
                            }
#ifndef NO_DSA2
                            att::causal_swa_block<att::bf16, att::bf16, false, true, QP>(cur, nxt, T, T, (char*)lds_, S);
#endif
                            if (last) break;
                            cur = nxt; ic = in_; in_ = q_fetch(head, slot);
                        }
                    }
                }
                {
#ifdef DUP_DIFF
                  for (int rep_ = 0; rep_ < 2; ++rep_) {
                    gu32* head = rep_ ? CTL + 10240 + 64 * (2 * l + 1) : CTL + CW_Q + 64 * (3 * l + 2);
#else
                  {
                    gu32* head = CTL + CW_Q + 64 * (3 * l + 2);
#endif
                    typedef att::BlockRef<att::bf16, att::bf16> Ref;
#define DIFF_REF(i_, r_) do { const int qb_ = 31 - ((i_) >> 4), b_ = ((i_) >> 3) & 1, h_ = ((i_) >> 1) & 3, mp_ = (i_) & 1; const size_t row_ = (size_t)b_ * T + 256 * qb_; \
        r_.Q = (const att::bf16*)(Q3 + row_ * QP + 1024 + 128 * h_ + 64 * mp_); r_.O = (att::bf16*)((mp_ ? O2 : O1) + row_ * 512 + 128 * h_); \
        r_.K = (const att::bf16*)(ZR + (size_t)b_ * T * ZP + ZC_FK + 128 * h_); r_.V = (const att::bf16*)(ZR + (size_t)b_ * T * ZP + ZC_FV + 128 * h_); r_.P0 = 256 * qb_; r_.koff = 128 * mp_; r_.mask = nullptr; } while (0)
                    int ic = q_fetch(head, slot);
                    if (ic < 512) {
                        int in_ = q_fetch(head, slot);
                        Ref cur; DIFF_REF(ic, cur);
                        att::Seam<att::bf16> S;
                        att::causal_swa_prime<att::bf16, att::bf16, true>(cur, T, (char*)lds_, S);
                        for (;;) {
                            const bool last = in_ >= 512;
                            Ref nxt = cur; if (!last) DIFF_REF(in_, nxt);
#ifndef NO_DIFF
                            att::causal_swa_block<att::bf16, att::bf16, true, false, 512>(cur, nxt, T, T, (char*)lds_, S);
#endif
                            if (last) break;
                            cur = nxt; ic = in_; in_ = q_fetch(head, slot);
                        }
                    }
                  }
                }
                SEAM(pm + 2);
            }
            if (IN(pm + 3)) { WSL();
                RPostP rp{ZR, Q3, YRAW, RDOTK, KIN(9) + l * 1792, KIN(14) + l * 128 * 512, KIN(18) + l * 512, KIN(19) + l * 512};
#ifndef NO_RPOST
                rwkv_post(rp, lds);
#endif
                constexpr float lambda_init = L == 0 ? 0.2f : 0.35550906759096927f;
                DPostP dq{O1, O2, Q3, KIN(20) + l * 64, KIN(21) + l * 64, KIN(22) + l * 64, KIN(23) + l * 64, KIN(24) + l * 128, lambda_init};
                diff_post(dq, gw, NGW, lane);
                SEAM(pm + 3);
            }
            if (IN(pm + 4)) { WSL();
                pg8::Gemm g{XN, WMi + (size_t)5632 * DM, M, 3072, DM, DM}; pg8::StaticOrder S; S.init(M, 3072, G, bid);
#ifdef GATE_RAW
                pg8::EpiStore<0> E{G3, 3072, G3, 3072, 1 << 30};
                pg8::gemm_phase<pg8::EpiStore<0>, pg8::StaticOrder, true, true>(lds, g, S, E);
#else
                pg8::EpiStore<1> E{G3, 3072, G3, 3072, 1 << 30};
                pg8::gemm_phase<pg8::EpiStore<1>, pg8::StaticOrder, true, true>(lds, g, S, E);
#endif
                SEAM(pm + 4);
            }
            if (IN(pm + 5)) { WSL();
#pragma unroll 1
                for (int n = 0; n < 3; ++n) {
                    pg8::Gemm g{Q3 + 512 * n, WMb + (size_t)n * DM * 512, M, DM, 512, QP}; pg8::StaticOrder S; S.init(M, DM, G, bid);
                    pg8::EpiGateMul E{MG, DM, G3 + 1024 * n, 3072, n == 0 ? 1 : 0};
                    pg8::gemm_phase<pg8::EpiGateMul, pg8::StaticOrder, true, true>(lds, g, S, E);
                    VM_WAIT(); __syncthreads();
                }
                SEAM(pm + 5);
            }
            if (IN(pm + 6)) { WSL();
                pg8::Gemm g{MG, WMo, M, DM, DM, DM}; pg8::StaticOrder S; S.init(M, DM, G, bid);
                pg8::EpiStore<0> E{YP, DM, YP, DM, 1 << 30};
                pg8::gemm_phase<pg8::EpiStore<0>, pg8::StaticOrder, true, true>(lds, g, S, E);
                SEAM(pm + 6);
            }
            if (IN(pm + 7)) { WSL();
                rownorm_rows<true, true>(XB, YP, 1.0f, KIN(7) + l * DM, l == NLAYER - 1 ? XB2 : XB, KIN(27) + l * DM, XN, gw, NGW, lane);
                CONV_FFN(l, 1);
                SEAM(pm + 7);
            }
}

__global__ void __launch_bounds__(NWAVES * 64, 2) mk_fwd(Args args) {
    extern __shared__ __attribute__((aligned(16))) unsigned char lds_[];
    LAS unsigned char* lds = (LAS unsigned char*)lds_;
    { const int tid = otid_(); if (tid < 64) MISC[tid] = 0u; }
    __syncthreads();
    (void)xcd_barrier_post((unsigned*)(kws_() + WS_CTL) + CW_BAR, MISC + 8);
    if (IN(0)) { WSL();
        CONV_FFN(0, 0);
        rownorm_rows<false, false>(KIN(0), nullptr, 0.f, nullptr, nullptr, KIN(1), XN, gw, NGW, lane);
        SEAM(0);
    }
    ffn_part<0, 0>(lds); mixer_part<0>(lds, lds_); ffn_part<0, 1>(lds);
    ffn_part<1, 0>(lds); mixer_part<1>(lds, lds_); ffn_part<1, 1>(lds);
}

#if PROBE
__device__ __forceinline__ void probe_acc(float num, float den, float* ctlf) {
    __shared__ float rn[256], rd[256];
    rn[threadIdx.x] = num; rd[threadIdx.x] = den; __syncthreads();
    for (int o = 128; o > 0; o >>= 1) { if ((int)threadIdx.x < o) { rn[threadIdx.x] += rn[threadIdx.x + o]; rd[threadIdx.x] += rd[threadIdx.x + o]; } __syncthreads(); }
    if (threadIdx.x == 0) { atomicAdd(ctlf + CW_PROBE, rn[0]); atomicAdd(ctlf + CW_PROBE + 1, rd[0]); }
}
__global__ void __launch_bounds__(256) probe_ffn(const unsigned char* ws, const float* Wg, const float* Wu, const float* Wd) {
    __shared__ float xn[1024]; __shared__ float hid[2816];
    const int m = 777 + 1931 * blockIdx.x, tid = threadIdx.x;
    const bf16* XNp = (const bf16*)(ws + WS_XN); const bf16* YPp = (const bf16*)(ws + WS_R2);
    for (int k = tid; k < 1024; k += 256) xn[k] = bf1(XNp[(size_t)m * 1024 + k]);
    __syncthreads();
    for (int j = tid; j < 2816; j += 256) { float g = 0.f, u = 0.f; for (int k = 0; k < 1024; ++k) { g += xn[k] * Wg[(size_t)k * 2816 + j]; u += xn[k] * Wu[(size_t)k * 2816 + j]; } hid[j] = g / (1.f + expf(-g)) * u; }
    __syncthreads();
    float num = 0.f, den = 0.f;
    for (int d = tid; d < 1024; d += 256) { float o = 0.f; for (int j = 0; j < 2816; ++j) o += hid[j] * Wd[(size_t)j * 1024 + d]; const float got = bf1(YPp[(size_t)m * 1024 + d]); num += (o - got) * (o - got); den += o * o; }
    probe_acc(num, den, (float*)(ws + WS_CTL));
}
__global__ void __launch_bounds__(256) probe_win(const unsigned char* ws, const float* Win) {
    __shared__ float xn[1024];
    const int m = 555 + 1999 * blockIdx.x, tid = threadIdx.x;
    const bf16* XNp = (const bf16*)(ws + WS_XN); const bf16* Q3p = (const bf16*)(ws + WS_Q3); const bf16* ZRp = (const bf16*)(ws + WS_ZR);
    for (int k = tid; k < 1024; k += 256) xn[k] = bf1(XNp[(size_t)m * 1024 + k]);
    __syncthreads();
    float num = 0.f, den = 0.f;
    for (int c = tid; c < 5448; c += 256) {
        float z = 0.f; for (int k = 0; k < 1024; ++k) z += xn[k] * Win[(size_t)k * NIN + c];
        float got;
        if (c < 512) got = bf1(Q3p[(size_t)m * QP + c]);
        else if (c < 2120) got = bf1(ZRp[(size_t)m * ZP + (c - 512)]);
        else if (c < 2632) got = bf1(Q3p[(size_t)m * QP + 512 + (c - 2120)]);
        else if (c < 3912) got = bf1(ZRp[(size_t)m * ZP + (c - 840)]);
        else if (c < 4424) got = bf1(Q3p[(size_t)m * QP + 1024 + (c - 3912)]);
        else got = bf1(ZRp[(size_t)m * ZP + (c - 1352)]);
        num += (z - got) * (z - got); den += z * z;
    }
    probe_acc(num, den, (float*)(ws + WS_CTL));
}
__global__ void __launch_bounds__(256) probe_wconv(const unsigned char* ws, const float* Win, int r0) {
    const bf16* WMp = (const bf16*)(ws + WS_WM); const int tid = threadIdx.x;
    float num = 0.f, den = 0.f;
    for (int rr = 0; rr < 64; ++rr) { const int n = r0 + 64 * blockIdx.x + rr; MapWin mw{Win, NIN}; const float* cp = mw.col(n);
        for (int k = tid; k < 1024; k += 256) { const float ref = cp ? cp[(size_t)k * NIN] : 0.f; const float got = bf1(WMp[(size_t)n * 1024 + k]); num += (ref - got) * (ref - got); den += ref * ref; } }
    probe_acc(num, den, (float*)(ws + WS_CTL));
}
__global__ void __launch_bounds__(256) probe_merge(const unsigned char* ws, const float* Win, const float* Wb, const float* Wo, int which) {
    __shared__ float xn[1024]; __shared__ float y[1536]; __shared__ float mg[1024];
    const int m = 333 + 2003 * blockIdx.x, tid = threadIdx.x;
    const bf16* XNp = (const bf16*)(ws + WS_XN); const bf16* Q3p = (const bf16*)(ws + WS_Q3); const bf16* MGp = (const bf16*)(ws + WS_MG); const bf16* YPp = (const bf16*)(ws + WS_R2);
    for (int k = tid; k < 1024; k += 256) xn[k] = bf1(XNp[(size_t)m * 1024 + k]);
    for (int k = tid; k < 1536; k += 256) y[k] = bf1(Q3p[(size_t)m * QP + k]);
    __syncthreads();
    float num = 0.f, den = 0.f;
    for (int d = tid; d < 1024; d += 256) {
        float acc = 0.f;
        for (int n = 0; n < 3; ++n) { float g = 0.f; for (int k = 0; k < 1024; ++k) g += xn[k] * Win[(size_t)k * NIN + 5448 + n * 1024 + d];
            float p = 0.f; for (int c = 0; c < 512; ++c) p += y[512 * n + c] * Wb[((size_t)n * 512 + c) * 1024 + d];
            acc += p / (1.f + expf(-g)); }
        mg[d] = acc; const float got = bf1(MGp[(size_t)m * 1024 + d]); if (which == 0) { num += (acc - got) * (acc - got); den += acc * acc; }
        if (which == 2) { const bf16* G3p = (const bf16*)(ws + WS_ZR); for (int n = 0; n < 3; ++n) { float g = 0.f; for (int k = 0; k < 1024; ++k) g += xn[k] * Win[(size_t)k * NIN + 5448 + n * 1024 + d];
            const float sg = 1.f / (1.f + expf(-g)), gg = bf1(G3p[(size_t)m * 3072 + n * 1024 + d]); num += (sg - gg) * (sg - gg); den += sg * sg; } }
        if (which == 3) { const bf16* G3p = (const bf16*)(ws + WS_ZR); float a2 = 0.f; for (int n = 0; n < 3; ++n) { float p = 0.f; for (int c = 0; c < 512; ++c) p += y[512 * n + c] * Wb[((size_t)n * 512 + c) * 1024 + d];
            a2 += p * bf1(G3p[(size_t)m * 3072 + n * 1024 + d]); } num += (a2 - got) * (a2 - got); den += a2 * a2; }
    }
    __syncthreads();
    if (which == 1) for (int d = tid; d < 1024; d += 256) { float o = 0.f; for (int j = 0; j < 1024; ++j) o += mg[j] * Wo[(size_t)j * 1024 + d]; const float got = bf1(YPp[(size_t)m * 1024 + d]); num += (o - got) * (o - got); den += o * o; }
    probe_acc(num, den, (float*)(ws + WS_CTL));
}
#endif
#ifndef MK_ONE_LAUNCH
#define MK_ONE_LAUNCH 0
#endif
extern "C" void kernel_launch(void* const* d_in, const int* in_sizes, int n_in, void* d_out, int out_size, void* d_ws, size_t ws_size, hipStream_t stream) {
    static int grid = 0;
    if (grid == 0) {
        if (n_in != 32 || in_sizes[0] != M * DM || out_size != M * DM || ws_size < WS_END) { fprintf(stderr, "kernel_launch: unexpected shapes / workspace (n_in %d, ws %zu)\n", n_in, ws_size); grid = -1; return; }
        int dev = 0, cus = 0;
        if (hipGetDevice(&dev) != hipSuccess || hipDeviceGetAttribute(&cus, hipDeviceAttributeMultiprocessorCount, dev) != hipSuccess) { grid = -1; return; }
        if (hipFuncSetAttribute((const void*)mk_fwd, hipFuncAttributeMaxDynamicSharedMemorySize, LDS_BYTES) != hipSuccess) { fprintf(stderr, "kernel_launch: hipFuncSetAttribute failed\n"); grid = -1; return; }
        int per_cu = 0;
        if (hipOccupancyMaxActiveBlocksPerMultiprocessor(&per_cu, (const void*)mk_fwd, NWAVES * 64, LDS_BYTES) != hipSuccess || per_cu < 1) { fprintf(stderr, "kernel_launch: occupancy query says %d\n", per_cu); }
        (void)hipGetLastError();
        grid = cus;
    }
    if (grid < 0) return;
    (void)hipMemsetAsync((char*)d_ws + WS_CTL, 0, CTL_ZERO_BYTES, stream);
    Args a{};
    for (int i = 0; i < 32; ++i) a.in[i] = (const float*)d_in[i];
    a.out = (float*)d_out; a.ws = (unsigned char*)d_ws;
#if MK_ONE_LAUNCH
    a.ph_lo = 0; a.ph_hi = N_PHASES;
    hipLaunchKernelGGL(mk_fwd, dim3(grid), dim3(NWAVES * 64), LDS_BYTES, stream, a);
#else
    for (int p = 0; p < N_PHASES; ++p) { a.ph_lo = p; a.ph_hi = p + 1; hipLaunchKernelGGL(mk_fwd, dim3(grid), dim3(NWAVES * 64), LDS_BYTES, stream, a);
#if PROBE == 1
        if (p == 2) hipLaunchKernelGGL(probe_ffn, dim3(8), dim3(256), 0, stream, (const unsigned char*)d_ws, a.in[3], a.in[4], a.in[5]);
#elif PROBE == 2
        if (p == 4) hipLaunchKernelGGL(probe_win, dim3(8), dim3(256), 0, stream, (const unsigned char*)d_ws, a.in[8]);
#elif PROBE == 3
        if (p == 8) hipLaunchKernelGGL(probe_merge, dim3(8), dim3(256), 0, stream, (const unsigned char*)d_ws, a.in[8], a.in[25], a.in[26], 0);
#elif PROBE == 5
        if (p == 8) hipLaunchKernelGGL(probe_merge, dim3(8), dim3(256), 0, stream, (const unsigned char*)d_ws, a.in[8], a.in[25], a.in[26], 2);
#elif PROBE == 6
        if (p == 8) hipLaunchKernelGGL(probe_merge, dim3(8), dim3(256), 0, stream, (const unsigned char*)d_ws, a.in[8], a.in[25], a.in[26], 3);
#elif PROBE == 7
        if (p == 6) hipLaunchKernelGGL(probe_wconv, dim3(48), dim3(256), 0, stream, (const unsigned char*)d_ws, a.in[8], 5632);
#elif PROBE == 8
        if (p == 3) hipLaunchKernelGGL(probe_wconv, dim3(48), dim3(256), 0, stream, (const unsigned char*)d_ws, a.in[8], 5632);
#elif PROBE == 9
        if (p == 7) hipLaunchKernelGGL(probe_merge, dim3(8), dim3(256), 0, stream, (const unsigned char*)d_ws, a.in[8], a.in[25], a.in[26], 2);
#elif PROBE == 4
        if (p == 9) hipLaunchKernelGGL(probe_merge, dim3(8), dim3(256), 0, stream, (const unsigned char*)d_ws, a.in[8], a.in[25], a.in[26], 1);
#endif
    }
#endif
}
```

```cpp
#include <hip/hip_runtime.h>
#include <hip/hip_bf16.h>
#include <cstdio>
#include <cstdint>
#define MK_ONE_LAUNCH 1
#define GATE_RAW 1

__device__ __forceinline__ int otid_() { int t = (int)threadIdx.x; asm volatile("" : "+v"(t)); return t; }
namespace pg8 {
#define PG8_LAS __attribute__((address_space(3)))
typedef unsigned short bf16_t;
typedef short bf16x8 __attribute__((ext_vector_type(8)));
typedef float f32x4 __attribute__((ext_vector_type(4)));
typedef unsigned u32x4 __attribute__((ext_vector_type(4)));
constexpr int BM = 256, BK = 64, HALF = 128, HTB = HALF * BK * 2  , STAGE_BYTES = 8 * HTB, NXCD = 8, WGM = 8;

__host__ __device__ __forceinline__ int lds_byte(int r, int c) { const int st = (r >> 4) * 2 + (c >> 5), rr = r & 15, cc = c & 31, ob = rr * 64 + cc * 2; return st * 1024 + (ob ^ (((ob >> 9) & 1) << 5)); }
__host__ __device__ __forceinline__ void stage_rc(int b, int& R, int& C) { const int st = b / 1024, sb = b % 1024, swz = sb ^ (((sb >> 9) & 1) << 5); R = (st >> 1) * 16 + swz / 64; C = (st & 1) * 32 + (swz % 64) / 2; }
__host__ __device__ __forceinline__ int perm32(int rho) { const int n = rho >> 4, i = rho & 15; return 8 * (i >> 2) + 4 * n + (i & 3); }

struct Unit { int pm, pn; };
struct Gemm { const bf16_t* A; const bf16_t* Bt; int M, N, K, lda; };

struct StaticOrder {
    int nM, nN, nwg, G, c;
    __host__ __device__ void init(int M, int N, int G_, int c_) { nM = M / BM; nN = N / BM; nwg = nM * nN; G = G_; c = c_; }
    __host__ __device__ bool next(int i, Unit& u) const {
        const long L = (long)i * G + c; if (L >= nwg) return false;
        int wgid = (int)L; { const int q = nwg / NXCD, r = nwg % NXCD, xcd = wgid % NXCD, off = wgid / NXCD; wgid = (xcd < r ? xcd * (q + 1) : r * (q + 1) + (xcd - r) * q) + off; }
        const int nig = WGM * nN, gid = wgid / nig, fm = gid * WGM, gsz = (nM - fm) < WGM ? (nM - fm) : WGM;
        u.pm = fm + ((wgid % nig) % gsz); u.pn = (wgid % nig) / gsz; return true;
    }
    __device__ __forceinline__ void a_ready(const Unit&) const {}
    __device__ __forceinline__ void done(const Unit&) const {}
};

__device__ __forceinline__ unsigned cvt_pk_bf16(float lo, float hi) { unsigned r; asm volatile("v_cvt_pk_bf16_f32 %0, %1, %2" : "=v"(r) : "v"(lo), "v"(hi)); return r; }

template <class Epi, class Sched, bool ALIGN_EPI = false, bool SP2 = false>
__device__ __forceinline__ void gemm_phase(PG8_LAS unsigned char* lds, const Gemm g, const Sched& S, const Epi& E) {
    const int tid = otid_(), wid = __builtin_amdgcn_readfirstlane(tid >> 6), lane = tid & 63, wr = wid >> 2, wc = wid & 3, fr = lane & 15, fq = lane >> 4;
    const int K = g.K, nt = K / BK;
    unsigned voffA[2], voffB[2];
#pragma unroll
    for (int i = 0; i < 2; ++i) { int R, C; stage_rc(tid * 16 + i * 8192, R, C); const int Rb = Epi::PERM ? ((R & ~31) + perm32(R & 31)) : R;
        voffA[i] = (unsigned)(R * g.lda + C) * 2u; voffB[i] = (unsigned)(Rb * K + C) * 2u; }
    const size_t kstep = (size_t)(BK * 2);
    const size_t hstepB = (size_t)HALF * K * 2, hstepA = (size_t)HALF * g.lda * 2;
    const size_t tstepB = 2 * hstepB, tstepA = 2 * hstepA;
    const unsigned ldsw = (unsigned)wid * 1024u;
    const int aoff = lds_byte(wr * 64 + fr, fq * 8), boff = lds_byte(wc * 32 + fr, fq * 8);
#define PG8_SA(b, h) (((b) * 2 + (h)) * HTB)
#define PG8_SB(b, h) ((4 + (b) * 2 + (h)) * HTB)
#define PG8_STAGE(bufoff, gbase, voff) do { _Pragma("unroll") for (int _i = 0; _i < 2; ++_i) \
        __builtin_amdgcn_global_load_lds((const unsigned*)((const char*)(gbase) + (voff)[_i]), (PG8_LAS unsigned*)(lds + (bufoff) + ldsw + _i * 8192), 16, 0, 0); } while (0)
#define PG8_LDA(dst, b, h) do { _Pragma("unroll") for (int m = 0; m < 4; ++m) _Pragma("unroll") for (int k = 0; k < 2; ++k) dst[m][k] = *(const PG8_LAS bf16x8*)(lds + PG8_SA(b, h) + aoff + m * 2048 + k * 1024); } while (0)
#define PG8_LDB(dst, b, h) do { _Pragma("unroll") for (int n = 0; n < 2; ++n) _Pragma("unroll") for (int k = 0; k < 2; ++k) dst[n][k] = *(const PG8_LAS bf16x8*)(lds + PG8_SB(b, h) + boff + n * 2048 + k * 1024); } while (0)
#define PG8_MMA(ai, bj, At, Bt) do { __builtin_amdgcn_s_setprio(1); _Pragma("unroll") for (int m = 0; m < 4; ++m) _Pragma("unroll") for (int n = 0; n < 2; ++n) _Pragma("unroll") for (int k = 0; k < 2; ++k) \
        acc[ai][bj][m][n] = __builtin_amdgcn_mfma_f32_16x16x32_bf16(Bt[n][k], At[m][k], acc[ai][bj][m][n], 0, 0, 0); __builtin_amdgcn_s_setprio(0); } while (0)
#define PG8_WAIT_V(n) asm volatile("s_waitcnt vmcnt(" #n ")" ::: "memory")
#define PG8_WAIT_L(n) asm volatile("s_waitcnt lgkmcnt(" #n ")" ::: "memory")
#define PG8_BAR __builtin_amdgcn_s_barrier()
#define PG8_SCHED __builtin_amdgcn_sched_barrier(0)
    Unit cur, nxt; int ui = 0;
    if (!S.next(0, cur)) return;
    f32x4 acc[2][2][4][2];
#pragma unroll
    for (int a = 0; a < 2; ++a)
#pragma unroll
        for (int b = 0; b < 2; ++b)
#pragma unroll
            for (int m = 0; m < 4; ++m)
#pragma unroll
                for (int n = 0; n < 2; ++n) acc[a][b][m][n] = (f32x4){0.f, 0.f, 0.f, 0.f};
    bf16x8 At[4][2], B0[2][2], B1[2][2];
    const char* cA = (const char*)g.A + (size_t)cur.pm * tstepA; const char* cB = (const char*)g.Bt + (size_t)cur.pn * tstepB;
    S.a_ready(cur);
    if constexpr (SP2) {
        PG8_STAGE(PG8_SB(0, 0), cB, voffB); PG8_STAGE(PG8_SB(0, 1), cB + hstepB, voffB); PG8_STAGE(PG8_SA(0, 0), cA, voffA); PG8_STAGE(PG8_SA(0, 1), cA + hstepA, voffA);
        if (wr == 1) PG8_BAR;
        PG8_WAIT_V(2); PG8_BAR;
        PG8_STAGE(PG8_SB(1, 0), cB + kstep, voffB); PG8_STAGE(PG8_SA(1, 0), cA + kstep, voffA); PG8_STAGE(PG8_SB(1, 1), cB + hstepB + kstep, voffB);
        PG8_WAIT_V(6); PG8_BAR;
    } else {
        PG8_STAGE(PG8_SB(0, 0), cB, voffB); PG8_STAGE(PG8_SA(0, 0), cA, voffA); PG8_STAGE(PG8_SB(0, 1), cB + hstepB, voffB); PG8_STAGE(PG8_SA(0, 1), cA + hstepA, voffA);
        if (wr == 1) PG8_BAR;
        PG8_WAIT_V(4); PG8_BAR;
        PG8_STAGE(PG8_SB(1, 0), cB + kstep, voffB); PG8_STAGE(PG8_SA(1, 0), cA + kstep, voffA); PG8_STAGE(PG8_SB(1, 1), cB + hstepB + kstep, voffB);
        PG8_WAIT_V(6); PG8_BAR;
    }
    for (;;) {
        const bool has_next = S.next(ui + 1, nxt);
        const char* nA = has_next ? (const char*)g.A + (size_t)nxt.pm * tstepA : cA; const char* nB = has_next ? (const char*)g.Bt + (size_t)nxt.pn * tstepB : cB;
        for (int t = 0; t < nt; t += 2) {
            const bool last = (t == nt - 2);
            const char* a1 = cA + (size_t)(t + 1) * kstep;
            const char* a2 = last ? nA : cA + (size_t)(t + 2) * kstep; const char* b2 = last ? nB : cB + (size_t)(t + 2) * kstep;
            const char* a3 = a2 + kstep; const char* b3 = b2 + kstep;
            if (last && has_next) S.a_ready(nxt);
            if constexpr (SP2) {
            PG8_LDB(B0, 0, 0); PG8_LDB(B1, 0, 1); PG8_SCHED; PG8_LDA(At, 0, 0); PG8_STAGE(PG8_SA(1, 1), a1 + hstepA, voffA);
            PG8_WAIT_V(8); PG8_WAIT_L(0); PG8_BAR; PG8_MMA(0, 0, At, B0); PG8_MMA(0, 1, At, B1); PG8_BAR; PG8_SCHED;
            PG8_LDA(At, 0, 1); PG8_STAGE(PG8_SB(0, 0), b2, voffB); PG8_STAGE(PG8_SB(0, 1), b2 + hstepB, voffB); PG8_STAGE(PG8_SA(0, 0), a2, voffA);
            PG8_WAIT_V(8); PG8_WAIT_L(0); PG8_BAR; PG8_MMA(1, 0, At, B0); PG8_MMA(1, 1, At, B1); PG8_BAR; PG8_SCHED;
            PG8_LDB(B0, 1, 0); PG8_LDB(B1, 1, 1); PG8_SCHED; PG8_LDA(At, 1, 0); PG8_STAGE(PG8_SA(0, 1), a2 + hstepA, voffA);
            PG8_WAIT_V(8); PG8_WAIT_L(0); PG8_BAR; PG8_MMA(0, 0, At, B0); PG8_MMA(0, 1, At, B1); PG8_BAR; PG8_SCHED;
            PG8_LDA(At, 1, 1); PG8_STAGE(PG8_SB(1, 0), b3, voffB); PG8_STAGE(PG8_SB(1, 1), b3 + hstepB, voffB); PG8_STAGE(PG8_SA(1, 0), a3, voffA);
            PG8_WAIT_V(8); PG8_WAIT_L(0); PG8_BAR; PG8_MMA(1, 0, At, B0); PG8_MMA(1, 1, At, B1); PG8_BAR; PG8_SCHED;
            } else {
            PG8_LDB(B0, 0, 0); PG8_SCHED; PG8_LDA(At, 0, 0); PG8_STAGE(PG8_SA(1, 1), a1 + hstepA, voffA);
            PG8_WAIT_L(8); PG8_BAR; PG8_WAIT_L(0); PG8_MMA(0, 0, At, B0); PG8_BAR; PG8_SCHED;
            PG8_LDB(B1, 0, 1); PG8_STAGE(PG8_SB(0, 0), b2, voffB);
            PG8_BAR; PG8_WAIT_L(0); PG8_MMA(0, 1, At, B1); PG8_BAR;
            PG8_LDA(At, 0, 1); PG8_STAGE(PG8_SA(0, 0), a2, voffA);
            PG8_BAR; PG8_WAIT_L(0); PG8_MMA(1, 0, At, B0); PG8_BAR; PG8_SCHED;
            PG8_STAGE(PG8_SB(0, 1), b2 + hstepB, voffB);
            PG8_WAIT_V(6); PG8_BAR; PG8_MMA(1, 1, At, B1); PG8_BAR;
            PG8_LDB(B0, 1, 0); PG8_SCHED; PG8_LDA(At, 1, 0); PG8_STAGE(PG8_SA(0, 1), a2 + hstepA, voffA);
            PG8_WAIT_L(8); PG8_BAR; PG8_WAIT_L(0); PG8_MMA(0, 0, At, B0); PG8_BAR; PG8_SCHED;
            PG8_LDB(B1, 1, 1); PG8_STAGE(PG8_SB(1, 0), b3, voffB);
            PG8_BAR; PG8_WAIT_L(0); PG8_MMA(0, 1, At, B1); PG8_BAR;
            PG8_LDA(At, 1, 1); PG8_STAGE(PG8_SA(1, 0), a3, voffA);
            PG8_BAR; PG8_WAIT_L(0); PG8_MMA(1, 0, At, B0); PG8_BAR; PG8_SCHED;
            PG8_STAGE(PG8_SB(1, 1), b3 + hstepB, voffB);
            PG8_WAIT_V(6); PG8_BAR; PG8_MMA(1, 1, At, B1); PG8_BAR;
            }
        }
        if constexpr (ALIGN_EPI) { if (wr == 0) PG8_BAR; }
        if constexpr (!Epi::AFTER_DRAIN) { E(acc, cur, wr, wc, fr, fq); S.done(cur); }
        if (!has_next) break;
#pragma unroll
        for (int a = 0; a < 2; ++a)
#pragma unroll
            for (int b = 0; b < 2; ++b)
#pragma unroll
                for (int m = 0; m < 4; ++m)
#pragma unroll
                    for (int n = 0; n < 2; ++n) acc[a][b][m][n] = (f32x4){0.f, 0.f, 0.f, 0.f};
        cur = nxt; cA = nA; cB = nB; ++ui;
        if constexpr (ALIGN_EPI) { if (wr == 1) PG8_BAR; }
    }
    PG8_WAIT_V(0);
    if constexpr (!ALIGN_EPI) { if (wr == 0) PG8_BAR; }
    PG8_BAR;
    if constexpr (Epi::AFTER_DRAIN) { E.fused(acc, cur, wr, wc, fr, fq, lds, wid, lane); S.done(cur); }
#undef PG8_SA
#undef PG8_SB
#undef PG8_STAGE
#undef PG8_LDA
#undef PG8_LDB
#undef PG8_MMA
#undef PG8_WAIT_V
#undef PG8_WAIT_L
#undef PG8_BAR
#undef PG8_SCHED
}
}
namespace pg8 {
typedef unsigned u32x2 __attribute__((ext_vector_type(2)));
__device__ __forceinline__ float bf_lo(unsigned w) { return __uint_as_float(w << 16); }
__device__ __forceinline__ float bf_hi(unsigned w) { return __uint_as_float(w & 0xffff0000u); }
__device__ __forceinline__ float sigmoidf_(float x) { return __builtin_amdgcn_rcpf(1.0f + __expf(-x)); }

struct EpiSwiGLU {
    static constexpr bool PERM = false, AFTER_DRAIN = false;
    bf16_t* H; int ldh;
    __device__ __forceinline__ void operator()(const f32x4 (&acc)[2][2][4][2], const Unit& u, int wr, int wc, int fr, int fq) const {
        const int row0 = u.pm * BM + wr * 64 + fr, hc0 = u.pn * 128 + wc * 16 + 4 * fq;
#pragma unroll
        for (int ai = 0; ai < 2; ++ai)
#pragma unroll
            for (int m = 0; m < 4; ++m) { bf16_t* rowp = H + (size_t)(row0 + ai * HALF + m * 16) * ldh + hc0;
#pragma unroll
                for (int bj = 0; bj < 2; ++bj) { const f32x4 g = acc[ai][bj][m][0], up = acc[ai][bj][m][1]; float h[4];
#pragma unroll
                    for (int e = 0; e < 4; ++e) h[e] = g[e] * sigmoidf_(g[e]) * up[e];
                    u32x2 w; w.x = cvt_pk_bf16(h[0], h[1]); w.y = cvt_pk_bf16(h[2], h[3]);
                    *(u32x2*)(rowp + bj * 64) = w; } }
    }
};
template <int ACT> struct EpiStore {
    static constexpr bool PERM = true, AFTER_DRAIN = false;
    bf16_t* O0; int ld0; bf16_t* O1; int ld1; int split_tiles;
    __device__ __forceinline__ void operator()(const f32x4 (&acc)[2][2][4][2], const Unit& u, int wr, int wc, int fr, int fq) const {
        const int row0 = u.pm * BM + wr * 64 + fr;
        bf16_t* base; int ld, colt;
        if (u.pn < split_tiles) { base = O0; ld = ld0; colt = u.pn * BM; } else { base = O1; ld = ld1; colt = (u.pn - split_tiles) * BM; }
        const int col0 = colt + wc * 32 + 8 * fq;
#pragma unroll
        for (int ai = 0; ai < 2; ++ai)
#pragma unroll
            for (int m = 0; m < 4; ++m) { bf16_t* rowp = base + (size_t)(row0 + ai * HALF + m * 16) * ld + col0;
#pragma unroll
                for (int bj = 0; bj < 2; ++bj) { f32x4 v0 = acc[ai][bj][m][0], v1 = acc[ai][bj][m][1];
                    if (ACT == 1) {
#pragma unroll
                        for (int e = 0; e < 4; ++e) { v0[e] = sigmoidf_(v0[e]); v1[e] = sigmoidf_(v1[e]); } }
                    u32x4 w; w.x = cvt_pk_bf16(v0[0], v0[1]); w.y = cvt_pk_bf16(v0[2], v0[3]); w.z = cvt_pk_bf16(v1[0], v1[1]); w.w = cvt_pk_bf16(v1[2], v1[3]);
                    *(u32x4*)(rowp + bj * HALF) = w; } }
    }
};
#ifdef GATE_RAW
#define GSIG(x) sigmoidf_(x)
#else
#define GSIG(x) (x)
#endif
struct EpiGateMul {
    static constexpr bool PERM = true, AFTER_DRAIN = false;
    bf16_t* MG; int ldm; const bf16_t* G; int ldg; int first;
    __device__ __forceinline__ void operator()(const f32x4 (&acc)[2][2][4][2], const Unit& u, int wr, int wc, int fr, int fq) const {
        const int row0 = u.pm * BM + wr * 64 + fr, col0 = u.pn * BM + wc * 32 + 8 * fq;
#pragma unroll
        for (int ai = 0; ai < 2; ++ai) {
            u32x4 g[8], p[8];
#pragma unroll
            for (int m = 0; m < 4; ++m)
#pragma unroll
                for (int bj = 0; bj < 2; ++bj) { const size_t r = (size_t)(row0 + ai * HALF + m * 16);
                    g[2 * m + bj] = *(const u32x4*)(G + r * ldg + col0 + bj * HALF);
                    if (!first) p[2 * m + bj] = *(const u32x4*)(MG + r * ldm + col0 + bj * HALF); }
#pragma unroll
            for (int m = 0; m < 4; ++m)
#pragma unroll
                for (int bj = 0; bj < 2; ++bj) { const size_t r = (size_t)(row0 + ai * HALF + m * 16);
                    const f32x4 v0 = acc[ai][bj][m][0], v1 = acc[ai][bj][m][1]; const u32x4 gg = g[2 * m + bj];
                    float o[8] = { v0[0] * GSIG(bf_lo(gg.x)), v0[1] * GSIG(bf_hi(gg.x)), v0[2] * GSIG(bf_lo(gg.y)), v0[3] * GSIG(bf_hi(gg.y)), v1[0] * GSIG(bf_lo(gg.z)), v1[1] * GSIG(bf_hi(gg.z)), v1[2] * GSIG(bf_lo(gg.w)), v1[3] * GSIG(bf_hi(gg.w)) };
                    if (!first) { const u32x4 pp = p[2 * m + bj];
                        o[0] += bf_lo(pp.x); o[1] += bf_hi(pp.x); o[2] += bf_lo(pp.y); o[3] += bf_hi(pp.y); o[4] += bf_lo(pp.z); o[5] += bf_hi(pp.z); o[6] += bf_lo(pp.w); o[7] += bf_hi(pp.w); }
                    u32x4 w; w.x = cvt_pk_bf16(o[0], o[1]); w.y = cvt_pk_bf16(o[2], o[3]); w.z = cvt_pk_bf16(o[4], o[5]); w.w = cvt_pk_bf16(o[6], o[7]);
                    *(u32x4*)(MG + r * ldm + col0 + bj * HALF) = w; }
        }
    }
};
}
namespace att {
constexpr int D = 128;
constexpr bool WSKIP = false;
constexpr float THR = 8.f;
constexpr int NW = 8, QBLK = 32, KVBLK = 64, QB = NW * QBLK;
constexpr int SHM_V = KVBLK * D * 2, SHM_K = KVBLK * D * 2;
constexpr int LDS_BYTES = 2 * SHM_V + 2 * SHM_K + NW * 64 * 4;
using bf16 = __hip_bfloat16;
typedef short bf16x8 __attribute__((ext_vector_type(8)));
typedef short s16x4 __attribute__((ext_vector_type(4)));
typedef float f32x16 __attribute__((ext_vector_type(16)));
typedef float f32x4 __attribute__((ext_vector_type(4)));
typedef unsigned u32x4 __attribute__((ext_vector_type(4)));
template <class A, class Bt> struct same_t { static constexpr bool v = false; };
template <class A> struct same_t<A, A> { static constexpr bool v = true; };

#define KSWZ(row, colB) ((row) * 256 + ((colB) ^ (((row) & 7) << 4)))
#define SBAR() __builtin_amdgcn_sched_barrier(0)
__device__ __forceinline__ int v_st(int k, int c) { const int kk = (k & ~0xC) | ((k & 4) << 1) | ((k & 8) >> 1); return ((kk >> 3) * 4 + (c >> 5)) * 512 + ((kk & 7) * 32 + (c & 31)) * 2; }
__device__ __forceinline__ int v_rd_base(int lane) { return ((lane & 3) << 3) | (((lane >> 2) & 3) << 6) | (((lane >> 4) & 1) << 5) | (((lane >> 5) & 1) << 8); }
constexpr int v_rd_off(int d0, int ks, int half) { return d0 * 512 + ks * 4096 + half * 2048; }
__device__ __forceinline__ int crow(int r, int hi) { return (r & 3) + 8 * (r >> 2) + 4 * hi; }
__device__ __forceinline__ unsigned cvtpk(float lo, float hi) {
    unsigned r; asm volatile("v_cvt_pk_bf16_f32 %0, %1, %2" : "=v"(r) : "v"(lo), "v"(hi)); return r;
}
__device__ __forceinline__ bf16x8 pack8(f32x4 a, f32x4 b) {
    u32x4 w = {cvtpk(a[0], a[1]), cvtpk(a[2], a[3]), cvtpk(b[0], b[1]), cvtpk(b[2], b[3])};
    return *reinterpret_cast<bf16x8*>(&w);
}
template <class T> __device__ __forceinline__ bf16x8 load8(const T* p) {
    if constexpr (same_t<T, float>::v) { return pack8(*(const f32x4*)p, *(const f32x4*)(p + 4)); }
    else { return *reinterpret_cast<const bf16x8*>(p); }
}
__device__ __forceinline__ void mask_tile(f32x16& p0, f32x16& p1, int dq, unsigned W) {
    const float NEG = -__builtin_inff();
#pragma unroll
    for (int r = 0; r < 16; ++r) {
        const int c = (r & 3) + 8 * (r >> 2);
        if ((unsigned)(dq - c) >= W) p0[r] = NEG;
        if ((unsigned)(dq - c - 32) >= W) p1[r] = NEG;
    }
}
typedef unsigned u32x2 __attribute__((ext_vector_type(2)));
__device__ __forceinline__ void bitmask_tile(f32x16& p0, f32x16& p1, u32x2 w, int hi) {
    const float NEG = -__builtin_inff();
    const unsigned a = w[0] >> (4 * hi), b = w[1] >> (4 * hi);
#pragma unroll
    for (int r = 0; r < 16; ++r) {
        const int c = (r & 3) + 8 * (r >> 2);
        if (!((a >> c) & 1u)) p0[r] = NEG;
        if (!((b >> c) & 1u)) p1[r] = NEG;
    }
}
template <bool HALFQK> __device__ __forceinline__ void partialSM(f32x16& p0, f32x16& p1, float& m_reg, float& mn, float& alpha) {
    constexpr float SCALE = HALFQK ? 0.125f : 0.08838834764831845f;
    float pmax = p0[0]; for (int r = 1; r < 16; ++r) pmax = fmaxf(pmax, p0[r]); for (int r = 0; r < 16; ++r) pmax = fmaxf(pmax, p1[r]);
    { auto rr = __builtin_amdgcn_permlane32_swap(__float_as_uint(pmax), __float_as_uint(pmax), false, false);
      pmax = fmaxf(__uint_as_float(rr[0]), __uint_as_float(rr[1])); }
    constexpr float C2 = 1.4426950408889634f * SCALE;
    if (__builtin_expect(__all((pmax - m_reg) * SCALE <= THR), 1)) { mn = m_reg; alpha = 1.f; }
    else { mn = fmaxf(m_reg, pmax); alpha = __builtin_amdgcn_exp2f((m_reg - mn) * C2); m_reg = mn; }
    const float mnL = -mn * C2;
    for (int r = 0; r < 16; ++r) p0[r] = fmaf(p0[r], C2, mnL); for (int r = 0; r < 16; ++r) p1[r] = fmaf(p1[r], C2, mnL);
    for (int r = 0; r < 16; ++r) p0[r] = __builtin_amdgcn_exp2f(p0[r]);
}
__device__ __forceinline__ void finishSM(f32x16& p0, f32x16& p1, float alpha, float& l_reg, bf16x8& pa0, bf16x8& pa1, bf16x8& pa2, bf16x8& pa3) {
    for (int r = 0; r < 16; ++r) p1[r] = __builtin_amdgcn_exp2f(p1[r]);
    float ps = 0; for (int r = 0; r < 16; ++r) ps += p0[r]; for (int r = 0; r < 16; ++r) ps += p1[r];
    { auto rr = __builtin_amdgcn_permlane32_swap(__float_as_uint(ps), __float_as_uint(ps), false, false);
      ps = __uint_as_float(rr[0]) + __uint_as_float(rr[1]); }
    l_reg = l_reg * alpha + ps;
#define PK4(P, B_, OUT) do { unsigned a0 = cvtpk(P[B_+0], P[B_+1]), a1 = cvtpk(P[B_+2], P[B_+3]);                          \
        unsigned b0 = cvtpk(P[B_+4], P[B_+5]), b1 = cvtpk(P[B_+6], P[B_+7]);                                             \
        auto r0 = __builtin_amdgcn_permlane32_swap(a0, b0, false, false); auto r1 = __builtin_amdgcn_permlane32_swap(a1, b1, false, false); \
        u32x4 w = {r0[0], r1[0], r0[1], r1[1]}; OUT = *reinterpret_cast<bf16x8*>(&w); } while (0)
    PK4(p0, 0, pa0); PK4(p0, 8, pa1); PK4(p1, 0, pa2); PK4(p1, 8, pa3);
#undef PK4
}
template <int KB, bool SK, bool HALFQK>
__device__ __forceinline__ void qkt(f32x16& p0, f32x16& p1, const char* K_lds, int r32, int hi, const bf16x8* qr, bool act, int koff) {
    if (SK && !act) { const float NEG = -__builtin_inff();
#pragma unroll
        for (int r = 0; r < 16; ++r) { p0[r] = NEG; p1[r] = NEG; } return; }
    p0 = f32x16{}; p1 = f32x16{};
    const char* kb[4];
#pragma unroll
    for (int dd = 0; dd < 4; ++dd) kb[dd] = K_lds + KB * SHM_K + KSWZ(r32, (dd * 16 + hi * 8) * 2) + koff;
#pragma unroll
    for (int d0 = 0; d0 < (HALFQK ? 4 : 8); ++d0) { const char* a = kb[d0 & 3] + (d0 >> 2) * 128;
        bf16x8 b0 = *reinterpret_cast<const bf16x8*>(a);
        bf16x8 b1 = *reinterpret_cast<const bf16x8*>(a + 32 * 256);
        p0 = __builtin_amdgcn_mfma_f32_32x32x16_bf16(b0, qr[d0], p0, 0, 0, 0);
        p1 = __builtin_amdgcn_mfma_f32_32x32x16_bf16(b1, qr[d0], p1, 0, 0, 0); }
}
template <int VB, bool SK>
__device__ __forceinline__ void pv_tile(f32x16* o, int vb0, bf16x8 pa0, bf16x8 pa1, bf16x8 pa2, bf16x8 pa3, bool act) {
    if (SK && !act) return;
#define TRRD(dst, off) asm volatile("ds_read_b64_tr_b16 %0, %1 offset:%2" : "=&v"(dst) : "v"(vb0), "i"(off) : "memory")
#define PV_D0(d0) do { s16x4 l0, l1, l2, l3, h0, h1, h2, h3; constexpr int b_ = VB * SHM_V + v_rd_off(d0, 0, 0);     \
        TRRD(l0, b_); TRRD(h0, b_ + 2048); TRRD(l1, b_ + 4096); TRRD(h1, b_ + 6144); TRRD(l2, b_ + 8192); TRRD(h2, b_ + 10240); TRRD(l3, b_ + 12288); TRRD(h3, b_ + 14336); \
        asm volatile("s_waitcnt lgkmcnt(0)" ::: "memory"); SBAR();                 \
        o[d0] = __builtin_amdgcn_mfma_f32_32x32x16_bf16(pa0, (bf16x8){l0[0], l0[1], l0[2], l0[3], h0[0], h0[1], h0[2], h0[3]}, o[d0], 0, 0, 0);   \
        o[d0] = __builtin_amdgcn_mfma_f32_32x32x16_bf16(pa1, (bf16x8){l1[0], l1[1], l1[2], l1[3], h1[0], h1[1], h1[2], h1[3]}, o[d0], 0, 0, 0);   \
        o[d0] = __builtin_amdgcn_mfma_f32_32x32x16_bf16(pa2, (bf16x8){l2[0], l2[1], l2[2], l2[3], h2[0], h2[1], h2[2], h2[3]}, o[d0], 0, 0, 0);   \
        o[d0] = __builtin_amdgcn_mfma_f32_32x32x16_bf16(pa3, (bf16x8){l3[0], l3[1], l3[2], l3[3], h3[0], h3[1], h3[2], h3[3]}, o[d0], 0, 0, 0); } while (0)
    PV_D0(0); PV_D0(1); PV_D0(2); PV_D0(3);
#undef PV_D0
#undef TRRD
}

constexpr int QS = 1536, KVS = 4096;
template <class TIn, class TOut> struct BlockRef { const TIn* Q; const TIn* K; const TIn* V; TOut* O; int P0; int koff; const unsigned* mask; };
template <class TIn> struct Seam {
    bf16x8 qr[8];
    bf16x8 st_v0, st_v1, st_k0, st_k1; f32x4 sf0, sf1, sf2, sf3;
    f32x4 tq[16];
};
__device__ __forceinline__ int swa_jlo(int P0, int W) { const int lowk = P0 - W + 1; return lowk > 0 ? lowk / KVBLK : 0; }
#define ROW(p, k0, rr) ((p) + (size_t)((k0) + (rr)) * KVS + sc)
#define VMW() asm volatile("s_waitcnt vmcnt(0)" ::: "memory")
#define VMWN(n) asm volatile("s_waitcnt vmcnt(%0)" :: "i"(n) : "memory")
#define SLOAD_H(Kp, Vp, k0) do { S.st_v0 = load8<TIn>(ROW(Vp, k0, sr)); S.st_v1 = load8<TIn>(ROW(Vp, k0, 32 + sr));              \
                         S.st_k0 = load8<TIn>(ROW(Kp, k0, sr)); S.st_k1 = load8<TIn>(ROW(Kp, k0, 32 + sr)); } while (0)
#define SWRITE_HK(bf) do { *(bf16x8*)(K_lds + (bf) * SHM_K + kws) = S.st_k0; *(bf16x8*)(K_lds + (bf) * SHM_K + kws + 32 * 256) = S.st_k1; } while (0)
#define SWRITE_HV(bf) do { *(bf16x8*)(V_lds + (bf) * SHM_V + vst0) = S.st_v0; *(bf16x8*)(V_lds + (bf) * SHM_V + vst1) = S.st_v1; } while (0)
#define SWRITE_H(bf) do { SWRITE_HV(bf); SWRITE_HK(bf); } while (0)
#define SLOAD_F(p, k0) do { S.sf0 = *(const f32x4*)ROW(p, k0, sr); S.sf1 = *(const f32x4*)(ROW(p, k0, sr) + 4);                \
                            S.sf2 = *(const f32x4*)ROW(p, k0, 32 + sr); S.sf3 = *(const f32x4*)(ROW(p, k0, 32 + sr) + 4); } while (0)
#define SWRITE_KF(bf) do { *(bf16x8*)(K_lds + (bf) * SHM_K + kws) = pack8(S.sf0, S.sf1); *(bf16x8*)(K_lds + (bf) * SHM_K + kws + 32 * 256) = pack8(S.sf2, S.sf3); } while (0)
#define SWRITE_VF(bf) do { *(bf16x8*)(V_lds + (bf) * SHM_V + vst0) = pack8(S.sf0, S.sf1); *(bf16x8*)(V_lds + (bf) * SHM_V + vst1) = pack8(S.sf2, S.sf3); } while (0)
template <class TIn, class TOut, bool HALFQK>
__device__ __forceinline__ void causal_swa_prime(const BlockRef<TIn, TOut>& cur, int W, char* lds, Seam<TIn>& S) {
    constexpr bool F32 = same_t<TIn, float>::v;
    const int tid = otid_(), wid = __builtin_amdgcn_readfirstlane(tid >> 6), lane = tid & 63, r32 = lane & 31, hi = lane >> 5;
    const int sr = tid >> 4, sc = (tid & 15) * 8, kws = KSWZ(sr, sc * 2); char* K_lds = lds + 2 * SHM_V;
    const int kb0 = swa_jlo(cur.P0, W) * KVBLK;
    for (int d0 = 0; d0 < (HALFQK ? 4 : 8); ++d0) S.qr[d0] = load8<TIn>(cur.Q + (size_t)(wid * QBLK + r32) * QS + d0 * 16 + hi * 8);
    if constexpr (F32) { SLOAD_F((const float*)cur.K, kb0); VMW(); SWRITE_KF(0); SBAR(); SLOAD_F((const float*)cur.V, kb0); }
    else { SLOAD_H(cur.K, cur.V, kb0); VMW(); SWRITE_HK(0); }
    __syncthreads();
}
template <class TIn, class TOut, bool HALFQK, bool MASKED, int OS>
__device__ __forceinline__ void causal_swa_block(const BlockRef<TIn, TOut>& cur, const BlockRef<TIn, TOut>& nxt, int skv, int W, char* lds, Seam<TIn>& S) {
    constexpr bool F32 = same_t<TIn, float>::v;
    const int tid = otid_(), wid = __builtin_amdgcn_readfirstlane(tid >> 6), lane = tid & 63, r32 = lane & 31, hi = lane >> 5;
    const int j_lo = swa_jlo(cur.P0, W);
    int j_hi = (cur.P0 + QB - 1) / KVBLK + 1; if (j_hi > skv / KVBLK) j_hi = skv / KVBLK;
    const int NT = j_hi - j_lo;
    const int kbn = swa_jlo(nxt.P0, W) * KVBLK;
    const int qlo = cur.P0 + wid * QBLK, qm = qlo + r32 - 4 * hi;
    char* V_lds = lds; char* K_lds = lds + 2 * SHM_V;
    float* ws = (float*)(lds + 2 * SHM_V + 2 * SHM_K) + wid * 64; float* li_l = ws, * al_l = ws + 32;
    float m_reg = -1e30f, l_reg = 0; f32x16 o[4] = {};
    const int sr = tid >> 4, sc = (tid & 15) * 8, vst0 = v_st(sr, sc), vst1 = v_st(32 + sr, sc), kws = KSWZ(sr, sc * 2);
    const int vb0 = (int)(uintptr_t)V_lds + v_rd_base(lane);
    const TIn* Kh = cur.K; const TIn* Vh = cur.V;
#define RESC(a) do { if (__any((a) < 1.f)) { if (hi == 0) al_l[r32] = (a); asm volatile("s_waitcnt lgkmcnt(0)" ::: "memory");              \
                     for (int d_ = 0; d_ < 4; ++d_) for (int r = 0; r < 16; ++r) o[d_][r] *= al_l[crow(r, hi)]; } } while (0)
#define KBASE(t) ((j_lo + (t)) * KVBLK)
#define ACT(t) (KBASE(t) <= qlo + QBLK - 1 && KBASE(t) + KVBLK - 1 >= qlo - W + 1)
#define MASKT(P0_, P1_, t) do { if constexpr (MASKED) bitmask_tile(P0_, P1_, mw, hi);   \
        else { const int kb_ = KBASE(t); if ((!SK || ACT(t)) && (kb_ + KVBLK - 1 > qlo || kb_ <= qlo + QBLK - 1 - W)) mask_tile(P0_, P1_, qm - kb_, (unsigned)W); } } while (0)
    const unsigned moff = (unsigned)((wid * QBLK + r32) * 1024 + 8 * j_lo); u32x2 mw = {0u, 0u};
#define MLOAD(t) do { if constexpr (MASKED) mw = *(const u32x2*)((const char*)cur.mask + (moff + 8u * (unsigned)(t))); } while (0)
    constexpr int NQL = F32 ? 16 : (HALFQK ? 4 : 8);
    constexpr bool SK = WSKIP && !F32;
#define SEAM_K0() do { VMWN(NQL); if constexpr (F32) { SWRITE_KF(0); SBAR(); SLOAD_F((const float*)nxt.V, kbn); } else { SWRITE_HK(0); } SBAR(); } while (0)
    f32x16 pA0, pA1, pB0, pB1; float mnA, mnB, alA, alB; bf16x8 pa0, pa1, pa2, pa3;
    if constexpr (F32) { VMW(); SWRITE_VF(0); SBAR(); } else { SWRITE_HV(0); SBAR(); }
    if (NT > 1) { if constexpr (F32) SLOAD_F((const float*)Kh, KBASE(1)); else SLOAD_H(Kh, Vh, KBASE(1)); }
    SBAR(); qkt<0, SK, HALFQK>(pA0, pA1, K_lds, r32, hi, S.qr, ACT(0), cur.koff); MLOAD(0);
    if constexpr (F32) { if (NT > 1) { VMW(); SWRITE_KF(1); SBAR(); SLOAD_F((const float*)Vh, KBASE(1)); } }
    MASKT(pA0, pA1, 0); partialSM<HALFQK>(pA0, pA1, m_reg, mnA, alA);
    if (NT > 1) { VMW(); if constexpr (F32) { SWRITE_VF(1); SBAR(); if (NT > 2) SLOAD_F((const float*)Kh, KBASE(2)); } else SWRITE_H(1); }
    __syncthreads();
#define HALF_STEP(PX0, PX1, mnX, alX, PY0, PY1, alY, t, KB, VB, SB) do {                                                      \
        SBAR(); qkt<KB, SK, HALFQK>(PX0, PX1, K_lds, r32, hi, S.qr, ACT(t), cur.koff); MLOAD(t);                                             \
        finishSM(PY0, PY1, alY, l_reg, pa0, pa1, pa2, pa3); SBAR();                                                           \
        if ((t) + 1 < NT) { if constexpr (F32) { VMW(); SWRITE_KF(SB); SBAR(); SLOAD_F((const float*)Vh, KBASE((t) + 1)); }  \
                            else { SLOAD_H(Kh, Vh, KBASE((t) + 1)); } SBAR(); }                                               \
        pv_tile<VB, SK>(o, vb0, pa0, pa1, pa2, pa3, ACT((t) - 1)); MASKT(PX0, PX1, (t)); partialSM<HALFQK>(PX0, PX1, m_reg, mnX, alX);                                        \
        __syncthreads();                                                                                                      \
        if ((t) + 1 < NT) { VMW(); if constexpr (F32) { SWRITE_VF(SB); SBAR(); if ((t) + 2 < NT) SLOAD_F((const float*)Kh, KBASE((t) + 2)); } \
                            else { SWRITE_H(SB); } }                                                                          \
        RESC(alX); __syncthreads(); } while (0)
    for (int t = 1; t + 1 < NT; t += 2) {
        HALF_STEP(pB0, pB1, mnB, alB, pA0, pA1, alA, t, 1, 0, 0);
        HALF_STEP(pA0, pA1, mnA, alA, pB0, pB1, alB, t + 1, 0, 1, 1);
    }
    const bool even = (NT & 1) == 0;
    if (even) { SBAR(); qkt<1, SK, HALFQK>(pB0, pB1, K_lds, r32, hi, S.qr, ACT(NT - 1), cur.koff); MLOAD(NT - 1); SBAR(); }
#define QROW(e) (nxt.Q + (size_t)(wid * QBLK + r32) * QS + ((e) >> 1) * 16 + hi * 8 + ((e) & 1) * 4)
    if constexpr (F32) { SLOAD_F((const float*)nxt.K, kbn); SBAR();
#pragma unroll
        for (int e = 0; e < 8; ++e) S.tq[e] = *(const f32x4*)QROW(e); }
    else { SLOAD_H(nxt.K, nxt.V, kbn); SBAR();
#pragma unroll
        for (int d0 = 0; d0 < (HALFQK ? 4 : 8); ++d0) S.qr[d0] = load8<TIn>(nxt.Q + (size_t)(wid * QBLK + r32) * QS + d0 * 16 + hi * 8); }
    SBAR();
    finishSM(pA0, pA1, alA, l_reg, pa0, pa1, pa2, pa3); SBAR();
    if constexpr (F32) {
#pragma unroll
        for (int e = 8; e < 16; ++e) S.tq[e] = *(const f32x4*)QROW(e); SBAR(); }
#undef QROW
    pv_tile<0, SK>(o, vb0, pa0, pa1, pa2, pa3, ACT(even ? NT - 2 : NT - 1));
    if (even) { MASKT(pB0, pB1, NT - 1); partialSM<HALFQK>(pB0, pB1, m_reg, mnB, alB); __syncthreads(); RESC(alB);
        finishSM(pB0, pB1, alB, l_reg, pa0, pa1, pa2, pa3); SBAR(); pv_tile<1, SK>(o, vb0, pa0, pa1, pa2, pa3, ACT(NT - 1)); }
    SBAR(); SEAM_K0();
    if (hi == 0) li_l[r32] = l_reg; asm volatile("s_waitcnt lgkmcnt(0)" ::: "memory");
    float rli[16];
#pragma unroll
    for (int r = 0; r < 16; ++r) rli[r] = __builtin_amdgcn_rcpf(li_l[crow(r, hi)]);
    TOut* Ow = cur.O + (size_t)(wid * QBLK) * OS;
#pragma unroll
    for (int r = 0; r < 16; ++r) { const int orow = crow(r, hi);
#pragma unroll
        for (int d0 = 0; d0 < 4; ++d0) { const float v = o[d0][r] * rli[r];
            if constexpr (same_t<TOut, float>::v) { Ow[(size_t)orow * OS + d0 * 32 + r32] = v; }
            else { const float vn = __shfl_xor(v, 1);
                   if ((r32 & 1) == 0) *(unsigned*)(Ow + (size_t)orow * OS + d0 * 32 + r32) = cvtpk(v, vn); } } }
    if constexpr (F32) {
#pragma unroll
        for (int d0 = 0; d0 < 8; ++d0) S.qr[d0] = pack8(S.tq[2 * d0], S.tq[2 * d0 + 1]); }
    __syncthreads();
#undef RESC
#undef KBASE
#undef ACT
#undef MASKT
#undef MLOAD
#undef SEAM_K0
#undef HALF_STEP
}
#undef ROW
#undef VMW
#undef VMWN
#undef SLOAD_H
#undef SWRITE_HK
#undef SWRITE_HV
#undef SWRITE_H
#undef SLOAD_F
#undef SWRITE_KF
#undef SWRITE_VF
}
#ifndef TSPROBE
#define TSPROBE 0
#endif
#ifndef TSQ
#define TSQ 32.f
#endif
#ifndef PROBE
#define PROBE 0
#endif
constexpr int NWAVES = 8;
constexpr int NB = 2, T = 8192, M = NB * T, DM = 1024, FF = 2816, NIN = 8520, NLAYER = 2;
constexpr float NORM_EPS = 1e-6f;
constexpr size_t MiB = 1u << 20;
constexpr size_t WS_CTL = 0, CTL_ZERO_BYTES = 1 * MiB;
constexpr size_t WS_WF = 1 * MiB;
constexpr size_t WS_WF_DOWN = WS_WF + 11 * MiB;
constexpr size_t WS_WM = 18 * MiB;
constexpr size_t WS_WM_BR = WS_WM + 17 * MiB, WS_WM_OUT = WS_WM + 20 * MiB;
constexpr size_t WS_XN = 40 * MiB;
constexpr size_t WS_Q3 = 72 * MiB;
constexpr size_t WS_ZR = 120 * MiB;
constexpr size_t WS_R2 = 248 * MiB;
constexpr size_t WS_END = 280 * MiB;
constexpr size_t WS_MG = WS_ZR + 96 * MiB;
constexpr size_t WS_YRAW = WS_WF;
constexpr size_t WS_A8 = WS_WM;
constexpr size_t WS_KID = WS_WM + 8 * MiB;
constexpr size_t WS_RDOTK = WS_WF + 16 * MiB;
constexpr int QP = 1536, ZP = 4096;
constexpr int ZC_DK = 0, ZC_DV = 512, ZC_QI = 1024, ZC_KI = 1536, ZC_WI = 1600, ZC_RK = 1792, ZC_RV = 2304, ZC_WC = 2816, ZC_AC = 2880, ZC_GC = 2944, ZC_FK = 3072, ZC_FV = 3584;
constexpr int CW_TMO = 0;
constexpr int CW_BAR = 4096;
constexpr int CW_Q = 8192;
constexpr int CW_CQ = 8576;
constexpr int CW_PROBE = 2048;
constexpr int CW_DONE = 12288;
constexpr int LDS_MISC = 160 * 1024 - 256;
constexpr int LDS_BYTES = 160 * 1024;

#define GAS __attribute__((address_space(1)))
#define LAS __attribute__((address_space(3)))
typedef unsigned short bf16;
typedef unsigned v4u __attribute__((ext_vector_type(4)));
typedef unsigned v2u __attribute__((ext_vector_type(2)));
typedef float f32x4 __attribute__((ext_vector_type(4)));
typedef float f32x2 __attribute__((ext_vector_type(2)));
typedef float f32x16 __attribute__((ext_vector_type(16)));
typedef short bf16x8 __attribute__((ext_vector_type(8)));
typedef GAS unsigned gu32;
#define RLX_AGENT __ATOMIC_RELAXED, __HIP_MEMORY_SCOPE_AGENT
#define LDS_WAIT() asm volatile("s_waitcnt lgkmcnt(0)" ::: "memory")
#define VM_WAIT() asm volatile("s_waitcnt vmcnt(0)" ::: "memory")
__device__ __forceinline__ unsigned f2bf(float f) { unsigned u = __builtin_bit_cast(unsigned, f); return (u + 0x7fffu + ((u >> 16) & 1u)) >> 16; }
__device__ __forceinline__ unsigned pk2(float lo, float hi) { return f2bf(lo) | (f2bf(hi) << 16); }
__device__ __forceinline__ float bflo(unsigned w) { return __uint_as_float(w << 16); }
__device__ __forceinline__ float bfhi(unsigned w) { return __uint_as_float(w & 0xffff0000u); }
__device__ __forceinline__ float bf1(bf16 h) { return __uint_as_float((unsigned)h << 16); }
__device__ __forceinline__ float wave_sum(float v) {
#pragma unroll
    for (int o = 1; o < 64; o <<= 1) v += __shfl_xor(v, o);
    return v;
}
__device__ __forceinline__ float sigm(float x) { return __builtin_amdgcn_rcpf(1.0f + __expf(-x)); }

#define XB_TMO      128
#define XB_XCNT(j)  (256  + 64 * (j))
#define XB_XSUB(j)  (1280 + 64 * (j))
#define XB_XGEN(j)  (2304 + 64 * (j))
#define XB_TOP      3328
#define XB_TOPGEN   3392
#define XCD_BAR_WORDS 3456
#define XB_SPIN_CAP (1u << 22)
__device__ __forceinline__ unsigned xb_ld(unsigned* p)              { return __hip_atomic_load(p, __ATOMIC_RELAXED, __HIP_MEMORY_SCOPE_AGENT); }
__device__ __forceinline__ unsigned xb_add(unsigned* p, unsigned v) { return __hip_atomic_fetch_add(p, v, __ATOMIC_RELAXED, __HIP_MEMORY_SCOPE_AGENT); }
__device__ __forceinline__ unsigned xb_xcc_id() { return (unsigned)__builtin_amdgcn_s_getreg((3 << 11) | 20) & 0xFu; }
#define XB_SPIN(cond, bar) do { unsigned _sp = 0; while (cond) { __builtin_amdgcn_s_sleep(1); \
    if ((++_sp & 255u) == 0u) { if (xb_ld(&(bar)[XB_TMO])) break; if (_sp > XB_SPIN_CAP) { atomicAdd(&(bar)[XB_TMO], 1u); break; } } } } while (0)
struct XcdBarrier { unsigned* bar; unsigned x; volatile LAS unsigned* st; };
__device__ __forceinline__ XcdBarrier xcd_barrier_post(unsigned* bar, volatile LAS unsigned* st) {
    XcdBarrier b; b.bar = bar; b.x = xb_xcc_id(); b.st = st;
    if (threadIdx.x == 0) (void)xb_add(&bar[XB_XCNT(b.x)], 1u);
    return b;
}
__device__ __forceinline__ void xcd_barrier_complete(unsigned* bar, unsigned x, unsigned& nloc, unsigned& nx) {
    const unsigned G = gridDim.x * gridDim.y * gridDim.z;
    unsigned sum, cnt, mine, sp = 0u;
    for (;;) {
        sum = 0u; cnt = 0u; mine = 0u;
#pragma unroll
        for (unsigned j = 0; j < 16; ++j) { const unsigned c = xb_ld(&bar[XB_XCNT(j)]); sum += c; cnt += (c > 0u) ? 1u : 0u; mine = (j == x) ? c : mine; }
        if (sum == G) break;
        __builtin_amdgcn_s_sleep(1);
        if ((++sp & 255u) == 0u) { if (xb_ld(&bar[XB_TMO])) break; if (sp > XB_SPIN_CAP) { atomicAdd(&bar[XB_TMO], 1u); break; } }
    }
    nloc = mine > 0u ? mine : 1u; nx = cnt > 0u ? cnt : 1u;
}
__device__ __forceinline__ void xcd_barrier(const XcdBarrier& b) {
    asm volatile("s_waitcnt vmcnt(0)" ::: "memory");
    __syncthreads();
    if (threadIdx.x == 0) {
        unsigned* bar = b.bar;
        __builtin_amdgcn_s_waitcnt(0);
        unsigned nloc = b.st[0], nx = b.st[1];
        if (nloc == 0u) { xcd_barrier_complete(bar, b.x, nloc, nx); b.st[0] = nloc; b.st[1] = nx; }
        const unsigned old = xb_add(&bar[XB_XSUB(b.x)], 1u);
        const unsigned gen = old / nloc;
        if (old + 1u == (gen + 1u) * nloc) {
            __builtin_amdgcn_fence(__ATOMIC_RELEASE, "agent");
            asm volatile("s_waitcnt vmcnt(0)" ::: "memory");
            const unsigned og = xb_add(&bar[XB_TOP], 1u);
            const unsigned tg = og / nx;
            if (og + 1u == (tg + 1u) * nx) xb_add(&bar[XB_TOPGEN], 1u);
            else XB_SPIN(xb_ld(&bar[XB_TOPGEN]) == tg, bar);
            __builtin_amdgcn_fence(__ATOMIC_ACQUIRE, "agent");
            xb_add(&bar[XB_XGEN(b.x)], 1u);
            asm volatile("s_waitcnt vmcnt(0)" ::: "memory");
        } else {
            XB_SPIN(xb_ld(&bar[XB_XGEN(b.x)]) == gen, bar);
            __builtin_amdgcn_fence(__ATOMIC_ACQUIRE, "agent");
            asm volatile("s_waitcnt vmcnt(0)" ::: "memory");
        }
    }
    __syncthreads();
}

struct MapIdent { const float* W; int ld; __device__ __forceinline__ const float* col(int n) const { return W + n; } };
struct MapUp {
    const float* G; const float* U; int ld;
    __device__ __forceinline__ const float* col(int n) const { const int g = n >> 5, j = n & 31; return j < 16 ? G + 16 * g + j : U + 16 * g + (j - 16); }
};
struct MapWin {
    const float* W; int ld;
    __device__ __forceinline__ const float* col(int n) const {
        int src;
        if (n < 512) src = n; else if (n < 1024) src = 2120 + (n - 512); else if (n < 1536) src = 3912 + (n - 1024);
        else if (n < 5632) { const int z = n - 1536; if (z < 1608) src = 512 + z; else if (z < 1792) src = -1; else if (z < 3072) src = 840 + z; else src = 1352 + z; }
        else src = 5448 + (n - 5632);
        return src < 0 ? nullptr : W + src;
    }
};
struct ConvDesc { const float* cp; size_t ld; bf16* dst; int K; };
template <class Map>
__device__ __forceinline__ ConvDesc conv_desc(const Map& mp, int K, bf16* WT, int item, int nblk, int lane) {
    const int kb = item / nblk, nb = item % nblk, k0 = 32 * kb, n0 = 32 * nb;
    const float* cp = mp.col(n0 + (lane & 31)); const size_t ld = (size_t)mp.ld;
    return ConvDesc{cp ? cp + (size_t)(k0 + (lane >> 5)) * ld : nullptr, ld, WT + (size_t)n0 * K + k0, K};
}
__device__ __forceinline__ void conv_load(const ConvDesc& d, float (&v)[16]) {
#pragma unroll
    for (int i = 0; i < 16; ++i) v[i] = d.cp ? d.cp[(size_t)(2 * i) * d.ld] : 0.f;
}
__device__ __forceinline__ void conv_store(const ConvDesc& d, const float (&v)[16], LAS float* scr, int lane) {
#pragma unroll
    for (int i = 0; i < 16; ++i) scr[(2 * i + (lane >> 5)) * 33 + (lane & 31)] = v[i];
    LDS_WAIT(); asm volatile("" ::: "memory");
    const int c = lane & 3;
#pragma unroll
    for (int j = 0; j < 2; ++j) { const int n = (lane >> 2) + 16 * j; const LAS float* s = scr + (8 * c) * 33 + n;
        v4u o; o.x = pg8::cvt_pk_bf16(s[0 * 33], s[1 * 33]); o.y = pg8::cvt_pk_bf16(s[2 * 33], s[3 * 33]); o.z = pg8::cvt_pk_bf16(s[4 * 33], s[5 * 33]); o.w = pg8::cvt_pk_bf16(s[6 * 33], s[7 * 33]);
        *(GAS v4u*)(d.dst + (size_t)n * d.K + 8 * c) = o; }
    LDS_WAIT(); asm volatile("" ::: "memory");
}
template <class D>
__device__ __forceinline__ void conv_batch(D desc, int n, LAS float* scr, int gw_, int ngw_, int lane) {
    constexpr int Q = 1;
    for (int it = gw_; it < n; it += Q * ngw_) {
        ConvDesc d[Q]; float v[Q][16];
#pragma unroll
        for (int q = 0; q < Q; ++q) if (it + q * ngw_ < n) { d[q] = desc(it + q * ngw_); conv_load(d[q], v[q]); }
#pragma unroll
        for (int q = 0; q < Q; ++q) if (it + q * ngw_ < n) conv_store(d[q], v[q], scr, lane);
    }
}
template <class D>
__device__ __forceinline__ void conv_queue(D desc, int n, LAS float* scr, gu32* head, int lane) {
    constexpr int CH = 4;
    for (;;) {
        unsigned b0 = 0u; if (lane == 0) b0 = __hip_atomic_fetch_add(head, (unsigned)CH, RLX_AGENT);
        const int base = (int)__builtin_amdgcn_readfirstlane(b0);
        if (base >= n) break;
#pragma unroll 1
        for (int j = 0; j < CH; ++j) { const int it = base + j; if (it < n) { const ConvDesc d = desc(it); float v[16]; conv_load(d, v); conv_store(d, v, scr, lane); } }
    }
}
__host__ __device__ constexpr int conv_items(int K, int N) { return (K / 32) * (N / 32); }

template <bool INB, bool OUTB>
__device__ __forceinline__ void rownorm_rows(const void* base, const bf16* Y, float s, const float* gpost, void* out, const float* gnext, bf16* XN, int gw, int NGW, int lane, float oscale = 1.f) {
    constexpr int R = INB ? 8 : 4;
    for (int m0 = gw; m0 < M; m0 += R * NGW) {
        v2u xb[R][4], yw[R][4]; f32x4 xf[R][4];
#pragma unroll
        for (int q = 0; q < R; ++q) { const size_t m = (size_t)(m0 + q * NGW);
#pragma unroll
            for (int j = 0; j < 4; ++j) {
                if constexpr (INB) xb[q][j] = ((const GAS v2u*)((const bf16*)base + m * DM))[lane + 64 * j];
                else xf[q][j] = ((const GAS f32x4*)((const float*)base + m * DM))[lane + 64 * j];
                if (Y) yw[q][j] = ((const GAS v2u*)(Y + m * DM))[lane + 64 * j]; } }
#pragma unroll
        for (int q = 0; q < R; ++q) { const size_t m = (size_t)(m0 + q * NGW);
            f32x4 v[4];
#pragma unroll
            for (int j = 0; j < 4; ++j) { if constexpr (INB) v[j] = (f32x4){bflo(xb[q][j].x), bfhi(xb[q][j].x), bflo(xb[q][j].y), bfhi(xb[q][j].y)}; else v[j] = xf[q][j]; }
            if (Y) {
                f32x4 y[4]; float ss = 0.f;
#pragma unroll
                for (int j = 0; j < 4; ++j) { const v2u w = yw[q][j]; y[j] = (f32x4){bflo(w.x), bfhi(w.x), bflo(w.y), bfhi(w.y)};
                    ss += (y[j].x * y[j].x + y[j].y * y[j].y) + (y[j].z * y[j].z + y[j].w * y[j].w); }
                const float r = s * __builtin_amdgcn_rsqf(wave_sum(ss) * (1.f / DM) + NORM_EPS);
#pragma unroll
                for (int j = 0; j < 4; ++j) { const f32x4 g = ((const GAS f32x4*)gpost)[lane + 64 * j]; v[j] = v[j] + y[j] * g * r;
                    if constexpr (OUTB) { v2u w; w.x = pk2(v[j].x, v[j].y); w.y = pk2(v[j].z, v[j].w); ((GAS v2u*)((bf16*)out + m * DM))[lane + 64 * j] = w; }
                    else ((GAS f32x4*)((float*)out + m * DM))[lane + 64 * j] = v[j] * oscale; }
            }
            if (XN) {
                float ss = 0.f;
#pragma unroll
                for (int j = 0; j < 4; ++j) ss += (v[j].x * v[j].x + v[j].y * v[j].y) + (v[j].z * v[j].z + v[j].w * v[j].w);
                const float r = __builtin_amdgcn_rsqf(wave_sum(ss) * (1.f / DM) + NORM_EPS);
#pragma unroll
                for (int j = 0; j < 4; ++j) { const f32x4 g = ((const GAS f32x4*)gnext)[lane + 64 * j]; const f32x4 o = v[j] * g * r;
                    v2u w; w.x = pk2(o.x, o.y); w.y = pk2(o.z, o.w); ((GAS v2u*)(XN + m * DM))[lane + 64 * j] = w; }
            }
        }
    }
}

namespace scan {
template <int CTRL> __device__ __forceinline__ float dpp_add(float x) {
    const int y = __builtin_amdgcn_update_dpp(0, __builtin_bit_cast(int, x), CTRL, 0xF, 0xF, false);
    return x + __builtin_bit_cast(float, y);
}
__device__ __forceinline__ float red8(float x) { x = dpp_add<0xB1>(x); x = dpp_add<0x4E>(x); x = dpp_add<0x141>(x); return x; }
__device__ __forceinline__ float red16(float x) { x = dpp_add<0xB1>(x); x = dpp_add<0x4E>(x); x = dpp_add<0x141>(x); x = dpp_add<0x140>(x); return x; }
__device__ __forceinline__ float prefix8tok(float x, int lane) {
    const bool half = (lane >> 3) & 1; const int row = lane >> 4;
    const float t1 = __builtin_bit_cast(float, __builtin_amdgcn_update_dpp(0x3f800000, __builtin_bit_cast(int, x), 0x118  , 0xF, 0xF, false));
    float P = x * t1;
    const float o1 = __builtin_bit_cast(float, __builtin_amdgcn_update_dpp(0, __builtin_bit_cast(int, P), 0x128  , 0xF, 0xF, false));
    const float R = half ? P : o1;
    { auto r16 = __builtin_amdgcn_permlane16_swap(__float_as_uint(R), __float_as_uint(R), false, false);
      const float m = (row & 1) ? __uint_as_float(r16[0]) : 1.f; P *= m; }
    const float o2 = __builtin_bit_cast(float, __builtin_amdgcn_update_dpp(0, __builtin_bit_cast(int, P), 0x128, 0xF, 0xF, false));
    const float T = half ? P : o2;
    { auto q16 = __builtin_amdgcn_permlane16_swap(__float_as_uint(T), __float_as_uint(T), false, false);
      auto r32 = __builtin_amdgcn_permlane32_swap(q16[1], q16[1], false, false);
      const float m = (row >= 2) ? __uint_as_float(r32[0]) : 1.f; P *= m; }
    return P;
}
__device__ __forceinline__ void ld8(const bf16* p, float (&o)[8]) { const v4u w = *(const GAS v4u*)p; o[0] = bflo(w.x); o[1] = bfhi(w.x); o[2] = bflo(w.y); o[3] = bfhi(w.y); o[4] = bflo(w.z); o[5] = bfhi(w.z); o[6] = bflo(w.w); o[7] = bfhi(w.w); }
}
struct PrepP { const bf16* ZR; bf16* X1; unsigned char* A8; bf16* KI; const float *mu, *w0, *wup, *a0, *aup; };
__device__ __forceinline__ void rwkv_prep(const PrepP& P, LAS unsigned char* lds) {
    const int tid = otid_(), lane = tid & 63, h = __builtin_amdgcn_readfirstlane(tid >> 6), c16 = lane & 15, quad = lane >> 4;
    constexpr int SP = 144;
    LAS unsigned char* TA = lds; LAS unsigned char* AA = lds + 64 * SP;
    bf16x8 bw[4][2], ba[4][2];
#pragma unroll
    for (int ct = 0; ct < 4; ++ct)
#pragma unroll
        for (int s = 0; s < 2; ++s) { const size_t o = (size_t)(32 * s + 8 * quad) * 512 + 64 * h + 16 * ct + c16; const float* gw_ = P.wup + o; const float* ga_ = P.aup + o;
            v4u w; w.x = pk2(gw_[0], gw_[512]); w.y = pk2(gw_[1024], gw_[1536]); w.z = pk2(gw_[2048], gw_[2560]); w.w = pk2(gw_[3072], gw_[3584]); bw[ct][s] = __builtin_bit_cast(bf16x8, w);
            v4u a; a.x = pk2(ga_[0], ga_[512]); a.y = pk2(ga_[1024], ga_[1536]); a.z = pk2(ga_[2048], ga_[2560]); a.w = pk2(ga_[3072], ga_[3584]); ba[ct][s] = __builtin_bit_cast(bf16x8, a); }
    float w0v[4], a0v[4];
#pragma unroll
    for (int ct = 0; ct < 4; ++ct) { w0v[ct] = P.w0[64 * h + 16 * ct + c16]; a0v[ct] = P.a0[64 * h + 16 * ct + c16]; }
    const int stok = tid >> 3, sseg = tid & 7;
#pragma unroll 1
    for (int m0 = blockIdx.x * 64; m0 < M; m0 += gridDim.x * 64) {
        {   const size_t m = (size_t)m0 + stok; const int t = (int)(m & (T - 1));
            *(GAS v4u*)(P.KI + m * 64 + 8 * sseg) = *(const GAS v4u*)(P.ZR + m * ZP + ZC_KI + 8 * sseg);
            float wc[8], ac[8], p8[8];
            scan::ld8(P.ZR + m * ZP + ZC_WC + 8 * sseg, wc); scan::ld8(P.ZR + m * ZP + ZC_AC + 8 * sseg, ac);
            if (t > 0) { scan::ld8(P.ZR + (m - 1) * ZP + ZC_WC + 8 * sseg, p8);
#pragma unroll
                for (int e = 0; e < 8; ++e) wc[e] += (p8[e] - wc[e]) * P.mu[1536 + 8 * sseg + e];
                scan::ld8(P.ZR + (m - 1) * ZP + ZC_AC + 8 * sseg, p8);
#pragma unroll
                for (int e = 0; e < 8; ++e) ac[e] += (p8[e] - ac[e]) * P.mu[1600 + 8 * sseg + e]; }
            else {
#pragma unroll
                for (int e = 0; e < 8; ++e) { wc[e] -= wc[e] * P.mu[1536 + 8 * sseg + e]; ac[e] -= ac[e] * P.mu[1600 + 8 * sseg + e]; } }
            float th[8];
#pragma unroll
            for (int e = 0; e < 8; ++e) th[e] = 1.f - 2.f * __builtin_amdgcn_rcpf(__expf(2.f * wc[e]) + 1.f);
            v4u o; o.x = pk2(th[0], th[1]); o.y = pk2(th[2], th[3]); o.z = pk2(th[4], th[5]); o.w = pk2(th[6], th[7]); *(LAS v4u*)(TA + stok * SP + 16 * sseg) = o;
            v4u q; q.x = pk2(ac[0], ac[1]); q.y = pk2(ac[2], ac[3]); q.z = pk2(ac[4], ac[5]); q.w = pk2(ac[6], ac[7]); *(LAS v4u*)(AA + stok * SP + 16 * sseg) = q;
        }
        __syncthreads();
#pragma unroll 1
        for (int rt = 0; rt < 4; ++rt) {
            f32x4 accw[4], acca[4];
#pragma unroll
            for (int ct = 0; ct < 4; ++ct) { accw[ct] = (f32x4){0.f, 0.f, 0.f, 0.f}; acca[ct] = (f32x4){0.f, 0.f, 0.f, 0.f}; }
#pragma unroll
            for (int s = 0; s < 2; ++s) { const bf16x8 fw = *(const LAS bf16x8*)(TA + (16 * rt + c16) * SP + (32 * s + 8 * quad) * 2), fa = *(const LAS bf16x8*)(AA + (16 * rt + c16) * SP + (32 * s + 8 * quad) * 2);
#pragma unroll
                for (int ct = 0; ct < 4; ++ct) { accw[ct] = __builtin_amdgcn_mfma_f32_16x16x32_bf16(fw, bw[ct][s], accw[ct], 0, 0, 0); acca[ct] = __builtin_amdgcn_mfma_f32_16x16x32_bf16(fa, ba[ct][s], acca[ct], 0, 0, 0); } }
#pragma unroll
            for (int j = 0; j < 4; ++j) { const size_t m = (size_t)m0 + 16 * rt + 4 * quad + j;
#pragma unroll
                for (int ct = 0; ct < 4; ++ct) { const int ch = 64 * h + 16 * ct + c16;
                    const float sg = sigm(w0v[ct] + accw[ct][j]);
                    const float x1 = 1.f - __expf(-0.6065306597126334f * sg);
                    const float a = sigm(a0v[ct] + acca[ct][j]);
                    P.X1[m * 512 + ch] = (bf16)f2bf(x1);
                    P.A8[m * 512 + ch] = (unsigned char)(int)(a * 255.f + 0.5f); } }
        }
        __syncthreads();
    }
}

struct ScanP { const bf16* Q3; const bf16* ZR; const bf16* X1; const unsigned char* A8; bf16* yraw; float* rdotk; const float *mu, *k_k, *k_a, *r_k; };
namespace scan {
constexpr int TB = 32, NBLK = T / TB;
constexpr int CB_W = 0, CB_B = 8192, CB_K = 16384, CB_KW = 24576, CB_V = 40960, CB_BR = 43008, CB_KR = 43136, CB_SA = 43264, CB_YP = 45312, CBSZ = 78080;
constexpr int L_END = 2 * CBSZ;
static_assert(L_END <= LDS_MISC, "scan LDS");
}
__device__ __forceinline__ void rwkv_scan_unit(const ScanP& P, int unit, LAS unsigned char* lds) {
    using namespace scan;
    const int tid = otid_(), wid = __builtin_amdgcn_readfirstlane(tid >> 6), lane = tid & 63;
    const int b = unit >> 5, h = (unit >> 2) & 7, vq = unit & 3;
    const size_t mrow0 = (size_t)b * T;
    if (wid >= 4) {
        const int pw = wid - 4, tokl = lane >> 3, seg = lane & 7, c0 = 8 * seg, hc0 = 64 * h + c0;
        float mu_r[8], mu_k[8], kkv[8], kav[8], rkv[8];
#pragma unroll
        for (int e = 0; e < 8; ++e) { mu_r[e] = P.mu[hc0 + e]; mu_k[e] = P.mu[512 + hc0 + e]; kkv[e] = P.k_k[hc0 + e]; kav[e] = P.k_a[hc0 + e]; rkv[e] = P.r_k[hc0 + e]; }
        const int vc0 = 64 * h + 16 * vq + 2 * seg;
        const float mu_v0 = P.mu[1024 + vc0], mu_v1 = P.mu[1024 + vc0 + 1];
        const int ptid = pw * 64 + lane;
        v4u nr, nrp, nk, nkp, nx; v2u na; unsigned nv, nvp;
#define SCAN_LOAD(nb_) do { const int t_ = (nb_) * TB + 8 * pw + tokl; const size_t m_ = mrow0 + t_, mp_ = t_ > 0 ? m_ - 1 : m_; \
            nr = *(const GAS v4u*)(P.Q3 + m_ * QP + 512 + hc0); nrp = *(const GAS v4u*)(P.Q3 + mp_ * QP + 512 + hc0); \
            nk = *(const GAS v4u*)(P.ZR + m_ * ZP + ZC_RK + hc0); nkp = *(const GAS v4u*)(P.ZR + mp_ * ZP + ZC_RK + hc0); \
            nx = *(const GAS v4u*)(P.X1 + m_ * 512 + hc0); na = *(const GAS v2u*)(P.A8 + m_ * 512 + hc0); \
            nv = *(const GAS unsigned*)(P.ZR + m_ * ZP + ZC_RV + vc0); nvp = *(const GAS unsigned*)(P.ZR + mp_ * ZP + ZC_RV + vc0); } while (0)
#define UNPK8(w_, o_) do { o_[0] = bflo(w_.x); o_[1] = bfhi(w_.x); o_[2] = bflo(w_.y); o_[3] = bfhi(w_.y); o_[4] = bflo(w_.z); o_[5] = bfhi(w_.z); o_[6] = bflo(w_.w); o_[7] = bfhi(w_.w); } while (0)
        SCAN_LOAD(0);
        for (int blk = -1; blk < NBLK; ++blk) {
            const int nb = blk + 1;
            LAS unsigned char* cb = lds + (nb & 1) * CBSZ;
            if (blk >= 1) {
                const int tok = ptid >> 3, v2 = (ptid & 7) * 2;
                const LAS float* YPp = (const LAS float*)(cb + CB_YP) + (tok * 16 + v2) * 16;
                float y0 = 0.f, y1 = 0.f;
#pragma unroll
                for (int q4 = 0; q4 < 4; ++q4) { const f32x4 a = *(const LAS f32x4*)(YPp + 4 * q4), c = *(const LAS f32x4*)(YPp + 16 + 4 * q4); y0 += (a.x + a.y) + (a.z + a.w); y1 += (c.x + c.y) + (c.z + c.w); }
                const float kr = *(const LAS float*)(cb + CB_KR + tok * 4);
                const f32x2 vv = *(const LAS f32x2*)(cb + CB_V + (tok * 16 + v2) * 4);
                y0 += vv.x * kr; y1 += vv.y * kr;
                const size_t m = mrow0 + (size_t)(blk - 1) * TB + tok;
                *(GAS unsigned*)(P.yraw + m * 512 + 64 * h + 16 * vq + v2) = pk2(y0, y1);
                LDS_WAIT(); asm volatile("" ::: "memory");
            }
            if (nb < NBLK) {
                const int t = nb * TB + 8 * pw + tokl; const size_t m = mrow0 + t;
                float r8[8], k8[8], p8[8], x8[8], a8[8];
                const v4u cr = nr, crp = nrp, ck = nk, ckp = nkp, cx = nx; const v2u ca = na; const unsigned cv = nv, cvp = nvp;
                if (nb + 1 < NBLK) SCAN_LOAD(nb + 1);
                UNPK8(cr, r8); UNPK8(ck, k8); UNPK8(cx, x8);
                { const float sc = 1.f / 255.f;
                  a8[0] = (float)(ca.x & 255u) * sc; a8[1] = (float)((ca.x >> 8) & 255u) * sc; a8[2] = (float)((ca.x >> 16) & 255u) * sc; a8[3] = (float)(ca.x >> 24) * sc;
                  a8[4] = (float)(ca.y & 255u) * sc; a8[5] = (float)((ca.y >> 8) & 255u) * sc; a8[6] = (float)((ca.y >> 16) & 255u) * sc; a8[7] = (float)(ca.y >> 24) * sc; }
                float v0 = bflo(cv), v1 = bfhi(cv);
                if (t > 0) {
                    UNPK8(crp, p8);
#pragma unroll
                    for (int e = 0; e < 8; ++e) r8[e] += (p8[e] - r8[e]) * mu_r[e];
                    UNPK8(ckp, p8);
#pragma unroll
                    for (int e = 0; e < 8; ++e) k8[e] += (p8[e] - k8[e]) * mu_k[e];
                    v0 += (bflo(cvp) - v0) * mu_v0; v1 += (bfhi(cvp) - v1) * mu_v1;
                } else {
#pragma unroll
                    for (int e = 0; e < 8; ++e) { r8[e] -= r8[e] * mu_r[e]; k8[e] -= k8[e] * mu_k[e]; }
                    v0 -= v0 * mu_v0; v1 -= v1 * mu_v1;
                }
                float kk8[8]; { float ss = 0.f;
#pragma unroll
                  for (int e = 0; e < 8; ++e) { kk8[e] = k8[e] * kkv[e]; ss += kk8[e] * kk8[e]; }
                  ss = red8(ss); const float inv = 1.f / fmaxf(sqrtf(ss), 1e-12f);
#pragma unroll
                  for (int e = 0; e < 8; ++e) kk8[e] *= inv; }
                float w8[8], bb[8], km[8], wr[8]; float brp = 0.f, krp = 0.f, rkp = 0.f;
#pragma unroll
                for (int e = 0; e < 8; ++e) {
                    bb[e] = kk8[e] * a8[e]; km[e] = k8[e] * (1.f + (a8[e] - 1.f) * kav[e]);
                    brp += bb[e] * r8[e]; krp += km[e] * r8[e]; rkp += r8[e] * km[e] * rkv[e];
                }
                brp = red8(brp); krp = red8(krp); rkp = red8(rkp);
#pragma unroll
                for (int e = 0; e < 8; ++e) {
                    const float wd = 1.f - x8[e], wc = prefix8tok(wd, lane), iwc = __builtin_amdgcn_rcpf(wc), wp = wc * __builtin_amdgcn_rcpf(wd);
                    w8[e] = wc; kk8[e] *= wp; bb[e] *= iwc; km[e] *= iwc; wr[e] = wc * r8[e] - kk8[e] * brp;
                }
                const int ti = 8 * pw + tokl;
                if (tokl == 7) { *(LAS f32x4*)(cb + CB_W + (pw * 64 + c0) * 4) = (f32x4){w8[0], w8[1], w8[2], w8[3]}; *(LAS f32x4*)(cb + CB_W + (pw * 64 + c0 + 4) * 4) = (f32x4){w8[4], w8[5], w8[6], w8[7]}; }
                *(LAS f32x4*)(cb + CB_B + (ti * 64 + c0) * 4) = (f32x4){bb[0], bb[1], bb[2], bb[3]}; *(LAS f32x4*)(cb + CB_B + (ti * 64 + c0 + 4) * 4) = (f32x4){bb[4], bb[5], bb[6], bb[7]};
                *(LAS f32x4*)(cb + CB_K + (ti * 64 + c0) * 4) = (f32x4){km[0], km[1], km[2], km[3]}; *(LAS f32x4*)(cb + CB_K + (ti * 64 + c0 + 4) * 4) = (f32x4){km[4], km[5], km[6], km[7]};
#pragma unroll
                for (int e = 0; e < 8; e += 2) *(LAS f32x4*)(cb + CB_KW + ti * 512 + ((e >> 1) & 1) * 256 + (2 * seg + (e >> 2)) * 16) = (f32x4){kk8[e], wr[e], kk8[e + 1], wr[e + 1]};
                *(LAS f32x2*)(cb + CB_V + (ti * 16 + 2 * seg) * 4) = (f32x2){v0, v1};
                if (seg == 0) { *(LAS float*)(cb + CB_KR + ti * 4) = krp; if (vq == 0) P.rdotk[m * 8 + h] = rkp; }
            }
            __syncthreads();
        }
        { const LAS unsigned char* cb = lds + ((NBLK - 1) & 1) * CBSZ;
          const int tok = ptid >> 3, v2 = (ptid & 7) * 2;
          const LAS float* YPp = (const LAS float*)(cb + CB_YP) + (tok * 16 + v2) * 16;
          float y0 = 0.f, y1 = 0.f;
#pragma unroll
          for (int q4 = 0; q4 < 4; ++q4) { const f32x4 a = *(const LAS f32x4*)(YPp + 4 * q4), c = *(const LAS f32x4*)(YPp + 16 + 4 * q4); y0 += (a.x + a.y) + (a.z + a.w); y1 += (c.x + c.y) + (c.z + c.w); }
          const float kr = *(const LAS float*)(cb + CB_KR + tok * 4);
          const f32x2 vv = *(const LAS f32x2*)(cb + CB_V + (tok * 16 + v2) * 4);
          y0 += vv.x * kr; y1 += vv.y * kr;
          const size_t m = mrow0 + (size_t)(NBLK - 1) * TB + tok;
          *(GAS unsigned*)(P.yraw + m * 512 + 64 * h + 16 * vq + v2) = pk2(y0, y1); }
    } else {
        const int vi = 4 * wid + (lane >> 4), cg = lane & 15;
        f32x2 s01 = {0.f, 0.f}, s23 = {0.f, 0.f};
        __syncthreads();
        __builtin_amdgcn_s_setprio(3);
        const unsigned lo4 = (unsigned)(4 * cg) * 4u;
        for (int blk = 0; blk < NBLK; ++blk) {
            const LAS unsigned char* cb = lds + (blk & 1) * CBSZ;
            f32x4 kwa = *(const LAS f32x4*)(cb + CB_KW + lo4), kwb = *(const LAS f32x4*)(cb + CB_KW + 256 + lo4);
            f32x4 b4 = *(const LAS f32x4*)(cb + CB_B + lo4), k4 = *(const LAS f32x4*)(cb + CB_K + lo4), wg4 = {1.f, 1.f, 1.f, 1.f};
            float vv = *(const LAS float*)(cb + CB_V + vi * 4);
#pragma unroll 8
            for (int tok = 0; tok < TB; ++tok) {
                const int tn = tok + 1 < TB ? tok + 1 : tok;
                const f32x4 nkwa = *(const LAS f32x4*)(cb + CB_KW + tn * 512 + lo4), nkwb = *(const LAS f32x4*)(cb + CB_KW + tn * 512 + 256 + lo4);
                const f32x4 nb4 = *(const LAS f32x4*)(cb + CB_B + tn * 256 + lo4), nk4 = *(const LAS f32x4*)(cb + CB_K + tn * 256 + lo4);
                if ((tok & 7) == 0) wg4 = *(const LAS f32x4*)(cb + CB_W + (tok >> 3) * 256 + lo4);
                const float nvv = *(const LAS float*)(cb + CB_V + (tn * 16 + vi) * 4);
                f32x2 p = (f32x2){s01.x, s01.x} * (f32x2){kwa.x, kwa.y};
                p += (f32x2){s01.y, s01.y} * (f32x2){kwa.z, kwa.w};
                p += (f32x2){s23.x, s23.x} * (f32x2){kwb.x, kwb.y};
                p += (f32x2){s23.y, s23.y} * (f32x2){kwb.z, kwb.w};
                *(LAS float*)(cb + CB_YP + ((tok * 16 + vi) * 16 + cg) * 4) = p.y;
                const f32x2 t01 = s01 + (f32x2){k4.x, k4.y} * vv, t23 = s23 + (f32x2){k4.z, k4.w} * vv;
                const float d1 = red16(p.x);
                s01 = t01 - (f32x2){b4.x, b4.y} * d1; s23 = t23 - (f32x2){b4.z, b4.w} * d1;
                if ((tok & 7) == 7) { s01 *= (f32x2){wg4.x, wg4.y}; s23 *= (f32x2){wg4.z, wg4.w}; }
                kwa = nkwa; kwb = nkwb; b4 = nb4; k4 = nk4; vv = nvv;
            }
            __syncthreads();
        }
        __builtin_amdgcn_s_setprio(0);
    }
    __syncthreads();
}

struct Dsa1P { const bf16* ZR; const bf16* KI; unsigned* bitm; gu32* done; };
namespace dsa1 {
constexpr int CAP = 769  , PRUNE_AT = 512, PRUNE_LO = 400, KEEP = 256;
constexpr int L_BUF = 0, L_CNT = 32 * CAP * 4, L_THR = L_CNT + 128, L_THRK = L_THR + 128, L_HIST = ((L_THRK + 128 + 15) / 16) * 16, L_MROW = L_HIST + 8 * 1024, L_QF = L_MROW + 8 * 1024, QFP = 1040, L_END = L_QF + 32 * QFP;
static_assert(L_END <= LDS_MISC, "dsa1 LDS");
__device__ __forceinline__ unsigned packkey(float s, int keyidx) { const unsigned bits = __float_as_uint(s); const unsigned u = bits ^ ((unsigned)((int)bits >> 31) | 0x80000000u); return (u & 0xFFFFE000u) | (unsigned)(8191 - keyidx); }
__device__ __forceinline__ float thr_of(unsigned key) { const unsigned u = key & 0xFFFFE000u; const unsigned bits = (u & 0x80000000u) ? (u ^ 0x80000000u) : ~u; return __uint_as_float(bits); }
__device__ __forceinline__ int wave_prefix_incl(int v) {
    v += __builtin_amdgcn_update_dpp(0, v, 0x111, 0xF, 0xF, true);
    v += __builtin_amdgcn_update_dpp(0, v, 0x112, 0xF, 0xF, true);
    v += __builtin_amdgcn_update_dpp(0, v, 0x114, 0xF, 0xF, true);
    v += __builtin_amdgcn_update_dpp(0, v, 0x118, 0xF, 0xF, true);
    v += __builtin_amdgcn_update_dpp(0, v, 0x142, 0xA, 0xF, false);
    v += __builtin_amdgcn_update_dpp(0, v, 0x143, 0xC, 0xF, false);
    return v;
}
__device__ __forceinline__ void prune(LAS unsigned char* lds, int qq, int wid, int lane, bool exact) {
    asm volatile("" : "+v"(lane));
    LAS unsigned* buf = (LAS unsigned*)(lds + L_BUF) + qq * CAP; LAS unsigned* cnt = (LAS unsigned*)(lds + L_CNT); LAS float* thr = (LAS float*)(lds + L_THR); LAS unsigned* thrk = (LAS unsigned*)(lds + L_THRK);
    LAS unsigned* hist = (LAS unsigned*)(lds + L_HIST) + wid * 256;
    const int n = (int)cnt[qq];
    unsigned e[12];
#pragma unroll
    for (int k = 0; k < 12; ++k) e[k] = (lane + 64 * k < n) ? buf[lane + 64 * k] : 0u;
    const unsigned tk = thrk[qq];
    unsigned cut = 0u; bool have = false;
    if (!exact && tk != 0u) {
        const unsigned base16 = tk >> 16;
        *(LAS v4u*)(hist + 4 * lane) = (v4u){0u, 0u, 0u, 0u};
        LDS_WAIT(); asm volatile("" ::: "memory");
#pragma unroll
        for (int k = 0; k < 12; ++k) if (lane + 64 * k < n) { unsigned bn = (e[k] >> 16) - base16; bn = bn > 255u ? 255u : bn; (void)__hip_atomic_fetch_add(hist + bn, 1u, __ATOMIC_RELAXED, __HIP_MEMORY_SCOPE_WORKGROUP); }
        LDS_WAIT(); asm volatile("" ::: "memory");
        const int rl = 63 - lane;
        const v4u hv = *(const LAS v4u*)(hist + 4 * rl);
        const int tot = (int)(hv.x + hv.y + hv.z + hv.w);
        int above = wave_prefix_incl(tot) - tot; int dsel = -1, csel = 0;
        { const int h3 = (int)hv.w, h2 = (int)hv.z, h1 = (int)hv.y, h0 = (int)hv.x;
          if (above < KEEP && KEEP <= above + h3) { dsel = 4 * rl + 3; csel = above + h3; } above += h3;
          if (above < KEEP && KEEP <= above + h2) { dsel = 4 * rl + 2; csel = above + h2; } above += h2;
          if (above < KEEP && KEEP <= above + h1) { dsel = 4 * rl + 1; csel = above + h1; } above += h1;
          if (above < KEEP && KEEP <= above + h0) { dsel = 4 * rl + 0; csel = above + h0; } }
        const unsigned long long bm = __ballot(dsel >= 0);
        const int src = bm ? (int)__builtin_ctzll(bm) : 0;
        const int d = __builtin_amdgcn_readlane(dsel, src), cd = __builtin_amdgcn_readlane(csel, src);
        LDS_WAIT(); asm volatile("" ::: "memory");
        if (bm != 0ull && cd <= KEEP + 128) { cut = (base16 + (unsigned)d) << 16; have = true; }
    }
    if (!have) {
        unsigned prefix = 0u; int want = KEEP;
#pragma unroll 1
        for (int p = 0; p < 4; ++p) {
            const int shift = 24 - 8 * p;
            *(LAS v4u*)(hist + 4 * lane) = (v4u){0u, 0u, 0u, 0u};
            LDS_WAIT(); asm volatile("" ::: "memory");
#pragma unroll
            for (int k = 0; k < 12; ++k) { const bool in = (lane + 64 * k < n) && (p == 0 || (e[k] >> (shift + 8)) == (prefix >> (shift + 8)));
                if (in) (void)__hip_atomic_fetch_add(hist + ((e[k] >> shift) & 255u), 1u, __ATOMIC_RELAXED, __HIP_MEMORY_SCOPE_WORKGROUP); }
            LDS_WAIT(); asm volatile("" ::: "memory");
            const int rl = 63 - lane;
            const v4u hv = *(const LAS v4u*)(hist + 4 * rl);
            const int tot = (int)(hv.x + hv.y + hv.z + hv.w);
            int above = wave_prefix_incl(tot) - tot;
            int dsel = -1, asel = 0, hsel = 0;
            { const int h3 = (int)hv.w, h2 = (int)hv.z, h1 = (int)hv.y, h0 = (int)hv.x;
              if (above < want && want <= above + h3) { dsel = 4 * rl + 3; asel = above; hsel = h3; } above += h3;
              if (above < want && want <= above + h2) { dsel = 4 * rl + 2; asel = above; hsel = h2; } above += h2;
              if (above < want && want <= above + h1) { dsel = 4 * rl + 1; asel = above; hsel = h1; } above += h1;
              if (above < want && want <= above + h0) { dsel = 4 * rl + 0; asel = above; hsel = h0; } }
            const unsigned long long bm = __ballot(dsel >= 0);
            const int src = bm ? (int)__builtin_ctzll(bm) : 0;
            const int d = __builtin_amdgcn_readlane(dsel, src), ab = __builtin_amdgcn_readlane(asel, src), hd = __builtin_amdgcn_readlane(hsel, src);
            prefix |= ((unsigned)(d < 0 ? 0 : d)) << shift;
            LDS_WAIT(); asm volatile("" ::: "memory");
            if (!exact && bm != 0ull && (KEEP - want) + ab + hd <= KEEP + 128) break;
            want -= ab;
        }
        cut = prefix;
    }
    int base = 0;
#pragma unroll
    for (int k = 0; k < 12; ++k) { const bool keep = (lane + 64 * k < n) && e[k] >= cut; const unsigned long long mk = __ballot(keep);
        const int pos = base + (int)__builtin_amdgcn_mbcnt_hi((unsigned)(mk >> 32), __builtin_amdgcn_mbcnt_lo((unsigned)mk, 0u));
        if (keep) buf[pos] = e[k]; base += (int)__builtin_popcountll(mk); }
    if (lane == 0) { cnt[qq] = (unsigned)base; thr[qq] = thr_of(cut); thrk[qq] = cut; }
    LDS_WAIT(); asm volatile("" ::: "memory");
}
}
__device__ __forceinline__ void dsa1_unit_lists(const Dsa1P& P, int u, LAS unsigned char* lds) {
    using namespace dsa1;
    const int tid = otid_(), wid = __builtin_amdgcn_readfirstlane(tid >> 6), lane = tid & 63, q = lane & 31, hi = lane >> 5;
    const int b = u & 1, qb32 = 255 - (u >> 1), t0 = 32 * qb32;
    const size_t brow = (size_t)b * T;
    LAS unsigned* buf = (LAS unsigned*)(lds + L_BUF); LAS unsigned* cnt = (LAS unsigned*)(lds + L_CNT); LAS float* thr = (LAS float*)(lds + L_THR);
    if (tid < 32) { cnt[tid] = 0u; thr[tid] = -__builtin_inff(); ((LAS unsigned*)(lds + L_THRK))[tid] = 0u; }
    const bf16* qrow = P.ZR + (brow + t0 + q) * ZP;
    { const int r = tid >> 4, sg = tid & 15; const bf16* src = P.ZR + (brow + t0 + r) * ZP + ZC_QI + 32 * sg;
#pragma unroll
      for (int j = 0; j < 4; ++j) *(LAS v4u*)(lds + L_QF + r * QFP + 64 * sg + 16 * j) = *(const GAS v4u*)(src + 8 * j); }
    float wq[8];
    { const v4u w = *(const GAS v4u*)(qrow + ZC_WI); const float c = 0.35355339059327373f * 0.125f;
      wq[0] = bflo(w.x) * c; wq[1] = bfhi(w.x) * c; wq[2] = bflo(w.y) * c; wq[3] = bfhi(w.y) * c; wq[4] = bflo(w.z) * c; wq[5] = bfhi(w.z) * c; wq[6] = bflo(w.w) * c; wq[7] = bfhi(w.w) * c; }
    const int tq = t0 + q;
    const int nsteps = (t0 + 32 + 255) >> 8;
    __syncthreads();
    float th = -__builtin_inff();
    bf16x8 afn[4];
    { const int k0 = 32 * wid; const bf16* krow = P.KI + (brow + (k0 <= t0 + 31 ? k0 : 0) + q) * 64 + 8 * hi;
#pragma unroll
      for (int s = 0; s < 4; ++s) afn[s] = *(const GAS bf16x8*)(krow + 16 * s); }
    for (int st = 0; st < nsteps; ++st) {
        const int key0 = 256 * st + 32 * wid;
        bf16x8 af[4];
#pragma unroll
        for (int s = 0; s < 4; ++s) af[s] = afn[s];
        { const int k1 = key0 + 256; const bf16* krow = P.KI + (brow + (k1 <= t0 + 31 ? k1 : 0) + q) * 64 + 8 * hi;
#pragma unroll
          for (int s = 0; s < 4; ++s) afn[s] = *(const GAS bf16x8*)(krow + 16 * s); }
        if (key0 <= t0 + 31) {
            f32x16 sc;
#pragma unroll
            for (int i = 0; i < 16; ++i) sc[i] = 0.f;
            unsigned qfo = (unsigned)(L_QF + q * QFP + 16 * hi); asm volatile("" : "+v"(qfo));
#pragma unroll
            for (int hd = 0; hd < 8; ++hd) {
                f32x16 acc;
#pragma unroll
                for (int i = 0; i < 16; ++i) acc[i] = 0.f;
#pragma unroll
                for (int s = 0; s < 4; ++s) { const bf16x8 qb = *(const LAS bf16x8*)(lds + qfo + hd * 128 + 32 * s);
                    acc = __builtin_amdgcn_mfma_f32_32x32x16_bf16(af[s], qb, acc, 0, 0, 0); }
#pragma unroll
                for (int i = 0; i < 16; ++i) sc[i] = fmaf(__builtin_amdgcn_fmed3f(acc[i], 0.f, 3.0e38f), wq[hd], sc[i]);
                __builtin_amdgcn_sched_barrier(0);
            }
            const bool diag = key0 + 31 > t0;
            unsigned pm = 0u;
#pragma unroll
            for (int i = 0; i < 16; ++i) { const int kidx = key0 + (i & 3) + 8 * (i >> 2) + 4 * hi; const bool ok = (sc[i] >= th) && (!diag || kidx <= tq); pm |= ok ? (1u << i) : 0u; }
            const int np = __builtin_popcount(pm);
            if (np > 0) {
                int pos = (int)__hip_atomic_fetch_add(cnt + q, (unsigned)np, __ATOMIC_RELAXED, __HIP_MEMORY_SCOPE_WORKGROUP);
                LAS unsigned* bq = buf + q * CAP;
#pragma unroll
                for (int i = 0; i < 16; ++i) if (pm & (1u << i)) { const int kidx = key0 + (i & 3) + 8 * (i >> 2) + 4 * hi; bq[pos] = packkey(sc[i], kidx); ++pos; }
            }
        }
        __syncthreads();
        { const unsigned cq = cnt[q]; unsigned nm = (unsigned)__ballot(cq > (unsigned)PRUNE_AT); if (nm) nm = (unsigned)__ballot(cq > (unsigned)PRUNE_LO); int i = 0;
          while (nm) { const int qq = __builtin_ctz(nm); nm &= nm - 1u; if ((i & 7) == wid) prune(lds, qq, wid, lane, false); ++i; } }
        __syncthreads();
        th = thr[q];
    }
    LAS unsigned* mrow = (LAS unsigned*)(lds + L_MROW) + wid * 256;
#pragma unroll 1
    for (int k = 0; k < 4; ++k) {
        const int qq = wid + 8 * k;
        if (cnt[qq] > (unsigned)KEEP) prune(lds, qq, wid, lane, true);
        const int nf = (int)cnt[qq];
        *(LAS v4u*)(mrow + 4 * lane) = (v4u){0u, 0u, 0u, 0u};
        LDS_WAIT(); asm volatile("" ::: "memory");
#pragma unroll
        for (int j = 0; j < 4; ++j) { const int idx = lane + 64 * j; if (idx < nf) { const unsigned e = buf[qq * CAP + idx]; const unsigned key = 8191u - (e & 0x1FFFu); (void)__hip_atomic_fetch_or(mrow + (key >> 5), 1u << (key & 31u), __ATOMIC_RELAXED, __HIP_MEMORY_SCOPE_WORKGROUP); } }
        LDS_WAIT(); asm volatile("" ::: "memory");
        unsigned long long* grow = (unsigned long long*)(P.bitm + (brow + t0 + qq) * 256);
#pragma unroll
        for (int j = 0; j < 2; ++j) { const int w2 = lane + 64 * j; const unsigned long long v = (unsigned long long)mrow[2 * w2] | ((unsigned long long)mrow[2 * w2 + 1] << 32);
            __hip_atomic_store(grow + w2, v, RLX_AGENT); }
        LDS_WAIT(); asm volatile("" ::: "memory");
    }
    VM_WAIT();
    __syncthreads();
    if (tid == 0) __hip_atomic_fetch_add(P.done + 64 * (b * 32 + (t0 >> 8)), 1u, RLX_AGENT);
}

namespace dsa1h {
constexpr int NBINS = 512, CAPB = 64, KEEP = 256;
constexpr int L_HIST = 0, L_MROW = 65536, L_BL = L_MROW + 32768, L_RMIN = L_BL + 32 * CAPB * 8, L_RMAX = L_RMIN + 128, L_BST = L_RMAX + 128, L_NEED = L_BST + 128, L_BCNT = L_NEED + 128, L_FLAG = L_BCNT + 128,
              L_QF = L_FLAG + 128, QFP = 1168  , L_END = L_QF + 32 * QFP;
static_assert(L_END <= LDS_MISC, "dsa1h LDS");
__device__ __forceinline__ unsigned ordu(float x) { const unsigned b = __float_as_uint(x); return b ^ ((unsigned)((int)b >> 31) | 0x80000000u); }
__device__ __forceinline__ float unordu(unsigned u) { const unsigned b = (u & 0x80000000u) ? (u ^ 0x80000000u) : ~u; return __uint_as_float(b); }
}
__device__ __forceinline__ bool dsa1_unit_hist(const Dsa1P& P, int u, LAS unsigned char* lds) {
    using namespace dsa1h;
    const int tid = otid_(), wid = __builtin_amdgcn_readfirstlane(tid >> 6), lane = tid & 63, q = lane & 31, hi = lane >> 5;
    const int b = u & 1, qb32 = 255 - (u >> 1), t0 = 32 * qb32;
    const size_t brow = (size_t)b * T;
    LAS unsigned* hist = (LAS unsigned*)(lds + L_HIST); LAS unsigned* mrow = (LAS unsigned*)(lds + L_MROW);
    LAS unsigned* rmin = (LAS unsigned*)(lds + L_RMIN); LAS unsigned* rmax = (LAS unsigned*)(lds + L_RMAX); LAS int* bst = (LAS int*)(lds + L_BST); LAS int* need = (LAS int*)(lds + L_NEED);
    LAS unsigned* bcnt = (LAS unsigned*)(lds + L_BCNT); LAS unsigned* flag = (LAS unsigned*)(lds + L_FLAG);
#pragma unroll
    for (int j = 0; j < 12; ++j) *(LAS v4u*)(lds + L_HIST + (j * 512 + tid) * 16) = (v4u){0u, 0u, 0u, 0u};
    if (tid < 32) { rmin[tid] = 0xFFFFFFFFu; rmax[tid] = 0u; bcnt[tid] = 0u; if (tid == 0) flag[0] = 0u; }
    const bf16* qrow = P.ZR + (brow + t0 + q) * ZP;
    { const int r = tid >> 4, sg = tid & 15; const bf16* src = P.ZR + (brow + t0 + r) * ZP + ZC_QI + 32 * sg;
#pragma unroll
      for (int j = 0; j < 4; ++j) *(LAS v4u*)(lds + L_QF + r * QFP + 64 * sg + 16 * j) = *(const GAS v4u*)(src + 8 * j); }
    float wq[8];
    { const v4u w = *(const GAS v4u*)(qrow + ZC_WI); const float c = 0.35355339059327373f * 0.125f;
      wq[0] = bflo(w.x) * c; wq[1] = bfhi(w.x) * c; wq[2] = bflo(w.y) * c; wq[3] = bfhi(w.y) * c; wq[4] = bflo(w.z) * c; wq[5] = bfhi(w.z) * c; wq[6] = bflo(w.w) * c; wq[7] = bfhi(w.w) * c; }
    const int tq = t0 + q;
    const int nsteps = (t0 + 32 + 255) >> 8;
    __syncthreads();
    if (tid < 256) { const int r = tid >> 3, ds = tid & 7;
        const v4u w = *(const GAS v4u*)(P.ZR + (brow + t0 + r) * ZP + ZC_WI); const float c2 = 0.35355339059327373f * 0.125f * 0.5f;
        const float wh[8] = {bflo(w.x) * c2, bfhi(w.x) * c2, bflo(w.y) * c2, bfhi(w.y) * c2, bflo(w.z) * c2, bfhi(w.z) * c2, bflo(w.w) * c2, bfhi(w.w) * c2};
        float ql[8] = {0.f, 0.f, 0.f, 0.f, 0.f, 0.f, 0.f, 0.f};
#pragma unroll
        for (int hd = 0; hd < 8; ++hd) { const v4u qv = *(const LAS v4u*)(lds + L_QF + r * QFP + hd * 128 + 16 * ds);
            ql[0] += wh[hd] * bflo(qv.x); ql[1] += wh[hd] * bfhi(qv.x); ql[2] += wh[hd] * bflo(qv.y); ql[3] += wh[hd] * bfhi(qv.y);
            ql[4] += wh[hd] * bflo(qv.z); ql[5] += wh[hd] * bfhi(qv.z); ql[6] += wh[hd] * bflo(qv.w); ql[7] += wh[hd] * bfhi(qv.w); }
        *(LAS v4u*)(lds + L_QF + r * QFP + 1024 + 16 * ds) = (v4u){pk2(ql[0], ql[1]), pk2(ql[2], ql[3]), pk2(ql[4], ql[5]), pk2(ql[6], ql[7])}; }
#pragma unroll
    for (int e = 0; e < 8; ++e) wq[e] *= 0.5f;
    __syncthreads();
    bf16x8 afn[4];
#define DSA1H_FIRST() do { const int k0_ = 32 * wid; const bf16* krow_ = P.KI + (brow + (k0_ <= t0 + 31 ? k0_ : 0) + q) * 64 + 8 * hi; \
        _Pragma("unroll") for (int s_ = 0; s_ < 4; ++s_) afn[s_] = *(const GAS bf16x8*)(krow_ + 16 * s_); } while (0)
#define DSA1H_LQ(buf_, hd_) do { _Pragma("unroll") for (int s_ = 0; s_ < 4; ++s_) buf_[s_] = *(const LAS bf16x8*)(lds + qfo_ + (hd_) * 128 + 32 * s_); } while (0)
#define DSA1H_MM(acc_, buf_) do { _Pragma("unroll") for (int i_ = 0; i_ < 16; ++i_) acc_[i_] = 0.f; \
        _Pragma("unroll") for (int s_ = 0; s_ < 4; ++s_) acc_ = __builtin_amdgcn_mfma_f32_32x32x16_bf16(af_[s_], buf_[s_], acc_, 0, 0, 0); } while (0)
#define DSA1H_RW(sc_, acc_, hd_) do { _Pragma("unroll") for (int i_ = 0; i_ < 16; ++i_) { float t_ = fmaf(__builtin_fabsf(acc_[i_]), wq[hd_], sc_[i_]); \
        asm volatile("" : "+v"(t_));   sc_[i_] = t_; } } while (0)
#define DSA1H_SB() __builtin_amdgcn_sched_barrier(0)
#define DSA1H_SCORES(st_, key0_, sc_) \
        bf16x8 af_[4]; \
        _Pragma("unroll") for (int s_ = 0; s_ < 4; ++s_) af_[s_] = afn[s_]; \
        { const int k1_ = (key0_) + 256; const bf16* krow_ = P.KI + (brow + (k1_ <= t0 + 31 ? k1_ : 0) + q) * 64 + 8 * hi; \
          _Pragma("unroll") for (int s_ = 0; s_ < 4; ++s_) afn[s_] = *(const GAS bf16x8*)(krow_ + 16 * s_); } \
        f32x16 sc_; \
        { unsigned qfo_ = (unsigned)(L_QF + q * QFP + 16 * hi); asm volatile("" : "+v"(qfo_)); \
          bf16x8 qa_[4], qb_[4]; f32x16 accA_, accB_; \
          DSA1H_LQ(qa_, 8); DSA1H_LQ(qb_, 0); DSA1H_SB(); \
          DSA1H_MM(sc_, qa_); DSA1H_SB();                                    \
          DSA1H_LQ(qa_, 1); DSA1H_MM(accA_, qb_); DSA1H_SB(); \
          DSA1H_LQ(qb_, 2); DSA1H_MM(accB_, qa_); DSA1H_RW(sc_, accA_, 0); DSA1H_SB(); \
          DSA1H_LQ(qa_, 3); DSA1H_MM(accA_, qb_); DSA1H_RW(sc_, accB_, 1); DSA1H_SB(); \
          DSA1H_LQ(qb_, 4); DSA1H_MM(accB_, qa_); DSA1H_RW(sc_, accA_, 2); DSA1H_SB(); \
          DSA1H_LQ(qa_, 5); DSA1H_MM(accA_, qb_); DSA1H_RW(sc_, accB_, 3); DSA1H_SB(); \
          DSA1H_LQ(qb_, 6); DSA1H_MM(accB_, qa_); DSA1H_RW(sc_, accA_, 4); DSA1H_SB(); \
          DSA1H_LQ(qa_, 7); DSA1H_MM(accA_, qb_); DSA1H_RW(sc_, accB_, 5); DSA1H_SB(); \
          DSA1H_MM(accB_, qa_); DSA1H_RW(sc_, accA_, 6); DSA1H_SB(); \
          DSA1H_RW(sc_, accB_, 7); DSA1H_SB(); }
    float lo, scale;
    DSA1H_FIRST();
    {   const int key0 = 32 * wid;
        DSA1H_SCORES(0, key0, sc0);
        float mn = sc0[0], mx = sc0[0];
#pragma unroll
        for (int i = 1; i < 16; ++i) { mn = fminf(mn, sc0[i]); mx = fmaxf(mx, sc0[i]); }
        (void)__hip_atomic_fetch_min(rmin + q, ordu(mn), __ATOMIC_RELAXED, __HIP_MEMORY_SCOPE_WORKGROUP);
        (void)__hip_atomic_fetch_max(rmax + q, ordu(mx), __ATOMIC_RELAXED, __HIP_MEMORY_SCOPE_WORKGROUP);
        __syncthreads();
        const float fmn = unordu(rmin[q]), fmx = unordu(rmax[q]), rg = fmx - fmn;
        scale = rg > 0.f ? (float)NBINS / (1.5f * rg) : 0.f; lo = -(fmn - 0.25f * rg) * scale;
        if (!(rg > 0.f) || !(rg < 3.0e37f)) { if (lane < 32) flag[0] = 1u; }
    }
#define DSA1H_BIN(x_) ({ unsigned b_ = (unsigned)fmaf((x_), scale, lo);   (int)(b_ > (unsigned)(NBINS - 1) ? (unsigned)(NBINS - 1) : b_); })
    DSA1H_FIRST();
    for (int st = 0; st < nsteps; ++st) {
        const int key0 = 256 * st + 32 * wid;
        if (key0 <= t0 + 31) {
            DSA1H_SCORES(st, key0, sc);
            const bool diag = key0 + 31 > t0;
            LAS unsigned* hq = hist + q * NBINS;
            if (!diag) {
#pragma unroll
                for (int i = 0; i < 16; ++i) { const int bn = DSA1H_BIN(sc[i]); (void)__hip_atomic_fetch_add(hq + bn, 1u, __ATOMIC_RELAXED, __HIP_MEMORY_SCOPE_WORKGROUP); }
            } else {
#pragma unroll
                for (int i = 0; i < 16; ++i) { const int kidx = key0 + (i & 3) + 8 * (i >> 2) + 4 * hi;
                    if (kidx <= tq) { const int bn = DSA1H_BIN(sc[i]); (void)__hip_atomic_fetch_add(hq + bn, 1u, __ATOMIC_RELAXED, __HIP_MEMORY_SCOPE_WORKGROUP); } }
            }
        } else { bf16x8 af_[4]; (void)af_; }
    }
    __syncthreads();
#pragma unroll 1
    for (int k = 0; k < 4; ++k) {
        const int qq = wid + 8 * k; const int rl = 63 - lane;
        const v4u ha = *(const LAS v4u*)(hist + qq * NBINS + 8 * rl), hb = *(const LAS v4u*)(hist + qq * NBINS + 8 * rl + 4);
        const unsigned hw[8] = {ha.x, ha.y, ha.z, ha.w, hb.x, hb.y, hb.z, hb.w};
        int tot = 0;
#pragma unroll
        for (int j = 0; j < 8; ++j) tot += (int)hw[j];
        int above = dsa1::wave_prefix_incl(tot) - tot; int bsel = -1, asel = 0, csel = 0;
#pragma unroll
        for (int j = 7; j >= 0; --j) { const int c = (int)hw[j];
            if (above < KEEP && KEEP <= above + c) { bsel = 8 * rl + j; asel = above; csel = c; } above += c; }
        const unsigned long long bm = __ballot(bsel >= 0);
        const int src = bm ? (int)__builtin_ctzll(bm) : 0;
        const int bs = __builtin_amdgcn_readlane(bsel, src), ab = __builtin_amdgcn_readlane(asel, src), cs = __builtin_amdgcn_readlane(csel, src);
        if (lane == 0) { bst[qq] = bs; need[qq] = KEEP - ab; if (bm == 0ull || cs > CAPB) flag[0] = 1u; }
    }
    __syncthreads();
    if (flag[0] != 0u) { __syncthreads(); return false; }
    const int mybst = bst[q];
    const float thr_lo = mybst == 0 ? -__builtin_inff() : (float)mybst, thr_hi = mybst == NBINS - 1 ? __builtin_inff() : (float)(mybst + 1);
    LAS unsigned* mq = mrow + q * 256; LAS unsigned long long* bl = (LAS unsigned long long*)(lds + L_BL) + q * CAPB;
    DSA1H_FIRST();
    for (int st = 0; st < nsteps; ++st) {
        const int key0 = 256 * st + 32 * wid;
        if (key0 <= t0 + 31) {
            DSA1H_SCORES(st, key0, sc);
            unsigned selw = 0u, bndw = 0u;
#pragma unroll
            for (int i = 0; i < 16; ++i) { const float y = fmaf(sc[i], scale, lo); const unsigned bit = 1u << ((i & 3) + 8 * (i >> 2));
                selw |= (y >= thr_hi) ? bit : 0u; bndw |= (y >= thr_lo) ? bit : 0u; }
            const int dk = tq - key0;
            const unsigned vmask = dk >= 31 ? 0xFFFFFFFFu : (dk < 0 ? 0u : ((2u << dk) - 1u));
            selw = (selw << (4 * hi)) & vmask; bndw = (bndw << (4 * hi)) & vmask & ~selw;
            if (selw) (void)__hip_atomic_fetch_or(mq + (key0 >> 5), selw, __ATOMIC_RELAXED, __HIP_MEMORY_SCOPE_WORKGROUP);
            while (bndw) {
                const int pos = __builtin_ctz(bndw); bndw &= bndw - 1u;
                const int pl = pos - 4 * hi, idx = (pl & 3) + 4 * (pl >> 3);
                const float e0 = (idx & 1) ? sc[1] : sc[0], e1 = (idx & 1) ? sc[3] : sc[2], e2 = (idx & 1) ? sc[5] : sc[4], e3 = (idx & 1) ? sc[7] : sc[6],
                            e4 = (idx & 1) ? sc[9] : sc[8], e5 = (idx & 1) ? sc[11] : sc[10], e6 = (idx & 1) ? sc[13] : sc[12], e7 = (idx & 1) ? sc[15] : sc[14];
                const float f0 = (idx & 2) ? e1 : e0, f1 = (idx & 2) ? e3 : e2, f2 = (idx & 2) ? e5 : e4, f3 = (idx & 2) ? e7 : e6;
                const float g0 = (idx & 4) ? f1 : f0, g1 = (idx & 4) ? f3 : f2;
                const float sv = (idx & 8) ? g1 : g0;
                const unsigned p = __hip_atomic_fetch_add(bcnt + q, 1u, __ATOMIC_RELAXED, __HIP_MEMORY_SCOPE_WORKGROUP);
                if (p < (unsigned)CAPB) bl[p] = ((unsigned long long)ordu(sv) << 32) | (unsigned)(8191 - (key0 + pos));
            }
        }
    }
    __syncthreads();
#pragma unroll 1
    for (int k = 0; k < 4; ++k) {
        const int qq = wid + 8 * k; const int m = (int)bcnt[qq], nd = need[qq];
        const LAS unsigned long long* blq = (const LAS unsigned long long*)(lds + L_BL) + qq * CAPB;
        const unsigned long long mine = lane < m ? blq[lane] : 0ull;
        int rank = 0;
        for (int j = 0; j < m; ++j) { const unsigned long long o = blq[j]; rank += (o > mine) ? 1 : 0; }
        LAS unsigned* mr = mrow + qq * 256;
        if (lane < m && rank < nd) { const unsigned key = 8191u - (unsigned)(mine & 0x1FFFu); (void)__hip_atomic_fetch_or(mr + (key >> 5), 1u << (key & 31u), __ATOMIC_RELAXED, __HIP_MEMORY_SCOPE_WORKGROUP); }
        LDS_WAIT(); asm volatile("" ::: "memory");
        unsigned long long* grow = (unsigned long long*)(P.bitm + (brow + t0 + qq) * 256);
#pragma unroll
        for (int j = 0; j < 2; ++j) { const int w2 = lane + 64 * j; const unsigned long long v = (unsigned long long)mr[2 * w2] | ((unsigned long long)mr[2 * w2 + 1] << 32);
            __hip_atomic_store(grow + w2, v, RLX_AGENT); }
    }
    VM_WAIT();
    __syncthreads();
    if (tid == 0) __hip_atomic_fetch_add(P.done + 64 * (b * 32 + (t0 >> 8)), 1u, RLX_AGENT);
    return true;
#undef DSA1H_FIRST
#undef DSA1H_SCORES
#undef DSA1H_LQ
#undef DSA1H_MM
#undef DSA1H_RW
#undef DSA1H_SB
#undef DSA1H_BIN
}
__device__ __forceinline__ void dsa1_unit(const Dsa1P& P, int u, LAS unsigned char* lds) {
    const int qb32 = 255 - (u >> 1);
    if (qb32 >= 8) { if (dsa1_unit_hist(P, u, lds)) return; }
    dsa1_unit_lists(P, u, lds);
}

struct RPostP { const bf16* ZR; bf16* Q3; const bf16* yraw; const float* rdotk; const float *mu, *gup, *lnw, *lnb; };
__device__ __forceinline__ void rwkv_post(const RPostP& P, LAS unsigned char* lds) {
    const int tid = otid_(), lane = tid & 63, h = __builtin_amdgcn_readfirstlane(tid >> 6), c16 = lane & 15, quad = lane >> 4;
    constexpr int SP = 272;
    LAS float* GT = (LAS float*)(lds + 64 * SP);
    bf16x8 bfr[4][4];
#pragma unroll
    for (int ct = 0; ct < 4; ++ct)
#pragma unroll
        for (int s = 0; s < 4; ++s) { const float* gp = P.gup + (size_t)(32 * s + 8 * quad) * 512 + 64 * h + 16 * ct + c16;
            v4u w; w.x = pk2(gp[0], gp[512]); w.y = pk2(gp[1024], gp[1536]); w.z = pk2(gp[2048], gp[2560]); w.w = pk2(gp[3072], gp[3584]); bfr[ct][s] = __builtin_bit_cast(bf16x8, w); }
    float muv[4], lnw[4], lnb[4];
#pragma unroll
    for (int ct = 0; ct < 4; ++ct) { const int ch = 64 * h + 16 * ct + c16; muv[ct] = P.mu[1024 + ch]; lnw[ct] = P.lnw[ch]; lnb[ct] = P.lnb[ch]; }
    const int stok = tid >> 3, sseg = tid & 7;
    const int vtok = tid >> 5, vseg = tid & 31, ch0 = 16 * vseg, vh = vseg >> 2;
#pragma unroll 1
    for (int m0 = blockIdx.x * 64; m0 < M; m0 += gridDim.x * 64) {
        {   const size_t m = (size_t)m0 + stok; const int t = (int)(m & (T - 1));
            float gv[16], pv[16];
            { const v4u a = *(const GAS v4u*)(P.ZR + m * ZP + ZC_GC + 16 * sseg), c = *(const GAS v4u*)(P.ZR + m * ZP + ZC_GC + 16 * sseg + 8);
              gv[0] = bflo(a.x); gv[1] = bfhi(a.x); gv[2] = bflo(a.y); gv[3] = bfhi(a.y); gv[4] = bflo(a.z); gv[5] = bfhi(a.z); gv[6] = bflo(a.w); gv[7] = bfhi(a.w);
              gv[8] = bflo(c.x); gv[9] = bfhi(c.x); gv[10] = bflo(c.y); gv[11] = bfhi(c.y); gv[12] = bflo(c.z); gv[13] = bfhi(c.z); gv[14] = bflo(c.w); gv[15] = bfhi(c.w); }
            if (t > 0) { const v4u a = *(const GAS v4u*)(P.ZR + (m - 1) * ZP + ZC_GC + 16 * sseg), c = *(const GAS v4u*)(P.ZR + (m - 1) * ZP + ZC_GC + 16 * sseg + 8);
              pv[0] = bflo(a.x); pv[1] = bfhi(a.x); pv[2] = bflo(a.y); pv[3] = bfhi(a.y); pv[4] = bflo(a.z); pv[5] = bfhi(a.z); pv[6] = bflo(a.w); pv[7] = bfhi(a.w);
              pv[8] = bflo(c.x); pv[9] = bfhi(c.x); pv[10] = bflo(c.y); pv[11] = bfhi(c.y); pv[12] = bflo(c.z); pv[13] = bfhi(c.z); pv[14] = bflo(c.w); pv[15] = bfhi(c.w); }
            else {
#pragma unroll
              for (int e = 0; e < 16; ++e) pv[e] = 0.f; }
            float sg[16];
#pragma unroll
            for (int e = 0; e < 16; ++e) { const float mu = P.mu[1664 + 16 * sseg + e]; sg[e] = sigm(gv[e] + (pv[e] - gv[e]) * mu); }
            v4u o0, o1; o0.x = pk2(sg[0], sg[1]); o0.y = pk2(sg[2], sg[3]); o0.z = pk2(sg[4], sg[5]); o0.w = pk2(sg[6], sg[7]); o1.x = pk2(sg[8], sg[9]); o1.y = pk2(sg[10], sg[11]); o1.z = pk2(sg[12], sg[13]); o1.w = pk2(sg[14], sg[15]);
            *(LAS v4u*)(lds + stok * SP + 32 * sseg) = o0; *(LAS v4u*)(lds + stok * SP + 32 * sseg + 16) = o1;
        }
        __syncthreads();
#pragma unroll 1
        for (int rt = 0; rt < 4; ++rt) {
            const size_t m = (size_t)m0 + 16 * rt + vtok; const int t = (int)(m & (T - 1)); const size_t mp = t > 0 ? m - 1 : m;
            const v4u ya = *(const GAS v4u*)(P.yraw + m * 512 + ch0), yc = *(const GAS v4u*)(P.yraw + m * 512 + ch0 + 8);
            const v4u va = *(const GAS v4u*)(P.ZR + m * ZP + ZC_RV + ch0), vc = *(const GAS v4u*)(P.ZR + m * ZP + ZC_RV + ch0 + 8);
            const v4u pa = *(const GAS v4u*)(P.ZR + mp * ZP + ZC_RV + ch0), pc = *(const GAS v4u*)(P.ZR + mp * ZP + ZC_RV + ch0 + 8);
            const float rk = P.rdotk[m * 8 + vh];
            f32x4 acc[4];
#pragma unroll
            for (int ct = 0; ct < 4; ++ct) acc[ct] = (f32x4){0.f, 0.f, 0.f, 0.f};
#pragma unroll
            for (int s = 0; s < 4; ++s) { const bf16x8 af = *(const LAS bf16x8*)(lds + (16 * rt + c16) * SP + (32 * s + 8 * quad) * 2);
#pragma unroll
                for (int ct = 0; ct < 4; ++ct) acc[ct] = __builtin_amdgcn_mfma_f32_16x16x32_bf16(af, bfr[ct][s], acc[ct], 0, 0, 0); }
#pragma unroll
            for (int ct = 0; ct < 4; ++ct)
#pragma unroll
                for (int j = 0; j < 4; ++j) GT[(4 * quad + j) * 512 + 64 * h + 16 * ct + c16] = acc[ct][j];
            __syncthreads();
            {   float y[16], vv[16], vp[16], g[16];
                { const v4u a = ya, c = yc;
                  y[0] = bflo(a.x); y[1] = bfhi(a.x); y[2] = bflo(a.y); y[3] = bfhi(a.y); y[4] = bflo(a.z); y[5] = bfhi(a.z); y[6] = bflo(a.w); y[7] = bfhi(a.w);
                  y[8] = bflo(c.x); y[9] = bfhi(c.x); y[10] = bflo(c.y); y[11] = bfhi(c.y); y[12] = bflo(c.z); y[13] = bfhi(c.z); y[14] = bflo(c.w); y[15] = bfhi(c.w); }
                { const v4u a = va, c = vc;
                  vv[0] = bflo(a.x); vv[1] = bfhi(a.x); vv[2] = bflo(a.y); vv[3] = bfhi(a.y); vv[4] = bflo(a.z); vv[5] = bfhi(a.z); vv[6] = bflo(a.w); vv[7] = bfhi(a.w);
                  vv[8] = bflo(c.x); vv[9] = bfhi(c.x); vv[10] = bflo(c.y); vv[11] = bfhi(c.y); vv[12] = bflo(c.z); vv[13] = bfhi(c.z); vv[14] = bflo(c.w); vv[15] = bfhi(c.w); }
                if (t > 0) { const v4u a = pa, c = pc;
                  vp[0] = bflo(a.x); vp[1] = bfhi(a.x); vp[2] = bflo(a.y); vp[3] = bfhi(a.y); vp[4] = bflo(a.z); vp[5] = bfhi(a.z); vp[6] = bflo(a.w); vp[7] = bfhi(a.w);
                  vp[8] = bflo(c.x); vp[9] = bfhi(c.x); vp[10] = bflo(c.y); vp[11] = bfhi(c.y); vp[12] = bflo(c.z); vp[13] = bfhi(c.z); vp[14] = bflo(c.w); vp[15] = bfhi(c.w); }
                else {
#pragma unroll
                  for (int e = 0; e < 16; ++e) vp[e] = 0.f; }
#pragma unroll
                for (int e4 = 0; e4 < 4; ++e4) { const f32x4 gq = *(const LAS f32x4*)(GT + vtok * 512 + ch0 + 4 * e4); g[4 * e4] = gq.x; g[4 * e4 + 1] = gq.y; g[4 * e4 + 2] = gq.z; g[4 * e4 + 3] = gq.w; }
                float sm = 0.f;
#pragma unroll
                for (int e = 0; e < 16; ++e) sm += y[e];
                sm = scan::dpp_add<0xB1>(sm); sm = scan::dpp_add<0x4E>(sm);
                const float mean = sm * (1.f / 64.f); float vs = 0.f;
#pragma unroll
                for (int e = 0; e < 16; ++e) { y[e] -= mean; vs += y[e] * y[e]; }
                vs = scan::dpp_add<0xB1>(vs); vs = scan::dpp_add<0x4E>(vs);
                const float rstd = __builtin_amdgcn_rsqf(vs * (1.f / 64.f) + 64e-5f);
                unsigned ow[8];
#pragma unroll
                for (int e = 0; e < 16; e += 2) { float o2[2];
#pragma unroll
                    for (int d = 0; d < 2; ++d) { const int ch = ch0 + e + d; const float v = vv[e + d] + (vp[e + d] - vv[e + d]) * P.mu[1024 + ch];
                        o2[d] = (y[e + d] * rstd * P.lnw[ch] + P.lnb[ch] + rk * v) * g[e + d]; }
                    ow[e >> 1] = pk2(o2[0], o2[1]); }
                *(GAS v4u*)(P.Q3 + m * QP + 512 + ch0) = (v4u){ow[0], ow[1], ow[2], ow[3]}; *(GAS v4u*)(P.Q3 + m * QP + 512 + ch0 + 8) = (v4u){ow[4], ow[5], ow[6], ow[7]};
            }
            __syncthreads();
        }
        __syncthreads();
    }
}
struct DPostP { const bf16* O1; const bf16* O2; bf16* Q3; const float *lq1, *lk1, *lq2, *lk2, *subln; float lambda_init; };
__device__ __forceinline__ void diff_post(const DPostP& P, int gw, int NGW, int lane) {
    const float lam = __expf(wave_sum(P.lq1[lane] * P.lk1[lane])) - __expf(wave_sum(P.lq2[lane] * P.lk2[lane])) + P.lambda_init;
    float sw[8];
#pragma unroll
    for (int e = 0; e < 8; ++e) sw[e] = P.subln[8 * (lane & 15) + e] * (1.f - P.lambda_init);
    constexpr int R = 8;
    for (int m0 = gw; m0 < M; m0 += R * NGW) {
        v4u a[R], c[R];
#pragma unroll
        for (int q = 0; q < R; ++q) { const size_t m = (size_t)(m0 + q * NGW); a[q] = *(const GAS v4u*)(P.O1 + m * 512 + 8 * lane); c[q] = *(const GAS v4u*)(P.O2 + m * 512 + 8 * lane); }
#pragma unroll
        for (int q = 0; q < R; ++q) { const size_t m = (size_t)(m0 + q * NGW);
            float x[8];
            x[0] = bflo(a[q].x) - lam * bflo(c[q].x); x[1] = bfhi(a[q].x) - lam * bfhi(c[q].x); x[2] = bflo(a[q].y) - lam * bflo(c[q].y); x[3] = bfhi(a[q].y) - lam * bfhi(c[q].y);
            x[4] = bflo(a[q].z) - lam * bflo(c[q].z); x[5] = bfhi(a[q].z) - lam * bfhi(c[q].z); x[6] = bflo(a[q].w) - lam * bflo(c[q].w); x[7] = bfhi(a[q].w) - lam * bfhi(c[q].w);
            float ss = 0.f;
#pragma unroll
            for (int e = 0; e < 8; ++e) ss += x[e] * x[e];
            const float r = __builtin_amdgcn_rsqf(scan::red16(ss) * (1.f / 128.f) + NORM_EPS);
            v4u o; o.x = pk2(x[0] * r * sw[0], x[1] * r * sw[1]); o.y = pk2(x[2] * r * sw[2], x[3] * r * sw[3]); o.z = pk2(x[4] * r * sw[4], x[5] * r * sw[5]); o.w = pk2(x[6] * r * sw[6], x[7] * r * sw[7]);
            *(GAS v4u*)(P.Q3 + m * QP + 1024 + 8 * lane) = o;
        }
    }
}

__device__ __forceinline__ int q_fetch(gu32* head, volatile LAS int* slot) {
    if (threadIdx.x == 0) *slot = (int)__hip_atomic_fetch_add(head, 1u, RLX_AGENT);
    __syncthreads();
    const int v = __builtin_amdgcn_readfirstlane(*slot);
    __syncthreads();
    return v;
}

struct Args { const float* in[32]; float* out; unsigned char* ws; int ph_lo, ph_hi; };
__device__ __forceinline__ const float* kin_(int i) { const char* ka = (const char*)__builtin_amdgcn_kernarg_segment_ptr(); unsigned off = (unsigned)i * 8u; asm volatile("" : "+s"(off)); return *(const float* const*)(ka + off); }
#define KIN(i) kin_(i)
#define XOUT ((float*)kin_(32))
#define XB ((bf16*)kin_(32))
#define XB2 ((bf16*)(wsl + WS_Q3))
#define OUTHI ((unsigned char*)kin_(32) + 32 * MiB)
__device__ __forceinline__ unsigned char* kws_() { return (unsigned char*)kin_(33); }
__device__ __forceinline__ int kint_(int byteoff) { const char* ka = (const char*)__builtin_amdgcn_kernarg_segment_ptr(); unsigned off = (unsigned)byteoff; asm volatile("" : "+s"(off)); return *(const int*)(ka + off); }
constexpr int PH_L = 14;
constexpr int N_PHASES = 1 + NLAYER * PH_L;

#define G ((int)gridDim.x)
#define bid ((int)blockIdx.x)
#define gw (bid * NWAVES + wave)
#define NGW (G * NWAVES)
#define MISC ((volatile LAS unsigned*)(lds + LDS_MISC))
#define IN(k) (kint_(272) <= (k) && (k) < kint_(276))
#define SEAM(k) do { if ((k) + 1 < kint_(276)) { XcdBarrier bar_; bar_.bar = (unsigned*)(kws_() + WS_CTL) + CW_BAR; bar_.x = xb_xcc_id(); bar_.st = MISC + 8; xcd_barrier(bar_); } } while (0)
#if TSPROBE
#define WSL() unsigned char* wsl = kws_(); const int tid = otid_(), lane = tid & 63, wave = __builtin_amdgcn_readfirstlane(tid >> 6); (void)lane; (void)wave; \
    if (blockIdx.x == 0 && tid == 0) { gu32* tc_ = (gu32*)(wsl + WS_CTL) + 3072; const unsigned n_ = __hip_atomic_fetch_add(tc_, 1u, RLX_AGENT); *(GAS unsigned long long*)(tc_ + 2 + 2 * n_) = __builtin_amdgcn_s_memrealtime(); }
#else
#define WSL() unsigned char* wsl = kws_(); const int tid = otid_(), lane = tid & 63, wave = __builtin_amdgcn_readfirstlane(tid >> 6); (void)lane; (void)wave
#endif
#define WFu ((bf16*)(wsl + WS_WF))
#define WFd ((bf16*)(wsl + WS_WF_DOWN))
#define WMi ((bf16*)(wsl + WS_WM))
#define WMb ((bf16*)(wsl + WS_WM_BR))
#define WMo ((bf16*)(wsl + WS_WM_OUT))
#define XN ((bf16*)(wsl + WS_XN))
#define Q3 ((bf16*)(wsl + WS_Q3))
#define ZR ((bf16*)(wsl + WS_ZR))
#define YP ((bf16*)(wsl + WS_R2))
#define HB ZR
#define G3 ZR
#define MG ((bf16*)(wsl + WS_MG))
#define O1 ((bf16*)(wsl + WS_R2))
#define O2 ((bf16*)(wsl + WS_R2) + (size_t)M * 512)
#define YRAW ((bf16*)(wsl + WS_YRAW))
#define BITM ((unsigned*)OUTHI)
#define RDOTK ((float*)(wsl + WS_RDOTK))
#define X1B ((bf16*)(OUTHI + 16 * MiB))
#define KID ((bf16*)(wsl + WS_KID))
#define A8B ((unsigned char*)(wsl + WS_A8))
#define CTL ((gu32*)(wsl + WS_CTL))
#define cscr ((LAS float*)(lds + wave * 16384))

#define CONV_FFN(l_, f_) do { const int gi_ = (f_) ? 29 : 3; \
        const MapUp mu_{KIN(gi_) + (size_t)(l_) * DM * FF, KIN(gi_ + 1) + (size_t)(l_) * DM * FF, FF}; const MapIdent md_{KIN(gi_ + 2) + (size_t)(l_) * FF * DM, DM}; \
        constexpr int nu_ = conv_items(DM, 2 * FF), nd_ = conv_items(FF, DM); \
        bf16* const wu_ = WFu; bf16* const wd_ = WFd; \
        conv_batch([&](int it_) { return it_ < nu_ ? conv_desc(mu_, DM, wu_, it_, 2 * FF / 32, lane) : conv_desc(md_, FF, wd_, it_ - nu_, DM / 32, lane); }, nu_ + nd_, cscr, gw, NGW, lane); } while (0)
#define CONV_MIX(l_) do { const MapWin mw_{KIN(8) + (size_t)(l_) * DM * NIN, NIN}; const MapIdent mo_{KIN(26) + (size_t)(l_) * DM * DM, DM}; const float* const wb_ = KIN(25) + (size_t)(l_) * 3 * 512 * DM; \
        constexpr int ni_ = conv_items(DM, 8704), nb_ = conv_items(512, DM), no_ = conv_items(DM, DM); \
        bf16* const wi_ = WMi; bf16* const wbr_ = WMb; bf16* const wo_ = WMo; \
        conv_batch([&](int it_) { \
            if (it_ < ni_) return conv_desc(mw_, DM, wi_, it_, 8704 / 32, lane); \
            if (it_ < ni_ + 3 * nb_) { const int r_ = it_ - ni_, n_ = r_ / nb_; const MapIdent mb_{wb_ + (size_t)n_ * 512 * DM, DM}; return conv_desc(mb_, 512, wbr_ + (size_t)n_ * DM * 512, r_ - n_ * nb_, DM / 32, lane); } \
            return conv_desc(mo_, DM, wo_, it_ - ni_ - 3 * nb_, DM / 32, lane); }, ni_ + 3 * nb_ + no_, cscr, gw, NGW, lane); } while (0)
#define CONV_MIX_Q(l_) do { const MapWin mw_{KIN(8) + (size_t)(l_) * DM * NIN, NIN}; const MapIdent mo_{KIN(26) + (size_t)(l_) * DM * DM, DM}; const float* const wb_ = KIN(25) + (size_t)(l_) * 3 * 512 * DM; \
        constexpr int ni_ = conv_items(DM, 8704), nb_ = conv_items(512, DM), no_ = conv_items(DM, DM); \
        bf16* const wi_ = WMi; bf16* const wbr_ = WMb; bf16* const wo_ = WMo; \
        conv_queue([&](int it_) { \
            if (it_ < ni_) return conv_desc(mw_, DM, wi_, it_, 8704 / 32, lane); \
            if (it_ < ni_ + 3 * nb_) { const int r_ = it_ - ni_, n_ = r_ / nb_; const MapIdent mb_{wb_ + (size_t)n_ * 512 * DM, DM}; return conv_desc(mb_, 512, wbr_ + (size_t)n_ * DM * 512, r_ - n_ * nb_, DM / 32, lane); } \
            return conv_desc(mo_, DM, wo_, it_ - ni_ - 3 * nb_, DM / 32, lane); }, ni_ + 3 * nb_ + no_, cscr, CTL + CW_CQ + 64 * (l_), lane); } while (0)

template <int L, int F> __device__ __forceinline__ void ffn_part(LAS unsigned char* lds) {
    constexpr int l = L, f = F, pb = 1 + PH_L * L, pf = pb + (F ? 11 : 0);
            if (IN(pf + 0)) { WSL();
                pg8::Gemm g{XN, WFu, M, 2 * FF, DM, DM}; pg8::StaticOrder S; S.init(M, 2 * FF, G, bid);
                pg8::EpiSwiGLU E{HB, FF};
                pg8::gemm_phase<pg8::EpiSwiGLU, pg8::StaticOrder, true, true>(lds, g, S, E);
                if constexpr (f == 0) { CONV_MIX_Q(l); }
                SEAM(pf + 0);
            }
            if (IN(pf + 1)) { WSL();
                pg8::Gemm g{HB, WFd, M, DM, FF, FF}; pg8::StaticOrder S; S.init(M, DM, G, bid);
                pg8::EpiStore<0> E{YP, DM, YP, DM, 1 << 30};
                pg8::gemm_phase<pg8::EpiStore<0>, pg8::StaticOrder, true, true>(lds, g, S, E);
                SEAM(pf + 1);
            }
            if (IN(pf + 2)) { WSL();
                const float* gpost = KIN(f ? 28 : 2) + l * DM;
                const float* gnext = f == 0 ? KIN(6) + l * DM : (l + 1 < NLAYER ? KIN(1) + (l + 1) * DM : nullptr);
#if PROBE
                float osc = 1.f;
                if (l == NLAYER - 1 && f == 1) { const float num = *(const float*)(wsl + WS_CTL + 4 * CW_PROBE), den = *(const float*)(wsl + WS_CTL + 4 * (CW_PROBE + 1)); osc = 1.f + 4.f * sqrtf(num / fmaxf(den, 1e-30f)); }
#elif TSPROBE
                float osc = 1.f;
                if (l == NLAYER - 1 && f == 1) { const GAS unsigned long long* ts_ = (const GAS unsigned long long*)((gu32*)(wsl + WS_CTL) + 3072 + 2); const unsigned long long tot = ts_[N_PHASES - 2] - ts_[0]; unsigned long long sel = 0;
                    for (int p_ = 0; p_ < N_PHASES - 2; ++p_) if ((TSPROBE_MASK >> p_) & 1ull) sel += ts_[p_ + 1] - ts_[p_];
                    float fr_ = (float)sel / (float)tot;
#if TSPROBE == 2
                    fr_ = (float)(ts_[100 + TSPROBE_L] - ts_[6 + 14 * TSPROBE_L]) / (float)(ts_[7 + 14 * TSPROBE_L] - ts_[6 + 14 * TSPROBE_L]);
#endif
                    osc = 1.f + floorf(fr_ * TSQ + 0.5f) * (1.f / TSQ); }
#else
                const float osc = 1.f;
#endif
                if constexpr (l == 0 && f == 0) rownorm_rows<false, true>(KIN(0), YP, 0.5f, gpost, XB, gnext, XN, gw, NGW, lane);
                else if constexpr (l == NLAYER - 1 && f == 1) rownorm_rows<true, false>(XB2, YP, 0.5f, gpost, XOUT, nullptr, nullptr, gw, NGW, lane, osc);
                else rownorm_rows<true, true>(XB, YP, 0.5f, gpost, XB, gnext, XN, gw, NGW, lane);
                if (f == 1 && l + 1 < NLAYER) { CONV_FFN(l + 1, 0); }
                SEAM(pf + 2);
            }
}
template <int L> __device__ __forceinline__ void mixer_part(LAS unsigned char* lds, unsigned char* lds_) {
    constexpr int l = L, pb = 1 + PH_L * L;
            const int pm = pb + 3;
            if (IN(pm + 0)) { WSL();
                pg8::Gemm g{XN, WMi, M, 5632, DM, DM}; pg8::StaticOrder S; S.init(M, 5632, G, bid);
                pg8::EpiStore<0> E{Q3, QP, ZR, ZP, 6};
                pg8::gemm_phase<pg8::EpiStore<0>, pg8::StaticOrder, true, true>(lds, g, S, E);
                SEAM(pm + 0);
            }
            if (IN(pm + 1)) { WSL();
                PrepP pp{ZR, X1B, A8B, KID, KIN(9) + l * 1792, KIN(10) + l * 512, KIN(11) + l * 64 * 512, KIN(12) + l * 512, KIN(13) + l * 64 * 512};
                rwkv_prep(pp, lds);
                SEAM(pm + 1);
            }
            if (IN(pm + 2)) { WSL();
                volatile LAS int* slot = (volatile LAS int*)(MISC + 16);
                if (bid < 64) {
                    ScanP sp{Q3, ZR, X1B, A8B, YRAW, RDOTK, KIN(9) + l * 1792, KIN(15) + l * 512, KIN(16) + l * 512, KIN(17) + l * 512};
#ifndef NO_SCAN
                    rwkv_scan_unit(sp, bid, lds);
#if TSPROBE == 2
                    if (bid == 5 && otid_() == 0) *(GAS unsigned long long*)((gu32*)(wsl + WS_CTL) + 3072 + 2 + 2 * (100 + l)) = __builtin_amdgcn_s_memrealtime();
#endif
#ifdef SCAN_TWICE
                    rwkv_scan_unit(sp, bid, lds);
#endif
#endif
                }
                {
                    Dsa1P dp{ZR, KID, BITM, CTL + CW_DONE + 64 * 64 * l};
                    gu32* head = CTL + CW_Q + 64 * (3 * l + 0);
                    #ifndef NO_DSA1
                    for (int u = q_fetch(head, slot); u < 512; u = q_fetch(head, slot)) dsa1_unit(dp, u, lds);
#ifdef DUP_DSA1
                    { gu32* head2 = CTL + 10240 + 64 * (2 * l + 0); for (int u = q_fetch(head2, slot); u < 512; u = q_fetch(head2, slot)) dsa1_unit(dp, u, lds); }
#endif
#endif
                }
                {
                    gu32* head = CTL + CW_Q + 64 * (3 * l + 1);
                    typedef att::BlockRef<att::bf16, att::bf16> Ref;
#define DSA2_REF(i_, r_) do { const int qb_ = 31 - ((i_) >> 3), b_ = ((i_) >> 2) & 1, h_ = (i_) & 3; const size_t row_ = (size_t)b_ * T + 256 * qb_; \
        r_.Q = (const att::bf16*)(Q3 + row_ * QP + 128 * h_); r_.O = (att::bf16*)(Q3 + row_ * QP + 128 * h_); r_.K = (const att::bf16*)(ZR + (size_t)b_ * T * ZP + ZC_DK + 128 * h_); \
        r_.V = (const att::bf16*)(ZR + (size_t)b_ * T * ZP + ZC_DV + 128 * h_); r_.P0 = 256 * qb_; r_.koff = 0; r_.mask = BITM + row_ * 256; } while (0)
                    int ic = q_fetch(head, slot);
                    if (ic < 256) {
                        int in_ = q_fetch(head, slot);
                        Ref cur; DSA2_REF(ic, cur);
                        att::Seam<att::bf16> S;
                        att::causal_swa_prime<att::bf16, att::bf16, false>(cur, T, (char*)lds_, S);
                        for (;;) {
                            const bool last = in_ >= 256;
                            Ref nxt = cur; if (!last) DSA2_REF(in_, nxt);
                            {
                                if (tid == 0) { gu32* dw = CTL + CW_DONE + 64 * (64 * l + (((ic >> 2) & 1) * 32 + (31 - (ic >> 3)))); unsigned sp = 0;
                                    while (__hip_atomic_load(dw, RLX_AGENT) < 8u) { __builtin_amdgcn_s_sleep(2); if (++sp > (1u << 24)) { __hip_atomic_store(CTL + CW_TMO, 1u, RLX_AGENT); break; } }
                                    __builtin_amdgcn_fence(__ATOMIC_ACQUIRE, "agent"); asm volatile("s_waitcnt vmcnt(0)" ::: "memory"); }
                                __syncthreads();
                            }
#ifndef NO_DSA2
                            att::causal_swa_block<att::bf16, att::bf16, false, true, QP>(cur, nxt, T, T, (char*)lds_, S);
#endif
                            if (last) break;
                            cur = nxt; ic = in_; in_ = q_fetch(head, slot);
                        }
                    }
                }
                {
#ifdef DUP_DIFF
                  for (int rep_ = 0; rep_ < 2; ++rep_) {
                    gu32* head = rep_ ? CTL + 10240 + 64 * (2 * l + 1) : CTL + CW_Q + 64 * (3 * l + 2);
#else
                  {
                    gu32* head = CTL + CW_Q + 64 * (3 * l + 2);
#endif
                    typedef att::BlockRef<att::bf16, att::bf16> Ref;
#define DIFF_REF(i_, r_) do { const int qb_ = 31 - ((i_) >> 4), b_ = ((i_) >> 3) & 1, h_ = ((i_) >> 1) & 3, mp_ = (i_) & 1; const size_t row_ = (size_t)b_ * T + 256 * qb_; \
        r_.Q = (const att::bf16*)(Q3 + row_ * QP + 1024 + 128 * h_ + 64 * mp_); r_.O = (att::bf16*)((mp_ ? O2 : O1) + row_ * 512 + 128 * h_); \
        r_.K = (const att::bf16*)(ZR + (size_t)b_ * T * ZP + ZC_FK + 128 * h_); r_.V = (const att::bf16*)(ZR + (size_t)b_ * T * ZP + ZC_FV + 128 * h_); r_.P0 = 256 * qb_; r_.koff = 128 * mp_; r_.mask = nullptr; } while (0)
                    int ic = q_fetch(head, slot);
                    if (ic < 512) {
                        int in_ = q_fetch(head, slot);
                        Ref cur; DIFF_REF(ic, cur);
                        att::Seam<att::bf16> S;
                        att::causal_swa_prime<att::bf16, att::bf16, true>(cur, T, (char*)lds_, S);
                        for (;;) {
                            const bool last = in_ >= 512;
                            Ref nxt = cur; if (!last) DIFF_REF(in_, nxt);
#ifndef NO_DIFF
                            att::causal_swa_block<att::bf16, att::bf16, true, false, 512>(cur, nxt, T, T, (char*)lds_, S);
#endif
                            if (last) break;
                            cur = nxt; ic = in_; in_ = q_fetch(head, slot);
                        }
                    }
                  }
                }
                SEAM(pm + 2);
            }
            if (IN(pm + 3)) { WSL();
                RPostP rp{ZR, Q3, YRAW, RDOTK, KIN(9) + l * 1792, KIN(14) + l * 128 * 512, KIN(18) + l * 512, KIN(19) + l * 512};
#ifndef NO_RPOST
                rwkv_post(rp, lds);
#endif
                constexpr float lambda_init = L == 0 ? 0.2f : 0.35550906759096927f;
                DPostP dq{O1, O2, Q3, KIN(20) + l * 64, KIN(21) + l * 64, KIN(22) + l * 64, KIN(23) + l * 64, KIN(24) + l * 128, lambda_init};
                diff_post(dq, gw, NGW, lane);
                SEAM(pm + 3);
            }
            if (IN(pm + 4)) { WSL();
                pg8::Gemm g{XN, WMi + (size_t)5632 * DM, M, 3072, DM, DM}; pg8::StaticOrder S; S.init(M, 3072, G, bid);
#ifdef GATE_RAW
                pg8::EpiStore<0> E{G3, 3072, G3, 3072, 1 << 30};
                pg8::gemm_phase<pg8::EpiStore<0>, pg8::StaticOrder, true, true>(lds, g, S, E);
#else
                pg8::EpiStore<1> E{G3, 3072, G3, 3072, 1 << 30};
                pg8::gemm_phase<pg8::EpiStore<1>, pg8::StaticOrder, true, true>(lds, g, S, E);
#endif
                SEAM(pm + 4);
            }
            if (IN(pm + 5)) { WSL();
#pragma unroll 1
                for (int n = 0; n < 3; ++n) {
                    pg8::Gemm g{Q3 + 512 * n, WMb + (size_t)n * DM * 512, M, DM, 512, QP}; pg8::StaticOrder S; S.init(M, DM, G, bid);
                    pg8::EpiGateMul E{MG, DM, G3 + 1024 * n, 3072, n == 0 ? 1 : 0};
                    pg8::gemm_phase<pg8::EpiGateMul, pg8::StaticOrder, true, true>(lds, g, S, E);
                    VM_WAIT(); __syncthreads();
                }
                SEAM(pm + 5);
            }
            if (IN(pm + 6)) { WSL();
                pg8::Gemm g{MG, WMo, M, DM, DM, DM}; pg8::StaticOrder S; S.init(M, DM, G, bid);
                pg8::EpiStore<0> E{YP, DM, YP, DM, 1 << 30};
                pg8::gemm_phase<pg8::EpiStore<0>, pg8::StaticOrder, true, true>(lds, g, S, E);
                SEAM(pm + 6);
            }
            if (IN(pm + 7)) { WSL();
                rownorm_rows<true, true>(XB, YP, 1.0f, KIN(7) + l * DM, l == NLAYER - 1 ? XB2 : XB, KIN(27) + l * DM, XN, gw, NGW, lane);
                CONV_FFN(l, 1);
                SEAM(pm + 7);
            }
}

__global__ void __launch_bounds__(NWAVES * 64, 2) mk_fwd(Args args) {
    extern __shared__ __attribute__((aligned(16))) unsigned char lds_[];
    LAS unsigned char* lds = (LAS unsigned char*)lds_;
    { const int tid = otid_(); if (tid < 64) MISC[tid] = 0u; }
    __syncthreads();
    (void)xcd_barrier_post((unsigned*)(kws_() + WS_CTL) + CW_BAR, MISC + 8);
    if (IN(0)) { WSL();
        CONV_FFN(0, 0);
        rownorm_rows<false, false>(KIN(0), nullptr, 0.f, nullptr, nullptr, KIN(1), XN, gw, NGW, lane);
        SEAM(0);
    }
    ffn_part<0, 0>(lds); mixer_part<0>(lds, lds_); ffn_part<0, 1>(lds);
    ffn_part<1, 0>(lds); mixer_part<1>(lds, lds_); ffn_part<1, 1>(lds);
}

#if PROBE
__device__ __forceinline__ void probe_acc(float num, float den, float* ctlf) {
    __shared__ float rn[256], rd[256];
    rn[threadIdx.x] = num; rd[threadIdx.x] = den; __syncthreads();
    for (int o = 128; o > 0; o >>= 1) { if ((int)threadIdx.x < o) { rn[threadIdx.x] += rn[threadIdx.x + o]; rd[threadIdx.x] += rd[threadIdx.x + o]; } __syncthreads(); }
    if (threadIdx.x == 0) { atomicAdd(ctlf + CW_PROBE, rn[0]); atomicAdd(ctlf + CW_PROBE + 1, rd[0]); }
}
__global__ void __launch_bounds__(256) probe_ffn(const unsigned char* ws, const float* Wg, const float* Wu, const float* Wd) {
    __shared__ float xn[1024]; __shared__ float hid[2816];
    const int m = 777 + 1931 * blockIdx.x, tid = threadIdx.x;
    const bf16* XNp = (const bf16*)(ws + WS_XN); const bf16* YPp = (const bf16*)(ws + WS_R2);
    for (int k = tid; k < 1024; k += 256) xn[k] = bf1(XNp[(size_t)m * 1024 + k]);
    __syncthreads();
    for (int j = tid; j < 2816; j += 256) { float g = 0.f, u = 0.f; for (int k = 0; k < 1024; ++k) { g += xn[k] * Wg[(size_t)k * 2816 + j]; u += xn[k] * Wu[(size_t)k * 2816 + j]; } hid[j] = g / (1.f + expf(-g)) * u; }
    __syncthreads();
    float num = 0.f, den = 0.f;
    for (int d = tid; d < 1024; d += 256) { float o = 0.f; for (int j = 0; j < 2816; ++j) o += hid[j] * Wd[(size_t)j * 1024 + d]; const float got = bf1(YPp[(size_t)m * 1024 + d]); num += (o - got) * (o - got); den += o * o; }
    probe_acc(num, den, (float*)(ws + WS_CTL));
}
__global__ void __launch_bounds__(256) probe_win(const unsigned char* ws, const float* Win) {
    __shared__ float xn[1024];
    const int m = 555 + 1999 * blockIdx.x, tid = threadIdx.x;
    const bf16* XNp = (const bf16*)(ws + WS_XN); const bf16* Q3p = (const bf16*)(ws + WS_Q3); const bf16* ZRp = (const bf16*)(ws + WS_ZR);
    for (int k = tid; k < 1024; k += 256) xn[k] = bf1(XNp[(size_t)m * 1024 + k]);
    __syncthreads();
    float num = 0.f, den = 0.f;
    for (int c = tid; c < 5448; c += 256) {
        float z = 0.f; for (int k = 0; k < 1024; ++k) z += xn[k] * Win[(size_t)k * NIN + c];
        float got;
        if (c < 512) got = bf1(Q3p[(size_t)m * QP + c]);
        else if (c < 2120) got = bf1(ZRp[(size_t)m * ZP + (c - 512)]);
        else if (c < 2632) got = bf1(Q3p[(size_t)m * QP + 512 + (c - 2120)]);
        else if (c < 3912) got = bf1(ZRp[(size_t)m * ZP + (c - 840)]);
        else if (c < 4424) got = bf1(Q3p[(size_t)m * QP + 1024 + (c - 3912)]);
        else got = bf1(ZRp[(size_t)m * ZP + (c - 1352)]);
        num += (z - got) * (z - got); den += z * z;
    }
    probe_acc(num, den, (float*)(ws + WS_CTL));
}
__global__ void __launch_bounds__(256) probe_wconv(const unsigned char* ws, const float* Win, int r0) {
    const bf16* WMp = (const bf16*)(ws + WS_WM); const int tid = threadIdx.x;
    float num = 0.f, den = 0.f;
    for (int rr = 0; rr < 64; ++rr) { const int n = r0 + 64 * blockIdx.x + rr; MapWin mw{Win, NIN}; const float* cp = mw.col(n);
        for (int k = tid; k < 1024; k += 256) { const float ref = cp ? cp[(size_t)k * NIN] : 0.f; const float got = bf1(WMp[(size_t)n * 1024 + k]); num += (ref - got) * (ref - got); den += ref * ref; } }
    probe_acc(num, den, (float*)(ws + WS_CTL));
}
__global__ void __launch_bounds__(256) probe_merge(const unsigned char* ws, const float* Win, const float* Wb, const float* Wo, int which) {
    __shared__ float xn[1024]; __shared__ float y[1536]; __shared__ float mg[1024];
    const int m = 333 + 2003 * blockIdx.x, tid = threadIdx.x;
    const bf16* XNp = (const bf16*)(ws + WS_XN); const bf16* Q3p = (const bf16*)(ws + WS_Q3); const bf16* MGp = (const bf16*)(ws + WS_MG); const bf16* YPp = (const bf16*)(ws + WS_R2);
    for (int k = tid; k < 1024; k += 256) xn[k] = bf1(XNp[(size_t)m * 1024 + k]);
    for (int k = tid; k < 1536; k += 256) y[k] = bf1(Q3p[(size_t)m * QP + k]);
    __syncthreads();
    float num = 0.f, den = 0.f;
    for (int d = tid; d < 1024; d += 256) {
        float acc = 0.f;
        for (int n = 0; n < 3; ++n) { float g = 0.f; for (int k = 0; k < 1024; ++k) g += xn[k] * Win[(size_t)k * NIN + 5448 + n * 1024 + d];
            float p = 0.f; for (int c = 0; c < 512; ++c) p += y[512 * n + c] * Wb[((size_t)n * 512 + c) * 1024 + d];
            acc += p / (1.f + expf(-g)); }
        mg[d] = acc; const float got = bf1(MGp[(size_t)m * 1024 + d]); if (which == 0) { num += (acc - got) * (acc - got); den += acc * acc; }
        if (which == 2) { const bf16* G3p = (const bf16*)(ws + WS_ZR); for (int n = 0; n < 3; ++n) { float g = 0.f; for (int k = 0; k < 1024; ++k) g += xn[k] * Win[(size_t)k * NIN + 5448 + n * 1024 + d];
            const float sg = 1.f / (1.f + expf(-g)), gg = bf1(G3p[(size_t)m * 3072 + n * 1024 + d]); num += (sg - gg) * (sg - gg); den += sg * sg; } }
        if (which == 3) { const bf16* G3p = (const bf16*)(ws + WS_ZR); float a2 = 0.f; for (int n = 0; n < 3; ++n) { float p = 0.f; for (int c = 0; c < 512; ++c) p += y[512 * n + c] * Wb[((size_t)n * 512 + c) * 1024 + d];
            a2 += p * bf1(G3p[(size_t)m * 3072 + n * 1024 + d]); } num += (a2 - got) * (a2 - got); den += a2 * a2; }
    }
    __syncthreads();
    if (which == 1) for (int d = tid; d < 1024; d += 256) { float o = 0.f; for (int j = 0; j < 1024; ++j) o += mg[j] * Wo[(size_t)j * 1024 + d]; const float got = bf1(YPp[(size_t)m * 1024 + d]); num += (o - got) * (o - got); den += o * o; }
    probe_acc(num, den, (float*)(ws + WS_CTL));
}
#endif
#ifndef MK_ONE_LAUNCH
#define MK_ONE_LAUNCH 0
#endif
extern "C" void kernel_launch(void* const* d_in, const int* in_sizes, int n_in, void* d_out, int out_size, void* d_ws, size_t ws_size, hipStream_t stream) {
    static int grid = 0;
    if (grid == 0) {
        if (n_in != 32 || in_sizes[0] != M * DM || out_size != M * DM || ws_size < WS_END) { fprintf(stderr, "kernel_launch: unexpected shapes / workspace (n_in %d, ws %zu)\n", n_in, ws_size); grid = -1; return; }
        int dev = 0, cus = 0;
        if (hipGetDevice(&dev) != hipSuccess || hipDeviceGetAttribute(&cus, hipDeviceAttributeMultiprocessorCount, dev) != hipSuccess) { grid = -1; return; }
        if (hipFuncSetAttribute((const void*)mk_fwd, hipFuncAttributeMaxDynamicSharedMemorySize, LDS_BYTES) != hipSuccess) { fprintf(stderr, "kernel_launch: hipFuncSetAttribute failed\n"); grid = -1; return; }
        int per_cu = 0;
        if (hipOccupancyMaxActiveBlocksPerMultiprocessor(&per_cu, (const void*)mk_fwd, NWAVES * 64, LDS_BYTES) != hipSuccess || per_cu < 1) { fprintf(stderr, "kernel_launch: occupancy query says %d\n", per_cu); }
        (void)hipGetLastError();
        grid = cus;
    }
    if (grid < 0) return;
    (void)hipMemsetAsync((char*)d_ws + WS_CTL, 0, CTL_ZERO_BYTES, stream);
    Args a{};
    for (int i = 0; i < 32; ++i) a.in[i] = (const float*)d_in[i];
    a.out = (float*)d_out; a.ws = (unsigned char*)d_ws;
#if MK_ONE_LAUNCH
    a.ph_lo = 0; a.ph_hi = N_PHASES;
    hipLaunchKernelGGL(mk_fwd, dim3(grid), dim3(NWAVES * 64), LDS_BYTES, stream, a);
#else
    for (int p = 0; p < N_PHASES; ++p) { a.ph_lo = p; a.ph_hi = p + 1; hipLaunchKernelGGL(mk_fwd, dim3(grid), dim3(NWAVES * 64), LDS_BYTES, stream, a);
#if PROBE == 1
        if (p == 2) hipLaunchKernelGGL(probe_ffn, dim3(8), dim3(256), 0, stream, (const unsigned char*)d_ws, a.in[3], a.in[4], a.in[5]);
#elif PROBE == 2
        if (p == 4) hipLaunchKernelGGL(probe_win, dim3(8), dim3(256), 0, stream, (const unsigned char*)d_ws, a.in[8]);
#elif PROBE == 3
        if (p == 8) hipLaunchKernelGGL(probe_merge, dim3(8), dim3(256), 0, stream, (const unsigned char*)d_ws, a.in[8], a.in[25], a.in[26], 0);
#elif PROBE == 5
        if (p == 8) hipLaunchKernelGGL(probe_merge, dim3(8), dim3(256), 0, stream, (const unsigned char*)d_ws, a.in[8], a.in[25], a.in[26], 2);
#elif PROBE == 6
        if (p == 8) hipLaunchKernelGGL(probe_merge, dim3(8), dim3(256), 0, stream, (const unsigned char*)d_ws, a.in[8], a.in[25], a.in[26], 3);
#elif PROBE == 7
        if (p == 6) hipLaunchKernelGGL(probe_wconv, dim3(48), dim3(256), 0, stream, (const unsigned char*)d_ws, a.in[8], 5632);
#elif PROBE == 8
        if (p == 3) hipLaunchKernelGGL(probe_wconv, dim3(48), dim3(256), 0, stream, (const unsigned char*)d_ws, a.in[8], 5632);
#elif PROBE == 9
        if (p == 7) hipLaunchKernelGGL(probe_merge, dim3(8), dim3(256), 0, stream, (const unsigned char*)d_ws, a.in[8], a.in[25], a.in[26], 2);
#elif PROBE == 4
        if (p == 9) hipLaunchKernelGGL(probe_merge, dim3(8), dim3(256), 0, stream, (const unsigned char*)d_ws, a.in[8], a.in[25], a.in[26], 1);
#endif
    }
#endif
}
```
